# Optimizing an MI355X kernel written in HIP

```python
import math
import jax
import jax.numpy as jnp
from jax import lax
import numpy as np

D_MODEL = 1024
BATCH = 2
SEQ = 16384
DEPTH = 2

RW_HEADS = 8
RW_HEAD_DIM = 64
RW_WIDTH = RW_HEADS * RW_HEAD_DIM
RW_DECAY_LORA = 64
RW_AAA_LORA = 64
RW_GATE_LORA = 128
RW_MV_LORA = 32
RW_GN_EPS = 64e-5
SSM_HEADS = 8
SSM_HEAD_DIM = 64
SSM_INNER = SSM_HEADS * SSM_HEAD_DIM
SSM_GROUPS = 2
SSM_STATE = 128
SSM_CONV = 4
SSM_CHUNK = 128
SSM_CONV_DIM = SSM_INNER + 2 * SSM_GROUPS * SSM_STATE
SSM_NORM_GROUP = SSM_INNER // SSM_GROUPS
RET_HEADS = 8
RET_HEAD_DIM = 64
RET_WIDTH = RET_HEADS * RET_HEAD_DIM
RET_CHUNK = 128
ROPE_BASE = 10000.0
N_BRANCH = 3
BRANCH_WIDTH = 512
D_FF = 2816
N_EXPERTS = 8
TOP_K = 2
D_FF_EXPERT = 3584
N_DENSE = (DEPTH + 1) // 2
N_MOE = DEPTH // 2
RMS_EPS = 1e-6

RW_COLS = 3 * RW_WIDTH + RW_DECAY_LORA + RW_AAA_LORA + RW_GATE_LORA
SSM_COLS = SSM_INNER + SSM_CONV_DIM + SSM_HEADS
RET_COLS = 4 * RET_WIDTH
GATE_COLS = N_BRANCH * D_MODEL
IN_COLS = RW_COLS + SSM_COLS + RET_COLS + GATE_COLS

kernel_name = 'hybrid_rwkv7_ssd_retention_moe'


def rms_norm(x, w):
    xf = x.astype(jnp.float32)
    y = xf * lax.rsqrt(jnp.mean(xf * xf, axis=-1, keepdims=True) + RMS_EPS)
    return (y * w.astype(jnp.float32)).astype(x.dtype)


def token_shift(x):
    return jnp.pad(x, ((0, 0), (1, 0), (0, 0)))[:, :-1]


def rwkv7_mix(p, mu, w_up, w0, a_up, a0, g_up, k_k, k_a, r_k, gn_w, gn_b, v_first, vres):
    bsz, T, _ = p.shape
    xm = p + (token_shift(p) - p) * mu
    o1, o2, o3 = RW_WIDTH, 2 * RW_WIDTH, 3 * RW_WIDTH
    o4 = o3 + RW_DECAY_LORA
    o5 = o4 + RW_AAA_LORA
    r, k, v = xm[..., :o1], xm[..., o1:o2], xm[..., o2:o3]
    xw, xa, xg = xm[..., o3:o4], xm[..., o4:o5], xm[..., o5:]
    log_decay = -jnp.exp(-jax.nn.softplus(-(w0 + jnp.tanh(xw) @ w_up)) - 0.5)
    a = jax.nn.sigmoid(a0 + xa @ a_up)
    g = jax.nn.sigmoid(xg) @ g_up
    if vres is None:
        v_first = v
    else:
        v_down, v_up, v0 = vres
        v = v + (v_first - v) * jax.nn.sigmoid(v0 + (v @ v_down) @ v_up)
    heads = lambda t: t.reshape(bsz, T, RW_HEADS, RW_HEAD_DIM)
    kk = heads(k * k_k)
    kk = kk * lax.rsqrt(jnp.maximum(jnp.sum(kk * kk, -1, keepdims=True), 1e-24))
    k = k * (1.0 + (a - 1.0) * k_a)
    r_h, k_h, v_h, a_h = heads(r), heads(k), heads(v), heads(a)
    seq_in = tuple(jnp.moveaxis(t, 1, 0) for t in
                   (r_h, heads(jnp.exp(log_decay)), k_h, v_h, -kk, kk * a_h))

    def step(state, inp):
        r_t, w_t, k_t, v_t, a_t, b_t = inp
        sa = jnp.einsum('bhij,bhj->bhi', state, a_t)
        state = (state * w_t[:, :, None, :] + sa[..., None] * b_t[:, :, None, :]
                 + v_t[..., None] * k_t[:, :, None, :])
        return state, jnp.einsum('bhij,bhj->bhi', state, r_t)

    s0 = jnp.zeros((bsz, RW_HEADS, RW_HEAD_DIM, RW_HEAD_DIM), jnp.float32)
    _, y = lax.scan(step, s0, seq_in, unroll=8)
    y = jnp.moveaxis(y, 0, 1)
    mean = jnp.mean(y, -1, keepdims=True)
    var = jnp.mean(jnp.square(y - mean), -1, keepdims=True)
    y = ((y - mean) * lax.rsqrt(var + RW_GN_EPS)).reshape(bsz, T, RW_WIDTH) * gn_w + gn_b
    bonus = jnp.sum(r_h * k_h * r_k, -1, keepdims=True) * v_h
    out = (y + bonus.reshape(bsz, T, RW_WIDTH)) * g
    return out, v_first


def causal_depthwise_conv(x, w, b):
    C = x.shape[-1]
    rhs = jnp.transpose(w).astype(x.dtype)[:, None, :]
    y = lax.conv_general_dilated(x, rhs, window_strides=(1,), padding=[(SSM_CONV - 1, 0)],
                                 dimension_numbers=('NWC', 'WIO', 'NWC'), feature_group_count=C)
    return y + b


def ssd_chunked(x, a, b, c):
    bsz, T, H, P = x.shape
    G, N = b.shape[-2], b.shape[-1]
    HG = H // G
    Q = SSM_CHUNK
    nc = T // Q
    x = x.reshape(bsz, nc, Q, G, HG, P)
    b = b.reshape(bsz, nc, Q, G, N)
    c = c.reshape(bsz, nc, Q, G, N)
    a = a.reshape(bsz, nc, Q, G, HG).transpose(0, 3, 4, 1, 2)
    a_cs = jnp.cumsum(a, axis=-1)
    causal = jnp.tril(jnp.ones((Q, Q), bool))
    seg = a_cs[..., :, None] - a_cs[..., None, :]
    L = jnp.where(causal, jnp.exp(jnp.where(causal, seg, 0.0)), 0.0)
    cb = jnp.einsum('bclgn,bcsgn->bgcls', c, b)
    y_diag = jnp.einsum('bghcls,bcsghp->bclghp', cb[:, :, None] * L, x)
    decay_states = jnp.exp(a_cs[..., -1:] - a_cs)
    states = jnp.einsum('bclgn,bghcl,bclghp->bcghpn', b, decay_states, x)
    chunk_decay = jnp.exp(a_cs[..., -1])

    def step(s, inp):
        st, dec = inp
        return dec[..., None, None] * s + st, s

    s0 = jnp.zeros((bsz, G, HG, P, N), x.dtype)
    _, prev = lax.scan(step, s0, (jnp.moveaxis(states, 1, 0), jnp.moveaxis(chunk_decay, -1, 0)))
    prev = jnp.moveaxis(prev, 0, 1)
    y_off = jnp.einsum('bclgn,bcghpn,bghcl->bclghp', c, prev, jnp.exp(a_cs))
    return (y_diag + y_off).reshape(bsz, T, H, P)


def mamba2_mix(p, conv_w, conv_b, dt_bias, a_log, d_skip, norm_w):
    bsz, T, _ = p.shape
    z = p[..., :SSM_INNER]
    xbc = p[..., SSM_INNER:SSM_INNER + SSM_CONV_DIM]
    dt = p[..., SSM_INNER + SSM_CONV_DIM:]
    xbc = jax.nn.silu(causal_depthwise_conv(xbc, conv_w, conv_b))
    nb = SSM_GROUPS * SSM_STATE
    xs = xbc[..., :SSM_INNER].reshape(bsz, T, SSM_HEADS, SSM_HEAD_DIM)
    bm = xbc[..., SSM_INNER:SSM_INNER + nb].reshape(bsz, T, SSM_GROUPS, SSM_STATE)
    cm = xbc[..., SSM_INNER + nb:].reshape(bsz, T, SSM_GROUPS, SSM_STATE)
    dt = jax.nn.softplus(dt + dt_bias)
    A = -jnp.exp(a_log)
    y = ssd_chunked(xs * dt[..., None], A * dt, bm, cm)
    y = y + d_skip[:, None] * xs
    y = y.reshape(bsz, T, SSM_INNER) * jax.nn.silu(z)
    yg = y.reshape(bsz, T, SSM_GROUPS, SSM_NORM_GROUP)
    yg = yg * lax.rsqrt(jnp.mean(yg * yg, -1, keepdims=True) + RMS_EPS)
    return yg.reshape(bsz, T, SSM_INNER) * norm_w


def rotary(t, positions):
    half = RET_HEAD_DIM // 2
    inv_freq = ROPE_BASE ** (-jnp.arange(half, dtype=jnp.float32) / half)
    ang = positions.astype(jnp.float32)[:, None] * inv_freq[None, :]
    cos = jnp.cos(ang)[None, :, None, :]
    sin = jnp.sin(ang)[None, :, None, :]
    t1, t2 = t[..., 0::2], t[..., 1::2]
    return jnp.stack([t1 * cos - t2 * sin, t1 * sin + t2 * cos], axis=-1).reshape(t.shape)


def retention_mix(p, positions):
    bsz, T, _ = p.shape
    H, Dh, Q = RET_HEADS, RET_HEAD_DIM, RET_CHUNK
    nc = T // Q
    q = rotary(p[..., :RET_WIDTH].reshape(bsz, T, H, Dh), positions)
    k = rotary(p[..., RET_WIDTH:2 * RET_WIDTH].reshape(bsz, T, H, Dh), positions) * (Dh ** -0.5)
    v = p[..., 2 * RET_WIDTH:3 * RET_WIDTH].reshape(bsz, T, H, Dh)
    g = p[..., 3 * RET_WIDTH:]
    log_gamma = jnp.log1p(-jnp.exp2(-5.0 - jnp.arange(H, dtype=jnp.float32)))
    q, k, v = (t.reshape(bsz, nc, Q, H, Dh) for t in (q, k, v))
    idx = jnp.arange(Q, dtype=jnp.float32)
    rel = idx[:, None] - idx[None, :]
    causal = rel >= 0
    decay_in = jnp.where(causal, jnp.exp(jnp.where(causal, rel, 0.0)[None] * log_gamma[:, None, None]), 0.0)
    scores = jnp.einsum('bclhd,bcshd->bchls', q, k) * decay_in
    y_in = jnp.einsum('bchls,bcshe->bclhe', scores, v)
    zeta = jnp.exp((Q - 1 - idx)[None, :] * log_gamma[:, None])
    kv = jnp.einsum('bcshd,hs,bcshe->bchde', k, zeta, v)
    chunk_decay = jnp.exp(Q * log_gamma)[:, None, None]

    def step(state, kv_c):
        return chunk_decay * state + kv_c, state

    _, prev = lax.scan(step, jnp.zeros((bsz, H, Dh, Dh), jnp.float32), jnp.moveaxis(kv, 1, 0))
    prev = jnp.moveaxis(prev, 0, 1)
    xi = jnp.exp((idx + 1.0)[None, :] * log_gamma[:, None])
    y_cross = jnp.einsum('bclhd,bchde,hl->bclhe', q, prev, xi)
    y = (y_in + y_cross).reshape(bsz, T, H, Dh)
    y = y * lax.rsqrt(jnp.mean(y * y, -1, keepdims=True) + RMS_EPS)
    return y.reshape(bsz, T, RET_WIDTH) * jax.nn.silu(g)


def swiglu(x, wg, wu, wd):
    return (jax.nn.silu(x @ wg) * (x @ wu)) @ wd


def moe_swiglu(x, router, wg, wu, wd):
    logits = (x @ router).astype(jnp.float32)
    top_v, top_i = lax.top_k(logits, TOP_K)
    top_w = jax.nn.softmax(top_v, axis=-1)
    gates = jnp.sum(jax.nn.one_hot(top_i, N_EXPERTS, dtype=jnp.float32) * top_w[..., None], axis=-2)
    gates = gates.astype(x.dtype)
    out = jnp.zeros_like(x)
    for e in range(N_EXPERTS):
        out = out + gates[..., e:e + 1] * swiglu(x, wg[e], wu[e], wd[e])
    return out


def setup_inputs(seed: int = 0) -> dict:
    key = jax.random.key(seed)
    ks = iter(jax.random.split(key, 48))
    f32 = jnp.float32

    def nrm(shape, scale):
        return jax.random.normal(next(ks), shape, f32) * scale

    def unif(shape, lo, hi):
        return jax.random.uniform(next(ks), shape, f32, lo, hi)

    L, Lv = DEPTH, DEPTH - 1
    dt_init = jnp.exp(unif((L, SSM_HEADS), math.log(1e-3), math.log(1e-1)))
    return {
        'x': nrm((BATCH, SEQ, D_MODEL), 1.0),
        'norm1_w': 1.0 + nrm((L, D_MODEL), 0.1),
        'w_in': nrm((L, D_MODEL, IN_COLS), D_MODEL ** -0.5),
        'rw_mu': unif((L, RW_COLS), 0.0, 1.0),
        'rw_w_up': nrm((L, RW_DECAY_LORA, RW_WIDTH), 0.1 * RW_DECAY_LORA ** -0.5),
        'rw_w0': unif((L, RW_WIDTH), -4.0, 1.0),
        'rw_a_up': nrm((L, RW_AAA_LORA, RW_WIDTH), 0.5 * RW_AAA_LORA ** -0.5),
        'rw_a0': nrm((L, RW_WIDTH), 0.5),
        'rw_g_up': nrm((L, RW_GATE_LORA, RW_WIDTH), RW_GATE_LORA ** -0.5),
        'rw_k_k': 0.85 + nrm((L, RW_WIDTH), 0.1),
        'rw_k_a': 1.0 + nrm((L, RW_WIDTH), 0.1),
        'rw_r_k': nrm((L, RW_HEADS, RW_HEAD_DIM), 0.1),
        'rw_gn_w': 1.0 + nrm((L, RW_WIDTH), 0.1),
        'rw_gn_b': nrm((L, RW_WIDTH), 0.01),
        'rw_v_down': nrm((Lv, RW_WIDTH, RW_MV_LORA), RW_WIDTH ** -0.5),
        'rw_v_up': nrm((Lv, RW_MV_LORA, RW_WIDTH), 0.5 * RW_MV_LORA ** -0.5),
        'rw_v0': 1.0 + nrm((Lv, RW_WIDTH), 0.1),
        'ssm_conv_w': nrm((L, SSM_CONV_DIM, SSM_CONV), SSM_CONV ** -0.5),
        'ssm_conv_b': nrm((L, SSM_CONV_DIM), 0.01),
        'ssm_dt_bias': dt_init + jnp.log(-jnp.expm1(-dt_init)),
        'ssm_a_log': jnp.log(unif((L, SSM_HEADS), 1.0, 16.0)),
        'ssm_d': 1.0 + nrm((L, SSM_HEADS), 0.1),
        'ssm_norm_w': 1.0 + nrm((L, SSM_INNER), 0.1),
        'w_branch': nrm((L, N_BRANCH, BRANCH_WIDTH, D_MODEL), BRANCH_WIDTH ** -0.5),
        'w_out': nrm((L, D_MODEL, D_MODEL), D_MODEL ** -0.5),
        'norm2_w': 1.0 + nrm((L, D_MODEL), 0.1),
        'ffn_wg': nrm((N_DENSE, D_MODEL, D_FF), D_MODEL ** -0.5),
        'ffn_wu': nrm((N_DENSE, D_MODEL, D_FF), D_MODEL ** -0.5),
        'ffn_wd': nrm((N_DENSE, D_FF, D_MODEL), D_FF ** -0.5),
        'moe_router': nrm((N_MOE, D_MODEL, N_EXPERTS), D_MODEL ** -0.5),
        'moe_wg': nrm((N_MOE, N_EXPERTS, D_MODEL, D_FF_EXPERT), D_MODEL ** -0.5),
        'moe_wu': nrm((N_MOE, N_EXPERTS, D_MODEL, D_FF_EXPERT), D_MODEL ** -0.5),
        'moe_wd': nrm((N_MOE, N_EXPERTS, D_FF_EXPERT, D_MODEL), D_FF_EXPERT ** -0.5),
        'final_norm_w': 1.0 + nrm((D_MODEL,), 0.1),
    }


def reference(x, norm1_w, w_in, rw_mu, rw_w_up, rw_w0, rw_a_up, rw_a0, rw_g_up, rw_k_k, rw_k_a,
              rw_r_k, rw_gn_w, rw_gn_b, rw_v_down, rw_v_up, rw_v0, ssm_conv_w, ssm_conv_b,
              ssm_dt_bias, ssm_a_log, ssm_d, ssm_norm_w, w_branch, w_out, norm2_w, ffn_wg,
              ffn_wu, ffn_wd, moe_router, moe_wg, moe_wu, moe_wd, final_norm_w):
    act_dtype = x.dtype
    f32 = jnp.float32
    positions = jnp.arange(x.shape[1])
    c1 = RW_COLS
    c2 = c1 + SSM_COLS
    c3 = c2 + RET_COLS
    v_first = None
    for layer in range(DEPTH):
        h = rms_norm(x, norm1_w[layer])
        wl = w_in[layer]
        p_rw = (h @ wl[:, :c1]).astype(f32)
        p_ssm = (h @ wl[:, c1:c2]).astype(f32)
        p_ret = (h @ wl[:, c2:c3]).astype(f32)
        gate_logits = h @ wl[:, c3:]
        vres = None if layer == 0 else (rw_v_down[layer - 1], rw_v_up[layer - 1], rw_v0[layer - 1])
        y_rw, v_first = rwkv7_mix(p_rw, rw_mu[layer], rw_w_up[layer], rw_w0[layer], rw_a_up[layer],
                                  rw_a0[layer], rw_g_up[layer], rw_k_k[layer], rw_k_a[layer],
                                  rw_r_k[layer], rw_gn_w[layer], rw_gn_b[layer], v_first, vres)
        y_ssm = mamba2_mix(p_ssm, ssm_conv_w[layer], ssm_conv_b[layer], ssm_dt_bias[layer],
                           ssm_a_log[layer], ssm_d[layer], ssm_norm_w[layer])
        y_ret = retention_mix(p_ret, positions)
        merged = None
        for i, y_b in enumerate((y_rw, y_ssm, y_ret)):
            gate = jax.nn.sigmoid(gate_logits[..., i * D_MODEL:(i + 1) * D_MODEL].astype(f32)).astype(act_dtype)
            term = gate * (y_b.astype(act_dtype) @ w_branch[layer, i])
            merged = term if merged is None else merged + term
        x = x + merged @ w_out[layer]
        h2 = rms_norm(x, norm2_w[layer])
        j = layer // 2
        if layer % 2 == 0:
            x = x + swiglu(h2, ffn_wg[j], ffn_wu[j], ffn_wd[j])
        else:
            x = x + moe_swiglu(h2, moe_router[j], moe_wg[j], moe_wu[j], moe_wd[j])
    return rms_norm(x, final_norm_w)
```

```cpp
#include <hip/hip_runtime.h>
#include <cstdio>
#include <cstdint>

#ifndef MK_ONE_LAUNCH
#define MK_ONE_LAUNCH 1
#endif

#define LAS __attribute__((address_space(3)))
#define GAS __attribute__((address_space(1)))
typedef unsigned short bf16;
typedef short bf16x8 __attribute__((ext_vector_type(8)));
typedef float f32x4 __attribute__((ext_vector_type(4)));
typedef unsigned u32x4 __attribute__((ext_vector_type(4)));
typedef unsigned u32x2 __attribute__((ext_vector_type(2)));

constexpr int BATCH = 2, T = 16384, D = 1024, M = BATCH * T;
constexpr int INC = 8456;
constexpr int PLD = 5376;
constexpr int NP = 5632;
constexpr int C_RW = 0, C_Z = 1792, C_XBC = 2304, C_RET = 3328, C_RETG = 4864;
constexpr int FF = 2816, FFE = 3584, NE = 8;

constexpr size_t MiB = 1u << 20;
constexpr size_t WS_CTL = 0, CTL_ZERO_BYTES = 64 * 1024;
constexpr size_t WS_RSTD = 1 * MiB, WS_GATES = 2 * MiB, WS_DT = 3 * MiB;
constexpr size_t WS_W = 4 * MiB;
constexpr size_t WL_IN = 0, WL_GATE = 11 * MiB, WL_BR = 17 * MiB, WL_OUT = 20 * MiB, WL_STRIDE = 22 * MiB;
constexpr size_t WS_FFUP = WS_W + 44 * MiB, WS_FFDN = WS_W + 55 * MiB;
constexpr size_t WS_XB = 68 * MiB;
constexpr size_t WS_VF = 132 * MiB;
constexpr size_t WS_BIG = 164 * MiB;
constexpr size_t WS_VMIX = WS_BIG + 336 * MiB, WS_YRW = WS_BIG + 368 * MiB, WS_END = WS_BIG + 400 * MiB;
constexpr size_t WS_MOEW = WS_BIG;
constexpr size_t MOEW_STRIDE = 21 * MiB, MOEW_DN = 14 * MiB;
constexpr size_t WS_ACT = WS_BIG + 168 * MiB;

constexpr int RING_BYTES = 131072, LDSCTL_OFF = RING_BYTES, MISC_OFF = LDSCTL_OFF + 320, LDS_BYTES = 147456;

__device__ __forceinline__ unsigned f2bf(float f) { unsigned u = __builtin_bit_cast(unsigned, f); return (u + 0x7fffu + ((u >> 16) & 1u)) >> 16; }
__device__ __forceinline__ unsigned pk2(float lo, float hi) { return f2bf(lo) | (f2bf(hi) << 16); }
__device__ __forceinline__ float bflo(unsigned u) { return __builtin_bit_cast(float, u << 16); }
__device__ __forceinline__ float bfhi(unsigned u) { return __builtin_bit_cast(float, u & 0xffff0000u); }
__device__ __forceinline__ void unpack8(const u32x4 u, float (&f)[8]) { f[0] = bflo(u.x); f[1] = bfhi(u.x); f[2] = bflo(u.y); f[3] = bfhi(u.y); f[4] = bflo(u.z); f[5] = bfhi(u.z); f[6] = bflo(u.w); f[7] = bfhi(u.w); }
__device__ __forceinline__ u32x4 pack8(const float (&f)[8]) { u32x4 w; w.x = pk2(f[0], f[1]); w.y = pk2(f[2], f[3]); w.z = pk2(f[4], f[5]); w.w = pk2(f[6], f[7]); return w; }
__device__ __forceinline__ float sigm(float x) { return 1.f / (1.f + __expf(-x)); }
__device__ __forceinline__ float silu(float x) { return x / (1.f + __expf(-x)); }
__device__ __forceinline__ float softplus_acc(float x) { return fmaxf(x, 0.f) + log1pf(expf(-fabsf(x))); }
__device__ __forceinline__ float wave_sum(float v) {
#pragma unroll
    for (int o = 1; o < 64; o <<= 1) v += __shfl_xor(v, o);
    return v;
}
__device__ __forceinline__ int otid() { int t = threadIdx.x; asm volatile("" : "+v"(t)); return t; }
#define LDS_WAIT() asm volatile("s_waitcnt lgkmcnt(0)" ::: "memory")

namespace pg8 {
constexpr int BM = 256, BK = 64, HALF = 128, HTB = HALF * BK * 2, STAGE_BYTES = 8 * HTB, NXCD = 8, WGM = 8;
__host__ __device__ __forceinline__ int lds_byte(int r, int c) { const int st = (r >> 4) * 2 + (c >> 5), rr = r & 15, cc = c & 31, ob = rr * 64 + cc * 2; return st * 1024 + (ob ^ (((ob >> 9) & 1) << 5)); }
__host__ __device__ __forceinline__ void stage_rc(int b, int& R, int& C) { const int st = b / 1024, sb = b % 1024, swz = sb ^ (((sb >> 9) & 1) << 5); R = (st >> 1) * 16 + swz / 64; C = (st & 1) * 32 + (swz % 64) / 2; }
__host__ __device__ __forceinline__ int perm32(int rho) { const int n = rho >> 4, i = rho & 15; return 8 * (i >> 2) + 4 * n + (i & 3); }

struct Unit { int pm, pn; };
struct Gemm { const bf16* A; const bf16* Bt; int lda, ldb, K; };

struct StaticOrder {
    int nM, nN, nwg, G, c;
    __device__ void init(int Mrows, int N, int G_, int c_) { nM = Mrows / BM; nN = N / BM; nwg = nM * nN; G = G_; c = c_; }
    __device__ bool next(int i, Unit& u) const {
        const long L = (long)i * G + c; if (L >= nwg) return false;
        int wgid = (int)L; { const int q = nwg / NXCD, r = nwg % NXCD, xcd = wgid % NXCD, off = wgid / NXCD; wgid = (xcd < r ? xcd * (q + 1) : r * (q + 1) + (xcd - r) * q) + off; }
        const int nig = WGM * nN, gid = wgid / nig, fm = gid * WGM, gsz = (nM - fm) < WGM ? (nM - fm) : WGM;
        u.pm = fm + ((wgid % nig) % gsz); u.pn = (wgid % nig) / gsz; return true;
    }
};

template <class Epi>
__device__ __forceinline__ void gemm_phase(LAS unsigned char* lds, const Gemm g, const StaticOrder& S, const Epi& E) {
    const int tid = otid(), wid = __builtin_amdgcn_readfirstlane(tid >> 6), lane = tid & 63, wr = wid >> 2, wc = wid & 3, fr = lane & 15, fq = lane >> 4;
    const int nt = g.K / BK;
    unsigned voffA[2], voffB[2];
#pragma unroll
    for (int i = 0; i < 2; ++i) { int R, C; stage_rc(tid * 16 + i * 8192, R, C); const int Rb = Epi::PERM ? ((R & ~31) + perm32(R & 31)) : R;
        voffA[i] = (unsigned)(R * g.lda + C) * 2u; voffB[i] = (unsigned)(Rb * g.ldb + C) * 2u; }
    const size_t kstep = (size_t)(BK * 2);
    const size_t hstepA = (size_t)HALF * g.lda * 2, hstepB = (size_t)HALF * g.ldb * 2;
    const size_t tstepA = 2 * hstepA, tstepB = 2 * hstepB;
    const unsigned ldsw = (unsigned)wid * 1024u;
    const int aoff = lds_byte(wr * 64 + fr, fq * 8), boff = lds_byte(wc * 32 + fr, fq * 8);
#define PG8_SA(b, h) (((b) * 2 + (h)) * HTB)
#define PG8_SB(b, h) ((4 + (b) * 2 + (h)) * HTB)
#define PG8_STAGE(bufoff, gbase, voff) do { _Pragma("unroll") for (int _i = 0; _i < 2; ++_i) \
        __builtin_amdgcn_global_load_lds((const unsigned*)((const char*)(gbase) + (voff)[_i]), (LAS unsigned*)(lds + (bufoff) + ldsw + _i * 8192), 16, 0, 0); } while (0)
#define PG8_LDA(dst, b, h) do { _Pragma("unroll") for (int m = 0; m < 4; ++m) _Pragma("unroll") for (int k = 0; k < 2; ++k) dst[m][k] = *(const LAS bf16x8*)(lds + PG8_SA(b, h) + aoff + m * 2048 + k * 1024); } while (0)
#define PG8_LDB(dst, b, h) do { _Pragma("unroll") for (int n = 0; n < 2; ++n) _Pragma("unroll") for (int k = 0; k < 2; ++k) dst[n][k] = *(const LAS bf16x8*)(lds + PG8_SB(b, h) + boff + n * 2048 + k * 1024); } while (0)
#define PG8_MMA(ai, bj, At, Bt) do { __builtin_amdgcn_s_setprio(1); _Pragma("unroll") for (int m = 0; m < 4; ++m) _Pragma("unroll") for (int n = 0; n < 2; ++n) _Pragma("unroll") for (int k = 0; k < 2; ++k) \
        acc[ai][bj][m][n] = __builtin_amdgcn_mfma_f32_16x16x32_bf16(Bt[n][k], At[m][k], acc[ai][bj][m][n], 0, 0, 0); __builtin_amdgcn_s_setprio(0); } while (0)
#define PG8_WAIT_V(n) asm volatile("s_waitcnt vmcnt(" #n ")" ::: "memory")
#define PG8_WAIT_L(n) asm volatile("s_waitcnt lgkmcnt(" #n ")" ::: "memory")
#define PG8_BAR __builtin_amdgcn_s_barrier()
#define PG8_SCHED __builtin_amdgcn_sched_barrier(0)
    Unit cur, nxt; int ui = 0;
    if (!S.next(0, cur)) return;
    f32x4 acc[2][2][4][2];
#pragma unroll
    for (int a = 0; a < 2; ++a)
#pragma unroll
        for (int b = 0; b < 2; ++b)
#pragma unroll
            for (int m = 0; m < 4; ++m)
#pragma unroll
                for (int n = 0; n < 2; ++n) acc[a][b][m][n] = (f32x4){0.f, 0.f, 0.f, 0.f};
    bf16x8 At[4][2], B0[2][2], B1[2][2];
    const char* cA = (const char*)g.A + (size_t)cur.pm * tstepA; const char* cB = (const char*)g.Bt + (size_t)cur.pn * tstepB;
    PG8_STAGE(PG8_SB(0, 0), cB, voffB); PG8_STAGE(PG8_SB(0, 1), cB + hstepB, voffB); PG8_STAGE(PG8_SA(0, 0), cA, voffA); PG8_STAGE(PG8_SA(0, 1), cA + hstepA, voffA);
    if (wr == 1) PG8_BAR;
    PG8_WAIT_V(2); PG8_BAR;
    PG8_STAGE(PG8_SB(1, 0), cB + kstep, voffB); PG8_STAGE(PG8_SA(1, 0), cA + kstep, voffA); PG8_STAGE(PG8_SB(1, 1), cB + hstepB + kstep, voffB);
    PG8_WAIT_V(6); PG8_BAR;
    for (;;) {
        const bool has_next = S.next(ui + 1, nxt);
        const char* nA = has_next ? (const char*)g.A + (size_t)nxt.pm * tstepA : cA; const char* nB = has_next ? (const char*)g.Bt + (size_t)nxt.pn * tstepB : cB;
        for (int t = 0; t < nt; t += 2) {
            const bool last = (t == nt - 2);
            const char* a1 = cA + (size_t)(t + 1) * kstep;
            const char* a2 = last ? nA : cA + (size_t)(t + 2) * kstep; const char* b2 = last ? nB : cB + (size_t)(t + 2) * kstep;
            const char* a3 = a2 + kstep; const char* b3 = b2 + kstep;
            PG8_LDB(B0, 0, 0); PG8_LDB(B1, 0, 1); PG8_SCHED; PG8_LDA(At, 0, 0); PG8_STAGE(PG8_SA(1, 1), a1 + hstepA, voffA);
            PG8_WAIT_V(8); PG8_WAIT_L(0); PG8_BAR; PG8_MMA(0, 0, At, B0); PG8_MMA(0, 1, At, B1); PG8_BAR; PG8_SCHED;
            PG8_LDA(At, 0, 1); PG8_STAGE(PG8_SB(0, 0), b2, voffB); PG8_STAGE(PG8_SB(0, 1), b2 + hstepB, voffB); PG8_STAGE(PG8_SA(0, 0), a2, voffA);
            PG8_WAIT_V(8); PG8_WAIT_L(0); PG8_BAR; PG8_MMA(1, 0, At, B0); PG8_MMA(1, 1, At, B1); PG8_BAR; PG8_SCHED;
            PG8_LDB(B0, 1, 0); PG8_LDB(B1, 1, 1); PG8_SCHED; PG8_LDA(At, 1, 0); PG8_STAGE(PG8_SA(0, 1), a2 + hstepA, voffA);
            PG8_WAIT_V(8); PG8_WAIT_L(0); PG8_BAR; PG8_MMA(0, 0, At, B0); PG8_MMA(0, 1, At, B1); PG8_BAR; PG8_SCHED;
            PG8_LDA(At, 1, 1); PG8_STAGE(PG8_SB(1, 0), b3, voffB); PG8_STAGE(PG8_SB(1, 1), b3 + hstepB, voffB); PG8_STAGE(PG8_SA(1, 0), a3, voffA);
            PG8_WAIT_V(8); PG8_WAIT_L(0); PG8_BAR; PG8_MMA(1, 0, At, B0); PG8_MMA(1, 1, At, B1); PG8_BAR; PG8_SCHED;
        }
        if (wr == 0) PG8_BAR;
        E(acc, cur, wr, wc, fr, fq);
        if (!has_next) break;
#pragma unroll
        for (int a = 0; a < 2; ++a)
#pragma unroll
            for (int b = 0; b < 2; ++b)
#pragma unroll
                for (int m = 0; m < 4; ++m)
#pragma unroll
                    for (int n = 0; n < 2; ++n) acc[a][b][m][n] = (f32x4){0.f, 0.f, 0.f, 0.f};
        cur = nxt; cA = nA; cB = nB; ++ui;
        if (wr == 1) PG8_BAR;
    }
    PG8_WAIT_V(0);
    PG8_BAR;
#undef PG8_SA
#undef PG8_SB
#undef PG8_STAGE
#undef PG8_LDA
#undef PG8_LDB
#undef PG8_MMA
#undef PG8_WAIT_V
#undef PG8_WAIT_L
#undef PG8_BAR
#undef PG8_SCHED
}

typedef const f32x4 (&AccRef)[2][2][4][2];

struct EpiInProj {
    static constexpr bool PERM = true;
    bf16* P; const float* rstd; float* dt;
    __device__ __forceinline__ void operator()(AccRef acc, const Unit& u, int wr, int wc, int fr, int fq) const {
        const int row0 = u.pm * BM + wr * 64 + fr;
        if (u.pn < 21) {
            const int col0 = u.pn * BM + wc * 32 + 8 * fq;
#pragma unroll
            for (int ai = 0; ai < 2; ++ai)
#pragma unroll
                for (int m = 0; m < 4; ++m) { const int row = row0 + ai * HALF + m * 16; const float s = rstd[row]; bf16* rowp = P + (size_t)row * PLD + col0;
#pragma unroll
                    for (int bj = 0; bj < 2; ++bj) { const f32x4 v0 = acc[ai][bj][m][0] * s, v1 = acc[ai][bj][m][1] * s;
                        u32x4 w; w.x = pk2(v0[0], v0[1]); w.y = pk2(v0[2], v0[3]); w.z = pk2(v1[0], v1[1]); w.w = pk2(v1[2], v1[3]);
                        *(u32x4*)(rowp + bj * HALF) = w; } }
        } else if (wc == 0 && fq == 0) {
#pragma unroll
            for (int ai = 0; ai < 2; ++ai)
#pragma unroll
                for (int m = 0; m < 4; ++m) { const int row = row0 + ai * HALF + m * 16; const float s = rstd[row];
                    *(f32x4*)(dt + (size_t)row * 8) = acc[ai][0][m][0] * s; *(f32x4*)(dt + (size_t)row * 8 + 4) = acc[ai][0][m][1] * s; }
        }
    }
};
struct EpiPlain {
    static constexpr bool PERM = true;
    bf16* O; int ldc;
    __device__ __forceinline__ void operator()(AccRef acc, const Unit& u, int wr, int wc, int fr, int fq) const {
        const int row0 = u.pm * BM + wr * 64 + fr, col0 = u.pn * BM + wc * 32 + 8 * fq;
#pragma unroll
        for (int ai = 0; ai < 2; ++ai)
#pragma unroll
            for (int m = 0; m < 4; ++m) { bf16* rowp = O + (size_t)(row0 + ai * HALF + m * 16) * ldc + col0;
#pragma unroll
                for (int bj = 0; bj < 2; ++bj) { const f32x4 v0 = acc[ai][bj][m][0], v1 = acc[ai][bj][m][1];
                    u32x4 w; w.x = pk2(v0[0], v0[1]); w.y = pk2(v0[2], v0[3]); w.z = pk2(v1[0], v1[1]); w.w = pk2(v1[2], v1[3]);
                    *(u32x4*)(rowp + bj * HALF) = w; } }
    }
};
struct EpiGateMerge {
    static constexpr bool PERM = true;
    const bf16* Y; int ldy; bf16* Mg; int ldm; const float* rstd; int first;
    __device__ __forceinline__ void operator()(AccRef acc, const Unit& u, int wr, int wc, int fr, int fq) const {
        const int row0 = u.pm * BM + wr * 64 + fr, col0 = u.pn * BM + wc * 32 + 8 * fq;
#pragma unroll
        for (int ai = 0; ai < 2; ++ai)
#pragma unroll
            for (int m = 0; m < 4; ++m) { const int row = row0 + ai * HALF + m * 16; const float s = rstd[row];
#pragma unroll
                for (int bj = 0; bj < 2; ++bj) { const int c = col0 + bj * HALF;
                    float y[8], o[8]; unpack8(*(const u32x4*)(Y + (size_t)row * ldy + c), y);
                    const f32x4 v0 = acc[ai][bj][m][0] * s, v1 = acc[ai][bj][m][1] * s;
#pragma unroll
                    for (int j = 0; j < 4; ++j) { o[j] = sigm(v0[j]) * y[j]; o[4 + j] = sigm(v1[j]) * y[4 + j]; }
                    if (!first) { float p[8]; unpack8(*(const u32x4*)(Mg + (size_t)row * ldm + c), p);
#pragma unroll
                        for (int j = 0; j < 8; ++j) o[j] += p[j]; }
                    *(u32x4*)(Mg + (size_t)row * ldm + c) = pack8(o); } }
    }
};
struct EpiResid {
    static constexpr bool PERM = false;
    const float* xin; float* xout; const float* gates; int e;
    __device__ __forceinline__ void operator()(AccRef acc, const Unit& u, int wr, int wc, int fr, int fq) const {
        const int row0 = u.pm * BM + wr * 64 + fr, col0 = u.pn * BM + wc * 32 + 4 * fq;
#pragma unroll
        for (int ai = 0; ai < 2; ++ai)
#pragma unroll
            for (int m = 0; m < 4; ++m) { const int row = row0 + ai * HALF + m * 16; const float s = gates ? gates[(size_t)row * 8 + e] : 1.f;
                const float* ip = xin + (size_t)row * D + col0; float* op = xout + (size_t)row * D + col0;
#pragma unroll
                for (int bj = 0; bj < 2; ++bj)
#pragma unroll
                    for (int n = 0; n < 2; ++n) *(f32x4*)(op + bj * HALF + n * 16) = *(const f32x4*)(ip + bj * HALF + n * 16) + acc[ai][bj][m][n] * s; }
    }
};
struct EpiSwiglu {
    static constexpr bool PERM = true;
    bf16* act; int ldc; const float* rstd;
    __device__ __forceinline__ void operator()(AccRef acc, const Unit& u, int wr, int wc, int fr, int fq) const {
        const int row0 = u.pm * BM + wr * 64 + fr, col0 = u.pn * HALF + wc * 32 + 8 * fq;
#pragma unroll
        for (int ai = 0; ai < 2; ++ai)
#pragma unroll
            for (int m = 0; m < 4; ++m) { const int row = row0 + ai * HALF + m * 16; const float s = rstd[row];
                float o[8];
#pragma unroll
                for (int n = 0; n < 2; ++n)
#pragma unroll
                    for (int j = 0; j < 4; ++j) o[4 * n + j] = silu(acc[ai][0][m][n][j] * s) * (acc[ai][1][m][n][j] * s);
                *(u32x4*)(act + (size_t)row * ldc + col0) = pack8(o); }
    }
};
}

#define XB_TMO      128
#define XB_XCNT(j)  (256  + 64 * (j))
#define XB_XSUB(j)  (1280 + 64 * (j))
#define XB_XGEN(j)  (2304 + 64 * (j))
#define XB_TOP      3328
#define XB_TOPGEN   3392
#define XCD_BAR_WORDS 3456
#define XB_SPIN_CAP (1u << 18)

__device__ __forceinline__ unsigned xb_ld(unsigned* p)              { return __hip_atomic_load(p, __ATOMIC_RELAXED, __HIP_MEMORY_SCOPE_AGENT); }
__device__ __forceinline__ unsigned xb_add(unsigned* p, unsigned v) { return __hip_atomic_fetch_add(p, v, __ATOMIC_RELAXED, __HIP_MEMORY_SCOPE_AGENT); }
__device__ __forceinline__ unsigned xb_xcc_id() { return (unsigned)__builtin_amdgcn_s_getreg((3 << 11) | 20) & 0xFu; }
#define XB_SPIN(cond, bar) do { unsigned _sp = 0; while (cond) { __builtin_amdgcn_s_sleep(1); \
    if ((++_sp & 255u) == 0u) { if (xb_ld(&(bar)[XB_TMO])) break; if (_sp > XB_SPIN_CAP) { atomicAdd(&(bar)[XB_TMO], 1u); break; } } } } while (0)

struct XcdBarrier { unsigned* bar; unsigned x; volatile LAS unsigned* st; };

__device__ __forceinline__ XcdBarrier xcd_barrier_post(unsigned* bar, volatile LAS unsigned* st) {
    XcdBarrier b; b.bar = bar; b.x = xb_xcc_id(); b.st = st;
    if (threadIdx.x == 0) (void)xb_add(&bar[XB_XCNT(b.x)], 1u);
    return b;
}
__device__ __forceinline__ void xcd_barrier_complete(unsigned* bar, unsigned x, unsigned& nloc, unsigned& nx) {
    const unsigned G = gridDim.x * gridDim.y * gridDim.z;
    unsigned sum, cnt, mine, sp = 0u;
    for (;;) {
        sum = 0u; cnt = 0u; mine = 0u;
#pragma unroll
        for (unsigned j = 0; j < 16; ++j) { const unsigned c = xb_ld(&bar[XB_XCNT(j)]); sum += c; cnt += (c > 0u) ? 1u : 0u; mine = (j == x) ? c : mine; }
        if (sum == G) break;
        __builtin_amdgcn_s_sleep(1);
        if ((++sp & 255u) == 0u) { if (xb_ld(&bar[XB_TMO])) break; if (sp > XB_SPIN_CAP) { atomicAdd(&bar[XB_TMO], 1u); break; } }
    }
    nloc = mine > 0u ? mine : 1u; nx = cnt > 0u ? cnt : 1u;
}
__device__ __forceinline__ void xcd_barrier(const XcdBarrier& b) {
    asm volatile("s_waitcnt vmcnt(0)" ::: "memory");
    __syncthreads();
    if (threadIdx.x == 0) {
        unsigned* bar = b.bar;
        __builtin_amdgcn_s_waitcnt(0);
        unsigned nloc = b.st[0], nx = b.st[1];
        if (nloc == 0u) { xcd_barrier_complete(bar, b.x, nloc, nx); b.st[0] = nloc; b.st[1] = nx; }
        const unsigned old = xb_add(&bar[XB_XSUB(b.x)], 1u);
        const unsigned gen = old / nloc;
        if (old + 1u == (gen + 1u) * nloc) {
            __builtin_amdgcn_fence(__ATOMIC_RELEASE, "agent");
            asm volatile("s_waitcnt vmcnt(0)" ::: "memory");
            const unsigned og = xb_add(&bar[XB_TOP], 1u);
            const unsigned tg = og / nx;
            if (og + 1u == (tg + 1u) * nx) xb_add(&bar[XB_TOPGEN], 1u);
            else XB_SPIN(xb_ld(&bar[XB_TOPGEN]) == tg, bar);
            __builtin_amdgcn_fence(__ATOMIC_ACQUIRE, "agent");
            xb_add(&bar[XB_XGEN(b.x)], 1u);
            asm volatile("s_waitcnt vmcnt(0)" ::: "memory");
        } else {
            XB_SPIN(xb_ld(&bar[XB_XGEN(b.x)]) == gen, bar);
            __builtin_amdgcn_fence(__ATOMIC_ACQUIRE, "agent");
            asm volatile("s_waitcnt vmcnt(0)" ::: "memory");
        }
    }
    __syncthreads();
}

struct Args { const float* in[34]; float* out; unsigned char* ws; int ph_lo, ph_hi; };
struct Frame {
    LAS unsigned char* lds;
    int vcu, G, cid;
    float* out; unsigned char* ws;
};
__device__ __forceinline__ const float* inptr(LAS unsigned char* lds, int i) {
    int off = LDSCTL_OFF + 8 * i; asm volatile("" : "+v"(off));
    const LAS unsigned* p = (const LAS unsigned*)(lds + off);
    const unsigned lo = __builtin_amdgcn_readfirstlane(p[0]), hi = __builtin_amdgcn_readfirstlane(p[1]);
    return (const float*)(((unsigned long long)hi << 32) | lo);
}
#define INP(i) inptr(F.lds, (i))

__device__ __forceinline__ void conv_item(const float* W, int ld, int k0, int c0, int nvalid, const float* scale, bf16* dst, int K, int drow0, LAS float* scr, int lane) {
    const int n = lane & 31;
#pragma unroll 8
    for (int i = 0; i < 32; ++i) { const int kk = 2 * i + (lane >> 5);
        float v = 0.f; if (n < nvalid) { v = W[(size_t)(k0 + kk) * ld + c0 + n]; if (scale) v *= scale[k0 + kk]; }
        scr[kk * 33 + n] = v; }
    LDS_WAIT(); asm volatile("" ::: "memory");
    const int c = lane & 7;
#pragma unroll
    for (int j = 0; j < 4; ++j) { const int nn = (lane >> 3) + 8 * j; const LAS float* s = scr + (8 * c) * 33 + nn;
        u32x4 o; o.x = pk2(s[0 * 33], s[1 * 33]); o.y = pk2(s[2 * 33], s[3 * 33]); o.z = pk2(s[4 * 33], s[5 * 33]); o.w = pk2(s[6 * 33], s[7 * 33]);
        *(u32x4*)(dst + (size_t)(drow0 + nn) * K + k0 + 8 * c) = o; }
    LDS_WAIT(); asm volatile("" ::: "memory");
}
__device__ __forceinline__ void conv_seg(Frame& F, const float* W, int ld, int K, int c0, int nvalid, int ntotal, const float* scale, bf16* dst, int r0, int blk, int blks) {
    const int ptid = otid(), plane = ptid & 63, pwave = __builtin_amdgcn_readfirstlane(ptid >> 6); (void)plane; (void)pwave;
    LAS float* scr = (LAS float*)(F.lds + pwave * 16384);
    const int gw = F.vcu * 8 + pwave, NGW = F.G * 8;
    const int nblk = ntotal / 32, nitems = (K / 64) * nblk;
    for (int it = gw; it < nitems; it += NGW) {
        const int kb = it / nblk, nb = it % nblk, n0 = nb * 32;
        int nv = nvalid - n0; nv = nv < 0 ? 0 : (nv > 32 ? 32 : nv);
        conv_item(W, ld, kb * 64, c0 + n0, nv, scale, dst, K, r0 + (n0 / blk) * blks + (n0 % blk), scr, plane);
    }
}
__device__ __forceinline__ void conv_layer_weights(Frame& F, int l) {
    unsigned char* wl = F.ws + WS_W + (size_t)l * WL_STRIDE;
    const float* win = INP(2) + (size_t)l * D * INC; const float* n1 = INP(1) + l * D;
    const int BIGB = 1 << 30;
    conv_seg(F, win, INC, D, 0, 3328, 3328, n1, (bf16*)(wl + WL_IN), 0, BIGB, 0);
    conv_seg(F, win, INC, D, 3336, 2048, 2048, n1, (bf16*)(wl + WL_IN), 3328, BIGB, 0);
    conv_seg(F, win, INC, D, 3328, 8, 256, n1, (bf16*)(wl + WL_IN), 5376, BIGB, 0);
    conv_seg(F, win, INC, D, 5384, 3072, 3072, n1, (bf16*)(wl + WL_GATE), 0, BIGB, 0);
    for (int i = 0; i < 3; ++i)
        conv_seg(F, INP(23) + ((size_t)l * 3 + i) * 512 * D, D, 512, 0, D, D, nullptr, (bf16*)(wl + WL_BR) + (size_t)i * D * 512, 0, BIGB, 0);
    conv_seg(F, INP(24) + (size_t)l * D * D, D, D, 0, D, D, nullptr, (bf16*)(wl + WL_OUT), 0, BIGB, 0);
}
__device__ __forceinline__ void conv_ffn_weights(Frame& F) {
    const float* n2 = INP(25);
    conv_seg(F, INP(26), FF, D, 0, FF, FF, n2, (bf16*)(F.ws + WS_FFUP), 0, 128, 256);
    conv_seg(F, INP(27), FF, D, 0, FF, FF, n2, (bf16*)(F.ws + WS_FFUP), 128, 128, 256);
    conv_seg(F, INP(28), D, FF, 0, D, D, nullptr, (bf16*)(F.ws + WS_FFDN), 0, 1 << 30, 0);
}
__device__ __forceinline__ void conv_moe_weights(Frame& F) {
    const float* n2 = INP(25) + D;
    for (int e = 0; e < NE; ++e) {
        bf16* up = (bf16*)(F.ws + WS_MOEW + (size_t)e * MOEW_STRIDE); bf16* dn = (bf16*)(F.ws + WS_MOEW + (size_t)e * MOEW_STRIDE + MOEW_DN);
        conv_seg(F, INP(30) + (size_t)e * D * FFE, FFE, D, 0, FFE, FFE, n2, up, 0, 128, 256);
        conv_seg(F, INP(31) + (size_t)e * D * FFE, FFE, D, 0, FFE, FFE, n2, up, 128, 128, 256);
        conv_seg(F, INP(32) + (size_t)e * FFE * D, D, FFE, 0, D, D, nullptr, dn, 0, 1 << 30, 0);
    }
}

__device__ __forceinline__ void xprep_phase(Frame& F, const float* x) {
    const int ptid = otid(), plane = ptid & 63, pwave = __builtin_amdgcn_readfirstlane(ptid >> 6); (void)plane; (void)pwave;
    const int gw = F.vcu * 8 + pwave, NGW = F.G * 8;
    bf16* xb = (bf16*)(F.ws + WS_XB); float* rstd = (float*)(F.ws + WS_RSTD);
    for (int m = gw; m < M; m += NGW) {
        const f32x4* xr = (const f32x4*)(x + (size_t)m * D) + plane;
        f32x4 v[4]; float s = 0.f;
#pragma unroll
        for (int j = 0; j < 4; ++j) { v[j] = xr[64 * j]; s += (v[j].x * v[j].x + v[j].y * v[j].y) + (v[j].z * v[j].z + v[j].w * v[j].w); }
        s = wave_sum(s);
        if (plane == 0) rstd[m] = 1.f / sqrtf(s * (1.f / D) + 1e-6f);
        u32x2* o8 = (u32x2*)(xb + (size_t)m * D) + plane;
#pragma unroll
        for (int j = 0; j < 4; ++j) { u32x2 w; w.x = pk2(v[j].x, v[j].y); w.y = pk2(v[j].z, v[j].w); o8[64 * j] = w; }
    }
}
__device__ __forceinline__ void final_norm_phase(Frame& F) {
    const int ptid = otid(), plane = ptid & 63, pwave = __builtin_amdgcn_readfirstlane(ptid >> 6); (void)plane; (void)pwave;
    const int gw = F.vcu * 8 + pwave, NGW = F.G * 8;
    const float* fw = INP(33);
    for (int m = gw; m < M; m += NGW) {
        f32x4* xr = (f32x4*)(F.out + (size_t)m * D) + plane;
        f32x4 v[4]; float s = 0.f;
#pragma unroll
        for (int j = 0; j < 4; ++j) { v[j] = xr[64 * j]; s += (v[j].x * v[j].x + v[j].y * v[j].y) + (v[j].z * v[j].z + v[j].w * v[j].w); }
        s = wave_sum(s);
        const float r = 1.f / sqrtf(s * (1.f / D) + 1e-6f);
#pragma unroll
        for (int j = 0; j < 4; ++j) { const f32x4 w = *((const f32x4*)fw + plane + 64 * j); xr[64 * j] = v[j] * r * w; }
    }
}
__device__ __forceinline__ void router_phase(Frame& F) {
    const int ptid = otid(), plane = ptid & 63, pwave = __builtin_amdgcn_readfirstlane(ptid >> 6); (void)plane; (void)pwave;
    const int gw = F.vcu * 8 + pwave, NGW = F.G * 8;
    const float* nw = INP(25) + D; const float* rt = INP(29); const float* rstd = (const float*)(F.ws + WS_RSTD); float* gates = (float*)(F.ws + WS_GATES);
    for (int m = gw; m < M; m += NGW) {
        float acc[8];
#pragma unroll
        for (int e = 0; e < 8; ++e) acc[e] = 0.f;
        const float* xr = F.out + (size_t)m * D;
#pragma unroll 4
        for (int j = 0; j < 16; ++j) { const int k = plane + 64 * j; const float xv = xr[k] * nw[k];
            const f32x4 r0 = *(const f32x4*)(rt + (size_t)k * 8), r1 = *(const f32x4*)(rt + (size_t)k * 8 + 4);
            acc[0] += xv * r0.x; acc[1] += xv * r0.y; acc[2] += xv * r0.z; acc[3] += xv * r0.w; acc[4] += xv * r1.x; acc[5] += xv * r1.y; acc[6] += xv * r1.z; acc[7] += xv * r1.w; }
        const float s = rstd[m];
#pragma unroll
        for (int e = 0; e < 8; ++e) acc[e] = wave_sum(acc[e]) * s;
        int i0 = 0; float v0 = acc[0];
#pragma unroll
        for (int e = 1; e < 8; ++e) if (acc[e] > v0) { v0 = acc[e]; i0 = e; }
        int i1 = -1; float v1 = -3.0e38f;
#pragma unroll
        for (int e = 0; e < 8; ++e) if (e != i0 && acc[e] > v1) { v1 = acc[e]; i1 = e; }
        const float e1 = expf(v1 - v0), w0 = 1.f / (1.f + e1), w1 = e1 / (1.f + e1);
        if (plane < 8) gates[(size_t)m * 8 + plane] = (plane == i0) ? w0 : ((plane == i1) ? w1 : 0.f);
    }
}

__device__ __forceinline__ void vprep_phase(Frame& F, int layer) {
    const int ptid = otid(), plane = ptid & 63, pwave = __builtin_amdgcn_readfirstlane(ptid >> 6); (void)plane; (void)pwave;
    LAS float* vt = (LAS float*)F.lds;
    LAS float* vd = vt + 32 * 516;
    const bf16* P = (const bf16*)(F.ws + WS_BIG); bf16* VF = (bf16*)(F.ws + WS_VF); bf16* VM = (bf16*)(F.ws + WS_VMIX);
    const float* mu = INP(3) + layer * 1792 + 1024;
    const int tok = ptid >> 4, part = ptid & 15;
    for (int it = F.vcu; it < M / 32; it += F.G) {
        const int m = it * 32 + tok; const int t = m & (T - 1);
        const bf16* cur = P + (size_t)m * PLD + 1024 + part * 32;
        float xm[32];
#pragma unroll
        for (int q = 0; q < 4; ++q) { float c[8], p[8]; unpack8(*(const u32x4*)(cur + q * 8), c);
            if (t > 0) unpack8(*(const u32x4*)(cur - PLD + q * 8), p); else {
#pragma unroll
                for (int e = 0; e < 8; ++e) p[e] = 0.f; }
#pragma unroll
            for (int e = 0; e < 8; ++e) xm[q * 8 + e] = c[e] + (p[e] - c[e]) * mu[part * 32 + q * 8 + e]; }
        if (layer == 0) {
#pragma unroll
            for (int q = 0; q < 4; ++q) { float o[8];
#pragma unroll
                for (int e = 0; e < 8; ++e) o[e] = xm[q * 8 + e];
                *(u32x4*)(VF + (size_t)m * 512 + part * 32 + q * 8) = pack8(o); }
        } else {
            const float* vdn = INP(14); const float* vup = INP(15); const float* v0 = INP(16);
#pragma unroll
            for (int e = 0; e < 32; ++e) vt[tok * 516 + part * 32 + e] = xm[e];
            __syncthreads();
            { float a0 = 0.f, a1 = 0.f; const int j = part * 2;
                for (int c = 0; c < 512; ++c) { const float v = vt[tok * 516 + c]; a0 += v * vdn[c * 32 + j]; a1 += v * vdn[c * 32 + j + 1]; }
                vd[tok * 33 + j] = a0; vd[tok * 33 + j + 1] = a1; }
            __syncthreads();
            float g[32];
#pragma unroll
            for (int e = 0; e < 32; ++e) g[e] = v0[part * 32 + e];
            for (int j = 0; j < 32; ++j) { const float d = vd[tok * 33 + j];
#pragma unroll
                for (int e = 0; e < 32; ++e) g[e] += d * vup[j * 512 + part * 32 + e]; }
#pragma unroll
            for (int q = 0; q < 4; ++q) { float vf[8], o[8]; unpack8(*(const u32x4*)(VF + (size_t)m * 512 + part * 32 + q * 8), vf);
#pragma unroll
                for (int e = 0; e < 8; ++e) { const float v = xm[q * 8 + e]; o[e] = v + (vf[e] - v) * sigm(g[q * 8 + e]); }
                *(u32x4*)(VM + (size_t)m * 512 + part * 32 + q * 8) = pack8(o); }
            __syncthreads();
        }
    }
}

__device__ __forceinline__ float red8(float v) { v += __shfl_xor(v, 1); v += __shfl_xor(v, 2); v += __shfl_xor(v, 4); return v; }
__device__ __forceinline__ float red16(float v) { v = red8(v); v += __shfl_xor(v, 8); return v; }

__device__ __forceinline__ void rwkv_seq(Frame& F, int layer, int bh) {
    const int ptid = otid(), plane = ptid & 63, pwave = __builtin_amdgcn_readfirstlane(ptid >> 6); (void)plane; (void)pwave;
    const int b = bh >> 3, h = bh & 7;
    LAS float* L = (LAS float*)F.lds;
    LAS float *rr = L, *ww = L + 2048, *kf = L + 4096, *vv = L + 6144, *aa = L + 8192, *bb = L + 10240, *gg = L + 12288, *yy = L + 14336, *tw = L + 16384, *xa = L + 18432, *sg = L + 20480, *bon = L + 24576;
    const float* mu = INP(3) + layer * 1792; const float* w_up = INP(4) + layer * 64 * 512; const float* w0 = INP(5) + layer * 512;
    const float* a_up = INP(6) + layer * 64 * 512; const float* a0 = INP(7) + layer * 512; const float* g_up = INP(8) + layer * 128 * 512;
    const float* k_k = INP(9) + layer * 512; const float* k_a = INP(10) + layer * 512; const float* r_k = INP(11) + layer * 512;
    const float* gn_w = INP(12) + layer * 512; const float* gn_b = INP(13) + layer * 512;
    const bf16* P = (const bf16*)(F.ws + WS_BIG); const bf16* vsrc = (const bf16*)(F.ws + (layer == 0 ? WS_VF : WS_VMIX)); bf16* yout = (bf16*)(F.ws + WS_YRW);
    const int tid = ptid, tok = tid >> 4, part = tid & 15, c4 = part * 4, cb = h * 64 + c4;
    const int srow = tid >> 3, sc0 = (tid & 7) * 8;
    float S[8];
#pragma unroll
    for (int j = 0; j < 8; ++j) S[j] = 0.f;
    for (int t0 = 0; t0 < T; t0 += 32) {
        {
            const int t = t0 + tok; const size_t m = (size_t)b * T + t;
            const bf16* cur = P + m * PLD;
#pragma unroll
            for (int q = 0; q < 3; ++q) {
                const int ch = part + 16 * q; int col, kind; LAS float* dst;
                if (ch < 8) { col = h * 64 + ch * 8; dst = rr + tok * 64 + ch * 8; kind = 0; }
                else if (ch < 16) { col = 512 + h * 64 + (ch - 8) * 8; dst = kf + tok * 64 + (ch - 8) * 8; kind = 0; }
                else if (ch < 24) { col = 1536 + (ch - 16) * 8; dst = tw + tok * 64 + (ch - 16) * 8; kind = 1; }
                else if (ch < 32) { col = 1600 + (ch - 24) * 8; dst = xa + tok * 64 + (ch - 24) * 8; kind = 0; }
                else { col = 1664 + (ch - 32) * 8; dst = sg + tok * 128 + (ch - 32) * 8; kind = 2; }
                float c[8], p[8]; unpack8(*(const u32x4*)(cur + col), c);
                if (t > 0) unpack8(*(const u32x4*)(cur - PLD + col), p); else {
#pragma unroll
                    for (int e = 0; e < 8; ++e) p[e] = 0.f; }
#pragma unroll
                for (int e = 0; e < 8; ++e) { float x = c[e] + (p[e] - c[e]) * mu[col + e]; if (kind == 1) x = tanhf(x); else if (kind == 2) x = sigm(x); dst[e] = x; }
            }
            if (part < 8) { float v[8]; unpack8(*(const u32x4*)(vsrc + m * 512 + h * 64 + part * 8), v);
#pragma unroll
                for (int e = 0; e < 8; ++e) vv[tok * 64 + part * 8 + e] = v[e]; }
        }
        __syncthreads();
        {
            f32x4 dw = *(const f32x4*)(w0 + cb), da = *(const f32x4*)(a0 + cb), dg = (f32x4){0.f, 0.f, 0.f, 0.f};
            for (int j = 0; j < 64; ++j) { const float tj = tw[tok * 64 + j], xj = xa[tok * 64 + j];
                dw += *(const f32x4*)(w_up + j * 512 + cb) * tj; da += *(const f32x4*)(a_up + j * 512 + cb) * xj; }
            for (int j = 0; j < 128; ++j) dg += *(const f32x4*)(g_up + j * 512 + cb) * sg[tok * 128 + j];
            float kr[4], kk[4], av[4], ss = 0.f;
#pragma unroll
            for (int e = 0; e < 4; ++e) { kr[e] = kf[tok * 64 + c4 + e]; kk[e] = kr[e] * k_k[cb + e]; ss += kk[e] * kk[e]; av[e] = sigm(da[e]); }
            ss = red16(ss);
            const float inv = 1.f / sqrtf(fmaxf(ss, 1e-24f));
            float bs = 0.f;
#pragma unroll
            for (int e = 0; e < 4; ++e) { const float kn = kk[e] * inv; const int o = tok * 64 + c4 + e;
                const float ld = -expf(-softplus_acc(-dw[e]) - 0.5f);
                ww[o] = expf(ld); aa[o] = -kn; bb[o] = kn * av[e];
                const float knew = kr[e] * (1.f + (av[e] - 1.f) * k_a[cb + e]); kf[o] = knew; gg[o] = dg[e];
                bs += rr[o] * knew * r_k[cb + e]; }
            bs = red16(bs);
            if (part == 0) bon[tok] = bs;
        }
        __syncthreads();
        for (int s = 0; s < 32; ++s) {
            const f32x4 a0v = *(const LAS f32x4*)(aa + s * 64 + sc0), a1v = *(const LAS f32x4*)(aa + s * 64 + sc0 + 4);
            const f32x4 w0v = *(const LAS f32x4*)(ww + s * 64 + sc0), w1v = *(const LAS f32x4*)(ww + s * 64 + sc0 + 4);
            const f32x4 b0v = *(const LAS f32x4*)(bb + s * 64 + sc0), b1v = *(const LAS f32x4*)(bb + s * 64 + sc0 + 4);
            const f32x4 k0v = *(const LAS f32x4*)(kf + s * 64 + sc0), k1v = *(const LAS f32x4*)(kf + s * 64 + sc0 + 4);
            const f32x4 r0v = *(const LAS f32x4*)(rr + s * 64 + sc0), r1v = *(const LAS f32x4*)(rr + s * 64 + sc0 + 4);
            const float vi = vv[s * 64 + srow];
            float sa = 0.f;
#pragma unroll
            for (int j = 0; j < 4; ++j) sa += S[j] * a0v[j] + S[4 + j] * a1v[j];
            sa = red8(sa);
            float y = 0.f;
#pragma unroll
            for (int j = 0; j < 4; ++j) { S[j] = S[j] * w0v[j] + sa * b0v[j] + vi * k0v[j]; S[4 + j] = S[4 + j] * w1v[j] + sa * b1v[j] + vi * k1v[j]; y += S[j] * r0v[j] + S[4 + j] * r1v[j]; }
            y = red8(y);
            if ((tid & 7) == 0) yy[s * 64 + srow] = y;
        }
        __syncthreads();
        {
            const size_t m = (size_t)b * T + t0 + tok;
            float y[4], sm = 0.f;
#pragma unroll
            for (int e = 0; e < 4; ++e) { y[e] = yy[tok * 64 + c4 + e]; sm += y[e]; }
            const float mean = red16(sm) * (1.f / 64.f);
            float vs = 0.f;
#pragma unroll
            for (int e = 0; e < 4; ++e) { y[e] -= mean; vs += y[e] * y[e]; }
            const float rs = 1.f / sqrtf(red16(vs) * (1.f / 64.f) + 64e-5f);
            const float bo = bon[tok];
            float o[4];
#pragma unroll
            for (int e = 0; e < 4; ++e) { const int idx = tok * 64 + c4 + e; o[e] = (y[e] * rs * gn_w[cb + e] + gn_b[cb + e] + bo * vv[idx]) * gg[idx]; }
            u32x2 w; w.x = pk2(o[0], o[1]); w.y = pk2(o[2], o[3]);
            *(u32x2*)(yout + m * 512 + cb) = w;
        }
        __syncthreads();
    }
}

__device__ __forceinline__ void ret_seq(Frame& F, int bh) {
    const int ptid = otid(), plane = ptid & 63, pwave = __builtin_amdgcn_readfirstlane(ptid >> 6); (void)plane; (void)pwave;
    const int b = bh >> 3, h = bh & 7;
    LAS float* L = (LAS float*)F.lds;
    LAS float *qq = L, *kk = L + 2048, *vv = L + 4096, *gg = L + 6144, *yy = L + 8192;
    bf16* P = (bf16*)(F.ws + WS_BIG);
    const int tid = ptid, tok = tid >> 4, part = tid & 15, c4 = part * 4;
    const int se = tid >> 3, sd0 = (tid & 7) * 8;
    const float gamma = 1.f - exp2f(-5.f - (float)h);
    float S[8];
#pragma unroll
    for (int j = 0; j < 8; ++j) S[j] = 0.f;
    for (int t0 = 0; t0 < T; t0 += 32) {
        {
            const int t = t0 + tok; const size_t m = (size_t)b * T + t;
#pragma unroll
            for (int q = 0; q < 2; ++q) {
                const int ch = part + 16 * q, kind = ch >> 3, cc = ch & 7;
                float x[8]; unpack8(*(const u32x4*)(P + m * PLD + C_RET + kind * 512 + h * 64 + cc * 8), x);
                LAS float* dst = (kind == 0 ? qq : kind == 1 ? kk : kind == 2 ? vv : gg) + tok * 64 + cc * 8;
                if (kind < 2) {
#pragma unroll
                    for (int p = 0; p < 4; ++p) { const int i = cc * 4 + p;
                        const double invf = exp(-(double)i * (9.210340371976184 / 32.0));
                        double sn, cs; sincos((double)t * invf, &sn, &cs);
                        const float x0 = x[2 * p], x1 = x[2 * p + 1], c = (float)cs, s = (float)sn;
                        float o0 = x0 * c - x1 * s, o1 = x0 * s + x1 * c;
                        if (kind == 1) { o0 *= 0.125f; o1 *= 0.125f; }
                        dst[2 * p] = o0; dst[2 * p + 1] = o1; }
                } else {
#pragma unroll
                    for (int e = 0; e < 8; ++e) dst[e] = x[e];
                }
            }
        }
        __syncthreads();
        for (int s = 0; s < 32; ++s) {
            const f32x4 k0v = *(const LAS f32x4*)(kk + s * 64 + sd0), k1v = *(const LAS f32x4*)(kk + s * 64 + sd0 + 4);
            const f32x4 q0v = *(const LAS f32x4*)(qq + s * 64 + sd0), q1v = *(const LAS f32x4*)(qq + s * 64 + sd0 + 4);
            const float ve = vv[s * 64 + se];
            float y = 0.f;
#pragma unroll
            for (int j = 0; j < 4; ++j) { S[j] = gamma * S[j] + k0v[j] * ve; S[4 + j] = gamma * S[4 + j] + k1v[j] * ve; y += q0v[j] * S[j] + q1v[j] * S[4 + j]; }
            y = red8(y);
            if ((tid & 7) == 0) yy[s * 64 + se] = y;
        }
        __syncthreads();
        {
            const size_t m = (size_t)b * T + t0 + tok;
            float y[4], ss = 0.f;
#pragma unroll
            for (int e = 0; e < 4; ++e) { y[e] = yy[tok * 64 + c4 + e]; ss += y[e] * y[e]; }
            const float rs = 1.f / sqrtf(red16(ss) * (1.f / 64.f) + 1e-6f);
            float o[4];
#pragma unroll
            for (int e = 0; e < 4; ++e) o[e] = y[e] * rs * silu(gg[tok * 64 + c4 + e]);
            u32x2 w; w.x = pk2(o[0], o[1]); w.y = pk2(o[2], o[3]);
            *(u32x2*)(P + m * PLD + C_RETG + h * 64 + c4) = w;
        }
        __syncthreads();
    }
}

__device__ __forceinline__ void ssd_seq(Frame& F, int layer, int bh) {
    const int ptid = otid(), plane = ptid & 63, pwave = __builtin_amdgcn_readfirstlane(ptid >> 6); (void)plane; (void)pwave;
    const int b = bh >> 3, h = bh & 7, g = h >> 2;
    LAS float* L = (LAS float*)F.lds;
    LAS float *raw = L  , *xs = L + 11200, *Bc = L + 13248, *Cc = L + 17344, *yy = L + 21440, *dts = L + 23488, *das = L + 23520;
    bf16* P = (bf16*)(F.ws + WS_BIG); const float* dtb = (const float*)(F.ws + WS_DT);
    const float* cw = INP(17) + layer * 1024 * 4; const float* cbias = INP(18) + layer * 1024;
    const float dt_bias = INP(19)[layer * 8 + h], A = -expf(INP(20)[layer * 8 + h]), Dh = INP(21)[layer * 8 + h];
    const int tid = ptid;
    const int sp = tid >> 3, sn0 = (tid & 7) * 16;
    float S[16];
#pragma unroll
    for (int j = 0; j < 16; ++j) S[j] = 0.f;
    for (int i = tid; i < 3 * 320; i += 512) raw[i] = 0.f;
    __syncthreads();
    for (int t0 = 0; t0 < T; t0 += 32) {
        for (int idx = tid; idx < 32 * 40; idx += 512) {
            const int row = idx / 40, ch = idx % 40; const size_t m = (size_t)b * T + t0 + row;
            const int col = ch < 8 ? (C_XBC + h * 64 + ch * 8) : (ch < 24 ? (C_XBC + 512 + g * 128 + (ch - 8) * 8) : (C_XBC + 768 + g * 128 + (ch - 24) * 8));
            float x[8]; unpack8(*(const u32x4*)(P + m * PLD + col), x);
#pragma unroll
            for (int e = 0; e < 8; ++e) raw[(3 + row) * 320 + ch * 8 + e] = x[e];
        }
        if (tid < 32) { const size_t m = (size_t)b * T + t0 + tid; const float dt = softplus_acc(dtb[m * 8 + h] + dt_bias); dts[tid] = dt; das[tid] = expf(A * dt); }
        __syncthreads();
        for (int idx = tid; idx < 32 * 320; idx += 512) {
            const int row = idx / 320, c = idx % 320;
            const int chn = c < 64 ? (h * 64 + c) : (c < 192 ? (512 + g * 128 + (c - 64)) : (768 + g * 128 + (c - 192)));
            float a = cbias[chn];
#pragma unroll
            for (int k = 0; k < 4; ++k) a += cw[chn * 4 + k] * raw[(row + k) * 320 + c];
            a = silu(a);
            if (c < 64) xs[row * 64 + c] = a; else if (c < 192) Bc[row * 128 + (c - 64)] = a; else Cc[row * 128 + (c - 192)] = a;
        }
        __syncthreads();
        for (int s = 0; s < 32; ++s) {
            const float da = das[s], xv = xs[s * 64 + sp], dtx = dts[s] * xv;
            float y = 0.f;
#pragma unroll
            for (int q = 0; q < 4; ++q) { const f32x4 bv = *(const LAS f32x4*)(Bc + s * 128 + sn0 + q * 4), cv = *(const LAS f32x4*)(Cc + s * 128 + sn0 + q * 4);
#pragma unroll
                for (int j = 0; j < 4; ++j) { S[q * 4 + j] = da * S[q * 4 + j] + dtx * bv[j]; y += S[q * 4 + j] * cv[j]; } }
            y = red8(y);
            if ((tid & 7) == 0) yy[s * 64 + sp] = y + Dh * xv;
        }
        __syncthreads();
        {
            const int tok = tid >> 4, c4 = (tid & 15) * 4; const size_t m = (size_t)b * T + t0 + tok;
            u32x2 w; w.x = pk2(yy[tok * 64 + c4], yy[tok * 64 + c4 + 1]); w.y = pk2(yy[tok * 64 + c4 + 2], yy[tok * 64 + c4 + 3]);
            *(u32x2*)(P + m * PLD + C_XBC + h * 64 + c4) = w;
            for (int i = tid; i < 3 * 320; i += 512) raw[i] = raw[32 * 320 + i];
        }
        __syncthreads();
    }
}
__device__ __forceinline__ void ssm_norm_phase(Frame& F, int layer) {
    const int ptid = otid(), plane = ptid & 63, pwave = __builtin_amdgcn_readfirstlane(ptid >> 6); (void)plane; (void)pwave;
    const int gw = F.vcu * 8 + pwave, NGW = F.G * 8;
    bf16* P = (bf16*)(F.ws + WS_BIG); const float* nw = INP(22) + layer * 512;
    for (int m = gw; m < M; m += NGW) {
        float y[8], z[8]; unpack8(*(const u32x4*)(P + (size_t)m * PLD + C_XBC + plane * 8), y); unpack8(*(const u32x4*)(P + (size_t)m * PLD + C_Z + plane * 8), z);
        float ss = 0.f;
#pragma unroll
        for (int e = 0; e < 8; ++e) { y[e] *= silu(z[e]); ss += y[e] * y[e]; }
        ss += __shfl_xor(ss, 1); ss += __shfl_xor(ss, 2); ss += __shfl_xor(ss, 4); ss += __shfl_xor(ss, 8); ss += __shfl_xor(ss, 16);
        const float rs = 1.f / sqrtf(ss * (1.f / 256.f) + 1e-6f);
#pragma unroll
        for (int e = 0; e < 8; ++e) y[e] *= rs * nw[plane * 8 + e];
        *(u32x4*)(P + (size_t)m * PLD + C_Z + plane * 8) = pack8(y);
    }
}

constexpr int LAYER_BASE0 = 1, LAYER_STRIDE = 15;
__device__ __forceinline__ Frame lf(const Frame& F0) {
    Frame F = F0; unsigned l = (unsigned)(unsigned long long)F.lds;
    asm volatile("" : "+s"(l), "+s"(F.vcu), "+s"(F.G), "+s"(F.cid), "+s"(F.out), "+s"(F.ws));
    F.lds = (LAS unsigned char*)(unsigned long long)l; return F;
}
__global__ void __launch_bounds__(512, 2) fwd(Args args) {
    extern __shared__ __attribute__((aligned(16))) unsigned char lds_raw[];
    Frame F0;
    F0.lds = (LAS unsigned char*)lds_raw;
    F0.G = gridDim.x; { const int bx = blockIdx.x; F0.vcu = (F0.G % 8 == 0) ? (bx % 8) * (F0.G / 8) + bx / 8 : bx; }
    F0.cid = blockIdx.x; F0.out = args.out; F0.ws = args.ws;
    volatile LAS unsigned* MISC = (volatile LAS unsigned*)(F0.lds + MISC_OFF);
    for (int u = threadIdx.x; u < (LDS_BYTES - LDSCTL_OFF) / 4; u += 512) ((LAS unsigned*)(F0.lds + LDSCTL_OFF))[u] = 0u;
    __syncthreads();
    if (threadIdx.x < 34) *(LAS unsigned long long*)(F0.lds + LDSCTL_OFF + 8 * threadIdx.x) = (unsigned long long)args.in[threadIdx.x];
    __syncthreads();
    const int lo = args.ph_lo, hi = args.ph_hi;
    XcdBarrier bar; bar.bar = (unsigned*)(F0.ws + WS_CTL); bar.x = 0; bar.st = nullptr;
    if (hi - lo > 1) bar = xcd_barrier_post((unsigned*)(F0.ws + WS_CTL), MISC + 8);
#define IN(k) (lo <= (k) && (k) < hi)
#define SEAM(k) do { if (IN(k) && IN((k) + 1)) xcd_barrier(bar); } while (0)
#define WSP(T_, off) ((T_*)(F.ws + (off)))

    if (IN(0)) { Frame F = lf(F0); conv_layer_weights(F, 0); conv_layer_weights(F, 1); conv_ffn_weights(F); xprep_phase(F, INP(0)); }
    SEAM(0);
    for (int l = 0; l < 2; ++l) {
        const int pb = LAYER_BASE0 + l * LAYER_STRIDE;
        if (IN(pb + 0)) {
            Frame F = lf(F0); unsigned char* wl = F.ws + WS_W + (size_t)l * WL_STRIDE;
            pg8::Gemm g{WSP(bf16, WS_XB), (const bf16*)(wl + WL_IN), D, D, D}; pg8::StaticOrder S; S.init(M, NP, F.G, F.cid);
            pg8::EpiInProj E{WSP(bf16, WS_BIG), WSP(float, WS_RSTD), WSP(float, WS_DT)};
            pg8::gemm_phase(F.lds, g, S, E);
        }
        SEAM(pb + 0);
        if (IN(pb + 1)) { Frame F = lf(F0); vprep_phase(F, l); }
        SEAM(pb + 1);
        if (IN(pb + 2)) {
            Frame F = lf(F0);
            if (F.cid < 16) rwkv_seq(F, l, F.cid);
            else if (F.cid < 32) ssd_seq(F, l, F.cid - 16);
            else if (F.cid < 48) ret_seq(F, F.cid - 32);
        }
        SEAM(pb + 2);
        if (IN(pb + 3)) { Frame F = lf(F0); ssm_norm_phase(F, l); }
        SEAM(pb + 3);
        for (int i = 0; i < 3; ++i) {
            if (IN(pb + 4 + 2 * i)) {
                Frame F = lf(F0); unsigned char* wl = F.ws + WS_W + (size_t)l * WL_STRIDE; bf16* P = WSP(bf16, WS_BIG);
                const bf16* A = (i == 0) ? WSP(const bf16, WS_YRW) : (i == 1 ? P + C_Z : P + C_RETG);
                pg8::Gemm g{A, (const bf16*)(wl + WL_BR) + (size_t)i * D * 512, (i == 0) ? 512 : PLD, 512, 512}; pg8::StaticOrder S; S.init(M, D, F.G, F.cid);
                pg8::EpiPlain E{P, PLD};
                pg8::gemm_phase(F.lds, g, S, E);
            }
            SEAM(pb + 4 + 2 * i);
            if (IN(pb + 5 + 2 * i)) {
                Frame F = lf(F0); unsigned char* wl = F.ws + WS_W + (size_t)l * WL_STRIDE; bf16* P = WSP(bf16, WS_BIG);
                pg8::Gemm g{WSP(bf16, WS_XB), (const bf16*)(wl + WL_GATE) + (size_t)i * D * D, D, D, D}; pg8::StaticOrder S; S.init(M, D, F.G, F.cid);
                pg8::EpiGateMerge E{P, PLD, P + C_RET, PLD, WSP(float, WS_RSTD), i == 0};
                pg8::gemm_phase(F.lds, g, S, E);
            }
            SEAM(pb + 5 + 2 * i);
        }
        if (IN(pb + 10)) {
            Frame F = lf(F0); unsigned char* wl = F.ws + WS_W + (size_t)l * WL_STRIDE; bf16* P = WSP(bf16, WS_BIG);
            pg8::Gemm g{P + C_RET, (const bf16*)(wl + WL_OUT), PLD, D, D}; pg8::StaticOrder S; S.init(M, D, F.G, F.cid);
            pg8::EpiResid E{(l == 0) ? INP(0) : F.out, F.out, nullptr, 0};
            pg8::gemm_phase(F.lds, g, S, E);
        }
        SEAM(pb + 10);
        if (IN(pb + 11)) { Frame F = lf(F0); xprep_phase(F, F.out); if (l == 1) conv_moe_weights(F); }
        SEAM(pb + 11);
        if (l == 0) {
            if (IN(pb + 12)) {
                Frame F = lf(F0);
                pg8::Gemm g{WSP(bf16, WS_XB), WSP(const bf16, WS_FFUP), D, D, D}; pg8::StaticOrder S; S.init(M, 2 * FF, F.G, F.cid);
                pg8::EpiSwiglu E{WSP(bf16, WS_ACT), FF, WSP(float, WS_RSTD)};
                pg8::gemm_phase(F.lds, g, S, E);
            }
            SEAM(pb + 12);
            if (IN(pb + 13)) {
                Frame F = lf(F0);
                pg8::Gemm g{WSP(const bf16, WS_ACT), WSP(const bf16, WS_FFDN), FF, FF, FF}; pg8::StaticOrder S; S.init(M, D, F.G, F.cid);
                pg8::EpiResid E{F.out, F.out, nullptr, 0};
                pg8::gemm_phase(F.lds, g, S, E);
            }
            SEAM(pb + 13);
            if (IN(pb + 14)) { Frame F = lf(F0); xprep_phase(F, F.out); }
            SEAM(pb + 14);
        }
    }
    {
        const int pb = LAYER_BASE0 + LAYER_STRIDE + 12;
        if (IN(pb)) { Frame F = lf(F0); router_phase(F); }
        SEAM(pb);
        for (int e = 0; e < NE; ++e) {
            if (IN(pb + 1 + 2 * e)) {
                Frame F = lf(F0); const bf16* up = (const bf16*)(F.ws + WS_MOEW + (size_t)e * MOEW_STRIDE);
                pg8::Gemm g{WSP(bf16, WS_XB), up, D, D, D}; pg8::StaticOrder S; S.init(M, 2 * FFE, F.G, F.cid);
                pg8::EpiSwiglu E{WSP(bf16, WS_ACT), FFE, WSP(float, WS_RSTD)};
                pg8::gemm_phase(F.lds, g, S, E);
            }
            SEAM(pb + 1 + 2 * e);
            if (IN(pb + 2 + 2 * e)) {
                Frame F = lf(F0); const bf16* dn = (const bf16*)(F.ws + WS_MOEW + (size_t)e * MOEW_STRIDE + MOEW_DN);
                pg8::Gemm g{WSP(const bf16, WS_ACT), dn, FFE, FFE, FFE}; pg8::StaticOrder S; S.init(M, D, F.G, F.cid);
                pg8::EpiResid E{F.out, F.out, WSP(float, WS_GATES), e};
                pg8::gemm_phase(F.lds, g, S, E);
            }
            SEAM(pb + 2 + 2 * e);
        }
        if (IN(pb + 17)) { Frame F = lf(F0); final_norm_phase(F); }
    }
#undef IN
#undef SEAM
#undef WSP
}
constexpr int LAST_PHASE = LAYER_BASE0 + LAYER_STRIDE + 12 + 17;
constexpr int N_PH = LAST_PHASE + 1;

extern "C" void kernel_launch(void* const* d_in, const int* in_sizes, int n_in, void* d_out, int out_size, void* d_ws, size_t ws_size, hipStream_t stream) {
    static int grid = 0;
    if (grid == 0) {
        if (n_in != 34 || out_size != M * D || ws_size < WS_END) { fprintf(stderr, "kernel_launch: unexpected problem (n_in %d out %d ws %zu need %zu)\n", n_in, out_size, ws_size, (size_t)WS_END); grid = -1; return; }
        int dev = 0, cus = 0;
        if (hipGetDevice(&dev) != hipSuccess || hipDeviceGetAttribute(&cus, hipDeviceAttributeMultiprocessorCount, dev) != hipSuccess) { grid = -1; return; }
        if (hipFuncSetAttribute((const void*)fwd, hipFuncAttributeMaxDynamicSharedMemorySize, LDS_BYTES) != hipSuccess) { fprintf(stderr, "kernel_launch: hipFuncSetAttribute failed\n"); grid = -1; return; }
        int per_cu = 0;
        if (hipOccupancyMaxActiveBlocksPerMultiprocessor(&per_cu, (const void*)fwd, 512, LDS_BYTES) != hipSuccess || per_cu < 1) fprintf(stderr, "kernel_launch: occupancy query says %d\n", per_cu);
        (void)hipGetLastError();
        grid = cus;
    }
    if (grid < 0) return;
    (void)hipMemsetAsync((char*)d_ws + WS_CTL, 0, CTL_ZERO_BYTES, stream);
    Args a{};
    for (int i = 0; i < 34; ++i) a.in[i] = (const float*)d_in[i];
    a.out = (float*)d_out; a.ws = (unsigned char*)d_ws;
#if MK_ONE_LAUNCH
    a.ph_lo = 0; a.ph_hi = N_PH;
    hipLaunchKernelGGL(fwd, dim3(grid), dim3(512), LDS_BYTES, stream, a);
#else
    for (int p = 0; p < N_PH; ++p) { a.ph_lo = p; a.ph_hi = p + 1; hipLaunchKernelGGL(fwd, dim3(grid), dim3(512), LDS_BYTES, stream, a); }
#endif
}
```

```cpp
#include <hip/hip_runtime.h>
#include <cstdio>
#include <cstdint>

#ifndef MK_ONE_LAUNCH
#define MK_ONE_LAUNCH 1
#endif

#define LAS __attribute__((address_space(3)))
#define GAS __attribute__((address_space(1)))
typedef unsigned short bf16;
typedef short bf16x8 __attribute__((ext_vector_type(8)));
typedef float f32x4 __attribute__((ext_vector_type(4)));
typedef unsigned u32x4 __attribute__((ext_vector_type(4)));
typedef unsigned u32x2 __attribute__((ext_vector_type(2)));

constexpr int BATCH = 2, T = 16384, D = 1024, M = BATCH * T;
constexpr int INC = 8456;
constexpr int PLD = 5376;
constexpr int NP = 5632;
constexpr int C_RW = 0, C_Z = 1792, C_XBC = 2304, C_RET = 3328, C_RETG = 4864;
constexpr int FF = 2816, FFE = 3584, NE = 8;

constexpr size_t MiB = 1u << 20;
constexpr size_t WS_CTL = 0, CTL_ZERO_BYTES = 64 * 1024;
constexpr size_t WS_RSTD = 1 * MiB, WS_GATES = 2 * MiB, WS_DT = 3 * MiB;
constexpr size_t WS_W = 4 * MiB;
constexpr size_t WL_IN = 0, WL_GATE = 11 * MiB, WL_BR = 17 * MiB, WL_OUT = 20 * MiB, WL_STRIDE = 22 * MiB;
constexpr size_t WS_FFUP = WS_W + 44 * MiB, WS_FFDN = WS_W + 55 * MiB;
constexpr size_t WS_XB = 68 * MiB;
constexpr size_t WS_VF = 132 * MiB;
constexpr size_t WS_BIG = 164 * MiB;
constexpr size_t WS_VMIX = WS_BIG + 336 * MiB, WS_YRW = WS_BIG + 368 * MiB, WS_END = WS_BIG + 400 * MiB;
constexpr size_t WS_MOEW = WS_BIG;
constexpr size_t MOEW_STRIDE = 21 * MiB, MOEW_DN = 14 * MiB;
constexpr size_t WS_ACT = WS_BIG + 168 * MiB;

constexpr size_t WS_DSTOT = 128 * 1024, WS_BND = 256 * 1024;
constexpr size_t WS_LORA = 1 * MiB + 512 * 1024, LORA_STRIDE = 262144;
constexpr size_t WS_ST_RW = WS_XB, WS_ST_RET = WS_XB + 16 * MiB, WS_ST_SSD = WS_XB + 32 * MiB, WS_MT = WS_YRW;
constexpr int RING_BYTES = 131072, LDSCTL_OFF = 159744, MISC_OFF = LDSCTL_OFF + 320, LDS_BYTES = 163840;
#ifndef RW_CH
#define RW_CH 1
#endif
#ifndef RET_CH
#define RET_CH 1
#endif
#ifndef SSD_CH
#define SSD_CH 1
#endif

__device__ __forceinline__ unsigned f2bf(float f) { unsigned u = __builtin_bit_cast(unsigned, f); return (u + 0x7fffu + ((u >> 16) & 1u)) >> 16; }
__device__ __forceinline__ unsigned pk2(float lo, float hi) { return f2bf(lo) | (f2bf(hi) << 16); }
__device__ __forceinline__ float bflo(unsigned u) { return __builtin_bit_cast(float, u << 16); }
__device__ __forceinline__ float bfhi(unsigned u) { return __builtin_bit_cast(float, u & 0xffff0000u); }
__device__ __forceinline__ void unpack8(const u32x4 u, float (&f)[8]) { f[0] = bflo(u.x); f[1] = bfhi(u.x); f[2] = bflo(u.y); f[3] = bfhi(u.y); f[4] = bflo(u.z); f[5] = bfhi(u.z); f[6] = bflo(u.w); f[7] = bfhi(u.w); }
__device__ __forceinline__ u32x4 pack8(const float (&f)[8]) { u32x4 w; w.x = pk2(f[0], f[1]); w.y = pk2(f[2], f[3]); w.z = pk2(f[4], f[5]); w.w = pk2(f[6], f[7]); return w; }
__device__ __forceinline__ float sigm(float x) { return 1.f / (1.f + __expf(-x)); }
__device__ __forceinline__ float silu(float x) { return x / (1.f + __expf(-x)); }
__device__ __forceinline__ float softplus_acc(float x) { return fmaxf(x, 0.f) + log1pf(expf(-fabsf(x))); }
__device__ __forceinline__ float wave_sum(float v) {
#pragma unroll
    for (int o = 1; o < 64; o <<= 1) v += __shfl_xor(v, o);
    return v;
}
__device__ __forceinline__ int otid() { int t = threadIdx.x; asm volatile("" : "+v"(t)); return t; }
__device__ __forceinline__ int fresh_tid(int t) { asm volatile("" : "+v"(t)); return t; }
#define LDS_WAIT() asm volatile("s_waitcnt lgkmcnt(0)" ::: "memory")

namespace pg8 {
constexpr int BM = 256, BK = 64, HALF = 128, HTB = HALF * BK * 2, STAGE_BYTES = 8 * HTB, NXCD = 8, WGM = 8;
__host__ __device__ __forceinline__ int lds_byte(int r, int c) { const int st = (r >> 4) * 2 + (c >> 5), rr = r & 15, cc = c & 31, ob = rr * 64 + cc * 2; return st * 1024 + (ob ^ (((ob >> 9) & 1) << 5)); }
__host__ __device__ __forceinline__ void stage_rc(int b, int& R, int& C) { const int st = b / 1024, sb = b % 1024, swz = sb ^ (((sb >> 9) & 1) << 5); R = (st >> 1) * 16 + swz / 64; C = (st & 1) * 32 + (swz % 64) / 2; }
__host__ __device__ __forceinline__ int perm32(int rho) { const int n = rho >> 4, i = rho & 15; return 8 * (i >> 2) + 4 * n + (i & 3); }

struct Unit { int pm, pn; };
struct Gemm { const bf16* A; const bf16* Bt; int lda, ldb, K; };

struct StaticOrder {
    int nM, nN, nwg, G, c;
    __device__ void init(int Mrows, int N, int G_, int c_) { nM = Mrows / BM; nN = N / BM; nwg = nM * nN; G = G_; c = c_; }
    __device__ bool next(int i, Unit& u) const {
        const long L = (long)i * G + c; if (L >= nwg) return false;
        int wgid = (int)L; { const int q = nwg / NXCD, r = nwg % NXCD, xcd = wgid % NXCD, off = wgid / NXCD; wgid = (xcd < r ? xcd * (q + 1) : r * (q + 1) + (xcd - r) * q) + off; }
        const int nig = WGM * nN, gid = wgid / nig, fm = gid * WGM, gsz = (nM - fm) < WGM ? (nM - fm) : WGM;
        u.pm = fm + ((wgid % nig) % gsz); u.pn = (wgid % nig) / gsz; return true;
    }
};

template <class Epi>
__device__ __forceinline__ void gemm_phase(LAS unsigned char* lds, const Gemm g, const StaticOrder& S, const Epi& E) {
    const int tid = otid(), wid = __builtin_amdgcn_readfirstlane(tid >> 6), lane = tid & 63, wr = wid >> 2, wc = wid & 3, fr = lane & 15, fq = lane >> 4;
    const int nt = g.K / BK;
    unsigned voffA[2], voffB[2];
#pragma unroll
    for (int i = 0; i < 2; ++i) { int R, C; stage_rc(tid * 16 + i * 8192, R, C); const int Rb = Epi::PERM ? ((R & ~31) + perm32(R & 31)) : R;
        voffA[i] = (unsigned)(R * g.lda + C) * 2u; voffB[i] = (unsigned)(Rb * g.ldb + C) * 2u; }
    const size_t kstep = (size_t)(BK * 2);
    const size_t hstepA = (size_t)HALF * g.lda * 2, hstepB = (size_t)HALF * g.ldb * 2;
    const size_t tstepA = 2 * hstepA, tstepB = 2 * hstepB;
    const unsigned ldsw = (unsigned)wid * 1024u;
    const int aoff = lds_byte(wr * 64 + fr, fq * 8), boff = lds_byte(wc * 32 + fr, fq * 8);
#define PG8_SA(b, h) (((b) * 2 + (h)) * HTB)
#define PG8_SB(b, h) ((4 + (b) * 2 + (h)) * HTB)
#define PG8_STAGE(bufoff, gbase, voff) do { _Pragma("unroll") for (int _i = 0; _i < 2; ++_i) \
        __builtin_amdgcn_global_load_lds((const unsigned*)((const char*)(gbase) + (voff)[_i]), (LAS unsigned*)(lds + (bufoff) + ldsw + _i * 8192), 16, 0, 0); } while (0)
#define PG8_LDA(dst, b, h) do { _Pragma("unroll") for (int m = 0; m < 4; ++m) _Pragma("unroll") for (int k = 0; k < 2; ++k) dst[m][k] = *(const LAS bf16x8*)(lds + PG8_SA(b, h) + aoff + m * 2048 + k * 1024); } while (0)
#define PG8_LDB(dst, b, h) do { _Pragma("unroll") for (int n = 0; n < 2; ++n) _Pragma("unroll") for (int k = 0; k < 2; ++k) dst[n][k] = *(const LAS bf16x8*)(lds + PG8_SB(b, h) + boff + n * 2048 + k * 1024); } while (0)
#define PG8_MMA(ai, bj, At, Bt) do { __builtin_amdgcn_s_setprio(1); _Pragma("unroll") for (int m = 0; m < 4; ++m) _Pragma("unroll") for (int n = 0; n < 2; ++n) _Pragma("unroll") for (int k = 0; k < 2; ++k) \
        acc[ai][bj][m][n] = __builtin_amdgcn_mfma_f32_16x16x32_bf16(Bt[n][k], At[m][k], acc[ai][bj][m][n], 0, 0, 0); __builtin_amdgcn_s_setprio(0); } while (0)
#define PG8_WAIT_V(n) asm volatile("s_waitcnt vmcnt(" #n ")" ::: "memory")
#define PG8_WAIT_L(n) asm volatile("s_waitcnt lgkmcnt(" #n ")" ::: "memory")
#define PG8_BAR __builtin_amdgcn_s_barrier()
#define PG8_SCHED __builtin_amdgcn_sched_barrier(0)
    Unit cur, nxt; int ui = 0;
    if (!S.next(0, cur)) return;
    f32x4 acc[2][2][4][2];
#pragma unroll
    for (int a = 0; a < 2; ++a)
#pragma unroll
        for (int b = 0; b < 2; ++b)
#pragma unroll
            for (int m = 0; m < 4; ++m)
#pragma unroll
                for (int n = 0; n < 2; ++n) acc[a][b][m][n] = (f32x4){0.f, 0.f, 0.f, 0.f};
    bf16x8 At[4][2], B0[2][2], B1[2][2];
    const char* cA = (const char*)g.A + (size_t)cur.pm * tstepA; const char* cB = (const char*)g.Bt + (size_t)cur.pn * tstepB;
    PG8_STAGE(PG8_SB(0, 0), cB, voffB); PG8_STAGE(PG8_SB(0, 1), cB + hstepB, voffB); PG8_STAGE(PG8_SA(0, 0), cA, voffA); PG8_STAGE(PG8_SA(0, 1), cA + hstepA, voffA);
    if (wr == 1) PG8_BAR;
    PG8_WAIT_V(2); PG8_BAR;
    PG8_STAGE(PG8_SB(1, 0), cB + kstep, voffB); PG8_STAGE(PG8_SA(1, 0), cA + kstep, voffA); PG8_STAGE(PG8_SB(1, 1), cB + hstepB + kstep, voffB);
    PG8_WAIT_V(6); PG8_BAR;
    for (;;) {
        const bool has_next = S.next(ui + 1, nxt);
        const char* nA = has_next ? (const char*)g.A + (size_t)nxt.pm * tstepA : cA; const char* nB = has_next ? (const char*)g.Bt + (size_t)nxt.pn * tstepB : cB;
        for (int t = 0; t < nt; t += 2) {
            const bool last = (t == nt - 2);
            const char* a1 = cA + (size_t)(t + 1) * kstep;
            const char* a2 = last ? nA : cA + (size_t)(t + 2) * kstep; const char* b2 = last ? nB : cB + (size_t)(t + 2) * kstep;
            const char* a3 = a2 + kstep; const char* b3 = b2 + kstep;
            PG8_LDB(B0, 0, 0); PG8_LDB(B1, 0, 1); PG8_SCHED; PG8_LDA(At, 0, 0); PG8_STAGE(PG8_SA(1, 1), a1 + hstepA, voffA);
            PG8_WAIT_V(8); PG8_WAIT_L(0); PG8_BAR; PG8_MMA(0, 0, At, B0); PG8_MMA(0, 1, At, B1); PG8_BAR; PG8_SCHED;
            PG8_LDA(At, 0, 1); PG8_STAGE(PG8_SB(0, 0), b2, voffB); PG8_STAGE(PG8_SB(0, 1), b2 + hstepB, voffB); PG8_STAGE(PG8_SA(0, 0), a2, voffA);
            PG8_WAIT_V(8); PG8_WAIT_L(0); PG8_BAR; PG8_MMA(1, 0, At, B0); PG8_MMA(1, 1, At, B1); PG8_BAR; PG8_SCHED;
            PG8_LDB(B0, 1, 0); PG8_LDB(B1, 1, 1); PG8_SCHED; PG8_LDA(At, 1, 0); PG8_STAGE(PG8_SA(0, 1), a2 + hstepA, voffA);
            PG8_WAIT_V(8); PG8_WAIT_L(0); PG8_BAR; PG8_MMA(0, 0, At, B0); PG8_MMA(0, 1, At, B1); PG8_BAR; PG8_SCHED;
            PG8_LDA(At, 1, 1); PG8_STAGE(PG8_SB(1, 0), b3, voffB); PG8_STAGE(PG8_SB(1, 1), b3 + hstepB, voffB); PG8_STAGE(PG8_SA(1, 0), a3, voffA);
            PG8_WAIT_V(8); PG8_WAIT_L(0); PG8_BAR; PG8_MMA(1, 0, At, B0); PG8_MMA(1, 1, At, B1); PG8_BAR; PG8_SCHED;
        }
        if (wr == 0) PG8_BAR;
        E(acc, cur, wr, wc, fr, fq);
        if (!has_next) break;
#pragma unroll
        for (int a = 0; a < 2; ++a)
#pragma unroll
            for (int b = 0; b < 2; ++b)
#pragma unroll
                for (int m = 0; m < 4; ++m)
#pragma unroll
                    for (int n = 0; n < 2; ++n) acc[a][b][m][n] = (f32x4){0.f, 0.f, 0.f, 0.f};
        cur = nxt; cA = nA; cB = nB; ++ui;
        if (wr == 1) PG8_BAR;
    }
    PG8_WAIT_V(0);
    PG8_BAR;
#undef PG8_SA
#undef PG8_SB
#undef PG8_STAGE
#undef PG8_LDA
#undef PG8_LDB
#undef PG8_MMA
#undef PG8_WAIT_V
#undef PG8_WAIT_L
#undef PG8_BAR
#undef PG8_SCHED
}

typedef const f32x4 (&AccRef)[2][2][4][2];

struct EpiInProj {
    static constexpr bool PERM = true;
    bf16* P; const float* rstd; float* dt;
    __device__ __forceinline__ void operator()(AccRef acc, const Unit& u, int wr, int wc, int fr, int fq) const {
        const int row0 = u.pm * BM + wr * 64 + fr;
        if (u.pn < 21) {
            const int col0 = u.pn * BM + wc * 32 + 8 * fq;
#pragma unroll
            for (int ai = 0; ai < 2; ++ai)
#pragma unroll
                for (int m = 0; m < 4; ++m) { const int row = row0 + ai * HALF + m * 16; const float s = rstd[row]; bf16* rowp = P + (size_t)row * PLD + col0;
#pragma unroll
                    for (int bj = 0; bj < 2; ++bj) { const f32x4 v0 = acc[ai][bj][m][0] * s, v1 = acc[ai][bj][m][1] * s;
                        u32x4 w; w.x = pk2(v0[0], v0[1]); w.y = pk2(v0[2], v0[3]); w.z = pk2(v1[0], v1[1]); w.w = pk2(v1[2], v1[3]);
                        *(u32x4*)(rowp + bj * HALF) = w; } }
        } else if (wc == 0 && fq == 0) {
#pragma unroll
            for (int ai = 0; ai < 2; ++ai)
#pragma unroll
                for (int m = 0; m < 4; ++m) { const int row = row0 + ai * HALF + m * 16; const float s = rstd[row];
                    *(f32x4*)(dt + (size_t)row * 8) = acc[ai][0][m][0] * s; *(f32x4*)(dt + (size_t)row * 8 + 4) = acc[ai][0][m][1] * s; }
        }
    }
};
struct EpiPlain {
    static constexpr bool PERM = true;
    bf16* O; int ldc;
    __device__ __forceinline__ void operator()(AccRef acc, const Unit& u, int wr, int wc, int fr, int fq) const {
        const int row0 = u.pm * BM + wr * 64 + fr, col0 = u.pn * BM + wc * 32 + 8 * fq;
#pragma unroll
        for (int ai = 0; ai < 2; ++ai)
#pragma unroll
            for (int m = 0; m < 4; ++m) { bf16* rowp = O + (size_t)(row0 + ai * HALF + m * 16) * ldc + col0;
#pragma unroll
                for (int bj = 0; bj < 2; ++bj) { const f32x4 v0 = acc[ai][bj][m][0], v1 = acc[ai][bj][m][1];
                    u32x4 w; w.x = pk2(v0[0], v0[1]); w.y = pk2(v0[2], v0[3]); w.z = pk2(v1[0], v1[1]); w.w = pk2(v1[2], v1[3]);
                    *(u32x4*)(rowp + bj * HALF) = w; } }
    }
};
struct EpiGateMerge {
    static constexpr bool PERM = true;
    const bf16* Y; int ldy; bf16* Mg; int ldm; const float* rstd; int first;
    __device__ __forceinline__ void operator()(AccRef acc, const Unit& u, int wr, int wc, int fr, int fq) const {
        const int row0 = u.pm * BM + wr * 64 + fr, col0 = u.pn * BM + wc * 32 + 8 * fq;
#pragma unroll
        for (int ai = 0; ai < 2; ++ai)
#pragma unroll
            for (int m = 0; m < 4; ++m) { const int row = row0 + ai * HALF + m * 16; const float s = rstd[row];
#pragma unroll
                for (int bj = 0; bj < 2; ++bj) { const int c = col0 + bj * HALF;
                    float y[8], o[8]; unpack8(*(const u32x4*)(Y + (size_t)row * ldy + c), y);
                    const f32x4 v0 = acc[ai][bj][m][0] * s, v1 = acc[ai][bj][m][1] * s;
#pragma unroll
                    for (int j = 0; j < 4; ++j) { o[j] = sigm(v0[j]) * y[j]; o[4 + j] = sigm(v1[j]) * y[4 + j]; }
                    if (!first) { float p[8]; unpack8(*(const u32x4*)(Mg + (size_t)row * ldm + c), p);
#pragma unroll
                        for (int j = 0; j < 8; ++j) o[j] += p[j]; }
                    *(u32x4*)(Mg + (size_t)row * ldm + c) = pack8(o); } }
    }
};
struct EpiResid {
    static constexpr bool PERM = false;
    const float* xin; float* xout; const float* gates; int e;
    __device__ __forceinline__ void operator()(AccRef acc, const Unit& u, int wr, int wc, int fr, int fq) const {
        const int row0 = u.pm * BM + wr * 64 + fr, col0 = u.pn * BM + wc * 32 + 4 * fq;
#pragma unroll
        for (int ai = 0; ai < 2; ++ai)
#pragma unroll
            for (int m = 0; m < 4; ++m) { const int row = row0 + ai * HALF + m * 16; const float s = gates ? gates[(size_t)row * 8 + e] : 1.f;
                const float* ip = xin + (size_t)row * D + col0; float* op = xout + (size_t)row * D + col0;
#pragma unroll
                for (int bj = 0; bj < 2; ++bj)
#pragma unroll
                    for (int n = 0; n < 2; ++n) *(f32x4*)(op + bj * HALF + n * 16) = *(const f32x4*)(ip + bj * HALF + n * 16) + acc[ai][bj][m][n] * s; }
    }
};
struct EpiSwiglu {
    static constexpr bool PERM = true;
    bf16* act; int ldc; const float* rstd;
    __device__ __forceinline__ void operator()(AccRef acc, const Unit& u, int wr, int wc, int fr, int fq) const {
        const int row0 = u.pm * BM + wr * 64 + fr, col0 = u.pn * HALF + wc * 32 + 8 * fq;
#pragma unroll
        for (int ai = 0; ai < 2; ++ai)
#pragma unroll
            for (int m = 0; m < 4; ++m) { const int row = row0 + ai * HALF + m * 16; const float s = rstd[row];
                float o[8];
#pragma unroll
                for (int n = 0; n < 2; ++n)
#pragma unroll
                    for (int j = 0; j < 4; ++j) o[4 * n + j] = silu(acc[ai][0][m][n][j] * s) * (acc[ai][1][m][n][j] * s);
                *(u32x4*)(act + (size_t)row * ldc + col0) = pack8(o); }
    }
};
}

#define XB_TMO      128
#define XB_XCNT(j)  (256  + 64 * (j))
#define XB_XSUB(j)  (1280 + 64 * (j))
#define XB_XGEN(j)  (2304 + 64 * (j))
#define XB_TOP      3328
#define XB_TOPGEN   3392
#define XCD_BAR_WORDS 3456
#define XB_SPIN_CAP (1u << 18)

__device__ __forceinline__ unsigned xb_ld(unsigned* p)              { return __hip_atomic_load(p, __ATOMIC_RELAXED, __HIP_MEMORY_SCOPE_AGENT); }
__device__ __forceinline__ unsigned xb_add(unsigned* p, unsigned v) { return __hip_atomic_fetch_add(p, v, __ATOMIC_RELAXED, __HIP_MEMORY_SCOPE_AGENT); }
__device__ __forceinline__ unsigned xb_xcc_id() { return (unsigned)__builtin_amdgcn_s_getreg((3 << 11) | 20) & 0xFu; }
#define XB_SPIN(cond, bar) do { unsigned _sp = 0; while (cond) { __builtin_amdgcn_s_sleep(1); \
    if ((++_sp & 255u) == 0u) { if (xb_ld(&(bar)[XB_TMO])) break; if (_sp > XB_SPIN_CAP) { atomicAdd(&(bar)[XB_TMO], 1u); break; } } } } while (0)

struct XcdBarrier { unsigned* bar; unsigned x; volatile LAS unsigned* st; };

__device__ __forceinline__ XcdBarrier xcd_barrier_post(unsigned* bar, volatile LAS unsigned* st) {
    XcdBarrier b; b.bar = bar; b.x = xb_xcc_id(); b.st = st;
    if (threadIdx.x == 0) (void)xb_add(&bar[XB_XCNT(b.x)], 1u);
    return b;
}
__device__ __forceinline__ void xcd_barrier_complete(unsigned* bar, unsigned x, unsigned& nloc, unsigned& nx) {
    const unsigned G = gridDim.x * gridDim.y * gridDim.z;
    unsigned sum, cnt, mine, sp = 0u;
    for (;;) {
        sum = 0u; cnt = 0u; mine = 0u;
#pragma unroll
        for (unsigned j = 0; j < 16; ++j) { const unsigned c = xb_ld(&bar[XB_XCNT(j)]); sum += c; cnt += (c > 0u) ? 1u : 0u; mine = (j == x) ? c : mine; }
        if (sum == G) break;
        __builtin_amdgcn_s_sleep(1);
        if ((++sp & 255u) == 0u) { if (xb_ld(&bar[XB_TMO])) break; if (sp > XB_SPIN_CAP) { atomicAdd(&bar[XB_TMO], 1u); break; } }
    }
    nloc = mine > 0u ? mine : 1u; nx = cnt > 0u ? cnt : 1u;
}
__device__ __forceinline__ void xcd_barrier(const XcdBarrier& b) {
    asm volatile("s_waitcnt vmcnt(0)" ::: "memory");
    __syncthreads();
    if (threadIdx.x == 0) {
        unsigned* bar = b.bar;
        __builtin_amdgcn_s_waitcnt(0);
        unsigned nloc = b.st[0], nx = b.st[1];
        if (nloc == 0u) { xcd_barrier_complete(bar, b.x, nloc, nx); b.st[0] = nloc; b.st[1] = nx; }
        const unsigned old = xb_add(&bar[XB_XSUB(b.x)], 1u);
        const unsigned gen = old / nloc;
        if (old + 1u == (gen + 1u) * nloc) {
            __builtin_amdgcn_fence(__ATOMIC_RELEASE, "agent");
            asm volatile("s_waitcnt vmcnt(0)" ::: "memory");
            const unsigned og = xb_add(&bar[XB_TOP], 1u);
            const unsigned tg = og / nx;
            if (og + 1u == (tg + 1u) * nx) xb_add(&bar[XB_TOPGEN], 1u);
            else XB_SPIN(xb_ld(&bar[XB_TOPGEN]) == tg, bar);
            __builtin_amdgcn_fence(__ATOMIC_ACQUIRE, "agent");
            xb_add(&bar[XB_XGEN(b.x)], 1u);
            asm volatile("s_waitcnt vmcnt(0)" ::: "memory");
        } else {
            XB_SPIN(xb_ld(&bar[XB_XGEN(b.x)]) == gen, bar);
            __builtin_amdgcn_fence(__ATOMIC_ACQUIRE, "agent");
            asm volatile("s_waitcnt vmcnt(0)" ::: "memory");
        }
    }
    __syncthreads();
}

struct Args { const float* in[34]; float* out; unsigned char* ws; int ph_lo, ph_hi; };
struct Frame {
    LAS unsigned char* lds;
    int vcu, G, cid;
    float* out; unsigned char* ws;
};
__device__ __forceinline__ const float* inptr(LAS unsigned char* lds, int i) {
    int off = LDSCTL_OFF + 8 * i; asm volatile("" : "+v"(off));
    const LAS unsigned* p = (const LAS unsigned*)(lds + off);
    const unsigned lo = __builtin_amdgcn_readfirstlane(p[0]), hi = __builtin_amdgcn_readfirstlane(p[1]);
    return (const float*)(((unsigned long long)hi << 32) | lo);
}
#define INP(i) inptr(F.lds, (i))

__device__ __forceinline__ void conv_item(const float* W, int ld, int k0, int c0, int nvalid, const float* scale, bf16* dst, int K, int drow0, LAS float* scr, int lane) {
    const int n = lane & 31;
#pragma unroll 8
    for (int i = 0; i < 32; ++i) { const int kk = 2 * i + (lane >> 5);
        float v = 0.f; if (n < nvalid) { v = W[(size_t)(k0 + kk) * ld + c0 + n]; if (scale) v *= scale[k0 + kk]; }
        scr[kk * 33 + n] = v; }
    LDS_WAIT(); asm volatile("" ::: "memory");
    const int c = lane & 7;
#pragma unroll
    for (int j = 0; j < 4; ++j) { const int nn = (lane >> 3) + 8 * j; const LAS float* s = scr + (8 * c) * 33 + nn;
        u32x4 o; o.x = pk2(s[0 * 33], s[1 * 33]); o.y = pk2(s[2 * 33], s[3 * 33]); o.z = pk2(s[4 * 33], s[5 * 33]); o.w = pk2(s[6 * 33], s[7 * 33]);
        *(u32x4*)(dst + (size_t)(drow0 + nn) * K + k0 + 8 * c) = o; }
    LDS_WAIT(); asm volatile("" ::: "memory");
}
__device__ __forceinline__ void conv_seg(Frame& F, const float* W, int ld, int K, int c0, int nvalid, int ntotal, const float* scale, bf16* dst, int r0, int blk, int blks) {
    const int ptid = otid(), plane = ptid & 63, pwave = __builtin_amdgcn_readfirstlane(ptid >> 6); (void)plane; (void)pwave;
    LAS float* scr = (LAS float*)(F.lds + pwave * 16384);
    const int gw = F.vcu * 8 + pwave, NGW = F.G * 8;
    const int nblk = ntotal / 32, nitems = (K / 64) * nblk;
    for (int it = gw; it < nitems; it += NGW) {
        const int kb = it / nblk, nb = it % nblk, n0 = nb * 32;
        int nv = nvalid - n0; nv = nv < 0 ? 0 : (nv > 32 ? 32 : nv);
        conv_item(W, ld, kb * 64, c0 + n0, nv, scale, dst, K, r0 + (n0 / blk) * blks + (n0 % blk), scr, plane);
    }
}
__device__ __forceinline__ void conv_layer_weights(Frame& F, int l) {
    unsigned char* wl = F.ws + WS_W + (size_t)l * WL_STRIDE;
    const float* win = INP(2) + (size_t)l * D * INC; const float* n1 = INP(1) + l * D;
    const int BIGB = 1 << 30;
    conv_seg(F, win, INC, D, 0, 3328, 3328, n1, (bf16*)(wl + WL_IN), 0, BIGB, 0);
    conv_seg(F, win, INC, D, 3336, 2048, 2048, n1, (bf16*)(wl + WL_IN), 3328, BIGB, 0);
    conv_seg(F, win, INC, D, 3328, 8, 256, n1, (bf16*)(wl + WL_IN), 5376, BIGB, 0);
    conv_seg(F, win, INC, D, 5384, 3072, 3072, n1, (bf16*)(wl + WL_GATE), 0, BIGB, 0);
    for (int i = 0; i < 3; ++i)
        conv_seg(F, INP(23) + ((size_t)l * 3 + i) * 512 * D, D, 512, 0, D, D, nullptr, (bf16*)(wl + WL_BR) + (size_t)i * D * 512, 0, BIGB, 0);
    conv_seg(F, INP(24) + (size_t)l * D * D, D, D, 0, D, D, nullptr, (bf16*)(wl + WL_OUT), 0, BIGB, 0);
}
__device__ __forceinline__ void conv_ffn_weights(Frame& F) {
    const float* n2 = INP(25);
    conv_seg(F, INP(26), FF, D, 0, FF, FF, n2, (bf16*)(F.ws + WS_FFUP), 0, 128, 256);
    conv_seg(F, INP(27), FF, D, 0, FF, FF, n2, (bf16*)(F.ws + WS_FFUP), 128, 128, 256);
    conv_seg(F, INP(28), D, FF, 0, D, D, nullptr, (bf16*)(F.ws + WS_FFDN), 0, 1 << 30, 0);
}
__device__ __forceinline__ void conv_moe_weights(Frame& F) {
    const float* n2 = INP(25) + D;
    for (int e = 0; e < NE; ++e) {
        bf16* up = (bf16*)(F.ws + WS_MOEW + (size_t)e * MOEW_STRIDE); bf16* dn = (bf16*)(F.ws + WS_MOEW + (size_t)e * MOEW_STRIDE + MOEW_DN);
        conv_seg(F, INP(30) + (size_t)e * D * FFE, FFE, D, 0, FFE, FFE, n2, up, 0, 128, 256);
        conv_seg(F, INP(31) + (size_t)e * D * FFE, FFE, D, 0, FFE, FFE, n2, up, 128, 128, 256);
        conv_seg(F, INP(32) + (size_t)e * FFE * D, D, FFE, 0, D, D, nullptr, dn, 0, 1 << 30, 0);
    }
}

__device__ __forceinline__ void xprep_phase(Frame& F, const float* x) {
    const int ptid = otid(), plane = ptid & 63, pwave = __builtin_amdgcn_readfirstlane(ptid >> 6); (void)plane; (void)pwave;
    const int gw = F.vcu * 8 + pwave, NGW = F.G * 8;
    bf16* xb = (bf16*)(F.ws + WS_XB); float* rstd = (float*)(F.ws + WS_RSTD);
    for (int m = gw; m < M; m += NGW) {
        const f32x4* xr = (const f32x4*)(x + (size_t)m * D) + plane;
        f32x4 v[4]; float s = 0.f;
#pragma unroll
        for (int j = 0; j < 4; ++j) { v[j] = xr[64 * j]; s += (v[j].x * v[j].x + v[j].y * v[j].y) + (v[j].z * v[j].z + v[j].w * v[j].w); }
        s = wave_sum(s);
        if (plane == 0) rstd[m] = 1.f / sqrtf(s * (1.f / D) + 1e-6f);
        u32x2* o8 = (u32x2*)(xb + (size_t)m * D) + plane;
#pragma unroll
        for (int j = 0; j < 4; ++j) { u32x2 w; w.x = pk2(v[j].x, v[j].y); w.y = pk2(v[j].z, v[j].w); o8[64 * j] = w; }
    }
}
__device__ __forceinline__ void final_norm_phase(Frame& F) {
    const int ptid = otid(), plane = ptid & 63, pwave = __builtin_amdgcn_readfirstlane(ptid >> 6); (void)plane; (void)pwave;
    const int gw = F.vcu * 8 + pwave, NGW = F.G * 8;
    const float* fw = INP(33);
    for (int m = gw; m < M; m += NGW) {
        f32x4* xr = (f32x4*)(F.out + (size_t)m * D) + plane;
        f32x4 v[4]; float s = 0.f;
#pragma unroll
        for (int j = 0; j < 4; ++j) { v[j] = xr[64 * j]; s += (v[j].x * v[j].x + v[j].y * v[j].y) + (v[j].z * v[j].z + v[j].w * v[j].w); }
        s = wave_sum(s);
        const float r = 1.f / sqrtf(s * (1.f / D) + 1e-6f);
#pragma unroll
        for (int j = 0; j < 4; ++j) { const f32x4 w = *((const f32x4*)fw + plane + 64 * j); xr[64 * j] = v[j] * r * w; }
    }
}
__device__ __forceinline__ void router_phase(Frame& F) {
    const int ptid = otid(), plane = ptid & 63, pwave = __builtin_amdgcn_readfirstlane(ptid >> 6); (void)plane; (void)pwave;
    const int gw = F.vcu * 8 + pwave, NGW = F.G * 8;
    const float* nw = INP(25) + D; const float* rt = INP(29); const float* rstd = (const float*)(F.ws + WS_RSTD); float* gates = (float*)(F.ws + WS_GATES);
    for (int m = gw; m < M; m += NGW) {
        float acc[8];
#pragma unroll
        for (int e = 0; e < 8; ++e) acc[e] = 0.f;
        const float* xr = F.out + (size_t)m * D;
#pragma unroll 4
        for (int j = 0; j < 16; ++j) { const int k = plane + 64 * j; const float xv = xr[k] * nw[k];
            const f32x4 r0 = *(const f32x4*)(rt + (size_t)k * 8), r1 = *(const f32x4*)(rt + (size_t)k * 8 + 4);
            acc[0] += xv * r0.x; acc[1] += xv * r0.y; acc[2] += xv * r0.z; acc[3] += xv * r0.w; acc[4] += xv * r1.x; acc[5] += xv * r1.y; acc[6] += xv * r1.z; acc[7] += xv * r1.w; }
        const float s = rstd[m];
#pragma unroll
        for (int e = 0; e < 8; ++e) acc[e] = wave_sum(acc[e]) * s;
        int i0 = 0; float v0 = acc[0];
#pragma unroll
        for (int e = 1; e < 8; ++e) if (acc[e] > v0) { v0 = acc[e]; i0 = e; }
        int i1 = -1; float v1 = -3.0e38f;
#pragma unroll
        for (int e = 0; e < 8; ++e) if (e != i0 && acc[e] > v1) { v1 = acc[e]; i1 = e; }
        const float e1 = expf(v1 - v0), w0 = 1.f / (1.f + e1), w1 = e1 / (1.f + e1);
        if (plane < 8) gates[(size_t)m * 8 + plane] = (plane == i0) ? w0 : ((plane == i1) ? w1 : 0.f);
    }
}

__device__ __forceinline__ void vprep_phase(Frame& F, int layer) {
    const int ptid = otid(), plane = ptid & 63, pwave = __builtin_amdgcn_readfirstlane(ptid >> 6); (void)plane; (void)pwave;
    LAS float* vt = (LAS float*)F.lds;
    LAS float* vd = vt + 32 * 516;
    const bf16* P = (const bf16*)(F.ws + WS_BIG); bf16* VF = (bf16*)(F.ws + WS_VF); bf16* VM = (bf16*)(F.ws + WS_VMIX);
    const float* mu = INP(3) + layer * 1792 + 1024;
    const int tok = ptid >> 4, part = ptid & 15;
    for (int it = F.vcu; it < M / 32; it += F.G) {
        const int m = it * 32 + tok; const int t = m & (T - 1);
        const bf16* cur = P + (size_t)m * PLD + 1024 + part * 32;
        float xm[32];
#pragma unroll
        for (int q = 0; q < 4; ++q) { float c[8], p[8]; unpack8(*(const u32x4*)(cur + q * 8), c);
            if (t > 0) unpack8(*(const u32x4*)(cur - PLD + q * 8), p); else {
#pragma unroll
                for (int e = 0; e < 8; ++e) p[e] = 0.f; }
#pragma unroll
            for (int e = 0; e < 8; ++e) xm[q * 8 + e] = c[e] + (p[e] - c[e]) * mu[part * 32 + q * 8 + e]; }
        if (layer == 0) {
#pragma unroll
            for (int q = 0; q < 4; ++q) { float o[8];
#pragma unroll
                for (int e = 0; e < 8; ++e) o[e] = xm[q * 8 + e];
                *(u32x4*)(VF + (size_t)m * 512 + part * 32 + q * 8) = pack8(o); }
        } else {
            const float* vdn = INP(14); const float* vup = INP(15); const float* v0 = INP(16);
#pragma unroll
            for (int e = 0; e < 32; ++e) vt[tok * 516 + part * 32 + e] = xm[e];
            __syncthreads();
            { float a0 = 0.f, a1 = 0.f; const int j = part * 2;
                for (int c = 0; c < 512; ++c) { const float v = vt[tok * 516 + c]; a0 += v * vdn[c * 32 + j]; a1 += v * vdn[c * 32 + j + 1]; }
                vd[tok * 33 + j] = a0; vd[tok * 33 + j + 1] = a1; }
            __syncthreads();
            float g[32];
#pragma unroll
            for (int e = 0; e < 32; ++e) g[e] = v0[part * 32 + e];
            for (int j = 0; j < 32; ++j) { const float d = vd[tok * 33 + j];
#pragma unroll
                for (int e = 0; e < 32; ++e) g[e] += d * vup[j * 512 + part * 32 + e]; }
#pragma unroll
            for (int q = 0; q < 4; ++q) { float vf[8], o[8]; unpack8(*(const u32x4*)(VF + (size_t)m * 512 + part * 32 + q * 8), vf);
#pragma unroll
                for (int e = 0; e < 8; ++e) { const float v = xm[q * 8 + e]; o[e] = v + (vf[e] - v) * sigm(g[q * 8 + e]); }
                *(u32x4*)(VM + (size_t)m * 512 + part * 32 + q * 8) = pack8(o); }
            __syncthreads();
        }
    }
}

__device__ __forceinline__ float red8(float v) { v += __shfl_xor(v, 1); v += __shfl_xor(v, 2); v += __shfl_xor(v, 4); return v; }
__device__ __forceinline__ float red16(float v) { v = red8(v); v += __shfl_xor(v, 8); return v; }

__device__ __forceinline__ void rwkv_seq(Frame& F, int layer, int bh) {
    const int ptid = otid(), plane = ptid & 63, pwave = __builtin_amdgcn_readfirstlane(ptid >> 6); (void)plane; (void)pwave;
    const int b = bh >> 3, h = bh & 7;
    LAS float* L = (LAS float*)F.lds;
    LAS float *rr = L, *ww = L + 2048, *kf = L + 4096, *vv = L + 6144, *aa = L + 8192, *bb = L + 10240, *gg = L + 12288, *yy = L + 14336, *tw = L + 16384, *xa = L + 18432, *sg = L + 20480, *bon = L + 24576;
    const float* mu = INP(3) + layer * 1792; const float* w_up = INP(4) + layer * 64 * 512; const float* w0 = INP(5) + layer * 512;
    const float* a_up = INP(6) + layer * 64 * 512; const float* a0 = INP(7) + layer * 512; const float* g_up = INP(8) + layer * 128 * 512;
    const float* k_k = INP(9) + layer * 512; const float* k_a = INP(10) + layer * 512; const float* r_k = INP(11) + layer * 512;
    const float* gn_w = INP(12) + layer * 512; const float* gn_b = INP(13) + layer * 512;
    const bf16* P = (const bf16*)(F.ws + WS_BIG); const bf16* vsrc = (const bf16*)(F.ws + (layer == 0 ? WS_VF : WS_VMIX)); bf16* yout = (bf16*)(F.ws + WS_YRW);
    const int tid = ptid, tok = tid >> 4, part = tid & 15, c4 = part * 4, cb = h * 64 + c4;
    const int srow = tid >> 3, sc0 = (tid & 7) * 8;
    float S[8];
#pragma unroll
    for (int j = 0; j < 8; ++j) S[j] = 0.f;
    for (int t0 = 0; t0 < T; t0 += 32) {
        {
            const int t = t0 + tok; const size_t m = (size_t)b * T + t;
            const bf16* cur = P + m * PLD;
#pragma unroll
            for (int q = 0; q < 3; ++q) {
                const int ch = part + 16 * q; int col, kind; LAS float* dst;
                if (ch < 8) { col = h * 64 + ch * 8; dst = rr + tok * 64 + ch * 8; kind = 0; }
                else if (ch < 16) { col = 512 + h * 64 + (ch - 8) * 8; dst = kf + tok * 64 + (ch - 8) * 8; kind = 0; }
                else if (ch < 24) { col = 1536 + (ch - 16) * 8; dst = tw + tok * 64 + (ch - 16) * 8; kind = 1; }
                else if (ch < 32) { col = 1600 + (ch - 24) * 8; dst = xa + tok * 64 + (ch - 24) * 8; kind = 0; }
                else { col = 1664 + (ch - 32) * 8; dst = sg + tok * 128 + (ch - 32) * 8; kind = 2; }
                float c[8], p[8]; unpack8(*(const u32x4*)(cur + col), c);
                if (t > 0) unpack8(*(const u32x4*)(cur - PLD + col), p); else {
#pragma unroll
                    for (int e = 0; e < 8; ++e) p[e] = 0.f; }
#pragma unroll
                for (int e = 0; e < 8; ++e) { float x = c[e] + (p[e] - c[e]) * mu[col + e]; if (kind == 1) x = tanhf(x); else if (kind == 2) x = sigm(x); dst[e] = x; }
            }
            if (part < 8) { float v[8]; unpack8(*(const u32x4*)(vsrc + m * 512 + h * 64 + part * 8), v);
#pragma unroll
                for (int e = 0; e < 8; ++e) vv[tok * 64 + part * 8 + e] = v[e]; }
        }
        __syncthreads();
        {
            f32x4 dw = *(const f32x4*)(w0 + cb), da = *(const f32x4*)(a0 + cb), dg = (f32x4){0.f, 0.f, 0.f, 0.f};
            for (int j = 0; j < 64; ++j) { const float tj = tw[tok * 64 + j], xj = xa[tok * 64 + j];
                dw += *(const f32x4*)(w_up + j * 512 + cb) * tj; da += *(const f32x4*)(a_up + j * 512 + cb) * xj; }
            for (int j = 0; j < 128; ++j) dg += *(const f32x4*)(g_up + j * 512 + cb) * sg[tok * 128 + j];
            float kr[4], kk[4], av[4], ss = 0.f;
#pragma unroll
            for (int e = 0; e < 4; ++e) { kr[e] = kf[tok * 64 + c4 + e]; kk[e] = kr[e] * k_k[cb + e]; ss += kk[e] * kk[e]; av[e] = sigm(da[e]); }
            ss = red16(ss);
            const float inv = 1.f / sqrtf(fmaxf(ss, 1e-24f));
            float bs = 0.f;
#pragma unroll
            for (int e = 0; e < 4; ++e) { const float kn = kk[e] * inv; const int o = tok * 64 + c4 + e;
                const float ld = -expf(-softplus_acc(-dw[e]) - 0.5f);
                ww[o] = expf(ld); aa[o] = -kn; bb[o] = kn * av[e];
                const float knew = kr[e] * (1.f + (av[e] - 1.f) * k_a[cb + e]); kf[o] = knew; gg[o] = dg[e];
                bs += rr[o] * knew * r_k[cb + e]; }
            bs = red16(bs);
            if (part == 0) bon[tok] = bs;
        }
        __syncthreads();
        for (int s = 0; s < 32; ++s) {
            const f32x4 a0v = *(const LAS f32x4*)(aa + s * 64 + sc0), a1v = *(const LAS f32x4*)(aa + s * 64 + sc0 + 4);
            const f32x4 w0v = *(const LAS f32x4*)(ww + s * 64 + sc0), w1v = *(const LAS f32x4*)(ww + s * 64 + sc0 + 4);
            const f32x4 b0v = *(const LAS f32x4*)(bb + s * 64 + sc0), b1v = *(const LAS f32x4*)(bb + s * 64 + sc0 + 4);
            const f32x4 k0v = *(const LAS f32x4*)(kf + s * 64 + sc0), k1v = *(const LAS f32x4*)(kf + s * 64 + sc0 + 4);
            const f32x4 r0v = *(const LAS f32x4*)(rr + s * 64 + sc0), r1v = *(const LAS f32x4*)(rr + s * 64 + sc0 + 4);
            const float vi = vv[s * 64 + srow];
            float sa = 0.f;
#pragma unroll
            for (int j = 0; j < 4; ++j) sa += S[j] * a0v[j] + S[4 + j] * a1v[j];
            sa = red8(sa);
            float y = 0.f;
#pragma unroll
            for (int j = 0; j < 4; ++j) { S[j] = S[j] * w0v[j] + sa * b0v[j] + vi * k0v[j]; S[4 + j] = S[4 + j] * w1v[j] + sa * b1v[j] + vi * k1v[j]; y += S[j] * r0v[j] + S[4 + j] * r1v[j]; }
            y = red8(y);
            if ((tid & 7) == 0) yy[s * 64 + srow] = y;
        }
        __syncthreads();
        {
            const size_t m = (size_t)b * T + t0 + tok;
            float y[4], sm = 0.f;
#pragma unroll
            for (int e = 0; e < 4; ++e) { y[e] = yy[tok * 64 + c4 + e]; sm += y[e]; }
            const float mean = red16(sm) * (1.f / 64.f);
            float vs = 0.f;
#pragma unroll
            for (int e = 0; e < 4; ++e) { y[e] -= mean; vs += y[e] * y[e]; }
            const float rs = 1.f / sqrtf(red16(vs) * (1.f / 64.f) + 64e-5f);
            const float bo = bon[tok];
            float o[4];
#pragma unroll
            for (int e = 0; e < 4; ++e) { const int idx = tok * 64 + c4 + e; o[e] = (y[e] * rs * gn_w[cb + e] + gn_b[cb + e] + bo * vv[idx]) * gg[idx]; }
            u32x2 w; w.x = pk2(o[0], o[1]); w.y = pk2(o[2], o[3]);
            *(u32x2*)(yout + m * 512 + cb) = w;
        }
        __syncthreads();
    }
}

__device__ __forceinline__ void ret_seq(Frame& F, int bh) {
    const int ptid = otid(), plane = ptid & 63, pwave = __builtin_amdgcn_readfirstlane(ptid >> 6); (void)plane; (void)pwave;
    const int b = bh >> 3, h = bh & 7;
    LAS float* L = (LAS float*)F.lds;
    LAS float *qq = L, *kk = L + 2048, *vv = L + 4096, *gg = L + 6144, *yy = L + 8192;
    bf16* P = (bf16*)(F.ws + WS_BIG);
    const int tid = ptid, tok = tid >> 4, part = tid & 15, c4 = part * 4;
    const int se = tid >> 3, sd0 = (tid & 7) * 8;
    const float gamma = 1.f - exp2f(-5.f - (float)h);
    float S[8];
#pragma unroll
    for (int j = 0; j < 8; ++j) S[j] = 0.f;
    for (int t0 = 0; t0 < T; t0 += 32) {
        {
            const int t = t0 + tok; const size_t m = (size_t)b * T + t;
#pragma unroll
            for (int q = 0; q < 2; ++q) {
                const int ch = part + 16 * q, kind = ch >> 3, cc = ch & 7;
                float x[8]; unpack8(*(const u32x4*)(P + m * PLD + C_RET + kind * 512 + h * 64 + cc * 8), x);
                LAS float* dst = (kind == 0 ? qq : kind == 1 ? kk : kind == 2 ? vv : gg) + tok * 64 + cc * 8;
                if (kind < 2) {
#pragma unroll
                    for (int p = 0; p < 4; ++p) { const int i = cc * 4 + p;
                        const double invf = exp(-(double)i * (9.210340371976184 / 32.0));
                        double sn, cs; sincos((double)t * invf, &sn, &cs);
                        const float x0 = x[2 * p], x1 = x[2 * p + 1], c = (float)cs, s = (float)sn;
                        float o0 = x0 * c - x1 * s, o1 = x0 * s + x1 * c;
                        if (kind == 1) { o0 *= 0.125f; o1 *= 0.125f; }
                        dst[2 * p] = o0; dst[2 * p + 1] = o1; }
                } else {
#pragma unroll
                    for (int e = 0; e < 8; ++e) dst[e] = x[e];
                }
            }
        }
        __syncthreads();
        for (int s = 0; s < 32; ++s) {
            const f32x4 k0v = *(const LAS f32x4*)(kk + s * 64 + sd0), k1v = *(const LAS f32x4*)(kk + s * 64 + sd0 + 4);
            const f32x4 q0v = *(const LAS f32x4*)(qq + s * 64 + sd0), q1v = *(const LAS f32x4*)(qq + s * 64 + sd0 + 4);
            const float ve = vv[s * 64 + se];
            float y = 0.f;
#pragma unroll
            for (int j = 0; j < 4; ++j) { S[j] = gamma * S[j] + k0v[j] * ve; S[4 + j] = gamma * S[4 + j] + k1v[j] * ve; y += q0v[j] * S[j] + q1v[j] * S[4 + j]; }
            y = red8(y);
            if ((tid & 7) == 0) yy[s * 64 + se] = y;
        }
        __syncthreads();
        {
            const size_t m = (size_t)b * T + t0 + tok;
            float y[4], ss = 0.f;
#pragma unroll
            for (int e = 0; e < 4; ++e) { y[e] = yy[tok * 64 + c4 + e]; ss += y[e] * y[e]; }
            const float rs = 1.f / sqrtf(red16(ss) * (1.f / 64.f) + 1e-6f);
            float o[4];
#pragma unroll
            for (int e = 0; e < 4; ++e) o[e] = y[e] * rs * silu(gg[tok * 64 + c4 + e]);
            u32x2 w; w.x = pk2(o[0], o[1]); w.y = pk2(o[2], o[3]);
            *(u32x2*)(P + m * PLD + C_RETG + h * 64 + c4) = w;
        }
        __syncthreads();
    }
}

__device__ __forceinline__ void ssd_seq(Frame& F, int layer, int bh) {
    const int ptid = otid(), plane = ptid & 63, pwave = __builtin_amdgcn_readfirstlane(ptid >> 6); (void)plane; (void)pwave;
    const int b = bh >> 3, h = bh & 7, g = h >> 2;
    LAS float* L = (LAS float*)F.lds;
    LAS float *raw = L  , *xs = L + 11200, *Bc = L + 13248, *Cc = L + 17344, *yy = L + 21440, *dts = L + 23488, *das = L + 23520;
    bf16* P = (bf16*)(F.ws + WS_BIG); const float* dtb = (const float*)(F.ws + WS_DT);
    const float* cw = INP(17) + layer * 1024 * 4; const float* cbias = INP(18) + layer * 1024;
    const float dt_bias = INP(19)[layer * 8 + h], A = -expf(INP(20)[layer * 8 + h]), Dh = INP(21)[layer * 8 + h];
    const int tid = ptid;
    const int sp = tid >> 3, sn0 = (tid & 7) * 16;
    float S[16];
#pragma unroll
    for (int j = 0; j < 16; ++j) S[j] = 0.f;
    for (int i = tid; i < 3 * 320; i += 512) raw[i] = 0.f;
    __syncthreads();
    for (int t0 = 0; t0 < T; t0 += 32) {
        for (int idx = tid; idx < 32 * 40; idx += 512) {
            const int row = idx / 40, ch = idx % 40; const size_t m = (size_t)b * T + t0 + row;
            const int col = ch < 8 ? (C_XBC + h * 64 + ch * 8) : (ch < 24 ? (C_XBC + 512 + g * 128 + (ch - 8) * 8) : (C_XBC + 768 + g * 128 + (ch - 24) * 8));
            float x[8]; unpack8(*(const u32x4*)(P + m * PLD + col), x);
#pragma unroll
            for (int e = 0; e < 8; ++e) raw[(3 + row) * 320 + ch * 8 + e] = x[e];
        }
        if (tid < 32) { const size_t m = (size_t)b * T + t0 + tid; const float dt = softplus_acc(dtb[m * 8 + h] + dt_bias); dts[tid] = dt; das[tid] = expf(A * dt); }
        __syncthreads();
        for (int idx = tid; idx < 32 * 320; idx += 512) {
            const int row = idx / 320, c = idx % 320;
            const int chn = c < 64 ? (h * 64 + c) : (c < 192 ? (512 + g * 128 + (c - 64)) : (768 + g * 128 + (c - 192)));
            float a = cbias[chn];
#pragma unroll
            for (int k = 0; k < 4; ++k) a += cw[chn * 4 + k] * raw[(row + k) * 320 + c];
            a = silu(a);
            if (c < 64) xs[row * 64 + c] = a; else if (c < 192) Bc[row * 128 + (c - 64)] = a; else Cc[row * 128 + (c - 192)] = a;
        }
        __syncthreads();
        for (int s = 0; s < 32; ++s) {
            const float da = das[s], xv = xs[s * 64 + sp], dtx = dts[s] * xv;
            float y = 0.f;
#pragma unroll
            for (int q = 0; q < 4; ++q) { const f32x4 bv = *(const LAS f32x4*)(Bc + s * 128 + sn0 + q * 4), cv = *(const LAS f32x4*)(Cc + s * 128 + sn0 + q * 4);
#pragma unroll
                for (int j = 0; j < 4; ++j) { S[q * 4 + j] = da * S[q * 4 + j] + dtx * bv[j]; y += S[q * 4 + j] * cv[j]; } }
            y = red8(y);
            if ((tid & 7) == 0) yy[s * 64 + sp] = y + Dh * xv;
        }
        __syncthreads();
        {
            const int tok = tid >> 4, c4 = (tid & 15) * 4; const size_t m = (size_t)b * T + t0 + tok;
            u32x2 w; w.x = pk2(yy[tok * 64 + c4], yy[tok * 64 + c4 + 1]); w.y = pk2(yy[tok * 64 + c4 + 2], yy[tok * 64 + c4 + 3]);
            *(u32x2*)(P + m * PLD + C_XBC + h * 64 + c4) = w;
            for (int i = tid; i < 3 * 320; i += 512) raw[i] = raw[32 * 320 + i];
        }
        __syncthreads();
    }
}
__device__ __forceinline__ void ssm_norm_phase(Frame& F, int layer) {
    const int ptid = otid(), plane = ptid & 63, pwave = __builtin_amdgcn_readfirstlane(ptid >> 6); (void)plane; (void)pwave;
    const int gw = F.vcu * 8 + pwave, NGW = F.G * 8;
    bf16* P = (bf16*)(F.ws + WS_BIG); const float* nw = INP(22) + layer * 512;
    for (int m = gw; m < M; m += NGW) {
        float y[8], z[8]; unpack8(*(const u32x4*)(P + (size_t)m * PLD + C_XBC + plane * 8), y); unpack8(*(const u32x4*)(P + (size_t)m * PLD + C_Z + plane * 8), z);
        float ss = 0.f;
#pragma unroll
        for (int e = 0; e < 8; ++e) { y[e] *= silu(z[e]); ss += y[e] * y[e]; }
        ss += __shfl_xor(ss, 1); ss += __shfl_xor(ss, 2); ss += __shfl_xor(ss, 4); ss += __shfl_xor(ss, 8); ss += __shfl_xor(ss, 16);
        const float rs = 1.f / sqrtf(ss * (1.f / 256.f) + 1e-6f);
#pragma unroll
        for (int e = 0; e < 8; ++e) y[e] *= rs * nw[plane * 8 + e];
        *(u32x4*)(P + (size_t)m * PLD + C_Z + plane * 8) = pack8(y);
    }
}

constexpr int PT = 72, PT2 = 136, PF = 68;
__device__ __forceinline__ f32x4 mfma16(bf16x8 a, bf16x8 b, f32x4 c) { return __builtin_amdgcn_mfma_f32_16x16x32_bf16(a, b, c, 0, 0, 0); }
template <int K> __device__ __forceinline__ f32x4 mm_ll(const LAS bf16* A, int pa, int m0, const LAS bf16* B, int pb, int n0, f32x4 acc, int lane) {
    const int r = lane & 15, q = lane >> 4;
    const LAS bf16* ap = A + (m0 + r) * pa + 8 * q; const LAS bf16* bp = B + (n0 + r) * pb + 8 * q;
#pragma unroll
    for (int k0 = 0; k0 < K; k0 += 32) acc = mfma16(*(const LAS bf16x8*)(ap + k0), *(const LAS bf16x8*)(bp + k0), acc);
    return acc;
}
template <int K> __device__ __forceinline__ f32x4 mm_lg(const LAS bf16* A, int pa, int m0, const bf16* B, int pb, int n0, f32x4 acc, int lane) {
    const int r = lane & 15, q = lane >> 4;
    const LAS bf16* ap = A + (m0 + r) * pa + 8 * q; const bf16* bp = B + (size_t)(n0 + r) * pb + 8 * q;
#pragma unroll
    for (int k0 = 0; k0 < K; k0 += 32) acc = mfma16(*(const LAS bf16x8*)(ap + k0), *(const bf16x8*)(bp + k0), acc);
    return acc;
}
__device__ __forceinline__ float redl16(float v) { v += __shfl_xor(v, 1); v += __shfl_xor(v, 2); v += __shfl_xor(v, 4); v += __shfl_xor(v, 8); return v; }
__device__ __forceinline__ void st4bf(LAS bf16* p, f32x4 v) { u32x2 w; w.x = pk2(v[0], v[1]); w.y = pk2(v[2], v[3]); *(LAS u32x2*)p = w; }
__device__ __forceinline__ float ldbf(const LAS bf16* p) { return __builtin_bit_cast(float, (unsigned)(*p) << 16); }
constexpr f32x4 FZ4 = {0.f, 0.f, 0.f, 0.f};

template <bool FINAL>
__device__ __forceinline__ void rwkv_chunk_unit(Frame& F, int layer, int u) {
    const int tid = otid(), w = __builtin_amdgcn_readfirstlane(tid >> 6);
#define IDS() const int ft = fresh_tid(tid); const int lane = ft & 63, r16 = lane & 15, q4 = lane >> 4, tok = ft >> 3, part = ft & 7; (void)lane; (void)r16; (void)q4; (void)tok; (void)part
    const int b = u >> 9, sc = (u >> 3) & 63, h = u & 7;
    constexpr int NV = FINAL ? 64 : 128, NVT = NV / 16, NZ = NVT / 2;
    constexpr int X_TW = 0, X_XA = 9216, X_SG = 18432, X_KF = 35840, X_RF = 52224;
    constexpr int O_AT = 0, O_RT = 9216, O_BT = 18432, O_KT = 27648, O_BH = 36864, O_KH = 46080, O_VT = 55296, O_TF = O_BT;
    constexpr int Y0 = 68608;
    constexpr int Y_A = Y0, Y_B = Y0 + 8192, Y_K = Y0 + 16384, Y_R = Y0 + 24576, Y_L = Y0 + 32768, Y_VF = Y0 + 49152;
    constexpr int Y_AAB = Y0, Y_AAK = Y0 + 17408, Y_ARB = Y_AAK + 9216, Y_ARK = Y_ARB + 9216, Y_TB = FINAL ? Y_ARK + 9216 : Y_AAK + 9216, Y_ZU = Y_TB + 9216, Y_YF = Y_AAB;
    static_assert(Y_ZU + NV * PT * 2 <= Y0 + 65536, "region Y");
    constexpr int Z0 = Y0 + 65536, Z_G = Z0, Z_S = FINAL ? Z0 + 8192 : Z0, Z_MISC = 152576, Z_BON = Z_MISC, Z_PC = Z_MISC + 256, Z_PAR = Z_MISC + 512, Z_XS = Y_ZU;
    static_assert(Z_S + NV * PT * 2 <= Z_MISC && Z_PAR + 832 * 4 <= LDSCTL_OFF, "region Z");
    LAS unsigned char* L = F.lds;
#define LB(off) ((LAS bf16*)(L + (off)))
#define LF(off) ((LAS float*)(L + (off)))
    {
        const int pidx = (w == 0) ? 5 : (w == 1) ? 7 : (w == 2) ? 9 : (w == 3) ? 10 : (w == 4) ? 11 : (w == 5) ? 12 : 13;
        if (w < 7) LF(Z_PAR)[w * 64 + (tid & 63)] = (INP(pidx) + layer * 512 + h * 64)[tid & 63];
        const float* mu = INP(3) + layer * 1792;
        for (int i = tid; i < 384; i += 512) LF(Z_PAR)[448 + i] = mu[(i < 64) ? (h * 64 + i) : (i < 128) ? (512 + h * 64 + (i - 64)) : (1536 + (i - 128))];
    }
    const bf16* WupT = (const bf16*)(F.ws + WS_LORA + (size_t)layer * LORA_STRIDE) + h * 64 * 64;
    const bf16* AupT = (const bf16*)(F.ws + WS_LORA + (size_t)layer * LORA_STRIDE + 65536) + h * 64 * 64;
    const bf16* GupT = (const bf16*)(F.ws + WS_LORA + (size_t)layer * LORA_STRIDE + 131072) + h * 64 * 128;
    const bf16* P = (const bf16*)(F.ws + WS_BIG); const bf16* vsrc = (const bf16*)(F.ws + (layer == 0 ? WS_VF : WS_VMIX));
    float* Nbuf = (float*)(F.ws + WS_ST_RW) + (size_t)u * 4096; bf16* MT = (bf16*)(F.ws + WS_MT) + (size_t)u * 4096;
    constexpr int NST = FINAL ? 2 : 4;
    f32x4 Sacc[NST];
    const int s_vb = FINAL ? (w & 3) : w;
#define S_CT(ti) (FINAL ? (2 * (w >> 2) + (ti)) : (ti))
    { IDS();
#pragma unroll
    for (int ti = 0; ti < NST; ++ti) {
        const int ct = S_CT(ti);
#pragma unroll
        for (int jj = 0; jj < 4; ++jj) { const int v = 16 * s_vb + 4 * q4 + jj, c = 16 * ct + r16;
            float x; if (FINAL) x = Nbuf[v * 64 + c]; else x = (v >= 64 && v - 64 == c) ? 1.f : 0.f;
            Sacc[ti][jj] = x; LB(Z_S)[v * PT + c] = (bf16)f2bf(x); }
    } }
    for (int j = 0; j < 4; ++j) {
        const int tl0 = sc * 256 + j * 64;
        {
            IDS();
            const int t = tl0 + tok; const size_t m = (size_t)b * T + t; const bf16* cur = P + m * PLD;
#pragma unroll
            for (int i = 0; i < 6; ++i) {
                const int col = (i == 0) ? (h * 64 + 8 * part) : (i == 1) ? (512 + h * 64 + 8 * part) : (i == 2) ? (1536 + 8 * part) : (i == 3) ? (1600 + 8 * part) : (1664 + 8 * part + (i - 4) * 64);
                float c[8], p[8]; unpack8(*(const u32x4*)(cur + col), c);
                if (t > 0) unpack8(*(const u32x4*)(cur - PLD + col), p); else {
#pragma unroll
                    for (int e = 0; e < 8; ++e) p[e] = 0.f; }
#pragma unroll
                for (int e = 0; e < 8; ++e) c[e] = c[e] + (p[e] - c[e]) * LF(Z_PAR)[448 + ((i < 4) ? 64 * i : 256 + 64 * (i - 4)) + 8 * part + e];
                if (i == 0) {
#pragma unroll
                    for (int e = 0; e < 8; ++e) LF(X_RF)[tok * 64 + 8 * part + e] = c[e];
                } else if (i == 1) {
#pragma unroll
                    for (int e = 0; e < 8; ++e) LF(X_KF)[tok * 64 + 8 * part + e] = c[e];
                } else if (i == 2) {
#pragma unroll
                    for (int e = 0; e < 8; ++e) c[e] = tanhf(c[e]);
                    *(LAS u32x4*)(LB(X_TW) + tok * PT + 8 * part) = pack8(c);
                } else if (i == 3) {
                    *(LAS u32x4*)(LB(X_XA) + tok * PT + 8 * part) = pack8(c);
                } else if (FINAL) {
#pragma unroll
                    for (int e = 0; e < 8; ++e) c[e] = sigm(c[e]);
                    *(LAS u32x4*)(LB(X_SG) + tok * PT2 + 8 * part + (i - 4) * 64) = pack8(c);
                }
            }
            float v[8]; unpack8(*(const u32x4*)(vsrc + m * 512 + h * 64 + 8 * part), v);
#pragma unroll
            for (int e = 0; e < 8; ++e) LF(Y_VF)[tok * 64 + 8 * part + e] = v[e];
        }
        __syncthreads();
        { IDS();
        if (w < 4) {
            const int rb = w;
            float inv[4], bs[4] = {0.f, 0.f, 0.f, 0.f};
            { float ss[4] = {0.f, 0.f, 0.f, 0.f};
#pragma unroll
                for (int nt = 0; nt < 4; ++nt) { const int c = 16 * nt + r16; const float kkc = LF(Z_PAR)[128 + c];
#pragma unroll
                    for (int jj = 0; jj < 4; ++jj) { const float kk = LF(X_KF)[(16 * rb + 4 * q4 + jj) * 64 + c] * kkc; ss[jj] += kk * kk; } }
#pragma unroll
                for (int jj = 0; jj < 4; ++jj) inv[jj] = 1.f / sqrtf(fmaxf(redl16(ss[jj]), 1e-24f)); }
#pragma unroll 1
            for (int nt = 0; nt < 4; ++nt) {
                const f32x4 aw = mm_lg<64>(LB(X_TW), PT, 16 * rb, WupT, 64, 16 * nt, FZ4, lane), aa = mm_lg<64>(LB(X_XA), PT, 16 * rb, AupT, 64, 16 * nt, FZ4, lane);
                const int c = 16 * nt + r16; const float w0c = LF(Z_PAR)[c], a0c = LF(Z_PAR)[64 + c], kkc = LF(Z_PAR)[128 + c], kac = LF(Z_PAR)[192 + c], rkc = LF(Z_PAR)[256 + c];
#pragma unroll
                for (int jj = 0; jj < 4; ++jj) { const int t = 16 * rb + 4 * q4 + jj, o = t * 64 + c;
                    LF(Y_L)[o] = -expf(-softplus_acc(-(w0c + aw[jj])) - 0.5f);
                    const float al = sigm(a0c + aa[jj]), kraw = LF(X_KF)[o], rr = LF(X_RF)[o], kn = kraw * kkc * inv[jj];
                    const float knew = kraw * (1.f + (al - 1.f) * kac);
                    LB(Y_A)[o] = (bf16)f2bf(-kn); LB(Y_B)[o] = (bf16)f2bf(kn * al); LB(Y_K)[o] = (bf16)f2bf(knew); LB(Y_R)[o] = (bf16)f2bf(rr);
                    bs[jj] += rr * knew * rkc; } }
#pragma unroll
            for (int jj = 0; jj < 4; ++jj) { const float sm = redl16(bs[jj]); if (r16 == 0) LF(Z_BON)[16 * rb + 4 * q4 + jj] = sm; }
        } else if (FINAL) {
            const int rb = w - 4;
#pragma unroll 1
            for (int nt = 0; nt < 4; ++nt) { const f32x4 ag = mm_lg<128>(LB(X_SG), PT2, 16 * rb, GupT, 128, 16 * nt, FZ4, lane);
#pragma unroll
                for (int jj = 0; jj < 4; ++jj) LB(Z_G)[(16 * rb + 4 * q4 + jj) * 64 + 16 * nt + r16] = (bf16)f2bf(ag[jj]); }
        } }
        __syncthreads();
        if (w == 0) { IDS(); float run = 0.f;
#pragma unroll 8
            for (int t = 0; t < 64; ++t) { run += LF(Y_L)[t * 64 + lane]; LF(Y_L)[t * 64 + lane] = run; }
            LF(Z_PC)[lane] = expf(run); }
        __syncthreads();
        {
            IDS(); const int t = tok, c0 = 8 * part;
            float at[8], rt[8], bt[8], kt[8];
#pragma unroll
            for (int e = 0; e < 8; ++e) { const int c = c0 + e, o = t * 64 + c;
                const float Lt = LF(Y_L)[o], Lp = (t > 0) ? LF(Y_L)[o - 64] : 0.f, Le = LF(Y_L)[63 * 64 + c];
                const float eL = expf(Lt), eLm = expf(Lp), eN = expf(-Lt), eE = expf(Le - Lt);
                const float a = ldbf(LB(Y_A) + o), bb = ldbf(LB(Y_B) + o), kk = ldbf(LB(Y_K) + o), rr = ldbf(LB(Y_R) + o);
                at[e] = a * eLm; rt[e] = rr * eL; bt[e] = bb * eN; kt[e] = kk * eN;
                LB(O_BH)[c * PT + t] = (bf16)f2bf(bb * eE); LB(O_KH)[c * PT + t] = (bf16)f2bf(kk * eE); LB(O_VT)[c * PT + t] = (bf16)f2bf(LF(Y_VF)[o]); }
            *(LAS u32x4*)(LB(O_AT) + t * PT + c0) = pack8(at); *(LAS u32x4*)(LB(O_RT) + t * PT + c0) = pack8(rt);
            *(LAS u32x4*)(LB(O_BT) + t * PT + c0) = pack8(bt); *(LAS u32x4*)(LB(O_KT) + t * PT + c0) = pack8(kt);
        }
        __syncthreads();
        {
            IDS(); const int rb = w & 3;
#pragma unroll
            for (int ci = 0; ci < 2; ++ci) { const int ct = 2 * (w >> 2) + ci;
                f32x4 ab = FZ4, ak = FZ4, arb = FZ4, ark = FZ4;
                if (ct <= rb) { ab = mm_ll<64>(LB(O_AT), PT, 16 * rb, LB(O_BT), PT, 16 * ct, FZ4, lane); ak = mm_ll<64>(LB(O_AT), PT, 16 * rb, LB(O_KT), PT, 16 * ct, FZ4, lane);
                    if (FINAL) { arb = mm_ll<64>(LB(O_RT), PT, 16 * rb, LB(O_BT), PT, 16 * ct, FZ4, lane); ark = mm_ll<64>(LB(O_RT), PT, 16 * rb, LB(O_KT), PT, 16 * ct, FZ4, lane); } }
#pragma unroll
                for (int jj = 0; jj < 4; ++jj) { const int t = 16 * rb + 4 * q4 + jj, i = 16 * ct + r16;
                    LF(Y_AAB)[t * PF + i] = (i < t) ? ab[jj] : 0.f; LB(Y_AAK)[t * PT + i] = (bf16)f2bf((i < t) ? ak[jj] : 0.f);
                    if (FINAL) { LB(Y_ARB)[t * PT + i] = (bf16)f2bf((i <= t) ? arb[jj] : 0.f); LB(Y_ARK)[t * PT + i] = (bf16)f2bf((i <= t) ? ark[jj] : 0.f); } } }
        }
        __syncthreads();
        { IDS(); for (int i = ft; i < 64 * PF; i += 512) LF(O_TF)[i] = 0.f; }
        __syncthreads();
        if (w == 0) { IDS(); const int blk = lane >> 4, col = lane & 15; float x[16];
#pragma unroll
            for (int i = 0; i < 16; ++i) x[i] = (i == col) ? 1.f : 0.f;
#pragma unroll
            for (int i = 1; i < 16; ++i) { float s = 0.f; asm volatile("" ::: "memory");
#pragma unroll
                for (int m2 = 0; m2 < i; ++m2) s += LF(Y_AAB)[(16 * blk + i) * PF + 16 * blk + m2] * x[m2];
                x[i] += s; }
#pragma unroll
            for (int i = 0; i < 16; ++i) LF(O_TF)[(16 * blk + i) * PF + 16 * blk + col] = x[i]; }
        __syncthreads();
        { IDS(); const int p = ft >> 8, i = (ft >> 4) & 15, jx = ft & 15; float s = 0.f;
#pragma unroll
            for (int m2 = 0; m2 < 16; ++m2) s += LF(Y_AAB)[(32 * p + 16 + i) * PF + 32 * p + m2] * LF(O_TF)[(32 * p + m2) * PF + 32 * p + jx];
            LF(Z_XS)[p * 256 + i * 16 + jx] = s; }
        __syncthreads();
        { IDS(); const int p = ft >> 8, i = (ft >> 4) & 15, jx = ft & 15; float s = 0.f;
#pragma unroll
            for (int m2 = 0; m2 < 16; ++m2) s += LF(O_TF)[(32 * p + 16 + i) * PF + 32 * p + 16 + m2] * LF(Z_XS)[p * 256 + m2 * 16 + jx];
            LF(O_TF)[(32 * p + 16 + i) * PF + 32 * p + jx] = s; }
        __syncthreads();
        { IDS(); const int i = ft >> 4, j0 = (ft & 15) * 2; float s0 = 0.f, s1 = 0.f;
#pragma unroll 8
            for (int m2 = 0; m2 < 32; ++m2) { const float a = LF(Y_AAB)[(32 + i) * PF + m2]; s0 += a * LF(O_TF)[m2 * PF + j0]; s1 += a * LF(O_TF)[m2 * PF + j0 + 1]; }
            LF(Z_XS)[i * 33 + j0] = s0; LF(Z_XS)[i * 33 + j0 + 1] = s1; }
        __syncthreads();
        { IDS(); const int i = ft >> 4, j0 = (ft & 15) * 2; float s0 = 0.f, s1 = 0.f;
#pragma unroll 8
            for (int m2 = 0; m2 < 32; ++m2) { const float a = LF(O_TF)[(32 + i) * PF + 32 + m2]; s0 += a * LF(Z_XS)[m2 * 33 + j0]; s1 += a * LF(Z_XS)[m2 * 33 + j0 + 1]; }
            LF(O_TF)[(32 + i) * PF + j0] = s0; LF(O_TF)[(32 + i) * PF + j0 + 1] = s1; }
        __syncthreads();
        { IDS(); const int t = tok, i0 = 8 * part; float o[8];
#pragma unroll
            for (int e = 0; e < 8; ++e) o[e] = LF(O_TF)[t * PF + i0 + e];
            *(LAS u32x4*)(LB(Y_TB) + t * PT + i0) = pack8(o); }
        __syncthreads();
        {
            IDS(); const int rb = w & 3;
            f32x4 uu[NZ];
#pragma unroll
            for (int ci = 0; ci < NZ; ++ci) { const int vt = (w >> 2) * NZ + ci;
                f32x4 z = mm_ll<64>(LB(O_AT), PT, 16 * rb, LB(Z_S), PT, 16 * vt, FZ4, lane);
                if (vt < 4) z = mm_ll<64>(LB(Y_AAK), PT, 16 * rb, LB(O_VT), PT, 16 * vt, z, lane);
                st4bf(LB(Y_ZU) + (16 * vt + r16) * PT + 16 * rb + 4 * q4, z); }
            __syncthreads();
#pragma unroll
            for (int ci = 0; ci < NZ; ++ci) { const int vt = (w >> 2) * NZ + ci; uu[ci] = mm_ll<64>(LB(Y_TB), PT, 16 * rb, LB(Y_ZU), PT, 16 * vt, FZ4, lane); }
            __syncthreads();
#pragma unroll
            for (int ci = 0; ci < NZ; ++ci) { const int vt = (w >> 2) * NZ + ci; st4bf(LB(Y_ZU) + (16 * vt + r16) * PT + 16 * rb + 4 * q4, uu[ci]); }
        }
        __syncthreads();
        {
            IDS(); f32x4 yy[2];
            if (FINAL) { const int rb = w & 3;
#pragma unroll
                for (int ci = 0; ci < 2; ++ci) { const int ct = 2 * (w >> 2) + ci;
                    f32x4 y = mm_ll<64>(LB(O_RT), PT, 16 * rb, LB(Z_S), PT, 16 * ct, FZ4, lane);
                    y = mm_ll<64>(LB(Y_ARB), PT, 16 * rb, LB(Y_ZU), PT, 16 * ct, y, lane);
                    yy[ci] = mm_ll<64>(LB(Y_ARK), PT, 16 * rb, LB(O_VT), PT, 16 * ct, y, lane); } }
#pragma unroll
            for (int ti = 0; ti < NST; ++ti) { const int ct = S_CT(ti); const float pc = LF(Z_PC)[16 * ct + r16];
                f32x4 s = Sacc[ti] * pc;
                s = mm_ll<64>(LB(Y_ZU), PT, 16 * s_vb, LB(O_BH), PT, 16 * ct, s, lane);
                if (s_vb < 4) s = mm_ll<64>(LB(O_VT), PT, 16 * s_vb, LB(O_KH), PT, 16 * ct, s, lane);
                Sacc[ti] = s; }
            __syncthreads();
#pragma unroll
            for (int ti = 0; ti < NST; ++ti) { const int ct = S_CT(ti);
#pragma unroll
                for (int jj = 0; jj < 4; ++jj) LB(Z_S)[(16 * s_vb + 4 * q4 + jj) * PT + 16 * ct + r16] = (bf16)f2bf(Sacc[ti][jj]); }
            if (FINAL) { const int rb = w & 3;
#pragma unroll
                for (int ci = 0; ci < 2; ++ci) { const int ct = 2 * (w >> 2) + ci;
#pragma unroll
                    for (int jj = 0; jj < 4; ++jj) LF(Y_YF)[(16 * rb + 4 * q4 + jj) * PF + 16 * ct + r16] = yy[ci][jj]; } }
        }
        __syncthreads();
        if (FINAL) {
            IDS();
            const int t = tok, c0 = 8 * part; const size_t m = (size_t)b * T + tl0 + t;
            float y[8], sm = 0.f;
#pragma unroll
            for (int e = 0; e < 8; ++e) { y[e] = LF(Y_YF)[t * PF + c0 + e]; sm += y[e]; }
            const float mean = red8(sm) * (1.f / 64.f); float vs = 0.f;
#pragma unroll
            for (int e = 0; e < 8; ++e) { y[e] -= mean; vs += y[e] * y[e]; }
            const float rs = 1.f / sqrtf(red8(vs) * (1.f / 64.f) + 64e-5f), bo = LF(Z_BON)[t];
#pragma unroll
            for (int e = 0; e < 8; ++e) { const int c = c0 + e; y[e] = (y[e] * rs * LF(Z_PAR)[320 + c] + LF(Z_PAR)[384 + c] + bo * ldbf(LB(O_VT) + c * PT + t)) * ldbf(LB(Z_G) + t * 64 + c); }
            *(u32x4*)((bf16*)(F.ws + WS_YRW) + m * 512 + h * 64 + c0) = pack8(y);
        }
        __syncthreads();
    }
    if (!FINAL) { IDS();
#pragma unroll
        for (int ti = 0; ti < NST; ++ti) { const int ct = S_CT(ti);
            if (s_vb < 4) {
#pragma unroll
                for (int jj = 0; jj < 4; ++jj) Nbuf[(16 * s_vb + 4 * q4 + jj) * 64 + 16 * ct + r16] = Sacc[ti][jj];
            } else { u32x2 wv; wv.x = pk2(Sacc[ti][0], Sacc[ti][1]); wv.y = pk2(Sacc[ti][2], Sacc[ti][3]);
                *(u32x2*)(MT + (16 * ct + r16) * 64 + 16 * (s_vb - 4) + 4 * q4) = wv; }
        }
    }
#undef IDS
#undef S_CT
#undef LB
#undef LF
}

template <bool FINAL>
__device__ __forceinline__ void ret_chunk_unit(Frame& F, int u) {
    const int tid = otid(), lane = tid & 63, w = __builtin_amdgcn_readfirstlane(tid >> 6), r16 = lane & 15, q4 = lane >> 4;
    const int b = u >> 9, sc = (u >> 3) & 63, h = u & 7;
    constexpr int R_QB = 0, R_KB = 9216, R_KHT = 18432, R_VT = 27648, R_GB = 36864, R_AB = 45056, R_SB = 54272, R_YF = 63488;
    LAS unsigned char* L = F.lds;
#define LB(off) ((LAS bf16*)(L + (off)))
#define LF(off) ((LAS float*)(L + (off)))
    bf16* P = (bf16*)(F.ws + WS_BIG);
    float* Sbuf = (float*)(F.ws + WS_ST_RET) + (size_t)u * 4096;
    const float lg = log2f(1.f - exp2f(-5.f - (float)h));
    const float g64 = exp2f(64.f * lg);
    const int db = w & 3;
    f32x4 Sacc[2];
#pragma unroll
    for (int ci = 0; ci < 2; ++ci) { const int et = 2 * (w >> 2) + ci;
#pragma unroll
        for (int jj = 0; jj < 4; ++jj) Sacc[ci][jj] = FINAL ? Sbuf[(16 * db + 4 * q4 + jj) * 64 + 16 * et + r16] : 0.f;
        if (FINAL) st4bf(LB(R_SB) + (16 * et + r16) * PT + 16 * db + 4 * q4, Sacc[ci]); }
    const int tok = tid >> 3, part = tid & 7;
    double invf[4];
#pragma unroll
    for (int p = 0; p < 4; ++p) invf[p] = exp(-(double)(part * 4 + p) * (9.210340371976184 / 32.0));
    for (int j = 0; j < 4; ++j) {
        const int tl0 = sc * 256 + j * 64;
        {
            const int t = tl0 + tok; const size_t m = (size_t)b * T + t; const bf16* row = P + m * PLD + C_RET + h * 64 + 8 * part;
            float qv[8], kv[8], vv[8]; unpack8(*(const u32x4*)(row + 512), kv); unpack8(*(const u32x4*)(row + 1024), vv);
            if (FINAL) { unpack8(*(const u32x4*)row, qv); *(LAS u32x4*)(LB(R_GB) + tok * 64 + 8 * part) = *(const u32x4*)(row + 1536); }
            const float zeta = exp2f((float)(63 - tok) * lg);
#pragma unroll
            for (int p = 0; p < 4; ++p) {
                double ang = (double)t * invf[p]; ang -= 6.283185307179586 * floor(ang * 0.15915494309189535);
                float sn, cs; sincosf((float)ang, &sn, &cs);
                const float k0 = kv[2 * p], k1 = kv[2 * p + 1]; kv[2 * p] = (k0 * cs - k1 * sn) * 0.125f; kv[2 * p + 1] = (k0 * sn + k1 * cs) * 0.125f;
                if (FINAL) { const float q0 = qv[2 * p], q1 = qv[2 * p + 1]; qv[2 * p] = q0 * cs - q1 * sn; qv[2 * p + 1] = q0 * sn + q1 * cs; } }
            if (FINAL) { *(LAS u32x4*)(LB(R_QB) + tok * PT + 8 * part) = pack8(qv); *(LAS u32x4*)(LB(R_KB) + tok * PT + 8 * part) = pack8(kv); }
#pragma unroll
            for (int e = 0; e < 8; ++e) { LB(R_KHT)[(8 * part + e) * PT + tok] = (bf16)f2bf(kv[e] * zeta); LB(R_VT)[(8 * part + e) * PT + tok] = (bf16)f2bf(vv[e]); }
        }
        __syncthreads();
        if (FINAL) { const int rb = w & 3;
#pragma unroll
            for (int ci = 0; ci < 2; ++ci) { const int ct = 2 * (w >> 2) + ci; f32x4 a = FZ4;
                if (ct <= rb) a = mm_ll<64>(LB(R_QB), PT, 16 * rb, LB(R_KB), PT, 16 * ct, FZ4, lane);
#pragma unroll
                for (int jj = 0; jj < 4; ++jj) { const int l = 16 * rb + 4 * q4 + jj, s = 16 * ct + r16; LB(R_AB)[l * PT + s] = (bf16)f2bf((s <= l) ? a[jj] * exp2f((float)(l - s) * lg) : 0.f); } }
            __syncthreads();
        }
        {
            f32x4 yy[2];
            if (FINAL) { const int rb = w & 3;
#pragma unroll
                for (int ci = 0; ci < 2; ++ci) { const int et = 2 * (w >> 2) + ci;
                    const f32x4 a1 = mm_ll<64>(LB(R_AB), PT, 16 * rb, LB(R_VT), PT, 16 * et, FZ4, lane), a2 = mm_ll<64>(LB(R_QB), PT, 16 * rb, LB(R_SB), PT, 16 * et, FZ4, lane);
#pragma unroll
                    for (int jj = 0; jj < 4; ++jj) yy[ci][jj] = a1[jj] + exp2f((float)(16 * rb + 4 * q4 + jj + 1) * lg) * a2[jj]; } }
#pragma unroll
            for (int ci = 0; ci < 2; ++ci) { const int et = 2 * (w >> 2) + ci; Sacc[ci] = mm_ll<64>(LB(R_KHT), PT, 16 * db, LB(R_VT), PT, 16 * et, Sacc[ci] * g64, lane); }
            __syncthreads();
            if (FINAL) { const int rb = w & 3;
#pragma unroll
                for (int ci = 0; ci < 2; ++ci) { const int et = 2 * (w >> 2) + ci; st4bf(LB(R_SB) + (16 * et + r16) * PT + 16 * db + 4 * q4, Sacc[ci]);
#pragma unroll
                    for (int jj = 0; jj < 4; ++jj) LF(R_YF)[(16 * rb + 4 * q4 + jj) * PF + 16 * et + r16] = yy[ci][jj]; } }
        }
        __syncthreads();
        if (FINAL) { const size_t m = (size_t)b * T + tl0 + tok; float y[8], g[8], ss = 0.f;
#pragma unroll
            for (int e = 0; e < 8; ++e) { y[e] = LF(R_YF)[tok * PF + 8 * part + e]; ss += y[e] * y[e]; }
            const float rs = 1.f / sqrtf(red8(ss) * (1.f / 64.f) + 1e-6f);
            unpack8(*(const LAS u32x4*)(LB(R_GB) + tok * 64 + 8 * part), g);
#pragma unroll
            for (int e = 0; e < 8; ++e) y[e] = y[e] * rs * silu(g[e]);
            *(u32x4*)(P + m * PLD + C_RETG + h * 64 + 8 * part) = pack8(y);
            __syncthreads(); }
    }
    if (!FINAL) {
#pragma unroll
        for (int ci = 0; ci < 2; ++ci) { const int et = 2 * (w >> 2) + ci;
#pragma unroll
            for (int jj = 0; jj < 4; ++jj) Sbuf[(16 * db + 4 * q4 + jj) * 64 + 16 * et + r16] = Sacc[ci][jj]; }
    }
#undef LB
#undef LF
}

template <bool FINAL>
__device__ __forceinline__ void ssd_chunk_unit(Frame& F, int layer, int u) {
    const int tid = otid(), lane = tid & 63, w = __builtin_amdgcn_readfirstlane(tid >> 6), r16 = lane & 15, q4 = lane >> 4;
    const int b = u >> 9, sc = (u >> 3) & 63, h = u & 7, g = h >> 2;
    constexpr int D_CB = 0, D_BB = 17408, D_BT = 34816, D_YF = 53248, D_XT = 70656, D_XDT = 79872, D_GM = 89088, D_SB = 98304, D_MISC = 115712;
    constexpr int D_DTS = D_MISC, D_ACS = D_MISC + 256, D_CAR = D_MISC + 512;
    LAS unsigned char* L = F.lds;
#define LB(off) ((LAS bf16*)(L + (off)))
#define LF(off) ((LAS float*)(L + (off)))
    bf16* P = (bf16*)(F.ws + WS_BIG); const float* dtb = (const float*)(F.ws + WS_DT);
    const bf16* BND = (const bf16*)(F.ws + WS_BND);
    float* Sbuf = (float*)(F.ws + WS_ST_SSD) + (size_t)u * 8192;
    const float* cw = INP(17) + layer * 1024 * 4; const float* cbias = INP(18) + layer * 1024;
    const float dt_bias = INP(19)[layer * 8 + h], A = -expf(INP(20)[layer * 8 + h]), Dh = INP(21)[layer * 8 + h];
    constexpr int D_WX = D_MISC + 1280, D_BX = D_WX + 1024, D_WBC = D_BX + 256, D_BBC = D_WBC + 4096;
    const int bc_chunk = tid & 31, bc_chn = (bc_chunk < 16) ? (512 + g * 128 + bc_chunk * 8) : (768 + g * 128 + (bc_chunk - 16) * 8);
    const int x_chunk = tid & 7, x_chn = h * 64 + x_chunk * 8;
    { const int chn = (tid < 64) ? (h * 64 + tid) : (tid < 192) ? (512 + g * 128 + (tid - 64)) : (768 + g * 128 + (tid - 192));
      if (tid < 320) { const f32x4 wv = *(const f32x4*)(cw + chn * 4); const float bv = cbias[chn];
          if (tid < 64) { *(LAS f32x4*)(LF(D_WX) + tid * 4) = wv; LF(D_BX)[tid] = bv; } else { *(LAS f32x4*)(LF(D_WBC) + (tid - 64) * 4) = wv; LF(D_BBC)[tid - 64] = bv; } } }
    __syncthreads();
    const int pb = w & 3;
    f32x4 Sacc[4];
#pragma unroll
    for (int ci = 0; ci < 4; ++ci) { const int nt = 4 * (w >> 2) + ci;
#pragma unroll
        for (int jj = 0; jj < 4; ++jj) { const float x = FINAL ? Sbuf[(16 * pb + 4 * q4 + jj) * 128 + 16 * nt + r16] : 0.f; Sacc[ci][jj] = x;
            if (FINAL) LB(D_SB)[(16 * pb + 4 * q4 + jj) * PT2 + 16 * nt + r16] = (bf16)f2bf(x); } }
    float dstot = 0.f;
    for (int j = 0; j < 4; ++j) {
        const int tl0 = sc * 256 + j * 64; const size_t m0 = (size_t)b * T + tl0;
        if (tid < 64) {
            const float dt = softplus_acc(dtb[(m0 + tid) * 8 + h] + dt_bias); float a = A * dt;
#pragma unroll
            for (int o = 1; o < 64; o <<= 1) { const float n = __shfl_up(a, o); if (lane >= o) a += n; }
            LF(D_DTS)[tid] = dt; LF(D_ACS)[tid] = a;
        }
        {
#pragma unroll
            for (int it = 0; it < 4; ++it) { const int t = it * 16 + (tid >> 5); const int ta = tl0 + t;
                float acc[8];
#pragma unroll
                for (int e = 0; e < 8; ++e) acc[e] = LF(D_BBC)[bc_chunk * 8 + e];
#pragma unroll
                for (int k = 0; k < 4; ++k) { if (ta - 3 + k >= 0) { float x[8]; unpack8(*(const u32x4*)(P + (m0 + t - 3 + k) * PLD + C_XBC + bc_chn), x);
#pragma unroll
                        for (int e = 0; e < 8; ++e) acc[e] += LF(D_WBC)[(bc_chunk * 8 + e) * 4 + k] * x[e]; } }
#pragma unroll
                for (int e = 0; e < 8; ++e) acc[e] = silu(acc[e]);
                if (bc_chunk < 16) { *(LAS u32x4*)(LB(D_BB) + t * PT2 + bc_chunk * 8) = pack8(acc);
#pragma unroll
                    for (int e = 0; e < 8; ++e) LB(D_BT)[(bc_chunk * 8 + e) * PT + t] = (bf16)f2bf(acc[e]); }
                else *(LAS u32x4*)(LB(D_CB) + t * PT2 + (bc_chunk - 16) * 8) = pack8(acc);
            }
        }
        __syncthreads();
        {
            const int t = tid >> 3; float acc[8];
#pragma unroll
            for (int e = 0; e < 8; ++e) acc[e] = LF(D_BX)[x_chunk * 8 + e];
#pragma unroll
            for (int k = 0; k < 4; ++k) { const int rel = t - 3 + k; float x[8]; bool have = true;
                if (rel >= 0 || !FINAL) { if (tl0 + rel >= 0) unpack8(*(const u32x4*)(P + (m0 + rel) * PLD + C_XBC + x_chn), x); else have = false; }
                else if (j == 0) { if (sc > 0) unpack8(*(const u32x4*)(BND + ((size_t)((b * 64 + sc) * 3 + (rel + 3))) * 512 + x_chn), x); else have = false; }
                else {
#pragma unroll
                    for (int e = 0; e < 8; ++e) x[e] = LF(D_CAR)[(rel + 3) * 64 + x_chunk * 8 + e]; }
                if (have) {
#pragma unroll
                    for (int e = 0; e < 8; ++e) acc[e] += LF(D_WX)[(x_chunk * 8 + e) * 4 + k] * x[e]; } }
            const float sc_d = LF(D_DTS)[t] * expf(LF(D_ACS)[63] - LF(D_ACS)[t]);
#pragma unroll
            for (int e = 0; e < 8; ++e) { const float xv = silu(acc[e]); LB(D_XT)[(x_chunk * 8 + e) * PT + t] = (bf16)f2bf(xv); LB(D_XDT)[(x_chunk * 8 + e) * PT + t] = (bf16)f2bf(xv * sc_d); }
        }
        if (FINAL) { const int rb = w & 3;
#pragma unroll
            for (int ci = 0; ci < 2; ++ci) { const int ct = 2 * (w >> 2) + ci; f32x4 a = FZ4;
                if (ct <= rb) a = mm_ll<128>(LB(D_CB), PT2, 16 * rb, LB(D_BB), PT2, 16 * ct, FZ4, lane);
#pragma unroll
                for (int jj = 0; jj < 4; ++jj) { const int l = 16 * rb + 4 * q4 + jj, s = 16 * ct + r16;
                    LB(D_GM)[l * PT + s] = (bf16)f2bf((s <= l) ? a[jj] * expf(LF(D_ACS)[l] - LF(D_ACS)[s]) * LF(D_DTS)[s] : 0.f); } } }
        __syncthreads();
        {
            f32x4 yy[2];
            if (FINAL) { const int rb = w & 3;
#pragma unroll
                for (int ci = 0; ci < 2; ++ci) { const int pt = 2 * (w >> 2) + ci;
                    const f32x4 a1 = mm_ll<64>(LB(D_GM), PT, 16 * rb, LB(D_XT), PT, 16 * pt, FZ4, lane), a2 = mm_ll<128>(LB(D_CB), PT2, 16 * rb, LB(D_SB), PT2, 16 * pt, FZ4, lane);
#pragma unroll
                    for (int jj = 0; jj < 4; ++jj) { const int l = 16 * rb + 4 * q4 + jj, p = 16 * pt + r16; yy[ci][jj] = a1[jj] + expf(LF(D_ACS)[l]) * a2[jj] + Dh * ldbf(LB(D_XT) + p * PT + l); } } }
            const float dec = expf(LF(D_ACS)[63]);
#pragma unroll
            for (int ci = 0; ci < 4; ++ci) { const int nt = 4 * (w >> 2) + ci; Sacc[ci] = mm_ll<64>(LB(D_XDT), PT, 16 * pb, LB(D_BT), PT, 16 * nt, Sacc[ci] * dec, lane); }
            dstot += LF(D_ACS)[63];
            if (FINAL && tid < 24) { const int k = tid >> 3, ch = tid & 7; float x[8]; unpack8(*(const u32x4*)(P + (m0 + 61 + k) * PLD + C_XBC + h * 64 + ch * 8), x);
#pragma unroll
                for (int e = 0; e < 8; ++e) LF(D_CAR)[k * 64 + ch * 8 + e] = x[e]; }
            __syncthreads();
            if (FINAL) { const int rb = w & 3;
#pragma unroll
                for (int ci = 0; ci < 4; ++ci) { const int nt = 4 * (w >> 2) + ci;
#pragma unroll
                    for (int jj = 0; jj < 4; ++jj) LB(D_SB)[(16 * pb + 4 * q4 + jj) * PT2 + 16 * nt + r16] = (bf16)f2bf(Sacc[ci][jj]); }
#pragma unroll
                for (int ci = 0; ci < 2; ++ci) { const int pt = 2 * (w >> 2) + ci;
#pragma unroll
                    for (int jj = 0; jj < 4; ++jj) LF(D_YF)[(16 * rb + 4 * q4 + jj) * PF + 16 * pt + r16] = yy[ci][jj]; } }
        }
        __syncthreads();
        if (FINAL) { const int tok = tid >> 3, part = tid & 7; float y[8];
#pragma unroll
            for (int e = 0; e < 8; ++e) y[e] = LF(D_YF)[tok * PF + 8 * part + e];
            *(u32x4*)(P + (m0 + tok) * PLD + C_XBC + h * 64 + 8 * part) = pack8(y);
            __syncthreads(); }
    }
    if (!FINAL) {
#pragma unroll
        for (int ci = 0; ci < 4; ++ci) { const int nt = 4 * (w >> 2) + ci;
#pragma unroll
            for (int jj = 0; jj < 4; ++jj) Sbuf[(16 * pb + 4 * q4 + jj) * 128 + 16 * nt + r16] = Sacc[ci][jj]; }
        if (tid == 0) ((float*)(F.ws + WS_DSTOT))[u] = dstot;
    }
#undef LB
#undef LF
}

__device__ __forceinline__ void rwkv_scan_chain(Frame& F, int chain) {
    const int tid = otid(), lane = tid & 63, w = __builtin_amdgcn_readfirstlane(tid >> 6), r16 = lane & 15, q4 = lane >> 4;
    const int b = chain >> 3, h = chain & 7, vb = w & 3;
    LAS bf16* SB = (LAS bf16*)F.lds;
    f32x4 Sacc[2] = {FZ4, FZ4};
    for (int i = tid; i < 64 * PT / 2; i += 512) ((LAS unsigned*)SB)[i] = 0u;
    __syncthreads();
    for (int sc = 0; sc < 64; ++sc) {
        const int u = (b * 64 + sc) * 8 + h;
        float* Nb = (float*)(F.ws + WS_ST_RW) + (size_t)u * 4096; const bf16* MT = (const bf16*)(F.ws + WS_MT) + (size_t)u * 4096;
        f32x4 nw[2];
#pragma unroll
        for (int ci = 0; ci < 2; ++ci) { const int ct = 2 * (w >> 2) + ci;
            f32x4 nv;
#pragma unroll
            for (int jj = 0; jj < 4; ++jj) { float* p = Nb + (16 * vb + 4 * q4 + jj) * 64 + 16 * ct + r16; nv[jj] = *p; *p = Sacc[ci][jj]; }
            nw[ci] = mm_lg<64>(SB, PT, 16 * vb, MT, 64, 16 * ct, nv, lane); }
        __syncthreads();
#pragma unroll
        for (int ci = 0; ci < 2; ++ci) { const int ct = 2 * (w >> 2) + ci; Sacc[ci] = nw[ci];
#pragma unroll
            for (int jj = 0; jj < 4; ++jj) SB[(16 * vb + 4 * q4 + jj) * PT + 16 * ct + r16] = (bf16)f2bf(nw[ci][jj]); }
        __syncthreads();
    }
}
__device__ __forceinline__ void elem_scans(Frame& F, int blk, int nblk) {
    const int tid = otid();
    const int NRET = 16 * 4096, NSSD = 16 * 8192;
    const float* dst = (const float*)(F.ws + WS_DSTOT);
    for (int it = blk * 512 + tid; it < NRET + NSSD; it += nblk * 512) {
        if (it < NRET) { const int chain = it >> 12, e = it & 4095, b = chain >> 3, h = chain & 7;
            const float g256 = exp2f(256.f * log2f(1.f - exp2f(-5.f - (float)h)));
            float* p = (float*)(F.ws + WS_ST_RET) + ((size_t)(b * 64) * 8 + h) * 4096 + e; float carry = 0.f;
#pragma unroll 8
            for (int sc = 0; sc < 64; ++sc) { const float t = p[(size_t)sc * 8 * 4096]; p[(size_t)sc * 8 * 4096] = carry; carry = g256 * carry + t; }
        } else { const int i2 = it - NRET, chain = i2 >> 13, e = i2 & 8191, b = chain >> 3, h = chain & 7;
            float* p = (float*)(F.ws + WS_ST_SSD) + ((size_t)(b * 64) * 8 + h) * 8192 + e; const float* d = dst + (b * 64) * 8 + h; float carry = 0.f;
#pragma unroll 8
            for (int sc = 0; sc < 64; ++sc) { const float t = p[(size_t)sc * 8 * 8192]; p[(size_t)sc * 8 * 8192] = carry; carry = expf(d[sc * 8]) * carry + t; }
        }
    }
}
__device__ __forceinline__ void conv_lora(Frame& F) {
    const int tid = otid();
    for (int l = 0; l < 2; ++l) {
        bf16* base = (bf16*)(F.ws + WS_LORA + (size_t)l * LORA_STRIDE);
        const float* wu = INP(4) + l * 64 * 512; const float* au = INP(6) + l * 64 * 512; const float* gu = INP(8) + l * 128 * 512;
        for (int i = F.vcu * 512 + tid; i < 512 * 64; i += F.G * 512) { const int c = i >> 6, jx = i & 63; base[i] = (bf16)f2bf(wu[jx * 512 + c]); base[32768 + i] = (bf16)f2bf(au[jx * 512 + c]); }
        for (int i = F.vcu * 512 + tid; i < 512 * 128; i += F.G * 512) { const int c = i >> 7, jx = i & 127; base[65536 + i] = (bf16)f2bf(gu[jx * 512 + c]); }
    }
}
__device__ __forceinline__ void save_bnd(Frame& F) {
    const int tid = otid();
    const bf16* P = (const bf16*)(F.ws + WS_BIG); bf16* BND = (bf16*)(F.ws + WS_BND);
    for (int i = F.vcu * 512 + tid; i < 2 * 64 * 3 * 64; i += F.G * 512) { const int ch = i & 63, k = (i >> 6) % 3, bs = i / 192, b = bs >> 6, sc = bs & 63;
        if (sc > 0) *(u32x4*)(BND + (size_t)(bs * 3 + k) * 512 + ch * 8) = *(const u32x4*)(P + ((size_t)b * T + sc * 256 - 3 + k) * PLD + C_XBC + ch * 8); }
}

constexpr int LAYER_BASE0 = 1, LAYER_STRIDE = 17, MOE_BASE = LAYER_BASE0 + LAYER_STRIDE + 14;
__device__ __forceinline__ Frame lf(const Frame& F0) {
    Frame F = F0; unsigned l = (unsigned)(unsigned long long)F.lds;
    asm volatile("" : "+s"(l), "+s"(F.vcu), "+s"(F.G), "+s"(F.cid), "+s"(F.out), "+s"(F.ws));
    F.lds = (LAS unsigned char*)(unsigned long long)l; return F;
}
__global__ void __launch_bounds__(512, 2) fwd(Args args) {
    extern __shared__ __attribute__((aligned(16))) unsigned char lds_raw[];
    Frame F0;
    F0.lds = (LAS unsigned char*)lds_raw;
    F0.G = gridDim.x; { const int bx = blockIdx.x; F0.vcu = (F0.G % 8 == 0) ? (bx % 8) * (F0.G / 8) + bx / 8 : bx; }
    F0.cid = blockIdx.x; F0.out = args.out; F0.ws = args.ws;
    volatile LAS unsigned* MISC = (volatile LAS unsigned*)(F0.lds + MISC_OFF);
    for (int u = threadIdx.x; u < (LDS_BYTES - LDSCTL_OFF) / 4; u += 512) ((LAS unsigned*)(F0.lds + LDSCTL_OFF))[u] = 0u;
    __syncthreads();
    if (threadIdx.x < 34) *(LAS unsigned long long*)(F0.lds + LDSCTL_OFF + 8 * threadIdx.x) = (unsigned long long)args.in[threadIdx.x];
    __syncthreads();
    const int lo = args.ph_lo, hi = args.ph_hi;
    XcdBarrier bar; bar.bar = (unsigned*)(F0.ws + WS_CTL); bar.x = 0; bar.st = nullptr;
    if (hi - lo > 1) bar = xcd_barrier_post((unsigned*)(F0.ws + WS_CTL), MISC + 8);
#define IN(k) (lo <= (k) && (k) < hi)
#define SEAM(k) do { if (IN(k) && IN((k) + 1)) xcd_barrier(bar); } while (0)
#define WSP(T_, off) ((T_*)(F.ws + (off)))

    if (IN(0)) { Frame F = lf(F0); conv_layer_weights(F, 0); conv_layer_weights(F, 1); conv_ffn_weights(F); conv_lora(F); xprep_phase(F, INP(0)); }
    SEAM(0);
    for (int l = 0; l < 2; ++l) {
        const int pb = LAYER_BASE0 + l * LAYER_STRIDE;
        if (IN(pb + 0)) {
            Frame F = lf(F0); unsigned char* wl = F.ws + WS_W + (size_t)l * WL_STRIDE;
            pg8::Gemm g{WSP(bf16, WS_XB), (const bf16*)(wl + WL_IN), D, D, D}; pg8::StaticOrder S; S.init(M, NP, F.G, F.cid);
            pg8::EpiInProj E{WSP(bf16, WS_BIG), WSP(float, WS_RSTD), WSP(float, WS_DT)};
            pg8::gemm_phase(F.lds, g, S, E);
        }
        SEAM(pb + 0);
        if (IN(pb + 1)) { Frame F = lf(F0); vprep_phase(F, l); save_bnd(F); }
        SEAM(pb + 1);
        if (IN(pb + 2)) {
#if RW_CH
            { Frame F = lf(F0); for (int u = F.cid; u < 1024; u += F.G) rwkv_chunk_unit<false>(F, l, u); }
#else
            { Frame F = lf(F0); if (F.cid < 16) rwkv_seq(F, l, F.cid); }
#endif
#if RET_CH
            { Frame F = lf(F0); for (int u = F.cid; u < 1024; u += F.G) ret_chunk_unit<false>(F, u); }
#else
            { Frame F = lf(F0); if (F.cid >= 32 && F.cid < 48) ret_seq(F, F.cid - 32); }
#endif
#if SSD_CH
            { Frame F = lf(F0); for (int u = F.cid; u < 1024; u += F.G) ssd_chunk_unit<false>(F, l, u); }
#else
            { Frame F = lf(F0); if (F.cid >= 16 && F.cid < 32) ssd_seq(F, l, F.cid - 16); }
#endif
        }
        SEAM(pb + 2);
        if (IN(pb + 3)) {
            Frame F = lf(F0);
            if (F.cid < 16) { if (RW_CH) rwkv_scan_chain(F, F.cid); }
            else elem_scans(F, F.cid - 16, F.G - 16);
        }
        SEAM(pb + 3);
        if (IN(pb + 4)) {
#if RW_CH
            { Frame F = lf(F0); for (int u = F.cid; u < 1024; u += F.G) rwkv_chunk_unit<true>(F, l, u); }
#endif
#if RET_CH
            { Frame F = lf(F0); for (int u = F.cid; u < 1024; u += F.G) ret_chunk_unit<true>(F, u); }
#endif
#if SSD_CH
            { Frame F = lf(F0); for (int u = F.cid; u < 1024; u += F.G) ssd_chunk_unit<true>(F, l, u); }
#endif
        }
        SEAM(pb + 4);
        if (IN(pb + 5)) { Frame F = lf(F0); ssm_norm_phase(F, l); xprep_phase(F, (l == 0) ? INP(0) : F.out); }
        SEAM(pb + 5);
        for (int i = 0; i < 3; ++i) {
            if (IN(pb + 6 + 2 * i)) {
                Frame F = lf(F0); unsigned char* wl = F.ws + WS_W + (size_t)l * WL_STRIDE; bf16* P = WSP(bf16, WS_BIG);
                const bf16* A = (i == 0) ? WSP(const bf16, WS_YRW) : (i == 1 ? P + C_Z : P + C_RETG);
                pg8::Gemm g{A, (const bf16*)(wl + WL_BR) + (size_t)i * D * 512, (i == 0) ? 512 : PLD, 512, 512}; pg8::StaticOrder S; S.init(M, D, F.G, F.cid);
                pg8::EpiPlain E{P, PLD};
                pg8::gemm_phase(F.lds, g, S, E);
            }
            SEAM(pb + 6 + 2 * i);
            if (IN(pb + 7 + 2 * i)) {
                Frame F = lf(F0); unsigned char* wl = F.ws + WS_W + (size_t)l * WL_STRIDE; bf16* P = WSP(bf16, WS_BIG);
                pg8::Gemm g{WSP(bf16, WS_XB), (const bf16*)(wl + WL_GATE) + (size_t)i * D * D, D, D, D}; pg8::StaticOrder S; S.init(M, D, F.G, F.cid);
                pg8::EpiGateMerge E{P, PLD, P + C_RET, PLD, WSP(float, WS_RSTD), i == 0};
                pg8::gemm_phase(F.lds, g, S, E);
            }
            SEAM(pb + 7 + 2 * i);
        }
        if (IN(pb + 12)) {
            Frame F = lf(F0); unsigned char* wl = F.ws + WS_W + (size_t)l * WL_STRIDE; bf16* P = WSP(bf16, WS_BIG);
            pg8::Gemm g{P + C_RET, (const bf16*)(wl + WL_OUT), PLD, D, D}; pg8::StaticOrder S; S.init(M, D, F.G, F.cid);
            pg8::EpiResid E{(l == 0) ? INP(0) : F.out, F.out, nullptr, 0};
            pg8::gemm_phase(F.lds, g, S, E);
        }
        SEAM(pb + 12);
        if (IN(pb + 13)) { Frame F = lf(F0); xprep_phase(F, F.out); if (l == 1) conv_moe_weights(F); }
        SEAM(pb + 13);
        if (l == 0) {
            if (IN(pb + 14)) {
                Frame F = lf(F0);
                pg8::Gemm g{WSP(bf16, WS_XB), WSP(const bf16, WS_FFUP), D, D, D}; pg8::StaticOrder S; S.init(M, 2 * FF, F.G, F.cid);
                pg8::EpiSwiglu E{WSP(bf16, WS_ACT), FF, WSP(float, WS_RSTD)};
                pg8::gemm_phase(F.lds, g, S, E);
            }
            SEAM(pb + 14);
            if (IN(pb + 15)) {
                Frame F = lf(F0);
                pg8::Gemm g{WSP(const bf16, WS_ACT), WSP(const bf16, WS_FFDN), FF, FF, FF}; pg8::StaticOrder S; S.init(M, D, F.G, F.cid);
                pg8::EpiResid E{F.out, F.out, nullptr, 0};
                pg8::gemm_phase(F.lds, g, S, E);
            }
            SEAM(pb + 15);
            if (IN(pb + 16)) { Frame F = lf(F0); xprep_phase(F, F.out); }
            SEAM(pb + 16);
        }
    }
    {
        const int pb = MOE_BASE;
        if (IN(pb)) { Frame F = lf(F0); router_phase(F); }
        SEAM(pb);
        for (int e = 0; e < NE; ++e) {
            if (IN(pb + 1 + 2 * e)) {
                Frame F = lf(F0); const bf16* up = (const bf16*)(F.ws + WS_MOEW + (size_t)e * MOEW_STRIDE);
                pg8::Gemm g{WSP(bf16, WS_XB), up, D, D, D}; pg8::StaticOrder S; S.init(M, 2 * FFE, F.G, F.cid);
                pg8::EpiSwiglu E{WSP(bf16, WS_ACT), FFE, WSP(float, WS_RSTD)};
                pg8::gemm_phase(F.lds, g, S, E);
            }
            SEAM(pb + 1 + 2 * e);
            if (IN(pb + 2 + 2 * e)) {
                Frame F = lf(F0); const bf16* dn = (const bf16*)(F.ws + WS_MOEW + (size_t)e * MOEW_STRIDE + MOEW_DN);
                pg8::Gemm g{WSP(const bf16, WS_ACT), dn, FFE, FFE, FFE}; pg8::StaticOrder S; S.init(M, D, F.G, F.cid);
                pg8::EpiResid E{F.out, F.out, WSP(float, WS_GATES), e};
                pg8::gemm_phase(F.lds, g, S, E);
            }
            SEAM(pb + 2 + 2 * e);
        }
        if (IN(pb + 17)) { Frame F = lf(F0); final_norm_phase(F); }
    }
#undef IN
#undef SEAM
#undef WSP
}
constexpr int LAST_PHASE = MOE_BASE + 17;
constexpr int N_PH = LAST_PHASE + 1;

extern "C" void kernel_launch(void* const* d_in, const int* in_sizes, int n_in, void* d_out, int out_size, void* d_ws, size_t ws_size, hipStream_t stream) {
    static int grid = 0;
    if (grid == 0) {
        if (n_in != 34 || out_size != M * D || ws_size < WS_END) { fprintf(stderr, "kernel_launch: unexpected problem (n_in %d out %d ws %zu need %zu)\n", n_in, out_size, ws_size, (size_t)WS_END); grid = -1; return; }
        int dev = 0, cus = 0;
        if (hipGetDevice(&dev) != hipSuccess || hipDeviceGetAttribute(&cus, hipDeviceAttributeMultiprocessorCount, dev) != hipSuccess) { grid = -1; return; }
        if (hipFuncSetAttribute((const void*)fwd, hipFuncAttributeMaxDynamicSharedMemorySize, LDS_BYTES) != hipSuccess) { fprintf(stderr, "kernel_launch: hipFuncSetAttribute failed\n"); grid = -1; return; }
        int per_cu = 0;
        if (hipOccupancyMaxActiveBlocksPerMultiprocessor(&per_cu, (const void*)fwd, 512, LDS_BYTES) != hipSuccess || per_cu < 1) fprintf(stderr, "kernel_launch: occupancy query says %d\n", per_cu);
        (void)hipGetLastError();
        grid = cus;
    }
    if (grid < 0) return;
    (void)hipMemsetAsync((char*)d_ws + WS_CTL, 0, CTL_ZERO_BYTES, stream);
    Args a{};
    for (int i = 0; i < 34; ++i) a.in[i] = (const float*)d_in[i];
    a.out = (float*)d_out; a.ws = (unsigned char*)d_ws;
#if MK_ONE_LAUNCH
    a.ph_lo = 0; a.ph_hi = N_PH;
    hipLaunchKernelGGL(fwd, dim3(grid), dim3(512), LDS_BYTES, stream, a);
#else
    for (int p = 0; p < N_PH; ++p) { a.ph_lo = p; a.ph_hi = p + 1; hipLaunchKernelGGL(fwd, dim3(grid), dim3(512), LDS_BYTES, stream, a); }
#endif
}
```

```cpp
#include <hip/hip_runtime.h>
#include <cstdio>
#include <cstdint>

#ifndef MK_ONE_LAUNCH
#define MK_ONE_LAUNCH 1
#endif

#define LAS __attribute__((address_space(3)))
#define GAS __attribute__((address_space(1)))
typedef unsigned short bf16;
typedef short bf16x8 __attribute__((ext_vector_type(8)));
typedef float f32x4 __attribute__((ext_vector_type(4)));
typedef unsigned u32x4 __attribute__((ext_vector_type(4)));
typedef unsigned u32x2 __attribute__((ext_vector_type(2)));
typedef float f32x2 __attribute__((ext_vector_type(2)));

constexpr int BATCH = 2, T = 16384, D = 1024, M = BATCH * T;
constexpr int INC = 8456;
constexpr int PLD = 5376;
constexpr int NP = 5632;
constexpr int C_RW = 0, C_Z = 1792, C_XBC = 2304, C_RET = 3328, C_RETG = 4864;
constexpr int FF = 2816, FFE = 3584, NE = 8;

constexpr size_t MiB = 1u << 20;
constexpr size_t WS_CTL = 0, CTL_ZERO_BYTES = 64 * 1024;
constexpr size_t WS_RSTD = 1 * MiB, WS_GATES = 2 * MiB, WS_DT = 3 * MiB;
constexpr size_t WS_W = 4 * MiB;
constexpr size_t WL_IN = 0, WL_GATE = 11 * MiB, WL_BR = 17 * MiB, WL_OUT = 20 * MiB, WL_STRIDE = 22 * MiB;
constexpr size_t WS_FFUP = WS_W + 44 * MiB, WS_FFDN = WS_W + 55 * MiB;
constexpr size_t WS_XB = 68 * MiB;
constexpr size_t WS_VF = 132 * MiB;
constexpr size_t WS_BIG = 164 * MiB;
constexpr size_t WS_VMIX = WS_BIG + 336 * MiB, WS_YRW = WS_BIG + 368 * MiB, WS_END = WS_BIG + 400 * MiB;
constexpr size_t WS_MOEW = WS_BIG;
constexpr size_t MOEW_STRIDE = 21 * MiB, MOEW_DN = 14 * MiB;
constexpr size_t WS_ACT = WS_BIG + 168 * MiB;

constexpr size_t WS_CNT = 32768, WS_LIST = 2 * MiB;
constexpr size_t WS_DSTOT = 128 * 1024, WS_BND = 256 * 1024;
constexpr size_t WS_LORA = 1 * MiB + 512 * 1024, LORA_STRIDE = 262144;
constexpr size_t WS_ST_RW = WS_XB, WS_ST_RET = WS_XB + 16 * MiB, WS_ST_SSD = WS_XB + 32 * MiB, WS_MT = WS_YRW;
constexpr int RING_BYTES = 131072, LDSCTL_OFF = 159744, MISC_OFF = LDSCTL_OFF + 320, LDS_BYTES = 163840;
#ifndef REP_CONV
#define REP_CONV 0
#endif
#ifndef REP_R1
#define REP_R1 0
#endif
#ifndef REP_RW
#define REP_RW 0
#endif
#ifndef REP_RET
#define REP_RET 0
#endif
#ifndef REP_SSD
#define REP_SSD 0
#endif
#ifndef REP_MISC
#define REP_MISC 0
#endif
#ifndef RW_CH
#define RW_CH 1
#endif
#ifndef RET_CH
#define RET_CH 1
#endif
#ifndef SSD_CH
#define SSD_CH 1
#endif

__device__ __forceinline__ unsigned f2bf(float f) { unsigned u = __builtin_bit_cast(unsigned, f); return (u + 0x7fffu + ((u >> 16) & 1u)) >> 16; }
__device__ __forceinline__ unsigned pk2(float lo, float hi) { return f2bf(lo) | (f2bf(hi) << 16); }
__device__ __forceinline__ float bflo(unsigned u) { return __builtin_bit_cast(float, u << 16); }
__device__ __forceinline__ float bfhi(unsigned u) { return __builtin_bit_cast(float, u & 0xffff0000u); }
__device__ __forceinline__ void unpack8(const u32x4 u, float (&f)[8]) { f[0] = bflo(u.x); f[1] = bfhi(u.x); f[2] = bflo(u.y); f[3] = bfhi(u.y); f[4] = bflo(u.z); f[5] = bfhi(u.z); f[6] = bflo(u.w); f[7] = bfhi(u.w); }
__device__ __forceinline__ u32x4 pack8(const float (&f)[8]) { u32x4 w; w.x = pk2(f[0], f[1]); w.y = pk2(f[2], f[3]); w.z = pk2(f[4], f[5]); w.w = pk2(f[6], f[7]); return w; }
__device__ __forceinline__ float sigm(float x) { return 1.f / (1.f + __expf(-x)); }
__device__ __forceinline__ float silu(float x) { return x / (1.f + __expf(-x)); }
__device__ __forceinline__ float ex2(float x) { return __builtin_amdgcn_exp2f(x); }
__device__ __forceinline__ float fast_tanh(float x) { return 1.f - 2.f / (1.f + __expf(2.f * x)); }
__device__ __forceinline__ float softplus_acc(float x) { return fmaxf(x, 0.f) + log1pf(expf(-fabsf(x))); }
__device__ __forceinline__ float wave_sum(float v) {
#pragma unroll
    for (int o = 1; o < 64; o <<= 1) v += __shfl_xor(v, o);
    return v;
}
__device__ __forceinline__ int otid_w(int wid) { int t = wid * 64 + (int)__builtin_amdgcn_mbcnt_hi(~0u, __builtin_amdgcn_mbcnt_lo(~0u, 0u)); asm volatile("" : "+v"(t)); return t; }
#define otid() otid_w(F.wid)
__device__ __forceinline__ int fresh_tid(int t) { asm volatile("" : "+v"(t)); return t; }
#define LDS_WAIT() asm volatile("s_waitcnt lgkmcnt(0)" ::: "memory")

namespace pg8 {
constexpr int BM = 256, BK = 64, HALF = 128, HTB = HALF * BK * 2, STAGE_BYTES = 8 * HTB, NXCD = 8, WGM = 8;
__host__ __device__ __forceinline__ int lds_byte(int r, int c) { const int st = (r >> 4) * 2 + (c >> 5), rr = r & 15, cc = c & 31, ob = rr * 64 + cc * 2; return st * 1024 + (ob ^ (((ob >> 9) & 1) << 5)); }
__host__ __device__ __forceinline__ void stage_rc(int b, int& R, int& C) { const int st = b / 1024, sb = b % 1024, swz = sb ^ (((sb >> 9) & 1) << 5); R = (st >> 1) * 16 + swz / 64; C = (st & 1) * 32 + (swz % 64) / 2; }
__host__ __device__ __forceinline__ int perm32(int rho) { const int n = rho >> 4, i = rho & 15; return 8 * (i >> 2) + 4 * n + (i & 3); }

struct Unit { int pm, pn; size_t aofs, bofs; const int* rows; int nvalid, e; };
struct Gemm { const bf16* A; const bf16* Bt; int lda, ldb, K; };

struct StaticOrder {
    static constexpr bool GATHER = false;
    int nM, nN, nwg, G, c; size_t tsA, tsB;
    __device__ __forceinline__ void init(int Mrows, int N, int G_, int c_, int lda, int ldb) { nM = Mrows / BM; nN = N / BM; nwg = nM * nN; G = G_; c = c_; tsA = (size_t)BM * lda * 2; tsB = (size_t)BM * ldb * 2; }
    __device__ __forceinline__ bool next(int i, Unit& u) const {
        const long L = (long)i * G + c; if (L >= nwg) return false;
        int wgid = (int)L; { const int q = nwg / NXCD, r = nwg % NXCD, xcd = wgid % NXCD, off = wgid / NXCD; wgid = (xcd < r ? xcd * (q + 1) : r * (q + 1) + (xcd - r) * q) + off; }
        const int nig = WGM * nN, gid = wgid / nig, fm = gid * WGM, gsz = (nM - fm) < WGM ? (nM - fm) : WGM;
        u.pm = fm + ((wgid % nig) % gsz); u.pn = (wgid % nig) / gsz; u.aofs = (size_t)u.pm * tsA; u.bofs = (size_t)u.pn * tsB; u.rows = nullptr; u.nvalid = BM; u.e = 0; return true;
    }
};
template <bool GATH> struct MoeOrder {
    static constexpr bool GATHER = GATH;
    unsigned q0, q1, q2, q3;
    int seg, nN, G, c; const int* list; size_t bstride, tsB, tsA;
    __device__ __forceinline__ void init(const int* counts, const int* list_, int seg_, int N, int G_, int c_, int lda, int ldb, size_t bstride_) {
        unsigned n[8];
#pragma unroll
        for (int e = 0; e < 8; ++e) { int v = __builtin_amdgcn_readfirstlane(counts[e]); v = v < 0 ? 0 : (v > 32768 ? 32768 : v); n[e] = (unsigned)v; }
        q0 = n[0] | (n[1] << 16); q1 = n[2] | (n[3] << 16); q2 = n[4] | (n[5] << 16); q3 = n[6] | (n[7] << 16);
        seg = seg_; nN = N / BM; G = G_; c = c_; list = list_; bstride = bstride_; tsB = (size_t)BM * ldb * 2; tsA = (size_t)BM * lda * 2;
    }
    __device__ __forceinline__ bool next(int i, Unit& u) const {
        const long L = (long)i * G + c; const int tl = (int)(L / nN), pn = (int)(L % nN), gt = seg * 128 + tl;
        int t = 0, e = 0, tbe = 0, cne = 0;
#pragma unroll
        for (int k = 0; k < 8; ++k) { const unsigned q = (k < 2) ? q0 : (k < 4) ? q1 : (k < 6) ? q2 : q3; const int n = (int)((k & 1) ? (q >> 16) : (q & 0xffffu));
            if (gt >= t) { e = k; tbe = t; cne = n; } t += (n + 255) >> 8; }
        int nt = t - seg * 128; nt = nt < 0 ? 0 : (nt > 128 ? 128 : nt);
        if (L >= (long)nt * nN) return false;
        const int rt = gt - tbe;
        u.pm = tl; u.pn = pn; u.e = e; u.bofs = (size_t)e * bstride + (size_t)pn * tsB; u.aofs = GATH ? 0 : (size_t)tl * tsA;
        u.rows = list + ((size_t)e * 32768 + rt * 256) * 2; int nv = cne - rt * 256; u.nvalid = nv > 256 ? 256 : nv; return true;
    }
};

template <class Epi, class Sched>
__device__ __forceinline__ void gemm_phase(LAS unsigned char* lds, int wid0, const Gemm g, const Sched& S, const Epi& E) {
    constexpr bool GATHER = Sched::GATHER;
    const int tid = otid_w(wid0), wid = __builtin_amdgcn_readfirstlane(tid >> 6), lane = tid & 63, wr = wid >> 2, wc = wid & 3, fr = lane & 15, fq = lane >> 4;
    const int nt = g.K / BK;
    unsigned voffA[2], voffB[2];
#pragma unroll
    for (int i = 0; i < 2; ++i) { int R, C; stage_rc(tid * 16 + i * 8192, R, C); const int Rb = Epi::PERM ? ((R & ~31) + perm32(R & 31)) : R;
        voffA[i] = (unsigned)(R * g.lda + C) * 2u; voffB[i] = (unsigned)(Rb * g.ldb + C) * 2u; }
    const size_t kstep = (size_t)(BK * 2);
    const size_t hstepA = GATHER ? 0 : (size_t)HALF * g.lda * 2, hstepB = (size_t)HALF * g.ldb * 2;
    const unsigned ldsw = (unsigned)wid * 1024u;
    const int aoff = lds_byte(wr * 64 + fr, fq * 8), boff = lds_byte(wc * 32 + fr, fq * 8);
#define PG8_SA(b, h) (((b) * 2 + (h)) * HTB)
#define PG8_SB(b, h) ((4 + (b) * 2 + (h)) * HTB)
#define PG8_STAGE2(bufoff, gbase, o0, o1) do { \
        __builtin_amdgcn_global_load_lds((const unsigned*)((const char*)(gbase) + (o0)), (LAS unsigned*)(lds + (bufoff) + ldsw), 16, 0, 0); \
        __builtin_amdgcn_global_load_lds((const unsigned*)((const char*)(gbase) + (o1)), (LAS unsigned*)(lds + (bufoff) + ldsw + 8192), 16, 0, 0); } while (0)
#define PG8_STAGE(bufoff, gbase, voff) PG8_STAGE2(bufoff, gbase, (voff)[0], (voff)[1])
#define PG8_LDA(dst, b, h) do { _Pragma("unroll") for (int m = 0; m < 4; ++m) _Pragma("unroll") for (int k = 0; k < 2; ++k) dst[m][k] = *(const LAS bf16x8*)(lds + PG8_SA(b, h) + aoff + m * 2048 + k * 1024); } while (0)
#define PG8_LDB(dst, b, h) do { _Pragma("unroll") for (int n = 0; n < 2; ++n) _Pragma("unroll") for (int k = 0; k < 2; ++k) dst[n][k] = *(const LAS bf16x8*)(lds + PG8_SB(b, h) + boff + n * 2048 + k * 1024); } while (0)
#define PG8_MMA(ai, bj, At, Bt) do { __builtin_amdgcn_s_setprio(1); _Pragma("unroll") for (int m = 0; m < 4; ++m) _Pragma("unroll") for (int n = 0; n < 2; ++n) _Pragma("unroll") for (int k = 0; k < 2; ++k) \
        acc[ai][bj][m][n] = Epi::TRANS ? __builtin_amdgcn_mfma_f32_16x16x32_bf16(Bt[n][k], At[m][k], acc[ai][bj][m][n], 0, 0, 0) : __builtin_amdgcn_mfma_f32_16x16x32_bf16(At[m][k], Bt[n][k], acc[ai][bj][m][n], 0, 0, 0); __builtin_amdgcn_s_setprio(0); } while (0)
#define PG8_WAIT_V(n) asm volatile("s_waitcnt vmcnt(" #n ")" ::: "memory")
#define PG8_WAIT_L(n) asm volatile("s_waitcnt lgkmcnt(" #n ")" ::: "memory")
#define PG8_BAR __builtin_amdgcn_s_barrier()
#define PG8_SCHED __builtin_amdgcn_sched_barrier(0)
#define GSLOT(which) ((LAS u32x4*)(lds + 131072 + (which) * 8192 + tid * 16))
#define PG8_ROWS(u, which) do { const int _ft = fresh_tid(tid); unsigned _vg[2][2]; _Pragma("unroll") for (int _i = 0; _i < 2; ++_i) { int _R, _C; stage_rc(_ft * 16 + _i * 8192, _R, _C); \
        _Pragma("unroll") for (int _h = 0; _h < 2; ++_h) { const int _r = _h * HALF + _R; \
        const int _t = (_r < (u).nvalid) ? (u).rows[2 * _r] : 0; _vg[_h][_i] = ((unsigned)_t * (unsigned)g.lda + (unsigned)_C) * 2u; } } \
        u32x4 _o; _o.x = _vg[0][0]; _o.y = _vg[0][1]; _o.z = _vg[1][0]; _o.w = _vg[1][1]; *GSLOT(which) = _o; } while (0)
    Unit cur, nxt; int ui = 0;
    if (!S.next(0, cur)) return;
    f32x4 acc[2][2][4][2];
#pragma unroll
    for (int a = 0; a < 2; ++a)
#pragma unroll
        for (int b = 0; b < 2; ++b)
#pragma unroll
            for (int m = 0; m < 4; ++m)
#pragma unroll
                for (int n = 0; n < 2; ++n) acc[a][b][m][n] = (f32x4){0.f, 0.f, 0.f, 0.f};
    bf16x8 At[4][2], B0[2][2], B1[2][2];
    u32x4 gc = {voffA[0], voffA[1], voffA[0], voffA[1]};
    if constexpr (GATHER) { PG8_ROWS(cur, 0); PG8_ROWS(cur, 1); gc = *GSLOT(0); }
#define VGC(h, i) (gc[2 * (h) + (i)])
    const char* cA = (const char*)g.A + cur.aofs; const char* cB = (const char*)g.Bt + cur.bofs;
    PG8_STAGE(PG8_SB(0, 0), cB, voffB); PG8_STAGE(PG8_SB(0, 1), cB + hstepB, voffB); PG8_STAGE2(PG8_SA(0, 0), cA, VGC(0, 0), VGC(0, 1)); PG8_STAGE2(PG8_SA(0, 1), cA + hstepA, VGC(1, 0), VGC(1, 1));
    if (wr == 1) PG8_BAR;
    PG8_WAIT_V(2); PG8_BAR;
    PG8_STAGE(PG8_SB(1, 0), cB + kstep, voffB); PG8_STAGE2(PG8_SA(1, 0), cA + kstep, VGC(0, 0), VGC(0, 1)); PG8_STAGE(PG8_SB(1, 1), cB + hstepB + kstep, voffB);
    PG8_WAIT_V(6); PG8_BAR;
    for (;;) {
        const bool has_next = S.next(ui + 1, nxt);
        const char* nA = has_next ? (const char*)g.A + nxt.aofs : cA; const char* nB = has_next ? (const char*)g.Bt + nxt.bofs : cB;
        if constexpr (GATHER) { if (has_next) PG8_ROWS(nxt, 1); else *GSLOT(1) = *GSLOT(0); }
        for (int t = 0; t < nt; t += 2) {
            const bool last = (t == nt - 2);
            const char* a1 = cA + (size_t)(t + 1) * kstep;
            const char* a2 = last ? nA : cA + (size_t)(t + 2) * kstep; const char* b2 = last ? nB : cB + (size_t)(t + 2) * kstep;
            const char* a3 = a2 + kstep; const char* b3 = b2 + kstep;
            u32x4 gn = gc; if constexpr (GATHER) { gc = *GSLOT(0); gn = last ? *GSLOT(1) : gc; }
            const unsigned s00 = gn.x, s01 = gn.y, s10 = gn.z, s11 = gn.w;
            PG8_LDB(B0, 0, 0); PG8_LDB(B1, 0, 1); PG8_SCHED; PG8_LDA(At, 0, 0); PG8_STAGE2(PG8_SA(1, 1), a1 + hstepA, VGC(1, 0), VGC(1, 1));
            PG8_WAIT_V(8); PG8_WAIT_L(0); PG8_BAR; PG8_MMA(0, 0, At, B0); PG8_MMA(0, 1, At, B1); PG8_BAR; PG8_SCHED;
            PG8_LDA(At, 0, 1); PG8_STAGE(PG8_SB(0, 0), b2, voffB); PG8_STAGE(PG8_SB(0, 1), b2 + hstepB, voffB); PG8_STAGE2(PG8_SA(0, 0), a2, s00, s01);
            PG8_WAIT_V(8); PG8_WAIT_L(0); PG8_BAR; PG8_MMA(1, 0, At, B0); PG8_MMA(1, 1, At, B1); PG8_BAR; PG8_SCHED;
            PG8_LDB(B0, 1, 0); PG8_LDB(B1, 1, 1); PG8_SCHED; PG8_LDA(At, 1, 0); PG8_STAGE2(PG8_SA(0, 1), a2 + hstepA, s10, s11);
            PG8_WAIT_V(8); PG8_WAIT_L(0); PG8_BAR; PG8_MMA(0, 0, At, B0); PG8_MMA(0, 1, At, B1); PG8_BAR; PG8_SCHED;
            PG8_LDA(At, 1, 1); PG8_STAGE(PG8_SB(1, 0), b3, voffB); PG8_STAGE(PG8_SB(1, 1), b3 + hstepB, voffB); PG8_STAGE2(PG8_SA(1, 0), a3, s00, s01);
            PG8_WAIT_V(8); PG8_WAIT_L(0); PG8_BAR; PG8_MMA(1, 0, At, B0); PG8_MMA(1, 1, At, B1); PG8_BAR; PG8_SCHED;
        }
        if (wr == 0) PG8_BAR;
        E(acc, cur, wr, wc, fr, fq);
        if (!has_next) break;
#pragma unroll
        for (int a = 0; a < 2; ++a)
#pragma unroll
            for (int b = 0; b < 2; ++b)
#pragma unroll
                for (int m = 0; m < 4; ++m)
#pragma unroll
                    for (int n = 0; n < 2; ++n) acc[a][b][m][n] = (f32x4){0.f, 0.f, 0.f, 0.f};
        cur = nxt; cA = nA; cB = nB; ++ui;
        if constexpr (GATHER) { *GSLOT(0) = *GSLOT(1); }
        if (wr == 1) PG8_BAR;
    }
    PG8_WAIT_V(0);
    PG8_BAR;
#undef PG8_SA
#undef PG8_SB
#undef PG8_STAGE
#undef PG8_STAGE2
#undef PG8_ROWS
#undef GSLOT
#undef VGC
#undef PG8_LDA
#undef PG8_LDB
#undef PG8_MMA
#undef PG8_WAIT_V
#undef PG8_WAIT_L
#undef PG8_BAR
#undef PG8_SCHED
}

typedef const f32x4 (&AccRef)[2][2][4][2];

struct EpiInProj {
    static constexpr bool PERM = true, TRANS = true;
    bf16* P; const float* rstd; float* dt;
    __device__ __forceinline__ void operator()(AccRef acc, const Unit& u, int wr, int wc, int fr, int fq) const {
        const int row0 = u.pm * BM + wr * 64 + fr;
        if (u.pn < 21) {
            const int col0 = u.pn * BM + wc * 32 + 8 * fq;
#pragma unroll
            for (int ai = 0; ai < 2; ++ai)
#pragma unroll
                for (int m = 0; m < 4; ++m) { const int row = row0 + ai * HALF + m * 16; const float s = rstd[row]; bf16* rowp = P + (size_t)row * PLD + col0;
#pragma unroll
                    for (int bj = 0; bj < 2; ++bj) { const f32x4 v0 = acc[ai][bj][m][0] * s, v1 = acc[ai][bj][m][1] * s;
                        u32x4 w; w.x = pk2(v0[0], v0[1]); w.y = pk2(v0[2], v0[3]); w.z = pk2(v1[0], v1[1]); w.w = pk2(v1[2], v1[3]);
                        *(u32x4*)(rowp + bj * HALF) = w; } }
        } else if (wc == 0 && fq == 0) {
#pragma unroll
            for (int ai = 0; ai < 2; ++ai)
#pragma unroll
                for (int m = 0; m < 4; ++m) { const int row = row0 + ai * HALF + m * 16; const float s = rstd[row];
                    *(f32x4*)(dt + (size_t)row * 8) = acc[ai][0][m][0] * s; *(f32x4*)(dt + (size_t)row * 8 + 4) = acc[ai][0][m][1] * s; }
        }
    }
};
struct EpiPlain {
    static constexpr bool PERM = true, TRANS = true;
    bf16* O; int ldc;
    __device__ __forceinline__ void operator()(AccRef acc, const Unit& u, int wr, int wc, int fr, int fq) const {
        const int row0 = u.pm * BM + wr * 64 + fr, col0 = u.pn * BM + wc * 32 + 8 * fq;
#pragma unroll
        for (int ai = 0; ai < 2; ++ai)
#pragma unroll
            for (int m = 0; m < 4; ++m) { bf16* rowp = O + (size_t)(row0 + ai * HALF + m * 16) * ldc + col0;
#pragma unroll
                for (int bj = 0; bj < 2; ++bj) { const f32x4 v0 = acc[ai][bj][m][0], v1 = acc[ai][bj][m][1];
                    u32x4 w; w.x = pk2(v0[0], v0[1]); w.y = pk2(v0[2], v0[3]); w.z = pk2(v1[0], v1[1]); w.w = pk2(v1[2], v1[3]);
                    *(u32x4*)(rowp + bj * HALF) = w; } }
    }
};
struct EpiGateMerge {
    static constexpr bool PERM = true, TRANS = true;
    const bf16* Y; int ldy; bf16* Mg; int ldm; const float* rstd; int first;
    __device__ __forceinline__ void operator()(AccRef acc, const Unit& u, int wr, int wc, int fr, int fq) const {
        const int row0 = u.pm * BM + wr * 64 + fr, col0 = u.pn * BM + wc * 32 + 8 * fq;
#pragma unroll
        for (int ai = 0; ai < 2; ++ai)
#pragma unroll
            for (int m = 0; m < 4; ++m) { const int row = row0 + ai * HALF + m * 16; const float s = rstd[row];
#pragma unroll
                for (int bj = 0; bj < 2; ++bj) { const int c = col0 + bj * HALF;
                    float y[8], o[8]; unpack8(*(const u32x4*)(Y + (size_t)row * ldy + c), y);
                    const f32x4 v0 = acc[ai][bj][m][0] * s, v1 = acc[ai][bj][m][1] * s;
#pragma unroll
                    for (int j = 0; j < 4; ++j) { o[j] = sigm(v0[j]) * y[j]; o[4 + j] = sigm(v1[j]) * y[4 + j]; }
                    if (!first) { float p[8]; unpack8(*(const u32x4*)(Mg + (size_t)row * ldm + c), p);
#pragma unroll
                        for (int j = 0; j < 8; ++j) o[j] += p[j]; }
                    *(u32x4*)(Mg + (size_t)row * ldm + c) = pack8(o); } }
    }
};
struct EpiResid {
    static constexpr bool PERM = false, TRANS = true;
    const float* xin; float* xout; const float* gates; int e;
    __device__ __forceinline__ void operator()(AccRef acc, const Unit& u, int wr, int wc, int fr, int fq) const {
        const int row0 = u.pm * BM + wr * 64 + fr, col0 = u.pn * BM + wc * 32 + 4 * fq;
#pragma unroll
        for (int ai = 0; ai < 2; ++ai)
#pragma unroll
            for (int m = 0; m < 4; ++m) { const int row = row0 + ai * HALF + m * 16; const float s = gates ? gates[(size_t)row * 8 + e] : 1.f;
                const float* ip = xin + (size_t)row * D + col0; float* op = xout + (size_t)row * D + col0;
#pragma unroll
                for (int bj = 0; bj < 2; ++bj)
#pragma unroll
                    for (int n = 0; n < 2; ++n) *(f32x4*)(op + bj * HALF + n * 16) = *(const f32x4*)(ip + bj * HALF + n * 16) + acc[ai][bj][m][n] * s; }
    }
};
struct EpiSwiglu {
    static constexpr bool PERM = true, TRANS = true;
    bf16* act; int ldc; const float* rstd;
    __device__ __forceinline__ void operator()(AccRef acc, const Unit& u, int wr, int wc, int fr, int fq) const {
        asm volatile("" : "+v"(fr), "+v"(fq));
        const int row0 = u.pm * BM + wr * 64 + fr, col0 = u.pn * HALF + wc * 32 + 8 * fq;
#pragma unroll
        for (int ai = 0; ai < 2; ++ai)
#pragma unroll
            for (int m = 0; m < 4; ++m) { const int row = row0 + ai * HALF + m * 16; const int lr = row - u.pm * BM;
                const float s = u.rows ? rstd[(lr < u.nvalid) ? u.rows[2 * lr] : 0] : rstd[row];
                float o[8];
#pragma unroll
                for (int n = 0; n < 2; ++n)
#pragma unroll
                    for (int j = 0; j < 4; ++j) o[4 * n + j] = silu(acc[ai][0][m][n][j] * s) * (acc[ai][1][m][n][j] * s);
                *(u32x4*)(act + (size_t)row * ldc + col0) = pack8(o); }
    }
};
struct EpiMoeDown {
    static constexpr bool PERM = false, TRANS = false;
    float* x;
    __device__ __forceinline__ void operator()(AccRef acc, const Unit& u, int wr, int wc, int fr, int fq) const {
        asm volatile("" : "+v"(fr), "+v"(fq));
        const int col0 = u.pn * BM + wc * 32 + fr;
#pragma unroll
        for (int ai = 0; ai < 2; ++ai)
#pragma unroll
            for (int m = 0; m < 4; ++m) { asm volatile("" ::: "memory");
#pragma unroll
                for (int j = 0; j < 4; ++j) { const int lr = ai * HALF + wr * 64 + m * 16 + 4 * fq + j;
                    if (lr < u.nvalid) { const int tok = u.rows[2 * lr]; const float wgt = __builtin_bit_cast(float, u.rows[2 * lr + 1]); float* xp = x + (size_t)tok * D + col0;
#pragma unroll
                        for (int bj = 0; bj < 2; ++bj)
#pragma unroll
                            for (int n = 0; n < 2; ++n) atomicAdd(xp + bj * HALF + n * 16, wgt * acc[ai][bj][m][n][j]); } } }
    }
};
}

#define XB_TMO      128
#define XB_XCNT(j)  (256  + 64 * (j))
#define XB_XSUB(j)  (1280 + 64 * (j))
#define XB_XGEN(j)  (2304 + 64 * (j))
#define XB_TOP      3328
#define XB_TOPGEN   3392
#define XCD_BAR_WORDS 3456
#define XB_SPIN_CAP (1u << 18)

__device__ __forceinline__ unsigned xb_ld(unsigned* p)              { return __hip_atomic_load(p, __ATOMIC_RELAXED, __HIP_MEMORY_SCOPE_AGENT); }
__device__ __forceinline__ unsigned xb_add(unsigned* p, unsigned v) { return __hip_atomic_fetch_add(p, v, __ATOMIC_RELAXED, __HIP_MEMORY_SCOPE_AGENT); }
__device__ __forceinline__ unsigned xb_xcc_id() { return (unsigned)__builtin_amdgcn_s_getreg((3 << 11) | 20) & 0xFu; }
#define XB_SPIN(cond, bar) do { unsigned _sp = 0; while (cond) { __builtin_amdgcn_s_sleep(1); \
    if ((++_sp & 255u) == 0u) { if (xb_ld(&(bar)[XB_TMO])) break; if (_sp > XB_SPIN_CAP) { atomicAdd(&(bar)[XB_TMO], 1u); break; } } } } while (0)

struct XcdBarrier { unsigned* bar; unsigned x; volatile LAS unsigned* st; };

__device__ __forceinline__ XcdBarrier xcd_barrier_post(unsigned* bar, volatile LAS unsigned* st) {
    XcdBarrier b; b.bar = bar; b.x = xb_xcc_id(); b.st = st;
    if (threadIdx.x == 0) (void)xb_add(&bar[XB_XCNT(b.x)], 1u);
    return b;
}
__device__ __forceinline__ void xcd_barrier_complete(unsigned* bar, unsigned x, unsigned& nloc, unsigned& nx) {
    const unsigned G = gridDim.x * gridDim.y * gridDim.z;
    unsigned sum, cnt, mine, sp = 0u;
    for (;;) {
        sum = 0u; cnt = 0u; mine = 0u;
#pragma unroll
        for (unsigned j = 0; j < 16; ++j) { const unsigned c = xb_ld(&bar[XB_XCNT(j)]); sum += c; cnt += (c > 0u) ? 1u : 0u; mine = (j == x) ? c : mine; }
        if (sum == G) break;
        __builtin_amdgcn_s_sleep(1);
        if ((++sp & 255u) == 0u) { if (xb_ld(&bar[XB_TMO])) break; if (sp > XB_SPIN_CAP) { atomicAdd(&bar[XB_TMO], 1u); break; } }
    }
    nloc = mine > 0u ? mine : 1u; nx = cnt > 0u ? cnt : 1u;
}
__device__ __forceinline__ void xcd_barrier(const XcdBarrier& b) {
    asm volatile("s_waitcnt vmcnt(0)" ::: "memory");
    __syncthreads();
    if (threadIdx.x == 0) {
        unsigned* bar = b.bar;
        __builtin_amdgcn_s_waitcnt(0);
        unsigned nloc = b.st[0], nx = b.st[1];
        if (nloc == 0u) { xcd_barrier_complete(bar, b.x, nloc, nx); b.st[0] = nloc; b.st[1] = nx; }
        const unsigned old = xb_add(&bar[XB_XSUB(b.x)], 1u);
        const unsigned gen = old / nloc;
        if (old + 1u == (gen + 1u) * nloc) {
            __builtin_amdgcn_fence(__ATOMIC_RELEASE, "agent");
            asm volatile("s_waitcnt vmcnt(0)" ::: "memory");
            const unsigned og = xb_add(&bar[XB_TOP], 1u);
            const unsigned tg = og / nx;
            if (og + 1u == (tg + 1u) * nx) xb_add(&bar[XB_TOPGEN], 1u);
            else XB_SPIN(xb_ld(&bar[XB_TOPGEN]) == tg, bar);
            __builtin_amdgcn_fence(__ATOMIC_ACQUIRE, "agent");
            xb_add(&bar[XB_XGEN(b.x)], 1u);
            asm volatile("s_waitcnt vmcnt(0)" ::: "memory");
        } else {
            XB_SPIN(xb_ld(&bar[XB_XGEN(b.x)]) == gen, bar);
            __builtin_amdgcn_fence(__ATOMIC_ACQUIRE, "agent");
            asm volatile("s_waitcnt vmcnt(0)" ::: "memory");
        }
    }
    __syncthreads();
}

struct Args { const float* in[34]; float* out; unsigned char* ws; int ph_lo, ph_hi; };
struct Frame {
    LAS unsigned char* lds;
    int vcu, G, cid, wid;
    float* out; unsigned char* ws;
};
__device__ __forceinline__ const float* inptr(LAS unsigned char* lds, int i) {
    int off = LDSCTL_OFF + 8 * i; asm volatile("" : "+v"(off));
    const LAS unsigned* p = (const LAS unsigned*)(lds + off);
    const unsigned lo = __builtin_amdgcn_readfirstlane(p[0]), hi = __builtin_amdgcn_readfirstlane(p[1]);
    return (const float*)(((unsigned long long)hi << 32) | lo);
}
#define INP(i) inptr(F.lds, (i))

__device__ __forceinline__ void conv_item(const float* W, int ld, int k0, int c0, int nvalid, const float* scale, bf16* dst, int K, int drow0, LAS float* scr, int lane) {
    const int n = lane & 31;
#pragma unroll 8
    for (int i = 0; i < 32; ++i) { const int kk = 2 * i + (lane >> 5);
        float v = 0.f; if (n < nvalid) { v = W[(size_t)(k0 + kk) * ld + c0 + n]; if (scale) v *= scale[k0 + kk]; }
        scr[kk * 33 + n] = v; }
    LDS_WAIT(); asm volatile("" ::: "memory");
    const int c = lane & 7;
#pragma unroll
    for (int j = 0; j < 4; ++j) { const int nn = (lane >> 3) + 8 * j; const LAS float* s = scr + (8 * c) * 33 + nn;
        u32x4 o; o.x = pk2(s[0 * 33], s[1 * 33]); o.y = pk2(s[2 * 33], s[3 * 33]); o.z = pk2(s[4 * 33], s[5 * 33]); o.w = pk2(s[6 * 33], s[7 * 33]);
        *(u32x4*)(dst + (size_t)(drow0 + nn) * K + k0 + 8 * c) = o; }
    LDS_WAIT(); asm volatile("" ::: "memory");
}
__device__ __forceinline__ void conv_seg(Frame& F, const float* W, int ld, int K, int c0, int nvalid, int ntotal, const float* scale, bf16* dst, int r0, int blk, int blks) {
    const int ptid = otid(), plane = ptid & 63, pwave = __builtin_amdgcn_readfirstlane(ptid >> 6); (void)plane; (void)pwave;
    LAS float* scr = (LAS float*)(F.lds + pwave * 16384);
    const int gw = F.vcu * 8 + pwave, NGW = F.G * 8;
    const int nblk = ntotal / 32, nitems = (K / 64) * nblk;
    for (int it = gw; it < nitems; it += NGW) {
        const int kb = it / nblk, nb = it % nblk, n0 = nb * 32;
        int nv = nvalid - n0; nv = nv < 0 ? 0 : (nv > 32 ? 32 : nv);
        conv_item(W, ld, kb * 64, c0 + n0, nv, scale, dst, K, r0 + (n0 / blk) * blks + (n0 % blk), scr, plane);
    }
}
__device__ __forceinline__ void conv_layer_weights(Frame& F, int l) {
    unsigned char* wl = F.ws + WS_W + (size_t)l * WL_STRIDE;
    const float* win = INP(2) + (size_t)l * D * INC; const float* n1 = INP(1) + l * D;
    const int BIGB = 1 << 30;
    conv_seg(F, win, INC, D, 0, 3328, 3328, n1, (bf16*)(wl + WL_IN), 0, BIGB, 0);
    conv_seg(F, win, INC, D, 3336, 2048, 2048, n1, (bf16*)(wl + WL_IN), 3328, BIGB, 0);
    conv_seg(F, win, INC, D, 3328, 8, 256, n1, (bf16*)(wl + WL_IN), 5376, BIGB, 0);
    conv_seg(F, win, INC, D, 5384, 3072, 3072, n1, (bf16*)(wl + WL_GATE), 0, BIGB, 0);
    for (int i = 0; i < 3; ++i)
        conv_seg(F, INP(23) + ((size_t)l * 3 + i) * 512 * D, D, 512, 0, D, D, nullptr, (bf16*)(wl + WL_BR) + (size_t)i * D * 512, 0, BIGB, 0);
    conv_seg(F, INP(24) + (size_t)l * D * D, D, D, 0, D, D, nullptr, (bf16*)(wl + WL_OUT), 0, BIGB, 0);
}
__device__ __forceinline__ void conv_ffn_weights(Frame& F) {
    const float* n2 = INP(25);
    conv_seg(F, INP(26), FF, D, 0, FF, FF, n2, (bf16*)(F.ws + WS_FFUP), 0, 128, 256);
    conv_seg(F, INP(27), FF, D, 0, FF, FF, n2, (bf16*)(F.ws + WS_FFUP), 128, 128, 256);
    conv_seg(F, INP(28), D, FF, 0, D, D, nullptr, (bf16*)(F.ws + WS_FFDN), 0, 1 << 30, 0);
}
__device__ __forceinline__ void conv_moe_weights(Frame& F) {
    const float* n2 = INP(25) + D;
    for (int e = 0; e < NE; ++e) {
        bf16* up = (bf16*)(F.ws + WS_MOEW + (size_t)e * MOEW_STRIDE); bf16* dn = (bf16*)(F.ws + WS_MOEW + (size_t)e * MOEW_STRIDE + MOEW_DN);
        conv_seg(F, INP(30) + (size_t)e * D * FFE, FFE, D, 0, FFE, FFE, n2, up, 0, 128, 256);
        conv_seg(F, INP(31) + (size_t)e * D * FFE, FFE, D, 0, FFE, FFE, n2, up, 128, 128, 256);
        conv_seg(F, INP(32) + (size_t)e * FFE * D, D, FFE, 0, D, D, nullptr, dn, 0, 1 << 30, 0);
    }
}

__device__ __forceinline__ void xprep_phase(Frame& F, const float* x) {
    const int ptid = otid(), plane = ptid & 63, pwave = __builtin_amdgcn_readfirstlane(ptid >> 6); (void)plane; (void)pwave;
    const int gw = F.vcu * 8 + pwave, NGW = F.G * 8;
    bf16* xb = (bf16*)(F.ws + WS_XB); float* rstd = (float*)(F.ws + WS_RSTD);
    for (int m = gw; m < M; m += NGW) {
        const f32x4* xr = (const f32x4*)(x + (size_t)m * D) + plane;
        f32x4 v[4]; float s = 0.f;
#pragma unroll
        for (int j = 0; j < 4; ++j) { v[j] = xr[64 * j]; s += (v[j].x * v[j].x + v[j].y * v[j].y) + (v[j].z * v[j].z + v[j].w * v[j].w); }
        s = wave_sum(s);
        if (plane == 0) rstd[m] = 1.f / sqrtf(s * (1.f / D) + 1e-6f);
        u32x2* o8 = (u32x2*)(xb + (size_t)m * D) + plane;
#pragma unroll
        for (int j = 0; j < 4; ++j) { u32x2 w; w.x = pk2(v[j].x, v[j].y); w.y = pk2(v[j].z, v[j].w); o8[64 * j] = w; }
    }
}
__device__ __forceinline__ void final_norm_phase(Frame& F) {
    const int ptid = otid(), plane = ptid & 63, pwave = __builtin_amdgcn_readfirstlane(ptid >> 6); (void)plane; (void)pwave;
    const int gw = F.vcu * 8 + pwave, NGW = F.G * 8;
    const float* fw = INP(33);
    for (int m = gw; m < M; m += NGW) {
        f32x4* xr = (f32x4*)(F.out + (size_t)m * D) + plane;
        f32x4 v[4]; float s = 0.f;
#pragma unroll
        for (int j = 0; j < 4; ++j) { v[j] = xr[64 * j]; s += (v[j].x * v[j].x + v[j].y * v[j].y) + (v[j].z * v[j].z + v[j].w * v[j].w); }
        s = wave_sum(s);
        const float r = 1.f / sqrtf(s * (1.f / D) + 1e-6f);
#pragma unroll
        for (int j = 0; j < 4; ++j) { const f32x4 w = *((const f32x4*)fw + plane + 64 * j); xr[64 * j] = v[j] * r * w; }
    }
}
__device__ __forceinline__ void router_phase(Frame& F) {
    const int ptid = otid(), plane = ptid & 63, pwave = __builtin_amdgcn_readfirstlane(ptid >> 6);
    const float* nw = INP(25) + D; const float* rt = INP(29); const float* rstd = (const float*)(F.ws + WS_RSTD);
    int* cnt = (int*)(F.ws + WS_CNT); int* list2 = (int*)(F.ws + WS_LIST);
    LAS int* lsel = (LAS int*)F.lds;
    LAS float* lwt = (LAS float*)(F.lds + 1024);
    LAS int* lrank = (LAS int*)(F.lds + 2048);
    LAS int* lcnt = (LAS int*)(F.lds + 3072);
    for (int blk = F.vcu; blk < M / 128; blk += F.G) {
        if (ptid < 16) lcnt[ptid] = 0;
        __syncthreads();
        for (int k = 0; k < 16; ++k) {
            const int lt = pwave * 16 + k, m = blk * 128 + lt;
            float acc[8];
#pragma unroll
            for (int e = 0; e < 8; ++e) acc[e] = 0.f;
            const float* xr = F.out + (size_t)m * D;
#pragma unroll 4
            for (int j = 0; j < 16; ++j) { const int kk = plane + 64 * j; const float xv = xr[kk] * nw[kk];
                const f32x4 r0v = *(const f32x4*)(rt + (size_t)kk * 8), r1v = *(const f32x4*)(rt + (size_t)kk * 8 + 4);
                acc[0] += xv * r0v.x; acc[1] += xv * r0v.y; acc[2] += xv * r0v.z; acc[3] += xv * r0v.w; acc[4] += xv * r1v.x; acc[5] += xv * r1v.y; acc[6] += xv * r1v.z; acc[7] += xv * r1v.w; }
            const float sc = rstd[m];
#pragma unroll
            for (int e = 0; e < 8; ++e) acc[e] = wave_sum(acc[e]) * sc;
            int i0 = 0; float v0 = acc[0];
#pragma unroll
            for (int e = 1; e < 8; ++e) if (acc[e] > v0) { v0 = acc[e]; i0 = e; }
            int i1 = -1; float v1 = -3.0e38f;
#pragma unroll
            for (int e = 0; e < 8; ++e) if (e != i0 && acc[e] > v1) { v1 = acc[e]; i1 = e; }
            const float e1 = expf(v1 - v0), w0 = 1.f / (1.f + e1), w1 = e1 / (1.f + e1);
            if (plane == 0) { lsel[2 * lt] = i0; lsel[2 * lt + 1] = i1; lwt[2 * lt] = w0; lwt[2 * lt + 1] = w1;
                lrank[2 * lt] = atomicAdd((int*)(lcnt + i0), 1); lrank[2 * lt + 1] = atomicAdd((int*)(lcnt + i1), 1); }
        }
        __syncthreads();
        if (ptid < 8) lcnt[8 + ptid] = atomicAdd(cnt + ptid, lcnt[ptid]);
        __syncthreads();
        if (ptid < 256) { const int e = lsel[ptid], slot = lcnt[8 + e] + lrank[ptid];
            u32x2 v; v.x = (unsigned)(blk * 128 + (ptid >> 1)); v.y = __builtin_bit_cast(unsigned, lwt[ptid]);
            *(u32x2*)(list2 + ((size_t)e * 32768 + slot) * 2) = v; }
        __syncthreads();
    }
}

__device__ __forceinline__ void vprep_phase(Frame& F, int layer) {
    const int ptid = otid(), plane = ptid & 63, pwave = __builtin_amdgcn_readfirstlane(ptid >> 6); (void)plane; (void)pwave;
    LAS float* vt = (LAS float*)F.lds;
    LAS float* vd = vt + 32 * 516;
    const bf16* P = (const bf16*)(F.ws + WS_BIG); bf16* VF = (bf16*)(F.ws + WS_VF); bf16* VM = (bf16*)(F.ws + WS_VMIX);
    const float* mu = INP(3) + layer * 1792 + 1024;
    const int tok = ptid >> 4, part = ptid & 15;
    for (int it = F.vcu; it < M / 32; it += F.G) {
        const int m = it * 32 + tok; const int t = m & (T - 1);
        const bf16* cur = P + (size_t)m * PLD + 1024 + part * 32;
        float xm[32];
#pragma unroll
        for (int q = 0; q < 4; ++q) { float c[8], p[8]; unpack8(*(const u32x4*)(cur + q * 8), c);
            if (t > 0) unpack8(*(const u32x4*)(cur - PLD + q * 8), p); else {
#pragma unroll
                for (int e = 0; e < 8; ++e) p[e] = 0.f; }
#pragma unroll
            for (int e = 0; e < 8; ++e) xm[q * 8 + e] = c[e] + (p[e] - c[e]) * mu[part * 32 + q * 8 + e]; }
        if (layer == 0) {
#pragma unroll
            for (int q = 0; q < 4; ++q) { float o[8];
#pragma unroll
                for (int e = 0; e < 8; ++e) o[e] = xm[q * 8 + e];
                *(u32x4*)(VF + (size_t)m * 512 + part * 32 + q * 8) = pack8(o); }
        } else {
            const float* vdn = INP(14); const float* vup = INP(15); const float* v0 = INP(16);
#pragma unroll
            for (int e = 0; e < 32; ++e) vt[tok * 516 + part * 32 + e] = xm[e];
            __syncthreads();
            { float a0 = 0.f, a1 = 0.f; const int j = part * 2;
                for (int c = 0; c < 512; ++c) { const float v = vt[tok * 516 + c]; a0 += v * vdn[c * 32 + j]; a1 += v * vdn[c * 32 + j + 1]; }
                vd[tok * 33 + j] = a0; vd[tok * 33 + j + 1] = a1; }
            __syncthreads();
            float g[32];
#pragma unroll
            for (int e = 0; e < 32; ++e) g[e] = v0[part * 32 + e];
            for (int j = 0; j < 32; ++j) { const float d = vd[tok * 33 + j];
#pragma unroll
                for (int e = 0; e < 32; ++e) g[e] += d * vup[j * 512 + part * 32 + e]; }
#pragma unroll
            for (int q = 0; q < 4; ++q) { float vf[8], o[8]; unpack8(*(const u32x4*)(VF + (size_t)m * 512 + part * 32 + q * 8), vf);
#pragma unroll
                for (int e = 0; e < 8; ++e) { const float v = xm[q * 8 + e]; o[e] = v + (vf[e] - v) * sigm(g[q * 8 + e]); }
                *(u32x4*)(VM + (size_t)m * 512 + part * 32 + q * 8) = pack8(o); }
            __syncthreads();
        }
    }
}

__device__ __forceinline__ float red8(float v) { v += __shfl_xor(v, 1); v += __shfl_xor(v, 2); v += __shfl_xor(v, 4); return v; }
__device__ __forceinline__ float red16(float v) { v = red8(v); v += __shfl_xor(v, 8); return v; }

__device__ __forceinline__ void rwkv_seq(Frame& F, int layer, int bh) {
    const int ptid = otid(), plane = ptid & 63, pwave = __builtin_amdgcn_readfirstlane(ptid >> 6); (void)plane; (void)pwave;
    const int b = bh >> 3, h = bh & 7;
    LAS float* L = (LAS float*)F.lds;
    LAS float *rr = L, *ww = L + 2048, *kf = L + 4096, *vv = L + 6144, *aa = L + 8192, *bb = L + 10240, *gg = L + 12288, *yy = L + 14336, *tw = L + 16384, *xa = L + 18432, *sg = L + 20480, *bon = L + 24576;
    const float* mu = INP(3) + layer * 1792; const float* w_up = INP(4) + layer * 64 * 512; const float* w0 = INP(5) + layer * 512;
    const float* a_up = INP(6) + layer * 64 * 512; const float* a0 = INP(7) + layer * 512; const float* g_up = INP(8) + layer * 128 * 512;
    const float* k_k = INP(9) + layer * 512; const float* k_a = INP(10) + layer * 512; const float* r_k = INP(11) + layer * 512;
    const float* gn_w = INP(12) + layer * 512; const float* gn_b = INP(13) + layer * 512;
    const bf16* P = (const bf16*)(F.ws + WS_BIG); const bf16* vsrc = (const bf16*)(F.ws + (layer == 0 ? WS_VF : WS_VMIX)); bf16* yout = (bf16*)(F.ws + WS_YRW);
    const int tid = ptid, tok = tid >> 4, part = tid & 15, c4 = part * 4, cb = h * 64 + c4;
    const int srow = tid >> 3, sc0 = (tid & 7) * 8;
    float S[8];
#pragma unroll
    for (int j = 0; j < 8; ++j) S[j] = 0.f;
    for (int t0 = 0; t0 < T; t0 += 32) {
        {
            const int t = t0 + tok; const size_t m = (size_t)b * T + t;
            const bf16* cur = P + m * PLD;
#pragma unroll
            for (int q = 0; q < 3; ++q) {
                const int ch = part + 16 * q; int col, kind; LAS float* dst;
                if (ch < 8) { col = h * 64 + ch * 8; dst = rr + tok * 64 + ch * 8; kind = 0; }
                else if (ch < 16) { col = 512 + h * 64 + (ch - 8) * 8; dst = kf + tok * 64 + (ch - 8) * 8; kind = 0; }
                else if (ch < 24) { col = 1536 + (ch - 16) * 8; dst = tw + tok * 64 + (ch - 16) * 8; kind = 1; }
                else if (ch < 32) { col = 1600 + (ch - 24) * 8; dst = xa + tok * 64 + (ch - 24) * 8; kind = 0; }
                else { col = 1664 + (ch - 32) * 8; dst = sg + tok * 128 + (ch - 32) * 8; kind = 2; }
                float c[8], p[8]; unpack8(*(const u32x4*)(cur + col), c);
                if (t > 0) unpack8(*(const u32x4*)(cur - PLD + col), p); else {
#pragma unroll
                    for (int e = 0; e < 8; ++e) p[e] = 0.f; }
#pragma unroll
                for (int e = 0; e < 8; ++e) { float x = c[e] + (p[e] - c[e]) * mu[col + e]; if (kind == 1) x = tanhf(x); else if (kind == 2) x = sigm(x); dst[e] = x; }
            }
            if (part < 8) { float v[8]; unpack8(*(const u32x4*)(vsrc + m * 512 + h * 64 + part * 8), v);
#pragma unroll
                for (int e = 0; e < 8; ++e) vv[tok * 64 + part * 8 + e] = v[e]; }
        }
        __syncthreads();
        {
            f32x4 dw = *(const f32x4*)(w0 + cb), da = *(const f32x4*)(a0 + cb), dg = (f32x4){0.f, 0.f, 0.f, 0.f};
            for (int j = 0; j < 64; ++j) { const float tj = tw[tok * 64 + j], xj = xa[tok * 64 + j];
                dw += *(const f32x4*)(w_up + j * 512 + cb) * tj; da += *(const f32x4*)(a_up + j * 512 + cb) * xj; }
            for (int j = 0; j < 128; ++j) dg += *(const f32x4*)(g_up + j * 512 + cb) * sg[tok * 128 + j];
            float kr[4], kk[4], av[4], ss = 0.f;
#pragma unroll
            for (int e = 0; e < 4; ++e) { kr[e] = kf[tok * 64 + c4 + e]; kk[e] = kr[e] * k_k[cb + e]; ss += kk[e] * kk[e]; av[e] = sigm(da[e]); }
            ss = red16(ss);
            const float inv = 1.f / sqrtf(fmaxf(ss, 1e-24f));
            float bs = 0.f;
#pragma unroll
            for (int e = 0; e < 4; ++e) { const float kn = kk[e] * inv; const int o = tok * 64 + c4 + e;
                const float ld = -expf(-softplus_acc(-dw[e]) - 0.5f);
                ww[o] = expf(ld); aa[o] = -kn; bb[o] = kn * av[e];
                const float knew = kr[e] * (1.f + (av[e] - 1.f) * k_a[cb + e]); kf[o] = knew; gg[o] = dg[e];
                bs += rr[o] * knew * r_k[cb + e]; }
            bs = red16(bs);
            if (part == 0) bon[tok] = bs;
        }
        __syncthreads();
        for (int s = 0; s < 32; ++s) {
            const f32x4 a0v = *(const LAS f32x4*)(aa + s * 64 + sc0), a1v = *(const LAS f32x4*)(aa + s * 64 + sc0 + 4);
            const f32x4 w0v = *(const LAS f32x4*)(ww + s * 64 + sc0), w1v = *(const LAS f32x4*)(ww + s * 64 + sc0 + 4);
            const f32x4 b0v = *(const LAS f32x4*)(bb + s * 64 + sc0), b1v = *(const LAS f32x4*)(bb + s * 64 + sc0 + 4);
            const f32x4 k0v = *(const LAS f32x4*)(kf + s * 64 + sc0), k1v = *(const LAS f32x4*)(kf + s * 64 + sc0 + 4);
            const f32x4 r0v = *(const LAS f32x4*)(rr + s * 64 + sc0), r1v = *(const LAS f32x4*)(rr + s * 64 + sc0 + 4);
            const float vi = vv[s * 64 + srow];
            float sa = 0.f;
#pragma unroll
            for (int j = 0; j < 4; ++j) sa += S[j] * a0v[j] + S[4 + j] * a1v[j];
            sa = red8(sa);
            float y = 0.f;
#pragma unroll
            for (int j = 0; j < 4; ++j) { S[j] = S[j] * w0v[j] + sa * b0v[j] + vi * k0v[j]; S[4 + j] = S[4 + j] * w1v[j] + sa * b1v[j] + vi * k1v[j]; y += S[j] * r0v[j] + S[4 + j] * r1v[j]; }
            y = red8(y);
            if ((tid & 7) == 0) yy[s * 64 + srow] = y;
        }
        __syncthreads();
        {
            const size_t m = (size_t)b * T + t0 + tok;
            float y[4], sm = 0.f;
#pragma unroll
            for (int e = 0; e < 4; ++e) { y[e] = yy[tok * 64 + c4 + e]; sm += y[e]; }
            const float mean = red16(sm) * (1.f / 64.f);
            float vs = 0.f;
#pragma unroll
            for (int e = 0; e < 4; ++e) { y[e] -= mean; vs += y[e] * y[e]; }
            const float rs = 1.f / sqrtf(red16(vs) * (1.f / 64.f) + 64e-5f);
            const float bo = bon[tok];
            float o[4];
#pragma unroll
            for (int e = 0; e < 4; ++e) { const int idx = tok * 64 + c4 + e; o[e] = (y[e] * rs * gn_w[cb + e] + gn_b[cb + e] + bo * vv[idx]) * gg[idx]; }
            u32x2 w; w.x = pk2(o[0], o[1]); w.y = pk2(o[2], o[3]);
            *(u32x2*)(yout + m * 512 + cb) = w;
        }
        __syncthreads();
    }
}

__device__ __forceinline__ void ret_seq(Frame& F, int bh) {
    const int ptid = otid(), plane = ptid & 63, pwave = __builtin_amdgcn_readfirstlane(ptid >> 6); (void)plane; (void)pwave;
    const int b = bh >> 3, h = bh & 7;
    LAS float* L = (LAS float*)F.lds;
    LAS float *qq = L, *kk = L + 2048, *vv = L + 4096, *gg = L + 6144, *yy = L + 8192;
    bf16* P = (bf16*)(F.ws + WS_BIG);
    const int tid = ptid, tok = tid >> 4, part = tid & 15, c4 = part * 4;
    const int se = tid >> 3, sd0 = (tid & 7) * 8;
    const float gamma = 1.f - exp2f(-5.f - (float)h);
    float S[8];
#pragma unroll
    for (int j = 0; j < 8; ++j) S[j] = 0.f;
    for (int t0 = 0; t0 < T; t0 += 32) {
        {
            const int t = t0 + tok; const size_t m = (size_t)b * T + t;
#pragma unroll
            for (int q = 0; q < 2; ++q) {
                const int ch = part + 16 * q, kind = ch >> 3, cc = ch & 7;
                float x[8]; unpack8(*(const u32x4*)(P + m * PLD + C_RET + kind * 512 + h * 64 + cc * 8), x);
                LAS float* dst = (kind == 0 ? qq : kind == 1 ? kk : kind == 2 ? vv : gg) + tok * 64 + cc * 8;
                if (kind < 2) {
#pragma unroll
                    for (int p = 0; p < 4; ++p) { const int i = cc * 4 + p;
                        const double invf = exp(-(double)i * (9.210340371976184 / 32.0));
                        double sn, cs; sincos((double)t * invf, &sn, &cs);
                        const float x0 = x[2 * p], x1 = x[2 * p + 1], c = (float)cs, s = (float)sn;
                        float o0 = x0 * c - x1 * s, o1 = x0 * s + x1 * c;
                        if (kind == 1) { o0 *= 0.125f; o1 *= 0.125f; }
                        dst[2 * p] = o0; dst[2 * p + 1] = o1; }
                } else {
#pragma unroll
                    for (int e = 0; e < 8; ++e) dst[e] = x[e];
                }
            }
        }
        __syncthreads();
        for (int s = 0; s < 32; ++s) {
            const f32x4 k0v = *(const LAS f32x4*)(kk + s * 64 + sd0), k1v = *(const LAS f32x4*)(kk + s * 64 + sd0 + 4);
            const f32x4 q0v = *(const LAS f32x4*)(qq + s * 64 + sd0), q1v = *(const LAS f32x4*)(qq + s * 64 + sd0 + 4);
            const float ve = vv[s * 64 + se];
            float y = 0.f;
#pragma unroll
            for (int j = 0; j < 4; ++j) { S[j] = gamma * S[j] + k0v[j] * ve; S[4 + j] = gamma * S[4 + j] + k1v[j] * ve; y += q0v[j] * S[j] + q1v[j] * S[4 + j]; }
            y = red8(y);
            if ((tid & 7) == 0) yy[s * 64 + se] = y;
        }
        __syncthreads();
        {
            const size_t m = (size_t)b * T + t0 + tok;
            float y[4], ss = 0.f;
#pragma unroll
            for (int e = 0; e < 4; ++e) { y[e] = yy[tok * 64 + c4 + e]; ss += y[e] * y[e]; }
            const float rs = 1.f / sqrtf(red16(ss) * (1.f / 64.f) + 1e-6f);
            float o[4];
#pragma unroll
            for (int e = 0; e < 4; ++e) o[e] = y[e] * rs * silu(gg[tok * 64 + c4 + e]);
            u32x2 w; w.x = pk2(o[0], o[1]); w.y = pk2(o[2], o[3]);
            *(u32x2*)(P + m * PLD + C_RETG + h * 64 + c4) = w;
        }
        __syncthreads();
    }
}

__device__ __forceinline__ void ssd_seq(Frame& F, int layer, int bh) {
    const int ptid = otid(), plane = ptid & 63, pwave = __builtin_amdgcn_readfirstlane(ptid >> 6); (void)plane; (void)pwave;
    const int b = bh >> 3, h = bh & 7, g = h >> 2;
    LAS float* L = (LAS float*)F.lds;
    LAS float *raw = L  , *xs = L + 11200, *Bc = L + 13248, *Cc = L + 17344, *yy = L + 21440, *dts = L + 23488, *das = L + 23520;
    bf16* P = (bf16*)(F.ws + WS_BIG); const float* dtb = (const float*)(F.ws + WS_DT);
    const float* cw = INP(17) + layer * 1024 * 4; const float* cbias = INP(18) + layer * 1024;
    const float dt_bias = INP(19)[layer * 8 + h], A = -expf(INP(20)[layer * 8 + h]), Dh = INP(21)[layer * 8 + h];
    const int tid = ptid;
    const int sp = tid >> 3, sn0 = (tid & 7) * 16;
    float S[16];
#pragma unroll
    for (int j = 0; j < 16; ++j) S[j] = 0.f;
    for (int i = tid; i < 3 * 320; i += 512) raw[i] = 0.f;
    __syncthreads();
    for (int t0 = 0; t0 < T; t0 += 32) {
        for (int idx = tid; idx < 32 * 40; idx += 512) {
            const int row = idx / 40, ch = idx % 40; const size_t m = (size_t)b * T + t0 + row;
            const int col = ch < 8 ? (C_XBC + h * 64 + ch * 8) : (ch < 24 ? (C_XBC + 512 + g * 128 + (ch - 8) * 8) : (C_XBC + 768 + g * 128 + (ch - 24) * 8));
            float x[8]; unpack8(*(const u32x4*)(P + m * PLD + col), x);
#pragma unroll
            for (int e = 0; e < 8; ++e) raw[(3 + row) * 320 + ch * 8 + e] = x[e];
        }
        if (tid < 32) { const size_t m = (size_t)b * T + t0 + tid; const float dt = softplus_acc(dtb[m * 8 + h] + dt_bias); dts[tid] = dt; das[tid] = expf(A * dt); }
        __syncthreads();
        for (int idx = tid; idx < 32 * 320; idx += 512) {
            const int row = idx / 320, c = idx % 320;
            const int chn = c < 64 ? (h * 64 + c) : (c < 192 ? (512 + g * 128 + (c - 64)) : (768 + g * 128 + (c - 192)));
            float a = cbias[chn];
#pragma unroll
            for (int k = 0; k < 4; ++k) a += cw[chn * 4 + k] * raw[(row + k) * 320 + c];
            a = silu(a);
            if (c < 64) xs[row * 64 + c] = a; else if (c < 192) Bc[row * 128 + (c - 64)] = a; else Cc[row * 128 + (c - 192)] = a;
        }
        __syncthreads();
        for (int s = 0; s < 32; ++s) {
            const float da = das[s], xv = xs[s * 64 + sp], dtx = dts[s] * xv;
            float y = 0.f;
#pragma unroll
            for (int q = 0; q < 4; ++q) { const f32x4 bv = *(const LAS f32x4*)(Bc + s * 128 + sn0 + q * 4), cv = *(const LAS f32x4*)(Cc + s * 128 + sn0 + q * 4);
#pragma unroll
                for (int j = 0; j < 4; ++j) { S[q * 4 + j] = da * S[q * 4 + j] + dtx * bv[j]; y += S[q * 4 + j] * cv[j]; } }
            y = red8(y);
            if ((tid & 7) == 0) yy[s * 64 + sp] = y + Dh * xv;
        }
        __syncthreads();
        {
            const int tok = tid >> 4, c4 = (tid & 15) * 4; const size_t m = (size_t)b * T + t0 + tok;
            u32x2 w; w.x = pk2(yy[tok * 64 + c4], yy[tok * 64 + c4 + 1]); w.y = pk2(yy[tok * 64 + c4 + 2], yy[tok * 64 + c4 + 3]);
            *(u32x2*)(P + m * PLD + C_XBC + h * 64 + c4) = w;
            for (int i = tid; i < 3 * 320; i += 512) raw[i] = raw[32 * 320 + i];
        }
        __syncthreads();
    }
}
__device__ __forceinline__ void ssm_norm_phase(Frame& F, int layer) {
    const int ptid = otid(), plane = ptid & 63, pwave = __builtin_amdgcn_readfirstlane(ptid >> 6); (void)plane; (void)pwave;
    const int gw = F.vcu * 8 + pwave, NGW = F.G * 8;
    bf16* P = (bf16*)(F.ws + WS_BIG); const float* nw = INP(22) + layer * 512;
    for (int m = gw; m < M; m += NGW) {
        float y[8], z[8]; unpack8(*(const u32x4*)(P + (size_t)m * PLD + C_XBC + plane * 8), y); unpack8(*(const u32x4*)(P + (size_t)m * PLD + C_Z + plane * 8), z);
        float ss = 0.f;
#pragma unroll
        for (int e = 0; e < 8; ++e) { y[e] *= silu(z[e]); ss += y[e] * y[e]; }
        ss += __shfl_xor(ss, 1); ss += __shfl_xor(ss, 2); ss += __shfl_xor(ss, 4); ss += __shfl_xor(ss, 8); ss += __shfl_xor(ss, 16);
        const float rs = 1.f / sqrtf(ss * (1.f / 256.f) + 1e-6f);
#pragma unroll
        for (int e = 0; e < 8; ++e) y[e] *= rs * nw[plane * 8 + e];
        *(u32x4*)(P + (size_t)m * PLD + C_Z + plane * 8) = pack8(y);
    }
}

constexpr int PT = 72, PT2 = 136, PF = 68;
__device__ __forceinline__ f32x4 mfma16(bf16x8 a, bf16x8 b, f32x4 c) { return __builtin_amdgcn_mfma_f32_16x16x32_bf16(a, b, c, 0, 0, 0); }
template <int K> __device__ __forceinline__ f32x4 mm_ll(const LAS bf16* A, int pa, int m0, const LAS bf16* B, int pb, int n0, f32x4 acc, int lane) {
    const int r = lane & 15, q = lane >> 4;
    const LAS bf16* ap = A + (m0 + r) * pa + 8 * q; const LAS bf16* bp = B + (n0 + r) * pb + 8 * q;
#pragma unroll
    for (int k0 = 0; k0 < K; k0 += 32) acc = mfma16(*(const LAS bf16x8*)(ap + k0), *(const LAS bf16x8*)(bp + k0), acc);
    return acc;
}
template <int K> __device__ __forceinline__ f32x4 mm_lg(const LAS bf16* A, int pa, int m0, const bf16* B, int pb, int n0, f32x4 acc, int lane) {
    const int r = lane & 15, q = lane >> 4;
    const LAS bf16* ap = A + (m0 + r) * pa + 8 * q; const bf16* bp = B + (size_t)(n0 + r) * pb + 8 * q;
#pragma unroll
    for (int k0 = 0; k0 < K; k0 += 32) acc = mfma16(*(const LAS bf16x8*)(ap + k0), *(const bf16x8*)(bp + k0), acc);
    return acc;
}
__device__ __forceinline__ float redl16(float v) { v += __shfl_xor(v, 1); v += __shfl_xor(v, 2); v += __shfl_xor(v, 4); v += __shfl_xor(v, 8); return v; }
__device__ __forceinline__ void st4bf(LAS bf16* p, f32x4 v) { u32x2 w; w.x = pk2(v[0], v[1]); w.y = pk2(v[2], v[3]); *(LAS u32x2*)p = w; }
__device__ __forceinline__ float ldbf(const LAS bf16* p) { return __builtin_bit_cast(float, (unsigned)(*p) << 16); }
constexpr f32x4 FZ4 = {0.f, 0.f, 0.f, 0.f};
__device__ __forceinline__ void tr_write8(LAS bf16* Tm, int pitch, int c0, int t, const float (&v)[8], int rot) {
    float a[8], b[8];
#pragma unroll
    for (int e = 0; e < 8; ++e) a[e] = (rot & 1) ? v[(e + 1) & 7] : v[e];
#pragma unroll
    for (int e = 0; e < 8; ++e) b[e] = (rot & 2) ? a[(e + 2) & 7] : a[e];
#pragma unroll
    for (int e = 0; e < 8; ++e) a[e] = (rot & 4) ? b[(e + 4) & 7] : b[e];
#pragma unroll
    for (int e = 0; e < 8; ++e) Tm[(c0 + ((e + rot) & 7)) * pitch + t] = (bf16)f2bf(a[e]);
}
__device__ __forceinline__ void ld8f(const LAS float* p, float (&v)[8]) { const f32x4 a = *(const LAS f32x4*)p, b = *(const LAS f32x4*)(p + 4); v[0] = a[0]; v[1] = a[1]; v[2] = a[2]; v[3] = a[3]; v[4] = b[0]; v[5] = b[1]; v[6] = b[2]; v[7] = b[3]; }
__device__ __forceinline__ void st8f(LAS float* p, const float (&v)[8]) { *(LAS f32x4*)p = (f32x4){v[0], v[1], v[2], v[3]}; *(LAS f32x4*)(p + 4) = (f32x4){v[4], v[5], v[6], v[7]}; }

template <bool FINAL>
__device__ __forceinline__ void rwkv_chunk_unit(Frame& F, int layer, int u) {
    const int tid = otid(), w = __builtin_amdgcn_readfirstlane(tid >> 6);
    bf16x8 lfr[16];
#define IDS() const int ft = fresh_tid(tid); const int lane = ft & 63, r16 = lane & 15, q4 = lane >> 4, tok = ft >> 3, part = ft & 7; (void)lane; (void)r16; (void)q4; (void)tok; (void)part
    const int b = u >> 9, sc = (u >> 3) & 63, h = u & 7;
    constexpr int NV = FINAL ? 64 : 128, NVT = NV / 16, NZ = NVT / 2;
    constexpr int X_TW = 0, X_XA = 9216, X_SG = 18432, X_KF = 35840, X_RF = 52224;
    constexpr int O_AT = 0, O_RT = 9216, O_BT = 18432, O_KT = 27648, O_BH = 36864, O_KH = 46080, O_VT = 55296, O_TF = O_BT;
    constexpr int Y0 = 68608;
    constexpr int Y_A = Y0, Y_B = Y0 + 8192, Y_K = Y0 + 16384, Y_R = Y0 + 24576, Y_L = Y0 + 32768, Y_VF = Y0 + 49152;
    constexpr int Y_AAB = Y0, Y_AAK = Y0 + 17408, Y_ARB = Y_AAK + 9216, Y_ARK = Y_ARB + 9216, Y_TB = FINAL ? Y_ARK + 9216 : Y_AAK + 9216, Y_ZU = Y_TB + 9216, Y_YF = Y_AAB;
    static_assert(Y_ZU + NV * PT * 2 <= Y0 + 65536, "region Y");
    constexpr int Z0 = Y0 + 65536, Z_G = Z0, Z_S = FINAL ? Z0 + 8192 : Z0, Z_MISC = 152576, Z_BON = Z_MISC, Z_PC = Z_MISC + 256, Z_PAR = Z_MISC + 512, Z_XS = Y_ZU;
    static_assert(Z_S + NV * PT * 2 <= Z_MISC && Z_PAR + 832 * 4 <= LDSCTL_OFF, "region Z");
    LAS unsigned char* L = F.lds;
#define LB(off) ((LAS bf16*)(L + (off)))
#define LF(off) ((LAS float*)(L + (off)))
    {
        const int pidx = (w == 0) ? 5 : (w == 1) ? 7 : (w == 2) ? 9 : (w == 3) ? 10 : (w == 4) ? 11 : (w == 5) ? 12 : 13;
        if (w < 7) LF(Z_PAR)[w * 64 + (tid & 63)] = (INP(pidx) + layer * 512 + h * 64)[tid & 63];
        const float* mu = INP(3) + layer * 1792;
        for (int i = tid; i < 384; i += 512) LF(Z_PAR)[448 + i] = mu[(i < 64) ? (h * 64 + i) : (i < 128) ? (512 + h * 64 + (i - 64)) : (1536 + (i - 128))];
    }
    const bf16* WupT = (const bf16*)(F.ws + WS_LORA + (size_t)layer * LORA_STRIDE) + h * 64 * 64;
    const bf16* AupT = (const bf16*)(F.ws + WS_LORA + (size_t)layer * LORA_STRIDE + 65536) + h * 64 * 64;
    const bf16* GupT = (const bf16*)(F.ws + WS_LORA + (size_t)layer * LORA_STRIDE + 131072) + h * 64 * 128;
    const bf16* P = (const bf16*)(F.ws + WS_BIG); const bf16* vsrc = (const bf16*)(F.ws + (layer == 0 ? WS_VF : WS_VMIX));
    float* Nbuf = (float*)(F.ws + WS_ST_RW) + (size_t)u * 4096; bf16* MT = (bf16*)(F.ws + WS_MT) + (size_t)u * 4096;
    { IDS();
        if (w < 4) {
#pragma unroll
            for (int nt = 0; nt < 4; ++nt)
#pragma unroll
                for (int k2 = 0; k2 < 2; ++k2) { lfr[nt * 4 + k2] = *(const bf16x8*)(WupT + (size_t)(16 * nt + r16) * 64 + 32 * k2 + 8 * q4); lfr[nt * 4 + 2 + k2] = *(const bf16x8*)(AupT + (size_t)(16 * nt + r16) * 64 + 32 * k2 + 8 * q4); }
        } else if (FINAL) {
#pragma unroll
            for (int nt = 0; nt < 4; ++nt)
#pragma unroll
                for (int k4 = 0; k4 < 4; ++k4) lfr[nt * 4 + k4] = *(const bf16x8*)(GupT + (size_t)(16 * nt + r16) * 128 + 32 * k4 + 8 * q4);
        } }
    constexpr int NST = FINAL ? 2 : 4;
    f32x4 Sacc[NST];
    const int s_vb = FINAL ? (w & 3) : w;
#define S_CT(ti) (FINAL ? (2 * (w >> 2) + (ti)) : (ti))
    { IDS();
#pragma unroll
    for (int ti = 0; ti < NST; ++ti) {
        const int ct = S_CT(ti);
#pragma unroll
        for (int jj = 0; jj < 4; ++jj) { const int v = 16 * s_vb + 4 * q4 + jj, c = 16 * ct + r16;
            float x; if (FINAL) x = Nbuf[v * 64 + c]; else x = (v >= 64 && v - 64 == c) ? 1.f : 0.f;
            Sacc[ti][jj] = x; LB(Z_S)[v * PT + c] = (bf16)f2bf(x); }
    } }
    for (int j = 0; j < 4; ++j) {
        const int tl0 = sc * 256 + j * 64;
        {
            IDS();
            const int t = tl0 + tok; const size_t m = (size_t)b * T + t; const bf16* cur = P + m * PLD;
#pragma unroll
            for (int i = 0; i < 6; ++i) {
                const int col = (i == 0) ? (h * 64 + 8 * part) : (i == 1) ? (512 + h * 64 + 8 * part) : (i == 2) ? (1536 + 8 * part) : (i == 3) ? (1600 + 8 * part) : (1664 + 8 * part + (i - 4) * 64);
                float c[8], p[8]; unpack8(*(const u32x4*)(cur + col), c);
                if (t > 0) unpack8(*(const u32x4*)(cur - PLD + col), p); else {
#pragma unroll
                    for (int e = 0; e < 8; ++e) p[e] = 0.f; }
#pragma unroll
                for (int e = 0; e < 8; ++e) c[e] = c[e] + (p[e] - c[e]) * LF(Z_PAR)[448 + ((i < 4) ? 64 * i : 256 + 64 * (i - 4)) + 8 * part + e];
                if (i == 0) { st8f(LF(X_RF) + tok * 64 + 8 * part, c);
                } else if (i == 1) { st8f(LF(X_KF) + tok * 64 + 8 * part, c);
                } else if (i == 2) {
#pragma unroll
                    for (int e = 0; e < 8; ++e) c[e] = fast_tanh(c[e]);
                    *(LAS u32x4*)(LB(X_TW) + tok * PT + 8 * part) = pack8(c);
                } else if (i == 3) {
                    *(LAS u32x4*)(LB(X_XA) + tok * PT + 8 * part) = pack8(c);
                } else if (FINAL) {
#pragma unroll
                    for (int e = 0; e < 8; ++e) c[e] = sigm(c[e]);
                    *(LAS u32x4*)(LB(X_SG) + tok * PT2 + 8 * part + (i - 4) * 64) = pack8(c);
                }
            }
            float v[8]; unpack8(*(const u32x4*)(vsrc + m * 512 + h * 64 + 8 * part), v);
            st8f(LF(Y_VF) + tok * 64 + 8 * part, v);
        }
        __syncthreads();
        { IDS();
        if (w < 4) {
            const int rb = w;
            float inv[4], bs[4] = {0.f, 0.f, 0.f, 0.f};
            { float ss[4] = {0.f, 0.f, 0.f, 0.f};
#pragma unroll
                for (int nt = 0; nt < 4; ++nt) { const int c = 16 * nt + r16; const float kkc = LF(Z_PAR)[128 + c];
#pragma unroll
                    for (int jj = 0; jj < 4; ++jj) { const float kk = LF(X_KF)[(16 * rb + 4 * q4 + jj) * 64 + c] * kkc; ss[jj] += kk * kk; } }
#pragma unroll
                for (int jj = 0; jj < 4; ++jj) inv[jj] = 1.f / sqrtf(fmaxf(redl16(ss[jj]), 1e-24f)); }
#pragma unroll
            for (int nt = 0; nt < 4; ++nt) {
                f32x4 aw = FZ4, aa = FZ4;
#pragma unroll
                for (int k2 = 0; k2 < 2; ++k2) { aw = mfma16(*(const LAS bf16x8*)(LB(X_TW) + (16 * rb + r16) * PT + 32 * k2 + 8 * q4), lfr[nt * 4 + k2], aw); aa = mfma16(*(const LAS bf16x8*)(LB(X_XA) + (16 * rb + r16) * PT + 32 * k2 + 8 * q4), lfr[nt * 4 + 2 + k2], aa); }
                const int c = 16 * nt + r16; const float w0c = LF(Z_PAR)[c], a0c = LF(Z_PAR)[64 + c], kkc = LF(Z_PAR)[128 + c], kac = LF(Z_PAR)[192 + c], rkc = LF(Z_PAR)[256 + c];
#pragma unroll
                for (int jj = 0; jj < 4; ++jj) { const int t = 16 * rb + 4 * q4 + jj, o = t * 64 + c;
                    LF(Y_L)[o] = -0.8750455979f * sigm(w0c + aw[jj]);
                    const float al = sigm(a0c + aa[jj]), kraw = LF(X_KF)[o], rr = LF(X_RF)[o], kn = kraw * kkc * inv[jj];
                    const float knew = kraw * (1.f + (al - 1.f) * kac);
                    LB(Y_A)[o] = (bf16)f2bf(-kn); LB(Y_B)[o] = (bf16)f2bf(kn * al); LB(Y_K)[o] = (bf16)f2bf(knew); LB(Y_R)[o] = (bf16)f2bf(rr);
                    bs[jj] += rr * knew * rkc; } }
#pragma unroll
            for (int jj = 0; jj < 4; ++jj) { const float sm = redl16(bs[jj]); if (r16 == 0) LF(Z_BON)[16 * rb + 4 * q4 + jj] = sm; }
        } else if (FINAL) {
            const int rb = w - 4;
#pragma unroll
            for (int nt = 0; nt < 4; ++nt) { f32x4 ag = FZ4;
#pragma unroll
                for (int k4 = 0; k4 < 4; ++k4) ag = mfma16(*(const LAS bf16x8*)(LB(X_SG) + (16 * rb + r16) * PT2 + 32 * k4 + 8 * q4), lfr[nt * 4 + k4], ag);
#pragma unroll
                for (int jj = 0; jj < 4; ++jj) LB(Z_G)[(16 * rb + 4 * q4 + jj) * 64 + 16 * nt + r16] = (bf16)f2bf(ag[jj]); }
        } }
        __syncthreads();
        if (w == 0) { IDS(); float run = 0.f;
#pragma unroll 8
            for (int t = 0; t < 64; ++t) { run += LF(Y_L)[t * 64 + lane]; LF(Y_L)[t * 64 + lane] = run; }
            LF(Z_PC)[lane] = ex2(run); }
        __syncthreads();
        {
            IDS(); const int t = tok, c0 = 8 * part;
            float Lt[8], Lp[8], Le[8], av[8], bv[8], kv[8], rv[8], vv[8], at[8], rt[8], bt[8], kt[8], bh[8], kh[8];
            ld8f(LF(Y_L) + t * 64 + c0, Lt); ld8f(LF(Y_L) + 63 * 64 + c0, Le); ld8f(LF(Y_VF) + t * 64 + c0, vv);
            if (t > 0) ld8f(LF(Y_L) + (t - 1) * 64 + c0, Lp); else {
#pragma unroll
                for (int e = 0; e < 8; ++e) Lp[e] = 0.f; }
            unpack8(*(const LAS u32x4*)(LB(Y_A) + t * 64 + c0), av); unpack8(*(const LAS u32x4*)(LB(Y_B) + t * 64 + c0), bv);
            unpack8(*(const LAS u32x4*)(LB(Y_K) + t * 64 + c0), kv); unpack8(*(const LAS u32x4*)(LB(Y_R) + t * 64 + c0), rv);
#pragma unroll
            for (int e = 0; e < 8; ++e) { const float eL = ex2(Lt[e]), eLm = ex2(Lp[e]), eN = ex2(-Lt[e]), eE = ex2(Le[e] - Lt[e]);
                at[e] = av[e] * eLm; rt[e] = rv[e] * eL; bt[e] = bv[e] * eN; kt[e] = kv[e] * eN; bh[e] = bv[e] * eE; kh[e] = kv[e] * eE; }
            tr_write8(LB(O_BH), PT, c0, t, bh, part); tr_write8(LB(O_KH), PT, c0, t, kh, part); tr_write8(LB(O_VT), PT, c0, t, vv, part);
            *(LAS u32x4*)(LB(O_AT) + t * PT + c0) = pack8(at); *(LAS u32x4*)(LB(O_RT) + t * PT + c0) = pack8(rt);
            *(LAS u32x4*)(LB(O_BT) + t * PT + c0) = pack8(bt); *(LAS u32x4*)(LB(O_KT) + t * PT + c0) = pack8(kt);
        }
        __syncthreads();
        {
            IDS(); const int rb = w & 3;
#pragma unroll
            for (int ci = 0; ci < 2; ++ci) { const int ct = 2 * (w >> 2) + ci;
                f32x4 ab = FZ4, ak = FZ4, arb = FZ4, ark = FZ4;
                if (ct <= rb) { ab = mm_ll<64>(LB(O_AT), PT, 16 * rb, LB(O_BT), PT, 16 * ct, FZ4, lane); ak = mm_ll<64>(LB(O_AT), PT, 16 * rb, LB(O_KT), PT, 16 * ct, FZ4, lane);
                    if (FINAL) { arb = mm_ll<64>(LB(O_RT), PT, 16 * rb, LB(O_BT), PT, 16 * ct, FZ4, lane); ark = mm_ll<64>(LB(O_RT), PT, 16 * rb, LB(O_KT), PT, 16 * ct, FZ4, lane); } }
#pragma unroll
                for (int jj = 0; jj < 4; ++jj) { const int t = 16 * rb + 4 * q4 + jj, i = 16 * ct + r16;
                    LF(Y_AAB)[t * PF + i] = (i < t) ? ab[jj] : 0.f; LB(Y_AAK)[t * PT + i] = (bf16)f2bf((i < t) ? ak[jj] : 0.f);
                    if (FINAL) { LB(Y_ARB)[t * PT + i] = (bf16)f2bf((i <= t) ? arb[jj] : 0.f); LB(Y_ARK)[t * PT + i] = (bf16)f2bf((i <= t) ? ark[jj] : 0.f); } } }
        }
        __syncthreads();
        { IDS(); for (int i = ft; i < 64 * PF; i += 512) LF(O_TF)[i] = 0.f; }
        __syncthreads();
        if (w == 0) { IDS(); const int blk = lane >> 4, col = lane & 15; float x[16];
#pragma unroll
            for (int i = 0; i < 16; ++i) x[i] = (i == col) ? 1.f : 0.f;
#pragma unroll
            for (int i = 1; i < 16; ++i) { float s = 0.f; asm volatile("" ::: "memory");
#pragma unroll
                for (int m2 = 0; m2 < i; ++m2) s += LF(Y_AAB)[(16 * blk + i) * PF + 16 * blk + m2] * x[m2];
                x[i] += s; }
#pragma unroll
            for (int i = 0; i < 16; ++i) LF(O_TF)[(16 * blk + i) * PF + 16 * blk + col] = x[i]; }
        __syncthreads();
        { IDS(); const int p = ft >> 8, i = (ft >> 4) & 15, jx = ft & 15; float s = 0.f;
#pragma unroll
            for (int m4 = 0; m4 < 4; ++m4) { const f32x4 a = *(const LAS f32x4*)(LF(Y_AAB) + (32 * p + 16 + i) * PF + 32 * p + 4 * m4);
#pragma unroll
                for (int e = 0; e < 4; ++e) s += a[e] * LF(O_TF)[(32 * p + 4 * m4 + e) * PF + 32 * p + jx]; }
            LF(Z_XS)[p * 256 + i * 16 + jx] = s; }
        __syncthreads();
        { IDS(); const int p = ft >> 8, i = (ft >> 4) & 15, jx = ft & 15; float s = 0.f;
#pragma unroll
            for (int m4 = 0; m4 < 4; ++m4) { const f32x4 a = *(const LAS f32x4*)(LF(O_TF) + (32 * p + 16 + i) * PF + 32 * p + 16 + 4 * m4);
#pragma unroll
                for (int e = 0; e < 4; ++e) s += a[e] * LF(Z_XS)[p * 256 + (4 * m4 + e) * 16 + jx]; }
            LF(O_TF)[(32 * p + 16 + i) * PF + 32 * p + jx] = s; }
        __syncthreads();
        { IDS(); const int i = ft >> 4, j0 = (ft & 15) * 2; float s0 = 0.f, s1 = 0.f;
#pragma unroll
            for (int m4 = 0; m4 < 8; ++m4) { const f32x4 a = *(const LAS f32x4*)(LF(Y_AAB) + (32 + i) * PF + 4 * m4);
#pragma unroll
                for (int e = 0; e < 4; ++e) { const f32x2 bv = *(const LAS f32x2*)(LF(O_TF) + (4 * m4 + e) * PF + j0); s0 += a[e] * bv.x; s1 += a[e] * bv.y; } }
            LF(Z_XS)[i * 33 + j0] = s0; LF(Z_XS)[i * 33 + j0 + 1] = s1; }
        __syncthreads();
        { IDS(); const int i = ft >> 4, j0 = (ft & 15) * 2; float s0 = 0.f, s1 = 0.f;
#pragma unroll
            for (int m4 = 0; m4 < 8; ++m4) { const f32x4 a = *(const LAS f32x4*)(LF(O_TF) + (32 + i) * PF + 32 + 4 * m4);
#pragma unroll
                for (int e = 0; e < 4; ++e) { s0 += a[e] * LF(Z_XS)[(4 * m4 + e) * 33 + j0]; s1 += a[e] * LF(Z_XS)[(4 * m4 + e) * 33 + j0 + 1]; } }
            LF(O_TF)[(32 + i) * PF + j0] = s0; LF(O_TF)[(32 + i) * PF + j0 + 1] = s1; }
        __syncthreads();
        { IDS(); const int t = tok, i0 = 8 * part; float o[8];
#pragma unroll
            for (int e = 0; e < 8; ++e) o[e] = LF(O_TF)[t * PF + i0 + e];
            *(LAS u32x4*)(LB(Y_TB) + t * PT + i0) = pack8(o); }
        __syncthreads();
        {
            IDS(); const int rb = w & 3;
            f32x4 uu[NZ];
#pragma unroll
            for (int ci = 0; ci < NZ; ++ci) { const int vt = (w >> 2) * NZ + ci;
                f32x4 z = mm_ll<64>(LB(O_AT), PT, 16 * rb, LB(Z_S), PT, 16 * vt, FZ4, lane);
                if (vt < 4) z = mm_ll<64>(LB(Y_AAK), PT, 16 * rb, LB(O_VT), PT, 16 * vt, z, lane);
                st4bf(LB(Y_ZU) + (16 * vt + r16) * PT + 16 * rb + 4 * q4, z); }
            __syncthreads();
#pragma unroll
            for (int ci = 0; ci < NZ; ++ci) { const int vt = (w >> 2) * NZ + ci; uu[ci] = mm_ll<64>(LB(Y_TB), PT, 16 * rb, LB(Y_ZU), PT, 16 * vt, FZ4, lane); }
            __syncthreads();
#pragma unroll
            for (int ci = 0; ci < NZ; ++ci) { const int vt = (w >> 2) * NZ + ci; st4bf(LB(Y_ZU) + (16 * vt + r16) * PT + 16 * rb + 4 * q4, uu[ci]); }
        }
        __syncthreads();
        {
            IDS(); f32x4 yy[2];
            if (FINAL) { const int rb = w & 3;
#pragma unroll
                for (int ci = 0; ci < 2; ++ci) { const int ct = 2 * (w >> 2) + ci;
                    f32x4 y = mm_ll<64>(LB(O_RT), PT, 16 * rb, LB(Z_S), PT, 16 * ct, FZ4, lane);
                    y = mm_ll<64>(LB(Y_ARB), PT, 16 * rb, LB(Y_ZU), PT, 16 * ct, y, lane);
                    yy[ci] = mm_ll<64>(LB(Y_ARK), PT, 16 * rb, LB(O_VT), PT, 16 * ct, y, lane); } }
#pragma unroll
            for (int ti = 0; ti < NST; ++ti) { const int ct = S_CT(ti); const float pc = LF(Z_PC)[16 * ct + r16];
                f32x4 s = Sacc[ti] * pc;
                s = mm_ll<64>(LB(Y_ZU), PT, 16 * s_vb, LB(O_BH), PT, 16 * ct, s, lane);
                if (s_vb < 4) s = mm_ll<64>(LB(O_VT), PT, 16 * s_vb, LB(O_KH), PT, 16 * ct, s, lane);
                Sacc[ti] = s; }
            __syncthreads();
#pragma unroll
            for (int ti = 0; ti < NST; ++ti) { const int ct = S_CT(ti);
#pragma unroll
                for (int jj = 0; jj < 4; ++jj) LB(Z_S)[(16 * s_vb + 4 * q4 + jj) * PT + 16 * ct + r16] = (bf16)f2bf(Sacc[ti][jj]); }
            if (FINAL) { const int rb = w & 3;
#pragma unroll
                for (int ci = 0; ci < 2; ++ci) { const int ct = 2 * (w >> 2) + ci;
#pragma unroll
                    for (int jj = 0; jj < 4; ++jj) LF(Y_YF)[(16 * rb + 4 * q4 + jj) * PF + 16 * ct + r16] = yy[ci][jj]; } }
        }
        __syncthreads();
        if (FINAL) {
            IDS();
            const int t = tok, c0 = 8 * part; const size_t m = (size_t)b * T + tl0 + t;
            float y[8], gg[8], sm = 0.f; ld8f(LF(Y_YF) + t * PF + c0, y); unpack8(*(const LAS u32x4*)(LB(Z_G) + t * 64 + c0), gg);
#pragma unroll
            for (int e = 0; e < 8; ++e) sm += y[e];
            const float mean = red8(sm) * (1.f / 64.f); float vs = 0.f;
#pragma unroll
            for (int e = 0; e < 8; ++e) { y[e] -= mean; vs += y[e] * y[e]; }
            const float rs = 1.f / sqrtf(red8(vs) * (1.f / 64.f) + 64e-5f), bo = LF(Z_BON)[t];
#pragma unroll
            for (int e = 0; e < 8; ++e) { const int c = c0 + e; y[e] = (y[e] * rs * LF(Z_PAR)[320 + c] + LF(Z_PAR)[384 + c] + bo * ldbf(LB(O_VT) + c * PT + t)) * gg[e]; }
            *(u32x4*)((bf16*)(F.ws + WS_YRW) + m * 512 + h * 64 + c0) = pack8(y);
        }
        __syncthreads();
    }
    if (!FINAL) { IDS();
#pragma unroll
        for (int ti = 0; ti < NST; ++ti) { const int ct = S_CT(ti);
            if (s_vb < 4) {
#pragma unroll
                for (int jj = 0; jj < 4; ++jj) Nbuf[(16 * s_vb + 4 * q4 + jj) * 64 + 16 * ct + r16] = Sacc[ti][jj];
            } else { u32x2 wv; wv.x = pk2(Sacc[ti][0], Sacc[ti][1]); wv.y = pk2(Sacc[ti][2], Sacc[ti][3]);
                *(u32x2*)(MT + (16 * ct + r16) * 64 + 16 * (s_vb - 4) + 4 * q4) = wv; }
        }
    }
#undef IDS
#undef S_CT
#undef LB
#undef LF
}

template <bool FINAL>
__device__ __forceinline__ void ret_chunk_unit(Frame& F, int u) {
    const int tid = otid(), lane = tid & 63, w = __builtin_amdgcn_readfirstlane(tid >> 6), r16 = lane & 15, q4 = lane >> 4;
    const int b = u >> 9, sc = (u >> 3) & 63, h = u & 7;
    constexpr int R_QB = 0, R_KB = 9216, R_KHT = 18432, R_VT = 27648, R_GB = 36864, R_AB = 45056, R_SB = 54272, R_YF = 63488;
    LAS unsigned char* L = F.lds;
#define LB(off) ((LAS bf16*)(L + (off)))
#define LF(off) ((LAS float*)(L + (off)))
    bf16* P = (bf16*)(F.ws + WS_BIG);
    float* Sbuf = (float*)(F.ws + WS_ST_RET) + (size_t)u * 4096;
    const float lg = log2f(1.f - exp2f(-5.f - (float)h));
    const float g64 = ex2(64.f * lg);
    const int db = w & 3;
    f32x4 Sacc[2];
#pragma unroll
    for (int ci = 0; ci < 2; ++ci) { const int et = 2 * (w >> 2) + ci;
#pragma unroll
        for (int jj = 0; jj < 4; ++jj) Sacc[ci][jj] = FINAL ? Sbuf[(16 * db + 4 * q4 + jj) * 64 + 16 * et + r16] : 0.f;
        if (FINAL) st4bf(LB(R_SB) + (16 * et + r16) * PT + 16 * db + 4 * q4, Sacc[ci]); }
    const int tok = tid >> 3, part = tid & 7;
    double invf[4];
#pragma unroll
    for (int p = 0; p < 4; ++p) invf[p] = exp(-(double)(part * 4 + p) * (9.210340371976184 / 32.0));
    for (int j = 0; j < 4; ++j) {
        const int tl0 = sc * 256 + j * 64;
        {
            const int t = tl0 + tok; const size_t m = (size_t)b * T + t; const bf16* row = P + m * PLD + C_RET + h * 64 + 8 * part;
            float qv[8], kv[8], vv[8]; unpack8(*(const u32x4*)(row + 512), kv); unpack8(*(const u32x4*)(row + 1024), vv);
            if (FINAL) { unpack8(*(const u32x4*)row, qv); *(LAS u32x4*)(LB(R_GB) + tok * 64 + 8 * part) = *(const u32x4*)(row + 1536); }
            const float zeta = ex2((float)(63 - tok) * lg);
#pragma unroll
            for (int p = 0; p < 4; ++p) {
                double rev = (double)t * invf[p] * 0.15915494309189535; rev -= floor(rev);
                const float sn = __builtin_amdgcn_sinf((float)rev), cs = __builtin_amdgcn_cosf((float)rev);
                const float k0 = kv[2 * p], k1 = kv[2 * p + 1]; kv[2 * p] = (k0 * cs - k1 * sn) * 0.125f; kv[2 * p + 1] = (k0 * sn + k1 * cs) * 0.125f;
                if (FINAL) { const float q0 = qv[2 * p], q1 = qv[2 * p + 1]; qv[2 * p] = q0 * cs - q1 * sn; qv[2 * p + 1] = q0 * sn + q1 * cs; } }
            if (FINAL) { *(LAS u32x4*)(LB(R_QB) + tok * PT + 8 * part) = pack8(qv); *(LAS u32x4*)(LB(R_KB) + tok * PT + 8 * part) = pack8(kv); }
            float kz[8];
#pragma unroll
            for (int e = 0; e < 8; ++e) kz[e] = kv[e] * zeta;
            tr_write8(LB(R_KHT), PT, 8 * part, tok, kz, part); tr_write8(LB(R_VT), PT, 8 * part, tok, vv, part);
        }
        __syncthreads();
        if (FINAL) { const int rb = w & 3;
#pragma unroll
            for (int ci = 0; ci < 2; ++ci) { const int ct = 2 * (w >> 2) + ci; f32x4 a = FZ4;
                if (ct <= rb) a = mm_ll<64>(LB(R_QB), PT, 16 * rb, LB(R_KB), PT, 16 * ct, FZ4, lane);
#pragma unroll
                for (int jj = 0; jj < 4; ++jj) { const int l = 16 * rb + 4 * q4 + jj, s = 16 * ct + r16; LB(R_AB)[l * PT + s] = (bf16)f2bf((s <= l) ? a[jj] * ex2((float)(l - s) * lg) : 0.f); } }
            __syncthreads();
        }
        {
            f32x4 yy[2];
            if (FINAL) { const int rb = w & 3;
#pragma unroll
                for (int ci = 0; ci < 2; ++ci) { const int et = 2 * (w >> 2) + ci;
                    const f32x4 a1 = mm_ll<64>(LB(R_AB), PT, 16 * rb, LB(R_VT), PT, 16 * et, FZ4, lane), a2 = mm_ll<64>(LB(R_QB), PT, 16 * rb, LB(R_SB), PT, 16 * et, FZ4, lane);
#pragma unroll
                    for (int jj = 0; jj < 4; ++jj) yy[ci][jj] = a1[jj] + ex2((float)(16 * rb + 4 * q4 + jj + 1) * lg) * a2[jj]; } }
#pragma unroll
            for (int ci = 0; ci < 2; ++ci) { const int et = 2 * (w >> 2) + ci; Sacc[ci] = mm_ll<64>(LB(R_KHT), PT, 16 * db, LB(R_VT), PT, 16 * et, Sacc[ci] * g64, lane); }
            __syncthreads();
            if (FINAL) { const int rb = w & 3;
#pragma unroll
                for (int ci = 0; ci < 2; ++ci) { const int et = 2 * (w >> 2) + ci; st4bf(LB(R_SB) + (16 * et + r16) * PT + 16 * db + 4 * q4, Sacc[ci]);
#pragma unroll
                    for (int jj = 0; jj < 4; ++jj) LF(R_YF)[(16 * rb + 4 * q4 + jj) * PF + 16 * et + r16] = yy[ci][jj]; } }
        }
        __syncthreads();
        if (FINAL) { const size_t m = (size_t)b * T + tl0 + tok; float y[8], g[8], ss = 0.f;
            ld8f(LF(R_YF) + tok * PF + 8 * part, y);
#pragma unroll
            for (int e = 0; e < 8; ++e) ss += y[e] * y[e];
            const float rs = 1.f / sqrtf(red8(ss) * (1.f / 64.f) + 1e-6f);
            unpack8(*(const LAS u32x4*)(LB(R_GB) + tok * 64 + 8 * part), g);
#pragma unroll
            for (int e = 0; e < 8; ++e) y[e] = y[e] * rs * silu(g[e]);
            *(u32x4*)(P + m * PLD + C_RETG + h * 64 + 8 * part) = pack8(y);
            __syncthreads(); }
    }
    if (!FINAL) {
#pragma unroll
        for (int ci = 0; ci < 2; ++ci) { const int et = 2 * (w >> 2) + ci;
#pragma unroll
            for (int jj = 0; jj < 4; ++jj) Sbuf[(16 * db + 4 * q4 + jj) * 64 + 16 * et + r16] = Sacc[ci][jj]; }
    }
#undef LB
#undef LF
}

template <bool FINAL>
__device__ __forceinline__ void ssd_chunk_unit(Frame& F, int layer, int u) {
    const int tid = otid(), w = __builtin_amdgcn_readfirstlane(tid >> 6);
#define IDS() const int ft = fresh_tid(tid); const int lane = ft & 63, r16 = lane & 15, q4 = lane >> 4; (void)lane; (void)r16; (void)q4
    const int b = u >> 9, sc = (u >> 3) & 63, h = u & 7, g = h >> 2;
    constexpr int D_CB = 0, D_BB = 17408, D_BT = 34816, D_YF = 53248, D_XT = 70656, D_XDT = 79872, D_GM = 89088, D_SB = 98304, D_MISC = 115712;
    constexpr int D_DTS = D_MISC, D_ACS = D_MISC + 256, D_CAR = D_MISC + 512;
    LAS unsigned char* L = F.lds;
#define LB(off) ((LAS bf16*)(L + (off)))
#define LF(off) ((LAS float*)(L + (off)))
    bf16* P = (bf16*)(F.ws + WS_BIG); const float* dtb = (const float*)(F.ws + WS_DT);
    const bf16* BND = (const bf16*)(F.ws + WS_BND);
    float* Sbuf = (float*)(F.ws + WS_ST_SSD) + (size_t)u * 8192;
    const float* cw = INP(17) + layer * 1024 * 4; const float* cbias = INP(18) + layer * 1024;
    const float dt_bias = INP(19)[layer * 8 + h], A = -expf(INP(20)[layer * 8 + h]), Dh = INP(21)[layer * 8 + h];
    const int bc_chunk = tid & 31, bc_chn = (bc_chunk < 16) ? (512 + g * 128 + bc_chunk * 8) : (768 + g * 128 + (bc_chunk - 16) * 8);
    const int x_chunk = tid & 7, x_chn = h * 64 + x_chunk * 8;
    f32x4 wbc[8]; float bbc[8];
#pragma unroll
    for (int e = 0; e < 8; ++e) { bbc[e] = cbias[bc_chn + e]; wbc[e] = *(const f32x4*)(cw + (bc_chn + e) * 4); }
    constexpr int D_WX = D_MISC + 1280, D_BX = D_WX + 1024;
    if (tid < 64) { const f32x4 wv = *(const f32x4*)(cw + (h * 64 + tid) * 4); const int ch = tid >> 3, e = tid & 7;
#pragma unroll
        for (int k = 0; k < 4; ++k) LF(D_WX)[(k * 8 + e) * 8 + ch] = wv[k];
        LF(D_BX)[e * 8 + ch] = cbias[h * 64 + tid]; }
    __syncthreads();
    const int pb = w & 3;
    f32x4 Sacc[4];
    { IDS();
#pragma unroll
    for (int ci = 0; ci < 4; ++ci) { const int nt = 4 * (w >> 2) + ci;
#pragma unroll
        for (int jj = 0; jj < 4; ++jj) { const float x = FINAL ? Sbuf[(16 * pb + 4 * q4 + jj) * 128 + 16 * nt + r16] : 0.f; Sacc[ci][jj] = x;
            if (FINAL) LB(D_SB)[(16 * pb + 4 * q4 + jj) * PT2 + 16 * nt + r16] = (bf16)f2bf(x); } } }
    float dstot = 0.f;
    for (int j = 0; j < 4; ++j) {
        const int tl0 = sc * 256 + j * 64; const size_t m0 = (size_t)b * T + tl0;
        if (w == 0) {
            IDS(); const float dt = softplus_acc(dtb[(m0 + lane) * 8 + h] + dt_bias); float a = A * dt;
#pragma unroll
            for (int o = 1; o < 64; o <<= 1) { const float n = __shfl_up(a, o); if (lane >= o) a += n; }
            LF(D_DTS)[lane] = dt; LF(D_ACS)[lane] = a;
        }
        {
            IDS();
#pragma unroll
            for (int it = 0; it < 4; ++it) { const int t = it * 16 + (ft >> 5); const int ta = tl0 + t;
                float acc[8];
#pragma unroll
                for (int e = 0; e < 8; ++e) acc[e] = bbc[e];
#pragma unroll
                for (int k = 0; k < 4; ++k) { if (ta - 3 + k >= 0) { float x[8]; unpack8(*(const u32x4*)(P + (m0 + t - 3 + k) * PLD + C_XBC + bc_chn), x);
#pragma unroll
                        for (int e = 0; e < 8; ++e) acc[e] += wbc[e][k] * x[e]; } }
#pragma unroll
                for (int e = 0; e < 8; ++e) acc[e] = silu(acc[e]);
                if (bc_chunk < 16) { *(LAS u32x4*)(LB(D_BB) + t * PT2 + bc_chunk * 8) = pack8(acc); tr_write8(LB(D_BT), PT, bc_chunk * 8, t, acc, bc_chunk & 7); }
                else *(LAS u32x4*)(LB(D_CB) + t * PT2 + (bc_chunk - 16) * 8) = pack8(acc);
            }
        }
        __syncthreads();
        {
            IDS(); const int t = ft >> 3; float acc[8];
#pragma unroll
            for (int e = 0; e < 8; ++e) acc[e] = LF(D_BX)[e * 8 + x_chunk];
#pragma unroll
            for (int k = 0; k < 4; ++k) { const int rel = t - 3 + k; float x[8]; bool have = true;
                if (rel >= 0 || !FINAL) { if (tl0 + rel >= 0) unpack8(*(const u32x4*)(P + (m0 + rel) * PLD + C_XBC + x_chn), x); else have = false; }
                else if (j == 0) { if (sc > 0) unpack8(*(const u32x4*)(BND + ((size_t)((b * 64 + sc) * 3 + (rel + 3))) * 512 + x_chn), x); else have = false; }
                else {
#pragma unroll
                    for (int e = 0; e < 8; ++e) x[e] = LF(D_CAR)[(rel + 3) * 64 + x_chunk * 8 + e]; }
                if (have) {
#pragma unroll
                    for (int e = 0; e < 8; ++e) acc[e] += LF(D_WX)[(k * 8 + e) * 8 + x_chunk] * x[e]; } }
            const float sc_d = LF(D_DTS)[t] * __expf(LF(D_ACS)[63] - LF(D_ACS)[t]);
            float xs8[8], xd8[8];
#pragma unroll
            for (int e = 0; e < 8; ++e) { xs8[e] = silu(acc[e]); xd8[e] = xs8[e] * sc_d; }
            tr_write8(LB(D_XT), PT, x_chunk * 8, t, xs8, x_chunk); tr_write8(LB(D_XDT), PT, x_chunk * 8, t, xd8, x_chunk);
        }
        if (FINAL) { IDS(); const int rb = w & 3;
#pragma unroll
            for (int ci = 0; ci < 2; ++ci) { const int ct = 2 * (w >> 2) + ci; f32x4 a = FZ4;
                if (ct <= rb) a = mm_ll<128>(LB(D_CB), PT2, 16 * rb, LB(D_BB), PT2, 16 * ct, FZ4, lane);
#pragma unroll
                for (int jj = 0; jj < 4; ++jj) { const int l = 16 * rb + 4 * q4 + jj, s = 16 * ct + r16;
                    LB(D_GM)[l * PT + s] = (bf16)f2bf((s <= l) ? a[jj] * __expf(LF(D_ACS)[l] - LF(D_ACS)[s]) * LF(D_DTS)[s] : 0.f); } } }
        __syncthreads();
        {
            IDS(); f32x4 yy[2];
            if (FINAL) { const int rb = w & 3;
#pragma unroll
                for (int ci = 0; ci < 2; ++ci) { const int pt = 2 * (w >> 2) + ci;
                    const f32x4 a1 = mm_ll<64>(LB(D_GM), PT, 16 * rb, LB(D_XT), PT, 16 * pt, FZ4, lane), a2 = mm_ll<128>(LB(D_CB), PT2, 16 * rb, LB(D_SB), PT2, 16 * pt, FZ4, lane);
#pragma unroll
                    for (int jj = 0; jj < 4; ++jj) { const int l = 16 * rb + 4 * q4 + jj, p = 16 * pt + r16; yy[ci][jj] = a1[jj] + __expf(LF(D_ACS)[l]) * a2[jj] + Dh * ldbf(LB(D_XT) + p * PT + l); } } }
            const float dec = expf(LF(D_ACS)[63]);
#pragma unroll
            for (int ci = 0; ci < 4; ++ci) { const int nt = 4 * (w >> 2) + ci; Sacc[ci] = mm_ll<64>(LB(D_XDT), PT, 16 * pb, LB(D_BT), PT, 16 * nt, Sacc[ci] * dec, lane); }
            dstot += LF(D_ACS)[63];
            if (FINAL && ft < 24) { const int k = ft >> 3, ch = ft & 7; float x[8]; unpack8(*(const u32x4*)(P + (m0 + 61 + k) * PLD + C_XBC + h * 64 + ch * 8), x);
#pragma unroll
                for (int e = 0; e < 8; ++e) LF(D_CAR)[k * 64 + ch * 8 + e] = x[e]; }
            __syncthreads();
            if (FINAL) { const int rb = w & 3;
#pragma unroll
                for (int ci = 0; ci < 4; ++ci) { const int nt = 4 * (w >> 2) + ci;
#pragma unroll
                    for (int jj = 0; jj < 4; ++jj) LB(D_SB)[(16 * pb + 4 * q4 + jj) * PT2 + 16 * nt + r16] = (bf16)f2bf(Sacc[ci][jj]); }
#pragma unroll
                for (int ci = 0; ci < 2; ++ci) { const int pt = 2 * (w >> 2) + ci;
#pragma unroll
                    for (int jj = 0; jj < 4; ++jj) LF(D_YF)[(16 * rb + 4 * q4 + jj) * PF + 16 * pt + r16] = yy[ci][jj]; } }
        }
        __syncthreads();
        if (FINAL) { IDS(); const int tok = ft >> 3, part = ft & 7; float y[8];
            ld8f(LF(D_YF) + tok * PF + 8 * part, y);
            *(u32x4*)(P + (m0 + tok) * PLD + C_XBC + h * 64 + 8 * part) = pack8(y);
            __syncthreads(); }
    }
    if (!FINAL) { IDS();
#pragma unroll
        for (int ci = 0; ci < 4; ++ci) { const int nt = 4 * (w >> 2) + ci;
#pragma unroll
            for (int jj = 0; jj < 4; ++jj) Sbuf[(16 * pb + 4 * q4 + jj) * 128 + 16 * nt + r16] = Sacc[ci][jj]; }
        if (tid == 0) ((float*)(F.ws + WS_DSTOT))[u] = dstot;
    }
#undef IDS
#undef LB
#undef LF
}

__device__ __forceinline__ void rwkv_scan_chain(Frame& F, int chain) {
    const int tid = otid(), lane = tid & 63, w = __builtin_amdgcn_readfirstlane(tid >> 6), r16 = lane & 15, q4 = lane >> 4;
    const int b = chain >> 3, h = chain & 7, vb = w & 3;
    LAS bf16* SB = (LAS bf16*)F.lds;
    f32x4 Sacc[2] = {FZ4, FZ4};
    for (int i = tid; i < 64 * PT / 2; i += 512) ((LAS unsigned*)SB)[i] = 0u;
    __syncthreads();
    for (int sc = 0; sc < 64; ++sc) {
        const int u = (b * 64 + sc) * 8 + h;
        float* Nb = (float*)(F.ws + WS_ST_RW) + (size_t)u * 4096; const bf16* MT = (const bf16*)(F.ws + WS_MT) + (size_t)u * 4096;
        f32x4 nw[2];
#pragma unroll
        for (int ci = 0; ci < 2; ++ci) { const int ct = 2 * (w >> 2) + ci;
            f32x4 nv;
#pragma unroll
            for (int jj = 0; jj < 4; ++jj) { float* p = Nb + (16 * vb + 4 * q4 + jj) * 64 + 16 * ct + r16; nv[jj] = *p; *p = Sacc[ci][jj]; }
            nw[ci] = mm_lg<64>(SB, PT, 16 * vb, MT, 64, 16 * ct, nv, lane); }
        __syncthreads();
#pragma unroll
        for (int ci = 0; ci < 2; ++ci) { const int ct = 2 * (w >> 2) + ci; Sacc[ci] = nw[ci];
#pragma unroll
            for (int jj = 0; jj < 4; ++jj) SB[(16 * vb + 4 * q4 + jj) * PT + 16 * ct + r16] = (bf16)f2bf(nw[ci][jj]); }
        __syncthreads();
    }
}
__device__ __forceinline__ void elem_scans(Frame& F, int blk, int nblk) {
    const int tid = otid();
    const int NRET = 16 * 4096, NSSD = 16 * 8192;
    const float* dst = (const float*)(F.ws + WS_DSTOT);
    for (int it = blk * 512 + tid; it < NRET + NSSD; it += nblk * 512) {
        if (it < NRET) { const int chain = it >> 12, e = it & 4095, b = chain >> 3, h = chain & 7;
            const float g256 = exp2f(256.f * log2f(1.f - exp2f(-5.f - (float)h)));
            float* p = (float*)(F.ws + WS_ST_RET) + ((size_t)(b * 64) * 8 + h) * 4096 + e; float carry = 0.f;
#pragma unroll 8
            for (int sc = 0; sc < 64; ++sc) { const float t = p[(size_t)sc * 8 * 4096]; p[(size_t)sc * 8 * 4096] = carry; carry = g256 * carry + t; }
        } else { const int i2 = it - NRET, chain = i2 >> 13, e = i2 & 8191, b = chain >> 3, h = chain & 7;
            float* p = (float*)(F.ws + WS_ST_SSD) + ((size_t)(b * 64) * 8 + h) * 8192 + e; const float* d = dst + (b * 64) * 8 + h; float carry = 0.f;
#pragma unroll 8
            for (int sc = 0; sc < 64; ++sc) { const float t = p[(size_t)sc * 8 * 8192]; p[(size_t)sc * 8 * 8192] = carry; carry = expf(d[sc * 8]) * carry + t; }
        }
    }
}
__device__ __forceinline__ void conv_lora(Frame& F) {
    const int tid = otid();
    for (int l = 0; l < 2; ++l) {
        bf16* base = (bf16*)(F.ws + WS_LORA + (size_t)l * LORA_STRIDE);
        const float* wu = INP(4) + l * 64 * 512; const float* au = INP(6) + l * 64 * 512; const float* gu = INP(8) + l * 128 * 512;
        for (int i = F.vcu * 512 + tid; i < 512 * 64; i += F.G * 512) { const int c = i >> 6, jx = i & 63; base[i] = (bf16)f2bf(wu[jx * 512 + c]); base[32768 + i] = (bf16)f2bf(au[jx * 512 + c]); }
        for (int i = F.vcu * 512 + tid; i < 512 * 128; i += F.G * 512) { const int c = i >> 7, jx = i & 127; base[65536 + i] = (bf16)f2bf(gu[jx * 512 + c]); }
    }
}
__device__ __forceinline__ void save_bnd(Frame& F) {
    const int tid = otid();
    const bf16* P = (const bf16*)(F.ws + WS_BIG); bf16* BND = (bf16*)(F.ws + WS_BND);
    for (int i = F.vcu * 512 + tid; i < 2 * 64 * 3 * 64; i += F.G * 512) { const int ch = i & 63, k = (i >> 6) % 3, bs = i / 192, b = bs >> 6, sc = bs & 63;
        if (sc > 0) *(u32x4*)(BND + (size_t)(bs * 3 + k) * 512 + ch * 8) = *(const u32x4*)(P + ((size_t)b * T + sc * 256 - 3 + k) * PLD + C_XBC + ch * 8); }
}

constexpr int LAYER_BASE0 = 1, LAYER_STRIDE = 17, MOE_BASE = LAYER_BASE0 + LAYER_STRIDE + 14;
__device__ __forceinline__ Frame lf(const Frame& F0) {
    Frame F = F0; unsigned l = (unsigned)(unsigned long long)F.lds;
    asm volatile("" : "+s"(l), "+s"(F.vcu), "+s"(F.G), "+s"(F.cid), "+s"(F.wid), "+s"(F.out), "+s"(F.ws));
    F.lds = (LAS unsigned char*)(unsigned long long)l; return F;
}
__global__ void __launch_bounds__(512, 2) fwd(Args args) {
    extern __shared__ __attribute__((aligned(16))) unsigned char lds_raw[];
    Frame F0;
    F0.lds = (LAS unsigned char*)lds_raw;
    F0.G = gridDim.x; { const int bx = blockIdx.x; F0.vcu = (F0.G % 8 == 0) ? (bx % 8) * (F0.G / 8) + bx / 8 : bx; }
    F0.cid = blockIdx.x; F0.out = args.out; F0.ws = args.ws; F0.wid = __builtin_amdgcn_readfirstlane(threadIdx.x >> 6);
    volatile LAS unsigned* MISC = (volatile LAS unsigned*)(F0.lds + MISC_OFF);
    for (int u = threadIdx.x; u < (LDS_BYTES - LDSCTL_OFF) / 4; u += 512) ((LAS unsigned*)(F0.lds + LDSCTL_OFF))[u] = 0u;
    __syncthreads();
    if (threadIdx.x < 34) *(LAS unsigned long long*)(F0.lds + LDSCTL_OFF + 8 * threadIdx.x) = (unsigned long long)args.in[threadIdx.x];
    __syncthreads();
    const int lo = args.ph_lo, hi = args.ph_hi;
    XcdBarrier bar; bar.bar = (unsigned*)(F0.ws + WS_CTL); bar.x = 0; bar.st = nullptr;
    if (hi - lo > 1) bar = xcd_barrier_post((unsigned*)(F0.ws + WS_CTL), MISC + 8);
#define IN(k) (lo <= (k) && (k) < hi)
#define SEAM(k) do { if (IN(k) && IN((k) + 1)) xcd_barrier(bar); } while (0)
#define WSP(T_, off) ((T_*)(F.ws + (off)))

    if (IN(0)) { for (int rep = 0; rep <= REP_CONV; ++rep) { Frame F = lf(F0); conv_layer_weights(F, 0); conv_layer_weights(F, 1); conv_ffn_weights(F); conv_lora(F); }
        for (int rep = 0; rep <= REP_MISC; ++rep) { Frame F = lf(F0); xprep_phase(F, INP(0)); } }
    SEAM(0);
    for (int l = 0; l < 2; ++l) {
        const int pb = LAYER_BASE0 + l * LAYER_STRIDE;
        if (IN(pb + 0)) {
            Frame F = lf(F0); unsigned char* wl = F.ws + WS_W + (size_t)l * WL_STRIDE;
            pg8::Gemm g{WSP(bf16, WS_XB), (const bf16*)(wl + WL_IN), D, D, D}; pg8::StaticOrder S; S.init(M, NP, F.G, F.cid, D, D);
            pg8::EpiInProj E{WSP(bf16, WS_BIG), WSP(float, WS_RSTD), WSP(float, WS_DT)};
            pg8::gemm_phase(F.lds, F.wid, g, S, E);
        }
        SEAM(pb + 0);
        if (IN(pb + 1)) for (int rep = 0; rep <= REP_MISC; ++rep) { Frame F = lf(F0); vprep_phase(F, l); save_bnd(F); }
        SEAM(pb + 1);
        if (IN(pb + 2)) for (int rep = 0; rep <= REP_R1; ++rep) {
#if RW_CH
            for (int r2 = 0; r2 <= REP_RW; ++r2) { Frame F = lf(F0); for (int u = F.cid; u < 1024; u += F.G) rwkv_chunk_unit<false>(F, l, u); }
#else
            { Frame F = lf(F0); if (F.cid < 16) rwkv_seq(F, l, F.cid); }
#endif
#if RET_CH
            for (int r2 = 0; r2 <= REP_RET; ++r2) { Frame F = lf(F0); for (int u = F.cid; u < 1024; u += F.G) ret_chunk_unit<false>(F, u); }
#else
            { Frame F = lf(F0); if (F.cid >= 32 && F.cid < 48) ret_seq(F, F.cid - 32); }
#endif
#if SSD_CH
            for (int r2 = 0; r2 <= REP_SSD; ++r2) { Frame F = lf(F0); for (int u = F.cid; u < 1024; u += F.G) ssd_chunk_unit<false>(F, l, u); }
#else
            { Frame F = lf(F0); if (F.cid >= 16 && F.cid < 32) ssd_seq(F, l, F.cid - 16); }
#endif
        }
        SEAM(pb + 2);
        if (IN(pb + 3)) {
            Frame F = lf(F0);
            if (F.cid < 16) { if (RW_CH) rwkv_scan_chain(F, F.cid); }
            else elem_scans(F, F.cid - 16, F.G - 16);
        }
        SEAM(pb + 3);
        if (IN(pb + 4)) {
#if RW_CH
            { Frame F = lf(F0); for (int u = F.cid; u < 1024; u += F.G) rwkv_chunk_unit<true>(F, l, u); }
#endif
#if RET_CH
            { Frame F = lf(F0); for (int u = F.cid; u < 1024; u += F.G) ret_chunk_unit<true>(F, u); }
#endif
#if SSD_CH
            { Frame F = lf(F0); for (int u = F.cid; u < 1024; u += F.G) ssd_chunk_unit<true>(F, l, u); }
#endif
        }
        SEAM(pb + 4);
        if (IN(pb + 5)) { Frame F = lf(F0); ssm_norm_phase(F, l); xprep_phase(F, (l == 0) ? INP(0) : F.out); }
        SEAM(pb + 5);
        for (int i = 0; i < 3; ++i) {
            if (IN(pb + 6 + 2 * i)) {
                Frame F = lf(F0); unsigned char* wl = F.ws + WS_W + (size_t)l * WL_STRIDE; bf16* P = WSP(bf16, WS_BIG);
                const bf16* A = (i == 0) ? WSP(const bf16, WS_YRW) : (i == 1 ? P + C_Z : P + C_RETG);
                pg8::Gemm g{A, (const bf16*)(wl + WL_BR) + (size_t)i * D * 512, (i == 0) ? 512 : PLD, 512, 512}; pg8::StaticOrder S; S.init(M, D, F.G, F.cid, (i == 0) ? 512 : PLD, 512);
                pg8::EpiPlain E{P, PLD};
                pg8::gemm_phase(F.lds, F.wid, g, S, E);
            }
            SEAM(pb + 6 + 2 * i);
            if (IN(pb + 7 + 2 * i)) {
                Frame F = lf(F0); unsigned char* wl = F.ws + WS_W + (size_t)l * WL_STRIDE; bf16* P = WSP(bf16, WS_BIG);
                pg8::Gemm g{WSP(bf16, WS_XB), (const bf16*)(wl + WL_GATE) + (size_t)i * D * D, D, D, D}; pg8::StaticOrder S; S.init(M, D, F.G, F.cid, D, D);
                pg8::EpiGateMerge E{P, PLD, P + C_RET, PLD, WSP(float, WS_RSTD), i == 0};
                pg8::gemm_phase(F.lds, F.wid, g, S, E);
            }
            SEAM(pb + 7 + 2 * i);
        }
        if (IN(pb + 12)) {
            Frame F = lf(F0); unsigned char* wl = F.ws + WS_W + (size_t)l * WL_STRIDE; bf16* P = WSP(bf16, WS_BIG);
            pg8::Gemm g{P + C_RET, (const bf16*)(wl + WL_OUT), PLD, D, D}; pg8::StaticOrder S; S.init(M, D, F.G, F.cid, PLD, D);
            pg8::EpiResid E{(l == 0) ? INP(0) : F.out, F.out, nullptr, 0};
            pg8::gemm_phase(F.lds, F.wid, g, S, E);
        }
        SEAM(pb + 12);
        if (IN(pb + 13)) { Frame F = lf(F0); xprep_phase(F, F.out); if (l == 1) for (int rep = 0; rep <= REP_CONV; ++rep) conv_moe_weights(F); }
        SEAM(pb + 13);
        if (l == 0) {
            if (IN(pb + 14)) {
                Frame F = lf(F0);
                pg8::Gemm g{WSP(bf16, WS_XB), WSP(const bf16, WS_FFUP), D, D, D}; pg8::StaticOrder S; S.init(M, 2 * FF, F.G, F.cid, D, D);
                pg8::EpiSwiglu E{WSP(bf16, WS_ACT), FF, WSP(float, WS_RSTD)};
                pg8::gemm_phase(F.lds, F.wid, g, S, E);
            }
            SEAM(pb + 14);
            if (IN(pb + 15)) {
                Frame F = lf(F0);
                pg8::Gemm g{WSP(const bf16, WS_ACT), WSP(const bf16, WS_FFDN), FF, FF, FF}; pg8::StaticOrder S; S.init(M, D, F.G, F.cid, FF, FF);
                pg8::EpiResid E{F.out, F.out, nullptr, 0};
                pg8::gemm_phase(F.lds, F.wid, g, S, E);
            }
            SEAM(pb + 15);
            if (IN(pb + 16)) { Frame F = lf(F0); xprep_phase(F, F.out); }
            SEAM(pb + 16);
        }
    }
    {
        const int pb = MOE_BASE;
        if (IN(pb)) { Frame F = lf(F0); router_phase(F); }
        SEAM(pb);
        for (int sg = 0; sg < 3; ++sg) {
            if (IN(pb + 1 + 2 * sg)) {
                Frame F = lf(F0);
                pg8::Gemm g{WSP(bf16, WS_XB), WSP(const bf16, WS_MOEW), D, D, D}; pg8::MoeOrder<true> S; S.init(WSP(const int, WS_CNT), WSP(const int, WS_LIST), sg, 2 * FFE, F.G, F.cid, D, D, MOEW_STRIDE);
                pg8::EpiSwiglu E{WSP(bf16, WS_ACT), FFE, WSP(float, WS_RSTD)};
                pg8::gemm_phase(F.lds, F.wid, g, S, E);
            }
            SEAM(pb + 1 + 2 * sg);
            if (IN(pb + 2 + 2 * sg)) {
                Frame F = lf(F0);
                pg8::Gemm g{WSP(const bf16, WS_ACT), WSP(const bf16, WS_MOEW + MOEW_DN), FFE, FFE, FFE}; pg8::MoeOrder<false> S; S.init(WSP(const int, WS_CNT), WSP(const int, WS_LIST), sg, D, F.G, F.cid, FFE, FFE, MOEW_STRIDE);
                pg8::EpiMoeDown E{F.out};
                pg8::gemm_phase(F.lds, F.wid, g, S, E);
            }
            SEAM(pb + 2 + 2 * sg);
        }
        if (IN(pb + 7)) { Frame F = lf(F0); final_norm_phase(F); }
    }
#undef IN
#undef SEAM
#undef WSP
}
constexpr int LAST_PHASE = MOE_BASE + 7;
constexpr int N_PH = LAST_PHASE + 1;

extern "C" void kernel_launch(void* const* d_in, const int* in_sizes, int n_in, void* d_out, int out_size, void* d_ws, size_t ws_size, hipStream_t stream) {
    static int grid = 0;
    if (grid == 0) {
        if (n_in != 34 || out_size != M * D || ws_size < WS_END) { fprintf(stderr, "kernel_launch: unexpected problem (n_in %d out %d ws %zu need %zu)\n", n_in, out_size, ws_size, (size_t)WS_END); grid = -1; return; }
        int dev = 0, cus = 0;
        if (hipGetDevice(&dev) != hipSuccess || hipDeviceGetAttribute(&cus, hipDeviceAttributeMultiprocessorCount, dev) != hipSuccess) { grid = -1; return; }
        if (hipFuncSetAttribute((const void*)fwd, hipFuncAttributeMaxDynamicSharedMemorySize, LDS_BYTES) != hipSuccess) { fprintf(stderr, "kernel_launch: hipFuncSetAttribute failed\n"); grid = -1; return; }
        int per_cu = 0;
        if (hipOccupancyMaxActiveBlocksPerMultiprocessor(&per_cu, (const void*)fwd, 512, LDS_BYTES) != hipSuccess || per_cu < 1) fprintf(stderr, "kernel_launch: occupancy query says %d\n", per_cu);
        (void)hipGetLastError();
        grid = cus;
    }
    if (grid < 0) return;
    (void)hipMemsetAsync((char*)d_ws + WS_CTL, 0, CTL_ZERO_BYTES, stream);
    Args a{};
    for (int i = 0; i < 34; ++i) a.in[i] = (const float*)d_in[i];
    a.out = (float*)d_out; a.ws = (unsigned char*)d_ws;
#if MK_ONE_LAUNCH
    a.ph_lo = 0; a.ph_hi = N_PH;
    hipLaunchKernelGGL(fwd, dim3(grid), dim3(512), LDS_BYTES, stream, a);
#else
    for (int p = 0; p < N_PH; ++p) { a.ph_lo = p; a.ph_hi = p + 1; hipLaunchKernelGGL(fwd, dim3(grid), dim3(512), LDS_BYTES, stream, a); }
#endif
}
```

```cpp
#include <hip/hip_runtime.h>
#include <cstdio>
#include <cstdint>

#ifndef MK_ONE_LAUNCH
#define MK_ONE_LAUNCH 1
#endif

#define LAS __attribute__((address_space(3)))
#define GAS __attribute__((address_space(1)))
typedef unsigned short bf16;
typedef short bf16x8 __attribute__((ext_vector_type(8)));
typedef float f32x4 __attribute__((ext_vector_type(4)));
typedef float f32x2 __attribute__((ext_vector_type(2)));
typedef unsigned u32x4 __attribute__((ext_vector_type(4)));
typedef unsigned u32x2 __attribute__((ext_vector_type(2)));

constexpr int BATCH = 2, T = 16384, D = 1024, M = BATCH * T;
constexpr int INC = 8456;
constexpr int PLD = 5376;
constexpr int NP = 5632;
constexpr int C_RW = 0, C_Z = 1792, C_XBC = 2304, C_RET = 3328, C_RETG = 4864;
constexpr int FF = 2816, FFE = 3584, NE = 8;

constexpr size_t MiB = 1u << 20;
constexpr size_t WS_CTL = 0, CTL_ZERO_BYTES = 64 * 1024;
constexpr size_t WS_RSTD = 1 * MiB, WS_GATES = 2 * MiB, WS_DT = 3 * MiB;
constexpr size_t WS_W = 4 * MiB;
constexpr size_t WL_IN = 0, WL_GATE = 11 * MiB, WL_BR = 17 * MiB, WL_OUT = 20 * MiB, WL_STRIDE = 22 * MiB;
constexpr size_t WS_FFUP = WS_W + 44 * MiB, WS_FFDN = WS_W + 55 * MiB;
constexpr size_t WS_XB = 68 * MiB;
constexpr size_t WS_VF = 132 * MiB;
constexpr size_t WS_BIG = 164 * MiB;
constexpr size_t WS_VMIX = WS_BIG + 336 * MiB, WS_YRW = WS_BIG + 368 * MiB, WS_END = 573 * MiB;
constexpr size_t WS_MOEW = WS_BIG;
constexpr size_t MOEW_STRIDE = 21 * MiB, MOEW_DN = 14 * MiB;
constexpr size_t WS_ACT = WS_BIG + 168 * MiB;

constexpr size_t WS_CNT = 32768, WS_LIST = 2 * MiB;
constexpr size_t WS_BND2 = 566 * MiB;
constexpr size_t WS_DSTOT = 128 * 1024, WS_BND = 256 * 1024;
constexpr size_t WS_LORA = 1 * MiB + 512 * 1024, LORA_STRIDE = 262144;
constexpr size_t WS_ST_RW = WS_XB, WS_ST_RET = WS_XB + 16 * MiB, WS_ST_SSD = WS_XB + 32 * MiB, WS_MT = WS_YRW;
constexpr int RING_BYTES = 131072, LDSCTL_OFF = 159744, MISC_OFF = LDSCTL_OFF + 320, LDS_BYTES = 163840;
#ifndef REP_CONV
#define REP_CONV 0
#endif
#ifndef REP_R1
#define REP_R1 0
#endif
#ifndef REP_RW
#define REP_RW 0
#endif
#ifndef REP_RET
#define REP_RET 0
#endif
#ifndef REP_SSD
#define REP_SSD 0
#endif
#ifndef REP_MISC
#define REP_MISC 0
#endif
#ifndef RW_CH
#define RW_CH 1
#endif
#ifndef RET_CH
#define RET_CH 1
#endif
#ifndef SSD_CH
#define SSD_CH 1
#endif

typedef __bf16 hbf16x2 __attribute__((ext_vector_type(2)));
__device__ __forceinline__ unsigned pk2(float lo, float hi) { const f32x2 v = {lo, hi}; return __builtin_bit_cast(unsigned, __builtin_convertvector(v, hbf16x2)); }
__device__ __forceinline__ unsigned f2bf(float f) { return (unsigned)__builtin_bit_cast(unsigned short, (__bf16)f); }
__device__ __forceinline__ float bflo(unsigned u) { return __builtin_bit_cast(float, u << 16); }
__device__ __forceinline__ float bfhi(unsigned u) { return __builtin_bit_cast(float, u & 0xffff0000u); }
__device__ __forceinline__ void unpack8(const u32x4 u, float (&f)[8]) { f[0] = bflo(u.x); f[1] = bfhi(u.x); f[2] = bflo(u.y); f[3] = bfhi(u.y); f[4] = bflo(u.z); f[5] = bfhi(u.z); f[6] = bflo(u.w); f[7] = bfhi(u.w); }
__device__ __forceinline__ u32x4 pack8(const float (&f)[8]) { u32x4 w; w.x = pk2(f[0], f[1]); w.y = pk2(f[2], f[3]); w.z = pk2(f[4], f[5]); w.w = pk2(f[6], f[7]); return w; }
__device__ __forceinline__ float sigm(float x) { return __builtin_amdgcn_rcpf(1.f + __expf(-x)); }
__device__ __forceinline__ float silu(float x) { return x * __builtin_amdgcn_rcpf(1.f + __expf(-x)); }
__device__ __forceinline__ float ex2(float x) { return __builtin_amdgcn_exp2f(x); }
__device__ __forceinline__ float fast_tanh(float x) { return 1.f - 2.f * __builtin_amdgcn_rcpf(1.f + __expf(2.f * x)); }
__device__ __forceinline__ float softplus_acc(float x) { return fmaxf(x, 0.f) + log1pf(expf(-fabsf(x))); }
__device__ __forceinline__ float wave_sum(float v) {
#pragma unroll
    for (int o = 1; o < 64; o <<= 1) v += __shfl_xor(v, o);
    return v;
}
__device__ __forceinline__ int otid_w(int wid) { unsigned z = 0u; asm volatile("" : "+v"(z)); int t = wid * 64 + (int)__builtin_amdgcn_mbcnt_hi(~0u, __builtin_amdgcn_mbcnt_lo(~0u, z)); asm volatile("" : "+v"(t)); return t; }
#define otid() otid_w(F.wid)
__device__ __forceinline__ int fresh_tid(int t) { asm volatile("" : "+v"(t)); return t; }
#define LDS_WAIT() asm volatile("s_waitcnt lgkmcnt(0)" ::: "memory")

namespace pg8 {
constexpr int BM = 256, BK = 64, HALF = 128, HTB = HALF * BK * 2, STAGE_BYTES = 8 * HTB, NXCD = 8, WGM = 8;
__host__ __device__ __forceinline__ int lds_byte(int r, int c) { const int st = (r >> 4) * 2 + (c >> 5), rr = r & 15, cc = c & 31, ob = rr * 64 + cc * 2; return st * 1024 + (ob ^ (((ob >> 9) & 1) << 5)); }
__host__ __device__ __forceinline__ void stage_rc(int b, int& R, int& C) { const int st = b / 1024, sb = b % 1024, swz = sb ^ (((sb >> 9) & 1) << 5); R = (st >> 1) * 16 + swz / 64; C = (st & 1) * 32 + (swz % 64) / 2; }
__host__ __device__ __forceinline__ int perm32(int rho) { const int n = rho >> 4, i = rho & 15; return 8 * (i >> 2) + 4 * n + (i & 3); }

struct Unit { int pm, pn; size_t aofs, bofs; const int* rows; int nvalid, e; };
struct Gemm { const bf16* A; const bf16* Bt; int lda, ldb, K; };

struct StaticOrder {
    static constexpr bool GATHER = false;
    int nM, nN, nwg, G, c; size_t tsA, tsB;
    __device__ __forceinline__ void init(int Mrows, int N, int G_, int c_, int lda, int ldb) { nM = Mrows / BM; nN = N / BM; nwg = nM * nN; G = G_; c = c_; tsA = (size_t)BM * lda * 2; tsB = (size_t)BM * ldb * 2; }
    __device__ __forceinline__ bool next(int i, Unit& u) const {
        const long L = (long)i * G + c; if (L >= nwg) return false;
        int wgid = (int)L; { const int q = nwg / NXCD, r = nwg % NXCD, xcd = wgid % NXCD, off = wgid / NXCD; wgid = (xcd < r ? xcd * (q + 1) : r * (q + 1) + (xcd - r) * q) + off; }
        const int nig = WGM * nN, gid = wgid / nig, fm = gid * WGM, gsz = (nM - fm) < WGM ? (nM - fm) : WGM;
        u.pm = fm + ((wgid % nig) % gsz); u.pn = (wgid % nig) / gsz; u.aofs = (size_t)u.pm * tsA; u.bofs = (size_t)u.pn * tsB; u.rows = nullptr; u.nvalid = BM; u.e = 0; return true;
    }
};
template <bool GATH> struct MoeOrder {
    static constexpr bool GATHER = GATH;
    unsigned q0, q1, q2, q3;
    int seg, nN, G, c; const int* list; size_t bstride, tsB, tsA;
    __device__ __forceinline__ void init(const int* counts, const int* list_, int seg_, int N, int G_, int c_, int lda, int ldb, size_t bstride_) {
        unsigned n[8];
#pragma unroll
        for (int e = 0; e < 8; ++e) { int v = __builtin_amdgcn_readfirstlane(counts[e]); v = v < 0 ? 0 : (v > 32768 ? 32768 : v); n[e] = (unsigned)v; }
        q0 = n[0] | (n[1] << 16); q1 = n[2] | (n[3] << 16); q2 = n[4] | (n[5] << 16); q3 = n[6] | (n[7] << 16);
        seg = seg_; nN = N / BM; G = G_; c = c_; list = list_; bstride = bstride_; tsB = (size_t)BM * ldb * 2; tsA = (size_t)BM * lda * 2;
    }
    __device__ __forceinline__ bool next(int i, Unit& u) const {
        const long L = (long)i * G + c; const int tl = (int)(L / nN), pn = (int)(L % nN), gt = seg * 128 + tl;
        int t = 0, e = 0, tbe = 0, cne = 0;
#pragma unroll
        for (int k = 0; k < 8; ++k) { const unsigned q = (k < 2) ? q0 : (k < 4) ? q1 : (k < 6) ? q2 : q3; const int n = (int)((k & 1) ? (q >> 16) : (q & 0xffffu));
            if (gt >= t) { e = k; tbe = t; cne = n; } t += (n + 255) >> 8; }
        int nt = t - seg * 128; nt = nt < 0 ? 0 : (nt > 128 ? 128 : nt);
        if (L >= (long)nt * nN) return false;
        const int rt = gt - tbe;
        u.pm = tl; u.pn = pn; u.e = e; u.bofs = (size_t)e * bstride + (size_t)pn * tsB; u.aofs = GATH ? 0 : (size_t)tl * tsA;
        u.rows = list + ((size_t)e * 32768 + rt * 256) * 2; int nv = cne - rt * 256; u.nvalid = nv > 256 ? 256 : nv; return true;
    }
};

template <class Epi, class Sched>
__device__ __forceinline__ void gemm_phase(LAS unsigned char* lds, int wid0, const Gemm g, const Sched& S, const Epi& E) {
    constexpr bool GATHER = Sched::GATHER;
    const int tid = otid_w(wid0), wid = __builtin_amdgcn_readfirstlane(tid >> 6), lane = tid & 63, wr = wid >> 2, wc = wid & 3, fr = lane & 15, fq = lane >> 4;
    const int nt = g.K / BK;
    unsigned voffA[2], voffB[2];
#pragma unroll
    for (int i = 0; i < 2; ++i) { int R, C; stage_rc(tid * 16 + i * 8192, R, C); const int Rb = Epi::PERM ? ((R & ~31) + perm32(R & 31)) : R;
        voffA[i] = (unsigned)(R * g.lda + C) * 2u; voffB[i] = (unsigned)(Rb * g.ldb + C) * 2u; }
    const size_t kstep = (size_t)(BK * 2);
    const size_t hstepA = GATHER ? 0 : (size_t)HALF * g.lda * 2, hstepB = (size_t)HALF * g.ldb * 2;
    const unsigned ldsw = (unsigned)wid * 1024u;
    const int aoff = lds_byte(wr * 64 + fr, fq * 8), boff = lds_byte(wc * 32 + fr, fq * 8);
#define PG8_SA(b, h) (((b) * 2 + (h)) * HTB)
#define PG8_SB(b, h) ((4 + (b) * 2 + (h)) * HTB)
#define PG8_STAGE2(bufoff, gbase, o0, o1) do { \
        __builtin_amdgcn_global_load_lds((const unsigned*)((const char*)(gbase) + (o0)), (LAS unsigned*)(lds + (bufoff) + ldsw), 16, 0, 0); \
        __builtin_amdgcn_global_load_lds((const unsigned*)((const char*)(gbase) + (o1)), (LAS unsigned*)(lds + (bufoff) + ldsw + 8192), 16, 0, 0); } while (0)
#define PG8_STAGE(bufoff, gbase, voff) PG8_STAGE2(bufoff, gbase, (voff)[0], (voff)[1])
#define PG8_LDA(dst, b, h) do { _Pragma("unroll") for (int m = 0; m < 4; ++m) _Pragma("unroll") for (int k = 0; k < 2; ++k) dst[m][k] = *(const LAS bf16x8*)(lds + PG8_SA(b, h) + aoff + m * 2048 + k * 1024); } while (0)
#define PG8_LDB(dst, b, h) do { _Pragma("unroll") for (int n = 0; n < 2; ++n) _Pragma("unroll") for (int k = 0; k < 2; ++k) dst[n][k] = *(const LAS bf16x8*)(lds + PG8_SB(b, h) + boff + n * 2048 + k * 1024); } while (0)
#define PG8_MMA(ai, bj, At, Bt) do { __builtin_amdgcn_s_setprio(1); _Pragma("unroll") for (int m = 0; m < 4; ++m) _Pragma("unroll") for (int n = 0; n < 2; ++n) _Pragma("unroll") for (int k = 0; k < 2; ++k) \
        acc[ai][bj][m][n] = Epi::TRANS ? __builtin_amdgcn_mfma_f32_16x16x32_bf16(Bt[n][k], At[m][k], acc[ai][bj][m][n], 0, 0, 0) : __builtin_amdgcn_mfma_f32_16x16x32_bf16(At[m][k], Bt[n][k], acc[ai][bj][m][n], 0, 0, 0); __builtin_amdgcn_s_setprio(0); } while (0)
#define PG8_WAIT_V(n) asm volatile("s_waitcnt vmcnt(" #n ")" ::: "memory")
#define PG8_WAIT_L(n) asm volatile("s_waitcnt lgkmcnt(" #n ")" ::: "memory")
#define PG8_BAR __builtin_amdgcn_s_barrier()
#define PG8_SCHED __builtin_amdgcn_sched_barrier(0)
#define GSLOT(which) ((LAS u32x4*)(lds + 131072 + (which) * 8192 + tid * 16))
#define PG8_ROWS(u, which) do { const int _ft = fresh_tid(tid); unsigned _vg[2][2]; _Pragma("unroll") for (int _i = 0; _i < 2; ++_i) { int _R, _C; stage_rc(_ft * 16 + _i * 8192, _R, _C); \
        _Pragma("unroll") for (int _h = 0; _h < 2; ++_h) { const int _r = _h * HALF + _R; \
        const int _t = (_r < (u).nvalid) ? (u).rows[2 * _r] : 0; _vg[_h][_i] = ((unsigned)_t * (unsigned)g.lda + (unsigned)_C) * 2u; } } \
        u32x4 _o; _o.x = _vg[0][0]; _o.y = _vg[0][1]; _o.z = _vg[1][0]; _o.w = _vg[1][1]; *GSLOT(which) = _o; } while (0)
    Unit cur, nxt; int ui = 0;
    if (!S.next(0, cur)) return;
    f32x4 acc[2][2][4][2];
#pragma unroll
    for (int a = 0; a < 2; ++a)
#pragma unroll
        for (int b = 0; b < 2; ++b)
#pragma unroll
            for (int m = 0; m < 4; ++m)
#pragma unroll
                for (int n = 0; n < 2; ++n) acc[a][b][m][n] = (f32x4){0.f, 0.f, 0.f, 0.f};
    bf16x8 At[4][2], B0[2][2], B1[2][2];
    u32x4 gc = {voffA[0], voffA[1], voffA[0], voffA[1]};
    if constexpr (GATHER) { PG8_ROWS(cur, 0); PG8_ROWS(cur, 1); gc = *GSLOT(0); }
#define VGC(h, i) (gc[2 * (h) + (i)])
    const char* cA = (const char*)g.A + cur.aofs; const char* cB = (const char*)g.Bt + cur.bofs;
    PG8_STAGE(PG8_SB(0, 0), cB, voffB); PG8_STAGE(PG8_SB(0, 1), cB + hstepB, voffB); PG8_STAGE2(PG8_SA(0, 0), cA, VGC(0, 0), VGC(0, 1)); PG8_STAGE2(PG8_SA(0, 1), cA + hstepA, VGC(1, 0), VGC(1, 1));
    if (wr == 1) PG8_BAR;
    PG8_WAIT_V(2); PG8_BAR;
    PG8_STAGE(PG8_SB(1, 0), cB + kstep, voffB); PG8_STAGE2(PG8_SA(1, 0), cA + kstep, VGC(0, 0), VGC(0, 1)); PG8_STAGE(PG8_SB(1, 1), cB + hstepB + kstep, voffB);
    PG8_WAIT_V(6); PG8_BAR;
    for (;;) {
        const bool has_next = S.next(ui + 1, nxt);
        const char* nA = has_next ? (const char*)g.A + nxt.aofs : cA; const char* nB = has_next ? (const char*)g.Bt + nxt.bofs : cB;
        if constexpr (GATHER) { if (has_next) PG8_ROWS(nxt, 1); else *GSLOT(1) = *GSLOT(0); }
        for (int t = 0; t < nt; t += 2) {
            const bool last = (t == nt - 2);
            const char* a1 = cA + (size_t)(t + 1) * kstep;
            const char* a2 = last ? nA : cA + (size_t)(t + 2) * kstep; const char* b2 = last ? nB : cB + (size_t)(t + 2) * kstep;
            const char* a3 = a2 + kstep; const char* b3 = b2 + kstep;
            u32x4 gn = gc; if constexpr (GATHER) { gc = *GSLOT(0); gn = last ? *GSLOT(1) : gc; }
            const unsigned s00 = gn.x, s01 = gn.y, s10 = gn.z, s11 = gn.w;
            PG8_LDB(B0, 0, 0); PG8_LDB(B1, 0, 1); PG8_SCHED; PG8_LDA(At, 0, 0); PG8_STAGE2(PG8_SA(1, 1), a1 + hstepA, VGC(1, 0), VGC(1, 1));
            PG8_WAIT_V(8); PG8_WAIT_L(0); PG8_BAR; PG8_MMA(0, 0, At, B0); PG8_MMA(0, 1, At, B1); PG8_BAR; PG8_SCHED;
            PG8_LDA(At, 0, 1); PG8_STAGE(PG8_SB(0, 0), b2, voffB); PG8_STAGE(PG8_SB(0, 1), b2 + hstepB, voffB); PG8_STAGE2(PG8_SA(0, 0), a2, s00, s01);
            PG8_WAIT_V(8); PG8_WAIT_L(0); PG8_BAR; PG8_MMA(1, 0, At, B0); PG8_MMA(1, 1, At, B1); PG8_BAR; PG8_SCHED;
            PG8_LDB(B0, 1, 0); PG8_LDB(B1, 1, 1); PG8_SCHED; PG8_LDA(At, 1, 0); PG8_STAGE2(PG8_SA(0, 1), a2 + hstepA, s10, s11);
            PG8_WAIT_V(8); PG8_WAIT_L(0); PG8_BAR; PG8_MMA(0, 0, At, B0); PG8_MMA(0, 1, At, B1); PG8_BAR; PG8_SCHED;
            PG8_LDA(At, 1, 1); PG8_STAGE(PG8_SB(1, 0), b3, voffB); PG8_STAGE(PG8_SB(1, 1), b3 + hstepB, voffB); PG8_STAGE2(PG8_SA(1, 0), a3, s00, s01);
            PG8_WAIT_V(8); PG8_WAIT_L(0); PG8_BAR; PG8_MMA(1, 0, At, B0); PG8_MMA(1, 1, At, B1); PG8_BAR; PG8_SCHED;
        }
        if (wr == 0) PG8_BAR;
        E(acc, cur, wr, wc, fr, fq);
        if (!has_next) break;
#pragma unroll
        for (int a = 0; a < 2; ++a)
#pragma unroll
            for (int b = 0; b < 2; ++b)
#pragma unroll
                for (int m = 0; m < 4; ++m)
#pragma unroll
                    for (int n = 0; n < 2; ++n) acc[a][b][m][n] = (f32x4){0.f, 0.f, 0.f, 0.f};
        cur = nxt; cA = nA; cB = nB; ++ui;
        if constexpr (GATHER) { *GSLOT(0) = *GSLOT(1); }
        if (wr == 1) PG8_BAR;
    }
    PG8_WAIT_V(0);
    PG8_BAR;
#undef PG8_SA
#undef PG8_SB
#undef PG8_STAGE
#undef PG8_STAGE2
#undef PG8_ROWS
#undef GSLOT
#undef VGC
#undef PG8_LDA
#undef PG8_LDB
#undef PG8_MMA
#undef PG8_WAIT_V
#undef PG8_WAIT_L
#undef PG8_BAR
#undef PG8_SCHED
}

typedef const f32x4 (&AccRef)[2][2][4][2];

struct EpiInProj {
    static constexpr bool PERM = true, TRANS = true;
    bf16* P; const float* rstd; float* dt;
    __device__ __forceinline__ void operator()(AccRef acc, const Unit& u, int wr, int wc, int fr, int fq) const {
        const int row0 = u.pm * BM + wr * 64 + fr;
        if (u.pn < 21) {
            const int col0 = u.pn * BM + wc * 32 + 8 * fq;
#pragma unroll
            for (int ai = 0; ai < 2; ++ai)
#pragma unroll
                for (int m = 0; m < 4; ++m) { const int row = row0 + ai * HALF + m * 16; const float s = rstd[row]; bf16* rowp = P + (size_t)row * PLD + col0;
#pragma unroll
                    for (int bj = 0; bj < 2; ++bj) { const f32x4 v0 = acc[ai][bj][m][0] * s, v1 = acc[ai][bj][m][1] * s;
                        u32x4 w; w.x = pk2(v0[0], v0[1]); w.y = pk2(v0[2], v0[3]); w.z = pk2(v1[0], v1[1]); w.w = pk2(v1[2], v1[3]);
                        *(u32x4*)(rowp + bj * HALF) = w; } }
        } else if (wc == 0 && fq == 0) {
#pragma unroll
            for (int ai = 0; ai < 2; ++ai)
#pragma unroll
                for (int m = 0; m < 4; ++m) { const int row = row0 + ai * HALF + m * 16; const float s = rstd[row];
                    *(f32x4*)(dt + (size_t)row * 8) = acc[ai][0][m][0] * s; *(f32x4*)(dt + (size_t)row * 8 + 4) = acc[ai][0][m][1] * s; }
        }
    }
};
struct EpiPlain {
    static constexpr bool PERM = true, TRANS = true;
    bf16* O; int ldc;
    __device__ __forceinline__ void operator()(AccRef acc, const Unit& u, int wr, int wc, int fr, int fq) const {
        const int row0 = u.pm * BM + wr * 64 + fr, col0 = u.pn * BM + wc * 32 + 8 * fq;
#pragma unroll
        for (int ai = 0; ai < 2; ++ai)
#pragma unroll
            for (int m = 0; m < 4; ++m) { bf16* rowp = O + (size_t)(row0 + ai * HALF + m * 16) * ldc + col0;
#pragma unroll
                for (int bj = 0; bj < 2; ++bj) { const f32x4 v0 = acc[ai][bj][m][0], v1 = acc[ai][bj][m][1];
                    u32x4 w; w.x = pk2(v0[0], v0[1]); w.y = pk2(v0[2], v0[3]); w.z = pk2(v1[0], v1[1]); w.w = pk2(v1[2], v1[3]);
                    *(u32x4*)(rowp + bj * HALF) = w; } }
    }
};
struct EpiGateMerge {
    static constexpr bool PERM = true, TRANS = true;
    const bf16* Y; int ldy; bf16* Mg; int ldm; const float* rstd; int first;
    __device__ __forceinline__ void operator()(AccRef acc, const Unit& u, int wr, int wc, int fr, int fq) const {
        const int row0 = u.pm * BM + wr * 64 + fr, col0 = u.pn * BM + wc * 32 + 8 * fq;
#pragma unroll
        for (int ai = 0; ai < 2; ++ai)
#pragma unroll
            for (int m = 0; m < 4; ++m) { const int row = row0 + ai * HALF + m * 16; const float s = rstd[row];
#pragma unroll
                for (int bj = 0; bj < 2; ++bj) { const int c = col0 + bj * HALF;
                    float y[8], o[8]; unpack8(*(const u32x4*)(Y + (size_t)row * ldy + c), y);
                    const f32x4 v0 = acc[ai][bj][m][0] * s, v1 = acc[ai][bj][m][1] * s;
#pragma unroll
                    for (int j = 0; j < 4; ++j) { o[j] = sigm(v0[j]) * y[j]; o[4 + j] = sigm(v1[j]) * y[4 + j]; }
                    if (!first) { float p[8]; unpack8(*(const u32x4*)(Mg + (size_t)row * ldm + c), p);
#pragma unroll
                        for (int j = 0; j < 8; ++j) o[j] += p[j]; }
                    *(u32x4*)(Mg + (size_t)row * ldm + c) = pack8(o); } }
    }
};
struct EpiResid {
    static constexpr bool PERM = false, TRANS = true;
    const float* xin; float* xout; const float* gates; int e;
    __device__ __forceinline__ void operator()(AccRef acc, const Unit& u, int wr, int wc, int fr, int fq) const {
        const int row0 = u.pm * BM + wr * 64 + fr, col0 = u.pn * BM + wc * 32 + 4 * fq;
#pragma unroll
        for (int ai = 0; ai < 2; ++ai)
#pragma unroll
            for (int m = 0; m < 4; ++m) { const int row = row0 + ai * HALF + m * 16; const float s = gates ? gates[(size_t)row * 8 + e] : 1.f;
                const float* ip = xin + (size_t)row * D + col0; float* op = xout + (size_t)row * D + col0;
#pragma unroll
                for (int bj = 0; bj < 2; ++bj)
#pragma unroll
                    for (int n = 0; n < 2; ++n) *(f32x4*)(op + bj * HALF + n * 16) = *(const f32x4*)(ip + bj * HALF + n * 16) + acc[ai][bj][m][n] * s; }
    }
};
struct EpiSwiglu {
    static constexpr bool PERM = true, TRANS = true;
    bf16* act; int ldc; const float* rstd;
    __device__ __forceinline__ void operator()(AccRef acc, const Unit& u, int wr, int wc, int fr, int fq) const {
        asm volatile("" : "+v"(fr), "+v"(fq));
        const int row0 = u.pm * BM + wr * 64 + fr, col0 = u.pn * HALF + wc * 32 + 8 * fq;
#pragma unroll
        for (int ai = 0; ai < 2; ++ai)
#pragma unroll
            for (int m = 0; m < 4; ++m) { const int row = row0 + ai * HALF + m * 16; const int lr = row - u.pm * BM;
                const float s = u.rows ? rstd[(lr < u.nvalid) ? u.rows[2 * lr] : 0] : rstd[row];
                float o[8];
#pragma unroll
                for (int n = 0; n < 2; ++n)
#pragma unroll
                    for (int j = 0; j < 4; ++j) o[4 * n + j] = silu(acc[ai][0][m][n][j] * s) * (acc[ai][1][m][n][j] * s);
                *(u32x4*)(act + (size_t)row * ldc + col0) = pack8(o); }
    }
};
struct EpiMoeDown {
    static constexpr bool PERM = false, TRANS = false;
    float* x;
    __device__ __forceinline__ void operator()(AccRef acc, const Unit& u, int wr, int wc, int fr, int fq) const {
        asm volatile("" : "+v"(fr), "+v"(fq));
        const int col0 = u.pn * BM + wc * 32 + fr;
#pragma unroll
        for (int ai = 0; ai < 2; ++ai)
#pragma unroll
            for (int m = 0; m < 4; ++m) { asm volatile("" ::: "memory");
#pragma unroll
                for (int j = 0; j < 4; ++j) { const int lr = ai * HALF + wr * 64 + m * 16 + 4 * fq + j;
                    if (lr < u.nvalid) { const int tok = u.rows[2 * lr]; const float wgt = __builtin_bit_cast(float, u.rows[2 * lr + 1]); float* xp = x + (size_t)tok * D + col0;
#pragma unroll
                        for (int bj = 0; bj < 2; ++bj)
#pragma unroll
                            for (int n = 0; n < 2; ++n) atomicAdd(xp + bj * HALF + n * 16, wgt * acc[ai][bj][m][n][j]); } } }
    }
};
}

#define XB_TMO      128
#define XB_XCNT(j)  (256  + 64 * (j))
#define XB_XSUB(j)  (1280 + 64 * (j))
#define XB_XGEN(j)  (2304 + 64 * (j))
#define XB_TOP      3328
#define XB_TOPGEN   3392
#define XCD_BAR_WORDS 3456
#define XB_SPIN_CAP (1u << 18)

__device__ __forceinline__ unsigned xb_ld(unsigned* p)              { return __hip_atomic_load(p, __ATOMIC_RELAXED, __HIP_MEMORY_SCOPE_AGENT); }
__device__ __forceinline__ unsigned xb_add(unsigned* p, unsigned v) { return __hip_atomic_fetch_add(p, v, __ATOMIC_RELAXED, __HIP_MEMORY_SCOPE_AGENT); }
__device__ __forceinline__ unsigned xb_xcc_id() { return (unsigned)__builtin_amdgcn_s_getreg((3 << 11) | 20) & 0xFu; }
#define XB_SPIN(cond, bar) do { unsigned _sp = 0; while (cond) { __builtin_amdgcn_s_sleep(1); \
    if ((++_sp & 255u) == 0u) { if (xb_ld(&(bar)[XB_TMO])) break; if (_sp > XB_SPIN_CAP) { atomicAdd(&(bar)[XB_TMO], 1u); break; } } } } while (0)

struct XcdBarrier { unsigned* bar; unsigned x; volatile LAS unsigned* st; };

__device__ __forceinline__ XcdBarrier xcd_barrier_post(unsigned* bar, volatile LAS unsigned* st) {
    XcdBarrier b; b.bar = bar; b.x = xb_xcc_id(); b.st = st;
    if (threadIdx.x == 0) (void)xb_add(&bar[XB_XCNT(b.x)], 1u);
    return b;
}
__device__ __forceinline__ void xcd_barrier_complete(unsigned* bar, unsigned x, unsigned& nloc, unsigned& nx) {
    const unsigned G = gridDim.x * gridDim.y * gridDim.z;
    unsigned sum, cnt, mine, sp = 0u;
    for (;;) {
        sum = 0u; cnt = 0u; mine = 0u;
#pragma unroll
        for (unsigned j = 0; j < 16; ++j) { const unsigned c = xb_ld(&bar[XB_XCNT(j)]); sum += c; cnt += (c > 0u) ? 1u : 0u; mine = (j == x) ? c : mine; }
        if (sum == G) break;
        __builtin_amdgcn_s_sleep(1);
        if ((++sp & 255u) == 0u) { if (xb_ld(&bar[XB_TMO])) break; if (sp > XB_SPIN_CAP) { atomicAdd(&bar[XB_TMO], 1u); break; } }
    }
    nloc = mine > 0u ? mine : 1u; nx = cnt > 0u ? cnt : 1u;
}
__device__ __forceinline__ void xcd_barrier(const XcdBarrier& b) {
    asm volatile("s_waitcnt vmcnt(0)" ::: "memory");
    __syncthreads();
    if (threadIdx.x == 0) {
        unsigned* bar = b.bar;
        __builtin_amdgcn_s_waitcnt(0);
        unsigned nloc = b.st[0], nx = b.st[1];
        if (nloc == 0u) { xcd_barrier_complete(bar, b.x, nloc, nx); b.st[0] = nloc; b.st[1] = nx; }
        const unsigned old = xb_add(&bar[XB_XSUB(b.x)], 1u);
        const unsigned gen = old / nloc;
        if (old + 1u == (gen + 1u) * nloc) {
            __builtin_amdgcn_fence(__ATOMIC_RELEASE, "agent");
            asm volatile("s_waitcnt vmcnt(0)" ::: "memory");
            const unsigned og = xb_add(&bar[XB_TOP], 1u);
            const unsigned tg = og / nx;
            if (og + 1u == (tg + 1u) * nx) xb_add(&bar[XB_TOPGEN], 1u);
            else XB_SPIN(xb_ld(&bar[XB_TOPGEN]) == tg, bar);
            __builtin_amdgcn_fence(__ATOMIC_ACQUIRE, "agent");
            xb_add(&bar[XB_XGEN(b.x)], 1u);
            asm volatile("s_waitcnt vmcnt(0)" ::: "memory");
        } else {
            XB_SPIN(xb_ld(&bar[XB_XGEN(b.x)]) == gen, bar);
            __builtin_amdgcn_fence(__ATOMIC_ACQUIRE, "agent");
            asm volatile("s_waitcnt vmcnt(0)" ::: "memory");
        }
    }
    __syncthreads();
}

struct Args { const float* in[34]; float* out; unsigned char* ws; int ph_lo, ph_hi; };
struct Frame {
    LAS unsigned char* lds;
    int vcu, G, cid, wid;
    float* out; unsigned char* ws;
};
__device__ __forceinline__ const float* inptr(LAS unsigned char* lds, int i) {
    int off = LDSCTL_OFF + 8 * i; asm volatile("" : "+v"(off));
    const LAS unsigned* p = (const LAS unsigned*)(lds + off);
    const unsigned lo = __builtin_amdgcn_readfirstlane(p[0]), hi = __builtin_amdgcn_readfirstlane(p[1]);
    return (const float*)(((unsigned long long)hi << 32) | lo);
}
#define INP(i) inptr(F.lds, (i))

__device__ __forceinline__ void conv_item(const float* W, int ld, int k0, int c0, int nvalid, const float* scale, bf16* dst, int K, int drow0, LAS float* scr, int lane) {
    const int n4 = (lane & 15) * 4;
#pragma unroll 4
    for (int i = 0; i < 16; ++i) { const int kk = 4 * i + (lane >> 4);
        f32x4 v = {0.f, 0.f, 0.f, 0.f}; if (n4 < nvalid) { v = *(const f32x4*)(W + (size_t)(k0 + kk) * ld + c0 + n4); if (scale) v *= scale[k0 + kk]; }
        LAS float* d = scr + kk * 65 + n4; d[0] = v[0]; d[1] = v[1]; d[2] = v[2]; d[3] = v[3]; }
    LDS_WAIT(); asm volatile("" ::: "memory");
    const int c = lane & 7;
#pragma unroll
    for (int j = 0; j < 8; ++j) { const int nn = (lane >> 3) + 8 * j; const LAS float* sp = scr + (8 * c) * 65 + nn;
        u32x4 o; o.x = pk2(sp[0 * 65], sp[1 * 65]); o.y = pk2(sp[2 * 65], sp[3 * 65]); o.z = pk2(sp[4 * 65], sp[5 * 65]); o.w = pk2(sp[6 * 65], sp[7 * 65]);
        *(u32x4*)(dst + (size_t)(drow0 + nn) * K + k0 + 8 * c) = o; }
    LDS_WAIT(); asm volatile("" ::: "memory");
}
__device__ __forceinline__ void conv_seg(Frame& F, const float* W, int ld, int K, int c0, int nvalid, int ntotal, const float* scale, bf16* dst, int r0, int blk, int blks) {
    const int ptid = otid(), plane = ptid & 63, pwave = __builtin_amdgcn_readfirstlane(ptid >> 6);
    LAS float* scr = (LAS float*)(F.lds + pwave * 16640);
    const int gw = F.vcu * 8 + pwave, NGW = F.G * 8;
    const int nblk = ntotal / 64, nitems = (K / 64) * nblk;
    for (int it = gw; it < nitems; it += NGW) {
        const int kb = it / nblk, nb = it % nblk, n0 = nb * 64;
        int nv = nvalid - n0; nv = nv < 0 ? 0 : (nv > 64 ? 64 : nv);
        conv_item(W, ld, kb * 64, c0 + n0, nv, scale, dst, K, r0 + (n0 / blk) * blks + (n0 % blk), scr, plane);
    }
}
__device__ __forceinline__ void conv_layer_weights(Frame& F, int l) {
    unsigned char* wl = F.ws + WS_W + (size_t)l * WL_STRIDE;
    const float* win = INP(2) + (size_t)l * D * INC; const float* n1 = INP(1) + l * D;
    const int BIGB = 1 << 30;
    conv_seg(F, win, INC, D, 0, 3328, 3328, n1, (bf16*)(wl + WL_IN), 0, BIGB, 0);
    conv_seg(F, win, INC, D, 3336, 2048, 2048, n1, (bf16*)(wl + WL_IN), 3328, BIGB, 0);
    conv_seg(F, win, INC, D, 3328, 8, 256, n1, (bf16*)(wl + WL_IN), 5376, BIGB, 0);
    conv_seg(F, win, INC, D, 5384, 3072, 3072, n1, (bf16*)(wl + WL_GATE), 0, BIGB, 0);
    for (int i = 0; i < 3; ++i)
        conv_seg(F, INP(23) + ((size_t)l * 3 + i) * 512 * D, D, 512, 0, D, D, nullptr, (bf16*)(wl + WL_BR) + (size_t)i * D * 512, 0, BIGB, 0);
    conv_seg(F, INP(24) + (size_t)l * D * D, D, D, 0, D, D, nullptr, (bf16*)(wl + WL_OUT), 0, BIGB, 0);
}
__device__ __forceinline__ void conv_ffn_weights(Frame& F) {
    const float* n2 = INP(25);
    conv_seg(F, INP(26), FF, D, 0, FF, FF, n2, (bf16*)(F.ws + WS_FFUP), 0, 128, 256);
    conv_seg(F, INP(27), FF, D, 0, FF, FF, n2, (bf16*)(F.ws + WS_FFUP), 128, 128, 256);
    conv_seg(F, INP(28), D, FF, 0, D, D, nullptr, (bf16*)(F.ws + WS_FFDN), 0, 1 << 30, 0);
}
__device__ __forceinline__ void conv_moe_weights(Frame& F) {
    const float* n2 = INP(25) + D;
    for (int e = 0; e < NE; ++e) {
        bf16* up = (bf16*)(F.ws + WS_MOEW + (size_t)e * MOEW_STRIDE); bf16* dn = (bf16*)(F.ws + WS_MOEW + (size_t)e * MOEW_STRIDE + MOEW_DN);
        conv_seg(F, INP(30) + (size_t)e * D * FFE, FFE, D, 0, FFE, FFE, n2, up, 0, 128, 256);
        conv_seg(F, INP(31) + (size_t)e * D * FFE, FFE, D, 0, FFE, FFE, n2, up, 128, 128, 256);
        conv_seg(F, INP(32) + (size_t)e * FFE * D, D, FFE, 0, D, D, nullptr, dn, 0, 1 << 30, 0);
    }
}

__device__ __forceinline__ void xprep_phase(Frame& F, const float* x) {
    const int ptid = otid(), plane = ptid & 63, pwave = __builtin_amdgcn_readfirstlane(ptid >> 6); (void)plane; (void)pwave;
    const int gw = F.vcu * 8 + pwave, NGW = F.G * 8;
    bf16* xb = (bf16*)(F.ws + WS_XB); float* rstd = (float*)(F.ws + WS_RSTD);
    for (int m = gw; m < M; m += NGW) {
        const f32x4* xr = (const f32x4*)(x + (size_t)m * D) + plane;
        f32x4 v[4]; float s = 0.f;
#pragma unroll
        for (int j = 0; j < 4; ++j) { v[j] = xr[64 * j]; s += (v[j].x * v[j].x + v[j].y * v[j].y) + (v[j].z * v[j].z + v[j].w * v[j].w); }
        s = wave_sum(s);
        if (plane == 0) rstd[m] = __builtin_amdgcn_rsqf(s * (1.f / D) + 1e-6f);
        u32x2* o8 = (u32x2*)(xb + (size_t)m * D) + plane;
#pragma unroll
        for (int j = 0; j < 4; ++j) { u32x2 w; w.x = pk2(v[j].x, v[j].y); w.y = pk2(v[j].z, v[j].w); o8[64 * j] = w; }
    }
}
__device__ __forceinline__ void final_norm_phase(Frame& F) {
    const int ptid = otid(), plane = ptid & 63, pwave = __builtin_amdgcn_readfirstlane(ptid >> 6); (void)plane; (void)pwave;
    const int gw = F.vcu * 8 + pwave, NGW = F.G * 8;
    const float* fw = INP(33);
    for (int m = gw; m < M; m += NGW) {
        f32x4* xr = (f32x4*)(F.out + (size_t)m * D) + plane;
        f32x4 v[4]; float s = 0.f;
#pragma unroll
        for (int j = 0; j < 4; ++j) { v[j] = xr[64 * j]; s += (v[j].x * v[j].x + v[j].y * v[j].y) + (v[j].z * v[j].z + v[j].w * v[j].w); }
        s = wave_sum(s);
        const float r = __builtin_amdgcn_rsqf(s * (1.f / D) + 1e-6f);
#pragma unroll
        for (int j = 0; j < 4; ++j) { const f32x4 w = *((const f32x4*)fw + plane + 64 * j); xr[64 * j] = v[j] * r * w; }
    }
}
__device__ __forceinline__ void router_phase(Frame& F) {
    const int ptid = otid(), plane = ptid & 63, pwave = __builtin_amdgcn_readfirstlane(ptid >> 6);
    const float* nw = INP(25) + D; const float* rt = INP(29); const float* rstd = (const float*)(F.ws + WS_RSTD);
    int* cnt = (int*)(F.ws + WS_CNT); int* list2 = (int*)(F.ws + WS_LIST);
    LAS int* lsel = (LAS int*)F.lds;
    LAS float* lwt = (LAS float*)(F.lds + 1024);
    LAS int* lrank = (LAS int*)(F.lds + 2048);
    LAS int* lcnt = (LAS int*)(F.lds + 3072);
    for (int blk = F.vcu; blk < M / 128; blk += F.G) {
        if (ptid < 16) lcnt[ptid] = 0;
        __syncthreads();
        for (int k = 0; k < 16; ++k) {
            const int lt = pwave * 16 + k, m = blk * 128 + lt;
            float acc[8];
#pragma unroll
            for (int e = 0; e < 8; ++e) acc[e] = 0.f;
            const float* xr = F.out + (size_t)m * D;
#pragma unroll 4
            for (int j = 0; j < 16; ++j) { const int kk = plane + 64 * j; const float xv = xr[kk] * nw[kk];
                const f32x4 r0v = *(const f32x4*)(rt + (size_t)kk * 8), r1v = *(const f32x4*)(rt + (size_t)kk * 8 + 4);
                acc[0] += xv * r0v.x; acc[1] += xv * r0v.y; acc[2] += xv * r0v.z; acc[3] += xv * r0v.w; acc[4] += xv * r1v.x; acc[5] += xv * r1v.y; acc[6] += xv * r1v.z; acc[7] += xv * r1v.w; }
            const float sc = rstd[m];
#pragma unroll
            for (int e = 0; e < 8; ++e) acc[e] = wave_sum(acc[e]) * sc;
            int i0 = 0; float v0 = acc[0];
#pragma unroll
            for (int e = 1; e < 8; ++e) if (acc[e] > v0) { v0 = acc[e]; i0 = e; }
            int i1 = -1; float v1 = -3.0e38f;
#pragma unroll
            for (int e = 0; e < 8; ++e) if (e != i0 && acc[e] > v1) { v1 = acc[e]; i1 = e; }
            const float e1 = expf(v1 - v0), w0 = 1.f / (1.f + e1), w1 = e1 / (1.f + e1);
            if (plane == 0) { lsel[2 * lt] = i0; lsel[2 * lt + 1] = i1; lwt[2 * lt] = w0; lwt[2 * lt + 1] = w1;
                lrank[2 * lt] = atomicAdd((int*)(lcnt + i0), 1); lrank[2 * lt + 1] = atomicAdd((int*)(lcnt + i1), 1); }
        }
        __syncthreads();
        if (ptid < 8) lcnt[8 + ptid] = atomicAdd(cnt + ptid, lcnt[ptid]);
        __syncthreads();
        if (ptid < 256) { const int e = lsel[ptid], slot = lcnt[8 + e] + lrank[ptid];
            u32x2 v; v.x = (unsigned)(blk * 128 + (ptid >> 1)); v.y = __builtin_bit_cast(unsigned, lwt[ptid]);
            *(u32x2*)(list2 + ((size_t)e * 32768 + slot) * 2) = v; }
        __syncthreads();
    }
}

__device__ __forceinline__ void vprep_phase(Frame& F, int layer) {
    const int ptid = otid(), plane = ptid & 63, pwave = __builtin_amdgcn_readfirstlane(ptid >> 6); (void)plane; (void)pwave;
    LAS float* vt = (LAS float*)F.lds;
    LAS float* vd = vt + 32 * 516;
    const bf16* P = (const bf16*)(F.ws + WS_BIG); bf16* VF = (bf16*)(F.ws + WS_VF); bf16* VM = (bf16*)(F.ws + WS_VMIX);
    const float* mu = INP(3) + layer * 1792 + 1024;
    const int tok = ptid >> 4, part = ptid & 15;
    for (int it = F.vcu; it < M / 32; it += F.G) {
        const int m = it * 32 + tok; const int t = m & (T - 1);
        const bf16* cur = P + (size_t)m * PLD + 1024 + part * 32;
        float xm[32];
#pragma unroll
        for (int q = 0; q < 4; ++q) { float c[8], p[8]; unpack8(*(const u32x4*)(cur + q * 8), c);
            if (t > 0) unpack8(*(const u32x4*)(cur - PLD + q * 8), p); else {
#pragma unroll
                for (int e = 0; e < 8; ++e) p[e] = 0.f; }
#pragma unroll
            for (int e = 0; e < 8; ++e) xm[q * 8 + e] = c[e] + (p[e] - c[e]) * mu[part * 32 + q * 8 + e]; }
        if (layer == 0) {
#pragma unroll
            for (int q = 0; q < 4; ++q) { float o[8];
#pragma unroll
                for (int e = 0; e < 8; ++e) o[e] = xm[q * 8 + e];
                *(u32x4*)(VF + (size_t)m * 512 + part * 32 + q * 8) = pack8(o); }
        } else {
            const float* vdn = INP(14); const float* vup = INP(15); const float* v0 = INP(16);
#pragma unroll
            for (int e = 0; e < 32; ++e) vt[tok * 516 + part * 32 + e] = xm[e];
            __syncthreads();
            { float a0 = 0.f, a1 = 0.f; const int j = part * 2;
                for (int c = 0; c < 512; ++c) { const float v = vt[tok * 516 + c]; a0 += v * vdn[c * 32 + j]; a1 += v * vdn[c * 32 + j + 1]; }
                vd[tok * 33 + j] = a0; vd[tok * 33 + j + 1] = a1; }
            __syncthreads();
            float g[32];
#pragma unroll
            for (int e = 0; e < 32; ++e) g[e] = v0[part * 32 + e];
            for (int j = 0; j < 32; ++j) { const float d = vd[tok * 33 + j];
#pragma unroll
                for (int e = 0; e < 32; ++e) g[e] += d * vup[j * 512 + part * 32 + e]; }
#pragma unroll
            for (int q = 0; q < 4; ++q) { float vf[8], o[8]; unpack8(*(const u32x4*)(VF + (size_t)m * 512 + part * 32 + q * 8), vf);
#pragma unroll
                for (int e = 0; e < 8; ++e) { const float v = xm[q * 8 + e]; o[e] = v + (vf[e] - v) * sigm(g[q * 8 + e]); }
                *(u32x4*)(VM + (size_t)m * 512 + part * 32 + q * 8) = pack8(o); }
            __syncthreads();
        }
    }
}

__device__ __forceinline__ void prepass_a(Frame& F) {
    const int tid = otid();
    bf16* P = (bf16*)(F.ws + WS_BIG); bf16* BND2 = (bf16*)(F.ws + WS_BND2);
    { const int ch = tid & 127; const int kind = ch >> 6, part = ch & 7;
      double invf[4];
#pragma unroll
      for (int p = 0; p < 4; ++p) invf[p] = exp(-(double)(part * 4 + p) * (9.210340371976184 / 32.0));
      for (int m = F.vcu * 4 + (tid >> 7); m < M; m += F.G * 4) {
          const int t = m & (T - 1); bf16* ptr = P + (size_t)m * PLD + C_RET + ch * 8;
          float x[8]; unpack8(*(const u32x4*)ptr, x);
#pragma unroll
          for (int p = 0; p < 4; ++p) { double rev = (double)t * invf[p] * 0.15915494309189535; rev -= floor(rev);
              const float sn = __builtin_amdgcn_sinf((float)rev), cs = __builtin_amdgcn_cosf((float)rev);
              const float x0 = x[2 * p], x1 = x[2 * p + 1]; float o0 = x0 * cs - x1 * sn, o1 = x0 * sn + x1 * cs;
              if (kind) { o0 *= 0.125f; o1 *= 0.125f; }
              x[2 * p] = o0; x[2 * p + 1] = o1; }
          *(u32x4*)ptr = pack8(x); } }
    for (int i = F.vcu * 512 + tid; i < 1024 * 3 * 128; i += F.G * 512) { const int ch = i & 127, k = (i >> 7) % 3, r = i / 384;
        if ((r & 511) != 0) *(u32x4*)(BND2 + ((size_t)r * 3 + k) * 1024 + ch * 8) = *(const u32x4*)(P + ((size_t)r * 32 - 3 + k) * PLD + C_XBC + ch * 8); }
}
__device__ __forceinline__ void prepass_conv(Frame& F, int layer) {
    const int tid = otid();
    bf16* P = (bf16*)(F.ws + WS_BIG); const bf16* BND2 = (const bf16*)(F.ws + WS_BND2);
    const float* cw = INP(17) + layer * 1024 * 4; const float* cbias = INP(18) + layer * 1024;
    const int ch = tid & 127;
    f32x4 wv[8]; float bv[8];
#pragma unroll
    for (int e = 0; e < 8; ++e) { wv[e] = *(const f32x4*)(cw + (ch * 8 + e) * 4); bv[e] = cbias[ch * 8 + e]; }
    for (int r = F.vcu * 4 + (tid >> 7); r < M / 32; r += F.G * 4) {
        float w0[8], w1[8], w2[8];
        if ((r & 511) != 0) { unpack8(*(const u32x4*)(BND2 + ((size_t)r * 3 + 0) * 1024 + ch * 8), w0); unpack8(*(const u32x4*)(BND2 + ((size_t)r * 3 + 1) * 1024 + ch * 8), w1); unpack8(*(const u32x4*)(BND2 + ((size_t)r * 3 + 2) * 1024 + ch * 8), w2); }
        else {
#pragma unroll
            for (int e = 0; e < 8; ++e) { w0[e] = 0.f; w1[e] = 0.f; w2[e] = 0.f; } }
        bf16* ptr = P + (size_t)r * 32 * PLD + C_XBC + ch * 8;
#pragma unroll 4
        for (int i = 0; i < 32; ++i) {
            float x[8], o[8]; unpack8(*(const u32x4*)(ptr + (size_t)i * PLD), x);
#pragma unroll
            for (int e = 0; e < 8; ++e) { o[e] = silu(bv[e] + wv[e][0] * w0[e] + wv[e][1] * w1[e] + wv[e][2] * w2[e] + wv[e][3] * x[e]); w0[e] = w1[e]; w1[e] = w2[e]; w2[e] = x[e]; }
            *(u32x4*)(ptr + (size_t)i * PLD) = pack8(o);
        }
    }
}
__device__ __forceinline__ float red8(float v) { v += __shfl_xor(v, 1); v += __shfl_xor(v, 2); v += __shfl_xor(v, 4); return v; }
__device__ __forceinline__ float red16(float v) { v = red8(v); v += __shfl_xor(v, 8); return v; }

__device__ __forceinline__ void rwkv_seq(Frame& F, int layer, int bh) {
    const int ptid = otid(), plane = ptid & 63, pwave = __builtin_amdgcn_readfirstlane(ptid >> 6); (void)plane; (void)pwave;
    const int b = bh >> 3, h = bh & 7;
    LAS float* L = (LAS float*)F.lds;
    LAS float *rr = L, *ww = L + 2048, *kf = L + 4096, *vv = L + 6144, *aa = L + 8192, *bb = L + 10240, *gg = L + 12288, *yy = L + 14336, *tw = L + 16384, *xa = L + 18432, *sg = L + 20480, *bon = L + 24576;
    const float* mu = INP(3) + layer * 1792; const float* w_up = INP(4) + layer * 64 * 512; const float* w0 = INP(5) + layer * 512;
    const float* a_up = INP(6) + layer * 64 * 512; const float* a0 = INP(7) + layer * 512; const float* g_up = INP(8) + layer * 128 * 512;
    const float* k_k = INP(9) + layer * 512; const float* k_a = INP(10) + layer * 512; const float* r_k = INP(11) + layer * 512;
    const float* gn_w = INP(12) + layer * 512; const float* gn_b = INP(13) + layer * 512;
    const bf16* P = (const bf16*)(F.ws + WS_BIG); const bf16* vsrc = (const bf16*)(F.ws + (layer == 0 ? WS_VF : WS_VMIX)); bf16* yout = (bf16*)(F.ws + WS_YRW);
    const int tid = ptid, tok = tid >> 4, part = tid & 15, c4 = part * 4, cb = h * 64 + c4;
    const int srow = tid >> 3, sc0 = (tid & 7) * 8;
    float S[8];
#pragma unroll
    for (int j = 0; j < 8; ++j) S[j] = 0.f;
    for (int t0 = 0; t0 < T; t0 += 32) {
        {
            const int t = t0 + tok; const size_t m = (size_t)b * T + t;
            const bf16* cur = P + m * PLD;
#pragma unroll
            for (int q = 0; q < 3; ++q) {
                const int ch = part + 16 * q; int col, kind; LAS float* dst;
                if (ch < 8) { col = h * 64 + ch * 8; dst = rr + tok * 64 + ch * 8; kind = 0; }
                else if (ch < 16) { col = 512 + h * 64 + (ch - 8) * 8; dst = kf + tok * 64 + (ch - 8) * 8; kind = 0; }
                else if (ch < 24) { col = 1536 + (ch - 16) * 8; dst = tw + tok * 64 + (ch - 16) * 8; kind = 1; }
                else if (ch < 32) { col = 1600 + (ch - 24) * 8; dst = xa + tok * 64 + (ch - 24) * 8; kind = 0; }
                else { col = 1664 + (ch - 32) * 8; dst = sg + tok * 128 + (ch - 32) * 8; kind = 2; }
                float c[8], p[8]; unpack8(*(const u32x4*)(cur + col), c);
                if (t > 0) unpack8(*(const u32x4*)(cur - PLD + col), p); else {
#pragma unroll
                    for (int e = 0; e < 8; ++e) p[e] = 0.f; }
#pragma unroll
                for (int e = 0; e < 8; ++e) { float x = c[e] + (p[e] - c[e]) * mu[col + e]; if (kind == 1) x = tanhf(x); else if (kind == 2) x = sigm(x); dst[e] = x; }
            }
            if (part < 8) { float v[8]; unpack8(*(const u32x4*)(vsrc + m * 512 + h * 64 + part * 8), v);
#pragma unroll
                for (int e = 0; e < 8; ++e) vv[tok * 64 + part * 8 + e] = v[e]; }
        }
        __syncthreads();
        {
            f32x4 dw = *(const f32x4*)(w0 + cb), da = *(const f32x4*)(a0 + cb), dg = (f32x4){0.f, 0.f, 0.f, 0.f};
            for (int j = 0; j < 64; ++j) { const float tj = tw[tok * 64 + j], xj = xa[tok * 64 + j];
                dw += *(const f32x4*)(w_up + j * 512 + cb) * tj; da += *(const f32x4*)(a_up + j * 512 + cb) * xj; }
            for (int j = 0; j < 128; ++j) dg += *(const f32x4*)(g_up + j * 512 + cb) * sg[tok * 128 + j];
            float kr[4], kk[4], av[4], ss = 0.f;
#pragma unroll
            for (int e = 0; e < 4; ++e) { kr[e] = kf[tok * 64 + c4 + e]; kk[e] = kr[e] * k_k[cb + e]; ss += kk[e] * kk[e]; av[e] = sigm(da[e]); }
            ss = red16(ss);
            const float inv = __builtin_amdgcn_rsqf(fmaxf(ss, 1e-24f));
            float bs = 0.f;
#pragma unroll
            for (int e = 0; e < 4; ++e) { const float kn = kk[e] * inv; const int o = tok * 64 + c4 + e;
                const float ld = -expf(-softplus_acc(-dw[e]) - 0.5f);
                ww[o] = expf(ld); aa[o] = -kn; bb[o] = kn * av[e];
                const float knew = kr[e] * (1.f + (av[e] - 1.f) * k_a[cb + e]); kf[o] = knew; gg[o] = dg[e];
                bs += rr[o] * knew * r_k[cb + e]; }
            bs = red16(bs);
            if (part == 0) bon[tok] = bs;
        }
        __syncthreads();
        for (int s = 0; s < 32; ++s) {
            const f32x4 a0v = *(const LAS f32x4*)(aa + s * 64 + sc0), a1v = *(const LAS f32x4*)(aa + s * 64 + sc0 + 4);
            const f32x4 w0v = *(const LAS f32x4*)(ww + s * 64 + sc0), w1v = *(const LAS f32x4*)(ww + s * 64 + sc0 + 4);
            const f32x4 b0v = *(const LAS f32x4*)(bb + s * 64 + sc0), b1v = *(const LAS f32x4*)(bb + s * 64 + sc0 + 4);
            const f32x4 k0v = *(const LAS f32x4*)(kf + s * 64 + sc0), k1v = *(const LAS f32x4*)(kf + s * 64 + sc0 + 4);
            const f32x4 r0v = *(const LAS f32x4*)(rr + s * 64 + sc0), r1v = *(const LAS f32x4*)(rr + s * 64 + sc0 + 4);
            const float vi = vv[s * 64 + srow];
            float sa = 0.f;
#pragma unroll
            for (int j = 0; j < 4; ++j) sa += S[j] * a0v[j] + S[4 + j] * a1v[j];
            sa = red8(sa);
            float y = 0.f;
#pragma unroll
            for (int j = 0; j < 4; ++j) { S[j] = S[j] * w0v[j] + sa * b0v[j] + vi * k0v[j]; S[4 + j] = S[4 + j] * w1v[j] + sa * b1v[j] + vi * k1v[j]; y += S[j] * r0v[j] + S[4 + j] * r1v[j]; }
            y = red8(y);
            if ((tid & 7) == 0) yy[s * 64 + srow] = y;
        }
        __syncthreads();
        {
            const size_t m = (size_t)b * T + t0 + tok;
            float y[4], sm = 0.f;
#pragma unroll
            for (int e = 0; e < 4; ++e) { y[e] = yy[tok * 64 + c4 + e]; sm += y[e]; }
            const float mean = red16(sm) * (1.f / 64.f);
            float vs = 0.f;
#pragma unroll
            for (int e = 0; e < 4; ++e) { y[e] -= mean; vs += y[e] * y[e]; }
            const float rs = __builtin_amdgcn_rsqf(red16(vs) * (1.f / 64.f) + 64e-5f);
            const float bo = bon[tok];
            float o[4];
#pragma unroll
            for (int e = 0; e < 4; ++e) { const int idx = tok * 64 + c4 + e; o[e] = (y[e] * rs * gn_w[cb + e] + gn_b[cb + e] + bo * vv[idx]) * gg[idx]; }
            u32x2 w; w.x = pk2(o[0], o[1]); w.y = pk2(o[2], o[3]);
            *(u32x2*)(yout + m * 512 + cb) = w;
        }
        __syncthreads();
    }
}

__device__ __forceinline__ void ret_seq(Frame& F, int bh) {
    const int ptid = otid(), plane = ptid & 63, pwave = __builtin_amdgcn_readfirstlane(ptid >> 6); (void)plane; (void)pwave;
    const int b = bh >> 3, h = bh & 7;
    LAS float* L = (LAS float*)F.lds;
    LAS float *qq = L, *kk = L + 2048, *vv = L + 4096, *gg = L + 6144, *yy = L + 8192;
    bf16* P = (bf16*)(F.ws + WS_BIG);
    const int tid = ptid, tok = tid >> 4, part = tid & 15, c4 = part * 4;
    const int se = tid >> 3, sd0 = (tid & 7) * 8;
    const float gamma = 1.f - exp2f(-5.f - (float)h);
    float S[8];
#pragma unroll
    for (int j = 0; j < 8; ++j) S[j] = 0.f;
    for (int t0 = 0; t0 < T; t0 += 32) {
        {
            const int t = t0 + tok; const size_t m = (size_t)b * T + t;
#pragma unroll
            for (int q = 0; q < 2; ++q) {
                const int ch = part + 16 * q, kind = ch >> 3, cc = ch & 7;
                float x[8]; unpack8(*(const u32x4*)(P + m * PLD + C_RET + kind * 512 + h * 64 + cc * 8), x);
                LAS float* dst = (kind == 0 ? qq : kind == 1 ? kk : kind == 2 ? vv : gg) + tok * 64 + cc * 8;
                if (kind < 2) {
#pragma unroll
                    for (int p = 0; p < 4; ++p) { const int i = cc * 4 + p;
                        const double invf = exp(-(double)i * (9.210340371976184 / 32.0));
                        double sn, cs; sincos((double)t * invf, &sn, &cs);
                        const float x0 = x[2 * p], x1 = x[2 * p + 1], c = (float)cs, s = (float)sn;
                        float o0 = x0 * c - x1 * s, o1 = x0 * s + x1 * c;
                        if (kind == 1) { o0 *= 0.125f; o1 *= 0.125f; }
                        dst[2 * p] = o0; dst[2 * p + 1] = o1; }
                } else {
#pragma unroll
                    for (int e = 0; e < 8; ++e) dst[e] = x[e];
                }
            }
        }
        __syncthreads();
        for (int s = 0; s < 32; ++s) {
            const f32x4 k0v = *(const LAS f32x4*)(kk + s * 64 + sd0), k1v = *(const LAS f32x4*)(kk + s * 64 + sd0 + 4);
            const f32x4 q0v = *(const LAS f32x4*)(qq + s * 64 + sd0), q1v = *(const LAS f32x4*)(qq + s * 64 + sd0 + 4);
            const float ve = vv[s * 64 + se];
            float y = 0.f;
#pragma unroll
            for (int j = 0; j < 4; ++j) { S[j] = gamma * S[j] + k0v[j] * ve; S[4 + j] = gamma * S[4 + j] + k1v[j] * ve; y += q0v[j] * S[j] + q1v[j] * S[4 + j]; }
            y = red8(y);
            if ((tid & 7) == 0) yy[s * 64 + se] = y;
        }
        __syncthreads();
        {
            const size_t m = (size_t)b * T + t0 + tok;
            float y[4], ss = 0.f;
#pragma unroll
            for (int e = 0; e < 4; ++e) { y[e] = yy[tok * 64 + c4 + e]; ss += y[e] * y[e]; }
            const float rs = __builtin_amdgcn_rsqf(red16(ss) * (1.f / 64.f) + 1e-6f);
            float o[4];
#pragma unroll
            for (int e = 0; e < 4; ++e) o[e] = y[e] * rs * silu(gg[tok * 64 + c4 + e]);
            u32x2 w; w.x = pk2(o[0], o[1]); w.y = pk2(o[2], o[3]);
            *(u32x2*)(P + m * PLD + C_RETG + h * 64 + c4) = w;
        }
        __syncthreads();
    }
}

__device__ __forceinline__ void ssd_seq(Frame& F, int layer, int bh) {
    const int ptid = otid(), plane = ptid & 63, pwave = __builtin_amdgcn_readfirstlane(ptid >> 6); (void)plane; (void)pwave;
    const int b = bh >> 3, h = bh & 7, g = h >> 2;
    LAS float* L = (LAS float*)F.lds;
    LAS float *raw = L  , *xs = L + 11200, *Bc = L + 13248, *Cc = L + 17344, *yy = L + 21440, *dts = L + 23488, *das = L + 23520;
    bf16* P = (bf16*)(F.ws + WS_BIG); const float* dtb = (const float*)(F.ws + WS_DT);
    const float* cw = INP(17) + layer * 1024 * 4; const float* cbias = INP(18) + layer * 1024;
    const float dt_bias = INP(19)[layer * 8 + h], A = -expf(INP(20)[layer * 8 + h]), Dh = INP(21)[layer * 8 + h];
    const int tid = ptid;
    const int sp = tid >> 3, sn0 = (tid & 7) * 16;
    float S[16];
#pragma unroll
    for (int j = 0; j < 16; ++j) S[j] = 0.f;
    for (int i = tid; i < 3 * 320; i += 512) raw[i] = 0.f;
    __syncthreads();
    for (int t0 = 0; t0 < T; t0 += 32) {
        for (int idx = tid; idx < 32 * 40; idx += 512) {
            const int row = idx / 40, ch = idx % 40; const size_t m = (size_t)b * T + t0 + row;
            const int col = ch < 8 ? (C_XBC + h * 64 + ch * 8) : (ch < 24 ? (C_XBC + 512 + g * 128 + (ch - 8) * 8) : (C_XBC + 768 + g * 128 + (ch - 24) * 8));
            float x[8]; unpack8(*(const u32x4*)(P + m * PLD + col), x);
#pragma unroll
            for (int e = 0; e < 8; ++e) raw[(3 + row) * 320 + ch * 8 + e] = x[e];
        }
        if (tid < 32) { const size_t m = (size_t)b * T + t0 + tid; const float dt = softplus_acc(dtb[m * 8 + h] + dt_bias); dts[tid] = dt; das[tid] = expf(A * dt); }
        __syncthreads();
        for (int idx = tid; idx < 32 * 320; idx += 512) {
            const int row = idx / 320, c = idx % 320;
            const int chn = c < 64 ? (h * 64 + c) : (c < 192 ? (512 + g * 128 + (c - 64)) : (768 + g * 128 + (c - 192)));
            float a = cbias[chn];
#pragma unroll
            for (int k = 0; k < 4; ++k) a += cw[chn * 4 + k] * raw[(row + k) * 320 + c];
            a = silu(a);
            if (c < 64) xs[row * 64 + c] = a; else if (c < 192) Bc[row * 128 + (c - 64)] = a; else Cc[row * 128 + (c - 192)] = a;
        }
        __syncthreads();
        for (int s = 0; s < 32; ++s) {
            const float da = das[s], xv = xs[s * 64 + sp], dtx = dts[s] * xv;
            float y = 0.f;
#pragma unroll
            for (int q = 0; q < 4; ++q) { const f32x4 bv = *(const LAS f32x4*)(Bc + s * 128 + sn0 + q * 4), cv = *(const LAS f32x4*)(Cc + s * 128 + sn0 + q * 4);
#pragma unroll
                for (int j = 0; j < 4; ++j) { S[q * 4 + j] = da * S[q * 4 + j] + dtx * bv[j]; y += S[q * 4 + j] * cv[j]; } }
            y = red8(y);
            if ((tid & 7) == 0) yy[s * 64 + sp] = y + Dh * xv;
        }
        __syncthreads();
        {
            const int tok = tid >> 4, c4 = (tid & 15) * 4; const size_t m = (size_t)b * T + t0 + tok;
            u32x2 w; w.x = pk2(yy[tok * 64 + c4], yy[tok * 64 + c4 + 1]); w.y = pk2(yy[tok * 64 + c4 + 2], yy[tok * 64 + c4 + 3]);
            *(u32x2*)(P + m * PLD + C_XBC + h * 64 + c4) = w;
            for (int i = tid; i < 3 * 320; i += 512) raw[i] = raw[32 * 320 + i];
        }
        __syncthreads();
    }
}
__device__ __forceinline__ void ssm_norm_phase(Frame& F, int layer) {
    const int ptid = otid(), plane = ptid & 63, pwave = __builtin_amdgcn_readfirstlane(ptid >> 6); (void)plane; (void)pwave;
    const int gw = F.vcu * 8 + pwave, NGW = F.G * 8;
    bf16* P = (bf16*)(F.ws + WS_BIG); const float* nw = INP(22) + layer * 512;
    for (int m = gw; m < M; m += NGW) {
        float y[8], z[8]; unpack8(*(const u32x4*)(P + (size_t)m * PLD + C_XBC + plane * 8), y); unpack8(*(const u32x4*)(P + (size_t)m * PLD + C_Z + plane * 8), z);
        float ss = 0.f;
#pragma unroll
        for (int e = 0; e < 8; ++e) { y[e] *= silu(z[e]); ss += y[e] * y[e]; }
        ss += __shfl_xor(ss, 1); ss += __shfl_xor(ss, 2); ss += __shfl_xor(ss, 4); ss += __shfl_xor(ss, 8); ss += __shfl_xor(ss, 16);
        const float rs = __builtin_amdgcn_rsqf(ss * (1.f / 256.f) + 1e-6f);
#pragma unroll
        for (int e = 0; e < 8; ++e) y[e] *= rs * nw[plane * 8 + e];
        *(u32x4*)(P + (size_t)m * PLD + C_Z + plane * 8) = pack8(y);
    }
}

constexpr int PT = 72, PT2 = 136, PF = 68;
__device__ __forceinline__ f32x4 mfma16(bf16x8 a, bf16x8 b, f32x4 c) { return __builtin_amdgcn_mfma_f32_16x16x32_bf16(a, b, c, 0, 0, 0); }
template <int K> __device__ __forceinline__ f32x4 mm_ll(const LAS bf16* A, int pa, int m0, const LAS bf16* B, int pb, int n0, f32x4 acc, int lane) {
    const int r = lane & 15, q = lane >> 4;
    const LAS bf16* ap = A + (m0 + r) * pa + 8 * q; const LAS bf16* bp = B + (n0 + r) * pb + 8 * q;
#pragma unroll
    for (int k0 = 0; k0 < K; k0 += 32) acc = mfma16(*(const LAS bf16x8*)(ap + k0), *(const LAS bf16x8*)(bp + k0), acc);
    return acc;
}
template <int K> __device__ __forceinline__ f32x4 mm_lg(const LAS bf16* A, int pa, int m0, const bf16* B, int pb, int n0, f32x4 acc, int lane) {
    const int r = lane & 15, q = lane >> 4;
    const LAS bf16* ap = A + (m0 + r) * pa + 8 * q; const bf16* bp = B + (size_t)(n0 + r) * pb + 8 * q;
#pragma unroll
    for (int k0 = 0; k0 < K; k0 += 32) acc = mfma16(*(const LAS bf16x8*)(ap + k0), *(const bf16x8*)(bp + k0), acc);
    return acc;
}
__device__ __forceinline__ float redl16(float v) { v += __shfl_xor(v, 1); v += __shfl_xor(v, 2); v += __shfl_xor(v, 4); v += __shfl_xor(v, 8); return v; }
__device__ __forceinline__ void st4bf(LAS bf16* p, f32x4 v) { u32x2 w; w.x = pk2(v[0], v[1]); w.y = pk2(v[2], v[3]); *(LAS u32x2*)p = w; }
__device__ __forceinline__ float ldbf(const LAS bf16* p) { return __builtin_bit_cast(float, (unsigned)(*p) << 16); }
constexpr f32x4 FZ4 = {0.f, 0.f, 0.f, 0.f};
__device__ __forceinline__ void tr_write8(LAS bf16* Tm, int pitch, int c0, int t, const float (&v)[8], int rot) {
    float a[8], b[8];
#pragma unroll
    for (int e = 0; e < 8; ++e) a[e] = (rot & 1) ? v[(e + 1) & 7] : v[e];
#pragma unroll
    for (int e = 0; e < 8; ++e) b[e] = (rot & 2) ? a[(e + 2) & 7] : a[e];
#pragma unroll
    for (int e = 0; e < 8; ++e) a[e] = (rot & 4) ? b[(e + 4) & 7] : b[e];
#pragma unroll
    for (int e = 0; e < 8; ++e) Tm[(c0 + ((e + rot) & 7)) * pitch + t] = (bf16)f2bf(a[e]);
}
__device__ __forceinline__ void ld8f(const LAS float* p, float (&v)[8]) { const f32x4 a = *(const LAS f32x4*)p, b = *(const LAS f32x4*)(p + 4); v[0] = a[0]; v[1] = a[1]; v[2] = a[2]; v[3] = a[3]; v[4] = b[0]; v[5] = b[1]; v[6] = b[2]; v[7] = b[3]; }
__device__ __forceinline__ void st8f(LAS float* p, const float (&v)[8]) { *(LAS f32x4*)p = (f32x4){v[0], v[1], v[2], v[3]}; *(LAS f32x4*)(p + 4) = (f32x4){v[4], v[5], v[6], v[7]}; }

template <bool FINAL>
__device__ __forceinline__ void rwkv_chunk_unit(Frame& F, int layer, int u) {
    const int tid = otid(), w = __builtin_amdgcn_readfirstlane(tid >> 6);
    bf16x8 lfr[16];
#define IDS() const int ft = fresh_tid(tid); const int lane = ft & 63, r16 = lane & 15, q4 = lane >> 4, tok = ft >> 3, part = ft & 7; (void)lane; (void)r16; (void)q4; (void)tok; (void)part
    const int b = u >> 9, sc = (u >> 3) & 63, h = u & 7;
    constexpr int NV = FINAL ? 64 : 128, NVT = NV / 16, NZ = NVT / 2;
    constexpr int X_TW = 0, X_XA = 9216, X_SG = 18432, X_KF = 35840, X_RF = 52224;
    constexpr int O_AT = 0, O_RT = 9216, O_BT = 18432, O_KT = 27648, O_BH = 36864, O_KH = 46080, O_VT = 55296, O_TF = O_BT;
    constexpr int Y0 = 68608;
    constexpr int Y_A = Y0, Y_B = Y0 + 8192, Y_K = Y0 + 16384, Y_R = Y0 + 24576, Y_L = Y0 + 32768, Y_VF = Y0 + 49152;
    constexpr int Y_AAB = Y0, Y_AAK = Y0 + 17408, Y_ARB = Y_AAK + 9216, Y_ARK = Y_ARB + 9216, Y_TB = FINAL ? Y_ARK + 9216 : Y_AAK + 9216, Y_ZU = Y_TB + 9216, Y_YF = Y_AAB;
    static_assert(Y_ZU + NV * PT * 2 <= Y0 + 65536, "region Y");
    constexpr int Z0 = Y0 + 65536, Z_G = Z0, Z_S = FINAL ? Z0 + 8192 : Z0, Z_MISC = 152576, Z_BON = Z_MISC, Z_PC = Z_MISC + 256, Z_PAR = Z_MISC + 512, Z_XS = Y_ZU;
    static_assert(Z_S + NV * PT * 2 <= Z_MISC && Z_PAR + 832 * 4 <= LDSCTL_OFF, "region Z");
    LAS unsigned char* L = F.lds;
#define LB(off) ((LAS bf16*)(L + (off)))
#define LF(off) ((LAS float*)(L + (off)))
    {
        const int pidx = (w == 0) ? 5 : (w == 1) ? 7 : (w == 2) ? 9 : (w == 3) ? 10 : (w == 4) ? 11 : (w == 5) ? 12 : 13;
        if (w < 7) LF(Z_PAR)[w * 64 + (tid & 63)] = (INP(pidx) + layer * 512 + h * 64)[tid & 63];
        const float* mu = INP(3) + layer * 1792;
        for (int i = tid; i < 384; i += 512) LF(Z_PAR)[448 + i] = mu[(i < 64) ? (h * 64 + i) : (i < 128) ? (512 + h * 64 + (i - 64)) : (1536 + (i - 128))];
    }
    const bf16* WupT = (const bf16*)(F.ws + WS_LORA + (size_t)layer * LORA_STRIDE) + h * 64 * 64;
    const bf16* AupT = (const bf16*)(F.ws + WS_LORA + (size_t)layer * LORA_STRIDE + 65536) + h * 64 * 64;
    const bf16* GupT = (const bf16*)(F.ws + WS_LORA + (size_t)layer * LORA_STRIDE + 131072) + h * 64 * 128;
    const bf16* P = (const bf16*)(F.ws + WS_BIG); const bf16* vsrc = (const bf16*)(F.ws + (layer == 0 ? WS_VF : WS_VMIX));
    float* Nbuf = (float*)(F.ws + WS_ST_RW) + (size_t)u * 4096; bf16* MT = (bf16*)(F.ws + WS_MT) + (size_t)u * 4096;
    { IDS();
        if (w < 4) {
#pragma unroll
            for (int nt = 0; nt < 4; ++nt)
#pragma unroll
                for (int k2 = 0; k2 < 2; ++k2) { lfr[nt * 4 + k2] = *(const bf16x8*)(WupT + (size_t)(16 * nt + r16) * 64 + 32 * k2 + 8 * q4); lfr[nt * 4 + 2 + k2] = *(const bf16x8*)(AupT + (size_t)(16 * nt + r16) * 64 + 32 * k2 + 8 * q4); }
        } else if (FINAL) {
#pragma unroll
            for (int nt = 0; nt < 4; ++nt)
#pragma unroll
                for (int k4 = 0; k4 < 4; ++k4) lfr[nt * 4 + k4] = *(const bf16x8*)(GupT + (size_t)(16 * nt + r16) * 128 + 32 * k4 + 8 * q4);
        } }
    constexpr int NST = FINAL ? 2 : 4;
    f32x4 Sacc[NST];
    const int s_vb = FINAL ? (w & 3) : w;
#define S_CT(ti) (FINAL ? (2 * (w >> 2) + (ti)) : (ti))
    { IDS();
#pragma unroll
    for (int ti = 0; ti < NST; ++ti) {
        const int ct = S_CT(ti);
#pragma unroll
        for (int jj = 0; jj < 4; ++jj) { const int v = 16 * s_vb + 4 * q4 + jj, c = 16 * ct + r16;
            float x; if (FINAL) x = Nbuf[v * 64 + c]; else x = (v >= 64 && v - 64 == c) ? 1.f : 0.f;
            Sacc[ti][jj] = x; LB(Z_S)[v * PT + c] = (bf16)f2bf(x); }
    } }
    for (int j = 0; j < 4; ++j) {
        const int tl0 = sc * 256 + j * 64;
        {
            IDS();
            const int t = tl0 + tok; const size_t m = (size_t)b * T + t; const bf16* cur = P + m * PLD;
#pragma unroll
            for (int i = 0; i < 6; ++i) {
                const int col = (i == 0) ? (h * 64 + 8 * part) : (i == 1) ? (512 + h * 64 + 8 * part) : (i == 2) ? (1536 + 8 * part) : (i == 3) ? (1600 + 8 * part) : (1664 + 8 * part + (i - 4) * 64);
                float c[8], p[8]; unpack8(*(const u32x4*)(cur + col), c);
                if (t > 0) unpack8(*(const u32x4*)(cur - PLD + col), p); else {
#pragma unroll
                    for (int e = 0; e < 8; ++e) p[e] = 0.f; }
#pragma unroll
                for (int e = 0; e < 8; ++e) c[e] = c[e] + (p[e] - c[e]) * LF(Z_PAR)[448 + ((i < 4) ? 64 * i : 256 + 64 * (i - 4)) + 8 * part + e];
                if (i == 0) { st8f(LF(X_RF) + tok * 64 + 8 * part, c);
                } else if (i == 1) { st8f(LF(X_KF) + tok * 64 + 8 * part, c);
                } else if (i == 2) {
#pragma unroll
                    for (int e = 0; e < 8; ++e) c[e] = fast_tanh(c[e]);
                    *(LAS u32x4*)(LB(X_TW) + tok * PT + 8 * part) = pack8(c);
                } else if (i == 3) {
                    *(LAS u32x4*)(LB(X_XA) + tok * PT + 8 * part) = pack8(c);
                } else if (FINAL) {
#pragma unroll
                    for (int e = 0; e < 8; ++e) c[e] = sigm(c[e]);
                    *(LAS u32x4*)(LB(X_SG) + tok * PT2 + 8 * part + (i - 4) * 64) = pack8(c);
                }
            }
            float v[8]; unpack8(*(const u32x4*)(vsrc + m * 512 + h * 64 + 8 * part), v);
            st8f(LF(Y_VF) + tok * 64 + 8 * part, v);
        }
        __syncthreads();
        { IDS();
        if (w < 4) {
            const int rb = w;
            float inv[4], bs[4] = {0.f, 0.f, 0.f, 0.f};
            { float ss[4] = {0.f, 0.f, 0.f, 0.f};
#pragma unroll
                for (int nt = 0; nt < 4; ++nt) { const int c = 16 * nt + r16; const float kkc = LF(Z_PAR)[128 + c];
#pragma unroll
                    for (int jj = 0; jj < 4; ++jj) { const float kk = LF(X_KF)[(16 * rb + 4 * q4 + jj) * 64 + c] * kkc; ss[jj] += kk * kk; } }
#pragma unroll
                for (int jj = 0; jj < 4; ++jj) inv[jj] = __builtin_amdgcn_rsqf(fmaxf(redl16(ss[jj]), 1e-24f)); }
#pragma unroll
            for (int nt = 0; nt < 4; ++nt) {
                f32x4 aw = FZ4, aa = FZ4;
#pragma unroll
                for (int k2 = 0; k2 < 2; ++k2) { aw = mfma16(*(const LAS bf16x8*)(LB(X_TW) + (16 * rb + r16) * PT + 32 * k2 + 8 * q4), lfr[nt * 4 + k2], aw); aa = mfma16(*(const LAS bf16x8*)(LB(X_XA) + (16 * rb + r16) * PT + 32 * k2 + 8 * q4), lfr[nt * 4 + 2 + k2], aa); }
                const int c = 16 * nt + r16; const float w0c = LF(Z_PAR)[c], a0c = LF(Z_PAR)[64 + c], kkc = LF(Z_PAR)[128 + c], kac = LF(Z_PAR)[192 + c], rkc = LF(Z_PAR)[256 + c];
#pragma unroll
                for (int jj = 0; jj < 4; ++jj) { const int t = 16 * rb + 4 * q4 + jj, o = t * 64 + c;
                    LF(Y_L)[o] = -0.8750455979f * sigm(w0c + aw[jj]);
                    const float al = sigm(a0c + aa[jj]), kraw = LF(X_KF)[o], rr = LF(X_RF)[o], kn = kraw * kkc * inv[jj];
                    const float knew = kraw * (1.f + (al - 1.f) * kac);
                    LB(Y_A)[o] = (bf16)f2bf(-kn); LB(Y_B)[o] = (bf16)f2bf(kn * al); LB(Y_K)[o] = (bf16)f2bf(knew); LB(Y_R)[o] = (bf16)f2bf(rr);
                    bs[jj] += rr * knew * rkc; } }
#pragma unroll
            for (int jj = 0; jj < 4; ++jj) { const float sm = redl16(bs[jj]); if (r16 == 0) LF(Z_BON)[16 * rb + 4 * q4 + jj] = sm; }
        } else if (FINAL) {
            const int rb = w - 4;
#pragma unroll
            for (int nt = 0; nt < 4; ++nt) { f32x4 ag = FZ4;
#pragma unroll
                for (int k4 = 0; k4 < 4; ++k4) ag = mfma16(*(const LAS bf16x8*)(LB(X_SG) + (16 * rb + r16) * PT2 + 32 * k4 + 8 * q4), lfr[nt * 4 + k4], ag);
#pragma unroll
                for (int jj = 0; jj < 4; ++jj) LB(Z_G)[(16 * rb + 4 * q4 + jj) * 64 + 16 * nt + r16] = (bf16)f2bf(ag[jj]); }
        } }
        __syncthreads();
        if (w == 0) { IDS(); float run = 0.f;
#pragma unroll 8
            for (int t = 0; t < 64; ++t) { run += LF(Y_L)[t * 64 + lane]; LF(Y_L)[t * 64 + lane] = run; }
            LF(Z_PC)[lane] = ex2(run); }
        __syncthreads();
        {
            IDS(); const int t = tok, c0 = 8 * part;
            float Lt[8], Lp[8], Le[8], av[8], bv[8], kv[8], rv[8], vv[8], at[8], rt[8], bt[8], kt[8], bh[8], kh[8];
            ld8f(LF(Y_L) + t * 64 + c0, Lt); ld8f(LF(Y_L) + 63 * 64 + c0, Le); ld8f(LF(Y_VF) + t * 64 + c0, vv);
            if (t > 0) ld8f(LF(Y_L) + (t - 1) * 64 + c0, Lp); else {
#pragma unroll
                for (int e = 0; e < 8; ++e) Lp[e] = 0.f; }
            unpack8(*(const LAS u32x4*)(LB(Y_A) + t * 64 + c0), av); unpack8(*(const LAS u32x4*)(LB(Y_B) + t * 64 + c0), bv);
            unpack8(*(const LAS u32x4*)(LB(Y_K) + t * 64 + c0), kv); unpack8(*(const LAS u32x4*)(LB(Y_R) + t * 64 + c0), rv);
#pragma unroll
            for (int e = 0; e < 8; ++e) { const float eL = ex2(Lt[e]), eLm = ex2(Lp[e]), eN = ex2(-Lt[e]), eE = ex2(Le[e] - Lt[e]);
                at[e] = av[e] * eLm; rt[e] = rv[e] * eL; bt[e] = bv[e] * eN; kt[e] = kv[e] * eN; bh[e] = bv[e] * eE; kh[e] = kv[e] * eE; }
            tr_write8(LB(O_BH), PT, c0, t, bh, part); tr_write8(LB(O_KH), PT, c0, t, kh, part); tr_write8(LB(O_VT), PT, c0, t, vv, part);
            *(LAS u32x4*)(LB(O_AT) + t * PT + c0) = pack8(at); *(LAS u32x4*)(LB(O_RT) + t * PT + c0) = pack8(rt);
            *(LAS u32x4*)(LB(O_BT) + t * PT + c0) = pack8(bt); *(LAS u32x4*)(LB(O_KT) + t * PT + c0) = pack8(kt);
        }
        __syncthreads();
        {
            IDS(); const int rb = w & 3;
#pragma unroll
            for (int ci = 0; ci < 2; ++ci) { const int ct = 2 * (w >> 2) + ci;
                f32x4 ab = FZ4, ak = FZ4, arb = FZ4, ark = FZ4;
                if (ct <= rb) { ab = mm_ll<64>(LB(O_AT), PT, 16 * rb, LB(O_BT), PT, 16 * ct, FZ4, lane); ak = mm_ll<64>(LB(O_AT), PT, 16 * rb, LB(O_KT), PT, 16 * ct, FZ4, lane);
                    if (FINAL) { arb = mm_ll<64>(LB(O_RT), PT, 16 * rb, LB(O_BT), PT, 16 * ct, FZ4, lane); ark = mm_ll<64>(LB(O_RT), PT, 16 * rb, LB(O_KT), PT, 16 * ct, FZ4, lane); } }
#pragma unroll
                for (int jj = 0; jj < 4; ++jj) { const int t = 16 * rb + 4 * q4 + jj, i = 16 * ct + r16;
                    LF(Y_AAB)[t * PF + i] = (i < t) ? ab[jj] : 0.f; LB(Y_AAK)[t * PT + i] = (bf16)f2bf((i < t) ? ak[jj] : 0.f);
                    if (FINAL) { LB(Y_ARB)[t * PT + i] = (bf16)f2bf((i <= t) ? arb[jj] : 0.f); LB(Y_ARK)[t * PT + i] = (bf16)f2bf((i <= t) ? ark[jj] : 0.f); } } }
        }
        __syncthreads();
        { IDS(); for (int i = ft; i < 64 * PF; i += 512) LF(O_TF)[i] = 0.f; }
        __syncthreads();
        if (w == 0) { IDS(); const int blk = lane >> 4, col = lane & 15; float x[16];
#pragma unroll
            for (int i = 0; i < 16; ++i) x[i] = (i == col) ? 1.f : 0.f;
#pragma unroll
            for (int i = 1; i < 16; ++i) { float s = 0.f; asm volatile("" ::: "memory");
#pragma unroll
                for (int m2 = 0; m2 < i; ++m2) s += LF(Y_AAB)[(16 * blk + i) * PF + 16 * blk + m2] * x[m2];
                x[i] += s; }
#pragma unroll
            for (int i = 0; i < 16; ++i) LF(O_TF)[(16 * blk + i) * PF + 16 * blk + col] = x[i]; }
        __syncthreads();
        { IDS(); const int p = ft >> 8, i = (ft >> 4) & 15, jx = ft & 15; float s = 0.f;
#pragma unroll
            for (int m4 = 0; m4 < 4; ++m4) { const f32x4 a = *(const LAS f32x4*)(LF(Y_AAB) + (32 * p + 16 + i) * PF + 32 * p + 4 * m4);
#pragma unroll
                for (int e = 0; e < 4; ++e) s += a[e] * LF(O_TF)[(32 * p + 4 * m4 + e) * PF + 32 * p + jx]; }
            LF(Z_XS)[p * 256 + i * 16 + jx] = s; }
        __syncthreads();
        { IDS(); const int p = ft >> 8, i = (ft >> 4) & 15, jx = ft & 15; float s = 0.f;
#pragma unroll
            for (int m4 = 0; m4 < 4; ++m4) { const f32x4 a = *(const LAS f32x4*)(LF(O_TF) + (32 * p + 16 + i) * PF + 32 * p + 16 + 4 * m4);
#pragma unroll
                for (int e = 0; e < 4; ++e) s += a[e] * LF(Z_XS)[p * 256 + (4 * m4 + e) * 16 + jx]; }
            LF(O_TF)[(32 * p + 16 + i) * PF + 32 * p + jx] = s; }
        __syncthreads();
        { IDS(); const int i = ft >> 4, j0 = (ft & 15) * 2; float s0 = 0.f, s1 = 0.f;
#pragma unroll
            for (int m4 = 0; m4 < 8; ++m4) { const f32x4 a = *(const LAS f32x4*)(LF(Y_AAB) + (32 + i) * PF + 4 * m4);
#pragma unroll
                for (int e = 0; e < 4; ++e) { const f32x2 bv = *(const LAS f32x2*)(LF(O_TF) + (4 * m4 + e) * PF + j0); s0 += a[e] * bv.x; s1 += a[e] * bv.y; } }
            LF(Z_XS)[i * 33 + j0] = s0; LF(Z_XS)[i * 33 + j0 + 1] = s1; }
        __syncthreads();
        { IDS(); const int i = ft >> 4, j0 = (ft & 15) * 2; float s0 = 0.f, s1 = 0.f;
#pragma unroll
            for (int m4 = 0; m4 < 8; ++m4) { const f32x4 a = *(const LAS f32x4*)(LF(O_TF) + (32 + i) * PF + 32 + 4 * m4);
#pragma unroll
                for (int e = 0; e < 4; ++e) { s0 += a[e] * LF(Z_XS)[(4 * m4 + e) * 33 + j0]; s1 += a[e] * LF(Z_XS)[(4 * m4 + e) * 33 + j0 + 1]; } }
            LF(O_TF)[(32 + i) * PF + j0] = s0; LF(O_TF)[(32 + i) * PF + j0 + 1] = s1; }
        __syncthreads();
        { IDS(); const int t = tok, i0 = 8 * part; float o[8];
#pragma unroll
            for (int e = 0; e < 8; ++e) o[e] = LF(O_TF)[t * PF + i0 + e];
            *(LAS u32x4*)(LB(Y_TB) + t * PT + i0) = pack8(o); }
        __syncthreads();
        {
            IDS(); const int rb = w & 3;
            f32x4 uu[NZ];
#pragma unroll
            for (int ci = 0; ci < NZ; ++ci) { const int vt = (w >> 2) * NZ + ci;
                f32x4 z = mm_ll<64>(LB(O_AT), PT, 16 * rb, LB(Z_S), PT, 16 * vt, FZ4, lane);
                if (vt < 4) z = mm_ll<64>(LB(Y_AAK), PT, 16 * rb, LB(O_VT), PT, 16 * vt, z, lane);
                st4bf(LB(Y_ZU) + (16 * vt + r16) * PT + 16 * rb + 4 * q4, z); }
            __syncthreads();
#pragma unroll
            for (int ci = 0; ci < NZ; ++ci) { const int vt = (w >> 2) * NZ + ci; uu[ci] = mm_ll<64>(LB(Y_TB), PT, 16 * rb, LB(Y_ZU), PT, 16 * vt, FZ4, lane); }
            __syncthreads();
#pragma unroll
            for (int ci = 0; ci < NZ; ++ci) { const int vt = (w >> 2) * NZ + ci; st4bf(LB(Y_ZU) + (16 * vt + r16) * PT + 16 * rb + 4 * q4, uu[ci]); }
        }
        __syncthreads();
        {
            IDS(); f32x4 yy[2];
            if (FINAL) { const int rb = w & 3;
#pragma unroll
                for (int ci = 0; ci < 2; ++ci) { const int ct = 2 * (w >> 2) + ci;
                    f32x4 y = mm_ll<64>(LB(O_RT), PT, 16 * rb, LB(Z_S), PT, 16 * ct, FZ4, lane);
                    y = mm_ll<64>(LB(Y_ARB), PT, 16 * rb, LB(Y_ZU), PT, 16 * ct, y, lane);
                    yy[ci] = mm_ll<64>(LB(Y_ARK), PT, 16 * rb, LB(O_VT), PT, 16 * ct, y, lane); } }
#pragma unroll
            for (int ti = 0; ti < NST; ++ti) { const int ct = S_CT(ti); const float pc = LF(Z_PC)[16 * ct + r16];
                f32x4 s = Sacc[ti] * pc;
                s = mm_ll<64>(LB(Y_ZU), PT, 16 * s_vb, LB(O_BH), PT, 16 * ct, s, lane);
                if (s_vb < 4) s = mm_ll<64>(LB(O_VT), PT, 16 * s_vb, LB(O_KH), PT, 16 * ct, s, lane);
                Sacc[ti] = s; }
            __syncthreads();
#pragma unroll
            for (int ti = 0; ti < NST; ++ti) { const int ct = S_CT(ti);
#pragma unroll
                for (int jj = 0; jj < 4; ++jj) LB(Z_S)[(16 * s_vb + 4 * q4 + jj) * PT + 16 * ct + r16] = (bf16)f2bf(Sacc[ti][jj]); }
            if (FINAL) { const int rb = w & 3;
#pragma unroll
                for (int ci = 0; ci < 2; ++ci) { const int ct = 2 * (w >> 2) + ci;
#pragma unroll
                    for (int jj = 0; jj < 4; ++jj) LF(Y_YF)[(16 * rb + 4 * q4 + jj) * PF + 16 * ct + r16] = yy[ci][jj]; } }
        }
        __syncthreads();
        if (FINAL) {
            IDS();
            const int t = tok, c0 = 8 * part; const size_t m = (size_t)b * T + tl0 + t;
            float y[8], gg[8], sm = 0.f; ld8f(LF(Y_YF) + t * PF + c0, y); unpack8(*(const LAS u32x4*)(LB(Z_G) + t * 64 + c0), gg);
#pragma unroll
            for (int e = 0; e < 8; ++e) sm += y[e];
            const float mean = red8(sm) * (1.f / 64.f); float vs = 0.f;
#pragma unroll
            for (int e = 0; e < 8; ++e) { y[e] -= mean; vs += y[e] * y[e]; }
            const float rs = __builtin_amdgcn_rsqf(red8(vs) * (1.f / 64.f) + 64e-5f), bo = LF(Z_BON)[t];
#pragma unroll
            for (int e = 0; e < 8; ++e) { const int c = c0 + e; y[e] = (y[e] * rs * LF(Z_PAR)[320 + c] + LF(Z_PAR)[384 + c] + bo * ldbf(LB(O_VT) + c * PT + t)) * gg[e]; }
            *(u32x4*)((bf16*)(F.ws + WS_YRW) + m * 512 + h * 64 + c0) = pack8(y);
        }
        __syncthreads();
    }
    if (!FINAL) { IDS();
#pragma unroll
        for (int ti = 0; ti < NST; ++ti) { const int ct = S_CT(ti);
            if (s_vb < 4) {
#pragma unroll
                for (int jj = 0; jj < 4; ++jj) Nbuf[(16 * s_vb + 4 * q4 + jj) * 64 + 16 * ct + r16] = Sacc[ti][jj];
            } else { u32x2 wv; wv.x = pk2(Sacc[ti][0], Sacc[ti][1]); wv.y = pk2(Sacc[ti][2], Sacc[ti][3]);
                *(u32x2*)(MT + (16 * ct + r16) * 64 + 16 * (s_vb - 4) + 4 * q4) = wv; }
        }
    }
#undef IDS
#undef S_CT
#undef LB
#undef LF
}

template <bool FINAL>
__device__ __forceinline__ void ret_chunk_unit(Frame& F, int u) {
    const int tid = otid(), lane = tid & 63, w = __builtin_amdgcn_readfirstlane(tid >> 6), r16 = lane & 15, q4 = lane >> 4;
    const int b = u >> 9, sc = (u >> 3) & 63, h = u & 7;
    constexpr int R_QB = 0, R_KB = 9216, R_KHT = 18432, R_VT = 27648, R_GB = 36864, R_AB = 45056, R_SB = 54272, R_YF = 63488;
    LAS unsigned char* L = F.lds;
#define LB(off) ((LAS bf16*)(L + (off)))
#define LF(off) ((LAS float*)(L + (off)))
    bf16* P = (bf16*)(F.ws + WS_BIG);
    float* Sbuf = (float*)(F.ws + WS_ST_RET) + (size_t)u * 4096;
    const float lg = log2f(1.f - exp2f(-5.f - (float)h));
    const float g64 = ex2(64.f * lg);
    const int db = w & 3;
    f32x4 Sacc[2];
#pragma unroll
    for (int ci = 0; ci < 2; ++ci) { const int et = 2 * (w >> 2) + ci;
#pragma unroll
        for (int jj = 0; jj < 4; ++jj) Sacc[ci][jj] = FINAL ? Sbuf[(16 * db + 4 * q4 + jj) * 64 + 16 * et + r16] : 0.f;
        if (FINAL) st4bf(LB(R_SB) + (16 * et + r16) * PT + 16 * db + 4 * q4, Sacc[ci]); }
    const int tok = tid >> 3, part = tid & 7;
    for (int j = 0; j < 4; ++j) {
        const int tl0 = sc * 256 + j * 64;
        {
            const int t = tl0 + tok; const size_t m = (size_t)b * T + t; const bf16* row = P + m * PLD + C_RET + h * 64 + 8 * part;
            float qv[8], kv[8], vv[8]; unpack8(*(const u32x4*)(row + 512), kv); unpack8(*(const u32x4*)(row + 1024), vv);
            if (FINAL) { unpack8(*(const u32x4*)row, qv); *(LAS u32x4*)(LB(R_GB) + tok * 64 + 8 * part) = *(const u32x4*)(row + 1536); }
            const float zeta = ex2((float)(63 - tok) * lg);
            if (FINAL) { *(LAS u32x4*)(LB(R_QB) + tok * PT + 8 * part) = pack8(qv); *(LAS u32x4*)(LB(R_KB) + tok * PT + 8 * part) = pack8(kv); }
            float kz[8];
#pragma unroll
            for (int e = 0; e < 8; ++e) kz[e] = kv[e] * zeta;
            tr_write8(LB(R_KHT), PT, 8 * part, tok, kz, part); tr_write8(LB(R_VT), PT, 8 * part, tok, vv, part);
        }
        __syncthreads();
        if (FINAL) { const int rb = w & 3;
#pragma unroll
            for (int ci = 0; ci < 2; ++ci) { const int ct = 2 * (w >> 2) + ci; f32x4 a = FZ4;
                if (ct <= rb) a = mm_ll<64>(LB(R_QB), PT, 16 * rb, LB(R_KB), PT, 16 * ct, FZ4, lane);
#pragma unroll
                for (int jj = 0; jj < 4; ++jj) { const int l = 16 * rb + 4 * q4 + jj, s = 16 * ct + r16; LB(R_AB)[l * PT + s] = (bf16)f2bf((s <= l) ? a[jj] * ex2((float)(l - s) * lg) : 0.f); } }
            __syncthreads();
        }
        {
            f32x4 yy[2];
            if (FINAL) { const int rb = w & 3;
#pragma unroll
                for (int ci = 0; ci < 2; ++ci) { const int et = 2 * (w >> 2) + ci;
                    const f32x4 a1 = mm_ll<64>(LB(R_AB), PT, 16 * rb, LB(R_VT), PT, 16 * et, FZ4, lane), a2 = mm_ll<64>(LB(R_QB), PT, 16 * rb, LB(R_SB), PT, 16 * et, FZ4, lane);
#pragma unroll
                    for (int jj = 0; jj < 4; ++jj) yy[ci][jj] = a1[jj] + ex2((float)(16 * rb + 4 * q4 + jj + 1) * lg) * a2[jj]; } }
#pragma unroll
            for (int ci = 0; ci < 2; ++ci) { const int et = 2 * (w >> 2) + ci; Sacc[ci] = mm_ll<64>(LB(R_KHT), PT, 16 * db, LB(R_VT), PT, 16 * et, Sacc[ci] * g64, lane); }
            __syncthreads();
            if (FINAL) { const int rb = w & 3;
#pragma unroll
                for (int ci = 0; ci < 2; ++ci) { const int et = 2 * (w >> 2) + ci; st4bf(LB(R_SB) + (16 * et + r16) * PT + 16 * db + 4 * q4, Sacc[ci]);
#pragma unroll
                    for (int jj = 0; jj < 4; ++jj) LF(R_YF)[(16 * rb + 4 * q4 + jj) * PF + 16 * et + r16] = yy[ci][jj]; } }
        }
        __syncthreads();
        if (FINAL) { const size_t m = (size_t)b * T + tl0 + tok; float y[8], g[8], ss = 0.f;
            ld8f(LF(R_YF) + tok * PF + 8 * part, y);
#pragma unroll
            for (int e = 0; e < 8; ++e) ss += y[e] * y[e];
            const float rs = __builtin_amdgcn_rsqf(red8(ss) * (1.f / 64.f) + 1e-6f);
            unpack8(*(const LAS u32x4*)(LB(R_GB) + tok * 64 + 8 * part), g);
#pragma unroll
            for (int e = 0; e < 8; ++e) y[e] = y[e] * rs * silu(g[e]);
            *(u32x4*)(P + m * PLD + C_RETG + h * 64 + 8 * part) = pack8(y);
            __syncthreads(); }
    }
    if (!FINAL) {
#pragma unroll
        for (int ci = 0; ci < 2; ++ci) { const int et = 2 * (w >> 2) + ci;
#pragma unroll
            for (int jj = 0; jj < 4; ++jj) Sbuf[(16 * db + 4 * q4 + jj) * 64 + 16 * et + r16] = Sacc[ci][jj]; }
    }
#undef LB
#undef LF
}

template <bool FINAL>
__device__ __forceinline__ void ssd_chunk_unit(Frame& F, int layer, int u) {
    const int tid = otid(), w = __builtin_amdgcn_readfirstlane(tid >> 6);
#define IDS() const int ft = fresh_tid(tid); const int lane = ft & 63, r16 = lane & 15, q4 = lane >> 4; (void)lane; (void)r16; (void)q4
    const int b = u >> 9, sc = (u >> 3) & 63, h = u & 7, g = h >> 2;
    constexpr int D_CB = 0, D_BB = 17408, D_BT = 34816, D_YF = 53248, D_XT = 70656, D_XDT = 79872, D_GM = 89088, D_SB = 98304, D_MISC = 115712;
    constexpr int D_DTS = D_MISC, D_ACS = D_MISC + 256, D_CAR = D_MISC + 512;
    LAS unsigned char* L = F.lds;
#define LB(off) ((LAS bf16*)(L + (off)))
#define LF(off) ((LAS float*)(L + (off)))
    bf16* P = (bf16*)(F.ws + WS_BIG); const float* dtb = (const float*)(F.ws + WS_DT);
    const bf16* BND = (const bf16*)(F.ws + WS_BND);
    float* Sbuf = (float*)(F.ws + WS_ST_SSD) + (size_t)u * 8192;
    const float* cw = INP(17) + layer * 1024 * 4; const float* cbias = INP(18) + layer * 1024;
    const float dt_bias = INP(19)[layer * 8 + h], A = -expf(INP(20)[layer * 8 + h]), Dh = INP(21)[layer * 8 + h];
    const int bc_chunk = tid & 31, bc_chn = (bc_chunk < 16) ? (512 + g * 128 + bc_chunk * 8) : (768 + g * 128 + (bc_chunk - 16) * 8);
    const int x_chunk = tid & 7, x_chn = h * 64 + x_chunk * 8;
    const int pb = w & 3;
    f32x4 Sacc[4];
    { IDS();
#pragma unroll
    for (int ci = 0; ci < 4; ++ci) { const int nt = 4 * (w >> 2) + ci;
#pragma unroll
        for (int jj = 0; jj < 4; ++jj) { const float x = FINAL ? Sbuf[(16 * pb + 4 * q4 + jj) * 128 + 16 * nt + r16] : 0.f; Sacc[ci][jj] = x;
            if (FINAL) LB(D_SB)[(16 * pb + 4 * q4 + jj) * PT2 + 16 * nt + r16] = (bf16)f2bf(x); } } }
    float dstot = 0.f;
    for (int j = 0; j < 4; ++j) {
        const int tl0 = sc * 256 + j * 64; const size_t m0 = (size_t)b * T + tl0;
        if (w == 0) {
            IDS(); const float dt = softplus_acc(dtb[(m0 + lane) * 8 + h] + dt_bias); float a = A * dt;
#pragma unroll
            for (int o = 1; o < 64; o <<= 1) { const float n = __shfl_up(a, o); if (lane >= o) a += n; }
            LF(D_DTS)[lane] = dt; LF(D_ACS)[lane] = a;
        }
        {
            IDS();
#pragma unroll
            for (int it = 0; it < 4; ++it) { const int t = it * 16 + (ft >> 5); const int ta = tl0 + t;
                float acc[8]; unpack8(*(const u32x4*)(P + (m0 + t) * PLD + C_XBC + bc_chn), acc); (void)ta;
                if (bc_chunk < 16) { *(LAS u32x4*)(LB(D_BB) + t * PT2 + bc_chunk * 8) = pack8(acc); tr_write8(LB(D_BT), PT, bc_chunk * 8, t, acc, bc_chunk & 7); }
                else *(LAS u32x4*)(LB(D_CB) + t * PT2 + (bc_chunk - 16) * 8) = pack8(acc);
            }
        }
        __syncthreads();
        {
            IDS(); const int t = ft >> 3; float acc[8]; unpack8(*(const u32x4*)(P + (m0 + t) * PLD + C_XBC + x_chn), acc);
            const float sc_d = LF(D_DTS)[t] * __expf(LF(D_ACS)[63] - LF(D_ACS)[t]);
            float xs8[8], xd8[8];
#pragma unroll
            for (int e = 0; e < 8; ++e) { xs8[e] = acc[e]; xd8[e] = acc[e] * sc_d; }
            tr_write8(LB(D_XT), PT, x_chunk * 8, t, xs8, x_chunk); tr_write8(LB(D_XDT), PT, x_chunk * 8, t, xd8, x_chunk);
        }
        if (FINAL) { IDS(); const int rb = w & 3;
#pragma unroll
            for (int ci = 0; ci < 2; ++ci) { const int ct = 2 * (w >> 2) + ci; f32x4 a = FZ4;
                if (ct <= rb) a = mm_ll<128>(LB(D_CB), PT2, 16 * rb, LB(D_BB), PT2, 16 * ct, FZ4, lane);
#pragma unroll
                for (int jj = 0; jj < 4; ++jj) { const int l = 16 * rb + 4 * q4 + jj, s = 16 * ct + r16;
                    LB(D_GM)[l * PT + s] = (bf16)f2bf((s <= l) ? a[jj] * __expf(LF(D_ACS)[l] - LF(D_ACS)[s]) * LF(D_DTS)[s] : 0.f); } } }
        __syncthreads();
        {
            IDS(); f32x4 yy[2];
            if (FINAL) { const int rb = w & 3;
#pragma unroll
                for (int ci = 0; ci < 2; ++ci) { const int pt = 2 * (w >> 2) + ci;
                    const f32x4 a1 = mm_ll<64>(LB(D_GM), PT, 16 * rb, LB(D_XT), PT, 16 * pt, FZ4, lane), a2 = mm_ll<128>(LB(D_CB), PT2, 16 * rb, LB(D_SB), PT2, 16 * pt, FZ4, lane);
#pragma unroll
                    for (int jj = 0; jj < 4; ++jj) { const int l = 16 * rb + 4 * q4 + jj, p = 16 * pt + r16; yy[ci][jj] = a1[jj] + __expf(LF(D_ACS)[l]) * a2[jj] + Dh * ldbf(LB(D_XT) + p * PT + l); } } }
            const float dec = expf(LF(D_ACS)[63]);
#pragma unroll
            for (int ci = 0; ci < 4; ++ci) { const int nt = 4 * (w >> 2) + ci; Sacc[ci] = mm_ll<64>(LB(D_XDT), PT, 16 * pb, LB(D_BT), PT, 16 * nt, Sacc[ci] * dec, lane); }
            dstot += LF(D_ACS)[63];
            __syncthreads();
            if (FINAL) { const int rb = w & 3;
#pragma unroll
                for (int ci = 0; ci < 4; ++ci) { const int nt = 4 * (w >> 2) + ci;
#pragma unroll
                    for (int jj = 0; jj < 4; ++jj) LB(D_SB)[(16 * pb + 4 * q4 + jj) * PT2 + 16 * nt + r16] = (bf16)f2bf(Sacc[ci][jj]); }
#pragma unroll
                for (int ci = 0; ci < 2; ++ci) { const int pt = 2 * (w >> 2) + ci;
#pragma unroll
                    for (int jj = 0; jj < 4; ++jj) LF(D_YF)[(16 * rb + 4 * q4 + jj) * PF + 16 * pt + r16] = yy[ci][jj]; } }
        }
        __syncthreads();
        if (FINAL) { IDS(); const int tok = ft >> 3, part = ft & 7; float y[8];
            ld8f(LF(D_YF) + tok * PF + 8 * part, y);
            *(u32x4*)(P + (m0 + tok) * PLD + C_XBC + h * 64 + 8 * part) = pack8(y);
            __syncthreads(); }
    }
    if (!FINAL) { IDS();
#pragma unroll
        for (int ci = 0; ci < 4; ++ci) { const int nt = 4 * (w >> 2) + ci;
#pragma unroll
            for (int jj = 0; jj < 4; ++jj) Sbuf[(16 * pb + 4 * q4 + jj) * 128 + 16 * nt + r16] = Sacc[ci][jj]; }
        if (tid == 0) ((float*)(F.ws + WS_DSTOT))[u] = dstot;
    }
#undef IDS
#undef LB
#undef LF
}

__device__ __forceinline__ void rwkv_scan_chain(Frame& F, int chain) {
    const int tid = otid(), lane = tid & 63, w = __builtin_amdgcn_readfirstlane(tid >> 6), r16 = lane & 15, q4 = lane >> 4;
    const int b = chain >> 3, h = chain & 7, vb = w & 3, ct0 = 2 * (w >> 2);
    LAS bf16* SB = (LAS bf16*)F.lds;
    f32x4 Sacc[2] = {FZ4, FZ4};
    for (int i = tid; i < 64 * PT / 2; i += 512) ((LAS unsigned*)SB)[i] = 0u;
    f32x4 nv[2]; bf16x8 mf[2][2];
    auto fetch = [&](int sc) {
        const int u = (b * 64 + sc) * 8 + h;
        const float* Nb = (const float*)(F.ws + WS_ST_RW) + (size_t)u * 4096; const bf16* MT = (const bf16*)(F.ws + WS_MT) + (size_t)u * 4096;
#pragma unroll
        for (int ci = 0; ci < 2; ++ci) {
#pragma unroll
            for (int jj = 0; jj < 4; ++jj) nv[ci][jj] = Nb[(16 * vb + 4 * q4 + jj) * 64 + 16 * (ct0 + ci) + r16];
#pragma unroll
            for (int k2 = 0; k2 < 2; ++k2) mf[ci][k2] = *(const bf16x8*)(MT + (size_t)(16 * (ct0 + ci) + r16) * 64 + 32 * k2 + 8 * q4); } };
    fetch(0);
    __syncthreads();
    for (int sc = 0; sc < 64; ++sc) {
        const int u = (b * 64 + sc) * 8 + h;
        float* Nb = (float*)(F.ws + WS_ST_RW) + (size_t)u * 4096;
        f32x4 nw[2];
#pragma unroll
        for (int ci = 0; ci < 2; ++ci) {
            f32x4 a = nv[ci];
#pragma unroll
            for (int k2 = 0; k2 < 2; ++k2) a = mfma16(*(const LAS bf16x8*)(SB + (16 * vb + r16) * PT + 32 * k2 + 8 * q4), mf[ci][k2], a);
            nw[ci] = a;
#pragma unroll
            for (int jj = 0; jj < 4; ++jj) Nb[(16 * vb + 4 * q4 + jj) * 64 + 16 * (ct0 + ci) + r16] = Sacc[ci][jj]; }
        if (sc + 1 < 64) fetch(sc + 1);
        __syncthreads();
#pragma unroll
        for (int ci = 0; ci < 2; ++ci) { Sacc[ci] = nw[ci];
#pragma unroll
            for (int jj = 0; jj < 4; ++jj) SB[(16 * vb + 4 * q4 + jj) * PT + 16 * (ct0 + ci) + r16] = (bf16)f2bf(nw[ci][jj]); }
        __syncthreads();
    }
}
__device__ __forceinline__ void elem_scans(Frame& F, int blk, int nblk) {
    const int tid = otid();
    const int NRET = 16 * 4096, NSSD = 16 * 8192;
    const float* dst = (const float*)(F.ws + WS_DSTOT);
    for (int it = blk * 512 + tid; it < NRET + NSSD; it += nblk * 512) {
        if (it < NRET) { const int chain = it >> 12, e = it & 4095, b = chain >> 3, h = chain & 7;
            const float g256 = exp2f(256.f * log2f(1.f - exp2f(-5.f - (float)h)));
            float* p = (float*)(F.ws + WS_ST_RET) + ((size_t)(b * 64) * 8 + h) * 4096 + e; float carry = 0.f;
#pragma unroll 8
            for (int sc = 0; sc < 64; ++sc) { const float t = p[(size_t)sc * 8 * 4096]; p[(size_t)sc * 8 * 4096] = carry; carry = g256 * carry + t; }
        } else { const int i2 = it - NRET, chain = i2 >> 13, e = i2 & 8191, b = chain >> 3, h = chain & 7;
            float* p = (float*)(F.ws + WS_ST_SSD) + ((size_t)(b * 64) * 8 + h) * 8192 + e; const float* d = dst + (b * 64) * 8 + h; float carry = 0.f;
#pragma unroll 8
            for (int sc = 0; sc < 64; ++sc) { const float t = p[(size_t)sc * 8 * 8192]; p[(size_t)sc * 8 * 8192] = carry; carry = expf(d[sc * 8]) * carry + t; }
        }
    }
}
__device__ __forceinline__ void conv_lora(Frame& F) {
    const int tid = otid();
    for (int l = 0; l < 2; ++l) {
        bf16* base = (bf16*)(F.ws + WS_LORA + (size_t)l * LORA_STRIDE);
        const float* wu = INP(4) + l * 64 * 512; const float* au = INP(6) + l * 64 * 512; const float* gu = INP(8) + l * 128 * 512;
        for (int i = F.vcu * 512 + tid; i < 512 * 64; i += F.G * 512) { const int c = i >> 6, jx = i & 63; base[i] = (bf16)f2bf(wu[jx * 512 + c]); base[32768 + i] = (bf16)f2bf(au[jx * 512 + c]); }
        for (int i = F.vcu * 512 + tid; i < 512 * 128; i += F.G * 512) { const int c = i >> 7, jx = i & 127; base[65536 + i] = (bf16)f2bf(gu[jx * 512 + c]); }
    }
}
__device__ __forceinline__ void save_bnd(Frame& F) {
    const int tid = otid();
    const bf16* P = (const bf16*)(F.ws + WS_BIG); bf16* BND = (bf16*)(F.ws + WS_BND);
    for (int i = F.vcu * 512 + tid; i < 2 * 64 * 3 * 64; i += F.G * 512) { const int ch = i & 63, k = (i >> 6) % 3, bs = i / 192, b = bs >> 6, sc = bs & 63;
        if (sc > 0) *(u32x4*)(BND + (size_t)(bs * 3 + k) * 512 + ch * 8) = *(const u32x4*)(P + ((size_t)b * T + sc * 256 - 3 + k) * PLD + C_XBC + ch * 8); }
}

constexpr int LAYER_BASE0 = 1, LAYER_STRIDE = 18, MOE_BASE = LAYER_BASE0 + LAYER_STRIDE + 15;
__device__ __forceinline__ Frame lf(const Frame& F0) {
    Frame F = F0; unsigned l = (unsigned)(unsigned long long)F.lds;
    asm volatile("" : "+s"(l), "+s"(F.vcu), "+s"(F.G), "+s"(F.cid), "+s"(F.wid), "+s"(F.out), "+s"(F.ws));
    F.lds = (LAS unsigned char*)(unsigned long long)l; return F;
}
__global__ void __launch_bounds__(512, 2) fwd(Args args) {
    extern __shared__ __attribute__((aligned(16))) unsigned char lds_raw[];
    Frame F0;
    F0.lds = (LAS unsigned char*)lds_raw;
    F0.G = gridDim.x; { const int bx = blockIdx.x; F0.vcu = (F0.G % 8 == 0) ? (bx % 8) * (F0.G / 8) + bx / 8 : bx; }
    F0.cid = blockIdx.x; F0.out = args.out; F0.ws = args.ws; F0.wid = __builtin_amdgcn_readfirstlane(threadIdx.x >> 6);
    volatile LAS unsigned* MISC = (volatile LAS unsigned*)(F0.lds + MISC_OFF);
    for (int u = threadIdx.x; u < (LDS_BYTES - LDSCTL_OFF) / 4; u += 512) ((LAS unsigned*)(F0.lds + LDSCTL_OFF))[u] = 0u;
    __syncthreads();
    if (threadIdx.x < 34) *(LAS unsigned long long*)(F0.lds + LDSCTL_OFF + 8 * threadIdx.x) = (unsigned long long)args.in[threadIdx.x];
    __syncthreads();
    const int lo = args.ph_lo, hi = args.ph_hi;
    XcdBarrier bar; bar.bar = (unsigned*)(F0.ws + WS_CTL); bar.x = 0; bar.st = nullptr;
    if (hi - lo > 1) bar = xcd_barrier_post((unsigned*)(F0.ws + WS_CTL), MISC + 8);
#define IN(k) (lo <= (k) && (k) < hi)
#define SEAM(k) do { if (IN(k) && IN((k) + 1)) xcd_barrier(bar); } while (0)
#define WSP(T_, off) ((T_*)(F.ws + (off)))

    if (IN(0)) { for (int rep = 0; rep <= REP_CONV; ++rep) { Frame F = lf(F0); conv_layer_weights(F, 0); conv_layer_weights(F, 1); conv_ffn_weights(F); conv_lora(F); }
        for (int rep = 0; rep <= REP_MISC; ++rep) { Frame F = lf(F0); xprep_phase(F, INP(0)); } }
    SEAM(0);
    for (int l = 0; l < 2; ++l) {
        const int pb = LAYER_BASE0 + l * LAYER_STRIDE;
        if (IN(pb + 0)) {
            Frame F = lf(F0); unsigned char* wl = F.ws + WS_W + (size_t)l * WL_STRIDE;
            pg8::Gemm g{WSP(bf16, WS_XB), (const bf16*)(wl + WL_IN), D, D, D}; pg8::StaticOrder S; S.init(M, NP, F.G, F.cid, D, D);
            pg8::EpiInProj E{WSP(bf16, WS_BIG), WSP(float, WS_RSTD), WSP(float, WS_DT)};
            pg8::gemm_phase(F.lds, F.wid, g, S, E);
        }
        SEAM(pb + 0);
        if (IN(pb + 1)) { Frame F = lf(F0); vprep_phase(F, l); prepass_a(F); }
        SEAM(pb + 1);
        if (IN(pb + 2)) { Frame F = lf(F0); prepass_conv(F, l); }
        if (IN(pb + 2) && IN(pb + 3)) xcd_barrier(bar);
        if (IN(pb + 3)) for (int rep = 0; rep <= REP_R1; ++rep) {
#if RW_CH
            for (int r2 = 0; r2 <= REP_RW; ++r2) { Frame F = lf(F0); for (int u = F.cid; u < 1024; u += F.G) rwkv_chunk_unit<false>(F, l, u); }
#else
            { Frame F = lf(F0); if (F.cid < 16) rwkv_seq(F, l, F.cid); }
#endif
#if RET_CH
            for (int r2 = 0; r2 <= REP_RET; ++r2) { Frame F = lf(F0); for (int u = F.cid; u < 1024; u += F.G) ret_chunk_unit<false>(F, u); }
#else
            { Frame F = lf(F0); if (F.cid >= 32 && F.cid < 48) ret_seq(F, F.cid - 32); }
#endif
#if SSD_CH
            for (int r2 = 0; r2 <= REP_SSD; ++r2) { Frame F = lf(F0); for (int u = F.cid; u < 1024; u += F.G) ssd_chunk_unit<false>(F, l, u); }
#else
            { Frame F = lf(F0); if (F.cid >= 16 && F.cid < 32) ssd_seq(F, l, F.cid - 16); }
#endif
        }
        SEAM(pb + 3);
        if (IN(pb + 4)) {
            Frame F = lf(F0);
            if (F.cid < 16) { if (RW_CH) rwkv_scan_chain(F, F.cid); }
            else elem_scans(F, F.cid - 16, F.G - 16);
        }
        SEAM(pb + 4);
        if (IN(pb + 5)) {
#if RW_CH
            { Frame F = lf(F0); for (int u = F.cid; u < 1024; u += F.G) rwkv_chunk_unit<true>(F, l, u); }
#endif
#if RET_CH
            { Frame F = lf(F0); for (int u = F.cid; u < 1024; u += F.G) ret_chunk_unit<true>(F, u); }
#endif
#if SSD_CH
            { Frame F = lf(F0); for (int u = F.cid; u < 1024; u += F.G) ssd_chunk_unit<true>(F, l, u); }
#endif
        }
        SEAM(pb + 5);
        if (IN(pb + 6)) { Frame F = lf(F0); ssm_norm_phase(F, l); xprep_phase(F, (l == 0) ? INP(0) : F.out); }
        SEAM(pb + 6);
        for (int i = 0; i < 3; ++i) {
            if (IN(pb + 7 + 2 * i)) {
                Frame F = lf(F0); unsigned char* wl = F.ws + WS_W + (size_t)l * WL_STRIDE; bf16* P = WSP(bf16, WS_BIG);
                const bf16* A = (i == 0) ? WSP(const bf16, WS_YRW) : (i == 1 ? P + C_Z : P + C_RETG);
                pg8::Gemm g{A, (const bf16*)(wl + WL_BR) + (size_t)i * D * 512, (i == 0) ? 512 : PLD, 512, 512}; pg8::StaticOrder S; S.init(M, D, F.G, F.cid, (i == 0) ? 512 : PLD, 512);
                pg8::EpiPlain E{P, PLD};
                pg8::gemm_phase(F.lds, F.wid, g, S, E);
            }
            SEAM(pb + 7 + 2 * i);
            if (IN(pb + 8 + 2 * i)) {
                Frame F = lf(F0); unsigned char* wl = F.ws + WS_W + (size_t)l * WL_STRIDE; bf16* P = WSP(bf16, WS_BIG);
                pg8::Gemm g{WSP(bf16, WS_XB), (const bf16*)(wl + WL_GATE) + (size_t)i * D * D, D, D, D}; pg8::StaticOrder S; S.init(M, D, F.G, F.cid, D, D);
                pg8::EpiGateMerge E{P, PLD, P + C_RET, PLD, WSP(float, WS_RSTD), i == 0};
                pg8::gemm_phase(F.lds, F.wid, g, S, E);
            }
            SEAM(pb + 8 + 2 * i);
        }
        if (IN(pb + 13)) {
            Frame F = lf(F0); unsigned char* wl = F.ws + WS_W + (size_t)l * WL_STRIDE; bf16* P = WSP(bf16, WS_BIG);
            pg8::Gemm g{P + C_RET, (const bf16*)(wl + WL_OUT), PLD, D, D}; pg8::StaticOrder S; S.init(M, D, F.G, F.cid, PLD, D);
            pg8::EpiResid E{(l == 0) ? INP(0) : F.out, F.out, nullptr, 0};
            pg8::gemm_phase(F.lds, F.wid, g, S, E);
        }
        SEAM(pb + 13);
        if (IN(pb + 14)) { Frame F = lf(F0); xprep_phase(F, F.out); if (l == 1) for (int rep = 0; rep <= REP_CONV; ++rep) conv_moe_weights(F); }
        SEAM(pb + 14);
        if (l == 0) {
            if (IN(pb + 15)) {
                Frame F = lf(F0);
                pg8::Gemm g{WSP(bf16, WS_XB), WSP(const bf16, WS_FFUP), D, D, D}; pg8::StaticOrder S; S.init(M, 2 * FF, F.G, F.cid, D, D);
                pg8::EpiSwiglu E{WSP(bf16, WS_ACT), FF, WSP(float, WS_RSTD)};
                pg8::gemm_phase(F.lds, F.wid, g, S, E);
            }
            SEAM(pb + 15);
            if (IN(pb + 16)) {
                Frame F = lf(F0);
                pg8::Gemm g{WSP(const bf16, WS_ACT), WSP(const bf16, WS_FFDN), FF, FF, FF}; pg8::StaticOrder S; S.init(M, D, F.G, F.cid, FF, FF);
                pg8::EpiResid E{F.out, F.out, nullptr, 0};
                pg8::gemm_phase(F.lds, F.wid, g, S, E);
            }
            SEAM(pb + 16);
            if (IN(pb + 17)) { Frame F = lf(F0); xprep_phase(F, F.out); }
            SEAM(pb + 17);
        }
    }
    {
        const int pb = MOE_BASE;
        if (IN(pb)) { Frame F = lf(F0); router_phase(F); }
        SEAM(pb);
        for (int sg = 0; sg < 3; ++sg) {
            if (IN(pb + 1 + 2 * sg)) {
                Frame F = lf(F0);
                pg8::Gemm g{WSP(bf16, WS_XB), WSP(const bf16, WS_MOEW), D, D, D}; pg8::MoeOrder<true> S; S.init(WSP(const int, WS_CNT), WSP(const int, WS_LIST), sg, 2 * FFE, F.G, F.cid, D, D, MOEW_STRIDE);
                pg8::EpiSwiglu E{WSP(bf16, WS_ACT), FFE, WSP(float, WS_RSTD)};
                pg8::gemm_phase(F.lds, F.wid, g, S, E);
            }
            SEAM(pb + 1 + 2 * sg);
            if (IN(pb + 2 + 2 * sg)) {
                Frame F = lf(F0);
                pg8::Gemm g{WSP(const bf16, WS_ACT), WSP(const bf16, WS_MOEW + MOEW_DN), FFE, FFE, FFE}; pg8::MoeOrder<false> S; S.init(WSP(const int, WS_CNT), WSP(const int, WS_LIST), sg, D, F.G, F.cid, FFE, FFE, MOEW_STRIDE);
                pg8::EpiMoeDown E{F.out};
                pg8::gemm_phase(F.lds, F.wid, g, S, E);
            }
            SEAM(pb + 2 + 2 * sg);
        }
        if (IN(pb + 7)) { Frame F = lf(F0); final_norm_phase(F); }
    }
#undef IN
#undef SEAM
#undef WSP
}
constexpr int LAST_PHASE = MOE_BASE + 7;
constexpr int N_PH = LAST_PHASE + 1;

extern "C" void kernel_launch(void* const* d_in, const int* in_sizes, int n_in, void* d_out, int out_size, void* d_ws, size_t ws_size, hipStream_t stream) {
    static int grid = 0;
    if (grid == 0) {
        if (n_in != 34 || out_size != M * D || ws_size < WS_END) { fprintf(stderr, "kernel_launch: unexpected problem (n_in %d out %d ws %zu need %zu)\n", n_in, out_size, ws_size, (size_t)WS_END); grid = -1; return; }
        int dev = 0, cus = 0;
        if (hipGetDevice(&dev) != hipSuccess || hipDeviceGetAttribute(&cus, hipDeviceAttributeMultiprocessorCount, dev) != hipSuccess) { grid = -1; return; }
        if (hipFuncSetAttribute((const void*)fwd, hipFuncAttributeMaxDynamicSharedMemorySize, LDS_BYTES) != hipSuccess) { fprintf(stderr, "kernel_launch: hipFuncSetAttribute failed\n"); grid = -1; return; }
        int per_cu = 0;
        if (hipOccupancyMaxActiveBlocksPerMultiprocessor(&per_cu, (const void*)fwd, 512, LDS_BYTES) != hipSuccess || per_cu < 1) fprintf(stderr, "kernel_launch: occupancy query says %d\n", per_cu);
        (void)hipGetLastError();
        grid = cus;
    }
    if (grid < 0) return;
    (void)hipMemsetAsync((char*)d_ws + WS_CTL, 0, CTL_ZERO_BYTES, stream);
    Args a{};
    for (int i = 0; i < 34; ++i) a.in[i] = (const float*)d_in[i];
    a.out = (float*)d_out; a.ws = (unsigned char*)d_ws;
#if MK_ONE_LAUNCH
    a.ph_lo = 0; a.ph_hi = N_PH;
    hipLaunchKernelGGL(fwd, dim3(grid), dim3(512), LDS_BYTES, stream, a);
#else
    for (int p = 0; p < N_PH; ++p) { a.ph_lo = p; a.ph_hi = p + 1; hipLaunchKernelGGL(fwd, dim3(grid), dim3(512), LDS_BYTES, stream, a); }
#endif
}
```

```cpp
#include <hip/hip_runtime.h>
#include <cstdio>
#include <cstdint>

#ifndef MK_ONE_LAUNCH
#define MK_ONE_LAUNCH 1
#endif

#define LAS __attribute__((address_space(3)))
#define GAS __attribute__((address_space(1)))
typedef unsigned short bf16;
typedef short bf16x8 __attribute__((ext_vector_type(8)));
typedef float f32x4 __attribute__((ext_vector_type(4)));
typedef float f32x2 __attribute__((ext_vector_type(2)));
typedef unsigned u32x4 __attribute__((ext_vector_type(4)));
typedef unsigned u32x2 __attribute__((ext_vector_type(2)));

constexpr int BATCH = 2, T = 16384, D = 1024, M = BATCH * T;
constexpr int INC = 8456;
constexpr int PLD = 5376;
constexpr int NP = 5632;
constexpr int C_RW = 0, C_Z = 1792, C_XBC = 2304, C_RET = 3328, C_RETG = 4864;
constexpr int FF = 2816, FFE = 3584, NE = 8;

constexpr size_t MiB = 1u << 20;
constexpr size_t WS_CTL = 0, CTL_ZERO_BYTES = 64 * 1024;
constexpr size_t WS_RSTD = 1 * MiB, WS_GATES = 2 * MiB, WS_DT = 3 * MiB;
constexpr size_t WS_W = 4 * MiB;
constexpr size_t WL_IN = 0, WL_GATE = 11 * MiB, WL_BR = 17 * MiB, WL_OUT = 20 * MiB, WL_STRIDE = 22 * MiB;
constexpr size_t WS_FFUP = WS_W + 44 * MiB, WS_FFDN = WS_W + 55 * MiB;
constexpr size_t WS_XB = 68 * MiB;
constexpr size_t WS_VF = 132 * MiB;
constexpr size_t WS_BIG = 164 * MiB;
constexpr size_t WS_VMIX = WS_BIG + 336 * MiB, WS_YRW = WS_BIG + 368 * MiB, WS_END = 573 * MiB;
constexpr size_t WS_MOEW = WS_BIG;
constexpr size_t MOEW_STRIDE = 21 * MiB, MOEW_DN = 14 * MiB;
constexpr size_t WS_ACT = WS_BIG + 168 * MiB;

constexpr size_t WS_CNT = 32768, WS_LIST = 2 * MiB;
constexpr size_t WS_BND2 = 566 * MiB;
constexpr size_t WS_DSTOT = 128 * 1024, WS_BND = 256 * 1024;
constexpr size_t WS_LORA = 1 * MiB + 512 * 1024, LORA_STRIDE = 262144;
constexpr size_t WS_ST_RW = WS_XB, WS_ST_RET = WS_XB + 16 * MiB, WS_ST_SSD = WS_XB + 32 * MiB, WS_MT = WS_YRW;
constexpr int RING_BYTES = 131072, LDSCTL_OFF = 159744, MISC_OFF = LDSCTL_OFF + 320, LDS_BYTES = 163840;
#ifndef REP_CONV
#define REP_CONV 0
#endif
#ifndef REP_R1
#define REP_R1 0
#endif
#ifndef REP_RW
#define REP_RW 0
#endif
#ifndef REP_RET
#define REP_RET 0
#endif
#ifndef REP_SSD
#define REP_SSD 0
#endif
#ifndef REP_MISC
#define REP_MISC 0
#endif
#ifndef RW_CH
#define RW_CH 1
#endif
#ifndef RET_CH
#define RET_CH 1
#endif
#ifndef SSD_CH
#define SSD_CH 1
#endif

typedef __bf16 hbf16x2 __attribute__((ext_vector_type(2)));
__device__ __forceinline__ unsigned pk2(float lo, float hi) { const f32x2 v = {lo, hi}; return __builtin_bit_cast(unsigned, __builtin_convertvector(v, hbf16x2)); }
__device__ __forceinline__ unsigned f2bf(float f) { return (unsigned)__builtin_bit_cast(unsigned short, (__bf16)f); }
__device__ __forceinline__ float bflo(unsigned u) { return __builtin_bit_cast(float, u << 16); }
__device__ __forceinline__ float bfhi(unsigned u) { return __builtin_bit_cast(float, u & 0xffff0000u); }
__device__ __forceinline__ void unpack8(const u32x4 u, float (&f)[8]) { f[0] = bflo(u.x); f[1] = bfhi(u.x); f[2] = bflo(u.y); f[3] = bfhi(u.y); f[4] = bflo(u.z); f[5] = bfhi(u.z); f[6] = bflo(u.w); f[7] = bfhi(u.w); }
__device__ __forceinline__ u32x4 pack8(const float (&f)[8]) { u32x4 w; w.x = pk2(f[0], f[1]); w.y = pk2(f[2], f[3]); w.z = pk2(f[4], f[5]); w.w = pk2(f[6], f[7]); return w; }
__device__ __forceinline__ float sigm(float x) { return __builtin_amdgcn_rcpf(1.f + __expf(-x)); }
__device__ __forceinline__ float silu(float x) { return x * __builtin_amdgcn_rcpf(1.f + __expf(-x)); }
__device__ __forceinline__ float ex2(float x) { return __builtin_amdgcn_exp2f(x); }
__device__ __forceinline__ float fast_tanh(float x) { return 1.f - 2.f * __builtin_amdgcn_rcpf(1.f + __expf(2.f * x)); }
__device__ __forceinline__ float softplus_acc(float x) { return fmaxf(x, 0.f) + log1pf(expf(-fabsf(x))); }
__device__ __forceinline__ float wave_sum(float v) {
#pragma unroll
    for (int o = 1; o < 64; o <<= 1) v += __shfl_xor(v, o);
    return v;
}
__device__ __forceinline__ int otid_w(int wid) { unsigned z = 0u; asm volatile("" : "+v"(z)); int t = wid * 64 + (int)__builtin_amdgcn_mbcnt_hi(~0u, __builtin_amdgcn_mbcnt_lo(~0u, z)); asm volatile("" : "+v"(t)); return t; }
#define otid() otid_w(F.wid)
__device__ __forceinline__ int fresh_tid(int t) { asm volatile("" : "+v"(t)); return t; }
#define LDS_WAIT() asm volatile("s_waitcnt lgkmcnt(0)" ::: "memory")

namespace pg8 {
constexpr int BM = 256, BK = 64, HALF = 128, HTB = HALF * BK * 2, STAGE_BYTES = 8 * HTB, NXCD = 8, WGM = 8;
__host__ __device__ __forceinline__ int lds_byte(int r, int c) { const int st = (r >> 4) * 2 + (c >> 5), rr = r & 15, cc = c & 31, ob = rr * 64 + cc * 2; return st * 1024 + (ob ^ (((ob >> 9) & 1) << 5)); }
__host__ __device__ __forceinline__ void stage_rc(int b, int& R, int& C) { const int st = b / 1024, sb = b % 1024, swz = sb ^ (((sb >> 9) & 1) << 5); R = (st >> 1) * 16 + swz / 64; C = (st & 1) * 32 + (swz % 64) / 2; }
__host__ __device__ __forceinline__ int perm32(int rho) { const int n = rho >> 4, i = rho & 15; return 8 * (i >> 2) + 4 * n + (i & 3); }

struct Unit { int pm, pn; size_t aofs, bofs; const int* rows; int nvalid, e; };
struct Gemm { const bf16* A; const bf16* Bt; int lda, ldb, K; };

struct StaticOrder {
    static constexpr bool GATHER = false;
    int nM, nN, nwg, G, c; size_t tsA, tsB;
    __device__ __forceinline__ void init(int Mrows, int N, int G_, int c_, int lda, int ldb) { nM = Mrows / BM; nN = N / BM; nwg = nM * nN; G = G_; c = c_; tsA = (size_t)BM * lda * 2; tsB = (size_t)BM * ldb * 2; }
    __device__ __forceinline__ bool next(int i, Unit& u) const {
        const long L = (long)i * G + c; if (L >= nwg) return false;
        int wgid = (int)L; { const int q = nwg / NXCD, r = nwg % NXCD, xcd = wgid % NXCD, off = wgid / NXCD; wgid = (xcd < r ? xcd * (q + 1) : r * (q + 1) + (xcd - r) * q) + off; }
        const int nig = WGM * nN, gid = wgid / nig, fm = gid * WGM, gsz = (nM - fm) < WGM ? (nM - fm) : WGM;
        u.pm = fm + ((wgid % nig) % gsz); u.pn = (wgid % nig) / gsz; u.aofs = (size_t)u.pm * tsA; u.bofs = (size_t)u.pn * tsB; u.rows = nullptr; u.nvalid = BM; u.e = 0; return true;
    }
};
template <bool GATH> struct MoeOrder {
    static constexpr bool GATHER = GATH;
    unsigned q0, q1, q2, q3;
    int seg, nN, G, c, ksplit; const int* list; size_t bstride, tsB, tsA, kbytes;
    __device__ __forceinline__ void init(const int* counts, const int* list_, int seg_, int N, int G_, int c_, int lda, int ldb, size_t bstride_, int ksplit_ = 1, int kpart = 0) {
        unsigned n[8];
#pragma unroll
        for (int e = 0; e < 8; ++e) { int v = __builtin_amdgcn_readfirstlane(counts[e]); v = v < 0 ? 0 : (v > 32768 ? 32768 : v); n[e] = (unsigned)v; }
        q0 = n[0] | (n[1] << 16); q1 = n[2] | (n[3] << 16); q2 = n[4] | (n[5] << 16); q3 = n[6] | (n[7] << 16);
        seg = seg_; nN = N / BM; G = G_; c = c_; list = list_; bstride = bstride_; tsB = (size_t)BM * ldb * 2; tsA = (size_t)BM * lda * 2; ksplit = ksplit_; kbytes = (size_t)kpart * 2;
    }
    __device__ __forceinline__ bool next(int i, Unit& u) const {
        const long L0 = (long)i * G + c; const long L = L0 / ksplit; const int ks = (int)(L0 % ksplit); const int tl = (int)(L / nN), pn = (int)(L % nN), gt = seg * 128 + tl;
        int t = 0, e = 0, tbe = 0, cne = 0;
#pragma unroll
        for (int k = 0; k < 8; ++k) { const unsigned q = (k < 2) ? q0 : (k < 4) ? q1 : (k < 6) ? q2 : q3; const int n = (int)((k & 1) ? (q >> 16) : (q & 0xffffu));
            if (gt >= t) { e = k; tbe = t; cne = n; } t += (n + 255) >> 8; }
        int nt = t - seg * 128; nt = nt < 0 ? 0 : (nt > 128 ? 128 : nt);
        if (L >= (long)nt * nN) return false;
        const int rt = gt - tbe;
        u.pm = tl; u.pn = pn; u.e = e; u.bofs = (size_t)e * bstride + (size_t)pn * tsB + ks * kbytes; u.aofs = (GATH ? 0 : (size_t)tl * tsA) + ks * kbytes;
        u.rows = list + ((size_t)e * 32768 + rt * 256) * 2; int nv = cne - rt * 256; u.nvalid = nv > 256 ? 256 : nv; return true;
    }
};

template <class Epi, class Sched>
__device__ __forceinline__ void gemm_phase(LAS unsigned char* lds, int wid0, const Gemm g, const Sched& S, const Epi& E) {
    constexpr bool GATHER = Sched::GATHER;
    const int tid = otid_w(wid0), wid = __builtin_amdgcn_readfirstlane(tid >> 6), lane = tid & 63, wr = wid >> 2, wc = wid & 3, fr = lane & 15, fq = lane >> 4;
    const int nt = g.K / BK;
    unsigned voffA[2], voffB[2];
#pragma unroll
    for (int i = 0; i < 2; ++i) { int R, C; stage_rc(tid * 16 + i * 8192, R, C); const int Rb = Epi::PERM ? ((R & ~31) + perm32(R & 31)) : R;
        voffA[i] = (unsigned)(R * g.lda + C) * 2u; voffB[i] = (unsigned)(Rb * g.ldb + C) * 2u; }
    const size_t kstep = (size_t)(BK * 2);
    const size_t hstepA = GATHER ? 0 : (size_t)HALF * g.lda * 2, hstepB = (size_t)HALF * g.ldb * 2;
    const unsigned ldsw = (unsigned)wid * 1024u;
    const int aoff = lds_byte(wr * 64 + fr, fq * 8), boff = lds_byte(wc * 32 + fr, fq * 8);
#define PG8_SA(b, h) (((b) * 2 + (h)) * HTB)
#define PG8_SB(b, h) ((4 + (b) * 2 + (h)) * HTB)
#define PG8_STAGE2(bufoff, gbase, o0, o1) do { \
        __builtin_amdgcn_global_load_lds((const unsigned*)((const char*)(gbase) + (o0)), (LAS unsigned*)(lds + (bufoff) + ldsw), 16, 0, 0); \
        __builtin_amdgcn_global_load_lds((const unsigned*)((const char*)(gbase) + (o1)), (LAS unsigned*)(lds + (bufoff) + ldsw + 8192), 16, 0, 0); } while (0)
#define PG8_STAGE(bufoff, gbase, voff) PG8_STAGE2(bufoff, gbase, (voff)[0], (voff)[1])
#define PG8_LDA(dst, b, h) do { _Pragma("unroll") for (int m = 0; m < 4; ++m) _Pragma("unroll") for (int k = 0; k < 2; ++k) dst[m][k] = *(const LAS bf16x8*)(lds + PG8_SA(b, h) + aoff + m * 2048 + k * 1024); } while (0)
#define PG8_LDB(dst, b, h) do { _Pragma("unroll") for (int n = 0; n < 2; ++n) _Pragma("unroll") for (int k = 0; k < 2; ++k) dst[n][k] = *(const LAS bf16x8*)(lds + PG8_SB(b, h) + boff + n * 2048 + k * 1024); } while (0)
#define PG8_MMA(ai, bj, At, Bt) do { __builtin_amdgcn_s_setprio(1); _Pragma("unroll") for (int m = 0; m < 4; ++m) _Pragma("unroll") for (int n = 0; n < 2; ++n) _Pragma("unroll") for (int k = 0; k < 2; ++k) \
        acc[ai][bj][m][n] = Epi::TRANS ? __builtin_amdgcn_mfma_f32_16x16x32_bf16(Bt[n][k], At[m][k], acc[ai][bj][m][n], 0, 0, 0) : __builtin_amdgcn_mfma_f32_16x16x32_bf16(At[m][k], Bt[n][k], acc[ai][bj][m][n], 0, 0, 0); __builtin_amdgcn_s_setprio(0); } while (0)
#define PG8_WAIT_V(n) asm volatile("s_waitcnt vmcnt(" #n ")" ::: "memory")
#define PG8_WAIT_L(n) asm volatile("s_waitcnt lgkmcnt(" #n ")" ::: "memory")
#define PG8_BAR __builtin_amdgcn_s_barrier()
#define PG8_SCHED __builtin_amdgcn_sched_barrier(0)
#define GSLOT(which) ((LAS u32x4*)(lds + 131072 + (which) * 8192 + tid * 16))
#define PG8_ROWS(u, which) do { const int _ft = fresh_tid(tid); unsigned _vg[2][2]; _Pragma("unroll") for (int _i = 0; _i < 2; ++_i) { int _R, _C; stage_rc(_ft * 16 + _i * 8192, _R, _C); \
        _Pragma("unroll") for (int _h = 0; _h < 2; ++_h) { const int _r = _h * HALF + _R; \
        const int _t = (_r < (u).nvalid) ? (u).rows[2 * _r] : 0; _vg[_h][_i] = ((unsigned)_t * (unsigned)g.lda + (unsigned)_C) * 2u; } } \
        u32x4 _o; _o.x = _vg[0][0]; _o.y = _vg[0][1]; _o.z = _vg[1][0]; _o.w = _vg[1][1]; *GSLOT(which) = _o; } while (0)
    Unit cur, nxt; int ui = 0;
    if (!S.next(0, cur)) return;
    f32x4 acc[2][2][4][2];
#pragma unroll
    for (int a = 0; a < 2; ++a)
#pragma unroll
        for (int b = 0; b < 2; ++b)
#pragma unroll
            for (int m = 0; m < 4; ++m)
#pragma unroll
                for (int n = 0; n < 2; ++n) acc[a][b][m][n] = (f32x4){0.f, 0.f, 0.f, 0.f};
    bf16x8 At[4][2], B0[2][2], B1[2][2];
    u32x4 gc = {voffA[0], voffA[1], voffA[0], voffA[1]};
    if constexpr (GATHER) { PG8_ROWS(cur, 0); PG8_ROWS(cur, 1); gc = *GSLOT(0); }
#define VGC(h, i) (gc[2 * (h) + (i)])
    const char* cA = (const char*)g.A + cur.aofs; const char* cB = (const char*)g.Bt + cur.bofs;
    PG8_STAGE(PG8_SB(0, 0), cB, voffB); PG8_STAGE(PG8_SB(0, 1), cB + hstepB, voffB); PG8_STAGE2(PG8_SA(0, 0), cA, VGC(0, 0), VGC(0, 1)); PG8_STAGE2(PG8_SA(0, 1), cA + hstepA, VGC(1, 0), VGC(1, 1));
    if (wr == 1) PG8_BAR;
    PG8_WAIT_V(2); PG8_BAR;
    PG8_STAGE(PG8_SB(1, 0), cB + kstep, voffB); PG8_STAGE2(PG8_SA(1, 0), cA + kstep, VGC(0, 0), VGC(0, 1)); PG8_STAGE(PG8_SB(1, 1), cB + hstepB + kstep, voffB);
    PG8_WAIT_V(6); PG8_BAR;
    for (;;) {
        const bool has_next = S.next(ui + 1, nxt);
        const char* nA = has_next ? (const char*)g.A + nxt.aofs : cA; const char* nB = has_next ? (const char*)g.Bt + nxt.bofs : cB;
        if constexpr (GATHER) { if (has_next) PG8_ROWS(nxt, 1); else *GSLOT(1) = *GSLOT(0); }
        for (int t = 0; t < nt; t += 2) {
            const bool last = (t == nt - 2);
            const char* a1 = cA + (size_t)(t + 1) * kstep;
            const char* a2 = last ? nA : cA + (size_t)(t + 2) * kstep; const char* b2 = last ? nB : cB + (size_t)(t + 2) * kstep;
            const char* a3 = a2 + kstep; const char* b3 = b2 + kstep;
            u32x4 gn = gc; if constexpr (GATHER) { gc = *GSLOT(0); gn = last ? *GSLOT(1) : gc; }
            const unsigned s00 = gn.x, s01 = gn.y, s10 = gn.z, s11 = gn.w;
            PG8_LDB(B0, 0, 0); PG8_LDB(B1, 0, 1); PG8_SCHED; PG8_LDA(At, 0, 0); PG8_STAGE2(PG8_SA(1, 1), a1 + hstepA, VGC(1, 0), VGC(1, 1));
            PG8_WAIT_V(8); PG8_WAIT_L(0); PG8_BAR; PG8_MMA(0, 0, At, B0); PG8_MMA(0, 1, At, B1); PG8_BAR; PG8_SCHED;
            PG8_LDA(At, 0, 1); PG8_STAGE(PG8_SB(0, 0), b2, voffB); PG8_STAGE(PG8_SB(0, 1), b2 + hstepB, voffB); PG8_STAGE2(PG8_SA(0, 0), a2, s00, s01);
            PG8_WAIT_V(8); PG8_WAIT_L(0); PG8_BAR; PG8_MMA(1, 0, At, B0); PG8_MMA(1, 1, At, B1); PG8_BAR; PG8_SCHED;
            PG8_LDB(B0, 1, 0); PG8_LDB(B1, 1, 1); PG8_SCHED; PG8_LDA(At, 1, 0); PG8_STAGE2(PG8_SA(0, 1), a2 + hstepA, s10, s11);
            PG8_WAIT_V(8); PG8_WAIT_L(0); PG8_BAR; PG8_MMA(0, 0, At, B0); PG8_MMA(0, 1, At, B1); PG8_BAR; PG8_SCHED;
            PG8_LDA(At, 1, 1); PG8_STAGE(PG8_SB(1, 0), b3, voffB); PG8_STAGE(PG8_SB(1, 1), b3 + hstepB, voffB); PG8_STAGE2(PG8_SA(1, 0), a3, s00, s01);
            PG8_WAIT_V(8); PG8_WAIT_L(0); PG8_BAR; PG8_MMA(1, 0, At, B0); PG8_MMA(1, 1, At, B1); PG8_BAR; PG8_SCHED;
        }
        if (wr == 0) PG8_BAR;
        E(acc, cur, wr, wc, fr, fq);
        if (!has_next) break;
#pragma unroll
        for (int a = 0; a < 2; ++a)
#pragma unroll
            for (int b = 0; b < 2; ++b)
#pragma unroll
                for (int m = 0; m < 4; ++m)
#pragma unroll
                    for (int n = 0; n < 2; ++n) acc[a][b][m][n] = (f32x4){0.f, 0.f, 0.f, 0.f};
        cur = nxt; cA = nA; cB = nB; ++ui;
        if constexpr (GATHER) { *GSLOT(0) = *GSLOT(1); }
        if (wr == 1) PG8_BAR;
    }
    PG8_WAIT_V(0);
    PG8_BAR;
#undef PG8_SA
#undef PG8_SB
#undef PG8_STAGE
#undef PG8_STAGE2
#undef PG8_ROWS
#undef GSLOT
#undef VGC
#undef PG8_LDA
#undef PG8_LDB
#undef PG8_MMA
#undef PG8_WAIT_V
#undef PG8_WAIT_L
#undef PG8_BAR
#undef PG8_SCHED
}

typedef const f32x4 (&AccRef)[2][2][4][2];

struct EpiInProj {
    static constexpr bool PERM = true, TRANS = true;
    bf16* P; const float* rstd; float* dt;
    __device__ __forceinline__ void operator()(AccRef acc, const Unit& u, int wr, int wc, int fr, int fq) const {
        const int row0 = u.pm * BM + wr * 64 + fr;
        if (u.pn < 21) {
            const int col0 = u.pn * BM + wc * 32 + 8 * fq;
#pragma unroll
            for (int ai = 0; ai < 2; ++ai)
#pragma unroll
                for (int m = 0; m < 4; ++m) { const int row = row0 + ai * HALF + m * 16; const float s = rstd[row]; bf16* rowp = P + (size_t)row * PLD + col0;
#pragma unroll
                    for (int bj = 0; bj < 2; ++bj) { const f32x4 v0 = acc[ai][bj][m][0] * s, v1 = acc[ai][bj][m][1] * s;
                        u32x4 w; w.x = pk2(v0[0], v0[1]); w.y = pk2(v0[2], v0[3]); w.z = pk2(v1[0], v1[1]); w.w = pk2(v1[2], v1[3]);
                        *(u32x4*)(rowp + bj * HALF) = w; } }
        } else if (wc == 0 && fq == 0) {
#pragma unroll
            for (int ai = 0; ai < 2; ++ai)
#pragma unroll
                for (int m = 0; m < 4; ++m) { const int row = row0 + ai * HALF + m * 16; const float s = rstd[row];
                    *(f32x4*)(dt + (size_t)row * 8) = acc[ai][0][m][0] * s; *(f32x4*)(dt + (size_t)row * 8 + 4) = acc[ai][0][m][1] * s; }
        }
    }
};
struct EpiPlain {
    static constexpr bool PERM = true, TRANS = true;
    bf16* O; int ldc;
    __device__ __forceinline__ void operator()(AccRef acc, const Unit& u, int wr, int wc, int fr, int fq) const {
        const int row0 = u.pm * BM + wr * 64 + fr, col0 = u.pn * BM + wc * 32 + 8 * fq;
#pragma unroll
        for (int ai = 0; ai < 2; ++ai)
#pragma unroll
            for (int m = 0; m < 4; ++m) { bf16* rowp = O + (size_t)(row0 + ai * HALF + m * 16) * ldc + col0;
#pragma unroll
                for (int bj = 0; bj < 2; ++bj) { const f32x4 v0 = acc[ai][bj][m][0], v1 = acc[ai][bj][m][1];
                    u32x4 w; w.x = pk2(v0[0], v0[1]); w.y = pk2(v0[2], v0[3]); w.z = pk2(v1[0], v1[1]); w.w = pk2(v1[2], v1[3]);
                    *(u32x4*)(rowp + bj * HALF) = w; } }
    }
};
struct EpiGateMerge {
    static constexpr bool PERM = true, TRANS = true;
    const bf16* Y; int ldy; bf16* Mg; int ldm; const float* rstd; int first;
    __device__ __forceinline__ void operator()(AccRef acc, const Unit& u, int wr, int wc, int fr, int fq) const {
        const int row0 = u.pm * BM + wr * 64 + fr, col0 = u.pn * BM + wc * 32 + 8 * fq;
#pragma unroll
        for (int ai = 0; ai < 2; ++ai)
#pragma unroll
            for (int m = 0; m < 4; ++m) { const int row = row0 + ai * HALF + m * 16; const float s = rstd[row];
#pragma unroll
                for (int bj = 0; bj < 2; ++bj) { const int c = col0 + bj * HALF;
                    float y[8], o[8]; unpack8(*(const u32x4*)(Y + (size_t)row * ldy + c), y);
                    const f32x4 v0 = acc[ai][bj][m][0] * s, v1 = acc[ai][bj][m][1] * s;
#pragma unroll
                    for (int j = 0; j < 4; ++j) { o[j] = sigm(v0[j]) * y[j]; o[4 + j] = sigm(v1[j]) * y[4 + j]; }
                    if (!first) { float p[8]; unpack8(*(const u32x4*)(Mg + (size_t)row * ldm + c), p);
#pragma unroll
                        for (int j = 0; j < 8; ++j) o[j] += p[j]; }
                    *(u32x4*)(Mg + (size_t)row * ldm + c) = pack8(o); } }
    }
};
struct EpiResid {
    static constexpr bool PERM = false, TRANS = true;
    const float* xin; float* xout; const float* gates; int e;
    __device__ __forceinline__ void operator()(AccRef acc, const Unit& u, int wr, int wc, int fr, int fq) const {
        const int row0 = u.pm * BM + wr * 64 + fr, col0 = u.pn * BM + wc * 32 + 4 * fq;
#pragma unroll
        for (int ai = 0; ai < 2; ++ai)
#pragma unroll
            for (int m = 0; m < 4; ++m) { const int row = row0 + ai * HALF + m * 16; const float s = gates ? gates[(size_t)row * 8 + e] : 1.f;
                const float* ip = xin + (size_t)row * D + col0; float* op = xout + (size_t)row * D + col0;
#pragma unroll
                for (int bj = 0; bj < 2; ++bj)
#pragma unroll
                    for (int n = 0; n < 2; ++n) *(f32x4*)(op + bj * HALF + n * 16) = *(const f32x4*)(ip + bj * HALF + n * 16) + acc[ai][bj][m][n] * s; }
    }
};
struct EpiSwiglu {
    static constexpr bool PERM = true, TRANS = true;
    bf16* act; int ldc; const float* rstd;
    __device__ __forceinline__ void operator()(AccRef acc, const Unit& u, int wr, int wc, int fr, int fq) const {
        asm volatile("" : "+v"(fr), "+v"(fq));
        const int row0 = u.pm * BM + wr * 64 + fr, col0 = u.pn * HALF + wc * 32 + 8 * fq;
#pragma unroll
        for (int ai = 0; ai < 2; ++ai)
#pragma unroll
            for (int m = 0; m < 4; ++m) { const int row = row0 + ai * HALF + m * 16; const int lr = row - u.pm * BM;
                const float s = u.rows ? rstd[(lr < u.nvalid) ? u.rows[2 * lr] : 0] : rstd[row];
                float o[8];
#pragma unroll
                for (int n = 0; n < 2; ++n)
#pragma unroll
                    for (int j = 0; j < 4; ++j) o[4 * n + j] = silu(acc[ai][0][m][n][j] * s) * (acc[ai][1][m][n][j] * s);
                *(u32x4*)(act + (size_t)row * ldc + col0) = pack8(o); }
    }
};
struct EpiMoeDown {
    static constexpr bool PERM = false, TRANS = false;
    float* x;
    __device__ __forceinline__ void operator()(AccRef acc, const Unit& u, int wr, int wc, int fr, int fq) const {
        asm volatile("" : "+v"(fr), "+v"(fq));
        const int col0 = u.pn * BM + wc * 32 + fr;
#pragma unroll
        for (int ai = 0; ai < 2; ++ai)
#pragma unroll
            for (int m = 0; m < 4; ++m) { asm volatile("" ::: "memory");
#pragma unroll
                for (int j = 0; j < 4; ++j) { const int lr = ai * HALF + wr * 64 + m * 16 + 4 * fq + j;
                    if (lr < u.nvalid) { const int tok = u.rows[2 * lr]; const float wgt = __builtin_bit_cast(float, u.rows[2 * lr + 1]); float* xp = x + (size_t)tok * D + col0;
#pragma unroll
                        for (int bj = 0; bj < 2; ++bj)
#pragma unroll
                            for (int n = 0; n < 2; ++n) atomicAdd(xp + bj * HALF + n * 16, wgt * acc[ai][bj][m][n][j]); } } }
    }
};
}

#define XB_TMO      128
#define XB_XCNT(j)  (256  + 64 * (j))
#define XB_XSUB(j)  (1280 + 64 * (j))
#define XB_XGEN(j)  (2304 + 64 * (j))
#define XB_TOP      3328
#define XB_TOPGEN   3392
#define XCD_BAR_WORDS 3456
#define XB_SPIN_CAP (1u << 18)

__device__ __forceinline__ unsigned xb_ld(unsigned* p)              { return __hip_atomic_load(p, __ATOMIC_RELAXED, __HIP_MEMORY_SCOPE_AGENT); }
__device__ __forceinline__ unsigned xb_add(unsigned* p, unsigned v) { return __hip_atomic_fetch_add(p, v, __ATOMIC_RELAXED, __HIP_MEMORY_SCOPE_AGENT); }
__device__ __forceinline__ unsigned xb_xcc_id() { return (unsigned)__builtin_amdgcn_s_getreg((3 << 11) | 20) & 0xFu; }
#define XB_SPIN(cond, bar) do { unsigned _sp = 0; while (cond) { __builtin_amdgcn_s_sleep(1); \
    if ((++_sp & 255u) == 0u) { if (xb_ld(&(bar)[XB_TMO])) break; if (_sp > XB_SPIN_CAP) { atomicAdd(&(bar)[XB_TMO], 1u); break; } } } } while (0)

struct XcdBarrier { unsigned* bar; unsigned x; volatile LAS unsigned* st; };

__device__ __forceinline__ XcdBarrier xcd_barrier_post(unsigned* bar, volatile LAS unsigned* st) {
    XcdBarrier b; b.bar = bar; b.x = xb_xcc_id(); b.st = st;
    if (threadIdx.x == 0) (void)xb_add(&bar[XB_XCNT(b.x)], 1u);
    return b;
}
__device__ __forceinline__ void xcd_barrier_complete(unsigned* bar, unsigned x, unsigned& nloc, unsigned& nx) {
    const unsigned G = gridDim.x * gridDim.y * gridDim.z;
    unsigned sum, cnt, mine, sp = 0u;
    for (;;) {
        sum = 0u; cnt = 0u; mine = 0u;
#pragma unroll
        for (unsigned j = 0; j < 16; ++j) { const unsigned c = xb_ld(&bar[XB_XCNT(j)]); sum += c; cnt += (c > 0u) ? 1u : 0u; mine = (j == x) ? c : mine; }
        if (sum == G) break;
        __builtin_amdgcn_s_sleep(1);
        if ((++sp & 255u) == 0u) { if (xb_ld(&bar[XB_TMO])) break; if (sp > XB_SPIN_CAP) { atomicAdd(&bar[XB_TMO], 1u); break; } }
    }
    nloc = mine > 0u ? mine : 1u; nx = cnt > 0u ? cnt : 1u;
}
__device__ __forceinline__ void xcd_barrier(const XcdBarrier& b) {
    asm volatile("s_waitcnt vmcnt(0)" ::: "memory");
    __syncthreads();
    if (threadIdx.x == 0) {
        unsigned* bar = b.bar;
        __builtin_amdgcn_s_waitcnt(0);
        unsigned nloc = b.st[0], nx = b.st[1];
        if (nloc == 0u) { xcd_barrier_complete(bar, b.x, nloc, nx); b.st[0] = nloc; b.st[1] = nx; }
        const unsigned old = xb_add(&bar[XB_XSUB(b.x)], 1u);
        const unsigned gen = old / nloc;
        if (old + 1u == (gen + 1u) * nloc) {
            __builtin_amdgcn_fence(__ATOMIC_RELEASE, "agent");
            asm volatile("s_waitcnt vmcnt(0)" ::: "memory");
            const unsigned og = xb_add(&bar[XB_TOP], 1u);
            const unsigned tg = og / nx;
            if (og + 1u == (tg + 1u) * nx) xb_add(&bar[XB_TOPGEN], 1u);
            else XB_SPIN(xb_ld(&bar[XB_TOPGEN]) == tg, bar);
            __builtin_amdgcn_fence(__ATOMIC_ACQUIRE, "agent");
            xb_add(&bar[XB_XGEN(b.x)], 1u);
            asm volatile("s_waitcnt vmcnt(0)" ::: "memory");
        } else {
            XB_SPIN(xb_ld(&bar[XB_XGEN(b.x)]) == gen, bar);
            __builtin_amdgcn_fence(__ATOMIC_ACQUIRE, "agent");
            asm volatile("s_waitcnt vmcnt(0)" ::: "memory");
        }
    }
    __syncthreads();
}

struct Args { const float* in[34]; float* out; unsigned char* ws; int ph_lo, ph_hi; };
struct Frame {
    LAS unsigned char* lds;
    int vcu, G, cid, wid;
    float* out; unsigned char* ws;
};
__device__ __forceinline__ const float* inptr(LAS unsigned char* lds, int i) {
    int off = LDSCTL_OFF + 8 * i; asm volatile("" : "+v"(off));
    const LAS unsigned* p = (const LAS unsigned*)(lds + off);
    const unsigned lo = __builtin_amdgcn_readfirstlane(p[0]), hi = __builtin_amdgcn_readfirstlane(p[1]);
    return (const float*)(((unsigned long long)hi << 32) | lo);
}
#define INP(i) inptr(F.lds, (i))

__device__ __forceinline__ void conv_item(const float* W, int ld, int k0, int c0, int nvalid, const float* scale, bf16* dst, int K, int drow0, LAS float* scr, int lane) {
    const int n4 = (lane & 15) * 4;
#pragma unroll 4
    for (int i = 0; i < 16; ++i) { const int kk = 4 * i + (lane >> 4);
        f32x4 v = {0.f, 0.f, 0.f, 0.f}; if (n4 < nvalid) { v = *(const f32x4*)(W + (size_t)(k0 + kk) * ld + c0 + n4); if (scale) v *= scale[k0 + kk]; }
        LAS float* d = scr + kk * 65 + n4; d[0] = v[0]; d[1] = v[1]; d[2] = v[2]; d[3] = v[3]; }
    LDS_WAIT(); asm volatile("" ::: "memory");
    const int c = lane & 7;
#pragma unroll
    for (int j = 0; j < 8; ++j) { const int nn = (lane >> 3) + 8 * j; const LAS float* sp = scr + (8 * c) * 65 + nn;
        u32x4 o; o.x = pk2(sp[0 * 65], sp[1 * 65]); o.y = pk2(sp[2 * 65], sp[3 * 65]); o.z = pk2(sp[4 * 65], sp[5 * 65]); o.w = pk2(sp[6 * 65], sp[7 * 65]);
        *(u32x4*)(dst + (size_t)(drow0 + nn) * K + k0 + 8 * c) = o; }
    LDS_WAIT(); asm volatile("" ::: "memory");
}
__device__ __forceinline__ void conv_seg(Frame& F, const float* W, int ld, int K, int c0, int nvalid, int ntotal, const float* scale, bf16* dst, int r0, int blk, int blks) {
    const int ptid = otid(), plane = ptid & 63, pwave = __builtin_amdgcn_readfirstlane(ptid >> 6);
    LAS float* scr = (LAS float*)(F.lds + pwave * 16640);
    const int gw = F.vcu * 8 + pwave, NGW = F.G * 8;
    const int nblk = ntotal / 64, nitems = (K / 64) * nblk;
    for (int it = gw; it < nitems; it += NGW) {
        const int kb = it / nblk, nb = it % nblk, n0 = nb * 64;
        int nv = nvalid - n0; nv = nv < 0 ? 0 : (nv > 64 ? 64 : nv);
        conv_item(W, ld, kb * 64, c0 + n0, nv, scale, dst, K, r0 + (n0 / blk) * blks + (n0 % blk), scr, plane);
    }
}
__device__ __forceinline__ void conv_layer_weights(Frame& F, int l) {
    unsigned char* wl = F.ws + WS_W + (size_t)l * WL_STRIDE;
    const float* win = INP(2) + (size_t)l * D * INC; const float* n1 = INP(1) + l * D;
    const int BIGB = 1 << 30;
    conv_seg(F, win, INC, D, 0, 3328, 3328, n1, (bf16*)(wl + WL_IN), 0, BIGB, 0);
    conv_seg(F, win, INC, D, 3336, 2048, 2048, n1, (bf16*)(wl + WL_IN), 3328, BIGB, 0);
    conv_seg(F, win, INC, D, 3328, 8, 256, n1, (bf16*)(wl + WL_IN), 5376, BIGB, 0);
    conv_seg(F, win, INC, D, 5384, 3072, 3072, n1, (bf16*)(wl + WL_GATE), 0, BIGB, 0);
    for (int i = 0; i < 3; ++i)
        conv_seg(F, INP(23) + ((size_t)l * 3 + i) * 512 * D, D, 512, 0, D, D, nullptr, (bf16*)(wl + WL_BR) + (size_t)i * D * 512, 0, BIGB, 0);
    conv_seg(F, INP(24) + (size_t)l * D * D, D, D, 0, D, D, nullptr, (bf16*)(wl + WL_OUT), 0, BIGB, 0);
}
__device__ __forceinline__ void conv_ffn_weights(Frame& F) {
    const float* n2 = INP(25);
    conv_seg(F, INP(26), FF, D, 0, FF, FF, n2, (bf16*)(F.ws + WS_FFUP), 0, 128, 256);
    conv_seg(F, INP(27), FF, D, 0, FF, FF, n2, (bf16*)(F.ws + WS_FFUP), 128, 128, 256);
    conv_seg(F, INP(28), D, FF, 0, D, D, nullptr, (bf16*)(F.ws + WS_FFDN), 0, 1 << 30, 0);
}
__device__ __forceinline__ void conv_moe_weights(Frame& F) {
    const float* n2 = INP(25) + D;
    for (int e = 0; e < NE; ++e) {
        bf16* up = (bf16*)(F.ws + WS_MOEW + (size_t)e * MOEW_STRIDE); bf16* dn = (bf16*)(F.ws + WS_MOEW + (size_t)e * MOEW_STRIDE + MOEW_DN);
        conv_seg(F, INP(30) + (size_t)e * D * FFE, FFE, D, 0, FFE, FFE, n2, up, 0, 128, 256);
        conv_seg(F, INP(31) + (size_t)e * D * FFE, FFE, D, 0, FFE, FFE, n2, up, 128, 128, 256);
        conv_seg(F, INP(32) + (size_t)e * FFE * D, D, FFE, 0, D, D, nullptr, dn, 0, 1 << 30, 0);
    }
}

__device__ __forceinline__ void xprep_phase(Frame& F, const float* x) {
    const int ptid = otid(), plane = ptid & 63, pwave = __builtin_amdgcn_readfirstlane(ptid >> 6); (void)plane; (void)pwave;
    const int gw = F.vcu * 8 + pwave, NGW = F.G * 8;
    bf16* xb = (bf16*)(F.ws + WS_XB); float* rstd = (float*)(F.ws + WS_RSTD);
    for (int m = gw; m < M; m += NGW) {
        const f32x4* xr = (const f32x4*)(x + (size_t)m * D) + plane;
        f32x4 v[4]; float s = 0.f;
#pragma unroll
        for (int j = 0; j < 4; ++j) { v[j] = xr[64 * j]; s += (v[j].x * v[j].x + v[j].y * v[j].y) + (v[j].z * v[j].z + v[j].w * v[j].w); }
        s = wave_sum(s);
        if (plane == 0) rstd[m] = __builtin_amdgcn_rsqf(s * (1.f / D) + 1e-6f);
        u32x2* o8 = (u32x2*)(xb + (size_t)m * D) + plane;
#pragma unroll
        for (int j = 0; j < 4; ++j) { u32x2 w; w.x = pk2(v[j].x, v[j].y); w.y = pk2(v[j].z, v[j].w); o8[64 * j] = w; }
    }
}
__device__ __forceinline__ void final_norm_phase(Frame& F) {
    const int ptid = otid(), plane = ptid & 63, pwave = __builtin_amdgcn_readfirstlane(ptid >> 6); (void)plane; (void)pwave;
    const int gw = F.vcu * 8 + pwave, NGW = F.G * 8;
    const float* fw = INP(33);
    for (int m = gw; m < M; m += NGW) {
        f32x4* xr = (f32x4*)(F.out + (size_t)m * D) + plane;
        f32x4 v[4]; float s = 0.f;
#pragma unroll
        for (int j = 0; j < 4; ++j) { v[j] = xr[64 * j]; s += (v[j].x * v[j].x + v[j].y * v[j].y) + (v[j].z * v[j].z + v[j].w * v[j].w); }
        s = wave_sum(s);
        const float r = __builtin_amdgcn_rsqf(s * (1.f / D) + 1e-6f);
#pragma unroll
        for (int j = 0; j < 4; ++j) { const f32x4 w = *((const f32x4*)fw + plane + 64 * j); xr[64 * j] = v[j] * r * w; }
    }
}
__device__ __forceinline__ void router_phase(Frame& F) {
    const int ptid = otid(), plane = ptid & 63, pwave = __builtin_amdgcn_readfirstlane(ptid >> 6);
    const float* nw = INP(25) + D; const float* rt = INP(29); float* rstd_w = (float*)(F.ws + WS_RSTD); bf16* xb = (bf16*)(F.ws + WS_XB);
    int* cnt = (int*)(F.ws + WS_CNT); int* list2 = (int*)(F.ws + WS_LIST);
    LAS int* lsel = (LAS int*)F.lds;
    LAS float* lwt = (LAS float*)(F.lds + 1024);
    LAS int* lrank = (LAS int*)(F.lds + 2048);
    LAS int* lcnt = (LAS int*)(F.lds + 3072);
    for (int blk = F.vcu; blk < M / 128; blk += F.G) {
        if (ptid < 16) lcnt[ptid] = 0;
        __syncthreads();
        for (int k = 0; k < 16; ++k) {
            const int lt = pwave * 16 + k, m = blk * 128 + lt;
            float acc[8];
#pragma unroll
            for (int e = 0; e < 8; ++e) acc[e] = 0.f;
            const f32x4* xr4 = (const f32x4*)(F.out + (size_t)m * D) + plane;
            f32x4 xv4[4]; float ssq = 0.f;
#pragma unroll
            for (int j = 0; j < 4; ++j) { xv4[j] = xr4[64 * j]; ssq += (xv4[j].x * xv4[j].x + xv4[j].y * xv4[j].y) + (xv4[j].z * xv4[j].z + xv4[j].w * xv4[j].w); }
            ssq = wave_sum(ssq);
            { u32x2* o8 = (u32x2*)(xb + (size_t)m * D) + plane;
#pragma unroll
              for (int j = 0; j < 4; ++j) { u32x2 wv; wv.x = pk2(xv4[j].x, xv4[j].y); wv.y = pk2(xv4[j].z, xv4[j].w); o8[64 * j] = wv; } }
#pragma unroll
            for (int j = 0; j < 4; ++j) { const int kk = 4 * plane + 256 * j; const f32x4 nwv = *(const f32x4*)(nw + kk);
#pragma unroll
                for (int q = 0; q < 4; ++q) { const float xv = xv4[j][q] * nwv[q];
                    const f32x4 r0v = *(const f32x4*)(rt + (size_t)(kk + q) * 8), r1v = *(const f32x4*)(rt + (size_t)(kk + q) * 8 + 4);
                    acc[0] += xv * r0v.x; acc[1] += xv * r0v.y; acc[2] += xv * r0v.z; acc[3] += xv * r0v.w; acc[4] += xv * r1v.x; acc[5] += xv * r1v.y; acc[6] += xv * r1v.z; acc[7] += xv * r1v.w; } }
            const float sc = __builtin_amdgcn_rsqf(ssq * (1.f / D) + 1e-6f);
            if (plane == 0) rstd_w[m] = sc;
#pragma unroll
            for (int e = 0; e < 8; ++e) acc[e] = wave_sum(acc[e]) * sc;
            int i0 = 0; float v0 = acc[0];
#pragma unroll
            for (int e = 1; e < 8; ++e) if (acc[e] > v0) { v0 = acc[e]; i0 = e; }
            int i1 = -1; float v1 = -3.0e38f;
#pragma unroll
            for (int e = 0; e < 8; ++e) if (e != i0 && acc[e] > v1) { v1 = acc[e]; i1 = e; }
            const float e1 = expf(v1 - v0), w0 = 1.f / (1.f + e1), w1 = e1 / (1.f + e1);
            if (plane == 0) { lsel[2 * lt] = i0; lsel[2 * lt + 1] = i1; lwt[2 * lt] = w0; lwt[2 * lt + 1] = w1;
                lrank[2 * lt] = atomicAdd((int*)(lcnt + i0), 1); lrank[2 * lt + 1] = atomicAdd((int*)(lcnt + i1), 1); }
        }
        __syncthreads();
        if (ptid < 8) lcnt[8 + ptid] = atomicAdd(cnt + ptid, lcnt[ptid]);
        __syncthreads();
        if (ptid < 256) { const int e = lsel[ptid], slot = lcnt[8 + e] + lrank[ptid];
            u32x2 v; v.x = (unsigned)(blk * 128 + (ptid >> 1)); v.y = __builtin_bit_cast(unsigned, lwt[ptid]);
            *(u32x2*)(list2 + ((size_t)e * 32768 + slot) * 2) = v; }
        __syncthreads();
    }
}

__device__ __forceinline__ void vprep_phase(Frame& F, int layer) {
    const int ptid = otid(), plane = ptid & 63, pwave = __builtin_amdgcn_readfirstlane(ptid >> 6); (void)plane; (void)pwave;
    LAS float* vt = (LAS float*)F.lds;
    LAS float* vd = vt + 32 * 516;
    const bf16* P = (const bf16*)(F.ws + WS_BIG); bf16* VF = (bf16*)(F.ws + WS_VF); bf16* VM = (bf16*)(F.ws + WS_VMIX);
    const float* mu = INP(3) + layer * 1792 + 1024;
    const int tok = ptid >> 4, part = ptid & 15;
    for (int it = F.vcu; it < M / 32; it += F.G) {
        const int m = it * 32 + tok; const int t = m & (T - 1);
        const bf16* cur = P + (size_t)m * PLD + 1024 + part * 32;
        float xm[32];
#pragma unroll
        for (int q = 0; q < 4; ++q) { float c[8], p[8]; unpack8(*(const u32x4*)(cur + q * 8), c);
            if (t > 0) unpack8(*(const u32x4*)(cur - PLD + q * 8), p); else {
#pragma unroll
                for (int e = 0; e < 8; ++e) p[e] = 0.f; }
#pragma unroll
            for (int e = 0; e < 8; ++e) xm[q * 8 + e] = c[e] + (p[e] - c[e]) * mu[part * 32 + q * 8 + e]; }
        if (layer == 0) {
#pragma unroll
            for (int q = 0; q < 4; ++q) { float o[8];
#pragma unroll
                for (int e = 0; e < 8; ++e) o[e] = xm[q * 8 + e];
                *(u32x4*)(VF + (size_t)m * 512 + part * 32 + q * 8) = pack8(o); }
        } else {
            const float* vdn = INP(14); const float* vup = INP(15); const float* v0 = INP(16);
#pragma unroll
            for (int e = 0; e < 32; ++e) vt[tok * 516 + part * 32 + e] = xm[e];
            __syncthreads();
            { float a0 = 0.f, a1 = 0.f; const int j = part * 2;
                for (int c = 0; c < 512; ++c) { const float v = vt[tok * 516 + c]; a0 += v * vdn[c * 32 + j]; a1 += v * vdn[c * 32 + j + 1]; }
                vd[tok * 33 + j] = a0; vd[tok * 33 + j + 1] = a1; }
            __syncthreads();
            float g[32];
#pragma unroll
            for (int e = 0; e < 32; ++e) g[e] = v0[part * 32 + e];
            for (int j = 0; j < 32; ++j) { const float d = vd[tok * 33 + j];
#pragma unroll
                for (int e = 0; e < 32; ++e) g[e] += d * vup[j * 512 + part * 32 + e]; }
#pragma unroll
            for (int q = 0; q < 4; ++q) { float vf[8], o[8]; unpack8(*(const u32x4*)(VF + (size_t)m * 512 + part * 32 + q * 8), vf);
#pragma unroll
                for (int e = 0; e < 8; ++e) { const float v = xm[q * 8 + e]; o[e] = v + (vf[e] - v) * sigm(g[q * 8 + e]); }
                *(u32x4*)(VM + (size_t)m * 512 + part * 32 + q * 8) = pack8(o); }
            __syncthreads();
        }
    }
}

__device__ __forceinline__ void prepass_a(Frame& F) {
    const int tid = otid();
    bf16* P = (bf16*)(F.ws + WS_BIG); bf16* BND2 = (bf16*)(F.ws + WS_BND2);
    { const int ch = tid & 127; const int kind = ch >> 6, part = ch & 7;
      double invf[4];
#pragma unroll
      for (int p = 0; p < 4; ++p) invf[p] = exp(-(double)(part * 4 + p) * (9.210340371976184 / 32.0));
      for (int m = F.vcu * 4 + (tid >> 7); m < M; m += F.G * 4) {
          const int t = m & (T - 1); bf16* ptr = P + (size_t)m * PLD + C_RET + ch * 8;
          float x[8]; unpack8(*(const u32x4*)ptr, x);
#pragma unroll
          for (int p = 0; p < 4; ++p) { double rev = (double)t * invf[p] * 0.15915494309189535; rev -= floor(rev);
              const float sn = __builtin_amdgcn_sinf((float)rev), cs = __builtin_amdgcn_cosf((float)rev);
              const float x0 = x[2 * p], x1 = x[2 * p + 1]; float o0 = x0 * cs - x1 * sn, o1 = x0 * sn + x1 * cs;
              if (kind) { o0 *= 0.125f; o1 *= 0.125f; }
              x[2 * p] = o0; x[2 * p + 1] = o1; }
          *(u32x4*)ptr = pack8(x); } }
    for (int i = F.vcu * 512 + tid; i < 1024 * 3 * 128; i += F.G * 512) { const int ch = i & 127, k = (i >> 7) % 3, r = i / 384;
        if ((r & 511) != 0) *(u32x4*)(BND2 + ((size_t)r * 3 + k) * 1024 + ch * 8) = *(const u32x4*)(P + ((size_t)r * 32 - 3 + k) * PLD + C_XBC + ch * 8); }
}
__device__ __forceinline__ void prepass_conv(Frame& F, int layer) {
    const int tid = otid();
    bf16* P = (bf16*)(F.ws + WS_BIG); const bf16* BND2 = (const bf16*)(F.ws + WS_BND2);
    const float* cw = INP(17) + layer * 1024 * 4; const float* cbias = INP(18) + layer * 1024;
    const int ch = tid & 127;
    f32x4 wv[8]; float bv[8];
#pragma unroll
    for (int e = 0; e < 8; ++e) { wv[e] = *(const f32x4*)(cw + (ch * 8 + e) * 4); bv[e] = cbias[ch * 8 + e]; }
    for (int r = F.vcu * 4 + (tid >> 7); r < M / 32; r += F.G * 4) {
        float w0[8], w1[8], w2[8];
        if ((r & 511) != 0) { unpack8(*(const u32x4*)(BND2 + ((size_t)r * 3 + 0) * 1024 + ch * 8), w0); unpack8(*(const u32x4*)(BND2 + ((size_t)r * 3 + 1) * 1024 + ch * 8), w1); unpack8(*(const u32x4*)(BND2 + ((size_t)r * 3 + 2) * 1024 + ch * 8), w2); }
        else {
#pragma unroll
            for (int e = 0; e < 8; ++e) { w0[e] = 0.f; w1[e] = 0.f; w2[e] = 0.f; } }
        bf16* ptr = P + (size_t)r * 32 * PLD + C_XBC + ch * 8;
#pragma unroll 4
        for (int i = 0; i < 32; ++i) {
            float x[8], o[8]; unpack8(*(const u32x4*)(ptr + (size_t)i * PLD), x);
#pragma unroll
            for (int e = 0; e < 8; ++e) { o[e] = silu(bv[e] + wv[e][0] * w0[e] + wv[e][1] * w1[e] + wv[e][2] * w2[e] + wv[e][3] * x[e]); w0[e] = w1[e]; w1[e] = w2[e]; w2[e] = x[e]; }
            *(u32x4*)(ptr + (size_t)i * PLD) = pack8(o);
        }
    }
}
template <int CTRL> __device__ __forceinline__ float dpp_f(float v) { return __builtin_bit_cast(float, __builtin_amdgcn_update_dpp(0, __builtin_bit_cast(int, v), CTRL, 0xF, 0xF, true)); }
__device__ __forceinline__ float red8(float v) { v += dpp_f<0xB1>(v); v += dpp_f<0x4E>(v); v += dpp_f<0x141>(v); return v; }
__device__ __forceinline__ float red16(float v) { v = red8(v); v += dpp_f<0x140>(v); return v; }

__device__ __forceinline__ void rwkv_seq(Frame& F, int layer, int bh) {
    const int ptid = otid(), plane = ptid & 63, pwave = __builtin_amdgcn_readfirstlane(ptid >> 6); (void)plane; (void)pwave;
    const int b = bh >> 3, h = bh & 7;
    LAS float* L = (LAS float*)F.lds;
    LAS float *rr = L, *ww = L + 2048, *kf = L + 4096, *vv = L + 6144, *aa = L + 8192, *bb = L + 10240, *gg = L + 12288, *yy = L + 14336, *tw = L + 16384, *xa = L + 18432, *sg = L + 20480, *bon = L + 24576;
    const float* mu = INP(3) + layer * 1792; const float* w_up = INP(4) + layer * 64 * 512; const float* w0 = INP(5) + layer * 512;
    const float* a_up = INP(6) + layer * 64 * 512; const float* a0 = INP(7) + layer * 512; const float* g_up = INP(8) + layer * 128 * 512;
    const float* k_k = INP(9) + layer * 512; const float* k_a = INP(10) + layer * 512; const float* r_k = INP(11) + layer * 512;
    const float* gn_w = INP(12) + layer * 512; const float* gn_b = INP(13) + layer * 512;
    const bf16* P = (const bf16*)(F.ws + WS_BIG); const bf16* vsrc = (const bf16*)(F.ws + (layer == 0 ? WS_VF : WS_VMIX)); bf16* yout = (bf16*)(F.ws + WS_YRW);
    const int tid = ptid, tok = tid >> 4, part = tid & 15, c4 = part * 4, cb = h * 64 + c4;
    const int srow = tid >> 3, sc0 = (tid & 7) * 8;
    float S[8];
#pragma unroll
    for (int j = 0; j < 8; ++j) S[j] = 0.f;
    for (int t0 = 0; t0 < T; t0 += 32) {
        {
            const int t = t0 + tok; const size_t m = (size_t)b * T + t;
            const bf16* cur = P + m * PLD;
#pragma unroll
            for (int q = 0; q < 3; ++q) {
                const int ch = part + 16 * q; int col, kind; LAS float* dst;
                if (ch < 8) { col = h * 64 + ch * 8; dst = rr + tok * 64 + ch * 8; kind = 0; }
                else if (ch < 16) { col = 512 + h * 64 + (ch - 8) * 8; dst = kf + tok * 64 + (ch - 8) * 8; kind = 0; }
                else if (ch < 24) { col = 1536 + (ch - 16) * 8; dst = tw + tok * 64 + (ch - 16) * 8; kind = 1; }
                else if (ch < 32) { col = 1600 + (ch - 24) * 8; dst = xa + tok * 64 + (ch - 24) * 8; kind = 0; }
                else { col = 1664 + (ch - 32) * 8; dst = sg + tok * 128 + (ch - 32) * 8; kind = 2; }
                float c[8], p[8]; unpack8(*(const u32x4*)(cur + col), c);
                if (t > 0) unpack8(*(const u32x4*)(cur - PLD + col), p); else {
#pragma unroll
                    for (int e = 0; e < 8; ++e) p[e] = 0.f; }
#pragma unroll
                for (int e = 0; e < 8; ++e) { float x = c[e] + (p[e] - c[e]) * mu[col + e]; if (kind == 1) x = tanhf(x); else if (kind == 2) x = sigm(x); dst[e] = x; }
            }
            if (part < 8) { float v[8]; unpack8(*(const u32x4*)(vsrc + m * 512 + h * 64 + part * 8), v);
#pragma unroll
                for (int e = 0; e < 8; ++e) vv[tok * 64 + part * 8 + e] = v[e]; }
        }
        __syncthreads();
        {
            f32x4 dw = *(const f32x4*)(w0 + cb), da = *(const f32x4*)(a0 + cb), dg = (f32x4){0.f, 0.f, 0.f, 0.f};
            for (int j = 0; j < 64; ++j) { const float tj = tw[tok * 64 + j], xj = xa[tok * 64 + j];
                dw += *(const f32x4*)(w_up + j * 512 + cb) * tj; da += *(const f32x4*)(a_up + j * 512 + cb) * xj; }
            for (int j = 0; j < 128; ++j) dg += *(const f32x4*)(g_up + j * 512 + cb) * sg[tok * 128 + j];
            float kr[4], kk[4], av[4], ss = 0.f;
#pragma unroll
            for (int e = 0; e < 4; ++e) { kr[e] = kf[tok * 64 + c4 + e]; kk[e] = kr[e] * k_k[cb + e]; ss += kk[e] * kk[e]; av[e] = sigm(da[e]); }
            ss = red16(ss);
            const float inv = __builtin_amdgcn_rsqf(fmaxf(ss, 1e-24f));
            float bs = 0.f;
#pragma unroll
            for (int e = 0; e < 4; ++e) { const float kn = kk[e] * inv; const int o = tok * 64 + c4 + e;
                const float ld = -expf(-softplus_acc(-dw[e]) - 0.5f);
                ww[o] = expf(ld); aa[o] = -kn; bb[o] = kn * av[e];
                const float knew = kr[e] * (1.f + (av[e] - 1.f) * k_a[cb + e]); kf[o] = knew; gg[o] = dg[e];
                bs += rr[o] * knew * r_k[cb + e]; }
            bs = red16(bs);
            if (part == 0) bon[tok] = bs;
        }
        __syncthreads();
        for (int s = 0; s < 32; ++s) {
            const f32x4 a0v = *(const LAS f32x4*)(aa + s * 64 + sc0), a1v = *(const LAS f32x4*)(aa + s * 64 + sc0 + 4);
            const f32x4 w0v = *(const LAS f32x4*)(ww + s * 64 + sc0), w1v = *(const LAS f32x4*)(ww + s * 64 + sc0 + 4);
            const f32x4 b0v = *(const LAS f32x4*)(bb + s * 64 + sc0), b1v = *(const LAS f32x4*)(bb + s * 64 + sc0 + 4);
            const f32x4 k0v = *(const LAS f32x4*)(kf + s * 64 + sc0), k1v = *(const LAS f32x4*)(kf + s * 64 + sc0 + 4);
            const f32x4 r0v = *(const LAS f32x4*)(rr + s * 64 + sc0), r1v = *(const LAS f32x4*)(rr + s * 64 + sc0 + 4);
            const float vi = vv[s * 64 + srow];
            float sa = 0.f;
#pragma unroll
            for (int j = 0; j < 4; ++j) sa += S[j] * a0v[j] + S[4 + j] * a1v[j];
            sa = red8(sa);
            float y = 0.f;
#pragma unroll
            for (int j = 0; j < 4; ++j) { S[j] = S[j] * w0v[j] + sa * b0v[j] + vi * k0v[j]; S[4 + j] = S[4 + j] * w1v[j] + sa * b1v[j] + vi * k1v[j]; y += S[j] * r0v[j] + S[4 + j] * r1v[j]; }
            y = red8(y);
            if ((tid & 7) == 0) yy[s * 64 + srow] = y;
        }
        __syncthreads();
        {
            const size_t m = (size_t)b * T + t0 + tok;
            float y[4], sm = 0.f;
#pragma unroll
            for (int e = 0; e < 4; ++e) { y[e] = yy[tok * 64 + c4 + e]; sm += y[e]; }
            const float mean = red16(sm) * (1.f / 64.f);
            float vs = 0.f;
#pragma unroll
            for (int e = 0; e < 4; ++e) { y[e] -= mean; vs += y[e] * y[e]; }
            const float rs = __builtin_amdgcn_rsqf(red16(vs) * (1.f / 64.f) + 64e-5f);
            const float bo = bon[tok];
            float o[4];
#pragma unroll
            for (int e = 0; e < 4; ++e) { const int idx = tok * 64 + c4 + e; o[e] = (y[e] * rs * gn_w[cb + e] + gn_b[cb + e] + bo * vv[idx]) * gg[idx]; }
            u32x2 w; w.x = pk2(o[0], o[1]); w.y = pk2(o[2], o[3]);
            *(u32x2*)(yout + m * 512 + cb) = w;
        }
        __syncthreads();
    }
}

__device__ __forceinline__ void ret_seq(Frame& F, int bh) {
    const int ptid = otid(), plane = ptid & 63, pwave = __builtin_amdgcn_readfirstlane(ptid >> 6); (void)plane; (void)pwave;
    const int b = bh >> 3, h = bh & 7;
    LAS float* L = (LAS float*)F.lds;
    LAS float *qq = L, *kk = L + 2048, *vv = L + 4096, *gg = L + 6144, *yy = L + 8192;
    bf16* P = (bf16*)(F.ws + WS_BIG);
    const int tid = ptid, tok = tid >> 4, part = tid & 15, c4 = part * 4;
    const int se = tid >> 3, sd0 = (tid & 7) * 8;
    const float gamma = 1.f - exp2f(-5.f - (float)h);
    float S[8];
#pragma unroll
    for (int j = 0; j < 8; ++j) S[j] = 0.f;
    for (int t0 = 0; t0 < T; t0 += 32) {
        {
            const int t = t0 + tok; const size_t m = (size_t)b * T + t;
#pragma unroll
            for (int q = 0; q < 2; ++q) {
                const int ch = part + 16 * q, kind = ch >> 3, cc = ch & 7;
                float x[8]; unpack8(*(const u32x4*)(P + m * PLD + C_RET + kind * 512 + h * 64 + cc * 8), x);
                LAS float* dst = (kind == 0 ? qq : kind == 1 ? kk : kind == 2 ? vv : gg) + tok * 64 + cc * 8;
                if (kind < 2) {
#pragma unroll
                    for (int p = 0; p < 4; ++p) { const int i = cc * 4 + p;
                        const double invf = exp(-(double)i * (9.210340371976184 / 32.0));
                        double sn, cs; sincos((double)t * invf, &sn, &cs);
                        const float x0 = x[2 * p], x1 = x[2 * p + 1], c = (float)cs, s = (float)sn;
                        float o0 = x0 * c - x1 * s, o1 = x0 * s + x1 * c;
                        if (kind == 1) { o0 *= 0.125f; o1 *= 0.125f; }
                        dst[2 * p] = o0; dst[2 * p + 1] = o1; }
                } else {
#pragma unroll
                    for (int e = 0; e < 8; ++e) dst[e] = x[e];
                }
            }
        }
        __syncthreads();
        for (int s = 0; s < 32; ++s) {
            const f32x4 k0v = *(const LAS f32x4*)(kk + s * 64 + sd0), k1v = *(const LAS f32x4*)(kk + s * 64 + sd0 + 4);
            const f32x4 q0v = *(const LAS f32x4*)(qq + s * 64 + sd0), q1v = *(const LAS f32x4*)(qq + s * 64 + sd0 + 4);
            const float ve = vv[s * 64 + se];
            float y = 0.f;
#pragma unroll
            for (int j = 0; j < 4; ++j) { S[j] = gamma * S[j] + k0v[j] * ve; S[4 + j] = gamma * S[4 + j] + k1v[j] * ve; y += q0v[j] * S[j] + q1v[j] * S[4 + j]; }
            y = red8(y);
            if ((tid & 7) == 0) yy[s * 64 + se] = y;
        }
        __syncthreads();
        {
            const size_t m = (size_t)b * T + t0 + tok;
            float y[4], ss = 0.f;
#pragma unroll
            for (int e = 0; e < 4; ++e) { y[e] = yy[tok * 64 + c4 + e]; ss += y[e] * y[e]; }
            const float rs = __builtin_amdgcn_rsqf(red16(ss) * (1.f / 64.f) + 1e-6f);
            float o[4];
#pragma unroll
            for (int e = 0; e < 4; ++e) o[e] = y[e] * rs * silu(gg[tok * 64 + c4 + e]);
            u32x2 w; w.x = pk2(o[0], o[1]); w.y = pk2(o[2], o[3]);
            *(u32x2*)(P + m * PLD + C_RETG + h * 64 + c4) = w;
        }
        __syncthreads();
    }
}

__device__ __forceinline__ void ssd_seq(Frame& F, int layer, int bh) {
    const int ptid = otid(), plane = ptid & 63, pwave = __builtin_amdgcn_readfirstlane(ptid >> 6); (void)plane; (void)pwave;
    const int b = bh >> 3, h = bh & 7, g = h >> 2;
    LAS float* L = (LAS float*)F.lds;
    LAS float *raw = L  , *xs = L + 11200, *Bc = L + 13248, *Cc = L + 17344, *yy = L + 21440, *dts = L + 23488, *das = L + 23520;
    bf16* P = (bf16*)(F.ws + WS_BIG); const float* dtb = (const float*)(F.ws + WS_DT);
    const float* cw = INP(17) + layer * 1024 * 4; const float* cbias = INP(18) + layer * 1024;
    const float dt_bias = INP(19)[layer * 8 + h], A = -expf(INP(20)[layer * 8 + h]), Dh = INP(21)[layer * 8 + h];
    const int tid = ptid;
    const int sp = tid >> 3, sn0 = (tid & 7) * 16;
    float S[16];
#pragma unroll
    for (int j = 0; j < 16; ++j) S[j] = 0.f;
    for (int i = tid; i < 3 * 320; i += 512) raw[i] = 0.f;
    __syncthreads();
    for (int t0 = 0; t0 < T; t0 += 32) {
        for (int idx = tid; idx < 32 * 40; idx += 512) {
            const int row = idx / 40, ch = idx % 40; const size_t m = (size_t)b * T + t0 + row;
            const int col = ch < 8 ? (C_XBC + h * 64 + ch * 8) : (ch < 24 ? (C_XBC + 512 + g * 128 + (ch - 8) * 8) : (C_XBC + 768 + g * 128 + (ch - 24) * 8));
            float x[8]; unpack8(*(const u32x4*)(P + m * PLD + col), x);
#pragma unroll
            for (int e = 0; e < 8; ++e) raw[(3 + row) * 320 + ch * 8 + e] = x[e];
        }
        if (tid < 32) { const size_t m = (size_t)b * T + t0 + tid; const float dt = softplus_acc(dtb[m * 8 + h] + dt_bias); dts[tid] = dt; das[tid] = expf(A * dt); }
        __syncthreads();
        for (int idx = tid; idx < 32 * 320; idx += 512) {
            const int row = idx / 320, c = idx % 320;
            const int chn = c < 64 ? (h * 64 + c) : (c < 192 ? (512 + g * 128 + (c - 64)) : (768 + g * 128 + (c - 192)));
            float a = cbias[chn];
#pragma unroll
            for (int k = 0; k < 4; ++k) a += cw[chn * 4 + k] * raw[(row + k) * 320 + c];
            a = silu(a);
            if (c < 64) xs[row * 64 + c] = a; else if (c < 192) Bc[row * 128 + (c - 64)] = a; else Cc[row * 128 + (c - 192)] = a;
        }
        __syncthreads();
        for (int s = 0; s < 32; ++s) {
            const float da = das[s], xv = xs[s * 64 + sp], dtx = dts[s] * xv;
            float y = 0.f;
#pragma unroll
            for (int q = 0; q < 4; ++q) { const f32x4 bv = *(const LAS f32x4*)(Bc + s * 128 + sn0 + q * 4), cv = *(const LAS f32x4*)(Cc + s * 128 + sn0 + q * 4);
#pragma unroll
                for (int j = 0; j < 4; ++j) { S[q * 4 + j] = da * S[q * 4 + j] + dtx * bv[j]; y += S[q * 4 + j] * cv[j]; } }
            y = red8(y);
            if ((tid & 7) == 0) yy[s * 64 + sp] = y + Dh * xv;
        }
        __syncthreads();
        {
            const int tok = tid >> 4, c4 = (tid & 15) * 4; const size_t m = (size_t)b * T + t0 + tok;
            u32x2 w; w.x = pk2(yy[tok * 64 + c4], yy[tok * 64 + c4 + 1]); w.y = pk2(yy[tok * 64 + c4 + 2], yy[tok * 64 + c4 + 3]);
            *(u32x2*)(P + m * PLD + C_XBC + h * 64 + c4) = w;
            for (int i = tid; i < 3 * 320; i += 512) raw[i] = raw[32 * 320 + i];
        }
        __syncthreads();
    }
}
__device__ __forceinline__ void ssm_norm_phase(Frame& F, int layer) {
    const int ptid = otid(), plane = ptid & 63, pwave = __builtin_amdgcn_readfirstlane(ptid >> 6); (void)plane; (void)pwave;
    const int gw = F.vcu * 8 + pwave, NGW = F.G * 8;
    bf16* P = (bf16*)(F.ws + WS_BIG); const float* nw = INP(22) + layer * 512;
    for (int m = gw; m < M; m += NGW) {
        float y[8], z[8]; unpack8(*(const u32x4*)(P + (size_t)m * PLD + C_XBC + plane * 8), y); unpack8(*(const u32x4*)(P + (size_t)m * PLD + C_Z + plane * 8), z);
        float ss = 0.f;
#pragma unroll
        for (int e = 0; e < 8; ++e) { y[e] *= silu(z[e]); ss += y[e] * y[e]; }
        ss += __shfl_xor(ss, 1); ss += __shfl_xor(ss, 2); ss += __shfl_xor(ss, 4); ss += __shfl_xor(ss, 8); ss += __shfl_xor(ss, 16);
        const float rs = __builtin_amdgcn_rsqf(ss * (1.f / 256.f) + 1e-6f);
#pragma unroll
        for (int e = 0; e < 8; ++e) y[e] *= rs * nw[plane * 8 + e];
        *(u32x4*)(P + (size_t)m * PLD + C_Z + plane * 8) = pack8(y);
    }
}

constexpr int PT = 72, PT2 = 136, PF = 68;
__device__ __forceinline__ f32x4 mfma16(bf16x8 a, bf16x8 b, f32x4 c) { return __builtin_amdgcn_mfma_f32_16x16x32_bf16(a, b, c, 0, 0, 0); }
template <int K, bool SA = false, bool SB = false> __device__ __forceinline__ f32x4 mm_ll(const LAS bf16* A, int pa, int m0, const LAS bf16* B, int pb, int n0, f32x4 acc, int lane) {
    const int r = lane & 15, q = lane >> 4;
    const int xa = SA ? (((m0 + r) >> 3) & 7) : 0, xb = SB ? (((n0 + r) >> 3) & 7) : 0;
    const LAS bf16* ap = A + (m0 + r) * pa; const LAS bf16* bp = B + (n0 + r) * pb;
#pragma unroll
    for (int k0 = 0; k0 < K; k0 += 32) acc = mfma16(*(const LAS bf16x8*)(ap + 8 * (((k0 >> 3) + q) ^ xa)), *(const LAS bf16x8*)(bp + 8 * (((k0 >> 3) + q) ^ xb)), acc);
    return acc;
}
template <int K> __device__ __forceinline__ f32x4 mm_lg(const LAS bf16* A, int pa, int m0, const bf16* B, int pb, int n0, f32x4 acc, int lane) {
    const int r = lane & 15, q = lane >> 4;
    const LAS bf16* ap = A + (m0 + r) * pa + 8 * q; const bf16* bp = B + (size_t)(n0 + r) * pb + 8 * q;
#pragma unroll
    for (int k0 = 0; k0 < K; k0 += 32) acc = mfma16(*(const LAS bf16x8*)(ap + k0), *(const bf16x8*)(bp + k0), acc);
    return acc;
}
__device__ __forceinline__ float redl16(float v) { return red16(v); }
__device__ __forceinline__ void st4bf(LAS bf16* p, f32x4 v) { u32x2 w; w.x = pk2(v[0], v[1]); w.y = pk2(v[2], v[3]); *(LAS u32x2*)p = w; }
__device__ __forceinline__ float ldbf(const LAS bf16* p) { return __builtin_bit_cast(float, (unsigned)(*p) << 16); }
constexpr f32x4 FZ4 = {0.f, 0.f, 0.f, 0.f};
__device__ __forceinline__ void tr_write8(LAS bf16* Tm, int pitch, int c0, int t, const float (&v)[8], int) {
    LAS bf16* base = Tm + c0 * pitch + (t ^ (((c0 >> 3) & 7) << 3));
#pragma unroll
    for (int e = 0; e < 8; ++e) base[e * pitch] = (bf16)f2bf(v[e]);
}
__device__ __forceinline__ float tr_at(const LAS bf16* Tm, int pitch, int row, int col) { return __builtin_bit_cast(float, (unsigned)Tm[row * pitch + (col ^ (((row >> 3) & 7) << 3))] << 16); }
__device__ __forceinline__ void ld8f(const LAS float* p, float (&v)[8]) { const f32x4 a = *(const LAS f32x4*)p, b = *(const LAS f32x4*)(p + 4); v[0] = a[0]; v[1] = a[1]; v[2] = a[2]; v[3] = a[3]; v[4] = b[0]; v[5] = b[1]; v[6] = b[2]; v[7] = b[3]; }
__device__ __forceinline__ void st8f(LAS float* p, const float (&v)[8]) { *(LAS f32x4*)p = (f32x4){v[0], v[1], v[2], v[3]}; *(LAS f32x4*)(p + 4) = (f32x4){v[4], v[5], v[6], v[7]}; }

template <bool FINAL>
__device__ __forceinline__ void rwkv_chunk_unit(Frame& F, int layer, int u) {
    const int tid = otid(), w = __builtin_amdgcn_readfirstlane(tid >> 6);
    bf16x8 lfr[16];
#define IDS() const int ft = fresh_tid(tid); const int lane = ft & 63, r16 = lane & 15, q4 = lane >> 4, tok = ft >> 3, part = ft & 7; (void)lane; (void)r16; (void)q4; (void)tok; (void)part
    const int b = u >> 9, sc = (u >> 3) & 63, h = u & 7;
    constexpr int NV = FINAL ? 64 : 128, NVT = NV / 16, NZ = NVT / 2;
    constexpr int X_TW = 0, X_XA = 9216, X_SG = 18432, X_KF = 35840, X_RF = 52224;
    constexpr int O_AT = 0, O_RT = 9216, O_BT = 18432, O_KT = 27648, O_BH = 36864, O_KH = 46080, O_VT = 55296, O_TF = O_BT;
    constexpr int Y0 = 68608;
    constexpr int Y_A = Y0, Y_B = Y0 + 8192, Y_K = Y0 + 16384, Y_R = Y0 + 24576, Y_L = Y0 + 32768, Y_VF = Y0 + 49152;
    constexpr int Y_AAB = Y0, Y_AAK = Y0 + 17408, Y_ARB = Y_AAK + 9216, Y_ARK = Y_ARB + 9216, Y_TB = FINAL ? Y_ARK + 9216 : Y_AAK + 9216, Y_ZU = Y_TB + 9216, Y_YF = Y_AAB;
    static_assert(Y_ZU + NV * PT * 2 <= Y0 + 65536, "region Y");
    constexpr int Z0 = Y0 + 65536, Z_G = Z0, Z_S = FINAL ? Z0 + 8192 : Z0, Z_MISC = 152576, Z_BON = Z_MISC, Z_PC = Z_MISC + 256, Z_PAR = Z_MISC + 512, Z_XS = Y_ZU;
    static_assert(Z_S + NV * PT * 2 <= Z_MISC && Z_PAR + 832 * 4 <= LDSCTL_OFF, "region Z");
    LAS unsigned char* L = F.lds;
#define LB(off) ((LAS bf16*)(L + (off)))
#define LF(off) ((LAS float*)(L + (off)))
    {
        const int pidx = (w == 0) ? 5 : (w == 1) ? 7 : (w == 2) ? 9 : (w == 3) ? 10 : (w == 4) ? 11 : (w == 5) ? 12 : 13;
        if (w < 7) LF(Z_PAR)[w * 64 + (tid & 63)] = (INP(pidx) + layer * 512 + h * 64)[tid & 63];
        const float* mu = INP(3) + layer * 1792;
        for (int i = tid; i < 384; i += 512) LF(Z_PAR)[448 + i] = mu[(i < 64) ? (h * 64 + i) : (i < 128) ? (512 + h * 64 + (i - 64)) : (1536 + (i - 128))];
    }
    const bf16* WupT = (const bf16*)(F.ws + WS_LORA + (size_t)layer * LORA_STRIDE) + h * 64 * 64;
    const bf16* AupT = (const bf16*)(F.ws + WS_LORA + (size_t)layer * LORA_STRIDE + 65536) + h * 64 * 64;
    const bf16* GupT = (const bf16*)(F.ws + WS_LORA + (size_t)layer * LORA_STRIDE + 131072) + h * 64 * 128;
    const bf16* P = (const bf16*)(F.ws + WS_BIG); const bf16* vsrc = (const bf16*)(F.ws + (layer == 0 ? WS_VF : WS_VMIX));
    float* Nbuf = (float*)(F.ws + WS_ST_RW) + (size_t)u * 4096; bf16* MT = (bf16*)(F.ws + WS_MT) + (size_t)u * 4096;
    { IDS();
        if (w < 4) {
#pragma unroll
            for (int nt = 0; nt < 4; ++nt)
#pragma unroll
                for (int k2 = 0; k2 < 2; ++k2) { lfr[nt * 4 + k2] = *(const bf16x8*)(WupT + (size_t)(16 * nt + r16) * 64 + 32 * k2 + 8 * q4); lfr[nt * 4 + 2 + k2] = *(const bf16x8*)(AupT + (size_t)(16 * nt + r16) * 64 + 32 * k2 + 8 * q4); }
        } else if (FINAL) {
#pragma unroll
            for (int nt = 0; nt < 4; ++nt)
#pragma unroll
                for (int k4 = 0; k4 < 4; ++k4) lfr[nt * 4 + k4] = *(const bf16x8*)(GupT + (size_t)(16 * nt + r16) * 128 + 32 * k4 + 8 * q4);
        } }
    constexpr int NST = FINAL ? 2 : 4;
    f32x4 Sacc[NST];
    const int s_vb = FINAL ? (w & 3) : w;
#define S_CT(ti) (FINAL ? (2 * (w >> 2) + (ti)) : (ti))
    { IDS();
#pragma unroll
    for (int ti = 0; ti < NST; ++ti) {
        const int ct = S_CT(ti);
#pragma unroll
        for (int jj = 0; jj < 4; ++jj) { const int v = 16 * s_vb + 4 * q4 + jj, c = 16 * ct + r16;
            float x; if (FINAL) x = Nbuf[v * 64 + c]; else x = (v >= 64 && v - 64 == c) ? 1.f : 0.f;
            Sacc[ti][jj] = x; LB(Z_S)[v * PT + c] = (bf16)f2bf(x); }
    } }
    for (int j = 0; j < 4; ++j) {
        const int tl0 = sc * 256 + j * 64;
        {
            IDS();
            const int t = tl0 + tok; const size_t m = (size_t)b * T + t; const bf16* cur = P + m * PLD;
#pragma unroll
            for (int i = 0; i < 6; ++i) {
                const int col = (i == 0) ? (h * 64 + 8 * part) : (i == 1) ? (512 + h * 64 + 8 * part) : (i == 2) ? (1536 + 8 * part) : (i == 3) ? (1600 + 8 * part) : (1664 + 8 * part + (i - 4) * 64);
                float c[8], p[8]; unpack8(*(const u32x4*)(cur + col), c);
                if (t > 0) unpack8(*(const u32x4*)(cur - PLD + col), p); else {
#pragma unroll
                    for (int e = 0; e < 8; ++e) p[e] = 0.f; }
#pragma unroll
                for (int e = 0; e < 8; ++e) c[e] = c[e] + (p[e] - c[e]) * LF(Z_PAR)[448 + ((i < 4) ? 64 * i : 256 + 64 * (i - 4)) + 8 * part + e];
                if (i == 0) { st8f(LF(X_RF) + tok * 64 + 8 * part, c);
                } else if (i == 1) { st8f(LF(X_KF) + tok * 64 + 8 * part, c);
                } else if (i == 2) {
#pragma unroll
                    for (int e = 0; e < 8; ++e) c[e] = fast_tanh(c[e]);
                    *(LAS u32x4*)(LB(X_TW) + tok * PT + 8 * part) = pack8(c);
                } else if (i == 3) {
                    *(LAS u32x4*)(LB(X_XA) + tok * PT + 8 * part) = pack8(c);
                } else if (FINAL) {
#pragma unroll
                    for (int e = 0; e < 8; ++e) c[e] = sigm(c[e]);
                    *(LAS u32x4*)(LB(X_SG) + tok * PT2 + 8 * part + (i - 4) * 64) = pack8(c);
                }
            }
            float v[8]; unpack8(*(const u32x4*)(vsrc + m * 512 + h * 64 + 8 * part), v);
            st8f(LF(Y_VF) + tok * 64 + 8 * part, v);
        }
        __syncthreads();
        { IDS();
        if (w < 4) {
            const int rb = w;
            float inv[4], bs[4] = {0.f, 0.f, 0.f, 0.f};
            { float ss[4] = {0.f, 0.f, 0.f, 0.f};
#pragma unroll
                for (int nt = 0; nt < 4; ++nt) { const int c = 16 * nt + r16; const float kkc = LF(Z_PAR)[128 + c];
#pragma unroll
                    for (int jj = 0; jj < 4; ++jj) { const float kk = LF(X_KF)[(16 * rb + 4 * q4 + jj) * 64 + c] * kkc; ss[jj] += kk * kk; } }
#pragma unroll
                for (int jj = 0; jj < 4; ++jj) inv[jj] = __builtin_amdgcn_rsqf(fmaxf(redl16(ss[jj]), 1e-24f)); }
#pragma unroll
            for (int nt = 0; nt < 4; ++nt) {
                f32x4 aw = FZ4, aa = FZ4;
#pragma unroll
                for (int k2 = 0; k2 < 2; ++k2) { aw = mfma16(*(const LAS bf16x8*)(LB(X_TW) + (16 * rb + r16) * PT + 32 * k2 + 8 * q4), lfr[nt * 4 + k2], aw); aa = mfma16(*(const LAS bf16x8*)(LB(X_XA) + (16 * rb + r16) * PT + 32 * k2 + 8 * q4), lfr[nt * 4 + 2 + k2], aa); }
                const int c = 16 * nt + r16; const float w0c = LF(Z_PAR)[c], a0c = LF(Z_PAR)[64 + c], kkc = LF(Z_PAR)[128 + c], kac = LF(Z_PAR)[192 + c], rkc = LF(Z_PAR)[256 + c];
#pragma unroll
                for (int jj = 0; jj < 4; ++jj) { const int t = 16 * rb + 4 * q4 + jj, o = t * 64 + c;
                    LF(Y_L)[o] = -0.8750455979f * sigm(w0c + aw[jj]);
                    const float al = sigm(a0c + aa[jj]), kraw = LF(X_KF)[o], rr = LF(X_RF)[o], kn = kraw * kkc * inv[jj];
                    const float knew = kraw * (1.f + (al - 1.f) * kac);
                    LB(Y_A)[o] = (bf16)f2bf(-kn); LB(Y_B)[o] = (bf16)f2bf(kn * al); LB(Y_K)[o] = (bf16)f2bf(knew); LB(Y_R)[o] = (bf16)f2bf(rr);
                    bs[jj] += rr * knew * rkc; } }
#pragma unroll
            for (int jj = 0; jj < 4; ++jj) { const float sm = redl16(bs[jj]); if (r16 == 0) LF(Z_BON)[16 * rb + 4 * q4 + jj] = sm; }
        } else if (FINAL) {
            const int rb = w - 4;
#pragma unroll
            for (int nt = 0; nt < 4; ++nt) { f32x4 ag = FZ4;
#pragma unroll
                for (int k4 = 0; k4 < 4; ++k4) ag = mfma16(*(const LAS bf16x8*)(LB(X_SG) + (16 * rb + r16) * PT2 + 32 * k4 + 8 * q4), lfr[nt * 4 + k4], ag);
#pragma unroll
                for (int jj = 0; jj < 4; ++jj) LB(Z_G)[(16 * rb + 4 * q4 + jj) * 64 + 16 * nt + r16] = (bf16)f2bf(ag[jj]); }
        } }
        __syncthreads();
        if (w == 0) { IDS(); float run = 0.f;
#pragma unroll 8
            for (int t = 0; t < 64; ++t) { run += LF(Y_L)[t * 64 + lane]; LF(Y_L)[t * 64 + lane] = run; }
            LF(Z_PC)[lane] = ex2(run); }
        __syncthreads();
        {
            IDS(); const int t = tok, c0 = 8 * part;
            float Lt[8], Lp[8], Le[8], av[8], bv[8], kv[8], rv[8], vv[8], at[8], rt[8], bt[8], kt[8], bh[8], kh[8];
            ld8f(LF(Y_L) + t * 64 + c0, Lt); ld8f(LF(Y_L) + 63 * 64 + c0, Le); ld8f(LF(Y_VF) + t * 64 + c0, vv);
            if (t > 0) ld8f(LF(Y_L) + (t - 1) * 64 + c0, Lp); else {
#pragma unroll
                for (int e = 0; e < 8; ++e) Lp[e] = 0.f; }
            unpack8(*(const LAS u32x4*)(LB(Y_A) + t * 64 + c0), av); unpack8(*(const LAS u32x4*)(LB(Y_B) + t * 64 + c0), bv);
            unpack8(*(const LAS u32x4*)(LB(Y_K) + t * 64 + c0), kv); unpack8(*(const LAS u32x4*)(LB(Y_R) + t * 64 + c0), rv);
#pragma unroll
            for (int e = 0; e < 8; ++e) { const float eL = ex2(Lt[e]), eLm = ex2(Lp[e]), eN = ex2(-Lt[e]), eE = ex2(Le[e] - Lt[e]);
                at[e] = av[e] * eLm; rt[e] = rv[e] * eL; bt[e] = bv[e] * eN; kt[e] = kv[e] * eN; bh[e] = bv[e] * eE; kh[e] = kv[e] * eE; }
            tr_write8(LB(O_BH), PT, c0, t, bh, part); tr_write8(LB(O_KH), PT, c0, t, kh, part); tr_write8(LB(O_VT), PT, c0, t, vv, part);
            *(LAS u32x4*)(LB(O_AT) + t * PT + c0) = pack8(at); *(LAS u32x4*)(LB(O_RT) + t * PT + c0) = pack8(rt);
            *(LAS u32x4*)(LB(O_BT) + t * PT + c0) = pack8(bt); *(LAS u32x4*)(LB(O_KT) + t * PT + c0) = pack8(kt);
        }
        __syncthreads();
        {
            IDS(); const int rb = w & 3;
#pragma unroll
            for (int ci = 0; ci < 2; ++ci) { const int ct = 2 * (w >> 2) + ci;
                f32x4 ab = FZ4, ak = FZ4, arb = FZ4, ark = FZ4;
                if (ct <= rb) { ab = mm_ll<64>(LB(O_AT), PT, 16 * rb, LB(O_BT), PT, 16 * ct, FZ4, lane); ak = mm_ll<64>(LB(O_AT), PT, 16 * rb, LB(O_KT), PT, 16 * ct, FZ4, lane);
                    if (FINAL) { arb = mm_ll<64>(LB(O_RT), PT, 16 * rb, LB(O_BT), PT, 16 * ct, FZ4, lane); ark = mm_ll<64>(LB(O_RT), PT, 16 * rb, LB(O_KT), PT, 16 * ct, FZ4, lane); } }
#pragma unroll
                for (int jj = 0; jj < 4; ++jj) { const int t = 16 * rb + 4 * q4 + jj, i = 16 * ct + r16;
                    LF(Y_AAB)[t * PF + i] = (i < t) ? ab[jj] : 0.f; LB(Y_AAK)[t * PT + i] = (bf16)f2bf((i < t) ? ak[jj] : 0.f);
                    if (FINAL) { LB(Y_ARB)[t * PT + i] = (bf16)f2bf((i <= t) ? arb[jj] : 0.f); LB(Y_ARK)[t * PT + i] = (bf16)f2bf((i <= t) ? ark[jj] : 0.f); } } }
        }
        __syncthreads();
        { IDS(); for (int i = ft; i < 64 * PF; i += 512) LF(O_TF)[i] = 0.f; }
        __syncthreads();
        if (w == 0) { IDS(); const int blk = lane >> 4, col = lane & 15; float x[16];
#pragma unroll
            for (int i = 0; i < 16; ++i) x[i] = (i == col) ? 1.f : 0.f;
#pragma unroll
            for (int i = 1; i < 16; ++i) { float s = 0.f; asm volatile("" ::: "memory");
#pragma unroll
                for (int m2 = 0; m2 < i; ++m2) s += LF(Y_AAB)[(16 * blk + i) * PF + 16 * blk + m2] * x[m2];
                x[i] += s; }
#pragma unroll
            for (int i = 0; i < 16; ++i) LF(O_TF)[(16 * blk + i) * PF + 16 * blk + col] = x[i]; }
        __syncthreads();
        { IDS(); const int p = ft >> 8, i = (ft >> 4) & 15, jx = ft & 15; float s = 0.f;
#pragma unroll
            for (int m4 = 0; m4 < 4; ++m4) { const f32x4 a = *(const LAS f32x4*)(LF(Y_AAB) + (32 * p + 16 + i) * PF + 32 * p + 4 * m4);
#pragma unroll
                for (int e = 0; e < 4; ++e) s += a[e] * LF(O_TF)[(32 * p + 4 * m4 + e) * PF + 32 * p + jx]; }
            LF(Z_XS)[p * 256 + i * 16 + jx] = s; }
        __syncthreads();
        { IDS(); const int p = ft >> 8, i = (ft >> 4) & 15, jx = ft & 15; float s = 0.f;
#pragma unroll
            for (int m4 = 0; m4 < 4; ++m4) { const f32x4 a = *(const LAS f32x4*)(LF(O_TF) + (32 * p + 16 + i) * PF + 32 * p + 16 + 4 * m4);
#pragma unroll
                for (int e = 0; e < 4; ++e) s += a[e] * LF(Z_XS)[p * 256 + (4 * m4 + e) * 16 + jx]; }
            LF(O_TF)[(32 * p + 16 + i) * PF + 32 * p + jx] = s; }
        __syncthreads();
        { IDS(); const int i = ft >> 4, j0 = (ft & 15) * 2; float s0 = 0.f, s1 = 0.f;
#pragma unroll
            for (int m4 = 0; m4 < 8; ++m4) { const f32x4 a = *(const LAS f32x4*)(LF(Y_AAB) + (32 + i) * PF + 4 * m4);
#pragma unroll
                for (int e = 0; e < 4; ++e) { const f32x2 bv = *(const LAS f32x2*)(LF(O_TF) + (4 * m4 + e) * PF + j0); s0 += a[e] * bv.x; s1 += a[e] * bv.y; } }
            LF(Z_XS)[i * 33 + j0] = s0; LF(Z_XS)[i * 33 + j0 + 1] = s1; }
        __syncthreads();
        { IDS(); const int i = ft >> 4, j0 = (ft & 15) * 2; float s0 = 0.f, s1 = 0.f;
#pragma unroll
            for (int m4 = 0; m4 < 8; ++m4) { const f32x4 a = *(const LAS f32x4*)(LF(O_TF) + (32 + i) * PF + 32 + 4 * m4);
#pragma unroll
                for (int e = 0; e < 4; ++e) { s0 += a[e] * LF(Z_XS)[(4 * m4 + e) * 33 + j0]; s1 += a[e] * LF(Z_XS)[(4 * m4 + e) * 33 + j0 + 1]; } }
            LF(O_TF)[(32 + i) * PF + j0] = s0; LF(O_TF)[(32 + i) * PF + j0 + 1] = s1; }
        __syncthreads();
        { IDS(); const int t = tok, i0 = 8 * part; float o[8];
#pragma unroll
            for (int e = 0; e < 8; ++e) o[e] = LF(O_TF)[t * PF + i0 + e];
            *(LAS u32x4*)(LB(Y_TB) + t * PT + i0) = pack8(o); }
        __syncthreads();
        {
            IDS(); const int rb = w & 3;
            f32x4 uu[NZ];
#pragma unroll
            for (int ci = 0; ci < NZ; ++ci) { const int vt = (w >> 2) * NZ + ci;
                f32x4 z = mm_ll<64>(LB(O_AT), PT, 16 * rb, LB(Z_S), PT, 16 * vt, FZ4, lane);
                if (vt < 4) z = mm_ll<64, false, true>(LB(Y_AAK), PT, 16 * rb, LB(O_VT), PT, 16 * vt, z, lane);
                st4bf(LB(Y_ZU) + (16 * vt + r16) * PT + 16 * rb + 4 * q4, z); }
            __syncthreads();
#pragma unroll
            for (int ci = 0; ci < NZ; ++ci) { const int vt = (w >> 2) * NZ + ci; uu[ci] = mm_ll<64>(LB(Y_TB), PT, 16 * rb, LB(Y_ZU), PT, 16 * vt, FZ4, lane); }
            __syncthreads();
#pragma unroll
            for (int ci = 0; ci < NZ; ++ci) { const int vt = (w >> 2) * NZ + ci; st4bf(LB(Y_ZU) + (16 * vt + r16) * PT + 16 * rb + 4 * q4, uu[ci]); }
        }
        __syncthreads();
        {
            IDS(); f32x4 yy[2];
            if (FINAL) { const int rb = w & 3;
#pragma unroll
                for (int ci = 0; ci < 2; ++ci) { const int ct = 2 * (w >> 2) + ci;
                    f32x4 y = mm_ll<64>(LB(O_RT), PT, 16 * rb, LB(Z_S), PT, 16 * ct, FZ4, lane);
                    y = mm_ll<64>(LB(Y_ARB), PT, 16 * rb, LB(Y_ZU), PT, 16 * ct, y, lane);
                    yy[ci] = mm_ll<64, false, true>(LB(Y_ARK), PT, 16 * rb, LB(O_VT), PT, 16 * ct, y, lane); } }
#pragma unroll
            for (int ti = 0; ti < NST; ++ti) { const int ct = S_CT(ti); const float pc = LF(Z_PC)[16 * ct + r16];
                f32x4 s = Sacc[ti] * pc;
                s = mm_ll<64, false, true>(LB(Y_ZU), PT, 16 * s_vb, LB(O_BH), PT, 16 * ct, s, lane);
                if (s_vb < 4) s = mm_ll<64, true, true>(LB(O_VT), PT, 16 * s_vb, LB(O_KH), PT, 16 * ct, s, lane);
                Sacc[ti] = s; }
            __syncthreads();
#pragma unroll
            for (int ti = 0; ti < NST; ++ti) { const int ct = S_CT(ti);
#pragma unroll
                for (int jj = 0; jj < 4; ++jj) LB(Z_S)[(16 * s_vb + 4 * q4 + jj) * PT + 16 * ct + r16] = (bf16)f2bf(Sacc[ti][jj]); }
            if (FINAL) { const int rb = w & 3;
#pragma unroll
                for (int ci = 0; ci < 2; ++ci) { const int ct = 2 * (w >> 2) + ci;
#pragma unroll
                    for (int jj = 0; jj < 4; ++jj) LF(Y_YF)[(16 * rb + 4 * q4 + jj) * PF + 16 * ct + r16] = yy[ci][jj]; } }
        }
        __syncthreads();
        if (FINAL) {
            IDS();
            const int t = tok, c0 = 8 * part; const size_t m = (size_t)b * T + tl0 + t;
            float y[8], gg[8], sm = 0.f; ld8f(LF(Y_YF) + t * PF + c0, y); unpack8(*(const LAS u32x4*)(LB(Z_G) + t * 64 + c0), gg);
#pragma unroll
            for (int e = 0; e < 8; ++e) sm += y[e];
            const float mean = red8(sm) * (1.f / 64.f); float vs = 0.f;
#pragma unroll
            for (int e = 0; e < 8; ++e) { y[e] -= mean; vs += y[e] * y[e]; }
            const float rs = __builtin_amdgcn_rsqf(red8(vs) * (1.f / 64.f) + 64e-5f), bo = LF(Z_BON)[t];
#pragma unroll
            for (int e = 0; e < 8; ++e) { const int c = c0 + e; y[e] = (y[e] * rs * LF(Z_PAR)[320 + c] + LF(Z_PAR)[384 + c] + bo * tr_at(LB(O_VT), PT, c, t)) * gg[e]; }
            *(u32x4*)((bf16*)(F.ws + WS_YRW) + m * 512 + h * 64 + c0) = pack8(y);
        }
        __syncthreads();
    }
    if (!FINAL) { IDS();
#pragma unroll
        for (int ti = 0; ti < NST; ++ti) { const int ct = S_CT(ti);
            if (s_vb < 4) {
#pragma unroll
                for (int jj = 0; jj < 4; ++jj) Nbuf[(16 * s_vb + 4 * q4 + jj) * 64 + 16 * ct + r16] = Sacc[ti][jj];
            } else { u32x2 wv; wv.x = pk2(Sacc[ti][0], Sacc[ti][1]); wv.y = pk2(Sacc[ti][2], Sacc[ti][3]);
                *(u32x2*)(MT + (16 * ct + r16) * 64 + 16 * (s_vb - 4) + 4 * q4) = wv; }
        }
    }
#undef IDS
#undef S_CT
#undef LB
#undef LF
}

template <bool FINAL>
__device__ __forceinline__ void ret_chunk_unit(Frame& F, int u) {
    const int tid = otid(), lane = tid & 63, w = __builtin_amdgcn_readfirstlane(tid >> 6), r16 = lane & 15, q4 = lane >> 4;
    const int b = u >> 9, sc = (u >> 3) & 63, h = u & 7;
    constexpr int R_QB = 0, R_KB = 9216, R_KHT = 18432, R_VT = 27648, R_GB = 36864, R_AB = 45056, R_SB = 54272, R_YF = 63488;
    LAS unsigned char* L = F.lds;
#define LB(off) ((LAS bf16*)(L + (off)))
#define LF(off) ((LAS float*)(L + (off)))
    bf16* P = (bf16*)(F.ws + WS_BIG);
    float* Sbuf = (float*)(F.ws + WS_ST_RET) + (size_t)u * 4096;
    const float lg = log2f(1.f - exp2f(-5.f - (float)h));
    const float g64 = ex2(64.f * lg);
    const int db = w & 3;
    f32x4 Sacc[2];
#pragma unroll
    for (int ci = 0; ci < 2; ++ci) { const int et = 2 * (w >> 2) + ci;
#pragma unroll
        for (int jj = 0; jj < 4; ++jj) Sacc[ci][jj] = FINAL ? Sbuf[(16 * db + 4 * q4 + jj) * 64 + 16 * et + r16] : 0.f;
        if (FINAL) st4bf(LB(R_SB) + (16 * et + r16) * PT + 16 * db + 4 * q4, Sacc[ci]); }
    const int tok = tid >> 3, part = tid & 7;
    for (int j = 0; j < 4; ++j) {
        const int tl0 = sc * 256 + j * 64;
        {
            const int t = tl0 + tok; const size_t m = (size_t)b * T + t; const bf16* row = P + m * PLD + C_RET + h * 64 + 8 * part;
            float qv[8], kv[8], vv[8]; unpack8(*(const u32x4*)(row + 512), kv); unpack8(*(const u32x4*)(row + 1024), vv);
            if (FINAL) { unpack8(*(const u32x4*)row, qv); *(LAS u32x4*)(LB(R_GB) + tok * 64 + 8 * part) = *(const u32x4*)(row + 1536); }
            const float zeta = ex2((float)(63 - tok) * lg);
            if (FINAL) { *(LAS u32x4*)(LB(R_QB) + tok * PT + 8 * part) = pack8(qv); *(LAS u32x4*)(LB(R_KB) + tok * PT + 8 * part) = pack8(kv); }
            float kz[8];
#pragma unroll
            for (int e = 0; e < 8; ++e) kz[e] = kv[e] * zeta;
            tr_write8(LB(R_KHT), PT, 8 * part, tok, kz, part); tr_write8(LB(R_VT), PT, 8 * part, tok, vv, part);
        }
        __syncthreads();
        if (FINAL) { const int rb = w & 3;
#pragma unroll
            for (int ci = 0; ci < 2; ++ci) { const int ct = 2 * (w >> 2) + ci; f32x4 a = FZ4;
                if (ct <= rb) a = mm_ll<64>(LB(R_QB), PT, 16 * rb, LB(R_KB), PT, 16 * ct, FZ4, lane);
#pragma unroll
                for (int jj = 0; jj < 4; ++jj) { const int l = 16 * rb + 4 * q4 + jj, s = 16 * ct + r16; LB(R_AB)[l * PT + s] = (bf16)f2bf((s <= l) ? a[jj] * ex2((float)(l - s) * lg) : 0.f); } }
            __syncthreads();
        }
        {
            f32x4 yy[2];
            if (FINAL) { const int rb = w & 3;
#pragma unroll
                for (int ci = 0; ci < 2; ++ci) { const int et = 2 * (w >> 2) + ci;
                    const f32x4 a1 = mm_ll<64, false, true>(LB(R_AB), PT, 16 * rb, LB(R_VT), PT, 16 * et, FZ4, lane), a2 = mm_ll<64>(LB(R_QB), PT, 16 * rb, LB(R_SB), PT, 16 * et, FZ4, lane);
#pragma unroll
                    for (int jj = 0; jj < 4; ++jj) yy[ci][jj] = a1[jj] + ex2((float)(16 * rb + 4 * q4 + jj + 1) * lg) * a2[jj]; } }
#pragma unroll
            for (int ci = 0; ci < 2; ++ci) { const int et = 2 * (w >> 2) + ci; Sacc[ci] = mm_ll<64, true, true>(LB(R_KHT), PT, 16 * db, LB(R_VT), PT, 16 * et, Sacc[ci] * g64, lane); }
            __syncthreads();
            if (FINAL) { const int rb = w & 3;
#pragma unroll
                for (int ci = 0; ci < 2; ++ci) { const int et = 2 * (w >> 2) + ci; st4bf(LB(R_SB) + (16 * et + r16) * PT + 16 * db + 4 * q4, Sacc[ci]);
#pragma unroll
                    for (int jj = 0; jj < 4; ++jj) LF(R_YF)[(16 * rb + 4 * q4 + jj) * PF + 16 * et + r16] = yy[ci][jj]; } }
        }
        __syncthreads();
        if (FINAL) { const size_t m = (size_t)b * T + tl0 + tok; float y[8], g[8], ss = 0.f;
            ld8f(LF(R_YF) + tok * PF + 8 * part, y);
#pragma unroll
            for (int e = 0; e < 8; ++e) ss += y[e] * y[e];
            const float rs = __builtin_amdgcn_rsqf(red8(ss) * (1.f / 64.f) + 1e-6f);
            unpack8(*(const LAS u32x4*)(LB(R_GB) + tok * 64 + 8 * part), g);
#pragma unroll
            for (int e = 0; e < 8; ++e) y[e] = y[e] * rs * silu(g[e]);
            *(u32x4*)(P + m * PLD + C_RETG + h * 64 + 8 * part) = pack8(y);
            __syncthreads(); }
    }
    if (!FINAL) {
#pragma unroll
        for (int ci = 0; ci < 2; ++ci) { const int et = 2 * (w >> 2) + ci;
#pragma unroll
            for (int jj = 0; jj < 4; ++jj) Sbuf[(16 * db + 4 * q4 + jj) * 64 + 16 * et + r16] = Sacc[ci][jj]; }
    }
#undef LB
#undef LF
}

template <bool FINAL>
__device__ __forceinline__ void ssd_chunk_unit(Frame& F, int layer, int u) {
    const int tid = otid(), w = __builtin_amdgcn_readfirstlane(tid >> 6);
#define IDS() const int ft = fresh_tid(tid); const int lane = ft & 63, r16 = lane & 15, q4 = lane >> 4; (void)lane; (void)r16; (void)q4
    const int b = u >> 9, sc = (u >> 3) & 63, h = u & 7, g = h >> 2;
    constexpr int D_CB = 0, D_BB = 17408, D_BT = 34816, D_YF = 53248, D_XT = 70656, D_XDT = 79872, D_GM = 89088, D_SB = 98304, D_MISC = 115712;
    constexpr int D_DTS = D_MISC, D_ACS = D_MISC + 256, D_CAR = D_MISC + 512;
    LAS unsigned char* L = F.lds;
#define LB(off) ((LAS bf16*)(L + (off)))
#define LF(off) ((LAS float*)(L + (off)))
    bf16* P = (bf16*)(F.ws + WS_BIG); const float* dtb = (const float*)(F.ws + WS_DT);
    const bf16* BND = (const bf16*)(F.ws + WS_BND);
    float* Sbuf = (float*)(F.ws + WS_ST_SSD) + (size_t)u * 8192;
    const float* cw = INP(17) + layer * 1024 * 4; const float* cbias = INP(18) + layer * 1024;
    const float dt_bias = INP(19)[layer * 8 + h], A = -expf(INP(20)[layer * 8 + h]), Dh = INP(21)[layer * 8 + h];
    const int bc_chunk = tid & 31, bc_chn = (bc_chunk < 16) ? (512 + g * 128 + bc_chunk * 8) : (768 + g * 128 + (bc_chunk - 16) * 8);
    const int x_chunk = tid & 7, x_chn = h * 64 + x_chunk * 8;
    const int pb = w & 3;
    f32x4 Sacc[4];
    { IDS();
#pragma unroll
    for (int ci = 0; ci < 4; ++ci) { const int nt = 4 * (w >> 2) + ci;
#pragma unroll
        for (int jj = 0; jj < 4; ++jj) { const float x = FINAL ? Sbuf[(16 * pb + 4 * q4 + jj) * 128 + 16 * nt + r16] : 0.f; Sacc[ci][jj] = x;
            if (FINAL) LB(D_SB)[(16 * pb + 4 * q4 + jj) * PT2 + 16 * nt + r16] = (bf16)f2bf(x); } } }
    float dstot = 0.f;
    for (int j = 0; j < 4; ++j) {
        const int tl0 = sc * 256 + j * 64; const size_t m0 = (size_t)b * T + tl0;
        if (w == 0) {
            IDS(); const float dt = softplus_acc(dtb[(m0 + lane) * 8 + h] + dt_bias); float a = A * dt;
#pragma unroll
            for (int o = 1; o < 64; o <<= 1) { const float n = __shfl_up(a, o); if (lane >= o) a += n; }
            LF(D_DTS)[lane] = dt; LF(D_ACS)[lane] = a;
        }
        {
            IDS();
#pragma unroll
            for (int it = 0; it < 4; ++it) { const int t = it * 16 + (ft >> 5); const int ta = tl0 + t;
                float acc[8]; unpack8(*(const u32x4*)(P + (m0 + t) * PLD + C_XBC + bc_chn), acc); (void)ta;
                if (bc_chunk < 16) { *(LAS u32x4*)(LB(D_BB) + t * PT2 + bc_chunk * 8) = pack8(acc); tr_write8(LB(D_BT), PT, bc_chunk * 8, t, acc, bc_chunk & 7); }
                else *(LAS u32x4*)(LB(D_CB) + t * PT2 + (bc_chunk - 16) * 8) = pack8(acc);
            }
        }
        __syncthreads();
        {
            IDS(); const int t = ft >> 3; float acc[8]; unpack8(*(const u32x4*)(P + (m0 + t) * PLD + C_XBC + x_chn), acc);
            const float sc_d = LF(D_DTS)[t] * __expf(LF(D_ACS)[63] - LF(D_ACS)[t]);
            float xs8[8], xd8[8];
#pragma unroll
            for (int e = 0; e < 8; ++e) { xs8[e] = acc[e]; xd8[e] = acc[e] * sc_d; }
            tr_write8(LB(D_XT), PT, x_chunk * 8, t, xs8, x_chunk); tr_write8(LB(D_XDT), PT, x_chunk * 8, t, xd8, x_chunk);
        }
        if (FINAL) { IDS(); const int rb = w & 3;
#pragma unroll
            for (int ci = 0; ci < 2; ++ci) { const int ct = 2 * (w >> 2) + ci; f32x4 a = FZ4;
                if (ct <= rb) a = mm_ll<128>(LB(D_CB), PT2, 16 * rb, LB(D_BB), PT2, 16 * ct, FZ4, lane);
#pragma unroll
                for (int jj = 0; jj < 4; ++jj) { const int l = 16 * rb + 4 * q4 + jj, s = 16 * ct + r16;
                    LB(D_GM)[l * PT + s] = (bf16)f2bf((s <= l) ? a[jj] * __expf(LF(D_ACS)[l] - LF(D_ACS)[s]) * LF(D_DTS)[s] : 0.f); } } }
        __syncthreads();
        {
            IDS(); f32x4 yy[2];
            if (FINAL) { const int rb = w & 3;
#pragma unroll
                for (int ci = 0; ci < 2; ++ci) { const int pt = 2 * (w >> 2) + ci;
                    const f32x4 a1 = mm_ll<64, false, true>(LB(D_GM), PT, 16 * rb, LB(D_XT), PT, 16 * pt, FZ4, lane), a2 = mm_ll<128>(LB(D_CB), PT2, 16 * rb, LB(D_SB), PT2, 16 * pt, FZ4, lane);
#pragma unroll
                    for (int jj = 0; jj < 4; ++jj) { const int l = 16 * rb + 4 * q4 + jj, p = 16 * pt + r16; yy[ci][jj] = a1[jj] + __expf(LF(D_ACS)[l]) * a2[jj] + Dh * tr_at(LB(D_XT), PT, p, l); } } }
            const float dec = expf(LF(D_ACS)[63]);
#pragma unroll
            for (int ci = 0; ci < 4; ++ci) { const int nt = 4 * (w >> 2) + ci; Sacc[ci] = mm_ll<64, true, true>(LB(D_XDT), PT, 16 * pb, LB(D_BT), PT, 16 * nt, Sacc[ci] * dec, lane); }
            dstot += LF(D_ACS)[63];
            __syncthreads();
            if (FINAL) { const int rb = w & 3;
#pragma unroll
                for (int ci = 0; ci < 4; ++ci) { const int nt = 4 * (w >> 2) + ci;
#pragma unroll
                    for (int jj = 0; jj < 4; ++jj) LB(D_SB)[(16 * pb + 4 * q4 + jj) * PT2 + 16 * nt + r16] = (bf16)f2bf(Sacc[ci][jj]); }
#pragma unroll
                for (int ci = 0; ci < 2; ++ci) { const int pt = 2 * (w >> 2) + ci;
#pragma unroll
                    for (int jj = 0; jj < 4; ++jj) LF(D_YF)[(16 * rb + 4 * q4 + jj) * PF + 16 * pt + r16] = yy[ci][jj]; } }
        }
        __syncthreads();
        if (FINAL) { IDS(); const int tok = ft >> 3, part = ft & 7; float y[8];
            ld8f(LF(D_YF) + tok * PF + 8 * part, y);
            *(u32x4*)(P + (m0 + tok) * PLD + C_XBC + h * 64 + 8 * part) = pack8(y);
            __syncthreads(); }
    }
    if (!FINAL) { IDS();
#pragma unroll
        for (int ci = 0; ci < 4; ++ci) { const int nt = 4 * (w >> 2) + ci;
#pragma unroll
            for (int jj = 0; jj < 4; ++jj) Sbuf[(16 * pb + 4 * q4 + jj) * 128 + 16 * nt + r16] = Sacc[ci][jj]; }
        if (tid == 0) ((float*)(F.ws + WS_DSTOT))[u] = dstot;
    }
#undef IDS
#undef LB
#undef LF
}

__device__ __forceinline__ void rwkv_scan_chain(Frame& F, int chain) {
    const int tid = otid(), lane = tid & 63, w = __builtin_amdgcn_readfirstlane(tid >> 6), r16 = lane & 15, q4 = lane >> 4;
    const int b = chain >> 3, h = chain & 7, vb = w & 3, ct0 = 2 * (w >> 2);
    LAS bf16* SB = (LAS bf16*)F.lds;
    f32x4 Sacc[2] = {FZ4, FZ4};
    for (int i = tid; i < 64 * PT / 2; i += 512) ((LAS unsigned*)SB)[i] = 0u;
    f32x4 nv[2]; bf16x8 mf[2][2];
    auto fetch = [&](int sc) {
        const int u = (b * 64 + sc) * 8 + h;
        const float* Nb = (const float*)(F.ws + WS_ST_RW) + (size_t)u * 4096; const bf16* MT = (const bf16*)(F.ws + WS_MT) + (size_t)u * 4096;
#pragma unroll
        for (int ci = 0; ci < 2; ++ci) {
#pragma unroll
            for (int jj = 0; jj < 4; ++jj) nv[ci][jj] = Nb[(16 * vb + 4 * q4 + jj) * 64 + 16 * (ct0 + ci) + r16];
#pragma unroll
            for (int k2 = 0; k2 < 2; ++k2) mf[ci][k2] = *(const bf16x8*)(MT + (size_t)(16 * (ct0 + ci) + r16) * 64 + 32 * k2 + 8 * q4); } };
    fetch(0);
    __syncthreads();
    for (int sc = 0; sc < 64; ++sc) {
        const int u = (b * 64 + sc) * 8 + h;
        float* Nb = (float*)(F.ws + WS_ST_RW) + (size_t)u * 4096;
        f32x4 nw[2];
#pragma unroll
        for (int ci = 0; ci < 2; ++ci) {
            f32x4 a = nv[ci];
#pragma unroll
            for (int k2 = 0; k2 < 2; ++k2) a = mfma16(*(const LAS bf16x8*)(SB + (16 * vb + r16) * PT + 32 * k2 + 8 * q4), mf[ci][k2], a);
            nw[ci] = a;
#pragma unroll
            for (int jj = 0; jj < 4; ++jj) Nb[(16 * vb + 4 * q4 + jj) * 64 + 16 * (ct0 + ci) + r16] = Sacc[ci][jj]; }
        if (sc + 1 < 64) fetch(sc + 1);
        __syncthreads();
#pragma unroll
        for (int ci = 0; ci < 2; ++ci) { Sacc[ci] = nw[ci];
#pragma unroll
            for (int jj = 0; jj < 4; ++jj) SB[(16 * vb + 4 * q4 + jj) * PT + 16 * (ct0 + ci) + r16] = (bf16)f2bf(nw[ci][jj]); }
        __syncthreads();
    }
}
__device__ __forceinline__ void elem_scans(Frame& F, int blk, int nblk) {
    const int tid = otid();
    const int NRET = 16 * 4096, NSSD = 16 * 8192;
    const float* dst = (const float*)(F.ws + WS_DSTOT);
    for (int it = blk * 512 + tid; it < NRET + NSSD; it += nblk * 512) {
        if (it < NRET) { const int chain = it >> 12, e = it & 4095, b = chain >> 3, h = chain & 7;
            const float g256 = exp2f(256.f * log2f(1.f - exp2f(-5.f - (float)h)));
            float* p = (float*)(F.ws + WS_ST_RET) + ((size_t)(b * 64) * 8 + h) * 4096 + e; float carry = 0.f;
#pragma unroll 8
            for (int sc = 0; sc < 64; ++sc) { const float t = p[(size_t)sc * 8 * 4096]; p[(size_t)sc * 8 * 4096] = carry; carry = g256 * carry + t; }
        } else { const int i2 = it - NRET, chain = i2 >> 13, e = i2 & 8191, b = chain >> 3, h = chain & 7;
            float* p = (float*)(F.ws + WS_ST_SSD) + ((size_t)(b * 64) * 8 + h) * 8192 + e; const float* d = dst + (b * 64) * 8 + h; float carry = 0.f;
#pragma unroll 8
            for (int sc = 0; sc < 64; ++sc) { const float t = p[(size_t)sc * 8 * 8192]; p[(size_t)sc * 8 * 8192] = carry; carry = expf(d[sc * 8]) * carry + t; }
        }
    }
}
__device__ __forceinline__ void conv_lora(Frame& F) {
    const int tid = otid();
    for (int l = 0; l < 2; ++l) {
        bf16* base = (bf16*)(F.ws + WS_LORA + (size_t)l * LORA_STRIDE);
        const float* wu = INP(4) + l * 64 * 512; const float* au = INP(6) + l * 64 * 512; const float* gu = INP(8) + l * 128 * 512;
        for (int i = F.vcu * 512 + tid; i < 512 * 64; i += F.G * 512) { const int c = i >> 6, jx = i & 63; base[i] = (bf16)f2bf(wu[jx * 512 + c]); base[32768 + i] = (bf16)f2bf(au[jx * 512 + c]); }
        for (int i = F.vcu * 512 + tid; i < 512 * 128; i += F.G * 512) { const int c = i >> 7, jx = i & 127; base[65536 + i] = (bf16)f2bf(gu[jx * 512 + c]); }
    }
}
__device__ __forceinline__ void save_bnd(Frame& F) {
    const int tid = otid();
    const bf16* P = (const bf16*)(F.ws + WS_BIG); bf16* BND = (bf16*)(F.ws + WS_BND);
    for (int i = F.vcu * 512 + tid; i < 2 * 64 * 3 * 64; i += F.G * 512) { const int ch = i & 63, k = (i >> 6) % 3, bs = i / 192, b = bs >> 6, sc = bs & 63;
        if (sc > 0) *(u32x4*)(BND + (size_t)(bs * 3 + k) * 512 + ch * 8) = *(const u32x4*)(P + ((size_t)b * T + sc * 256 - 3 + k) * PLD + C_XBC + ch * 8); }
}

constexpr int LAYER_BASE0 = 1, LAYER_STRIDE = 18, MOE_BASE = LAYER_BASE0 + LAYER_STRIDE + 15;
__device__ __forceinline__ Frame lf(const Frame& F0) {
    Frame F = F0; unsigned l = (unsigned)(unsigned long long)F.lds;
    asm volatile("" : "+s"(l), "+s"(F.vcu), "+s"(F.G), "+s"(F.cid), "+s"(F.wid), "+s"(F.out), "+s"(F.ws));
    F.lds = (LAS unsigned char*)(unsigned long long)l; return F;
}
__global__ void __launch_bounds__(512, 2) fwd(Args args) {
    extern __shared__ __attribute__((aligned(16))) unsigned char lds_raw[];
    Frame F0;
    F0.lds = (LAS unsigned char*)lds_raw;
    F0.G = gridDim.x; { const int bx = blockIdx.x; F0.vcu = (F0.G % 8 == 0) ? (bx % 8) * (F0.G / 8) + bx / 8 : bx; }
    F0.cid = blockIdx.x; F0.out = args.out; F0.ws = args.ws; F0.wid = __builtin_amdgcn_readfirstlane(threadIdx.x >> 6);
    volatile LAS unsigned* MISC = (volatile LAS unsigned*)(F0.lds + MISC_OFF);
    for (int u = threadIdx.x; u < (LDS_BYTES - LDSCTL_OFF) / 4; u += 512) ((LAS unsigned*)(F0.lds + LDSCTL_OFF))[u] = 0u;
    __syncthreads();
    if (threadIdx.x < 34) *(LAS unsigned long long*)(F0.lds + LDSCTL_OFF + 8 * threadIdx.x) = (unsigned long long)args.in[threadIdx.x];
    __syncthreads();
    const int lo = args.ph_lo, hi = args.ph_hi;
    XcdBarrier bar; bar.bar = (unsigned*)(F0.ws + WS_CTL); bar.x = 0; bar.st = nullptr;
    if (hi - lo > 1) bar = xcd_barrier_post((unsigned*)(F0.ws + WS_CTL), MISC + 8);
#define IN(k) (lo <= (k) && (k) < hi)
#define SEAM(k) do { if (IN(k) && IN((k) + 1)) xcd_barrier(bar); } while (0)
#define WSP(T_, off) ((T_*)(F.ws + (off)))

    if (IN(0)) { for (int rep = 0; rep <= REP_CONV; ++rep) { Frame F = lf(F0); conv_layer_weights(F, 0); conv_layer_weights(F, 1); conv_ffn_weights(F); conv_lora(F); }
        for (int rep = 0; rep <= REP_MISC; ++rep) { Frame F = lf(F0); xprep_phase(F, INP(0)); } }
    SEAM(0);
    for (int l = 0; l < 2; ++l) {
        const int pb = LAYER_BASE0 + l * LAYER_STRIDE;
        if (IN(pb + 0)) {
            Frame F = lf(F0); unsigned char* wl = F.ws + WS_W + (size_t)l * WL_STRIDE;
            pg8::Gemm g{WSP(bf16, WS_XB), (const bf16*)(wl + WL_IN), D, D, D}; pg8::StaticOrder S; S.init(M, NP, F.G, F.cid, D, D);
            pg8::EpiInProj E{WSP(bf16, WS_BIG), WSP(float, WS_RSTD), WSP(float, WS_DT)};
            pg8::gemm_phase(F.lds, F.wid, g, S, E);
        }
        SEAM(pb + 0);
        if (IN(pb + 1)) { Frame F = lf(F0); vprep_phase(F, l); prepass_a(F); }
        SEAM(pb + 1);
        if (IN(pb + 2)) { Frame F = lf(F0); prepass_conv(F, l); }
        if (IN(pb + 2) && IN(pb + 3)) xcd_barrier(bar);
        if (IN(pb + 3)) for (int rep = 0; rep <= REP_R1; ++rep) {
#if RW_CH
            for (int r2 = 0; r2 <= REP_RW; ++r2) { Frame F = lf(F0); for (int u = F.cid; u < 1024; u += F.G) rwkv_chunk_unit<false>(F, l, u); }
#else
            { Frame F = lf(F0); if (F.cid < 16) rwkv_seq(F, l, F.cid); }
#endif
#if RET_CH
            for (int r2 = 0; r2 <= REP_RET; ++r2) { Frame F = lf(F0); for (int u = F.cid; u < 1024; u += F.G) ret_chunk_unit<false>(F, u); }
#else
            { Frame F = lf(F0); if (F.cid >= 32 && F.cid < 48) ret_seq(F, F.cid - 32); }
#endif
#if SSD_CH
            for (int r2 = 0; r2 <= REP_SSD; ++r2) { Frame F = lf(F0); for (int u = F.cid; u < 1024; u += F.G) ssd_chunk_unit<false>(F, l, u); }
#else
            { Frame F = lf(F0); if (F.cid >= 16 && F.cid < 32) ssd_seq(F, l, F.cid - 16); }
#endif
        }
        SEAM(pb + 3);
        if (IN(pb + 4)) {
            Frame F = lf(F0);
            if (F.cid < 16) { if (RW_CH) rwkv_scan_chain(F, F.cid); }
            else elem_scans(F, F.cid - 16, F.G - 16);
        }
        SEAM(pb + 4);
        if (IN(pb + 5)) {
#if RW_CH
            { Frame F = lf(F0); for (int u = F.cid; u < 1024; u += F.G) rwkv_chunk_unit<true>(F, l, u); }
#endif
#if RET_CH
            { Frame F = lf(F0); for (int u = F.cid; u < 1024; u += F.G) ret_chunk_unit<true>(F, u); }
#endif
#if SSD_CH
            { Frame F = lf(F0); for (int u = F.cid; u < 1024; u += F.G) ssd_chunk_unit<true>(F, l, u); }
#endif
        }
        SEAM(pb + 5);
        if (IN(pb + 6)) { Frame F = lf(F0); ssm_norm_phase(F, l); xprep_phase(F, (l == 0) ? INP(0) : F.out); }
        SEAM(pb + 6);
        for (int i = 0; i < 3; ++i) {
            if (IN(pb + 7 + 2 * i)) {
                Frame F = lf(F0); unsigned char* wl = F.ws + WS_W + (size_t)l * WL_STRIDE; bf16* P = WSP(bf16, WS_BIG);
                const bf16* A = (i == 0) ? WSP(const bf16, WS_YRW) : (i == 1 ? P + C_Z : P + C_RETG);
                pg8::Gemm g{A, (const bf16*)(wl + WL_BR) + (size_t)i * D * 512, (i == 0) ? 512 : PLD, 512, 512}; pg8::StaticOrder S; S.init(M, D, F.G, F.cid, (i == 0) ? 512 : PLD, 512);
                pg8::EpiPlain E{P, PLD};
                pg8::gemm_phase(F.lds, F.wid, g, S, E);
            }
            SEAM(pb + 7 + 2 * i);
            if (IN(pb + 8 + 2 * i)) {
                Frame F = lf(F0); unsigned char* wl = F.ws + WS_W + (size_t)l * WL_STRIDE; bf16* P = WSP(bf16, WS_BIG);
                pg8::Gemm g{WSP(bf16, WS_XB), (const bf16*)(wl + WL_GATE) + (size_t)i * D * D, D, D, D}; pg8::StaticOrder S; S.init(M, D, F.G, F.cid, D, D);
                pg8::EpiGateMerge E{P, PLD, P + C_RET, PLD, WSP(float, WS_RSTD), i == 0};
                pg8::gemm_phase(F.lds, F.wid, g, S, E);
            }
            SEAM(pb + 8 + 2 * i);
        }
        if (IN(pb + 13)) {
            Frame F = lf(F0); unsigned char* wl = F.ws + WS_W + (size_t)l * WL_STRIDE; bf16* P = WSP(bf16, WS_BIG);
            pg8::Gemm g{P + C_RET, (const bf16*)(wl + WL_OUT), PLD, D, D}; pg8::StaticOrder S; S.init(M, D, F.G, F.cid, PLD, D);
            pg8::EpiResid E{(l == 0) ? INP(0) : F.out, F.out, nullptr, 0};
            pg8::gemm_phase(F.lds, F.wid, g, S, E);
        }
        SEAM(pb + 13);
        if (IN(pb + 14)) { Frame F = lf(F0); if (l == 0) xprep_phase(F, F.out); else { router_phase(F); conv_moe_weights(F); } }
        SEAM(pb + 14);
        if (l == 0) {
            if (IN(pb + 15)) {
                Frame F = lf(F0);
                pg8::Gemm g{WSP(bf16, WS_XB), WSP(const bf16, WS_FFUP), D, D, D}; pg8::StaticOrder S; S.init(M, 2 * FF, F.G, F.cid, D, D);
                pg8::EpiSwiglu E{WSP(bf16, WS_ACT), FF, WSP(float, WS_RSTD)};
                pg8::gemm_phase(F.lds, F.wid, g, S, E);
            }
            SEAM(pb + 15);
            if (IN(pb + 16)) {
                Frame F = lf(F0);
                pg8::Gemm g{WSP(const bf16, WS_ACT), WSP(const bf16, WS_FFDN), FF, FF, FF}; pg8::StaticOrder S; S.init(M, D, F.G, F.cid, FF, FF);
                pg8::EpiResid E{F.out, F.out, nullptr, 0};
                pg8::gemm_phase(F.lds, F.wid, g, S, E);
            }
            SEAM(pb + 16);
            if (IN(pb + 17)) { Frame F = lf(F0); xprep_phase(F, F.out); }
            SEAM(pb + 17);
        }
    }
    {
        const int pb = MOE_BASE;
        for (int sg = 0; sg < 3; ++sg) {
            if (IN(pb + 0 + 2 * sg)) {
                Frame F = lf(F0);
                pg8::Gemm g{WSP(bf16, WS_XB), WSP(const bf16, WS_MOEW), D, D, D}; pg8::MoeOrder<true> S; S.init(WSP(const int, WS_CNT), WSP(const int, WS_LIST), sg, 2 * FFE, F.G, F.cid, D, D, MOEW_STRIDE);
                pg8::EpiSwiglu E{WSP(bf16, WS_ACT), FFE, WSP(float, WS_RSTD)};
                pg8::gemm_phase(F.lds, F.wid, g, S, E);
            }
            SEAM(pb + 0 + 2 * sg);
            if (IN(pb + 1 + 2 * sg)) {
                Frame F = lf(F0);
                const int ksp = (sg == 2) ? 4 : 1;
                pg8::Gemm g{WSP(const bf16, WS_ACT), WSP(const bf16, WS_MOEW + MOEW_DN), FFE, FFE, FFE / ksp}; pg8::MoeOrder<false> S; S.init(WSP(const int, WS_CNT), WSP(const int, WS_LIST), sg, D, F.G, F.cid, FFE, FFE, MOEW_STRIDE, ksp, FFE / ksp);
                pg8::EpiMoeDown E{F.out};
                pg8::gemm_phase(F.lds, F.wid, g, S, E);
            }
            SEAM(pb + 1 + 2 * sg);
        }
        if (IN(pb + 6)) { Frame F = lf(F0); final_norm_phase(F); }
    }
#undef IN
#undef SEAM
#undef WSP
}
constexpr int LAST_PHASE = MOE_BASE + 6;
constexpr int N_PH = LAST_PHASE + 1;

extern "C" void kernel_launch(void* const* d_in, const int* in_sizes, int n_in, void* d_out, int out_size, void* d_ws, size_t ws_size, hipStream_t stream) {
    static int grid = 0;
    if (grid == 0) {
        if (n_in != 34 || out_size != M * D || ws_size < WS_END) { fprintf(stderr, "kernel_launch: unexpected problem (n_in %d out %d ws %zu need %zu)\n", n_in, out_size, ws_size, (size_t)WS_END); grid = -1; return; }
        int dev = 0, cus = 0;
        if (hipGetDevice(&dev) != hipSuccess || hipDeviceGetAttribute(&cus, hipDeviceAttributeMultiprocessorCount, dev) != hipSuccess) { grid = -1; return; }
        if (hipFuncSetAttribute((const void*)fwd, hipFuncAttributeMaxDynamicSharedMemorySize, LDS_BYTES) != hipSuccess) { fprintf(stderr, "kernel_launch: hipFuncSetAttribute failed\n"); grid = -1; return; }
        int per_cu = 0;
        if (hipOccupancyMaxActiveBlocksPerMultiprocessor(&per_cu, (const void*)fwd, 512, LDS_BYTES) != hipSuccess || per_cu < 1) fprintf(stderr, "kernel_launch: occupancy query says %d\n", per_cu);
        (void)hipGetLastError();
        grid = cus;
    }
    if (grid < 0) return;
    (void)hipMemsetAsync((char*)d_ws + WS_CTL, 0, CTL_ZERO_BYTES, stream);
    Args a{};
    for (int i = 0; i < 34; ++i) a.in[i] = (const float*)d_in[i];
    a.out = (float*)d_out; a.ws = (unsigned char*)d_ws;
#if MK_ONE_LAUNCH
    a.ph_lo = 0; a.ph_hi = N_PH;
    hipLaunchKernelGGL(fwd, dim3(grid), dim3(512), LDS_BYTES, stream, a);
#else
    for (int p = 0; p < N_PH; ++p) { a.ph_lo = p; a.ph_hi = p + 1; hipLaunchKernelGGL(fwd, dim3(grid), dim3(512), LDS_BYTES, stream, a); }
#endif
}
```

```cpp
#include <hip/hip_runtime.h>
#include <cstdio>
#include <cstdint>

#ifndef MK_ONE_LAUNCH
#define MK_ONE_LAUNCH 1
#endif

#define LAS __attribute__((address_space(3)))
#define GAS __attribute__((address_space(1)))
typedef unsigned short bf16;
typedef short bf16x8 __attribute__((ext_vector_type(8)));
typedef float f32x4 __attribute__((ext_vector_type(4)));
typedef float f32x2 __attribute__((ext_vector_type(2)));
typedef unsigned u32x4 __attribute__((ext_vector_type(4)));
typedef unsigned u32x2 __attribute__((ext_vector_type(2)));

constexpr int BATCH = 2, T = 16384, D = 1024, M = BATCH * T;
constexpr int INC = 8456;
constexpr int PLD = 5376;
constexpr int NP = 5632;
constexpr int C_RW = 0, C_Z = 1792, C_XBC = 2304, C_RET = 3328, C_RETG = 4864;
constexpr int FF = 2816, FFE = 3584, NE = 8;

constexpr size_t MiB = 1u << 20;
constexpr size_t WS_CTL = 0, CTL_ZERO_BYTES = 64 * 1024;
constexpr size_t WS_RSTD = 1 * MiB, WS_GATES = 2 * MiB, WS_DT = 3 * MiB;
constexpr size_t WS_W = 4 * MiB;
constexpr size_t WL_IN = 0, WL_GATE = 11 * MiB, WL_BR = 17 * MiB, WL_OUT = 20 * MiB, WL_STRIDE = 22 * MiB;
constexpr size_t WS_FFUP = WS_W + 44 * MiB, WS_FFDN = WS_W + 55 * MiB;
constexpr size_t WS_XB = 68 * MiB;
constexpr size_t WS_VF = 132 * MiB;
constexpr size_t WS_BIG = 164 * MiB;
constexpr size_t WS_VMIX = WS_BIG + 336 * MiB, WS_YRW = WS_BIG + 368 * MiB, WS_END = 573 * MiB;
constexpr size_t WS_MOEW = WS_BIG;
constexpr size_t MOEW_STRIDE = 21 * MiB, MOEW_DN = 14 * MiB;
constexpr size_t WS_ACT = WS_BIG + 168 * MiB;

constexpr size_t WS_CNT = 32768, WS_LIST = 2 * MiB;
constexpr size_t WS_BND2 = 566 * MiB;
constexpr size_t WS_VLORA = 192 * 1024;
constexpr size_t WS_DSTOT = 128 * 1024, WS_BND = 256 * 1024;
constexpr size_t WS_LORA = 1 * MiB + 512 * 1024, LORA_STRIDE = 262144;
constexpr size_t WS_ST_RW = WS_XB, WS_ST_RET = WS_XB + 16 * MiB, WS_ST_SSD = WS_XB + 32 * MiB, WS_MT = WS_YRW;
constexpr int RING_BYTES = 131072, LDSCTL_OFF = 159744, MISC_OFF = LDSCTL_OFF + 320, LDS_BYTES = 163840;
#ifndef REP_CONV
#define REP_CONV 0
#endif
#ifndef REP_R1
#define REP_R1 0
#endif
#ifndef REP_RW
#define REP_RW 0
#endif
#ifndef REP_RET
#define REP_RET 0
#endif
#ifndef REP_SSD
#define REP_SSD 0
#endif
#ifndef REP_MISC
#define REP_MISC 0
#endif
#ifndef RW_CH
#define RW_CH 1
#endif
#ifndef RET_CH
#define RET_CH 1
#endif
#ifndef SSD_CH
#define SSD_CH 1
#endif

typedef __bf16 hbf16x2 __attribute__((ext_vector_type(2)));
__device__ __forceinline__ unsigned pk2(float lo, float hi) { const f32x2 v = {lo, hi}; return __builtin_bit_cast(unsigned, __builtin_convertvector(v, hbf16x2)); }
__device__ __forceinline__ unsigned f2bf(float f) { return (unsigned)__builtin_bit_cast(unsigned short, (__bf16)f); }
__device__ __forceinline__ float bflo(unsigned u) { return __builtin_bit_cast(float, u << 16); }
__device__ __forceinline__ float bfhi(unsigned u) { return __builtin_bit_cast(float, u & 0xffff0000u); }
__device__ __forceinline__ void unpack8(const u32x4 u, float (&f)[8]) { f[0] = bflo(u.x); f[1] = bfhi(u.x); f[2] = bflo(u.y); f[3] = bfhi(u.y); f[4] = bflo(u.z); f[5] = bfhi(u.z); f[6] = bflo(u.w); f[7] = bfhi(u.w); }
__device__ __forceinline__ u32x4 pack8(const float (&f)[8]) { u32x4 w; w.x = pk2(f[0], f[1]); w.y = pk2(f[2], f[3]); w.z = pk2(f[4], f[5]); w.w = pk2(f[6], f[7]); return w; }
__device__ __forceinline__ float sigm(float x) { return __builtin_amdgcn_rcpf(1.f + __expf(-x)); }
__device__ __forceinline__ float silu(float x) { return x * __builtin_amdgcn_rcpf(1.f + __expf(-x)); }
__device__ __forceinline__ float ex2(float x) { return __builtin_amdgcn_exp2f(x); }
__device__ __forceinline__ float fast_tanh(float x) { return 1.f - 2.f * __builtin_amdgcn_rcpf(1.f + __expf(2.f * x)); }
__device__ __forceinline__ float softplus_acc(float x) { return fmaxf(x, 0.f) + log1pf(expf(-fabsf(x))); }
__device__ __forceinline__ float wave_sum(float v) {
#pragma unroll
    for (int o = 1; o < 64; o <<= 1) v += __shfl_xor(v, o);
    return v;
}
__device__ __forceinline__ int otid_w(int wid) { unsigned z = 0u; asm volatile("" : "+v"(z)); int t = wid * 64 + (int)__builtin_amdgcn_mbcnt_hi(~0u, __builtin_amdgcn_mbcnt_lo(~0u, z)); asm volatile("" : "+v"(t)); return t; }
#define otid() otid_w(F.wid)
__device__ __forceinline__ int fresh_tid(int t) { asm volatile("" : "+v"(t)); return t; }
#define LDS_WAIT() asm volatile("s_waitcnt lgkmcnt(0)" ::: "memory")

namespace pg8 {
constexpr int BM = 256, BK = 64, HALF = 128, HTB = HALF * BK * 2, STAGE_BYTES = 8 * HTB, NXCD = 8, WGM = 8;
__host__ __device__ __forceinline__ int lds_byte(int r, int c) { const int st = (r >> 4) * 2 + (c >> 5), rr = r & 15, cc = c & 31, ob = rr * 64 + cc * 2; return st * 1024 + (ob ^ (((ob >> 9) & 1) << 5)); }
__host__ __device__ __forceinline__ void stage_rc(int b, int& R, int& C) { const int st = b / 1024, sb = b % 1024, swz = sb ^ (((sb >> 9) & 1) << 5); R = (st >> 1) * 16 + swz / 64; C = (st & 1) * 32 + (swz % 64) / 2; }
__host__ __device__ __forceinline__ int perm32(int rho) { const int n = rho >> 4, i = rho & 15; return 8 * (i >> 2) + 4 * n + (i & 3); }

struct Unit { int pm, pn; size_t aofs, bofs; const int* rows; int nvalid, e; };
struct Gemm { const bf16* A; const bf16* Bt; int lda, ldb, K; };

struct StaticOrder {
    static constexpr bool GATHER = false;
    int nM, nN, nwg, G, c; size_t tsA, tsB;
    __device__ __forceinline__ void init(int Mrows, int N, int G_, int c_, int lda, int ldb) { nM = Mrows / BM; nN = N / BM; nwg = nM * nN; G = G_; c = c_; tsA = (size_t)BM * lda * 2; tsB = (size_t)BM * ldb * 2; }
    __device__ __forceinline__ void tile(int L, int& pm, int& pn) const {
        int wgid = L; { const int q = nwg / NXCD, r = nwg % NXCD, xcd = wgid % NXCD, off = wgid / NXCD; wgid = (xcd < r ? xcd * (q + 1) : r * (q + 1) + (xcd - r) * q) + off; }
        const int nig = WGM * nN, gid = wgid / nig, fm = gid * WGM, gsz = (nM - fm) < WGM ? (nM - fm) : WGM;
        pm = fm + ((wgid % nig) % gsz); pn = (wgid % nig) / gsz;
    }
    __device__ __forceinline__ bool next(int i, Unit& u) const {
        const long L = (long)i * G + c; if (L >= nwg) return false;
        tile((int)L, u.pm, u.pn); u.aofs = (size_t)u.pm * tsA; u.bofs = (size_t)u.pn * tsB; u.rows = nullptr; u.nvalid = BM; u.e = 0; return true;
    }
};
struct BranchOrder {
    static constexpr bool GATHER = false;
    StaticOrder so;
    __device__ __forceinline__ void init(int G_, int c_) { so.init(M, D, G_, c_, PLD, 512); }
    __device__ __forceinline__ bool next(int j, Unit& u) const {
        const long L = (long)j * so.G + so.c; if (L >= 3 * so.nwg) return false;
        const int i = (int)(L / so.nwg); so.tile((int)(L % so.nwg), u.pm, u.pn);
        const int acol = (i == 0) ? 1024 : (i == 1 ? C_Z : C_RETG);
        u.aofs = (size_t)u.pm * so.tsA + (size_t)acol * 2; u.bofs = ((size_t)i * D + (size_t)u.pn * BM) * 512 * 2; u.rows = nullptr; u.nvalid = BM; u.e = i; return true;
    }
};
struct GateOrder {
    static constexpr bool GATHER = false;
    StaticOrder so;
    __device__ __forceinline__ void init(int G_, int c_) { so.init(M, D, G_, c_, D, D); }
    __device__ __forceinline__ bool next(int j, Unit& u) const {
        const long tt = (long)(j / 3) * so.G + so.c; if (tt >= so.nwg) return false;
        const int i = j % 3; so.tile((int)tt, u.pm, u.pn);
        u.aofs = (size_t)u.pm * so.tsA; u.bofs = ((size_t)i * D + (size_t)u.pn * BM) * D * 2; u.rows = nullptr; u.nvalid = BM; u.e = i; return true;
    }
};
template <bool GATH> struct MoeOrder {
    static constexpr bool GATHER = GATH;
    unsigned q0, q1, q2, q3;
    int seg, nN, G, c, ksplit; const int* list; size_t bstride, tsB, tsA, kbytes;
    __device__ __forceinline__ void init(const int* counts, const int* list_, int seg_, int N, int G_, int c_, int lda, int ldb, size_t bstride_, int ksplit_ = 1, int kpart = 0) {
        unsigned n[8];
#pragma unroll
        for (int e = 0; e < 8; ++e) { int v = __builtin_amdgcn_readfirstlane(counts[e]); v = v < 0 ? 0 : (v > 32768 ? 32768 : v); n[e] = (unsigned)v; }
        q0 = n[0] | (n[1] << 16); q1 = n[2] | (n[3] << 16); q2 = n[4] | (n[5] << 16); q3 = n[6] | (n[7] << 16);
        seg = seg_; nN = N / BM; G = G_; c = c_; list = list_; bstride = bstride_; tsB = (size_t)BM * ldb * 2; tsA = (size_t)BM * lda * 2; ksplit = ksplit_; kbytes = (size_t)kpart * 2;
    }
    __device__ __forceinline__ bool next(int i, Unit& u) const {
        const long L0 = (long)i * G + c; const long L = L0 / ksplit; const int ks = (int)(L0 % ksplit); const int tl = (int)(L / nN), pn = (int)(L % nN), gt = seg * 128 + tl;
        int t = 0, e = 0, tbe = 0, cne = 0;
#pragma unroll
        for (int k = 0; k < 8; ++k) { const unsigned q = (k < 2) ? q0 : (k < 4) ? q1 : (k < 6) ? q2 : q3; const int n = (int)((k & 1) ? (q >> 16) : (q & 0xffffu));
            if (gt >= t) { e = k; tbe = t; cne = n; } t += (n + 255) >> 8; }
        int nt = t - seg * 128; nt = nt < 0 ? 0 : (nt > 128 ? 128 : nt);
        if (L >= (long)nt * nN) return false;
        const int rt = gt - tbe;
        u.pm = tl; u.pn = pn; u.e = e; u.bofs = (size_t)e * bstride + (size_t)pn * tsB + ks * kbytes; u.aofs = (GATH ? 0 : (size_t)tl * tsA) + ks * kbytes;
        u.rows = list + ((size_t)e * 32768 + rt * 256) * 2; int nv = cne - rt * 256; u.nvalid = nv > 256 ? 256 : nv; return true;
    }
};

template <class Epi, class Sched>
__device__ __forceinline__ void gemm_phase(LAS unsigned char* lds, int wid0, const Gemm g, const Sched& S, const Epi& E) {
    constexpr bool GATHER = Sched::GATHER;
    const int tid = otid_w(wid0), wid = __builtin_amdgcn_readfirstlane(tid >> 6), lane = tid & 63, wr = wid >> 2, wc = wid & 3, fr = lane & 15, fq = lane >> 4;
    const int nt = g.K / BK;
    unsigned voffA[2], voffB[2];
#pragma unroll
    for (int i = 0; i < 2; ++i) { int R, C; stage_rc(tid * 16 + i * 8192, R, C); const int Rb = Epi::PERM ? ((R & ~31) + perm32(R & 31)) : R;
        voffA[i] = (unsigned)(R * g.lda + C) * 2u; voffB[i] = (unsigned)(Rb * g.ldb + C) * 2u; }
    const size_t kstep = (size_t)(BK * 2);
    const size_t hstepA = GATHER ? 0 : (size_t)HALF * g.lda * 2, hstepB = (size_t)HALF * g.ldb * 2;
    const unsigned ldsw = (unsigned)wid * 1024u;
    const int aoff = lds_byte(wr * 64 + fr, fq * 8), boff = lds_byte(wc * 32 + fr, fq * 8);
#define PG8_SA(b, h) (((b) * 2 + (h)) * HTB)
#define PG8_SB(b, h) ((4 + (b) * 2 + (h)) * HTB)
#define PG8_STAGE2(bufoff, gbase, o0, o1) do { \
        __builtin_amdgcn_global_load_lds((const unsigned*)((const char*)(gbase) + (o0)), (LAS unsigned*)(lds + (bufoff) + ldsw), 16, 0, 0); \
        __builtin_amdgcn_global_load_lds((const unsigned*)((const char*)(gbase) + (o1)), (LAS unsigned*)(lds + (bufoff) + ldsw + 8192), 16, 0, 0); } while (0)
#define PG8_STAGE(bufoff, gbase, voff) PG8_STAGE2(bufoff, gbase, (voff)[0], (voff)[1])
#define PG8_LDA(dst, b, h) do { _Pragma("unroll") for (int m = 0; m < 4; ++m) _Pragma("unroll") for (int k = 0; k < 2; ++k) dst[m][k] = *(const LAS bf16x8*)(lds + PG8_SA(b, h) + aoff + m * 2048 + k * 1024); } while (0)
#define PG8_LDB(dst, b, h) do { _Pragma("unroll") for (int n = 0; n < 2; ++n) _Pragma("unroll") for (int k = 0; k < 2; ++k) dst[n][k] = *(const LAS bf16x8*)(lds + PG8_SB(b, h) + boff + n * 2048 + k * 1024); } while (0)
#define PG8_MMA(ai, bj, At, Bt) do { __builtin_amdgcn_s_setprio(1); _Pragma("unroll") for (int m = 0; m < 4; ++m) _Pragma("unroll") for (int n = 0; n < 2; ++n) _Pragma("unroll") for (int k = 0; k < 2; ++k) \
        acc[ai][bj][m][n] = Epi::TRANS ? __builtin_amdgcn_mfma_f32_16x16x32_bf16(Bt[n][k], At[m][k], acc[ai][bj][m][n], 0, 0, 0) : __builtin_amdgcn_mfma_f32_16x16x32_bf16(At[m][k], Bt[n][k], acc[ai][bj][m][n], 0, 0, 0); __builtin_amdgcn_s_setprio(0); } while (0)
#define PG8_WAIT_V(n) asm volatile("s_waitcnt vmcnt(" #n ")" ::: "memory")
#define PG8_WAIT_L(n) asm volatile("s_waitcnt lgkmcnt(" #n ")" ::: "memory")
#define PG8_BAR __builtin_amdgcn_s_barrier()
#define PG8_SCHED __builtin_amdgcn_sched_barrier(0)
#define GSLOT(which) ((LAS u32x4*)(lds + 131072 + (which) * 8192 + tid * 16))
#define PG8_ROWS(u, which) do { const int _ft = fresh_tid(tid); unsigned _vg[2][2]; _Pragma("unroll") for (int _i = 0; _i < 2; ++_i) { int _R, _C; stage_rc(_ft * 16 + _i * 8192, _R, _C); \
        _Pragma("unroll") for (int _h = 0; _h < 2; ++_h) { const int _r = _h * HALF + _R; \
        const int _t = (_r < (u).nvalid) ? (u).rows[2 * _r] : 0; _vg[_h][_i] = ((unsigned)_t * (unsigned)g.lda + (unsigned)_C) * 2u; } } \
        u32x4 _o; _o.x = _vg[0][0]; _o.y = _vg[0][1]; _o.z = _vg[1][0]; _o.w = _vg[1][1]; *GSLOT(which) = _o; } while (0)
    Unit cur, nxt; int ui = 0;
    if (!S.next(0, cur)) return;
    f32x4 acc[2][2][4][2];
#pragma unroll
    for (int a = 0; a < 2; ++a)
#pragma unroll
        for (int b = 0; b < 2; ++b)
#pragma unroll
            for (int m = 0; m < 4; ++m)
#pragma unroll
                for (int n = 0; n < 2; ++n) acc[a][b][m][n] = (f32x4){0.f, 0.f, 0.f, 0.f};
    bf16x8 At[4][2], B0[2][2], B1[2][2];
    u32x4 gc = {voffA[0], voffA[1], voffA[0], voffA[1]};
    if constexpr (GATHER) { PG8_ROWS(cur, 0); PG8_ROWS(cur, 1); gc = *GSLOT(0); }
#define VGC(h, i) (gc[2 * (h) + (i)])
    const char* cA = (const char*)g.A + cur.aofs; const char* cB = (const char*)g.Bt + cur.bofs;
    PG8_STAGE(PG8_SB(0, 0), cB, voffB); PG8_STAGE(PG8_SB(0, 1), cB + hstepB, voffB); PG8_STAGE2(PG8_SA(0, 0), cA, VGC(0, 0), VGC(0, 1)); PG8_STAGE2(PG8_SA(0, 1), cA + hstepA, VGC(1, 0), VGC(1, 1));
    if (wr == 1) PG8_BAR;
    PG8_WAIT_V(2); PG8_BAR;
    PG8_STAGE(PG8_SB(1, 0), cB + kstep, voffB); PG8_STAGE2(PG8_SA(1, 0), cA + kstep, VGC(0, 0), VGC(0, 1)); PG8_STAGE(PG8_SB(1, 1), cB + hstepB + kstep, voffB);
    PG8_WAIT_V(6); PG8_BAR;
    for (;;) {
        const bool has_next = S.next(ui + 1, nxt);
        const char* nA = has_next ? (const char*)g.A + nxt.aofs : cA; const char* nB = has_next ? (const char*)g.Bt + nxt.bofs : cB;
        if constexpr (GATHER) { if (has_next) PG8_ROWS(nxt, 1); else *GSLOT(1) = *GSLOT(0); }
        for (int t = 0; t < nt; t += 2) {
            const bool last = (t == nt - 2);
            const char* a1 = cA + (size_t)(t + 1) * kstep;
            const char* a2 = last ? nA : cA + (size_t)(t + 2) * kstep; const char* b2 = last ? nB : cB + (size_t)(t + 2) * kstep;
            const char* a3 = a2 + kstep; const char* b3 = b2 + kstep;
            u32x4 gn = gc; if constexpr (GATHER) { gc = *GSLOT(0); gn = last ? *GSLOT(1) : gc; }
            const unsigned s00 = gn.x, s01 = gn.y, s10 = gn.z, s11 = gn.w;
            PG8_LDB(B0, 0, 0); PG8_LDB(B1, 0, 1); PG8_SCHED; PG8_LDA(At, 0, 0); PG8_STAGE2(PG8_SA(1, 1), a1 + hstepA, VGC(1, 0), VGC(1, 1));
            PG8_WAIT_V(8); PG8_WAIT_L(0); PG8_BAR; PG8_MMA(0, 0, At, B0); PG8_MMA(0, 1, At, B1); PG8_BAR; PG8_SCHED;
            PG8_LDA(At, 0, 1); PG8_STAGE(PG8_SB(0, 0), b2, voffB); PG8_STAGE(PG8_SB(0, 1), b2 + hstepB, voffB); PG8_STAGE2(PG8_SA(0, 0), a2, s00, s01);
            PG8_WAIT_V(8); PG8_WAIT_L(0); PG8_BAR; PG8_MMA(1, 0, At, B0); PG8_MMA(1, 1, At, B1); PG8_BAR; PG8_SCHED;
            PG8_LDB(B0, 1, 0); PG8_LDB(B1, 1, 1); PG8_SCHED; PG8_LDA(At, 1, 0); PG8_STAGE2(PG8_SA(0, 1), a2 + hstepA, s10, s11);
            PG8_WAIT_V(8); PG8_WAIT_L(0); PG8_BAR; PG8_MMA(0, 0, At, B0); PG8_MMA(0, 1, At, B1); PG8_BAR; PG8_SCHED;
            PG8_LDA(At, 1, 1); PG8_STAGE(PG8_SB(1, 0), b3, voffB); PG8_STAGE(PG8_SB(1, 1), b3 + hstepB, voffB); PG8_STAGE2(PG8_SA(1, 0), a3, s00, s01);
            PG8_WAIT_V(8); PG8_WAIT_L(0); PG8_BAR; PG8_MMA(1, 0, At, B0); PG8_MMA(1, 1, At, B1); PG8_BAR; PG8_SCHED;
        }
        if (wr == 0) PG8_BAR;
        E(acc, cur, wr, wc, fr, fq);
        if (!has_next) break;
#pragma unroll
        for (int a = 0; a < 2; ++a)
#pragma unroll
            for (int b = 0; b < 2; ++b)
#pragma unroll
                for (int m = 0; m < 4; ++m)
#pragma unroll
                    for (int n = 0; n < 2; ++n) acc[a][b][m][n] = (f32x4){0.f, 0.f, 0.f, 0.f};
        cur = nxt; cA = nA; cB = nB; ++ui;
        if constexpr (GATHER) { *GSLOT(0) = *GSLOT(1); }
        if (wr == 1) PG8_BAR;
    }
    PG8_WAIT_V(0);
    PG8_BAR;
#undef PG8_SA
#undef PG8_SB
#undef PG8_STAGE
#undef PG8_STAGE2
#undef PG8_ROWS
#undef GSLOT
#undef VGC
#undef PG8_LDA
#undef PG8_LDB
#undef PG8_MMA
#undef PG8_WAIT_V
#undef PG8_WAIT_L
#undef PG8_BAR
#undef PG8_SCHED
}

typedef const f32x4 (&AccRef)[2][2][4][2];

struct EpiInProj {
    static constexpr bool PERM = true, TRANS = true;
    bf16* P; const float* rstd; float* dt;
    __device__ __forceinline__ void operator()(AccRef acc, const Unit& u, int wr, int wc, int fr, int fq) const {
        const int row0 = u.pm * BM + wr * 64 + fr;
        if (u.pn < 21) {
            const int col0 = u.pn * BM + wc * 32 + 8 * fq;
#pragma unroll
            for (int ai = 0; ai < 2; ++ai)
#pragma unroll
                for (int m = 0; m < 4; ++m) { const int row = row0 + ai * HALF + m * 16; const float s = rstd[row]; bf16* rowp = P + (size_t)row * PLD + col0;
#pragma unroll
                    for (int bj = 0; bj < 2; ++bj) { const f32x4 v0 = acc[ai][bj][m][0] * s, v1 = acc[ai][bj][m][1] * s;
                        u32x4 w; w.x = pk2(v0[0], v0[1]); w.y = pk2(v0[2], v0[3]); w.z = pk2(v1[0], v1[1]); w.w = pk2(v1[2], v1[3]);
                        *(u32x4*)(rowp + bj * HALF) = w; } }
        } else if (wc == 0 && fq == 0) {
#pragma unroll
            for (int ai = 0; ai < 2; ++ai)
#pragma unroll
                for (int m = 0; m < 4; ++m) { const int row = row0 + ai * HALF + m * 16; const float s = rstd[row];
                    *(f32x4*)(dt + (size_t)row * 8) = acc[ai][0][m][0] * s; *(f32x4*)(dt + (size_t)row * 8 + 4) = acc[ai][0][m][1] * s; }
        }
    }
};
struct EpiPlain {
    static constexpr bool PERM = true, TRANS = true;
    bf16* P; bf16* Y2;
    __device__ __forceinline__ void operator()(AccRef acc, const Unit& u, int wr, int wc, int fr, int fq) const {
        bf16* O = (u.e == 0) ? P : (u.e == 1 ? P + C_XBC : Y2); const int ldc = (u.e == 2) ? D : PLD;
        const int row0 = u.pm * BM + wr * 64 + fr, col0 = u.pn * BM + wc * 32 + 8 * fq;
#pragma unroll
        for (int ai = 0; ai < 2; ++ai)
#pragma unroll
            for (int m = 0; m < 4; ++m) { bf16* rowp = O + (size_t)(row0 + ai * HALF + m * 16) * ldc + col0;
#pragma unroll
                for (int bj = 0; bj < 2; ++bj) { const f32x4 v0 = acc[ai][bj][m][0], v1 = acc[ai][bj][m][1];
                    u32x4 w; w.x = pk2(v0[0], v0[1]); w.y = pk2(v0[2], v0[3]); w.z = pk2(v1[0], v1[1]); w.w = pk2(v1[2], v1[3]);
                    *(u32x4*)(rowp + bj * HALF) = w; } }
    }
};
struct EpiGateMerge {
    static constexpr bool PERM = true, TRANS = true;
    const bf16* P; const bf16* Y2; bf16* Mg; int ldm; const float* rstd;
    __device__ __forceinline__ void operator()(AccRef acc, const Unit& u, int wr, int wc, int fr, int fq) const {
        asm volatile("" : "+v"(fr), "+v"(fq));
        const bf16* Y = (u.e == 0) ? P : (u.e == 1 ? P + C_XBC : Y2); const int ldy = (u.e == 2) ? D : PLD; const int first = (u.e == 0);
        const int row0 = u.pm * BM + wr * 64 + fr, col0 = u.pn * BM + wc * 32 + 8 * fq;
#pragma unroll
        for (int ai = 0; ai < 2; ++ai)
#pragma unroll
            for (int m = 0; m < 4; ++m) { const int row = row0 + ai * HALF + m * 16; const float s = rstd[row];
#pragma unroll
                for (int bj = 0; bj < 2; ++bj) { const int c = col0 + bj * HALF;
                    float y[8], o[8]; unpack8(*(const u32x4*)(Y + (size_t)row * ldy + c), y);
                    const f32x4 v0 = acc[ai][bj][m][0] * s, v1 = acc[ai][bj][m][1] * s;
#pragma unroll
                    for (int j = 0; j < 4; ++j) { o[j] = sigm(v0[j]) * y[j]; o[4 + j] = sigm(v1[j]) * y[4 + j]; }
                    if (!first) { float p[8]; unpack8(*(const u32x4*)(Mg + (size_t)row * ldm + c), p);
#pragma unroll
                        for (int j = 0; j < 8; ++j) o[j] += p[j]; }
                    *(u32x4*)(Mg + (size_t)row * ldm + c) = pack8(o); } }
    }
};
struct EpiResid {
    static constexpr bool PERM = false, TRANS = true;
    const float* xin; float* xout; const float* gates; int e;
    __device__ __forceinline__ void operator()(AccRef acc, const Unit& u, int wr, int wc, int fr, int fq) const {
        const int row0 = u.pm * BM + wr * 64 + fr, col0 = u.pn * BM + wc * 32 + 4 * fq;
#pragma unroll
        for (int ai = 0; ai < 2; ++ai)
#pragma unroll
            for (int m = 0; m < 4; ++m) { const int row = row0 + ai * HALF + m * 16; const float s = gates ? gates[(size_t)row * 8 + e] : 1.f;
                const float* ip = xin + (size_t)row * D + col0; float* op = xout + (size_t)row * D + col0;
#pragma unroll
                for (int bj = 0; bj < 2; ++bj)
#pragma unroll
                    for (int n = 0; n < 2; ++n) *(f32x4*)(op + bj * HALF + n * 16) = *(const f32x4*)(ip + bj * HALF + n * 16) + acc[ai][bj][m][n] * s; }
    }
};
struct EpiSwiglu {
    static constexpr bool PERM = true, TRANS = true;
    bf16* act; int ldc; const float* rstd;
    __device__ __forceinline__ void operator()(AccRef acc, const Unit& u, int wr, int wc, int fr, int fq) const {
        asm volatile("" : "+v"(fr), "+v"(fq));
        const int row0 = u.pm * BM + wr * 64 + fr, col0 = u.pn * HALF + wc * 32 + 8 * fq;
#pragma unroll
        for (int ai = 0; ai < 2; ++ai)
#pragma unroll
            for (int m = 0; m < 4; ++m) { const int row = row0 + ai * HALF + m * 16; const int lr = row - u.pm * BM;
                const float s = u.rows ? rstd[(lr < u.nvalid) ? u.rows[2 * lr] : 0] : rstd[row];
                float o[8];
#pragma unroll
                for (int n = 0; n < 2; ++n)
#pragma unroll
                    for (int j = 0; j < 4; ++j) o[4 * n + j] = silu(acc[ai][0][m][n][j] * s) * (acc[ai][1][m][n][j] * s);
                *(u32x4*)(act + (size_t)row * ldc + col0) = pack8(o); }
    }
};
struct EpiMoeDown {
    static constexpr bool PERM = false, TRANS = false;
    float* x;
    __device__ __forceinline__ void operator()(AccRef acc, const Unit& u, int wr, int wc, int fr, int fq) const {
        asm volatile("" : "+v"(fr), "+v"(fq));
        const int col0 = u.pn * BM + wc * 32 + fr;
#pragma unroll
        for (int ai = 0; ai < 2; ++ai)
#pragma unroll
            for (int m = 0; m < 4; ++m) { asm volatile("" ::: "memory");
#pragma unroll
                for (int j = 0; j < 4; ++j) { const int lr = ai * HALF + wr * 64 + m * 16 + 4 * fq + j;
                    if (lr < u.nvalid) { const int tok = u.rows[2 * lr]; const float wgt = __builtin_bit_cast(float, u.rows[2 * lr + 1]); float* xp = x + (size_t)tok * D + col0;
#pragma unroll
                        for (int bj = 0; bj < 2; ++bj)
#pragma unroll
                            for (int n = 0; n < 2; ++n) atomicAdd(xp + bj * HALF + n * 16, wgt * acc[ai][bj][m][n][j]); } } }
    }
};
}

#define XB_TMO      128
#define XB_XCNT(j)  (256  + 64 * (j))
#define XB_XSUB(j)  (1280 + 64 * (j))
#define XB_XGEN(j)  (2304 + 64 * (j))
#define XB_TOP      3328
#define XB_TOPGEN   3392
#define XCD_BAR_WORDS 3456
#define XB_SPIN_CAP (1u << 18)

__device__ __forceinline__ unsigned xb_ld(unsigned* p)              { return __hip_atomic_load(p, __ATOMIC_RELAXED, __HIP_MEMORY_SCOPE_AGENT); }
__device__ __forceinline__ unsigned xb_add(unsigned* p, unsigned v) { return __hip_atomic_fetch_add(p, v, __ATOMIC_RELAXED, __HIP_MEMORY_SCOPE_AGENT); }
__device__ __forceinline__ unsigned xb_xcc_id() { return (unsigned)__builtin_amdgcn_s_getreg((3 << 11) | 20) & 0xFu; }
#define XB_SPIN(cond, bar) do { unsigned _sp = 0; while (cond) { __builtin_amdgcn_s_sleep(1); \
    if ((++_sp & 255u) == 0u) { if (xb_ld(&(bar)[XB_TMO])) break; if (_sp > XB_SPIN_CAP) { atomicAdd(&(bar)[XB_TMO], 1u); break; } } } } while (0)

struct XcdBarrier { unsigned* bar; unsigned x; volatile LAS unsigned* st; };

__device__ __forceinline__ XcdBarrier xcd_barrier_post(unsigned* bar, volatile LAS unsigned* st) {
    XcdBarrier b; b.bar = bar; b.x = xb_xcc_id(); b.st = st;
    if (threadIdx.x == 0) (void)xb_add(&bar[XB_XCNT(b.x)], 1u);
    return b;
}
__device__ __forceinline__ void xcd_barrier_complete(unsigned* bar, unsigned x, unsigned& nloc, unsigned& nx) {
    const unsigned G = gridDim.x * gridDim.y * gridDim.z;
    unsigned sum, cnt, mine, sp = 0u;
    for (;;) {
        sum = 0u; cnt = 0u; mine = 0u;
#pragma unroll
        for (unsigned j = 0; j < 16; ++j) { const unsigned c = xb_ld(&bar[XB_XCNT(j)]); sum += c; cnt += (c > 0u) ? 1u : 0u; mine = (j == x) ? c : mine; }
        if (sum == G) break;
        __builtin_amdgcn_s_sleep(1);
        if ((++sp & 255u) == 0u) { if (xb_ld(&bar[XB_TMO])) break; if (sp > XB_SPIN_CAP) { atomicAdd(&bar[XB_TMO], 1u); break; } }
    }
    nloc = mine > 0u ? mine : 1u; nx = cnt > 0u ? cnt : 1u;
}
__device__ __forceinline__ void xcd_barrier(const XcdBarrier& b) {
    asm volatile("s_waitcnt vmcnt(0)" ::: "memory");
    __syncthreads();
    if (threadIdx.x == 0) {
        unsigned* bar = b.bar;
        __builtin_amdgcn_s_waitcnt(0);
        unsigned nloc = b.st[0], nx = b.st[1];
        if (nloc == 0u) { xcd_barrier_complete(bar, b.x, nloc, nx); b.st[0] = nloc; b.st[1] = nx; }
        const unsigned old = xb_add(&bar[XB_XSUB(b.x)], 1u);
        const unsigned gen = old / nloc;
        if (old + 1u == (gen + 1u) * nloc) {
            __builtin_amdgcn_fence(__ATOMIC_RELEASE, "agent");
            asm volatile("s_waitcnt vmcnt(0)" ::: "memory");
            const unsigned og = xb_add(&bar[XB_TOP], 1u);
            const unsigned tg = og / nx;
            if (og + 1u == (tg + 1u) * nx) xb_add(&bar[XB_TOPGEN], 1u);
            else XB_SPIN(xb_ld(&bar[XB_TOPGEN]) == tg, bar);
            __builtin_amdgcn_fence(__ATOMIC_ACQUIRE, "agent");
            xb_add(&bar[XB_XGEN(b.x)], 1u);
            asm volatile("s_waitcnt vmcnt(0)" ::: "memory");
        } else {
            XB_SPIN(xb_ld(&bar[XB_XGEN(b.x)]) == gen, bar);
            __builtin_amdgcn_fence(__ATOMIC_ACQUIRE, "agent");
            asm volatile("s_waitcnt vmcnt(0)" ::: "memory");
        }
    }
    __syncthreads();
}

struct Args { const float* in[34]; float* out; unsigned char* ws; int ph_lo, ph_hi; };
struct Frame {
    LAS unsigned char* lds;
    int vcu, G, cid, wid;
    float* out; unsigned char* ws;
};
__device__ __forceinline__ const float* inptr(LAS unsigned char* lds, int i) {
    int off = LDSCTL_OFF + 8 * i; asm volatile("" : "+v"(off));
    const LAS unsigned* p = (const LAS unsigned*)(lds + off);
    const unsigned lo = __builtin_amdgcn_readfirstlane(p[0]), hi = __builtin_amdgcn_readfirstlane(p[1]);
    return (const float*)(((unsigned long long)hi << 32) | lo);
}
#define INP(i) inptr(F.lds, (i))

__device__ __forceinline__ void conv_item(const float* W, int ld, int k0, int c0, int nvalid, const float* scale, bf16* dst, int K, int drow0, LAS float* scr, int lane) {
    const int n4 = (lane & 15) * 4;
#pragma unroll 4
    for (int i = 0; i < 16; ++i) { const int kk = 4 * i + (lane >> 4);
        f32x4 v = {0.f, 0.f, 0.f, 0.f}; if (n4 < nvalid) { v = *(const f32x4*)(W + (size_t)(k0 + kk) * ld + c0 + n4); if (scale) v *= scale[k0 + kk]; }
        LAS float* d = scr + kk * 65 + n4; d[0] = v[0]; d[1] = v[1]; d[2] = v[2]; d[3] = v[3]; }
    LDS_WAIT(); asm volatile("" ::: "memory");
    const int c = lane & 7;
#pragma unroll
    for (int j = 0; j < 8; ++j) { const int nn = (lane >> 3) + 8 * j; const LAS float* sp = scr + (8 * c) * 65 + nn;
        u32x4 o; o.x = pk2(sp[0 * 65], sp[1 * 65]); o.y = pk2(sp[2 * 65], sp[3 * 65]); o.z = pk2(sp[4 * 65], sp[5 * 65]); o.w = pk2(sp[6 * 65], sp[7 * 65]);
        *(u32x4*)(dst + (size_t)(drow0 + nn) * K + k0 + 8 * c) = o; }
    LDS_WAIT(); asm volatile("" ::: "memory");
}
__device__ __forceinline__ void conv_seg(Frame& F, const float* W, int ld, int K, int c0, int nvalid, int ntotal, const float* scale, bf16* dst, int r0, int blk, int blks) {
    const int ptid = otid(), plane = ptid & 63, pwave = __builtin_amdgcn_readfirstlane(ptid >> 6);
    LAS float* scr = (LAS float*)(F.lds + pwave * 16640);
    const int gw = F.vcu * 8 + pwave, NGW = F.G * 8;
    const int nblk = ntotal / 64, nitems = (K / 64) * nblk;
    for (int it = gw; it < nitems; it += NGW) {
        const int kb = it / nblk, nb = it % nblk, n0 = nb * 64;
        int nv = nvalid - n0; nv = nv < 0 ? 0 : (nv > 64 ? 64 : nv);
        conv_item(W, ld, kb * 64, c0 + n0, nv, scale, dst, K, r0 + (n0 / blk) * blks + (n0 % blk), scr, plane);
    }
}
__device__ __forceinline__ void conv_layer_weights(Frame& F, int l) {
    unsigned char* wl = F.ws + WS_W + (size_t)l * WL_STRIDE;
    const float* win = INP(2) + (size_t)l * D * INC; const float* n1 = INP(1) + l * D;
    const int BIGB = 1 << 30;
    conv_seg(F, win, INC, D, 0, 3328, 3328, n1, (bf16*)(wl + WL_IN), 0, BIGB, 0);
    conv_seg(F, win, INC, D, 3336, 2048, 2048, n1, (bf16*)(wl + WL_IN), 3328, BIGB, 0);
    conv_seg(F, win, INC, D, 3328, 8, 256, n1, (bf16*)(wl + WL_IN), 5376, BIGB, 0);
    conv_seg(F, win, INC, D, 5384, 3072, 3072, n1, (bf16*)(wl + WL_GATE), 0, BIGB, 0);
    for (int i = 0; i < 3; ++i)
        conv_seg(F, INP(23) + ((size_t)l * 3 + i) * 512 * D, D, 512, 0, D, D, nullptr, (bf16*)(wl + WL_BR) + (size_t)i * D * 512, 0, BIGB, 0);
    conv_seg(F, INP(24) + (size_t)l * D * D, D, D, 0, D, D, nullptr, (bf16*)(wl + WL_OUT), 0, BIGB, 0);
}
__device__ __forceinline__ void conv_ffn_weights(Frame& F) {
    const float* n2 = INP(25);
    conv_seg(F, INP(26), FF, D, 0, FF, FF, n2, (bf16*)(F.ws + WS_FFUP), 0, 128, 256);
    conv_seg(F, INP(27), FF, D, 0, FF, FF, n2, (bf16*)(F.ws + WS_FFUP), 128, 128, 256);
    conv_seg(F, INP(28), D, FF, 0, D, D, nullptr, (bf16*)(F.ws + WS_FFDN), 0, 1 << 30, 0);
}
__device__ __forceinline__ void conv_moe_weights(Frame& F) {
    const float* n2 = INP(25) + D;
    for (int e = 0; e < NE; ++e) {
        bf16* up = (bf16*)(F.ws + WS_MOEW + (size_t)e * MOEW_STRIDE); bf16* dn = (bf16*)(F.ws + WS_MOEW + (size_t)e * MOEW_STRIDE + MOEW_DN);
        conv_seg(F, INP(30) + (size_t)e * D * FFE, FFE, D, 0, FFE, FFE, n2, up, 0, 128, 256);
        conv_seg(F, INP(31) + (size_t)e * D * FFE, FFE, D, 0, FFE, FFE, n2, up, 128, 128, 256);
        conv_seg(F, INP(32) + (size_t)e * FFE * D, D, FFE, 0, D, D, nullptr, dn, 0, 1 << 30, 0);
    }
}

__device__ __forceinline__ void xprep_phase(Frame& F, const float* x) {
    const int ptid = otid(), plane = ptid & 63, pwave = __builtin_amdgcn_readfirstlane(ptid >> 6); (void)plane; (void)pwave;
    const int gw = F.vcu * 8 + pwave, NGW = F.G * 8;
    bf16* xb = (bf16*)(F.ws + WS_XB); float* rstd = (float*)(F.ws + WS_RSTD);
    for (int m = gw; m < M; m += NGW) {
        const f32x4* xr = (const f32x4*)(x + (size_t)m * D) + plane;
        f32x4 v[4]; float s = 0.f;
#pragma unroll
        for (int j = 0; j < 4; ++j) { v[j] = xr[64 * j]; s += (v[j].x * v[j].x + v[j].y * v[j].y) + (v[j].z * v[j].z + v[j].w * v[j].w); }
        s = wave_sum(s);
        if (plane == 0) rstd[m] = __builtin_amdgcn_rsqf(s * (1.f / D) + 1e-6f);
        u32x2* o8 = (u32x2*)(xb + (size_t)m * D) + plane;
#pragma unroll
        for (int j = 0; j < 4; ++j) { u32x2 w; w.x = pk2(v[j].x, v[j].y); w.y = pk2(v[j].z, v[j].w); o8[64 * j] = w; }
    }
}
__device__ __forceinline__ void final_norm_phase(Frame& F) {
    const int ptid = otid(), plane = ptid & 63, pwave = __builtin_amdgcn_readfirstlane(ptid >> 6); (void)plane; (void)pwave;
    const int gw = F.vcu * 8 + pwave, NGW = F.G * 8;
    const float* fw = INP(33);
    for (int m = gw; m < M; m += NGW) {
        f32x4* xr = (f32x4*)(F.out + (size_t)m * D) + plane;
        f32x4 v[4]; float s = 0.f;
#pragma unroll
        for (int j = 0; j < 4; ++j) { v[j] = xr[64 * j]; s += (v[j].x * v[j].x + v[j].y * v[j].y) + (v[j].z * v[j].z + v[j].w * v[j].w); }
        s = wave_sum(s);
        const float r = __builtin_amdgcn_rsqf(s * (1.f / D) + 1e-6f);
#pragma unroll
        for (int j = 0; j < 4; ++j) { const f32x4 w = *((const f32x4*)fw + plane + 64 * j); xr[64 * j] = v[j] * r * w; }
    }
}
__device__ __forceinline__ void router_phase(Frame& F) {
    const int ptid = otid(), plane = ptid & 63, pwave = __builtin_amdgcn_readfirstlane(ptid >> 6);
    const float* nw = INP(25) + D; const float* rt = INP(29); float* rstd_w = (float*)(F.ws + WS_RSTD); bf16* xb = (bf16*)(F.ws + WS_XB);
    int* cnt = (int*)(F.ws + WS_CNT); int* list2 = (int*)(F.ws + WS_LIST);
    LAS int* lsel = (LAS int*)F.lds;
    LAS float* lwt = (LAS float*)(F.lds + 1024);
    LAS int* lrank = (LAS int*)(F.lds + 2048);
    LAS int* lcnt = (LAS int*)(F.lds + 3072);
    for (int blk = F.vcu; blk < M / 128; blk += F.G) {
        if (ptid < 16) lcnt[ptid] = 0;
        __syncthreads();
        for (int k = 0; k < 16; ++k) {
            const int lt = pwave * 16 + k, m = blk * 128 + lt;
            float acc[8];
#pragma unroll
            for (int e = 0; e < 8; ++e) acc[e] = 0.f;
            const f32x4* xr4 = (const f32x4*)(F.out + (size_t)m * D) + plane;
            f32x4 xv4[4]; float ssq = 0.f;
#pragma unroll
            for (int j = 0; j < 4; ++j) { xv4[j] = xr4[64 * j]; ssq += (xv4[j].x * xv4[j].x + xv4[j].y * xv4[j].y) + (xv4[j].z * xv4[j].z + xv4[j].w * xv4[j].w); }
            ssq = wave_sum(ssq);
            { u32x2* o8 = (u32x2*)(xb + (size_t)m * D) + plane;
#pragma unroll
              for (int j = 0; j < 4; ++j) { u32x2 wv; wv.x = pk2(xv4[j].x, xv4[j].y); wv.y = pk2(xv4[j].z, xv4[j].w); o8[64 * j] = wv; } }
#pragma unroll
            for (int j = 0; j < 4; ++j) { const int kk = 4 * plane + 256 * j; const f32x4 nwv = *(const f32x4*)(nw + kk);
#pragma unroll
                for (int q = 0; q < 4; ++q) { const float xv = xv4[j][q] * nwv[q];
                    const f32x4 r0v = *(const f32x4*)(rt + (size_t)(kk + q) * 8), r1v = *(const f32x4*)(rt + (size_t)(kk + q) * 8 + 4);
                    acc[0] += xv * r0v.x; acc[1] += xv * r0v.y; acc[2] += xv * r0v.z; acc[3] += xv * r0v.w; acc[4] += xv * r1v.x; acc[5] += xv * r1v.y; acc[6] += xv * r1v.z; acc[7] += xv * r1v.w; } }
            const float sc = __builtin_amdgcn_rsqf(ssq * (1.f / D) + 1e-6f);
            if (plane == 0) rstd_w[m] = sc;
#pragma unroll
            for (int e = 0; e < 8; ++e) acc[e] = wave_sum(acc[e]) * sc;
            int i0 = 0; float v0 = acc[0];
#pragma unroll
            for (int e = 1; e < 8; ++e) if (acc[e] > v0) { v0 = acc[e]; i0 = e; }
            int i1 = -1; float v1 = -3.0e38f;
#pragma unroll
            for (int e = 0; e < 8; ++e) if (e != i0 && acc[e] > v1) { v1 = acc[e]; i1 = e; }
            const float e1 = expf(v1 - v0), w0 = 1.f / (1.f + e1), w1 = e1 / (1.f + e1);
            if (plane == 0) { lsel[2 * lt] = i0; lsel[2 * lt + 1] = i1; lwt[2 * lt] = w0; lwt[2 * lt + 1] = w1;
                lrank[2 * lt] = atomicAdd((int*)(lcnt + i0), 1); lrank[2 * lt + 1] = atomicAdd((int*)(lcnt + i1), 1); }
        }
        __syncthreads();
        if (ptid < 8) lcnt[8 + ptid] = atomicAdd(cnt + ptid, lcnt[ptid]);
        __syncthreads();
        if (ptid < 256) { const int e = lsel[ptid], slot = lcnt[8 + e] + lrank[ptid];
            u32x2 v; v.x = (unsigned)(blk * 128 + (ptid >> 1)); v.y = __builtin_bit_cast(unsigned, lwt[ptid]);
            *(u32x2*)(list2 + ((size_t)e * 32768 + slot) * 2) = v; }
        __syncthreads();
    }
}

__device__ __forceinline__ void vprep_phase(Frame& F, int layer) {
    const int ptid = otid(), plane = ptid & 63, pwave = __builtin_amdgcn_readfirstlane(ptid >> 6);
    constexpr int VP = 520, V_VB = 0, V_GB = 64 * VP * 2, V_VD = 2 * 64 * VP * 2;
    LAS bf16* VB = (LAS bf16*)(F.lds + V_VB); LAS bf16* GB = (LAS bf16*)(F.lds + V_GB); LAS bf16* VD = (LAS bf16*)(F.lds + V_VD);
    const bf16* P = (const bf16*)(F.ws + WS_BIG); bf16* VF = (bf16*)(F.ws + WS_VF); bf16* VM = (bf16*)(F.ws + WS_VMIX);
    const bf16* vdT = (const bf16*)(F.ws + WS_VLORA); const bf16* vuT = vdT + 32 * 512;
    const float* mu = INP(3) + layer * 1792 + 1024; const float* v0 = INP(16);
    const int tok = ptid >> 3, part = ptid & 7, r16 = plane & 15, q4 = plane >> 4;
    for (int it = F.vcu; it < M / 64; it += F.G) {
        const int m = it * 64 + tok; const int t = m & (T - 1);
        const bf16* cur = P + (size_t)m * PLD + 1024 + part * 64;
#pragma unroll
        for (int q = 0; q < 8; ++q) { float c[8], p[8]; unpack8(*(const u32x4*)(cur + q * 8), c);
            if (t > 0) unpack8(*(const u32x4*)(cur - PLD + q * 8), p); else {
#pragma unroll
                for (int e = 0; e < 8; ++e) p[e] = 0.f; }
            const f32x4 m0 = *(const f32x4*)(mu + part * 64 + q * 8), m1 = *(const f32x4*)(mu + part * 64 + q * 8 + 4);
#pragma unroll
            for (int e = 0; e < 4; ++e) { c[e] = c[e] + (p[e] - c[e]) * m0[e]; c[4 + e] = c[4 + e] + (p[4 + e] - c[4 + e]) * m1[e]; }
            const u32x4 o = pack8(c);
            if (layer == 0) *(u32x4*)(VF + (size_t)m * 512 + part * 64 + q * 8) = o; else *(LAS u32x4*)(VB + tok * VP + part * 64 + q * 8) = o; }
        if (layer == 0) continue;
        __syncthreads();
        { const int rb = pwave & 3, jt = pwave >> 2; f32x4 acc = {0.f, 0.f, 0.f, 0.f};
#pragma unroll 4
          for (int k0 = 0; k0 < 512; k0 += 32) acc = __builtin_amdgcn_mfma_f32_16x16x32_bf16(*(const LAS bf16x8*)(VB + (16 * rb + r16) * VP + k0 + 8 * q4), *(const bf16x8*)(vdT + (size_t)(16 * jt + r16) * 512 + k0 + 8 * q4), acc, 0, 0, 0);
#pragma unroll
          for (int jj = 0; jj < 4; ++jj) VD[(16 * rb + 4 * q4 + jj) * 40 + 16 * jt + r16] = (bf16)f2bf(acc[jj]); }
        __syncthreads();
        { const int rb = pwave & 3; const bf16x8 af = *(const LAS bf16x8*)(VD + (16 * rb + r16) * 40 + 8 * q4);
#pragma unroll 4
          for (int i = 0; i < 16; ++i) { const int ct = (pwave >> 2) * 16 + i;
              const f32x4 acc = __builtin_amdgcn_mfma_f32_16x16x32_bf16(af, *(const bf16x8*)(vuT + (size_t)(16 * ct + r16) * 32 + 8 * q4), (f32x4){0.f, 0.f, 0.f, 0.f}, 0, 0, 0);
              const float vc = v0[16 * ct + r16];
#pragma unroll
              for (int jj = 0; jj < 4; ++jj) GB[(16 * rb + 4 * q4 + jj) * VP + 16 * ct + r16] = (bf16)f2bf(sigm(vc + acc[jj])); } }
        __syncthreads();
#pragma unroll
        for (int q = 0; q < 8; ++q) { float v[8], g[8], vf[8]; unpack8(*(const LAS u32x4*)(VB + tok * VP + part * 64 + q * 8), v); unpack8(*(const LAS u32x4*)(GB + tok * VP + part * 64 + q * 8), g);
            unpack8(*(const u32x4*)(VF + (size_t)m * 512 + part * 64 + q * 8), vf);
#pragma unroll
            for (int e = 0; e < 8; ++e) v[e] = v[e] + (vf[e] - v[e]) * g[e];
            *(u32x4*)(VM + (size_t)m * 512 + part * 64 + q * 8) = pack8(v); }
        __syncthreads();
    }
}
__device__ __forceinline__ void prepass_a(Frame& F) {
    const int tid = otid();
    bf16* P = (bf16*)(F.ws + WS_BIG); bf16* BND2 = (bf16*)(F.ws + WS_BND2);
    { const int ch = tid & 127; const int kind = ch >> 6, part = ch & 7;
      double invf[4];
#pragma unroll
      for (int p = 0; p < 4; ++p) invf[p] = exp(-(double)(part * 4 + p) * (9.210340371976184 / 32.0));
      for (int m = F.vcu * 4 + (tid >> 7); m < M; m += F.G * 4) {
          const int t = m & (T - 1); bf16* ptr = P + (size_t)m * PLD + C_RET + ch * 8;
          float x[8]; unpack8(*(const u32x4*)ptr, x);
#pragma unroll
          for (int p = 0; p < 4; ++p) { double rev = (double)t * invf[p] * 0.15915494309189535; rev -= floor(rev);
              const float sn = __builtin_amdgcn_sinf((float)rev), cs = __builtin_amdgcn_cosf((float)rev);
              const float x0 = x[2 * p], x1 = x[2 * p + 1]; float o0 = x0 * cs - x1 * sn, o1 = x0 * sn + x1 * cs;
              if (kind) { o0 *= 0.125f; o1 *= 0.125f; }
              x[2 * p] = o0; x[2 * p + 1] = o1; }
          *(u32x4*)ptr = pack8(x); } }
    for (int i = F.vcu * 512 + tid; i < 1024 * 3 * 128; i += F.G * 512) { const int ch = i & 127, k = (i >> 7) % 3, r = i / 384;
        if ((r & 511) != 0) *(u32x4*)(BND2 + ((size_t)r * 3 + k) * 1024 + ch * 8) = *(const u32x4*)(P + ((size_t)r * 32 - 3 + k) * PLD + C_XBC + ch * 8); }
}
__device__ __forceinline__ void prepass_conv(Frame& F, int layer) {
    const int tid = otid();
    bf16* P = (bf16*)(F.ws + WS_BIG); const bf16* BND2 = (const bf16*)(F.ws + WS_BND2);
    const float* cw = INP(17) + layer * 1024 * 4; const float* cbias = INP(18) + layer * 1024;
    const int ch = tid & 127;
    f32x4 wv[8]; float bv[8];
#pragma unroll
    for (int e = 0; e < 8; ++e) { wv[e] = *(const f32x4*)(cw + (ch * 8 + e) * 4); bv[e] = cbias[ch * 8 + e]; }
    for (int r = F.vcu * 4 + (tid >> 7); r < M / 32; r += F.G * 4) {
        float w0[8], w1[8], w2[8];
        if ((r & 511) != 0) { unpack8(*(const u32x4*)(BND2 + ((size_t)r * 3 + 0) * 1024 + ch * 8), w0); unpack8(*(const u32x4*)(BND2 + ((size_t)r * 3 + 1) * 1024 + ch * 8), w1); unpack8(*(const u32x4*)(BND2 + ((size_t)r * 3 + 2) * 1024 + ch * 8), w2); }
        else {
#pragma unroll
            for (int e = 0; e < 8; ++e) { w0[e] = 0.f; w1[e] = 0.f; w2[e] = 0.f; } }
        bf16* ptr = P + (size_t)r * 32 * PLD + C_XBC + ch * 8;
#pragma unroll 4
        for (int i = 0; i < 32; ++i) {
            float x[8], o[8]; unpack8(*(const u32x4*)(ptr + (size_t)i * PLD), x);
#pragma unroll
            for (int e = 0; e < 8; ++e) { o[e] = silu(bv[e] + wv[e][0] * w0[e] + wv[e][1] * w1[e] + wv[e][2] * w2[e] + wv[e][3] * x[e]); w0[e] = w1[e]; w1[e] = w2[e]; w2[e] = x[e]; }
            *(u32x4*)(ptr + (size_t)i * PLD) = pack8(o);
        }
    }
}
template <int CTRL> __device__ __forceinline__ float dpp_f(float v) { return __builtin_bit_cast(float, __builtin_amdgcn_update_dpp(0, __builtin_bit_cast(int, v), CTRL, 0xF, 0xF, true)); }
__device__ __forceinline__ float red8(float v) { v += dpp_f<0xB1>(v); v += dpp_f<0x4E>(v); v += dpp_f<0x141>(v); return v; }
__device__ __forceinline__ float red16(float v) { v = red8(v); v += dpp_f<0x140>(v); return v; }

__device__ __forceinline__ void rwkv_seq(Frame& F, int layer, int bh) {
    const int ptid = otid(), plane = ptid & 63, pwave = __builtin_amdgcn_readfirstlane(ptid >> 6); (void)plane; (void)pwave;
    const int b = bh >> 3, h = bh & 7;
    LAS float* L = (LAS float*)F.lds;
    LAS float *rr = L, *ww = L + 2048, *kf = L + 4096, *vv = L + 6144, *aa = L + 8192, *bb = L + 10240, *gg = L + 12288, *yy = L + 14336, *tw = L + 16384, *xa = L + 18432, *sg = L + 20480, *bon = L + 24576;
    const float* mu = INP(3) + layer * 1792; const float* w_up = INP(4) + layer * 64 * 512; const float* w0 = INP(5) + layer * 512;
    const float* a_up = INP(6) + layer * 64 * 512; const float* a0 = INP(7) + layer * 512; const float* g_up = INP(8) + layer * 128 * 512;
    const float* k_k = INP(9) + layer * 512; const float* k_a = INP(10) + layer * 512; const float* r_k = INP(11) + layer * 512;
    const float* gn_w = INP(12) + layer * 512; const float* gn_b = INP(13) + layer * 512;
    const bf16* P = (const bf16*)(F.ws + WS_BIG); const bf16* vsrc = (const bf16*)(F.ws + (layer == 0 ? WS_VF : WS_VMIX)); bf16* yout = (bf16*)(F.ws + WS_YRW);
    const int tid = ptid, tok = tid >> 4, part = tid & 15, c4 = part * 4, cb = h * 64 + c4;
    const int srow = tid >> 3, sc0 = (tid & 7) * 8;
    float S[8];
#pragma unroll
    for (int j = 0; j < 8; ++j) S[j] = 0.f;
    for (int t0 = 0; t0 < T; t0 += 32) {
        {
            const int t = t0 + tok; const size_t m = (size_t)b * T + t;
            const bf16* cur = P + m * PLD;
#pragma unroll
            for (int q = 0; q < 3; ++q) {
                const int ch = part + 16 * q; int col, kind; LAS float* dst;
                if (ch < 8) { col = h * 64 + ch * 8; dst = rr + tok * 64 + ch * 8; kind = 0; }
                else if (ch < 16) { col = 512 + h * 64 + (ch - 8) * 8; dst = kf + tok * 64 + (ch - 8) * 8; kind = 0; }
                else if (ch < 24) { col = 1536 + (ch - 16) * 8; dst = tw + tok * 64 + (ch - 16) * 8; kind = 1; }
                else if (ch < 32) { col = 1600 + (ch - 24) * 8; dst = xa + tok * 64 + (ch - 24) * 8; kind = 0; }
                else { col = 1664 + (ch - 32) * 8; dst = sg + tok * 128 + (ch - 32) * 8; kind = 2; }
                float c[8], p[8]; unpack8(*(const u32x4*)(cur + col), c);
                if (t > 0) unpack8(*(const u32x4*)(cur - PLD + col), p); else {
#pragma unroll
                    for (int e = 0; e < 8; ++e) p[e] = 0.f; }
#pragma unroll
                for (int e = 0; e < 8; ++e) { float x = c[e] + (p[e] - c[e]) * mu[col + e]; if (kind == 1) x = tanhf(x); else if (kind == 2) x = sigm(x); dst[e] = x; }
            }
            if (part < 8) { float v[8]; unpack8(*(const u32x4*)(vsrc + m * 512 + h * 64 + part * 8), v);
#pragma unroll
                for (int e = 0; e < 8; ++e) vv[tok * 64 + part * 8 + e] = v[e]; }
        }
        __syncthreads();
        {
            f32x4 dw = *(const f32x4*)(w0 + cb), da = *(const f32x4*)(a0 + cb), dg = (f32x4){0.f, 0.f, 0.f, 0.f};
            for (int j = 0; j < 64; ++j) { const float tj = tw[tok * 64 + j], xj = xa[tok * 64 + j];
                dw += *(const f32x4*)(w_up + j * 512 + cb) * tj; da += *(const f32x4*)(a_up + j * 512 + cb) * xj; }
            for (int j = 0; j < 128; ++j) dg += *(const f32x4*)(g_up + j * 512 + cb) * sg[tok * 128 + j];
            float kr[4], kk[4], av[4], ss = 0.f;
#pragma unroll
            for (int e = 0; e < 4; ++e) { kr[e] = kf[tok * 64 + c4 + e]; kk[e] = kr[e] * k_k[cb + e]; ss += kk[e] * kk[e]; av[e] = sigm(da[e]); }
            ss = red16(ss);
            const float inv = __builtin_amdgcn_rsqf(fmaxf(ss, 1e-24f));
            float bs = 0.f;
#pragma unroll
            for (int e = 0; e < 4; ++e) { const float kn = kk[e] * inv; const int o = tok * 64 + c4 + e;
                const float ld = -expf(-softplus_acc(-dw[e]) - 0.5f);
                ww[o] = expf(ld); aa[o] = -kn; bb[o] = kn * av[e];
                const float knew = kr[e] * (1.f + (av[e] - 1.f) * k_a[cb + e]); kf[o] = knew; gg[o] = dg[e];
                bs += rr[o] * knew * r_k[cb + e]; }
            bs = red16(bs);
            if (part == 0) bon[tok] = bs;
        }
        __syncthreads();
        for (int s = 0; s < 32; ++s) {
            const f32x4 a0v = *(const LAS f32x4*)(aa + s * 64 + sc0), a1v = *(const LAS f32x4*)(aa + s * 64 + sc0 + 4);
            const f32x4 w0v = *(const LAS f32x4*)(ww + s * 64 + sc0), w1v = *(const LAS f32x4*)(ww + s * 64 + sc0 + 4);
            const f32x4 b0v = *(const LAS f32x4*)(bb + s * 64 + sc0), b1v = *(const LAS f32x4*)(bb + s * 64 + sc0 + 4);
            const f32x4 k0v = *(const LAS f32x4*)(kf + s * 64 + sc0), k1v = *(const LAS f32x4*)(kf + s * 64 + sc0 + 4);
            const f32x4 r0v = *(const LAS f32x4*)(rr + s * 64 + sc0), r1v = *(const LAS f32x4*)(rr + s * 64 + sc0 + 4);
            const float vi = vv[s * 64 + srow];
            float sa = 0.f;
#pragma unroll
            for (int j = 0; j < 4; ++j) sa += S[j] * a0v[j] + S[4 + j] * a1v[j];
            sa = red8(sa);
            float y = 0.f;
#pragma unroll
            for (int j = 0; j < 4; ++j) { S[j] = S[j] * w0v[j] + sa * b0v[j] + vi * k0v[j]; S[4 + j] = S[4 + j] * w1v[j] + sa * b1v[j] + vi * k1v[j]; y += S[j] * r0v[j] + S[4 + j] * r1v[j]; }
            y = red8(y);
            if ((tid & 7) == 0) yy[s * 64 + srow] = y;
        }
        __syncthreads();
        {
            const size_t m = (size_t)b * T + t0 + tok;
            float y[4], sm = 0.f;
#pragma unroll
            for (int e = 0; e < 4; ++e) { y[e] = yy[tok * 64 + c4 + e]; sm += y[e]; }
            const float mean = red16(sm) * (1.f / 64.f);
            float vs = 0.f;
#pragma unroll
            for (int e = 0; e < 4; ++e) { y[e] -= mean; vs += y[e] * y[e]; }
            const float rs = __builtin_amdgcn_rsqf(red16(vs) * (1.f / 64.f) + 64e-5f);
            const float bo = bon[tok];
            float o[4];
#pragma unroll
            for (int e = 0; e < 4; ++e) { const int idx = tok * 64 + c4 + e; o[e] = (y[e] * rs * gn_w[cb + e] + gn_b[cb + e] + bo * vv[idx]) * gg[idx]; }
            u32x2 w; w.x = pk2(o[0], o[1]); w.y = pk2(o[2], o[3]);
            *(u32x2*)(yout + m * 512 + cb) = w;
        }
        __syncthreads();
    }
}

__device__ __forceinline__ void ret_seq(Frame& F, int bh) {
    const int ptid = otid(), plane = ptid & 63, pwave = __builtin_amdgcn_readfirstlane(ptid >> 6); (void)plane; (void)pwave;
    const int b = bh >> 3, h = bh & 7;
    LAS float* L = (LAS float*)F.lds;
    LAS float *qq = L, *kk = L + 2048, *vv = L + 4096, *gg = L + 6144, *yy = L + 8192;
    bf16* P = (bf16*)(F.ws + WS_BIG);
    const int tid = ptid, tok = tid >> 4, part = tid & 15, c4 = part * 4;
    const int se = tid >> 3, sd0 = (tid & 7) * 8;
    const float gamma = 1.f - exp2f(-5.f - (float)h);
    float S[8];
#pragma unroll
    for (int j = 0; j < 8; ++j) S[j] = 0.f;
    for (int t0 = 0; t0 < T; t0 += 32) {
        {
            const int t = t0 + tok; const size_t m = (size_t)b * T + t;
#pragma unroll
            for (int q = 0; q < 2; ++q) {
                const int ch = part + 16 * q, kind = ch >> 3, cc = ch & 7;
                float x[8]; unpack8(*(const u32x4*)(P + m * PLD + C_RET + kind * 512 + h * 64 + cc * 8), x);
                LAS float* dst = (kind == 0 ? qq : kind == 1 ? kk : kind == 2 ? vv : gg) + tok * 64 + cc * 8;
                if (kind < 2) {
#pragma unroll
                    for (int p = 0; p < 4; ++p) { const int i = cc * 4 + p;
                        const double invf = exp(-(double)i * (9.210340371976184 / 32.0));
                        double sn, cs; sincos((double)t * invf, &sn, &cs);
                        const float x0 = x[2 * p], x1 = x[2 * p + 1], c = (float)cs, s = (float)sn;
                        float o0 = x0 * c - x1 * s, o1 = x0 * s + x1 * c;
                        if (kind == 1) { o0 *= 0.125f; o1 *= 0.125f; }
                        dst[2 * p] = o0; dst[2 * p + 1] = o1; }
                } else {
#pragma unroll
                    for (int e = 0; e < 8; ++e) dst[e] = x[e];
                }
            }
        }
        __syncthreads();
        for (int s = 0; s < 32; ++s) {
            const f32x4 k0v = *(const LAS f32x4*)(kk + s * 64 + sd0), k1v = *(const LAS f32x4*)(kk + s * 64 + sd0 + 4);
            const f32x4 q0v = *(const LAS f32x4*)(qq + s * 64 + sd0), q1v = *(const LAS f32x4*)(qq + s * 64 + sd0 + 4);
            const float ve = vv[s * 64 + se];
            float y = 0.f;
#pragma unroll
            for (int j = 0; j < 4; ++j) { S[j] = gamma * S[j] + k0v[j] * ve; S[4 + j] = gamma * S[4 + j] + k1v[j] * ve; y += q0v[j] * S[j] + q1v[j] * S[4 + j]; }
            y = red8(y);
            if ((tid & 7) == 0) yy[s * 64 + se] = y;
        }
        __syncthreads();
        {
            const size_t m = (size_t)b * T + t0 + tok;
            float y[4], ss = 0.f;
#pragma unroll
            for (int e = 0; e < 4; ++e) { y[e] = yy[tok * 64 + c4 + e]; ss += y[e] * y[e]; }
            const float rs = __builtin_amdgcn_rsqf(red16(ss) * (1.f / 64.f) + 1e-6f);
            float o[4];
#pragma unroll
            for (int e = 0; e < 4; ++e) o[e] = y[e] * rs * silu(gg[tok * 64 + c4 + e]);
            u32x2 w; w.x = pk2(o[0], o[1]); w.y = pk2(o[2], o[3]);
            *(u32x2*)(P + m * PLD + C_RETG + h * 64 + c4) = w;
        }
        __syncthreads();
    }
}

__device__ __forceinline__ void ssd_seq(Frame& F, int layer, int bh) {
    const int ptid = otid(), plane = ptid & 63, pwave = __builtin_amdgcn_readfirstlane(ptid >> 6); (void)plane; (void)pwave;
    const int b = bh >> 3, h = bh & 7, g = h >> 2;
    LAS float* L = (LAS float*)F.lds;
    LAS float *raw = L  , *xs = L + 11200, *Bc = L + 13248, *Cc = L + 17344, *yy = L + 21440, *dts = L + 23488, *das = L + 23520;
    bf16* P = (bf16*)(F.ws + WS_BIG); const float* dtb = (const float*)(F.ws + WS_DT);
    const float* cw = INP(17) + layer * 1024 * 4; const float* cbias = INP(18) + layer * 1024;
    const float dt_bias = INP(19)[layer * 8 + h], A = -expf(INP(20)[layer * 8 + h]), Dh = INP(21)[layer * 8 + h];
    const int tid = ptid;
    const int sp = tid >> 3, sn0 = (tid & 7) * 16;
    float S[16];
#pragma unroll
    for (int j = 0; j < 16; ++j) S[j] = 0.f;
    for (int i = tid; i < 3 * 320; i += 512) raw[i] = 0.f;
    __syncthreads();
    for (int t0 = 0; t0 < T; t0 += 32) {
        for (int idx = tid; idx < 32 * 40; idx += 512) {
            const int row = idx / 40, ch = idx % 40; const size_t m = (size_t)b * T + t0 + row;
            const int col = ch < 8 ? (C_XBC + h * 64 + ch * 8) : (ch < 24 ? (C_XBC + 512 + g * 128 + (ch - 8) * 8) : (C_XBC + 768 + g * 128 + (ch - 24) * 8));
            float x[8]; unpack8(*(const u32x4*)(P + m * PLD + col), x);
#pragma unroll
            for (int e = 0; e < 8; ++e) raw[(3 + row) * 320 + ch * 8 + e] = x[e];
        }
        if (tid < 32) { const size_t m = (size_t)b * T + t0 + tid; const float dt = softplus_acc(dtb[m * 8 + h] + dt_bias); dts[tid] = dt; das[tid] = expf(A * dt); }
        __syncthreads();
        for (int idx = tid; idx < 32 * 320; idx += 512) {
            const int row = idx / 320, c = idx % 320;
            const int chn = c < 64 ? (h * 64 + c) : (c < 192 ? (512 + g * 128 + (c - 64)) : (768 + g * 128 + (c - 192)));
            float a = cbias[chn];
#pragma unroll
            for (int k = 0; k < 4; ++k) a += cw[chn * 4 + k] * raw[(row + k) * 320 + c];
            a = silu(a);
            if (c < 64) xs[row * 64 + c] = a; else if (c < 192) Bc[row * 128 + (c - 64)] = a; else Cc[row * 128 + (c - 192)] = a;
        }
        __syncthreads();
        for (int s = 0; s < 32; ++s) {
            const float da = das[s], xv = xs[s * 64 + sp], dtx = dts[s] * xv;
            float y = 0.f;
#pragma unroll
            for (int q = 0; q < 4; ++q) { const f32x4 bv = *(const LAS f32x4*)(Bc + s * 128 + sn0 + q * 4), cv = *(const LAS f32x4*)(Cc + s * 128 + sn0 + q * 4);
#pragma unroll
                for (int j = 0; j < 4; ++j) { S[q * 4 + j] = da * S[q * 4 + j] + dtx * bv[j]; y += S[q * 4 + j] * cv[j]; } }
            y = red8(y);
            if ((tid & 7) == 0) yy[s * 64 + sp] = y + Dh * xv;
        }
        __syncthreads();
        {
            const int tok = tid >> 4, c4 = (tid & 15) * 4; const size_t m = (size_t)b * T + t0 + tok;
            u32x2 w; w.x = pk2(yy[tok * 64 + c4], yy[tok * 64 + c4 + 1]); w.y = pk2(yy[tok * 64 + c4 + 2], yy[tok * 64 + c4 + 3]);
            *(u32x2*)(P + m * PLD + C_XBC + h * 64 + c4) = w;
            for (int i = tid; i < 3 * 320; i += 512) raw[i] = raw[32 * 320 + i];
        }
        __syncthreads();
    }
}
__device__ __forceinline__ void ssm_norm_phase(Frame& F, int layer) {
    const int ptid = otid(), plane = ptid & 63, pwave = __builtin_amdgcn_readfirstlane(ptid >> 6); (void)plane; (void)pwave;
    const int gw = F.vcu * 8 + pwave, NGW = F.G * 8;
    bf16* P = (bf16*)(F.ws + WS_BIG); const float* nw = INP(22) + layer * 512;
    for (int m = gw; m < M; m += NGW) {
        float y[8], z[8]; unpack8(*(const u32x4*)(P + (size_t)m * PLD + C_XBC + plane * 8), y); unpack8(*(const u32x4*)(P + (size_t)m * PLD + C_Z + plane * 8), z);
        float ss = 0.f;
#pragma unroll
        for (int e = 0; e < 8; ++e) { y[e] *= silu(z[e]); ss += y[e] * y[e]; }
        ss += __shfl_xor(ss, 1); ss += __shfl_xor(ss, 2); ss += __shfl_xor(ss, 4); ss += __shfl_xor(ss, 8); ss += __shfl_xor(ss, 16);
        const float rs = __builtin_amdgcn_rsqf(ss * (1.f / 256.f) + 1e-6f);
#pragma unroll
        for (int e = 0; e < 8; ++e) y[e] *= rs * nw[plane * 8 + e];
        *(u32x4*)(P + (size_t)m * PLD + C_Z + plane * 8) = pack8(y);
    }
}

constexpr int PT = 72, PT2 = 136, PF = 68;
__device__ __forceinline__ f32x4 mfma16(bf16x8 a, bf16x8 b, f32x4 c) { return __builtin_amdgcn_mfma_f32_16x16x32_bf16(a, b, c, 0, 0, 0); }
template <int K, bool SA = false, bool SB = false> __device__ __forceinline__ f32x4 mm_ll(const LAS bf16* A, int pa, int m0, const LAS bf16* B, int pb, int n0, f32x4 acc, int lane) {
    const int r = lane & 15, q = lane >> 4;
    const int xa = SA ? (((m0 + r) >> 3) & 7) : 0, xb = SB ? (((n0 + r) >> 3) & 7) : 0;
    const LAS bf16* ap = A + (m0 + r) * pa; const LAS bf16* bp = B + (n0 + r) * pb;
#pragma unroll
    for (int k0 = 0; k0 < K; k0 += 32) acc = mfma16(*(const LAS bf16x8*)(ap + 8 * (((k0 >> 3) + q) ^ xa)), *(const LAS bf16x8*)(bp + 8 * (((k0 >> 3) + q) ^ xb)), acc);
    return acc;
}
template <int K> __device__ __forceinline__ f32x4 mm_lg(const LAS bf16* A, int pa, int m0, const bf16* B, int pb, int n0, f32x4 acc, int lane) {
    const int r = lane & 15, q = lane >> 4;
    const LAS bf16* ap = A + (m0 + r) * pa + 8 * q; const bf16* bp = B + (size_t)(n0 + r) * pb + 8 * q;
#pragma unroll
    for (int k0 = 0; k0 < K; k0 += 32) acc = mfma16(*(const LAS bf16x8*)(ap + k0), *(const bf16x8*)(bp + k0), acc);
    return acc;
}
__device__ __forceinline__ float redl16(float v) { return red16(v); }
__device__ __forceinline__ void st4bf(LAS bf16* p, f32x4 v) { u32x2 w; w.x = pk2(v[0], v[1]); w.y = pk2(v[2], v[3]); *(LAS u32x2*)p = w; }
__device__ __forceinline__ float ldbf(const LAS bf16* p) { return __builtin_bit_cast(float, (unsigned)(*p) << 16); }
constexpr f32x4 FZ4 = {0.f, 0.f, 0.f, 0.f};
__device__ __forceinline__ void tr_write8(LAS bf16* Tm, int pitch, int c0, int t, const float (&v)[8], int) {
    LAS bf16* base = Tm + c0 * pitch + (t ^ (((c0 >> 3) & 7) << 3));
#pragma unroll
    for (int e = 0; e < 8; ++e) base[e * pitch] = (bf16)f2bf(v[e]);
}
__device__ __forceinline__ float tr_at(const LAS bf16* Tm, int pitch, int row, int col) { return __builtin_bit_cast(float, (unsigned)Tm[row * pitch + (col ^ (((row >> 3) & 7) << 3))] << 16); }
__device__ __forceinline__ void ld8f(const LAS float* p, float (&v)[8]) { const f32x4 a = *(const LAS f32x4*)p, b = *(const LAS f32x4*)(p + 4); v[0] = a[0]; v[1] = a[1]; v[2] = a[2]; v[3] = a[3]; v[4] = b[0]; v[5] = b[1]; v[6] = b[2]; v[7] = b[3]; }
__device__ __forceinline__ void st8f(LAS float* p, const float (&v)[8]) { *(LAS f32x4*)p = (f32x4){v[0], v[1], v[2], v[3]}; *(LAS f32x4*)(p + 4) = (f32x4){v[4], v[5], v[6], v[7]}; }

template <bool FINAL>
__device__ __forceinline__ void rwkv_chunk_unit(Frame& F, int layer, int u) {
    const int tid = otid(), w = __builtin_amdgcn_readfirstlane(tid >> 6);
    bf16x8 lfr[16];
#define IDS() const int ft = fresh_tid(tid); const int lane = ft & 63, r16 = lane & 15, q4 = lane >> 4, tok = ft >> 3, part = ft & 7; (void)lane; (void)r16; (void)q4; (void)tok; (void)part
    const int b = u >> 9, sc = (u >> 3) & 63, h = u & 7;
    constexpr int NV = FINAL ? 64 : 128, NVT = NV / 16, NZ = NVT / 2;
    constexpr int X_TW = 0, X_XA = 9216, X_SG = 18432, X_KF = 35840, X_RF = 52224;
    constexpr int O_AT = 0, O_RT = 9216, O_BT = 18432, O_KT = 27648, O_BH = 36864, O_KH = 46080, O_VT = 55296, O_TF = O_BT;
    constexpr int Y0 = 68608;
    constexpr int Y_A = Y0, Y_B = Y0 + 8192, Y_K = Y0 + 16384, Y_R = Y0 + 24576, Y_L = Y0 + 32768, Y_VF = Y0 + 49152;
    constexpr int Y_AAB = Y0, Y_AAK = Y0 + 17408, Y_ARB = Y_AAK + 9216, Y_ARK = Y_ARB + 9216, Y_TB = FINAL ? Y_ARK + 9216 : Y_AAK + 9216, Y_ZU = Y_TB + 9216, Y_YF = Y_AAB;
    static_assert(Y_ZU + NV * PT * 2 <= Y0 + 65536, "region Y");
    constexpr int Z0 = Y0 + 65536, Z_G = Z0, Z_S = FINAL ? Z0 + 8192 : Z0, Z_MISC = 152576, Z_BON = Z_MISC, Z_PC = Z_MISC + 256, Z_PAR = Z_MISC + 512, Z_XS = Y_ZU;
    static_assert(Z_S + NV * PT * 2 <= Z_MISC && Z_PAR + 832 * 4 <= LDSCTL_OFF, "region Z");
    LAS unsigned char* L = F.lds;
#define LB(off) ((LAS bf16*)(L + (off)))
#define LF(off) ((LAS float*)(L + (off)))
    {
        const int pidx = (w == 0) ? 5 : (w == 1) ? 7 : (w == 2) ? 9 : (w == 3) ? 10 : (w == 4) ? 11 : (w == 5) ? 12 : 13;
        if (w < 7) LF(Z_PAR)[w * 64 + (tid & 63)] = (INP(pidx) + layer * 512 + h * 64)[tid & 63];
        const float* mu = INP(3) + layer * 1792;
        for (int i = tid; i < 384; i += 512) LF(Z_PAR)[448 + i] = mu[(i < 64) ? (h * 64 + i) : (i < 128) ? (512 + h * 64 + (i - 64)) : (1536 + (i - 128))];
    }
    const bf16* WupT = (const bf16*)(F.ws + WS_LORA + (size_t)layer * LORA_STRIDE) + h * 64 * 64;
    const bf16* AupT = (const bf16*)(F.ws + WS_LORA + (size_t)layer * LORA_STRIDE + 65536) + h * 64 * 64;
    const bf16* GupT = (const bf16*)(F.ws + WS_LORA + (size_t)layer * LORA_STRIDE + 131072) + h * 64 * 128;
    const bf16* P = (const bf16*)(F.ws + WS_BIG); const bf16* vsrc = (const bf16*)(F.ws + (layer == 0 ? WS_VF : WS_VMIX));
    float* Nbuf = (float*)(F.ws + WS_ST_RW) + (size_t)u * 4096; bf16* MT = (bf16*)(F.ws + WS_MT) + (size_t)u * 4096;
    { IDS();
        if (w < 4) {
#pragma unroll
            for (int nt = 0; nt < 4; ++nt)
#pragma unroll
                for (int k2 = 0; k2 < 2; ++k2) { lfr[nt * 4 + k2] = *(const bf16x8*)(WupT + (size_t)(16 * nt + r16) * 64 + 32 * k2 + 8 * q4); lfr[nt * 4 + 2 + k2] = *(const bf16x8*)(AupT + (size_t)(16 * nt + r16) * 64 + 32 * k2 + 8 * q4); }
        } else if (FINAL) {
#pragma unroll
            for (int nt = 0; nt < 4; ++nt)
#pragma unroll
                for (int k4 = 0; k4 < 4; ++k4) lfr[nt * 4 + k4] = *(const bf16x8*)(GupT + (size_t)(16 * nt + r16) * 128 + 32 * k4 + 8 * q4);
        } }
    constexpr int NST = FINAL ? 2 : 4;
    f32x4 Sacc[NST];
    const int s_vb = FINAL ? (w & 3) : w;
#define S_CT(ti) (FINAL ? (2 * (w >> 2) + (ti)) : (ti))
    { IDS();
#pragma unroll
    for (int ti = 0; ti < NST; ++ti) {
        const int ct = S_CT(ti);
#pragma unroll
        for (int jj = 0; jj < 4; ++jj) { const int v = 16 * s_vb + 4 * q4 + jj, c = 16 * ct + r16;
            float x; if (FINAL) x = Nbuf[v * 64 + c]; else x = (v >= 64 && v - 64 == c) ? 1.f : 0.f;
            Sacc[ti][jj] = x; LB(Z_S)[v * PT + c] = (bf16)f2bf(x); }
    } }
    for (int j = 0; j < 4; ++j) {
        const int tl0 = sc * 256 + j * 64;
        {
            IDS();
            const int t = tl0 + tok; const size_t m = (size_t)b * T + t; const bf16* cur = P + m * PLD;
#pragma unroll
            for (int i = 0; i < 6; ++i) {
                const int col = (i == 0) ? (h * 64 + 8 * part) : (i == 1) ? (512 + h * 64 + 8 * part) : (i == 2) ? (1536 + 8 * part) : (i == 3) ? (1600 + 8 * part) : (1664 + 8 * part + (i - 4) * 64);
                float c[8], p[8]; unpack8(*(const u32x4*)(cur + col), c);
                if (t > 0) unpack8(*(const u32x4*)(cur - PLD + col), p); else {
#pragma unroll
                    for (int e = 0; e < 8; ++e) p[e] = 0.f; }
#pragma unroll
                for (int e = 0; e < 8; ++e) c[e] = c[e] + (p[e] - c[e]) * LF(Z_PAR)[448 + ((i < 4) ? 64 * i : 256 + 64 * (i - 4)) + 8 * part + e];
                if (i == 0) { st8f(LF(X_RF) + tok * 64 + 8 * part, c);
                } else if (i == 1) { st8f(LF(X_KF) + tok * 64 + 8 * part, c);
                } else if (i == 2) {
#pragma unroll
                    for (int e = 0; e < 8; ++e) c[e] = fast_tanh(c[e]);
                    *(LAS u32x4*)(LB(X_TW) + tok * PT + 8 * part) = pack8(c);
                } else if (i == 3) {
                    *(LAS u32x4*)(LB(X_XA) + tok * PT + 8 * part) = pack8(c);
                } else if (FINAL) {
#pragma unroll
                    for (int e = 0; e < 8; ++e) c[e] = sigm(c[e]);
                    *(LAS u32x4*)(LB(X_SG) + tok * PT2 + 8 * part + (i - 4) * 64) = pack8(c);
                }
            }
            float v[8]; unpack8(*(const u32x4*)(vsrc + m * 512 + h * 64 + 8 * part), v);
            st8f(LF(Y_VF) + tok * 64 + 8 * part, v);
        }
        __syncthreads();
        { IDS();
        if (w < 4) {
            const int rb = w;
            float inv[4], bs[4] = {0.f, 0.f, 0.f, 0.f};
            { float ss[4] = {0.f, 0.f, 0.f, 0.f};
#pragma unroll
                for (int nt = 0; nt < 4; ++nt) { const int c = 16 * nt + r16; const float kkc = LF(Z_PAR)[128 + c];
#pragma unroll
                    for (int jj = 0; jj < 4; ++jj) { const float kk = LF(X_KF)[(16 * rb + 4 * q4 + jj) * 64 + c] * kkc; ss[jj] += kk * kk; } }
#pragma unroll
                for (int jj = 0; jj < 4; ++jj) inv[jj] = __builtin_amdgcn_rsqf(fmaxf(redl16(ss[jj]), 1e-24f)); }
#pragma unroll
            for (int nt = 0; nt < 4; ++nt) {
                f32x4 aw = FZ4, aa = FZ4;
#pragma unroll
                for (int k2 = 0; k2 < 2; ++k2) { aw = mfma16(*(const LAS bf16x8*)(LB(X_TW) + (16 * rb + r16) * PT + 32 * k2 + 8 * q4), lfr[nt * 4 + k2], aw); aa = mfma16(*(const LAS bf16x8*)(LB(X_XA) + (16 * rb + r16) * PT + 32 * k2 + 8 * q4), lfr[nt * 4 + 2 + k2], aa); }
                const int c = 16 * nt + r16; const float w0c = LF(Z_PAR)[c], a0c = LF(Z_PAR)[64 + c], kkc = LF(Z_PAR)[128 + c], kac = LF(Z_PAR)[192 + c], rkc = LF(Z_PAR)[256 + c];
#pragma unroll
                for (int jj = 0; jj < 4; ++jj) { const int t = 16 * rb + 4 * q4 + jj, o = t * 64 + c;
                    LF(Y_L)[o] = -0.8750455979f * sigm(w0c + aw[jj]);
                    const float al = sigm(a0c + aa[jj]), kraw = LF(X_KF)[o], rr = LF(X_RF)[o], kn = kraw * kkc * inv[jj];
                    const float knew = kraw * (1.f + (al - 1.f) * kac);
                    LB(Y_A)[o] = (bf16)f2bf(-kn); LB(Y_B)[o] = (bf16)f2bf(kn * al); LB(Y_K)[o] = (bf16)f2bf(knew); LB(Y_R)[o] = (bf16)f2bf(rr);
                    bs[jj] += rr * knew * rkc; } }
#pragma unroll
            for (int jj = 0; jj < 4; ++jj) { const float sm = redl16(bs[jj]); if (r16 == 0) LF(Z_BON)[16 * rb + 4 * q4 + jj] = sm; }
        } else if (FINAL) {
            const int rb = w - 4;
#pragma unroll
            for (int nt = 0; nt < 4; ++nt) { f32x4 ag = FZ4;
#pragma unroll
                for (int k4 = 0; k4 < 4; ++k4) ag = mfma16(*(const LAS bf16x8*)(LB(X_SG) + (16 * rb + r16) * PT2 + 32 * k4 + 8 * q4), lfr[nt * 4 + k4], ag);
#pragma unroll
                for (int jj = 0; jj < 4; ++jj) LB(Z_G)[(16 * rb + 4 * q4 + jj) * 64 + 16 * nt + r16] = (bf16)f2bf(ag[jj]); }
        } }
        __syncthreads();
        if (w == 0) { IDS(); float run = 0.f;
#pragma unroll 8
            for (int t = 0; t < 64; ++t) { run += LF(Y_L)[t * 64 + lane]; LF(Y_L)[t * 64 + lane] = run; }
            LF(Z_PC)[lane] = ex2(run); }
        __syncthreads();
        {
            IDS(); const int t = tok, c0 = 8 * part;
            float Lt[8], Lp[8], Le[8], av[8], bv[8], kv[8], rv[8], vv[8], at[8], rt[8], bt[8], kt[8], bh[8], kh[8];
            ld8f(LF(Y_L) + t * 64 + c0, Lt); ld8f(LF(Y_L) + 63 * 64 + c0, Le); ld8f(LF(Y_VF) + t * 64 + c0, vv);
            if (t > 0) ld8f(LF(Y_L) + (t - 1) * 64 + c0, Lp); else {
#pragma unroll
                for (int e = 0; e < 8; ++e) Lp[e] = 0.f; }
            unpack8(*(const LAS u32x4*)(LB(Y_A) + t * 64 + c0), av); unpack8(*(const LAS u32x4*)(LB(Y_B) + t * 64 + c0), bv);
            unpack8(*(const LAS u32x4*)(LB(Y_K) + t * 64 + c0), kv); unpack8(*(const LAS u32x4*)(LB(Y_R) + t * 64 + c0), rv);
#pragma unroll
            for (int e = 0; e < 8; ++e) { const float eL = ex2(Lt[e]), eLm = ex2(Lp[e]), eN = ex2(-Lt[e]), eE = ex2(Le[e] - Lt[e]);
                at[e] = av[e] * eLm; rt[e] = rv[e] * eL; bt[e] = bv[e] * eN; kt[e] = kv[e] * eN; bh[e] = bv[e] * eE; kh[e] = kv[e] * eE; }
            tr_write8(LB(O_BH), PT, c0, t, bh, part); tr_write8(LB(O_KH), PT, c0, t, kh, part); tr_write8(LB(O_VT), PT, c0, t, vv, part);
            *(LAS u32x4*)(LB(O_AT) + t * PT + c0) = pack8(at); *(LAS u32x4*)(LB(O_RT) + t * PT + c0) = pack8(rt);
            *(LAS u32x4*)(LB(O_BT) + t * PT + c0) = pack8(bt); *(LAS u32x4*)(LB(O_KT) + t * PT + c0) = pack8(kt);
        }
        __syncthreads();
        {
            IDS(); const int rb = w & 3;
#pragma unroll
            for (int ci = 0; ci < 2; ++ci) { const int ct = 2 * (w >> 2) + ci;
                f32x4 ab = FZ4, ak = FZ4, arb = FZ4, ark = FZ4;
                if (ct <= rb) { ab = mm_ll<64>(LB(O_AT), PT, 16 * rb, LB(O_BT), PT, 16 * ct, FZ4, lane); ak = mm_ll<64>(LB(O_AT), PT, 16 * rb, LB(O_KT), PT, 16 * ct, FZ4, lane);
                    if (FINAL) { arb = mm_ll<64>(LB(O_RT), PT, 16 * rb, LB(O_BT), PT, 16 * ct, FZ4, lane); ark = mm_ll<64>(LB(O_RT), PT, 16 * rb, LB(O_KT), PT, 16 * ct, FZ4, lane); } }
#pragma unroll
                for (int jj = 0; jj < 4; ++jj) { const int t = 16 * rb + 4 * q4 + jj, i = 16 * ct + r16;
                    LF(Y_AAB)[t * PF + i] = (i < t) ? ab[jj] : 0.f; LB(Y_AAK)[t * PT + i] = (bf16)f2bf((i < t) ? ak[jj] : 0.f);
                    if (FINAL) { LB(Y_ARB)[t * PT + i] = (bf16)f2bf((i <= t) ? arb[jj] : 0.f); LB(Y_ARK)[t * PT + i] = (bf16)f2bf((i <= t) ? ark[jj] : 0.f); } } }
        }
        __syncthreads();
        { IDS(); for (int i = ft; i < 64 * PF; i += 512) LF(O_TF)[i] = 0.f; }
        __syncthreads();
        if (w == 0) { IDS(); const int blk = lane >> 4, col = lane & 15; float x[16];
#pragma unroll
            for (int i = 0; i < 16; ++i) x[i] = (i == col) ? 1.f : 0.f;
#pragma unroll
            for (int i = 1; i < 16; ++i) { float s = 0.f; asm volatile("" ::: "memory");
#pragma unroll
                for (int m2 = 0; m2 < i; ++m2) s += LF(Y_AAB)[(16 * blk + i) * PF + 16 * blk + m2] * x[m2];
                x[i] += s; }
#pragma unroll
            for (int i = 0; i < 16; ++i) LF(O_TF)[(16 * blk + i) * PF + 16 * blk + col] = x[i]; }
        __syncthreads();
        { IDS(); const int p = ft >> 8, i = (ft >> 4) & 15, jx = ft & 15; float s = 0.f;
#pragma unroll
            for (int m4 = 0; m4 < 4; ++m4) { const f32x4 a = *(const LAS f32x4*)(LF(Y_AAB) + (32 * p + 16 + i) * PF + 32 * p + 4 * m4);
#pragma unroll
                for (int e = 0; e < 4; ++e) s += a[e] * LF(O_TF)[(32 * p + 4 * m4 + e) * PF + 32 * p + jx]; }
            LF(Z_XS)[p * 256 + i * 16 + jx] = s; }
        __syncthreads();
        { IDS(); const int p = ft >> 8, i = (ft >> 4) & 15, jx = ft & 15; float s = 0.f;
#pragma unroll
            for (int m4 = 0; m4 < 4; ++m4) { const f32x4 a = *(const LAS f32x4*)(LF(O_TF) + (32 * p + 16 + i) * PF + 32 * p + 16 + 4 * m4);
#pragma unroll
                for (int e = 0; e < 4; ++e) s += a[e] * LF(Z_XS)[p * 256 + (4 * m4 + e) * 16 + jx]; }
            LF(O_TF)[(32 * p + 16 + i) * PF + 32 * p + jx] = s; }
        __syncthreads();
        { IDS(); const int i = ft >> 4, j0 = (ft & 15) * 2; float s0 = 0.f, s1 = 0.f;
#pragma unroll
            for (int m4 = 0; m4 < 8; ++m4) { const f32x4 a = *(const LAS f32x4*)(LF(Y_AAB) + (32 + i) * PF + 4 * m4);
#pragma unroll
                for (int e = 0; e < 4; ++e) { const f32x2 bv = *(const LAS f32x2*)(LF(O_TF) + (4 * m4 + e) * PF + j0); s0 += a[e] * bv.x; s1 += a[e] * bv.y; } }
            LF(Z_XS)[i * 33 + j0] = s0; LF(Z_XS)[i * 33 + j0 + 1] = s1; }
        __syncthreads();
        { IDS(); const int i = ft >> 4, j0 = (ft & 15) * 2; float s0 = 0.f, s1 = 0.f;
#pragma unroll
            for (int m4 = 0; m4 < 8; ++m4) { const f32x4 a = *(const LAS f32x4*)(LF(O_TF) + (32 + i) * PF + 32 + 4 * m4);
#pragma unroll
                for (int e = 0; e < 4; ++e) { s0 += a[e] * LF(Z_XS)[(4 * m4 + e) * 33 + j0]; s1 += a[e] * LF(Z_XS)[(4 * m4 + e) * 33 + j0 + 1]; } }
            LF(O_TF)[(32 + i) * PF + j0] = s0; LF(O_TF)[(32 + i) * PF + j0 + 1] = s1; }
        __syncthreads();
        { IDS(); const int t = tok, i0 = 8 * part; float o[8];
#pragma unroll
            for (int e = 0; e < 8; ++e) o[e] = LF(O_TF)[t * PF + i0 + e];
            *(LAS u32x4*)(LB(Y_TB) + t * PT + i0) = pack8(o); }
        __syncthreads();
        {
            IDS(); const int rb = w & 3;
            f32x4 uu[NZ];
#pragma unroll
            for (int ci = 0; ci < NZ; ++ci) { const int vt = (w >> 2) * NZ + ci;
                f32x4 z = mm_ll<64>(LB(O_AT), PT, 16 * rb, LB(Z_S), PT, 16 * vt, FZ4, lane);
                if (vt < 4) z = mm_ll<64, false, true>(LB(Y_AAK), PT, 16 * rb, LB(O_VT), PT, 16 * vt, z, lane);
                st4bf(LB(Y_ZU) + (16 * vt + r16) * PT + 16 * rb + 4 * q4, z); }
            __syncthreads();
#pragma unroll
            for (int ci = 0; ci < NZ; ++ci) { const int vt = (w >> 2) * NZ + ci; uu[ci] = mm_ll<64>(LB(Y_TB), PT, 16 * rb, LB(Y_ZU), PT, 16 * vt, FZ4, lane); }
            __syncthreads();
#pragma unroll
            for (int ci = 0; ci < NZ; ++ci) { const int vt = (w >> 2) * NZ + ci; st4bf(LB(Y_ZU) + (16 * vt + r16) * PT + 16 * rb + 4 * q4, uu[ci]); }
        }
        __syncthreads();
        {
            IDS(); f32x4 yy[2];
            if (FINAL) { const int rb = w & 3;
#pragma unroll
                for (int ci = 0; ci < 2; ++ci) { const int ct = 2 * (w >> 2) + ci;
                    f32x4 y = mm_ll<64>(LB(O_RT), PT, 16 * rb, LB(Z_S), PT, 16 * ct, FZ4, lane);
                    y = mm_ll<64>(LB(Y_ARB), PT, 16 * rb, LB(Y_ZU), PT, 16 * ct, y, lane);
                    yy[ci] = mm_ll<64, false, true>(LB(Y_ARK), PT, 16 * rb, LB(O_VT), PT, 16 * ct, y, lane); } }
#pragma unroll
            for (int ti = 0; ti < NST; ++ti) { const int ct = S_CT(ti); const float pc = LF(Z_PC)[16 * ct + r16];
                f32x4 s = Sacc[ti] * pc;
                s = mm_ll<64, false, true>(LB(Y_ZU), PT, 16 * s_vb, LB(O_BH), PT, 16 * ct, s, lane);
                if (s_vb < 4) s = mm_ll<64, true, true>(LB(O_VT), PT, 16 * s_vb, LB(O_KH), PT, 16 * ct, s, lane);
                Sacc[ti] = s; }
            __syncthreads();
#pragma unroll
            for (int ti = 0; ti < NST; ++ti) { const int ct = S_CT(ti);
#pragma unroll
                for (int jj = 0; jj < 4; ++jj) LB(Z_S)[(16 * s_vb + 4 * q4 + jj) * PT + 16 * ct + r16] = (bf16)f2bf(Sacc[ti][jj]); }
            if (FINAL) { const int rb = w & 3;
#pragma unroll
                for (int ci = 0; ci < 2; ++ci) { const int ct = 2 * (w >> 2) + ci;
#pragma unroll
                    for (int jj = 0; jj < 4; ++jj) LF(Y_YF)[(16 * rb + 4 * q4 + jj) * PF + 16 * ct + r16] = yy[ci][jj]; } }
        }
        __syncthreads();
        if (FINAL) {
            IDS();
            const int t = tok, c0 = 8 * part; const size_t m = (size_t)b * T + tl0 + t;
            float y[8], gg[8], sm = 0.f; ld8f(LF(Y_YF) + t * PF + c0, y); unpack8(*(const LAS u32x4*)(LB(Z_G) + t * 64 + c0), gg);
#pragma unroll
            for (int e = 0; e < 8; ++e) sm += y[e];
            const float mean = red8(sm) * (1.f / 64.f); float vs = 0.f;
#pragma unroll
            for (int e = 0; e < 8; ++e) { y[e] -= mean; vs += y[e] * y[e]; }
            const float rs = __builtin_amdgcn_rsqf(red8(vs) * (1.f / 64.f) + 64e-5f), bo = LF(Z_BON)[t];
#pragma unroll
            for (int e = 0; e < 8; ++e) { const int c = c0 + e; y[e] = (y[e] * rs * LF(Z_PAR)[320 + c] + LF(Z_PAR)[384 + c] + bo * tr_at(LB(O_VT), PT, c, t)) * gg[e]; }
            *(u32x4*)((bf16*)(F.ws + WS_BIG) + m * PLD + 1024 + h * 64 + c0) = pack8(y);
        }
        __syncthreads();
    }
    if (!FINAL) { IDS();
#pragma unroll
        for (int ti = 0; ti < NST; ++ti) { const int ct = S_CT(ti);
            if (s_vb < 4) {
#pragma unroll
                for (int jj = 0; jj < 4; ++jj) Nbuf[(16 * s_vb + 4 * q4 + jj) * 64 + 16 * ct + r16] = Sacc[ti][jj];
            } else { u32x2 wv; wv.x = pk2(Sacc[ti][0], Sacc[ti][1]); wv.y = pk2(Sacc[ti][2], Sacc[ti][3]);
                *(u32x2*)(MT + (16 * ct + r16) * 64 + 16 * (s_vb - 4) + 4 * q4) = wv; }
        }
    }
#undef IDS
#undef S_CT
#undef LB
#undef LF
}

template <bool FINAL>
__device__ __forceinline__ void ret_chunk_unit(Frame& F, int u) {
    const int tid = otid(), lane = tid & 63, w = __builtin_amdgcn_readfirstlane(tid >> 6), r16 = lane & 15, q4 = lane >> 4;
    const int b = u >> 9, sc = (u >> 3) & 63, h = u & 7;
    constexpr int R_QB = 0, R_KB = 9216, R_KHT = 18432, R_VT = 27648, R_GB = 36864, R_AB = 45056, R_SB = 54272, R_YF = 63488;
    LAS unsigned char* L = F.lds;
#define LB(off) ((LAS bf16*)(L + (off)))
#define LF(off) ((LAS float*)(L + (off)))
    bf16* P = (bf16*)(F.ws + WS_BIG);
    float* Sbuf = (float*)(F.ws + WS_ST_RET) + (size_t)u * 4096;
    const float lg = log2f(1.f - exp2f(-5.f - (float)h));
    const float g64 = ex2(64.f * lg);
    const int db = w & 3;
    f32x4 Sacc[2];
#pragma unroll
    for (int ci = 0; ci < 2; ++ci) { const int et = 2 * (w >> 2) + ci;
#pragma unroll
        for (int jj = 0; jj < 4; ++jj) Sacc[ci][jj] = FINAL ? Sbuf[(16 * db + 4 * q4 + jj) * 64 + 16 * et + r16] : 0.f;
        if (FINAL) st4bf(LB(R_SB) + (16 * et + r16) * PT + 16 * db + 4 * q4, Sacc[ci]); }
    const int tok = tid >> 3, part = tid & 7;
    for (int j = 0; j < 4; ++j) {
        const int tl0 = sc * 256 + j * 64;
        {
            const int t = tl0 + tok; const size_t m = (size_t)b * T + t; const bf16* row = P + m * PLD + C_RET + h * 64 + 8 * part;
            float qv[8], kv[8], vv[8]; unpack8(*(const u32x4*)(row + 512), kv); unpack8(*(const u32x4*)(row + 1024), vv);
            if (FINAL) { unpack8(*(const u32x4*)row, qv); *(LAS u32x4*)(LB(R_GB) + tok * 64 + 8 * part) = *(const u32x4*)(row + 1536); }
            const float zeta = ex2((float)(63 - tok) * lg);
            if (FINAL) { *(LAS u32x4*)(LB(R_QB) + tok * PT + 8 * part) = pack8(qv); *(LAS u32x4*)(LB(R_KB) + tok * PT + 8 * part) = pack8(kv); }
            float kz[8];
#pragma unroll
            for (int e = 0; e < 8; ++e) kz[e] = kv[e] * zeta;
            tr_write8(LB(R_KHT), PT, 8 * part, tok, kz, part); tr_write8(LB(R_VT), PT, 8 * part, tok, vv, part);
        }
        __syncthreads();
        if (FINAL) { const int rb = w & 3;
#pragma unroll
            for (int ci = 0; ci < 2; ++ci) { const int ct = 2 * (w >> 2) + ci; f32x4 a = FZ4;
                if (ct <= rb) a = mm_ll<64>(LB(R_QB), PT, 16 * rb, LB(R_KB), PT, 16 * ct, FZ4, lane);
#pragma unroll
                for (int jj = 0; jj < 4; ++jj) { const int l = 16 * rb + 4 * q4 + jj, s = 16 * ct + r16; LB(R_AB)[l * PT + s] = (bf16)f2bf((s <= l) ? a[jj] * ex2((float)(l - s) * lg) : 0.f); } }
            __syncthreads();
        }
        {
            f32x4 yy[2];
            if (FINAL) { const int rb = w & 3;
#pragma unroll
                for (int ci = 0; ci < 2; ++ci) { const int et = 2 * (w >> 2) + ci;
                    const f32x4 a1 = mm_ll<64, false, true>(LB(R_AB), PT, 16 * rb, LB(R_VT), PT, 16 * et, FZ4, lane), a2 = mm_ll<64>(LB(R_QB), PT, 16 * rb, LB(R_SB), PT, 16 * et, FZ4, lane);
#pragma unroll
                    for (int jj = 0; jj < 4; ++jj) yy[ci][jj] = a1[jj] + ex2((float)(16 * rb + 4 * q4 + jj + 1) * lg) * a2[jj]; } }
#pragma unroll
            for (int ci = 0; ci < 2; ++ci) { const int et = 2 * (w >> 2) + ci; Sacc[ci] = mm_ll<64, true, true>(LB(R_KHT), PT, 16 * db, LB(R_VT), PT, 16 * et, Sacc[ci] * g64, lane); }
            __syncthreads();
            if (FINAL) { const int rb = w & 3;
#pragma unroll
                for (int ci = 0; ci < 2; ++ci) { const int et = 2 * (w >> 2) + ci; st4bf(LB(R_SB) + (16 * et + r16) * PT + 16 * db + 4 * q4, Sacc[ci]);
#pragma unroll
                    for (int jj = 0; jj < 4; ++jj) LF(R_YF)[(16 * rb + 4 * q4 + jj) * PF + 16 * et + r16] = yy[ci][jj]; } }
        }
        __syncthreads();
        if (FINAL) { const size_t m = (size_t)b * T + tl0 + tok; float y[8], g[8], ss = 0.f;
            ld8f(LF(R_YF) + tok * PF + 8 * part, y);
#pragma unroll
            for (int e = 0; e < 8; ++e) ss += y[e] * y[e];
            const float rs = __builtin_amdgcn_rsqf(red8(ss) * (1.f / 64.f) + 1e-6f);
            unpack8(*(const LAS u32x4*)(LB(R_GB) + tok * 64 + 8 * part), g);
#pragma unroll
            for (int e = 0; e < 8; ++e) y[e] = y[e] * rs * silu(g[e]);
            *(u32x4*)(P + m * PLD + C_RETG + h * 64 + 8 * part) = pack8(y);
            __syncthreads(); }
    }
    if (!FINAL) {
#pragma unroll
        for (int ci = 0; ci < 2; ++ci) { const int et = 2 * (w >> 2) + ci;
#pragma unroll
            for (int jj = 0; jj < 4; ++jj) Sbuf[(16 * db + 4 * q4 + jj) * 64 + 16 * et + r16] = Sacc[ci][jj]; }
    }
#undef LB
#undef LF
}

template <bool FINAL>
__device__ __forceinline__ void ssd_chunk_unit(Frame& F, int layer, int u) {
    const int tid = otid(), w = __builtin_amdgcn_readfirstlane(tid >> 6);
#define IDS() const int ft = fresh_tid(tid); const int lane = ft & 63, r16 = lane & 15, q4 = lane >> 4; (void)lane; (void)r16; (void)q4
    const int b = u >> 9, sc = (u >> 3) & 63, h = u & 7, g = h >> 2;
    constexpr int D_CB = 0, D_BB = 17408, D_BT = 34816, D_YF = 53248, D_XT = 70656, D_XDT = 79872, D_GM = 89088, D_SB = 98304, D_MISC = 115712;
    constexpr int D_DTS = D_MISC, D_ACS = D_MISC + 256, D_CAR = D_MISC + 512;
    LAS unsigned char* L = F.lds;
#define LB(off) ((LAS bf16*)(L + (off)))
#define LF(off) ((LAS float*)(L + (off)))
    bf16* P = (bf16*)(F.ws + WS_BIG); const float* dtb = (const float*)(F.ws + WS_DT);
    const bf16* BND = (const bf16*)(F.ws + WS_BND);
    float* Sbuf = (float*)(F.ws + WS_ST_SSD) + (size_t)u * 8192;
    const float* cw = INP(17) + layer * 1024 * 4; const float* cbias = INP(18) + layer * 1024;
    const float dt_bias = INP(19)[layer * 8 + h], A = -expf(INP(20)[layer * 8 + h]), Dh = INP(21)[layer * 8 + h];
    const int bc_chunk = tid & 31, bc_chn = (bc_chunk < 16) ? (512 + g * 128 + bc_chunk * 8) : (768 + g * 128 + (bc_chunk - 16) * 8);
    const int x_chunk = tid & 7, x_chn = h * 64 + x_chunk * 8;
    const int pb = w & 3;
    f32x4 Sacc[4];
    { IDS();
#pragma unroll
    for (int ci = 0; ci < 4; ++ci) { const int nt = 4 * (w >> 2) + ci;
#pragma unroll
        for (int jj = 0; jj < 4; ++jj) { const float x = FINAL ? Sbuf[(16 * pb + 4 * q4 + jj) * 128 + 16 * nt + r16] : 0.f; Sacc[ci][jj] = x;
            if (FINAL) LB(D_SB)[(16 * pb + 4 * q4 + jj) * PT2 + 16 * nt + r16] = (bf16)f2bf(x); } } }
    float dstot = 0.f;
    for (int j = 0; j < 4; ++j) {
        const int tl0 = sc * 256 + j * 64; const size_t m0 = (size_t)b * T + tl0;
        if (w == 0) {
            IDS(); const float dt = softplus_acc(dtb[(m0 + lane) * 8 + h] + dt_bias); float a = A * dt;
#pragma unroll
            for (int o = 1; o < 64; o <<= 1) { const float n = __shfl_up(a, o); if (lane >= o) a += n; }
            LF(D_DTS)[lane] = dt; LF(D_ACS)[lane] = a;
        }
        {
            IDS();
#pragma unroll
            for (int it = 0; it < 4; ++it) { const int t = it * 16 + (ft >> 5); const int ta = tl0 + t;
                float acc[8]; unpack8(*(const u32x4*)(P + (m0 + t) * PLD + C_XBC + bc_chn), acc); (void)ta;
                if (bc_chunk < 16) { *(LAS u32x4*)(LB(D_BB) + t * PT2 + bc_chunk * 8) = pack8(acc); tr_write8(LB(D_BT), PT, bc_chunk * 8, t, acc, bc_chunk & 7); }
                else *(LAS u32x4*)(LB(D_CB) + t * PT2 + (bc_chunk - 16) * 8) = pack8(acc);
            }
        }
        __syncthreads();
        {
            IDS(); const int t = ft >> 3; float acc[8]; unpack8(*(const u32x4*)(P + (m0 + t) * PLD + C_XBC + x_chn), acc);
            const float sc_d = LF(D_DTS)[t] * __expf(LF(D_ACS)[63] - LF(D_ACS)[t]);
            float xs8[8], xd8[8];
#pragma unroll
            for (int e = 0; e < 8; ++e) { xs8[e] = acc[e]; xd8[e] = acc[e] * sc_d; }
            tr_write8(LB(D_XT), PT, x_chunk * 8, t, xs8, x_chunk); tr_write8(LB(D_XDT), PT, x_chunk * 8, t, xd8, x_chunk);
        }
        if (FINAL) { IDS(); const int rb = w & 3;
#pragma unroll
            for (int ci = 0; ci < 2; ++ci) { const int ct = 2 * (w >> 2) + ci; f32x4 a = FZ4;
                if (ct <= rb) a = mm_ll<128>(LB(D_CB), PT2, 16 * rb, LB(D_BB), PT2, 16 * ct, FZ4, lane);
#pragma unroll
                for (int jj = 0; jj < 4; ++jj) { const int l = 16 * rb + 4 * q4 + jj, s = 16 * ct + r16;
                    LB(D_GM)[l * PT + s] = (bf16)f2bf((s <= l) ? a[jj] * __expf(LF(D_ACS)[l] - LF(D_ACS)[s]) * LF(D_DTS)[s] : 0.f); } } }
        __syncthreads();
        {
            IDS(); f32x4 yy[2];
            if (FINAL) { const int rb = w & 3;
#pragma unroll
                for (int ci = 0; ci < 2; ++ci) { const int pt = 2 * (w >> 2) + ci;
                    const f32x4 a1 = mm_ll<64, false, true>(LB(D_GM), PT, 16 * rb, LB(D_XT), PT, 16 * pt, FZ4, lane), a2 = mm_ll<128>(LB(D_CB), PT2, 16 * rb, LB(D_SB), PT2, 16 * pt, FZ4, lane);
#pragma unroll
                    for (int jj = 0; jj < 4; ++jj) { const int l = 16 * rb + 4 * q4 + jj, p = 16 * pt + r16; yy[ci][jj] = a1[jj] + __expf(LF(D_ACS)[l]) * a2[jj] + Dh * tr_at(LB(D_XT), PT, p, l); } } }
            const float dec = expf(LF(D_ACS)[63]);
#pragma unroll
            for (int ci = 0; ci < 4; ++ci) { const int nt = 4 * (w >> 2) + ci; Sacc[ci] = mm_ll<64, true, true>(LB(D_XDT), PT, 16 * pb, LB(D_BT), PT, 16 * nt, Sacc[ci] * dec, lane); }
            dstot += LF(D_ACS)[63];
            __syncthreads();
            if (FINAL) { const int rb = w & 3;
#pragma unroll
                for (int ci = 0; ci < 4; ++ci) { const int nt = 4 * (w >> 2) + ci;
#pragma unroll
                    for (int jj = 0; jj < 4; ++jj) LB(D_SB)[(16 * pb + 4 * q4 + jj) * PT2 + 16 * nt + r16] = (bf16)f2bf(Sacc[ci][jj]); }
#pragma unroll
                for (int ci = 0; ci < 2; ++ci) { const int pt = 2 * (w >> 2) + ci;
#pragma unroll
                    for (int jj = 0; jj < 4; ++jj) LF(D_YF)[(16 * rb + 4 * q4 + jj) * PF + 16 * pt + r16] = yy[ci][jj]; } }
        }
        __syncthreads();
        if (FINAL) { IDS(); const int tok = ft >> 3, part = ft & 7; float y[8];
            ld8f(LF(D_YF) + tok * PF + 8 * part, y);
            *(u32x4*)(P + (m0 + tok) * PLD + C_XBC + h * 64 + 8 * part) = pack8(y);
            __syncthreads(); }
    }
    if (!FINAL) { IDS();
#pragma unroll
        for (int ci = 0; ci < 4; ++ci) { const int nt = 4 * (w >> 2) + ci;
#pragma unroll
            for (int jj = 0; jj < 4; ++jj) Sbuf[(16 * pb + 4 * q4 + jj) * 128 + 16 * nt + r16] = Sacc[ci][jj]; }
        if (tid == 0) ((float*)(F.ws + WS_DSTOT))[u] = dstot;
    }
#undef IDS
#undef LB
#undef LF
}

__device__ __forceinline__ void rwkv_scan_chain(Frame& F, int chain) {
    const int tid = otid(), lane = tid & 63, w = __builtin_amdgcn_readfirstlane(tid >> 6), r16 = lane & 15, q4 = lane >> 4;
    const int b = chain >> 3, h = chain & 7, vb = w & 3, ct0 = 2 * (w >> 2);
    LAS bf16* SB = (LAS bf16*)F.lds;
    f32x4 Sacc[2] = {FZ4, FZ4};
    for (int i = tid; i < 64 * PT / 2; i += 512) ((LAS unsigned*)SB)[i] = 0u;
    f32x4 nv[2]; bf16x8 mf[2][2];
    auto fetch = [&](int sc) {
        const int u = (b * 64 + sc) * 8 + h;
        const float* Nb = (const float*)(F.ws + WS_ST_RW) + (size_t)u * 4096; const bf16* MT = (const bf16*)(F.ws + WS_MT) + (size_t)u * 4096;
#pragma unroll
        for (int ci = 0; ci < 2; ++ci) {
#pragma unroll
            for (int jj = 0; jj < 4; ++jj) nv[ci][jj] = Nb[(16 * vb + 4 * q4 + jj) * 64 + 16 * (ct0 + ci) + r16];
#pragma unroll
            for (int k2 = 0; k2 < 2; ++k2) mf[ci][k2] = *(const bf16x8*)(MT + (size_t)(16 * (ct0 + ci) + r16) * 64 + 32 * k2 + 8 * q4); } };
    fetch(0);
    __syncthreads();
    for (int sc = 0; sc < 64; ++sc) {
        const int u = (b * 64 + sc) * 8 + h;
        float* Nb = (float*)(F.ws + WS_ST_RW) + (size_t)u * 4096;
        f32x4 nw[2];
#pragma unroll
        for (int ci = 0; ci < 2; ++ci) {
            f32x4 a = nv[ci];
#pragma unroll
            for (int k2 = 0; k2 < 2; ++k2) a = mfma16(*(const LAS bf16x8*)(SB + (16 * vb + r16) * PT + 32 * k2 + 8 * q4), mf[ci][k2], a);
            nw[ci] = a;
#pragma unroll
            for (int jj = 0; jj < 4; ++jj) Nb[(16 * vb + 4 * q4 + jj) * 64 + 16 * (ct0 + ci) + r16] = Sacc[ci][jj]; }
        if (sc + 1 < 64) fetch(sc + 1);
        __syncthreads();
#pragma unroll
        for (int ci = 0; ci < 2; ++ci) { Sacc[ci] = nw[ci];
#pragma unroll
            for (int jj = 0; jj < 4; ++jj) SB[(16 * vb + 4 * q4 + jj) * PT + 16 * (ct0 + ci) + r16] = (bf16)f2bf(nw[ci][jj]); }
        __syncthreads();
    }
}
__device__ __forceinline__ void elem_scans(Frame& F, int blk, int nblk) {
    const int tid = otid();
    const int NRET = 16 * 4096, NSSD = 16 * 8192;
    const float* dst = (const float*)(F.ws + WS_DSTOT);
    for (int it = blk * 512 + tid; it < NRET + NSSD; it += nblk * 512) {
        if (it < NRET) { const int chain = it >> 12, e = it & 4095, b = chain >> 3, h = chain & 7;
            const float g256 = exp2f(256.f * log2f(1.f - exp2f(-5.f - (float)h)));
            float* p = (float*)(F.ws + WS_ST_RET) + ((size_t)(b * 64) * 8 + h) * 4096 + e; float carry = 0.f;
#pragma unroll 8
            for (int sc = 0; sc < 64; ++sc) { const float t = p[(size_t)sc * 8 * 4096]; p[(size_t)sc * 8 * 4096] = carry; carry = g256 * carry + t; }
        } else { const int i2 = it - NRET, chain = i2 >> 13, e = i2 & 8191, b = chain >> 3, h = chain & 7;
            float* p = (float*)(F.ws + WS_ST_SSD) + ((size_t)(b * 64) * 8 + h) * 8192 + e; const float* d = dst + (b * 64) * 8 + h; float carry = 0.f;
#pragma unroll 8
            for (int sc = 0; sc < 64; ++sc) { const float t = p[(size_t)sc * 8 * 8192]; p[(size_t)sc * 8 * 8192] = carry; carry = expf(d[sc * 8]) * carry + t; }
        }
    }
}
__device__ __forceinline__ void conv_lora(Frame& F) {
    const int tid = otid();
    for (int l = 0; l < 2; ++l) {
        bf16* base = (bf16*)(F.ws + WS_LORA + (size_t)l * LORA_STRIDE);
        const float* wu = INP(4) + l * 64 * 512; const float* au = INP(6) + l * 64 * 512; const float* gu = INP(8) + l * 128 * 512;
        for (int i = F.vcu * 512 + tid; i < 512 * 64; i += F.G * 512) { const int c = i >> 6, jx = i & 63; base[i] = (bf16)f2bf(wu[jx * 512 + c]); base[32768 + i] = (bf16)f2bf(au[jx * 512 + c]); }
        for (int i = F.vcu * 512 + tid; i < 512 * 128; i += F.G * 512) { const int c = i >> 7, jx = i & 127; base[65536 + i] = (bf16)f2bf(gu[jx * 512 + c]); }
    }
}
__device__ __forceinline__ void conv_vlora(Frame& F) {
    const int tid = otid();
    bf16* vdT = (bf16*)(F.ws + WS_VLORA); bf16* vuT = vdT + 32 * 512;
    const float* vdn = INP(14); const float* vup = INP(15);
    for (int i = F.vcu * 512 + tid; i < 32 * 512; i += F.G * 512) { const int j = i >> 9, c = i & 511; vdT[i] = (bf16)f2bf(vdn[c * 32 + j]); }
    for (int i = F.vcu * 512 + tid; i < 512 * 32; i += F.G * 512) { const int c = i >> 5, j = i & 31; vuT[i] = (bf16)f2bf(vup[j * 512 + c]); }
}
__device__ __forceinline__ void save_bnd(Frame& F) {
    const int tid = otid();
    const bf16* P = (const bf16*)(F.ws + WS_BIG); bf16* BND = (bf16*)(F.ws + WS_BND);
    for (int i = F.vcu * 512 + tid; i < 2 * 64 * 3 * 64; i += F.G * 512) { const int ch = i & 63, k = (i >> 6) % 3, bs = i / 192, b = bs >> 6, sc = bs & 63;
        if (sc > 0) *(u32x4*)(BND + (size_t)(bs * 3 + k) * 512 + ch * 8) = *(const u32x4*)(P + ((size_t)b * T + sc * 256 - 3 + k) * PLD + C_XBC + ch * 8); }
}

constexpr int LAYER_BASE0 = 1, LAYER_STRIDE = 18, MOE_BASE = LAYER_BASE0 + LAYER_STRIDE + 15;
__device__ __forceinline__ Frame lf(const Frame& F0) {
    Frame F = F0; unsigned l = (unsigned)(unsigned long long)F.lds;
    asm volatile("" : "+s"(l), "+s"(F.vcu), "+s"(F.G), "+s"(F.cid), "+s"(F.wid), "+s"(F.out), "+s"(F.ws));
    F.lds = (LAS unsigned char*)(unsigned long long)l; return F;
}
__global__ void __launch_bounds__(512, 2) fwd(Args args) {
    extern __shared__ __attribute__((aligned(16))) unsigned char lds_raw[];
    Frame F0;
    F0.lds = (LAS unsigned char*)lds_raw;
    F0.G = gridDim.x; { const int bx = blockIdx.x; F0.vcu = (F0.G % 8 == 0) ? (bx % 8) * (F0.G / 8) + bx / 8 : bx; }
    F0.cid = blockIdx.x; F0.out = args.out; F0.ws = args.ws; F0.wid = __builtin_amdgcn_readfirstlane(threadIdx.x >> 6);
    volatile LAS unsigned* MISC = (volatile LAS unsigned*)(F0.lds + MISC_OFF);
    for (int u = threadIdx.x; u < (LDS_BYTES - LDSCTL_OFF) / 4; u += 512) ((LAS unsigned*)(F0.lds + LDSCTL_OFF))[u] = 0u;
    __syncthreads();
    if (threadIdx.x < 34) *(LAS unsigned long long*)(F0.lds + LDSCTL_OFF + 8 * threadIdx.x) = (unsigned long long)args.in[threadIdx.x];
    __syncthreads();
    const int lo = args.ph_lo, hi = args.ph_hi;
    XcdBarrier bar; bar.bar = (unsigned*)(F0.ws + WS_CTL); bar.x = 0; bar.st = nullptr;
    if (hi - lo > 1) bar = xcd_barrier_post((unsigned*)(F0.ws + WS_CTL), MISC + 8);
#define IN(k) (lo <= (k) && (k) < hi)
#define SEAM(k) do { if (IN(k) && IN((k) + 1)) xcd_barrier(bar); } while (0)
#define WSP(T_, off) ((T_*)(F.ws + (off)))

    if (IN(0)) { for (int rep = 0; rep <= REP_CONV; ++rep) { Frame F = lf(F0); conv_layer_weights(F, 0); conv_layer_weights(F, 1); conv_ffn_weights(F); conv_lora(F); conv_vlora(F); }
        for (int rep = 0; rep <= REP_MISC; ++rep) { Frame F = lf(F0); xprep_phase(F, INP(0)); } }
    SEAM(0);
    for (int l = 0; l < 2; ++l) {
        const int pb = LAYER_BASE0 + l * LAYER_STRIDE;
        if (IN(pb + 0)) {
            Frame F = lf(F0); unsigned char* wl = F.ws + WS_W + (size_t)l * WL_STRIDE;
            pg8::Gemm g{WSP(bf16, WS_XB), (const bf16*)(wl + WL_IN), D, D, D}; pg8::StaticOrder S; S.init(M, NP, F.G, F.cid, D, D);
            pg8::EpiInProj E{WSP(bf16, WS_BIG), WSP(float, WS_RSTD), WSP(float, WS_DT)};
            pg8::gemm_phase(F.lds, F.wid, g, S, E);
        }
        SEAM(pb + 0);
        if (IN(pb + 1)) { Frame F = lf(F0); vprep_phase(F, l); prepass_a(F); }
        SEAM(pb + 1);
        if (IN(pb + 2)) { Frame F = lf(F0); prepass_conv(F, l); }
        if (IN(pb + 2) && IN(pb + 3)) xcd_barrier(bar);
        if (IN(pb + 3)) for (int rep = 0; rep <= REP_R1; ++rep) {
#if RW_CH
            for (int r2 = 0; r2 <= REP_RW; ++r2) { Frame F = lf(F0); for (int u = F.cid; u < 1024; u += F.G) rwkv_chunk_unit<false>(F, l, u); }
#else
            { Frame F = lf(F0); if (F.cid < 16) rwkv_seq(F, l, F.cid); }
#endif
#if RET_CH
            for (int r2 = 0; r2 <= REP_RET; ++r2) { Frame F = lf(F0); for (int u = F.cid; u < 1024; u += F.G) ret_chunk_unit<false>(F, u); }
#else
            { Frame F = lf(F0); if (F.cid >= 32 && F.cid < 48) ret_seq(F, F.cid - 32); }
#endif
#if SSD_CH
            for (int r2 = 0; r2 <= REP_SSD; ++r2) { Frame F = lf(F0); for (int u = F.cid; u < 1024; u += F.G) ssd_chunk_unit<false>(F, l, u); }
#else
            { Frame F = lf(F0); if (F.cid >= 16 && F.cid < 32) ssd_seq(F, l, F.cid - 16); }
#endif
        }
        SEAM(pb + 3);
        if (IN(pb + 4)) {
            Frame F = lf(F0);
            if (F.cid < 16) { if (RW_CH) rwkv_scan_chain(F, F.cid); }
            else elem_scans(F, F.cid - 16, F.G - 16);
        }
        SEAM(pb + 4);
        if (IN(pb + 5)) {
#if RW_CH
            { Frame F = lf(F0); for (int u = F.cid; u < 1024; u += F.G) rwkv_chunk_unit<true>(F, l, u); }
#endif
#if RET_CH
            { Frame F = lf(F0); for (int u = F.cid; u < 1024; u += F.G) ret_chunk_unit<true>(F, u); }
#endif
#if SSD_CH
            { Frame F = lf(F0); for (int u = F.cid; u < 1024; u += F.G) ssd_chunk_unit<true>(F, l, u); }
#endif
        }
        SEAM(pb + 5);
        if (IN(pb + 6)) { Frame F = lf(F0); ssm_norm_phase(F, l); xprep_phase(F, (l == 0) ? INP(0) : F.out); }
        SEAM(pb + 6);
        if (IN(pb + 7)) {
            Frame F = lf(F0); unsigned char* wl = F.ws + WS_W + (size_t)l * WL_STRIDE; bf16* P = WSP(bf16, WS_BIG);
            pg8::Gemm g{P, (const bf16*)(wl + WL_BR), PLD, 512, 512}; pg8::BranchOrder S; S.init(F.G, F.cid);
            pg8::EpiPlain E{P, WSP(bf16, WS_VMIX)};
            pg8::gemm_phase(F.lds, F.wid, g, S, E);
        }
        SEAM(pb + 7);
        if (IN(pb + 8)) {
            Frame F = lf(F0); unsigned char* wl = F.ws + WS_W + (size_t)l * WL_STRIDE; bf16* P = WSP(bf16, WS_BIG);
            pg8::Gemm g{WSP(bf16, WS_XB), (const bf16*)(wl + WL_GATE), D, D, D}; pg8::GateOrder S; S.init(F.G, F.cid);
            pg8::EpiGateMerge E{P, WSP(const bf16, WS_VMIX), P + C_RET, PLD, WSP(float, WS_RSTD)};
            pg8::gemm_phase(F.lds, F.wid, g, S, E);
        }
        if (IN(pb + 8) && IN(pb + 13)) xcd_barrier(bar);
        if (IN(pb + 13)) {
            Frame F = lf(F0); unsigned char* wl = F.ws + WS_W + (size_t)l * WL_STRIDE; bf16* P = WSP(bf16, WS_BIG);
            pg8::Gemm g{P + C_RET, (const bf16*)(wl + WL_OUT), PLD, D, D}; pg8::StaticOrder S; S.init(M, D, F.G, F.cid, PLD, D);
            pg8::EpiResid E{(l == 0) ? INP(0) : F.out, F.out, nullptr, 0};
            pg8::gemm_phase(F.lds, F.wid, g, S, E);
        }
        SEAM(pb + 13);
        if (IN(pb + 14)) { Frame F = lf(F0); if (l == 0) xprep_phase(F, F.out); else { router_phase(F); conv_moe_weights(F); } }
        SEAM(pb + 14);
        if (l == 0) {
            if (IN(pb + 15)) {
                Frame F = lf(F0);
                pg8::Gemm g{WSP(bf16, WS_XB), WSP(const bf16, WS_FFUP), D, D, D}; pg8::StaticOrder S; S.init(M, 2 * FF, F.G, F.cid, D, D);
                pg8::EpiSwiglu E{WSP(bf16, WS_ACT), FF, WSP(float, WS_RSTD)};
                pg8::gemm_phase(F.lds, F.wid, g, S, E);
            }
            SEAM(pb + 15);
            if (IN(pb + 16)) {
                Frame F = lf(F0);
                pg8::Gemm g{WSP(const bf16, WS_ACT), WSP(const bf16, WS_FFDN), FF, FF, FF}; pg8::StaticOrder S; S.init(M, D, F.G, F.cid, FF, FF);
                pg8::EpiResid E{F.out, F.out, nullptr, 0};
                pg8::gemm_phase(F.lds, F.wid, g, S, E);
            }
            SEAM(pb + 16);
            if (IN(pb + 17)) { Frame F = lf(F0); xprep_phase(F, F.out); }
            SEAM(pb + 17);
        }
    }
    {
        const int pb = MOE_BASE;
        for (int sg = 0; sg < 3; ++sg) {
            if (IN(pb + 0 + 2 * sg)) {
                Frame F = lf(F0);
                pg8::Gemm g{WSP(bf16, WS_XB), WSP(const bf16, WS_MOEW), D, D, D}; pg8::MoeOrder<true> S; S.init(WSP(const int, WS_CNT), WSP(const int, WS_LIST), sg, 2 * FFE, F.G, F.cid, D, D, MOEW_STRIDE);
                pg8::EpiSwiglu E{WSP(bf16, WS_ACT), FFE, WSP(float, WS_RSTD)};
                pg8::gemm_phase(F.lds, F.wid, g, S, E);
            }
            SEAM(pb + 0 + 2 * sg);
            if (IN(pb + 1 + 2 * sg)) {
                Frame F = lf(F0);
                const int ksp = (sg == 2) ? 4 : 1;
                pg8::Gemm g{WSP(const bf16, WS_ACT), WSP(const bf16, WS_MOEW + MOEW_DN), FFE, FFE, FFE / ksp}; pg8::MoeOrder<false> S; S.init(WSP(const int, WS_CNT), WSP(const int, WS_LIST), sg, D, F.G, F.cid, FFE, FFE, MOEW_STRIDE, ksp, FFE / ksp);
                pg8::EpiMoeDown E{F.out};
                pg8::gemm_phase(F.lds, F.wid, g, S, E);
            }
            SEAM(pb + 1 + 2 * sg);
        }
        if (IN(pb + 6)) { Frame F = lf(F0); final_norm_phase(F); }
    }
#undef IN
#undef SEAM
#undef WSP
}
constexpr int LAST_PHASE = MOE_BASE + 6;
constexpr int N_PH = LAST_PHASE + 1;

extern "C" void kernel_launch(void* const* d_in, const int* in_sizes, int n_in, void* d_out, int out_size, void* d_ws, size_t ws_size, hipStream_t stream) {
    static int grid = 0;
    if (grid == 0) {
        if (n_in != 34 || out_size != M * D || ws_size < WS_END) { fprintf(stderr, "kernel_launch: unexpected problem (n_in %d out %d ws %zu need %zu)\n", n_in, out_size, ws_size, (size_t)WS_END); grid = -1; return; }
        int dev = 0, cus = 0;
        if (hipGetDevice(&dev) != hipSuccess || hipDeviceGetAttribute(&cus, hipDeviceAttributeMultiprocessorCount, dev) != hipSuccess) { grid = -1; return; }
        if (hipFuncSetAttribute((const void*)fwd, hipFuncAttributeMaxDynamicSharedMemorySize, LDS_BYTES) != hipSuccess) { fprintf(stderr, "kernel_launch: hipFuncSetAttribute failed\n"); grid = -1; return; }
        int per_cu = 0;
        if (hipOccupancyMaxActiveBlocksPerMultiprocessor(&per_cu, (const void*)fwd, 512, LDS_BYTES) != hipSuccess || per_cu < 1) fprintf(stderr, "kernel_launch: occupancy query says %d\n", per_cu);
        (void)hipGetLastError();
        grid = cus;
    }
    if (grid < 0) return;
    (void)hipMemsetAsync((char*)d_ws + WS_CTL, 0, CTL_ZERO_BYTES, stream);
    Args a{};
    for (int i = 0; i < 34; ++i) a.in[i] = (const float*)d_in[i];
    a.out = (float*)d_out; a.ws = (unsigned char*)d_ws;
#if MK_ONE_LAUNCH
    a.ph_lo = 0; a.ph_hi = N_PH;
    hipLaunchKernelGGL(fwd, dim3(grid), dim3(512), LDS_BYTES, stream, a);
#else
    for (int p = 0; p < N_PH; ++p) { a.ph_lo = p; a.ph_hi = p + 1; hipLaunchKernelGGL(fwd, dim3(grid), dim3(512), LDS_BYTES, stream, a); }
#endif
}
```

```cpp
#include <hip/hip_runtime.h>
#include <cstdio>
#include <cstdint>

#ifndef MK_ONE_LAUNCH
#define MK_ONE_LAUNCH 1
#endif

#define LAS __attribute__((address_space(3)))
#define GAS __attribute__((address_space(1)))
typedef unsigned short bf16;
typedef short bf16x8 __attribute__((ext_vector_type(8)));
typedef float f32x4 __attribute__((ext_vector_type(4)));
typedef float f32x2 __attribute__((ext_vector_type(2)));
typedef unsigned u32x4 __attribute__((ext_vector_type(4)));
typedef unsigned u32x2 __attribute__((ext_vector_type(2)));

constexpr int BATCH = 2, T = 16384, D = 1024, M = BATCH * T;
constexpr int INC = 8456;
constexpr int PLD = 5376;
constexpr int NP = 5632;
constexpr int C_RW = 0, C_Z = 1792, C_XBC = 2304, C_RET = 3328, C_RETG = 4864;
constexpr int FF = 2816, FFE = 3584, NE = 8;

constexpr size_t MiB = 1u << 20;
constexpr size_t WS_CTL = 0, CTL_ZERO_BYTES = 64 * 1024;
constexpr size_t WS_RSTD = 1 * MiB, WS_GATES = 2 * MiB, WS_DT = 3 * MiB;
constexpr size_t WS_W = 4 * MiB;
constexpr size_t WL_IN = 0, WL_GATE = 11 * MiB, WL_BR = 17 * MiB, WL_OUT = 20 * MiB, WL_STRIDE = 22 * MiB;
constexpr size_t WS_FFUP = WS_W + 44 * MiB, WS_FFDN = WS_W + 55 * MiB;
constexpr size_t WS_XB = 68 * MiB;
constexpr size_t WS_VF = 132 * MiB;
constexpr size_t WS_BIG = 164 * MiB;
constexpr size_t WS_VMIX = WS_BIG + 336 * MiB, WS_YRW = WS_BIG + 368 * MiB, WS_END = 573 * MiB;
constexpr size_t WS_MOEW = WS_BIG;
constexpr size_t MOEW_STRIDE = 21 * MiB, MOEW_DN = 14 * MiB;
constexpr size_t WS_ACT = WS_BIG + 168 * MiB;

constexpr size_t WS_CNT = 32768, WS_LIST = 2 * MiB;
constexpr size_t WS_BND2 = 566 * MiB;
constexpr size_t WS_VLORA = 192 * 1024;
constexpr size_t WS_DSTOT = 128 * 1024, WS_BND = 256 * 1024;
constexpr size_t WS_LORA = 1 * MiB + 512 * 1024, LORA_STRIDE = 262144;
constexpr size_t WS_ST_RW = WS_XB, WS_ST_RET = WS_XB + 16 * MiB, WS_ST_SSD = WS_XB + 32 * MiB, WS_MT = WS_YRW;
constexpr int RING_BYTES = 131072, LDSCTL_OFF = 159744, MISC_OFF = LDSCTL_OFF + 320, LDS_BYTES = 163840;
#ifndef REP_CONV
#define REP_CONV 0
#endif
#ifndef REP_R1
#define REP_R1 0
#endif
#ifndef REP_RW
#define REP_RW 0
#endif
#ifndef REP_RET
#define REP_RET 0
#endif
#ifndef REP_SSD
#define REP_SSD 0
#endif
#ifndef REP_MISC
#define REP_MISC 0
#endif
#ifndef RW_CH
#define RW_CH 1
#endif
#ifndef RET_CH
#define RET_CH 1
#endif
#ifndef SSD_CH
#define SSD_CH 1
#endif

typedef __bf16 hbf16x2 __attribute__((ext_vector_type(2)));
__device__ __forceinline__ unsigned pk2(float lo, float hi) { const f32x2 v = {lo, hi}; return __builtin_bit_cast(unsigned, __builtin_convertvector(v, hbf16x2)); }
__device__ __forceinline__ unsigned f2bf(float f) { return (unsigned)__builtin_bit_cast(unsigned short, (__bf16)f); }
__device__ __forceinline__ float bflo(unsigned u) { return __builtin_bit_cast(float, u << 16); }
__device__ __forceinline__ float bfhi(unsigned u) { return __builtin_bit_cast(float, u & 0xffff0000u); }
__device__ __forceinline__ void unpack8(const u32x4 u, float (&f)[8]) { f[0] = bflo(u.x); f[1] = bfhi(u.x); f[2] = bflo(u.y); f[3] = bfhi(u.y); f[4] = bflo(u.z); f[5] = bfhi(u.z); f[6] = bflo(u.w); f[7] = bfhi(u.w); }
__device__ __forceinline__ u32x4 pack8(const float (&f)[8]) { u32x4 w; w.x = pk2(f[0], f[1]); w.y = pk2(f[2], f[3]); w.z = pk2(f[4], f[5]); w.w = pk2(f[6], f[7]); return w; }
__device__ __forceinline__ float sigm(float x) { return __builtin_amdgcn_rcpf(1.f + __expf(-x)); }
__device__ __forceinline__ float silu(float x) { return x * __builtin_amdgcn_rcpf(1.f + __expf(-x)); }
__device__ __forceinline__ float ex2(float x) { return __builtin_amdgcn_exp2f(x); }
__device__ __forceinline__ float fast_tanh(float x) { return 1.f - 2.f * __builtin_amdgcn_rcpf(1.f + __expf(2.f * x)); }
__device__ __forceinline__ float softplus_acc(float x) { return fmaxf(x, 0.f) + log1pf(expf(-fabsf(x))); }
__device__ __forceinline__ float wave_sum(float v) {
#pragma unroll
    for (int o = 1; o < 64; o <<= 1) v += __shfl_xor(v, o);
    return v;
}
__device__ __forceinline__ int otid_w(int wid) { unsigned z = 0u; asm volatile("" : "+v"(z)); int t = wid * 64 + (int)__builtin_amdgcn_mbcnt_hi(~0u, __builtin_amdgcn_mbcnt_lo(~0u, z)); asm volatile("" : "+v"(t)); return t; }
#define otid() otid_w(F.wid)
__device__ __forceinline__ int fresh_tid(int t) { asm volatile("" : "+v"(t)); return t; }
#define LDS_WAIT() asm volatile("s_waitcnt lgkmcnt(0)" ::: "memory")

namespace pg8 {
constexpr int BM = 256, BK = 64, HALF = 128, HTB = HALF * BK * 2, STAGE_BYTES = 8 * HTB, NXCD = 8, WGM = 8;
__host__ __device__ __forceinline__ int lds_byte(int r, int c) { const int st = (r >> 4) * 2 + (c >> 5), rr = r & 15, cc = c & 31, ob = rr * 64 + cc * 2; return st * 1024 + (ob ^ (((ob >> 9) & 1) << 5)); }
__host__ __device__ __forceinline__ void stage_rc(int b, int& R, int& C) { const int st = b / 1024, sb = b % 1024, swz = sb ^ (((sb >> 9) & 1) << 5); R = (st >> 1) * 16 + swz / 64; C = (st & 1) * 32 + (swz % 64) / 2; }
__host__ __device__ __forceinline__ int perm32(int rho) { const int n = rho >> 4, i = rho & 15; return 8 * (i >> 2) + 4 * n + (i & 3); }

struct Unit { int pm, pn; size_t aofs, bofs; const int* rows; int nvalid, e; };
struct Gemm { const bf16* A; const bf16* Bt; int lda, ldb, K; };

struct StaticOrder {
    static constexpr bool GATHER = false;
    int nM, nN, nwg, G, c; size_t tsA, tsB;
    __device__ __forceinline__ void init(int Mrows, int N, int G_, int c_, int lda, int ldb) { nM = Mrows / BM; nN = N / BM; nwg = nM * nN; G = G_; c = c_; tsA = (size_t)BM * lda * 2; tsB = (size_t)BM * ldb * 2; }
    __device__ __forceinline__ void tile(int L, int& pm, int& pn) const {
        int wgid = L; { const int q = nwg / NXCD, r = nwg % NXCD, xcd = wgid % NXCD, off = wgid / NXCD; wgid = (xcd < r ? xcd * (q + 1) : r * (q + 1) + (xcd - r) * q) + off; }
        const int nig = WGM * nN, gid = wgid / nig, fm = gid * WGM, gsz = (nM - fm) < WGM ? (nM - fm) : WGM;
        pm = fm + ((wgid % nig) % gsz); pn = (wgid % nig) / gsz;
    }
    __device__ __forceinline__ bool next(int i, Unit& u) const {
        const long L = (long)i * G + c; if (L >= nwg) return false;
        tile((int)L, u.pm, u.pn); u.aofs = (size_t)u.pm * tsA; u.bofs = (size_t)u.pn * tsB; u.rows = nullptr; u.nvalid = BM; u.e = 0; return true;
    }
};
struct BranchOrder {
    static constexpr bool GATHER = false;
    StaticOrder so;
    __device__ __forceinline__ void init(int G_, int c_) { so.init(M, D, G_, c_, PLD, 512); }
    __device__ __forceinline__ bool next(int j, Unit& u) const {
        const long L = (long)j * so.G + so.c; if (L >= 3 * so.nwg) return false;
        const int i = (int)(L / so.nwg); so.tile((int)(L % so.nwg), u.pm, u.pn);
        const int acol = (i == 0) ? 1024 : (i == 1 ? C_Z : C_RETG);
        u.aofs = (size_t)u.pm * so.tsA + (size_t)acol * 2; u.bofs = ((size_t)i * D + (size_t)u.pn * BM) * 512 * 2; u.rows = nullptr; u.nvalid = BM; u.e = i; return true;
    }
};
struct GateOrder {
    static constexpr bool GATHER = false;
    StaticOrder so;
    __device__ __forceinline__ void init(int G_, int c_) { so.init(M, D, G_, c_, D, D); }
    __device__ __forceinline__ bool next(int j, Unit& u) const {
        const long tt = (long)(j / 3) * so.G + so.c; if (tt >= so.nwg) return false;
        const int i = j % 3; so.tile((int)tt, u.pm, u.pn);
        u.aofs = (size_t)u.pm * so.tsA; u.bofs = ((size_t)i * D + (size_t)u.pn * BM) * D * 2; u.rows = nullptr; u.nvalid = BM; u.e = i; return true;
    }
};
template <bool GATH> struct MoeOrder {
    static constexpr bool GATHER = GATH;
    unsigned q0, q1, q2, q3;
    int seg, nN, G, c, ksplit; const int* list; size_t bstride, tsB, tsA, kbytes;
    __device__ __forceinline__ void init(const int* counts, const int* list_, int seg_, int N, int G_, int c_, int lda, int ldb, size_t bstride_, int ksplit_ = 1, int kpart = 0) {
        unsigned n[8];
#pragma unroll
        for (int e = 0; e < 8; ++e) { int v = __builtin_amdgcn_readfirstlane(counts[e]); v = v < 0 ? 0 : (v > 32768 ? 32768 : v); n[e] = (unsigned)v; }
        q0 = n[0] | (n[1] << 16); q1 = n[2] | (n[3] << 16); q2 = n[4] | (n[5] << 16); q3 = n[6] | (n[7] << 16);
        seg = seg_; nN = N / BM; G = G_; c = c_; list = list_; bstride = bstride_; tsB = (size_t)BM * ldb * 2; tsA = (size_t)BM * lda * 2; ksplit = ksplit_; kbytes = (size_t)kpart * 2;
    }
    __device__ __forceinline__ bool next(int i, Unit& u) const {
        const long L0 = (long)i * G + c; const long L = L0 / ksplit; const int ks = (int)(L0 % ksplit); const int tl = (int)(L / nN), pn = (int)(L % nN), gt = seg * 128 + tl;
        int t = 0, e = 0, tbe = 0, cne = 0;
#pragma unroll
        for (int k = 0; k < 8; ++k) { const unsigned q = (k < 2) ? q0 : (k < 4) ? q1 : (k < 6) ? q2 : q3; const int n = (int)((k & 1) ? (q >> 16) : (q & 0xffffu));
            if (gt >= t) { e = k; tbe = t; cne = n; } t += (n + 255) >> 8; }
        int nt = t - seg * 128; nt = nt < 0 ? 0 : (nt > 128 ? 128 : nt);
        if (L >= (long)nt * nN) return false;
        const int rt = gt - tbe;
        u.pm = tl; u.pn = pn; u.e = e; u.bofs = (size_t)e * bstride + (size_t)pn * tsB + ks * kbytes; u.aofs = (GATH ? 0 : (size_t)tl * tsA) + ks * kbytes;
        u.rows = list + ((size_t)e * 32768 + rt * 256) * 2; int nv = cne - rt * 256; u.nvalid = nv > 256 ? 256 : nv; return true;
    }
};

template <class Epi, class Sched>
__device__ __forceinline__ void gemm_phase(LAS unsigned char* lds, int wid0, const Gemm g, const Sched& S, const Epi& E) {
    constexpr bool GATHER = Sched::GATHER;
    const int tid = otid_w(wid0), wid = __builtin_amdgcn_readfirstlane(tid >> 6), lane = tid & 63, wr = wid >> 2, wc = wid & 3, fr = lane & 15, fq = lane >> 4;
    const int nt = g.K / BK;
    unsigned voffA[2], voffB[2];
#pragma unroll
    for (int i = 0; i < 2; ++i) { int R, C; stage_rc(tid * 16 + i * 8192, R, C); const int Rb = Epi::PERM ? ((R & ~31) + perm32(R & 31)) : R;
        voffA[i] = (unsigned)(R * g.lda + C) * 2u; voffB[i] = (unsigned)(Rb * g.ldb + C) * 2u; }
    const size_t kstep = (size_t)(BK * 2);
    const size_t hstepA = GATHER ? 0 : (size_t)HALF * g.lda * 2, hstepB = (size_t)HALF * g.ldb * 2;
    const unsigned ldsw = (unsigned)wid * 1024u;
    const int aoff = lds_byte(wr * 64 + fr, fq * 8), boff = lds_byte(wc * 32 + fr, fq * 8);
#define PG8_SA(b, h) (((b) * 2 + (h)) * HTB)
#define PG8_SB(b, h) ((4 + (b) * 2 + (h)) * HTB)
#define PG8_STAGE2(bufoff, gbase, o0, o1) do { \
        __builtin_amdgcn_global_load_lds((const unsigned*)((const char*)(gbase) + (o0)), (LAS unsigned*)(lds + (bufoff) + ldsw), 16, 0, 0); \
        __builtin_amdgcn_global_load_lds((const unsigned*)((const char*)(gbase) + (o1)), (LAS unsigned*)(lds + (bufoff) + ldsw + 8192), 16, 0, 0); } while (0)
#define PG8_STAGE(bufoff, gbase, voff) PG8_STAGE2(bufoff, gbase, (voff)[0], (voff)[1])
#define PG8_LDA(dst, b, h) do { _Pragma("unroll") for (int m = 0; m < 4; ++m) _Pragma("unroll") for (int k = 0; k < 2; ++k) dst[m][k] = *(const LAS bf16x8*)(lds + PG8_SA(b, h) + aoff + m * 2048 + k * 1024); } while (0)
#define PG8_LDB(dst, b, h) do { _Pragma("unroll") for (int n = 0; n < 2; ++n) _Pragma("unroll") for (int k = 0; k < 2; ++k) dst[n][k] = *(const LAS bf16x8*)(lds + PG8_SB(b, h) + boff + n * 2048 + k * 1024); } while (0)
#define PG8_MMA(ai, bj, At, Bt) do { __builtin_amdgcn_s_setprio(1); _Pragma("unroll") for (int m = 0; m < 4; ++m) _Pragma("unroll") for (int n = 0; n < 2; ++n) _Pragma("unroll") for (int k = 0; k < 2; ++k) \
        acc[ai][bj][m][n] = Epi::TRANS ? __builtin_amdgcn_mfma_f32_16x16x32_bf16(Bt[n][k], At[m][k], acc[ai][bj][m][n], 0, 0, 0) : __builtin_amdgcn_mfma_f32_16x16x32_bf16(At[m][k], Bt[n][k], acc[ai][bj][m][n], 0, 0, 0); __builtin_amdgcn_s_setprio(0); } while (0)
#define PG8_WAIT_V(n) asm volatile("s_waitcnt vmcnt(" #n ")" ::: "memory")
#define PG8_WAIT_L(n) asm volatile("s_waitcnt lgkmcnt(" #n ")" ::: "memory")
#define PG8_BAR __builtin_amdgcn_s_barrier()
#define PG8_SCHED __builtin_amdgcn_sched_barrier(0)
#define GSLOT(which) ((LAS u32x4*)(lds + 131072 + (which) * 8192 + tid * 16))
#define PG8_ROWS(u, which) do { const int _ft = fresh_tid(tid); unsigned _vg[2][2]; _Pragma("unroll") for (int _i = 0; _i < 2; ++_i) { int _R, _C; stage_rc(_ft * 16 + _i * 8192, _R, _C); \
        _Pragma("unroll") for (int _h = 0; _h < 2; ++_h) { const int _r = _h * HALF + _R; \
        const int _t = (_r < (u).nvalid) ? (u).rows[2 * _r] : 0; _vg[_h][_i] = ((unsigned)_t * (unsigned)g.lda + (unsigned)_C) * 2u; } } \
        u32x4 _o; _o.x = _vg[0][0]; _o.y = _vg[0][1]; _o.z = _vg[1][0]; _o.w = _vg[1][1]; *GSLOT(which) = _o; } while (0)
    Unit cur, nxt; int ui = 0;
    if (!S.next(0, cur)) return;
    f32x4 acc[2][2][4][2];
#pragma unroll
    for (int a = 0; a < 2; ++a)
#pragma unroll
        for (int b = 0; b < 2; ++b)
#pragma unroll
            for (int m = 0; m < 4; ++m)
#pragma unroll
                for (int n = 0; n < 2; ++n) acc[a][b][m][n] = (f32x4){0.f, 0.f, 0.f, 0.f};
    bf16x8 At[4][2], B0[2][2], B1[2][2];
    u32x4 gc = {voffA[0], voffA[1], voffA[0], voffA[1]};
    if constexpr (GATHER) { PG8_ROWS(cur, 0); PG8_ROWS(cur, 1); gc = *GSLOT(0); }
#define VGC(h, i) (gc[2 * (h) + (i)])
    const char* cA = (const char*)g.A + cur.aofs; const char* cB = (const char*)g.Bt + cur.bofs;
    PG8_STAGE(PG8_SB(0, 0), cB, voffB); PG8_STAGE(PG8_SB(0, 1), cB + hstepB, voffB); PG8_STAGE2(PG8_SA(0, 0), cA, VGC(0, 0), VGC(0, 1)); PG8_STAGE2(PG8_SA(0, 1), cA + hstepA, VGC(1, 0), VGC(1, 1));
    if (wr == 1) PG8_BAR;
    PG8_WAIT_V(2); PG8_BAR;
    PG8_STAGE(PG8_SB(1, 0), cB + kstep, voffB); PG8_STAGE2(PG8_SA(1, 0), cA + kstep, VGC(0, 0), VGC(0, 1)); PG8_STAGE(PG8_SB(1, 1), cB + hstepB + kstep, voffB);
    PG8_WAIT_V(6); PG8_BAR;
    for (;;) {
        const bool has_next = S.next(ui + 1, nxt);
        const char* nA = has_next ? (const char*)g.A + nxt.aofs : cA; const char* nB = has_next ? (const char*)g.Bt + nxt.bofs : cB;
        if constexpr (GATHER) { if (has_next) PG8_ROWS(nxt, 1); else *GSLOT(1) = *GSLOT(0); }
        for (int t = 0; t < nt; t += 2) {
            const bool last = (t == nt - 2);
            const char* a1 = cA + (size_t)(t + 1) * kstep;
            const char* a2 = last ? nA : cA + (size_t)(t + 2) * kstep; const char* b2 = last ? nB : cB + (size_t)(t + 2) * kstep;
            const char* a3 = a2 + kstep; const char* b3 = b2 + kstep;
            u32x4 gn = gc; if constexpr (GATHER) { gc = *GSLOT(0); gn = last ? *GSLOT(1) : gc; }
            const unsigned s00 = gn.x, s01 = gn.y, s10 = gn.z, s11 = gn.w;
            PG8_LDB(B0, 0, 0); PG8_LDB(B1, 0, 1); PG8_SCHED; PG8_LDA(At, 0, 0); PG8_STAGE2(PG8_SA(1, 1), a1 + hstepA, VGC(1, 0), VGC(1, 1));
            PG8_WAIT_V(8); PG8_WAIT_L(0); PG8_BAR; PG8_MMA(0, 0, At, B0); PG8_MMA(0, 1, At, B1); PG8_BAR; PG8_SCHED;
            PG8_LDA(At, 0, 1); PG8_STAGE(PG8_SB(0, 0), b2, voffB); PG8_STAGE(PG8_SB(0, 1), b2 + hstepB, voffB); PG8_STAGE2(PG8_SA(0, 0), a2, s00, s01);
            PG8_WAIT_V(8); PG8_WAIT_L(0); PG8_BAR; PG8_MMA(1, 0, At, B0); PG8_MMA(1, 1, At, B1); PG8_BAR; PG8_SCHED;
            PG8_LDB(B0, 1, 0); PG8_LDB(B1, 1, 1); PG8_SCHED; PG8_LDA(At, 1, 0); PG8_STAGE2(PG8_SA(0, 1), a2 + hstepA, s10, s11);
            PG8_WAIT_V(8); PG8_WAIT_L(0); PG8_BAR; PG8_MMA(0, 0, At, B0); PG8_MMA(0, 1, At, B1); PG8_BAR; PG8_SCHED;
            PG8_LDA(At, 1, 1); PG8_STAGE(PG8_SB(1, 0), b3, voffB); PG8_STAGE(PG8_SB(1, 1), b3 + hstepB, voffB); PG8_STAGE2(PG8_SA(1, 0), a3, s00, s01);
            PG8_WAIT_V(8); PG8_WAIT_L(0); PG8_BAR; PG8_MMA(1, 0, At, B0); PG8_MMA(1, 1, At, B1); PG8_BAR; PG8_SCHED;
        }
        if (wr == 0) PG8_BAR;
        E(acc, cur, wr, wc, fr, fq);
        if (!has_next) break;
#pragma unroll
        for (int a = 0; a < 2; ++a)
#pragma unroll
            for (int b = 0; b < 2; ++b)
#pragma unroll
                for (int m = 0; m < 4; ++m)
#pragma unroll
                    for (int n = 0; n < 2; ++n) acc[a][b][m][n] = (f32x4){0.f, 0.f, 0.f, 0.f};
        cur = nxt; cA = nA; cB = nB; ++ui;
        if constexpr (GATHER) { *GSLOT(0) = *GSLOT(1); }
        if (wr == 1) PG8_BAR;
    }
    PG8_WAIT_V(0);
    PG8_BAR;
#undef PG8_SA
#undef PG8_SB
#undef PG8_STAGE
#undef PG8_STAGE2
#undef PG8_ROWS
#undef GSLOT
#undef VGC
#undef PG8_LDA
#undef PG8_LDB
#undef PG8_MMA
#undef PG8_WAIT_V
#undef PG8_WAIT_L
#undef PG8_BAR
#undef PG8_SCHED
}

typedef const f32x4 (&AccRef)[2][2][4][2];

struct EpiInProj {
    static constexpr bool PERM = true, TRANS = true;
    bf16* P; const float* rstd; float* dt;
    __device__ __forceinline__ void operator()(AccRef acc, const Unit& u, int wr, int wc, int fr, int fq) const {
        const int row0 = u.pm * BM + wr * 64 + fr;
        if (u.pn < 21) {
            const int col0 = u.pn * BM + wc * 32 + 8 * fq;
#pragma unroll
            for (int ai = 0; ai < 2; ++ai)
#pragma unroll
                for (int m = 0; m < 4; ++m) { const int row = row0 + ai * HALF + m * 16; const float s = rstd[row]; bf16* rowp = P + (size_t)row * PLD + col0;
#pragma unroll
                    for (int bj = 0; bj < 2; ++bj) { const f32x4 v0 = acc[ai][bj][m][0] * s, v1 = acc[ai][bj][m][1] * s;
                        u32x4 w; w.x = pk2(v0[0], v0[1]); w.y = pk2(v0[2], v0[3]); w.z = pk2(v1[0], v1[1]); w.w = pk2(v1[2], v1[3]);
                        *(u32x4*)(rowp + bj * HALF) = w; } }
        } else if (wc == 0 && fq == 0) {
#pragma unroll
            for (int ai = 0; ai < 2; ++ai)
#pragma unroll
                for (int m = 0; m < 4; ++m) { const int row = row0 + ai * HALF + m * 16; const float s = rstd[row];
                    *(f32x4*)(dt + (size_t)row * 8) = acc[ai][0][m][0] * s; *(f32x4*)(dt + (size_t)row * 8 + 4) = acc[ai][0][m][1] * s; }
        }
    }
};
struct EpiPlain {
    static constexpr bool PERM = true, TRANS = true;
    bf16* P; bf16* Y2;
    __device__ __forceinline__ void operator()(AccRef acc, const Unit& u, int wr, int wc, int fr, int fq) const {
        bf16* O = (u.e == 0) ? P : (u.e == 1 ? P + C_XBC : Y2); const int ldc = (u.e == 2) ? D : PLD;
        const int row0 = u.pm * BM + wr * 64 + fr, col0 = u.pn * BM + wc * 32 + 8 * fq;
#pragma unroll
        for (int ai = 0; ai < 2; ++ai)
#pragma unroll
            for (int m = 0; m < 4; ++m) { bf16* rowp = O + (size_t)(row0 + ai * HALF + m * 16) * ldc + col0;
#pragma unroll
                for (int bj = 0; bj < 2; ++bj) { const f32x4 v0 = acc[ai][bj][m][0], v1 = acc[ai][bj][m][1];
                    u32x4 w; w.x = pk2(v0[0], v0[1]); w.y = pk2(v0[2], v0[3]); w.z = pk2(v1[0], v1[1]); w.w = pk2(v1[2], v1[3]);
                    *(u32x4*)(rowp + bj * HALF) = w; } }
    }
};
struct EpiGateMerge {
    static constexpr bool PERM = true, TRANS = true;
    const bf16* P; const bf16* Y2; bf16* Mg; int ldm; const float* rstd;
    __device__ __forceinline__ void operator()(AccRef acc, const Unit& u, int wr, int wc, int fr, int fq) const {
        asm volatile("" : "+v"(fr), "+v"(fq));
        const bf16* Y = (u.e == 0) ? P : (u.e == 1 ? P + C_XBC : Y2); const int ldy = (u.e == 2) ? D : PLD; const int first = (u.e == 0);
        const int row0 = u.pm * BM + wr * 64 + fr, col0 = u.pn * BM + wc * 32 + 8 * fq;
#pragma unroll
        for (int ai = 0; ai < 2; ++ai)
#pragma unroll
            for (int m = 0; m < 4; ++m) { const int row = row0 + ai * HALF + m * 16; const float s = rstd[row];
#pragma unroll
                for (int bj = 0; bj < 2; ++bj) { const int c = col0 + bj * HALF;
                    float y[8], o[8]; unpack8(*(const u32x4*)(Y + (size_t)row * ldy + c), y);
                    const f32x4 v0 = acc[ai][bj][m][0] * s, v1 = acc[ai][bj][m][1] * s;
#pragma unroll
                    for (int j = 0; j < 4; ++j) { o[j] = sigm(v0[j]) * y[j]; o[4 + j] = sigm(v1[j]) * y[4 + j]; }
                    if (!first) { float p[8]; unpack8(*(const u32x4*)(Mg + (size_t)row * ldm + c), p);
#pragma unroll
                        for (int j = 0; j < 8; ++j) o[j] += p[j]; }
                    *(u32x4*)(Mg + (size_t)row * ldm + c) = pack8(o); } }
    }
};
struct EpiResid {
    static constexpr bool PERM = false, TRANS = true;
    const float* xin; float* xout; const float* gates; int e;
    __device__ __forceinline__ void operator()(AccRef acc, const Unit& u, int wr, int wc, int fr, int fq) const {
        const int row0 = u.pm * BM + wr * 64 + fr, col0 = u.pn * BM + wc * 32 + 4 * fq;
#pragma unroll
        for (int ai = 0; ai < 2; ++ai)
#pragma unroll
            for (int m = 0; m < 4; ++m) { const int row = row0 + ai * HALF + m * 16; const float s = gates ? gates[(size_t)row * 8 + e] : 1.f;
                const float* ip = xin + (size_t)row * D + col0; float* op = xout + (size_t)row * D + col0;
#pragma unroll
                for (int bj = 0; bj < 2; ++bj)
#pragma unroll
                    for (int n = 0; n < 2; ++n) *(f32x4*)(op + bj * HALF + n * 16) = *(const f32x4*)(ip + bj * HALF + n * 16) + acc[ai][bj][m][n] * s; }
    }
};
struct EpiSwiglu {
    static constexpr bool PERM = true, TRANS = true;
    bf16* act; int ldc; const float* rstd;
    __device__ __forceinline__ void operator()(AccRef acc, const Unit& u, int wr, int wc, int fr, int fq) const {
        asm volatile("" : "+v"(fr), "+v"(fq));
        const int row0 = u.pm * BM + wr * 64 + fr, col0 = u.pn * HALF + wc * 32 + 8 * fq;
#pragma unroll
        for (int ai = 0; ai < 2; ++ai)
#pragma unroll
            for (int m = 0; m < 4; ++m) { const int row = row0 + ai * HALF + m * 16; const int lr = row - u.pm * BM;
                const float s = u.rows ? rstd[(lr < u.nvalid) ? u.rows[2 * lr] : 0] : rstd[row];
                float o[8];
#pragma unroll
                for (int n = 0; n < 2; ++n)
#pragma unroll
                    for (int j = 0; j < 4; ++j) o[4 * n + j] = silu(acc[ai][0][m][n][j] * s) * (acc[ai][1][m][n][j] * s);
                *(u32x4*)(act + (size_t)row * ldc + col0) = pack8(o); }
    }
};
struct EpiMoeDown {
    static constexpr bool PERM = false, TRANS = false;
    float* x;
    __device__ __forceinline__ void operator()(AccRef acc, const Unit& u, int wr, int wc, int fr, int fq) const {
        asm volatile("" : "+v"(fr), "+v"(fq));
        const int col0 = u.pn * BM + wc * 32 + fr;
#pragma unroll
        for (int ai = 0; ai < 2; ++ai)
#pragma unroll
            for (int m = 0; m < 4; ++m) { asm volatile("" ::: "memory");
#pragma unroll
                for (int j = 0; j < 4; ++j) { const int lr = ai * HALF + wr * 64 + m * 16 + 4 * fq + j;
                    if (lr < u.nvalid) { const int tok = u.rows[2 * lr]; const float wgt = __builtin_bit_cast(float, u.rows[2 * lr + 1]); float* xp = x + (size_t)tok * D + col0;
#pragma unroll
                        for (int bj = 0; bj < 2; ++bj)
#pragma unroll
                            for (int n = 0; n < 2; ++n) atomicAdd(xp + bj * HALF + n * 16, wgt * acc[ai][bj][m][n][j]); } } }
    }
};
}

#define XB_TMO      128
#define XB_XCNT(j)  (256  + 64 * (j))
#define XB_XSUB(j)  (1280 + 64 * (j))
#define XB_XGEN(j)  (2304 + 64 * (j))
#define XB_TOP      3328
#define XB_TOPGEN   3392
#define XCD_BAR_WORDS 3456
#define XB_SPIN_CAP (1u << 18)

__device__ __forceinline__ unsigned xb_ld(unsigned* p)              { return __hip_atomic_load(p, __ATOMIC_RELAXED, __HIP_MEMORY_SCOPE_AGENT); }
__device__ __forceinline__ unsigned xb_add(unsigned* p, unsigned v) { return __hip_atomic_fetch_add(p, v, __ATOMIC_RELAXED, __HIP_MEMORY_SCOPE_AGENT); }
__device__ __forceinline__ unsigned xb_xcc_id() { return (unsigned)__builtin_amdgcn_s_getreg((3 << 11) | 20) & 0xFu; }
#define XB_SPIN(cond, bar) do { unsigned _sp = 0; while (cond) { __builtin_amdgcn_s_sleep(1); \
    if ((++_sp & 255u) == 0u) { if (xb_ld(&(bar)[XB_TMO])) break; if (_sp > XB_SPIN_CAP) { atomicAdd(&(bar)[XB_TMO], 1u); break; } } } } while (0)

struct XcdBarrier { unsigned* bar; unsigned x; volatile LAS unsigned* st; };

__device__ __forceinline__ XcdBarrier xcd_barrier_post(unsigned* bar, volatile LAS unsigned* st) {
    XcdBarrier b; b.bar = bar; b.x = xb_xcc_id(); b.st = st;
    if (threadIdx.x == 0) (void)xb_add(&bar[XB_XCNT(b.x)], 1u);
    return b;
}
__device__ __forceinline__ void xcd_barrier_complete(unsigned* bar, unsigned x, unsigned& nloc, unsigned& nx) {
    const unsigned G = gridDim.x * gridDim.y * gridDim.z;
    unsigned sum, cnt, mine, sp = 0u;
    for (;;) {
        sum = 0u; cnt = 0u; mine = 0u;
#pragma unroll
        for (unsigned j = 0; j < 16; ++j) { const unsigned c = xb_ld(&bar[XB_XCNT(j)]); sum += c; cnt += (c > 0u) ? 1u : 0u; mine = (j == x) ? c : mine; }
        if (sum == G) break;
        __builtin_amdgcn_s_sleep(1);
        if ((++sp & 255u) == 0u) { if (xb_ld(&bar[XB_TMO])) break; if (sp > XB_SPIN_CAP) { atomicAdd(&bar[XB_TMO], 1u); break; } }
    }
    nloc = mine > 0u ? mine : 1u; nx = cnt > 0u ? cnt : 1u;
}
__device__ __forceinline__ void xcd_barrier(const XcdBarrier& b) {
    asm volatile("s_waitcnt vmcnt(0)" ::: "memory");
    __syncthreads();
    if (threadIdx.x == 0) {
        unsigned* bar = b.bar;
        __builtin_amdgcn_s_waitcnt(0);
        unsigned nloc = b.st[0], nx = b.st[1];
        if (nloc == 0u) { xcd_barrier_complete(bar, b.x, nloc, nx); b.st[0] = nloc; b.st[1] = nx; }
        const unsigned old = xb_add(&bar[XB_XSUB(b.x)], 1u);
        const unsigned gen = old / nloc;
        if (old + 1u == (gen + 1u) * nloc) {
            __builtin_amdgcn_fence(__ATOMIC_RELEASE, "agent");
            asm volatile("s_waitcnt vmcnt(0)" ::: "memory");
            const unsigned og = xb_add(&bar[XB_TOP], 1u);
            const unsigned tg = og / nx;
            if (og + 1u == (tg + 1u) * nx) xb_add(&bar[XB_TOPGEN], 1u);
            else XB_SPIN(xb_ld(&bar[XB_TOPGEN]) == tg, bar);
            __builtin_amdgcn_fence(__ATOMIC_ACQUIRE, "agent");
            xb_add(&bar[XB_XGEN(b.x)], 1u);
            asm volatile("s_waitcnt vmcnt(0)" ::: "memory");
        } else {
            XB_SPIN(xb_ld(&bar[XB_XGEN(b.x)]) == gen, bar);
            __builtin_amdgcn_fence(__ATOMIC_ACQUIRE, "agent");
            asm volatile("s_waitcnt vmcnt(0)" ::: "memory");
        }
    }
    __syncthreads();
}

struct Args { const float* in[34]; float* out; unsigned char* ws; int ph_lo, ph_hi; };
struct Frame {
    LAS unsigned char* lds;
    int vcu, G, cid, wid;
    float* out; unsigned char* ws; unsigned char* st;
};
__device__ __forceinline__ const float* inptr(LAS unsigned char* lds, int i) {
    int off = LDSCTL_OFF + 8 * i; asm volatile("" : "+v"(off));
    const LAS unsigned* p = (const LAS unsigned*)(lds + off);
    const unsigned lo = __builtin_amdgcn_readfirstlane(p[0]), hi = __builtin_amdgcn_readfirstlane(p[1]);
    return (const float*)(((unsigned long long)hi << 32) | lo);
}
#define INP(i) inptr(F.lds, (i))

__device__ __forceinline__ void conv_item(const float* W, int ld, int k0, int c0, int nvalid, const float* scale, bf16* dst, int K, int drow0, LAS float* scr, int lane) {
    const int n4 = (lane & 15) * 4;
#pragma unroll 4
    for (int i = 0; i < 16; ++i) { const int kk = 4 * i + (lane >> 4);
        f32x4 v = {0.f, 0.f, 0.f, 0.f}; if (n4 < nvalid) { v = *(const f32x4*)(W + (size_t)(k0 + kk) * ld + c0 + n4); if (scale) v *= scale[k0 + kk]; }
        LAS float* d = scr + kk * 65 + n4; d[0] = v[0]; d[1] = v[1]; d[2] = v[2]; d[3] = v[3]; }
    LDS_WAIT(); asm volatile("" ::: "memory");
    const int c = lane & 7;
#pragma unroll
    for (int j = 0; j < 8; ++j) { const int nn = (lane >> 3) + 8 * j; const LAS float* sp = scr + (8 * c) * 65 + nn;
        u32x4 o; o.x = pk2(sp[0 * 65], sp[1 * 65]); o.y = pk2(sp[2 * 65], sp[3 * 65]); o.z = pk2(sp[4 * 65], sp[5 * 65]); o.w = pk2(sp[6 * 65], sp[7 * 65]);
        *(u32x4*)(dst + (size_t)(drow0 + nn) * K + k0 + 8 * c) = o; }
    LDS_WAIT(); asm volatile("" ::: "memory");
}
__device__ __forceinline__ void conv_seg(Frame& F, const float* W, int ld, int K, int c0, int nvalid, int ntotal, const float* scale, bf16* dst, int r0, int blk, int blks) {
    const int ptid = otid(), plane = ptid & 63, pwave = __builtin_amdgcn_readfirstlane(ptid >> 6);
    LAS float* scr = (LAS float*)(F.lds + pwave * 16640);
    const int gw = F.vcu * 8 + pwave, NGW = F.G * 8;
    const int nblk = ntotal / 64, nitems = (K / 64) * nblk;
    for (int it = gw; it < nitems; it += NGW) {
        const int kb = it / nblk, nb = it % nblk, n0 = nb * 64;
        int nv = nvalid - n0; nv = nv < 0 ? 0 : (nv > 64 ? 64 : nv);
        conv_item(W, ld, kb * 64, c0 + n0, nv, scale, dst, K, r0 + (n0 / blk) * blks + (n0 % blk), scr, plane);
    }
}
__device__ __forceinline__ void conv_layer_weights(Frame& F, int l) {
    unsigned char* wl = F.ws + WS_W + (size_t)l * WL_STRIDE;
    const float* win = INP(2) + (size_t)l * D * INC; const float* n1 = INP(1) + l * D;
    const int BIGB = 1 << 30;
    conv_seg(F, win, INC, D, 0, 3328, 3328, n1, (bf16*)(wl + WL_IN), 0, BIGB, 0);
    conv_seg(F, win, INC, D, 3336, 2048, 2048, n1, (bf16*)(wl + WL_IN), 3328, BIGB, 0);
    conv_seg(F, win, INC, D, 3328, 8, 256, n1, (bf16*)(wl + WL_IN), 5376, BIGB, 0);
    conv_seg(F, win, INC, D, 5384, 3072, 3072, n1, (bf16*)(wl + WL_GATE), 0, BIGB, 0);
    for (int i = 0; i < 3; ++i)
        conv_seg(F, INP(23) + ((size_t)l * 3 + i) * 512 * D, D, 512, 0, D, D, nullptr, (bf16*)(wl + WL_BR) + (size_t)i * D * 512, 0, BIGB, 0);
    conv_seg(F, INP(24) + (size_t)l * D * D, D, D, 0, D, D, nullptr, (bf16*)(wl + WL_OUT), 0, BIGB, 0);
}
__device__ __forceinline__ void conv_ffn_weights(Frame& F) {
    const float* n2 = INP(25);
    conv_seg(F, INP(26), FF, D, 0, FF, FF, n2, (bf16*)(F.ws + WS_FFUP), 0, 128, 256);
    conv_seg(F, INP(27), FF, D, 0, FF, FF, n2, (bf16*)(F.ws + WS_FFUP), 128, 128, 256);
    conv_seg(F, INP(28), D, FF, 0, D, D, nullptr, (bf16*)(F.ws + WS_FFDN), 0, 1 << 30, 0);
}
__device__ __forceinline__ void conv_moe_weights(Frame& F) {
    const float* n2 = INP(25) + D;
    for (int e = 0; e < NE; ++e) {
        bf16* up = (bf16*)(F.ws + WS_MOEW + (size_t)e * MOEW_STRIDE); bf16* dn = (bf16*)(F.ws + WS_MOEW + (size_t)e * MOEW_STRIDE + MOEW_DN);
        conv_seg(F, INP(30) + (size_t)e * D * FFE, FFE, D, 0, FFE, FFE, n2, up, 0, 128, 256);
        conv_seg(F, INP(31) + (size_t)e * D * FFE, FFE, D, 0, FFE, FFE, n2, up, 128, 128, 256);
        conv_seg(F, INP(32) + (size_t)e * FFE * D, D, FFE, 0, D, D, nullptr, dn, 0, 1 << 30, 0);
    }
}

__device__ __forceinline__ void xprep_phase(Frame& F, const float* x) {
    const int ptid = otid(), plane = ptid & 63, pwave = __builtin_amdgcn_readfirstlane(ptid >> 6); (void)plane; (void)pwave;
    const int gw = F.vcu * 8 + pwave, NGW = F.G * 8;
    bf16* xb = (bf16*)(F.ws + WS_XB); float* rstd = (float*)(F.ws + WS_RSTD);
    for (int m = gw; m < M; m += NGW) {
        const f32x4* xr = (const f32x4*)(x + (size_t)m * D) + plane;
        f32x4 v[4]; float s = 0.f;
#pragma unroll
        for (int j = 0; j < 4; ++j) { v[j] = xr[64 * j]; s += (v[j].x * v[j].x + v[j].y * v[j].y) + (v[j].z * v[j].z + v[j].w * v[j].w); }
        s = wave_sum(s);
        if (plane == 0) rstd[m] = __builtin_amdgcn_rsqf(s * (1.f / D) + 1e-6f);
        u32x2* o8 = (u32x2*)(xb + (size_t)m * D) + plane;
#pragma unroll
        for (int j = 0; j < 4; ++j) { u32x2 w; w.x = pk2(v[j].x, v[j].y); w.y = pk2(v[j].z, v[j].w); o8[64 * j] = w; }
    }
}
__device__ __forceinline__ void final_norm_phase(Frame& F) {
    const int ptid = otid(), plane = ptid & 63, pwave = __builtin_amdgcn_readfirstlane(ptid >> 6); (void)plane; (void)pwave;
    const int gw = F.vcu * 8 + pwave, NGW = F.G * 8;
    const float* fw = INP(33);
    for (int m = gw; m < M; m += NGW) {
        f32x4* xr = (f32x4*)(F.out + (size_t)m * D) + plane;
        f32x4 v[4]; float s = 0.f;
#pragma unroll
        for (int j = 0; j < 4; ++j) { v[j] = xr[64 * j]; s += (v[j].x * v[j].x + v[j].y * v[j].y) + (v[j].z * v[j].z + v[j].w * v[j].w); }
        s = wave_sum(s);
        const float r = __builtin_amdgcn_rsqf(s * (1.f / D) + 1e-6f);
#pragma unroll
        for (int j = 0; j < 4; ++j) { const f32x4 w = *((const f32x4*)fw + plane + 64 * j); xr[64 * j] = v[j] * r * w; }
    }
}
__device__ __forceinline__ void router_phase(Frame& F) {
    const int ptid = otid(), plane = ptid & 63, pwave = __builtin_amdgcn_readfirstlane(ptid >> 6);
    const float* nw = INP(25) + D; const float* rt = INP(29); float* rstd_w = (float*)(F.ws + WS_RSTD); bf16* xb = (bf16*)(F.ws + WS_XB);
    int* cnt = (int*)(F.ws + WS_CNT); int* list2 = (int*)(F.ws + WS_LIST);
    LAS int* lsel = (LAS int*)F.lds;
    LAS float* lwt = (LAS float*)(F.lds + 1024);
    LAS int* lrank = (LAS int*)(F.lds + 2048);
    LAS int* lcnt = (LAS int*)(F.lds + 3072);
    for (int blk = F.vcu; blk < M / 128; blk += F.G) {
        if (ptid < 16) lcnt[ptid] = 0;
        __syncthreads();
        for (int k = 0; k < 16; ++k) {
            const int lt = pwave * 16 + k, m = blk * 128 + lt;
            float acc[8];
#pragma unroll
            for (int e = 0; e < 8; ++e) acc[e] = 0.f;
            const f32x4* xr4 = (const f32x4*)(F.out + (size_t)m * D) + plane;
            f32x4 xv4[4]; float ssq = 0.f;
#pragma unroll
            for (int j = 0; j < 4; ++j) { xv4[j] = xr4[64 * j]; ssq += (xv4[j].x * xv4[j].x + xv4[j].y * xv4[j].y) + (xv4[j].z * xv4[j].z + xv4[j].w * xv4[j].w); }
            ssq = wave_sum(ssq);
            { u32x2* o8 = (u32x2*)(xb + (size_t)m * D) + plane;
#pragma unroll
              for (int j = 0; j < 4; ++j) { u32x2 wv; wv.x = pk2(xv4[j].x, xv4[j].y); wv.y = pk2(xv4[j].z, xv4[j].w); o8[64 * j] = wv; } }
#pragma unroll
            for (int j = 0; j < 4; ++j) { const int kk = 4 * plane + 256 * j; const f32x4 nwv = *(const f32x4*)(nw + kk);
#pragma unroll
                for (int q = 0; q < 4; ++q) { const float xv = xv4[j][q] * nwv[q];
                    const f32x4 r0v = *(const f32x4*)(rt + (size_t)(kk + q) * 8), r1v = *(const f32x4*)(rt + (size_t)(kk + q) * 8 + 4);
                    acc[0] += xv * r0v.x; acc[1] += xv * r0v.y; acc[2] += xv * r0v.z; acc[3] += xv * r0v.w; acc[4] += xv * r1v.x; acc[5] += xv * r1v.y; acc[6] += xv * r1v.z; acc[7] += xv * r1v.w; } }
            const float sc = __builtin_amdgcn_rsqf(ssq * (1.f / D) + 1e-6f);
            if (plane == 0) rstd_w[m] = sc;
#pragma unroll
            for (int e = 0; e < 8; ++e) acc[e] = wave_sum(acc[e]) * sc;
            int i0 = 0; float v0 = acc[0];
#pragma unroll
            for (int e = 1; e < 8; ++e) if (acc[e] > v0) { v0 = acc[e]; i0 = e; }
            int i1 = -1; float v1 = -3.0e38f;
#pragma unroll
            for (int e = 0; e < 8; ++e) if (e != i0 && acc[e] > v1) { v1 = acc[e]; i1 = e; }
            const float e1 = expf(v1 - v0), w0 = 1.f / (1.f + e1), w1 = e1 / (1.f + e1);
            if (plane == 0) { lsel[2 * lt] = i0; lsel[2 * lt + 1] = i1; lwt[2 * lt] = w0; lwt[2 * lt + 1] = w1;
                lrank[2 * lt] = atomicAdd((int*)(lcnt + i0), 1); lrank[2 * lt + 1] = atomicAdd((int*)(lcnt + i1), 1); }
        }
        __syncthreads();
        if (ptid < 8) lcnt[8 + ptid] = atomicAdd(cnt + ptid, lcnt[ptid]);
        __syncthreads();
        if (ptid < 256) { const int e = lsel[ptid], slot = lcnt[8 + e] + lrank[ptid];
            u32x2 v; v.x = (unsigned)(blk * 128 + (ptid >> 1)); v.y = __builtin_bit_cast(unsigned, lwt[ptid]);
            *(u32x2*)(list2 + ((size_t)e * 32768 + slot) * 2) = v; }
        __syncthreads();
    }
}

__device__ __forceinline__ void vprep_phase(Frame& F, int layer) {
    const int ptid = otid(), plane = ptid & 63, pwave = __builtin_amdgcn_readfirstlane(ptid >> 6);
    constexpr int VP = 520, V_VB = 0, V_GB = 64 * VP * 2, V_VD = 2 * 64 * VP * 2;
    LAS bf16* VB = (LAS bf16*)(F.lds + V_VB); LAS bf16* GB = (LAS bf16*)(F.lds + V_GB); LAS bf16* VD = (LAS bf16*)(F.lds + V_VD);
    const bf16* P = (const bf16*)(F.ws + WS_BIG); bf16* VF = (bf16*)(F.ws + WS_VF); bf16* VM = (bf16*)(F.ws + WS_VMIX);
    const bf16* vdT = (const bf16*)(F.ws + WS_VLORA); const bf16* vuT = vdT + 32 * 512;
    const float* mu = INP(3) + layer * 1792 + 1024; const float* v0 = INP(16);
    const int tok = ptid >> 3, part = ptid & 7, r16 = plane & 15, q4 = plane >> 4;
    for (int it = F.vcu; it < M / 64; it += F.G) {
        const int m = it * 64 + tok; const int t = m & (T - 1);
        const bf16* cur = P + (size_t)m * PLD + 1024 + part * 64;
#pragma unroll
        for (int q = 0; q < 8; ++q) { float c[8], p[8]; unpack8(*(const u32x4*)(cur + q * 8), c);
            if (t > 0) unpack8(*(const u32x4*)(cur - PLD + q * 8), p); else {
#pragma unroll
                for (int e = 0; e < 8; ++e) p[e] = 0.f; }
            const f32x4 m0 = *(const f32x4*)(mu + part * 64 + q * 8), m1 = *(const f32x4*)(mu + part * 64 + q * 8 + 4);
#pragma unroll
            for (int e = 0; e < 4; ++e) { c[e] = c[e] + (p[e] - c[e]) * m0[e]; c[4 + e] = c[4 + e] + (p[4 + e] - c[4 + e]) * m1[e]; }
            const u32x4 o = pack8(c);
            if (layer == 0) *(u32x4*)(VF + (size_t)m * 512 + part * 64 + q * 8) = o; else *(LAS u32x4*)(VB + tok * VP + part * 64 + q * 8) = o; }
        if (layer == 0) continue;
        __syncthreads();
        { const int rb = pwave & 3, jt = pwave >> 2; f32x4 acc = {0.f, 0.f, 0.f, 0.f};
#pragma unroll 4
          for (int k0 = 0; k0 < 512; k0 += 32) acc = __builtin_amdgcn_mfma_f32_16x16x32_bf16(*(const LAS bf16x8*)(VB + (16 * rb + r16) * VP + k0 + 8 * q4), *(const bf16x8*)(vdT + (size_t)(16 * jt + r16) * 512 + k0 + 8 * q4), acc, 0, 0, 0);
#pragma unroll
          for (int jj = 0; jj < 4; ++jj) VD[(16 * rb + 4 * q4 + jj) * 40 + 16 * jt + r16] = (bf16)f2bf(acc[jj]); }
        __syncthreads();
        { const int rb = pwave & 3; const bf16x8 af = *(const LAS bf16x8*)(VD + (16 * rb + r16) * 40 + 8 * q4);
#pragma unroll 4
          for (int i = 0; i < 16; ++i) { const int ct = (pwave >> 2) * 16 + i;
              const f32x4 acc = __builtin_amdgcn_mfma_f32_16x16x32_bf16(af, *(const bf16x8*)(vuT + (size_t)(16 * ct + r16) * 32 + 8 * q4), (f32x4){0.f, 0.f, 0.f, 0.f}, 0, 0, 0);
              const float vc = v0[16 * ct + r16];
#pragma unroll
              for (int jj = 0; jj < 4; ++jj) GB[(16 * rb + 4 * q4 + jj) * VP + 16 * ct + r16] = (bf16)f2bf(sigm(vc + acc[jj])); } }
        __syncthreads();
#pragma unroll
        for (int q = 0; q < 8; ++q) { float v[8], g[8], vf[8]; unpack8(*(const LAS u32x4*)(VB + tok * VP + part * 64 + q * 8), v); unpack8(*(const LAS u32x4*)(GB + tok * VP + part * 64 + q * 8), g);
            unpack8(*(const u32x4*)(VF + (size_t)m * 512 + part * 64 + q * 8), vf);
#pragma unroll
            for (int e = 0; e < 8; ++e) v[e] = v[e] + (vf[e] - v[e]) * g[e];
            *(u32x4*)(VM + (size_t)m * 512 + part * 64 + q * 8) = pack8(v); }
        __syncthreads();
    }
}
__device__ __forceinline__ void prepass_a(Frame& F) {
    const int tid = otid();
    bf16* P = (bf16*)(F.ws + WS_BIG); bf16* BND2 = (bf16*)(F.ws + WS_BND2);
    { const int ch = tid & 127; const int kind = ch >> 6, part = ch & 7;
      double invf[4];
#pragma unroll
      for (int p = 0; p < 4; ++p) invf[p] = exp(-(double)(part * 4 + p) * (9.210340371976184 / 32.0));
      for (int m = F.vcu * 4 + (tid >> 7); m < M; m += F.G * 4) {
          const int t = m & (T - 1); bf16* ptr = P + (size_t)m * PLD + C_RET + ch * 8;
          float x[8]; unpack8(*(const u32x4*)ptr, x);
#pragma unroll
          for (int p = 0; p < 4; ++p) { double rev = (double)t * invf[p] * 0.15915494309189535; rev -= floor(rev);
              const float sn = __builtin_amdgcn_sinf((float)rev), cs = __builtin_amdgcn_cosf((float)rev);
              const float x0 = x[2 * p], x1 = x[2 * p + 1]; float o0 = x0 * cs - x1 * sn, o1 = x0 * sn + x1 * cs;
              if (kind) { o0 *= 0.125f; o1 *= 0.125f; }
              x[2 * p] = o0; x[2 * p + 1] = o1; }
          *(u32x4*)ptr = pack8(x); } }
    for (int i = F.vcu * 512 + tid; i < 1024 * 3 * 128; i += F.G * 512) { const int ch = i & 127, k = (i >> 7) % 3, r = i / 384;
        if ((r & 511) != 0) *(u32x4*)(BND2 + ((size_t)r * 3 + k) * 1024 + ch * 8) = *(const u32x4*)(P + ((size_t)r * 32 - 3 + k) * PLD + C_XBC + ch * 8); }
}
__device__ __forceinline__ void prepass_conv(Frame& F, int layer) {
    const int tid = otid();
    bf16* P = (bf16*)(F.ws + WS_BIG); const bf16* BND2 = (const bf16*)(F.ws + WS_BND2);
    const float* cw = INP(17) + layer * 1024 * 4; const float* cbias = INP(18) + layer * 1024;
    const int ch = tid & 127;
    f32x4 wv[8]; float bv[8];
#pragma unroll
    for (int e = 0; e < 8; ++e) { wv[e] = *(const f32x4*)(cw + (ch * 8 + e) * 4); bv[e] = cbias[ch * 8 + e]; }
    for (int r = F.vcu * 4 + (tid >> 7); r < M / 32; r += F.G * 4) {
        float w0[8], w1[8], w2[8];
        if ((r & 511) != 0) { unpack8(*(const u32x4*)(BND2 + ((size_t)r * 3 + 0) * 1024 + ch * 8), w0); unpack8(*(const u32x4*)(BND2 + ((size_t)r * 3 + 1) * 1024 + ch * 8), w1); unpack8(*(const u32x4*)(BND2 + ((size_t)r * 3 + 2) * 1024 + ch * 8), w2); }
        else {
#pragma unroll
            for (int e = 0; e < 8; ++e) { w0[e] = 0.f; w1[e] = 0.f; w2[e] = 0.f; } }
        bf16* ptr = P + (size_t)r * 32 * PLD + C_XBC + ch * 8;
#pragma unroll 4
        for (int i = 0; i < 32; ++i) {
            float x[8], o[8]; unpack8(*(const u32x4*)(ptr + (size_t)i * PLD), x);
#pragma unroll
            for (int e = 0; e < 8; ++e) { o[e] = silu(bv[e] + wv[e][0] * w0[e] + wv[e][1] * w1[e] + wv[e][2] * w2[e] + wv[e][3] * x[e]); w0[e] = w1[e]; w1[e] = w2[e]; w2[e] = x[e]; }
            *(u32x4*)(ptr + (size_t)i * PLD) = pack8(o);
        }
    }
}
template <int CTRL> __device__ __forceinline__ float dpp_f(float v) { return __builtin_bit_cast(float, __builtin_amdgcn_update_dpp(0, __builtin_bit_cast(int, v), CTRL, 0xF, 0xF, true)); }
__device__ __forceinline__ float red8(float v) { v += dpp_f<0xB1>(v); v += dpp_f<0x4E>(v); v += dpp_f<0x141>(v); return v; }
__device__ __forceinline__ float red16(float v) { v = red8(v); v += dpp_f<0x140>(v); return v; }

__device__ __forceinline__ void rwkv_seq(Frame& F, int layer, int bh) {
    const int ptid = otid(), plane = ptid & 63, pwave = __builtin_amdgcn_readfirstlane(ptid >> 6); (void)plane; (void)pwave;
    const int b = bh >> 3, h = bh & 7;
    LAS float* L = (LAS float*)F.lds;
    LAS float *rr = L, *ww = L + 2048, *kf = L + 4096, *vv = L + 6144, *aa = L + 8192, *bb = L + 10240, *gg = L + 12288, *yy = L + 14336, *tw = L + 16384, *xa = L + 18432, *sg = L + 20480, *bon = L + 24576;
    const float* mu = INP(3) + layer * 1792; const float* w_up = INP(4) + layer * 64 * 512; const float* w0 = INP(5) + layer * 512;
    const float* a_up = INP(6) + layer * 64 * 512; const float* a0 = INP(7) + layer * 512; const float* g_up = INP(8) + layer * 128 * 512;
    const float* k_k = INP(9) + layer * 512; const float* k_a = INP(10) + layer * 512; const float* r_k = INP(11) + layer * 512;
    const float* gn_w = INP(12) + layer * 512; const float* gn_b = INP(13) + layer * 512;
    const bf16* P = (const bf16*)(F.ws + WS_BIG); const bf16* vsrc = (const bf16*)(F.ws + (layer == 0 ? WS_VF : WS_VMIX)); bf16* yout = (bf16*)(F.ws + WS_YRW);
    const int tid = ptid, tok = tid >> 4, part = tid & 15, c4 = part * 4, cb = h * 64 + c4;
    const int srow = tid >> 3, sc0 = (tid & 7) * 8;
    float S[8];
#pragma unroll
    for (int j = 0; j < 8; ++j) S[j] = 0.f;
    for (int t0 = 0; t0 < T; t0 += 32) {
        {
            const int t = t0 + tok; const size_t m = (size_t)b * T + t;
            const bf16* cur = P + m * PLD;
#pragma unroll
            for (int q = 0; q < 3; ++q) {
                const int ch = part + 16 * q; int col, kind; LAS float* dst;
                if (ch < 8) { col = h * 64 + ch * 8; dst = rr + tok * 64 + ch * 8; kind = 0; }
                else if (ch < 16) { col = 512 + h * 64 + (ch - 8) * 8; dst = kf + tok * 64 + (ch - 8) * 8; kind = 0; }
                else if (ch < 24) { col = 1536 + (ch - 16) * 8; dst = tw + tok * 64 + (ch - 16) * 8; kind = 1; }
                else if (ch < 32) { col = 1600 + (ch - 24) * 8; dst = xa + tok * 64 + (ch - 24) * 8; kind = 0; }
                else { col = 1664 + (ch - 32) * 8; dst = sg + tok * 128 + (ch - 32) * 8; kind = 2; }
                float c[8], p[8]; unpack8(*(const u32x4*)(cur + col), c);
                if (t > 0) unpack8(*(const u32x4*)(cur - PLD + col), p); else {
#pragma unroll
                    for (int e = 0; e < 8; ++e) p[e] = 0.f; }
#pragma unroll
                for (int e = 0; e < 8; ++e) { float x = c[e] + (p[e] - c[e]) * mu[col + e]; if (kind == 1) x = tanhf(x); else if (kind == 2) x = sigm(x); dst[e] = x; }
            }
            if (part < 8) { float v[8]; unpack8(*(const u32x4*)(vsrc + m * 512 + h * 64 + part * 8), v);
#pragma unroll
                for (int e = 0; e < 8; ++e) vv[tok * 64 + part * 8 + e] = v[e]; }
        }
        __syncthreads();
        {
            f32x4 dw = *(const f32x4*)(w0 + cb), da = *(const f32x4*)(a0 + cb), dg = (f32x4){0.f, 0.f, 0.f, 0.f};
            for (int j = 0; j < 64; ++j) { const float tj = tw[tok * 64 + j], xj = xa[tok * 64 + j];
                dw += *(const f32x4*)(w_up + j * 512 + cb) * tj; da += *(const f32x4*)(a_up + j * 512 + cb) * xj; }
            for (int j = 0; j < 128; ++j) dg += *(const f32x4*)(g_up + j * 512 + cb) * sg[tok * 128 + j];
            float kr[4], kk[4], av[4], ss = 0.f;
#pragma unroll
            for (int e = 0; e < 4; ++e) { kr[e] = kf[tok * 64 + c4 + e]; kk[e] = kr[e] * k_k[cb + e]; ss += kk[e] * kk[e]; av[e] = sigm(da[e]); }
            ss = red16(ss);
            const float inv = __builtin_amdgcn_rsqf(fmaxf(ss, 1e-24f));
            float bs = 0.f;
#pragma unroll
            for (int e = 0; e < 4; ++e) { const float kn = kk[e] * inv; const int o = tok * 64 + c4 + e;
                const float ld = -expf(-softplus_acc(-dw[e]) - 0.5f);
                ww[o] = expf(ld); aa[o] = -kn; bb[o] = kn * av[e];
                const float knew = kr[e] * (1.f + (av[e] - 1.f) * k_a[cb + e]); kf[o] = knew; gg[o] = dg[e];
                bs += rr[o] * knew * r_k[cb + e]; }
            bs = red16(bs);
            if (part == 0) bon[tok] = bs;
        }
        __syncthreads();
        for (int s = 0; s < 32; ++s) {
            const f32x4 a0v = *(const LAS f32x4*)(aa + s * 64 + sc0), a1v = *(const LAS f32x4*)(aa + s * 64 + sc0 + 4);
            const f32x4 w0v = *(const LAS f32x4*)(ww + s * 64 + sc0), w1v = *(const LAS f32x4*)(ww + s * 64 + sc0 + 4);
            const f32x4 b0v = *(const LAS f32x4*)(bb + s * 64 + sc0), b1v = *(const LAS f32x4*)(bb + s * 64 + sc0 + 4);
            const f32x4 k0v = *(const LAS f32x4*)(kf + s * 64 + sc0), k1v = *(const LAS f32x4*)(kf + s * 64 + sc0 + 4);
            const f32x4 r0v = *(const LAS f32x4*)(rr + s * 64 + sc0), r1v = *(const LAS f32x4*)(rr + s * 64 + sc0 + 4);
            const float vi = vv[s * 64 + srow];
            float sa = 0.f;
#pragma unroll
            for (int j = 0; j < 4; ++j) sa += S[j] * a0v[j] + S[4 + j] * a1v[j];
            sa = red8(sa);
            float y = 0.f;
#pragma unroll
            for (int j = 0; j < 4; ++j) { S[j] = S[j] * w0v[j] + sa * b0v[j] + vi * k0v[j]; S[4 + j] = S[4 + j] * w1v[j] + sa * b1v[j] + vi * k1v[j]; y += S[j] * r0v[j] + S[4 + j] * r1v[j]; }
            y = red8(y);
            if ((tid & 7) == 0) yy[s * 64 + srow] = y;
        }
        __syncthreads();
        {
            const size_t m = (size_t)b * T + t0 + tok;
            float y[4], sm = 0.f;
#pragma unroll
            for (int e = 0; e < 4; ++e) { y[e] = yy[tok * 64 + c4 + e]; sm += y[e]; }
            const float mean = red16(sm) * (1.f / 64.f);
            float vs = 0.f;
#pragma unroll
            for (int e = 0; e < 4; ++e) { y[e] -= mean; vs += y[e] * y[e]; }
            const float rs = __builtin_amdgcn_rsqf(red16(vs) * (1.f / 64.f) + 64e-5f);
            const float bo = bon[tok];
            float o[4];
#pragma unroll
            for (int e = 0; e < 4; ++e) { const int idx = tok * 64 + c4 + e; o[e] = (y[e] * rs * gn_w[cb + e] + gn_b[cb + e] + bo * vv[idx]) * gg[idx]; }
            u32x2 w; w.x = pk2(o[0], o[1]); w.y = pk2(o[2], o[3]);
            *(u32x2*)(yout + m * 512 + cb) = w;
        }
        __syncthreads();
    }
}

__device__ __forceinline__ void ret_seq(Frame& F, int bh) {
    const int ptid = otid(), plane = ptid & 63, pwave = __builtin_amdgcn_readfirstlane(ptid >> 6); (void)plane; (void)pwave;
    const int b = bh >> 3, h = bh & 7;
    LAS float* L = (LAS float*)F.lds;
    LAS float *qq = L, *kk = L + 2048, *vv = L + 4096, *gg = L + 6144, *yy = L + 8192;
    bf16* P = (bf16*)(F.ws + WS_BIG);
    const int tid = ptid, tok = tid >> 4, part = tid & 15, c4 = part * 4;
    const int se = tid >> 3, sd0 = (tid & 7) * 8;
    const float gamma = 1.f - exp2f(-5.f - (float)h);
    float S[8];
#pragma unroll
    for (int j = 0; j < 8; ++j) S[j] = 0.f;
    for (int t0 = 0; t0 < T; t0 += 32) {
        {
            const int t = t0 + tok; const size_t m = (size_t)b * T + t;
#pragma unroll
            for (int q = 0; q < 2; ++q) {
                const int ch = part + 16 * q, kind = ch >> 3, cc = ch & 7;
                float x[8]; unpack8(*(const u32x4*)(P + m * PLD + C_RET + kind * 512 + h * 64 + cc * 8), x);
                LAS float* dst = (kind == 0 ? qq : kind == 1 ? kk : kind == 2 ? vv : gg) + tok * 64 + cc * 8;
                if (kind < 2) {
#pragma unroll
                    for (int p = 0; p < 4; ++p) { const int i = cc * 4 + p;
                        const double invf = exp(-(double)i * (9.210340371976184 / 32.0));
                        double sn, cs; sincos((double)t * invf, &sn, &cs);
                        const float x0 = x[2 * p], x1 = x[2 * p + 1], c = (float)cs, s = (float)sn;
                        float o0 = x0 * c - x1 * s, o1 = x0 * s + x1 * c;
                        if (kind == 1) { o0 *= 0.125f; o1 *= 0.125f; }
                        dst[2 * p] = o0; dst[2 * p + 1] = o1; }
                } else {
#pragma unroll
                    for (int e = 0; e < 8; ++e) dst[e] = x[e];
                }
            }
        }
        __syncthreads();
        for (int s = 0; s < 32; ++s) {
            const f32x4 k0v = *(const LAS f32x4*)(kk + s * 64 + sd0), k1v = *(const LAS f32x4*)(kk + s * 64 + sd0 + 4);
            const f32x4 q0v = *(const LAS f32x4*)(qq + s * 64 + sd0), q1v = *(const LAS f32x4*)(qq + s * 64 + sd0 + 4);
            const float ve = vv[s * 64 + se];
            float y = 0.f;
#pragma unroll
            for (int j = 0; j < 4; ++j) { S[j] = gamma * S[j] + k0v[j] * ve; S[4 + j] = gamma * S[4 + j] + k1v[j] * ve; y += q0v[j] * S[j] + q1v[j] * S[4 + j]; }
            y = red8(y);
            if ((tid & 7) == 0) yy[s * 64 + se] = y;
        }
        __syncthreads();
        {
            const size_t m = (size_t)b * T + t0 + tok;
            float y[4], ss = 0.f;
#pragma unroll
            for (int e = 0; e < 4; ++e) { y[e] = yy[tok * 64 + c4 + e]; ss += y[e] * y[e]; }
            const float rs = __builtin_amdgcn_rsqf(red16(ss) * (1.f / 64.f) + 1e-6f);
            float o[4];
#pragma unroll
            for (int e = 0; e < 4; ++e) o[e] = y[e] * rs * silu(gg[tok * 64 + c4 + e]);
            u32x2 w; w.x = pk2(o[0], o[1]); w.y = pk2(o[2], o[3]);
            *(u32x2*)(P + m * PLD + C_RETG + h * 64 + c4) = w;
        }
        __syncthreads();
    }
}

__device__ __forceinline__ void ssd_seq(Frame& F, int layer, int bh) {
    const int ptid = otid(), plane = ptid & 63, pwave = __builtin_amdgcn_readfirstlane(ptid >> 6); (void)plane; (void)pwave;
    const int b = bh >> 3, h = bh & 7, g = h >> 2;
    LAS float* L = (LAS float*)F.lds;
    LAS float *raw = L  , *xs = L + 11200, *Bc = L + 13248, *Cc = L + 17344, *yy = L + 21440, *dts = L + 23488, *das = L + 23520;
    bf16* P = (bf16*)(F.ws + WS_BIG); const float* dtb = (const float*)(F.ws + WS_DT);
    const float* cw = INP(17) + layer * 1024 * 4; const float* cbias = INP(18) + layer * 1024;
    const float dt_bias = INP(19)[layer * 8 + h], A = -expf(INP(20)[layer * 8 + h]), Dh = INP(21)[layer * 8 + h];
    const int tid = ptid;
    const int sp = tid >> 3, sn0 = (tid & 7) * 16;
    float S[16];
#pragma unroll
    for (int j = 0; j < 16; ++j) S[j] = 0.f;
    for (int i = tid; i < 3 * 320; i += 512) raw[i] = 0.f;
    __syncthreads();
    for (int t0 = 0; t0 < T; t0 += 32) {
        for (int idx = tid; idx < 32 * 40; idx += 512) {
            const int row = idx / 40, ch = idx % 40; const size_t m = (size_t)b * T + t0 + row;
            const int col = ch < 8 ? (C_XBC + h * 64 + ch * 8) : (ch < 24 ? (C_XBC + 512 + g * 128 + (ch - 8) * 8) : (C_XBC + 768 + g * 128 + (ch - 24) * 8));
            float x[8]; unpack8(*(const u32x4*)(P + m * PLD + col), x);
#pragma unroll
            for (int e = 0; e < 8; ++e) raw[(3 + row) * 320 + ch * 8 + e] = x[e];
        }
        if (tid < 32) { const size_t m = (size_t)b * T + t0 + tid; const float dt = softplus_acc(dtb[m * 8 + h] + dt_bias); dts[tid] = dt; das[tid] = expf(A * dt); }
        __syncthreads();
        for (int idx = tid; idx < 32 * 320; idx += 512) {
            const int row = idx / 320, c = idx % 320;
            const int chn = c < 64 ? (h * 64 + c) : (c < 192 ? (512 + g * 128 + (c - 64)) : (768 + g * 128 + (c - 192)));
            float a = cbias[chn];
#pragma unroll
            for (int k = 0; k < 4; ++k) a += cw[chn * 4 + k] * raw[(row + k) * 320 + c];
            a = silu(a);
            if (c < 64) xs[row * 64 + c] = a; else if (c < 192) Bc[row * 128 + (c - 64)] = a; else Cc[row * 128 + (c - 192)] = a;
        }
        __syncthreads();
        for (int s = 0; s < 32; ++s) {
            const float da = das[s], xv = xs[s * 64 + sp], dtx = dts[s] * xv;
            float y = 0.f;
#pragma unroll
            for (int q = 0; q < 4; ++q) { const f32x4 bv = *(const LAS f32x4*)(Bc + s * 128 + sn0 + q * 4), cv = *(const LAS f32x4*)(Cc + s * 128 + sn0 + q * 4);
#pragma unroll
                for (int j = 0; j < 4; ++j) { S[q * 4 + j] = da * S[q * 4 + j] + dtx * bv[j]; y += S[q * 4 + j] * cv[j]; } }
            y = red8(y);
            if ((tid & 7) == 0) yy[s * 64 + sp] = y + Dh * xv;
        }
        __syncthreads();
        {
            const int tok = tid >> 4, c4 = (tid & 15) * 4; const size_t m = (size_t)b * T + t0 + tok;
            u32x2 w; w.x = pk2(yy[tok * 64 + c4], yy[tok * 64 + c4 + 1]); w.y = pk2(yy[tok * 64 + c4 + 2], yy[tok * 64 + c4 + 3]);
            *(u32x2*)(P + m * PLD + C_XBC + h * 64 + c4) = w;
            for (int i = tid; i < 3 * 320; i += 512) raw[i] = raw[32 * 320 + i];
        }
        __syncthreads();
    }
}
__device__ __forceinline__ void ssm_norm_phase(Frame& F, int layer) {
    const int ptid = otid(), plane = ptid & 63, pwave = __builtin_amdgcn_readfirstlane(ptid >> 6); (void)plane; (void)pwave;
    const int gw = F.vcu * 8 + pwave, NGW = F.G * 8;
    bf16* P = (bf16*)(F.ws + WS_BIG); const float* nw = INP(22) + layer * 512;
    for (int m = gw; m < M; m += NGW) {
        float y[8], z[8]; unpack8(*(const u32x4*)(P + (size_t)m * PLD + C_XBC + plane * 8), y); unpack8(*(const u32x4*)(P + (size_t)m * PLD + C_Z + plane * 8), z);
        float ss = 0.f;
#pragma unroll
        for (int e = 0; e < 8; ++e) { y[e] *= silu(z[e]); ss += y[e] * y[e]; }
        ss += __shfl_xor(ss, 1); ss += __shfl_xor(ss, 2); ss += __shfl_xor(ss, 4); ss += __shfl_xor(ss, 8); ss += __shfl_xor(ss, 16);
        const float rs = __builtin_amdgcn_rsqf(ss * (1.f / 256.f) + 1e-6f);
#pragma unroll
        for (int e = 0; e < 8; ++e) y[e] *= rs * nw[plane * 8 + e];
        *(u32x4*)(P + (size_t)m * PLD + C_Z + plane * 8) = pack8(y);
    }
}

constexpr int PT = 72, PT2 = 136, PF = 68;
__device__ __forceinline__ f32x4 mfma16(bf16x8 a, bf16x8 b, f32x4 c) { return __builtin_amdgcn_mfma_f32_16x16x32_bf16(a, b, c, 0, 0, 0); }
template <int K, bool SA = false, bool SB = false> __device__ __forceinline__ f32x4 mm_ll(const LAS bf16* A, int pa, int m0, const LAS bf16* B, int pb, int n0, f32x4 acc, int lane) {
    const int r = lane & 15, q = lane >> 4;
    const int xa = SA ? (((m0 + r) >> 3) & 7) : 0, xb = SB ? (((n0 + r) >> 3) & 7) : 0;
    const LAS bf16* ap = A + (m0 + r) * pa; const LAS bf16* bp = B + (n0 + r) * pb;
#pragma unroll
    for (int k0 = 0; k0 < K; k0 += 32) acc = mfma16(*(const LAS bf16x8*)(ap + 8 * (((k0 >> 3) + q) ^ xa)), *(const LAS bf16x8*)(bp + 8 * (((k0 >> 3) + q) ^ xb)), acc);
    return acc;
}
template <int K> __device__ __forceinline__ f32x4 mm_lg(const LAS bf16* A, int pa, int m0, const bf16* B, int pb, int n0, f32x4 acc, int lane) {
    const int r = lane & 15, q = lane >> 4;
    const LAS bf16* ap = A + (m0 + r) * pa + 8 * q; const bf16* bp = B + (size_t)(n0 + r) * pb + 8 * q;
#pragma unroll
    for (int k0 = 0; k0 < K; k0 += 32) acc = mfma16(*(const LAS bf16x8*)(ap + k0), *(const bf16x8*)(bp + k0), acc);
    return acc;
}
__device__ __forceinline__ float redl16(float v) { return red16(v); }
__device__ __forceinline__ void st4bf(LAS bf16* p, f32x4 v) { u32x2 w; w.x = pk2(v[0], v[1]); w.y = pk2(v[2], v[3]); *(LAS u32x2*)p = w; }
__device__ __forceinline__ float ldbf(const LAS bf16* p) { return __builtin_bit_cast(float, (unsigned)(*p) << 16); }
constexpr f32x4 FZ4 = {0.f, 0.f, 0.f, 0.f};
__device__ __forceinline__ void tr_write8(LAS bf16* Tm, int pitch, int c0, int t, const float (&v)[8], int) {
    LAS bf16* base = Tm + c0 * pitch + (t ^ (((c0 >> 3) & 7) << 3));
#pragma unroll
    for (int e = 0; e < 8; ++e) base[e * pitch] = (bf16)f2bf(v[e]);
}
__device__ __forceinline__ float tr_at(const LAS bf16* Tm, int pitch, int row, int col) { return __builtin_bit_cast(float, (unsigned)Tm[row * pitch + (col ^ (((row >> 3) & 7) << 3))] << 16); }
__device__ __forceinline__ void ld8f(const LAS float* p, float (&v)[8]) { const f32x4 a = *(const LAS f32x4*)p, b = *(const LAS f32x4*)(p + 4); v[0] = a[0]; v[1] = a[1]; v[2] = a[2]; v[3] = a[3]; v[4] = b[0]; v[5] = b[1]; v[6] = b[2]; v[7] = b[3]; }
__device__ __forceinline__ void st8f(LAS float* p, const float (&v)[8]) { *(LAS f32x4*)p = (f32x4){v[0], v[1], v[2], v[3]}; *(LAS f32x4*)(p + 4) = (f32x4){v[4], v[5], v[6], v[7]}; }

template <bool FINAL>
__device__ __forceinline__ void rwkv_chunk_unit(Frame& F, int layer, int u) {
    const int tid = otid(), w = __builtin_amdgcn_readfirstlane(tid >> 6);
    bf16x8 lfr[16];
#define IDS() const int ft = fresh_tid(tid); const int lane = ft & 63, r16 = lane & 15, q4 = lane >> 4, tok = ft >> 3, part = ft & 7; (void)lane; (void)r16; (void)q4; (void)tok; (void)part
    const int b = u >> 9, sc = (u >> 3) & 63, h = u & 7;
    constexpr int NV = FINAL ? 64 : 128, NVT = NV / 16, NZ = NVT / 2;
    constexpr int X_TW = 0, X_XA = 9216, X_SG = 18432, X_KF = 35840, X_RF = 52224;
    constexpr int O_AT = 0, O_RT = 9216, O_BT = 18432, O_KT = 27648, O_BH = 36864, O_KH = 46080, O_VT = 55296, O_TF = O_BT;
    constexpr int Y0 = 68608;
    constexpr int Y_A = Y0, Y_B = Y0 + 8192, Y_K = Y0 + 16384, Y_R = Y0 + 24576, Y_L = Y0 + 32768, Y_VF = Y0 + 49152;
    constexpr int Y_AAB = Y0, Y_AAK = Y0 + 17408, Y_ARB = Y_AAK + 9216, Y_ARK = Y_ARB + 9216, Y_TB = FINAL ? Y_ARK + 9216 : Y_AAK + 9216, Y_ZU = Y_TB + 9216, Y_YF = Y_AAB;
    static_assert(Y_ZU + NV * PT * 2 <= Y0 + 65536, "region Y");
    constexpr int Z0 = Y0 + 65536, Z_G = Z0, Z_S = FINAL ? Z0 + 8192 : Z0, Z_MISC = 152576, Z_BON = Z_MISC, Z_PC = Z_MISC + 256, Z_PAR = Z_MISC + 512, Z_XS = Y_ZU;
    static_assert(Z_S + NV * PT * 2 <= Z_MISC && Z_PAR + 832 * 4 <= LDSCTL_OFF, "region Z");
    LAS unsigned char* L = F.lds;
#define LB(off) ((LAS bf16*)(L + (off)))
#define LF(off) ((LAS float*)(L + (off)))
    {
        const int pidx = (w == 0) ? 5 : (w == 1) ? 7 : (w == 2) ? 9 : (w == 3) ? 10 : (w == 4) ? 11 : (w == 5) ? 12 : 13;
        if (w < 7) LF(Z_PAR)[w * 64 + (tid & 63)] = (INP(pidx) + layer * 512 + h * 64)[tid & 63];
        const float* mu = INP(3) + layer * 1792;
        for (int i = tid; i < 384; i += 512) LF(Z_PAR)[448 + i] = mu[(i < 64) ? (h * 64 + i) : (i < 128) ? (512 + h * 64 + (i - 64)) : (1536 + (i - 128))];
    }
    __syncthreads();
    const bf16* WupT = (const bf16*)(F.ws + WS_LORA + (size_t)layer * LORA_STRIDE) + h * 64 * 64;
    const bf16* AupT = (const bf16*)(F.ws + WS_LORA + (size_t)layer * LORA_STRIDE + 65536) + h * 64 * 64;
    const bf16* GupT = (const bf16*)(F.ws + WS_LORA + (size_t)layer * LORA_STRIDE + 131072) + h * 64 * 128;
    const bf16* P = (const bf16*)(F.ws + WS_BIG); const bf16* vsrc = (const bf16*)(F.ws + (layer == 0 ? WS_VF : WS_VMIX));
    float* Nbuf = (float*)(F.st + 0) + (size_t)u * 4096; bf16* MT = (bf16*)(F.ws + WS_MT) + (size_t)u * 4096;
    { IDS();
        if (w < 4) {
#pragma unroll
            for (int nt = 0; nt < 4; ++nt)
#pragma unroll
                for (int k2 = 0; k2 < 2; ++k2) { lfr[nt * 4 + k2] = *(const bf16x8*)(WupT + (size_t)(16 * nt + r16) * 64 + 32 * k2 + 8 * q4); lfr[nt * 4 + 2 + k2] = *(const bf16x8*)(AupT + (size_t)(16 * nt + r16) * 64 + 32 * k2 + 8 * q4); }
        } else if (FINAL) {
#pragma unroll
            for (int nt = 0; nt < 4; ++nt)
#pragma unroll
                for (int k4 = 0; k4 < 4; ++k4) lfr[nt * 4 + k4] = *(const bf16x8*)(GupT + (size_t)(16 * nt + r16) * 128 + 32 * k4 + 8 * q4);
        } }
    constexpr int NST = FINAL ? 2 : 4;
    f32x4 Sacc[NST];
    const int s_vb = FINAL ? (w & 3) : w;
#define S_CT(ti) (FINAL ? (2 * (w >> 2) + (ti)) : (ti))
    { IDS();
#pragma unroll
    for (int ti = 0; ti < NST; ++ti) {
        const int ct = S_CT(ti);
#pragma unroll
        for (int jj = 0; jj < 4; ++jj) { const int v = 16 * s_vb + 4 * q4 + jj, c = 16 * ct + r16;
            float x; if (FINAL) x = Nbuf[v * 64 + c]; else x = (v >= 64 && v - 64 == c) ? 1.f : 0.f;
            Sacc[ti][jj] = x; LB(Z_S)[v * PT + c] = (bf16)f2bf(x); }
    } }
    u32x4 pfc[6], pfp[6], pfv;
#define RW_PREFETCH(jn) do { IDS(); const int t_ = sc * 256 + (jn) * 64 + tok; const size_t m_ = (size_t)b * T + t_; const bf16* cur_ = P + m_ * PLD; \
        _Pragma("unroll") for (int i_ = 0; i_ < 6; ++i_) { const int col_ = (i_ == 0) ? (h * 64 + 8 * part) : (i_ == 1) ? (512 + h * 64 + 8 * part) : (i_ == 2) ? (1536 + 8 * part) : (i_ == 3) ? (1600 + 8 * part) : (1664 + 8 * part + (i_ - 4) * 64); \
            pfc[i_] = *(const u32x4*)(cur_ + col_); pfp[i_] = (t_ > 0) ? *(const u32x4*)(cur_ - PLD + col_) : (u32x4){0u, 0u, 0u, 0u}; } \
        pfv = *(const u32x4*)(vsrc + m_ * 512 + h * 64 + 8 * part); } while (0)
    RW_PREFETCH(0);
    for (int j = 0; j < 4; ++j) {
        const int tl0 = sc * 256 + j * 64;
        {
            IDS();
            const int t = tl0 + tok; const size_t m = (size_t)b * T + t; const bf16* cur = P + m * PLD;
#pragma unroll
            for (int i = 0; i < 6; ++i) {
                const int col = (i == 0) ? (h * 64 + 8 * part) : (i == 1) ? (512 + h * 64 + 8 * part) : (i == 2) ? (1536 + 8 * part) : (i == 3) ? (1600 + 8 * part) : (1664 + 8 * part + (i - 4) * 64);
                float c[8], p[8]; unpack8(pfc[i], c); unpack8(pfp[i], p); (void)col;
#pragma unroll
                for (int e = 0; e < 8; ++e) c[e] = c[e] + (p[e] - c[e]) * LF(Z_PAR)[448 + ((i < 4) ? 64 * i : 256 + 64 * (i - 4)) + 8 * part + e];
                if (i == 0) { st8f(LF(X_RF) + tok * 64 + 8 * part, c);
                } else if (i == 1) { st8f(LF(X_KF) + tok * 64 + 8 * part, c);
                } else if (i == 2) {
#pragma unroll
                    for (int e = 0; e < 8; ++e) c[e] = fast_tanh(c[e]);
                    *(LAS u32x4*)(LB(X_TW) + tok * PT + 8 * part) = pack8(c);
                } else if (i == 3) {
                    *(LAS u32x4*)(LB(X_XA) + tok * PT + 8 * part) = pack8(c);
                } else if (FINAL) {
#pragma unroll
                    for (int e = 0; e < 8; ++e) c[e] = sigm(c[e]);
                    *(LAS u32x4*)(LB(X_SG) + tok * PT2 + 8 * part + (i - 4) * 64) = pack8(c);
                }
            }
            float v[8]; unpack8(pfv, v); (void)m; (void)cur;
            st8f(LF(Y_VF) + tok * 64 + 8 * part, v);
        }
        if (j < 3) RW_PREFETCH(j + 1);
        __syncthreads();
        { IDS();
        if (w < 4) {
            const int rb = w;
            float inv[4], bs[4] = {0.f, 0.f, 0.f, 0.f};
            { float ss[4] = {0.f, 0.f, 0.f, 0.f};
#pragma unroll
                for (int nt = 0; nt < 4; ++nt) { const int c = 16 * nt + r16; const float kkc = LF(Z_PAR)[128 + c];
#pragma unroll
                    for (int jj = 0; jj < 4; ++jj) { const float kk = LF(X_KF)[(16 * rb + 4 * q4 + jj) * 64 + c] * kkc; ss[jj] += kk * kk; } }
#pragma unroll
                for (int jj = 0; jj < 4; ++jj) inv[jj] = __builtin_amdgcn_rsqf(fmaxf(redl16(ss[jj]), 1e-24f)); }
#pragma unroll
            for (int nt = 0; nt < 4; ++nt) {
                f32x4 aw = FZ4, aa = FZ4;
#pragma unroll
                for (int k2 = 0; k2 < 2; ++k2) { aw = mfma16(*(const LAS bf16x8*)(LB(X_TW) + (16 * rb + r16) * PT + 32 * k2 + 8 * q4), lfr[nt * 4 + k2], aw); aa = mfma16(*(const LAS bf16x8*)(LB(X_XA) + (16 * rb + r16) * PT + 32 * k2 + 8 * q4), lfr[nt * 4 + 2 + k2], aa); }
                const int c = 16 * nt + r16; const float w0c = LF(Z_PAR)[c], a0c = LF(Z_PAR)[64 + c], kkc = LF(Z_PAR)[128 + c], kac = LF(Z_PAR)[192 + c], rkc = LF(Z_PAR)[256 + c];
#pragma unroll
                for (int jj = 0; jj < 4; ++jj) { const int t = 16 * rb + 4 * q4 + jj, o = t * 64 + c;
                    LF(Y_L)[o] = -0.8750455979f * sigm(w0c + aw[jj]);
                    const float al = sigm(a0c + aa[jj]), kraw = LF(X_KF)[o], rr = LF(X_RF)[o], kn = kraw * kkc * inv[jj];
                    const float knew = kraw * (1.f + (al - 1.f) * kac);
                    LB(Y_A)[o] = (bf16)f2bf(-kn); LB(Y_B)[o] = (bf16)f2bf(kn * al); LB(Y_K)[o] = (bf16)f2bf(knew); LB(Y_R)[o] = (bf16)f2bf(rr);
                    bs[jj] += rr * knew * rkc; } }
#pragma unroll
            for (int jj = 0; jj < 4; ++jj) { const float sm = redl16(bs[jj]); if (r16 == 0) LF(Z_BON)[16 * rb + 4 * q4 + jj] = sm; }
        } else if (FINAL) {
            const int rb = w - 4;
#pragma unroll
            for (int nt = 0; nt < 4; ++nt) { f32x4 ag = FZ4;
#pragma unroll
                for (int k4 = 0; k4 < 4; ++k4) ag = mfma16(*(const LAS bf16x8*)(LB(X_SG) + (16 * rb + r16) * PT2 + 32 * k4 + 8 * q4), lfr[nt * 4 + k4], ag);
#pragma unroll
                for (int jj = 0; jj < 4; ++jj) LB(Z_G)[(16 * rb + 4 * q4 + jj) * 64 + 16 * nt + r16] = (bf16)f2bf(ag[jj]); }
        } }
        __syncthreads();
        if (w == 0) { IDS(); float run = 0.f;
#pragma unroll 8
            for (int t = 0; t < 64; ++t) { run += LF(Y_L)[t * 64 + lane]; LF(Y_L)[t * 64 + lane] = run; }
            LF(Z_PC)[lane] = ex2(run); }
        __syncthreads();
        {
            IDS(); const int t = tok, c0 = 8 * part;
            float Lt[8], Lp[8], Le[8], av[8], bv[8], kv[8], rv[8], vv[8], at[8], rt[8], bt[8], kt[8], bh[8], kh[8];
            ld8f(LF(Y_L) + t * 64 + c0, Lt); ld8f(LF(Y_L) + 63 * 64 + c0, Le); ld8f(LF(Y_VF) + t * 64 + c0, vv);
            if (t > 0) ld8f(LF(Y_L) + (t - 1) * 64 + c0, Lp); else {
#pragma unroll
                for (int e = 0; e < 8; ++e) Lp[e] = 0.f; }
            unpack8(*(const LAS u32x4*)(LB(Y_A) + t * 64 + c0), av); unpack8(*(const LAS u32x4*)(LB(Y_B) + t * 64 + c0), bv);
            unpack8(*(const LAS u32x4*)(LB(Y_K) + t * 64 + c0), kv); unpack8(*(const LAS u32x4*)(LB(Y_R) + t * 64 + c0), rv);
#pragma unroll
            for (int e = 0; e < 8; ++e) { const float eL = ex2(Lt[e]), eLm = ex2(Lp[e]), eN = ex2(-Lt[e]), eE = ex2(Le[e] - Lt[e]);
                at[e] = av[e] * eLm; rt[e] = rv[e] * eL; bt[e] = bv[e] * eN; kt[e] = kv[e] * eN; bh[e] = bv[e] * eE; kh[e] = kv[e] * eE; }
            tr_write8(LB(O_BH), PT, c0, t, bh, part); tr_write8(LB(O_KH), PT, c0, t, kh, part); tr_write8(LB(O_VT), PT, c0, t, vv, part);
            *(LAS u32x4*)(LB(O_AT) + t * PT + c0) = pack8(at); *(LAS u32x4*)(LB(O_RT) + t * PT + c0) = pack8(rt);
            *(LAS u32x4*)(LB(O_BT) + t * PT + c0) = pack8(bt); *(LAS u32x4*)(LB(O_KT) + t * PT + c0) = pack8(kt);
        }
        __syncthreads();
        {
            IDS(); const int rb = w & 3;
#pragma unroll
            for (int ci = 0; ci < 2; ++ci) { const int ct = 2 * (w >> 2) + ci;
                f32x4 ab = FZ4, ak = FZ4, arb = FZ4, ark = FZ4;
                if (ct <= rb) { ab = mm_ll<64>(LB(O_AT), PT, 16 * rb, LB(O_BT), PT, 16 * ct, FZ4, lane); ak = mm_ll<64>(LB(O_AT), PT, 16 * rb, LB(O_KT), PT, 16 * ct, FZ4, lane);
                    if (FINAL) { arb = mm_ll<64>(LB(O_RT), PT, 16 * rb, LB(O_BT), PT, 16 * ct, FZ4, lane); ark = mm_ll<64>(LB(O_RT), PT, 16 * rb, LB(O_KT), PT, 16 * ct, FZ4, lane); } }
#pragma unroll
                for (int jj = 0; jj < 4; ++jj) { const int t = 16 * rb + 4 * q4 + jj, i = 16 * ct + r16;
                    LF(Y_AAB)[t * PF + i] = (i < t) ? ab[jj] : 0.f; LB(Y_TB)[t * PT + i] = (bf16)f2bf(((i >> 4) < (t >> 4)) ? ab[jj] : 0.f); LB(Y_AAK)[t * PT + i] = (bf16)f2bf((i < t) ? ak[jj] : 0.f);
                    if (FINAL) { LB(Y_ARB)[t * PT + i] = (bf16)f2bf((i <= t) ? arb[jj] : 0.f); LB(Y_ARK)[t * PT + i] = (bf16)f2bf((i <= t) ? ark[jj] : 0.f); } } }
        }
        __syncthreads();
        {
            IDS(); const int rb = w & 3;
            constexpr int O_DB = O_BT, O_VB = O_BT + 5120;
            if (w == 0) { const int blk = lane >> 4, col = lane & 15; float x[16];
#pragma unroll
                for (int i = 0; i < 16; ++i) x[i] = (i == col) ? 1.f : 0.f;
#pragma unroll
                for (int i = 1; i < 16; ++i) { float sacc = 0.f; asm volatile("" ::: "memory");
#pragma unroll
                    for (int m2 = 0; m2 < i; ++m2) sacc += LF(Y_AAB)[(16 * blk + i) * PF + 16 * blk + m2] * x[m2];
                    x[i] += sacc; }
#pragma unroll
                for (int i = 0; i < 16; ++i) LB(O_DB)[(16 * blk + i) * 40 + col] = (bf16)f2bf(x[i]);
                *(LAS u32x4*)(LB(O_DB) + lane * 40 + 16) = (u32x4){0u, 0u, 0u, 0u}; *(LAS u32x4*)(LB(O_DB) + lane * 40 + 24) = (u32x4){0u, 0u, 0u, 0u}; }
            if (lane < 16) { *(LAS u32x4*)(LB(O_VB) + w * 640 + lane * 40 + 16) = (u32x4){0u, 0u, 0u, 0u}; *(LAS u32x4*)(LB(O_VB) + w * 640 + lane * 40 + 24) = (u32x4){0u, 0u, 0u, 0u}; }
#pragma unroll
            for (int ci = 0; ci < NZ; ++ci) { const int vt = (w >> 2) * NZ + ci;
                f32x4 z = mm_ll<64>(LB(O_AT), PT, 16 * rb, LB(Z_S), PT, 16 * vt, FZ4, lane);
                if (vt < 4) z = mm_ll<64, false, true>(LB(Y_AAK), PT, 16 * rb, LB(O_VT), PT, 16 * vt, z, lane);
                st4bf(LB(Y_ZU) + (16 * vt + r16) * PT + 16 * rb + 4 * q4, z); }
            __syncthreads();
            if (w < NVT) { const int vt = w; LAS bf16* vb = LB(O_VB) + w * 640; LAS bf16* zrow = LB(Y_ZU) + (16 * vt + r16) * PT;
#pragma unroll
                for (int bb = 0; bb < 4; ++bb) {
                    f32x4 acc; { const u32x2 zz = *(const LAS u32x2*)(zrow + 16 * bb + 4 * q4); acc[0] = bflo(zz.x); acc[1] = bfhi(zz.x); acc[2] = bflo(zz.y); acc[3] = bfhi(zz.y); }
                    if (bb >= 1) acc = mfma16(*(const LAS bf16x8*)(LB(Y_TB) + (16 * bb + r16) * PT + 8 * q4), *(const LAS bf16x8*)(zrow + 8 * q4), acc);
                    if (bb >= 3) acc = mfma16(*(const LAS bf16x8*)(LB(Y_TB) + (16 * bb + r16) * PT + 32 + 8 * q4), *(const LAS bf16x8*)(zrow + 32 + 8 * q4), acc);
                    st4bf(vb + r16 * 40 + 4 * q4, acc);
                    const f32x4 ub = mfma16(*(const LAS bf16x8*)(LB(O_DB) + (16 * bb + r16) * 40 + 8 * q4), *(const LAS bf16x8*)(vb + r16 * 40 + 8 * q4), FZ4);
                    st4bf(zrow + 16 * bb + 4 * q4, ub); }
            }
        }
        __syncthreads();
        {
            IDS(); f32x4 yy[2];
            if (FINAL) { const int rb = w & 3;
#pragma unroll
                for (int ci = 0; ci < 2; ++ci) { const int ct = 2 * (w >> 2) + ci;
                    f32x4 y = mm_ll<64>(LB(O_RT), PT, 16 * rb, LB(Z_S), PT, 16 * ct, FZ4, lane);
                    y = mm_ll<64>(LB(Y_ARB), PT, 16 * rb, LB(Y_ZU), PT, 16 * ct, y, lane);
                    yy[ci] = mm_ll<64, false, true>(LB(Y_ARK), PT, 16 * rb, LB(O_VT), PT, 16 * ct, y, lane); } }
#pragma unroll
            for (int ti = 0; ti < NST; ++ti) { const int ct = S_CT(ti); const float pc = LF(Z_PC)[16 * ct + r16];
                f32x4 s = Sacc[ti] * pc;
                s = mm_ll<64, false, true>(LB(Y_ZU), PT, 16 * s_vb, LB(O_BH), PT, 16 * ct, s, lane);
                if (s_vb < 4) s = mm_ll<64, true, true>(LB(O_VT), PT, 16 * s_vb, LB(O_KH), PT, 16 * ct, s, lane);
                Sacc[ti] = s; }
            __syncthreads();
#pragma unroll
            for (int ti = 0; ti < NST; ++ti) { const int ct = S_CT(ti);
#pragma unroll
                for (int jj = 0; jj < 4; ++jj) LB(Z_S)[(16 * s_vb + 4 * q4 + jj) * PT + 16 * ct + r16] = (bf16)f2bf(Sacc[ti][jj]); }
            if (FINAL) { const int rb = w & 3;
#pragma unroll
                for (int ci = 0; ci < 2; ++ci) { const int ct = 2 * (w >> 2) + ci;
#pragma unroll
                    for (int jj = 0; jj < 4; ++jj) LF(Y_YF)[(16 * rb + 4 * q4 + jj) * PF + 16 * ct + r16] = yy[ci][jj]; } }
        }
        __syncthreads();
        if (FINAL) {
            IDS();
            const int t = tok, c0 = 8 * part; const size_t m = (size_t)b * T + tl0 + t;
            float y[8], gg[8], sm = 0.f; ld8f(LF(Y_YF) + t * PF + c0, y); unpack8(*(const LAS u32x4*)(LB(Z_G) + t * 64 + c0), gg);
#pragma unroll
            for (int e = 0; e < 8; ++e) sm += y[e];
            const float mean = red8(sm) * (1.f / 64.f); float vs = 0.f;
#pragma unroll
            for (int e = 0; e < 8; ++e) { y[e] -= mean; vs += y[e] * y[e]; }
            const float rs = __builtin_amdgcn_rsqf(red8(vs) * (1.f / 64.f) + 64e-5f), bo = LF(Z_BON)[t];
#pragma unroll
            for (int e = 0; e < 8; ++e) { const int c = c0 + e; y[e] = (y[e] * rs * LF(Z_PAR)[320 + c] + LF(Z_PAR)[384 + c] + bo * tr_at(LB(O_VT), PT, c, t)) * gg[e]; }
            *(u32x4*)((bf16*)(F.ws + WS_BIG) + m * PLD + 1024 + h * 64 + c0) = pack8(y);
        }
        __syncthreads();
    }
    if (!FINAL) { IDS();
#pragma unroll
        for (int ti = 0; ti < NST; ++ti) { const int ct = S_CT(ti);
            if (s_vb < 4) {
#pragma unroll
                for (int jj = 0; jj < 4; ++jj) Nbuf[(16 * s_vb + 4 * q4 + jj) * 64 + 16 * ct + r16] = Sacc[ti][jj];
            } else { u32x2 wv; wv.x = pk2(Sacc[ti][0], Sacc[ti][1]); wv.y = pk2(Sacc[ti][2], Sacc[ti][3]);
                *(u32x2*)(MT + (16 * ct + r16) * 64 + 16 * (s_vb - 4) + 4 * q4) = wv; }
        }
    }
#undef RW_PREFETCH
#undef IDS
#undef S_CT
#undef LB
#undef LF
}

template <bool FINAL>
__device__ __forceinline__ void ret_chunk_unit(Frame& F, int u) {
    const int tid = otid(), lane = tid & 63, w = __builtin_amdgcn_readfirstlane(tid >> 6), r16 = lane & 15, q4 = lane >> 4;
    const int b = u >> 9, sc = (u >> 3) & 63, h = u & 7;
    constexpr int R_QB = 0, R_KB = 9216, R_KHT = 18432, R_VT = 27648, R_GB = 36864, R_AB = 45056, R_SB = 54272, R_YF = 63488;
    LAS unsigned char* L = F.lds;
#define LB(off) ((LAS bf16*)(L + (off)))
#define LF(off) ((LAS float*)(L + (off)))
    bf16* P = (bf16*)(F.ws + WS_BIG);
    float* Sbuf = (float*)(F.st + 16 * MiB) + (size_t)u * 4096;
    const float lg = log2f(1.f - exp2f(-5.f - (float)h));
    const float g64 = ex2(64.f * lg);
    const int db = w & 3;
    f32x4 Sacc[2];
#pragma unroll
    for (int ci = 0; ci < 2; ++ci) { const int et = 2 * (w >> 2) + ci;
#pragma unroll
        for (int jj = 0; jj < 4; ++jj) Sacc[ci][jj] = FINAL ? Sbuf[(16 * db + 4 * q4 + jj) * 64 + 16 * et + r16] : 0.f;
        if (FINAL) st4bf(LB(R_SB) + (16 * et + r16) * PT + 16 * db + 4 * q4, Sacc[ci]); }
    const int tok = tid >> 3, part = tid & 7;
    for (int j = 0; j < 4; ++j) {
        const int tl0 = sc * 256 + j * 64;
        {
            const int t = tl0 + tok; const size_t m = (size_t)b * T + t; const bf16* row = P + m * PLD + C_RET + h * 64 + 8 * part;
            float qv[8], kv[8], vv[8]; unpack8(*(const u32x4*)(row + 512), kv); unpack8(*(const u32x4*)(row + 1024), vv);
            if (FINAL) { unpack8(*(const u32x4*)row, qv); *(LAS u32x4*)(LB(R_GB) + tok * 64 + 8 * part) = *(const u32x4*)(row + 1536); }
            const float zeta = ex2((float)(63 - tok) * lg);
            if (FINAL) { *(LAS u32x4*)(LB(R_QB) + tok * PT + 8 * part) = pack8(qv); *(LAS u32x4*)(LB(R_KB) + tok * PT + 8 * part) = pack8(kv); }
            float kz[8];
#pragma unroll
            for (int e = 0; e < 8; ++e) kz[e] = kv[e] * zeta;
            tr_write8(LB(R_KHT), PT, 8 * part, tok, kz, part); tr_write8(LB(R_VT), PT, 8 * part, tok, vv, part);
        }
        __syncthreads();
        if (FINAL) { const int rb = w & 3;
#pragma unroll
            for (int ci = 0; ci < 2; ++ci) { const int ct = 2 * (w >> 2) + ci; f32x4 a = FZ4;
                if (ct <= rb) a = mm_ll<64>(LB(R_QB), PT, 16 * rb, LB(R_KB), PT, 16 * ct, FZ4, lane);
#pragma unroll
                for (int jj = 0; jj < 4; ++jj) { const int l = 16 * rb + 4 * q4 + jj, s = 16 * ct + r16; LB(R_AB)[l * PT + s] = (bf16)f2bf((s <= l) ? a[jj] * ex2((float)(l - s) * lg) : 0.f); } }
            __syncthreads();
        }
        {
            f32x4 yy[2];
            if (FINAL) { const int rb = w & 3;
#pragma unroll
                for (int ci = 0; ci < 2; ++ci) { const int et = 2 * (w >> 2) + ci;
                    const f32x4 a1 = mm_ll<64, false, true>(LB(R_AB), PT, 16 * rb, LB(R_VT), PT, 16 * et, FZ4, lane), a2 = mm_ll<64>(LB(R_QB), PT, 16 * rb, LB(R_SB), PT, 16 * et, FZ4, lane);
#pragma unroll
                    for (int jj = 0; jj < 4; ++jj) yy[ci][jj] = a1[jj] + ex2((float)(16 * rb + 4 * q4 + jj + 1) * lg) * a2[jj]; } }
#pragma unroll
            for (int ci = 0; ci < 2; ++ci) { const int et = 2 * (w >> 2) + ci; Sacc[ci] = mm_ll<64, true, true>(LB(R_KHT), PT, 16 * db, LB(R_VT), PT, 16 * et, Sacc[ci] * g64, lane); }
            __syncthreads();
            if (FINAL) { const int rb = w & 3;
#pragma unroll
                for (int ci = 0; ci < 2; ++ci) { const int et = 2 * (w >> 2) + ci; st4bf(LB(R_SB) + (16 * et + r16) * PT + 16 * db + 4 * q4, Sacc[ci]);
#pragma unroll
                    for (int jj = 0; jj < 4; ++jj) LF(R_YF)[(16 * rb + 4 * q4 + jj) * PF + 16 * et + r16] = yy[ci][jj]; } }
        }
        __syncthreads();
        if (FINAL) { const size_t m = (size_t)b * T + tl0 + tok; float y[8], g[8], ss = 0.f;
            ld8f(LF(R_YF) + tok * PF + 8 * part, y);
#pragma unroll
            for (int e = 0; e < 8; ++e) ss += y[e] * y[e];
            const float rs = __builtin_amdgcn_rsqf(red8(ss) * (1.f / 64.f) + 1e-6f);
            unpack8(*(const LAS u32x4*)(LB(R_GB) + tok * 64 + 8 * part), g);
#pragma unroll
            for (int e = 0; e < 8; ++e) y[e] = y[e] * rs * silu(g[e]);
            *(u32x4*)(P + m * PLD + C_RETG + h * 64 + 8 * part) = pack8(y);
            __syncthreads(); }
    }
    if (!FINAL) {
#pragma unroll
        for (int ci = 0; ci < 2; ++ci) { const int et = 2 * (w >> 2) + ci;
#pragma unroll
            for (int jj = 0; jj < 4; ++jj) Sbuf[(16 * db + 4 * q4 + jj) * 64 + 16 * et + r16] = Sacc[ci][jj]; }
    }
#undef LB
#undef LF
}

template <bool FINAL>
__device__ __forceinline__ void ssd_chunk_unit(Frame& F, int layer, int u) {
    const int tid = otid(), w = __builtin_amdgcn_readfirstlane(tid >> 6);
#define IDS() const int ft = fresh_tid(tid); const int lane = ft & 63, r16 = lane & 15, q4 = lane >> 4; (void)lane; (void)r16; (void)q4
    const int b = u >> 9, sc = (u >> 3) & 63, h = u & 7, g = h >> 2;
    constexpr int D_CB = 0, D_BB = 17408, D_BT = 34816, D_YF = 53248, D_XT = 70656, D_XDT = 79872, D_GM = 89088, D_SB = 98304, D_MISC = 115712;
    constexpr int D_DTS = D_MISC, D_ACS = D_MISC + 256, D_CAR = D_MISC + 512;
    LAS unsigned char* L = F.lds;
#define LB(off) ((LAS bf16*)(L + (off)))
#define LF(off) ((LAS float*)(L + (off)))
    bf16* P = (bf16*)(F.ws + WS_BIG); const float* dtb = (const float*)(F.ws + WS_DT);
    const bf16* BND = (const bf16*)(F.ws + WS_BND);
    float* Sbuf = (float*)(F.st + 32 * MiB) + (size_t)u * 8192;
    const float* cw = INP(17) + layer * 1024 * 4; const float* cbias = INP(18) + layer * 1024;
    const float dt_bias = INP(19)[layer * 8 + h], A = -expf(INP(20)[layer * 8 + h]), Dh = INP(21)[layer * 8 + h];
    const int bc_chunk = tid & 31, bc_chn = (bc_chunk < 16) ? (512 + g * 128 + bc_chunk * 8) : (768 + g * 128 + (bc_chunk - 16) * 8);
    const int x_chunk = tid & 7, x_chn = h * 64 + x_chunk * 8;
    const int pb = w & 3;
    f32x4 Sacc[4];
    { IDS();
#pragma unroll
    for (int ci = 0; ci < 4; ++ci) { const int nt = 4 * (w >> 2) + ci;
#pragma unroll
        for (int jj = 0; jj < 4; ++jj) { const float x = FINAL ? Sbuf[(16 * pb + 4 * q4 + jj) * 128 + 16 * nt + r16] : 0.f; Sacc[ci][jj] = x;
            if (FINAL) LB(D_SB)[(16 * pb + 4 * q4 + jj) * PT2 + 16 * nt + r16] = (bf16)f2bf(x); } } }
    float dstot = 0.f;
    for (int j = 0; j < 4; ++j) {
        const int tl0 = sc * 256 + j * 64; const size_t m0 = (size_t)b * T + tl0;
        if (w == 0) {
            IDS(); const float dt = softplus_acc(dtb[(m0 + lane) * 8 + h] + dt_bias); float a = A * dt;
#pragma unroll
            for (int o = 1; o < 64; o <<= 1) { const float n = __shfl_up(a, o); if (lane >= o) a += n; }
            LF(D_DTS)[lane] = dt; LF(D_ACS)[lane] = a;
        }
        {
            IDS();
#pragma unroll
            for (int it = 0; it < 4; ++it) { const int t = it * 16 + (ft >> 5); const int ta = tl0 + t;
                float acc[8]; unpack8(*(const u32x4*)(P + (m0 + t) * PLD + C_XBC + bc_chn), acc); (void)ta;
                if (bc_chunk < 16) { *(LAS u32x4*)(LB(D_BB) + t * PT2 + bc_chunk * 8) = pack8(acc); tr_write8(LB(D_BT), PT, bc_chunk * 8, t, acc, bc_chunk & 7); }
                else *(LAS u32x4*)(LB(D_CB) + t * PT2 + (bc_chunk - 16) * 8) = pack8(acc);
            }
        }
        __syncthreads();
        {
            IDS(); const int t = ft >> 3; float acc[8]; unpack8(*(const u32x4*)(P + (m0 + t) * PLD + C_XBC + x_chn), acc);
            const float sc_d = LF(D_DTS)[t] * __expf(LF(D_ACS)[63] - LF(D_ACS)[t]);
            float xs8[8], xd8[8];
#pragma unroll
            for (int e = 0; e < 8; ++e) { xs8[e] = acc[e]; xd8[e] = acc[e] * sc_d; }
            tr_write8(LB(D_XT), PT, x_chunk * 8, t, xs8, x_chunk); tr_write8(LB(D_XDT), PT, x_chunk * 8, t, xd8, x_chunk);
        }
        if (FINAL) { IDS(); const int rb = w & 3;
#pragma unroll
            for (int ci = 0; ci < 2; ++ci) { const int ct = 2 * (w >> 2) + ci; f32x4 a = FZ4;
                if (ct <= rb) a = mm_ll<128>(LB(D_CB), PT2, 16 * rb, LB(D_BB), PT2, 16 * ct, FZ4, lane);
#pragma unroll
                for (int jj = 0; jj < 4; ++jj) { const int l = 16 * rb + 4 * q4 + jj, s = 16 * ct + r16;
                    LB(D_GM)[l * PT + s] = (bf16)f2bf((s <= l) ? a[jj] * __expf(LF(D_ACS)[l] - LF(D_ACS)[s]) * LF(D_DTS)[s] : 0.f); } } }
        __syncthreads();
        {
            IDS(); f32x4 yy[2];
            if (FINAL) { const int rb = w & 3;
#pragma unroll
                for (int ci = 0; ci < 2; ++ci) { const int pt = 2 * (w >> 2) + ci;
                    const f32x4 a1 = mm_ll<64, false, true>(LB(D_GM), PT, 16 * rb, LB(D_XT), PT, 16 * pt, FZ4, lane), a2 = mm_ll<128>(LB(D_CB), PT2, 16 * rb, LB(D_SB), PT2, 16 * pt, FZ4, lane);
#pragma unroll
                    for (int jj = 0; jj < 4; ++jj) { const int l = 16 * rb + 4 * q4 + jj, p = 16 * pt + r16; yy[ci][jj] = a1[jj] + __expf(LF(D_ACS)[l]) * a2[jj] + Dh * tr_at(LB(D_XT), PT, p, l); } } }
            const float dec = expf(LF(D_ACS)[63]);
#pragma unroll
            for (int ci = 0; ci < 4; ++ci) { const int nt = 4 * (w >> 2) + ci; Sacc[ci] = mm_ll<64, true, true>(LB(D_XDT), PT, 16 * pb, LB(D_BT), PT, 16 * nt, Sacc[ci] * dec, lane); }
            dstot += LF(D_ACS)[63];
            __syncthreads();
            if (FINAL) { const int rb = w & 3;
#pragma unroll
                for (int ci = 0; ci < 4; ++ci) { const int nt = 4 * (w >> 2) + ci;
#pragma unroll
                    for (int jj = 0; jj < 4; ++jj) LB(D_SB)[(16 * pb + 4 * q4 + jj) * PT2 + 16 * nt + r16] = (bf16)f2bf(Sacc[ci][jj]); }
#pragma unroll
                for (int ci = 0; ci < 2; ++ci) { const int pt = 2 * (w >> 2) + ci;
#pragma unroll
                    for (int jj = 0; jj < 4; ++jj) LF(D_YF)[(16 * rb + 4 * q4 + jj) * PF + 16 * pt + r16] = yy[ci][jj]; } }
        }
        __syncthreads();
        if (FINAL) { IDS(); const int tok = ft >> 3, part = ft & 7; float y[8];
            ld8f(LF(D_YF) + tok * PF + 8 * part, y);
            *(u32x4*)(P + (m0 + tok) * PLD + C_XBC + h * 64 + 8 * part) = pack8(y);
            __syncthreads(); }
    }
    if (!FINAL) { IDS();
#pragma unroll
        for (int ci = 0; ci < 4; ++ci) { const int nt = 4 * (w >> 2) + ci;
#pragma unroll
            for (int jj = 0; jj < 4; ++jj) Sbuf[(16 * pb + 4 * q4 + jj) * 128 + 16 * nt + r16] = Sacc[ci][jj]; }
        if (tid == 0) ((float*)(F.ws + WS_DSTOT))[u] = dstot;
    }
#undef IDS
#undef LB
#undef LF
}

__device__ __forceinline__ void rwkv_scan_chain(Frame& F, int chain) {
    const int tid = otid(), lane = tid & 63, w = __builtin_amdgcn_readfirstlane(tid >> 6), r16 = lane & 15, q4 = lane >> 4;
    const int b = chain >> 3, h = chain & 7, vb = w & 3, ct0 = 2 * (w >> 2);
    LAS bf16* SB = (LAS bf16*)F.lds;
    f32x4 Sacc[2] = {FZ4, FZ4};
    for (int i = tid; i < 64 * PT / 2; i += 512) ((LAS unsigned*)SB)[i] = 0u;
    f32x4 nv[2]; bf16x8 mf[2][2];
    auto fetch = [&](int sc) {
        const int u = (b * 64 + sc) * 8 + h;
        const float* Nb = (const float*)(F.st + 0) + (size_t)u * 4096; const bf16* MT = (const bf16*)(F.ws + WS_MT) + (size_t)u * 4096;
#pragma unroll
        for (int ci = 0; ci < 2; ++ci) {
#pragma unroll
            for (int jj = 0; jj < 4; ++jj) nv[ci][jj] = Nb[(16 * vb + 4 * q4 + jj) * 64 + 16 * (ct0 + ci) + r16];
#pragma unroll
            for (int k2 = 0; k2 < 2; ++k2) mf[ci][k2] = *(const bf16x8*)(MT + (size_t)(16 * (ct0 + ci) + r16) * 64 + 32 * k2 + 8 * q4); } };
    fetch(0);
    __syncthreads();
    for (int sc = 0; sc < 64; ++sc) {
        const int u = (b * 64 + sc) * 8 + h;
        float* Nb = (float*)(F.st + 0) + (size_t)u * 4096;
        f32x4 nw[2];
#pragma unroll
        for (int ci = 0; ci < 2; ++ci) {
            f32x4 a = nv[ci];
#pragma unroll
            for (int k2 = 0; k2 < 2; ++k2) a = mfma16(*(const LAS bf16x8*)(SB + (16 * vb + r16) * PT + 32 * k2 + 8 * q4), mf[ci][k2], a);
            nw[ci] = a;
#pragma unroll
            for (int jj = 0; jj < 4; ++jj) Nb[(16 * vb + 4 * q4 + jj) * 64 + 16 * (ct0 + ci) + r16] = Sacc[ci][jj]; }
        if (sc + 1 < 64) fetch(sc + 1);
        __syncthreads();
#pragma unroll
        for (int ci = 0; ci < 2; ++ci) { Sacc[ci] = nw[ci];
#pragma unroll
            for (int jj = 0; jj < 4; ++jj) SB[(16 * vb + 4 * q4 + jj) * PT + 16 * (ct0 + ci) + r16] = (bf16)f2bf(nw[ci][jj]); }
        __syncthreads();
    }
}
__device__ __forceinline__ void elem_scans(Frame& F, int blk, int nblk) {
    const int tid = otid();
    const int NRET = 16 * 4096, NSSD = 16 * 8192;
    const float* dst = (const float*)(F.ws + WS_DSTOT);
    for (int it = blk * 512 + tid; it < NRET + NSSD; it += nblk * 512) {
        if (it < NRET) { const int chain = it >> 12, e = it & 4095, b = chain >> 3, h = chain & 7;
            const float g256 = exp2f(256.f * log2f(1.f - exp2f(-5.f - (float)h)));
            float* p = (float*)(F.st + 16 * MiB) + ((size_t)(b * 64) * 8 + h) * 4096 + e; float carry = 0.f;
#pragma unroll 8
            for (int sc = 0; sc < 64; ++sc) { const float t = p[(size_t)sc * 8 * 4096]; p[(size_t)sc * 8 * 4096] = carry; carry = g256 * carry + t; }
        } else { const int i2 = it - NRET, chain = i2 >> 13, e = i2 & 8191, b = chain >> 3, h = chain & 7;
            float* p = (float*)(F.st + 32 * MiB) + ((size_t)(b * 64) * 8 + h) * 8192 + e; const float* d = dst + (b * 64) * 8 + h; float carry = 0.f;
#pragma unroll 8
            for (int sc = 0; sc < 64; ++sc) { const float t = p[(size_t)sc * 8 * 8192]; p[(size_t)sc * 8 * 8192] = carry; carry = expf(d[sc * 8]) * carry + t; }
        }
    }
}
__device__ __forceinline__ void conv_lora(Frame& F) {
    const int tid = otid();
    for (int l = 0; l < 2; ++l) {
        bf16* base = (bf16*)(F.ws + WS_LORA + (size_t)l * LORA_STRIDE);
        const float* wu = INP(4) + l * 64 * 512; const float* au = INP(6) + l * 64 * 512; const float* gu = INP(8) + l * 128 * 512;
        for (int i = F.vcu * 512 + tid; i < 512 * 64; i += F.G * 512) { const int c = i >> 6, jx = i & 63; base[i] = (bf16)f2bf(wu[jx * 512 + c]); base[32768 + i] = (bf16)f2bf(au[jx * 512 + c]); }
        for (int i = F.vcu * 512 + tid; i < 512 * 128; i += F.G * 512) { const int c = i >> 7, jx = i & 127; base[65536 + i] = (bf16)f2bf(gu[jx * 512 + c]); }
    }
}
__device__ __forceinline__ void conv_vlora(Frame& F) {
    const int tid = otid();
    bf16* vdT = (bf16*)(F.ws + WS_VLORA); bf16* vuT = vdT + 32 * 512;
    const float* vdn = INP(14); const float* vup = INP(15);
    for (int i = F.vcu * 512 + tid; i < 32 * 512; i += F.G * 512) { const int j = i >> 9, c = i & 511; vdT[i] = (bf16)f2bf(vdn[c * 32 + j]); }
    for (int i = F.vcu * 512 + tid; i < 512 * 32; i += F.G * 512) { const int c = i >> 5, j = i & 31; vuT[i] = (bf16)f2bf(vup[j * 512 + c]); }
}
__device__ __forceinline__ void save_bnd(Frame& F) {
    const int tid = otid();
    const bf16* P = (const bf16*)(F.ws + WS_BIG); bf16* BND = (bf16*)(F.ws + WS_BND);
    for (int i = F.vcu * 512 + tid; i < 2 * 64 * 3 * 64; i += F.G * 512) { const int ch = i & 63, k = (i >> 6) % 3, bs = i / 192, b = bs >> 6, sc = bs & 63;
        if (sc > 0) *(u32x4*)(BND + (size_t)(bs * 3 + k) * 512 + ch * 8) = *(const u32x4*)(P + ((size_t)b * T + sc * 256 - 3 + k) * PLD + C_XBC + ch * 8); }
}

constexpr int LAYER_BASE0 = 1, LAYER_STRIDE = 18, MOE_BASE = LAYER_BASE0 + LAYER_STRIDE + 15;
__device__ __forceinline__ Frame lf(const Frame& F0) {
    Frame F = F0; unsigned l = (unsigned)(unsigned long long)F.lds;
    asm volatile("" : "+s"(l), "+s"(F.vcu), "+s"(F.G), "+s"(F.cid), "+s"(F.wid), "+s"(F.out), "+s"(F.ws), "+s"(F.st));
    F.lds = (LAS unsigned char*)(unsigned long long)l; return F;
}
__global__ void __launch_bounds__(512, 2) fwd(Args args) {
    extern __shared__ __attribute__((aligned(16))) unsigned char lds_raw[];
    Frame F0;
    F0.lds = (LAS unsigned char*)lds_raw;
    F0.G = gridDim.x; { const int bx = blockIdx.x; F0.vcu = (F0.G % 8 == 0) ? (bx % 8) * (F0.G / 8) + bx / 8 : bx; }
    F0.cid = blockIdx.x; F0.out = args.out; F0.ws = args.ws; F0.wid = __builtin_amdgcn_readfirstlane(threadIdx.x >> 6); F0.st = args.ws + WS_XB;
    volatile LAS unsigned* MISC = (volatile LAS unsigned*)(F0.lds + MISC_OFF);
    for (int u = threadIdx.x; u < (LDS_BYTES - LDSCTL_OFF) / 4; u += 512) ((LAS unsigned*)(F0.lds + LDSCTL_OFF))[u] = 0u;
    __syncthreads();
    if (threadIdx.x < 34) *(LAS unsigned long long*)(F0.lds + LDSCTL_OFF + 8 * threadIdx.x) = (unsigned long long)args.in[threadIdx.x];
    __syncthreads();
    const int lo = args.ph_lo, hi = args.ph_hi;
    XcdBarrier bar; bar.bar = (unsigned*)(F0.ws + WS_CTL); bar.x = 0; bar.st = nullptr;
    if (hi - lo > 1) bar = xcd_barrier_post((unsigned*)(F0.ws + WS_CTL), MISC + 8);
#define IN(k) (lo <= (k) && (k) < hi)
#define SEAM(k) do { if (IN(k) && IN((k) + 1)) xcd_barrier(bar); } while (0)
#define WSP(T_, off) ((T_*)(F.ws + (off)))

    if (IN(0)) { for (int rep = 0; rep <= REP_CONV; ++rep) { Frame F = lf(F0); conv_layer_weights(F, 0); conv_layer_weights(F, 1); conv_ffn_weights(F); conv_lora(F); conv_vlora(F); }
        for (int rep = 0; rep <= REP_MISC; ++rep) { Frame F = lf(F0); xprep_phase(F, INP(0)); } }
    SEAM(0);
    for (int l = 0; l < 2; ++l) {
        const int pb = LAYER_BASE0 + l * LAYER_STRIDE;
        F0.st = (l == 0) ? (unsigned char*)F0.out : F0.ws + WS_XB;
        if (IN(pb + 0)) {
            Frame F = lf(F0); unsigned char* wl = F.ws + WS_W + (size_t)l * WL_STRIDE;
            pg8::Gemm g{WSP(bf16, WS_XB), (const bf16*)(wl + WL_IN), D, D, D}; pg8::StaticOrder S; S.init(M, NP, F.G, F.cid, D, D);
            pg8::EpiInProj E{WSP(bf16, WS_BIG), WSP(float, WS_RSTD), WSP(float, WS_DT)};
            pg8::gemm_phase(F.lds, F.wid, g, S, E);
        }
        SEAM(pb + 0);
        if (IN(pb + 1)) { Frame F = lf(F0); vprep_phase(F, l); prepass_a(F); }
        SEAM(pb + 1);
        if (IN(pb + 2)) { Frame F = lf(F0); prepass_conv(F, l); }
        if (IN(pb + 2) && IN(pb + 3)) xcd_barrier(bar);
        if (IN(pb + 3)) for (int rep = 0; rep <= REP_R1; ++rep) {
#if RW_CH
            for (int r2 = 0; r2 <= REP_RW; ++r2) { Frame F = lf(F0); for (int u = F.cid; u < 1024; u += F.G) rwkv_chunk_unit<false>(F, l, u); }
#else
            { Frame F = lf(F0); if (F.cid < 16) rwkv_seq(F, l, F.cid); }
#endif
#if RET_CH
            for (int r2 = 0; r2 <= REP_RET; ++r2) { Frame F = lf(F0); for (int u = F.cid; u < 1024; u += F.G) ret_chunk_unit<false>(F, u); }
#else
            { Frame F = lf(F0); if (F.cid >= 32 && F.cid < 48) ret_seq(F, F.cid - 32); }
#endif
#if SSD_CH
            for (int r2 = 0; r2 <= REP_SSD; ++r2) { Frame F = lf(F0); for (int u = F.cid; u < 1024; u += F.G) ssd_chunk_unit<false>(F, l, u); }
#else
            { Frame F = lf(F0); if (F.cid >= 16 && F.cid < 32) ssd_seq(F, l, F.cid - 16); }
#endif
        }
        SEAM(pb + 3);
        if (IN(pb + 4)) {
            Frame F = lf(F0);
            if (F.cid < 16) { if (RW_CH) rwkv_scan_chain(F, F.cid); }
            else elem_scans(F, F.cid - 16, F.G - 16);
        }
        SEAM(pb + 4);
        if (IN(pb + 5)) {
#if RW_CH
            { Frame F = lf(F0); for (int u = F.cid; u < 1024; u += F.G) rwkv_chunk_unit<true>(F, l, u); }
#endif
#if RET_CH
            { Frame F = lf(F0); for (int u = F.cid; u < 1024; u += F.G) ret_chunk_unit<true>(F, u); }
#endif
#if SSD_CH
            { Frame F = lf(F0); for (int u = F.cid; u < 1024; u += F.G) ssd_chunk_unit<true>(F, l, u); }
#endif
        }
        SEAM(pb + 5);
        if (IN(pb + 6)) { Frame F = lf(F0); ssm_norm_phase(F, l); if (l == 1) xprep_phase(F, F.out); }
        SEAM(pb + 6);
        if (IN(pb + 7)) {
            Frame F = lf(F0); unsigned char* wl = F.ws + WS_W + (size_t)l * WL_STRIDE; bf16* P = WSP(bf16, WS_BIG);
            pg8::Gemm g{P, (const bf16*)(wl + WL_BR), PLD, 512, 512}; pg8::BranchOrder S; S.init(F.G, F.cid);
            pg8::EpiPlain E{P, WSP(bf16, WS_VMIX)};
            pg8::gemm_phase(F.lds, F.wid, g, S, E);
        }
        SEAM(pb + 7);
        if (IN(pb + 8)) {
            Frame F = lf(F0); unsigned char* wl = F.ws + WS_W + (size_t)l * WL_STRIDE; bf16* P = WSP(bf16, WS_BIG);
            pg8::Gemm g{WSP(bf16, WS_XB), (const bf16*)(wl + WL_GATE), D, D, D}; pg8::GateOrder S; S.init(F.G, F.cid);
            pg8::EpiGateMerge E{P, WSP(const bf16, WS_VMIX), P + C_RET, PLD, WSP(float, WS_RSTD)};
            pg8::gemm_phase(F.lds, F.wid, g, S, E);
        }
        if (IN(pb + 8) && IN(pb + 13)) xcd_barrier(bar);
        if (IN(pb + 13)) {
            Frame F = lf(F0); unsigned char* wl = F.ws + WS_W + (size_t)l * WL_STRIDE; bf16* P = WSP(bf16, WS_BIG);
            pg8::Gemm g{P + C_RET, (const bf16*)(wl + WL_OUT), PLD, D, D}; pg8::StaticOrder S; S.init(M, D, F.G, F.cid, PLD, D);
            pg8::EpiResid E{(l == 0) ? INP(0) : F.out, F.out, nullptr, 0};
            pg8::gemm_phase(F.lds, F.wid, g, S, E);
        }
        SEAM(pb + 13);
        if (IN(pb + 14)) { Frame F = lf(F0); if (l == 0) xprep_phase(F, F.out); else { router_phase(F); conv_moe_weights(F); } }
        SEAM(pb + 14);
        if (l == 0) {
            if (IN(pb + 15)) {
                Frame F = lf(F0);
                pg8::Gemm g{WSP(bf16, WS_XB), WSP(const bf16, WS_FFUP), D, D, D}; pg8::StaticOrder S; S.init(M, 2 * FF, F.G, F.cid, D, D);
                pg8::EpiSwiglu E{WSP(bf16, WS_ACT), FF, WSP(float, WS_RSTD)};
                pg8::gemm_phase(F.lds, F.wid, g, S, E);
            }
            SEAM(pb + 15);
            if (IN(pb + 16)) {
                Frame F = lf(F0);
                pg8::Gemm g{WSP(const bf16, WS_ACT), WSP(const bf16, WS_FFDN), FF, FF, FF}; pg8::StaticOrder S; S.init(M, D, F.G, F.cid, FF, FF);
                pg8::EpiResid E{F.out, F.out, nullptr, 0};
                pg8::gemm_phase(F.lds, F.wid, g, S, E);
            }
            SEAM(pb + 16);
            if (IN(pb + 17)) { Frame F = lf(F0); xprep_phase(F, F.out); }
            SEAM(pb + 17);
        }
    }
    {
        const int pb = MOE_BASE;
        for (int sg = 0; sg < 3; ++sg) {
            if (IN(pb + 0 + 2 * sg)) {
                Frame F = lf(F0);
                pg8::Gemm g{WSP(bf16, WS_XB), WSP(const bf16, WS_MOEW), D, D, D}; pg8::MoeOrder<true> S; S.init(WSP(const int, WS_CNT), WSP(const int, WS_LIST), sg, 2 * FFE, F.G, F.cid, D, D, MOEW_STRIDE);
                pg8::EpiSwiglu E{WSP(bf16, WS_ACT), FFE, WSP(float, WS_RSTD)};
                pg8::gemm_phase(F.lds, F.wid, g, S, E);
            }
            SEAM(pb + 0 + 2 * sg);
            if (IN(pb + 1 + 2 * sg)) {
                Frame F = lf(F0);
                const int ksp = (sg == 2) ? 4 : 1;
                pg8::Gemm g{WSP(const bf16, WS_ACT), WSP(const bf16, WS_MOEW + MOEW_DN), FFE, FFE, FFE / ksp}; pg8::MoeOrder<false> S; S.init(WSP(const int, WS_CNT), WSP(const int, WS_LIST), sg, D, F.G, F.cid, FFE, FFE, MOEW_STRIDE, ksp, FFE / ksp);
                pg8::EpiMoeDown E{F.out};
                pg8::gemm_phase(F.lds, F.wid, g, S, E);
            }
            SEAM(pb + 1 + 2 * sg);
        }
        if (IN(pb + 6)) { Frame F = lf(F0); final_norm_phase(F); }
    }
#undef IN
#undef SEAM
#undef WSP
}
constexpr int LAST_PHASE = MOE_BASE + 6;
constexpr int N_PH = LAST_PHASE + 1;

extern "C" void kernel_launch(void* const* d_in, const int* in_sizes, int n_in, void* d_out, int out_size, void* d_ws, size_t ws_size, hipStream_t stream) {
    static int grid = 0;
    if (grid == 0) {
        if (n_in != 34 || out_size != M * D || ws_size < WS_END) { fprintf(stderr, "kernel_launch: unexpected problem (n_in %d out %d ws %zu need %zu)\n", n_in, out_size, ws_size, (size_t)WS_END); grid = -1; return; }
        int dev = 0, cus = 0;
        if (hipGetDevice(&dev) != hipSuccess || hipDeviceGetAttribute(&cus, hipDeviceAttributeMultiprocessorCount, dev) != hipSuccess) { grid = -1; return; }
        if (hipFuncSetAttribute((const void*)fwd, hipFuncAttributeMaxDynamicSharedMemorySize, LDS_BYTES) != hipSuccess) { fprintf(stderr, "kernel_launch: hipFuncSetAttribute failed\n"); grid = -1; return; }
        int per_cu = 0;
        if (hipOccupancyMaxActiveBlocksPerMultiprocessor(&per_cu, (const void*)fwd, 512, LDS_BYTES) != hipSuccess || per_cu < 1) fprintf(stderr, "kernel_launch: occupancy query says %d\n", per_cu);
        (void)hipGetLastError();
        grid = cus;
    }
    if (grid < 0) return;
    (void)hipMemsetAsync((char*)d_ws + WS_CTL, 0, CTL_ZERO_BYTES, stream);
    Args a{};
    for (int i = 0; i < 34; ++i) a.in[i] = (const float*)d_in[i];
    a.out = (float*)d_out; a.ws = (unsigned char*)d_ws;
#if MK_ONE_LAUNCH
    a.ph_lo = 0; a.ph_hi = N_PH;
    hipLaunchKernelGGL(fwd, dim3(grid), dim3(512), LDS_BYTES, stream, a);
#else
    for (int p = 0; p < N_PH; ++p) { a.ph_lo = p; a.ph_hi = p + 1; hipLaunchKernelGGL(fwd, dim3(grid), dim3(512), LDS_BYTES, stream, a); }
#endif
}
```

```cpp
#include <hip/hip_runtime.h>
#include <cstdio>
#include <cstdint>

#ifndef MK_ONE_LAUNCH
#define MK_ONE_LAUNCH 1
#endif

#define LAS __attribute__((address_space(3)))
#define GAS __attribute__((address_space(1)))
typedef unsigned short bf16;
typedef short bf16x8 __attribute__((ext_vector_type(8)));
typedef float f32x4 __attribute__((ext_vector_type(4)));
typedef float f32x2 __attribute__((ext_vector_type(2)));
typedef unsigned u32x4 __attribute__((ext_vector_type(4)));
typedef unsigned u32x2 __attribute__((ext_vector_type(2)));

constexpr int BATCH = 2, T = 16384, D = 1024, M = BATCH * T;
constexpr int INC = 8456;
constexpr int PLD = 5376;
constexpr int NP = 5632;
constexpr int C_RW = 0, C_Z = 1792, C_XBC = 2304, C_RET = 3328, C_RETG = 4864;
constexpr int FF = 2816, FFE = 3584, NE = 8;

constexpr size_t MiB = 1u << 20;
constexpr size_t WS_CTL = 0, CTL_ZERO_BYTES = 64 * 1024;
constexpr size_t WS_RSTD = 1 * MiB, WS_GATES = 2 * MiB, WS_DT = 3 * MiB;
constexpr size_t WS_W = 4 * MiB;
constexpr size_t WL_IN = 0, WL_GATE = 11 * MiB, WL_BR = 17 * MiB, WL_OUT = 20 * MiB, WL_STRIDE = 22 * MiB;
constexpr size_t WS_FFUP = WS_W + 44 * MiB, WS_FFDN = WS_W + 55 * MiB;
constexpr size_t WS_XB = 68 * MiB;
constexpr size_t WS_VF = 132 * MiB;
constexpr size_t WS_BIG = 164 * MiB;
constexpr size_t WS_VMIX = WS_BIG + 336 * MiB, WS_YRW = WS_BIG + 368 * MiB, WS_END = 573 * MiB;
constexpr size_t WS_MOEW = WS_BIG;
constexpr size_t MOEW_STRIDE = 21 * MiB, MOEW_DN = 14 * MiB;
constexpr size_t WS_ACT = WS_BIG + 168 * MiB;

constexpr size_t WS_CNT = 32768, WS_LIST = 2 * MiB;
constexpr size_t WS_BND2 = 566 * MiB;
constexpr size_t WS_VLORA = 192 * 1024;
constexpr size_t WS_DSTOT = 128 * 1024, WS_BND = 256 * 1024;
constexpr size_t WS_LORA = 1 * MiB + 512 * 1024, LORA_STRIDE = 262144;
constexpr size_t WS_ST_RW = WS_XB, WS_ST_RET = WS_XB + 16 * MiB, WS_ST_SSD = WS_XB + 32 * MiB, WS_MT = WS_YRW;
constexpr int RING_BYTES = 131072, LDSCTL_OFF = 159744, MISC_OFF = LDSCTL_OFF + 320, LDS_BYTES = 163840;
#ifndef REP_CONV
#define REP_CONV 0
#endif
#ifndef REP_R1
#define REP_R1 0
#endif
#ifndef REP_RW
#define REP_RW 0
#endif
#ifndef REP_RET
#define REP_RET 0
#endif
#ifndef REP_SSD
#define REP_SSD 0
#endif
#ifndef REP_MISC
#define REP_MISC 0
#endif
#ifndef RW_CH
#define RW_CH 1
#endif
#ifndef RET_CH
#define RET_CH 1
#endif
#ifndef SSD_CH
#define SSD_CH 1
#endif

typedef __bf16 hbf16x2 __attribute__((ext_vector_type(2)));
__device__ __forceinline__ unsigned pk2(float lo, float hi) { const f32x2 v = {lo, hi}; return __builtin_bit_cast(unsigned, __builtin_convertvector(v, hbf16x2)); }
__device__ __forceinline__ unsigned f2bf(float f) { return (unsigned)__builtin_bit_cast(unsigned short, (__bf16)f); }
__device__ __forceinline__ float bflo(unsigned u) { return __builtin_bit_cast(float, u << 16); }
__device__ __forceinline__ float bfhi(unsigned u) { return __builtin_bit_cast(float, u & 0xffff0000u); }
__device__ __forceinline__ void unpack8(const u32x4 u, float (&f)[8]) { f[0] = bflo(u.x); f[1] = bfhi(u.x); f[2] = bflo(u.y); f[3] = bfhi(u.y); f[4] = bflo(u.z); f[5] = bfhi(u.z); f[6] = bflo(u.w); f[7] = bfhi(u.w); }
__device__ __forceinline__ u32x4 pack8(const float (&f)[8]) { u32x4 w; w.x = pk2(f[0], f[1]); w.y = pk2(f[2], f[3]); w.z = pk2(f[4], f[5]); w.w = pk2(f[6], f[7]); return w; }
__device__ __forceinline__ float sigm(float x) { return __builtin_amdgcn_rcpf(1.f + __expf(-x)); }
__device__ __forceinline__ float silu(float x) { return x * __builtin_amdgcn_rcpf(1.f + __expf(-x)); }
__device__ __forceinline__ float ex2(float x) { return __builtin_amdgcn_exp2f(x); }
__device__ __forceinline__ float fast_tanh(float x) { return 1.f - 2.f * __builtin_amdgcn_rcpf(1.f + __expf(2.f * x)); }
__device__ __forceinline__ float softplus_acc(float x) { return fmaxf(x, 0.f) + log1pf(expf(-fabsf(x))); }
__device__ __forceinline__ float wave_sum(float v) {
#pragma unroll
    for (int o = 1; o < 64; o <<= 1) v += __shfl_xor(v, o);
    return v;
}
__device__ __forceinline__ int otid_w(int wid) { unsigned z = 0u; asm volatile("" : "+v"(z)); int t = wid * 64 + (int)__builtin_amdgcn_mbcnt_hi(~0u, __builtin_amdgcn_mbcnt_lo(~0u, z)); asm volatile("" : "+v"(t)); return t; }
#define otid() otid_w(F.wid)
__device__ __forceinline__ int fresh_tid(int t) { asm volatile("" : "+v"(t)); return t; }
#define LDS_WAIT() asm volatile("s_waitcnt lgkmcnt(0)" ::: "memory")

namespace pg8 {
constexpr int BM = 256, BK = 64, HALF = 128, HTB = HALF * BK * 2, STAGE_BYTES = 8 * HTB, NXCD = 8, WGM = 8;
__host__ __device__ __forceinline__ int lds_byte(int r, int c) { const int st = (r >> 4) * 2 + (c >> 5), rr = r & 15, cc = c & 31, ob = rr * 64 + cc * 2; return st * 1024 + (ob ^ (((ob >> 9) & 1) << 5)); }
__host__ __device__ __forceinline__ void stage_rc(int b, int& R, int& C) { const int st = b / 1024, sb = b % 1024, swz = sb ^ (((sb >> 9) & 1) << 5); R = (st >> 1) * 16 + swz / 64; C = (st & 1) * 32 + (swz % 64) / 2; }
__host__ __device__ __forceinline__ int perm32(int rho) { const int n = rho >> 4, i = rho & 15; return 8 * (i >> 2) + 4 * n + (i & 3); }

struct Unit { int pm, pn; size_t aofs, bofs; const int* rows; int nvalid, e; };
struct Gemm { const bf16* A; const bf16* Bt; int lda, ldb, K; };

struct StaticOrder {
    static constexpr bool GATHER = false;
    int nM, nN, nwg, G, c; size_t tsA, tsB;
    __device__ __forceinline__ void init(int Mrows, int N, int G_, int c_, int lda, int ldb) { nM = Mrows / BM; nN = N / BM; nwg = nM * nN; G = G_; c = c_; tsA = (size_t)BM * lda * 2; tsB = (size_t)BM * ldb * 2; }
    __device__ __forceinline__ void tile(int L, int& pm, int& pn) const {
        int wgid = L; { const int q = nwg / NXCD, r = nwg % NXCD, xcd = wgid % NXCD, off = wgid / NXCD; wgid = (xcd < r ? xcd * (q + 1) : r * (q + 1) + (xcd - r) * q) + off; }
        const int nig = WGM * nN, gid = wgid / nig, fm = gid * WGM, gsz = (nM - fm) < WGM ? (nM - fm) : WGM;
        pm = fm + ((wgid % nig) % gsz); pn = (wgid % nig) / gsz;
    }
    __device__ __forceinline__ bool next(int i, Unit& u) const {
        const long L = (long)i * G + c; if (L >= nwg) return false;
        tile((int)L, u.pm, u.pn); u.aofs = (size_t)u.pm * tsA; u.bofs = (size_t)u.pn * tsB; u.rows = nullptr; u.nvalid = BM; u.e = 0; return true;
    }
};
struct BranchOrder {
    static constexpr bool GATHER = false;
    StaticOrder so;
    __device__ __forceinline__ void init(int G_, int c_) { so.init(M, D, G_, c_, PLD, 512); }
    __device__ __forceinline__ bool next(int j, Unit& u) const {
        const long L = (long)j * so.G + so.c; if (L >= 3 * so.nwg) return false;
        const int i = (int)(L / so.nwg); so.tile((int)(L % so.nwg), u.pm, u.pn);
        const int acol = (i == 0) ? 1024 : (i == 1 ? C_Z : C_RETG);
        u.aofs = (size_t)u.pm * so.tsA + (size_t)acol * 2; u.bofs = ((size_t)i * D + (size_t)u.pn * BM) * 512 * 2; u.rows = nullptr; u.nvalid = BM; u.e = i; return true;
    }
};
struct GateOrder {
    static constexpr bool GATHER = false;
    StaticOrder so;
    __device__ __forceinline__ void init(int G_, int c_) { so.init(M, D, G_, c_, D, D); }
    __device__ __forceinline__ bool next(int j, Unit& u) const {
        const long tt = (long)(j / 3) * so.G + so.c; if (tt >= so.nwg) return false;
        const int i = j % 3; so.tile((int)tt, u.pm, u.pn);
        u.aofs = (size_t)u.pm * so.tsA; u.bofs = ((size_t)i * D + (size_t)u.pn * BM) * D * 2; u.rows = nullptr; u.nvalid = BM; u.e = i; return true;
    }
};
template <bool GATH> struct MoeOrder {
    static constexpr bool GATHER = GATH;
    unsigned q0, q1, q2, q3;
    int seg, nN, G, c, ksplit; const int* list; size_t bstride, tsB, tsA, kbytes;
    __device__ __forceinline__ void init(const int* counts, const int* list_, int seg_, int N, int G_, int c_, int lda, int ldb, size_t bstride_, int ksplit_ = 1, int kpart = 0) {
        unsigned n[8];
#pragma unroll
        for (int e = 0; e < 8; ++e) { int v = __builtin_amdgcn_readfirstlane(counts[e]); v = v < 0 ? 0 : (v > 32768 ? 32768 : v); n[e] = (unsigned)v; }
        q0 = n[0] | (n[1] << 16); q1 = n[2] | (n[3] << 16); q2 = n[4] | (n[5] << 16); q3 = n[6] | (n[7] << 16);
        seg = seg_; nN = N / BM; G = G_; c = c_; list = list_; bstride = bstride_; tsB = (size_t)BM * ldb * 2; tsA = (size_t)BM * lda * 2; ksplit = ksplit_; kbytes = (size_t)kpart * 2;
    }
    __device__ __forceinline__ bool next(int i, Unit& u) const {
        const long L0 = (long)i * G + c; const long L = L0 / ksplit; const int ks = (int)(L0 % ksplit); const int tl = (int)(L / nN), pn = (int)(L % nN), gt = seg * 128 + tl;
        int t = 0, e = 0, tbe = 0, cne = 0;
#pragma unroll
        for (int k = 0; k < 8; ++k) { const unsigned q = (k < 2) ? q0 : (k < 4) ? q1 : (k < 6) ? q2 : q3; const int n = (int)((k & 1) ? (q >> 16) : (q & 0xffffu));
            if (gt >= t) { e = k; tbe = t; cne = n; } t += (n + 255) >> 8; }
        int nt = t - seg * 128; nt = nt < 0 ? 0 : (nt > 128 ? 128 : nt);
        if (L >= (long)nt * nN) return false;
        const int rt = gt - tbe;
        u.pm = tl; u.pn = pn; u.e = e; u.bofs = (size_t)e * bstride + (size_t)pn * tsB + ks * kbytes; u.aofs = (GATH ? 0 : (size_t)tl * tsA) + ks * kbytes;
        u.rows = list + ((size_t)e * 32768 + rt * 256) * 2; int nv = cne - rt * 256; u.nvalid = nv > 256 ? 256 : nv; return true;
    }
};

template <class Epi, class Sched>
__device__ __forceinline__ void gemm_phase(LAS unsigned char* lds, int wid0, const Gemm g, const Sched& S, const Epi& E) {
    constexpr bool GATHER = Sched::GATHER;
    const int tid = otid_w(wid0), wid = __builtin_amdgcn_readfirstlane(tid >> 6), lane = tid & 63, wr = wid >> 2, wc = wid & 3, fr = lane & 15, fq = lane >> 4;
    const int nt = g.K / BK;
    unsigned voffA[2], voffB[2];
#pragma unroll
    for (int i = 0; i < 2; ++i) { int R, C; stage_rc(tid * 16 + i * 8192, R, C); const int Rb = Epi::PERM ? ((R & ~31) + perm32(R & 31)) : R;
        voffA[i] = (unsigned)(R * g.lda + C) * 2u; voffB[i] = (unsigned)(Rb * g.ldb + C) * 2u; }
    const size_t kstep = (size_t)(BK * 2);
    const size_t hstepA = GATHER ? 0 : (size_t)HALF * g.lda * 2, hstepB = (size_t)HALF * g.ldb * 2;
    const unsigned ldsw = (unsigned)wid * 1024u;
    const int aoff = lds_byte(wr * 64 + fr, fq * 8), boff = lds_byte(wc * 32 + fr, fq * 8);
#define PG8_SA(b, h) (((b) * 2 + (h)) * HTB)
#define PG8_SB(b, h) ((4 + (b) * 2 + (h)) * HTB)
#define PG8_STAGE2(bufoff, gbase, o0, o1) do { \
        __builtin_amdgcn_global_load_lds((const unsigned*)((const char*)(gbase) + (o0)), (LAS unsigned*)(lds + (bufoff) + ldsw), 16, 0, 0); \
        __builtin_amdgcn_global_load_lds((const unsigned*)((const char*)(gbase) + (o1)), (LAS unsigned*)(lds + (bufoff) + ldsw + 8192), 16, 0, 0); } while (0)
#define PG8_STAGE(bufoff, gbase, voff) PG8_STAGE2(bufoff, gbase, (voff)[0], (voff)[1])
#define PG8_LDA(dst, b, h) do { _Pragma("unroll") for (int m = 0; m < 4; ++m) _Pragma("unroll") for (int k = 0; k < 2; ++k) dst[m][k] = *(const LAS bf16x8*)(lds + PG8_SA(b, h) + aoff + m * 2048 + k * 1024); } while (0)
#define PG8_LDB(dst, b, h) do { _Pragma("unroll") for (int n = 0; n < 2; ++n) _Pragma("unroll") for (int k = 0; k < 2; ++k) dst[n][k] = *(const LAS bf16x8*)(lds + PG8_SB(b, h) + boff + n * 2048 + k * 1024); } while (0)
#define PG8_MMA(ai, bj, At, Bt) do { __builtin_amdgcn_s_setprio(1); _Pragma("unroll") for (int m = 0; m < 4; ++m) _Pragma("unroll") for (int n = 0; n < 2; ++n) _Pragma("unroll") for (int k = 0; k < 2; ++k) \
        acc[ai][bj][m][n] = Epi::TRANS ? __builtin_amdgcn_mfma_f32_16x16x32_bf16(Bt[n][k], At[m][k], acc[ai][bj][m][n], 0, 0, 0) : __builtin_amdgcn_mfma_f32_16x16x32_bf16(At[m][k], Bt[n][k], acc[ai][bj][m][n], 0, 0, 0); __builtin_amdgcn_s_setprio(0); } while (0)
#define PG8_WAIT_V(n) asm volatile("s_waitcnt vmcnt(" #n ")" ::: "memory")
#define PG8_WAIT_L(n) asm volatile("s_waitcnt lgkmcnt(" #n ")" ::: "memory")
#define PG8_BAR __builtin_amdgcn_s_barrier()
#define PG8_SCHED __builtin_amdgcn_sched_barrier(0)
#define GSLOT(which) ((LAS u32x4*)(lds + 131072 + (which) * 8192 + tid * 16))
#define PG8_ROWS(u, which) do { const int _ft = fresh_tid(tid); unsigned _vg[2][2]; _Pragma("unroll") for (int _i = 0; _i < 2; ++_i) { int _R, _C; stage_rc(_ft * 16 + _i * 8192, _R, _C); \
        _Pragma("unroll") for (int _h = 0; _h < 2; ++_h) { const int _r = _h * HALF + _R; \
        const int _t = (_r < (u).nvalid) ? (u).rows[2 * _r] : 0; _vg[_h][_i] = ((unsigned)_t * (unsigned)g.lda + (unsigned)_C) * 2u; } } \
        u32x4 _o; _o.x = _vg[0][0]; _o.y = _vg[0][1]; _o.z = _vg[1][0]; _o.w = _vg[1][1]; *GSLOT(which) = _o; } while (0)
    Unit cur, nxt; int ui = 0;
    if (!S.next(0, cur)) return;
    f32x4 acc[2][2][4][2];
#pragma unroll
    for (int a = 0; a < 2; ++a)
#pragma unroll
        for (int b = 0; b < 2; ++b)
#pragma unroll
            for (int m = 0; m < 4; ++m)
#pragma unroll
                for (int n = 0; n < 2; ++n) acc[a][b][m][n] = (f32x4){0.f, 0.f, 0.f, 0.f};
    bf16x8 At[4][2], B0[2][2], B1[2][2];
    u32x4 gc = {voffA[0], voffA[1], voffA[0], voffA[1]};
    if constexpr (GATHER) { PG8_ROWS(cur, 0); PG8_ROWS(cur, 1); gc = *GSLOT(0); }
#define VGC(h, i) (gc[2 * (h) + (i)])
    const char* cA = (const char*)g.A + cur.aofs; const char* cB = (const char*)g.Bt + cur.bofs;
    PG8_STAGE(PG8_SB(0, 0), cB, voffB); PG8_STAGE(PG8_SB(0, 1), cB + hstepB, voffB); PG8_STAGE2(PG8_SA(0, 0), cA, VGC(0, 0), VGC(0, 1)); PG8_STAGE2(PG8_SA(0, 1), cA + hstepA, VGC(1, 0), VGC(1, 1));
    if (wr == 1) PG8_BAR;
    PG8_WAIT_V(2); PG8_BAR;
    PG8_STAGE(PG8_SB(1, 0), cB + kstep, voffB); PG8_STAGE2(PG8_SA(1, 0), cA + kstep, VGC(0, 0), VGC(0, 1)); PG8_STAGE(PG8_SB(1, 1), cB + hstepB + kstep, voffB);
    PG8_WAIT_V(6); PG8_BAR;
    for (;;) {
        const bool has_next = S.next(ui + 1, nxt);
        const char* nA = has_next ? (const char*)g.A + nxt.aofs : cA; const char* nB = has_next ? (const char*)g.Bt + nxt.bofs : cB;
        if constexpr (GATHER) { if (has_next) PG8_ROWS(nxt, 1); else *GSLOT(1) = *GSLOT(0); }
        for (int t = 0; t < nt; t += 2) {
            const bool last = (t == nt - 2);
            const char* a1 = cA + (size_t)(t + 1) * kstep;
            const char* a2 = last ? nA : cA + (size_t)(t + 2) * kstep; const char* b2 = last ? nB : cB + (size_t)(t + 2) * kstep;
            const char* a3 = a2 + kstep; const char* b3 = b2 + kstep;
            u32x4 gn = gc; if constexpr (GATHER) { gc = *GSLOT(0); gn = last ? *GSLOT(1) : gc; }
            const unsigned s00 = gn.x, s01 = gn.y, s10 = gn.z, s11 = gn.w;
            PG8_LDB(B0, 0, 0); PG8_LDB(B1, 0, 1); PG8_SCHED; PG8_LDA(At, 0, 0); PG8_STAGE2(PG8_SA(1, 1), a1 + hstepA, VGC(1, 0), VGC(1, 1));
            PG8_WAIT_V(8); PG8_WAIT_L(0); PG8_BAR; PG8_MMA(0, 0, At, B0); PG8_MMA(0, 1, At, B1); PG8_BAR; PG8_SCHED;
            PG8_LDA(At, 0, 1); PG8_STAGE(PG8_SB(0, 0), b2, voffB); PG8_STAGE(PG8_SB(0, 1), b2 + hstepB, voffB); PG8_STAGE2(PG8_SA(0, 0), a2, s00, s01);
            PG8_WAIT_V(8); PG8_WAIT_L(0); PG8_BAR; PG8_MMA(1, 0, At, B0); PG8_MMA(1, 1, At, B1); PG8_BAR; PG8_SCHED;
            PG8_LDB(B0, 1, 0); PG8_LDB(B1, 1, 1); PG8_SCHED; PG8_LDA(At, 1, 0); PG8_STAGE2(PG8_SA(0, 1), a2 + hstepA, s10, s11);
            PG8_WAIT_V(8); PG8_WAIT_L(0); PG8_BAR; PG8_MMA(0, 0, At, B0); PG8_MMA(0, 1, At, B1); PG8_BAR; PG8_SCHED;
            PG8_LDA(At, 1, 1); PG8_STAGE(PG8_SB(1, 0), b3, voffB); PG8_STAGE(PG8_SB(1, 1), b3 + hstepB, voffB); PG8_STAGE2(PG8_SA(1, 0), a3, s00, s01);
            PG8_WAIT_V(8); PG8_WAIT_L(0); PG8_BAR; PG8_MMA(1, 0, At, B0); PG8_MMA(1, 1, At, B1); PG8_BAR; PG8_SCHED;
        }
        if (wr == 0) PG8_BAR;
        E(acc, cur, wr, wc, fr, fq);
        if (!has_next) break;
#pragma unroll
        for (int a = 0; a < 2; ++a)
#pragma unroll
            for (int b = 0; b < 2; ++b)
#pragma unroll
                for (int m = 0; m < 4; ++m)
#pragma unroll
                    for (int n = 0; n < 2; ++n) acc[a][b][m][n] = (f32x4){0.f, 0.f, 0.f, 0.f};
        cur = nxt; cA = nA; cB = nB; ++ui;
        if constexpr (GATHER) { *GSLOT(0) = *GSLOT(1); }
        if (wr == 1) PG8_BAR;
    }
    PG8_WAIT_V(0);
    PG8_BAR;
#undef PG8_SA
#undef PG8_SB
#undef PG8_STAGE
#undef PG8_STAGE2
#undef PG8_ROWS
#undef GSLOT
#undef VGC
#undef PG8_LDA
#undef PG8_LDB
#undef PG8_MMA
#undef PG8_WAIT_V
#undef PG8_WAIT_L
#undef PG8_BAR
#undef PG8_SCHED
}

typedef const f32x4 (&AccRef)[2][2][4][2];

struct EpiInProj {
    static constexpr bool PERM = true, TRANS = true;
    bf16* P; const float* rstd; float* dt;
    __device__ __forceinline__ void operator()(AccRef acc, const Unit& u, int wr, int wc, int fr, int fq) const {
        const int row0 = u.pm * BM + wr * 64 + fr;
        if (u.pn < 21) {
            const int col0 = u.pn * BM + wc * 32 + 8 * fq;
#pragma unroll
            for (int ai = 0; ai < 2; ++ai)
#pragma unroll
                for (int m = 0; m < 4; ++m) { const int row = row0 + ai * HALF + m * 16; const float s = rstd[row]; bf16* rowp = P + (size_t)row * PLD + col0;
#pragma unroll
                    for (int bj = 0; bj < 2; ++bj) { const f32x4 v0 = acc[ai][bj][m][0] * s, v1 = acc[ai][bj][m][1] * s;
                        u32x4 w; w.x = pk2(v0[0], v0[1]); w.y = pk2(v0[2], v0[3]); w.z = pk2(v1[0], v1[1]); w.w = pk2(v1[2], v1[3]);
                        *(u32x4*)(rowp + bj * HALF) = w; } }
        } else if (wc == 0 && fq == 0) {
#pragma unroll
            for (int ai = 0; ai < 2; ++ai)
#pragma unroll
                for (int m = 0; m < 4; ++m) { const int row = row0 + ai * HALF + m * 16; const float s = rstd[row];
                    *(f32x4*)(dt + (size_t)row * 8) = acc[ai][0][m][0] * s; *(f32x4*)(dt + (size_t)row * 8 + 4) = acc[ai][0][m][1] * s; }
        }
    }
};
struct EpiPlain {
    static constexpr bool PERM = true, TRANS = true;
    bf16* P; bf16* Y2;
    __device__ __forceinline__ void operator()(AccRef acc, const Unit& u, int wr, int wc, int fr, int fq) const {
        bf16* O = (u.e == 0) ? P : (u.e == 1 ? P + C_XBC : Y2); const int ldc = (u.e == 2) ? D : PLD;
        const int row0 = u.pm * BM + wr * 64 + fr, col0 = u.pn * BM + wc * 32 + 8 * fq;
#pragma unroll
        for (int ai = 0; ai < 2; ++ai)
#pragma unroll
            for (int m = 0; m < 4; ++m) { bf16* rowp = O + (size_t)(row0 + ai * HALF + m * 16) * ldc + col0;
#pragma unroll
                for (int bj = 0; bj < 2; ++bj) { const f32x4 v0 = acc[ai][bj][m][0], v1 = acc[ai][bj][m][1];
                    u32x4 w; w.x = pk2(v0[0], v0[1]); w.y = pk2(v0[2], v0[3]); w.z = pk2(v1[0], v1[1]); w.w = pk2(v1[2], v1[3]);
                    *(u32x4*)(rowp + bj * HALF) = w; } }
    }
};
struct EpiGateMerge {
    static constexpr bool PERM = true, TRANS = true;
    const bf16* P; const bf16* Y2; bf16* Mg; int ldm; const float* rstd;
    __device__ __forceinline__ void operator()(AccRef acc, const Unit& u, int wr, int wc, int fr, int fq) const {
        asm volatile("" : "+v"(fr), "+v"(fq));
        const bf16* Y = (u.e == 0) ? P : (u.e == 1 ? P + C_XBC : Y2); const int ldy = (u.e == 2) ? D : PLD; const int first = (u.e == 0);
        const int row0 = u.pm * BM + wr * 64 + fr, col0 = u.pn * BM + wc * 32 + 8 * fq;
#pragma unroll
        for (int ai = 0; ai < 2; ++ai)
#pragma unroll
            for (int m = 0; m < 4; ++m) { const int row = row0 + ai * HALF + m * 16; const float s = rstd[row];
#pragma unroll
                for (int bj = 0; bj < 2; ++bj) { const int c = col0 + bj * HALF;
                    float y[8], o[8]; unpack8(*(const u32x4*)(Y + (size_t)row * ldy + c), y);
                    const f32x4 v0 = acc[ai][bj][m][0] * s, v1 = acc[ai][bj][m][1] * s;
#pragma unroll
                    for (int j = 0; j < 4; ++j) { o[j] = sigm(v0[j]) * y[j]; o[4 + j] = sigm(v1[j]) * y[4 + j]; }
                    if (!first) { float p[8]; unpack8(*(const u32x4*)(Mg + (size_t)row * ldm + c), p);
#pragma unroll
                        for (int j = 0; j < 8; ++j) o[j] += p[j]; }
                    *(u32x4*)(Mg + (size_t)row * ldm + c) = pack8(o); } }
    }
};
struct EpiResid {
    static constexpr bool PERM = false, TRANS = true;
    const float* xin; float* xout; const float* gates; int e;
    __device__ __forceinline__ void operator()(AccRef acc, const Unit& u, int wr, int wc, int fr, int fq) const {
        const int row0 = u.pm * BM + wr * 64 + fr, col0 = u.pn * BM + wc * 32 + 4 * fq;
#pragma unroll
        for (int ai = 0; ai < 2; ++ai)
#pragma unroll
            for (int m = 0; m < 4; ++m) { const int row = row0 + ai * HALF + m * 16; const float s = gates ? gates[(size_t)row * 8 + e] : 1.f;
                const float* ip = xin + (size_t)row * D + col0; float* op = xout + (size_t)row * D + col0;
#pragma unroll
                for (int bj = 0; bj < 2; ++bj)
#pragma unroll
                    for (int n = 0; n < 2; ++n) *(f32x4*)(op + bj * HALF + n * 16) = *(const f32x4*)(ip + bj * HALF + n * 16) + acc[ai][bj][m][n] * s; }
    }
};
struct EpiSwiglu {
    static constexpr bool PERM = true, TRANS = true;
    bf16* act; int ldc; const float* rstd;
    __device__ __forceinline__ void operator()(AccRef acc, const Unit& u, int wr, int wc, int fr, int fq) const {
        asm volatile("" : "+v"(fr), "+v"(fq));
        const int row0 = u.pm * BM + wr * 64 + fr, col0 = u.pn * HALF + wc * 32 + 8 * fq;
#pragma unroll
        for (int ai = 0; ai < 2; ++ai)
#pragma unroll
            for (int m = 0; m < 4; ++m) { const int row = row0 + ai * HALF + m * 16; const int lr = row - u.pm * BM;
                const float s = u.rows ? rstd[(lr < u.nvalid) ? u.rows[2 * lr] : 0] : rstd[row];
                float o[8];
#pragma unroll
                for (int n = 0; n < 2; ++n)
#pragma unroll
                    for (int j = 0; j < 4; ++j) o[4 * n + j] = silu(acc[ai][0][m][n][j] * s) * (acc[ai][1][m][n][j] * s);
                *(u32x4*)(act + (size_t)row * ldc + col0) = pack8(o); }
    }
};
struct EpiMoeDown {
    static constexpr bool PERM = false, TRANS = false;
    float* x;
    __device__ __forceinline__ void operator()(AccRef acc, const Unit& u, int wr, int wc, int fr, int fq) const {
        asm volatile("" : "+v"(fr), "+v"(fq));
        const int col0 = u.pn * BM + wc * 32 + fr;
#pragma unroll
        for (int ai = 0; ai < 2; ++ai)
#pragma unroll
            for (int m = 0; m < 4; ++m) { asm volatile("" ::: "memory");
#pragma unroll
                for (int j = 0; j < 4; ++j) { const int lr = ai * HALF + wr * 64 + m * 16 + 4 * fq + j;
                    if (lr < u.nvalid) { const int tok = u.rows[2 * lr]; const float wgt = __builtin_bit_cast(float, u.rows[2 * lr + 1]); float* xp = x + (size_t)tok * D + col0;
#pragma unroll
                        for (int bj = 0; bj < 2; ++bj)
#pragma unroll
                            for (int n = 0; n < 2; ++n) atomicAdd(xp + bj * HALF + n * 16, wgt * acc[ai][bj][m][n][j]); } } }
    }
};
}

#define XB_TMO      128
#define XB_XCNT(j)  (256  + 64 * (j))
#define XB_XSUB(j)  (1280 + 64 * (j))
#define XB_XGEN(j)  (2304 + 64 * (j))
#define XB_TOP      3328
#define XB_TOPGEN   3392
#define XCD_BAR_WORDS 3456
#define XB_SPIN_CAP (1u << 18)

__device__ __forceinline__ unsigned xb_ld(unsigned* p)              { return __hip_atomic_load(p, __ATOMIC_RELAXED, __HIP_MEMORY_SCOPE_AGENT); }
__device__ __forceinline__ unsigned xb_add(unsigned* p, unsigned v) { return __hip_atomic_fetch_add(p, v, __ATOMIC_RELAXED, __HIP_MEMORY_SCOPE_AGENT); }
__device__ __forceinline__ unsigned xb_xcc_id() { return (unsigned)__builtin_amdgcn_s_getreg((3 << 11) | 20) & 0xFu; }
#define XB_SPIN(cond, bar) do { unsigned _sp = 0; while (cond) { __builtin_amdgcn_s_sleep(1); \
    if ((++_sp & 255u) == 0u) { if (xb_ld(&(bar)[XB_TMO])) break; if (_sp > XB_SPIN_CAP) { atomicAdd(&(bar)[XB_TMO], 1u); break; } } } } while (0)

struct XcdBarrier { unsigned* bar; unsigned x; volatile LAS unsigned* st; };

__device__ __forceinline__ XcdBarrier xcd_barrier_post(unsigned* bar, volatile LAS unsigned* st) {
    XcdBarrier b; b.bar = bar; b.x = xb_xcc_id(); b.st = st;
    if (threadIdx.x == 0) (void)xb_add(&bar[XB_XCNT(b.x)], 1u);
    return b;
}
__device__ __forceinline__ void xcd_barrier_complete(unsigned* bar, unsigned x, unsigned& nloc, unsigned& nx) {
    const unsigned G = gridDim.x * gridDim.y * gridDim.z;
    unsigned sum, cnt, mine, sp = 0u;
    for (;;) {
        sum = 0u; cnt = 0u; mine = 0u;
#pragma unroll
        for (unsigned j = 0; j < 16; ++j) { const unsigned c = xb_ld(&bar[XB_XCNT(j)]); sum += c; cnt += (c > 0u) ? 1u : 0u; mine = (j == x) ? c : mine; }
        if (sum == G) break;
        __builtin_amdgcn_s_sleep(1);
        if ((++sp & 255u) == 0u) { if (xb_ld(&bar[XB_TMO])) break; if (sp > XB_SPIN_CAP) { atomicAdd(&bar[XB_TMO], 1u); break; } }
    }
    nloc = mine > 0u ? mine : 1u; nx = cnt > 0u ? cnt : 1u;
}
__device__ __forceinline__ void xcd_barrier(const XcdBarrier& b) {
    asm volatile("s_waitcnt vmcnt(0)" ::: "memory");
    __syncthreads();
    if (threadIdx.x == 0) {
        unsigned* bar = b.bar;
        __builtin_amdgcn_s_waitcnt(0);
        unsigned nloc = b.st[0], nx = b.st[1];
        if (nloc == 0u) { xcd_barrier_complete(bar, b.x, nloc, nx); b.st[0] = nloc; b.st[1] = nx; }
        const unsigned old = xb_add(&bar[XB_XSUB(b.x)], 1u);
        const unsigned gen = old / nloc;
        if (old + 1u == (gen + 1u) * nloc) {
            __builtin_amdgcn_fence(__ATOMIC_RELEASE, "agent");
            asm volatile("s_waitcnt vmcnt(0)" ::: "memory");
            const unsigned og = xb_add(&bar[XB_TOP], 1u);
            const unsigned tg = og / nx;
            if (og + 1u == (tg + 1u) * nx) xb_add(&bar[XB_TOPGEN], 1u);
            else XB_SPIN(xb_ld(&bar[XB_TOPGEN]) == tg, bar);
            __builtin_amdgcn_fence(__ATOMIC_ACQUIRE, "agent");
            xb_add(&bar[XB_XGEN(b.x)], 1u);
            asm volatile("s_waitcnt vmcnt(0)" ::: "memory");
        } else {
            XB_SPIN(xb_ld(&bar[XB_XGEN(b.x)]) == gen, bar);
            __builtin_amdgcn_fence(__ATOMIC_ACQUIRE, "agent");
            asm volatile("s_waitcnt vmcnt(0)" ::: "memory");
        }
    }
    __syncthreads();
}

struct Args { const float* in[34]; float* out; unsigned char* ws; int ph_lo, ph_hi; };
struct Frame {
    LAS unsigned char* lds;
    int vcu, G, cid, wid;
    float* out; unsigned char* ws; unsigned char* st;
};
__device__ __forceinline__ const float* inptr(LAS unsigned char* lds, int i) {
    int off = LDSCTL_OFF + 8 * i; asm volatile("" : "+v"(off));
    const LAS unsigned* p = (const LAS unsigned*)(lds + off);
    const unsigned lo = __builtin_amdgcn_readfirstlane(p[0]), hi = __builtin_amdgcn_readfirstlane(p[1]);
    return (const float*)(((unsigned long long)hi << 32) | lo);
}
#define INP(i) inptr(F.lds, (i))

__device__ __forceinline__ void conv_item(const float* W, int ld, int k0, int c0, int nvalid, const float* scale, bf16* dst, int K, int drow0, LAS float* scr, int lane) {
    const int n4 = (lane & 15) * 4;
#pragma unroll 4
    for (int i = 0; i < 16; ++i) { const int kk = 4 * i + (lane >> 4);
        f32x4 v = {0.f, 0.f, 0.f, 0.f}; if (n4 < nvalid) { v = *(const f32x4*)(W + (size_t)(k0 + kk) * ld + c0 + n4); if (scale) v *= scale[k0 + kk]; }
        LAS float* d = scr + kk * 65 + n4; d[0] = v[0]; d[1] = v[1]; d[2] = v[2]; d[3] = v[3]; }
    LDS_WAIT(); asm volatile("" ::: "memory");
    const int c = lane & 7;
#pragma unroll
    for (int j = 0; j < 8; ++j) { const int nn = (lane >> 3) + 8 * j; const LAS float* sp = scr + (8 * c) * 65 + nn;
        u32x4 o; o.x = pk2(sp[0 * 65], sp[1 * 65]); o.y = pk2(sp[2 * 65], sp[3 * 65]); o.z = pk2(sp[4 * 65], sp[5 * 65]); o.w = pk2(sp[6 * 65], sp[7 * 65]);
        *(u32x4*)(dst + (size_t)(drow0 + nn) * K + k0 + 8 * c) = o; }
    LDS_WAIT(); asm volatile("" ::: "memory");
}
__device__ __forceinline__ void conv_seg(Frame& F, const float* W, int ld, int K, int c0, int nvalid, int ntotal, const float* scale, bf16* dst, int r0, int blk, int blks) {
    const int ptid = otid(), plane = ptid & 63, pwave = __builtin_amdgcn_readfirstlane(ptid >> 6);
    LAS float* scr = (LAS float*)(F.lds + pwave * 16640);
    const int gw = F.vcu * 8 + pwave, NGW = F.G * 8;
    const int nblk = ntotal / 64, nitems = (K / 64) * nblk;
    for (int it = gw; it < nitems; it += NGW) {
        const int kb = it / nblk, nb = it % nblk, n0 = nb * 64;
        int nv = nvalid - n0; nv = nv < 0 ? 0 : (nv > 64 ? 64 : nv);
        conv_item(W, ld, kb * 64, c0 + n0, nv, scale, dst, K, r0 + (n0 / blk) * blks + (n0 % blk), scr, plane);
    }
}
__device__ __forceinline__ void conv_layer_weights(Frame& F, int l) {
    unsigned char* wl = F.ws + WS_W + (size_t)l * WL_STRIDE;
    const float* win = INP(2) + (size_t)l * D * INC; const float* n1 = INP(1) + l * D;
    const int BIGB = 1 << 30;
    conv_seg(F, win, INC, D, 0, 3328, 3328, n1, (bf16*)(wl + WL_IN), 0, BIGB, 0);
    conv_seg(F, win, INC, D, 3336, 2048, 2048, n1, (bf16*)(wl + WL_IN), 3328, BIGB, 0);
    conv_seg(F, win, INC, D, 3328, 8, 256, n1, (bf16*)(wl + WL_IN), 5376, BIGB, 0);
    conv_seg(F, win, INC, D, 5384, 3072, 3072, n1, (bf16*)(wl + WL_GATE), 0, BIGB, 0);
    for (int i = 0; i < 3; ++i)
        conv_seg(F, INP(23) + ((size_t)l * 3 + i) * 512 * D, D, 512, 0, D, D, nullptr, (bf16*)(wl + WL_BR) + (size_t)i * D * 512, 0, BIGB, 0);
    conv_seg(F, INP(24) + (size_t)l * D * D, D, D, 0, D, D, nullptr, (bf16*)(wl + WL_OUT), 0, BIGB, 0);
}
__device__ __forceinline__ void conv_ffn_weights(Frame& F) {
    const float* n2 = INP(25);
    conv_seg(F, INP(26), FF, D, 0, FF, FF, n2, (bf16*)(F.ws + WS_FFUP), 0, 128, 256);
    conv_seg(F, INP(27), FF, D, 0, FF, FF, n2, (bf16*)(F.ws + WS_FFUP), 128, 128, 256);
    conv_seg(F, INP(28), D, FF, 0, D, D, nullptr, (bf16*)(F.ws + WS_FFDN), 0, 1 << 30, 0);
}
__device__ __forceinline__ void conv_moe_weights(Frame& F) {
    const float* n2 = INP(25) + D;
    for (int e = 0; e < NE; ++e) {
        bf16* up = (bf16*)(F.ws + WS_MOEW + (size_t)e * MOEW_STRIDE); bf16* dn = (bf16*)(F.ws + WS_MOEW + (size_t)e * MOEW_STRIDE + MOEW_DN);
        conv_seg(F, INP(30) + (size_t)e * D * FFE, FFE, D, 0, FFE, FFE, n2, up, 0, 128, 256);
        conv_seg(F, INP(31) + (size_t)e * D * FFE, FFE, D, 0, FFE, FFE, n2, up, 128, 128, 256);
        conv_seg(F, INP(32) + (size_t)e * FFE * D, D, FFE, 0, D, D, nullptr, dn, 0, 1 << 30, 0);
    }
}

__device__ __forceinline__ void xprep_phase(Frame& F, const float* x) {
    const int ptid = otid(), plane = ptid & 63, pwave = __builtin_amdgcn_readfirstlane(ptid >> 6); (void)plane; (void)pwave;
    const int gw = F.vcu * 8 + pwave, NGW = F.G * 8;
    bf16* xb = (bf16*)(F.ws + WS_XB); float* rstd = (float*)(F.ws + WS_RSTD);
    for (int m = gw; m < M; m += NGW) {
        const f32x4* xr = (const f32x4*)(x + (size_t)m * D) + plane;
        f32x4 v[4]; float s = 0.f;
#pragma unroll
        for (int j = 0; j < 4; ++j) { v[j] = xr[64 * j]; s += (v[j].x * v[j].x + v[j].y * v[j].y) + (v[j].z * v[j].z + v[j].w * v[j].w); }
        s = wave_sum(s);
        if (plane == 0) rstd[m] = __builtin_amdgcn_rsqf(s * (1.f / D) + 1e-6f);
        u32x2* o8 = (u32x2*)(xb + (size_t)m * D) + plane;
#pragma unroll
        for (int j = 0; j < 4; ++j) { u32x2 w; w.x = pk2(v[j].x, v[j].y); w.y = pk2(v[j].z, v[j].w); o8[64 * j] = w; }
    }
}
__device__ __forceinline__ void final_norm_phase(Frame& F) {
    const int ptid = otid(), plane = ptid & 63, pwave = __builtin_amdgcn_readfirstlane(ptid >> 6); (void)plane; (void)pwave;
    const int gw = F.vcu * 8 + pwave, NGW = F.G * 8;
    const float* fw = INP(33);
    for (int m = gw; m < M; m += NGW) {
        f32x4* xr = (f32x4*)(F.out + (size_t)m * D) + plane;
        f32x4 v[4]; float s = 0.f;
#pragma unroll
        for (int j = 0; j < 4; ++j) { v[j] = xr[64 * j]; s += (v[j].x * v[j].x + v[j].y * v[j].y) + (v[j].z * v[j].z + v[j].w * v[j].w); }
        s = wave_sum(s);
        const float r = __builtin_amdgcn_rsqf(s * (1.f / D) + 1e-6f);
#pragma unroll
        for (int j = 0; j < 4; ++j) { const f32x4 w = *((const f32x4*)fw + plane + 64 * j); xr[64 * j] = v[j] * r * w; }
    }
}
__device__ __forceinline__ void router_phase(Frame& F) {
    const int ptid = otid(), plane = ptid & 63, pwave = __builtin_amdgcn_readfirstlane(ptid >> 6);
    const float* nw = INP(25) + D; const float* rt = INP(29); float* rstd_w = (float*)(F.ws + WS_RSTD); bf16* xb = (bf16*)(F.ws + WS_XB);
    int* cnt = (int*)(F.ws + WS_CNT); int* list2 = (int*)(F.ws + WS_LIST);
    LAS int* lsel = (LAS int*)F.lds;
    LAS float* lwt = (LAS float*)(F.lds + 1024);
    LAS int* lrank = (LAS int*)(F.lds + 2048);
    LAS int* lcnt = (LAS int*)(F.lds + 3072);
    for (int blk = F.vcu; blk < M / 128; blk += F.G) {
        if (ptid < 16) lcnt[ptid] = 0;
        __syncthreads();
        for (int k = 0; k < 16; ++k) {
            const int lt = pwave * 16 + k, m = blk * 128 + lt;
            float acc[8];
#pragma unroll
            for (int e = 0; e < 8; ++e) acc[e] = 0.f;
            const f32x4* xr4 = (const f32x4*)(F.out + (size_t)m * D) + plane;
            f32x4 xv4[4]; float ssq = 0.f;
#pragma unroll
            for (int j = 0; j < 4; ++j) { xv4[j] = xr4[64 * j]; ssq += (xv4[j].x * xv4[j].x + xv4[j].y * xv4[j].y) + (xv4[j].z * xv4[j].z + xv4[j].w * xv4[j].w); }
            ssq = wave_sum(ssq);
            { u32x2* o8 = (u32x2*)(xb + (size_t)m * D) + plane;
#pragma unroll
              for (int j = 0; j < 4; ++j) { u32x2 wv; wv.x = pk2(xv4[j].x, xv4[j].y); wv.y = pk2(xv4[j].z, xv4[j].w); o8[64 * j] = wv; } }
#pragma unroll
            for (int j = 0; j < 4; ++j) { const int kk = 4 * plane + 256 * j; const f32x4 nwv = *(const f32x4*)(nw + kk);
#pragma unroll
                for (int q = 0; q < 4; ++q) { const float xv = xv4[j][q] * nwv[q];
                    const f32x4 r0v = *(const f32x4*)(rt + (size_t)(kk + q) * 8), r1v = *(const f32x4*)(rt + (size_t)(kk + q) * 8 + 4);
                    acc[0] += xv * r0v.x; acc[1] += xv * r0v.y; acc[2] += xv * r0v.z; acc[3] += xv * r0v.w; acc[4] += xv * r1v.x; acc[5] += xv * r1v.y; acc[6] += xv * r1v.z; acc[7] += xv * r1v.w; } }
            const float sc = __builtin_amdgcn_rsqf(ssq * (1.f / D) + 1e-6f);
            if (plane == 0) rstd_w[m] = sc;
#pragma unroll
            for (int e = 0; e < 8; ++e) acc[e] = wave_sum(acc[e]) * sc;
            int i0 = 0; float v0 = acc[0];
#pragma unroll
            for (int e = 1; e < 8; ++e) if (acc[e] > v0) { v0 = acc[e]; i0 = e; }
            int i1 = -1; float v1 = -3.0e38f;
#pragma unroll
            for (int e = 0; e < 8; ++e) if (e != i0 && acc[e] > v1) { v1 = acc[e]; i1 = e; }
            const float e1 = expf(v1 - v0), w0 = 1.f / (1.f + e1), w1 = e1 / (1.f + e1);
            if (plane == 0) { lsel[2 * lt] = i0; lsel[2 * lt + 1] = i1; lwt[2 * lt] = w0; lwt[2 * lt + 1] = w1;
                lrank[2 * lt] = atomicAdd((int*)(lcnt + i0), 1); lrank[2 * lt + 1] = atomicAdd((int*)(lcnt + i1), 1); }
        }
        __syncthreads();
        if (ptid < 8) lcnt[8 + ptid] = atomicAdd(cnt + ptid, lcnt[ptid]);
        __syncthreads();
        if (ptid < 256) { const int e = lsel[ptid], slot = lcnt[8 + e] + lrank[ptid];
            u32x2 v; v.x = (unsigned)(blk * 128 + (ptid >> 1)); v.y = __builtin_bit_cast(unsigned, lwt[ptid]);
            *(u32x2*)(list2 + ((size_t)e * 32768 + slot) * 2) = v; }
        __syncthreads();
    }
}

__device__ __forceinline__ void vprep_phase(Frame& F, int layer) {
    const int ptid = otid(), plane = ptid & 63, pwave = __builtin_amdgcn_readfirstlane(ptid >> 6);
    constexpr int VP = 520, V_VB = 0, V_GB = 64 * VP * 2, V_VD = 2 * 64 * VP * 2;
    LAS bf16* VB = (LAS bf16*)(F.lds + V_VB); LAS bf16* GB = (LAS bf16*)(F.lds + V_GB); LAS bf16* VD = (LAS bf16*)(F.lds + V_VD);
    const bf16* P = (const bf16*)(F.ws + WS_BIG); bf16* VF = (bf16*)(F.ws + WS_VF); bf16* VM = (bf16*)(F.ws + WS_VMIX);
    const bf16* vdT = (const bf16*)(F.ws + WS_VLORA); const bf16* vuT = vdT + 32 * 512;
    const float* mu = INP(3) + layer * 1792 + 1024; const float* v0 = INP(16);
    const int tok = ptid >> 3, part = ptid & 7, r16 = plane & 15, q4 = plane >> 4;
    for (int it = F.vcu; it < M / 64; it += F.G) {
        const int m = it * 64 + tok; const int t = m & (T - 1);
        const bf16* cur = P + (size_t)m * PLD + 1024 + part * 64;
#pragma unroll
        for (int q = 0; q < 8; ++q) { float c[8], p[8]; unpack8(*(const u32x4*)(cur + q * 8), c);
            if (t > 0) unpack8(*(const u32x4*)(cur - PLD + q * 8), p); else {
#pragma unroll
                for (int e = 0; e < 8; ++e) p[e] = 0.f; }
            const f32x4 m0 = *(const f32x4*)(mu + part * 64 + q * 8), m1 = *(const f32x4*)(mu + part * 64 + q * 8 + 4);
#pragma unroll
            for (int e = 0; e < 4; ++e) { c[e] = c[e] + (p[e] - c[e]) * m0[e]; c[4 + e] = c[4 + e] + (p[4 + e] - c[4 + e]) * m1[e]; }
            const u32x4 o = pack8(c);
            if (layer == 0) *(u32x4*)(VF + (size_t)m * 512 + part * 64 + q * 8) = o; else *(LAS u32x4*)(VB + tok * VP + part * 64 + q * 8) = o; }
        if (layer == 0) continue;
        __syncthreads();
        { const int rb = pwave & 3, jt = pwave >> 2; f32x4 acc = {0.f, 0.f, 0.f, 0.f};
#pragma unroll 4
          for (int k0 = 0; k0 < 512; k0 += 32) acc = __builtin_amdgcn_mfma_f32_16x16x32_bf16(*(const LAS bf16x8*)(VB + (16 * rb + r16) * VP + k0 + 8 * q4), *(const bf16x8*)(vdT + (size_t)(16 * jt + r16) * 512 + k0 + 8 * q4), acc, 0, 0, 0);
#pragma unroll
          for (int jj = 0; jj < 4; ++jj) VD[(16 * rb + 4 * q4 + jj) * 40 + 16 * jt + r16] = (bf16)f2bf(acc[jj]); }
        __syncthreads();
        { const int rb = pwave & 3; const bf16x8 af = *(const LAS bf16x8*)(VD + (16 * rb + r16) * 40 + 8 * q4);
#pragma unroll 4
          for (int i = 0; i < 16; ++i) { const int ct = (pwave >> 2) * 16 + i;
              const f32x4 acc = __builtin_amdgcn_mfma_f32_16x16x32_bf16(af, *(const bf16x8*)(vuT + (size_t)(16 * ct + r16) * 32 + 8 * q4), (f32x4){0.f, 0.f, 0.f, 0.f}, 0, 0, 0);
              const float vc = v0[16 * ct + r16];
#pragma unroll
              for (int jj = 0; jj < 4; ++jj) GB[(16 * rb + 4 * q4 + jj) * VP + 16 * ct + r16] = (bf16)f2bf(sigm(vc + acc[jj])); } }
        __syncthreads();
#pragma unroll
        for (int q = 0; q < 8; ++q) { float v[8], g[8], vf[8]; unpack8(*(const LAS u32x4*)(VB + tok * VP + part * 64 + q * 8), v); unpack8(*(const LAS u32x4*)(GB + tok * VP + part * 64 + q * 8), g);
            unpack8(*(const u32x4*)(VF + (size_t)m * 512 + part * 64 + q * 8), vf);
#pragma unroll
            for (int e = 0; e < 8; ++e) v[e] = v[e] + (vf[e] - v[e]) * g[e];
            *(u32x4*)(VM + (size_t)m * 512 + part * 64 + q * 8) = pack8(v); }
        __syncthreads();
    }
}
__device__ __forceinline__ void prepass_a(Frame& F) {
    const int tid = otid();
    bf16* P = (bf16*)(F.ws + WS_BIG); bf16* BND2 = (bf16*)(F.ws + WS_BND2);
    { const int ch = tid & 127; const int kind = ch >> 6, part = ch & 7;
      double invf[4];
#pragma unroll
      for (int p = 0; p < 4; ++p) invf[p] = exp(-(double)(part * 4 + p) * (9.210340371976184 / 32.0));
      for (int m = F.vcu * 4 + (tid >> 7); m < M; m += F.G * 4) {
          const int t = m & (T - 1); bf16* ptr = P + (size_t)m * PLD + C_RET + ch * 8;
          float x[8]; unpack8(*(const u32x4*)ptr, x);
#pragma unroll
          for (int p = 0; p < 4; ++p) { double rev = (double)t * invf[p] * 0.15915494309189535; rev -= floor(rev);
              const float sn = __builtin_amdgcn_sinf((float)rev), cs = __builtin_amdgcn_cosf((float)rev);
              const float x0 = x[2 * p], x1 = x[2 * p + 1]; float o0 = x0 * cs - x1 * sn, o1 = x0 * sn + x1 * cs;
              if (kind) { o0 *= 0.125f; o1 *= 0.125f; }
              x[2 * p] = o0; x[2 * p + 1] = o1; }
          *(u32x4*)ptr = pack8(x); } }
    for (int i = F.vcu * 512 + tid; i < 1024 * 3 * 128; i += F.G * 512) { const int ch = i & 127, k = (i >> 7) % 3, r = i / 384;
        if ((r & 511) != 0) *(u32x4*)(BND2 + ((size_t)r * 3 + k) * 1024 + ch * 8) = *(const u32x4*)(P + ((size_t)r * 32 - 3 + k) * PLD + C_XBC + ch * 8); }
}
__device__ __forceinline__ void prepass_conv(Frame& F, int layer) {
    const int tid = otid();
    bf16* P = (bf16*)(F.ws + WS_BIG); const bf16* BND2 = (const bf16*)(F.ws + WS_BND2);
    const float* cw = INP(17) + layer * 1024 * 4; const float* cbias = INP(18) + layer * 1024;
    const int ch = tid & 127;
    f32x4 wv[8]; float bv[8];
#pragma unroll
    for (int e = 0; e < 8; ++e) { wv[e] = *(const f32x4*)(cw + (ch * 8 + e) * 4); bv[e] = cbias[ch * 8 + e]; }
    for (int r = F.vcu * 4 + (tid >> 7); r < M / 32; r += F.G * 4) {
        float w0[8], w1[8], w2[8];
        if ((r & 511) != 0) { unpack8(*(const u32x4*)(BND2 + ((size_t)r * 3 + 0) * 1024 + ch * 8), w0); unpack8(*(const u32x4*)(BND2 + ((size_t)r * 3 + 1) * 1024 + ch * 8), w1); unpack8(*(const u32x4*)(BND2 + ((size_t)r * 3 + 2) * 1024 + ch * 8), w2); }
        else {
#pragma unroll
            for (int e = 0; e < 8; ++e) { w0[e] = 0.f; w1[e] = 0.f; w2[e] = 0.f; } }
        bf16* ptr = P + (size_t)r * 32 * PLD + C_XBC + ch * 8;
#pragma unroll 4
        for (int i = 0; i < 32; ++i) {
            float x[8], o[8]; unpack8(*(const u32x4*)(ptr + (size_t)i * PLD), x);
#pragma unroll
            for (int e = 0; e < 8; ++e) { o[e] = silu(bv[e] + wv[e][0] * w0[e] + wv[e][1] * w1[e] + wv[e][2] * w2[e] + wv[e][3] * x[e]); w0[e] = w1[e]; w1[e] = w2[e]; w2[e] = x[e]; }
            *(u32x4*)(ptr + (size_t)i * PLD) = pack8(o);
        }
    }
}
template <int CTRL> __device__ __forceinline__ float dpp_f(float v) { return __builtin_bit_cast(float, __builtin_amdgcn_update_dpp(0, __builtin_bit_cast(int, v), CTRL, 0xF, 0xF, true)); }
__device__ __forceinline__ float red8(float v) { v += dpp_f<0xB1>(v); v += dpp_f<0x4E>(v); v += dpp_f<0x141>(v); return v; }
__device__ __forceinline__ float red16(float v) { v = red8(v); v += dpp_f<0x140>(v); return v; }

__device__ __forceinline__ void rwkv_seq(Frame& F, int layer, int bh) {
    const int ptid = otid(), plane = ptid & 63, pwave = __builtin_amdgcn_readfirstlane(ptid >> 6); (void)plane; (void)pwave;
    const int b = bh >> 3, h = bh & 7;
    LAS float* L = (LAS float*)F.lds;
    LAS float *rr = L, *ww = L + 2048, *kf = L + 4096, *vv = L + 6144, *aa = L + 8192, *bb = L + 10240, *gg = L + 12288, *yy = L + 14336, *tw = L + 16384, *xa = L + 18432, *sg = L + 20480, *bon = L + 24576;
    const float* mu = INP(3) + layer * 1792; const float* w_up = INP(4) + layer * 64 * 512; const float* w0 = INP(5) + layer * 512;
    const float* a_up = INP(6) + layer * 64 * 512; const float* a0 = INP(7) + layer * 512; const float* g_up = INP(8) + layer * 128 * 512;
    const float* k_k = INP(9) + layer * 512; const float* k_a = INP(10) + layer * 512; const float* r_k = INP(11) + layer * 512;
    const float* gn_w = INP(12) + layer * 512; const float* gn_b = INP(13) + layer * 512;
    const bf16* P = (const bf16*)(F.ws + WS_BIG); const bf16* vsrc = (const bf16*)(F.ws + (layer == 0 ? WS_VF : WS_VMIX)); bf16* yout = (bf16*)(F.ws + WS_YRW);
    const int tid = ptid, tok = tid >> 4, part = tid & 15, c4 = part * 4, cb = h * 64 + c4;
    const int srow = tid >> 3, sc0 = (tid & 7) * 8;
    float S[8];
#pragma unroll
    for (int j = 0; j < 8; ++j) S[j] = 0.f;
    for (int t0 = 0; t0 < T; t0 += 32) {
        {
            const int t = t0 + tok; const size_t m = (size_t)b * T + t;
            const bf16* cur = P + m * PLD;
#pragma unroll
            for (int q = 0; q < 3; ++q) {
                const int ch = part + 16 * q; int col, kind; LAS float* dst;
                if (ch < 8) { col = h * 64 + ch * 8; dst = rr + tok * 64 + ch * 8; kind = 0; }
                else if (ch < 16) { col = 512 + h * 64 + (ch - 8) * 8; dst = kf + tok * 64 + (ch - 8) * 8; kind = 0; }
                else if (ch < 24) { col = 1536 + (ch - 16) * 8; dst = tw + tok * 64 + (ch - 16) * 8; kind = 1; }
                else if (ch < 32) { col = 1600 + (ch - 24) * 8; dst = xa + tok * 64 + (ch - 24) * 8; kind = 0; }
                else { col = 1664 + (ch - 32) * 8; dst = sg + tok * 128 + (ch - 32) * 8; kind = 2; }
                float c[8], p[8]; unpack8(*(const u32x4*)(cur + col), c);
                if (t > 0) unpack8(*(const u32x4*)(cur - PLD + col), p); else {
#pragma unroll
                    for (int e = 0; e < 8; ++e) p[e] = 0.f; }
#pragma unroll
                for (int e = 0; e < 8; ++e) { float x = c[e] + (p[e] - c[e]) * mu[col + e]; if (kind == 1) x = tanhf(x); else if (kind == 2) x = sigm(x); dst[e] = x; }
            }
            if (part < 8) { float v[8]; unpack8(*(const u32x4*)(vsrc + m * 512 + h * 64 + part * 8), v);
#pragma unroll
                for (int e = 0; e < 8; ++e) vv[tok * 64 + part * 8 + e] = v[e]; }
        }
        __syncthreads();
        {
            f32x4 dw = *(const f32x4*)(w0 + cb), da = *(const f32x4*)(a0 + cb), dg = (f32x4){0.f, 0.f, 0.f, 0.f};
            for (int j = 0; j < 64; ++j) { const float tj = tw[tok * 64 + j], xj = xa[tok * 64 + j];
                dw += *(const f32x4*)(w_up + j * 512 + cb) * tj; da += *(const f32x4*)(a_up + j * 512 + cb) * xj; }
            for (int j = 0; j < 128; ++j) dg += *(const f32x4*)(g_up + j * 512 + cb) * sg[tok * 128 + j];
            float kr[4], kk[4], av[4], ss = 0.f;
#pragma unroll
            for (int e = 0; e < 4; ++e) { kr[e] = kf[tok * 64 + c4 + e]; kk[e] = kr[e] * k_k[cb + e]; ss += kk[e] * kk[e]; av[e] = sigm(da[e]); }
            ss = red16(ss);
            const float inv = __builtin_amdgcn_rsqf(fmaxf(ss, 1e-24f));
            float bs = 0.f;
#pragma unroll
            for (int e = 0; e < 4; ++e) { const float kn = kk[e] * inv; const int o = tok * 64 + c4 + e;
                const float ld = -expf(-softplus_acc(-dw[e]) - 0.5f);
                ww[o] = expf(ld); aa[o] = -kn; bb[o] = kn * av[e];
                const float knew = kr[e] * (1.f + (av[e] - 1.f) * k_a[cb + e]); kf[o] = knew; gg[o] = dg[e];
                bs += rr[o] * knew * r_k[cb + e]; }
            bs = red16(bs);
            if (part == 0) bon[tok] = bs;
        }
        __syncthreads();
        for (int s = 0; s < 32; ++s) {
            const f32x4 a0v = *(const LAS f32x4*)(aa + s * 64 + sc0), a1v = *(const LAS f32x4*)(aa + s * 64 + sc0 + 4);
            const f32x4 w0v = *(const LAS f32x4*)(ww + s * 64 + sc0), w1v = *(const LAS f32x4*)(ww + s * 64 + sc0 + 4);
            const f32x4 b0v = *(const LAS f32x4*)(bb + s * 64 + sc0), b1v = *(const LAS f32x4*)(bb + s * 64 + sc0 + 4);
            const f32x4 k0v = *(const LAS f32x4*)(kf + s * 64 + sc0), k1v = *(const LAS f32x4*)(kf + s * 64 + sc0 + 4);
            const f32x4 r0v = *(const LAS f32x4*)(rr + s * 64 + sc0), r1v = *(const LAS f32x4*)(rr + s * 64 + sc0 + 4);
            const float vi = vv[s * 64 + srow];
            float sa = 0.f;
#pragma unroll
            for (int j = 0; j < 4; ++j) sa += S[j] * a0v[j] + S[4 + j] * a1v[j];
            sa = red8(sa);
            float y = 0.f;
#pragma unroll
            for (int j = 0; j < 4; ++j) { S[j] = S[j] * w0v[j] + sa * b0v[j] + vi * k0v[j]; S[4 + j] = S[4 + j] * w1v[j] + sa * b1v[j] + vi * k1v[j]; y += S[j] * r0v[j] + S[4 + j] * r1v[j]; }
            y = red8(y);
            if ((tid & 7) == 0) yy[s * 64 + srow] = y;
        }
        __syncthreads();
        {
            const size_t m = (size_t)b * T + t0 + tok;
            float y[4], sm = 0.f;
#pragma unroll
            for (int e = 0; e < 4; ++e) { y[e] = yy[tok * 64 + c4 + e]; sm += y[e]; }
            const float mean = red16(sm) * (1.f / 64.f);
            float vs = 0.f;
#pragma unroll
            for (int e = 0; e < 4; ++e) { y[e] -= mean; vs += y[e] * y[e]; }
            const float rs = __builtin_amdgcn_rsqf(red16(vs) * (1.f / 64.f) + 64e-5f);
            const float bo = bon[tok];
            float o[4];
#pragma unroll
            for (int e = 0; e < 4; ++e) { const int idx = tok * 64 + c4 + e; o[e] = (y[e] * rs * gn_w[cb + e] + gn_b[cb + e] + bo * vv[idx]) * gg[idx]; }
            u32x2 w; w.x = pk2(o[0], o[1]); w.y = pk2(o[2], o[3]);
            *(u32x2*)(yout + m * 512 + cb) = w;
        }
        __syncthreads();
    }
}

__device__ __forceinline__ void ret_seq(Frame& F, int bh) {
    const int ptid = otid(), plane = ptid & 63, pwave = __builtin_amdgcn_readfirstlane(ptid >> 6); (void)plane; (void)pwave;
    const int b = bh >> 3, h = bh & 7;
    LAS float* L = (LAS float*)F.lds;
    LAS float *qq = L, *kk = L + 2048, *vv = L + 4096, *gg = L + 6144, *yy = L + 8192;
    bf16* P = (bf16*)(F.ws + WS_BIG);
    const int tid = ptid, tok = tid >> 4, part = tid & 15, c4 = part * 4;
    const int se = tid >> 3, sd0 = (tid & 7) * 8;
    const float gamma = 1.f - exp2f(-5.f - (float)h);
    float S[8];
#pragma unroll
    for (int j = 0; j < 8; ++j) S[j] = 0.f;
    for (int t0 = 0; t0 < T; t0 += 32) {
        {
            const int t = t0 + tok; const size_t m = (size_t)b * T + t;
#pragma unroll
            for (int q = 0; q < 2; ++q) {
                const int ch = part + 16 * q, kind = ch >> 3, cc = ch & 7;
                float x[8]; unpack8(*(const u32x4*)(P + m * PLD + C_RET + kind * 512 + h * 64 + cc * 8), x);
                LAS float* dst = (kind == 0 ? qq : kind == 1 ? kk : kind == 2 ? vv : gg) + tok * 64 + cc * 8;
                if (kind < 2) {
#pragma unroll
                    for (int p = 0; p < 4; ++p) { const int i = cc * 4 + p;
                        const double invf = exp(-(double)i * (9.210340371976184 / 32.0));
                        double sn, cs; sincos((double)t * invf, &sn, &cs);
                        const float x0 = x[2 * p], x1 = x[2 * p + 1], c = (float)cs, s = (float)sn;
                        float o0 = x0 * c - x1 * s, o1 = x0 * s + x1 * c;
                        if (kind == 1) { o0 *= 0.125f; o1 *= 0.125f; }
                        dst[2 * p] = o0; dst[2 * p + 1] = o1; }
                } else {
#pragma unroll
                    for (int e = 0; e < 8; ++e) dst[e] = x[e];
                }
            }
        }
        __syncthreads();
        for (int s = 0; s < 32; ++s) {
            const f32x4 k0v = *(const LAS f32x4*)(kk + s * 64 + sd0), k1v = *(const LAS f32x4*)(kk + s * 64 + sd0 + 4);
            const f32x4 q0v = *(const LAS f32x4*)(qq + s * 64 + sd0), q1v = *(const LAS f32x4*)(qq + s * 64 + sd0 + 4);
            const float ve = vv[s * 64 + se];
            float y = 0.f;
#pragma unroll
            for (int j = 0; j < 4; ++j) { S[j] = gamma * S[j] + k0v[j] * ve; S[4 + j] = gamma * S[4 + j] + k1v[j] * ve; y += q0v[j] * S[j] + q1v[j] * S[4 + j]; }
            y = red8(y);
            if ((tid & 7) == 0) yy[s * 64 + se] = y;
        }
        __syncthreads();
        {
            const size_t m = (size_t)b * T + t0 + tok;
            float y[4], ss = 0.f;
#pragma unroll
            for (int e = 0; e < 4; ++e) { y[e] = yy[tok * 64 + c4 + e]; ss += y[e] * y[e]; }
            const float rs = __builtin_amdgcn_rsqf(red16(ss) * (1.f / 64.f) + 1e-6f);
            float o[4];
#pragma unroll
            for (int e = 0; e < 4; ++e) o[e] = y[e] * rs * silu(gg[tok * 64 + c4 + e]);
            u32x2 w; w.x = pk2(o[0], o[1]); w.y = pk2(o[2], o[3]);
            *(u32x2*)(P + m * PLD + C_RETG + h * 64 + c4) = w;
        }
        __syncthreads();
    }
}

__device__ __forceinline__ void ssd_seq(Frame& F, int layer, int bh) {
    const int ptid = otid(), plane = ptid & 63, pwave = __builtin_amdgcn_readfirstlane(ptid >> 6); (void)plane; (void)pwave;
    const int b = bh >> 3, h = bh & 7, g = h >> 2;
    LAS float* L = (LAS float*)F.lds;
    LAS float *raw = L  , *xs = L + 11200, *Bc = L + 13248, *Cc = L + 17344, *yy = L + 21440, *dts = L + 23488, *das = L + 23520;
    bf16* P = (bf16*)(F.ws + WS_BIG); const float* dtb = (const float*)(F.ws + WS_DT);
    const float* cw = INP(17) + layer * 1024 * 4; const float* cbias = INP(18) + layer * 1024;
    const float dt_bias = INP(19)[layer * 8 + h], A = -expf(INP(20)[layer * 8 + h]), Dh = INP(21)[layer * 8 + h];
    const int tid = ptid;
    const int sp = tid >> 3, sn0 = (tid & 7) * 16;
    float S[16];
#pragma unroll
    for (int j = 0; j < 16; ++j) S[j] = 0.f;
    for (int i = tid; i < 3 * 320; i += 512) raw[i] = 0.f;
    __syncthreads();
    for (int t0 = 0; t0 < T; t0 += 32) {
        for (int idx = tid; idx < 32 * 40; idx += 512) {
            const int row = idx / 40, ch = idx % 40; const size_t m = (size_t)b * T + t0 + row;
            const int col = ch < 8 ? (C_XBC + h * 64 + ch * 8) : (ch < 24 ? (C_XBC + 512 + g * 128 + (ch - 8) * 8) : (C_XBC + 768 + g * 128 + (ch - 24) * 8));
            float x[8]; unpack8(*(const u32x4*)(P + m * PLD + col), x);
#pragma unroll
            for (int e = 0; e < 8; ++e) raw[(3 + row) * 320 + ch * 8 + e] = x[e];
        }
        if (tid < 32) { const size_t m = (size_t)b * T + t0 + tid; const float dt = softplus_acc(dtb[m * 8 + h] + dt_bias); dts[tid] = dt; das[tid] = expf(A * dt); }
        __syncthreads();
        for (int idx = tid; idx < 32 * 320; idx += 512) {
            const int row = idx / 320, c = idx % 320;
            const int chn = c < 64 ? (h * 64 + c) : (c < 192 ? (512 + g * 128 + (c - 64)) : (768 + g * 128 + (c - 192)));
            float a = cbias[chn];
#pragma unroll
            for (int k = 0; k < 4; ++k) a += cw[chn * 4 + k] * raw[(row + k) * 320 + c];
            a = silu(a);
            if (c < 64) xs[row * 64 + c] = a; else if (c < 192) Bc[row * 128 + (c - 64)] = a; else Cc[row * 128 + (c - 192)] = a;
        }
        __syncthreads();
        for (int s = 0; s < 32; ++s) {
            const float da = das[s], xv = xs[s * 64 + sp], dtx = dts[s] * xv;
            float y = 0.f;
#pragma unroll
            for (int q = 0; q < 4; ++q) { const f32x4 bv = *(const LAS f32x4*)(Bc + s * 128 + sn0 + q * 4), cv = *(const LAS f32x4*)(Cc + s * 128 + sn0 + q * 4);
#pragma unroll
                for (int j = 0; j < 4; ++j) { S[q * 4 + j] = da * S[q * 4 + j] + dtx * bv[j]; y += S[q * 4 + j] * cv[j]; } }
            y = red8(y);
            if ((tid & 7) == 0) yy[s * 64 + sp] = y + Dh * xv;
        }
        __syncthreads();
        {
            const int tok = tid >> 4, c4 = (tid & 15) * 4; const size_t m = (size_t)b * T + t0 + tok;
            u32x2 w; w.x = pk2(yy[tok * 64 + c4], yy[tok * 64 + c4 + 1]); w.y = pk2(yy[tok * 64 + c4 + 2], yy[tok * 64 + c4 + 3]);
            *(u32x2*)(P + m * PLD + C_XBC + h * 64 + c4) = w;
            for (int i = tid; i < 3 * 320; i += 512) raw[i] = raw[32 * 320 + i];
        }
        __syncthreads();
    }
}
__device__ __forceinline__ void ssm_norm_phase(Frame& F, int layer) {
    const int ptid = otid(), plane = ptid & 63, pwave = __builtin_amdgcn_readfirstlane(ptid >> 6); (void)plane; (void)pwave;
    const int gw = F.vcu * 8 + pwave, NGW = F.G * 8;
    bf16* P = (bf16*)(F.ws + WS_BIG); const float* nw = INP(22) + layer * 512;
    for (int m = gw; m < M; m += NGW) {
        float y[8], z[8]; unpack8(*(const u32x4*)(P + (size_t)m * PLD + C_XBC + plane * 8), y); unpack8(*(const u32x4*)(P + (size_t)m * PLD + C_Z + plane * 8), z);
        float ss = 0.f;
#pragma unroll
        for (int e = 0; e < 8; ++e) { y[e] *= silu(z[e]); ss += y[e] * y[e]; }
        ss += __shfl_xor(ss, 1); ss += __shfl_xor(ss, 2); ss += __shfl_xor(ss, 4); ss += __shfl_xor(ss, 8); ss += __shfl_xor(ss, 16);
        const float rs = __builtin_amdgcn_rsqf(ss * (1.f / 256.f) + 1e-6f);
#pragma unroll
        for (int e = 0; e < 8; ++e) y[e] *= rs * nw[plane * 8 + e];
        *(u32x4*)(P + (size_t)m * PLD + C_Z + plane * 8) = pack8(y);
    }
}

constexpr int PT = 72, PT2 = 136, PF = 68;
__device__ __forceinline__ f32x4 mfma16(bf16x8 a, bf16x8 b, f32x4 c) { return __builtin_amdgcn_mfma_f32_16x16x32_bf16(a, b, c, 0, 0, 0); }
template <int K, bool SA = false, bool SB = false> __device__ __forceinline__ f32x4 mm_ll(const LAS bf16* A, int pa, int m0, const LAS bf16* B, int pb, int n0, f32x4 acc, int lane) {
    const int r = lane & 15, q = lane >> 4;
    const int xa = SA ? (((m0 + r) >> 3) & 7) : 0, xb = SB ? (((n0 + r) >> 3) & 7) : 0;
    const LAS bf16* ap = A + (m0 + r) * pa; const LAS bf16* bp = B + (n0 + r) * pb;
#pragma unroll
    for (int k0 = 0; k0 < K; k0 += 32) acc = mfma16(*(const LAS bf16x8*)(ap + 8 * (((k0 >> 3) + q) ^ xa)), *(const LAS bf16x8*)(bp + 8 * (((k0 >> 3) + q) ^ xb)), acc);
    return acc;
}
template <int K> __device__ __forceinline__ f32x4 mm_lg(const LAS bf16* A, int pa, int m0, const bf16* B, int pb, int n0, f32x4 acc, int lane) {
    const int r = lane & 15, q = lane >> 4;
    const LAS bf16* ap = A + (m0 + r) * pa + 8 * q; const bf16* bp = B + (size_t)(n0 + r) * pb + 8 * q;
#pragma unroll
    for (int k0 = 0; k0 < K; k0 += 32) acc = mfma16(*(const LAS bf16x8*)(ap + k0), *(const bf16x8*)(bp + k0), acc);
    return acc;
}
__device__ __forceinline__ float redl16(float v) { return red16(v); }
__device__ __forceinline__ void st4bf(LAS bf16* p, f32x4 v) { u32x2 w; w.x = pk2(v[0], v[1]); w.y = pk2(v[2], v[3]); *(LAS u32x2*)p = w; }
__device__ __forceinline__ float ldbf(const LAS bf16* p) { return __builtin_bit_cast(float, (unsigned)(*p) << 16); }
constexpr f32x4 FZ4 = {0.f, 0.f, 0.f, 0.f};
__device__ __forceinline__ void tr_write8(LAS bf16* Tm, int pitch, int c0, int t, const float (&v)[8], int) {
    LAS bf16* base = Tm + c0 * pitch + (t ^ (((c0 >> 3) & 7) << 3));
#pragma unroll
    for (int e = 0; e < 8; ++e) base[e * pitch] = (bf16)f2bf(v[e]);
}
__device__ __forceinline__ float tr_at(const LAS bf16* Tm, int pitch, int row, int col) { return __builtin_bit_cast(float, (unsigned)Tm[row * pitch + (col ^ (((row >> 3) & 7) << 3))] << 16); }
__device__ __forceinline__ void ld8f(const LAS float* p, float (&v)[8]) { const f32x4 a = *(const LAS f32x4*)p, b = *(const LAS f32x4*)(p + 4); v[0] = a[0]; v[1] = a[1]; v[2] = a[2]; v[3] = a[3]; v[4] = b[0]; v[5] = b[1]; v[6] = b[2]; v[7] = b[3]; }
__device__ __forceinline__ void st8f(LAS float* p, const float (&v)[8]) { *(LAS f32x4*)p = (f32x4){v[0], v[1], v[2], v[3]}; *(LAS f32x4*)(p + 4) = (f32x4){v[4], v[5], v[6], v[7]}; }

template <bool FINAL>
__device__ __forceinline__ void rwkv_chunk_unit(Frame& F, int layer, int u) {
    const int tid = otid(), w = __builtin_amdgcn_readfirstlane(tid >> 6);
    bf16x8 lfr[16];
#define IDS() const int ft = fresh_tid(tid); const int lane = ft & 63, r16 = lane & 15, q4 = lane >> 4, tok = ft >> 3, part = ft & 7; (void)lane; (void)r16; (void)q4; (void)tok; (void)part
    const int b = u >> 9, sc = (u >> 3) & 63, h = u & 7;
    constexpr int NV = FINAL ? 64 : 128, NVT = NV / 16, NZ = NVT / 2;
    constexpr int X_TW = 0, X_XA = 9216, X_SG = 18432, X_KF = 35840, X_RF = 52224;
    constexpr int O_AT = 0, O_RT = 9216, O_BT = 18432, O_KT = 27648, O_BH = 36864, O_KH = 46080, O_VT = 55296, O_TF = O_BT;
    constexpr int Y0 = 68608;
    constexpr int Y_A = Y0, Y_B = Y0 + 8192, Y_K = Y0 + 16384, Y_R = Y0 + 24576, Y_L = Y0 + 32768, Y_VF = Y0 + 49152;
    constexpr int Y_AAB = Y0, Y_AAK = Y0 + 17408, Y_ARB = Y_AAK + 9216, Y_ARK = Y_ARB + 9216, Y_TB = FINAL ? Y_ARK + 9216 : Y_AAK + 9216, Y_ZU = Y_TB + 9216, Y_YF = Y_AAB;
    static_assert(Y_ZU + NV * PT * 2 <= Y0 + 65536, "region Y");
    constexpr int Z0 = Y0 + 65536, Z_G = Z0, Z_S = FINAL ? Z0 + 8192 : Z0, Z_MISC = 152576, Z_BON = Z_MISC, Z_PC = Z_MISC + 256, Z_PAR = Z_MISC + 512, Z_XS = Y_ZU;
    static_assert(Z_S + NV * PT * 2 <= Z_MISC && Z_PAR + 832 * 4 <= LDSCTL_OFF, "region Z");
    LAS unsigned char* L = F.lds;
#define LB(off) ((LAS bf16*)(L + (off)))
#define LF(off) ((LAS float*)(L + (off)))
    {
        const int pidx = (w == 0) ? 5 : (w == 1) ? 7 : (w == 2) ? 9 : (w == 3) ? 10 : (w == 4) ? 11 : (w == 5) ? 12 : 13;
        if (w < 7) LF(Z_PAR)[w * 64 + (tid & 63)] = (INP(pidx) + layer * 512 + h * 64)[tid & 63];
        const float* mu = INP(3) + layer * 1792;
        for (int i = tid; i < 384; i += 512) LF(Z_PAR)[448 + i] = mu[(i < 64) ? (h * 64 + i) : (i < 128) ? (512 + h * 64 + (i - 64)) : (1536 + (i - 128))];
    }
    __syncthreads();
    const bf16* WupT = (const bf16*)(F.ws + WS_LORA + (size_t)layer * LORA_STRIDE) + h * 64 * 64;
    const bf16* AupT = (const bf16*)(F.ws + WS_LORA + (size_t)layer * LORA_STRIDE + 65536) + h * 64 * 64;
    const bf16* GupT = (const bf16*)(F.ws + WS_LORA + (size_t)layer * LORA_STRIDE + 131072) + h * 64 * 128;
    const bf16* P = (const bf16*)(F.ws + WS_BIG); const bf16* vsrc = (const bf16*)(F.ws + (layer == 0 ? WS_VF : WS_VMIX));
    float* Nbuf = (float*)(F.st + 0) + (size_t)u * 4096; bf16* MT = (bf16*)(F.ws + WS_MT) + (size_t)u * 4096;
    { IDS();
        if (w < 4) {
#pragma unroll
            for (int nt = 0; nt < 4; ++nt)
#pragma unroll
                for (int k2 = 0; k2 < 2; ++k2) { lfr[nt * 4 + k2] = *(const bf16x8*)(WupT + (size_t)(16 * nt + r16) * 64 + 32 * k2 + 8 * q4); lfr[nt * 4 + 2 + k2] = *(const bf16x8*)(AupT + (size_t)(16 * nt + r16) * 64 + 32 * k2 + 8 * q4); }
        } else if (FINAL) {
#pragma unroll
            for (int nt = 0; nt < 4; ++nt)
#pragma unroll
                for (int k4 = 0; k4 < 4; ++k4) lfr[nt * 4 + k4] = *(const bf16x8*)(GupT + (size_t)(16 * nt + r16) * 128 + 32 * k4 + 8 * q4);
        } }
    constexpr int NST = FINAL ? 2 : 4;
    f32x4 Sacc[NST];
    const int s_vb = FINAL ? (w & 3) : w;
#define S_CT(ti) (FINAL ? (2 * (w >> 2) + (ti)) : (ti))
    { IDS();
#pragma unroll
    for (int ti = 0; ti < NST; ++ti) {
        const int ct = S_CT(ti);
#pragma unroll
        for (int jj = 0; jj < 4; ++jj) { const int v = 16 * s_vb + 4 * q4 + jj, c = 16 * ct + r16;
            float x; if (FINAL) x = Nbuf[v * 64 + c]; else x = (v >= 64 && v - 64 == c) ? 1.f : 0.f;
            Sacc[ti][jj] = x; LB(Z_S)[v * PT + c] = (bf16)f2bf(x); }
    } }
    u32x4 pfc[6], pfp[6], pfv;
#define RW_PREFETCH(jn) do { IDS(); const int t_ = sc * 256 + (jn) * 64 + tok; const size_t m_ = (size_t)b * T + t_; const bf16* cur_ = P + m_ * PLD; \
        _Pragma("unroll") for (int i_ = 0; i_ < 6; ++i_) { const int col_ = (i_ == 0) ? (h * 64 + 8 * part) : (i_ == 1) ? (512 + h * 64 + 8 * part) : (i_ == 2) ? (1536 + 8 * part) : (i_ == 3) ? (1600 + 8 * part) : (1664 + 8 * part + (i_ - 4) * 64); \
            pfc[i_] = *(const u32x4*)(cur_ + col_); pfp[i_] = (t_ > 0) ? *(const u32x4*)(cur_ - PLD + col_) : (u32x4){0u, 0u, 0u, 0u}; } \
        pfv = *(const u32x4*)(vsrc + m_ * 512 + h * 64 + 8 * part); } while (0)
    RW_PREFETCH(0);
    for (int j = 0; j < 4; ++j) {
        const int tl0 = sc * 256 + j * 64;
        {
            IDS();
            const int t = tl0 + tok; const size_t m = (size_t)b * T + t; const bf16* cur = P + m * PLD;
#pragma unroll
            for (int i = 0; i < 6; ++i) {
                const int col = (i == 0) ? (h * 64 + 8 * part) : (i == 1) ? (512 + h * 64 + 8 * part) : (i == 2) ? (1536 + 8 * part) : (i == 3) ? (1600 + 8 * part) : (1664 + 8 * part + (i - 4) * 64);
                float c[8], p[8]; unpack8(pfc[i], c); unpack8(pfp[i], p); (void)col;
#pragma unroll
                for (int e = 0; e < 8; ++e) c[e] = c[e] + (p[e] - c[e]) * LF(Z_PAR)[448 + ((i < 4) ? 64 * i : 256 + 64 * (i - 4)) + 8 * part + e];
                if (i == 0) { st8f(LF(X_RF) + tok * 64 + 8 * part, c);
                } else if (i == 1) { st8f(LF(X_KF) + tok * 64 + 8 * part, c);
                } else if (i == 2) {
#pragma unroll
                    for (int e = 0; e < 8; ++e) c[e] = fast_tanh(c[e]);
                    *(LAS u32x4*)(LB(X_TW) + tok * PT + 8 * part) = pack8(c);
                } else if (i == 3) {
                    *(LAS u32x4*)(LB(X_XA) + tok * PT + 8 * part) = pack8(c);
                } else if (FINAL) {
#pragma unroll
                    for (int e = 0; e < 8; ++e) c[e] = sigm(c[e]);
                    *(LAS u32x4*)(LB(X_SG) + tok * PT2 + 8 * part + (i - 4) * 64) = pack8(c);
                }
            }
            float v[8]; unpack8(pfv, v); (void)m; (void)cur;
            st8f(LF(Y_VF) + tok * 64 + 8 * part, v);
        }
        if (j < 3) RW_PREFETCH(j + 1);
        __syncthreads();
        { IDS();
        if (w < 4) {
            const int rb = w;
            float inv[4], bs[4] = {0.f, 0.f, 0.f, 0.f};
            { float ss[4] = {0.f, 0.f, 0.f, 0.f};
#pragma unroll
                for (int nt = 0; nt < 4; ++nt) { const int c = 16 * nt + r16; const float kkc = LF(Z_PAR)[128 + c];
#pragma unroll
                    for (int jj = 0; jj < 4; ++jj) { const float kk = LF(X_KF)[(16 * rb + 4 * q4 + jj) * 64 + c] * kkc; ss[jj] += kk * kk; } }
#pragma unroll
                for (int jj = 0; jj < 4; ++jj) inv[jj] = __builtin_amdgcn_rsqf(fmaxf(redl16(ss[jj]), 1e-24f)); }
#pragma unroll
            for (int nt = 0; nt < 4; ++nt) {
                f32x4 aw = FZ4, aa = FZ4;
#pragma unroll
                for (int k2 = 0; k2 < 2; ++k2) { aw = mfma16(*(const LAS bf16x8*)(LB(X_TW) + (16 * rb + r16) * PT + 32 * k2 + 8 * q4), lfr[nt * 4 + k2], aw); aa = mfma16(*(const LAS bf16x8*)(LB(X_XA) + (16 * rb + r16) * PT + 32 * k2 + 8 * q4), lfr[nt * 4 + 2 + k2], aa); }
                const int c = 16 * nt + r16; const float w0c = LF(Z_PAR)[c], a0c = LF(Z_PAR)[64 + c], kkc = LF(Z_PAR)[128 + c], kac = LF(Z_PAR)[192 + c], rkc = LF(Z_PAR)[256 + c];
#pragma unroll
                for (int jj = 0; jj < 4; ++jj) { const int t = 16 * rb + 4 * q4 + jj, o = t * 64 + c;
                    LF(Y_L)[o] = -0.8750455979f * sigm(w0c + aw[jj]);
                    const float al = sigm(a0c + aa[jj]), kraw = LF(X_KF)[o], rr = LF(X_RF)[o], kn = kraw * kkc * inv[jj];
                    const float knew = kraw * (1.f + (al - 1.f) * kac);
                    LB(Y_A)[o] = (bf16)f2bf(-kn); LB(Y_B)[o] = (bf16)f2bf(kn * al); LB(Y_K)[o] = (bf16)f2bf(knew); LB(Y_R)[o] = (bf16)f2bf(rr);
                    bs[jj] += rr * knew * rkc; } }
#pragma unroll
            for (int jj = 0; jj < 4; ++jj) { const float sm = redl16(bs[jj]); if (r16 == 0) LF(Z_BON)[16 * rb + 4 * q4 + jj] = sm; }
        } else if (FINAL) {
            const int rb = w - 4;
#pragma unroll
            for (int nt = 0; nt < 4; ++nt) { f32x4 ag = FZ4;
#pragma unroll
                for (int k4 = 0; k4 < 4; ++k4) ag = mfma16(*(const LAS bf16x8*)(LB(X_SG) + (16 * rb + r16) * PT2 + 32 * k4 + 8 * q4), lfr[nt * 4 + k4], ag);
#pragma unroll
                for (int jj = 0; jj < 4; ++jj) LB(Z_G)[(16 * rb + 4 * q4 + jj) * 64 + 16 * nt + r16] = (bf16)f2bf(ag[jj]); }
        } }
        __syncthreads();
        if (w == 0) { IDS(); float run = 0.f;
#pragma unroll 8
            for (int t = 0; t < 64; ++t) { run += LF(Y_L)[t * 64 + lane]; LF(Y_L)[t * 64 + lane] = run; }
            LF(Z_PC)[lane] = ex2(run); }
        __syncthreads();
        {
            IDS(); const int t = tok, c0 = 8 * part;
            float Lt[8], Lp[8], Le[8], av[8], bv[8], kv[8], rv[8], vv[8], at[8], rt[8], bt[8], kt[8], bh[8], kh[8];
            ld8f(LF(Y_L) + t * 64 + c0, Lt); ld8f(LF(Y_L) + 63 * 64 + c0, Le); ld8f(LF(Y_VF) + t * 64 + c0, vv);
            if (t > 0) ld8f(LF(Y_L) + (t - 1) * 64 + c0, Lp); else {
#pragma unroll
                for (int e = 0; e < 8; ++e) Lp[e] = 0.f; }
            unpack8(*(const LAS u32x4*)(LB(Y_A) + t * 64 + c0), av); unpack8(*(const LAS u32x4*)(LB(Y_B) + t * 64 + c0), bv);
            unpack8(*(const LAS u32x4*)(LB(Y_K) + t * 64 + c0), kv); unpack8(*(const LAS u32x4*)(LB(Y_R) + t * 64 + c0), rv);
#pragma unroll
            for (int e = 0; e < 8; ++e) { const float eL = ex2(Lt[e]), eLm = ex2(Lp[e]), eN = ex2(-Lt[e]), eE = ex2(Le[e] - Lt[e]);
                at[e] = av[e] * eLm; rt[e] = rv[e] * eL; bt[e] = bv[e] * eN; kt[e] = kv[e] * eN; bh[e] = bv[e] * eE; kh[e] = kv[e] * eE; }
            tr_write8(LB(O_BH), PT, c0, t, bh, part); tr_write8(LB(O_KH), PT, c0, t, kh, part); tr_write8(LB(O_VT), PT, c0, t, vv, part);
            *(LAS u32x4*)(LB(O_AT) + t * PT + c0) = pack8(at); *(LAS u32x4*)(LB(O_RT) + t * PT + c0) = pack8(rt);
            *(LAS u32x4*)(LB(O_BT) + t * PT + c0) = pack8(bt); *(LAS u32x4*)(LB(O_KT) + t * PT + c0) = pack8(kt);
        }
        __syncthreads();
        {
            IDS(); const int rb = w & 3;
#pragma unroll
            for (int ci = 0; ci < 2; ++ci) { const int ct = 2 * (w >> 2) + ci;
                f32x4 ab = FZ4, ak = FZ4, arb = FZ4, ark = FZ4;
                if (ct <= rb) { ab = mm_ll<64>(LB(O_AT), PT, 16 * rb, LB(O_BT), PT, 16 * ct, FZ4, lane); ak = mm_ll<64>(LB(O_AT), PT, 16 * rb, LB(O_KT), PT, 16 * ct, FZ4, lane);
                    if (FINAL) { arb = mm_ll<64>(LB(O_RT), PT, 16 * rb, LB(O_BT), PT, 16 * ct, FZ4, lane); ark = mm_ll<64>(LB(O_RT), PT, 16 * rb, LB(O_KT), PT, 16 * ct, FZ4, lane); } }
#pragma unroll
                for (int jj = 0; jj < 4; ++jj) { const int t = 16 * rb + 4 * q4 + jj, i = 16 * ct + r16;
                    LF(Y_AAB)[t * PF + i] = (i < t) ? ab[jj] : 0.f; LB(Y_TB)[t * PT + i] = (bf16)f2bf(((i >> 4) < (t >> 4)) ? ab[jj] : 0.f); LB(Y_AAK)[t * PT + i] = (bf16)f2bf((i < t) ? ak[jj] : 0.f);
                    if (FINAL) { LB(Y_ARB)[t * PT + i] = (bf16)f2bf((i <= t) ? arb[jj] : 0.f); LB(Y_ARK)[t * PT + i] = (bf16)f2bf((i <= t) ? ark[jj] : 0.f); } } }
        }
        __syncthreads();
        {
            IDS(); const int rb = w & 3;
            constexpr int O_DB = O_BT, O_VB = O_BT + 5120;
            if (w == 0) { const int blk = lane >> 4, col = lane & 15; float x[16];
#pragma unroll
                for (int i = 0; i < 16; ++i) x[i] = (i == col) ? 1.f : 0.f;
#pragma unroll
                for (int g3 = 0; g3 < 3; ++g3) {
                    f32x4 ar[5][4];
#pragma unroll
                    for (int ii = 0; ii < 5; ++ii) { const int i = 1 + 5 * g3 + ii;
#pragma unroll
                        for (int g4 = 0; g4 < 4; ++g4) if (4 * g4 < i) ar[ii][g4] = *(const LAS f32x4*)(LF(Y_AAB) + (16 * blk + i) * PF + 16 * blk + 4 * g4); }
                    asm volatile("" ::: "memory");
#pragma unroll
                    for (int ii = 0; ii < 5; ++ii) { const int i = 1 + 5 * g3 + ii; float sacc = 0.f;
#pragma unroll
                        for (int m2 = 0; m2 < i; ++m2) sacc += ar[ii][m2 >> 2][m2 & 3] * x[m2];
                        x[i] += sacc; }
                }
#pragma unroll
                for (int i = 0; i < 16; ++i) LB(O_DB)[(16 * blk + i) * 40 + col] = (bf16)f2bf(x[i]);
                *(LAS u32x4*)(LB(O_DB) + lane * 40 + 16) = (u32x4){0u, 0u, 0u, 0u}; *(LAS u32x4*)(LB(O_DB) + lane * 40 + 24) = (u32x4){0u, 0u, 0u, 0u}; }
            if (lane < 16) { *(LAS u32x4*)(LB(O_VB) + w * 640 + lane * 40 + 16) = (u32x4){0u, 0u, 0u, 0u}; *(LAS u32x4*)(LB(O_VB) + w * 640 + lane * 40 + 24) = (u32x4){0u, 0u, 0u, 0u}; }
#pragma unroll
            for (int ci = 0; ci < NZ; ++ci) { const int vt = (w >> 2) * NZ + ci;
                f32x4 z = mm_ll<64>(LB(O_AT), PT, 16 * rb, LB(Z_S), PT, 16 * vt, FZ4, lane);
                if (vt < 4) z = mm_ll<64, false, true>(LB(Y_AAK), PT, 16 * rb, LB(O_VT), PT, 16 * vt, z, lane);
                st4bf(LB(Y_ZU) + (16 * vt + r16) * PT + 16 * rb + 4 * q4, z); }
            __syncthreads();
            if (w < NVT) { const int vt = w; LAS bf16* vb = LB(O_VB) + w * 640; LAS bf16* zrow = LB(Y_ZU) + (16 * vt + r16) * PT;
#pragma unroll
                for (int bb = 0; bb < 4; ++bb) {
                    f32x4 acc; { const u32x2 zz = *(const LAS u32x2*)(zrow + 16 * bb + 4 * q4); acc[0] = bflo(zz.x); acc[1] = bfhi(zz.x); acc[2] = bflo(zz.y); acc[3] = bfhi(zz.y); }
                    if (bb >= 1) acc = mfma16(*(const LAS bf16x8*)(LB(Y_TB) + (16 * bb + r16) * PT + 8 * q4), *(const LAS bf16x8*)(zrow + 8 * q4), acc);
                    if (bb >= 3) acc = mfma16(*(const LAS bf16x8*)(LB(Y_TB) + (16 * bb + r16) * PT + 32 + 8 * q4), *(const LAS bf16x8*)(zrow + 32 + 8 * q4), acc);
                    st4bf(vb + r16 * 40 + 4 * q4, acc);
                    const f32x4 ub = mfma16(*(const LAS bf16x8*)(LB(O_DB) + (16 * bb + r16) * 40 + 8 * q4), *(const LAS bf16x8*)(vb + r16 * 40 + 8 * q4), FZ4);
                    st4bf(zrow + 16 * bb + 4 * q4, ub); }
            }
        }
        __syncthreads();
        {
            IDS(); f32x4 yy[2];
            if (FINAL) { const int rb = w & 3;
#pragma unroll
                for (int ci = 0; ci < 2; ++ci) { const int ct = 2 * (w >> 2) + ci;
                    f32x4 y = mm_ll<64>(LB(O_RT), PT, 16 * rb, LB(Z_S), PT, 16 * ct, FZ4, lane);
                    y = mm_ll<64>(LB(Y_ARB), PT, 16 * rb, LB(Y_ZU), PT, 16 * ct, y, lane);
                    yy[ci] = mm_ll<64, false, true>(LB(Y_ARK), PT, 16 * rb, LB(O_VT), PT, 16 * ct, y, lane); } }
#pragma unroll
            for (int ti = 0; ti < NST; ++ti) { const int ct = S_CT(ti); const float pc = LF(Z_PC)[16 * ct + r16];
                f32x4 s = Sacc[ti] * pc;
                s = mm_ll<64, false, true>(LB(Y_ZU), PT, 16 * s_vb, LB(O_BH), PT, 16 * ct, s, lane);
                if (s_vb < 4) s = mm_ll<64, true, true>(LB(O_VT), PT, 16 * s_vb, LB(O_KH), PT, 16 * ct, s, lane);
                Sacc[ti] = s; }
            __syncthreads();
#pragma unroll
            for (int ti = 0; ti < NST; ++ti) { const int ct = S_CT(ti);
#pragma unroll
                for (int jj = 0; jj < 4; ++jj) LB(Z_S)[(16 * s_vb + 4 * q4 + jj) * PT + 16 * ct + r16] = (bf16)f2bf(Sacc[ti][jj]); }
            if (FINAL) { const int rb = w & 3;
#pragma unroll
                for (int ci = 0; ci < 2; ++ci) { const int ct = 2 * (w >> 2) + ci;
#pragma unroll
                    for (int jj = 0; jj < 4; ++jj) LF(Y_YF)[(16 * rb + 4 * q4 + jj) * PF + 16 * ct + r16] = yy[ci][jj]; } }
        }
        __syncthreads();
        if (FINAL) {
            IDS();
            const int t = tok, c0 = 8 * part; const size_t m = (size_t)b * T + tl0 + t;
            float y[8], gg[8], sm = 0.f; ld8f(LF(Y_YF) + t * PF + c0, y); unpack8(*(const LAS u32x4*)(LB(Z_G) + t * 64 + c0), gg);
#pragma unroll
            for (int e = 0; e < 8; ++e) sm += y[e];
            const float mean = red8(sm) * (1.f / 64.f); float vs = 0.f;
#pragma unroll
            for (int e = 0; e < 8; ++e) { y[e] -= mean; vs += y[e] * y[e]; }
            const float rs = __builtin_amdgcn_rsqf(red8(vs) * (1.f / 64.f) + 64e-5f), bo = LF(Z_BON)[t];
#pragma unroll
            for (int e = 0; e < 8; ++e) { const int c = c0 + e; y[e] = (y[e] * rs * LF(Z_PAR)[320 + c] + LF(Z_PAR)[384 + c] + bo * tr_at(LB(O_VT), PT, c, t)) * gg[e]; }
            *(u32x4*)((bf16*)(F.ws + WS_BIG) + m * PLD + 1024 + h * 64 + c0) = pack8(y);
        }
        __syncthreads();
    }
    if (!FINAL) { IDS();
#pragma unroll
        for (int ti = 0; ti < NST; ++ti) { const int ct = S_CT(ti);
            if (s_vb < 4) {
#pragma unroll
                for (int jj = 0; jj < 4; ++jj) Nbuf[(16 * s_vb + 4 * q4 + jj) * 64 + 16 * ct + r16] = Sacc[ti][jj];
            } else { u32x2 wv; wv.x = pk2(Sacc[ti][0], Sacc[ti][1]); wv.y = pk2(Sacc[ti][2], Sacc[ti][3]);
                *(u32x2*)(MT + (16 * ct + r16) * 64 + 16 * (s_vb - 4) + 4 * q4) = wv; }
        }
    }
#undef RW_PREFETCH
#undef IDS
#undef S_CT
#undef LB
#undef LF
}

template <bool FINAL>
__device__ __forceinline__ void ret_chunk_unit(Frame& F, int u) {
    const int tid = otid(), lane = tid & 63, w = __builtin_amdgcn_readfirstlane(tid >> 6), r16 = lane & 15, q4 = lane >> 4;
    const int b = u >> 9, sc = (u >> 3) & 63, h = u & 7;
    constexpr int R_QB = 0, R_KB = 9216, R_KHT = 18432, R_VT = 27648, R_GB = 36864, R_AB = 45056, R_SB = 54272, R_YF = 63488;
    LAS unsigned char* L = F.lds;
#define LB(off) ((LAS bf16*)(L + (off)))
#define LF(off) ((LAS float*)(L + (off)))
    bf16* P = (bf16*)(F.ws + WS_BIG);
    float* Sbuf = (float*)(F.st + 16 * MiB) + (size_t)u * 4096;
    const float lg = log2f(1.f - exp2f(-5.f - (float)h));
    const float g64 = ex2(64.f * lg);
    const int db = w & 3;
    f32x4 Sacc[2];
#pragma unroll
    for (int ci = 0; ci < 2; ++ci) { const int et = 2 * (w >> 2) + ci;
#pragma unroll
        for (int jj = 0; jj < 4; ++jj) Sacc[ci][jj] = FINAL ? Sbuf[(16 * db + 4 * q4 + jj) * 64 + 16 * et + r16] : 0.f;
        if (FINAL) st4bf(LB(R_SB) + (16 * et + r16) * PT + 16 * db + 4 * q4, Sacc[ci]); }
    const int tok = tid >> 3, part = tid & 7;
    for (int j = 0; j < 4; ++j) {
        const int tl0 = sc * 256 + j * 64;
        {
            const int t = tl0 + tok; const size_t m = (size_t)b * T + t; const bf16* row = P + m * PLD + C_RET + h * 64 + 8 * part;
            float qv[8], kv[8], vv[8]; unpack8(*(const u32x4*)(row + 512), kv); unpack8(*(const u32x4*)(row + 1024), vv);
            if (FINAL) { unpack8(*(const u32x4*)row, qv); *(LAS u32x4*)(LB(R_GB) + tok * 64 + 8 * part) = *(const u32x4*)(row + 1536); }
            const float zeta = ex2((float)(63 - tok) * lg);
            if (FINAL) { *(LAS u32x4*)(LB(R_QB) + tok * PT + 8 * part) = pack8(qv); *(LAS u32x4*)(LB(R_KB) + tok * PT + 8 * part) = pack8(kv); }
            float kz[8];
#pragma unroll
            for (int e = 0; e < 8; ++e) kz[e] = kv[e] * zeta;
            tr_write8(LB(R_KHT), PT, 8 * part, tok, kz, part); tr_write8(LB(R_VT), PT, 8 * part, tok, vv, part);
        }
        __syncthreads();
        if (FINAL) { const int rb = w & 3;
#pragma unroll
            for (int ci = 0; ci < 2; ++ci) { const int ct = 2 * (w >> 2) + ci; f32x4 a = FZ4;
                if (ct <= rb) a = mm_ll<64>(LB(R_QB), PT, 16 * rb, LB(R_KB), PT, 16 * ct, FZ4, lane);
#pragma unroll
                for (int jj = 0; jj < 4; ++jj) { const int l = 16 * rb + 4 * q4 + jj, s = 16 * ct + r16; LB(R_AB)[l * PT + s] = (bf16)f2bf((s <= l) ? a[jj] * ex2((float)(l - s) * lg) : 0.f); } }
            __syncthreads();
        }
        {
            f32x4 yy[2];
            if (FINAL) { const int rb = w & 3;
#pragma unroll
                for (int ci = 0; ci < 2; ++ci) { const int et = 2 * (w >> 2) + ci;
                    const f32x4 a1 = mm_ll<64, false, true>(LB(R_AB), PT, 16 * rb, LB(R_VT), PT, 16 * et, FZ4, lane), a2 = mm_ll<64>(LB(R_QB), PT, 16 * rb, LB(R_SB), PT, 16 * et, FZ4, lane);
#pragma unroll
                    for (int jj = 0; jj < 4; ++jj) yy[ci][jj] = a1[jj] + ex2((float)(16 * rb + 4 * q4 + jj + 1) * lg) * a2[jj]; } }
#pragma unroll
            for (int ci = 0; ci < 2; ++ci) { const int et = 2 * (w >> 2) + ci; Sacc[ci] = mm_ll<64, true, true>(LB(R_KHT), PT, 16 * db, LB(R_VT), PT, 16 * et, Sacc[ci] * g64, lane); }
            __syncthreads();
            if (FINAL) { const int rb = w & 3;
#pragma unroll
                for (int ci = 0; ci < 2; ++ci) { const int et = 2 * (w >> 2) + ci; st4bf(LB(R_SB) + (16 * et + r16) * PT + 16 * db + 4 * q4, Sacc[ci]);
#pragma unroll
                    for (int jj = 0; jj < 4; ++jj) LF(R_YF)[(16 * rb + 4 * q4 + jj) * PF + 16 * et + r16] = yy[ci][jj]; } }
        }
        __syncthreads();
        if (FINAL) { const size_t m = (size_t)b * T + tl0 + tok; float y[8], g[8], ss = 0.f;
            ld8f(LF(R_YF) + tok * PF + 8 * part, y);
#pragma unroll
            for (int e = 0; e < 8; ++e) ss += y[e] * y[e];
            const float rs = __builtin_amdgcn_rsqf(red8(ss) * (1.f / 64.f) + 1e-6f);
            unpack8(*(const LAS u32x4*)(LB(R_GB) + tok * 64 + 8 * part), g);
#pragma unroll
            for (int e = 0; e < 8; ++e) y[e] = y[e] * rs * silu(g[e]);
            *(u32x4*)(P + m * PLD + C_RETG + h * 64 + 8 * part) = pack8(y);
            __syncthreads(); }
    }
    if (!FINAL) {
#pragma unroll
        for (int ci = 0; ci < 2; ++ci) { const int et = 2 * (w >> 2) + ci;
#pragma unroll
            for (int jj = 0; jj < 4; ++jj) Sbuf[(16 * db + 4 * q4 + jj) * 64 + 16 * et + r16] = Sacc[ci][jj]; }
    }
#undef LB
#undef LF
}

template <bool FINAL>
__device__ __forceinline__ void ssd_chunk_unit(Frame& F, int layer, int u) {
    const int tid = otid(), w = __builtin_amdgcn_readfirstlane(tid >> 6);
#define IDS() const int ft = fresh_tid(tid); const int lane = ft & 63, r16 = lane & 15, q4 = lane >> 4; (void)lane; (void)r16; (void)q4
    const int b = u >> 9, sc = (u >> 3) & 63, h = u & 7, g = h >> 2;
    constexpr int D_CB = 0, D_BB = 17408, D_BT = 34816, D_YF = 53248, D_XT = 70656, D_XDT = 79872, D_GM = 89088, D_SB = 98304, D_MISC = 115712;
    constexpr int D_DTS = D_MISC, D_ACS = D_MISC + 256, D_CAR = D_MISC + 512;
    LAS unsigned char* L = F.lds;
#define LB(off) ((LAS bf16*)(L + (off)))
#define LF(off) ((LAS float*)(L + (off)))
    bf16* P = (bf16*)(F.ws + WS_BIG); const float* dtb = (const float*)(F.ws + WS_DT);
    const bf16* BND = (const bf16*)(F.ws + WS_BND);
    float* Sbuf = (float*)(F.st + 32 * MiB) + (size_t)u * 8192;
    const float* cw = INP(17) + layer * 1024 * 4; const float* cbias = INP(18) + layer * 1024;
    const float dt_bias = INP(19)[layer * 8 + h], A = -expf(INP(20)[layer * 8 + h]), Dh = INP(21)[layer * 8 + h];
    const int bc_chunk = tid & 31, bc_chn = (bc_chunk < 16) ? (512 + g * 128 + bc_chunk * 8) : (768 + g * 128 + (bc_chunk - 16) * 8);
    const int x_chunk = tid & 7, x_chn = h * 64 + x_chunk * 8;
    const int pb = w & 3;
    f32x4 Sacc[4];
    { IDS();
#pragma unroll
    for (int ci = 0; ci < 4; ++ci) { const int nt = 4 * (w >> 2) + ci;
#pragma unroll
        for (int jj = 0; jj < 4; ++jj) { const float x = FINAL ? Sbuf[(16 * pb + 4 * q4 + jj) * 128 + 16 * nt + r16] : 0.f; Sacc[ci][jj] = x;
            if (FINAL) LB(D_SB)[(16 * pb + 4 * q4 + jj) * PT2 + 16 * nt + r16] = (bf16)f2bf(x); } } }
    float dstot = 0.f;
    for (int j = 0; j < 4; ++j) {
        const int tl0 = sc * 256 + j * 64; const size_t m0 = (size_t)b * T + tl0;
        if (w == 0) {
            IDS(); const float dt = softplus_acc(dtb[(m0 + lane) * 8 + h] + dt_bias); float a = A * dt;
#pragma unroll
            for (int o = 1; o < 64; o <<= 1) { const float n = __shfl_up(a, o); if (lane >= o) a += n; }
            LF(D_DTS)[lane] = dt; LF(D_ACS)[lane] = a;
        }
        {
            IDS();
#pragma unroll
            for (int it = 0; it < 4; ++it) { const int t = it * 16 + (ft >> 5); const int ta = tl0 + t;
                float acc[8]; unpack8(*(const u32x4*)(P + (m0 + t) * PLD + C_XBC + bc_chn), acc); (void)ta;
                if (bc_chunk < 16) { *(LAS u32x4*)(LB(D_BB) + t * PT2 + bc_chunk * 8) = pack8(acc); tr_write8(LB(D_BT), PT, bc_chunk * 8, t, acc, bc_chunk & 7); }
                else *(LAS u32x4*)(LB(D_CB) + t * PT2 + (bc_chunk - 16) * 8) = pack8(acc);
            }
        }
        __syncthreads();
        {
            IDS(); const int t = ft >> 3; float acc[8]; unpack8(*(const u32x4*)(P + (m0 + t) * PLD + C_XBC + x_chn), acc);
            const float sc_d = LF(D_DTS)[t] * __expf(LF(D_ACS)[63] - LF(D_ACS)[t]);
            float xs8[8], xd8[8];
#pragma unroll
            for (int e = 0; e < 8; ++e) { xs8[e] = acc[e]; xd8[e] = acc[e] * sc_d; }
            tr_write8(LB(D_XT), PT, x_chunk * 8, t, xs8, x_chunk); tr_write8(LB(D_XDT), PT, x_chunk * 8, t, xd8, x_chunk);
        }
        if (FINAL) { IDS(); const int rb = w & 3;
#pragma unroll
            for (int ci = 0; ci < 2; ++ci) { const int ct = 2 * (w >> 2) + ci; f32x4 a = FZ4;
                if (ct <= rb) a = mm_ll<128>(LB(D_CB), PT2, 16 * rb, LB(D_BB), PT2, 16 * ct, FZ4, lane);
#pragma unroll
                for (int jj = 0; jj < 4; ++jj) { const int l = 16 * rb + 4 * q4 + jj, s = 16 * ct + r16;
                    LB(D_GM)[l * PT + s] = (bf16)f2bf((s <= l) ? a[jj] * __expf(LF(D_ACS)[l] - LF(D_ACS)[s]) * LF(D_DTS)[s] : 0.f); } } }
        __syncthreads();
        {
            IDS(); f32x4 yy[2];
            if (FINAL) { const int rb = w & 3;
#pragma unroll
                for (int ci = 0; ci < 2; ++ci) { const int pt = 2 * (w >> 2) + ci;
                    const f32x4 a1 = mm_ll<64, false, true>(LB(D_GM), PT, 16 * rb, LB(D_XT), PT, 16 * pt, FZ4, lane), a2 = mm_ll<128>(LB(D_CB), PT2, 16 * rb, LB(D_SB), PT2, 16 * pt, FZ4, lane);
#pragma unroll
                    for (int jj = 0; jj < 4; ++jj) { const int l = 16 * rb + 4 * q4 + jj, p = 16 * pt + r16; yy[ci][jj] = a1[jj] + __expf(LF(D_ACS)[l]) * a2[jj] + Dh * tr_at(LB(D_XT), PT, p, l); } } }
            const float dec = expf(LF(D_ACS)[63]);
#pragma unroll
            for (int ci = 0; ci < 4; ++ci) { const int nt = 4 * (w >> 2) + ci; Sacc[ci] = mm_ll<64, true, true>(LB(D_XDT), PT, 16 * pb, LB(D_BT), PT, 16 * nt, Sacc[ci] * dec, lane); }
            dstot += LF(D_ACS)[63];
            __syncthreads();
            if (FINAL) { const int rb = w & 3;
#pragma unroll
                for (int ci = 0; ci < 4; ++ci) { const int nt = 4 * (w >> 2) + ci;
#pragma unroll
                    for (int jj = 0; jj < 4; ++jj) LB(D_SB)[(16 * pb + 4 * q4 + jj) * PT2 + 16 * nt + r16] = (bf16)f2bf(Sacc[ci][jj]); }
#pragma unroll
                for (int ci = 0; ci < 2; ++ci) { const int pt = 2 * (w >> 2) + ci;
#pragma unroll
                    for (int jj = 0; jj < 4; ++jj) LF(D_YF)[(16 * rb + 4 * q4 + jj) * PF + 16 * pt + r16] = yy[ci][jj]; } }
        }
        __syncthreads();
        if (FINAL) { IDS(); const int tok = ft >> 3, part = ft & 7; float y[8];
            ld8f(LF(D_YF) + tok * PF + 8 * part, y);
            *(u32x4*)(P + (m0 + tok) * PLD + C_XBC + h * 64 + 8 * part) = pack8(y);
            __syncthreads(); }
    }
    if (!FINAL) { IDS();
#pragma unroll
        for (int ci = 0; ci < 4; ++ci) { const int nt = 4 * (w >> 2) + ci;
#pragma unroll
            for (int jj = 0; jj < 4; ++jj) Sbuf[(16 * pb + 4 * q4 + jj) * 128 + 16 * nt + r16] = Sacc[ci][jj]; }
        if (tid == 0) ((float*)(F.ws + WS_DSTOT))[u] = dstot;
    }
#undef IDS
#undef LB
#undef LF
}

__device__ __forceinline__ void rwkv_scan_chain(Frame& F, int chain) {
    const int tid = otid(), lane = tid & 63, w = __builtin_amdgcn_readfirstlane(tid >> 6), r16 = lane & 15, q4 = lane >> 4;
    const int b = chain >> 3, h = chain & 7, vb = w & 3, ct0 = 2 * (w >> 2);
    LAS bf16* SB = (LAS bf16*)F.lds;
    f32x4 Sacc[2] = {FZ4, FZ4};
    for (int i = tid; i < 64 * PT / 2; i += 512) ((LAS unsigned*)SB)[i] = 0u;
    f32x4 nv[2]; bf16x8 mf[2][2];
    auto fetch = [&](int sc) {
        const int u = (b * 64 + sc) * 8 + h;
        const float* Nb = (const float*)(F.st + 0) + (size_t)u * 4096; const bf16* MT = (const bf16*)(F.ws + WS_MT) + (size_t)u * 4096;
#pragma unroll
        for (int ci = 0; ci < 2; ++ci) {
#pragma unroll
            for (int jj = 0; jj < 4; ++jj) nv[ci][jj] = Nb[(16 * vb + 4 * q4 + jj) * 64 + 16 * (ct0 + ci) + r16];
#pragma unroll
            for (int k2 = 0; k2 < 2; ++k2) mf[ci][k2] = *(const bf16x8*)(MT + (size_t)(16 * (ct0 + ci) + r16) * 64 + 32 * k2 + 8 * q4); } };
    fetch(0);
    __syncthreads();
    for (int sc = 0; sc < 64; ++sc) {
        const int u = (b * 64 + sc) * 8 + h;
        float* Nb = (float*)(F.st + 0) + (size_t)u * 4096;
        f32x4 nw[2];
#pragma unroll
        for (int ci = 0; ci < 2; ++ci) {
            f32x4 a = nv[ci];
#pragma unroll
            for (int k2 = 0; k2 < 2; ++k2) a = mfma16(*(const LAS bf16x8*)(SB + (16 * vb + r16) * PT + 32 * k2 + 8 * q4), mf[ci][k2], a);
            nw[ci] = a;
#pragma unroll
            for (int jj = 0; jj < 4; ++jj) Nb[(16 * vb + 4 * q4 + jj) * 64 + 16 * (ct0 + ci) + r16] = Sacc[ci][jj]; }
        if (sc + 1 < 64) fetch(sc + 1);
        __syncthreads();
#pragma unroll
        for (int ci = 0; ci < 2; ++ci) { Sacc[ci] = nw[ci];
#pragma unroll
            for (int jj = 0; jj < 4; ++jj) SB[(16 * vb + 4 * q4 + jj) * PT + 16 * (ct0 + ci) + r16] = (bf16)f2bf(nw[ci][jj]); }
        __syncthreads();
    }
}
__device__ __forceinline__ void elem_scans(Frame& F, int blk, int nblk) {
    const int tid = otid();
    const int NRET = 16 * 4096, NSSD = 16 * 8192;
    const float* dst = (const float*)(F.ws + WS_DSTOT);
    for (int it = blk * 512 + tid; it < NRET + NSSD; it += nblk * 512) {
        if (it < NRET) { const int chain = it >> 12, e = it & 4095, b = chain >> 3, h = chain & 7;
            const float g256 = exp2f(256.f * log2f(1.f - exp2f(-5.f - (float)h)));
            float* p = (float*)(F.st + 16 * MiB) + ((size_t)(b * 64) * 8 + h) * 4096 + e; float carry = 0.f;
#pragma unroll 8
            for (int sc = 0; sc < 64; ++sc) { const float t = p[(size_t)sc * 8 * 4096]; p[(size_t)sc * 8 * 4096] = carry; carry = g256 * carry + t; }
        } else { const int i2 = it - NRET, chain = i2 >> 13, e = i2 & 8191, b = chain >> 3, h = chain & 7;
            float* p = (float*)(F.st + 32 * MiB) + ((size_t)(b * 64) * 8 + h) * 8192 + e; const float* d = dst + (b * 64) * 8 + h; float carry = 0.f;
#pragma unroll 8
            for (int sc = 0; sc < 64; ++sc) { const float t = p[(size_t)sc * 8 * 8192]; p[(size_t)sc * 8 * 8192] = carry; carry = expf(d[sc * 8]) * carry + t; }
        }
    }
}
__device__ __forceinline__ void conv_lora(Frame& F) {
    const int tid = otid();
    for (int l = 0; l < 2; ++l) {
        bf16* base = (bf16*)(F.ws + WS_LORA + (size_t)l * LORA_STRIDE);
        const float* wu = INP(4) + l * 64 * 512; const float* au = INP(6) + l * 64 * 512; const float* gu = INP(8) + l * 128 * 512;
        for (int i = F.vcu * 512 + tid; i < 512 * 64; i += F.G * 512) { const int c = i >> 6, jx = i & 63; base[i] = (bf16)f2bf(wu[jx * 512 + c]); base[32768 + i] = (bf16)f2bf(au[jx * 512 + c]); }
        for (int i = F.vcu * 512 + tid; i < 512 * 128; i += F.G * 512) { const int c = i >> 7, jx = i & 127; base[65536 + i] = (bf16)f2bf(gu[jx * 512 + c]); }
    }
}
__device__ __forceinline__ void conv_vlora(Frame& F) {
    const int tid = otid();
    bf16* vdT = (bf16*)(F.ws + WS_VLORA); bf16* vuT = vdT + 32 * 512;
    const float* vdn = INP(14); const float* vup = INP(15);
    for (int i = F.vcu * 512 + tid; i < 32 * 512; i += F.G * 512) { const int j = i >> 9, c = i & 511; vdT[i] = (bf16)f2bf(vdn[c * 32 + j]); }
    for (int i = F.vcu * 512 + tid; i < 512 * 32; i += F.G * 512) { const int c = i >> 5, j = i & 31; vuT[i] = (bf16)f2bf(vup[j * 512 + c]); }
}
__device__ __forceinline__ void save_bnd(Frame& F) {
    const int tid = otid();
    const bf16* P = (const bf16*)(F.ws + WS_BIG); bf16* BND = (bf16*)(F.ws + WS_BND);
    for (int i = F.vcu * 512 + tid; i < 2 * 64 * 3 * 64; i += F.G * 512) { const int ch = i & 63, k = (i >> 6) % 3, bs = i / 192, b = bs >> 6, sc = bs & 63;
        if (sc > 0) *(u32x4*)(BND + (size_t)(bs * 3 + k) * 512 + ch * 8) = *(const u32x4*)(P + ((size_t)b * T + sc * 256 - 3 + k) * PLD + C_XBC + ch * 8); }
}

constexpr int LAYER_BASE0 = 1, LAYER_STRIDE = 18, MOE_BASE = LAYER_BASE0 + LAYER_STRIDE + 15;
__device__ __forceinline__ Frame lf(const Frame& F0) {
    Frame F = F0; unsigned l = (unsigned)(unsigned long long)F.lds;
    asm volatile("" : "+s"(l), "+s"(F.vcu), "+s"(F.G), "+s"(F.cid), "+s"(F.wid), "+s"(F.out), "+s"(F.ws), "+s"(F.st));
    F.lds = (LAS unsigned char*)(unsigned long long)l; return F;
}
__global__ void __launch_bounds__(512, 2) fwd(Args args) {
    extern __shared__ __attribute__((aligned(16))) unsigned char lds_raw[];
    Frame F0;
    F0.lds = (LAS unsigned char*)lds_raw;
    F0.G = gridDim.x; { const int bx = blockIdx.x; F0.vcu = (F0.G % 8 == 0) ? (bx % 8) * (F0.G / 8) + bx / 8 : bx; }
    F0.cid = blockIdx.x; F0.out = args.out; F0.ws = args.ws; F0.wid = __builtin_amdgcn_readfirstlane(threadIdx.x >> 6); F0.st = args.ws + WS_XB;
    volatile LAS unsigned* MISC = (volatile LAS unsigned*)(F0.lds + MISC_OFF);
    for (int u = threadIdx.x; u < (LDS_BYTES - LDSCTL_OFF) / 4; u += 512) ((LAS unsigned*)(F0.lds + LDSCTL_OFF))[u] = 0u;
    __syncthreads();
    if (threadIdx.x < 34) *(LAS unsigned long long*)(F0.lds + LDSCTL_OFF + 8 * threadIdx.x) = (unsigned long long)args.in[threadIdx.x];
    __syncthreads();
    const int lo = args.ph_lo, hi = args.ph_hi;
    XcdBarrier bar; bar.bar = (unsigned*)(F0.ws + WS_CTL); bar.x = 0; bar.st = nullptr;
    if (hi - lo > 1) bar = xcd_barrier_post((unsigned*)(F0.ws + WS_CTL), MISC + 8);
#define IN(k) (lo <= (k) && (k) < hi)
#define SEAM(k) do { if (IN(k) && IN((k) + 1)) xcd_barrier(bar); } while (0)
#define WSP(T_, off) ((T_*)(F.ws + (off)))

    if (IN(0)) { for (int rep = 0; rep <= REP_CONV; ++rep) { Frame F = lf(F0); conv_layer_weights(F, 0); conv_layer_weights(F, 1); conv_ffn_weights(F); conv_lora(F); conv_vlora(F); }
        for (int rep = 0; rep <= REP_MISC; ++rep) { Frame F = lf(F0); xprep_phase(F, INP(0)); } }
    SEAM(0);
    for (int l = 0; l < 2; ++l) {
        const int pb = LAYER_BASE0 + l * LAYER_STRIDE;
        F0.st = (l == 0) ? (unsigned char*)F0.out : F0.ws + WS_XB;
        if (IN(pb + 0)) {
            Frame F = lf(F0); unsigned char* wl = F.ws + WS_W + (size_t)l * WL_STRIDE;
            pg8::Gemm g{WSP(bf16, WS_XB), (const bf16*)(wl + WL_IN), D, D, D}; pg8::StaticOrder S; S.init(M, NP, F.G, F.cid, D, D);
            pg8::EpiInProj E{WSP(bf16, WS_BIG), WSP(float, WS_RSTD), WSP(float, WS_DT)};
            pg8::gemm_phase(F.lds, F.wid, g, S, E);
        }
        SEAM(pb + 0);
        if (IN(pb + 1)) { Frame F = lf(F0); vprep_phase(F, l); prepass_a(F); }
        SEAM(pb + 1);
        if (IN(pb + 2)) { Frame F = lf(F0); prepass_conv(F, l); }
        if (IN(pb + 2) && IN(pb + 3)) xcd_barrier(bar);
        if (IN(pb + 3)) for (int rep = 0; rep <= REP_R1; ++rep) {
#if RW_CH
            for (int r2 = 0; r2 <= REP_RW; ++r2) { Frame F = lf(F0); for (int u = F.cid; u < 1024; u += F.G) rwkv_chunk_unit<false>(F, l, u); }
#else
            { Frame F = lf(F0); if (F.cid < 16) rwkv_seq(F, l, F.cid); }
#endif
#if RET_CH
            for (int r2 = 0; r2 <= REP_RET; ++r2) { Frame F = lf(F0); for (int u = F.cid; u < 1024; u += F.G) ret_chunk_unit<false>(F, u); }
#else
            { Frame F = lf(F0); if (F.cid >= 32 && F.cid < 48) ret_seq(F, F.cid - 32); }
#endif
#if SSD_CH
            for (int r2 = 0; r2 <= REP_SSD; ++r2) { Frame F = lf(F0); for (int u = F.cid; u < 1024; u += F.G) ssd_chunk_unit<false>(F, l, u); }
#else
            { Frame F = lf(F0); if (F.cid >= 16 && F.cid < 32) ssd_seq(F, l, F.cid - 16); }
#endif
        }
        SEAM(pb + 3);
        if (IN(pb + 4)) {
            Frame F = lf(F0);
            if (F.cid < 16) { if (RW_CH) rwkv_scan_chain(F, F.cid); }
            else elem_scans(F, F.cid - 16, F.G - 16);
        }
        SEAM(pb + 4);
        if (IN(pb + 5)) {
#if RW_CH
            { Frame F = lf(F0); for (int u = F.cid; u < 1024; u += F.G) rwkv_chunk_unit<true>(F, l, u); }
#endif
#if RET_CH
            { Frame F = lf(F0); for (int u = F.cid; u < 1024; u += F.G) ret_chunk_unit<true>(F, u); }
#endif
#if SSD_CH
            { Frame F = lf(F0); for (int u = F.cid; u < 1024; u += F.G) ssd_chunk_unit<true>(F, l, u); }
#endif
        }
        SEAM(pb + 5);
        if (IN(pb + 6)) { Frame F = lf(F0); ssm_norm_phase(F, l); if (l == 1) xprep_phase(F, F.out); }
        SEAM(pb + 6);
        if (IN(pb + 7)) {
            Frame F = lf(F0); unsigned char* wl = F.ws + WS_W + (size_t)l * WL_STRIDE; bf16* P = WSP(bf16, WS_BIG);
            pg8::Gemm g{P, (const bf16*)(wl + WL_BR), PLD, 512, 512}; pg8::BranchOrder S; S.init(F.G, F.cid);
            pg8::EpiPlain E{P, WSP(bf16, WS_VMIX)};
            pg8::gemm_phase(F.lds, F.wid, g, S, E);
        }
        SEAM(pb + 7);
        if (IN(pb + 8)) {
            Frame F = lf(F0); unsigned char* wl = F.ws + WS_W + (size_t)l * WL_STRIDE; bf16* P = WSP(bf16, WS_BIG);
            pg8::Gemm g{WSP(bf16, WS_XB), (const bf16*)(wl + WL_GATE), D, D, D}; pg8::GateOrder S; S.init(F.G, F.cid);
            pg8::EpiGateMerge E{P, WSP(const bf16, WS_VMIX), P + C_RET, PLD, WSP(float, WS_RSTD)};
            pg8::gemm_phase(F.lds, F.wid, g, S, E);
        }
        if (IN(pb + 8) && IN(pb + 13)) xcd_barrier(bar);
        if (IN(pb + 13)) {
            Frame F = lf(F0); unsigned char* wl = F.ws + WS_W + (size_t)l * WL_STRIDE; bf16* P = WSP(bf16, WS_BIG);
            pg8::Gemm g{P + C_RET, (const bf16*)(wl + WL_OUT), PLD, D, D}; pg8::StaticOrder S; S.init(M, D, F.G, F.cid, PLD, D);
            pg8::EpiResid E{(l == 0) ? INP(0) : F.out, F.out, nullptr, 0};
            pg8::gemm_phase(F.lds, F.wid, g, S, E);
        }
        SEAM(pb + 13);
        if (IN(pb + 14)) { Frame F = lf(F0); if (l == 0) xprep_phase(F, F.out); else { router_phase(F); conv_moe_weights(F); } }
        SEAM(pb + 14);
        if (l == 0) {
            if (IN(pb + 15)) {
                Frame F = lf(F0);
                pg8::Gemm g{WSP(bf16, WS_XB), WSP(const bf16, WS_FFUP), D, D, D}; pg8::StaticOrder S; S.init(M, 2 * FF, F.G, F.cid, D, D);
                pg8::EpiSwiglu E{WSP(bf16, WS_ACT), FF, WSP(float, WS_RSTD)};
                pg8::gemm_phase(F.lds, F.wid, g, S, E);
            }
            SEAM(pb + 15);
            if (IN(pb + 16)) {
                Frame F = lf(F0);
                pg8::Gemm g{WSP(const bf16, WS_ACT), WSP(const bf16, WS_FFDN), FF, FF, FF}; pg8::StaticOrder S; S.init(M, D, F.G, F.cid, FF, FF);
                pg8::EpiResid E{F.out, F.out, nullptr, 0};
                pg8::gemm_phase(F.lds, F.wid, g, S, E);
            }
            SEAM(pb + 16);
            if (IN(pb + 17)) { Frame F = lf(F0); xprep_phase(F, F.out); }
            SEAM(pb + 17);
        }
    }
    {
        const int pb = MOE_BASE;
        for (int sg = 0; sg < 3; ++sg) {
            if (IN(pb + 0 + 2 * sg)) {
                Frame F = lf(F0);
                pg8::Gemm g{WSP(bf16, WS_XB), WSP(const bf16, WS_MOEW), D, D, D}; pg8::MoeOrder<true> S; S.init(WSP(const int, WS_CNT), WSP(const int, WS_LIST), sg, 2 * FFE, F.G, F.cid, D, D, MOEW_STRIDE);
                pg8::EpiSwiglu E{WSP(bf16, WS_ACT), FFE, WSP(float, WS_RSTD)};
                pg8::gemm_phase(F.lds, F.wid, g, S, E);
            }
            SEAM(pb + 0 + 2 * sg);
            if (IN(pb + 1 + 2 * sg)) {
                Frame F = lf(F0);
                const int ksp = (sg == 2) ? 4 : 1;
                pg8::Gemm g{WSP(const bf16, WS_ACT), WSP(const bf16, WS_MOEW + MOEW_DN), FFE, FFE, FFE / ksp}; pg8::MoeOrder<false> S; S.init(WSP(const int, WS_CNT), WSP(const int, WS_LIST), sg, D, F.G, F.cid, FFE, FFE, MOEW_STRIDE, ksp, FFE / ksp);
                pg8::EpiMoeDown E{F.out};
                pg8::gemm_phase(F.lds, F.wid, g, S, E);
            }
            SEAM(pb + 1 + 2 * sg);
        }
        if (IN(pb + 6)) { Frame F = lf(F0); final_norm_phase(F); }
    }
#undef IN
#undef SEAM
#undef WSP
}
constexpr int LAST_PHASE = MOE_BASE + 6;
constexpr int N_PH = LAST_PHASE + 1;

extern "C" void kernel_launch(void* const* d_in, const int* in_sizes, int n_in, void* d_out, int out_size, void* d_ws, size_t ws_size, hipStream_t stream) {
    static int grid = 0;
    if (grid == 0) {
        if (n_in != 34 || out_size != M * D || ws_size < WS_END) { fprintf(stderr, "kernel_launch: unexpected problem (n_in %d out %d ws %zu need %zu)\n", n_in, out_size, ws_size, (size_t)WS_END); grid = -1; return; }
        int dev = 0, cus = 0;
        if (hipGetDevice(&dev) != hipSuccess || hipDeviceGetAttribute(&cus, hipDeviceAttributeMultiprocessorCount, dev) != hipSuccess) { grid = -1; return; }
        if (hipFuncSetAttribute((const void*)fwd, hipFuncAttributeMaxDynamicSharedMemorySize, LDS_BYTES) != hipSuccess) { fprintf(stderr, "kernel_launch: hipFuncSetAttribute failed\n"); grid = -1; return; }
        int per_cu = 0;
        if (hipOccupancyMaxActiveBlocksPerMultiprocessor(&per_cu, (const void*)fwd, 512, LDS_BYTES) != hipSuccess || per_cu < 1) fprintf(stderr, "kernel_launch: occupancy query says %d\n", per_cu);
        (void)hipGetLastError();
        grid = cus;
    }
    if (grid < 0) return;
    (void)hipMemsetAsync((char*)d_ws + WS_CTL, 0, CTL_ZERO_BYTES, stream);
    Args a{};
    for (int i = 0; i < 34; ++i) a.in[i] = (const float*)d_in[i];
    a.out = (float*)d_out; a.ws = (unsigned char*)d_ws;
#if MK_ONE_LAUNCH
    a.ph_lo = 0; a.ph_hi = N_PH;
    hipLaunchKernelGGL(fwd, dim3(grid), dim3(512), LDS_BYTES, stream, a);
#else
    for (int p = 0; p < N_PH; ++p) { a.ph_lo = p; a.ph_hi = p + 1; hipLaunchKernelGGL(fwd, dim3(grid), dim3(512), LDS_BYTES, stream, a); }
#endif
}
```

```cpp
#include <hip/hip_runtime.h>
#include <cstdio>
#include <cstdint>

#ifndef MK_ONE_LAUNCH
#define MK_ONE_LAUNCH 1
#endif

#define LAS __attribute__((address_space(3)))
#define GAS __attribute__((address_space(1)))
typedef unsigned short bf16;
typedef short bf16x8 __attribute__((ext_vector_type(8)));
typedef float f32x4 __attribute__((ext_vector_type(4)));
typedef float f32x2 __attribute__((ext_vector_type(2)));
typedef unsigned u32x4 __attribute__((ext_vector_type(4)));
typedef unsigned u32x2 __attribute__((ext_vector_type(2)));

constexpr int BATCH = 2, T = 16384, D = 1024, M = BATCH * T;
constexpr int INC = 8456;
constexpr int PLD = 5376;
constexpr int NP = 5632;
constexpr int C_RW = 0, C_Z = 1792, C_XBC = 2304, C_RET = 3328, C_RETG = 4864;
constexpr int FF = 2816, FFE = 3584, NE = 8;

constexpr size_t MiB = 1u << 20;
constexpr size_t WS_CTL = 0, CTL_ZERO_BYTES = 64 * 1024;
constexpr size_t WS_RSTD = 1 * MiB, WS_GATES = 2 * MiB, WS_DT = 3 * MiB;
constexpr size_t WS_W = 4 * MiB;
constexpr size_t WL_IN = 0, WL_GATE = 11 * MiB, WL_BR = 17 * MiB, WL_OUT = 20 * MiB, WL_STRIDE = 22 * MiB;
constexpr size_t WS_FFUP = WS_W + 44 * MiB, WS_FFDN = WS_W + 55 * MiB;
constexpr size_t WS_XB = 68 * MiB;
constexpr size_t WS_VF = 132 * MiB;
constexpr size_t WS_BIG = 164 * MiB;
constexpr size_t WS_VMIX = WS_BIG + 336 * MiB, WS_YRW = WS_BIG + 368 * MiB, WS_END = 577 * MiB;
constexpr size_t WS_MOEW = WS_BIG;
constexpr size_t MOEW_STRIDE = 21 * MiB, MOEW_DN = 14 * MiB;
constexpr size_t WS_ACT = WS_BIG + 168 * MiB;

constexpr size_t WS_YP0 = 4 * MiB, WS_YP1 = WS_XB, WS_YP2 = 556 * MiB, YP2_STRIDE = 4 * MiB, WS_PINFO = 572 * MiB, WS_ACT2 = 132 * MiB;
constexpr size_t WS_CNT = 32768, WS_LIST = 2 * MiB;
constexpr size_t WS_BND2 = 566 * MiB;
constexpr size_t WS_VLORA = 192 * 1024;
constexpr size_t WS_SS1 = 573 * MiB, WS_SS2 = 575 * MiB;
constexpr size_t WS_DSTOT = 128 * 1024, WS_BND = 256 * 1024;
constexpr size_t WS_LORA = 1 * MiB + 512 * 1024, LORA_STRIDE = 262144;
constexpr size_t WS_ST_RW = WS_XB, WS_ST_RET = WS_XB + 16 * MiB, WS_ST_SSD = WS_XB + 32 * MiB, WS_MT = WS_YRW;
constexpr int RING_BYTES = 131072, LDSCTL_OFF = 159744, MISC_OFF = LDSCTL_OFF + 320, LDS_BYTES = 163840;
#ifndef REP_CONV
#define REP_CONV 0
#endif
#ifndef REP_R1
#define REP_R1 0
#endif
#ifndef REP_RW
#define REP_RW 0
#endif
#ifndef REP_RET
#define REP_RET 0
#endif
#ifndef REP_SSD
#define REP_SSD 0
#endif
#ifndef REP_MISC
#define REP_MISC 0
#endif
#ifndef RW_CH
#define RW_CH 1
#endif
#ifndef RET_CH
#define RET_CH 1
#endif
#ifndef SSD_CH
#define SSD_CH 1
#endif

typedef __bf16 hbf16x2 __attribute__((ext_vector_type(2)));
__device__ __forceinline__ unsigned pk2(float lo, float hi) { const f32x2 v = {lo, hi}; return __builtin_bit_cast(unsigned, __builtin_convertvector(v, hbf16x2)); }
__device__ __forceinline__ unsigned f2bf(float f) { return (unsigned)__builtin_bit_cast(unsigned short, (__bf16)f); }
__device__ __forceinline__ float bflo(unsigned u) { return __builtin_bit_cast(float, u << 16); }
__device__ __forceinline__ float bfhi(unsigned u) { return __builtin_bit_cast(float, u & 0xffff0000u); }
__device__ __forceinline__ void unpack8(const u32x4 u, float (&f)[8]) { f[0] = bflo(u.x); f[1] = bfhi(u.x); f[2] = bflo(u.y); f[3] = bfhi(u.y); f[4] = bflo(u.z); f[5] = bfhi(u.z); f[6] = bflo(u.w); f[7] = bfhi(u.w); }
__device__ __forceinline__ u32x4 pack8(const float (&f)[8]) { u32x4 w; w.x = pk2(f[0], f[1]); w.y = pk2(f[2], f[3]); w.z = pk2(f[4], f[5]); w.w = pk2(f[6], f[7]); return w; }
__device__ __forceinline__ float sigm(float x) { return __builtin_amdgcn_rcpf(1.f + __expf(-x)); }
__device__ __forceinline__ float silu(float x) { return x * __builtin_amdgcn_rcpf(1.f + __expf(-x)); }
__device__ __forceinline__ float ex2(float x) { return __builtin_amdgcn_exp2f(x); }
__device__ __forceinline__ float fast_tanh(float x) { return 1.f - 2.f * __builtin_amdgcn_rcpf(1.f + __expf(2.f * x)); }
__device__ __forceinline__ float softplus_acc(float x) { return fmaxf(x, 0.f) + log1pf(expf(-fabsf(x))); }
__device__ __forceinline__ float wave_sum(float v) {
#pragma unroll
    for (int o = 1; o < 64; o <<= 1) v += __shfl_xor(v, o);
    return v;
}
__device__ __forceinline__ int otid_w(int wid) { unsigned z = 0u; asm volatile("" : "+v"(z)); int t = wid * 64 + (int)__builtin_amdgcn_mbcnt_hi(~0u, __builtin_amdgcn_mbcnt_lo(~0u, z)); asm volatile("" : "+v"(t)); return t; }
#define otid() otid_w(F.wid)
__device__ __forceinline__ int fresh_tid(int t) { asm volatile("" : "+v"(t)); return t; }
#define LDS_WAIT() asm volatile("s_waitcnt lgkmcnt(0)" ::: "memory")

namespace pg8 {
constexpr int BM = 256, BK = 64, HALF = 128, HTB = HALF * BK * 2, STAGE_BYTES = 8 * HTB, NXCD = 8, WGM = 8;
__host__ __device__ __forceinline__ int lds_byte(int r, int c) { const int st = (r >> 4) * 2 + (c >> 5), rr = r & 15, cc = c & 31, ob = rr * 64 + cc * 2; return st * 1024 + (ob ^ (((ob >> 9) & 1) << 5)); }
__host__ __device__ __forceinline__ void stage_rc(int b, int& R, int& C) { const int st = b / 1024, sb = b % 1024, swz = sb ^ (((sb >> 9) & 1) << 5); R = (st >> 1) * 16 + swz / 64; C = (st & 1) * 32 + (swz % 64) / 2; }
__host__ __device__ __forceinline__ int perm32(int rho) { const int n = rho >> 4, i = rho & 15; return 8 * (i >> 2) + 4 * n + (i & 3); }

struct Unit { int pm, pn; size_t aofs, bofs; const int* rows; int nvalid, e, ks; };
struct Gemm { const bf16* A; const bf16* Bt; int lda, ldb, K; };

struct StaticOrder {
    static constexpr bool GATHER = false;
    int nM, nN, nwg, G, c; size_t tsA, tsB;
    __device__ __forceinline__ void init(int Mrows, int N, int G_, int c_, int lda, int ldb) { nM = Mrows / BM; nN = N / BM; nwg = nM * nN; G = G_; c = c_; tsA = (size_t)BM * lda * 2; tsB = (size_t)BM * ldb * 2; }
    __device__ __forceinline__ void tile(int L, int& pm, int& pn) const {
        int wgid = L; { const int q = nwg / NXCD, r = nwg % NXCD, xcd = wgid % NXCD, off = wgid / NXCD; wgid = (xcd < r ? xcd * (q + 1) : r * (q + 1) + (xcd - r) * q) + off; }
        const int nig = WGM * nN, gid = wgid / nig, fm = gid * WGM, gsz = (nM - fm) < WGM ? (nM - fm) : WGM;
        pm = fm + ((wgid % nig) % gsz); pn = (wgid % nig) / gsz;
    }
    __device__ __forceinline__ bool next(int i, Unit& u) const {
        const long L = (long)i * G + c; if (L >= nwg) return false;
        tile((int)L, u.pm, u.pn); u.aofs = (size_t)u.pm * tsA; u.bofs = (size_t)u.pn * tsB; u.rows = nullptr; u.nvalid = BM; u.e = 0; u.ks = 0; return true;
    }
};
struct BranchOrder {
    static constexpr bool GATHER = false;
    StaticOrder so;
    __device__ __forceinline__ void init(int G_, int c_) { so.init(M, D, G_, c_, PLD, 512); }
    __device__ __forceinline__ bool next(int j, Unit& u) const {
        const long L = (long)j * so.G + so.c; if (L >= 3 * so.nwg) return false;
        const int i = (int)(L / so.nwg); so.tile((int)(L % so.nwg), u.pm, u.pn);
        const int acol = (i == 0) ? 1024 : (i == 1 ? C_Z : C_RETG);
        u.aofs = (size_t)u.pm * so.tsA + (size_t)acol * 2; u.bofs = ((size_t)i * D + (size_t)u.pn * BM) * 512 * 2; u.rows = nullptr; u.nvalid = BM; u.e = i; u.ks = 0; return true;
    }
};
struct GateOrder {
    static constexpr bool GATHER = false;
    StaticOrder so;
    __device__ __forceinline__ void init(int G_, int c_) { so.init(M, D, G_, c_, D, D); }
    __device__ __forceinline__ bool next(int j, Unit& u) const {
        const long tt = (long)(j / 3) * so.G + so.c; if (tt >= so.nwg) return false;
        const int i = j % 3; so.tile((int)tt, u.pm, u.pn);
        u.aofs = (size_t)u.pm * so.tsA; u.bofs = ((size_t)i * D + (size_t)u.pn * BM) * D * 2; u.rows = nullptr; u.nvalid = BM; u.e = i; u.ks = 0; return true;
    }
};
template <bool GATH> struct MoeOrder {
    static constexpr bool GATHER = GATH;
    unsigned q0, q1, q2, q3;
    int seg, nN, G, c, ksplit; const int* list; size_t bstride, tsB, tsA, kbytes;
    __device__ __forceinline__ void init(const int* counts, const int* list_, int seg_, int N, int G_, int c_, int lda, int ldb, size_t bstride_, int ksplit_ = 1, int kpart = 0) {
        unsigned n[8];
#pragma unroll
        for (int e = 0; e < 8; ++e) { int v = __builtin_amdgcn_readfirstlane(counts[e]); v = v < 0 ? 0 : (v > 32768 ? 32768 : v); n[e] = (unsigned)v; }
        q0 = n[0] | (n[1] << 16); q1 = n[2] | (n[3] << 16); q2 = n[4] | (n[5] << 16); q3 = n[6] | (n[7] << 16);
        seg = seg_; nN = N / BM; G = G_; c = c_; list = list_; bstride = bstride_; tsB = (size_t)BM * ldb * 2; tsA = (size_t)BM * lda * 2; ksplit = ksplit_; kbytes = (size_t)kpart * 2;
    }
    __device__ __forceinline__ bool next(int i, Unit& u) const {
        const long L0 = (long)i * G + c; const long L = L0 / ksplit; const int ks = (int)(L0 % ksplit); const int tl = (int)(L / nN), pn = (int)(L % nN), gt = seg * 128 + tl;
        int t = 0, e = 0, tbe = 0, cne = 0;
#pragma unroll
        for (int k = 0; k < 8; ++k) { const unsigned q = (k < 2) ? q0 : (k < 4) ? q1 : (k < 6) ? q2 : q3; const int n = (int)((k & 1) ? (q >> 16) : (q & 0xffffu));
            if (gt >= t) { e = k; tbe = t; cne = n; } t += (n + 255) >> 8; }
        int nt = t - seg * 128; nt = nt < 0 ? 0 : (nt > 128 ? 128 : nt);
        if (L >= (long)nt * nN) return false;
        const int rt = gt - tbe;
        u.pm = tl; u.pn = pn; u.e = e; u.ks = ks; u.bofs = (size_t)e * bstride + (size_t)pn * tsB + ks * kbytes; u.aofs = (GATH ? 0 : (size_t)tl * tsA) + ks * kbytes;
        u.rows = list + ((size_t)e * 32768 + rt * 256) * 2; int nv = cne - rt * 256; u.nvalid = nv > 256 ? 256 : nv; return true;
    }
};

template <class Epi, class Sched>
__device__ __forceinline__ void gemm_phase(LAS unsigned char* lds, int wid0, const Gemm g, const Sched& S, const Epi& E) {
    constexpr bool GATHER = Sched::GATHER;
    const int tid = otid_w(wid0), wid = __builtin_amdgcn_readfirstlane(tid >> 6), lane = tid & 63, wr = wid >> 2, wc = wid & 3, fr = lane & 15, fq = lane >> 4;
    const int nt = g.K / BK;
    unsigned voffA[2], voffB[2];
#pragma unroll
    for (int i = 0; i < 2; ++i) { int R, C; stage_rc(tid * 16 + i * 8192, R, C); const int Rb = Epi::PERM ? ((R & ~31) + perm32(R & 31)) : R;
        voffA[i] = (unsigned)(R * g.lda + C) * 2u; voffB[i] = (unsigned)(Rb * g.ldb + C) * 2u; }
    const size_t kstep = (size_t)(BK * 2);
    const size_t hstepA = GATHER ? 0 : (size_t)HALF * g.lda * 2, hstepB = (size_t)HALF * g.ldb * 2;
    const unsigned ldsw = (unsigned)wid * 1024u;
    const int aoff = lds_byte(wr * 64 + fr, fq * 8), boff = lds_byte(wc * 32 + fr, fq * 8);
#define PG8_SA(b, h) (((b) * 2 + (h)) * HTB)
#define PG8_SB(b, h) ((4 + (b) * 2 + (h)) * HTB)
#define PG8_STAGE2(bufoff, gbase, o0, o1) do { \
        __builtin_amdgcn_global_load_lds((const unsigned*)((const char*)(gbase) + (o0)), (LAS unsigned*)(lds + (bufoff) + ldsw), 16, 0, 0); \
        __builtin_amdgcn_global_load_lds((const unsigned*)((const char*)(gbase) + (o1)), (LAS unsigned*)(lds + (bufoff) + ldsw + 8192), 16, 0, 0); } while (0)
#define PG8_STAGE(bufoff, gbase, voff) PG8_STAGE2(bufoff, gbase, (voff)[0], (voff)[1])
#define PG8_LDA(dst, b, h) do { _Pragma("unroll") for (int m = 0; m < 4; ++m) _Pragma("unroll") for (int k = 0; k < 2; ++k) dst[m][k] = *(const LAS bf16x8*)(lds + PG8_SA(b, h) + aoff + m * 2048 + k * 1024); } while (0)
#define PG8_LDB(dst, b, h) do { _Pragma("unroll") for (int n = 0; n < 2; ++n) _Pragma("unroll") for (int k = 0; k < 2; ++k) dst[n][k] = *(const LAS bf16x8*)(lds + PG8_SB(b, h) + boff + n * 2048 + k * 1024); } while (0)
#define PG8_MMA(ai, bj, At, Bt) do { __builtin_amdgcn_s_setprio(1); _Pragma("unroll") for (int m = 0; m < 4; ++m) _Pragma("unroll") for (int n = 0; n < 2; ++n) _Pragma("unroll") for (int k = 0; k < 2; ++k) \
        acc[ai][bj][m][n] = Epi::TRANS ? __builtin_amdgcn_mfma_f32_16x16x32_bf16(Bt[n][k], At[m][k], acc[ai][bj][m][n], 0, 0, 0) : __builtin_amdgcn_mfma_f32_16x16x32_bf16(At[m][k], Bt[n][k], acc[ai][bj][m][n], 0, 0, 0); __builtin_amdgcn_s_setprio(0); } while (0)
#define PG8_WAIT_V(n) asm volatile("s_waitcnt vmcnt(" #n ")" ::: "memory")
#define PG8_WAIT_L(n) asm volatile("s_waitcnt lgkmcnt(" #n ")" ::: "memory")
#define PG8_BAR __builtin_amdgcn_s_barrier()
#define PG8_SCHED __builtin_amdgcn_sched_barrier(0)
#define GSLOT(which) ((LAS u32x4*)(lds + 131072 + (which) * 8192 + tid * 16))
#define PG8_ROWS(u, which) do { const int _ft = fresh_tid(tid); unsigned _vg[2][2]; _Pragma("unroll") for (int _i = 0; _i < 2; ++_i) { int _R, _C; stage_rc(_ft * 16 + _i * 8192, _R, _C); \
        _Pragma("unroll") for (int _h = 0; _h < 2; ++_h) { const int _r = _h * HALF + _R; \
        const int _t = (_r < (u).nvalid) ? (u).rows[2 * _r] : 0; _vg[_h][_i] = ((unsigned)_t * (unsigned)g.lda + (unsigned)_C) * 2u; } } \
        u32x4 _o; _o.x = _vg[0][0]; _o.y = _vg[0][1]; _o.z = _vg[1][0]; _o.w = _vg[1][1]; *GSLOT(which) = _o; } while (0)
    Unit cur, nxt; int ui = 0;
    if (!S.next(0, cur)) return;
    f32x4 acc[2][2][4][2];
#pragma unroll
    for (int a = 0; a < 2; ++a)
#pragma unroll
        for (int b = 0; b < 2; ++b)
#pragma unroll
            for (int m = 0; m < 4; ++m)
#pragma unroll
                for (int n = 0; n < 2; ++n) acc[a][b][m][n] = (f32x4){0.f, 0.f, 0.f, 0.f};
    bf16x8 At[4][2], B0[2][2], B1[2][2];
    u32x4 gc = {voffA[0], voffA[1], voffA[0], voffA[1]};
    if constexpr (GATHER) { PG8_ROWS(cur, 0); PG8_ROWS(cur, 1); gc = *GSLOT(0); }
#define VGC(h, i) (gc[2 * (h) + (i)])
    const char* cA = (const char*)g.A + cur.aofs; const char* cB = (const char*)g.Bt + cur.bofs;
    PG8_STAGE(PG8_SB(0, 0), cB, voffB); PG8_STAGE(PG8_SB(0, 1), cB + hstepB, voffB); PG8_STAGE2(PG8_SA(0, 0), cA, VGC(0, 0), VGC(0, 1)); PG8_STAGE2(PG8_SA(0, 1), cA + hstepA, VGC(1, 0), VGC(1, 1));
    if (wr == 1) PG8_BAR;
    PG8_WAIT_V(2); PG8_BAR;
    PG8_STAGE(PG8_SB(1, 0), cB + kstep, voffB); PG8_STAGE2(PG8_SA(1, 0), cA + kstep, VGC(0, 0), VGC(0, 1)); PG8_STAGE(PG8_SB(1, 1), cB + hstepB + kstep, voffB);
    PG8_WAIT_V(6); PG8_BAR;
    for (;;) {
        const bool has_next = S.next(ui + 1, nxt);
        const char* nA = has_next ? (const char*)g.A + nxt.aofs : cA; const char* nB = has_next ? (const char*)g.Bt + nxt.bofs : cB;
        if constexpr (GATHER) { if (has_next) PG8_ROWS(nxt, 1); else *GSLOT(1) = *GSLOT(0); }
        for (int t = 0; t < nt; t += 2) {
            const bool last = (t == nt - 2);
            const char* a1 = cA + (size_t)(t + 1) * kstep;
            const char* a2 = last ? nA : cA + (size_t)(t + 2) * kstep; const char* b2 = last ? nB : cB + (size_t)(t + 2) * kstep;
            const char* a3 = a2 + kstep; const char* b3 = b2 + kstep;
            u32x4 gn = gc; if constexpr (GATHER) { gc = *GSLOT(0); gn = last ? *GSLOT(1) : gc; }
            const unsigned s00 = gn.x, s01 = gn.y, s10 = gn.z, s11 = gn.w;
            PG8_LDB(B0, 0, 0); PG8_LDB(B1, 0, 1); PG8_SCHED; PG8_LDA(At, 0, 0); PG8_STAGE2(PG8_SA(1, 1), a1 + hstepA, VGC(1, 0), VGC(1, 1));
            PG8_WAIT_V(8); PG8_WAIT_L(0); PG8_BAR; PG8_MMA(0, 0, At, B0); PG8_MMA(0, 1, At, B1); PG8_BAR; PG8_SCHED;
            PG8_LDA(At, 0, 1); PG8_STAGE(PG8_SB(0, 0), b2, voffB); PG8_STAGE(PG8_SB(0, 1), b2 + hstepB, voffB); PG8_STAGE2(PG8_SA(0, 0), a2, s00, s01);
            PG8_WAIT_V(8); PG8_WAIT_L(0); PG8_BAR; PG8_MMA(1, 0, At, B0); PG8_MMA(1, 1, At, B1); PG8_BAR; PG8_SCHED;
            PG8_LDB(B0, 1, 0); PG8_LDB(B1, 1, 1); PG8_SCHED; PG8_LDA(At, 1, 0); PG8_STAGE2(PG8_SA(0, 1), a2 + hstepA, s10, s11);
            PG8_WAIT_V(8); PG8_WAIT_L(0); PG8_BAR; PG8_MMA(0, 0, At, B0); PG8_MMA(0, 1, At, B1); PG8_BAR; PG8_SCHED;
            PG8_LDA(At, 1, 1); PG8_STAGE(PG8_SB(1, 0), b3, voffB); PG8_STAGE(PG8_SB(1, 1), b3 + hstepB, voffB); PG8_STAGE2(PG8_SA(1, 0), a3, s00, s01);
            PG8_WAIT_V(8); PG8_WAIT_L(0); PG8_BAR; PG8_MMA(1, 0, At, B0); PG8_MMA(1, 1, At, B1); PG8_BAR; PG8_SCHED;
        }
        if (wr == 0) PG8_BAR;
        E(acc, cur, wr, wc, fr, fq);
        if (!has_next) break;
#pragma unroll
        for (int a = 0; a < 2; ++a)
#pragma unroll
            for (int b = 0; b < 2; ++b)
#pragma unroll
                for (int m = 0; m < 4; ++m)
#pragma unroll
                    for (int n = 0; n < 2; ++n) acc[a][b][m][n] = (f32x4){0.f, 0.f, 0.f, 0.f};
        cur = nxt; cA = nA; cB = nB; ++ui;
        if constexpr (GATHER) { *GSLOT(0) = *GSLOT(1); }
        if (wr == 1) PG8_BAR;
    }
    PG8_WAIT_V(0);
    PG8_BAR;
#undef PG8_SA
#undef PG8_SB
#undef PG8_STAGE
#undef PG8_STAGE2
#undef PG8_ROWS
#undef GSLOT
#undef VGC
#undef PG8_LDA
#undef PG8_LDB
#undef PG8_MMA
#undef PG8_WAIT_V
#undef PG8_WAIT_L
#undef PG8_BAR
#undef PG8_SCHED
}

typedef const f32x4 (&AccRef)[2][2][4][2];
__device__ __forceinline__ float ss16(const float* p) { const f32x4 a = *(const f32x4*)p, b = *(const f32x4*)(p + 4), c = *(const f32x4*)(p + 8), d = *(const f32x4*)(p + 12);
    return (((a[0] + a[1]) + (a[2] + a[3])) + ((b[0] + b[1]) + (b[2] + b[3]))) + (((c[0] + c[1]) + (c[2] + c[3])) + ((d[0] + d[1]) + (d[2] + d[3]))); }
__device__ __forceinline__ float rs_of(const float* rstd, int ssmode, int row) { return ssmode ? __builtin_amdgcn_rsqf(ss16(rstd + (size_t)row * 16) * (1.f / D) + 1e-6f) : rstd[row]; }

struct EpiInProj {
    static constexpr bool PERM = true, TRANS = true;
    bf16* P; const float* rstd; float* dt; int ssmode;
    __device__ __forceinline__ void operator()(AccRef acc, const Unit& u, int wr, int wc, int fr, int fq) const {
        const int row0 = u.pm * BM + wr * 64 + fr;
        if (u.pn < 21) {
            const int col0 = u.pn * BM + wc * 32 + 8 * fq;
#pragma unroll
            for (int ai = 0; ai < 2; ++ai)
#pragma unroll
                for (int m = 0; m < 4; ++m) { const int row = row0 + ai * HALF + m * 16; const float s = rs_of(rstd, ssmode, row); bf16* rowp = P + (size_t)row * PLD + col0;
#pragma unroll
                    for (int bj = 0; bj < 2; ++bj) { const f32x4 v0 = acc[ai][bj][m][0] * s, v1 = acc[ai][bj][m][1] * s;
                        u32x4 w; w.x = pk2(v0[0], v0[1]); w.y = pk2(v0[2], v0[3]); w.z = pk2(v1[0], v1[1]); w.w = pk2(v1[2], v1[3]);
                        *(u32x4*)(rowp + bj * HALF) = w; } }
        } else if (wc == 0 && fq == 0) {
#pragma unroll
            for (int ai = 0; ai < 2; ++ai)
#pragma unroll
                for (int m = 0; m < 4; ++m) { const int row = row0 + ai * HALF + m * 16; const float s = rs_of(rstd, ssmode, row);
                    *(f32x4*)(dt + (size_t)row * 8) = acc[ai][0][m][0] * s; *(f32x4*)(dt + (size_t)row * 8 + 4) = acc[ai][0][m][1] * s; }
        }
    }
};
struct EpiPlain {
    static constexpr bool PERM = true, TRANS = true;
    bf16* P; bf16* Y2;
    __device__ __forceinline__ void operator()(AccRef acc, const Unit& u, int wr, int wc, int fr, int fq) const {
        bf16* O = (u.e == 0) ? P : (u.e == 1 ? P + C_XBC : Y2); const int ldc = (u.e == 2) ? D : PLD;
        const int row0 = u.pm * BM + wr * 64 + fr, col0 = u.pn * BM + wc * 32 + 8 * fq;
#pragma unroll
        for (int ai = 0; ai < 2; ++ai)
#pragma unroll
            for (int m = 0; m < 4; ++m) { bf16* rowp = O + (size_t)(row0 + ai * HALF + m * 16) * ldc + col0;
#pragma unroll
                for (int bj = 0; bj < 2; ++bj) { const f32x4 v0 = acc[ai][bj][m][0], v1 = acc[ai][bj][m][1];
                    u32x4 w; w.x = pk2(v0[0], v0[1]); w.y = pk2(v0[2], v0[3]); w.z = pk2(v1[0], v1[1]); w.w = pk2(v1[2], v1[3]);
                    *(u32x4*)(rowp + bj * HALF) = w; } }
    }
};
struct EpiGateMerge {
    static constexpr bool PERM = true, TRANS = true;
    const bf16* P; const bf16* Y2; bf16* Mg; int ldm; const float* rstd; int ssmode;
    __device__ __forceinline__ void operator()(AccRef acc, const Unit& u, int wr, int wc, int fr, int fq) const {
        asm volatile("" : "+v"(fr), "+v"(fq));
        const bf16* Y = (u.e == 0) ? P : (u.e == 1 ? P + C_XBC : Y2); const int ldy = (u.e == 2) ? D : PLD; const int first = (u.e == 0);
        const int row0 = u.pm * BM + wr * 64 + fr, col0 = u.pn * BM + wc * 32 + 8 * fq;
#pragma unroll
        for (int ai = 0; ai < 2; ++ai)
#pragma unroll
            for (int m = 0; m < 4; ++m) { const int row = row0 + ai * HALF + m * 16; const float s = rs_of(rstd, ssmode, row);
#pragma unroll
                for (int bj = 0; bj < 2; ++bj) { const int c = col0 + bj * HALF;
                    float y[8], o[8]; unpack8(*(const u32x4*)(Y + (size_t)row * ldy + c), y);
                    const f32x4 v0 = acc[ai][bj][m][0] * s, v1 = acc[ai][bj][m][1] * s;
#pragma unroll
                    for (int j = 0; j < 4; ++j) { o[j] = sigm(v0[j]) * y[j]; o[4 + j] = sigm(v1[j]) * y[4 + j]; }
                    if (!first) { float p[8]; unpack8(*(const u32x4*)(Mg + (size_t)row * ldm + c), p);
#pragma unroll
                        for (int j = 0; j < 8; ++j) o[j] += p[j]; }
                    *(u32x4*)(Mg + (size_t)row * ldm + c) = pack8(o); } }
    }
};
struct EpiResid {
    static constexpr bool PERM = false, TRANS = true;
    const float* xin; float* xout; const float* gates; int e;
    __device__ __forceinline__ void operator()(AccRef acc, const Unit& u, int wr, int wc, int fr, int fq) const {
        const int row0 = u.pm * BM + wr * 64 + fr, col0 = u.pn * BM + wc * 32 + 4 * fq;
#pragma unroll
        for (int ai = 0; ai < 2; ++ai)
#pragma unroll
            for (int m = 0; m < 4; ++m) { const int row = row0 + ai * HALF + m * 16; const float s = gates ? gates[(size_t)row * 8 + e] : 1.f;
                const float* ip = xin + (size_t)row * D + col0; float* op = xout + (size_t)row * D + col0;
#pragma unroll
                for (int bj = 0; bj < 2; ++bj)
#pragma unroll
                    for (int n = 0; n < 2; ++n) *(f32x4*)(op + bj * HALF + n * 16) = *(const f32x4*)(ip + bj * HALF + n * 16) + acc[ai][bj][m][n] * s; }
    }
};
struct EpiResidB {
    static constexpr bool PERM = true, TRANS = true;
    bf16* xb; float* SS; float* xf;
    __device__ __forceinline__ void operator()(AccRef acc, const Unit& u, int wr, int wc, int fr, int fq) const {
        asm volatile("" : "+v"(fr), "+v"(fq));
        const int row0 = u.pm * BM + wr * 64 + fr, col0 = u.pn * BM + wc * 32 + 8 * fq;
#pragma unroll
        for (int ai = 0; ai < 2; ++ai)
#pragma unroll
            for (int m = 0; m < 4; ++m) { const int row = row0 + ai * HALF + m * 16; bf16* rowp = xb + (size_t)row * D + col0; float ss = 0.f;
#pragma unroll
                for (int bj = 0; bj < 2; ++bj) { float v[8]; unpack8(*(const u32x4*)(rowp + bj * HALF), v);
#pragma unroll
                    for (int j = 0; j < 4; ++j) { v[j] += acc[ai][bj][m][0][j]; v[4 + j] += acc[ai][bj][m][1][j]; }
                    *(u32x4*)(rowp + bj * HALF) = pack8(v);
                    if (xf) { float* fp = xf + (size_t)row * D + col0 + bj * HALF; *(f32x4*)fp = (f32x4){v[0], v[1], v[2], v[3]}; *(f32x4*)(fp + 4) = (f32x4){v[4], v[5], v[6], v[7]}; }
#pragma unroll
                    for (int j = 0; j < 8; ++j) ss += v[j] * v[j]; }
                if (SS) { ss += __shfl_xor(ss, 16); ss += __shfl_xor(ss, 32); if (fq == 0) SS[(size_t)row * 16 + u.pn * 4 + wc] = ss; } }
    }
};
struct EpiSwiglu {
    static constexpr bool PERM = true, TRANS = true;
    bf16* act; int ldc; const float* rstd; int ssmode;
    __device__ __forceinline__ void operator()(AccRef acc, const Unit& u, int wr, int wc, int fr, int fq) const {
        asm volatile("" : "+v"(fr), "+v"(fq));
        const int row0 = u.pm * BM + wr * 64 + fr, col0 = u.pn * HALF + wc * 32 + 8 * fq;
#pragma unroll
        for (int ai = 0; ai < 2; ++ai)
#pragma unroll
            for (int m = 0; m < 4; ++m) { const int row = row0 + ai * HALF + m * 16; const int lr = row - u.pm * BM;
                const float s = u.rows ? rstd[(lr < u.nvalid) ? u.rows[2 * lr] : 0] : rs_of(rstd, ssmode, row);
                float o[8];
#pragma unroll
                for (int n = 0; n < 2; ++n)
#pragma unroll
                    for (int j = 0; j < 4; ++j) o[4 * n + j] = silu(acc[ai][0][m][n][j] * s) * (acc[ai][1][m][n][j] * s);
                *(u32x4*)(act + (size_t)row * ldc + col0) = pack8(o); }
    }
};
struct EpiMoeOut {
    static constexpr bool PERM = true, TRANS = true;
    bf16* Y; size_t kstride;
    __device__ __forceinline__ void operator()(AccRef acc, const Unit& u, int wr, int wc, int fr, int fq) const {
        const int row0 = u.pm * BM + wr * 64 + fr, col0 = u.pn * BM + wc * 32 + 8 * fq; bf16* O = Y + (size_t)u.ks * kstride;
#pragma unroll
        for (int ai = 0; ai < 2; ++ai)
#pragma unroll
            for (int m = 0; m < 4; ++m) { bf16* rowp = O + (size_t)(row0 + ai * HALF + m * 16) * D + col0;
#pragma unroll
                for (int bj = 0; bj < 2; ++bj) { const f32x4 v0 = acc[ai][bj][m][0], v1 = acc[ai][bj][m][1];
                    u32x4 w; w.x = pk2(v0[0], v0[1]); w.y = pk2(v0[2], v0[3]); w.z = pk2(v1[0], v1[1]); w.w = pk2(v1[2], v1[3]);
                    *(u32x4*)(rowp + bj * HALF) = w; } }
    }
};
}

#define XB_TMO      128
#define XB_XCNT(j)  (256  + 64 * (j))
#define XB_XSUB(j)  (1280 + 64 * (j))
#define XB_XGEN(j)  (2304 + 64 * (j))
#define XB_TOP      3328
#define XB_TOPGEN   3392
#define XCD_BAR_WORDS 3456
#define XB_SPIN_CAP (1u << 18)

__device__ __forceinline__ unsigned xb_ld(unsigned* p)              { return __hip_atomic_load(p, __ATOMIC_RELAXED, __HIP_MEMORY_SCOPE_AGENT); }
__device__ __forceinline__ unsigned xb_add(unsigned* p, unsigned v) { return __hip_atomic_fetch_add(p, v, __ATOMIC_RELAXED, __HIP_MEMORY_SCOPE_AGENT); }
__device__ __forceinline__ unsigned xb_xcc_id() { return (unsigned)__builtin_amdgcn_s_getreg((3 << 11) | 20) & 0xFu; }
#define XB_SPIN(cond, bar) do { unsigned _sp = 0; while (cond) { __builtin_amdgcn_s_sleep(1); \
    if ((++_sp & 255u) == 0u) { if (xb_ld(&(bar)[XB_TMO])) break; if (_sp > XB_SPIN_CAP) { atomicAdd(&(bar)[XB_TMO], 1u); break; } } } } while (0)

struct XcdBarrier { unsigned* bar; unsigned x; volatile LAS unsigned* st; };

__device__ __forceinline__ XcdBarrier xcd_barrier_post(unsigned* bar, volatile LAS unsigned* st) {
    XcdBarrier b; b.bar = bar; b.x = xb_xcc_id(); b.st = st;
    if (threadIdx.x == 0) (void)xb_add(&bar[XB_XCNT(b.x)], 1u);
    return b;
}
__device__ __forceinline__ void xcd_barrier_complete(unsigned* bar, unsigned x, unsigned& nloc, unsigned& nx) {
    const unsigned G = gridDim.x * gridDim.y * gridDim.z;
    unsigned sum, cnt, mine, sp = 0u;
    for (;;) {
        sum = 0u; cnt = 0u; mine = 0u;
#pragma unroll
        for (unsigned j = 0; j < 16; ++j) { const unsigned c = xb_ld(&bar[XB_XCNT(j)]); sum += c; cnt += (c > 0u) ? 1u : 0u; mine = (j == x) ? c : mine; }
        if (sum == G) break;
        __builtin_amdgcn_s_sleep(1);
        if ((++sp & 255u) == 0u) { if (xb_ld(&bar[XB_TMO])) break; if (sp > XB_SPIN_CAP) { atomicAdd(&bar[XB_TMO], 1u); break; } }
    }
    nloc = mine > 0u ? mine : 1u; nx = cnt > 0u ? cnt : 1u;
}
__device__ __forceinline__ void xcd_barrier(const XcdBarrier& b) {
    asm volatile("s_waitcnt vmcnt(0)" ::: "memory");
    __syncthreads();
    if (threadIdx.x == 0) {
        unsigned* bar = b.bar;
        __builtin_amdgcn_s_waitcnt(0);
        unsigned nloc = b.st[0], nx = b.st[1];
        if (nloc == 0u) { xcd_barrier_complete(bar, b.x, nloc, nx); b.st[0] = nloc; b.st[1] = nx; }
        const unsigned old = xb_add(&bar[XB_XSUB(b.x)], 1u);
        const unsigned gen = old / nloc;
        if (old + 1u == (gen + 1u) * nloc) {
            __builtin_amdgcn_fence(__ATOMIC_RELEASE, "agent");
            asm volatile("s_waitcnt vmcnt(0)" ::: "memory");
            const unsigned og = xb_add(&bar[XB_TOP], 1u);
            const unsigned tg = og / nx;
            if (og + 1u == (tg + 1u) * nx) xb_add(&bar[XB_TOPGEN], 1u);
            else XB_SPIN(xb_ld(&bar[XB_TOPGEN]) == tg, bar);
            __builtin_amdgcn_fence(__ATOMIC_ACQUIRE, "agent");
            xb_add(&bar[XB_XGEN(b.x)], 1u);
            asm volatile("s_waitcnt vmcnt(0)" ::: "memory");
        } else {
            XB_SPIN(xb_ld(&bar[XB_XGEN(b.x)]) == gen, bar);
            __builtin_amdgcn_fence(__ATOMIC_ACQUIRE, "agent");
            asm volatile("s_waitcnt vmcnt(0)" ::: "memory");
        }
    }
    __syncthreads();
}

struct Args { const float* in[34]; float* out; unsigned char* ws; int ph_lo, ph_hi; };
struct Frame {
    LAS unsigned char* lds;
    int vcu, G, cid, wid;
    float* out; unsigned char* ws; unsigned char* st;
};
__device__ __forceinline__ const float* inptr(LAS unsigned char* lds, int i) {
    int off = LDSCTL_OFF + 8 * i; asm volatile("" : "+v"(off));
    const LAS unsigned* p = (const LAS unsigned*)(lds + off);
    const unsigned lo = __builtin_amdgcn_readfirstlane(p[0]), hi = __builtin_amdgcn_readfirstlane(p[1]);
    return (const float*)(((unsigned long long)hi << 32) | lo);
}
#define INP(i) inptr(F.lds, (i))

__device__ __forceinline__ void conv_item(const float* W, int ld, int k0, int c0, int nvalid, const float* scale, bf16* dst, int K, int drow0, LAS float* scr, int lane) {
    const int n4 = (lane & 15) * 4;
#pragma unroll 4
    for (int i = 0; i < 16; ++i) { const int kk = 4 * i + (lane >> 4);
        f32x4 v = {0.f, 0.f, 0.f, 0.f}; if (n4 < nvalid) { v = *(const f32x4*)(W + (size_t)(k0 + kk) * ld + c0 + n4); if (scale) v *= scale[k0 + kk]; }
        LAS float* d = scr + kk * 65 + n4; d[0] = v[0]; d[1] = v[1]; d[2] = v[2]; d[3] = v[3]; }
    LDS_WAIT(); asm volatile("" ::: "memory");
    const int c = lane & 7;
#pragma unroll
    for (int j = 0; j < 8; ++j) { const int nn = (lane >> 3) + 8 * j; const LAS float* sp = scr + (8 * c) * 65 + nn;
        u32x4 o; o.x = pk2(sp[0 * 65], sp[1 * 65]); o.y = pk2(sp[2 * 65], sp[3 * 65]); o.z = pk2(sp[4 * 65], sp[5 * 65]); o.w = pk2(sp[6 * 65], sp[7 * 65]);
        *(u32x4*)(dst + (size_t)(drow0 + nn) * K + k0 + 8 * c) = o; }
    LDS_WAIT(); asm volatile("" ::: "memory");
}
__device__ __forceinline__ void conv_seg(Frame& F, const float* W, int ld, int K, int c0, int nvalid, int ntotal, const float* scale, bf16* dst, int r0, int blk, int blks) {
    const int ptid = otid(), plane = ptid & 63, pwave = __builtin_amdgcn_readfirstlane(ptid >> 6);
    LAS float* scr = (LAS float*)(F.lds + pwave * 16640);
    const int gw = F.vcu * 8 + pwave, NGW = F.G * 8;
    const int nblk = ntotal / 64, nitems = (K / 64) * nblk;
    for (int it = gw; it < nitems; it += NGW) {
        const int kb = it / nblk, nb = it % nblk, n0 = nb * 64;
        int nv = nvalid - n0; nv = nv < 0 ? 0 : (nv > 64 ? 64 : nv);
        conv_item(W, ld, kb * 64, c0 + n0, nv, scale, dst, K, r0 + (n0 / blk) * blks + (n0 % blk), scr, plane);
    }
}
__device__ __forceinline__ void conv_layer_weights(Frame& F, int l) {
    unsigned char* wl = F.ws + WS_W + (size_t)l * WL_STRIDE;
    const float* win = INP(2) + (size_t)l * D * INC; const float* n1 = INP(1) + l * D;
    const int BIGB = 1 << 30;
    conv_seg(F, win, INC, D, 0, 3328, 3328, n1, (bf16*)(wl + WL_IN), 0, BIGB, 0);
    conv_seg(F, win, INC, D, 3336, 2048, 2048, n1, (bf16*)(wl + WL_IN), 3328, BIGB, 0);
    conv_seg(F, win, INC, D, 3328, 8, 256, n1, (bf16*)(wl + WL_IN), 5376, BIGB, 0);
    conv_seg(F, win, INC, D, 5384, 3072, 3072, n1, (bf16*)(wl + WL_GATE), 0, BIGB, 0);
    for (int i = 0; i < 3; ++i)
        conv_seg(F, INP(23) + ((size_t)l * 3 + i) * 512 * D, D, 512, 0, D, D, nullptr, (bf16*)(wl + WL_BR) + (size_t)i * D * 512, 0, BIGB, 0);
    conv_seg(F, INP(24) + (size_t)l * D * D, D, D, 0, D, D, nullptr, (bf16*)(wl + WL_OUT), 0, BIGB, 0);
}
__device__ __forceinline__ void conv_ffn_weights(Frame& F) {
    const float* n2 = INP(25);
    conv_seg(F, INP(26), FF, D, 0, FF, FF, n2, (bf16*)(F.ws + WS_FFUP), 0, 128, 256);
    conv_seg(F, INP(27), FF, D, 0, FF, FF, n2, (bf16*)(F.ws + WS_FFUP), 128, 128, 256);
    conv_seg(F, INP(28), D, FF, 0, D, D, nullptr, (bf16*)(F.ws + WS_FFDN), 0, 1 << 30, 0);
}
__device__ __forceinline__ void conv_moe_weights(Frame& F) {
    const float* n2 = INP(25) + D;
    for (int e = 0; e < NE; ++e) {
        bf16* up = (bf16*)(F.ws + WS_MOEW + (size_t)e * MOEW_STRIDE); bf16* dn = (bf16*)(F.ws + WS_MOEW + (size_t)e * MOEW_STRIDE + MOEW_DN);
        conv_seg(F, INP(30) + (size_t)e * D * FFE, FFE, D, 0, FFE, FFE, n2, up, 0, 128, 256);
        conv_seg(F, INP(31) + (size_t)e * D * FFE, FFE, D, 0, FFE, FFE, n2, up, 128, 128, 256);
        conv_seg(F, INP(32) + (size_t)e * FFE * D, D, FFE, 0, D, D, nullptr, dn, 0, 1 << 30, 0);
    }
}

__device__ __forceinline__ void xprep_phase(Frame& F, const float* x) {
    const int ptid = otid(), plane = ptid & 63, pwave = __builtin_amdgcn_readfirstlane(ptid >> 6); (void)plane; (void)pwave;
    const int gw = F.vcu * 8 + pwave, NGW = F.G * 8;
    bf16* xb = (bf16*)(F.ws + WS_XB); float* rstd = (float*)(F.ws + WS_RSTD);
    for (int m = gw; m < M; m += NGW) {
        const f32x4* xr = (const f32x4*)(x + (size_t)m * D) + plane;
        f32x4 v[4]; float s = 0.f;
#pragma unroll
        for (int j = 0; j < 4; ++j) { v[j] = xr[64 * j]; s += (v[j].x * v[j].x + v[j].y * v[j].y) + (v[j].z * v[j].z + v[j].w * v[j].w); }
        s = wave_sum(s);
        if (plane == 0) rstd[m] = __builtin_amdgcn_rsqf(s * (1.f / D) + 1e-6f);
        u32x2* o8 = (u32x2*)(xb + (size_t)m * D) + plane;
#pragma unroll
        for (int j = 0; j < 4; ++j) { u32x2 w; w.x = pk2(v[j].x, v[j].y); w.y = pk2(v[j].z, v[j].w); o8[64 * j] = w; }
    }
}
__device__ __forceinline__ void final_norm_phase(Frame& F) {
    const int ptid = otid(), plane = ptid & 63, pwave = __builtin_amdgcn_readfirstlane(ptid >> 6);
    const int gw = F.vcu * 8 + pwave, NGW = F.G * 8;
    const float* fw = INP(33); const unsigned* pinfo = (const unsigned*)(F.ws + WS_PINFO); const int* cnt = (const int*)(F.ws + WS_CNT);
    int tb[8]; { int t = 0;
#pragma unroll
        for (int e = 0; e < 8; ++e) { int n = __builtin_amdgcn_readfirstlane(cnt[e]); n = n < 0 ? 0 : (n > 32768 ? 32768 : n); tb[e] = t; t += (n + 255) >> 8; } }
    const bf16* Y0 = (const bf16*)(F.ws + WS_YP0); const bf16* Y1 = (const bf16*)(F.ws + WS_YP1); const bf16* Y2 = (const bf16*)(F.ws + WS_YP2);
    for (int m = gw; m < M; m += NGW) {
        f32x4* xr = (f32x4*)(F.out + (size_t)m * D) + plane;
        f32x4 v[4];
#pragma unroll
        for (int j = 0; j < 4; ++j) v[j] = xr[64 * j];
#pragma unroll
        for (int p = 0; p < 2; ++p) {
            const unsigned pk = __builtin_amdgcn_readfirstlane(pinfo[((size_t)m * 2 + p) * 2]); const float wgt = __builtin_bit_cast(float, __builtin_amdgcn_readfirstlane(pinfo[((size_t)m * 2 + p) * 2 + 1]));
            const int e = (int)(pk >> 20), slot = (int)(pk & 0xFFFFFu);
            int tbe = tb[0];
#pragma unroll
            for (int k = 1; k < 8; ++k) tbe = (e == k) ? tb[k] : tbe;
            const int gr = tbe * 256 + slot, seg = gr >> 15, lr = gr & 32767;
            if (seg < 2) { const bf16* yr = (seg == 0 ? Y0 : Y1) + (size_t)lr * D + 4 * plane;
#pragma unroll
                for (int j = 0; j < 4; ++j) { const u32x2 yy = *(const u32x2*)(yr + 256 * j); v[j].x += wgt * bflo(yy.x); v[j].y += wgt * bfhi(yy.x); v[j].z += wgt * bflo(yy.y); v[j].w += wgt * bfhi(yy.y); } }
            else {
#pragma unroll
                for (int ks = 0; ks < 4; ++ks) { const bf16* yr = Y2 + (size_t)ks * (YP2_STRIDE / 2) + (size_t)lr * D + 4 * plane;
#pragma unroll
                    for (int j = 0; j < 4; ++j) { const u32x2 yy = *(const u32x2*)(yr + 256 * j); v[j].x += wgt * bflo(yy.x); v[j].y += wgt * bfhi(yy.x); v[j].z += wgt * bflo(yy.y); v[j].w += wgt * bfhi(yy.y); } } }
        }
        float ssq = 0.f;
#pragma unroll
        for (int j = 0; j < 4; ++j) ssq += (v[j].x * v[j].x + v[j].y * v[j].y) + (v[j].z * v[j].z + v[j].w * v[j].w);
        ssq = wave_sum(ssq);
        const float r = __builtin_amdgcn_rsqf(ssq * (1.f / D) + 1e-6f);
#pragma unroll
        for (int j = 0; j < 4; ++j) { const f32x4 w = *((const f32x4*)fw + plane + 64 * j); xr[64 * j] = v[j] * r * w; }
    }
}
__device__ __forceinline__ void router_phase(Frame& F) {
    const int ptid = otid(), plane = ptid & 63, pwave = __builtin_amdgcn_readfirstlane(ptid >> 6);
    const float* nw = INP(25) + D; const float* rt = INP(29); float* rstd_w = (float*)(F.ws + WS_RSTD); bf16* xb = (bf16*)(F.ws + WS_XB);
    int* cnt = (int*)(F.ws + WS_CNT); int* list2 = (int*)(F.ws + WS_LIST);
    LAS int* lsel = (LAS int*)F.lds;
    LAS float* lwt = (LAS float*)(F.lds + 1024);
    LAS int* lrank = (LAS int*)(F.lds + 2048);
    LAS int* lcnt = (LAS int*)(F.lds + 3072);
    for (int blk = F.vcu; blk < M / 128; blk += F.G) {
        if (ptid < 16) lcnt[ptid] = 0;
        __syncthreads();
        for (int k = 0; k < 16; ++k) {
            const int lt = pwave * 16 + k, m = blk * 128 + lt;
            float acc[8];
#pragma unroll
            for (int e = 0; e < 8; ++e) acc[e] = 0.f;
            const u32x2* xr2 = (const u32x2*)(xb + (size_t)m * D) + plane;
            f32x4 xv4[4]; float ssq = 0.f;
#pragma unroll
            for (int j = 0; j < 4; ++j) { const u32x2 xx = xr2[64 * j]; xv4[j] = (f32x4){bflo(xx.x), bfhi(xx.x), bflo(xx.y), bfhi(xx.y)}; ssq += (xv4[j].x * xv4[j].x + xv4[j].y * xv4[j].y) + (xv4[j].z * xv4[j].z + xv4[j].w * xv4[j].w); }
            ssq = wave_sum(ssq);
#pragma unroll
            for (int j = 0; j < 4; ++j) { const int kk = 4 * plane + 256 * j; const f32x4 nwv = *(const f32x4*)(nw + kk);
#pragma unroll
                for (int q = 0; q < 4; ++q) { const float xv = xv4[j][q] * nwv[q];
                    const f32x4 r0v = *(const f32x4*)(rt + (size_t)(kk + q) * 8), r1v = *(const f32x4*)(rt + (size_t)(kk + q) * 8 + 4);
                    acc[0] += xv * r0v.x; acc[1] += xv * r0v.y; acc[2] += xv * r0v.z; acc[3] += xv * r0v.w; acc[4] += xv * r1v.x; acc[5] += xv * r1v.y; acc[6] += xv * r1v.z; acc[7] += xv * r1v.w; } }
            const float sc = __builtin_amdgcn_rsqf(ssq * (1.f / D) + 1e-6f);
            if (plane == 0) rstd_w[m] = sc;
#pragma unroll
            for (int e = 0; e < 8; ++e) acc[e] = wave_sum(acc[e]) * sc;
            int i0 = 0; float v0 = acc[0];
#pragma unroll
            for (int e = 1; e < 8; ++e) if (acc[e] > v0) { v0 = acc[e]; i0 = e; }
            int i1 = -1; float v1 = -3.0e38f;
#pragma unroll
            for (int e = 0; e < 8; ++e) if (e != i0 && acc[e] > v1) { v1 = acc[e]; i1 = e; }
            const float e1 = expf(v1 - v0), w0 = 1.f / (1.f + e1), w1 = e1 / (1.f + e1);
            if (plane == 0) { lsel[2 * lt] = i0; lsel[2 * lt + 1] = i1; lwt[2 * lt] = w0; lwt[2 * lt + 1] = w1;
                lrank[2 * lt] = atomicAdd((int*)(lcnt + i0), 1); lrank[2 * lt + 1] = atomicAdd((int*)(lcnt + i1), 1); }
        }
        __syncthreads();
        if (ptid < 8) lcnt[8 + ptid] = atomicAdd(cnt + ptid, lcnt[ptid]);
        __syncthreads();
        if (ptid < 256) { const int e = lsel[ptid], slot = lcnt[8 + e] + lrank[ptid];
            u32x2 v; v.x = (unsigned)(blk * 128 + (ptid >> 1)); v.y = __builtin_bit_cast(unsigned, lwt[ptid]);
            *(u32x2*)(list2 + ((size_t)e * 32768 + slot) * 2) = v;
            u32x2 pi; pi.x = ((unsigned)e << 20) | (unsigned)slot; pi.y = v.y; *(u32x2*)((unsigned*)(F.ws + WS_PINFO) + ((size_t)(blk * 128) * 2 + ptid) * 2) = pi; }
        __syncthreads();
    }
}

__device__ __forceinline__ void vprep_phase(Frame& F, int layer) {
    const int ptid = otid(), plane = ptid & 63, pwave = __builtin_amdgcn_readfirstlane(ptid >> 6);
    constexpr int VP = 520, V_VB = 0, V_GB = 64 * VP * 2, V_VD = 2 * 64 * VP * 2;
    LAS bf16* VB = (LAS bf16*)(F.lds + V_VB); LAS bf16* GB = (LAS bf16*)(F.lds + V_GB); LAS bf16* VD = (LAS bf16*)(F.lds + V_VD);
    const bf16* P = (const bf16*)(F.ws + WS_BIG); bf16* VF = (bf16*)(F.ws + WS_VF); bf16* VM = (bf16*)(F.ws + WS_VMIX);
    const bf16* vdT = (const bf16*)(F.ws + WS_VLORA); const bf16* vuT = vdT + 32 * 512;
    const float* mu = INP(3) + layer * 1792 + 1024; const float* v0 = INP(16);
    const int tok = ptid >> 3, part = ptid & 7, r16 = plane & 15, q4 = plane >> 4;
    for (int it = F.vcu; it < M / 64; it += F.G) {
        const int m = it * 64 + tok; const int t = m & (T - 1);
        const bf16* cur = P + (size_t)m * PLD + 1024 + part * 64;
#pragma unroll
        for (int q = 0; q < 8; ++q) { float c[8], p[8]; unpack8(*(const u32x4*)(cur + q * 8), c);
            if (t > 0) unpack8(*(const u32x4*)(cur - PLD + q * 8), p); else {
#pragma unroll
                for (int e = 0; e < 8; ++e) p[e] = 0.f; }
            const f32x4 m0 = *(const f32x4*)(mu + part * 64 + q * 8), m1 = *(const f32x4*)(mu + part * 64 + q * 8 + 4);
#pragma unroll
            for (int e = 0; e < 4; ++e) { c[e] = c[e] + (p[e] - c[e]) * m0[e]; c[4 + e] = c[4 + e] + (p[4 + e] - c[4 + e]) * m1[e]; }
            const u32x4 o = pack8(c);
            if (layer == 0) *(u32x4*)(VF + (size_t)m * 512 + part * 64 + q * 8) = o; else *(LAS u32x4*)(VB + tok * VP + part * 64 + q * 8) = o; }
        if (layer == 0) continue;
        __syncthreads();
        { const int rb = pwave & 3, jt = pwave >> 2; f32x4 acc = {0.f, 0.f, 0.f, 0.f};
#pragma unroll 4
          for (int k0 = 0; k0 < 512; k0 += 32) acc = __builtin_amdgcn_mfma_f32_16x16x32_bf16(*(const LAS bf16x8*)(VB + (16 * rb + r16) * VP + k0 + 8 * q4), *(const bf16x8*)(vdT + (size_t)(16 * jt + r16) * 512 + k0 + 8 * q4), acc, 0, 0, 0);
#pragma unroll
          for (int jj = 0; jj < 4; ++jj) VD[(16 * rb + 4 * q4 + jj) * 40 + 16 * jt + r16] = (bf16)f2bf(acc[jj]); }
        __syncthreads();
        { const int rb = pwave & 3; const bf16x8 af = *(const LAS bf16x8*)(VD + (16 * rb + r16) * 40 + 8 * q4);
#pragma unroll 4
          for (int i = 0; i < 16; ++i) { const int ct = (pwave >> 2) * 16 + i;
              const f32x4 acc = __builtin_amdgcn_mfma_f32_16x16x32_bf16(af, *(const bf16x8*)(vuT + (size_t)(16 * ct + r16) * 32 + 8 * q4), (f32x4){0.f, 0.f, 0.f, 0.f}, 0, 0, 0);
              const float vc = v0[16 * ct + r16];
#pragma unroll
              for (int jj = 0; jj < 4; ++jj) GB[(16 * rb + 4 * q4 + jj) * VP + 16 * ct + r16] = (bf16)f2bf(sigm(vc + acc[jj])); } }
        __syncthreads();
#pragma unroll
        for (int q = 0; q < 8; ++q) { float v[8], g[8], vf[8]; unpack8(*(const LAS u32x4*)(VB + tok * VP + part * 64 + q * 8), v); unpack8(*(const LAS u32x4*)(GB + tok * VP + part * 64 + q * 8), g);
            unpack8(*(const u32x4*)(VF + (size_t)m * 512 + part * 64 + q * 8), vf);
#pragma unroll
            for (int e = 0; e < 8; ++e) v[e] = v[e] + (vf[e] - v[e]) * g[e];
            *(u32x4*)(VM + (size_t)m * 512 + part * 64 + q * 8) = pack8(v); }
        __syncthreads();
    }
}
__device__ __forceinline__ void prepass_a(Frame& F) {
    const int tid = otid();
    bf16* P = (bf16*)(F.ws + WS_BIG); bf16* BND2 = (bf16*)(F.ws + WS_BND2);
    { const int ch = tid & 127; const int kind = ch >> 6, part = ch & 7;
      double invf[4];
#pragma unroll
      for (int p = 0; p < 4; ++p) invf[p] = exp(-(double)(part * 4 + p) * (9.210340371976184 / 32.0));
      for (int m = F.vcu * 4 + (tid >> 7); m < M; m += F.G * 4) {
          const int t = m & (T - 1); bf16* ptr = P + (size_t)m * PLD + C_RET + ch * 8;
          float x[8]; unpack8(*(const u32x4*)ptr, x);
#pragma unroll
          for (int p = 0; p < 4; ++p) { double rev = (double)t * invf[p] * 0.15915494309189535; rev -= floor(rev);
              const float sn = __builtin_amdgcn_sinf((float)rev), cs = __builtin_amdgcn_cosf((float)rev);
              const float x0 = x[2 * p], x1 = x[2 * p + 1]; float o0 = x0 * cs - x1 * sn, o1 = x0 * sn + x1 * cs;
              if (kind) { o0 *= 0.125f; o1 *= 0.125f; }
              x[2 * p] = o0; x[2 * p + 1] = o1; }
          *(u32x4*)ptr = pack8(x); } }
    for (int i = F.vcu * 512 + tid; i < 1024 * 3 * 128; i += F.G * 512) { const int ch = i & 127, k = (i >> 7) % 3, r = i / 384;
        if ((r & 511) != 0) *(u32x4*)(BND2 + ((size_t)r * 3 + k) * 1024 + ch * 8) = *(const u32x4*)(P + ((size_t)r * 32 - 3 + k) * PLD + C_XBC + ch * 8); }
}
__device__ __forceinline__ void prepass_conv(Frame& F, int layer) {
    const int tid = otid();
    bf16* P = (bf16*)(F.ws + WS_BIG); const bf16* BND2 = (const bf16*)(F.ws + WS_BND2);
    const float* cw = INP(17) + layer * 1024 * 4; const float* cbias = INP(18) + layer * 1024;
    const int ch = tid & 127;
    f32x4 wv[8]; float bv[8];
#pragma unroll
    for (int e = 0; e < 8; ++e) { wv[e] = *(const f32x4*)(cw + (ch * 8 + e) * 4); bv[e] = cbias[ch * 8 + e]; }
    for (int r = F.vcu * 4 + (tid >> 7); r < M / 32; r += F.G * 4) {
        float w0[8], w1[8], w2[8];
        if ((r & 511) != 0) { unpack8(*(const u32x4*)(BND2 + ((size_t)r * 3 + 0) * 1024 + ch * 8), w0); unpack8(*(const u32x4*)(BND2 + ((size_t)r * 3 + 1) * 1024 + ch * 8), w1); unpack8(*(const u32x4*)(BND2 + ((size_t)r * 3 + 2) * 1024 + ch * 8), w2); }
        else {
#pragma unroll
            for (int e = 0; e < 8; ++e) { w0[e] = 0.f; w1[e] = 0.f; w2[e] = 0.f; } }
        bf16* ptr = P + (size_t)r * 32 * PLD + C_XBC + ch * 8;
#pragma unroll 4
        for (int i = 0; i < 32; ++i) {
            float x[8], o[8]; unpack8(*(const u32x4*)(ptr + (size_t)i * PLD), x);
#pragma unroll
            for (int e = 0; e < 8; ++e) { o[e] = silu(bv[e] + wv[e][0] * w0[e] + wv[e][1] * w1[e] + wv[e][2] * w2[e] + wv[e][3] * x[e]); w0[e] = w1[e]; w1[e] = w2[e]; w2[e] = x[e]; }
            *(u32x4*)(ptr + (size_t)i * PLD) = pack8(o);
        }
    }
}
template <int CTRL> __device__ __forceinline__ float dpp_f(float v) { return __builtin_bit_cast(float, __builtin_amdgcn_update_dpp(0, __builtin_bit_cast(int, v), CTRL, 0xF, 0xF, true)); }
__device__ __forceinline__ float red8(float v) { v += dpp_f<0xB1>(v); v += dpp_f<0x4E>(v); v += dpp_f<0x141>(v); return v; }
__device__ __forceinline__ float red16(float v) { v = red8(v); v += dpp_f<0x140>(v); return v; }

__device__ __forceinline__ void rwkv_seq(Frame& F, int layer, int bh) {
    const int ptid = otid(), plane = ptid & 63, pwave = __builtin_amdgcn_readfirstlane(ptid >> 6); (void)plane; (void)pwave;
    const int b = bh >> 3, h = bh & 7;
    LAS float* L = (LAS float*)F.lds;
    LAS float *rr = L, *ww = L + 2048, *kf = L + 4096, *vv = L + 6144, *aa = L + 8192, *bb = L + 10240, *gg = L + 12288, *yy = L + 14336, *tw = L + 16384, *xa = L + 18432, *sg = L + 20480, *bon = L + 24576;
    const float* mu = INP(3) + layer * 1792; const float* w_up = INP(4) + layer * 64 * 512; const float* w0 = INP(5) + layer * 512;
    const float* a_up = INP(6) + layer * 64 * 512; const float* a0 = INP(7) + layer * 512; const float* g_up = INP(8) + layer * 128 * 512;
    const float* k_k = INP(9) + layer * 512; const float* k_a = INP(10) + layer * 512; const float* r_k = INP(11) + layer * 512;
    const float* gn_w = INP(12) + layer * 512; const float* gn_b = INP(13) + layer * 512;
    const bf16* P = (const bf16*)(F.ws + WS_BIG); const bf16* vsrc = (const bf16*)(F.ws + (layer == 0 ? WS_VF : WS_VMIX)); bf16* yout = (bf16*)(F.ws + WS_YRW);
    const int tid = ptid, tok = tid >> 4, part = tid & 15, c4 = part * 4, cb = h * 64 + c4;
    const int srow = tid >> 3, sc0 = (tid & 7) * 8;
    float S[8];
#pragma unroll
    for (int j = 0; j < 8; ++j) S[j] = 0.f;
    for (int t0 = 0; t0 < T; t0 += 32) {
        {
            const int t = t0 + tok; const size_t m = (size_t)b * T + t;
            const bf16* cur = P + m * PLD;
#pragma unroll
            for (int q = 0; q < 3; ++q) {
                const int ch = part + 16 * q; int col, kind; LAS float* dst;
                if (ch < 8) { col = h * 64 + ch * 8; dst = rr + tok * 64 + ch * 8; kind = 0; }
                else if (ch < 16) { col = 512 + h * 64 + (ch - 8) * 8; dst = kf + tok * 64 + (ch - 8) * 8; kind = 0; }
                else if (ch < 24) { col = 1536 + (ch - 16) * 8; dst = tw + tok * 64 + (ch - 16) * 8; kind = 1; }
                else if (ch < 32) { col = 1600 + (ch - 24) * 8; dst = xa + tok * 64 + (ch - 24) * 8; kind = 0; }
                else { col = 1664 + (ch - 32) * 8; dst = sg + tok * 128 + (ch - 32) * 8; kind = 2; }
                float c[8], p[8]; unpack8(*(const u32x4*)(cur + col), c);
                if (t > 0) unpack8(*(const u32x4*)(cur - PLD + col), p); else {
#pragma unroll
                    for (int e = 0; e < 8; ++e) p[e] = 0.f; }
#pragma unroll
                for (int e = 0; e < 8; ++e) { float x = c[e] + (p[e] - c[e]) * mu[col + e]; if (kind == 1) x = tanhf(x); else if (kind == 2) x = sigm(x); dst[e] = x; }
            }
            if (part < 8) { float v[8]; unpack8(*(const u32x4*)(vsrc + m * 512 + h * 64 + part * 8), v);
#pragma unroll
                for (int e = 0; e < 8; ++e) vv[tok * 64 + part * 8 + e] = v[e]; }
        }
        __syncthreads();
        {
            f32x4 dw = *(const f32x4*)(w0 + cb), da = *(const f32x4*)(a0 + cb), dg = (f32x4){0.f, 0.f, 0.f, 0.f};
            for (int j = 0; j < 64; ++j) { const float tj = tw[tok * 64 + j], xj = xa[tok * 64 + j];
                dw += *(const f32x4*)(w_up + j * 512 + cb) * tj; da += *(const f32x4*)(a_up + j * 512 + cb) * xj; }
            for (int j = 0; j < 128; ++j) dg += *(const f32x4*)(g_up + j * 512 + cb) * sg[tok * 128 + j];
            float kr[4], kk[4], av[4], ss = 0.f;
#pragma unroll
            for (int e = 0; e < 4; ++e) { kr[e] = kf[tok * 64 + c4 + e]; kk[e] = kr[e] * k_k[cb + e]; ss += kk[e] * kk[e]; av[e] = sigm(da[e]); }
            ss = red16(ss);
            const float inv = __builtin_amdgcn_rsqf(fmaxf(ss, 1e-24f));
            float bs = 0.f;
#pragma unroll
            for (int e = 0; e < 4; ++e) { const float kn = kk[e] * inv; const int o = tok * 64 + c4 + e;
                const float ld = -expf(-softplus_acc(-dw[e]) - 0.5f);
                ww[o] = expf(ld); aa[o] = -kn; bb[o] = kn * av[e];
                const float knew = kr[e] * (1.f + (av[e] - 1.f) * k_a[cb + e]); kf[o] = knew; gg[o] = dg[e];
                bs += rr[o] * knew * r_k[cb + e]; }
            bs = red16(bs);
            if (part == 0) bon[tok] = bs;
        }
        __syncthreads();
        for (int s = 0; s < 32; ++s) {
            const f32x4 a0v = *(const LAS f32x4*)(aa + s * 64 + sc0), a1v = *(const LAS f32x4*)(aa + s * 64 + sc0 + 4);
            const f32x4 w0v = *(const LAS f32x4*)(ww + s * 64 + sc0), w1v = *(const LAS f32x4*)(ww + s * 64 + sc0 + 4);
            const f32x4 b0v = *(const LAS f32x4*)(bb + s * 64 + sc0), b1v = *(const LAS f32x4*)(bb + s * 64 + sc0 + 4);
            const f32x4 k0v = *(const LAS f32x4*)(kf + s * 64 + sc0), k1v = *(const LAS f32x4*)(kf + s * 64 + sc0 + 4);
            const f32x4 r0v = *(const LAS f32x4*)(rr + s * 64 + sc0), r1v = *(const LAS f32x4*)(rr + s * 64 + sc0 + 4);
            const float vi = vv[s * 64 + srow];
            float sa = 0.f;
#pragma unroll
            for (int j = 0; j < 4; ++j) sa += S[j] * a0v[j] + S[4 + j] * a1v[j];
            sa = red8(sa);
            float y = 0.f;
#pragma unroll
            for (int j = 0; j < 4; ++j) { S[j] = S[j] * w0v[j] + sa * b0v[j] + vi * k0v[j]; S[4 + j] = S[4 + j] * w1v[j] + sa * b1v[j] + vi * k1v[j]; y += S[j] * r0v[j] + S[4 + j] * r1v[j]; }
            y = red8(y);
            if ((tid & 7) == 0) yy[s * 64 + srow] = y;
        }
        __syncthreads();
        {
            const size_t m = (size_t)b * T + t0 + tok;
            float y[4], sm = 0.f;
#pragma unroll
            for (int e = 0; e < 4; ++e) { y[e] = yy[tok * 64 + c4 + e]; sm += y[e]; }
            const float mean = red16(sm) * (1.f / 64.f);
            float vs = 0.f;
#pragma unroll
            for (int e = 0; e < 4; ++e) { y[e] -= mean; vs += y[e] * y[e]; }
            const float rs = __builtin_amdgcn_rsqf(red16(vs) * (1.f / 64.f) + 64e-5f);
            const float bo = bon[tok];
            float o[4];
#pragma unroll
            for (int e = 0; e < 4; ++e) { const int idx = tok * 64 + c4 + e; o[e] = (y[e] * rs * gn_w[cb + e] + gn_b[cb + e] + bo * vv[idx]) * gg[idx]; }
            u32x2 w; w.x = pk2(o[0], o[1]); w.y = pk2(o[2], o[3]);
            *(u32x2*)(yout + m * 512 + cb) = w;
        }
        __syncthreads();
    }
}

__device__ __forceinline__ void ret_seq(Frame& F, int bh) {
    const int ptid = otid(), plane = ptid & 63, pwave = __builtin_amdgcn_readfirstlane(ptid >> 6); (void)plane; (void)pwave;
    const int b = bh >> 3, h = bh & 7;
    LAS float* L = (LAS float*)F.lds;
    LAS float *qq = L, *kk = L + 2048, *vv = L + 4096, *gg = L + 6144, *yy = L + 8192;
    bf16* P = (bf16*)(F.ws + WS_BIG);
    const int tid = ptid, tok = tid >> 4, part = tid & 15, c4 = part * 4;
    const int se = tid >> 3, sd0 = (tid & 7) * 8;
    const float gamma = 1.f - exp2f(-5.f - (float)h);
    float S[8];
#pragma unroll
    for (int j = 0; j < 8; ++j) S[j] = 0.f;
    for (int t0 = 0; t0 < T; t0 += 32) {
        {
            const int t = t0 + tok; const size_t m = (size_t)b * T + t;
#pragma unroll
            for (int q = 0; q < 2; ++q) {
                const int ch = part + 16 * q, kind = ch >> 3, cc = ch & 7;
                float x[8]; unpack8(*(const u32x4*)(P + m * PLD + C_RET + kind * 512 + h * 64 + cc * 8), x);
                LAS float* dst = (kind == 0 ? qq : kind == 1 ? kk : kind == 2 ? vv : gg) + tok * 64 + cc * 8;
                if (kind < 2) {
#pragma unroll
                    for (int p = 0; p < 4; ++p) { const int i = cc * 4 + p;
                        const double invf = exp(-(double)i * (9.210340371976184 / 32.0));
                        double sn, cs; sincos((double)t * invf, &sn, &cs);
                        const float x0 = x[2 * p], x1 = x[2 * p + 1], c = (float)cs, s = (float)sn;
                        float o0 = x0 * c - x1 * s, o1 = x0 * s + x1 * c;
                        if (kind == 1) { o0 *= 0.125f; o1 *= 0.125f; }
                        dst[2 * p] = o0; dst[2 * p + 1] = o1; }
                } else {
#pragma unroll
                    for (int e = 0; e < 8; ++e) dst[e] = x[e];
                }
            }
        }
        __syncthreads();
        for (int s = 0; s < 32; ++s) {
            const f32x4 k0v = *(const LAS f32x4*)(kk + s * 64 + sd0), k1v = *(const LAS f32x4*)(kk + s * 64 + sd0 + 4);
            const f32x4 q0v = *(const LAS f32x4*)(qq + s * 64 + sd0), q1v = *(const LAS f32x4*)(qq + s * 64 + sd0 + 4);
            const float ve = vv[s * 64 + se];
            float y = 0.f;
#pragma unroll
            for (int j = 0; j < 4; ++j) { S[j] = gamma * S[j] + k0v[j] * ve; S[4 + j] = gamma * S[4 + j] + k1v[j] * ve; y += q0v[j] * S[j] + q1v[j] * S[4 + j]; }
            y = red8(y);
            if ((tid & 7) == 0) yy[s * 64 + se] = y;
        }
        __syncthreads();
        {
            const size_t m = (size_t)b * T + t0 + tok;
            float y[4], ss = 0.f;
#pragma unroll
            for (int e = 0; e < 4; ++e) { y[e] = yy[tok * 64 + c4 + e]; ss += y[e] * y[e]; }
            const float rs = __builtin_amdgcn_rsqf(red16(ss) * (1.f / 64.f) + 1e-6f);
            float o[4];
#pragma unroll
            for (int e = 0; e < 4; ++e) o[e] = y[e] * rs * silu(gg[tok * 64 + c4 + e]);
            u32x2 w; w.x = pk2(o[0], o[1]); w.y = pk2(o[2], o[3]);
            *(u32x2*)(P + m * PLD + C_RETG + h * 64 + c4) = w;
        }
        __syncthreads();
    }
}

__device__ __forceinline__ void ssd_seq(Frame& F, int layer, int bh) {
    const int ptid = otid(), plane = ptid & 63, pwave = __builtin_amdgcn_readfirstlane(ptid >> 6); (void)plane; (void)pwave;
    const int b = bh >> 3, h = bh & 7, g = h >> 2;
    LAS float* L = (LAS float*)F.lds;
    LAS float *raw = L  , *xs = L + 11200, *Bc = L + 13248, *Cc = L + 17344, *yy = L + 21440, *dts = L + 23488, *das = L + 23520;
    bf16* P = (bf16*)(F.ws + WS_BIG); const float* dtb = (const float*)(F.ws + WS_DT);
    const float* cw = INP(17) + layer * 1024 * 4; const float* cbias = INP(18) + layer * 1024;
    const float dt_bias = INP(19)[layer * 8 + h], A = -expf(INP(20)[layer * 8 + h]), Dh = INP(21)[layer * 8 + h];
    const int tid = ptid;
    const int sp = tid >> 3, sn0 = (tid & 7) * 16;
    float S[16];
#pragma unroll
    for (int j = 0; j < 16; ++j) S[j] = 0.f;
    for (int i = tid; i < 3 * 320; i += 512) raw[i] = 0.f;
    __syncthreads();
    for (int t0 = 0; t0 < T; t0 += 32) {
        for (int idx = tid; idx < 32 * 40; idx += 512) {
            const int row = idx / 40, ch = idx % 40; const size_t m = (size_t)b * T + t0 + row;
            const int col = ch < 8 ? (C_XBC + h * 64 + ch * 8) : (ch < 24 ? (C_XBC + 512 + g * 128 + (ch - 8) * 8) : (C_XBC + 768 + g * 128 + (ch - 24) * 8));
            float x[8]; unpack8(*(const u32x4*)(P + m * PLD + col), x);
#pragma unroll
            for (int e = 0; e < 8; ++e) raw[(3 + row) * 320 + ch * 8 + e] = x[e];
        }
        if (tid < 32) { const size_t m = (size_t)b * T + t0 + tid; const float dt = softplus_acc(dtb[m * 8 + h] + dt_bias); dts[tid] = dt; das[tid] = expf(A * dt); }
        __syncthreads();
        for (int idx = tid; idx < 32 * 320; idx += 512) {
            const int row = idx / 320, c = idx % 320;
            const int chn = c < 64 ? (h * 64 + c) : (c < 192 ? (512 + g * 128 + (c - 64)) : (768 + g * 128 + (c - 192)));
            float a = cbias[chn];
#pragma unroll
            for (int k = 0; k < 4; ++k) a += cw[chn * 4 + k] * raw[(row + k) * 320 + c];
            a = silu(a);
            if (c < 64) xs[row * 64 + c] = a; else if (c < 192) Bc[row * 128 + (c - 64)] = a; else Cc[row * 128 + (c - 192)] = a;
        }
        __syncthreads();
        for (int s = 0; s < 32; ++s) {
            const float da = das[s], xv = xs[s * 64 + sp], dtx = dts[s] * xv;
            float y = 0.f;
#pragma unroll
            for (int q = 0; q < 4; ++q) { const f32x4 bv = *(const LAS f32x4*)(Bc + s * 128 + sn0 + q * 4), cv = *(const LAS f32x4*)(Cc + s * 128 + sn0 + q * 4);
#pragma unroll
                for (int j = 0; j < 4; ++j) { S[q * 4 + j] = da * S[q * 4 + j] + dtx * bv[j]; y += S[q * 4 + j] * cv[j]; } }
            y = red8(y);
            if ((tid & 7) == 0) yy[s * 64 + sp] = y + Dh * xv;
        }
        __syncthreads();
        {
            const int tok = tid >> 4, c4 = (tid & 15) * 4; const size_t m = (size_t)b * T + t0 + tok;
            u32x2 w; w.x = pk2(yy[tok * 64 + c4], yy[tok * 64 + c4 + 1]); w.y = pk2(yy[tok * 64 + c4 + 2], yy[tok * 64 + c4 + 3]);
            *(u32x2*)(P + m * PLD + C_XBC + h * 64 + c4) = w;
            for (int i = tid; i < 3 * 320; i += 512) raw[i] = raw[32 * 320 + i];
        }
        __syncthreads();
    }
}
__device__ __forceinline__ void ssm_norm_phase(Frame& F, int layer) {
    const int ptid = otid(), plane = ptid & 63, pwave = __builtin_amdgcn_readfirstlane(ptid >> 6); (void)plane; (void)pwave;
    const int gw = F.vcu * 8 + pwave, NGW = F.G * 8;
    bf16* P = (bf16*)(F.ws + WS_BIG); const float* nw = INP(22) + layer * 512;
    for (int m = gw; m < M; m += NGW) {
        float y[8], z[8]; unpack8(*(const u32x4*)(P + (size_t)m * PLD + C_XBC + plane * 8), y); unpack8(*(const u32x4*)(P + (size_t)m * PLD + C_Z + plane * 8), z);
        float ss = 0.f;
#pragma unroll
        for (int e = 0; e < 8; ++e) { y[e] *= silu(z[e]); ss += y[e] * y[e]; }
        ss += __shfl_xor(ss, 1); ss += __shfl_xor(ss, 2); ss += __shfl_xor(ss, 4); ss += __shfl_xor(ss, 8); ss += __shfl_xor(ss, 16);
        const float rs = __builtin_amdgcn_rsqf(ss * (1.f / 256.f) + 1e-6f);
#pragma unroll
        for (int e = 0; e < 8; ++e) y[e] *= rs * nw[plane * 8 + e];
        *(u32x4*)(P + (size_t)m * PLD + C_Z + plane * 8) = pack8(y);
    }
}

constexpr int PT = 72, PT2 = 136, PF = 68;
__device__ __forceinline__ f32x4 mfma16(bf16x8 a, bf16x8 b, f32x4 c) { return __builtin_amdgcn_mfma_f32_16x16x32_bf16(a, b, c, 0, 0, 0); }
template <int K, bool SA = false, bool SB = false> __device__ __forceinline__ f32x4 mm_ll(const LAS bf16* A, int pa, int m0, const LAS bf16* B, int pb, int n0, f32x4 acc, int lane) {
    const int r = lane & 15, q = lane >> 4;
    const int xa = SA ? (((m0 + r) >> 3) & 7) : 0, xb = SB ? (((n0 + r) >> 3) & 7) : 0;
    const LAS bf16* ap = A + (m0 + r) * pa; const LAS bf16* bp = B + (n0 + r) * pb;
#pragma unroll
    for (int k0 = 0; k0 < K; k0 += 32) acc = mfma16(*(const LAS bf16x8*)(ap + 8 * (((k0 >> 3) + q) ^ xa)), *(const LAS bf16x8*)(bp + 8 * (((k0 >> 3) + q) ^ xb)), acc);
    return acc;
}
template <int K> __device__ __forceinline__ f32x4 mm_lg(const LAS bf16* A, int pa, int m0, const bf16* B, int pb, int n0, f32x4 acc, int lane) {
    const int r = lane & 15, q = lane >> 4;
    const LAS bf16* ap = A + (m0 + r) * pa + 8 * q; const bf16* bp = B + (size_t)(n0 + r) * pb + 8 * q;
#pragma unroll
    for (int k0 = 0; k0 < K; k0 += 32) acc = mfma16(*(const LAS bf16x8*)(ap + k0), *(const bf16x8*)(bp + k0), acc);
    return acc;
}
__device__ __forceinline__ float redl16(float v) { return red16(v); }
__device__ __forceinline__ void st4bf(LAS bf16* p, f32x4 v) { u32x2 w; w.x = pk2(v[0], v[1]); w.y = pk2(v[2], v[3]); *(LAS u32x2*)p = w; }
__device__ __forceinline__ float ldbf(const LAS bf16* p) { return __builtin_bit_cast(float, (unsigned)(*p) << 16); }
constexpr f32x4 FZ4 = {0.f, 0.f, 0.f, 0.f};
__device__ __forceinline__ void tr_write8(LAS bf16* Tm, int pitch, int c0, int t, const float (&v)[8], int) {
    LAS bf16* base = Tm + c0 * pitch + (t ^ (((c0 >> 3) & 7) << 3));
#pragma unroll
    for (int e = 0; e < 8; ++e) base[e * pitch] = (bf16)f2bf(v[e]);
}
__device__ __forceinline__ float tr_at(const LAS bf16* Tm, int pitch, int row, int col) { return __builtin_bit_cast(float, (unsigned)Tm[row * pitch + (col ^ (((row >> 3) & 7) << 3))] << 16); }
__device__ __forceinline__ void ld8f(const LAS float* p, float (&v)[8]) { const f32x4 a = *(const LAS f32x4*)p, b = *(const LAS f32x4*)(p + 4); v[0] = a[0]; v[1] = a[1]; v[2] = a[2]; v[3] = a[3]; v[4] = b[0]; v[5] = b[1]; v[6] = b[2]; v[7] = b[3]; }
__device__ __forceinline__ void st8f(LAS float* p, const float (&v)[8]) { *(LAS f32x4*)p = (f32x4){v[0], v[1], v[2], v[3]}; *(LAS f32x4*)(p + 4) = (f32x4){v[4], v[5], v[6], v[7]}; }

template <bool FINAL>
__device__ __forceinline__ void rwkv_chunk_unit(Frame& F, int layer, int u) {
    const int tid = otid(), w = __builtin_amdgcn_readfirstlane(tid >> 6);
    bf16x8 lfr[16];
#define IDS() const int ft = fresh_tid(tid); const int lane = ft & 63, r16 = lane & 15, q4 = lane >> 4, tok = ft >> 3, part = ft & 7; (void)lane; (void)r16; (void)q4; (void)tok; (void)part
    const int b = u >> 9, sc = (u >> 3) & 63, h = u & 7;
    constexpr int NV = FINAL ? 64 : 128, NVT = NV / 16, NZ = NVT / 2;
    constexpr int X_TW = 0, X_XA = 9216, X_SG = 18432, X_KF = 35840, X_RF = 52224;
    constexpr int O_AT = 0, O_RT = 9216, O_BT = 18432, O_KT = 27648, O_BH = 36864, O_KH = 46080, O_VT = 55296, O_TF = O_BT;
    constexpr int Y0 = 68608;
    constexpr int Y_A = Y0, Y_B = Y0 + 8192, Y_K = Y0 + 16384, Y_R = Y0 + 24576, Y_L = Y0 + 32768, Y_VF = Y0 + 49152;
    constexpr int Y_AAB = Y0, Y_AAK = Y0 + 17408, Y_ARB = Y_AAK + 9216, Y_ARK = Y_ARB + 9216, Y_TB = FINAL ? Y_ARK + 9216 : Y_AAK + 9216, Y_ZU = Y_TB + 9216, Y_YF = Y_AAB;
    static_assert(Y_ZU + NV * PT * 2 <= Y0 + 65536, "region Y");
    constexpr int Z0 = Y0 + 65536, Z_G = Z0, Z_S = FINAL ? Z0 + 8192 : Z0, Z_MISC = 152576, Z_BON = Z_MISC, Z_PC = Z_MISC + 256, Z_PAR = Z_MISC + 512, Z_XS = Y_ZU;
    static_assert(Z_S + NV * PT * 2 <= Z_MISC && Z_PAR + 832 * 4 <= LDSCTL_OFF, "region Z");
    LAS unsigned char* L = F.lds;
#define LB(off) ((LAS bf16*)(L + (off)))
#define LF(off) ((LAS float*)(L + (off)))
    {
        const int pidx = (w == 0) ? 5 : (w == 1) ? 7 : (w == 2) ? 9 : (w == 3) ? 10 : (w == 4) ? 11 : (w == 5) ? 12 : 13;
        if (w < 7) LF(Z_PAR)[w * 64 + (tid & 63)] = (INP(pidx) + layer * 512 + h * 64)[tid & 63];
        const float* mu = INP(3) + layer * 1792;
        for (int i = tid; i < 384; i += 512) LF(Z_PAR)[448 + i] = mu[(i < 64) ? (h * 64 + i) : (i < 128) ? (512 + h * 64 + (i - 64)) : (1536 + (i - 128))];
    }
    __syncthreads();
    const bf16* WupT = (const bf16*)(F.ws + WS_LORA + (size_t)layer * LORA_STRIDE) + h * 64 * 64;
    const bf16* AupT = (const bf16*)(F.ws + WS_LORA + (size_t)layer * LORA_STRIDE + 65536) + h * 64 * 64;
    const bf16* GupT = (const bf16*)(F.ws + WS_LORA + (size_t)layer * LORA_STRIDE + 131072) + h * 64 * 128;
    const bf16* P = (const bf16*)(F.ws + WS_BIG); const bf16* vsrc = (const bf16*)(F.ws + (layer == 0 ? WS_VF : WS_VMIX));
    float* Nbuf = (float*)(F.st + 0) + (size_t)u * 4096; bf16* MT = (bf16*)(F.ws + WS_MT) + (size_t)u * 4096;
    { IDS();
        if (w < 4) {
#pragma unroll
            for (int nt = 0; nt < 4; ++nt)
#pragma unroll
                for (int k2 = 0; k2 < 2; ++k2) { lfr[nt * 4 + k2] = *(const bf16x8*)(WupT + (size_t)(16 * nt + r16) * 64 + 32 * k2 + 8 * q4); lfr[nt * 4 + 2 + k2] = *(const bf16x8*)(AupT + (size_t)(16 * nt + r16) * 64 + 32 * k2 + 8 * q4); }
        } else if (FINAL) {
#pragma unroll
            for (int nt = 0; nt < 4; ++nt)
#pragma unroll
                for (int k4 = 0; k4 < 4; ++k4) lfr[nt * 4 + k4] = *(const bf16x8*)(GupT + (size_t)(16 * nt + r16) * 128 + 32 * k4 + 8 * q4);
        } }
    constexpr int NST = FINAL ? 2 : 4;
    f32x4 Sacc[NST];
    const int s_vb = FINAL ? (w & 3) : w;
#define S_CT(ti) (FINAL ? (2 * (w >> 2) + (ti)) : (ti))
    { IDS();
#pragma unroll
    for (int ti = 0; ti < NST; ++ti) {
        const int ct = S_CT(ti);
#pragma unroll
        for (int jj = 0; jj < 4; ++jj) { const int v = 16 * s_vb + 4 * q4 + jj, c = 16 * ct + r16;
            float x; if (FINAL) x = Nbuf[v * 64 + c]; else x = (v >= 64 && v - 64 == c) ? 1.f : 0.f;
            Sacc[ti][jj] = x; LB(Z_S)[v * PT + c] = (bf16)f2bf(x); }
    } }
    u32x4 pfc[6], pfp[6], pfv;
#define RW_PREFETCH(jn) do { IDS(); const int t_ = sc * 256 + (jn) * 64 + tok; const size_t m_ = (size_t)b * T + t_; const bf16* cur_ = P + m_ * PLD; \
        _Pragma("unroll") for (int i_ = 0; i_ < 6; ++i_) { const int col_ = (i_ == 0) ? (h * 64 + 8 * part) : (i_ == 1) ? (512 + h * 64 + 8 * part) : (i_ == 2) ? (1536 + 8 * part) : (i_ == 3) ? (1600 + 8 * part) : (1664 + 8 * part + (i_ - 4) * 64); \
            pfc[i_] = *(const u32x4*)(cur_ + col_); pfp[i_] = (t_ > 0) ? *(const u32x4*)(cur_ - PLD + col_) : (u32x4){0u, 0u, 0u, 0u}; } \
        pfv = *(const u32x4*)(vsrc + m_ * 512 + h * 64 + 8 * part); } while (0)
    RW_PREFETCH(0);
    for (int j = 0; j < 4; ++j) {
        const int tl0 = sc * 256 + j * 64;
        {
            IDS();
            const int t = tl0 + tok; const size_t m = (size_t)b * T + t; const bf16* cur = P + m * PLD;
#pragma unroll
            for (int i = 0; i < 6; ++i) {
                const int col = (i == 0) ? (h * 64 + 8 * part) : (i == 1) ? (512 + h * 64 + 8 * part) : (i == 2) ? (1536 + 8 * part) : (i == 3) ? (1600 + 8 * part) : (1664 + 8 * part + (i - 4) * 64);
                float c[8], p[8]; unpack8(pfc[i], c); unpack8(pfp[i], p); (void)col;
#pragma unroll
                for (int e = 0; e < 8; ++e) c[e] = c[e] + (p[e] - c[e]) * LF(Z_PAR)[448 + ((i < 4) ? 64 * i : 256 + 64 * (i - 4)) + 8 * part + e];
                if (i == 0) { st8f(LF(X_RF) + tok * 64 + 8 * part, c);
                } else if (i == 1) { st8f(LF(X_KF) + tok * 64 + 8 * part, c);
                } else if (i == 2) {
#pragma unroll
                    for (int e = 0; e < 8; ++e) c[e] = fast_tanh(c[e]);
                    *(LAS u32x4*)(LB(X_TW) + tok * PT + 8 * part) = pack8(c);
                } else if (i == 3) {
                    *(LAS u32x4*)(LB(X_XA) + tok * PT + 8 * part) = pack8(c);
                } else if (FINAL) {
#pragma unroll
                    for (int e = 0; e < 8; ++e) c[e] = sigm(c[e]);
                    *(LAS u32x4*)(LB(X_SG) + tok * PT2 + 8 * part + (i - 4) * 64) = pack8(c);
                }
            }
            float v[8]; unpack8(pfv, v); (void)m; (void)cur;
            st8f(LF(Y_VF) + tok * 64 + 8 * part, v);
        }
        if (j < 3) RW_PREFETCH(j + 1);
        __syncthreads();
        { IDS();
        if (w < 4) {
            const int rb = w;
            float inv[4], bs[4] = {0.f, 0.f, 0.f, 0.f};
            { float ss[4] = {0.f, 0.f, 0.f, 0.f};
#pragma unroll
                for (int nt = 0; nt < 4; ++nt) { const int c = 16 * nt + r16; const float kkc = LF(Z_PAR)[128 + c];
#pragma unroll
                    for (int jj = 0; jj < 4; ++jj) { const float kk = LF(X_KF)[(16 * rb + 4 * q4 + jj) * 64 + c] * kkc; ss[jj] += kk * kk; } }
#pragma unroll
                for (int jj = 0; jj < 4; ++jj) inv[jj] = __builtin_amdgcn_rsqf(fmaxf(redl16(ss[jj]), 1e-24f)); }
#pragma unroll
            for (int nt = 0; nt < 4; ++nt) {
                f32x4 aw = FZ4, aa = FZ4;
#pragma unroll
                for (int k2 = 0; k2 < 2; ++k2) { aw = mfma16(*(const LAS bf16x8*)(LB(X_TW) + (16 * rb + r16) * PT + 32 * k2 + 8 * q4), lfr[nt * 4 + k2], aw); aa = mfma16(*(const LAS bf16x8*)(LB(X_XA) + (16 * rb + r16) * PT + 32 * k2 + 8 * q4), lfr[nt * 4 + 2 + k2], aa); }
                const int c = 16 * nt + r16; const float w0c = LF(Z_PAR)[c], a0c = LF(Z_PAR)[64 + c], kkc = LF(Z_PAR)[128 + c], kac = LF(Z_PAR)[192 + c], rkc = LF(Z_PAR)[256 + c];
#pragma unroll
                for (int jj = 0; jj < 4; ++jj) { const int t = 16 * rb + 4 * q4 + jj, o = t * 64 + c;
                    LF(Y_L)[o] = -0.8750455979f * sigm(w0c + aw[jj]);
                    const float al = sigm(a0c + aa[jj]), kraw = LF(X_KF)[o], rr = LF(X_RF)[o], kn = kraw * kkc * inv[jj];
                    const float knew = kraw * (1.f + (al - 1.f) * kac);
                    LB(Y_A)[o] = (bf16)f2bf(-kn); LB(Y_B)[o] = (bf16)f2bf(kn * al); LB(Y_K)[o] = (bf16)f2bf(knew); LB(Y_R)[o] = (bf16)f2bf(rr);
                    bs[jj] += rr * knew * rkc; } }
#pragma unroll
            for (int jj = 0; jj < 4; ++jj) { const float sm = redl16(bs[jj]); if (r16 == 0) LF(Z_BON)[16 * rb + 4 * q4 + jj] = sm; }
        } else if (FINAL) {
            const int rb = w - 4;
#pragma unroll
            for (int nt = 0; nt < 4; ++nt) { f32x4 ag = FZ4;
#pragma unroll
                for (int k4 = 0; k4 < 4; ++k4) ag = mfma16(*(const LAS bf16x8*)(LB(X_SG) + (16 * rb + r16) * PT2 + 32 * k4 + 8 * q4), lfr[nt * 4 + k4], ag);
#pragma unroll
                for (int jj = 0; jj < 4; ++jj) LB(Z_G)[(16 * rb + 4 * q4 + jj) * 64 + 16 * nt + r16] = (bf16)f2bf(ag[jj]); }
        } }
        __syncthreads();
        if (w == 0) { IDS(); float run = 0.f;
#pragma unroll 8
            for (int t = 0; t < 64; ++t) { run += LF(Y_L)[t * 64 + lane]; LF(Y_L)[t * 64 + lane] = run; }
            LF(Z_PC)[lane] = ex2(run); }
        __syncthreads();
        {
            IDS(); const int t = tok, c0 = 8 * part;
            float Lt[8], Lp[8], Le[8], av[8], bv[8], kv[8], rv[8], vv[8], at[8], rt[8], bt[8], kt[8], bh[8], kh[8];
            ld8f(LF(Y_L) + t * 64 + c0, Lt); ld8f(LF(Y_L) + 63 * 64 + c0, Le); ld8f(LF(Y_VF) + t * 64 + c0, vv);
            if (t > 0) ld8f(LF(Y_L) + (t - 1) * 64 + c0, Lp); else {
#pragma unroll
                for (int e = 0; e < 8; ++e) Lp[e] = 0.f; }
            unpack8(*(const LAS u32x4*)(LB(Y_A) + t * 64 + c0), av); unpack8(*(const LAS u32x4*)(LB(Y_B) + t * 64 + c0), bv);
            unpack8(*(const LAS u32x4*)(LB(Y_K) + t * 64 + c0), kv); unpack8(*(const LAS u32x4*)(LB(Y_R) + t * 64 + c0), rv);
#pragma unroll
            for (int e = 0; e < 8; ++e) { const float eL = ex2(Lt[e]), eLm = ex2(Lp[e]), eN = ex2(-Lt[e]), eE = ex2(Le[e] - Lt[e]);
                at[e] = av[e] * eLm; rt[e] = rv[e] * eL; bt[e] = bv[e] * eN; kt[e] = kv[e] * eN; bh[e] = bv[e] * eE; kh[e] = kv[e] * eE; }
            tr_write8(LB(O_BH), PT, c0, t, bh, part); tr_write8(LB(O_KH), PT, c0, t, kh, part); tr_write8(LB(O_VT), PT, c0, t, vv, part);
            *(LAS u32x4*)(LB(O_AT) + t * PT + c0) = pack8(at); *(LAS u32x4*)(LB(O_RT) + t * PT + c0) = pack8(rt);
            *(LAS u32x4*)(LB(O_BT) + t * PT + c0) = pack8(bt); *(LAS u32x4*)(LB(O_KT) + t * PT + c0) = pack8(kt);
        }
        __syncthreads();
        {
            IDS(); const int rb = w & 3;
#pragma unroll
            for (int ci = 0; ci < 2; ++ci) { const int ct = 2 * (w >> 2) + ci;
                f32x4 ab = FZ4, ak = FZ4, arb = FZ4, ark = FZ4;
                if (ct <= rb) { ab = mm_ll<64>(LB(O_AT), PT, 16 * rb, LB(O_BT), PT, 16 * ct, FZ4, lane); ak = mm_ll<64>(LB(O_AT), PT, 16 * rb, LB(O_KT), PT, 16 * ct, FZ4, lane);
                    if (FINAL) { arb = mm_ll<64>(LB(O_RT), PT, 16 * rb, LB(O_BT), PT, 16 * ct, FZ4, lane); ark = mm_ll<64>(LB(O_RT), PT, 16 * rb, LB(O_KT), PT, 16 * ct, FZ4, lane); } }
#pragma unroll
                for (int jj = 0; jj < 4; ++jj) { const int t = 16 * rb + 4 * q4 + jj, i = 16 * ct + r16;
                    LF(Y_AAB)[t * PF + i] = (i < t) ? ab[jj] : 0.f; LB(Y_TB)[t * PT + i] = (bf16)f2bf(((i >> 4) < (t >> 4)) ? ab[jj] : 0.f); LB(Y_AAK)[t * PT + i] = (bf16)f2bf((i < t) ? ak[jj] : 0.f);
                    if (FINAL) { LB(Y_ARB)[t * PT + i] = (bf16)f2bf((i <= t) ? arb[jj] : 0.f); LB(Y_ARK)[t * PT + i] = (bf16)f2bf((i <= t) ? ark[jj] : 0.f); } } }
        }
        __syncthreads();
        {
            IDS(); const int rb = w & 3;
            constexpr int O_DB = O_BT, O_VB = O_BT + 5120;
            if (w == 0) { const int blk = lane >> 4, col = lane & 15; float x[16];
#pragma unroll
                for (int i = 0; i < 16; ++i) x[i] = (i == col) ? 1.f : 0.f;
#pragma unroll
                for (int g3 = 0; g3 < 3; ++g3) {
                    f32x4 ar[5][4];
#pragma unroll
                    for (int ii = 0; ii < 5; ++ii) { const int i = 1 + 5 * g3 + ii;
#pragma unroll
                        for (int g4 = 0; g4 < 4; ++g4) if (4 * g4 < i) ar[ii][g4] = *(const LAS f32x4*)(LF(Y_AAB) + (16 * blk + i) * PF + 16 * blk + 4 * g4); }
                    asm volatile("" ::: "memory");
#pragma unroll
                    for (int ii = 0; ii < 5; ++ii) { const int i = 1 + 5 * g3 + ii; float sacc = 0.f;
#pragma unroll
                        for (int m2 = 0; m2 < i; ++m2) sacc += ar[ii][m2 >> 2][m2 & 3] * x[m2];
                        x[i] += sacc; }
                }
#pragma unroll
                for (int i = 0; i < 16; ++i) LB(O_DB)[(16 * blk + i) * 40 + col] = (bf16)f2bf(x[i]);
                *(LAS u32x4*)(LB(O_DB) + lane * 40 + 16) = (u32x4){0u, 0u, 0u, 0u}; *(LAS u32x4*)(LB(O_DB) + lane * 40 + 24) = (u32x4){0u, 0u, 0u, 0u}; }
            if (lane < 16) { *(LAS u32x4*)(LB(O_VB) + w * 640 + lane * 40 + 16) = (u32x4){0u, 0u, 0u, 0u}; *(LAS u32x4*)(LB(O_VB) + w * 640 + lane * 40 + 24) = (u32x4){0u, 0u, 0u, 0u}; }
#pragma unroll
            for (int ci = 0; ci < NZ; ++ci) { const int vt = (w >> 2) * NZ + ci;
                f32x4 z = mm_ll<64>(LB(O_AT), PT, 16 * rb, LB(Z_S), PT, 16 * vt, FZ4, lane);
                if (vt < 4) z = mm_ll<64, false, true>(LB(Y_AAK), PT, 16 * rb, LB(O_VT), PT, 16 * vt, z, lane);
                st4bf(LB(Y_ZU) + (16 * vt + r16) * PT + 16 * rb + 4 * q4, z); }
            __syncthreads();
            if (w < NVT) { const int vt = w; LAS bf16* vb = LB(O_VB) + w * 640; LAS bf16* zrow = LB(Y_ZU) + (16 * vt + r16) * PT;
#pragma unroll
                for (int bb = 0; bb < 4; ++bb) {
                    f32x4 acc; { const u32x2 zz = *(const LAS u32x2*)(zrow + 16 * bb + 4 * q4); acc[0] = bflo(zz.x); acc[1] = bfhi(zz.x); acc[2] = bflo(zz.y); acc[3] = bfhi(zz.y); }
                    if (bb >= 1) acc = mfma16(*(const LAS bf16x8*)(LB(Y_TB) + (16 * bb + r16) * PT + 8 * q4), *(const LAS bf16x8*)(zrow + 8 * q4), acc);
                    if (bb >= 3) acc = mfma16(*(const LAS bf16x8*)(LB(Y_TB) + (16 * bb + r16) * PT + 32 + 8 * q4), *(const LAS bf16x8*)(zrow + 32 + 8 * q4), acc);
                    st4bf(vb + r16 * 40 + 4 * q4, acc);
                    const f32x4 ub = mfma16(*(const LAS bf16x8*)(LB(O_DB) + (16 * bb + r16) * 40 + 8 * q4), *(const LAS bf16x8*)(vb + r16 * 40 + 8 * q4), FZ4);
                    st4bf(zrow + 16 * bb + 4 * q4, ub); }
            }
        }
        __syncthreads();
        {
            IDS(); f32x4 yy[2];
            if (FINAL) { const int rb = w & 3;
#pragma unroll
                for (int ci = 0; ci < 2; ++ci) { const int ct = 2 * (w >> 2) + ci;
                    f32x4 y = mm_ll<64>(LB(O_RT), PT, 16 * rb, LB(Z_S), PT, 16 * ct, FZ4, lane);
                    y = mm_ll<64>(LB(Y_ARB), PT, 16 * rb, LB(Y_ZU), PT, 16 * ct, y, lane);
                    yy[ci] = mm_ll<64, false, true>(LB(Y_ARK), PT, 16 * rb, LB(O_VT), PT, 16 * ct, y, lane); } }
#pragma unroll
            for (int ti = 0; ti < NST; ++ti) { const int ct = S_CT(ti); const float pc = LF(Z_PC)[16 * ct + r16];
                f32x4 s = Sacc[ti] * pc;
                s = mm_ll<64, false, true>(LB(Y_ZU), PT, 16 * s_vb, LB(O_BH), PT, 16 * ct, s, lane);
                if (s_vb < 4) s = mm_ll<64, true, true>(LB(O_VT), PT, 16 * s_vb, LB(O_KH), PT, 16 * ct, s, lane);
                Sacc[ti] = s; }
            __syncthreads();
#pragma unroll
            for (int ti = 0; ti < NST; ++ti) { const int ct = S_CT(ti);
#pragma unroll
                for (int jj = 0; jj < 4; ++jj) LB(Z_S)[(16 * s_vb + 4 * q4 + jj) * PT + 16 * ct + r16] = (bf16)f2bf(Sacc[ti][jj]); }
            if (FINAL) { const int rb = w & 3;
#pragma unroll
                for (int ci = 0; ci < 2; ++ci) { const int ct = 2 * (w >> 2) + ci;
#pragma unroll
                    for (int jj = 0; jj < 4; ++jj) LF(Y_YF)[(16 * rb + 4 * q4 + jj) * PF + 16 * ct + r16] = yy[ci][jj]; } }
        }
        __syncthreads();
        if (FINAL) {
            IDS();
            const int t = tok, c0 = 8 * part; const size_t m = (size_t)b * T + tl0 + t;
            float y[8], gg[8], sm = 0.f; ld8f(LF(Y_YF) + t * PF + c0, y); unpack8(*(const LAS u32x4*)(LB(Z_G) + t * 64 + c0), gg);
#pragma unroll
            for (int e = 0; e < 8; ++e) sm += y[e];
            const float mean = red8(sm) * (1.f / 64.f); float vs = 0.f;
#pragma unroll
            for (int e = 0; e < 8; ++e) { y[e] -= mean; vs += y[e] * y[e]; }
            const float rs = __builtin_amdgcn_rsqf(red8(vs) * (1.f / 64.f) + 64e-5f), bo = LF(Z_BON)[t];
#pragma unroll
            for (int e = 0; e < 8; ++e) { const int c = c0 + e; y[e] = (y[e] * rs * LF(Z_PAR)[320 + c] + LF(Z_PAR)[384 + c] + bo * tr_at(LB(O_VT), PT, c, t)) * gg[e]; }
            *(u32x4*)((bf16*)(F.ws + WS_BIG) + m * PLD + 1024 + h * 64 + c0) = pack8(y);
        }
        __syncthreads();
    }
    if (!FINAL) { IDS();
#pragma unroll
        for (int ti = 0; ti < NST; ++ti) { const int ct = S_CT(ti);
            if (s_vb < 4) {
#pragma unroll
                for (int jj = 0; jj < 4; ++jj) Nbuf[(16 * s_vb + 4 * q4 + jj) * 64 + 16 * ct + r16] = Sacc[ti][jj];
            } else { u32x2 wv; wv.x = pk2(Sacc[ti][0], Sacc[ti][1]); wv.y = pk2(Sacc[ti][2], Sacc[ti][3]);
                *(u32x2*)(MT + (16 * ct + r16) * 64 + 16 * (s_vb - 4) + 4 * q4) = wv; }
        }
    }
#undef RW_PREFETCH
#undef IDS
#undef S_CT
#undef LB
#undef LF
}

template <bool FINAL>
__device__ __forceinline__ void ret_chunk_unit(Frame& F, int u) {
    const int tid = otid(), lane = tid & 63, w = __builtin_amdgcn_readfirstlane(tid >> 6), r16 = lane & 15, q4 = lane >> 4;
    const int b = u >> 9, sc = (u >> 3) & 63, h = u & 7;
    constexpr int R_QB = 0, R_KB = 9216, R_KHT = 18432, R_VT = 27648, R_GB = 36864, R_AB = 45056, R_SB = 54272, R_YF = 63488;
    LAS unsigned char* L = F.lds;
#define LB(off) ((LAS bf16*)(L + (off)))
#define LF(off) ((LAS float*)(L + (off)))
    bf16* P = (bf16*)(F.ws + WS_BIG);
    float* Sbuf = (float*)(F.st + 16 * MiB) + (size_t)u * 4096;
    const float lg = log2f(1.f - exp2f(-5.f - (float)h));
    const float g64 = ex2(64.f * lg);
    const int db = w & 3;
    f32x4 Sacc[2];
#pragma unroll
    for (int ci = 0; ci < 2; ++ci) { const int et = 2 * (w >> 2) + ci;
#pragma unroll
        for (int jj = 0; jj < 4; ++jj) Sacc[ci][jj] = FINAL ? Sbuf[(16 * db + 4 * q4 + jj) * 64 + 16 * et + r16] : 0.f;
        if (FINAL) st4bf(LB(R_SB) + (16 * et + r16) * PT + 16 * db + 4 * q4, Sacc[ci]); }
    const int tok = tid >> 3, part = tid & 7;
    for (int j = 0; j < 4; ++j) {
        const int tl0 = sc * 256 + j * 64;
        {
            const int t = tl0 + tok; const size_t m = (size_t)b * T + t; const bf16* row = P + m * PLD + C_RET + h * 64 + 8 * part;
            float qv[8], kv[8], vv[8]; unpack8(*(const u32x4*)(row + 512), kv); unpack8(*(const u32x4*)(row + 1024), vv);
            if (FINAL) { unpack8(*(const u32x4*)row, qv); *(LAS u32x4*)(LB(R_GB) + tok * 64 + 8 * part) = *(const u32x4*)(row + 1536); }
            const float zeta = ex2((float)(63 - tok) * lg);
            if (FINAL) { *(LAS u32x4*)(LB(R_QB) + tok * PT + 8 * part) = pack8(qv); *(LAS u32x4*)(LB(R_KB) + tok * PT + 8 * part) = pack8(kv); }
            float kz[8];
#pragma unroll
            for (int e = 0; e < 8; ++e) kz[e] = kv[e] * zeta;
            tr_write8(LB(R_KHT), PT, 8 * part, tok, kz, part); tr_write8(LB(R_VT), PT, 8 * part, tok, vv, part);
        }
        __syncthreads();
        if (FINAL) { const int rb = w & 3;
#pragma unroll
            for (int ci = 0; ci < 2; ++ci) { const int ct = 2 * (w >> 2) + ci; f32x4 a = FZ4;
                if (ct <= rb) a = mm_ll<64>(LB(R_QB), PT, 16 * rb, LB(R_KB), PT, 16 * ct, FZ4, lane);
#pragma unroll
                for (int jj = 0; jj < 4; ++jj) { const int l = 16 * rb + 4 * q4 + jj, s = 16 * ct + r16; LB(R_AB)[l * PT + s] = (bf16)f2bf((s <= l) ? a[jj] * ex2((float)(l - s) * lg) : 0.f); } }
            __syncthreads();
        }
        {
            f32x4 yy[2];
            if (FINAL) { const int rb = w & 3;
#pragma unroll
                for (int ci = 0; ci < 2; ++ci) { const int et = 2 * (w >> 2) + ci;
                    const f32x4 a1 = mm_ll<64, false, true>(LB(R_AB), PT, 16 * rb, LB(R_VT), PT, 16 * et, FZ4, lane), a2 = mm_ll<64>(LB(R_QB), PT, 16 * rb, LB(R_SB), PT, 16 * et, FZ4, lane);
#pragma unroll
                    for (int jj = 0; jj < 4; ++jj) yy[ci][jj] = a1[jj] + ex2((float)(16 * rb + 4 * q4 + jj + 1) * lg) * a2[jj]; } }
#pragma unroll
            for (int ci = 0; ci < 2; ++ci) { const int et = 2 * (w >> 2) + ci; Sacc[ci] = mm_ll<64, true, true>(LB(R_KHT), PT, 16 * db, LB(R_VT), PT, 16 * et, Sacc[ci] * g64, lane); }
            __syncthreads();
            if (FINAL) { const int rb = w & 3;
#pragma unroll
                for (int ci = 0; ci < 2; ++ci) { const int et = 2 * (w >> 2) + ci; st4bf(LB(R_SB) + (16 * et + r16) * PT + 16 * db + 4 * q4, Sacc[ci]);
#pragma unroll
                    for (int jj = 0; jj < 4; ++jj) LF(R_YF)[(16 * rb + 4 * q4 + jj) * PF + 16 * et + r16] = yy[ci][jj]; } }
        }
        __syncthreads();
        if (FINAL) { const size_t m = (size_t)b * T + tl0 + tok; float y[8], g[8], ss = 0.f;
            ld8f(LF(R_YF) + tok * PF + 8 * part, y);
#pragma unroll
            for (int e = 0; e < 8; ++e) ss += y[e] * y[e];
            const float rs = __builtin_amdgcn_rsqf(red8(ss) * (1.f / 64.f) + 1e-6f);
            unpack8(*(const LAS u32x4*)(LB(R_GB) + tok * 64 + 8 * part), g);
#pragma unroll
            for (int e = 0; e < 8; ++e) y[e] = y[e] * rs * silu(g[e]);
            *(u32x4*)(P + m * PLD + C_RETG + h * 64 + 8 * part) = pack8(y);
            __syncthreads(); }
    }
    if (!FINAL) {
#pragma unroll
        for (int ci = 0; ci < 2; ++ci) { const int et = 2 * (w >> 2) + ci;
#pragma unroll
            for (int jj = 0; jj < 4; ++jj) Sbuf[(16 * db + 4 * q4 + jj) * 64 + 16 * et + r16] = Sacc[ci][jj]; }
    }
#undef LB
#undef LF
}

template <bool FINAL>
__device__ __forceinline__ void ssd_chunk_unit(Frame& F, int layer, int u) {
    const int tid = otid(), w = __builtin_amdgcn_readfirstlane(tid >> 6);
#define IDS() const int ft = fresh_tid(tid); const int lane = ft & 63, r16 = lane & 15, q4 = lane >> 4; (void)lane; (void)r16; (void)q4
    const int b = u >> 9, sc = (u >> 3) & 63, h = u & 7, g = h >> 2;
    constexpr int D_CB = 0, D_BB = 17408, D_BT = 34816, D_YF = 53248, D_XT = 70656, D_XDT = 79872, D_GM = 89088, D_SB = 98304, D_MISC = 115712;
    constexpr int D_DTS = D_MISC, D_ACS = D_MISC + 256, D_CAR = D_MISC + 512;
    LAS unsigned char* L = F.lds;
#define LB(off) ((LAS bf16*)(L + (off)))
#define LF(off) ((LAS float*)(L + (off)))
    bf16* P = (bf16*)(F.ws + WS_BIG); const float* dtb = (const float*)(F.ws + WS_DT);
    const bf16* BND = (const bf16*)(F.ws + WS_BND);
    float* Sbuf = (float*)(F.st + 32 * MiB) + (size_t)u * 8192;
    const float* cw = INP(17) + layer * 1024 * 4; const float* cbias = INP(18) + layer * 1024;
    const float dt_bias = INP(19)[layer * 8 + h], A = -expf(INP(20)[layer * 8 + h]), Dh = INP(21)[layer * 8 + h];
    const int bc_chunk = tid & 31, bc_chn = (bc_chunk < 16) ? (512 + g * 128 + bc_chunk * 8) : (768 + g * 128 + (bc_chunk - 16) * 8);
    const int x_chunk = tid & 7, x_chn = h * 64 + x_chunk * 8;
    const int pb = w & 3;
    f32x4 Sacc[4];
    { IDS();
#pragma unroll
    for (int ci = 0; ci < 4; ++ci) { const int nt = 4 * (w >> 2) + ci;
#pragma unroll
        for (int jj = 0; jj < 4; ++jj) { const float x = FINAL ? Sbuf[(16 * pb + 4 * q4 + jj) * 128 + 16 * nt + r16] : 0.f; Sacc[ci][jj] = x;
            if (FINAL) LB(D_SB)[(16 * pb + 4 * q4 + jj) * PT2 + 16 * nt + r16] = (bf16)f2bf(x); } } }
    float dstot = 0.f;
    for (int j = 0; j < 4; ++j) {
        const int tl0 = sc * 256 + j * 64; const size_t m0 = (size_t)b * T + tl0;
        if (w == 0) {
            IDS(); const float dt = softplus_acc(dtb[(m0 + lane) * 8 + h] + dt_bias); float a = A * dt;
#pragma unroll
            for (int o = 1; o < 64; o <<= 1) { const float n = __shfl_up(a, o); if (lane >= o) a += n; }
            LF(D_DTS)[lane] = dt; LF(D_ACS)[lane] = a;
        }
        {
            IDS();
#pragma unroll
            for (int it = 0; it < 4; ++it) { const int t = it * 16 + (ft >> 5); const int ta = tl0 + t;
                float acc[8]; unpack8(*(const u32x4*)(P + (m0 + t) * PLD + C_XBC + bc_chn), acc); (void)ta;
                if (bc_chunk < 16) { *(LAS u32x4*)(LB(D_BB) + t * PT2 + bc_chunk * 8) = pack8(acc); tr_write8(LB(D_BT), PT, bc_chunk * 8, t, acc, bc_chunk & 7); }
                else *(LAS u32x4*)(LB(D_CB) + t * PT2 + (bc_chunk - 16) * 8) = pack8(acc);
            }
        }
        __syncthreads();
        {
            IDS(); const int t = ft >> 3; float acc[8]; unpack8(*(const u32x4*)(P + (m0 + t) * PLD + C_XBC + x_chn), acc);
            const float sc_d = LF(D_DTS)[t] * __expf(LF(D_ACS)[63] - LF(D_ACS)[t]);
            float xs8[8], xd8[8];
#pragma unroll
            for (int e = 0; e < 8; ++e) { xs8[e] = acc[e]; xd8[e] = acc[e] * sc_d; }
            tr_write8(LB(D_XT), PT, x_chunk * 8, t, xs8, x_chunk); tr_write8(LB(D_XDT), PT, x_chunk * 8, t, xd8, x_chunk);
        }
        if (FINAL) { IDS(); const int rb = w & 3;
#pragma unroll
            for (int ci = 0; ci < 2; ++ci) { const int ct = 2 * (w >> 2) + ci; f32x4 a = FZ4;
                if (ct <= rb) a = mm_ll<128>(LB(D_CB), PT2, 16 * rb, LB(D_BB), PT2, 16 * ct, FZ4, lane);
#pragma unroll
                for (int jj = 0; jj < 4; ++jj) { const int l = 16 * rb + 4 * q4 + jj, s = 16 * ct + r16;
                    LB(D_GM)[l * PT + s] = (bf16)f2bf((s <= l) ? a[jj] * __expf(LF(D_ACS)[l] - LF(D_ACS)[s]) * LF(D_DTS)[s] : 0.f); } } }
        __syncthreads();
        {
            IDS(); f32x4 yy[2];
            if (FINAL) { const int rb = w & 3;
#pragma unroll
                for (int ci = 0; ci < 2; ++ci) { const int pt = 2 * (w >> 2) + ci;
                    const f32x4 a1 = mm_ll<64, false, true>(LB(D_GM), PT, 16 * rb, LB(D_XT), PT, 16 * pt, FZ4, lane), a2 = mm_ll<128>(LB(D_CB), PT2, 16 * rb, LB(D_SB), PT2, 16 * pt, FZ4, lane);
#pragma unroll
                    for (int jj = 0; jj < 4; ++jj) { const int l = 16 * rb + 4 * q4 + jj, p = 16 * pt + r16; yy[ci][jj] = a1[jj] + __expf(LF(D_ACS)[l]) * a2[jj] + Dh * tr_at(LB(D_XT), PT, p, l); } } }
            const float dec = expf(LF(D_ACS)[63]);
#pragma unroll
            for (int ci = 0; ci < 4; ++ci) { const int nt = 4 * (w >> 2) + ci; Sacc[ci] = mm_ll<64, true, true>(LB(D_XDT), PT, 16 * pb, LB(D_BT), PT, 16 * nt, Sacc[ci] * dec, lane); }
            dstot += LF(D_ACS)[63];
            __syncthreads();
            if (FINAL) { const int rb = w & 3;
#pragma unroll
                for (int ci = 0; ci < 4; ++ci) { const int nt = 4 * (w >> 2) + ci;
#pragma unroll
                    for (int jj = 0; jj < 4; ++jj) LB(D_SB)[(16 * pb + 4 * q4 + jj) * PT2 + 16 * nt + r16] = (bf16)f2bf(Sacc[ci][jj]); }
#pragma unroll
                for (int ci = 0; ci < 2; ++ci) { const int pt = 2 * (w >> 2) + ci;
#pragma unroll
                    for (int jj = 0; jj < 4; ++jj) LF(D_YF)[(16 * rb + 4 * q4 + jj) * PF + 16 * pt + r16] = yy[ci][jj]; } }
        }
        __syncthreads();
        if (FINAL) { IDS(); const int tok = ft >> 3, part = ft & 7; float y[8];
            ld8f(LF(D_YF) + tok * PF + 8 * part, y);
            *(u32x4*)(P + (m0 + tok) * PLD + C_XBC + h * 64 + 8 * part) = pack8(y);
            __syncthreads(); }
    }
    if (!FINAL) { IDS();
#pragma unroll
        for (int ci = 0; ci < 4; ++ci) { const int nt = 4 * (w >> 2) + ci;
#pragma unroll
            for (int jj = 0; jj < 4; ++jj) Sbuf[(16 * pb + 4 * q4 + jj) * 128 + 16 * nt + r16] = Sacc[ci][jj]; }
        if (tid == 0) ((float*)(F.ws + WS_DSTOT))[u] = dstot;
    }
#undef IDS
#undef LB
#undef LF
}

__device__ __forceinline__ void rwkv_scan_chain(Frame& F, int chain) {
    const int tid = otid(), lane = tid & 63, w = __builtin_amdgcn_readfirstlane(tid >> 6), r16 = lane & 15, q4 = lane >> 4;
    const int b = chain >> 3, h = chain & 7, vb = w & 3, ct0 = 2 * (w >> 2);
    LAS bf16* SB = (LAS bf16*)F.lds;
    f32x4 Sacc[2] = {FZ4, FZ4};
    for (int i = tid; i < 64 * PT / 2; i += 512) ((LAS unsigned*)SB)[i] = 0u;
    f32x4 nv[2]; bf16x8 mf[2][2];
    auto fetch = [&](int sc) {
        const int u = (b * 64 + sc) * 8 + h;
        const float* Nb = (const float*)(F.st + 0) + (size_t)u * 4096; const bf16* MT = (const bf16*)(F.ws + WS_MT) + (size_t)u * 4096;
#pragma unroll
        for (int ci = 0; ci < 2; ++ci) {
#pragma unroll
            for (int jj = 0; jj < 4; ++jj) nv[ci][jj] = Nb[(16 * vb + 4 * q4 + jj) * 64 + 16 * (ct0 + ci) + r16];
#pragma unroll
            for (int k2 = 0; k2 < 2; ++k2) mf[ci][k2] = *(const bf16x8*)(MT + (size_t)(16 * (ct0 + ci) + r16) * 64 + 32 * k2 + 8 * q4); } };
    fetch(0);
    __syncthreads();
    for (int sc = 0; sc < 64; ++sc) {
        const int u = (b * 64 + sc) * 8 + h;
        float* Nb = (float*)(F.st + 0) + (size_t)u * 4096;
        f32x4 nw[2];
#pragma unroll
        for (int ci = 0; ci < 2; ++ci) {
            f32x4 a = nv[ci];
#pragma unroll
            for (int k2 = 0; k2 < 2; ++k2) a = mfma16(*(const LAS bf16x8*)(SB + (16 * vb + r16) * PT + 32 * k2 + 8 * q4), mf[ci][k2], a);
            nw[ci] = a;
#pragma unroll
            for (int jj = 0; jj < 4; ++jj) Nb[(16 * vb + 4 * q4 + jj) * 64 + 16 * (ct0 + ci) + r16] = Sacc[ci][jj]; }
        if (sc + 1 < 64) fetch(sc + 1);
        __syncthreads();
#pragma unroll
        for (int ci = 0; ci < 2; ++ci) { Sacc[ci] = nw[ci];
#pragma unroll
            for (int jj = 0; jj < 4; ++jj) SB[(16 * vb + 4 * q4 + jj) * PT + 16 * (ct0 + ci) + r16] = (bf16)f2bf(nw[ci][jj]); }
        __syncthreads();
    }
}
__device__ __forceinline__ void elem_scans(Frame& F, int blk, int nblk) {
    const int tid = otid();
    const int NRET = 16 * 4096, NSSD = 16 * 8192;
    const float* dst = (const float*)(F.ws + WS_DSTOT);
    for (int it = blk * 512 + tid; it < NRET + NSSD; it += nblk * 512) {
        if (it < NRET) { const int chain = it >> 12, e = it & 4095, b = chain >> 3, h = chain & 7;
            const float g256 = exp2f(256.f * log2f(1.f - exp2f(-5.f - (float)h)));
            float* p = (float*)(F.st + 16 * MiB) + ((size_t)(b * 64) * 8 + h) * 4096 + e; float carry = 0.f;
#pragma unroll 8
            for (int sc = 0; sc < 64; ++sc) { const float t = p[(size_t)sc * 8 * 4096]; p[(size_t)sc * 8 * 4096] = carry; carry = g256 * carry + t; }
        } else { const int i2 = it - NRET, chain = i2 >> 13, e = i2 & 8191, b = chain >> 3, h = chain & 7;
            float* p = (float*)(F.st + 32 * MiB) + ((size_t)(b * 64) * 8 + h) * 8192 + e; const float* d = dst + (b * 64) * 8 + h; float carry = 0.f;
#pragma unroll 8
            for (int sc = 0; sc < 64; ++sc) { const float t = p[(size_t)sc * 8 * 8192]; p[(size_t)sc * 8 * 8192] = carry; carry = expf(d[sc * 8]) * carry + t; }
        }
    }
}
__device__ __forceinline__ void conv_lora(Frame& F) {
    const int tid = otid();
    for (int l = 0; l < 2; ++l) {
        bf16* base = (bf16*)(F.ws + WS_LORA + (size_t)l * LORA_STRIDE);
        const float* wu = INP(4) + l * 64 * 512; const float* au = INP(6) + l * 64 * 512; const float* gu = INP(8) + l * 128 * 512;
        for (int i = F.vcu * 512 + tid; i < 512 * 64; i += F.G * 512) { const int c = i >> 6, jx = i & 63; base[i] = (bf16)f2bf(wu[jx * 512 + c]); base[32768 + i] = (bf16)f2bf(au[jx * 512 + c]); }
        for (int i = F.vcu * 512 + tid; i < 512 * 128; i += F.G * 512) { const int c = i >> 7, jx = i & 127; base[65536 + i] = (bf16)f2bf(gu[jx * 512 + c]); }
    }
}
__device__ __forceinline__ void conv_vlora(Frame& F) {
    const int tid = otid();
    bf16* vdT = (bf16*)(F.ws + WS_VLORA); bf16* vuT = vdT + 32 * 512;
    const float* vdn = INP(14); const float* vup = INP(15);
    for (int i = F.vcu * 512 + tid; i < 32 * 512; i += F.G * 512) { const int j = i >> 9, c = i & 511; vdT[i] = (bf16)f2bf(vdn[c * 32 + j]); }
    for (int i = F.vcu * 512 + tid; i < 512 * 32; i += F.G * 512) { const int c = i >> 5, j = i & 31; vuT[i] = (bf16)f2bf(vup[j * 512 + c]); }
}
__device__ __forceinline__ void save_bnd(Frame& F) {
    const int tid = otid();
    const bf16* P = (const bf16*)(F.ws + WS_BIG); bf16* BND = (bf16*)(F.ws + WS_BND);
    for (int i = F.vcu * 512 + tid; i < 2 * 64 * 3 * 64; i += F.G * 512) { const int ch = i & 63, k = (i >> 6) % 3, bs = i / 192, b = bs >> 6, sc = bs & 63;
        if (sc > 0) *(u32x4*)(BND + (size_t)(bs * 3 + k) * 512 + ch * 8) = *(const u32x4*)(P + ((size_t)b * T + sc * 256 - 3 + k) * PLD + C_XBC + ch * 8); }
}

constexpr int LAYER_BASE0 = 1, LAYER_STRIDE = 18, MOE_BASE = LAYER_BASE0 + LAYER_STRIDE + 15;
__device__ __forceinline__ Frame lf(const Frame& F0) {
    Frame F = F0; unsigned l = (unsigned)(unsigned long long)F.lds;
    asm volatile("" : "+s"(l), "+s"(F.vcu), "+s"(F.G), "+s"(F.cid), "+s"(F.wid), "+s"(F.out), "+s"(F.ws), "+s"(F.st));
    F.lds = (LAS unsigned char*)(unsigned long long)l; return F;
}
__global__ void __launch_bounds__(512, 2) fwd(Args args) {
    extern __shared__ __attribute__((aligned(16))) unsigned char lds_raw[];
    Frame F0;
    F0.lds = (LAS unsigned char*)lds_raw;
    F0.G = gridDim.x; { const int bx = blockIdx.x; F0.vcu = (F0.G % 8 == 0) ? (bx % 8) * (F0.G / 8) + bx / 8 : bx; }
    F0.cid = blockIdx.x; F0.out = args.out; F0.ws = args.ws; F0.wid = __builtin_amdgcn_readfirstlane(threadIdx.x >> 6); F0.st = args.ws + WS_XB;
    volatile LAS unsigned* MISC = (volatile LAS unsigned*)(F0.lds + MISC_OFF);
    for (int u = threadIdx.x; u < (LDS_BYTES - LDSCTL_OFF) / 4; u += 512) ((LAS unsigned*)(F0.lds + LDSCTL_OFF))[u] = 0u;
    __syncthreads();
    if (threadIdx.x < 34) *(LAS unsigned long long*)(F0.lds + LDSCTL_OFF + 8 * threadIdx.x) = (unsigned long long)args.in[threadIdx.x];
    __syncthreads();
    const int lo = args.ph_lo, hi = args.ph_hi;
    XcdBarrier bar; bar.bar = (unsigned*)(F0.ws + WS_CTL); bar.x = 0; bar.st = nullptr;
    if (hi - lo > 1) bar = xcd_barrier_post((unsigned*)(F0.ws + WS_CTL), MISC + 8);
#define IN(k) (lo <= (k) && (k) < hi)
#define SEAM(k) do { if (IN(k) && IN((k) + 1)) xcd_barrier(bar); } while (0)
#define WSP(T_, off) ((T_*)(F.ws + (off)))

    if (IN(0)) { for (int rep = 0; rep <= REP_CONV; ++rep) { Frame F = lf(F0); conv_layer_weights(F, 0); conv_layer_weights(F, 1); conv_ffn_weights(F); conv_lora(F); conv_vlora(F); }
        for (int rep = 0; rep <= REP_MISC; ++rep) { Frame F = lf(F0); xprep_phase(F, INP(0)); } }
    SEAM(0);
    for (int l = 0; l < 2; ++l) {
        const int pb = LAYER_BASE0 + l * LAYER_STRIDE;
        F0.st = (unsigned char*)F0.out;
        if (IN(pb + 0)) {
            Frame F = lf(F0); unsigned char* wl = F.ws + WS_W + (size_t)l * WL_STRIDE;
            pg8::Gemm g{WSP(bf16, WS_XB), (const bf16*)(wl + WL_IN), D, D, D}; pg8::StaticOrder S; S.init(M, NP, F.G, F.cid, D, D);
            pg8::EpiInProj E{WSP(bf16, WS_BIG), (l == 0) ? WSP(float, WS_RSTD) : WSP(float, WS_SS1), WSP(float, WS_DT), l};
            pg8::gemm_phase(F.lds, F.wid, g, S, E);
        }
        SEAM(pb + 0);
        if (IN(pb + 1)) { Frame F = lf(F0); vprep_phase(F, l); prepass_a(F); }
        SEAM(pb + 1);
        if (IN(pb + 2)) { Frame F = lf(F0); prepass_conv(F, l); }
        if (IN(pb + 2) && IN(pb + 3)) xcd_barrier(bar);
        if (IN(pb + 3)) for (int rep = 0; rep <= REP_R1; ++rep) {
#if RW_CH
            for (int r2 = 0; r2 <= REP_RW; ++r2) { Frame F = lf(F0); for (int u = F.cid; u < 1024; u += F.G) rwkv_chunk_unit<false>(F, l, u); }
#else
            { Frame F = lf(F0); if (F.cid < 16) rwkv_seq(F, l, F.cid); }
#endif
#if RET_CH
            for (int r2 = 0; r2 <= REP_RET; ++r2) { Frame F = lf(F0); for (int u = F.cid; u < 1024; u += F.G) ret_chunk_unit<false>(F, u); }
#else
            { Frame F = lf(F0); if (F.cid >= 32 && F.cid < 48) ret_seq(F, F.cid - 32); }
#endif
#if SSD_CH
            for (int r2 = 0; r2 <= REP_SSD; ++r2) { Frame F = lf(F0); for (int u = F.cid; u < 1024; u += F.G) ssd_chunk_unit<false>(F, l, u); }
#else
            { Frame F = lf(F0); if (F.cid >= 16 && F.cid < 32) ssd_seq(F, l, F.cid - 16); }
#endif
        }
        SEAM(pb + 3);
        if (IN(pb + 4)) {
            Frame F = lf(F0);
            if (F.cid < 16) { if (RW_CH) rwkv_scan_chain(F, F.cid); }
            else elem_scans(F, F.cid - 16, F.G - 16);
        }
        SEAM(pb + 4);
        if (IN(pb + 5)) {
#if RW_CH
            { Frame F = lf(F0); for (int u = F.cid; u < 1024; u += F.G) rwkv_chunk_unit<true>(F, l, u); }
#endif
#if RET_CH
            { Frame F = lf(F0); for (int u = F.cid; u < 1024; u += F.G) ret_chunk_unit<true>(F, u); }
#endif
#if SSD_CH
            { Frame F = lf(F0); for (int u = F.cid; u < 1024; u += F.G) ssd_chunk_unit<true>(F, l, u); }
#endif
        }
        SEAM(pb + 5);
        if (IN(pb + 6)) { Frame F = lf(F0); ssm_norm_phase(F, l); }
        SEAM(pb + 6);
        if (IN(pb + 7)) {
            Frame F = lf(F0); unsigned char* wl = F.ws + WS_W + (size_t)l * WL_STRIDE; bf16* P = WSP(bf16, WS_BIG);
            pg8::Gemm g{P, (const bf16*)(wl + WL_BR), PLD, 512, 512}; pg8::BranchOrder S; S.init(F.G, F.cid);
            pg8::EpiPlain E{P, WSP(bf16, WS_VMIX)};
            pg8::gemm_phase(F.lds, F.wid, g, S, E);
        }
        SEAM(pb + 7);
        if (IN(pb + 8)) {
            Frame F = lf(F0); unsigned char* wl = F.ws + WS_W + (size_t)l * WL_STRIDE; bf16* P = WSP(bf16, WS_BIG);
            pg8::Gemm g{WSP(bf16, WS_XB), (const bf16*)(wl + WL_GATE), D, D, D}; pg8::GateOrder S; S.init(F.G, F.cid);
            pg8::EpiGateMerge E{P, WSP(const bf16, WS_VMIX), P + C_RET, PLD, (l == 0) ? WSP(float, WS_RSTD) : WSP(float, WS_SS1), l};
            pg8::gemm_phase(F.lds, F.wid, g, S, E);
        }
        if (IN(pb + 8) && IN(pb + 13)) xcd_barrier(bar);
        if (IN(pb + 13)) {
            Frame F = lf(F0); unsigned char* wl = F.ws + WS_W + (size_t)l * WL_STRIDE; bf16* P = WSP(bf16, WS_BIG);
            pg8::Gemm g{P + C_RET, (const bf16*)(wl + WL_OUT), PLD, D, D}; pg8::StaticOrder S; S.init(M, D, F.G, F.cid, PLD, D);
            pg8::EpiResidB E{WSP(bf16, WS_XB), (l == 0) ? WSP(float, WS_SS2) : nullptr, (l == 0) ? nullptr : F.out};
            pg8::gemm_phase(F.lds, F.wid, g, S, E);
        }
        SEAM(pb + 13);
        if (IN(pb + 14)) { Frame F = lf(F0); if (l == 1) { router_phase(F); conv_moe_weights(F); } }
        if (l == 1) SEAM(pb + 14);
        if (l == 0) {
            if (IN(pb + 15)) {
                Frame F = lf(F0);
                pg8::Gemm g{WSP(bf16, WS_XB), WSP(const bf16, WS_FFUP), D, D, D}; pg8::StaticOrder S; S.init(M, 2 * FF, F.G, F.cid, D, D);
                pg8::EpiSwiglu E{WSP(bf16, WS_ACT), FF, WSP(float, WS_SS2), 1};
                pg8::gemm_phase(F.lds, F.wid, g, S, E);
            }
            SEAM(pb + 15);
            if (IN(pb + 16)) {
                Frame F = lf(F0);
                pg8::Gemm g{WSP(const bf16, WS_ACT), WSP(const bf16, WS_FFDN), FF, FF, FF}; pg8::StaticOrder S; S.init(M, D, F.G, F.cid, FF, FF);
                pg8::EpiResidB E{WSP(bf16, WS_XB), WSP(float, WS_SS1), nullptr};
                pg8::gemm_phase(F.lds, F.wid, g, S, E);
            }
            if (IN(pb + 16) && IN(pb + 18)) xcd_barrier(bar);
        }
    }
    {
        const int pb = MOE_BASE;
        for (int st = 0; st < 6; ++st) {
            const int isup = (st == 0 || st == 2 || st == 3), sg = (st < 2) ? 0 : ((st == 2 || st == 4) ? 1 : 2);
            if (IN(pb + st)) {
                if (isup) {
                    Frame F = lf(F0);
                    pg8::Gemm g{WSP(bf16, WS_XB), WSP(const bf16, WS_MOEW), D, D, D}; pg8::MoeOrder<true> S; S.init(WSP(const int, WS_CNT), WSP(const int, WS_LIST), sg, 2 * FFE, F.G, F.cid, D, D, MOEW_STRIDE);
                    pg8::EpiSwiglu E{(sg == 2) ? WSP(bf16, WS_ACT2) : WSP(bf16, WS_ACT), FFE, WSP(float, WS_RSTD), 0};
                    pg8::gemm_phase(F.lds, F.wid, g, S, E);
                } else {
                    Frame F = lf(F0);
                    const int ksp = (sg == 2) ? 4 : 1;
                    pg8::Gemm g{(sg == 2) ? WSP(const bf16, WS_ACT2) : WSP(const bf16, WS_ACT), WSP(const bf16, WS_MOEW + MOEW_DN), FFE, FFE, FFE / ksp}; pg8::MoeOrder<false> S; S.init(WSP(const int, WS_CNT), WSP(const int, WS_LIST), sg, D, F.G, F.cid, FFE, FFE, MOEW_STRIDE, ksp, FFE / ksp);
                    pg8::EpiMoeOut E{(sg == 0) ? WSP(bf16, WS_YP0) : (sg == 1 ? WSP(bf16, WS_YP1) : WSP(bf16, WS_YP2)), YP2_STRIDE / 2};
                    pg8::gemm_phase(F.lds, F.wid, g, S, E);
                }
            }
            SEAM(pb + st);
        }
        if (IN(pb + 6)) { Frame F = lf(F0); final_norm_phase(F); }
    }
#undef IN
#undef SEAM
#undef WSP
}
constexpr int LAST_PHASE = MOE_BASE + 6;
constexpr int N_PH = LAST_PHASE + 1;

extern "C" void kernel_launch(void* const* d_in, const int* in_sizes, int n_in, void* d_out, int out_size, void* d_ws, size_t ws_size, hipStream_t stream) {
    static int grid = 0;
    if (grid == 0) {
        if (n_in != 34 || out_size != M * D || ws_size < WS_END) { fprintf(stderr, "kernel_launch: unexpected problem (n_in %d out %d ws %zu need %zu)\n", n_in, out_size, ws_size, (size_t)WS_END); grid = -1; return; }
        int dev = 0, cus = 0;
        if (hipGetDevice(&dev) != hipSuccess || hipDeviceGetAttribute(&cus, hipDeviceAttributeMultiprocessorCount, dev) != hipSuccess) { grid = -1; return; }
        if (hipFuncSetAttribute((const void*)fwd, hipFuncAttributeMaxDynamicSharedMemorySize, LDS_BYTES) != hipSuccess) { fprintf(stderr, "kernel_launch: hipFuncSetAttribute failed\n"); grid = -1; return; }
        int per_cu = 0;
        if (hipOccupancyMaxActiveBlocksPerMultiprocessor(&per_cu, (const void*)fwd, 512, LDS_BYTES) != hipSuccess || per_cu < 1) fprintf(stderr, "kernel_launch: occupancy query says %d\n", per_cu);
        (void)hipGetLastError();
        grid = cus;
    }
    if (grid < 0) return;
    (void)hipMemsetAsync((char*)d_ws + WS_CTL, 0, CTL_ZERO_BYTES, stream);
    Args a{};
    for (int i = 0; i < 34; ++i) a.in[i] = (const float*)d_in[i];
    a.out = (float*)d_out; a.ws = (unsigned char*)d_ws;
#if MK_ONE_LAUNCH
    a.ph_lo = 0; a.ph_hi = N_PH;
    hipLaunchKernelGGL(fwd, dim3(grid), dim3(512), LDS_BYTES, stream, a);
#else
    for (int p = 0; p < N_PH; ++p) { a.ph_lo = p; a.ph_hi = p + 1; hipLaunchKernelGGL(fwd, dim3(grid), dim3(512), LDS_BYTES, stream, a); }
#endif
}
```

```cpp
#include <hip/hip_runtime.h>
#include <cstdio>
#include <cstdint>

#ifndef MK_ONE_LAUNCH
#define MK_ONE_LAUNCH 1
#endif

#define LAS __attribute__((address_space(3)))
#define GAS __attribute__((address_space(1)))
typedef unsigned short bf16;
typedef short bf16x8 __attribute__((ext_vector_type(8)));
typedef float f32x4 __attribute__((ext_vector_type(4)));
typedef float f32x2 __attribute__((ext_vector_type(2)));
typedef unsigned u32x4 __attribute__((ext_vector_type(4)));
typedef unsigned u32x2 __attribute__((ext_vector_type(2)));

constexpr int BATCH = 2, T = 16384, D = 1024, M = BATCH * T;
constexpr int INC = 8456;
constexpr int PLD = 5376;
constexpr int NP = 5632;
constexpr int C_RW = 0, C_Z = 1792, C_XBC = 2304, C_RET = 3328, C_RETG = 4864;
constexpr int FF = 2816, FFE = 3584, NE = 8;

constexpr size_t MiB = 1u << 20;
constexpr size_t WS_CTL = 0, CTL_ZERO_BYTES = 64 * 1024;
constexpr size_t WS_RSTD = 1 * MiB, WS_GATES = 2 * MiB, WS_DT = 3 * MiB;
constexpr size_t WS_W = 4 * MiB;
constexpr size_t WL_IN = 0, WL_GATE = 11 * MiB, WL_BR = 17 * MiB, WL_OUT = 20 * MiB, WL_STRIDE = 22 * MiB;
constexpr size_t WS_FFUP = WS_W + 44 * MiB, WS_FFDN = WS_W + 55 * MiB;
constexpr size_t WS_XB = 68 * MiB;
constexpr size_t WS_VF = 132 * MiB;
constexpr size_t WS_BIG = 164 * MiB;
constexpr size_t WS_VMIX = WS_BIG + 336 * MiB, WS_YRW = WS_BIG + 368 * MiB, WS_END = 577 * MiB;
constexpr size_t WS_MOEW = WS_BIG;
constexpr size_t MOEW_STRIDE = 21 * MiB, MOEW_DN = 14 * MiB;
constexpr size_t WS_ACT = WS_BIG + 168 * MiB;

constexpr size_t WS_YP0 = 4 * MiB, WS_YP1 = WS_XB, WS_YP2 = 556 * MiB, YP2_STRIDE = 4 * MiB, WS_PINFO = 572 * MiB, WS_ACT2 = 132 * MiB;
constexpr size_t WS_CNT = 32768, WS_LIST = 2 * MiB;
constexpr size_t WS_BND2 = 566 * MiB;
constexpr size_t WS_VLORA = 192 * 1024;
constexpr size_t WS_SS1 = 573 * MiB, WS_SS2 = 575 * MiB;
constexpr size_t WS_DSTOT = 128 * 1024, WS_BND = 256 * 1024;
constexpr size_t WS_LORA = 1 * MiB + 512 * 1024, LORA_STRIDE = 262144;
constexpr size_t WS_ST_RW = WS_XB, WS_ST_RET = WS_XB + 16 * MiB, WS_ST_SSD = WS_XB + 32 * MiB, WS_MT = WS_YRW;
constexpr int RING_BYTES = 131072, LDSCTL_OFF = 159744, MISC_OFF = LDSCTL_OFF + 320, LDS_BYTES = 163840;
#ifndef REP_CONV
#define REP_CONV 0
#endif
#ifndef REP_R1
#define REP_R1 0
#endif
#ifndef REP_RW
#define REP_RW 0
#endif
#ifndef REP_RET
#define REP_RET 0
#endif
#ifndef REP_SSD
#define REP_SSD 0
#endif
#ifndef REP_MISC
#define REP_MISC 0
#endif
#ifndef RW_CH
#define RW_CH 1
#endif
#ifndef RET_CH
#define RET_CH 1
#endif
#ifndef SSD_CH
#define SSD_CH 1
#endif

typedef __bf16 hbf16x2 __attribute__((ext_vector_type(2)));
__device__ __forceinline__ unsigned pk2(float lo, float hi) { const f32x2 v = {lo, hi}; return __builtin_bit_cast(unsigned, __builtin_convertvector(v, hbf16x2)); }
__device__ __forceinline__ unsigned f2bf(float f) { return (unsigned)__builtin_bit_cast(unsigned short, (__bf16)f); }
__device__ __forceinline__ float bflo(unsigned u) { return __builtin_bit_cast(float, u << 16); }
__device__ __forceinline__ float bfhi(unsigned u) { return __builtin_bit_cast(float, u & 0xffff0000u); }
__device__ __forceinline__ void unpack8(const u32x4 u, float (&f)[8]) { f[0] = bflo(u.x); f[1] = bfhi(u.x); f[2] = bflo(u.y); f[3] = bfhi(u.y); f[4] = bflo(u.z); f[5] = bfhi(u.z); f[6] = bflo(u.w); f[7] = bfhi(u.w); }
__device__ __forceinline__ u32x4 pack8(const float (&f)[8]) { u32x4 w; w.x = pk2(f[0], f[1]); w.y = pk2(f[2], f[3]); w.z = pk2(f[4], f[5]); w.w = pk2(f[6], f[7]); return w; }
__device__ __forceinline__ float sigm(float x) { return __builtin_amdgcn_rcpf(1.f + __expf(-x)); }
__device__ __forceinline__ float silu(float x) { return x * __builtin_amdgcn_rcpf(1.f + __expf(-x)); }
__device__ __forceinline__ float ex2(float x) { return __builtin_amdgcn_exp2f(x); }
__device__ __forceinline__ float fast_tanh(float x) { return 1.f - 2.f * __builtin_amdgcn_rcpf(1.f + __expf(2.f * x)); }
__device__ __forceinline__ float softplus_acc(float x) { return fmaxf(x, 0.f) + log1pf(expf(-fabsf(x))); }
__device__ __forceinline__ float wave_sum(float v) {
#pragma unroll
    for (int o = 1; o < 64; o <<= 1) v += __shfl_xor(v, o);
    return v;
}
__device__ __forceinline__ int otid_w(int wid) { unsigned z = 0u; asm volatile("" : "+v"(z)); int t = wid * 64 + (int)__builtin_amdgcn_mbcnt_hi(~0u, __builtin_amdgcn_mbcnt_lo(~0u, z)); asm volatile("" : "+v"(t)); return t; }
#define otid() otid_w(F.wid)
__device__ __forceinline__ int fresh_tid(int t) { asm volatile("" : "+v"(t)); return t; }
#define LDS_WAIT() asm volatile("s_waitcnt lgkmcnt(0)" ::: "memory")

namespace pg8 {
constexpr int BM = 256, BK = 64, HALF = 128, HTB = HALF * BK * 2, STAGE_BYTES = 8 * HTB, NXCD = 8, WGM = 8;
__host__ __device__ __forceinline__ int lds_byte(int r, int c) { const int st = (r >> 4) * 2 + (c >> 5), rr = r & 15, cc = c & 31, ob = rr * 64 + cc * 2; return st * 1024 + (ob ^ (((ob >> 9) & 1) << 5)); }
__host__ __device__ __forceinline__ void stage_rc(int b, int& R, int& C) { const int st = b / 1024, sb = b % 1024, swz = sb ^ (((sb >> 9) & 1) << 5); R = (st >> 1) * 16 + swz / 64; C = (st & 1) * 32 + (swz % 64) / 2; }
__host__ __device__ __forceinline__ int perm32(int rho) { const int n = rho >> 4, i = rho & 15; return 8 * (i >> 2) + 4 * n + (i & 3); }

struct Unit { int pm, pn; size_t aofs, bofs; const int* rows; int nvalid, e, ks; };
struct Gemm { const bf16* A; const bf16* Bt; int lda, ldb, K; };

struct StaticOrder {
    static constexpr bool GATHER = false;
    int nM, nN, nwg, G, c; size_t tsA, tsB;
    __device__ __forceinline__ void init(int Mrows, int N, int G_, int c_, int lda, int ldb) { nM = Mrows / BM; nN = N / BM; nwg = nM * nN; G = G_; c = c_; tsA = (size_t)BM * lda * 2; tsB = (size_t)BM * ldb * 2; }
    __device__ __forceinline__ void tile(int L, int& pm, int& pn) const {
        int wgid = L; { const int q = nwg / NXCD, r = nwg % NXCD, xcd = wgid % NXCD, off = wgid / NXCD; wgid = (xcd < r ? xcd * (q + 1) : r * (q + 1) + (xcd - r) * q) + off; }
        const int nig = WGM * nN, gid = wgid / nig, fm = gid * WGM, gsz = (nM - fm) < WGM ? (nM - fm) : WGM;
        pm = fm + ((wgid % nig) % gsz); pn = (wgid % nig) / gsz;
    }
    __device__ __forceinline__ bool next(int i, Unit& u) const {
        const long L = (long)i * G + c; if (L >= nwg) return false;
        tile((int)L, u.pm, u.pn); u.aofs = (size_t)u.pm * tsA; u.bofs = (size_t)u.pn * tsB; u.rows = nullptr; u.nvalid = BM; u.e = 0; u.ks = 0; return true;
    }
};
struct BranchOrder {
    static constexpr bool GATHER = false;
    StaticOrder so;
    __device__ __forceinline__ void init(int G_, int c_) { so.init(M, D, G_, c_, PLD, 512); }
    __device__ __forceinline__ bool next(int j, Unit& u) const {
        const long L = (long)j * so.G + so.c; if (L >= 3 * so.nwg) return false;
        const int i = (int)(L / so.nwg); so.tile((int)(L % so.nwg), u.pm, u.pn);
        const int acol = (i == 0) ? 1024 : (i == 1 ? C_Z : C_RETG);
        u.aofs = (size_t)u.pm * so.tsA + (size_t)acol * 2; u.bofs = ((size_t)i * D + (size_t)u.pn * BM) * 512 * 2; u.rows = nullptr; u.nvalid = BM; u.e = i; u.ks = 0; return true;
    }
};
struct GateOrder {
    static constexpr bool GATHER = false;
    StaticOrder so;
    __device__ __forceinline__ void init(int G_, int c_) { so.init(M, D, G_, c_, D, D); }
    __device__ __forceinline__ bool next(int j, Unit& u) const {
        const long tt = (long)(j / 3) * so.G + so.c; if (tt >= so.nwg) return false;
        const int i = j % 3; so.tile((int)tt, u.pm, u.pn);
        u.aofs = (size_t)u.pm * so.tsA; u.bofs = ((size_t)i * D + (size_t)u.pn * BM) * D * 2; u.rows = nullptr; u.nvalid = BM; u.e = i; u.ks = 0; return true;
    }
};
template <bool GATH> struct MoeOrder {
    static constexpr bool GATHER = GATH;
    unsigned q0, q1, q2, q3;
    int seg, nN, G, c, ksplit; const int* list; size_t bstride, tsB, tsA, kbytes;
    __device__ __forceinline__ void init(const int* counts, const int* list_, int seg_, int N, int G_, int c_, int lda, int ldb, size_t bstride_, int ksplit_ = 1, int kpart = 0) {
        unsigned n[8];
#pragma unroll
        for (int e = 0; e < 8; ++e) { int v = __builtin_amdgcn_readfirstlane(counts[e]); v = v < 0 ? 0 : (v > 32768 ? 32768 : v); n[e] = (unsigned)v; }
        q0 = n[0] | (n[1] << 16); q1 = n[2] | (n[3] << 16); q2 = n[4] | (n[5] << 16); q3 = n[6] | (n[7] << 16);
        seg = seg_; nN = N / BM; G = G_; c = c_; list = list_; bstride = bstride_; tsB = (size_t)BM * ldb * 2; tsA = (size_t)BM * lda * 2; ksplit = ksplit_; kbytes = (size_t)kpart * 2;
    }
    __device__ __forceinline__ bool next(int i, Unit& u) const {
        const long L0 = (long)i * G + c; const long L = L0 / ksplit; const int ks = (int)(L0 % ksplit); const int tl = (int)(L / nN), pn = (int)(L % nN), gt = seg * 128 + tl;
        int t = 0, e = 0, tbe = 0, cne = 0;
#pragma unroll
        for (int k = 0; k < 8; ++k) { const unsigned q = (k < 2) ? q0 : (k < 4) ? q1 : (k < 6) ? q2 : q3; const int n = (int)((k & 1) ? (q >> 16) : (q & 0xffffu));
            if (gt >= t) { e = k; tbe = t; cne = n; } t += (n + 255) >> 8; }
        int nt = t - seg * 128; nt = nt < 0 ? 0 : (nt > 128 ? 128 : nt);
        if (L >= (long)nt * nN) return false;
        const int rt = gt - tbe;
        u.pm = tl; u.pn = pn; u.e = e; u.ks = ks; u.bofs = (size_t)e * bstride + (size_t)pn * tsB + ks * kbytes; u.aofs = (GATH ? 0 : (size_t)tl * tsA) + ks * kbytes;
        u.rows = list + ((size_t)e * 32768 + rt * 256) * 2; int nv = cne - rt * 256; u.nvalid = nv > 256 ? 256 : nv; return true;
    }
};

template <class Epi, class Sched>
__device__ __forceinline__ void gemm_phase(LAS unsigned char* lds, int wid0, const Gemm g, const Sched& S, const Epi& E) {
    constexpr bool GATHER = Sched::GATHER;
    const int tid = otid_w(wid0), wid = __builtin_amdgcn_readfirstlane(tid >> 6), lane = tid & 63, wr = wid >> 2, wc = wid & 3, fr = lane & 15, fq = lane >> 4;
    const int nt = g.K / BK;
    unsigned voffA[2], voffB[2];
#pragma unroll
    for (int i = 0; i < 2; ++i) { int R, C; stage_rc(tid * 16 + i * 8192, R, C); const int Rb = Epi::PERM ? ((R & ~31) + perm32(R & 31)) : R;
        voffA[i] = (unsigned)(R * g.lda + C) * 2u; voffB[i] = (unsigned)(Rb * g.ldb + C) * 2u; }
    const size_t kstep = (size_t)(BK * 2);
    const size_t hstepA = GATHER ? 0 : (size_t)HALF * g.lda * 2, hstepB = (size_t)HALF * g.ldb * 2;
    const unsigned ldsw = (unsigned)wid * 1024u;
    const int aoff = lds_byte(wr * 64 + fr, fq * 8), boff = lds_byte(wc * 32 + fr, fq * 8);
#define PG8_SA(b, h) (((b) * 2 + (h)) * HTB)
#define PG8_SB(b, h) ((4 + (b) * 2 + (h)) * HTB)
#define PG8_STAGE2(bufoff, gbase, o0, o1) do { \
        __builtin_amdgcn_global_load_lds((const unsigned*)((const char*)(gbase) + (o0)), (LAS unsigned*)(lds + (bufoff) + ldsw), 16, 0, 0); \
        __builtin_amdgcn_global_load_lds((const unsigned*)((const char*)(gbase) + (o1)), (LAS unsigned*)(lds + (bufoff) + ldsw + 8192), 16, 0, 0); } while (0)
#define PG8_STAGE(bufoff, gbase, voff) PG8_STAGE2(bufoff, gbase, (voff)[0], (voff)[1])
#define PG8_LDA(dst, b, h) do { _Pragma("unroll") for (int m = 0; m < 4; ++m) _Pragma("unroll") for (int k = 0; k < 2; ++k) dst[m][k] = *(const LAS bf16x8*)(lds + PG8_SA(b, h) + aoff + m * 2048 + k * 1024); } while (0)
#define PG8_LDB(dst, b, h) do { _Pragma("unroll") for (int n = 0; n < 2; ++n) _Pragma("unroll") for (int k = 0; k < 2; ++k) dst[n][k] = *(const LAS bf16x8*)(lds + PG8_SB(b, h) + boff + n * 2048 + k * 1024); } while (0)
#define PG8_MMA(ai, bj, At, Bt) do { __builtin_amdgcn_s_setprio(1); _Pragma("unroll") for (int m = 0; m < 4; ++m) _Pragma("unroll") for (int n = 0; n < 2; ++n) _Pragma("unroll") for (int k = 0; k < 2; ++k) \
        acc[ai][bj][m][n] = Epi::TRANS ? __builtin_amdgcn_mfma_f32_16x16x32_bf16(Bt[n][k], At[m][k], acc[ai][bj][m][n], 0, 0, 0) : __builtin_amdgcn_mfma_f32_16x16x32_bf16(At[m][k], Bt[n][k], acc[ai][bj][m][n], 0, 0, 0); __builtin_amdgcn_s_setprio(0); } while (0)
#define PG8_WAIT_V(n) asm volatile("s_waitcnt vmcnt(" #n ")" ::: "memory")
#define PG8_WAIT_L(n) asm volatile("s_waitcnt lgkmcnt(" #n ")" ::: "memory")
#define PG8_BAR __builtin_amdgcn_s_barrier()
#define PG8_SCHED __builtin_amdgcn_sched_barrier(0)
#define GSLOT(which) ((LAS u32x4*)(lds + 131072 + (which) * 8192 + tid * 16))
#define PG8_ROWS(u, which) do { const int _ft = fresh_tid(tid); unsigned _vg[2][2]; _Pragma("unroll") for (int _i = 0; _i < 2; ++_i) { int _R, _C; stage_rc(_ft * 16 + _i * 8192, _R, _C); \
        _Pragma("unroll") for (int _h = 0; _h < 2; ++_h) { const int _r = _h * HALF + _R; \
        const int _t = (_r < (u).nvalid) ? (u).rows[2 * _r] : 0; _vg[_h][_i] = ((unsigned)_t * (unsigned)g.lda + (unsigned)_C) * 2u; } } \
        u32x4 _o; _o.x = _vg[0][0]; _o.y = _vg[0][1]; _o.z = _vg[1][0]; _o.w = _vg[1][1]; *GSLOT(which) = _o; } while (0)
    Unit cur, nxt; int ui = 0;
    if (!S.next(0, cur)) return;
    f32x4 acc[2][2][4][2];
#pragma unroll
    for (int a = 0; a < 2; ++a)
#pragma unroll
        for (int b = 0; b < 2; ++b)
#pragma unroll
            for (int m = 0; m < 4; ++m)
#pragma unroll
                for (int n = 0; n < 2; ++n) acc[a][b][m][n] = (f32x4){0.f, 0.f, 0.f, 0.f};
    bf16x8 At[4][2], B0[2][2], B1[2][2];
    u32x4 gc = {voffA[0], voffA[1], voffA[0], voffA[1]};
    if constexpr (GATHER) { PG8_ROWS(cur, 0); PG8_ROWS(cur, 1); gc = *GSLOT(0); }
#define VGC(h, i) (gc[2 * (h) + (i)])
    const char* cA = (const char*)g.A + cur.aofs; const char* cB = (const char*)g.Bt + cur.bofs;
    PG8_STAGE(PG8_SB(0, 0), cB, voffB); PG8_STAGE(PG8_SB(0, 1), cB + hstepB, voffB); PG8_STAGE2(PG8_SA(0, 0), cA, VGC(0, 0), VGC(0, 1)); PG8_STAGE2(PG8_SA(0, 1), cA + hstepA, VGC(1, 0), VGC(1, 1));
    if (wr == 1) PG8_BAR;
    PG8_WAIT_V(2); PG8_BAR;
    PG8_STAGE(PG8_SB(1, 0), cB + kstep, voffB); PG8_STAGE2(PG8_SA(1, 0), cA + kstep, VGC(0, 0), VGC(0, 1)); PG8_STAGE(PG8_SB(1, 1), cB + hstepB + kstep, voffB);
    PG8_WAIT_V(6); PG8_BAR;
    for (;;) {
        const bool has_next = S.next(ui + 1, nxt);
        const char* nA = has_next ? (const char*)g.A + nxt.aofs : cA; const char* nB = has_next ? (const char*)g.Bt + nxt.bofs : cB;
        if constexpr (GATHER) { if (has_next) PG8_ROWS(nxt, 1); else *GSLOT(1) = *GSLOT(0); }
        for (int t = 0; t < nt; t += 2) {
            const bool last = (t == nt - 2);
            const char* a1 = cA + (size_t)(t + 1) * kstep;
            const char* a2 = last ? nA : cA + (size_t)(t + 2) * kstep; const char* b2 = last ? nB : cB + (size_t)(t + 2) * kstep;
            const char* a3 = a2 + kstep; const char* b3 = b2 + kstep;
            u32x4 gn = gc; if constexpr (GATHER) { gc = *GSLOT(0); gn = last ? *GSLOT(1) : gc; }
            const unsigned s00 = gn.x, s01 = gn.y, s10 = gn.z, s11 = gn.w;
            PG8_LDB(B0, 0, 0); PG8_LDB(B1, 0, 1); PG8_SCHED; PG8_LDA(At, 0, 0); PG8_STAGE2(PG8_SA(1, 1), a1 + hstepA, VGC(1, 0), VGC(1, 1));
            PG8_WAIT_V(8); PG8_WAIT_L(0); PG8_BAR; PG8_MMA(0, 0, At, B0); PG8_MMA(0, 1, At, B1); PG8_BAR; PG8_SCHED;
            PG8_LDA(At, 0, 1); PG8_STAGE(PG8_SB(0, 0), b2, voffB); PG8_STAGE(PG8_SB(0, 1), b2 + hstepB, voffB); PG8_STAGE2(PG8_SA(0, 0), a2, s00, s01);
            PG8_WAIT_V(8); PG8_WAIT_L(0); PG8_BAR; PG8_MMA(1, 0, At, B0); PG8_MMA(1, 1, At, B1); PG8_BAR; PG8_SCHED;
            PG8_LDB(B0, 1, 0); PG8_LDB(B1, 1, 1); PG8_SCHED; PG8_LDA(At, 1, 0); PG8_STAGE2(PG8_SA(0, 1), a2 + hstepA, s10, s11);
            PG8_WAIT_V(8); PG8_WAIT_L(0); PG8_BAR; PG8_MMA(0, 0, At, B0); PG8_MMA(0, 1, At, B1); PG8_BAR; PG8_SCHED;
            PG8_LDA(At, 1, 1); PG8_STAGE(PG8_SB(1, 0), b3, voffB); PG8_STAGE(PG8_SB(1, 1), b3 + hstepB, voffB); PG8_STAGE2(PG8_SA(1, 0), a3, s00, s01);
            PG8_WAIT_V(8); PG8_WAIT_L(0); PG8_BAR; PG8_MMA(1, 0, At, B0); PG8_MMA(1, 1, At, B1); PG8_BAR; PG8_SCHED;
        }
        if (wr == 0) PG8_BAR;
        E(acc, cur, wr, wc, fr, fq);
        if (!has_next) break;
#pragma unroll
        for (int a = 0; a < 2; ++a)
#pragma unroll
            for (int b = 0; b < 2; ++b)
#pragma unroll
                for (int m = 0; m < 4; ++m)
#pragma unroll
                    for (int n = 0; n < 2; ++n) acc[a][b][m][n] = (f32x4){0.f, 0.f, 0.f, 0.f};
        cur = nxt; cA = nA; cB = nB; ++ui;
        if constexpr (GATHER) { *GSLOT(0) = *GSLOT(1); }
        if (wr == 1) PG8_BAR;
    }
    PG8_WAIT_V(0);
    PG8_BAR;
#undef PG8_SA
#undef PG8_SB
#undef PG8_STAGE
#undef PG8_STAGE2
#undef PG8_ROWS
#undef GSLOT
#undef VGC
#undef PG8_LDA
#undef PG8_LDB
#undef PG8_MMA
#undef PG8_WAIT_V
#undef PG8_WAIT_L
#undef PG8_BAR
#undef PG8_SCHED
}

typedef const f32x4 (&AccRef)[2][2][4][2];
__device__ __forceinline__ float ss16(const float* p) { const f32x4 a = *(const f32x4*)p, b = *(const f32x4*)(p + 4), c = *(const f32x4*)(p + 8), d = *(const f32x4*)(p + 12);
    return (((a[0] + a[1]) + (a[2] + a[3])) + ((b[0] + b[1]) + (b[2] + b[3]))) + (((c[0] + c[1]) + (c[2] + c[3])) + ((d[0] + d[1]) + (d[2] + d[3]))); }
__device__ __forceinline__ float rs_of(const float* rstd, int ssmode, int row) { return ssmode ? __builtin_amdgcn_rsqf(ss16(rstd + (size_t)row * 16) * (1.f / D) + 1e-6f) : rstd[row]; }

struct EpiInProj {
    static constexpr bool PERM = true, TRANS = true;
    bf16* P; const float* rstd; float* dt; int ssmode;
    __device__ __forceinline__ void operator()(AccRef acc, const Unit& u, int wr, int wc, int fr, int fq) const {
        const int row0 = u.pm * BM + wr * 64 + fr;
        if (u.pn < 21) {
            const int col0 = u.pn * BM + wc * 32 + 8 * fq;
#pragma unroll
            for (int ai = 0; ai < 2; ++ai)
#pragma unroll
                for (int m = 0; m < 4; ++m) { const int row = row0 + ai * HALF + m * 16; const float s = rs_of(rstd, ssmode, row); bf16* rowp = P + (size_t)row * PLD + col0;
#pragma unroll
                    for (int bj = 0; bj < 2; ++bj) { const f32x4 v0 = acc[ai][bj][m][0] * s, v1 = acc[ai][bj][m][1] * s;
                        u32x4 w; w.x = pk2(v0[0], v0[1]); w.y = pk2(v0[2], v0[3]); w.z = pk2(v1[0], v1[1]); w.w = pk2(v1[2], v1[3]);
                        *(u32x4*)(rowp + bj * HALF) = w; } }
        } else if (wc == 0 && fq == 0) {
#pragma unroll
            for (int ai = 0; ai < 2; ++ai)
#pragma unroll
                for (int m = 0; m < 4; ++m) { const int row = row0 + ai * HALF + m * 16; const float s = rs_of(rstd, ssmode, row);
                    *(f32x4*)(dt + (size_t)row * 8) = acc[ai][0][m][0] * s; *(f32x4*)(dt + (size_t)row * 8 + 4) = acc[ai][0][m][1] * s; }
        }
    }
};
struct EpiPlain {
    static constexpr bool PERM = true, TRANS = true;
    bf16* P; bf16* Y2;
    __device__ __forceinline__ void operator()(AccRef acc, const Unit& u, int wr, int wc, int fr, int fq) const {
        bf16* O = (u.e == 0) ? P : (u.e == 1 ? P + C_XBC : Y2); const int ldc = (u.e == 2) ? D : PLD;
        const int row0 = u.pm * BM + wr * 64 + fr, col0 = u.pn * BM + wc * 32 + 8 * fq;
#pragma unroll
        for (int ai = 0; ai < 2; ++ai)
#pragma unroll
            for (int m = 0; m < 4; ++m) { bf16* rowp = O + (size_t)(row0 + ai * HALF + m * 16) * ldc + col0;
#pragma unroll
                for (int bj = 0; bj < 2; ++bj) { const f32x4 v0 = acc[ai][bj][m][0], v1 = acc[ai][bj][m][1];
                    u32x4 w; w.x = pk2(v0[0], v0[1]); w.y = pk2(v0[2], v0[3]); w.z = pk2(v1[0], v1[1]); w.w = pk2(v1[2], v1[3]);
                    *(u32x4*)(rowp + bj * HALF) = w; } }
    }
};
struct EpiGateMerge {
    static constexpr bool PERM = true, TRANS = true;
    const bf16* P; const bf16* Y2; bf16* Mg; int ldm; const float* rstd; int ssmode;
    __device__ __forceinline__ void operator()(AccRef acc, const Unit& u, int wr, int wc, int fr, int fq) const {
        asm volatile("" : "+v"(fr), "+v"(fq));
        const bf16* Y = (u.e == 0) ? P : (u.e == 1 ? P + C_XBC : Y2); const int ldy = (u.e == 2) ? D : PLD; const int first = (u.e == 0);
        const int row0 = u.pm * BM + wr * 64 + fr, col0 = u.pn * BM + wc * 32 + 8 * fq;
#pragma unroll
        for (int ai = 0; ai < 2; ++ai)
#pragma unroll
            for (int m = 0; m < 4; ++m) { const int row = row0 + ai * HALF + m * 16; const float s = rs_of(rstd, ssmode, row);
#pragma unroll
                for (int bj = 0; bj < 2; ++bj) { const int c = col0 + bj * HALF;
                    float y[8], o[8]; unpack8(*(const u32x4*)(Y + (size_t)row * ldy + c), y);
                    const f32x4 v0 = acc[ai][bj][m][0] * s, v1 = acc[ai][bj][m][1] * s;
#pragma unroll
                    for (int j = 0; j < 4; ++j) { o[j] = sigm(v0[j]) * y[j]; o[4 + j] = sigm(v1[j]) * y[4 + j]; }
                    if (!first) { float p[8]; unpack8(*(const u32x4*)(Mg + (size_t)row * ldm + c), p);
#pragma unroll
                        for (int j = 0; j < 8; ++j) o[j] += p[j]; }
                    *(u32x4*)(Mg + (size_t)row * ldm + c) = pack8(o); } }
    }
};
struct EpiResid {
    static constexpr bool PERM = false, TRANS = true;
    const float* xin; float* xout; const float* gates; int e;
    __device__ __forceinline__ void operator()(AccRef acc, const Unit& u, int wr, int wc, int fr, int fq) const {
        const int row0 = u.pm * BM + wr * 64 + fr, col0 = u.pn * BM + wc * 32 + 4 * fq;
#pragma unroll
        for (int ai = 0; ai < 2; ++ai)
#pragma unroll
            for (int m = 0; m < 4; ++m) { const int row = row0 + ai * HALF + m * 16; const float s = gates ? gates[(size_t)row * 8 + e] : 1.f;
                const float* ip = xin + (size_t)row * D + col0; float* op = xout + (size_t)row * D + col0;
#pragma unroll
                for (int bj = 0; bj < 2; ++bj)
#pragma unroll
                    for (int n = 0; n < 2; ++n) *(f32x4*)(op + bj * HALF + n * 16) = *(const f32x4*)(ip + bj * HALF + n * 16) + acc[ai][bj][m][n] * s; }
    }
};
struct EpiResidB {
    static constexpr bool PERM = true, TRANS = true;
    bf16* xb; float* SS; float* xf;
    __device__ __forceinline__ void operator()(AccRef acc, const Unit& u, int wr, int wc, int fr, int fq) const {
        asm volatile("" : "+v"(fr), "+v"(fq));
        const int row0 = u.pm * BM + wr * 64 + fr, col0 = u.pn * BM + wc * 32 + 8 * fq;
#pragma unroll
        for (int ai = 0; ai < 2; ++ai)
#pragma unroll
            for (int m = 0; m < 4; ++m) { const int row = row0 + ai * HALF + m * 16; bf16* rowp = xb + (size_t)row * D + col0; float ss = 0.f;
#pragma unroll
                for (int bj = 0; bj < 2; ++bj) { float v[8]; unpack8(*(const u32x4*)(rowp + bj * HALF), v);
#pragma unroll
                    for (int j = 0; j < 4; ++j) { v[j] += acc[ai][bj][m][0][j]; v[4 + j] += acc[ai][bj][m][1][j]; }
                    *(u32x4*)(rowp + bj * HALF) = pack8(v);
                    if (xf) { float* fp = xf + (size_t)row * D + col0 + bj * HALF; *(f32x4*)fp = (f32x4){v[0], v[1], v[2], v[3]}; *(f32x4*)(fp + 4) = (f32x4){v[4], v[5], v[6], v[7]}; }
#pragma unroll
                    for (int j = 0; j < 8; ++j) ss += v[j] * v[j]; }
                if (SS) { ss += __shfl_xor(ss, 16); ss += __shfl_xor(ss, 32); if (fq == 0) SS[(size_t)row * 16 + u.pn * 4 + wc] = ss; } }
    }
};
struct EpiSwiglu {
    static constexpr bool PERM = true, TRANS = true;
    bf16* act; int ldc; const float* rstd; int ssmode;
    __device__ __forceinline__ void operator()(AccRef acc, const Unit& u, int wr, int wc, int fr, int fq) const {
        asm volatile("" : "+v"(fr), "+v"(fq));
        const int row0 = u.pm * BM + wr * 64 + fr, col0 = u.pn * HALF + wc * 32 + 8 * fq;
#pragma unroll
        for (int ai = 0; ai < 2; ++ai)
#pragma unroll
            for (int m = 0; m < 4; ++m) { const int row = row0 + ai * HALF + m * 16; const int lr = row - u.pm * BM;
                const float s = u.rows ? rstd[(lr < u.nvalid) ? u.rows[2 * lr] : 0] : rs_of(rstd, ssmode, row);
                float o[8];
#pragma unroll
                for (int n = 0; n < 2; ++n)
#pragma unroll
                    for (int j = 0; j < 4; ++j) o[4 * n + j] = silu(acc[ai][0][m][n][j] * s) * (acc[ai][1][m][n][j] * s);
                *(u32x4*)(act + (size_t)row * ldc + col0) = pack8(o); }
    }
};
struct EpiMoeOut {
    static constexpr bool PERM = true, TRANS = true;
    bf16* Y; size_t kstride;
    __device__ __forceinline__ void operator()(AccRef acc, const Unit& u, int wr, int wc, int fr, int fq) const {
        const int row0 = u.pm * BM + wr * 64 + fr, col0 = u.pn * BM + wc * 32 + 8 * fq; bf16* O = Y + (size_t)u.ks * kstride;
#pragma unroll
        for (int ai = 0; ai < 2; ++ai)
#pragma unroll
            for (int m = 0; m < 4; ++m) { bf16* rowp = O + (size_t)(row0 + ai * HALF + m * 16) * D + col0;
#pragma unroll
                for (int bj = 0; bj < 2; ++bj) { const f32x4 v0 = acc[ai][bj][m][0], v1 = acc[ai][bj][m][1];
                    u32x4 w; w.x = pk2(v0[0], v0[1]); w.y = pk2(v0[2], v0[3]); w.z = pk2(v1[0], v1[1]); w.w = pk2(v1[2], v1[3]);
                    *(u32x4*)(rowp + bj * HALF) = w; } }
    }
};
}

#define XB_TMO      128
#define XB_XCNT(j)  (256  + 64 * (j))
#define XB_XSUB(j)  (1280 + 64 * (j))
#define XB_XGEN(j)  (2304 + 64 * (j))
#define XB_TOP      3328
#define XB_TOPGEN   3392
#define XCD_BAR_WORDS 3456
#define XB_SPIN_CAP (1u << 18)

__device__ __forceinline__ unsigned xb_ld(unsigned* p)              { return __hip_atomic_load(p, __ATOMIC_RELAXED, __HIP_MEMORY_SCOPE_AGENT); }
__device__ __forceinline__ unsigned xb_add(unsigned* p, unsigned v) { return __hip_atomic_fetch_add(p, v, __ATOMIC_RELAXED, __HIP_MEMORY_SCOPE_AGENT); }
__device__ __forceinline__ unsigned xb_xcc_id() { return (unsigned)__builtin_amdgcn_s_getreg((3 << 11) | 20) & 0xFu; }
#define XB_SPIN(cond, bar) do { unsigned _sp = 0; while (cond) { __builtin_amdgcn_s_sleep(1); \
    if ((++_sp & 255u) == 0u) { if (xb_ld(&(bar)[XB_TMO])) break; if (_sp > XB_SPIN_CAP) { atomicAdd(&(bar)[XB_TMO], 1u); break; } } } } while (0)

struct XcdBarrier { unsigned* bar; unsigned x; volatile LAS unsigned* st; };

__device__ __forceinline__ XcdBarrier xcd_barrier_post(unsigned* bar, volatile LAS unsigned* st) {
    XcdBarrier b; b.bar = bar; b.x = xb_xcc_id(); b.st = st;
    if (threadIdx.x == 0) (void)xb_add(&bar[XB_XCNT(b.x)], 1u);
    return b;
}
__device__ __forceinline__ void xcd_barrier_complete(unsigned* bar, unsigned x, unsigned& nloc, unsigned& nx) {
    const unsigned G = gridDim.x * gridDim.y * gridDim.z;
    unsigned sum, cnt, mine, sp = 0u;
    for (;;) {
        sum = 0u; cnt = 0u; mine = 0u;
#pragma unroll
        for (unsigned j = 0; j < 16; ++j) { const unsigned c = xb_ld(&bar[XB_XCNT(j)]); sum += c; cnt += (c > 0u) ? 1u : 0u; mine = (j == x) ? c : mine; }
        if (sum == G) break;
        __builtin_amdgcn_s_sleep(1);
        if ((++sp & 255u) == 0u) { if (xb_ld(&bar[XB_TMO])) break; if (sp > XB_SPIN_CAP) { atomicAdd(&bar[XB_TMO], 1u); break; } }
    }
    nloc = mine > 0u ? mine : 1u; nx = cnt > 0u ? cnt : 1u;
}
__device__ __forceinline__ void xcd_barrier(const XcdBarrier& b) {
    asm volatile("s_waitcnt vmcnt(0)" ::: "memory");
    __syncthreads();
    if (threadIdx.x == 0) {
        unsigned* bar = b.bar;
        __builtin_amdgcn_s_waitcnt(0);
        unsigned nloc = b.st[0], nx = b.st[1];
        if (nloc == 0u) { xcd_barrier_complete(bar, b.x, nloc, nx); b.st[0] = nloc; b.st[1] = nx; }
        const unsigned old = xb_add(&bar[XB_XSUB(b.x)], 1u);
        const unsigned gen = old / nloc;
        if (old + 1u == (gen + 1u) * nloc) {
            __builtin_amdgcn_fence(__ATOMIC_RELEASE, "agent");
            asm volatile("s_waitcnt vmcnt(0)" ::: "memory");
            const unsigned og = xb_add(&bar[XB_TOP], 1u);
            const unsigned tg = og / nx;
            if (og + 1u == (tg + 1u) * nx) xb_add(&bar[XB_TOPGEN], 1u);
            else XB_SPIN(xb_ld(&bar[XB_TOPGEN]) == tg, bar);
            __builtin_amdgcn_fence(__ATOMIC_ACQUIRE, "agent");
            xb_add(&bar[XB_XGEN(b.x)], 1u);
            asm volatile("s_waitcnt vmcnt(0)" ::: "memory");
        } else {
            XB_SPIN(xb_ld(&bar[XB_XGEN(b.x)]) == gen, bar);
            __builtin_amdgcn_fence(__ATOMIC_ACQUIRE, "agent");
            asm volatile("s_waitcnt vmcnt(0)" ::: "memory");
        }
    }
    __syncthreads();
}

struct Args { const float* in[34]; float* out; unsigned char* ws; int ph_lo, ph_hi; };
struct Frame {
    LAS unsigned char* lds;
    int vcu, G, cid, wid;
    float* out; unsigned char* ws; unsigned char* st;
};
__device__ __forceinline__ const float* inptr(LAS unsigned char* lds, int i) {
    int off = LDSCTL_OFF + 8 * i; asm volatile("" : "+v"(off));
    const LAS unsigned* p = (const LAS unsigned*)(lds + off);
    const unsigned lo = __builtin_amdgcn_readfirstlane(p[0]), hi = __builtin_amdgcn_readfirstlane(p[1]);
    return (const float*)(((unsigned long long)hi << 32) | lo);
}
#define INP(i) inptr(F.lds, (i))

__device__ __forceinline__ void conv_item(const float* W, int ld, int k0, int c0, int nvalid, const float* scale, bf16* dst, int K, int drow0, LAS float* scr, int lane) {
    const int n4 = (lane & 15) * 4;
#pragma unroll 4
    for (int i = 0; i < 16; ++i) { const int kk = 4 * i + (lane >> 4);
        f32x4 v = {0.f, 0.f, 0.f, 0.f}; if (n4 < nvalid) { v = *(const f32x4*)(W + (size_t)(k0 + kk) * ld + c0 + n4); if (scale) v *= scale[k0 + kk]; }
        LAS float* d = scr + kk * 65 + n4; d[0] = v[0]; d[1] = v[1]; d[2] = v[2]; d[3] = v[3]; }
    LDS_WAIT(); asm volatile("" ::: "memory");
    const int c = lane & 7;
#pragma unroll
    for (int j = 0; j < 8; ++j) { const int nn = (lane >> 3) + 8 * j; const LAS float* sp = scr + (8 * c) * 65 + nn;
        u32x4 o; o.x = pk2(sp[0 * 65], sp[1 * 65]); o.y = pk2(sp[2 * 65], sp[3 * 65]); o.z = pk2(sp[4 * 65], sp[5 * 65]); o.w = pk2(sp[6 * 65], sp[7 * 65]);
        *(u32x4*)(dst + (size_t)(drow0 + nn) * K + k0 + 8 * c) = o; }
    LDS_WAIT(); asm volatile("" ::: "memory");
}
__device__ __forceinline__ void conv_seg(Frame& F, const float* W, int ld, int K, int c0, int nvalid, int ntotal, const float* scale, bf16* dst, int r0, int blk, int blks) {
    const int ptid = otid(), plane = ptid & 63, pwave = __builtin_amdgcn_readfirstlane(ptid >> 6);
    LAS float* scr = (LAS float*)(F.lds + pwave * 16640);
    const int gw = F.vcu * 8 + pwave, NGW = F.G * 8;
    const int nblk = ntotal / 64, nitems = (K / 64) * nblk;
    for (int it = gw; it < nitems; it += NGW) {
        const int kb = it / nblk, nb = it % nblk, n0 = nb * 64;
        int nv = nvalid - n0; nv = nv < 0 ? 0 : (nv > 64 ? 64 : nv);
        conv_item(W, ld, kb * 64, c0 + n0, nv, scale, dst, K, r0 + (n0 / blk) * blks + (n0 % blk), scr, plane);
    }
}
__device__ __forceinline__ void conv_layer_weights(Frame& F, int l, int part) {
    unsigned char* wl = F.ws + WS_W + (size_t)l * WL_STRIDE;
    const float* win = INP(2) + (size_t)l * D * INC; const float* n1 = INP(1) + l * D;
    const int BIGB = 1 << 30;
    if (part == 0) {
        conv_seg(F, win, INC, D, 0, 3328, 3328, n1, (bf16*)(wl + WL_IN), 0, BIGB, 0);
        conv_seg(F, win, INC, D, 3336, 2048, 2048, n1, (bf16*)(wl + WL_IN), 3328, BIGB, 0);
        conv_seg(F, win, INC, D, 3328, 8, 256, n1, (bf16*)(wl + WL_IN), 5376, BIGB, 0);
    } else {
        conv_seg(F, win, INC, D, 5384, 3072, 3072, n1, (bf16*)(wl + WL_GATE), 0, BIGB, 0);
        for (int i = 0; i < 3; ++i)
            conv_seg(F, INP(23) + ((size_t)l * 3 + i) * 512 * D, D, 512, 0, D, D, nullptr, (bf16*)(wl + WL_BR) + (size_t)i * D * 512, 0, BIGB, 0);
        conv_seg(F, INP(24) + (size_t)l * D * D, D, D, 0, D, D, nullptr, (bf16*)(wl + WL_OUT), 0, BIGB, 0);
    }
}
__device__ __forceinline__ void conv_ffn_weights(Frame& F) {
    const float* n2 = INP(25);
    conv_seg(F, INP(26), FF, D, 0, FF, FF, n2, (bf16*)(F.ws + WS_FFUP), 0, 128, 256);
    conv_seg(F, INP(27), FF, D, 0, FF, FF, n2, (bf16*)(F.ws + WS_FFUP), 128, 128, 256);
    conv_seg(F, INP(28), D, FF, 0, D, D, nullptr, (bf16*)(F.ws + WS_FFDN), 0, 1 << 30, 0);
}
__device__ __forceinline__ void conv_moe_weights(Frame& F) {
    const float* n2 = INP(25) + D;
    for (int e = 0; e < NE; ++e) {
        bf16* up = (bf16*)(F.ws + WS_MOEW + (size_t)e * MOEW_STRIDE); bf16* dn = (bf16*)(F.ws + WS_MOEW + (size_t)e * MOEW_STRIDE + MOEW_DN);
        conv_seg(F, INP(30) + (size_t)e * D * FFE, FFE, D, 0, FFE, FFE, n2, up, 0, 128, 256);
        conv_seg(F, INP(31) + (size_t)e * D * FFE, FFE, D, 0, FFE, FFE, n2, up, 128, 128, 256);
        conv_seg(F, INP(32) + (size_t)e * FFE * D, D, FFE, 0, D, D, nullptr, dn, 0, 1 << 30, 0);
    }
}

__device__ __forceinline__ void xprep_phase(Frame& F, const float* x) {
    const int ptid = otid(), plane = ptid & 63, pwave = __builtin_amdgcn_readfirstlane(ptid >> 6); (void)plane; (void)pwave;
    const int gw = F.vcu * 8 + pwave, NGW = F.G * 8;
    bf16* xb = (bf16*)(F.ws + WS_XB); float* rstd = (float*)(F.ws + WS_RSTD);
    for (int m = gw; m < M; m += NGW) {
        const f32x4* xr = (const f32x4*)(x + (size_t)m * D) + plane;
        f32x4 v[4]; float s = 0.f;
#pragma unroll
        for (int j = 0; j < 4; ++j) { v[j] = xr[64 * j]; s += (v[j].x * v[j].x + v[j].y * v[j].y) + (v[j].z * v[j].z + v[j].w * v[j].w); }
        s = wave_sum(s);
        if (plane == 0) rstd[m] = __builtin_amdgcn_rsqf(s * (1.f / D) + 1e-6f);
        u32x2* o8 = (u32x2*)(xb + (size_t)m * D) + plane;
#pragma unroll
        for (int j = 0; j < 4; ++j) { u32x2 w; w.x = pk2(v[j].x, v[j].y); w.y = pk2(v[j].z, v[j].w); o8[64 * j] = w; }
    }
}
__device__ __forceinline__ void final_norm_phase(Frame& F) {
    const int ptid = otid(), plane = ptid & 63, pwave = __builtin_amdgcn_readfirstlane(ptid >> 6);
    const int gw = F.vcu * 8 + pwave, NGW = F.G * 8;
    const float* fw = INP(33); const unsigned* pinfo = (const unsigned*)(F.ws + WS_PINFO); const int* cnt = (const int*)(F.ws + WS_CNT);
    int tb[8]; { int t = 0;
#pragma unroll
        for (int e = 0; e < 8; ++e) { int n = __builtin_amdgcn_readfirstlane(cnt[e]); n = n < 0 ? 0 : (n > 32768 ? 32768 : n); tb[e] = t; t += (n + 255) >> 8; } }
    const bf16* Y0 = (const bf16*)(F.ws + WS_YP0); const bf16* Y1 = (const bf16*)(F.ws + WS_YP1); const bf16* Y2 = (const bf16*)(F.ws + WS_YP2);
    for (int m = gw; m < M; m += NGW) {
        f32x4* xr = (f32x4*)(F.out + (size_t)m * D) + plane;
        f32x4 v[4];
#pragma unroll
        for (int j = 0; j < 4; ++j) v[j] = xr[64 * j];
#pragma unroll
        for (int p = 0; p < 2; ++p) {
            const unsigned pk = __builtin_amdgcn_readfirstlane(pinfo[((size_t)m * 2 + p) * 2]); const float wgt = __builtin_bit_cast(float, __builtin_amdgcn_readfirstlane(pinfo[((size_t)m * 2 + p) * 2 + 1]));
            const int e = (int)(pk >> 20), slot = (int)(pk & 0xFFFFFu);
            int tbe = tb[0];
#pragma unroll
            for (int k = 1; k < 8; ++k) tbe = (e == k) ? tb[k] : tbe;
            const int gr = tbe * 256 + slot, seg = gr >> 15, lr = gr & 32767;
            if (seg < 2) { const bf16* yr = (seg == 0 ? Y0 : Y1) + (size_t)lr * D + 4 * plane;
#pragma unroll
                for (int j = 0; j < 4; ++j) { const u32x2 yy = *(const u32x2*)(yr + 256 * j); v[j].x += wgt * bflo(yy.x); v[j].y += wgt * bfhi(yy.x); v[j].z += wgt * bflo(yy.y); v[j].w += wgt * bfhi(yy.y); } }
            else {
#pragma unroll
                for (int ks = 0; ks < 4; ++ks) { const bf16* yr = Y2 + (size_t)ks * (YP2_STRIDE / 2) + (size_t)lr * D + 4 * plane;
#pragma unroll
                    for (int j = 0; j < 4; ++j) { const u32x2 yy = *(const u32x2*)(yr + 256 * j); v[j].x += wgt * bflo(yy.x); v[j].y += wgt * bfhi(yy.x); v[j].z += wgt * bflo(yy.y); v[j].w += wgt * bfhi(yy.y); } } }
        }
        float ssq = 0.f;
#pragma unroll
        for (int j = 0; j < 4; ++j) ssq += (v[j].x * v[j].x + v[j].y * v[j].y) + (v[j].z * v[j].z + v[j].w * v[j].w);
        ssq = wave_sum(ssq);
        const float r = __builtin_amdgcn_rsqf(ssq * (1.f / D) + 1e-6f);
#pragma unroll
        for (int j = 0; j < 4; ++j) { const f32x4 w = *((const f32x4*)fw + plane + 64 * j); xr[64 * j] = v[j] * r * w; }
    }
}
__device__ __forceinline__ void router_phase(Frame& F) {
    const int ptid = otid(), plane = ptid & 63, pwave = __builtin_amdgcn_readfirstlane(ptid >> 6);
    const float* nw = INP(25) + D; const float* rt = INP(29); float* rstd_w = (float*)(F.ws + WS_RSTD); bf16* xb = (bf16*)(F.ws + WS_XB);
    int* cnt = (int*)(F.ws + WS_CNT); int* list2 = (int*)(F.ws + WS_LIST);
    LAS int* lsel = (LAS int*)F.lds;
    LAS float* lwt = (LAS float*)(F.lds + 1024);
    LAS int* lrank = (LAS int*)(F.lds + 2048);
    LAS int* lcnt = (LAS int*)(F.lds + 3072);
    for (int blk = F.vcu; blk < M / 128; blk += F.G) {
        if (ptid < 16) lcnt[ptid] = 0;
        __syncthreads();
        for (int k = 0; k < 16; ++k) {
            const int lt = pwave * 16 + k, m = blk * 128 + lt;
            float acc[8];
#pragma unroll
            for (int e = 0; e < 8; ++e) acc[e] = 0.f;
            const u32x2* xr2 = (const u32x2*)(xb + (size_t)m * D) + plane;
            f32x4 xv4[4]; float ssq = 0.f;
#pragma unroll
            for (int j = 0; j < 4; ++j) { const u32x2 xx = xr2[64 * j]; xv4[j] = (f32x4){bflo(xx.x), bfhi(xx.x), bflo(xx.y), bfhi(xx.y)}; ssq += (xv4[j].x * xv4[j].x + xv4[j].y * xv4[j].y) + (xv4[j].z * xv4[j].z + xv4[j].w * xv4[j].w); }
            ssq = wave_sum(ssq);
#pragma unroll
            for (int j = 0; j < 4; ++j) { const int kk = 4 * plane + 256 * j; const f32x4 nwv = *(const f32x4*)(nw + kk);
#pragma unroll
                for (int q = 0; q < 4; ++q) { const float xv = xv4[j][q] * nwv[q];
                    const f32x4 r0v = *(const f32x4*)(rt + (size_t)(kk + q) * 8), r1v = *(const f32x4*)(rt + (size_t)(kk + q) * 8 + 4);
                    acc[0] += xv * r0v.x; acc[1] += xv * r0v.y; acc[2] += xv * r0v.z; acc[3] += xv * r0v.w; acc[4] += xv * r1v.x; acc[5] += xv * r1v.y; acc[6] += xv * r1v.z; acc[7] += xv * r1v.w; } }
            const float sc = __builtin_amdgcn_rsqf(ssq * (1.f / D) + 1e-6f);
            if (plane == 0) rstd_w[m] = sc;
#pragma unroll
            for (int e = 0; e < 8; ++e) acc[e] = wave_sum(acc[e]) * sc;
            int i0 = 0; float v0 = acc[0];
#pragma unroll
            for (int e = 1; e < 8; ++e) if (acc[e] > v0) { v0 = acc[e]; i0 = e; }
            int i1 = -1; float v1 = -3.0e38f;
#pragma unroll
            for (int e = 0; e < 8; ++e) if (e != i0 && acc[e] > v1) { v1 = acc[e]; i1 = e; }
            const float e1 = expf(v1 - v0), w0 = 1.f / (1.f + e1), w1 = e1 / (1.f + e1);
            if (plane == 0) { lsel[2 * lt] = i0; lsel[2 * lt + 1] = i1; lwt[2 * lt] = w0; lwt[2 * lt + 1] = w1;
                lrank[2 * lt] = atomicAdd((int*)(lcnt + i0), 1); lrank[2 * lt + 1] = atomicAdd((int*)(lcnt + i1), 1); }
        }
        __syncthreads();
        if (ptid < 8) lcnt[8 + ptid] = atomicAdd(cnt + ptid, lcnt[ptid]);
        __syncthreads();
        if (ptid < 256) { const int e = lsel[ptid], slot = lcnt[8 + e] + lrank[ptid];
            u32x2 v; v.x = (unsigned)(blk * 128 + (ptid >> 1)); v.y = __builtin_bit_cast(unsigned, lwt[ptid]);
            *(u32x2*)(list2 + ((size_t)e * 32768 + slot) * 2) = v;
            u32x2 pi; pi.x = ((unsigned)e << 20) | (unsigned)slot; pi.y = v.y; *(u32x2*)((unsigned*)(F.ws + WS_PINFO) + ((size_t)(blk * 128) * 2 + ptid) * 2) = pi; }
        __syncthreads();
    }
}

__device__ __forceinline__ void vprep_phase(Frame& F, int layer) {
    const int ptid = otid(), plane = ptid & 63, pwave = __builtin_amdgcn_readfirstlane(ptid >> 6);
    constexpr int VP = 520, V_VB = 0, V_GB = 64 * VP * 2, V_VD = 2 * 64 * VP * 2;
    LAS bf16* VB = (LAS bf16*)(F.lds + V_VB); LAS bf16* GB = (LAS bf16*)(F.lds + V_GB); LAS bf16* VD = (LAS bf16*)(F.lds + V_VD);
    const bf16* P = (const bf16*)(F.ws + WS_BIG); bf16* VF = (bf16*)(F.ws + WS_VF); bf16* VM = (bf16*)(F.ws + WS_VMIX);
    const bf16* vdT = (const bf16*)(F.ws + WS_VLORA); const bf16* vuT = vdT + 32 * 512;
    const float* mu = INP(3) + layer * 1792 + 1024; const float* v0 = INP(16);
    const int tok = ptid >> 3, part = ptid & 7, r16 = plane & 15, q4 = plane >> 4;
    for (int it = F.vcu; it < M / 64; it += F.G) {
        const int m = it * 64 + tok; const int t = m & (T - 1);
        const bf16* cur = P + (size_t)m * PLD + 1024 + part * 64;
#pragma unroll
        for (int q = 0; q < 8; ++q) { float c[8], p[8]; unpack8(*(const u32x4*)(cur + q * 8), c);
            if (t > 0) unpack8(*(const u32x4*)(cur - PLD + q * 8), p); else {
#pragma unroll
                for (int e = 0; e < 8; ++e) p[e] = 0.f; }
            const f32x4 m0 = *(const f32x4*)(mu + part * 64 + q * 8), m1 = *(const f32x4*)(mu + part * 64 + q * 8 + 4);
#pragma unroll
            for (int e = 0; e < 4; ++e) { c[e] = c[e] + (p[e] - c[e]) * m0[e]; c[4 + e] = c[4 + e] + (p[4 + e] - c[4 + e]) * m1[e]; }
            const u32x4 o = pack8(c);
            if (layer == 0) *(u32x4*)(VF + (size_t)m * 512 + part * 64 + q * 8) = o; else *(LAS u32x4*)(VB + tok * VP + part * 64 + q * 8) = o; }
        if (layer == 0) continue;
        __syncthreads();
        { const int rb = pwave & 3, jt = pwave >> 2; f32x4 acc = {0.f, 0.f, 0.f, 0.f};
#pragma unroll 4
          for (int k0 = 0; k0 < 512; k0 += 32) acc = __builtin_amdgcn_mfma_f32_16x16x32_bf16(*(const LAS bf16x8*)(VB + (16 * rb + r16) * VP + k0 + 8 * q4), *(const bf16x8*)(vdT + (size_t)(16 * jt + r16) * 512 + k0 + 8 * q4), acc, 0, 0, 0);
#pragma unroll
          for (int jj = 0; jj < 4; ++jj) VD[(16 * rb + 4 * q4 + jj) * 40 + 16 * jt + r16] = (bf16)f2bf(acc[jj]); }
        __syncthreads();
        { const int rb = pwave & 3; const bf16x8 af = *(const LAS bf16x8*)(VD + (16 * rb + r16) * 40 + 8 * q4);
#pragma unroll 4
          for (int i = 0; i < 16; ++i) { const int ct = (pwave >> 2) * 16 + i;
              const f32x4 acc = __builtin_amdgcn_mfma_f32_16x16x32_bf16(af, *(const bf16x8*)(vuT + (size_t)(16 * ct + r16) * 32 + 8 * q4), (f32x4){0.f, 0.f, 0.f, 0.f}, 0, 0, 0);
              const float vc = v0[16 * ct + r16];
#pragma unroll
              for (int jj = 0; jj < 4; ++jj) GB[(16 * rb + 4 * q4 + jj) * VP + 16 * ct + r16] = (bf16)f2bf(sigm(vc + acc[jj])); } }
        __syncthreads();
#pragma unroll
        for (int q = 0; q < 8; ++q) { float v[8], g[8], vf[8]; unpack8(*(const LAS u32x4*)(VB + tok * VP + part * 64 + q * 8), v); unpack8(*(const LAS u32x4*)(GB + tok * VP + part * 64 + q * 8), g);
            unpack8(*(const u32x4*)(VF + (size_t)m * 512 + part * 64 + q * 8), vf);
#pragma unroll
            for (int e = 0; e < 8; ++e) v[e] = v[e] + (vf[e] - v[e]) * g[e];
            *(u32x4*)(VM + (size_t)m * 512 + part * 64 + q * 8) = pack8(v); }
        __syncthreads();
    }
}
__device__ __forceinline__ void prepass_a(Frame& F) {
    const int tid = otid();
    bf16* P = (bf16*)(F.ws + WS_BIG); bf16* BND2 = (bf16*)(F.ws + WS_BND2);
    { const int ch = tid & 127; const int kind = ch >> 6, part = ch & 7;
      double invf[4];
#pragma unroll
      for (int p = 0; p < 4; ++p) invf[p] = exp(-(double)(part * 4 + p) * (9.210340371976184 / 32.0));
      for (int m = F.vcu * 4 + (tid >> 7); m < M; m += F.G * 4) {
          const int t = m & (T - 1); bf16* ptr = P + (size_t)m * PLD + C_RET + ch * 8;
          float x[8]; unpack8(*(const u32x4*)ptr, x);
#pragma unroll
          for (int p = 0; p < 4; ++p) { double rev = (double)t * invf[p] * 0.15915494309189535; rev -= floor(rev);
              const float sn = __builtin_amdgcn_sinf((float)rev), cs = __builtin_amdgcn_cosf((float)rev);
              const float x0 = x[2 * p], x1 = x[2 * p + 1]; float o0 = x0 * cs - x1 * sn, o1 = x0 * sn + x1 * cs;
              if (kind) { o0 *= 0.125f; o1 *= 0.125f; }
              x[2 * p] = o0; x[2 * p + 1] = o1; }
          *(u32x4*)ptr = pack8(x); } }
    for (int i = F.vcu * 512 + tid; i < 1024 * 3 * 128; i += F.G * 512) { const int ch = i & 127, k = (i >> 7) % 3, r = i / 384;
        if ((r & 511) != 0) *(u32x4*)(BND2 + ((size_t)r * 3 + k) * 1024 + ch * 8) = *(const u32x4*)(P + ((size_t)r * 32 - 3 + k) * PLD + C_XBC + ch * 8); }
}
__device__ __forceinline__ void prepass_conv(Frame& F, int layer) {
    const int tid = otid();
    bf16* P = (bf16*)(F.ws + WS_BIG); const bf16* BND2 = (const bf16*)(F.ws + WS_BND2);
    const float* cw = INP(17) + layer * 1024 * 4; const float* cbias = INP(18) + layer * 1024;
    const int ch = tid & 127;
    f32x4 wv[8]; float bv[8];
#pragma unroll
    for (int e = 0; e < 8; ++e) { wv[e] = *(const f32x4*)(cw + (ch * 8 + e) * 4); bv[e] = cbias[ch * 8 + e]; }
    for (int r = F.vcu * 4 + (tid >> 7); r < M / 32; r += F.G * 4) {
        float w0[8], w1[8], w2[8];
        if ((r & 511) != 0) { unpack8(*(const u32x4*)(BND2 + ((size_t)r * 3 + 0) * 1024 + ch * 8), w0); unpack8(*(const u32x4*)(BND2 + ((size_t)r * 3 + 1) * 1024 + ch * 8), w1); unpack8(*(const u32x4*)(BND2 + ((size_t)r * 3 + 2) * 1024 + ch * 8), w2); }
        else {
#pragma unroll
            for (int e = 0; e < 8; ++e) { w0[e] = 0.f; w1[e] = 0.f; w2[e] = 0.f; } }
        bf16* ptr = P + (size_t)r * 32 * PLD + C_XBC + ch * 8;
#pragma unroll 4
        for (int i = 0; i < 32; ++i) {
            float x[8], o[8]; unpack8(*(const u32x4*)(ptr + (size_t)i * PLD), x);
#pragma unroll
            for (int e = 0; e < 8; ++e) { o[e] = silu(bv[e] + wv[e][0] * w0[e] + wv[e][1] * w1[e] + wv[e][2] * w2[e] + wv[e][3] * x[e]); w0[e] = w1[e]; w1[e] = w2[e]; w2[e] = x[e]; }
            *(u32x4*)(ptr + (size_t)i * PLD) = pack8(o);
        }
    }
}
template <int CTRL> __device__ __forceinline__ float dpp_f(float v) { return __builtin_bit_cast(float, __builtin_amdgcn_update_dpp(0, __builtin_bit_cast(int, v), CTRL, 0xF, 0xF, true)); }
__device__ __forceinline__ float red8(float v) { v += dpp_f<0xB1>(v); v += dpp_f<0x4E>(v); v += dpp_f<0x141>(v); return v; }
__device__ __forceinline__ float red16(float v) { v = red8(v); v += dpp_f<0x140>(v); return v; }

__device__ __forceinline__ void rwkv_seq(Frame& F, int layer, int bh) {
    const int ptid = otid(), plane = ptid & 63, pwave = __builtin_amdgcn_readfirstlane(ptid >> 6); (void)plane; (void)pwave;
    const int b = bh >> 3, h = bh & 7;
    LAS float* L = (LAS float*)F.lds;
    LAS float *rr = L, *ww = L + 2048, *kf = L + 4096, *vv = L + 6144, *aa = L + 8192, *bb = L + 10240, *gg = L + 12288, *yy = L + 14336, *tw = L + 16384, *xa = L + 18432, *sg = L + 20480, *bon = L + 24576;
    const float* mu = INP(3) + layer * 1792; const float* w_up = INP(4) + layer * 64 * 512; const float* w0 = INP(5) + layer * 512;
    const float* a_up = INP(6) + layer * 64 * 512; const float* a0 = INP(7) + layer * 512; const float* g_up = INP(8) + layer * 128 * 512;
    const float* k_k = INP(9) + layer * 512; const float* k_a = INP(10) + layer * 512; const float* r_k = INP(11) + layer * 512;
    const float* gn_w = INP(12) + layer * 512; const float* gn_b = INP(13) + layer * 512;
    const bf16* P = (const bf16*)(F.ws + WS_BIG); const bf16* vsrc = (const bf16*)(F.ws + (layer == 0 ? WS_VF : WS_VMIX)); bf16* yout = (bf16*)(F.ws + WS_YRW);
    const int tid = ptid, tok = tid >> 4, part = tid & 15, c4 = part * 4, cb = h * 64 + c4;
    const int srow = tid >> 3, sc0 = (tid & 7) * 8;
    float S[8];
#pragma unroll
    for (int j = 0; j < 8; ++j) S[j] = 0.f;
    for (int t0 = 0; t0 < T; t0 += 32) {
        {
            const int t = t0 + tok; const size_t m = (size_t)b * T + t;
            const bf16* cur = P + m * PLD;
#pragma unroll
            for (int q = 0; q < 3; ++q) {
                const int ch = part + 16 * q; int col, kind; LAS float* dst;
                if (ch < 8) { col = h * 64 + ch * 8; dst = rr + tok * 64 + ch * 8; kind = 0; }
                else if (ch < 16) { col = 512 + h * 64 + (ch - 8) * 8; dst = kf + tok * 64 + (ch - 8) * 8; kind = 0; }
                else if (ch < 24) { col = 1536 + (ch - 16) * 8; dst = tw + tok * 64 + (ch - 16) * 8; kind = 1; }
                else if (ch < 32) { col = 1600 + (ch - 24) * 8; dst = xa + tok * 64 + (ch - 24) * 8; kind = 0; }
                else { col = 1664 + (ch - 32) * 8; dst = sg + tok * 128 + (ch - 32) * 8; kind = 2; }
                float c[8], p[8]; unpack8(*(const u32x4*)(cur + col), c);
                if (t > 0) unpack8(*(const u32x4*)(cur - PLD + col), p); else {
#pragma unroll
                    for (int e = 0; e < 8; ++e) p[e] = 0.f; }
#pragma unroll
                for (int e = 0; e < 8; ++e) { float x = c[e] + (p[e] - c[e]) * mu[col + e]; if (kind == 1) x = tanhf(x); else if (kind == 2) x = sigm(x); dst[e] = x; }
            }
            if (part < 8) { float v[8]; unpack8(*(const u32x4*)(vsrc + m * 512 + h * 64 + part * 8), v);
#pragma unroll
                for (int e = 0; e < 8; ++e) vv[tok * 64 + part * 8 + e] = v[e]; }
        }
        __syncthreads();
        {
            f32x4 dw = *(const f32x4*)(w0 + cb), da = *(const f32x4*)(a0 + cb), dg = (f32x4){0.f, 0.f, 0.f, 0.f};
            for (int j = 0; j < 64; ++j) { const float tj = tw[tok * 64 + j], xj = xa[tok * 64 + j];
                dw += *(const f32x4*)(w_up + j * 512 + cb) * tj; da += *(const f32x4*)(a_up + j * 512 + cb) * xj; }
            for (int j = 0; j < 128; ++j) dg += *(const f32x4*)(g_up + j * 512 + cb) * sg[tok * 128 + j];
            float kr[4], kk[4], av[4], ss = 0.f;
#pragma unroll
            for (int e = 0; e < 4; ++e) { kr[e] = kf[tok * 64 + c4 + e]; kk[e] = kr[e] * k_k[cb + e]; ss += kk[e] * kk[e]; av[e] = sigm(da[e]); }
            ss = red16(ss);
            const float inv = __builtin_amdgcn_rsqf(fmaxf(ss, 1e-24f));
            float bs = 0.f;
#pragma unroll
            for (int e = 0; e < 4; ++e) { const float kn = kk[e] * inv; const int o = tok * 64 + c4 + e;
                const float ld = -expf(-softplus_acc(-dw[e]) - 0.5f);
                ww[o] = expf(ld); aa[o] = -kn; bb[o] = kn * av[e];
                const float knew = kr[e] * (1.f + (av[e] - 1.f) * k_a[cb + e]); kf[o] = knew; gg[o] = dg[e];
                bs += rr[o] * knew * r_k[cb + e]; }
            bs = red16(bs);
            if (part == 0) bon[tok] = bs;
        }
        __syncthreads();
        for (int s = 0; s < 32; ++s) {
            const f32x4 a0v = *(const LAS f32x4*)(aa + s * 64 + sc0), a1v = *(const LAS f32x4*)(aa + s * 64 + sc0 + 4);
            const f32x4 w0v = *(const LAS f32x4*)(ww + s * 64 + sc0), w1v = *(const LAS f32x4*)(ww + s * 64 + sc0 + 4);
            const f32x4 b0v = *(const LAS f32x4*)(bb + s * 64 + sc0), b1v = *(const LAS f32x4*)(bb + s * 64 + sc0 + 4);
            const f32x4 k0v = *(const LAS f32x4*)(kf + s * 64 + sc0), k1v = *(const LAS f32x4*)(kf + s * 64 + sc0 + 4);
            const f32x4 r0v = *(const LAS f32x4*)(rr + s * 64 + sc0), r1v = *(const LAS f32x4*)(rr + s * 64 + sc0 + 4);
            const float vi = vv[s * 64 + srow];
            float sa = 0.f;
#pragma unroll
            for (int j = 0; j < 4; ++j) sa += S[j] * a0v[j] + S[4 + j] * a1v[j];
            sa = red8(sa);
            float y = 0.f;
#pragma unroll
            for (int j = 0; j < 4; ++j) { S[j] = S[j] * w0v[j] + sa * b0v[j] + vi * k0v[j]; S[4 + j] = S[4 + j] * w1v[j] + sa * b1v[j] + vi * k1v[j]; y += S[j] * r0v[j] + S[4 + j] * r1v[j]; }
            y = red8(y);
            if ((tid & 7) == 0) yy[s * 64 + srow] = y;
        }
        __syncthreads();
        {
            const size_t m = (size_t)b * T + t0 + tok;
            float y[4], sm = 0.f;
#pragma unroll
            for (int e = 0; e < 4; ++e) { y[e] = yy[tok * 64 + c4 + e]; sm += y[e]; }
            const float mean = red16(sm) * (1.f / 64.f);
            float vs = 0.f;
#pragma unroll
            for (int e = 0; e < 4; ++e) { y[e] -= mean; vs += y[e] * y[e]; }
            const float rs = __builtin_amdgcn_rsqf(red16(vs) * (1.f / 64.f) + 64e-5f);
            const float bo = bon[tok];
            float o[4];
#pragma unroll
            for (int e = 0; e < 4; ++e) { const int idx = tok * 64 + c4 + e; o[e] = (y[e] * rs * gn_w[cb + e] + gn_b[cb + e] + bo * vv[idx]) * gg[idx]; }
            u32x2 w; w.x = pk2(o[0], o[1]); w.y = pk2(o[2], o[3]);
            *(u32x2*)(yout + m * 512 + cb) = w;
        }
        __syncthreads();
    }
}

__device__ __forceinline__ void ret_seq(Frame& F, int bh) {
    const int ptid = otid(), plane = ptid & 63, pwave = __builtin_amdgcn_readfirstlane(ptid >> 6); (void)plane; (void)pwave;
    const int b = bh >> 3, h = bh & 7;
    LAS float* L = (LAS float*)F.lds;
    LAS float *qq = L, *kk = L + 2048, *vv = L + 4096, *gg = L + 6144, *yy = L + 8192;
    bf16* P = (bf16*)(F.ws + WS_BIG);
    const int tid = ptid, tok = tid >> 4, part = tid & 15, c4 = part * 4;
    const int se = tid >> 3, sd0 = (tid & 7) * 8;
    const float gamma = 1.f - exp2f(-5.f - (float)h);
    float S[8];
#pragma unroll
    for (int j = 0; j < 8; ++j) S[j] = 0.f;
    for (int t0 = 0; t0 < T; t0 += 32) {
        {
            const int t = t0 + tok; const size_t m = (size_t)b * T + t;
#pragma unroll
            for (int q = 0; q < 2; ++q) {
                const int ch = part + 16 * q, kind = ch >> 3, cc = ch & 7;
                float x[8]; unpack8(*(const u32x4*)(P + m * PLD + C_RET + kind * 512 + h * 64 + cc * 8), x);
                LAS float* dst = (kind == 0 ? qq : kind == 1 ? kk : kind == 2 ? vv : gg) + tok * 64 + cc * 8;
                if (kind < 2) {
#pragma unroll
                    for (int p = 0; p < 4; ++p) { const int i = cc * 4 + p;
                        const double invf = exp(-(double)i * (9.210340371976184 / 32.0));
                        double sn, cs; sincos((double)t * invf, &sn, &cs);
                        const float x0 = x[2 * p], x1 = x[2 * p + 1], c = (float)cs, s = (float)sn;
                        float o0 = x0 * c - x1 * s, o1 = x0 * s + x1 * c;
                        if (kind == 1) { o0 *= 0.125f; o1 *= 0.125f; }
                        dst[2 * p] = o0; dst[2 * p + 1] = o1; }
                } else {
#pragma unroll
                    for (int e = 0; e < 8; ++e) dst[e] = x[e];
                }
            }
        }
        __syncthreads();
        for (int s = 0; s < 32; ++s) {
            const f32x4 k0v = *(const LAS f32x4*)(kk + s * 64 + sd0), k1v = *(const LAS f32x4*)(kk + s * 64 + sd0 + 4);
            const f32x4 q0v = *(const LAS f32x4*)(qq + s * 64 + sd0), q1v = *(const LAS f32x4*)(qq + s * 64 + sd0 + 4);
            const float ve = vv[s * 64 + se];
            float y = 0.f;
#pragma unroll
            for (int j = 0; j < 4; ++j) { S[j] = gamma * S[j] + k0v[j] * ve; S[4 + j] = gamma * S[4 + j] + k1v[j] * ve; y += q0v[j] * S[j] + q1v[j] * S[4 + j]; }
            y = red8(y);
            if ((tid & 7) == 0) yy[s * 64 + se] = y;
        }
        __syncthreads();
        {
            const size_t m = (size_t)b * T + t0 + tok;
            float y[4], ss = 0.f;
#pragma unroll
            for (int e = 0; e < 4; ++e) { y[e] = yy[tok * 64 + c4 + e]; ss += y[e] * y[e]; }
            const float rs = __builtin_amdgcn_rsqf(red16(ss) * (1.f / 64.f) + 1e-6f);
            float o[4];
#pragma unroll
            for (int e = 0; e < 4; ++e) o[e] = y[e] * rs * silu(gg[tok * 64 + c4 + e]);
            u32x2 w; w.x = pk2(o[0], o[1]); w.y = pk2(o[2], o[3]);
            *(u32x2*)(P + m * PLD + C_RETG + h * 64 + c4) = w;
        }
        __syncthreads();
    }
}

__device__ __forceinline__ void ssd_seq(Frame& F, int layer, int bh) {
    const int ptid = otid(), plane = ptid & 63, pwave = __builtin_amdgcn_readfirstlane(ptid >> 6); (void)plane; (void)pwave;
    const int b = bh >> 3, h = bh & 7, g = h >> 2;
    LAS float* L = (LAS float*)F.lds;
    LAS float *raw = L  , *xs = L + 11200, *Bc = L + 13248, *Cc = L + 17344, *yy = L + 21440, *dts = L + 23488, *das = L + 23520;
    bf16* P = (bf16*)(F.ws + WS_BIG); const float* dtb = (const float*)(F.ws + WS_DT);
    const float* cw = INP(17) + layer * 1024 * 4; const float* cbias = INP(18) + layer * 1024;
    const float dt_bias = INP(19)[layer * 8 + h], A = -expf(INP(20)[layer * 8 + h]), Dh = INP(21)[layer * 8 + h];
    const int tid = ptid;
    const int sp = tid >> 3, sn0 = (tid & 7) * 16;
    float S[16];
#pragma unroll
    for (int j = 0; j < 16; ++j) S[j] = 0.f;
    for (int i = tid; i < 3 * 320; i += 512) raw[i] = 0.f;
    __syncthreads();
    for (int t0 = 0; t0 < T; t0 += 32) {
        for (int idx = tid; idx < 32 * 40; idx += 512) {
            const int row = idx / 40, ch = idx % 40; const size_t m = (size_t)b * T + t0 + row;
            const int col = ch < 8 ? (C_XBC + h * 64 + ch * 8) : (ch < 24 ? (C_XBC + 512 + g * 128 + (ch - 8) * 8) : (C_XBC + 768 + g * 128 + (ch - 24) * 8));
            float x[8]; unpack8(*(const u32x4*)(P + m * PLD + col), x);
#pragma unroll
            for (int e = 0; e < 8; ++e) raw[(3 + row) * 320 + ch * 8 + e] = x[e];
        }
        if (tid < 32) { const size_t m = (size_t)b * T + t0 + tid; const float dt = softplus_acc(dtb[m * 8 + h] + dt_bias); dts[tid] = dt; das[tid] = expf(A * dt); }
        __syncthreads();
        for (int idx = tid; idx < 32 * 320; idx += 512) {
            const int row = idx / 320, c = idx % 320;
            const int chn = c < 64 ? (h * 64 + c) : (c < 192 ? (512 + g * 128 + (c - 64)) : (768 + g * 128 + (c - 192)));
            float a = cbias[chn];
#pragma unroll
            for (int k = 0; k < 4; ++k) a += cw[chn * 4 + k] * raw[(row + k) * 320 + c];
            a = silu(a);
            if (c < 64) xs[row * 64 + c] = a; else if (c < 192) Bc[row * 128 + (c - 64)] = a; else Cc[row * 128 + (c - 192)] = a;
        }
        __syncthreads();
        for (int s = 0; s < 32; ++s) {
            const float da = das[s], xv = xs[s * 64 + sp], dtx = dts[s] * xv;
            float y = 0.f;
#pragma unroll
            for (int q = 0; q < 4; ++q) { const f32x4 bv = *(const LAS f32x4*)(Bc + s * 128 + sn0 + q * 4), cv = *(const LAS f32x4*)(Cc + s * 128 + sn0 + q * 4);
#pragma unroll
                for (int j = 0; j < 4; ++j) { S[q * 4 + j] = da * S[q * 4 + j] + dtx * bv[j]; y += S[q * 4 + j] * cv[j]; } }
            y = red8(y);
            if ((tid & 7) == 0) yy[s * 64 + sp] = y + Dh * xv;
        }
        __syncthreads();
        {
            const int tok = tid >> 4, c4 = (tid & 15) * 4; const size_t m = (size_t)b * T + t0 + tok;
            u32x2 w; w.x = pk2(yy[tok * 64 + c4], yy[tok * 64 + c4 + 1]); w.y = pk2(yy[tok * 64 + c4 + 2], yy[tok * 64 + c4 + 3]);
            *(u32x2*)(P + m * PLD + C_XBC + h * 64 + c4) = w;
            for (int i = tid; i < 3 * 320; i += 512) raw[i] = raw[32 * 320 + i];
        }
        __syncthreads();
    }
}
__device__ __forceinline__ void ssm_norm_phase(Frame& F, int layer) {
    const int ptid = otid(), plane = ptid & 63, pwave = __builtin_amdgcn_readfirstlane(ptid >> 6); (void)plane; (void)pwave;
    const int gw = F.vcu * 8 + pwave, NGW = F.G * 8;
    bf16* P = (bf16*)(F.ws + WS_BIG); const float* nw = INP(22) + layer * 512;
    for (int m = gw; m < M; m += NGW) {
        float y[8], z[8]; unpack8(*(const u32x4*)(P + (size_t)m * PLD + C_XBC + plane * 8), y); unpack8(*(const u32x4*)(P + (size_t)m * PLD + C_Z + plane * 8), z);
        float ss = 0.f;
#pragma unroll
        for (int e = 0; e < 8; ++e) { y[e] *= silu(z[e]); ss += y[e] * y[e]; }
        ss += __shfl_xor(ss, 1); ss += __shfl_xor(ss, 2); ss += __shfl_xor(ss, 4); ss += __shfl_xor(ss, 8); ss += __shfl_xor(ss, 16);
        const float rs = __builtin_amdgcn_rsqf(ss * (1.f / 256.f) + 1e-6f);
#pragma unroll
        for (int e = 0; e < 8; ++e) y[e] *= rs * nw[plane * 8 + e];
        *(u32x4*)(P + (size_t)m * PLD + C_Z + plane * 8) = pack8(y);
    }
}

constexpr int PT = 72, PT2 = 136, PF = 68;
__device__ __forceinline__ f32x4 mfma16(bf16x8 a, bf16x8 b, f32x4 c) { return __builtin_amdgcn_mfma_f32_16x16x32_bf16(a, b, c, 0, 0, 0); }
template <int K, bool SA = false, bool SB = false> __device__ __forceinline__ f32x4 mm_ll(const LAS bf16* A, int pa, int m0, const LAS bf16* B, int pb, int n0, f32x4 acc, int lane) {
    const int r = lane & 15, q = lane >> 4;
    const int xa = SA ? (((m0 + r) >> 3) & 7) : 0, xb = SB ? (((n0 + r) >> 3) & 7) : 0;
    const LAS bf16* ap = A + (m0 + r) * pa; const LAS bf16* bp = B + (n0 + r) * pb;
#pragma unroll
    for (int k0 = 0; k0 < K; k0 += 32) acc = mfma16(*(const LAS bf16x8*)(ap + 8 * (((k0 >> 3) + q) ^ xa)), *(const LAS bf16x8*)(bp + 8 * (((k0 >> 3) + q) ^ xb)), acc);
    return acc;
}
template <int K> __device__ __forceinline__ f32x4 mm_lg(const LAS bf16* A, int pa, int m0, const bf16* B, int pb, int n0, f32x4 acc, int lane) {
    const int r = lane & 15, q = lane >> 4;
    const LAS bf16* ap = A + (m0 + r) * pa + 8 * q; const bf16* bp = B + (size_t)(n0 + r) * pb + 8 * q;
#pragma unroll
    for (int k0 = 0; k0 < K; k0 += 32) acc = mfma16(*(const LAS bf16x8*)(ap + k0), *(const bf16x8*)(bp + k0), acc);
    return acc;
}
__device__ __forceinline__ float redl16(float v) { return red16(v); }
__device__ __forceinline__ void st4bf(LAS bf16* p, f32x4 v) { u32x2 w; w.x = pk2(v[0], v[1]); w.y = pk2(v[2], v[3]); *(LAS u32x2*)p = w; }
__device__ __forceinline__ float ldbf(const LAS bf16* p) { return __builtin_bit_cast(float, (unsigned)(*p) << 16); }
constexpr f32x4 FZ4 = {0.f, 0.f, 0.f, 0.f};
__device__ __forceinline__ void tr_write8(LAS bf16* Tm, int pitch, int c0, int t, const float (&v)[8], int) {
    LAS bf16* base = Tm + c0 * pitch + (t ^ (((c0 >> 3) & 7) << 3));
#pragma unroll
    for (int e = 0; e < 8; ++e) base[e * pitch] = (bf16)f2bf(v[e]);
}
__device__ __forceinline__ float tr_at(const LAS bf16* Tm, int pitch, int row, int col) { return __builtin_bit_cast(float, (unsigned)Tm[row * pitch + (col ^ (((row >> 3) & 7) << 3))] << 16); }
__device__ __forceinline__ void ld8f(const LAS float* p, float (&v)[8]) { const f32x4 a = *(const LAS f32x4*)p, b = *(const LAS f32x4*)(p + 4); v[0] = a[0]; v[1] = a[1]; v[2] = a[2]; v[3] = a[3]; v[4] = b[0]; v[5] = b[1]; v[6] = b[2]; v[7] = b[3]; }
__device__ __forceinline__ void st8f(LAS float* p, const float (&v)[8]) { *(LAS f32x4*)p = (f32x4){v[0], v[1], v[2], v[3]}; *(LAS f32x4*)(p + 4) = (f32x4){v[4], v[5], v[6], v[7]}; }

template <bool FINAL>
__device__ __forceinline__ void rwkv_chunk_unit(Frame& F, int layer, int u) {
    const int tid = otid(), w = __builtin_amdgcn_readfirstlane(tid >> 6);
    bf16x8 lfr[16];
#define IDS() const int ft = fresh_tid(tid); const int lane = ft & 63, r16 = lane & 15, q4 = lane >> 4, tok = ft >> 3, part = ft & 7; (void)lane; (void)r16; (void)q4; (void)tok; (void)part
    const int b = u >> 9, sc = (u >> 3) & 63, h = u & 7;
    constexpr int NV = FINAL ? 64 : 128, NVT = NV / 16, NZ = NVT / 2;
    constexpr int X_TW = 0, X_XA = 9216, X_SG = 18432, X_KF = 35840, X_RF = 52224;
    constexpr int O_AT = 0, O_RT = 9216, O_BT = 18432, O_KT = 27648, O_BH = 36864, O_KH = 46080, O_VT = 55296, O_TF = O_BT;
    constexpr int Y0 = 68608;
    constexpr int Y_A = Y0, Y_B = Y0 + 8192, Y_K = Y0 + 16384, Y_R = Y0 + 24576, Y_L = Y0 + 32768, Y_VF = Y0 + 49152;
    constexpr int Y_AAB = Y0, Y_AAK = Y0 + 17408, Y_ARB = Y_AAK + 9216, Y_ARK = Y_ARB + 9216, Y_TB = FINAL ? Y_ARK + 9216 : Y_AAK + 9216, Y_ZU = Y_TB + 9216, Y_YF = Y_AAB;
    static_assert(Y_ZU + NV * PT * 2 <= Y0 + 65536, "region Y");
    constexpr int Z0 = Y0 + 65536, Z_G = Z0, Z_S = FINAL ? Z0 + 8192 : Z0, Z_MISC = 152576, Z_BON = Z_MISC, Z_PC = Z_MISC + 256, Z_PAR = Z_MISC + 512, Z_XS = Y_ZU;
    static_assert(Z_S + NV * PT * 2 <= Z_MISC && Z_PAR + 832 * 4 <= LDSCTL_OFF, "region Z");
    LAS unsigned char* L = F.lds;
#define LB(off) ((LAS bf16*)(L + (off)))
#define LF(off) ((LAS float*)(L + (off)))
    {
        const int pidx = (w == 0) ? 5 : (w == 1) ? 7 : (w == 2) ? 9 : (w == 3) ? 10 : (w == 4) ? 11 : (w == 5) ? 12 : 13;
        if (w < 7) LF(Z_PAR)[w * 64 + (tid & 63)] = (INP(pidx) + layer * 512 + h * 64)[tid & 63];
        const float* mu = INP(3) + layer * 1792;
        for (int i = tid; i < 384; i += 512) LF(Z_PAR)[448 + i] = mu[(i < 64) ? (h * 64 + i) : (i < 128) ? (512 + h * 64 + (i - 64)) : (1536 + (i - 128))];
    }
    __syncthreads();
    const bf16* WupT = (const bf16*)(F.ws + WS_LORA + (size_t)layer * LORA_STRIDE) + h * 64 * 64;
    const bf16* AupT = (const bf16*)(F.ws + WS_LORA + (size_t)layer * LORA_STRIDE + 65536) + h * 64 * 64;
    const bf16* GupT = (const bf16*)(F.ws + WS_LORA + (size_t)layer * LORA_STRIDE + 131072) + h * 64 * 128;
    const bf16* P = (const bf16*)(F.ws + WS_BIG); const bf16* vsrc = (const bf16*)(F.ws + (layer == 0 ? WS_VF : WS_VMIX));
    float* Nbuf = (float*)(F.st + 0) + (size_t)u * 4096; bf16* MT = (bf16*)(F.ws + WS_MT) + (size_t)u * 4096;
    { IDS();
        if (w < 4) {
#pragma unroll
            for (int nt = 0; nt < 4; ++nt)
#pragma unroll
                for (int k2 = 0; k2 < 2; ++k2) { lfr[nt * 4 + k2] = *(const bf16x8*)(WupT + (size_t)(16 * nt + r16) * 64 + 32 * k2 + 8 * q4); lfr[nt * 4 + 2 + k2] = *(const bf16x8*)(AupT + (size_t)(16 * nt + r16) * 64 + 32 * k2 + 8 * q4); }
        } else if (FINAL) {
#pragma unroll
            for (int nt = 0; nt < 4; ++nt)
#pragma unroll
                for (int k4 = 0; k4 < 4; ++k4) lfr[nt * 4 + k4] = *(const bf16x8*)(GupT + (size_t)(16 * nt + r16) * 128 + 32 * k4 + 8 * q4);
        } }
    constexpr int NST = FINAL ? 2 : 4;
    f32x4 Sacc[NST];
    const int s_vb = FINAL ? (w & 3) : w;
#define S_CT(ti) (FINAL ? (2 * (w >> 2) + (ti)) : (ti))
    { IDS();
#pragma unroll
    for (int ti = 0; ti < NST; ++ti) {
        const int ct = S_CT(ti);
#pragma unroll
        for (int jj = 0; jj < 4; ++jj) { const int v = 16 * s_vb + 4 * q4 + jj, c = 16 * ct + r16;
            float x; if (FINAL) x = Nbuf[v * 64 + c]; else x = (v >= 64 && v - 64 == c) ? 1.f : 0.f;
            Sacc[ti][jj] = x; LB(Z_S)[v * PT + c] = (bf16)f2bf(x); }
    } }
    u32x4 pfc[6], pfp[6], pfv;
#define RW_PREFETCH(jn) do { IDS(); const int t_ = sc * 256 + (jn) * 64 + tok; const size_t m_ = (size_t)b * T + t_; const bf16* cur_ = P + m_ * PLD; \
        _Pragma("unroll") for (int i_ = 0; i_ < 6; ++i_) { const int col_ = (i_ == 0) ? (h * 64 + 8 * part) : (i_ == 1) ? (512 + h * 64 + 8 * part) : (i_ == 2) ? (1536 + 8 * part) : (i_ == 3) ? (1600 + 8 * part) : (1664 + 8 * part + (i_ - 4) * 64); \
            pfc[i_] = *(const u32x4*)(cur_ + col_); pfp[i_] = (t_ > 0) ? *(const u32x4*)(cur_ - PLD + col_) : (u32x4){0u, 0u, 0u, 0u}; } \
        pfv = *(const u32x4*)(vsrc + m_ * 512 + h * 64 + 8 * part); } while (0)
    RW_PREFETCH(0);
    for (int j = 0; j < 4; ++j) {
        const int tl0 = sc * 256 + j * 64;
        {
            IDS();
            const int t = tl0 + tok; const size_t m = (size_t)b * T + t; const bf16* cur = P + m * PLD;
#pragma unroll
            for (int i = 0; i < 6; ++i) {
                const int col = (i == 0) ? (h * 64 + 8 * part) : (i == 1) ? (512 + h * 64 + 8 * part) : (i == 2) ? (1536 + 8 * part) : (i == 3) ? (1600 + 8 * part) : (1664 + 8 * part + (i - 4) * 64);
                float c[8], p[8]; unpack8(pfc[i], c); unpack8(pfp[i], p); (void)col;
#pragma unroll
                for (int e = 0; e < 8; ++e) c[e] = c[e] + (p[e] - c[e]) * LF(Z_PAR)[448 + ((i < 4) ? 64 * i : 256 + 64 * (i - 4)) + 8 * part + e];
                if (i == 0) { st8f(LF(X_RF) + tok * 64 + 8 * part, c);
                } else if (i == 1) { st8f(LF(X_KF) + tok * 64 + 8 * part, c);
                } else if (i == 2) {
#pragma unroll
                    for (int e = 0; e < 8; ++e) c[e] = fast_tanh(c[e]);
                    *(LAS u32x4*)(LB(X_TW) + tok * PT + 8 * part) = pack8(c);
                } else if (i == 3) {
                    *(LAS u32x4*)(LB(X_XA) + tok * PT + 8 * part) = pack8(c);
                } else if (FINAL) {
#pragma unroll
                    for (int e = 0; e < 8; ++e) c[e] = sigm(c[e]);
                    *(LAS u32x4*)(LB(X_SG) + tok * PT2 + 8 * part + (i - 4) * 64) = pack8(c);
                }
            }
            float v[8]; unpack8(pfv, v); (void)m; (void)cur;
            st8f(LF(Y_VF) + tok * 64 + 8 * part, v);
        }
        if (j < 3) RW_PREFETCH(j + 1);
        __syncthreads();
        { IDS();
        if (w < 4) {
            const int rb = w;
            float inv[4], bs[4] = {0.f, 0.f, 0.f, 0.f};
            { float ss[4] = {0.f, 0.f, 0.f, 0.f};
#pragma unroll
                for (int nt = 0; nt < 4; ++nt) { const int c = 16 * nt + r16; const float kkc = LF(Z_PAR)[128 + c];
#pragma unroll
                    for (int jj = 0; jj < 4; ++jj) { const float kk = LF(X_KF)[(16 * rb + 4 * q4 + jj) * 64 + c] * kkc; ss[jj] += kk * kk; } }
#pragma unroll
                for (int jj = 0; jj < 4; ++jj) inv[jj] = __builtin_amdgcn_rsqf(fmaxf(redl16(ss[jj]), 1e-24f)); }
#pragma unroll
            for (int nt = 0; nt < 4; ++nt) {
                f32x4 aw = FZ4, aa = FZ4;
#pragma unroll
                for (int k2 = 0; k2 < 2; ++k2) { aw = mfma16(*(const LAS bf16x8*)(LB(X_TW) + (16 * rb + r16) * PT + 32 * k2 + 8 * q4), lfr[nt * 4 + k2], aw); aa = mfma16(*(const LAS bf16x8*)(LB(X_XA) + (16 * rb + r16) * PT + 32 * k2 + 8 * q4), lfr[nt * 4 + 2 + k2], aa); }
                const int c = 16 * nt + r16; const float w0c = LF(Z_PAR)[c], a0c = LF(Z_PAR)[64 + c], kkc = LF(Z_PAR)[128 + c], kac = LF(Z_PAR)[192 + c], rkc = LF(Z_PAR)[256 + c];
#pragma unroll
                for (int jj = 0; jj < 4; ++jj) { const int t = 16 * rb + 4 * q4 + jj, o = t * 64 + c;
                    LF(Y_L)[o] = -0.8750455979f * sigm(w0c + aw[jj]);
                    const float al = sigm(a0c + aa[jj]), kraw = LF(X_KF)[o], rr = LF(X_RF)[o], kn = kraw * kkc * inv[jj];
                    const float knew = kraw * (1.f + (al - 1.f) * kac);
                    LB(Y_A)[o] = (bf16)f2bf(-kn); LB(Y_B)[o] = (bf16)f2bf(kn * al); LB(Y_K)[o] = (bf16)f2bf(knew); LB(Y_R)[o] = (bf16)f2bf(rr);
                    bs[jj] += rr * knew * rkc; } }
#pragma unroll
            for (int jj = 0; jj < 4; ++jj) { const float sm = redl16(bs[jj]); if (r16 == 0) LF(Z_BON)[16 * rb + 4 * q4 + jj] = sm; }
        } else if (FINAL) {
            const int rb = w - 4;
#pragma unroll
            for (int nt = 0; nt < 4; ++nt) { f32x4 ag = FZ4;
#pragma unroll
                for (int k4 = 0; k4 < 4; ++k4) ag = mfma16(*(const LAS bf16x8*)(LB(X_SG) + (16 * rb + r16) * PT2 + 32 * k4 + 8 * q4), lfr[nt * 4 + k4], ag);
#pragma unroll
                for (int jj = 0; jj < 4; ++jj) LB(Z_G)[(16 * rb + 4 * q4 + jj) * 64 + 16 * nt + r16] = (bf16)f2bf(ag[jj]); }
        } }
        __syncthreads();
        if (w == 0) { IDS(); float run = 0.f;
#pragma unroll 8
            for (int t = 0; t < 64; ++t) { run += LF(Y_L)[t * 64 + lane]; LF(Y_L)[t * 64 + lane] = run; }
            LF(Z_PC)[lane] = ex2(run); }
        __syncthreads();
        {
            IDS(); const int t = tok, c0 = 8 * part;
            float Lt[8], Lp[8], Le[8], av[8], bv[8], kv[8], rv[8], vv[8], at[8], rt[8], bt[8], kt[8], bh[8], kh[8];
            ld8f(LF(Y_L) + t * 64 + c0, Lt); ld8f(LF(Y_L) + 63 * 64 + c0, Le); ld8f(LF(Y_VF) + t * 64 + c0, vv);
            if (t > 0) ld8f(LF(Y_L) + (t - 1) * 64 + c0, Lp); else {
#pragma unroll
                for (int e = 0; e < 8; ++e) Lp[e] = 0.f; }
            unpack8(*(const LAS u32x4*)(LB(Y_A) + t * 64 + c0), av); unpack8(*(const LAS u32x4*)(LB(Y_B) + t * 64 + c0), bv);
            unpack8(*(const LAS u32x4*)(LB(Y_K) + t * 64 + c0), kv); unpack8(*(const LAS u32x4*)(LB(Y_R) + t * 64 + c0), rv);
#pragma unroll
            for (int e = 0; e < 8; ++e) { const float eL = ex2(Lt[e]), eLm = ex2(Lp[e]), eN = ex2(-Lt[e]), eE = ex2(Le[e] - Lt[e]);
                at[e] = av[e] * eLm; rt[e] = rv[e] * eL; bt[e] = bv[e] * eN; kt[e] = kv[e] * eN; bh[e] = bv[e] * eE; kh[e] = kv[e] * eE; }
            tr_write8(LB(O_BH), PT, c0, t, bh, part); tr_write8(LB(O_KH), PT, c0, t, kh, part); tr_write8(LB(O_VT), PT, c0, t, vv, part);
            *(LAS u32x4*)(LB(O_AT) + t * PT + c0) = pack8(at); *(LAS u32x4*)(LB(O_RT) + t * PT + c0) = pack8(rt);
            *(LAS u32x4*)(LB(O_BT) + t * PT + c0) = pack8(bt); *(LAS u32x4*)(LB(O_KT) + t * PT + c0) = pack8(kt);
        }
        __syncthreads();
        {
            IDS(); const int rb = w & 3;
#pragma unroll
            for (int ci = 0; ci < 2; ++ci) { const int ct = 2 * (w >> 2) + ci;
                f32x4 ab = FZ4, ak = FZ4, arb = FZ4, ark = FZ4;
                if (ct <= rb) { ab = mm_ll<64>(LB(O_AT), PT, 16 * rb, LB(O_BT), PT, 16 * ct, FZ4, lane); ak = mm_ll<64>(LB(O_AT), PT, 16 * rb, LB(O_KT), PT, 16 * ct, FZ4, lane);
                    if (FINAL) { arb = mm_ll<64>(LB(O_RT), PT, 16 * rb, LB(O_BT), PT, 16 * ct, FZ4, lane); ark = mm_ll<64>(LB(O_RT), PT, 16 * rb, LB(O_KT), PT, 16 * ct, FZ4, lane); } }
#pragma unroll
                for (int jj = 0; jj < 4; ++jj) { const int t = 16 * rb + 4 * q4 + jj, i = 16 * ct + r16;
                    LF(Y_AAB)[t * PF + i] = (i < t) ? ab[jj] : 0.f; LB(Y_TB)[t * PT + i] = (bf16)f2bf(((i >> 4) < (t >> 4)) ? ab[jj] : 0.f); LB(Y_AAK)[t * PT + i] = (bf16)f2bf((i < t) ? ak[jj] : 0.f);
                    if (FINAL) { LB(Y_ARB)[t * PT + i] = (bf16)f2bf((i <= t) ? arb[jj] : 0.f); LB(Y_ARK)[t * PT + i] = (bf16)f2bf((i <= t) ? ark[jj] : 0.f); } } }
        }
        __syncthreads();
        {
            IDS(); const int rb = w & 3;
            constexpr int O_DB = O_BT, O_VB = O_BT + 5120;
            if (w == 0) { const int blk = lane >> 4, col = lane & 15; float x[16];
#pragma unroll
                for (int i = 0; i < 16; ++i) x[i] = (i == col) ? 1.f : 0.f;
#pragma unroll
                for (int g3 = 0; g3 < 3; ++g3) {
                    f32x4 ar[5][4];
#pragma unroll
                    for (int ii = 0; ii < 5; ++ii) { const int i = 1 + 5 * g3 + ii;
#pragma unroll
                        for (int g4 = 0; g4 < 4; ++g4) if (4 * g4 < i) ar[ii][g4] = *(const LAS f32x4*)(LF(Y_AAB) + (16 * blk + i) * PF + 16 * blk + 4 * g4); }
                    asm volatile("" ::: "memory");
#pragma unroll
                    for (int ii = 0; ii < 5; ++ii) { const int i = 1 + 5 * g3 + ii; float sacc = 0.f;
#pragma unroll
                        for (int m2 = 0; m2 < i; ++m2) sacc += ar[ii][m2 >> 2][m2 & 3] * x[m2];
                        x[i] += sacc; }
                }
#pragma unroll
                for (int i = 0; i < 16; ++i) LB(O_DB)[(16 * blk + i) * 40 + col] = (bf16)f2bf(x[i]);
                *(LAS u32x4*)(LB(O_DB) + lane * 40 + 16) = (u32x4){0u, 0u, 0u, 0u}; *(LAS u32x4*)(LB(O_DB) + lane * 40 + 24) = (u32x4){0u, 0u, 0u, 0u}; }
            if (lane < 16) { *(LAS u32x4*)(LB(O_VB) + w * 640 + lane * 40 + 16) = (u32x4){0u, 0u, 0u, 0u}; *(LAS u32x4*)(LB(O_VB) + w * 640 + lane * 40 + 24) = (u32x4){0u, 0u, 0u, 0u}; }
#pragma unroll
            for (int ci = 0; ci < NZ; ++ci) { const int vt = (w >> 2) * NZ + ci;
                f32x4 z = mm_ll<64>(LB(O_AT), PT, 16 * rb, LB(Z_S), PT, 16 * vt, FZ4, lane);
                if (vt < 4) z = mm_ll<64, false, true>(LB(Y_AAK), PT, 16 * rb, LB(O_VT), PT, 16 * vt, z, lane);
                st4bf(LB(Y_ZU) + (16 * vt + r16) * PT + 16 * rb + 4 * q4, z); }
            __syncthreads();
            if (w < NVT) { const int vt = w; LAS bf16* vb = LB(O_VB) + w * 640; LAS bf16* zrow = LB(Y_ZU) + (16 * vt + r16) * PT;
#pragma unroll
                for (int bb = 0; bb < 4; ++bb) {
                    f32x4 acc; { const u32x2 zz = *(const LAS u32x2*)(zrow + 16 * bb + 4 * q4); acc[0] = bflo(zz.x); acc[1] = bfhi(zz.x); acc[2] = bflo(zz.y); acc[3] = bfhi(zz.y); }
                    if (bb >= 1) acc = mfma16(*(const LAS bf16x8*)(LB(Y_TB) + (16 * bb + r16) * PT + 8 * q4), *(const LAS bf16x8*)(zrow + 8 * q4), acc);
                    if (bb >= 3) acc = mfma16(*(const LAS bf16x8*)(LB(Y_TB) + (16 * bb + r16) * PT + 32 + 8 * q4), *(const LAS bf16x8*)(zrow + 32 + 8 * q4), acc);
                    st4bf(vb + r16 * 40 + 4 * q4, acc);
                    const f32x4 ub = mfma16(*(const LAS bf16x8*)(LB(O_DB) + (16 * bb + r16) * 40 + 8 * q4), *(const LAS bf16x8*)(vb + r16 * 40 + 8 * q4), FZ4);
                    st4bf(zrow + 16 * bb + 4 * q4, ub); }
            }
        }
        __syncthreads();
        {
            IDS(); f32x4 yy[2];
            if (FINAL) { const int rb = w & 3;
#pragma unroll
                for (int ci = 0; ci < 2; ++ci) { const int ct = 2 * (w >> 2) + ci;
                    f32x4 y = mm_ll<64>(LB(O_RT), PT, 16 * rb, LB(Z_S), PT, 16 * ct, FZ4, lane);
                    y = mm_ll<64>(LB(Y_ARB), PT, 16 * rb, LB(Y_ZU), PT, 16 * ct, y, lane);
                    yy[ci] = mm_ll<64, false, true>(LB(Y_ARK), PT, 16 * rb, LB(O_VT), PT, 16 * ct, y, lane); } }
#pragma unroll
            for (int ti = 0; ti < NST; ++ti) { const int ct = S_CT(ti); const float pc = LF(Z_PC)[16 * ct + r16];
                f32x4 s = Sacc[ti] * pc;
                s = mm_ll<64, false, true>(LB(Y_ZU), PT, 16 * s_vb, LB(O_BH), PT, 16 * ct, s, lane);
                if (s_vb < 4) s = mm_ll<64, true, true>(LB(O_VT), PT, 16 * s_vb, LB(O_KH), PT, 16 * ct, s, lane);
                Sacc[ti] = s; }
            __syncthreads();
#pragma unroll
            for (int ti = 0; ti < NST; ++ti) { const int ct = S_CT(ti);
#pragma unroll
                for (int jj = 0; jj < 4; ++jj) LB(Z_S)[(16 * s_vb + 4 * q4 + jj) * PT + 16 * ct + r16] = (bf16)f2bf(Sacc[ti][jj]); }
            if (FINAL) { const int rb = w & 3;
#pragma unroll
                for (int ci = 0; ci < 2; ++ci) { const int ct = 2 * (w >> 2) + ci;
#pragma unroll
                    for (int jj = 0; jj < 4; ++jj) LF(Y_YF)[(16 * rb + 4 * q4 + jj) * PF + 16 * ct + r16] = yy[ci][jj]; } }
        }
        __syncthreads();
        if (FINAL) {
            IDS();
            const int t = tok, c0 = 8 * part; const size_t m = (size_t)b * T + tl0 + t;
            float y[8], gg[8], sm = 0.f; ld8f(LF(Y_YF) + t * PF + c0, y); unpack8(*(const LAS u32x4*)(LB(Z_G) + t * 64 + c0), gg);
#pragma unroll
            for (int e = 0; e < 8; ++e) sm += y[e];
            const float mean = red8(sm) * (1.f / 64.f); float vs = 0.f;
#pragma unroll
            for (int e = 0; e < 8; ++e) { y[e] -= mean; vs += y[e] * y[e]; }
            const float rs = __builtin_amdgcn_rsqf(red8(vs) * (1.f / 64.f) + 64e-5f), bo = LF(Z_BON)[t];
#pragma unroll
            for (int e = 0; e < 8; ++e) { const int c = c0 + e; y[e] = (y[e] * rs * LF(Z_PAR)[320 + c] + LF(Z_PAR)[384 + c] + bo * tr_at(LB(O_VT), PT, c, t)) * gg[e]; }
            *(u32x4*)((bf16*)(F.ws + WS_BIG) + m * PLD + 1024 + h * 64 + c0) = pack8(y);
        }
        __syncthreads();
    }
    if (!FINAL) { IDS();
#pragma unroll
        for (int ti = 0; ti < NST; ++ti) { const int ct = S_CT(ti);
            if (s_vb < 4) {
#pragma unroll
                for (int jj = 0; jj < 4; ++jj) Nbuf[(16 * s_vb + 4 * q4 + jj) * 64 + 16 * ct + r16] = Sacc[ti][jj];
            } else { u32x2 wv; wv.x = pk2(Sacc[ti][0], Sacc[ti][1]); wv.y = pk2(Sacc[ti][2], Sacc[ti][3]);
                *(u32x2*)(MT + (16 * ct + r16) * 64 + 16 * (s_vb - 4) + 4 * q4) = wv; }
        }
    }
#undef RW_PREFETCH
#undef IDS
#undef S_CT
#undef LB
#undef LF
}

template <bool FINAL>
__device__ __forceinline__ void ret_chunk_unit(Frame& F, int u) {
    const int tid = otid(), lane = tid & 63, w = __builtin_amdgcn_readfirstlane(tid >> 6), r16 = lane & 15, q4 = lane >> 4;
    const int b = u >> 9, sc = (u >> 3) & 63, h = u & 7;
    constexpr int R_QB = 0, R_KB = 9216, R_KHT = 18432, R_VT = 27648, R_GB = 36864, R_AB = 45056, R_SB = 54272, R_YF = 63488;
    LAS unsigned char* L = F.lds;
#define LB(off) ((LAS bf16*)(L + (off)))
#define LF(off) ((LAS float*)(L + (off)))
    bf16* P = (bf16*)(F.ws + WS_BIG);
    float* Sbuf = (float*)(F.st + 16 * MiB) + (size_t)u * 4096;
    const float lg = log2f(1.f - exp2f(-5.f - (float)h));
    const float g64 = ex2(64.f * lg);
    const int db = w & 3;
    f32x4 Sacc[2];
#pragma unroll
    for (int ci = 0; ci < 2; ++ci) { const int et = 2 * (w >> 2) + ci;
#pragma unroll
        for (int jj = 0; jj < 4; ++jj) Sacc[ci][jj] = FINAL ? Sbuf[(16 * db + 4 * q4 + jj) * 64 + 16 * et + r16] : 0.f;
        if (FINAL) st4bf(LB(R_SB) + (16 * et + r16) * PT + 16 * db + 4 * q4, Sacc[ci]); }
    const int tok = tid >> 3, part = tid & 7;
    for (int j = 0; j < 4; ++j) {
        const int tl0 = sc * 256 + j * 64;
        {
            const int t = tl0 + tok; const size_t m = (size_t)b * T + t; const bf16* row = P + m * PLD + C_RET + h * 64 + 8 * part;
            float qv[8], kv[8], vv[8]; unpack8(*(const u32x4*)(row + 512), kv); unpack8(*(const u32x4*)(row + 1024), vv);
            if (FINAL) { unpack8(*(const u32x4*)row, qv); *(LAS u32x4*)(LB(R_GB) + tok * 64 + 8 * part) = *(const u32x4*)(row + 1536); }
            const float zeta = ex2((float)(63 - tok) * lg);
            if (FINAL) { *(LAS u32x4*)(LB(R_QB) + tok * PT + 8 * part) = pack8(qv); *(LAS u32x4*)(LB(R_KB) + tok * PT + 8 * part) = pack8(kv); }
            float kz[8];
#pragma unroll
            for (int e = 0; e < 8; ++e) kz[e] = kv[e] * zeta;
            tr_write8(LB(R_KHT), PT, 8 * part, tok, kz, part); tr_write8(LB(R_VT), PT, 8 * part, tok, vv, part);
        }
        __syncthreads();
        if (FINAL) { const int rb = w & 3;
#pragma unroll
            for (int ci = 0; ci < 2; ++ci) { const int ct = 2 * (w >> 2) + ci; f32x4 a = FZ4;
                if (ct <= rb) a = mm_ll<64>(LB(R_QB), PT, 16 * rb, LB(R_KB), PT, 16 * ct, FZ4, lane);
#pragma unroll
                for (int jj = 0; jj < 4; ++jj) { const int l = 16 * rb + 4 * q4 + jj, s = 16 * ct + r16; LB(R_AB)[l * PT + s] = (bf16)f2bf((s <= l) ? a[jj] * ex2((float)(l - s) * lg) : 0.f); } }
            __syncthreads();
        }
        {
            f32x4 yy[2];
            if (FINAL) { const int rb = w & 3;
#pragma unroll
                for (int ci = 0; ci < 2; ++ci) { const int et = 2 * (w >> 2) + ci;
                    const f32x4 a1 = mm_ll<64, false, true>(LB(R_AB), PT, 16 * rb, LB(R_VT), PT, 16 * et, FZ4, lane), a2 = mm_ll<64>(LB(R_QB), PT, 16 * rb, LB(R_SB), PT, 16 * et, FZ4, lane);
#pragma unroll
                    for (int jj = 0; jj < 4; ++jj) yy[ci][jj] = a1[jj] + ex2((float)(16 * rb + 4 * q4 + jj + 1) * lg) * a2[jj]; } }
#pragma unroll
            for (int ci = 0; ci < 2; ++ci) { const int et = 2 * (w >> 2) + ci; Sacc[ci] = mm_ll<64, true, true>(LB(R_KHT), PT, 16 * db, LB(R_VT), PT, 16 * et, Sacc[ci] * g64, lane); }
            __syncthreads();
            if (FINAL) { const int rb = w & 3;
#pragma unroll
                for (int ci = 0; ci < 2; ++ci) { const int et = 2 * (w >> 2) + ci; st4bf(LB(R_SB) + (16 * et + r16) * PT + 16 * db + 4 * q4, Sacc[ci]);
#pragma unroll
                    for (int jj = 0; jj < 4; ++jj) LF(R_YF)[(16 * rb + 4 * q4 + jj) * PF + 16 * et + r16] = yy[ci][jj]; } }
        }
        __syncthreads();
        if (FINAL) { const size_t m = (size_t)b * T + tl0 + tok; float y[8], g[8], ss = 0.f;
            ld8f(LF(R_YF) + tok * PF + 8 * part, y);
#pragma unroll
            for (int e = 0; e < 8; ++e) ss += y[e] * y[e];
            const float rs = __builtin_amdgcn_rsqf(red8(ss) * (1.f / 64.f) + 1e-6f);
            unpack8(*(const LAS u32x4*)(LB(R_GB) + tok * 64 + 8 * part), g);
#pragma unroll
            for (int e = 0; e < 8; ++e) y[e] = y[e] * rs * silu(g[e]);
            *(u32x4*)(P + m * PLD + C_RETG + h * 64 + 8 * part) = pack8(y);
            __syncthreads(); }
    }
    if (!FINAL) {
#pragma unroll
        for (int ci = 0; ci < 2; ++ci) { const int et = 2 * (w >> 2) + ci;
#pragma unroll
            for (int jj = 0; jj < 4; ++jj) Sbuf[(16 * db + 4 * q4 + jj) * 64 + 16 * et + r16] = Sacc[ci][jj]; }
    }
#undef LB
#undef LF
}

template <bool FINAL>
__device__ __forceinline__ void ssd_chunk_unit(Frame& F, int layer, int u) {
    const int tid = otid(), w = __builtin_amdgcn_readfirstlane(tid >> 6);
#define IDS() const int ft = fresh_tid(tid); const int lane = ft & 63, r16 = lane & 15, q4 = lane >> 4; (void)lane; (void)r16; (void)q4
    const int b = u >> 9, sc = (u >> 3) & 63, h = u & 7, g = h >> 2;
    constexpr int D_CB = 0, D_BB = 17408, D_BT = 34816, D_YF = 53248, D_XT = 70656, D_XDT = 79872, D_GM = 89088, D_SB = 98304, D_MISC = 115712;
    constexpr int D_DTS = D_MISC, D_ACS = D_MISC + 256, D_CAR = D_MISC + 512;
    LAS unsigned char* L = F.lds;
#define LB(off) ((LAS bf16*)(L + (off)))
#define LF(off) ((LAS float*)(L + (off)))
    bf16* P = (bf16*)(F.ws + WS_BIG); const float* dtb = (const float*)(F.ws + WS_DT);
    const bf16* BND = (const bf16*)(F.ws + WS_BND);
    float* Sbuf = (float*)(F.st + 32 * MiB) + (size_t)u * 8192;
    const float* cw = INP(17) + layer * 1024 * 4; const float* cbias = INP(18) + layer * 1024;
    const float dt_bias = INP(19)[layer * 8 + h], A = -expf(INP(20)[layer * 8 + h]), Dh = INP(21)[layer * 8 + h];
    const int bc_chunk = tid & 31, bc_chn = (bc_chunk < 16) ? (512 + g * 128 + bc_chunk * 8) : (768 + g * 128 + (bc_chunk - 16) * 8);
    const int x_chunk = tid & 7, x_chn = h * 64 + x_chunk * 8;
    const int pb = w & 3;
    f32x4 Sacc[4];
    { IDS();
#pragma unroll
    for (int ci = 0; ci < 4; ++ci) { const int nt = 4 * (w >> 2) + ci;
#pragma unroll
        for (int jj = 0; jj < 4; ++jj) { const float x = FINAL ? Sbuf[(16 * pb + 4 * q4 + jj) * 128 + 16 * nt + r16] : 0.f; Sacc[ci][jj] = x;
            if (FINAL) LB(D_SB)[(16 * pb + 4 * q4 + jj) * PT2 + 16 * nt + r16] = (bf16)f2bf(x); } } }
    float dstot = 0.f;
    for (int j = 0; j < 4; ++j) {
        const int tl0 = sc * 256 + j * 64; const size_t m0 = (size_t)b * T + tl0;
        if (w == 0) {
            IDS(); const float dt = softplus_acc(dtb[(m0 + lane) * 8 + h] + dt_bias); float a = A * dt;
#pragma unroll
            for (int o = 1; o < 64; o <<= 1) { const float n = __shfl_up(a, o); if (lane >= o) a += n; }
            LF(D_DTS)[lane] = dt; LF(D_ACS)[lane] = a;
        }
        {
            IDS();
#pragma unroll
            for (int it = 0; it < 4; ++it) { const int t = it * 16 + (ft >> 5); const int ta = tl0 + t;
                float acc[8]; unpack8(*(const u32x4*)(P + (m0 + t) * PLD + C_XBC + bc_chn), acc); (void)ta;
                if (bc_chunk < 16) { *(LAS u32x4*)(LB(D_BB) + t * PT2 + bc_chunk * 8) = pack8(acc); tr_write8(LB(D_BT), PT, bc_chunk * 8, t, acc, bc_chunk & 7); }
                else *(LAS u32x4*)(LB(D_CB) + t * PT2 + (bc_chunk - 16) * 8) = pack8(acc);
            }
        }
        __syncthreads();
        {
            IDS(); const int t = ft >> 3; float acc[8]; unpack8(*(const u32x4*)(P + (m0 + t) * PLD + C_XBC + x_chn), acc);
            const float sc_d = LF(D_DTS)[t] * __expf(LF(D_ACS)[63] - LF(D_ACS)[t]);
            float xs8[8], xd8[8];
#pragma unroll
            for (int e = 0; e < 8; ++e) { xs8[e] = acc[e]; xd8[e] = acc[e] * sc_d; }
            tr_write8(LB(D_XT), PT, x_chunk * 8, t, xs8, x_chunk); tr_write8(LB(D_XDT), PT, x_chunk * 8, t, xd8, x_chunk);
        }
        if (FINAL) { IDS(); const int rb = w & 3;
#pragma unroll
            for (int ci = 0; ci < 2; ++ci) { const int ct = 2 * (w >> 2) + ci; f32x4 a = FZ4;
                if (ct <= rb) a = mm_ll<128>(LB(D_CB), PT2, 16 * rb, LB(D_BB), PT2, 16 * ct, FZ4, lane);
#pragma unroll
                for (int jj = 0; jj < 4; ++jj) { const int l = 16 * rb + 4 * q4 + jj, s = 16 * ct + r16;
                    LB(D_GM)[l * PT + s] = (bf16)f2bf((s <= l) ? a[jj] * __expf(LF(D_ACS)[l] - LF(D_ACS)[s]) * LF(D_DTS)[s] : 0.f); } } }
        __syncthreads();
        {
            IDS(); f32x4 yy[2];
            if (FINAL) { const int rb = w & 3;
#pragma unroll
                for (int ci = 0; ci < 2; ++ci) { const int pt = 2 * (w >> 2) + ci;
                    const f32x4 a1 = mm_ll<64, false, true>(LB(D_GM), PT, 16 * rb, LB(D_XT), PT, 16 * pt, FZ4, lane), a2 = mm_ll<128>(LB(D_CB), PT2, 16 * rb, LB(D_SB), PT2, 16 * pt, FZ4, lane);
#pragma unroll
                    for (int jj = 0; jj < 4; ++jj) { const int l = 16 * rb + 4 * q4 + jj, p = 16 * pt + r16; yy[ci][jj] = a1[jj] + __expf(LF(D_ACS)[l]) * a2[jj] + Dh * tr_at(LB(D_XT), PT, p, l); } } }
            const float dec = expf(LF(D_ACS)[63]);
#pragma unroll
            for (int ci = 0; ci < 4; ++ci) { const int nt = 4 * (w >> 2) + ci; Sacc[ci] = mm_ll<64, true, true>(LB(D_XDT), PT, 16 * pb, LB(D_BT), PT, 16 * nt, Sacc[ci] * dec, lane); }
            dstot += LF(D_ACS)[63];
            __syncthreads();
            if (FINAL) { const int rb = w & 3;
#pragma unroll
                for (int ci = 0; ci < 4; ++ci) { const int nt = 4 * (w >> 2) + ci;
#pragma unroll
                    for (int jj = 0; jj < 4; ++jj) LB(D_SB)[(16 * pb + 4 * q4 + jj) * PT2 + 16 * nt + r16] = (bf16)f2bf(Sacc[ci][jj]); }
#pragma unroll
                for (int ci = 0; ci < 2; ++ci) { const int pt = 2 * (w >> 2) + ci;
#pragma unroll
                    for (int jj = 0; jj < 4; ++jj) LF(D_YF)[(16 * rb + 4 * q4 + jj) * PF + 16 * pt + r16] = yy[ci][jj]; } }
        }
        __syncthreads();
        if (FINAL) { IDS(); const int tok = ft >> 3, part = ft & 7; float y[8];
            ld8f(LF(D_YF) + tok * PF + 8 * part, y);
            *(u32x4*)(P + (m0 + tok) * PLD + C_XBC + h * 64 + 8 * part) = pack8(y);
            __syncthreads(); }
    }
    if (!FINAL) { IDS();
#pragma unroll
        for (int ci = 0; ci < 4; ++ci) { const int nt = 4 * (w >> 2) + ci;
#pragma unroll
            for (int jj = 0; jj < 4; ++jj) Sbuf[(16 * pb + 4 * q4 + jj) * 128 + 16 * nt + r16] = Sacc[ci][jj]; }
        if (tid == 0) ((float*)(F.ws + WS_DSTOT))[u] = dstot;
    }
#undef IDS
#undef LB
#undef LF
}

__device__ __forceinline__ void rwkv_scan_chain(Frame& F, int chain) {
    const int tid = otid(), lane = tid & 63, w = __builtin_amdgcn_readfirstlane(tid >> 6), r16 = lane & 15, q4 = lane >> 4;
    const int b = chain >> 3, h = chain & 7, vb = w & 3, ct0 = 2 * (w >> 2);
    LAS bf16* SB = (LAS bf16*)F.lds;
    f32x4 Sacc[2] = {FZ4, FZ4};
    for (int i = tid; i < 64 * PT / 2; i += 512) ((LAS unsigned*)SB)[i] = 0u;
    f32x4 nv[2]; bf16x8 mf[2][2];
    auto fetch = [&](int sc) {
        const int u = (b * 64 + sc) * 8 + h;
        const float* Nb = (const float*)(F.st + 0) + (size_t)u * 4096; const bf16* MT = (const bf16*)(F.ws + WS_MT) + (size_t)u * 4096;
#pragma unroll
        for (int ci = 0; ci < 2; ++ci) {
#pragma unroll
            for (int jj = 0; jj < 4; ++jj) nv[ci][jj] = Nb[(16 * vb + 4 * q4 + jj) * 64 + 16 * (ct0 + ci) + r16];
#pragma unroll
            for (int k2 = 0; k2 < 2; ++k2) mf[ci][k2] = *(const bf16x8*)(MT + (size_t)(16 * (ct0 + ci) + r16) * 64 + 32 * k2 + 8 * q4); } };
    fetch(0);
    __syncthreads();
    for (int sc = 0; sc < 64; ++sc) {
        const int u = (b * 64 + sc) * 8 + h;
        float* Nb = (float*)(F.st + 0) + (size_t)u * 4096;
        f32x4 nw[2];
#pragma unroll
        for (int ci = 0; ci < 2; ++ci) {
            f32x4 a = nv[ci];
#pragma unroll
            for (int k2 = 0; k2 < 2; ++k2) a = mfma16(*(const LAS bf16x8*)(SB + (16 * vb + r16) * PT + 32 * k2 + 8 * q4), mf[ci][k2], a);
            nw[ci] = a;
#pragma unroll
            for (int jj = 0; jj < 4; ++jj) Nb[(16 * vb + 4 * q4 + jj) * 64 + 16 * (ct0 + ci) + r16] = Sacc[ci][jj]; }
        if (sc + 1 < 64) fetch(sc + 1);
        __syncthreads();
#pragma unroll
        for (int ci = 0; ci < 2; ++ci) { Sacc[ci] = nw[ci];
#pragma unroll
            for (int jj = 0; jj < 4; ++jj) SB[(16 * vb + 4 * q4 + jj) * PT + 16 * (ct0 + ci) + r16] = (bf16)f2bf(nw[ci][jj]); }
        __syncthreads();
    }
}
__device__ __forceinline__ void elem_scans(Frame& F, int blk, int nblk) {
    const int tid = otid();
    const int NRET = 16 * 4096, NSSD = 16 * 8192;
    const float* dst = (const float*)(F.ws + WS_DSTOT);
    for (int it = blk * 512 + tid; it < NRET + NSSD; it += nblk * 512) {
        if (it < NRET) { const int chain = it >> 12, e = it & 4095, b = chain >> 3, h = chain & 7;
            const float g256 = exp2f(256.f * log2f(1.f - exp2f(-5.f - (float)h)));
            float* p = (float*)(F.st + 16 * MiB) + ((size_t)(b * 64) * 8 + h) * 4096 + e; float carry = 0.f;
#pragma unroll 8
            for (int sc = 0; sc < 64; ++sc) { const float t = p[(size_t)sc * 8 * 4096]; p[(size_t)sc * 8 * 4096] = carry; carry = g256 * carry + t; }
        } else { const int i2 = it - NRET, chain = i2 >> 13, e = i2 & 8191, b = chain >> 3, h = chain & 7;
            float* p = (float*)(F.st + 32 * MiB) + ((size_t)(b * 64) * 8 + h) * 8192 + e; const float* d = dst + (b * 64) * 8 + h; float carry = 0.f;
#pragma unroll 8
            for (int sc = 0; sc < 64; ++sc) { const float t = p[(size_t)sc * 8 * 8192]; p[(size_t)sc * 8 * 8192] = carry; carry = expf(d[sc * 8]) * carry + t; }
        }
    }
}
__device__ __forceinline__ void conv_lora(Frame& F) {
    const int tid = otid();
    for (int l = 0; l < 2; ++l) {
        bf16* base = (bf16*)(F.ws + WS_LORA + (size_t)l * LORA_STRIDE);
        const float* wu = INP(4) + l * 64 * 512; const float* au = INP(6) + l * 64 * 512; const float* gu = INP(8) + l * 128 * 512;
        for (int i = F.vcu * 512 + tid; i < 512 * 64; i += F.G * 512) { const int c = i >> 6, jx = i & 63; base[i] = (bf16)f2bf(wu[jx * 512 + c]); base[32768 + i] = (bf16)f2bf(au[jx * 512 + c]); }
        for (int i = F.vcu * 512 + tid; i < 512 * 128; i += F.G * 512) { const int c = i >> 7, jx = i & 127; base[65536 + i] = (bf16)f2bf(gu[jx * 512 + c]); }
    }
}
__device__ __forceinline__ void conv_vlora(Frame& F) {
    const int tid = otid();
    bf16* vdT = (bf16*)(F.ws + WS_VLORA); bf16* vuT = vdT + 32 * 512;
    const float* vdn = INP(14); const float* vup = INP(15);
    for (int i = F.vcu * 512 + tid; i < 32 * 512; i += F.G * 512) { const int j = i >> 9, c = i & 511; vdT[i] = (bf16)f2bf(vdn[c * 32 + j]); }
    for (int i = F.vcu * 512 + tid; i < 512 * 32; i += F.G * 512) { const int c = i >> 5, j = i & 31; vuT[i] = (bf16)f2bf(vup[j * 512 + c]); }
}
__device__ __forceinline__ void save_bnd(Frame& F) {
    const int tid = otid();
    const bf16* P = (const bf16*)(F.ws + WS_BIG); bf16* BND = (bf16*)(F.ws + WS_BND);
    for (int i = F.vcu * 512 + tid; i < 2 * 64 * 3 * 64; i += F.G * 512) { const int ch = i & 63, k = (i >> 6) % 3, bs = i / 192, b = bs >> 6, sc = bs & 63;
        if (sc > 0) *(u32x4*)(BND + (size_t)(bs * 3 + k) * 512 + ch * 8) = *(const u32x4*)(P + ((size_t)b * T + sc * 256 - 3 + k) * PLD + C_XBC + ch * 8); }
}

constexpr int LAYER_BASE0 = 1, LAYER_STRIDE = 18, MOE_BASE = LAYER_BASE0 + LAYER_STRIDE + 15;
__device__ __forceinline__ Frame lf(const Frame& F0) {
    Frame F = F0; unsigned l = (unsigned)(unsigned long long)F.lds;
    asm volatile("" : "+s"(l), "+s"(F.vcu), "+s"(F.G), "+s"(F.cid), "+s"(F.wid), "+s"(F.out), "+s"(F.ws), "+s"(F.st));
    F.lds = (LAS unsigned char*)(unsigned long long)l; return F;
}
__global__ void __launch_bounds__(512, 2) fwd(Args args) {
    extern __shared__ __attribute__((aligned(16))) unsigned char lds_raw[];
    Frame F0;
    F0.lds = (LAS unsigned char*)lds_raw;
    F0.G = gridDim.x; { const int bx = blockIdx.x; F0.vcu = (F0.G % 8 == 0) ? (bx % 8) * (F0.G / 8) + bx / 8 : bx; }
    F0.cid = blockIdx.x; F0.out = args.out; F0.ws = args.ws; F0.wid = __builtin_amdgcn_readfirstlane(threadIdx.x >> 6); F0.st = args.ws + WS_XB;
    volatile LAS unsigned* MISC = (volatile LAS unsigned*)(F0.lds + MISC_OFF);
    for (int u = threadIdx.x; u < (LDS_BYTES - LDSCTL_OFF) / 4; u += 512) ((LAS unsigned*)(F0.lds + LDSCTL_OFF))[u] = 0u;
    __syncthreads();
    if (threadIdx.x < 34) *(LAS unsigned long long*)(F0.lds + LDSCTL_OFF + 8 * threadIdx.x) = (unsigned long long)args.in[threadIdx.x];
    __syncthreads();
    const int lo = args.ph_lo, hi = args.ph_hi;
    XcdBarrier bar; bar.bar = (unsigned*)(F0.ws + WS_CTL); bar.x = 0; bar.st = nullptr;
    if (hi - lo > 1) bar = xcd_barrier_post((unsigned*)(F0.ws + WS_CTL), MISC + 8);
#define IN(k) (lo <= (k) && (k) < hi)
#define SEAM(k) do { if (IN(k) && IN((k) + 1)) xcd_barrier(bar); } while (0)
#define WSP(T_, off) ((T_*)(F.ws + (off)))

    if (IN(0)) { Frame F = lf(F0); conv_layer_weights(F, 0, 0); conv_lora(F); conv_vlora(F); xprep_phase(F, INP(0)); }
    SEAM(0);
    for (int l = 0; l < 2; ++l) {
        const int pb = LAYER_BASE0 + l * LAYER_STRIDE;
        F0.st = (unsigned char*)F0.out;
        if (IN(pb + 0)) {
            Frame F = lf(F0); unsigned char* wl = F.ws + WS_W + (size_t)l * WL_STRIDE;
            pg8::Gemm g{WSP(bf16, WS_XB), (const bf16*)(wl + WL_IN), D, D, D}; pg8::StaticOrder S; S.init(M, NP, F.G, F.cid, D, D);
            pg8::EpiInProj E{WSP(bf16, WS_BIG), (l == 0) ? WSP(float, WS_RSTD) : WSP(float, WS_SS1), WSP(float, WS_DT), l};
            pg8::gemm_phase(F.lds, F.wid, g, S, E);
        }
        SEAM(pb + 0);
        if (IN(pb + 1)) { Frame F = lf(F0); vprep_phase(F, l); prepass_a(F); }
        SEAM(pb + 1);
        if (IN(pb + 2)) { Frame F = lf(F0); prepass_conv(F, l); }
        if (IN(pb + 2) && IN(pb + 3)) xcd_barrier(bar);
        if (IN(pb + 3)) for (int rep = 0; rep <= REP_R1; ++rep) {
#if RW_CH
            for (int r2 = 0; r2 <= REP_RW; ++r2) { Frame F = lf(F0); for (int u = F.cid; u < 1024; u += F.G) rwkv_chunk_unit<false>(F, l, u); }
#else
            { Frame F = lf(F0); if (F.cid < 16) rwkv_seq(F, l, F.cid); }
#endif
#if RET_CH
            for (int r2 = 0; r2 <= REP_RET; ++r2) { Frame F = lf(F0); for (int u = F.cid; u < 1024; u += F.G) ret_chunk_unit<false>(F, u); }
#else
            { Frame F = lf(F0); if (F.cid >= 32 && F.cid < 48) ret_seq(F, F.cid - 32); }
#endif
#if SSD_CH
            for (int r2 = 0; r2 <= REP_SSD; ++r2) { Frame F = lf(F0); for (int u = F.cid; u < 1024; u += F.G) ssd_chunk_unit<false>(F, l, u); }
#else
            { Frame F = lf(F0); if (F.cid >= 16 && F.cid < 32) ssd_seq(F, l, F.cid - 16); }
#endif
        }
        SEAM(pb + 3);
        if (IN(pb + 4)) {
            Frame F = lf(F0);
            if (F.cid < 16) { if (RW_CH) rwkv_scan_chain(F, F.cid); }
            else elem_scans(F, F.cid - 16, F.G - 16);
            if (l == 0 && F.cid >= 16) { Frame Fc = lf(F0); Fc.vcu = Fc.cid - 16; Fc.G = Fc.G - 16;
                conv_layer_weights(Fc, 0, 1); conv_layer_weights(Fc, 1, 0); conv_layer_weights(Fc, 1, 1); conv_ffn_weights(Fc); }
        }
        SEAM(pb + 4);
        if (IN(pb + 5)) {
#if RW_CH
            { Frame F = lf(F0); for (int u = F.cid; u < 1024; u += F.G) rwkv_chunk_unit<true>(F, l, u); }
#endif
#if RET_CH
            { Frame F = lf(F0); for (int u = F.cid; u < 1024; u += F.G) ret_chunk_unit<true>(F, u); }
#endif
#if SSD_CH
            { Frame F = lf(F0); for (int u = F.cid; u < 1024; u += F.G) ssd_chunk_unit<true>(F, l, u); }
#endif
        }
        SEAM(pb + 5);
        if (IN(pb + 6)) { Frame F = lf(F0); ssm_norm_phase(F, l); }
        SEAM(pb + 6);
        if (IN(pb + 7)) {
            Frame F = lf(F0); unsigned char* wl = F.ws + WS_W + (size_t)l * WL_STRIDE; bf16* P = WSP(bf16, WS_BIG);
            pg8::Gemm g{P, (const bf16*)(wl + WL_BR), PLD, 512, 512}; pg8::BranchOrder S; S.init(F.G, F.cid);
            pg8::EpiPlain E{P, WSP(bf16, WS_VMIX)};
            pg8::gemm_phase(F.lds, F.wid, g, S, E);
        }
        SEAM(pb + 7);
        if (IN(pb + 8)) {
            Frame F = lf(F0); unsigned char* wl = F.ws + WS_W + (size_t)l * WL_STRIDE; bf16* P = WSP(bf16, WS_BIG);
            pg8::Gemm g{WSP(bf16, WS_XB), (const bf16*)(wl + WL_GATE), D, D, D}; pg8::GateOrder S; S.init(F.G, F.cid);
            pg8::EpiGateMerge E{P, WSP(const bf16, WS_VMIX), P + C_RET, PLD, (l == 0) ? WSP(float, WS_RSTD) : WSP(float, WS_SS1), l};
            pg8::gemm_phase(F.lds, F.wid, g, S, E);
        }
        if (IN(pb + 8) && IN(pb + 13)) xcd_barrier(bar);
        if (IN(pb + 13)) {
            Frame F = lf(F0); unsigned char* wl = F.ws + WS_W + (size_t)l * WL_STRIDE; bf16* P = WSP(bf16, WS_BIG);
            pg8::Gemm g{P + C_RET, (const bf16*)(wl + WL_OUT), PLD, D, D}; pg8::StaticOrder S; S.init(M, D, F.G, F.cid, PLD, D);
            pg8::EpiResidB E{WSP(bf16, WS_XB), (l == 0) ? WSP(float, WS_SS2) : nullptr, (l == 0) ? nullptr : F.out};
            pg8::gemm_phase(F.lds, F.wid, g, S, E);
        }
        SEAM(pb + 13);
        if (IN(pb + 14)) { Frame F = lf(F0); if (l == 1) { router_phase(F); conv_moe_weights(F); } }
        if (l == 1) SEAM(pb + 14);
        if (l == 0) {
            if (IN(pb + 15)) {
                Frame F = lf(F0);
                pg8::Gemm g{WSP(bf16, WS_XB), WSP(const bf16, WS_FFUP), D, D, D}; pg8::StaticOrder S; S.init(M, 2 * FF, F.G, F.cid, D, D);
                pg8::EpiSwiglu E{WSP(bf16, WS_ACT), FF, WSP(float, WS_SS2), 1};
                pg8::gemm_phase(F.lds, F.wid, g, S, E);
            }
            SEAM(pb + 15);
            if (IN(pb + 16)) {
                Frame F = lf(F0);
                pg8::Gemm g{WSP(const bf16, WS_ACT), WSP(const bf16, WS_FFDN), FF, FF, FF}; pg8::StaticOrder S; S.init(M, D, F.G, F.cid, FF, FF);
                pg8::EpiResidB E{WSP(bf16, WS_XB), WSP(float, WS_SS1), nullptr};
                pg8::gemm_phase(F.lds, F.wid, g, S, E);
            }
            if (IN(pb + 16) && IN(pb + 18)) xcd_barrier(bar);
        }
    }
    {
        const int pb = MOE_BASE;
        for (int st = 0; st < 6; ++st) {
            const int isup = (st == 0 || st == 2 || st == 3), sg = (st < 2) ? 0 : ((st == 2 || st == 4) ? 1 : 2);
            if (IN(pb + st)) {
                if (isup) {
                    Frame F = lf(F0);
                    pg8::Gemm g{WSP(bf16, WS_XB), WSP(const bf16, WS_MOEW), D, D, D}; pg8::MoeOrder<true> S; S.init(WSP(const int, WS_CNT), WSP(const int, WS_LIST), sg, 2 * FFE, F.G, F.cid, D, D, MOEW_STRIDE);
                    pg8::EpiSwiglu E{(sg == 2) ? WSP(bf16, WS_ACT2) : WSP(bf16, WS_ACT), FFE, WSP(float, WS_RSTD), 0};
                    pg8::gemm_phase(F.lds, F.wid, g, S, E);
                } else {
                    Frame F = lf(F0);
                    const int ksp = (sg == 2) ? 4 : 1;
                    pg8::Gemm g{(sg == 2) ? WSP(const bf16, WS_ACT2) : WSP(const bf16, WS_ACT), WSP(const bf16, WS_MOEW + MOEW_DN), FFE, FFE, FFE / ksp}; pg8::MoeOrder<false> S; S.init(WSP(const int, WS_CNT), WSP(const int, WS_LIST), sg, D, F.G, F.cid, FFE, FFE, MOEW_STRIDE, ksp, FFE / ksp);
                    pg8::EpiMoeOut E{(sg == 0) ? WSP(bf16, WS_YP0) : (sg == 1 ? WSP(bf16, WS_YP1) : WSP(bf16, WS_YP2)), YP2_STRIDE / 2};
                    pg8::gemm_phase(F.lds, F.wid, g, S, E);
                }
            }
            SEAM(pb + st);
        }
        if (IN(pb + 6)) { Frame F = lf(F0); final_norm_phase(F); }
    }
#undef IN
#undef SEAM
#undef WSP
}
constexpr int LAST_PHASE = MOE_BASE + 6;
constexpr int N_PH = LAST_PHASE + 1;

extern "C" void kernel_launch(void* const* d_in, const int* in_sizes, int n_in, void* d_out, int out_size, void* d_ws, size_t ws_size, hipStream_t stream) {
    static int grid = 0;
    if (grid == 0) {
        if (n_in != 34 || out_size != M * D || ws_size < WS_END) { fprintf(stderr, "kernel_launch: unexpected problem (n_in %d out %d ws %zu need %zu)\n", n_in, out_size, ws_size, (size_t)WS_END); grid = -1; return; }
        int dev = 0, cus = 0;
        if (hipGetDevice(&dev) != hipSuccess || hipDeviceGetAttribute(&cus, hipDeviceAttributeMultiprocessorCount, dev) != hipSuccess) { grid = -1; return; }
        if (hipFuncSetAttribute((const void*)fwd, hipFuncAttributeMaxDynamicSharedMemorySize, LDS_BYTES) != hipSuccess) { fprintf(stderr, "kernel_launch: hipFuncSetAttribute failed\n"); grid = -1; return; }
        int per_cu = 0;
        if (hipOccupancyMaxActiveBlocksPerMultiprocessor(&per_cu, (const void*)fwd, 512, LDS_BYTES) != hipSuccess || per_cu < 1) fprintf(stderr, "kernel_launch: occupancy query says %d\n", per_cu);
        (void)hipGetLastError();
        grid = cus;
    }
    if (grid < 0) return;
    (void)hipMemsetAsync((char*)d_ws + WS_CTL, 0, CTL_ZERO_BYTES, stream);
    Args a{};
    for (int i = 0; i < 34; ++i) a.in[i] = (const float*)d_in[i];
    a.out = (float*)d_out; a.ws = (unsigned char*)d_ws;
#if MK_ONE_LAUNCH
    a.ph_lo = 0; a.ph_hi = N_PH;
    hipLaunchKernelGGL(fwd, dim3(grid), dim3(512), LDS_BYTES, stream, a);
#else
    for (int p = 0; p < N_PH; ++p) { a.ph_lo = p; a.ph_hi = p + 1; hipLaunchKernelGGL(fwd, dim3(grid), dim3(512), LDS_BYTES, stream, a); }
#endif
}
```

```cpp
#include <hip/hip_runtime.h>
#include <cstdio>
#include <cstdint>

#ifndef MK_ONE_LAUNCH
#define MK_ONE_LAUNCH 1
#endif

#define LAS __attribute__((address_space(3)))
#define GAS __attribute__((address_space(1)))
typedef unsigned short bf16;
typedef short bf16x8 __attribute__((ext_vector_type(8)));
typedef float f32x4 __attribute__((ext_vector_type(4)));
typedef float f32x2 __attribute__((ext_vector_type(2)));
typedef unsigned u32x4 __attribute__((ext_vector_type(4)));
typedef unsigned u32x2 __attribute__((ext_vector_type(2)));

constexpr int BATCH = 2, T = 16384, D = 1024, M = BATCH * T;
constexpr int INC = 8456;
constexpr int PLD = 5376;
constexpr int NP = 5632;
constexpr int C_RW = 0, C_Z = 1792, C_XBC = 2304, C_RET = 3328, C_RETG = 4864;
constexpr int FF = 2816, FFE = 3584, NE = 8;

constexpr size_t MiB = 1u << 20;
constexpr size_t WS_CTL = 0, CTL_ZERO_BYTES = 64 * 1024;
constexpr size_t WS_RSTD = 1 * MiB, WS_GATES = 2 * MiB, WS_DT = 3 * MiB;
constexpr size_t WS_W = 4 * MiB;
constexpr size_t WL_IN = 0, WL_GATE = 11 * MiB, WL_BR = 17 * MiB, WL_OUT = 20 * MiB, WL_STRIDE = 22 * MiB;
constexpr size_t WS_FFUP = WS_W + 44 * MiB, WS_FFDN = WS_W + 55 * MiB;
constexpr size_t WS_XB = 68 * MiB;
constexpr size_t WS_VF = 132 * MiB;
constexpr size_t WS_BIG = 164 * MiB;
constexpr size_t WS_VMIX = WS_BIG + 336 * MiB, WS_YRW = WS_BIG + 368 * MiB, WS_END = 577 * MiB;
constexpr size_t WS_MOEW = WS_BIG;
constexpr size_t MOEW_STRIDE = 21 * MiB, MOEW_DN = 14 * MiB;
constexpr size_t WS_ACT = WS_BIG + 168 * MiB;

constexpr size_t WS_YP0 = 4 * MiB, WS_YP1 = WS_XB, WS_YP2 = 556 * MiB, YP2_STRIDE = 4 * MiB, WS_PINFO = 572 * MiB, WS_ACT2 = 132 * MiB;
constexpr size_t WS_CNT = 32768, WS_LIST = 2 * MiB;
constexpr size_t WS_BND2 = 566 * MiB;
constexpr size_t WS_VLORA = 192 * 1024;
constexpr size_t WS_SS1 = 573 * MiB, WS_SS2 = 575 * MiB;
constexpr size_t WS_DSTOT = 128 * 1024, WS_BND = 256 * 1024;
constexpr size_t WS_LORA = 1 * MiB + 512 * 1024, LORA_STRIDE = 262144;
constexpr size_t WS_ST_RW = WS_XB, WS_ST_RET = WS_XB + 16 * MiB, WS_ST_SSD = WS_XB + 32 * MiB, WS_MT = WS_YRW;
constexpr int RING_BYTES = 131072, LDSCTL_OFF = 159744, MISC_OFF = LDSCTL_OFF + 320, LDS_BYTES = 163840;
#ifndef REP_CONV
#define REP_CONV 0
#endif
#ifndef REP_R1
#define REP_R1 0
#endif
#ifndef REP_RW
#define REP_RW 0
#endif
#ifndef REP_RET
#define REP_RET 0
#endif
#ifndef REP_SSD
#define REP_SSD 0
#endif
#ifndef REP_MISC
#define REP_MISC 0
#endif
#ifndef RW_CH
#define RW_CH 1
#endif
#ifndef RET_CH
#define RET_CH 1
#endif
#ifndef SSD_CH
#define SSD_CH 1
#endif

typedef __bf16 hbf16x2 __attribute__((ext_vector_type(2)));
__device__ __forceinline__ unsigned pk2(float lo, float hi) { const f32x2 v = {lo, hi}; return __builtin_bit_cast(unsigned, __builtin_convertvector(v, hbf16x2)); }
__device__ __forceinline__ unsigned f2bf(float f) { return (unsigned)__builtin_bit_cast(unsigned short, (__bf16)f); }
__device__ __forceinline__ float bflo(unsigned u) { return __builtin_bit_cast(float, u << 16); }
__device__ __forceinline__ float bfhi(unsigned u) { return __builtin_bit_cast(float, u & 0xffff0000u); }
__device__ __forceinline__ void unpack8(const u32x4 u, float (&f)[8]) { f[0] = bflo(u.x); f[1] = bfhi(u.x); f[2] = bflo(u.y); f[3] = bfhi(u.y); f[4] = bflo(u.z); f[5] = bfhi(u.z); f[6] = bflo(u.w); f[7] = bfhi(u.w); }
__device__ __forceinline__ u32x4 pack8(const float (&f)[8]) { u32x4 w; w.x = pk2(f[0], f[1]); w.y = pk2(f[2], f[3]); w.z = pk2(f[4], f[5]); w.w = pk2(f[6], f[7]); return w; }
__device__ __forceinline__ float sigm(float x) { return __builtin_amdgcn_rcpf(1.f + __expf(-x)); }
__device__ __forceinline__ float silu(float x) { return x * __builtin_amdgcn_rcpf(1.f + __expf(-x)); }
__device__ __forceinline__ float ex2(float x) { return __builtin_amdgcn_exp2f(x); }
__device__ __forceinline__ float fast_tanh(float x) { return 1.f - 2.f * __builtin_amdgcn_rcpf(1.f + __expf(2.f * x)); }
__device__ __forceinline__ float softplus_acc(float x) { return fmaxf(x, 0.f) + log1pf(expf(-fabsf(x))); }
__device__ __forceinline__ float wave_sum(float v) {
#pragma unroll
    for (int o = 1; o < 64; o <<= 1) v += __shfl_xor(v, o);
    return v;
}
__device__ __forceinline__ int otid_w(int wid) { unsigned z = 0u; asm volatile("" : "+v"(z)); int t = wid * 64 + (int)__builtin_amdgcn_mbcnt_hi(~0u, __builtin_amdgcn_mbcnt_lo(~0u, z)); asm volatile("" : "+v"(t)); return t; }
#define otid() otid_w(F.wid)
__device__ __forceinline__ int fresh_tid(int t) { asm volatile("" : "+v"(t)); return t; }
#define LDS_WAIT() asm volatile("s_waitcnt lgkmcnt(0)" ::: "memory")

namespace pg8 {
constexpr int BM = 256, BK = 64, HALF = 128, HTB = HALF * BK * 2, STAGE_BYTES = 8 * HTB, NXCD = 8, WGM = 8;
__host__ __device__ __forceinline__ int lds_byte(int r, int c) { const int st = (r >> 4) * 2 + (c >> 5), rr = r & 15, cc = c & 31, ob = rr * 64 + cc * 2; return st * 1024 + (ob ^ (((ob >> 9) & 1) << 5)); }
__host__ __device__ __forceinline__ void stage_rc(int b, int& R, int& C) { const int st = b / 1024, sb = b % 1024, swz = sb ^ (((sb >> 9) & 1) << 5); R = (st >> 1) * 16 + swz / 64; C = (st & 1) * 32 + (swz % 64) / 2; }
__host__ __device__ __forceinline__ int perm32(int rho) { const int n = rho >> 4, i = rho & 15; return 8 * (i >> 2) + 4 * n + (i & 3); }

struct Unit { int pm, pn; size_t aofs, bofs; const int* rows; int nvalid, e, ks; };
struct Gemm { const bf16* A; const bf16* Bt; int lda, ldb, K; };

struct StaticOrder {
    static constexpr bool GATHER = false;
    int nM, nN, nwg, G, c; size_t tsA, tsB;
    __device__ __forceinline__ void init(int Mrows, int N, int G_, int c_, int lda, int ldb) { nM = Mrows / BM; nN = N / BM; nwg = nM * nN; G = G_; c = c_; tsA = (size_t)BM * lda * 2; tsB = (size_t)BM * ldb * 2; }
    __device__ __forceinline__ void tile(int L, int& pm, int& pn) const {
        int wgid = L; { const int q = nwg / NXCD, r = nwg % NXCD, xcd = wgid % NXCD, off = wgid / NXCD; wgid = (xcd < r ? xcd * (q + 1) : r * (q + 1) + (xcd - r) * q) + off; }
        const int nig = WGM * nN, gid = wgid / nig, fm = gid * WGM, gsz = (nM - fm) < WGM ? (nM - fm) : WGM;
        pm = fm + ((wgid % nig) % gsz); pn = (wgid % nig) / gsz;
    }
    __device__ __forceinline__ bool next(int i, Unit& u) const {
        const long L = (long)i * G + c; if (L >= nwg) return false;
        tile((int)L, u.pm, u.pn); u.aofs = (size_t)u.pm * tsA; u.bofs = (size_t)u.pn * tsB; u.rows = nullptr; u.nvalid = BM; u.e = 0; u.ks = 0; return true;
    }
};
struct BranchOrder {
    static constexpr bool GATHER = false;
    StaticOrder so;
    __device__ __forceinline__ void init(int G_, int c_) { so.init(M, D, G_, c_, PLD, 512); }
    __device__ __forceinline__ bool next(int j, Unit& u) const {
        const long L = (long)j * so.G + so.c; if (L >= 3 * so.nwg) return false;
        const int i = (int)(L / so.nwg); so.tile((int)(L % so.nwg), u.pm, u.pn);
        const int acol = (i == 0) ? 1024 : (i == 1 ? C_Z : C_RETG);
        u.aofs = (size_t)u.pm * so.tsA + (size_t)acol * 2; u.bofs = ((size_t)i * D + (size_t)u.pn * BM) * 512 * 2; u.rows = nullptr; u.nvalid = BM; u.e = i; u.ks = 0; return true;
    }
};
struct GateOrder {
    static constexpr bool GATHER = false;
    StaticOrder so;
    __device__ __forceinline__ void init(int G_, int c_) { so.init(M, D, G_, c_, D, D); }
    __device__ __forceinline__ bool next(int j, Unit& u) const {
        const long tt = (long)(j / 3) * so.G + so.c; if (tt >= so.nwg) return false;
        const int i = j % 3; so.tile((int)tt, u.pm, u.pn);
        u.aofs = (size_t)u.pm * so.tsA; u.bofs = ((size_t)i * D + (size_t)u.pn * BM) * D * 2; u.rows = nullptr; u.nvalid = BM; u.e = i; u.ks = 0; return true;
    }
};
template <bool GATH> struct MoeOrder {
    static constexpr bool GATHER = GATH;
    unsigned q0, q1, q2, q3;
    int seg, nN, G, c, ksplit; const int* list; size_t bstride, tsB, tsA, kbytes;
    __device__ __forceinline__ void init(const int* counts, const int* list_, int seg_, int N, int G_, int c_, int lda, int ldb, size_t bstride_, int ksplit_ = 1, int kpart = 0) {
        unsigned n[8];
#pragma unroll
        for (int e = 0; e < 8; ++e) { int v = __builtin_amdgcn_readfirstlane(counts[e]); v = v < 0 ? 0 : (v > 32768 ? 32768 : v); n[e] = (unsigned)v; }
        q0 = n[0] | (n[1] << 16); q1 = n[2] | (n[3] << 16); q2 = n[4] | (n[5] << 16); q3 = n[6] | (n[7] << 16);
        seg = seg_; nN = N / BM; G = G_; c = c_; list = list_; bstride = bstride_; tsB = (size_t)BM * ldb * 2; tsA = (size_t)BM * lda * 2; ksplit = ksplit_; kbytes = (size_t)kpart * 2;
    }
    __device__ __forceinline__ bool next(int i, Unit& u) const {
        const long L0 = (long)i * G + c; const long L = L0 / ksplit; const int ks = (int)(L0 % ksplit); const int tl = (int)(L / nN), pn = (int)(L % nN), gt = seg * 128 + tl;
        int t = 0, e = 0, tbe = 0, cne = 0;
#pragma unroll
        for (int k = 0; k < 8; ++k) { const unsigned q = (k < 2) ? q0 : (k < 4) ? q1 : (k < 6) ? q2 : q3; const int n = (int)((k & 1) ? (q >> 16) : (q & 0xffffu));
            if (gt >= t) { e = k; tbe = t; cne = n; } t += (n + 255) >> 8; }
        int nt = t - seg * 128; nt = nt < 0 ? 0 : (nt > 128 ? 128 : nt);
        if (L >= (long)nt * nN) return false;
        const int rt = gt - tbe;
        u.pm = tl; u.pn = pn; u.e = e; u.ks = ks; u.bofs = (size_t)e * bstride + (size_t)pn * tsB + ks * kbytes; u.aofs = (GATH ? 0 : (size_t)tl * tsA) + ks * kbytes;
        u.rows = list + ((size_t)e * 32768 + rt * 256) * 2; int nv = cne - rt * 256; u.nvalid = nv > 256 ? 256 : nv; return true;
    }
};

template <class Epi, class Sched>
__device__ __forceinline__ void gemm_phase(LAS unsigned char* lds, int wid0, const Gemm g, const Sched& S, const Epi& E) {
    constexpr bool GATHER = Sched::GATHER;
    const int tid = otid_w(wid0), wid = __builtin_amdgcn_readfirstlane(tid >> 6), lane = tid & 63, wr = wid >> 2, wc = wid & 3, fr = lane & 15, fq = lane >> 4;
    const int nt = g.K / BK;
    unsigned voffA[2], voffB[2];
#pragma unroll
    for (int i = 0; i < 2; ++i) { int R, C; stage_rc(tid * 16 + i * 8192, R, C); const int Rb = Epi::PERM ? ((R & ~31) + perm32(R & 31)) : R;
        voffA[i] = (unsigned)(R * g.lda + C) * 2u; voffB[i] = (unsigned)(Rb * g.ldb + C) * 2u; }
    const size_t kstep = (size_t)(BK * 2);
    const size_t hstepA = GATHER ? 0 : (size_t)HALF * g.lda * 2, hstepB = (size_t)HALF * g.ldb * 2;
    const unsigned ldsw = (unsigned)wid * 1024u;
    const int aoff = lds_byte(wr * 64 + fr, fq * 8), boff = lds_byte(wc * 32 + fr, fq * 8);
#define PG8_SA(b, h) (((b) * 2 + (h)) * HTB)
#define PG8_SB(b, h) ((4 + (b) * 2 + (h)) * HTB)
#define PG8_STAGE2(bufoff, gbase, o0, o1) do { \
        __builtin_amdgcn_global_load_lds((const unsigned*)((const char*)(gbase) + (o0)), (LAS unsigned*)(lds + (bufoff) + ldsw), 16, 0, 0); \
        __builtin_amdgcn_global_load_lds((const unsigned*)((const char*)(gbase) + (o1)), (LAS unsigned*)(lds + (bufoff) + ldsw + 8192), 16, 0, 0); } while (0)
#define PG8_STAGE(bufoff, gbase, voff) PG8_STAGE2(bufoff, gbase, (voff)[0], (voff)[1])
#define PG8_LDA(dst, b, h) do { _Pragma("unroll") for (int m = 0; m < 4; ++m) _Pragma("unroll") for (int k = 0; k < 2; ++k) dst[m][k] = *(const LAS bf16x8*)(lds + PG8_SA(b, h) + aoff + m * 2048 + k * 1024); } while (0)
#define PG8_LDB(dst, b, h) do { _Pragma("unroll") for (int n = 0; n < 2; ++n) _Pragma("unroll") for (int k = 0; k < 2; ++k) dst[n][k] = *(const LAS bf16x8*)(lds + PG8_SB(b, h) + boff + n * 2048 + k * 1024); } while (0)
#define PG8_MMA(ai, bj, At, Bt) do { __builtin_amdgcn_s_setprio(1); _Pragma("unroll") for (int m = 0; m < 4; ++m) _Pragma("unroll") for (int n = 0; n < 2; ++n) _Pragma("unroll") for (int k = 0; k < 2; ++k) \
        acc[ai][bj][m][n] = Epi::TRANS ? __builtin_amdgcn_mfma_f32_16x16x32_bf16(Bt[n][k], At[m][k], acc[ai][bj][m][n], 0, 0, 0) : __builtin_amdgcn_mfma_f32_16x16x32_bf16(At[m][k], Bt[n][k], acc[ai][bj][m][n], 0, 0, 0); __builtin_amdgcn_s_setprio(0); } while (0)
#define PG8_WAIT_V(n) asm volatile("s_waitcnt vmcnt(" #n ")" ::: "memory")
#define PG8_WAIT_L(n) asm volatile("s_waitcnt lgkmcnt(" #n ")" ::: "memory")
#define PG8_BAR __builtin_amdgcn_s_barrier()
#define PG8_SCHED __builtin_amdgcn_sched_barrier(0)
#define GSLOT(which) ((LAS u32x4*)(lds + 131072 + (which) * 8192 + tid * 16))
#define PG8_ROWS(u, which) do { const int _ft = fresh_tid(tid); unsigned _vg[2][2]; _Pragma("unroll") for (int _i = 0; _i < 2; ++_i) { int _R, _C; stage_rc(_ft * 16 + _i * 8192, _R, _C); \
        _Pragma("unroll") for (int _h = 0; _h < 2; ++_h) { const int _r = _h * HALF + _R; \
        const int _t = (_r < (u).nvalid) ? (u).rows[2 * _r] : 0; _vg[_h][_i] = ((unsigned)_t * (unsigned)g.lda + (unsigned)_C) * 2u; } } \
        u32x4 _o; _o.x = _vg[0][0]; _o.y = _vg[0][1]; _o.z = _vg[1][0]; _o.w = _vg[1][1]; *GSLOT(which) = _o; } while (0)
    Unit cur, nxt; int ui = 0;
    if (!S.next(0, cur)) return;
    f32x4 acc[2][2][4][2];
#pragma unroll
    for (int a = 0; a < 2; ++a)
#pragma unroll
        for (int b = 0; b < 2; ++b)
#pragma unroll
            for (int m = 0; m < 4; ++m)
#pragma unroll
                for (int n = 0; n < 2; ++n) acc[a][b][m][n] = (f32x4){0.f, 0.f, 0.f, 0.f};
    bf16x8 At[4][2], B0[2][2], B1[2][2];
    u32x4 gc = {voffA[0], voffA[1], voffA[0], voffA[1]};
    if constexpr (GATHER) { PG8_ROWS(cur, 0); PG8_ROWS(cur, 1); gc = *GSLOT(0); }
#define VGC(h, i) (gc[2 * (h) + (i)])
    const char* cA = (const char*)g.A + cur.aofs; const char* cB = (const char*)g.Bt + cur.bofs;
    PG8_STAGE(PG8_SB(0, 0), cB, voffB); PG8_STAGE(PG8_SB(0, 1), cB + hstepB, voffB); PG8_STAGE2(PG8_SA(0, 0), cA, VGC(0, 0), VGC(0, 1)); PG8_STAGE2(PG8_SA(0, 1), cA + hstepA, VGC(1, 0), VGC(1, 1));
    if (wr == 1) PG8_BAR;
    PG8_WAIT_V(2); PG8_BAR;
    PG8_STAGE(PG8_SB(1, 0), cB + kstep, voffB); PG8_STAGE2(PG8_SA(1, 0), cA + kstep, VGC(0, 0), VGC(0, 1)); PG8_STAGE(PG8_SB(1, 1), cB + hstepB + kstep, voffB);
    PG8_WAIT_V(6); PG8_BAR;
    for (;;) {
        const bool has_next = S.next(ui + 1, nxt);
        const char* nA = has_next ? (const char*)g.A + nxt.aofs : cA; const char* nB = has_next ? (const char*)g.Bt + nxt.bofs : cB;
        if constexpr (GATHER) { if (has_next) PG8_ROWS(nxt, 1); else *GSLOT(1) = *GSLOT(0); }
        for (int t = 0; t < nt; t += 2) {
            const bool last = (t == nt - 2);
            const char* a1 = cA + (size_t)(t + 1) * kstep;
            const char* a2 = last ? nA : cA + (size_t)(t + 2) * kstep; const char* b2 = last ? nB : cB + (size_t)(t + 2) * kstep;
            const char* a3 = a2 + kstep; const char* b3 = b2 + kstep;
            u32x4 gn = gc; if constexpr (GATHER) { gc = *GSLOT(0); gn = last ? *GSLOT(1) : gc; }
            const unsigned s00 = gn.x, s01 = gn.y, s10 = gn.z, s11 = gn.w;
            PG8_LDB(B0, 0, 0); PG8_LDB(B1, 0, 1); PG8_SCHED; PG8_LDA(At, 0, 0); PG8_STAGE2(PG8_SA(1, 1), a1 + hstepA, VGC(1, 0), VGC(1, 1));
            PG8_WAIT_V(8); PG8_WAIT_L(0); PG8_BAR; PG8_MMA(0, 0, At, B0); PG8_MMA(0, 1, At, B1); PG8_BAR; PG8_SCHED;
            PG8_LDA(At, 0, 1); PG8_STAGE(PG8_SB(0, 0), b2, voffB); PG8_STAGE(PG8_SB(0, 1), b2 + hstepB, voffB); PG8_STAGE2(PG8_SA(0, 0), a2, s00, s01);
            PG8_WAIT_V(8); PG8_WAIT_L(0); PG8_BAR; PG8_MMA(1, 0, At, B0); PG8_MMA(1, 1, At, B1); PG8_BAR; PG8_SCHED;
            PG8_LDB(B0, 1, 0); PG8_LDB(B1, 1, 1); PG8_SCHED; PG8_LDA(At, 1, 0); PG8_STAGE2(PG8_SA(0, 1), a2 + hstepA, s10, s11);
            PG8_WAIT_V(8); PG8_WAIT_L(0); PG8_BAR; PG8_MMA(0, 0, At, B0); PG8_MMA(0, 1, At, B1); PG8_BAR; PG8_SCHED;
            PG8_LDA(At, 1, 1); PG8_STAGE(PG8_SB(1, 0), b3, voffB); PG8_STAGE(PG8_SB(1, 1), b3 + hstepB, voffB); PG8_STAGE2(PG8_SA(1, 0), a3, s00, s01);
            PG8_WAIT_V(8); PG8_WAIT_L(0); PG8_BAR; PG8_MMA(1, 0, At, B0); PG8_MMA(1, 1, At, B1); PG8_BAR; PG8_SCHED;
        }
        if (wr == 0) PG8_BAR;
        E(acc, cur, wr, wc, fr, fq);
        if (!has_next) break;
#pragma unroll
        for (int a = 0; a < 2; ++a)
#pragma unroll
            for (int b = 0; b < 2; ++b)
#pragma unroll
                for (int m = 0; m < 4; ++m)
#pragma unroll
                    for (int n = 0; n < 2; ++n) acc[a][b][m][n] = (f32x4){0.f, 0.f, 0.f, 0.f};
        cur = nxt; cA = nA; cB = nB; ++ui;
        if constexpr (GATHER) { *GSLOT(0) = *GSLOT(1); }
        if (wr == 1) PG8_BAR;
    }
    PG8_WAIT_V(0);
    PG8_BAR;
#undef PG8_SA
#undef PG8_SB
#undef PG8_STAGE
#undef PG8_STAGE2
#undef PG8_ROWS
#undef GSLOT
#undef VGC
#undef PG8_LDA
#undef PG8_LDB
#undef PG8_MMA
#undef PG8_WAIT_V
#undef PG8_WAIT_L
#undef PG8_BAR
#undef PG8_SCHED
}

typedef const f32x4 (&AccRef)[2][2][4][2];
__device__ __forceinline__ float ss16(const float* p) { const f32x4 a = *(const f32x4*)p, b = *(const f32x4*)(p + 4), c = *(const f32x4*)(p + 8), d = *(const f32x4*)(p + 12);
    return (((a[0] + a[1]) + (a[2] + a[3])) + ((b[0] + b[1]) + (b[2] + b[3]))) + (((c[0] + c[1]) + (c[2] + c[3])) + ((d[0] + d[1]) + (d[2] + d[3]))); }
__device__ __forceinline__ float rs_of(const float* rstd, int ssmode, int row) { return ssmode ? __builtin_amdgcn_rsqf(ss16(rstd + (size_t)row * 16) * (1.f / D) + 1e-6f) : rstd[row]; }

struct EpiInProj {
    static constexpr bool PERM = true, TRANS = true;
    bf16* P; const float* rstd; float* dt; int ssmode;
    __device__ __forceinline__ void operator()(AccRef acc, const Unit& u, int wr, int wc, int fr, int fq) const {
        const int row0 = u.pm * BM + wr * 64 + fr;
        float scl[2][4];
#pragma unroll
        for (int ai = 0; ai < 2; ++ai)
#pragma unroll
            for (int m = 0; m < 4; ++m) scl[ai][m] = rs_of(rstd, ssmode, row0 + ai * HALF + m * 16);
        if (u.pn < 21) {
            const int col0 = u.pn * BM + wc * 32 + 8 * fq;
#pragma unroll
            for (int ai = 0; ai < 2; ++ai)
#pragma unroll
                for (int m = 0; m < 4; ++m) { const int row = row0 + ai * HALF + m * 16; const float s = scl[ai][m]; bf16* rowp = P + (size_t)row * PLD + col0;
#pragma unroll
                    for (int bj = 0; bj < 2; ++bj) { const f32x4 v0 = acc[ai][bj][m][0] * s, v1 = acc[ai][bj][m][1] * s;
                        u32x4 w; w.x = pk2(v0[0], v0[1]); w.y = pk2(v0[2], v0[3]); w.z = pk2(v1[0], v1[1]); w.w = pk2(v1[2], v1[3]);
                        *(u32x4*)(rowp + bj * HALF) = w; } }
        } else if (wc == 0 && fq == 0) {
#pragma unroll
            for (int ai = 0; ai < 2; ++ai)
#pragma unroll
                for (int m = 0; m < 4; ++m) { const int row = row0 + ai * HALF + m * 16; const float s = scl[ai][m];
                    *(f32x4*)(dt + (size_t)row * 8) = acc[ai][0][m][0] * s; *(f32x4*)(dt + (size_t)row * 8 + 4) = acc[ai][0][m][1] * s; }
        }
    }
};
struct EpiPlain {
    static constexpr bool PERM = true, TRANS = true;
    bf16* P; bf16* Y2;
    __device__ __forceinline__ void operator()(AccRef acc, const Unit& u, int wr, int wc, int fr, int fq) const {
        bf16* O = (u.e == 0) ? P : (u.e == 1 ? P + C_XBC : Y2); const int ldc = (u.e == 2) ? D : PLD;
        const int row0 = u.pm * BM + wr * 64 + fr, col0 = u.pn * BM + wc * 32 + 8 * fq;
#pragma unroll
        for (int ai = 0; ai < 2; ++ai)
#pragma unroll
            for (int m = 0; m < 4; ++m) { bf16* rowp = O + (size_t)(row0 + ai * HALF + m * 16) * ldc + col0;
#pragma unroll
                for (int bj = 0; bj < 2; ++bj) { const f32x4 v0 = acc[ai][bj][m][0], v1 = acc[ai][bj][m][1];
                    u32x4 w; w.x = pk2(v0[0], v0[1]); w.y = pk2(v0[2], v0[3]); w.z = pk2(v1[0], v1[1]); w.w = pk2(v1[2], v1[3]);
                    *(u32x4*)(rowp + bj * HALF) = w; } }
    }
};
struct EpiGateMerge {
    static constexpr bool PERM = true, TRANS = true;
    const bf16* P; const bf16* Y2; bf16* Mg; int ldm; const float* rstd; int ssmode;
    __device__ __forceinline__ void operator()(AccRef acc, const Unit& u, int wr, int wc, int fr, int fq) const {
        asm volatile("" : "+v"(fr), "+v"(fq));
        const bf16* Y = (u.e == 0) ? P : (u.e == 1 ? P + C_XBC : Y2); const int ldy = (u.e == 2) ? D : PLD; const int first = (u.e == 0);
        const int row0 = u.pm * BM + wr * 64 + fr, col0 = u.pn * BM + wc * 32 + 8 * fq;
#pragma unroll
        for (int ai = 0; ai < 2; ++ai) {
            u32x4 yv[4][2], mv[4][2]; float sc[4];
#pragma unroll
            for (int m = 0; m < 4; ++m) { const int row = row0 + ai * HALF + m * 16; sc[m] = rs_of(rstd, ssmode, row);
#pragma unroll
                for (int bj = 0; bj < 2; ++bj) { yv[m][bj] = *(const u32x4*)(Y + (size_t)row * ldy + col0 + bj * HALF);
                    mv[m][bj] = first ? (u32x4){0u, 0u, 0u, 0u} : *(const u32x4*)(Mg + (size_t)row * ldm + col0 + bj * HALF); } }
#pragma unroll
            for (int m = 0; m < 4; ++m) { const int row = row0 + ai * HALF + m * 16;
#pragma unroll
                for (int bj = 0; bj < 2; ++bj) { float y[8], p[8], o[8]; unpack8(yv[m][bj], y); unpack8(mv[m][bj], p);
                    const f32x4 v0 = acc[ai][bj][m][0] * sc[m], v1 = acc[ai][bj][m][1] * sc[m];
#pragma unroll
                    for (int j = 0; j < 4; ++j) { o[j] = sigm(v0[j]) * y[j] + p[j]; o[4 + j] = sigm(v1[j]) * y[4 + j] + p[4 + j]; }
                    *(u32x4*)(Mg + (size_t)row * ldm + col0 + bj * HALF) = pack8(o); } }
        }
    }
};
struct EpiResid {
    static constexpr bool PERM = false, TRANS = true;
    const float* xin; float* xout; const float* gates; int e;
    __device__ __forceinline__ void operator()(AccRef acc, const Unit& u, int wr, int wc, int fr, int fq) const {
        const int row0 = u.pm * BM + wr * 64 + fr, col0 = u.pn * BM + wc * 32 + 4 * fq;
#pragma unroll
        for (int ai = 0; ai < 2; ++ai)
#pragma unroll
            for (int m = 0; m < 4; ++m) { const int row = row0 + ai * HALF + m * 16; const float s = gates ? gates[(size_t)row * 8 + e] : 1.f;
                const float* ip = xin + (size_t)row * D + col0; float* op = xout + (size_t)row * D + col0;
#pragma unroll
                for (int bj = 0; bj < 2; ++bj)
#pragma unroll
                    for (int n = 0; n < 2; ++n) *(f32x4*)(op + bj * HALF + n * 16) = *(const f32x4*)(ip + bj * HALF + n * 16) + acc[ai][bj][m][n] * s; }
    }
};
struct EpiResidB {
    static constexpr bool PERM = true, TRANS = true;
    bf16* xb; float* SS; float* xf;
    __device__ __forceinline__ void operator()(AccRef acc, const Unit& u, int wr, int wc, int fr, int fq) const {
        asm volatile("" : "+v"(fr), "+v"(fq));
        const int row0 = u.pm * BM + wr * 64 + fr, col0 = u.pn * BM + wc * 32 + 8 * fq;
#pragma unroll
        for (int ai = 0; ai < 2; ++ai) {
            u32x4 xv[4][2];
#pragma unroll
            for (int m = 0; m < 4; ++m)
#pragma unroll
                for (int bj = 0; bj < 2; ++bj) xv[m][bj] = *(const u32x4*)(xb + (size_t)(row0 + ai * HALF + m * 16) * D + col0 + bj * HALF);
#pragma unroll
            for (int m = 0; m < 4; ++m) { const int row = row0 + ai * HALF + m * 16; bf16* rowp = xb + (size_t)row * D + col0; float ss = 0.f;
#pragma unroll
                for (int bj = 0; bj < 2; ++bj) { float v[8]; unpack8(xv[m][bj], v);
#pragma unroll
                    for (int j = 0; j < 4; ++j) { v[j] += acc[ai][bj][m][0][j]; v[4 + j] += acc[ai][bj][m][1][j]; }
                    *(u32x4*)(rowp + bj * HALF) = pack8(v);
                    if (xf) { float* fp = xf + (size_t)row * D + col0 + bj * HALF; *(f32x4*)fp = (f32x4){v[0], v[1], v[2], v[3]}; *(f32x4*)(fp + 4) = (f32x4){v[4], v[5], v[6], v[7]}; }
#pragma unroll
                    for (int j = 0; j < 8; ++j) ss += v[j] * v[j]; }
                if (SS) { ss += __shfl_xor(ss, 16); ss += __shfl_xor(ss, 32); if (fq == 0) SS[(size_t)row * 16 + u.pn * 4 + wc] = ss; } }
        }
    }
};
struct EpiSwiglu {
    static constexpr bool PERM = true, TRANS = true;
    bf16* act; int ldc; const float* rstd; int ssmode;
    __device__ __forceinline__ void operator()(AccRef acc, const Unit& u, int wr, int wc, int fr, int fq) const {
        asm volatile("" : "+v"(fr), "+v"(fq));
        const int row0 = u.pm * BM + wr * 64 + fr, col0 = u.pn * HALF + wc * 32 + 8 * fq;
        float scl[2][4];
        if (u.rows) { int tk[2][4];
#pragma unroll
            for (int ai = 0; ai < 2; ++ai)
#pragma unroll
                for (int m = 0; m < 4; ++m) { const int lr = wr * 64 + fr + ai * HALF + m * 16; tk[ai][m] = (lr < u.nvalid) ? u.rows[2 * lr] : 0; }
#pragma unroll
            for (int ai = 0; ai < 2; ++ai)
#pragma unroll
                for (int m = 0; m < 4; ++m) scl[ai][m] = rstd[tk[ai][m]];
        } else {
#pragma unroll
            for (int ai = 0; ai < 2; ++ai)
#pragma unroll
                for (int m = 0; m < 4; ++m) scl[ai][m] = rs_of(rstd, ssmode, row0 + ai * HALF + m * 16); }
#pragma unroll
        for (int ai = 0; ai < 2; ++ai)
#pragma unroll
            for (int m = 0; m < 4; ++m) { const int row = row0 + ai * HALF + m * 16;
                const float s = scl[ai][m];
                float o[8];
#pragma unroll
                for (int n = 0; n < 2; ++n)
#pragma unroll
                    for (int j = 0; j < 4; ++j) o[4 * n + j] = silu(acc[ai][0][m][n][j] * s) * (acc[ai][1][m][n][j] * s);
                *(u32x4*)(act + (size_t)row * ldc + col0) = pack8(o); }
    }
};
struct EpiMoeOut {
    static constexpr bool PERM = true, TRANS = true;
    bf16* Y; size_t kstride;
    __device__ __forceinline__ void operator()(AccRef acc, const Unit& u, int wr, int wc, int fr, int fq) const {
        const int row0 = u.pm * BM + wr * 64 + fr, col0 = u.pn * BM + wc * 32 + 8 * fq; bf16* O = Y + (size_t)u.ks * kstride;
#pragma unroll
        for (int ai = 0; ai < 2; ++ai)
#pragma unroll
            for (int m = 0; m < 4; ++m) { bf16* rowp = O + (size_t)(row0 + ai * HALF + m * 16) * D + col0;
#pragma unroll
                for (int bj = 0; bj < 2; ++bj) { const f32x4 v0 = acc[ai][bj][m][0], v1 = acc[ai][bj][m][1];
                    u32x4 w; w.x = pk2(v0[0], v0[1]); w.y = pk2(v0[2], v0[3]); w.z = pk2(v1[0], v1[1]); w.w = pk2(v1[2], v1[3]);
                    *(u32x4*)(rowp + bj * HALF) = w; } }
    }
};
}

#define XB_TMO      128
#define XB_XCNT(j)  (256  + 64 * (j))
#define XB_XSUB(j)  (1280 + 64 * (j))
#define XB_XGEN(j)  (2304 + 64 * (j))
#define XB_TOP      3328
#define XB_TOPGEN   3392
#define XCD_BAR_WORDS 3456
#define XB_SPIN_CAP (1u << 18)

__device__ __forceinline__ unsigned xb_ld(unsigned* p)              { return __hip_atomic_load(p, __ATOMIC_RELAXED, __HIP_MEMORY_SCOPE_AGENT); }
__device__ __forceinline__ unsigned xb_add(unsigned* p, unsigned v) { return __hip_atomic_fetch_add(p, v, __ATOMIC_RELAXED, __HIP_MEMORY_SCOPE_AGENT); }
__device__ __forceinline__ unsigned xb_xcc_id() { return (unsigned)__builtin_amdgcn_s_getreg((3 << 11) | 20) & 0xFu; }
#define XB_SPIN(cond, bar) do { unsigned _sp = 0; while (cond) { __builtin_amdgcn_s_sleep(1); \
    if ((++_sp & 255u) == 0u) { if (xb_ld(&(bar)[XB_TMO])) break; if (_sp > XB_SPIN_CAP) { atomicAdd(&(bar)[XB_TMO], 1u); break; } } } } while (0)

struct XcdBarrier { unsigned* bar; unsigned x; volatile LAS unsigned* st; };

__device__ __forceinline__ XcdBarrier xcd_barrier_post(unsigned* bar, volatile LAS unsigned* st) {
    XcdBarrier b; b.bar = bar; b.x = xb_xcc_id(); b.st = st;
    if (threadIdx.x == 0) (void)xb_add(&bar[XB_XCNT(b.x)], 1u);
    return b;
}
__device__ __forceinline__ void xcd_barrier_complete(unsigned* bar, unsigned x, unsigned& nloc, unsigned& nx) {
    const unsigned G = gridDim.x * gridDim.y * gridDim.z;
    unsigned sum, cnt, mine, sp = 0u;
    for (;;) {
        sum = 0u; cnt = 0u; mine = 0u;
#pragma unroll
        for (unsigned j = 0; j < 16; ++j) { const unsigned c = xb_ld(&bar[XB_XCNT(j)]); sum += c; cnt += (c > 0u) ? 1u : 0u; mine = (j == x) ? c : mine; }
        if (sum == G) break;
        __builtin_amdgcn_s_sleep(1);
        if ((++sp & 255u) == 0u) { if (xb_ld(&bar[XB_TMO])) break; if (sp > XB_SPIN_CAP) { atomicAdd(&bar[XB_TMO], 1u); break; } }
    }
    nloc = mine > 0u ? mine : 1u; nx = cnt > 0u ? cnt : 1u;
}
__device__ __forceinline__ void xcd_barrier(const XcdBarrier& b) {
    asm volatile("s_waitcnt vmcnt(0)" ::: "memory");
    __syncthreads();
    if (threadIdx.x == 0) {
        unsigned* bar = b.bar;
        __builtin_amdgcn_s_waitcnt(0);
        unsigned nloc = b.st[0], nx = b.st[1];
        if (nloc == 0u) { xcd_barrier_complete(bar, b.x, nloc, nx); b.st[0] = nloc; b.st[1] = nx; }
        const unsigned old = xb_add(&bar[XB_XSUB(b.x)], 1u);
        const unsigned gen = old / nloc;
        if (old + 1u == (gen + 1u) * nloc) {
            __builtin_amdgcn_fence(__ATOMIC_RELEASE, "agent");
            asm volatile("s_waitcnt vmcnt(0)" ::: "memory");
            const unsigned og = xb_add(&bar[XB_TOP], 1u);
            const unsigned tg = og / nx;
            if (og + 1u == (tg + 1u) * nx) xb_add(&bar[XB_TOPGEN], 1u);
            else XB_SPIN(xb_ld(&bar[XB_TOPGEN]) == tg, bar);
            __builtin_amdgcn_fence(__ATOMIC_ACQUIRE, "agent");
            xb_add(&bar[XB_XGEN(b.x)], 1u);
            asm volatile("s_waitcnt vmcnt(0)" ::: "memory");
        } else {
            XB_SPIN(xb_ld(&bar[XB_XGEN(b.x)]) == gen, bar);
            __builtin_amdgcn_fence(__ATOMIC_ACQUIRE, "agent");
            asm volatile("s_waitcnt vmcnt(0)" ::: "memory");
        }
    }
    __syncthreads();
}

struct Args { const float* in[34]; float* out; unsigned char* ws; int ph_lo, ph_hi; };
struct Frame {
    LAS unsigned char* lds;
    int vcu, G, cid, wid;
    float* out; unsigned char* ws; unsigned char* st;
};
__device__ __forceinline__ const float* inptr(LAS unsigned char* lds, int i) {
    int off = LDSCTL_OFF + 8 * i; asm volatile("" : "+v"(off));
    const LAS unsigned* p = (const LAS unsigned*)(lds + off);
    const unsigned lo = __builtin_amdgcn_readfirstlane(p[0]), hi = __builtin_amdgcn_readfirstlane(p[1]);
    return (const float*)(((unsigned long long)hi << 32) | lo);
}
#define INP(i) inptr(F.lds, (i))

__device__ __forceinline__ void conv_item(const float* W, int ld, int k0, int c0, int nvalid, const float* scale, bf16* dst, int K, int drow0, LAS float* scr, int lane) {
    const int n4 = (lane & 15) * 4;
#pragma unroll 4
    for (int i = 0; i < 16; ++i) { const int kk = 4 * i + (lane >> 4);
        f32x4 v = {0.f, 0.f, 0.f, 0.f}; if (n4 < nvalid) { v = *(const f32x4*)(W + (size_t)(k0 + kk) * ld + c0 + n4); if (scale) v *= scale[k0 + kk]; }
        LAS float* d = scr + kk * 65 + n4; d[0] = v[0]; d[1] = v[1]; d[2] = v[2]; d[3] = v[3]; }
    LDS_WAIT(); asm volatile("" ::: "memory");
    const int c = lane & 7;
#pragma unroll
    for (int j = 0; j < 8; ++j) { const int nn = (lane >> 3) + 8 * j; const LAS float* sp = scr + (8 * c) * 65 + nn;
        u32x4 o; o.x = pk2(sp[0 * 65], sp[1 * 65]); o.y = pk2(sp[2 * 65], sp[3 * 65]); o.z = pk2(sp[4 * 65], sp[5 * 65]); o.w = pk2(sp[6 * 65], sp[7 * 65]);
        *(u32x4*)(dst + (size_t)(drow0 + nn) * K + k0 + 8 * c) = o; }
    LDS_WAIT(); asm volatile("" ::: "memory");
}
__device__ __forceinline__ void conv_seg(Frame& F, const float* W, int ld, int K, int c0, int nvalid, int ntotal, const float* scale, bf16* dst, int r0, int blk, int blks) {
    const int ptid = otid(), plane = ptid & 63, pwave = __builtin_amdgcn_readfirstlane(ptid >> 6);
    LAS float* scr = (LAS float*)(F.lds + pwave * 16640);
    const int gw = F.vcu * 8 + pwave, NGW = F.G * 8;
    const int nblk = ntotal / 64, nitems = (K / 64) * nblk;
    for (int it = gw; it < nitems; it += NGW) {
        const int kb = it / nblk, nb = it % nblk, n0 = nb * 64;
        int nv = nvalid - n0; nv = nv < 0 ? 0 : (nv > 64 ? 64 : nv);
        conv_item(W, ld, kb * 64, c0 + n0, nv, scale, dst, K, r0 + (n0 / blk) * blks + (n0 % blk), scr, plane);
    }
}
__device__ __forceinline__ void conv_layer_weights(Frame& F, int l, int part) {
    unsigned char* wl = F.ws + WS_W + (size_t)l * WL_STRIDE;
    const float* win = INP(2) + (size_t)l * D * INC; const float* n1 = INP(1) + l * D;
    const int BIGB = 1 << 30;
    if (part == 0) {
        conv_seg(F, win, INC, D, 0, 3328, 3328, n1, (bf16*)(wl + WL_IN), 0, BIGB, 0);
        conv_seg(F, win, INC, D, 3336, 2048, 2048, n1, (bf16*)(wl + WL_IN), 3328, BIGB, 0);
        conv_seg(F, win, INC, D, 3328, 8, 256, n1, (bf16*)(wl + WL_IN), 5376, BIGB, 0);
    } else {
        conv_seg(F, win, INC, D, 5384, 3072, 3072, n1, (bf16*)(wl + WL_GATE), 0, BIGB, 0);
        for (int i = 0; i < 3; ++i)
            conv_seg(F, INP(23) + ((size_t)l * 3 + i) * 512 * D, D, 512, 0, D, D, nullptr, (bf16*)(wl + WL_BR) + (size_t)i * D * 512, 0, BIGB, 0);
        conv_seg(F, INP(24) + (size_t)l * D * D, D, D, 0, D, D, nullptr, (bf16*)(wl + WL_OUT), 0, BIGB, 0);
    }
}
__device__ __forceinline__ void conv_ffn_weights(Frame& F) {
    const float* n2 = INP(25);
    conv_seg(F, INP(26), FF, D, 0, FF, FF, n2, (bf16*)(F.ws + WS_FFUP), 0, 128, 256);
    conv_seg(F, INP(27), FF, D, 0, FF, FF, n2, (bf16*)(F.ws + WS_FFUP), 128, 128, 256);
    conv_seg(F, INP(28), D, FF, 0, D, D, nullptr, (bf16*)(F.ws + WS_FFDN), 0, 1 << 30, 0);
}
__device__ __forceinline__ void conv_moe_weights(Frame& F) {
    const float* n2 = INP(25) + D;
    for (int e = 0; e < NE; ++e) {
        bf16* up = (bf16*)(F.ws + WS_MOEW + (size_t)e * MOEW_STRIDE); bf16* dn = (bf16*)(F.ws + WS_MOEW + (size_t)e * MOEW_STRIDE + MOEW_DN);
        conv_seg(F, INP(30) + (size_t)e * D * FFE, FFE, D, 0, FFE, FFE, n2, up, 0, 128, 256);
        conv_seg(F, INP(31) + (size_t)e * D * FFE, FFE, D, 0, FFE, FFE, n2, up, 128, 128, 256);
        conv_seg(F, INP(32) + (size_t)e * FFE * D, D, FFE, 0, D, D, nullptr, dn, 0, 1 << 30, 0);
    }
}

__device__ __forceinline__ void xprep_phase(Frame& F, const float* x) {
    const int ptid = otid(), plane = ptid & 63, pwave = __builtin_amdgcn_readfirstlane(ptid >> 6);
    const int gw = F.vcu * 8 + pwave, NGW = F.G * 8;
    bf16* xb = (bf16*)(F.ws + WS_XB); float* rstd = (float*)(F.ws + WS_RSTD);
    for (int m0 = 2 * gw; m0 < M; m0 += 2 * NGW) {
        f32x4 v[2][4];
#pragma unroll
        for (int q = 0; q < 2; ++q) { const f32x4* xr = (const f32x4*)(x + (size_t)(m0 + q) * D) + plane;
#pragma unroll
            for (int j = 0; j < 4; ++j) v[q][j] = xr[64 * j]; }
#pragma unroll
        for (int q = 0; q < 2; ++q) { const int m = m0 + q; float sq = 0.f;
#pragma unroll
            for (int j = 0; j < 4; ++j) sq += (v[q][j].x * v[q][j].x + v[q][j].y * v[q][j].y) + (v[q][j].z * v[q][j].z + v[q][j].w * v[q][j].w);
            sq = wave_sum(sq);
            if (plane == 0) rstd[m] = __builtin_amdgcn_rsqf(sq * (1.f / D) + 1e-6f);
            u32x2* o8 = (u32x2*)(xb + (size_t)m * D) + plane;
#pragma unroll
            for (int j = 0; j < 4; ++j) { u32x2 w; w.x = pk2(v[q][j].x, v[q][j].y); w.y = pk2(v[q][j].z, v[q][j].w); o8[64 * j] = w; } }
    }
}
__device__ __forceinline__ void final_norm_phase(Frame& F) {
    const int ptid = otid(), plane = ptid & 63, pwave = __builtin_amdgcn_readfirstlane(ptid >> 6);
    const int gw = F.vcu * 8 + pwave, NGW = F.G * 8;
    const float* fw = INP(33); const unsigned* pinfo = (const unsigned*)(F.ws + WS_PINFO); const int* cnt = (const int*)(F.ws + WS_CNT);
    int tb[8]; { int t = 0;
#pragma unroll
        for (int e = 0; e < 8; ++e) { int n = __builtin_amdgcn_readfirstlane(cnt[e]); n = n < 0 ? 0 : (n > 32768 ? 32768 : n); tb[e] = t; t += (n + 255) >> 8; } }
    const bf16* Y0 = (const bf16*)(F.ws + WS_YP0); const bf16* Y1 = (const bf16*)(F.ws + WS_YP1); const bf16* Y2 = (const bf16*)(F.ws + WS_YP2);
    f32x4 fwv[4];
#pragma unroll
    for (int j = 0; j < 4; ++j) fwv[j] = *((const f32x4*)fw + plane + 64 * j);
    for (int m0 = 2 * gw; m0 < M; m0 += 2 * NGW) {
        f32x4 v[2][4]; u32x2 ya[2][2][4]; float wg[2][2]; int sgm[2][2]; const bf16* yp[2][2];
#pragma unroll
        for (int q = 0; q < 2; ++q) { const int m = m0 + q;
            const f32x4* xr = (const f32x4*)(F.out + (size_t)m * D) + plane;
#pragma unroll
            for (int j = 0; j < 4; ++j) v[q][j] = xr[64 * j];
#pragma unroll
            for (int p = 0; p < 2; ++p) {
                const unsigned pk = __builtin_amdgcn_readfirstlane(pinfo[((size_t)m * 2 + p) * 2]); wg[q][p] = __builtin_bit_cast(float, __builtin_amdgcn_readfirstlane(pinfo[((size_t)m * 2 + p) * 2 + 1]));
                const int e = (int)(pk >> 20), slot = (int)(pk & 0xFFFFFu);
                int tbe = tb[0];
#pragma unroll
                for (int k = 1; k < 8; ++k) tbe = (e == k) ? tb[k] : tbe;
                const int gr = tbe * 256 + slot, seg = gr >> 15, lr = gr & 32767; sgm[q][p] = seg;
                yp[q][p] = (seg == 0 ? Y0 : (seg == 1 ? Y1 : Y2)) + (size_t)lr * D + 4 * plane; } }
#pragma unroll
        for (int q = 0; q < 2; ++q)
#pragma unroll
            for (int p = 0; p < 2; ++p)
#pragma unroll
                for (int j = 0; j < 4; ++j) ya[q][p][j] = *(const u32x2*)(yp[q][p] + 256 * j);
#pragma unroll
        for (int q = 0; q < 2; ++q) { const int m = m0 + q;
#pragma unroll
            for (int p = 0; p < 2; ++p) { const float wgt = wg[q][p];
#pragma unroll
                for (int j = 0; j < 4; ++j) { const u32x2 yy = ya[q][p][j]; v[q][j].x += wgt * bflo(yy.x); v[q][j].y += wgt * bfhi(yy.x); v[q][j].z += wgt * bflo(yy.y); v[q][j].w += wgt * bfhi(yy.y); }
                if (sgm[q][p] == 2) {
#pragma unroll
                    for (int ks = 1; ks < 4; ++ks)
#pragma unroll
                        for (int j = 0; j < 4; ++j) { const u32x2 yy = *(const u32x2*)(yp[q][p] + (size_t)ks * (YP2_STRIDE / 2) + 256 * j); v[q][j].x += wgt * bflo(yy.x); v[q][j].y += wgt * bfhi(yy.x); v[q][j].z += wgt * bflo(yy.y); v[q][j].w += wgt * bfhi(yy.y); } } }
            float ssq = 0.f;
#pragma unroll
            for (int j = 0; j < 4; ++j) ssq += (v[q][j].x * v[q][j].x + v[q][j].y * v[q][j].y) + (v[q][j].z * v[q][j].z + v[q][j].w * v[q][j].w);
            ssq = wave_sum(ssq);
            const float r = __builtin_amdgcn_rsqf(ssq * (1.f / D) + 1e-6f);
            f32x4* xo = (f32x4*)(F.out + (size_t)m * D) + plane;
#pragma unroll
            for (int j = 0; j < 4; ++j) xo[64 * j] = v[q][j] * r * fwv[j]; }
    }
}
__device__ __forceinline__ void router_phase(Frame& F) {
    const int ptid = otid(), plane = ptid & 63, pwave = __builtin_amdgcn_readfirstlane(ptid >> 6);
    const float* nw = INP(25) + D; const float* rt = INP(29); float* rstd_w = (float*)(F.ws + WS_RSTD); bf16* xb = (bf16*)(F.ws + WS_XB);
    int* cnt = (int*)(F.ws + WS_CNT); int* list2 = (int*)(F.ws + WS_LIST);
    LAS int* lsel = (LAS int*)F.lds;
    LAS float* lwt = (LAS float*)(F.lds + 1024);
    LAS int* lrank = (LAS int*)(F.lds + 2048);
    LAS int* lcnt = (LAS int*)(F.lds + 3072);
    for (int blk = F.vcu; blk < M / 128; blk += F.G) {
        if (ptid < 16) lcnt[ptid] = 0;
        __syncthreads();
        for (int k = 0; k < 16; ++k) {
            const int lt = pwave * 16 + k, m = blk * 128 + lt;
            float acc[8];
#pragma unroll
            for (int e = 0; e < 8; ++e) acc[e] = 0.f;
            const u32x2* xr2 = (const u32x2*)(xb + (size_t)m * D) + plane;
            f32x4 xv4[4]; float ssq = 0.f;
#pragma unroll
            for (int j = 0; j < 4; ++j) { const u32x2 xx = xr2[64 * j]; xv4[j] = (f32x4){bflo(xx.x), bfhi(xx.x), bflo(xx.y), bfhi(xx.y)}; ssq += (xv4[j].x * xv4[j].x + xv4[j].y * xv4[j].y) + (xv4[j].z * xv4[j].z + xv4[j].w * xv4[j].w); }
            ssq = wave_sum(ssq);
#pragma unroll
            for (int j = 0; j < 4; ++j) { const int kk = 4 * plane + 256 * j; const f32x4 nwv = *(const f32x4*)(nw + kk);
#pragma unroll
                for (int q = 0; q < 4; ++q) { const float xv = xv4[j][q] * nwv[q];
                    const f32x4 r0v = *(const f32x4*)(rt + (size_t)(kk + q) * 8), r1v = *(const f32x4*)(rt + (size_t)(kk + q) * 8 + 4);
                    acc[0] += xv * r0v.x; acc[1] += xv * r0v.y; acc[2] += xv * r0v.z; acc[3] += xv * r0v.w; acc[4] += xv * r1v.x; acc[5] += xv * r1v.y; acc[6] += xv * r1v.z; acc[7] += xv * r1v.w; } }
            const float sc = __builtin_amdgcn_rsqf(ssq * (1.f / D) + 1e-6f);
            if (plane == 0) rstd_w[m] = sc;
#pragma unroll
            for (int e = 0; e < 8; ++e) acc[e] = wave_sum(acc[e]) * sc;
            int i0 = 0; float v0 = acc[0];
#pragma unroll
            for (int e = 1; e < 8; ++e) if (acc[e] > v0) { v0 = acc[e]; i0 = e; }
            int i1 = -1; float v1 = -3.0e38f;
#pragma unroll
            for (int e = 0; e < 8; ++e) if (e != i0 && acc[e] > v1) { v1 = acc[e]; i1 = e; }
            const float e1 = expf(v1 - v0), w0 = 1.f / (1.f + e1), w1 = e1 / (1.f + e1);
            if (plane == 0) { lsel[2 * lt] = i0; lsel[2 * lt + 1] = i1; lwt[2 * lt] = w0; lwt[2 * lt + 1] = w1;
                lrank[2 * lt] = atomicAdd((int*)(lcnt + i0), 1); lrank[2 * lt + 1] = atomicAdd((int*)(lcnt + i1), 1); }
        }
        __syncthreads();
        if (ptid < 8) lcnt[8 + ptid] = atomicAdd(cnt + ptid, lcnt[ptid]);
        __syncthreads();
        if (ptid < 256) { const int e = lsel[ptid], slot = lcnt[8 + e] + lrank[ptid];
            u32x2 v; v.x = (unsigned)(blk * 128 + (ptid >> 1)); v.y = __builtin_bit_cast(unsigned, lwt[ptid]);
            *(u32x2*)(list2 + ((size_t)e * 32768 + slot) * 2) = v;
            u32x2 pi; pi.x = ((unsigned)e << 20) | (unsigned)slot; pi.y = v.y; *(u32x2*)((unsigned*)(F.ws + WS_PINFO) + ((size_t)(blk * 128) * 2 + ptid) * 2) = pi; }
        __syncthreads();
    }
}

__device__ __forceinline__ void vprep_phase(Frame& F, int layer) {
    const int ptid = otid(), plane = ptid & 63, pwave = __builtin_amdgcn_readfirstlane(ptid >> 6);
    constexpr int VP = 520, V_VB = 0, V_GB = 64 * VP * 2, V_VD = 2 * 64 * VP * 2;
    LAS bf16* VB = (LAS bf16*)(F.lds + V_VB); LAS bf16* GB = (LAS bf16*)(F.lds + V_GB); LAS bf16* VD = (LAS bf16*)(F.lds + V_VD);
    const bf16* P = (const bf16*)(F.ws + WS_BIG); bf16* VF = (bf16*)(F.ws + WS_VF); bf16* VM = (bf16*)(F.ws + WS_VMIX);
    const bf16* vdT = (const bf16*)(F.ws + WS_VLORA); const bf16* vuT = vdT + 32 * 512;
    const float* mu = INP(3) + layer * 1792 + 1024; const float* v0 = INP(16);
    const int tok = ptid >> 3, part = ptid & 7, r16 = plane & 15, q4 = plane >> 4;
    for (int it = F.vcu; it < M / 64; it += F.G) {
        const int m = it * 64 + tok; const int t = m & (T - 1);
        const bf16* cur = P + (size_t)m * PLD + 1024 + part * 64;
#pragma unroll
        for (int q = 0; q < 8; ++q) { float c[8], p[8]; unpack8(*(const u32x4*)(cur + q * 8), c);
            if (t > 0) unpack8(*(const u32x4*)(cur - PLD + q * 8), p); else {
#pragma unroll
                for (int e = 0; e < 8; ++e) p[e] = 0.f; }
            const f32x4 m0 = *(const f32x4*)(mu + part * 64 + q * 8), m1 = *(const f32x4*)(mu + part * 64 + q * 8 + 4);
#pragma unroll
            for (int e = 0; e < 4; ++e) { c[e] = c[e] + (p[e] - c[e]) * m0[e]; c[4 + e] = c[4 + e] + (p[4 + e] - c[4 + e]) * m1[e]; }
            const u32x4 o = pack8(c);
            if (layer == 0) *(u32x4*)(VF + (size_t)m * 512 + part * 64 + q * 8) = o; else *(LAS u32x4*)(VB + tok * VP + part * 64 + q * 8) = o; }
        if (layer == 0) continue;
        __syncthreads();
        { const int rb = pwave & 3, jt = pwave >> 2; f32x4 acc = {0.f, 0.f, 0.f, 0.f};
#pragma unroll 4
          for (int k0 = 0; k0 < 512; k0 += 32) acc = __builtin_amdgcn_mfma_f32_16x16x32_bf16(*(const LAS bf16x8*)(VB + (16 * rb + r16) * VP + k0 + 8 * q4), *(const bf16x8*)(vdT + (size_t)(16 * jt + r16) * 512 + k0 + 8 * q4), acc, 0, 0, 0);
#pragma unroll
          for (int jj = 0; jj < 4; ++jj) VD[(16 * rb + 4 * q4 + jj) * 40 + 16 * jt + r16] = (bf16)f2bf(acc[jj]); }
        __syncthreads();
        { const int rb = pwave & 3; const bf16x8 af = *(const LAS bf16x8*)(VD + (16 * rb + r16) * 40 + 8 * q4);
#pragma unroll 4
          for (int i = 0; i < 16; ++i) { const int ct = (pwave >> 2) * 16 + i;
              const f32x4 acc = __builtin_amdgcn_mfma_f32_16x16x32_bf16(af, *(const bf16x8*)(vuT + (size_t)(16 * ct + r16) * 32 + 8 * q4), (f32x4){0.f, 0.f, 0.f, 0.f}, 0, 0, 0);
              const float vc = v0[16 * ct + r16];
#pragma unroll
              for (int jj = 0; jj < 4; ++jj) GB[(16 * rb + 4 * q4 + jj) * VP + 16 * ct + r16] = (bf16)f2bf(sigm(vc + acc[jj])); } }
        __syncthreads();
#pragma unroll
        for (int q = 0; q < 8; ++q) { float v[8], g[8], vf[8]; unpack8(*(const LAS u32x4*)(VB + tok * VP + part * 64 + q * 8), v); unpack8(*(const LAS u32x4*)(GB + tok * VP + part * 64 + q * 8), g);
            unpack8(*(const u32x4*)(VF + (size_t)m * 512 + part * 64 + q * 8), vf);
#pragma unroll
            for (int e = 0; e < 8; ++e) v[e] = v[e] + (vf[e] - v[e]) * g[e];
            *(u32x4*)(VM + (size_t)m * 512 + part * 64 + q * 8) = pack8(v); }
        __syncthreads();
    }
}
__device__ __forceinline__ void prepass_a(Frame& F) {
    const int tid = otid();
    bf16* P = (bf16*)(F.ws + WS_BIG); bf16* BND2 = (bf16*)(F.ws + WS_BND2);
    { const int ch = tid & 127; const int kind = ch >> 6, part = ch & 7;
      double invf[4];
#pragma unroll
      for (int p = 0; p < 4; ++p) invf[p] = exp(-(double)(part * 4 + p) * (9.210340371976184 / 32.0));
      for (int m = F.vcu * 4 + (tid >> 7); m < M; m += F.G * 4) {
          const int t = m & (T - 1); bf16* ptr = P + (size_t)m * PLD + C_RET + ch * 8;
          float x[8]; unpack8(*(const u32x4*)ptr, x);
#pragma unroll
          for (int p = 0; p < 4; ++p) { double rev = (double)t * invf[p] * 0.15915494309189535; rev -= floor(rev);
              const float sn = __builtin_amdgcn_sinf((float)rev), cs = __builtin_amdgcn_cosf((float)rev);
              const float x0 = x[2 * p], x1 = x[2 * p + 1]; float o0 = x0 * cs - x1 * sn, o1 = x0 * sn + x1 * cs;
              if (kind) { o0 *= 0.125f; o1 *= 0.125f; }
              x[2 * p] = o0; x[2 * p + 1] = o1; }
          *(u32x4*)ptr = pack8(x); } }
    for (int i = F.vcu * 512 + tid; i < 1024 * 3 * 128; i += F.G * 512) { const int ch = i & 127, k = (i >> 7) % 3, r = i / 384;
        if ((r & 511) != 0) *(u32x4*)(BND2 + ((size_t)r * 3 + k) * 1024 + ch * 8) = *(const u32x4*)(P + ((size_t)r * 32 - 3 + k) * PLD + C_XBC + ch * 8); }
}
__device__ __forceinline__ void prepass_conv(Frame& F, int layer) {
    const int tid = otid();
    bf16* P = (bf16*)(F.ws + WS_BIG); const bf16* BND2 = (const bf16*)(F.ws + WS_BND2);
    const float* cw = INP(17) + layer * 1024 * 4; const float* cbias = INP(18) + layer * 1024;
    const int ch = tid & 127;
    f32x4 wv[8]; float bv[8];
#pragma unroll
    for (int e = 0; e < 8; ++e) { wv[e] = *(const f32x4*)(cw + (ch * 8 + e) * 4); bv[e] = cbias[ch * 8 + e]; }
    for (int r = F.vcu * 4 + (tid >> 7); r < M / 32; r += F.G * 4) {
        float w0[8], w1[8], w2[8];
        if ((r & 511) != 0) { unpack8(*(const u32x4*)(BND2 + ((size_t)r * 3 + 0) * 1024 + ch * 8), w0); unpack8(*(const u32x4*)(BND2 + ((size_t)r * 3 + 1) * 1024 + ch * 8), w1); unpack8(*(const u32x4*)(BND2 + ((size_t)r * 3 + 2) * 1024 + ch * 8), w2); }
        else {
#pragma unroll
            for (int e = 0; e < 8; ++e) { w0[e] = 0.f; w1[e] = 0.f; w2[e] = 0.f; } }
        bf16* ptr = P + (size_t)r * 32 * PLD + C_XBC + ch * 8;
#pragma unroll 4
        for (int i = 0; i < 32; ++i) {
            float x[8], o[8]; unpack8(*(const u32x4*)(ptr + (size_t)i * PLD), x);
#pragma unroll
            for (int e = 0; e < 8; ++e) { o[e] = silu(bv[e] + wv[e][0] * w0[e] + wv[e][1] * w1[e] + wv[e][2] * w2[e] + wv[e][3] * x[e]); w0[e] = w1[e]; w1[e] = w2[e]; w2[e] = x[e]; }
            *(u32x4*)(ptr + (size_t)i * PLD) = pack8(o);
        }
    }
}
template <int CTRL> __device__ __forceinline__ float dpp_f(float v) { return __builtin_bit_cast(float, __builtin_amdgcn_update_dpp(0, __builtin_bit_cast(int, v), CTRL, 0xF, 0xF, true)); }
__device__ __forceinline__ float red8(float v) { v += dpp_f<0xB1>(v); v += dpp_f<0x4E>(v); v += dpp_f<0x141>(v); return v; }
__device__ __forceinline__ float red16(float v) { v = red8(v); v += dpp_f<0x140>(v); return v; }

__device__ __forceinline__ void rwkv_seq(Frame& F, int layer, int bh) {
    const int ptid = otid(), plane = ptid & 63, pwave = __builtin_amdgcn_readfirstlane(ptid >> 6); (void)plane; (void)pwave;
    const int b = bh >> 3, h = bh & 7;
    LAS float* L = (LAS float*)F.lds;
    LAS float *rr = L, *ww = L + 2048, *kf = L + 4096, *vv = L + 6144, *aa = L + 8192, *bb = L + 10240, *gg = L + 12288, *yy = L + 14336, *tw = L + 16384, *xa = L + 18432, *sg = L + 20480, *bon = L + 24576;
    const float* mu = INP(3) + layer * 1792; const float* w_up = INP(4) + layer * 64 * 512; const float* w0 = INP(5) + layer * 512;
    const float* a_up = INP(6) + layer * 64 * 512; const float* a0 = INP(7) + layer * 512; const float* g_up = INP(8) + layer * 128 * 512;
    const float* k_k = INP(9) + layer * 512; const float* k_a = INP(10) + layer * 512; const float* r_k = INP(11) + layer * 512;
    const float* gn_w = INP(12) + layer * 512; const float* gn_b = INP(13) + layer * 512;
    const bf16* P = (const bf16*)(F.ws + WS_BIG); const bf16* vsrc = (const bf16*)(F.ws + (layer == 0 ? WS_VF : WS_VMIX)); bf16* yout = (bf16*)(F.ws + WS_YRW);
    const int tid = ptid, tok = tid >> 4, part = tid & 15, c4 = part * 4, cb = h * 64 + c4;
    const int srow = tid >> 3, sc0 = (tid & 7) * 8;
    float S[8];
#pragma unroll
    for (int j = 0; j < 8; ++j) S[j] = 0.f;
    for (int t0 = 0; t0 < T; t0 += 32) {
        {
            const int t = t0 + tok; const size_t m = (size_t)b * T + t;
            const bf16* cur = P + m * PLD;
#pragma unroll
            for (int q = 0; q < 3; ++q) {
                const int ch = part + 16 * q; int col, kind; LAS float* dst;
                if (ch < 8) { col = h * 64 + ch * 8; dst = rr + tok * 64 + ch * 8; kind = 0; }
                else if (ch < 16) { col = 512 + h * 64 + (ch - 8) * 8; dst = kf + tok * 64 + (ch - 8) * 8; kind = 0; }
                else if (ch < 24) { col = 1536 + (ch - 16) * 8; dst = tw + tok * 64 + (ch - 16) * 8; kind = 1; }
                else if (ch < 32) { col = 1600 + (ch - 24) * 8; dst = xa + tok * 64 + (ch - 24) * 8; kind = 0; }
                else { col = 1664 + (ch - 32) * 8; dst = sg + tok * 128 + (ch - 32) * 8; kind = 2; }
                float c[8], p[8]; unpack8(*(const u32x4*)(cur + col), c);
                if (t > 0) unpack8(*(const u32x4*)(cur - PLD + col), p); else {
#pragma unroll
                    for (int e = 0; e < 8; ++e) p[e] = 0.f; }
#pragma unroll
                for (int e = 0; e < 8; ++e) { float x = c[e] + (p[e] - c[e]) * mu[col + e]; if (kind == 1) x = tanhf(x); else if (kind == 2) x = sigm(x); dst[e] = x; }
            }
            if (part < 8) { float v[8]; unpack8(*(const u32x4*)(vsrc + m * 512 + h * 64 + part * 8), v);
#pragma unroll
                for (int e = 0; e < 8; ++e) vv[tok * 64 + part * 8 + e] = v[e]; }
        }
        __syncthreads();
        {
            f32x4 dw = *(const f32x4*)(w0 + cb), da = *(const f32x4*)(a0 + cb), dg = (f32x4){0.f, 0.f, 0.f, 0.f};
            for (int j = 0; j < 64; ++j) { const float tj = tw[tok * 64 + j], xj = xa[tok * 64 + j];
                dw += *(const f32x4*)(w_up + j * 512 + cb) * tj; da += *(const f32x4*)(a_up + j * 512 + cb) * xj; }
            for (int j = 0; j < 128; ++j) dg += *(const f32x4*)(g_up + j * 512 + cb) * sg[tok * 128 + j];
            float kr[4], kk[4], av[4], ss = 0.f;
#pragma unroll
            for (int e = 0; e < 4; ++e) { kr[e] = kf[tok * 64 + c4 + e]; kk[e] = kr[e] * k_k[cb + e]; ss += kk[e] * kk[e]; av[e] = sigm(da[e]); }
            ss = red16(ss);
            const float inv = __builtin_amdgcn_rsqf(fmaxf(ss, 1e-24f));
            float bs = 0.f;
#pragma unroll
            for (int e = 0; e < 4; ++e) { const float kn = kk[e] * inv; const int o = tok * 64 + c4 + e;
                const float ld = -expf(-softplus_acc(-dw[e]) - 0.5f);
                ww[o] = expf(ld); aa[o] = -kn; bb[o] = kn * av[e];
                const float knew = kr[e] * (1.f + (av[e] - 1.f) * k_a[cb + e]); kf[o] = knew; gg[o] = dg[e];
                bs += rr[o] * knew * r_k[cb + e]; }
            bs = red16(bs);
            if (part == 0) bon[tok] = bs;
        }
        __syncthreads();
        for (int s = 0; s < 32; ++s) {
            const f32x4 a0v = *(const LAS f32x4*)(aa + s * 64 + sc0), a1v = *(const LAS f32x4*)(aa + s * 64 + sc0 + 4);
            const f32x4 w0v = *(const LAS f32x4*)(ww + s * 64 + sc0), w1v = *(const LAS f32x4*)(ww + s * 64 + sc0 + 4);
            const f32x4 b0v = *(const LAS f32x4*)(bb + s * 64 + sc0), b1v = *(const LAS f32x4*)(bb + s * 64 + sc0 + 4);
            const f32x4 k0v = *(const LAS f32x4*)(kf + s * 64 + sc0), k1v = *(const LAS f32x4*)(kf + s * 64 + sc0 + 4);
            const f32x4 r0v = *(const LAS f32x4*)(rr + s * 64 + sc0), r1v = *(const LAS f32x4*)(rr + s * 64 + sc0 + 4);
            const float vi = vv[s * 64 + srow];
            float sa = 0.f;
#pragma unroll
            for (int j = 0; j < 4; ++j) sa += S[j] * a0v[j] + S[4 + j] * a1v[j];
            sa = red8(sa);
            float y = 0.f;
#pragma unroll
            for (int j = 0; j < 4; ++j) { S[j] = S[j] * w0v[j] + sa * b0v[j] + vi * k0v[j]; S[4 + j] = S[4 + j] * w1v[j] + sa * b1v[j] + vi * k1v[j]; y += S[j] * r0v[j] + S[4 + j] * r1v[j]; }
            y = red8(y);
            if ((tid & 7) == 0) yy[s * 64 + srow] = y;
        }
        __syncthreads();
        {
            const size_t m = (size_t)b * T + t0 + tok;
            float y[4], sm = 0.f;
#pragma unroll
            for (int e = 0; e < 4; ++e) { y[e] = yy[tok * 64 + c4 + e]; sm += y[e]; }
            const float mean = red16(sm) * (1.f / 64.f);
            float vs = 0.f;
#pragma unroll
            for (int e = 0; e < 4; ++e) { y[e] -= mean; vs += y[e] * y[e]; }
            const float rs = __builtin_amdgcn_rsqf(red16(vs) * (1.f / 64.f) + 64e-5f);
            const float bo = bon[tok];
            float o[4];
#pragma unroll
            for (int e = 0; e < 4; ++e) { const int idx = tok * 64 + c4 + e; o[e] = (y[e] * rs * gn_w[cb + e] + gn_b[cb + e] + bo * vv[idx]) * gg[idx]; }
            u32x2 w; w.x = pk2(o[0], o[1]); w.y = pk2(o[2], o[3]);
            *(u32x2*)(yout + m * 512 + cb) = w;
        }
        __syncthreads();
    }
}

__device__ __forceinline__ void ret_seq(Frame& F, int bh) {
    const int ptid = otid(), plane = ptid & 63, pwave = __builtin_amdgcn_readfirstlane(ptid >> 6); (void)plane; (void)pwave;
    const int b = bh >> 3, h = bh & 7;
    LAS float* L = (LAS float*)F.lds;
    LAS float *qq = L, *kk = L + 2048, *vv = L + 4096, *gg = L + 6144, *yy = L + 8192;
    bf16* P = (bf16*)(F.ws + WS_BIG);
    const int tid = ptid, tok = tid >> 4, part = tid & 15, c4 = part * 4;
    const int se = tid >> 3, sd0 = (tid & 7) * 8;
    const float gamma = 1.f - exp2f(-5.f - (float)h);
    float S[8];
#pragma unroll
    for (int j = 0; j < 8; ++j) S[j] = 0.f;
    for (int t0 = 0; t0 < T; t0 += 32) {
        {
            const int t = t0 + tok; const size_t m = (size_t)b * T + t;
#pragma unroll
            for (int q = 0; q < 2; ++q) {
                const int ch = part + 16 * q, kind = ch >> 3, cc = ch & 7;
                float x[8]; unpack8(*(const u32x4*)(P + m * PLD + C_RET + kind * 512 + h * 64 + cc * 8), x);
                LAS float* dst = (kind == 0 ? qq : kind == 1 ? kk : kind == 2 ? vv : gg) + tok * 64 + cc * 8;
                if (kind < 2) {
#pragma unroll
                    for (int p = 0; p < 4; ++p) { const int i = cc * 4 + p;
                        const double invf = exp(-(double)i * (9.210340371976184 / 32.0));
                        double sn, cs; sincos((double)t * invf, &sn, &cs);
                        const float x0 = x[2 * p], x1 = x[2 * p + 1], c = (float)cs, s = (float)sn;
                        float o0 = x0 * c - x1 * s, o1 = x0 * s + x1 * c;
                        if (kind == 1) { o0 *= 0.125f; o1 *= 0.125f; }
                        dst[2 * p] = o0; dst[2 * p + 1] = o1; }
                } else {
#pragma unroll
                    for (int e = 0; e < 8; ++e) dst[e] = x[e];
                }
            }
        }
        __syncthreads();
        for (int s = 0; s < 32; ++s) {
            const f32x4 k0v = *(const LAS f32x4*)(kk + s * 64 + sd0), k1v = *(const LAS f32x4*)(kk + s * 64 + sd0 + 4);
            const f32x4 q0v = *(const LAS f32x4*)(qq + s * 64 + sd0), q1v = *(const LAS f32x4*)(qq + s * 64 + sd0 + 4);
            const float ve = vv[s * 64 + se];
            float y = 0.f;
#pragma unroll
            for (int j = 0; j < 4; ++j) { S[j] = gamma * S[j] + k0v[j] * ve; S[4 + j] = gamma * S[4 + j] + k1v[j] * ve; y += q0v[j] * S[j] + q1v[j] * S[4 + j]; }
            y = red8(y);
            if ((tid & 7) == 0) yy[s * 64 + se] = y;
        }
        __syncthreads();
        {
            const size_t m = (size_t)b * T + t0 + tok;
            float y[4], ss = 0.f;
#pragma unroll
            for (int e = 0; e < 4; ++e) { y[e] = yy[tok * 64 + c4 + e]; ss += y[e] * y[e]; }
            const float rs = __builtin_amdgcn_rsqf(red16(ss) * (1.f / 64.f) + 1e-6f);
            float o[4];
#pragma unroll
            for (int e = 0; e < 4; ++e) o[e] = y[e] * rs * silu(gg[tok * 64 + c4 + e]);
            u32x2 w; w.x = pk2(o[0], o[1]); w.y = pk2(o[2], o[3]);
            *(u32x2*)(P + m * PLD + C_RETG + h * 64 + c4) = w;
        }
        __syncthreads();
    }
}

__device__ __forceinline__ void ssd_seq(Frame& F, int layer, int bh) {
    const int ptid = otid(), plane = ptid & 63, pwave = __builtin_amdgcn_readfirstlane(ptid >> 6); (void)plane; (void)pwave;
    const int b = bh >> 3, h = bh & 7, g = h >> 2;
    LAS float* L = (LAS float*)F.lds;
    LAS float *raw = L  , *xs = L + 11200, *Bc = L + 13248, *Cc = L + 17344, *yy = L + 21440, *dts = L + 23488, *das = L + 23520;
    bf16* P = (bf16*)(F.ws + WS_BIG); const float* dtb = (const float*)(F.ws + WS_DT);
    const float* cw = INP(17) + layer * 1024 * 4; const float* cbias = INP(18) + layer * 1024;
    const float dt_bias = INP(19)[layer * 8 + h], A = -expf(INP(20)[layer * 8 + h]), Dh = INP(21)[layer * 8 + h];
    const int tid = ptid;
    const int sp = tid >> 3, sn0 = (tid & 7) * 16;
    float S[16];
#pragma unroll
    for (int j = 0; j < 16; ++j) S[j] = 0.f;
    for (int i = tid; i < 3 * 320; i += 512) raw[i] = 0.f;
    __syncthreads();
    for (int t0 = 0; t0 < T; t0 += 32) {
        for (int idx = tid; idx < 32 * 40; idx += 512) {
            const int row = idx / 40, ch = idx % 40; const size_t m = (size_t)b * T + t0 + row;
            const int col = ch < 8 ? (C_XBC + h * 64 + ch * 8) : (ch < 24 ? (C_XBC + 512 + g * 128 + (ch - 8) * 8) : (C_XBC + 768 + g * 128 + (ch - 24) * 8));
            float x[8]; unpack8(*(const u32x4*)(P + m * PLD + col), x);
#pragma unroll
            for (int e = 0; e < 8; ++e) raw[(3 + row) * 320 + ch * 8 + e] = x[e];
        }
        if (tid < 32) { const size_t m = (size_t)b * T + t0 + tid; const float dt = softplus_acc(dtb[m * 8 + h] + dt_bias); dts[tid] = dt; das[tid] = expf(A * dt); }
        __syncthreads();
        for (int idx = tid; idx < 32 * 320; idx += 512) {
            const int row = idx / 320, c = idx % 320;
            const int chn = c < 64 ? (h * 64 + c) : (c < 192 ? (512 + g * 128 + (c - 64)) : (768 + g * 128 + (c - 192)));
            float a = cbias[chn];
#pragma unroll
            for (int k = 0; k < 4; ++k) a += cw[chn * 4 + k] * raw[(row + k) * 320 + c];
            a = silu(a);
            if (c < 64) xs[row * 64 + c] = a; else if (c < 192) Bc[row * 128 + (c - 64)] = a; else Cc[row * 128 + (c - 192)] = a;
        }
        __syncthreads();
        for (int s = 0; s < 32; ++s) {
            const float da = das[s], xv = xs[s * 64 + sp], dtx = dts[s] * xv;
            float y = 0.f;
#pragma unroll
            for (int q = 0; q < 4; ++q) { const f32x4 bv = *(const LAS f32x4*)(Bc + s * 128 + sn0 + q * 4), cv = *(const LAS f32x4*)(Cc + s * 128 + sn0 + q * 4);
#pragma unroll
                for (int j = 0; j < 4; ++j) { S[q * 4 + j] = da * S[q * 4 + j] + dtx * bv[j]; y += S[q * 4 + j] * cv[j]; } }
            y = red8(y);
            if ((tid & 7) == 0) yy[s * 64 + sp] = y + Dh * xv;
        }
        __syncthreads();
        {
            const int tok = tid >> 4, c4 = (tid & 15) * 4; const size_t m = (size_t)b * T + t0 + tok;
            u32x2 w; w.x = pk2(yy[tok * 64 + c4], yy[tok * 64 + c4 + 1]); w.y = pk2(yy[tok * 64 + c4 + 2], yy[tok * 64 + c4 + 3]);
            *(u32x2*)(P + m * PLD + C_XBC + h * 64 + c4) = w;
            for (int i = tid; i < 3 * 320; i += 512) raw[i] = raw[32 * 320 + i];
        }
        __syncthreads();
    }
}
__device__ __forceinline__ void ssm_norm_phase(Frame& F, int layer) {
    const int ptid = otid(), plane = ptid & 63, pwave = __builtin_amdgcn_readfirstlane(ptid >> 6);
    const int gw = F.vcu * 8 + pwave, NGW = F.G * 8;
    bf16* P = (bf16*)(F.ws + WS_BIG); const float* nw = INP(22) + layer * 512;
    float nwv[8];
#pragma unroll
    for (int e = 0; e < 8; ++e) nwv[e] = nw[plane * 8 + e];
    for (int m0 = 2 * gw; m0 < M; m0 += 2 * NGW) {
        u32x4 yv[2], zv[2];
#pragma unroll
        for (int q = 0; q < 2; ++q) { yv[q] = *(const u32x4*)(P + (size_t)(m0 + q) * PLD + C_XBC + plane * 8); zv[q] = *(const u32x4*)(P + (size_t)(m0 + q) * PLD + C_Z + plane * 8); }
#pragma unroll
        for (int q = 0; q < 2; ++q) { float y[8], z[8]; unpack8(yv[q], y); unpack8(zv[q], z);
            float ss = 0.f;
#pragma unroll
            for (int e = 0; e < 8; ++e) { y[e] *= silu(z[e]); ss += y[e] * y[e]; }
            ss = red16(ss); ss += __shfl_xor(ss, 16);
            const float rs = __builtin_amdgcn_rsqf(ss * (1.f / 256.f) + 1e-6f);
#pragma unroll
            for (int e = 0; e < 8; ++e) y[e] *= rs * nwv[e];
            *(u32x4*)(P + (size_t)(m0 + q) * PLD + C_Z + plane * 8) = pack8(y); }
    }
}
constexpr int PT = 72, PT2 = 136, PF = 68;
__device__ __forceinline__ f32x4 mfma16(bf16x8 a, bf16x8 b, f32x4 c) { return __builtin_amdgcn_mfma_f32_16x16x32_bf16(a, b, c, 0, 0, 0); }
template <int K, bool SA = false, bool SB = false> __device__ __forceinline__ f32x4 mm_ll(const LAS bf16* A, int pa, int m0, const LAS bf16* B, int pb, int n0, f32x4 acc, int lane) {
    const int r = lane & 15, q = lane >> 4;
    const int xa = SA ? (((m0 + r) >> 3) & 7) : 0, xb = SB ? (((n0 + r) >> 3) & 7) : 0;
    const LAS bf16* ap = A + (m0 + r) * pa; const LAS bf16* bp = B + (n0 + r) * pb;
#pragma unroll
    for (int k0 = 0; k0 < K; k0 += 32) acc = mfma16(*(const LAS bf16x8*)(ap + 8 * (((k0 >> 3) + q) ^ xa)), *(const LAS bf16x8*)(bp + 8 * (((k0 >> 3) + q) ^ xb)), acc);
    return acc;
}
template <int K> __device__ __forceinline__ f32x4 mm_lg(const LAS bf16* A, int pa, int m0, const bf16* B, int pb, int n0, f32x4 acc, int lane) {
    const int r = lane & 15, q = lane >> 4;
    const LAS bf16* ap = A + (m0 + r) * pa + 8 * q; const bf16* bp = B + (size_t)(n0 + r) * pb + 8 * q;
#pragma unroll
    for (int k0 = 0; k0 < K; k0 += 32) acc = mfma16(*(const LAS bf16x8*)(ap + k0), *(const bf16x8*)(bp + k0), acc);
    return acc;
}
__device__ __forceinline__ float redl16(float v) { return red16(v); }
__device__ __forceinline__ void st4bf(LAS bf16* p, f32x4 v) { u32x2 w; w.x = pk2(v[0], v[1]); w.y = pk2(v[2], v[3]); *(LAS u32x2*)p = w; }
__device__ __forceinline__ float ldbf(const LAS bf16* p) { return __builtin_bit_cast(float, (unsigned)(*p) << 16); }
constexpr f32x4 FZ4 = {0.f, 0.f, 0.f, 0.f};
__device__ __forceinline__ void tr_write8(LAS bf16* Tm, int pitch, int c0, int t, const float (&v)[8], int) {
    LAS bf16* base = Tm + c0 * pitch + (t ^ (((c0 >> 3) & 7) << 3));
#pragma unroll
    for (int e = 0; e < 8; ++e) base[e * pitch] = (bf16)f2bf(v[e]);
}
__device__ __forceinline__ float tr_at(const LAS bf16* Tm, int pitch, int row, int col) { return __builtin_bit_cast(float, (unsigned)Tm[row * pitch + (col ^ (((row >> 3) & 7) << 3))] << 16); }
__device__ __forceinline__ void ld8f(const LAS float* p, float (&v)[8]) { const f32x4 a = *(const LAS f32x4*)p, b = *(const LAS f32x4*)(p + 4); v[0] = a[0]; v[1] = a[1]; v[2] = a[2]; v[3] = a[3]; v[4] = b[0]; v[5] = b[1]; v[6] = b[2]; v[7] = b[3]; }
__device__ __forceinline__ void st8f(LAS float* p, const float (&v)[8]) { *(LAS f32x4*)p = (f32x4){v[0], v[1], v[2], v[3]}; *(LAS f32x4*)(p + 4) = (f32x4){v[4], v[5], v[6], v[7]}; }

template <bool FINAL>
__device__ __forceinline__ void rwkv_chunk_unit(Frame& F, int layer, int u) {
    const int tid = otid(), w = __builtin_amdgcn_readfirstlane(tid >> 6);
    bf16x8 lfr[16];
#define IDS() const int ft = fresh_tid(tid); const int lane = ft & 63, r16 = lane & 15, q4 = lane >> 4, tok = ft >> 3, part = ft & 7; (void)lane; (void)r16; (void)q4; (void)tok; (void)part
    const int b = u >> 9, sc = (u >> 3) & 63, h = u & 7;
    constexpr int NV = FINAL ? 64 : 128, NVT = NV / 16, NZ = NVT / 2;
    constexpr int X_TW = 0, X_XA = 9216, X_SG = 18432, X_KF = 35840, X_RF = 52224;
    constexpr int O_AT = 0, O_RT = 9216, O_BT = 18432, O_KT = 27648, O_BH = 36864, O_KH = 46080, O_VT = 55296, O_TF = O_BT;
    constexpr int Y0 = 68608;
    constexpr int Y_A = Y0, Y_B = Y0 + 8192, Y_K = Y0 + 16384, Y_R = Y0 + 24576, Y_L = Y0 + 32768, Y_VF = Y0 + 49152;
    constexpr int Y_AAB = Y0, Y_AAK = Y0 + 17408, Y_ARB = Y_AAK + 9216, Y_ARK = Y_ARB + 9216, Y_TB = FINAL ? Y_ARK + 9216 : Y_AAK + 9216, Y_ZU = Y_TB + 9216, Y_YF = Y_AAB;
    static_assert(Y_ZU + NV * PT * 2 <= Y0 + 65536, "region Y");
    constexpr int Z0 = Y0 + 65536, Z_G = Z0, Z_S = FINAL ? Z0 + 8192 : Z0, Z_MISC = 152576, Z_BON = Z_MISC, Z_PC = Z_MISC + 256, Z_PAR = Z_MISC + 512, Z_XS = Y_ZU;
    static_assert(Z_S + NV * PT * 2 <= Z_MISC && Z_PAR + 832 * 4 <= LDSCTL_OFF, "region Z");
    LAS unsigned char* L = F.lds;
#define LB(off) ((LAS bf16*)(L + (off)))
#define LF(off) ((LAS float*)(L + (off)))
    {
        const int pidx = (w == 0) ? 5 : (w == 1) ? 7 : (w == 2) ? 9 : (w == 3) ? 10 : (w == 4) ? 11 : (w == 5) ? 12 : 13;
        if (w < 7) LF(Z_PAR)[w * 64 + (tid & 63)] = (INP(pidx) + layer * 512 + h * 64)[tid & 63];
        const float* mu = INP(3) + layer * 1792;
        for (int i = tid; i < 384; i += 512) LF(Z_PAR)[448 + i] = mu[(i < 64) ? (h * 64 + i) : (i < 128) ? (512 + h * 64 + (i - 64)) : (1536 + (i - 128))];
    }
    __syncthreads();
    const bf16* WupT = (const bf16*)(F.ws + WS_LORA + (size_t)layer * LORA_STRIDE) + h * 64 * 64;
    const bf16* AupT = (const bf16*)(F.ws + WS_LORA + (size_t)layer * LORA_STRIDE + 65536) + h * 64 * 64;
    const bf16* GupT = (const bf16*)(F.ws + WS_LORA + (size_t)layer * LORA_STRIDE + 131072) + h * 64 * 128;
    const bf16* P = (const bf16*)(F.ws + WS_BIG); const bf16* vsrc = (const bf16*)(F.ws + (layer == 0 ? WS_VF : WS_VMIX));
    float* Nbuf = (float*)(F.st + 0) + (size_t)u * 4096; bf16* MT = (bf16*)(F.ws + WS_MT) + (size_t)u * 4096;
    { IDS();
        if (w < 4) {
#pragma unroll
            for (int nt = 0; nt < 4; ++nt)
#pragma unroll
                for (int k2 = 0; k2 < 2; ++k2) { lfr[nt * 4 + k2] = *(const bf16x8*)(WupT + (size_t)(16 * nt + r16) * 64 + 32 * k2 + 8 * q4); lfr[nt * 4 + 2 + k2] = *(const bf16x8*)(AupT + (size_t)(16 * nt + r16) * 64 + 32 * k2 + 8 * q4); }
        } else if (FINAL) {
#pragma unroll
            for (int nt = 0; nt < 4; ++nt)
#pragma unroll
                for (int k4 = 0; k4 < 4; ++k4) lfr[nt * 4 + k4] = *(const bf16x8*)(GupT + (size_t)(16 * nt + r16) * 128 + 32 * k4 + 8 * q4);
        } }
    constexpr int NST = FINAL ? 2 : 4;
    f32x4 Sacc[NST];
    const int s_vb = FINAL ? (w & 3) : w;
#define S_CT(ti) (FINAL ? (2 * (w >> 2) + (ti)) : (ti))
    { IDS();
#pragma unroll
    for (int ti = 0; ti < NST; ++ti) {
        const int ct = S_CT(ti);
#pragma unroll
        for (int jj = 0; jj < 4; ++jj) { const int v = 16 * s_vb + 4 * q4 + jj, c = 16 * ct + r16;
            float x; if (FINAL) x = Nbuf[v * 64 + c]; else x = (v >= 64 && v - 64 == c) ? 1.f : 0.f;
            Sacc[ti][jj] = x; LB(Z_S)[v * PT + c] = (bf16)f2bf(x); }
    } }
    u32x4 pfc[6], pfp[6], pfv;
#define RW_PREFETCH(jn) do { IDS(); const int t_ = sc * 256 + (jn) * 64 + tok; const size_t m_ = (size_t)b * T + t_; const bf16* cur_ = P + m_ * PLD; \
        _Pragma("unroll") for (int i_ = 0; i_ < 6; ++i_) { const int col_ = (i_ == 0) ? (h * 64 + 8 * part) : (i_ == 1) ? (512 + h * 64 + 8 * part) : (i_ == 2) ? (1536 + 8 * part) : (i_ == 3) ? (1600 + 8 * part) : (1664 + 8 * part + (i_ - 4) * 64); \
            pfc[i_] = *(const u32x4*)(cur_ + col_); pfp[i_] = (t_ > 0) ? *(const u32x4*)(cur_ - PLD + col_) : (u32x4){0u, 0u, 0u, 0u}; } \
        pfv = *(const u32x4*)(vsrc + m_ * 512 + h * 64 + 8 * part); } while (0)
    RW_PREFETCH(0);
    for (int j = 0; j < 4; ++j) {
        const int tl0 = sc * 256 + j * 64;
        {
            IDS();
            const int t = tl0 + tok; const size_t m = (size_t)b * T + t; const bf16* cur = P + m * PLD;
#pragma unroll
            for (int i = 0; i < 6; ++i) {
                const int col = (i == 0) ? (h * 64 + 8 * part) : (i == 1) ? (512 + h * 64 + 8 * part) : (i == 2) ? (1536 + 8 * part) : (i == 3) ? (1600 + 8 * part) : (1664 + 8 * part + (i - 4) * 64);
                float c[8], p[8]; unpack8(pfc[i], c); unpack8(pfp[i], p); (void)col;
#pragma unroll
                for (int e = 0; e < 8; ++e) c[e] = c[e] + (p[e] - c[e]) * LF(Z_PAR)[448 + ((i < 4) ? 64 * i : 256 + 64 * (i - 4)) + 8 * part + e];
                if (i == 0) { st8f(LF(X_RF) + tok * 64 + 8 * part, c);
                } else if (i == 1) { st8f(LF(X_KF) + tok * 64 + 8 * part, c);
                } else if (i == 2) {
#pragma unroll
                    for (int e = 0; e < 8; ++e) c[e] = fast_tanh(c[e]);
                    *(LAS u32x4*)(LB(X_TW) + tok * PT + 8 * part) = pack8(c);
                } else if (i == 3) {
                    *(LAS u32x4*)(LB(X_XA) + tok * PT + 8 * part) = pack8(c);
                } else if (FINAL) {
#pragma unroll
                    for (int e = 0; e < 8; ++e) c[e] = sigm(c[e]);
                    *(LAS u32x4*)(LB(X_SG) + tok * PT2 + 8 * part + (i - 4) * 64) = pack8(c);
                }
            }
            float v[8]; unpack8(pfv, v); (void)m; (void)cur;
            st8f(LF(Y_VF) + tok * 64 + 8 * part, v);
        }
        if (j < 3) RW_PREFETCH(j + 1);
        __syncthreads();
        { IDS();
        if (w < 4) {
            const int rb = w;
            float inv[4], bs[4] = {0.f, 0.f, 0.f, 0.f};
            { float ss[4] = {0.f, 0.f, 0.f, 0.f};
#pragma unroll
                for (int nt = 0; nt < 4; ++nt) { const int c = 16 * nt + r16; const float kkc = LF(Z_PAR)[128 + c];
#pragma unroll
                    for (int jj = 0; jj < 4; ++jj) { const float kk = LF(X_KF)[(16 * rb + 4 * q4 + jj) * 64 + c] * kkc; ss[jj] += kk * kk; } }
#pragma unroll
                for (int jj = 0; jj < 4; ++jj) inv[jj] = __builtin_amdgcn_rsqf(fmaxf(redl16(ss[jj]), 1e-24f)); }
#pragma unroll
            for (int nt = 0; nt < 4; ++nt) {
                f32x4 aw = FZ4, aa = FZ4;
#pragma unroll
                for (int k2 = 0; k2 < 2; ++k2) { aw = mfma16(*(const LAS bf16x8*)(LB(X_TW) + (16 * rb + r16) * PT + 32 * k2 + 8 * q4), lfr[nt * 4 + k2], aw); aa = mfma16(*(const LAS bf16x8*)(LB(X_XA) + (16 * rb + r16) * PT + 32 * k2 + 8 * q4), lfr[nt * 4 + 2 + k2], aa); }
                const int c = 16 * nt + r16; const float w0c = LF(Z_PAR)[c], a0c = LF(Z_PAR)[64 + c], kkc = LF(Z_PAR)[128 + c], kac = LF(Z_PAR)[192 + c], rkc = LF(Z_PAR)[256 + c];
#pragma unroll
                for (int jj = 0; jj < 4; ++jj) { const int t = 16 * rb + 4 * q4 + jj, o = t * 64 + c;
                    LF(Y_L)[o] = -0.8750455979f * sigm(w0c + aw[jj]);
                    const float al = sigm(a0c + aa[jj]), kraw = LF(X_KF)[o], rr = LF(X_RF)[o], kn = kraw * kkc * inv[jj];
                    const float knew = kraw * (1.f + (al - 1.f) * kac);
                    LB(Y_A)[o] = (bf16)f2bf(-kn); LB(Y_B)[o] = (bf16)f2bf(kn * al); LB(Y_K)[o] = (bf16)f2bf(knew); LB(Y_R)[o] = (bf16)f2bf(rr);
                    bs[jj] += rr * knew * rkc; } }
#pragma unroll
            for (int jj = 0; jj < 4; ++jj) { const float sm = redl16(bs[jj]); if (r16 == 0) LF(Z_BON)[16 * rb + 4 * q4 + jj] = sm; }
        } else if (FINAL) {
            const int rb = w - 4;
#pragma unroll
            for (int nt = 0; nt < 4; ++nt) { f32x4 ag = FZ4;
#pragma unroll
                for (int k4 = 0; k4 < 4; ++k4) ag = mfma16(*(const LAS bf16x8*)(LB(X_SG) + (16 * rb + r16) * PT2 + 32 * k4 + 8 * q4), lfr[nt * 4 + k4], ag);
#pragma unroll
                for (int jj = 0; jj < 4; ++jj) LB(Z_G)[(16 * rb + 4 * q4 + jj) * 64 + 16 * nt + r16] = (bf16)f2bf(ag[jj]); }
        } }
        __syncthreads();
        if (w == 0) { IDS(); float run = 0.f;
#pragma unroll 8
            for (int t = 0; t < 64; ++t) { run += LF(Y_L)[t * 64 + lane]; LF(Y_L)[t * 64 + lane] = run; }
            LF(Z_PC)[lane] = ex2(run); }
        __syncthreads();
        {
            IDS(); const int t = tok, c0 = 8 * part;
            float Lt[8], Lp[8], Le[8], av[8], bv[8], kv[8], rv[8], vv[8], at[8], rt[8], bt[8], kt[8], bh[8], kh[8];
            ld8f(LF(Y_L) + t * 64 + c0, Lt); ld8f(LF(Y_L) + 63 * 64 + c0, Le); ld8f(LF(Y_VF) + t * 64 + c0, vv);
            if (t > 0) ld8f(LF(Y_L) + (t - 1) * 64 + c0, Lp); else {
#pragma unroll
                for (int e = 0; e < 8; ++e) Lp[e] = 0.f; }
            unpack8(*(const LAS u32x4*)(LB(Y_A) + t * 64 + c0), av); unpack8(*(const LAS u32x4*)(LB(Y_B) + t * 64 + c0), bv);
            unpack8(*(const LAS u32x4*)(LB(Y_K) + t * 64 + c0), kv); unpack8(*(const LAS u32x4*)(LB(Y_R) + t * 64 + c0), rv);
#pragma unroll
            for (int e = 0; e < 8; ++e) { const float eL = ex2(Lt[e]), eLm = ex2(Lp[e]), eN = ex2(-Lt[e]), eE = ex2(Le[e] - Lt[e]);
                at[e] = av[e] * eLm; rt[e] = rv[e] * eL; bt[e] = bv[e] * eN; kt[e] = kv[e] * eN; bh[e] = bv[e] * eE; kh[e] = kv[e] * eE; }
            tr_write8(LB(O_BH), PT, c0, t, bh, part); tr_write8(LB(O_KH), PT, c0, t, kh, part); tr_write8(LB(O_VT), PT, c0, t, vv, part);
            *(LAS u32x4*)(LB(O_AT) + t * PT + c0) = pack8(at); *(LAS u32x4*)(LB(O_RT) + t * PT + c0) = pack8(rt);
            *(LAS u32x4*)(LB(O_BT) + t * PT + c0) = pack8(bt); *(LAS u32x4*)(LB(O_KT) + t * PT + c0) = pack8(kt);
        }
        __syncthreads();
        {
            IDS(); const int rb = w & 3;
#pragma unroll
            for (int ci = 0; ci < 2; ++ci) { const int ct = 2 * (w >> 2) + ci;
                f32x4 ab = FZ4, ak = FZ4, arb = FZ4, ark = FZ4;
                if (ct <= rb) { ab = mm_ll<64>(LB(O_AT), PT, 16 * rb, LB(O_BT), PT, 16 * ct, FZ4, lane); ak = mm_ll<64>(LB(O_AT), PT, 16 * rb, LB(O_KT), PT, 16 * ct, FZ4, lane);
                    if (FINAL) { arb = mm_ll<64>(LB(O_RT), PT, 16 * rb, LB(O_BT), PT, 16 * ct, FZ4, lane); ark = mm_ll<64>(LB(O_RT), PT, 16 * rb, LB(O_KT), PT, 16 * ct, FZ4, lane); } }
#pragma unroll
                for (int jj = 0; jj < 4; ++jj) { const int t = 16 * rb + 4 * q4 + jj, i = 16 * ct + r16;
                    LF(Y_AAB)[t * PF + i] = (i < t) ? ab[jj] : 0.f; LB(Y_TB)[t * PT + i] = (bf16)f2bf(((i >> 4) < (t >> 4)) ? ab[jj] : 0.f); LB(Y_AAK)[t * PT + i] = (bf16)f2bf((i < t) ? ak[jj] : 0.f);
                    if (FINAL) { LB(Y_ARB)[t * PT + i] = (bf16)f2bf((i <= t) ? arb[jj] : 0.f); LB(Y_ARK)[t * PT + i] = (bf16)f2bf((i <= t) ? ark[jj] : 0.f); } } }
        }
        __syncthreads();
        {
            IDS(); const int rb = w & 3;
            constexpr int O_DB = O_BT, O_VB = O_BT + 5120;
            if (w == 0) { const int blk = lane >> 4, col = lane & 15; float x[16];
#pragma unroll
                for (int i = 0; i < 16; ++i) x[i] = (i == col) ? 1.f : 0.f;
#pragma unroll
                for (int g3 = 0; g3 < 3; ++g3) {
                    f32x4 ar[5][4];
#pragma unroll
                    for (int ii = 0; ii < 5; ++ii) { const int i = 1 + 5 * g3 + ii;
#pragma unroll
                        for (int g4 = 0; g4 < 4; ++g4) if (4 * g4 < i) ar[ii][g4] = *(const LAS f32x4*)(LF(Y_AAB) + (16 * blk + i) * PF + 16 * blk + 4 * g4); }
                    asm volatile("" ::: "memory");
#pragma unroll
                    for (int ii = 0; ii < 5; ++ii) { const int i = 1 + 5 * g3 + ii; float sacc = 0.f;
#pragma unroll
                        for (int m2 = 0; m2 < i; ++m2) sacc += ar[ii][m2 >> 2][m2 & 3] * x[m2];
                        x[i] += sacc; }
                }
#pragma unroll
                for (int i = 0; i < 16; ++i) LB(O_DB)[(16 * blk + i) * 40 + col] = (bf16)f2bf(x[i]);
                *(LAS u32x4*)(LB(O_DB) + lane * 40 + 16) = (u32x4){0u, 0u, 0u, 0u}; *(LAS u32x4*)(LB(O_DB) + lane * 40 + 24) = (u32x4){0u, 0u, 0u, 0u}; }
            if (lane < 16) { *(LAS u32x4*)(LB(O_VB) + w * 640 + lane * 40 + 16) = (u32x4){0u, 0u, 0u, 0u}; *(LAS u32x4*)(LB(O_VB) + w * 640 + lane * 40 + 24) = (u32x4){0u, 0u, 0u, 0u}; }
#pragma unroll
            for (int ci = 0; ci < NZ; ++ci) { const int vt = (w >> 2) * NZ + ci;
                f32x4 z = mm_ll<64>(LB(O_AT), PT, 16 * rb, LB(Z_S), PT, 16 * vt, FZ4, lane);
                if (vt < 4) z = mm_ll<64, false, true>(LB(Y_AAK), PT, 16 * rb, LB(O_VT), PT, 16 * vt, z, lane);
                st4bf(LB(Y_ZU) + (16 * vt + r16) * PT + 16 * rb + 4 * q4, z); }
            __syncthreads();
            if (w < NVT) { const int vt = w; LAS bf16* vb = LB(O_VB) + w * 640; LAS bf16* zrow = LB(Y_ZU) + (16 * vt + r16) * PT;
#pragma unroll
                for (int bb = 0; bb < 4; ++bb) {
                    f32x4 acc; { const u32x2 zz = *(const LAS u32x2*)(zrow + 16 * bb + 4 * q4); acc[0] = bflo(zz.x); acc[1] = bfhi(zz.x); acc[2] = bflo(zz.y); acc[3] = bfhi(zz.y); }
                    if (bb >= 1) acc = mfma16(*(const LAS bf16x8*)(LB(Y_TB) + (16 * bb + r16) * PT + 8 * q4), *(const LAS bf16x8*)(zrow + 8 * q4), acc);
                    if (bb >= 3) acc = mfma16(*(const LAS bf16x8*)(LB(Y_TB) + (16 * bb + r16) * PT + 32 + 8 * q4), *(const LAS bf16x8*)(zrow + 32 + 8 * q4), acc);
                    st4bf(vb + r16 * 40 + 4 * q4, acc);
                    const f32x4 ub = mfma16(*(const LAS bf16x8*)(LB(O_DB) + (16 * bb + r16) * 40 + 8 * q4), *(const LAS bf16x8*)(vb + r16 * 40 + 8 * q4), FZ4);
                    st4bf(zrow + 16 * bb + 4 * q4, ub); }
            }
        }
        __syncthreads();
        {
            IDS(); f32x4 yy[2];
            if (FINAL) { const int rb = w & 3;
#pragma unroll
                for (int ci = 0; ci < 2; ++ci) { const int ct = 2 * (w >> 2) + ci;
                    f32x4 y = mm_ll<64>(LB(O_RT), PT, 16 * rb, LB(Z_S), PT, 16 * ct, FZ4, lane);
                    y = mm_ll<64>(LB(Y_ARB), PT, 16 * rb, LB(Y_ZU), PT, 16 * ct, y, lane);
                    yy[ci] = mm_ll<64, false, true>(LB(Y_ARK), PT, 16 * rb, LB(O_VT), PT, 16 * ct, y, lane); } }
#pragma unroll
            for (int ti = 0; ti < NST; ++ti) { const int ct = S_CT(ti); const float pc = LF(Z_PC)[16 * ct + r16];
                f32x4 s = Sacc[ti] * pc;
                s = mm_ll<64, false, true>(LB(Y_ZU), PT, 16 * s_vb, LB(O_BH), PT, 16 * ct, s, lane);
                if (s_vb < 4) s = mm_ll<64, true, true>(LB(O_VT), PT, 16 * s_vb, LB(O_KH), PT, 16 * ct, s, lane);
                Sacc[ti] = s; }
            __syncthreads();
#pragma unroll
            for (int ti = 0; ti < NST; ++ti) { const int ct = S_CT(ti);
#pragma unroll
                for (int jj = 0; jj < 4; ++jj) LB(Z_S)[(16 * s_vb + 4 * q4 + jj) * PT + 16 * ct + r16] = (bf16)f2bf(Sacc[ti][jj]); }
            if (FINAL) { const int rb = w & 3;
#pragma unroll
                for (int ci = 0; ci < 2; ++ci) { const int ct = 2 * (w >> 2) + ci;
#pragma unroll
                    for (int jj = 0; jj < 4; ++jj) LF(Y_YF)[(16 * rb + 4 * q4 + jj) * PF + 16 * ct + r16] = yy[ci][jj]; } }
        }
        __syncthreads();
        if (FINAL) {
            IDS();
            const int t = tok, c0 = 8 * part; const size_t m = (size_t)b * T + tl0 + t;
            float y[8], gg[8], sm = 0.f; ld8f(LF(Y_YF) + t * PF + c0, y); unpack8(*(const LAS u32x4*)(LB(Z_G) + t * 64 + c0), gg);
#pragma unroll
            for (int e = 0; e < 8; ++e) sm += y[e];
            const float mean = red8(sm) * (1.f / 64.f); float vs = 0.f;
#pragma unroll
            for (int e = 0; e < 8; ++e) { y[e] -= mean; vs += y[e] * y[e]; }
            const float rs = __builtin_amdgcn_rsqf(red8(vs) * (1.f / 64.f) + 64e-5f), bo = LF(Z_BON)[t];
#pragma unroll
            for (int e = 0; e < 8; ++e) { const int c = c0 + e; y[e] = (y[e] * rs * LF(Z_PAR)[320 + c] + LF(Z_PAR)[384 + c] + bo * tr_at(LB(O_VT), PT, c, t)) * gg[e]; }
            *(u32x4*)((bf16*)(F.ws + WS_BIG) + m * PLD + 1024 + h * 64 + c0) = pack8(y);
        }
        __syncthreads();
    }
    if (!FINAL) { IDS();
#pragma unroll
        for (int ti = 0; ti < NST; ++ti) { const int ct = S_CT(ti);
            if (s_vb < 4) {
#pragma unroll
                for (int jj = 0; jj < 4; ++jj) Nbuf[(16 * s_vb + 4 * q4 + jj) * 64 + 16 * ct + r16] = Sacc[ti][jj];
            } else { u32x2 wv; wv.x = pk2(Sacc[ti][0], Sacc[ti][1]); wv.y = pk2(Sacc[ti][2], Sacc[ti][3]);
                *(u32x2*)(MT + (16 * ct + r16) * 64 + 16 * (s_vb - 4) + 4 * q4) = wv; }
        }
    }
#undef RW_PREFETCH
#undef IDS
#undef S_CT
#undef LB
#undef LF
}

template <bool FINAL>
__device__ __forceinline__ void ret_chunk_unit(Frame& F, int u) {
    const int tid = otid(), lane = tid & 63, w = __builtin_amdgcn_readfirstlane(tid >> 6), r16 = lane & 15, q4 = lane >> 4;
    const int b = u >> 9, sc = (u >> 3) & 63, h = u & 7;
    constexpr int R_QB = 0, R_KB = 9216, R_KHT = 18432, R_VT = 27648, R_GB = 36864, R_AB = 45056, R_SB = 54272, R_YF = 63488;
    LAS unsigned char* L = F.lds;
#define LB(off) ((LAS bf16*)(L + (off)))
#define LF(off) ((LAS float*)(L + (off)))
    bf16* P = (bf16*)(F.ws + WS_BIG);
    float* Sbuf = (float*)(F.st + 16 * MiB) + (size_t)u * 4096;
    const float lg = log2f(1.f - exp2f(-5.f - (float)h));
    const float g64 = ex2(64.f * lg);
    const int db = w & 3;
    f32x4 Sacc[2];
#pragma unroll
    for (int ci = 0; ci < 2; ++ci) { const int et = 2 * (w >> 2) + ci;
#pragma unroll
        for (int jj = 0; jj < 4; ++jj) Sacc[ci][jj] = FINAL ? Sbuf[(16 * db + 4 * q4 + jj) * 64 + 16 * et + r16] : 0.f;
        if (FINAL) st4bf(LB(R_SB) + (16 * et + r16) * PT + 16 * db + 4 * q4, Sacc[ci]); }
    const int tok = tid >> 3, part = tid & 7;
    for (int j = 0; j < 4; ++j) {
        const int tl0 = sc * 256 + j * 64;
        {
            const int t = tl0 + tok; const size_t m = (size_t)b * T + t; const bf16* row = P + m * PLD + C_RET + h * 64 + 8 * part;
            float qv[8], kv[8], vv[8]; unpack8(*(const u32x4*)(row + 512), kv); unpack8(*(const u32x4*)(row + 1024), vv);
            if (FINAL) { unpack8(*(const u32x4*)row, qv); *(LAS u32x4*)(LB(R_GB) + tok * 64 + 8 * part) = *(const u32x4*)(row + 1536); }
            const float zeta = ex2((float)(63 - tok) * lg);
            if (FINAL) { *(LAS u32x4*)(LB(R_QB) + tok * PT + 8 * part) = pack8(qv); *(LAS u32x4*)(LB(R_KB) + tok * PT + 8 * part) = pack8(kv); }
            float kz[8];
#pragma unroll
            for (int e = 0; e < 8; ++e) kz[e] = kv[e] * zeta;
            tr_write8(LB(R_KHT), PT, 8 * part, tok, kz, part); tr_write8(LB(R_VT), PT, 8 * part, tok, vv, part);
        }
        __syncthreads();
        if (FINAL) { const int rb = w & 3;
#pragma unroll
            for (int ci = 0; ci < 2; ++ci) { const int ct = 2 * (w >> 2) + ci; f32x4 a = FZ4;
                if (ct <= rb) a = mm_ll<64>(LB(R_QB), PT, 16 * rb, LB(R_KB), PT, 16 * ct, FZ4, lane);
#pragma unroll
                for (int jj = 0; jj < 4; ++jj) { const int l = 16 * rb + 4 * q4 + jj, s = 16 * ct + r16; LB(R_AB)[l * PT + s] = (bf16)f2bf((s <= l) ? a[jj] * ex2((float)(l - s) * lg) : 0.f); } }
            __syncthreads();
        }
        {
            f32x4 yy[2];
            if (FINAL) { const int rb = w & 3;
#pragma unroll
                for (int ci = 0; ci < 2; ++ci) { const int et = 2 * (w >> 2) + ci;
                    const f32x4 a1 = mm_ll<64, false, true>(LB(R_AB), PT, 16 * rb, LB(R_VT), PT, 16 * et, FZ4, lane), a2 = mm_ll<64>(LB(R_QB), PT, 16 * rb, LB(R_SB), PT, 16 * et, FZ4, lane);
#pragma unroll
                    for (int jj = 0; jj < 4; ++jj) yy[ci][jj] = a1[jj] + ex2((float)(16 * rb + 4 * q4 + jj + 1) * lg) * a2[jj]; } }
#pragma unroll
            for (int ci = 0; ci < 2; ++ci) { const int et = 2 * (w >> 2) + ci; Sacc[ci] = mm_ll<64, true, true>(LB(R_KHT), PT, 16 * db, LB(R_VT), PT, 16 * et, Sacc[ci] * g64, lane); }
            __syncthreads();
            if (FINAL) { const int rb = w & 3;
#pragma unroll
                for (int ci = 0; ci < 2; ++ci) { const int et = 2 * (w >> 2) + ci; st4bf(LB(R_SB) + (16 * et + r16) * PT + 16 * db + 4 * q4, Sacc[ci]);
#pragma unroll
                    for (int jj = 0; jj < 4; ++jj) LF(R_YF)[(16 * rb + 4 * q4 + jj) * PF + 16 * et + r16] = yy[ci][jj]; } }
        }
        __syncthreads();
        if (FINAL) { const size_t m = (size_t)b * T + tl0 + tok; float y[8], g[8], ss = 0.f;
            ld8f(LF(R_YF) + tok * PF + 8 * part, y);
#pragma unroll
            for (int e = 0; e < 8; ++e) ss += y[e] * y[e];
            const float rs = __builtin_amdgcn_rsqf(red8(ss) * (1.f / 64.f) + 1e-6f);
            unpack8(*(const LAS u32x4*)(LB(R_GB) + tok * 64 + 8 * part), g);
#pragma unroll
            for (int e = 0; e < 8; ++e) y[e] = y[e] * rs * silu(g[e]);
            *(u32x4*)(P + m * PLD + C_RETG + h * 64 + 8 * part) = pack8(y);
            __syncthreads(); }
    }
    if (!FINAL) {
#pragma unroll
        for (int ci = 0; ci < 2; ++ci) { const int et = 2 * (w >> 2) + ci;
#pragma unroll
            for (int jj = 0; jj < 4; ++jj) Sbuf[(16 * db + 4 * q4 + jj) * 64 + 16 * et + r16] = Sacc[ci][jj]; }
    }
#undef LB
#undef LF
}

template <bool FINAL>
__device__ __forceinline__ void ssd_chunk_unit(Frame& F, int layer, int u) {
    const int tid = otid(), w = __builtin_amdgcn_readfirstlane(tid >> 6);
#define IDS() const int ft = fresh_tid(tid); const int lane = ft & 63, r16 = lane & 15, q4 = lane >> 4; (void)lane; (void)r16; (void)q4
    const int b = u >> 9, sc = (u >> 3) & 63, h = u & 7, g = h >> 2;
    constexpr int D_CB = 0, D_BB = 17408, D_BT = 34816, D_YF = 53248, D_XT = 70656, D_XDT = 79872, D_GM = 89088, D_SB = 98304, D_MISC = 115712;
    constexpr int D_DTS = D_MISC, D_ACS = D_MISC + 256, D_CAR = D_MISC + 512;
    LAS unsigned char* L = F.lds;
#define LB(off) ((LAS bf16*)(L + (off)))
#define LF(off) ((LAS float*)(L + (off)))
    bf16* P = (bf16*)(F.ws + WS_BIG); const float* dtb = (const float*)(F.ws + WS_DT);
    const bf16* BND = (const bf16*)(F.ws + WS_BND);
    float* Sbuf = (float*)(F.st + 32 * MiB) + (size_t)u * 8192;
    const float* cw = INP(17) + layer * 1024 * 4; const float* cbias = INP(18) + layer * 1024;
    const float dt_bias = INP(19)[layer * 8 + h], A = -expf(INP(20)[layer * 8 + h]), Dh = INP(21)[layer * 8 + h];
    const int bc_chunk = tid & 31, bc_chn = (bc_chunk < 16) ? (512 + g * 128 + bc_chunk * 8) : (768 + g * 128 + (bc_chunk - 16) * 8);
    const int x_chunk = tid & 7, x_chn = h * 64 + x_chunk * 8;
    const int pb = w & 3;
    f32x4 Sacc[4];
    { IDS();
#pragma unroll
    for (int ci = 0; ci < 4; ++ci) { const int nt = 4 * (w >> 2) + ci;
#pragma unroll
        for (int jj = 0; jj < 4; ++jj) { const float x = FINAL ? Sbuf[(16 * pb + 4 * q4 + jj) * 128 + 16 * nt + r16] : 0.f; Sacc[ci][jj] = x;
            if (FINAL) LB(D_SB)[(16 * pb + 4 * q4 + jj) * PT2 + 16 * nt + r16] = (bf16)f2bf(x); } } }
    float dstot = 0.f;
    for (int j = 0; j < 4; ++j) {
        const int tl0 = sc * 256 + j * 64; const size_t m0 = (size_t)b * T + tl0;
        if (w == 0) {
            IDS(); const float dt = softplus_acc(dtb[(m0 + lane) * 8 + h] + dt_bias); float a = A * dt;
#pragma unroll
            for (int o = 1; o < 64; o <<= 1) { const float n = __shfl_up(a, o); if (lane >= o) a += n; }
            LF(D_DTS)[lane] = dt; LF(D_ACS)[lane] = a;
        }
        {
            IDS();
#pragma unroll
            for (int it = 0; it < 4; ++it) { const int t = it * 16 + (ft >> 5); const int ta = tl0 + t;
                float acc[8]; unpack8(*(const u32x4*)(P + (m0 + t) * PLD + C_XBC + bc_chn), acc); (void)ta;
                if (bc_chunk < 16) { *(LAS u32x4*)(LB(D_BB) + t * PT2 + bc_chunk * 8) = pack8(acc); tr_write8(LB(D_BT), PT, bc_chunk * 8, t, acc, bc_chunk & 7); }
                else *(LAS u32x4*)(LB(D_CB) + t * PT2 + (bc_chunk - 16) * 8) = pack8(acc);
            }
        }
        __syncthreads();
        {
            IDS(); const int t = ft >> 3; float acc[8]; unpack8(*(const u32x4*)(P + (m0 + t) * PLD + C_XBC + x_chn), acc);
            const float sc_d = LF(D_DTS)[t] * __expf(LF(D_ACS)[63] - LF(D_ACS)[t]);
            float xs8[8], xd8[8];
#pragma unroll
            for (int e = 0; e < 8; ++e) { xs8[e] = acc[e]; xd8[e] = acc[e] * sc_d; }
            tr_write8(LB(D_XT), PT, x_chunk * 8, t, xs8, x_chunk); tr_write8(LB(D_XDT), PT, x_chunk * 8, t, xd8, x_chunk);
        }
        if (FINAL) { IDS(); const int rb = w & 3;
#pragma unroll
            for (int ci = 0; ci < 2; ++ci) { const int ct = 2 * (w >> 2) + ci; f32x4 a = FZ4;
                if (ct <= rb) a = mm_ll<128>(LB(D_CB), PT2, 16 * rb, LB(D_BB), PT2, 16 * ct, FZ4, lane);
#pragma unroll
                for (int jj = 0; jj < 4; ++jj) { const int l = 16 * rb + 4 * q4 + jj, s = 16 * ct + r16;
                    LB(D_GM)[l * PT + s] = (bf16)f2bf((s <= l) ? a[jj] * __expf(LF(D_ACS)[l] - LF(D_ACS)[s]) * LF(D_DTS)[s] : 0.f); } } }
        __syncthreads();
        {
            IDS(); f32x4 yy[2];
            if (FINAL) { const int rb = w & 3;
#pragma unroll
                for (int ci = 0; ci < 2; ++ci) { const int pt = 2 * (w >> 2) + ci;
                    const f32x4 a1 = mm_ll<64, false, true>(LB(D_GM), PT, 16 * rb, LB(D_XT), PT, 16 * pt, FZ4, lane), a2 = mm_ll<128>(LB(D_CB), PT2, 16 * rb, LB(D_SB), PT2, 16 * pt, FZ4, lane);
#pragma unroll
                    for (int jj = 0; jj < 4; ++jj) { const int l = 16 * rb + 4 * q4 + jj, p = 16 * pt + r16; yy[ci][jj] = a1[jj] + __expf(LF(D_ACS)[l]) * a2[jj] + Dh * tr_at(LB(D_XT), PT, p, l); } } }
            const float dec = expf(LF(D_ACS)[63]);
#pragma unroll
            for (int ci = 0; ci < 4; ++ci) { const int nt = 4 * (w >> 2) + ci; Sacc[ci] = mm_ll<64, true, true>(LB(D_XDT), PT, 16 * pb, LB(D_BT), PT, 16 * nt, Sacc[ci] * dec, lane); }
            dstot += LF(D_ACS)[63];
            __syncthreads();
            if (FINAL) { const int rb = w & 3;
#pragma unroll
                for (int ci = 0; ci < 4; ++ci) { const int nt = 4 * (w >> 2) + ci;
#pragma unroll
                    for (int jj = 0; jj < 4; ++jj) LB(D_SB)[(16 * pb + 4 * q4 + jj) * PT2 + 16 * nt + r16] = (bf16)f2bf(Sacc[ci][jj]); }
#pragma unroll
                for (int ci = 0; ci < 2; ++ci) { const int pt = 2 * (w >> 2) + ci;
#pragma unroll
                    for (int jj = 0; jj < 4; ++jj) LF(D_YF)[(16 * rb + 4 * q4 + jj) * PF + 16 * pt + r16] = yy[ci][jj]; } }
        }
        __syncthreads();
        if (FINAL) { IDS(); const int tok = ft >> 3, part = ft & 7; float y[8];
            ld8f(LF(D_YF) + tok * PF + 8 * part, y);
            *(u32x4*)(P + (m0 + tok) * PLD + C_XBC + h * 64 + 8 * part) = pack8(y);
            __syncthreads(); }
    }
    if (!FINAL) { IDS();
#pragma unroll
        for (int ci = 0; ci < 4; ++ci) { const int nt = 4 * (w >> 2) + ci;
#pragma unroll
            for (int jj = 0; jj < 4; ++jj) Sbuf[(16 * pb + 4 * q4 + jj) * 128 + 16 * nt + r16] = Sacc[ci][jj]; }
        if (tid == 0) ((float*)(F.ws + WS_DSTOT))[u] = dstot;
    }
#undef IDS
#undef LB
#undef LF
}

__device__ __forceinline__ void rwkv_scan_chain(Frame& F, int chain) {
    const int tid = otid(), lane = tid & 63, w = __builtin_amdgcn_readfirstlane(tid >> 6), r16 = lane & 15, q4 = lane >> 4;
    const int b = chain >> 3, h = chain & 7, vb = w & 3, ct0 = 2 * (w >> 2);
    LAS bf16* SB = (LAS bf16*)F.lds;
    f32x4 Sacc[2] = {FZ4, FZ4};
    for (int i = tid; i < 64 * PT / 2; i += 512) ((LAS unsigned*)SB)[i] = 0u;
    f32x4 nv[2]; bf16x8 mf[2][2];
    auto fetch = [&](int sc) {
        const int u = (b * 64 + sc) * 8 + h;
        const float* Nb = (const float*)(F.st + 0) + (size_t)u * 4096; const bf16* MT = (const bf16*)(F.ws + WS_MT) + (size_t)u * 4096;
#pragma unroll
        for (int ci = 0; ci < 2; ++ci) {
#pragma unroll
            for (int jj = 0; jj < 4; ++jj) nv[ci][jj] = Nb[(16 * vb + 4 * q4 + jj) * 64 + 16 * (ct0 + ci) + r16];
#pragma unroll
            for (int k2 = 0; k2 < 2; ++k2) mf[ci][k2] = *(const bf16x8*)(MT + (size_t)(16 * (ct0 + ci) + r16) * 64 + 32 * k2 + 8 * q4); } };
    fetch(0);
    __syncthreads();
    for (int sc = 0; sc < 64; ++sc) {
        const int u = (b * 64 + sc) * 8 + h;
        float* Nb = (float*)(F.st + 0) + (size_t)u * 4096;
        f32x4 nw[2];
#pragma unroll
        for (int ci = 0; ci < 2; ++ci) {
            f32x4 a = nv[ci];
#pragma unroll
            for (int k2 = 0; k2 < 2; ++k2) a = mfma16(*(const LAS bf16x8*)(SB + (16 * vb + r16) * PT + 32 * k2 + 8 * q4), mf[ci][k2], a);
            nw[ci] = a;
#pragma unroll
            for (int jj = 0; jj < 4; ++jj) Nb[(16 * vb + 4 * q4 + jj) * 64 + 16 * (ct0 + ci) + r16] = Sacc[ci][jj]; }
        if (sc + 1 < 64) fetch(sc + 1);
        __syncthreads();
#pragma unroll
        for (int ci = 0; ci < 2; ++ci) { Sacc[ci] = nw[ci];
#pragma unroll
            for (int jj = 0; jj < 4; ++jj) SB[(16 * vb + 4 * q4 + jj) * PT + 16 * (ct0 + ci) + r16] = (bf16)f2bf(nw[ci][jj]); }
        __syncthreads();
    }
}
__device__ __forceinline__ void elem_scans(Frame& F, int blk, int nblk) {
    const int tid = otid();
    const int NRET = 16 * 4096, NSSD = 16 * 8192;
    const float* dst = (const float*)(F.ws + WS_DSTOT);
    for (int it = blk * 512 + tid; it < NRET + NSSD; it += nblk * 512) {
        if (it < NRET) { const int chain = it >> 12, e = it & 4095, b = chain >> 3, h = chain & 7;
            const float g256 = exp2f(256.f * log2f(1.f - exp2f(-5.f - (float)h)));
            float* p = (float*)(F.st + 16 * MiB) + ((size_t)(b * 64) * 8 + h) * 4096 + e; float carry = 0.f;
#pragma unroll 8
            for (int sc = 0; sc < 64; ++sc) { const float t = p[(size_t)sc * 8 * 4096]; p[(size_t)sc * 8 * 4096] = carry; carry = g256 * carry + t; }
        } else { const int i2 = it - NRET, chain = i2 >> 13, e = i2 & 8191, b = chain >> 3, h = chain & 7;
            float* p = (float*)(F.st + 32 * MiB) + ((size_t)(b * 64) * 8 + h) * 8192 + e; const float* d = dst + (b * 64) * 8 + h; float carry = 0.f;
#pragma unroll 8
            for (int sc = 0; sc < 64; ++sc) { const float t = p[(size_t)sc * 8 * 8192]; p[(size_t)sc * 8 * 8192] = carry; carry = expf(d[sc * 8]) * carry + t; }
        }
    }
}
__device__ __forceinline__ void conv_lora(Frame& F) {
    const int tid = otid();
    for (int l = 0; l < 2; ++l) {
        bf16* base = (bf16*)(F.ws + WS_LORA + (size_t)l * LORA_STRIDE);
        const float* wu = INP(4) + l * 64 * 512; const float* au = INP(6) + l * 64 * 512; const float* gu = INP(8) + l * 128 * 512;
        for (int i = F.vcu * 512 + tid; i < 512 * 64; i += F.G * 512) { const int c = i >> 6, jx = i & 63; base[i] = (bf16)f2bf(wu[jx * 512 + c]); base[32768 + i] = (bf16)f2bf(au[jx * 512 + c]); }
        for (int i = F.vcu * 512 + tid; i < 512 * 128; i += F.G * 512) { const int c = i >> 7, jx = i & 127; base[65536 + i] = (bf16)f2bf(gu[jx * 512 + c]); }
    }
}
__device__ __forceinline__ void conv_vlora(Frame& F) {
    const int tid = otid();
    bf16* vdT = (bf16*)(F.ws + WS_VLORA); bf16* vuT = vdT + 32 * 512;
    const float* vdn = INP(14); const float* vup = INP(15);
    for (int i = F.vcu * 512 + tid; i < 32 * 512; i += F.G * 512) { const int j = i >> 9, c = i & 511; vdT[i] = (bf16)f2bf(vdn[c * 32 + j]); }
    for (int i = F.vcu * 512 + tid; i < 512 * 32; i += F.G * 512) { const int c = i >> 5, j = i & 31; vuT[i] = (bf16)f2bf(vup[j * 512 + c]); }
}
__device__ __forceinline__ void save_bnd(Frame& F) {
    const int tid = otid();
    const bf16* P = (const bf16*)(F.ws + WS_BIG); bf16* BND = (bf16*)(F.ws + WS_BND);
    for (int i = F.vcu * 512 + tid; i < 2 * 64 * 3 * 64; i += F.G * 512) { const int ch = i & 63, k = (i >> 6) % 3, bs = i / 192, b = bs >> 6, sc = bs & 63;
        if (sc > 0) *(u32x4*)(BND + (size_t)(bs * 3 + k) * 512 + ch * 8) = *(const u32x4*)(P + ((size_t)b * T + sc * 256 - 3 + k) * PLD + C_XBC + ch * 8); }
}

__device__ __forceinline__ void stagger(int cid) { const int dly = __builtin_amdgcn_readfirstlane((cid >> 3) & 7); for (int i = 0; i < dly; ++i) __builtin_amdgcn_s_sleep(16); }
constexpr int LAYER_BASE0 = 1, LAYER_STRIDE = 18, MOE_BASE = LAYER_BASE0 + LAYER_STRIDE + 15;
__device__ __forceinline__ Frame lf(const Frame& F0) {
    Frame F = F0; unsigned l = (unsigned)(unsigned long long)F.lds;
    asm volatile("" : "+s"(l), "+s"(F.vcu), "+s"(F.G), "+s"(F.cid), "+s"(F.wid), "+s"(F.out), "+s"(F.ws), "+s"(F.st));
    F.lds = (LAS unsigned char*)(unsigned long long)l; return F;
}
__global__ void __launch_bounds__(512, 2) fwd(Args args) {
    extern __shared__ __attribute__((aligned(16))) unsigned char lds_raw[];
    Frame F0;
    F0.lds = (LAS unsigned char*)lds_raw;
    F0.G = gridDim.x; { const int bx = blockIdx.x; F0.vcu = (F0.G % 8 == 0) ? (bx % 8) * (F0.G / 8) + bx / 8 : bx; }
    F0.cid = blockIdx.x; F0.out = args.out; F0.ws = args.ws; F0.wid = __builtin_amdgcn_readfirstlane(threadIdx.x >> 6); F0.st = args.ws + WS_XB;
    volatile LAS unsigned* MISC = (volatile LAS unsigned*)(F0.lds + MISC_OFF);
    for (int u = threadIdx.x; u < (LDS_BYTES - LDSCTL_OFF) / 4; u += 512) ((LAS unsigned*)(F0.lds + LDSCTL_OFF))[u] = 0u;
    __syncthreads();
    if (threadIdx.x < 34) *(LAS unsigned long long*)(F0.lds + LDSCTL_OFF + 8 * threadIdx.x) = (unsigned long long)args.in[threadIdx.x];
    __syncthreads();
    const int lo = args.ph_lo, hi = args.ph_hi;
    XcdBarrier bar; bar.bar = (unsigned*)(F0.ws + WS_CTL); bar.x = 0; bar.st = nullptr;
    if (hi - lo > 1) bar = xcd_barrier_post((unsigned*)(F0.ws + WS_CTL), MISC + 8);
#define IN(k) (lo <= (k) && (k) < hi)
#define SEAM(k) do { if (IN(k) && IN((k) + 1)) xcd_barrier(bar); } while (0)
#define WSP(T_, off) ((T_*)(F.ws + (off)))

    if (IN(0)) { Frame F = lf(F0); conv_layer_weights(F, 0, 0); conv_lora(F); conv_vlora(F); xprep_phase(F, INP(0)); }
    SEAM(0);
    for (int l = 0; l < 2; ++l) {
        const int pb = LAYER_BASE0 + l * LAYER_STRIDE;
        F0.st = (unsigned char*)F0.out;
        if (IN(pb + 0)) {
            Frame F = lf(F0); unsigned char* wl = F.ws + WS_W + (size_t)l * WL_STRIDE;
            pg8::Gemm g{WSP(bf16, WS_XB), (const bf16*)(wl + WL_IN), D, D, D}; pg8::StaticOrder S; S.init(M, NP, F.G, F.cid, D, D);
            pg8::EpiInProj E{WSP(bf16, WS_BIG), (l == 0) ? WSP(float, WS_RSTD) : WSP(float, WS_SS1), WSP(float, WS_DT), l};
            stagger(F.cid); pg8::gemm_phase(F.lds, F.wid, g, S, E);
        }
        SEAM(pb + 0);
        if (IN(pb + 1)) { Frame F = lf(F0); vprep_phase(F, l); prepass_a(F); }
        SEAM(pb + 1);
        if (IN(pb + 2)) { Frame F = lf(F0); prepass_conv(F, l); }
        if (IN(pb + 2) && IN(pb + 3)) xcd_barrier(bar);
        if (IN(pb + 3)) for (int rep = 0; rep <= REP_R1; ++rep) {
#if RW_CH
            for (int r2 = 0; r2 <= REP_RW; ++r2) { Frame F = lf(F0); for (int u = F.cid; u < 1024; u += F.G) rwkv_chunk_unit<false>(F, l, u); }
#else
            { Frame F = lf(F0); if (F.cid < 16) rwkv_seq(F, l, F.cid); }
#endif
#if RET_CH
            for (int r2 = 0; r2 <= REP_RET; ++r2) { Frame F = lf(F0); for (int u = F.cid; u < 1024; u += F.G) ret_chunk_unit<false>(F, u); }
#else
            { Frame F = lf(F0); if (F.cid >= 32 && F.cid < 48) ret_seq(F, F.cid - 32); }
#endif
#if SSD_CH
            for (int r2 = 0; r2 <= REP_SSD; ++r2) { Frame F = lf(F0); for (int u = F.cid; u < 1024; u += F.G) ssd_chunk_unit<false>(F, l, u); }
#else
            { Frame F = lf(F0); if (F.cid >= 16 && F.cid < 32) ssd_seq(F, l, F.cid - 16); }
#endif
        }
        SEAM(pb + 3);
        if (IN(pb + 4)) {
            Frame F = lf(F0);
            if (F.cid < 16) { if (RW_CH) rwkv_scan_chain(F, F.cid); }
            else elem_scans(F, F.cid - 16, F.G - 16);
            if (l == 0 && F.cid >= 16) { Frame Fc = lf(F0); Fc.vcu = Fc.cid - 16; Fc.G = Fc.G - 16;
                conv_layer_weights(Fc, 0, 1); conv_layer_weights(Fc, 1, 0); conv_layer_weights(Fc, 1, 1); conv_ffn_weights(Fc); }
        }
        SEAM(pb + 4);
        if (IN(pb + 5)) {
#if RW_CH
            { Frame F = lf(F0); for (int u = F.cid; u < 1024; u += F.G) rwkv_chunk_unit<true>(F, l, u); }
#endif
#if RET_CH
            { Frame F = lf(F0); for (int u = F.cid; u < 1024; u += F.G) ret_chunk_unit<true>(F, u); }
#endif
#if SSD_CH
            { Frame F = lf(F0); for (int u = F.cid; u < 1024; u += F.G) ssd_chunk_unit<true>(F, l, u); }
#endif
        }
        SEAM(pb + 5);
        if (IN(pb + 6)) { Frame F = lf(F0); ssm_norm_phase(F, l); }
        SEAM(pb + 6);
        if (IN(pb + 7)) {
            Frame F = lf(F0); unsigned char* wl = F.ws + WS_W + (size_t)l * WL_STRIDE; bf16* P = WSP(bf16, WS_BIG);
            pg8::Gemm g{P, (const bf16*)(wl + WL_BR), PLD, 512, 512}; pg8::BranchOrder S; S.init(F.G, F.cid);
            pg8::EpiPlain E{P, WSP(bf16, WS_VMIX)};
            stagger(F.cid); pg8::gemm_phase(F.lds, F.wid, g, S, E);
        }
        SEAM(pb + 7);
        if (IN(pb + 8)) {
            Frame F = lf(F0); unsigned char* wl = F.ws + WS_W + (size_t)l * WL_STRIDE; bf16* P = WSP(bf16, WS_BIG);
            pg8::Gemm g{WSP(bf16, WS_XB), (const bf16*)(wl + WL_GATE), D, D, D}; pg8::GateOrder S; S.init(F.G, F.cid);
            pg8::EpiGateMerge E{P, WSP(const bf16, WS_VMIX), P + C_RET, PLD, (l == 0) ? WSP(float, WS_RSTD) : WSP(float, WS_SS1), l};
            stagger(F.cid); pg8::gemm_phase(F.lds, F.wid, g, S, E);
        }
        if (IN(pb + 8) && IN(pb + 13)) xcd_barrier(bar);
        if (IN(pb + 13)) {
            Frame F = lf(F0); unsigned char* wl = F.ws + WS_W + (size_t)l * WL_STRIDE; bf16* P = WSP(bf16, WS_BIG);
            pg8::Gemm g{P + C_RET, (const bf16*)(wl + WL_OUT), PLD, D, D}; pg8::StaticOrder S; S.init(M, D, F.G, F.cid, PLD, D);
            pg8::EpiResidB E{WSP(bf16, WS_XB), (l == 0) ? WSP(float, WS_SS2) : nullptr, (l == 0) ? nullptr : F.out};
            stagger(F.cid); pg8::gemm_phase(F.lds, F.wid, g, S, E);
        }
        SEAM(pb + 13);
        if (IN(pb + 14)) { Frame F = lf(F0); if (l == 1) { router_phase(F); conv_moe_weights(F); } }
        if (l == 1) SEAM(pb + 14);
        if (l == 0) {
            if (IN(pb + 15)) {
                Frame F = lf(F0);
                pg8::Gemm g{WSP(bf16, WS_XB), WSP(const bf16, WS_FFUP), D, D, D}; pg8::StaticOrder S; S.init(M, 2 * FF, F.G, F.cid, D, D);
                pg8::EpiSwiglu E{WSP(bf16, WS_ACT), FF, WSP(float, WS_SS2), 1};
                stagger(F.cid); pg8::gemm_phase(F.lds, F.wid, g, S, E);
            }
            SEAM(pb + 15);
            if (IN(pb + 16)) {
                Frame F = lf(F0);
                pg8::Gemm g{WSP(const bf16, WS_ACT), WSP(const bf16, WS_FFDN), FF, FF, FF}; pg8::StaticOrder S; S.init(M, D, F.G, F.cid, FF, FF);
                pg8::EpiResidB E{WSP(bf16, WS_XB), WSP(float, WS_SS1), nullptr};
                stagger(F.cid); pg8::gemm_phase(F.lds, F.wid, g, S, E);
            }
            if (IN(pb + 16) && IN(pb + 18)) xcd_barrier(bar);
        }
    }
    {
        const int pb = MOE_BASE;
        for (int st = 0; st < 6; ++st) {
            const int isup = (st == 0 || st == 2 || st == 3), sg = (st < 2) ? 0 : ((st == 2 || st == 4) ? 1 : 2);
            if (IN(pb + st)) {
                if (isup) {
                    Frame F = lf(F0);
                    pg8::Gemm g{WSP(bf16, WS_XB), WSP(const bf16, WS_MOEW), D, D, D}; pg8::MoeOrder<true> S; S.init(WSP(const int, WS_CNT), WSP(const int, WS_LIST), sg, 2 * FFE, F.G, F.cid, D, D, MOEW_STRIDE);
                    pg8::EpiSwiglu E{(sg == 2) ? WSP(bf16, WS_ACT2) : WSP(bf16, WS_ACT), FFE, WSP(float, WS_RSTD), 0};
                    stagger(F.cid); pg8::gemm_phase(F.lds, F.wid, g, S, E);
                } else {
                    Frame F = lf(F0);
                    const int ksp = (sg == 2) ? 4 : 1;
                    pg8::Gemm g{(sg == 2) ? WSP(const bf16, WS_ACT2) : WSP(const bf16, WS_ACT), WSP(const bf16, WS_MOEW + MOEW_DN), FFE, FFE, FFE / ksp}; pg8::MoeOrder<false> S; S.init(WSP(const int, WS_CNT), WSP(const int, WS_LIST), sg, D, F.G, F.cid, FFE, FFE, MOEW_STRIDE, ksp, FFE / ksp);
                    pg8::EpiMoeOut E{(sg == 0) ? WSP(bf16, WS_YP0) : (sg == 1 ? WSP(bf16, WS_YP1) : WSP(bf16, WS_YP2)), YP2_STRIDE / 2};
                    stagger(F.cid); pg8::gemm_phase(F.lds, F.wid, g, S, E);
                }
            }
            SEAM(pb + st);
        }
        if (IN(pb + 6)) { Frame F = lf(F0); final_norm_phase(F); }
    }
#undef IN
#undef SEAM
#undef WSP
}
constexpr int LAST_PHASE = MOE_BASE + 6;
constexpr int N_PH = LAST_PHASE + 1;

extern "C" void kernel_launch(void* const* d_in, const int* in_sizes, int n_in, void* d_out, int out_size, void* d_ws, size_t ws_size, hipStream_t stream) {
    static int grid = 0;
    if (grid == 0) {
        if (n_in != 34 || out_size != M * D || ws_size < WS_END) { fprintf(stderr, "kernel_launch: unexpected problem (n_in %d out %d ws %zu need %zu)\n", n_in, out_size, ws_size, (size_t)WS_END); grid = -1; return; }
        int dev = 0, cus = 0;
        if (hipGetDevice(&dev) != hipSuccess || hipDeviceGetAttribute(&cus, hipDeviceAttributeMultiprocessorCount, dev) != hipSuccess) { grid = -1; return; }
        if (hipFuncSetAttribute((const void*)fwd, hipFuncAttributeMaxDynamicSharedMemorySize, LDS_BYTES) != hipSuccess) { fprintf(stderr, "kernel_launch: hipFuncSetAttribute failed\n"); grid = -1; return; }
        int per_cu = 0;
        if (hipOccupancyMaxActiveBlocksPerMultiprocessor(&per_cu, (const void*)fwd, 512, LDS_BYTES) != hipSuccess || per_cu < 1) fprintf(stderr, "kernel_launch: occupancy query says %d\n", per_cu);
        (void)hipGetLastError();
        grid = cus;
    }
    if (grid < 0) return;
    (void)hipMemsetAsync((char*)d_ws + WS_CTL, 0, CTL_ZERO_BYTES, stream);
    Args a{};
    for (int i = 0; i < 34; ++i) a.in[i] = (const float*)d_in[i];
    a.out = (float*)d_out; a.ws = (unsigned char*)d_ws;
#if MK_ONE_LAUNCH
    a.ph_lo = 0; a.ph_hi = N_PH;
    hipLaunchKernelGGL(fwd, dim3(grid), dim3(512), LDS_BYTES, stream, a);
#else
    for (int p = 0; p < N_PH; ++p) { a.ph_lo = p; a.ph_hi = p + 1; hipLaunchKernelGGL(fwd, dim3(grid), dim3(512), LDS_BYTES, stream, a); }
#endif
}
```

```cpp
#include <hip/hip_runtime.h>
#include <cstdio>
#include <cstdint>

#ifndef MK_ONE_LAUNCH
#define MK_ONE_LAUNCH 1
#endif

#define LAS __attribute__((address_space(3)))
#define GAS __attribute__((address_space(1)))
typedef unsigned short bf16;
typedef short bf16x8 __attribute__((ext_vector_type(8)));
typedef float f32x4 __attribute__((ext_vector_type(4)));
typedef float f32x2 __attribute__((ext_vector_type(2)));
typedef unsigned u32x4 __attribute__((ext_vector_type(4)));
typedef unsigned u32x2 __attribute__((ext_vector_type(2)));

constexpr int BATCH = 2, T = 16384, D = 1024, M = BATCH * T;
constexpr int INC = 8456;
constexpr int PLD = 5376;
constexpr int NP = 5632;
constexpr int C_RW = 0, C_Z = 1792, C_XBC = 2304, C_RET = 3328, C_RETG = 4864;
constexpr int FF = 2816, FFE = 3584, NE = 8;

constexpr size_t MiB = 1u << 20;
constexpr size_t WS_CTL = 0, CTL_ZERO_BYTES = 64 * 1024;
constexpr size_t WS_RSTD = 1 * MiB, WS_GATES = 2 * MiB, WS_DT = 3 * MiB;
constexpr size_t WS_W = 4 * MiB;
constexpr size_t WL_IN = 0, WL_GATE = 11 * MiB, WL_BR = 17 * MiB, WL_OUT = 20 * MiB, WL_STRIDE = 22 * MiB;
constexpr size_t WS_FFUP = WS_W + 44 * MiB, WS_FFDN = WS_W + 55 * MiB;
constexpr size_t WS_XB = 68 * MiB;
constexpr size_t WS_VF = 132 * MiB;
constexpr size_t WS_BIG = 164 * MiB;
constexpr size_t WS_VMIX = WS_BIG + 336 * MiB, WS_YRW = WS_BIG + 368 * MiB, WS_END = 577 * MiB;
constexpr size_t WS_MOEW = WS_BIG;
constexpr size_t MOEW_STRIDE = 21 * MiB / 2, MOEW_DN = 7 * MiB;
constexpr size_t WS_X8 = WS_BIG + 88 * MiB;
constexpr int MOE_KSP = 2;
constexpr size_t WS_ACT = WS_BIG + 168 * MiB;

constexpr size_t WS_YP0 = 4 * MiB, WS_YP1 = WS_XB, WS_YP2 = 556 * MiB, YP2_STRIDE = 4 * MiB, WS_PINFO = 572 * MiB, WS_ACT2 = 132 * MiB;
constexpr size_t WS_CNT = 32768, WS_LIST = 2 * MiB;
constexpr size_t WS_BND2 = 566 * MiB;
constexpr size_t WS_VLORA = 192 * 1024;
constexpr size_t WS_SS1 = 573 * MiB, WS_SS2 = 575 * MiB;
constexpr size_t WS_DSTOT = 128 * 1024, WS_BND = 256 * 1024;
constexpr size_t WS_LORA = 1 * MiB + 512 * 1024, LORA_STRIDE = 262144;
constexpr size_t WS_ST_RW = WS_XB, WS_ST_RET = WS_XB + 16 * MiB, WS_ST_SSD = WS_XB + 32 * MiB, WS_MT = WS_YRW;
constexpr int RING_BYTES = 131072, LDSCTL_OFF = 159744, MISC_OFF = LDSCTL_OFF + 320, LDS_BYTES = 163840;
#ifndef REP_CONV
#define REP_CONV 0
#endif
#ifndef REP_R1
#define REP_R1 0
#endif
#ifndef REP_RW
#define REP_RW 0
#endif
#ifndef REP_RET
#define REP_RET 0
#endif
#ifndef REP_SSD
#define REP_SSD 0
#endif
#ifndef REP_MISC
#define REP_MISC 0
#endif
#ifndef RW_CH
#define RW_CH 1
#endif
#ifndef RET_CH
#define RET_CH 1
#endif
#ifndef SSD_CH
#define SSD_CH 1
#endif

typedef __bf16 hbf16x2 __attribute__((ext_vector_type(2)));
__device__ __forceinline__ unsigned pk2(float lo, float hi) { const f32x2 v = {lo, hi}; return __builtin_bit_cast(unsigned, __builtin_convertvector(v, hbf16x2)); }
__device__ __forceinline__ unsigned f2bf(float f) { return (unsigned)__builtin_bit_cast(unsigned short, (__bf16)f); }
__device__ __forceinline__ float bflo(unsigned u) { return __builtin_bit_cast(float, u << 16); }
__device__ __forceinline__ float bfhi(unsigned u) { return __builtin_bit_cast(float, u & 0xffff0000u); }
__device__ __forceinline__ void unpack8(const u32x4 u, float (&f)[8]) { f[0] = bflo(u.x); f[1] = bfhi(u.x); f[2] = bflo(u.y); f[3] = bfhi(u.y); f[4] = bflo(u.z); f[5] = bfhi(u.z); f[6] = bflo(u.w); f[7] = bfhi(u.w); }
__device__ __forceinline__ unsigned pk4f8(float a, float b, float c, float d) {
    a = __builtin_amdgcn_fmed3f(a, -448.f, 448.f); b = __builtin_amdgcn_fmed3f(b, -448.f, 448.f); c = __builtin_amdgcn_fmed3f(c, -448.f, 448.f); d = __builtin_amdgcn_fmed3f(d, -448.f, 448.f);
    int w = __builtin_amdgcn_cvt_pk_fp8_f32(a, b, 0, false); w = __builtin_amdgcn_cvt_pk_fp8_f32(c, d, w, true); return (unsigned)w; }
__device__ __forceinline__ u32x4 pack8(const float (&f)[8]) { u32x4 w; w.x = pk2(f[0], f[1]); w.y = pk2(f[2], f[3]); w.z = pk2(f[4], f[5]); w.w = pk2(f[6], f[7]); return w; }
__device__ __forceinline__ float sigm(float x) { return __builtin_amdgcn_rcpf(1.f + __expf(-x)); }
__device__ __forceinline__ float silu(float x) { return x * __builtin_amdgcn_rcpf(1.f + __expf(-x)); }
__device__ __forceinline__ float ex2(float x) { return __builtin_amdgcn_exp2f(x); }
__device__ __forceinline__ float fast_tanh(float x) { return 1.f - 2.f * __builtin_amdgcn_rcpf(1.f + __expf(2.f * x)); }
__device__ __forceinline__ float softplus_acc(float x) { return fmaxf(x, 0.f) + log1pf(expf(-fabsf(x))); }
__device__ __forceinline__ float wave_sum(float v) {
#pragma unroll
    for (int o = 1; o < 64; o <<= 1) v += __shfl_xor(v, o);
    return v;
}
__device__ __forceinline__ int otid_w(int wid) { unsigned z = 0u; asm volatile("" : "+v"(z)); int t = wid * 64 + (int)__builtin_amdgcn_mbcnt_hi(~0u, __builtin_amdgcn_mbcnt_lo(~0u, z)); asm volatile("" : "+v"(t)); return t; }
#define otid() otid_w(F.wid)
__device__ __forceinline__ int fresh_tid(int t) { asm volatile("" : "+v"(t)); return t; }
#define LDS_WAIT() asm volatile("s_waitcnt lgkmcnt(0)" ::: "memory")

namespace pg8 {
constexpr int BM = 256, BK = 64, HALF = 128, HTB = HALF * BK * 2, STAGE_BYTES = 8 * HTB, NXCD = 8, WGM = 8;
__host__ __device__ __forceinline__ int lds_byte(int r, int c) { const int st = (r >> 4) * 2 + (c >> 5), rr = r & 15, cc = c & 31, ob = rr * 64 + cc * 2; return st * 1024 + (ob ^ (((ob >> 9) & 1) << 5)); }
__host__ __device__ __forceinline__ void stage_rc(int b, int& R, int& C) { const int st = b / 1024, sb = b % 1024, swz = sb ^ (((sb >> 9) & 1) << 5); R = (st >> 1) * 16 + swz / 64; C = (st & 1) * 32 + (swz % 64) / 2; }
__host__ __device__ __forceinline__ int perm32(int rho) { const int n = rho >> 4, i = rho & 15; return 8 * (i >> 2) + 4 * n + (i & 3); }

typedef int i32x4v __attribute__((ext_vector_type(4)));
struct Unit { int pm, pn; size_t aofs, bofs; const int* rows; int nvalid, e, ks; };
struct Gemm { const bf16* A; const bf16* Bt; int lda, ldb, K; };

struct StaticOrder {
    static constexpr bool GATHER = false;
    int nM, nN, nwg, G, c; size_t tsA, tsB;
    __device__ __forceinline__ void init(int Mrows, int N, int G_, int c_, int lda, int ldb) { nM = Mrows / BM; nN = N / BM; nwg = nM * nN; G = G_; c = c_; tsA = (size_t)BM * lda * 2; tsB = (size_t)BM * ldb * 2; }
    __device__ __forceinline__ void tile(int L, int& pm, int& pn) const {
        int wgid = L; { const int q = nwg / NXCD, r = nwg % NXCD, xcd = wgid % NXCD, off = wgid / NXCD; wgid = (xcd < r ? xcd * (q + 1) : r * (q + 1) + (xcd - r) * q) + off; }
        const int nig = WGM * nN, gid = wgid / nig, fm = gid * WGM, gsz = (nM - fm) < WGM ? (nM - fm) : WGM;
        pm = fm + ((wgid % nig) % gsz); pn = (wgid % nig) / gsz;
    }
    __device__ __forceinline__ bool next(int i, Unit& u) const {
        const long L = (long)i * G + c; if (L >= nwg) return false;
        tile((int)L, u.pm, u.pn); u.aofs = (size_t)u.pm * tsA; u.bofs = (size_t)u.pn * tsB; u.rows = nullptr; u.nvalid = BM; u.e = 0; u.ks = 0; return true;
    }
};
struct BranchOrder {
    static constexpr bool GATHER = false;
    StaticOrder so;
    __device__ __forceinline__ void init(int G_, int c_) { so.init(M, D, G_, c_, PLD, 512); }
    __device__ __forceinline__ bool next(int j, Unit& u) const {
        const long L = (long)j * so.G + so.c; if (L >= 3 * so.nwg) return false;
        const int i = (int)(L / so.nwg); so.tile((int)(L % so.nwg), u.pm, u.pn);
        const int acol = (i == 0) ? 1024 : (i == 1 ? C_Z : C_RETG);
        u.aofs = (size_t)u.pm * so.tsA + (size_t)acol * 2; u.bofs = ((size_t)i * D + (size_t)u.pn * BM) * 512 * 2; u.rows = nullptr; u.nvalid = BM; u.e = i; u.ks = 0; return true;
    }
};
struct GateOrder {
    static constexpr bool GATHER = false;
    StaticOrder so;
    __device__ __forceinline__ void init(int G_, int c_) { so.init(M, D, G_, c_, D, D); }
    __device__ __forceinline__ bool next(int j, Unit& u) const {
        const long tt = (long)(j / 3) * so.G + so.c; if (tt >= so.nwg) return false;
        const int i = j % 3; so.tile((int)tt, u.pm, u.pn);
        u.aofs = (size_t)u.pm * so.tsA; u.bofs = ((size_t)i * D + (size_t)u.pn * BM) * D * 2; u.rows = nullptr; u.nvalid = BM; u.e = i; u.ks = 0; return true;
    }
};
template <bool GATH> struct MoeOrder {
    static constexpr bool GATHER = GATH;
    unsigned q0, q1, q2, q3;
    int seg, nN, G, c, ksplit; const int* list; size_t bstride, tsB, tsA, kbytes;
    __device__ __forceinline__ void init(const int* counts, const int* list_, int seg_, int N, int G_, int c_, int lda, int ldb, size_t bstride_, int ksplit_ = 1, int kpart = 0) {
        unsigned n[8];
#pragma unroll
        for (int e = 0; e < 8; ++e) { int v = __builtin_amdgcn_readfirstlane(counts[e]); v = v < 0 ? 0 : (v > 32768 ? 32768 : v); n[e] = (unsigned)v; }
        q0 = n[0] | (n[1] << 16); q1 = n[2] | (n[3] << 16); q2 = n[4] | (n[5] << 16); q3 = n[6] | (n[7] << 16);
        seg = seg_; nN = N / BM; G = G_; c = c_; list = list_; bstride = bstride_; tsB = (size_t)BM * ldb * 2; tsA = (size_t)BM * lda * 2; ksplit = ksplit_; kbytes = (size_t)kpart * 2;
    }
    __device__ __forceinline__ bool next(int i, Unit& u) const {
        const long L0 = (long)i * G + c; const long L = L0 / ksplit; const int ks = (int)(L0 % ksplit); const int tl = (int)(L / nN), pn = (int)(L % nN), gt = seg * 128 + tl;
        int t = 0, e = 0, tbe = 0, cne = 0;
#pragma unroll
        for (int k = 0; k < 8; ++k) { const unsigned q = (k < 2) ? q0 : (k < 4) ? q1 : (k < 6) ? q2 : q3; const int n = (int)((k & 1) ? (q >> 16) : (q & 0xffffu));
            if (gt >= t) { e = k; tbe = t; cne = n; } t += (n + 255) >> 8; }
        int nt = t - seg * 128; nt = nt < 0 ? 0 : (nt > 128 ? 128 : nt);
        if (L >= (long)nt * nN) return false;
        const int rt = gt - tbe;
        u.pm = tl; u.pn = pn; u.e = e; u.ks = ks; u.bofs = (size_t)e * bstride + (size_t)pn * tsB + ks * kbytes; u.aofs = (GATH ? 0 : (size_t)tl * tsA) + ks * kbytes;
        u.rows = list + ((size_t)e * 32768 + rt * 256) * 2; int nv = cne - rt * 256; u.nvalid = nv > 256 ? 256 : nv; return true;
    }
};

template <class Epi, class Sched, bool F8 = false>
__device__ __forceinline__ void gemm_phase(LAS unsigned char* lds, int wid0, const Gemm g, const Sched& S, const Epi& E) {
    constexpr bool GATHER = Sched::GATHER;
    const int tid = otid_w(wid0), wid = __builtin_amdgcn_readfirstlane(tid >> 6), lane = tid & 63, wr = wid >> 2, wc = wid & 3, fr = lane & 15, fq = lane >> 4;
    const int nt = g.K / BK;
    unsigned voffA[2], voffB[2];
#pragma unroll
    for (int i = 0; i < 2; ++i) { int R, C; stage_rc(tid * 16 + i * 8192, R, C); const int Rb = Epi::PERM ? ((R & ~31) + perm32(R & 31)) : R;
        voffA[i] = (unsigned)(R * g.lda + C) * 2u; voffB[i] = (unsigned)(Rb * g.ldb + C) * 2u; }
    const size_t kstep = (size_t)(BK * 2);
    const size_t hstepA = GATHER ? 0 : (size_t)HALF * g.lda * 2, hstepB = (size_t)HALF * g.ldb * 2;
    const unsigned ldsw = (unsigned)wid * 1024u;
    const int aoff = lds_byte(wr * 64 + fr, fq * 8), boff = lds_byte(wc * 32 + fr, fq * 8);
#define PG8_SA(b, h) (((b) * 2 + (h)) * HTB)
#define PG8_SB(b, h) ((4 + (b) * 2 + (h)) * HTB)
#define PG8_STAGE2(bufoff, gbase, o0, o1) do { \
        __builtin_amdgcn_global_load_lds((const unsigned*)((const char*)(gbase) + (o0)), (LAS unsigned*)(lds + (bufoff) + ldsw), 16, 0, 0); \
        __builtin_amdgcn_global_load_lds((const unsigned*)((const char*)(gbase) + (o1)), (LAS unsigned*)(lds + (bufoff) + ldsw + 8192), 16, 0, 0); } while (0)
#define PG8_STAGE(bufoff, gbase, voff) PG8_STAGE2(bufoff, gbase, (voff)[0], (voff)[1])
#define PG8_LDA(dst, b, h) do { _Pragma("unroll") for (int m = 0; m < 4; ++m) _Pragma("unroll") for (int k = 0; k < 2; ++k) dst[m][k] = *(const LAS bf16x8*)(lds + PG8_SA(b, h) + aoff + m * 2048 + k * 1024); } while (0)
#define PG8_LDB(dst, b, h) do { _Pragma("unroll") for (int n = 0; n < 2; ++n) _Pragma("unroll") for (int k = 0; k < 2; ++k) dst[n][k] = *(const LAS bf16x8*)(lds + PG8_SB(b, h) + boff + n * 2048 + k * 1024); } while (0)
#define PG8_CAT(x) __builtin_shufflevector(__builtin_bit_cast(i32x4v, (x)[0]), __builtin_bit_cast(i32x4v, (x)[1]), 0, 1, 2, 3, 4, 5, 6, 7)
#define PG8_MMA(ai, bj, At, Bt) do { __builtin_amdgcn_s_setprio(1); if constexpr (F8) { _Pragma("unroll") for (int m = 0; m < 4; ++m) _Pragma("unroll") for (int n = 0; n < 2; ++n) \
        asm volatile("v_mfma_f32_16x16x128_f8f6f4 %0, %1, %2, %0" : "+v"(acc[ai][bj][m][n]) : "v"(PG8_CAT(Bt[n])), "v"(PG8_CAT(At[m]))); } else { \
        _Pragma("unroll") for (int m = 0; m < 4; ++m) _Pragma("unroll") for (int n = 0; n < 2; ++n) _Pragma("unroll") for (int k = 0; k < 2; ++k) \
        acc[ai][bj][m][n] = Epi::TRANS ? __builtin_amdgcn_mfma_f32_16x16x32_bf16(Bt[n][k], At[m][k], acc[ai][bj][m][n], 0, 0, 0) : __builtin_amdgcn_mfma_f32_16x16x32_bf16(At[m][k], Bt[n][k], acc[ai][bj][m][n], 0, 0, 0); } __builtin_amdgcn_s_setprio(0); } while (0)
#define PG8_WAIT_V(n) asm volatile("s_waitcnt vmcnt(" #n ")" ::: "memory")
#define PG8_WAIT_L(n) asm volatile("s_waitcnt lgkmcnt(" #n ")" ::: "memory")
#define PG8_BAR __builtin_amdgcn_s_barrier()
#define PG8_SCHED __builtin_amdgcn_sched_barrier(0)
#define GSLOT(which) ((LAS u32x4*)(lds + 131072 + (which) * 8192 + tid * 16))
#define PG8_ROWS(u, which) do { const int _ft = fresh_tid(tid); unsigned _vg[2][2]; _Pragma("unroll") for (int _i = 0; _i < 2; ++_i) { int _R, _C; stage_rc(_ft * 16 + _i * 8192, _R, _C); \
        _Pragma("unroll") for (int _h = 0; _h < 2; ++_h) { const int _r = _h * HALF + _R; \
        const int _t = (_r < (u).nvalid) ? (u).rows[2 * _r] : 0; _vg[_h][_i] = ((unsigned)_t * (unsigned)g.lda + (unsigned)_C) * 2u; } } \
        u32x4 _o; _o.x = _vg[0][0]; _o.y = _vg[0][1]; _o.z = _vg[1][0]; _o.w = _vg[1][1]; *GSLOT(which) = _o; } while (0)
    Unit cur, nxt; int ui = 0;
    if (!S.next(0, cur)) return;
    f32x4 acc[2][2][4][2];
#pragma unroll
    for (int a = 0; a < 2; ++a)
#pragma unroll
        for (int b = 0; b < 2; ++b)
#pragma unroll
            for (int m = 0; m < 4; ++m)
#pragma unroll
                for (int n = 0; n < 2; ++n) acc[a][b][m][n] = (f32x4){0.f, 0.f, 0.f, 0.f};
    bf16x8 At[4][2], B0[2][2], B1[2][2];
    u32x4 gc = {voffA[0], voffA[1], voffA[0], voffA[1]};
    if constexpr (GATHER) { PG8_ROWS(cur, 0); PG8_ROWS(cur, 1); gc = *GSLOT(0); }
#define VGC(h, i) (gc[2 * (h) + (i)])
    const char* cA = (const char*)g.A + cur.aofs; const char* cB = (const char*)g.Bt + cur.bofs;
    PG8_STAGE(PG8_SB(0, 0), cB, voffB); PG8_STAGE(PG8_SB(0, 1), cB + hstepB, voffB); PG8_STAGE2(PG8_SA(0, 0), cA, VGC(0, 0), VGC(0, 1)); PG8_STAGE2(PG8_SA(0, 1), cA + hstepA, VGC(1, 0), VGC(1, 1));
    if (wr == 1) PG8_BAR;
    PG8_WAIT_V(2); PG8_BAR;
    PG8_STAGE(PG8_SB(1, 0), cB + kstep, voffB); PG8_STAGE2(PG8_SA(1, 0), cA + kstep, VGC(0, 0), VGC(0, 1)); PG8_STAGE(PG8_SB(1, 1), cB + hstepB + kstep, voffB);
    PG8_WAIT_V(6); PG8_BAR;
    for (;;) {
        const bool has_next = S.next(ui + 1, nxt);
        const char* nA = has_next ? (const char*)g.A + nxt.aofs : cA; const char* nB = has_next ? (const char*)g.Bt + nxt.bofs : cB;
        if constexpr (GATHER) { if (has_next) PG8_ROWS(nxt, 1); else *GSLOT(1) = *GSLOT(0); }
        for (int t = 0; t < nt; t += 2) {
            const bool last = (t == nt - 2);
            const char* a1 = cA + (size_t)(t + 1) * kstep;
            const char* a2 = last ? nA : cA + (size_t)(t + 2) * kstep; const char* b2 = last ? nB : cB + (size_t)(t + 2) * kstep;
            const char* a3 = a2 + kstep; const char* b3 = b2 + kstep;
            u32x4 gn = gc; if constexpr (GATHER) { gc = *GSLOT(0); gn = last ? *GSLOT(1) : gc; }
            const unsigned s00 = gn.x, s01 = gn.y, s10 = gn.z, s11 = gn.w;
            PG8_LDB(B0, 0, 0); PG8_LDB(B1, 0, 1); PG8_SCHED; PG8_LDA(At, 0, 0); PG8_STAGE2(PG8_SA(1, 1), a1 + hstepA, VGC(1, 0), VGC(1, 1));
            PG8_WAIT_V(8); PG8_WAIT_L(0); PG8_BAR; PG8_MMA(0, 0, At, B0); PG8_MMA(0, 1, At, B1); PG8_BAR; PG8_SCHED;
            PG8_LDA(At, 0, 1); PG8_STAGE(PG8_SB(0, 0), b2, voffB); PG8_STAGE(PG8_SB(0, 1), b2 + hstepB, voffB); PG8_STAGE2(PG8_SA(0, 0), a2, s00, s01);
            PG8_WAIT_V(8); PG8_WAIT_L(0); PG8_BAR; PG8_MMA(1, 0, At, B0); PG8_MMA(1, 1, At, B1); PG8_BAR; PG8_SCHED;
            PG8_LDB(B0, 1, 0); PG8_LDB(B1, 1, 1); PG8_SCHED; PG8_LDA(At, 1, 0); PG8_STAGE2(PG8_SA(0, 1), a2 + hstepA, s10, s11);
            PG8_WAIT_V(8); PG8_WAIT_L(0); PG8_BAR; PG8_MMA(0, 0, At, B0); PG8_MMA(0, 1, At, B1); PG8_BAR; PG8_SCHED;
            PG8_LDA(At, 1, 1); PG8_STAGE(PG8_SB(1, 0), b3, voffB); PG8_STAGE(PG8_SB(1, 1), b3 + hstepB, voffB); PG8_STAGE2(PG8_SA(1, 0), a3, s00, s01);
            PG8_WAIT_V(8); PG8_WAIT_L(0); PG8_BAR; PG8_MMA(1, 0, At, B0); PG8_MMA(1, 1, At, B1); PG8_BAR; PG8_SCHED;
        }
        if (wr == 0) PG8_BAR;
        if constexpr (F8) asm volatile("s_nop 15\n\ts_nop 15" ::: "memory");
        E(acc, cur, wr, wc, fr, fq);
        if (!has_next) break;
#pragma unroll
        for (int a = 0; a < 2; ++a)
#pragma unroll
            for (int b = 0; b < 2; ++b)
#pragma unroll
                for (int m = 0; m < 4; ++m)
#pragma unroll
                    for (int n = 0; n < 2; ++n) acc[a][b][m][n] = (f32x4){0.f, 0.f, 0.f, 0.f};
        cur = nxt; cA = nA; cB = nB; ++ui;
        if constexpr (GATHER) { *GSLOT(0) = *GSLOT(1); }
        if (wr == 1) PG8_BAR;
    }
    PG8_WAIT_V(0);
    PG8_BAR;
#undef PG8_SA
#undef PG8_SB
#undef PG8_STAGE
#undef PG8_STAGE2
#undef PG8_ROWS
#undef GSLOT
#undef VGC
#undef PG8_LDA
#undef PG8_LDB
#undef PG8_MMA
#undef PG8_CAT
#undef PG8_WAIT_V
#undef PG8_WAIT_L
#undef PG8_BAR
#undef PG8_SCHED
}

typedef const f32x4 (&AccRef)[2][2][4][2];
__device__ __forceinline__ float ss16(const float* p) { const f32x4 a = *(const f32x4*)p, b = *(const f32x4*)(p + 4), c = *(const f32x4*)(p + 8), d = *(const f32x4*)(p + 12);
    return (((a[0] + a[1]) + (a[2] + a[3])) + ((b[0] + b[1]) + (b[2] + b[3]))) + (((c[0] + c[1]) + (c[2] + c[3])) + ((d[0] + d[1]) + (d[2] + d[3]))); }
__device__ __forceinline__ float rs_of(const float* rstd, int ssmode, int row) { return ssmode ? __builtin_amdgcn_rsqf(ss16(rstd + (size_t)row * 16) * (1.f / D) + 1e-6f) : rstd[row]; }

struct EpiInProj {
    static constexpr bool PERM = true, TRANS = true;
    bf16* P; const float* rstd; float* dt; int ssmode;
    __device__ __forceinline__ void operator()(AccRef acc, const Unit& u, int wr, int wc, int fr, int fq) const {
        const int row0 = u.pm * BM + wr * 64 + fr;
        float scl[2][4];
#pragma unroll
        for (int ai = 0; ai < 2; ++ai)
#pragma unroll
            for (int m = 0; m < 4; ++m) scl[ai][m] = rs_of(rstd, ssmode, row0 + ai * HALF + m * 16);
        if (u.pn < 21) {
            const int col0 = u.pn * BM + wc * 32 + 8 * fq;
#pragma unroll
            for (int ai = 0; ai < 2; ++ai)
#pragma unroll
                for (int m = 0; m < 4; ++m) { const int row = row0 + ai * HALF + m * 16; const float s = scl[ai][m]; bf16* rowp = P + (size_t)row * PLD + col0;
#pragma unroll
                    for (int bj = 0; bj < 2; ++bj) { const f32x4 v0 = acc[ai][bj][m][0] * s, v1 = acc[ai][bj][m][1] * s;
                        u32x4 w; w.x = pk2(v0[0], v0[1]); w.y = pk2(v0[2], v0[3]); w.z = pk2(v1[0], v1[1]); w.w = pk2(v1[2], v1[3]);
                        *(u32x4*)(rowp + bj * HALF) = w; } }
        } else if (wc == 0 && fq == 0) {
#pragma unroll
            for (int ai = 0; ai < 2; ++ai)
#pragma unroll
                for (int m = 0; m < 4; ++m) { const int row = row0 + ai * HALF + m * 16; const float s = scl[ai][m];
                    *(f32x4*)(dt + (size_t)row * 8) = acc[ai][0][m][0] * s; *(f32x4*)(dt + (size_t)row * 8 + 4) = acc[ai][0][m][1] * s; }
        }
    }
};
struct EpiPlain {
    static constexpr bool PERM = true, TRANS = true;
    bf16* P; bf16* Y2;
    __device__ __forceinline__ void operator()(AccRef acc, const Unit& u, int wr, int wc, int fr, int fq) const {
        bf16* O = (u.e == 0) ? P : (u.e == 1 ? P + C_XBC : Y2); const int ldc = (u.e == 2) ? D : PLD;
        const int row0 = u.pm * BM + wr * 64 + fr, col0 = u.pn * BM + wc * 32 + 8 * fq;
#pragma unroll
        for (int ai = 0; ai < 2; ++ai)
#pragma unroll
            for (int m = 0; m < 4; ++m) { bf16* rowp = O + (size_t)(row0 + ai * HALF + m * 16) * ldc + col0;
#pragma unroll
                for (int bj = 0; bj < 2; ++bj) { const f32x4 v0 = acc[ai][bj][m][0], v1 = acc[ai][bj][m][1];
                    u32x4 w; w.x = pk2(v0[0], v0[1]); w.y = pk2(v0[2], v0[3]); w.z = pk2(v1[0], v1[1]); w.w = pk2(v1[2], v1[3]);
                    *(u32x4*)(rowp + bj * HALF) = w; } }
    }
};
struct EpiGateMerge {
    static constexpr bool PERM = true, TRANS = true;
    const bf16* P; const bf16* Y2; bf16* Mg; int ldm; const float* rstd; int ssmode;
    __device__ __forceinline__ void operator()(AccRef acc, const Unit& u, int wr, int wc, int fr, int fq) const {
        asm volatile("" : "+v"(fr), "+v"(fq));
        const bf16* Y = (u.e == 0) ? P : (u.e == 1 ? P + C_XBC : Y2); const int ldy = (u.e == 2) ? D : PLD; const int first = (u.e == 0);
        const int row0 = u.pm * BM + wr * 64 + fr, col0 = u.pn * BM + wc * 32 + 8 * fq;
#pragma unroll
        for (int ai = 0; ai < 2; ++ai) {
            u32x4 yv[4][2], mv[4][2]; float sc[4];
#pragma unroll
            for (int m = 0; m < 4; ++m) { const int row = row0 + ai * HALF + m * 16; sc[m] = rs_of(rstd, ssmode, row);
#pragma unroll
                for (int bj = 0; bj < 2; ++bj) { yv[m][bj] = *(const u32x4*)(Y + (size_t)row * ldy + col0 + bj * HALF);
                    mv[m][bj] = first ? (u32x4){0u, 0u, 0u, 0u} : *(const u32x4*)(Mg + (size_t)row * ldm + col0 + bj * HALF); } }
#pragma unroll
            for (int m = 0; m < 4; ++m) { const int row = row0 + ai * HALF + m * 16;
#pragma unroll
                for (int bj = 0; bj < 2; ++bj) { float y[8], p[8], o[8]; unpack8(yv[m][bj], y); unpack8(mv[m][bj], p);
                    const f32x4 v0 = acc[ai][bj][m][0] * sc[m], v1 = acc[ai][bj][m][1] * sc[m];
#pragma unroll
                    for (int j = 0; j < 4; ++j) { o[j] = sigm(v0[j]) * y[j] + p[j]; o[4 + j] = sigm(v1[j]) * y[4 + j] + p[4 + j]; }
                    *(u32x4*)(Mg + (size_t)row * ldm + col0 + bj * HALF) = pack8(o); } }
        }
    }
};
struct EpiResid {
    static constexpr bool PERM = false, TRANS = true;
    const float* xin; float* xout; const float* gates; int e;
    __device__ __forceinline__ void operator()(AccRef acc, const Unit& u, int wr, int wc, int fr, int fq) const {
        const int row0 = u.pm * BM + wr * 64 + fr, col0 = u.pn * BM + wc * 32 + 4 * fq;
#pragma unroll
        for (int ai = 0; ai < 2; ++ai)
#pragma unroll
            for (int m = 0; m < 4; ++m) { const int row = row0 + ai * HALF + m * 16; const float s = gates ? gates[(size_t)row * 8 + e] : 1.f;
                const float* ip = xin + (size_t)row * D + col0; float* op = xout + (size_t)row * D + col0;
#pragma unroll
                for (int bj = 0; bj < 2; ++bj)
#pragma unroll
                    for (int n = 0; n < 2; ++n) *(f32x4*)(op + bj * HALF + n * 16) = *(const f32x4*)(ip + bj * HALF + n * 16) + acc[ai][bj][m][n] * s; }
    }
};
struct EpiResidB {
    static constexpr bool PERM = true, TRANS = true;
    bf16* xb; float* SS; float* xf;
    __device__ __forceinline__ void operator()(AccRef acc, const Unit& u, int wr, int wc, int fr, int fq) const {
        asm volatile("" : "+v"(fr), "+v"(fq));
        const int row0 = u.pm * BM + wr * 64 + fr, col0 = u.pn * BM + wc * 32 + 8 * fq;
#pragma unroll
        for (int ai = 0; ai < 2; ++ai) {
            u32x4 xv[4][2];
#pragma unroll
            for (int m = 0; m < 4; ++m)
#pragma unroll
                for (int bj = 0; bj < 2; ++bj) xv[m][bj] = *(const u32x4*)(xb + (size_t)(row0 + ai * HALF + m * 16) * D + col0 + bj * HALF);
#pragma unroll
            for (int m = 0; m < 4; ++m) { const int row = row0 + ai * HALF + m * 16; bf16* rowp = xb + (size_t)row * D + col0; float ss = 0.f;
#pragma unroll
                for (int bj = 0; bj < 2; ++bj) { float v[8]; unpack8(xv[m][bj], v);
#pragma unroll
                    for (int j = 0; j < 4; ++j) { v[j] += acc[ai][bj][m][0][j]; v[4 + j] += acc[ai][bj][m][1][j]; }
                    *(u32x4*)(rowp + bj * HALF) = pack8(v);
                    if (xf) { float* fp = xf + (size_t)row * D + col0 + bj * HALF; *(f32x4*)fp = (f32x4){v[0], v[1], v[2], v[3]}; *(f32x4*)(fp + 4) = (f32x4){v[4], v[5], v[6], v[7]}; }
#pragma unroll
                    for (int j = 0; j < 8; ++j) ss += v[j] * v[j]; }
                if (SS) { ss += __shfl_xor(ss, 16); ss += __shfl_xor(ss, 32); if (fq == 0) SS[(size_t)row * 16 + u.pn * 4 + wc] = ss; } }
        }
    }
};
struct EpiSwiglu {
    static constexpr bool PERM = true, TRANS = true;
    bf16* act; int ldc; const float* rstd; int ssmode;
    __device__ __forceinline__ void operator()(AccRef acc, const Unit& u, int wr, int wc, int fr, int fq) const {
        asm volatile("" : "+v"(fr), "+v"(fq));
        const int row0 = u.pm * BM + wr * 64 + fr, col0 = u.pn * HALF + wc * 32 + 8 * fq;
        float scl[2][4];
        if (u.rows) { int tk[2][4];
#pragma unroll
            for (int ai = 0; ai < 2; ++ai)
#pragma unroll
                for (int m = 0; m < 4; ++m) { const int lr = wr * 64 + fr + ai * HALF + m * 16; tk[ai][m] = (lr < u.nvalid) ? u.rows[2 * lr] : 0; }
#pragma unroll
            for (int ai = 0; ai < 2; ++ai)
#pragma unroll
                for (int m = 0; m < 4; ++m) scl[ai][m] = rstd[tk[ai][m]];
        } else {
#pragma unroll
            for (int ai = 0; ai < 2; ++ai)
#pragma unroll
                for (int m = 0; m < 4; ++m) scl[ai][m] = rs_of(rstd, ssmode, row0 + ai * HALF + m * 16); }
#pragma unroll
        for (int ai = 0; ai < 2; ++ai)
#pragma unroll
            for (int m = 0; m < 4; ++m) { const int row = row0 + ai * HALF + m * 16;
                const float s = scl[ai][m];
                float o[8];
#pragma unroll
                for (int n = 0; n < 2; ++n)
#pragma unroll
                    for (int j = 0; j < 4; ++j) o[4 * n + j] = silu(acc[ai][0][m][n][j] * s) * (acc[ai][1][m][n][j] * s);
                *(u32x4*)(act + (size_t)row * ldc + col0) = pack8(o); }
    }
};
struct EpiSwiglu8 {
    static constexpr bool PERM = true, TRANS = true;
    unsigned char* act; int ldc; const float* rstd;
    __device__ __forceinline__ void operator()(AccRef acc, const Unit& u, int wr, int wc, int fr, int fq) const {
        asm volatile("" : "+v"(fr), "+v"(fq));
        const int row0 = u.pm * BM + wr * 64 + fr, col0 = u.pn * HALF + wc * 32 + 8 * fq;
        float scl[2][4]; int tk[2][4];
#pragma unroll
        for (int ai = 0; ai < 2; ++ai)
#pragma unroll
            for (int m = 0; m < 4; ++m) { const int lr = wr * 64 + fr + ai * HALF + m * 16; tk[ai][m] = (lr < u.nvalid) ? u.rows[2 * lr] : 0; }
#pragma unroll
        for (int ai = 0; ai < 2; ++ai)
#pragma unroll
            for (int m = 0; m < 4; ++m) scl[ai][m] = rstd[tk[ai][m]] * (1.f / 256.f);
#pragma unroll
        for (int ai = 0; ai < 2; ++ai)
#pragma unroll
            for (int m = 0; m < 4; ++m) { const int row = row0 + ai * HALF + m * 16;
                const float s = scl[ai][m], s8 = s * 8.f;
                float o[8];
#pragma unroll
                for (int n = 0; n < 2; ++n)
#pragma unroll
                    for (int j = 0; j < 4; ++j) o[4 * n + j] = silu(acc[ai][0][m][n][j] * s) * (acc[ai][1][m][n][j] * s8);
                u32x2 w; w.x = pk4f8(o[0], o[1], o[2], o[3]); w.y = pk4f8(o[4], o[5], o[6], o[7]);
                *(u32x2*)(act + (size_t)row * ldc + col0) = w; }
    }
};
struct EpiMoeOut {
    static constexpr bool PERM = true, TRANS = true;
    bf16* Y; size_t kstride; float mul;
    __device__ __forceinline__ void operator()(AccRef acc, const Unit& u, int wr, int wc, int fr, int fq) const {
        const int row0 = u.pm * BM + wr * 64 + fr, col0 = u.pn * BM + wc * 32 + 8 * fq; bf16* O = Y + (size_t)u.ks * kstride;
#pragma unroll
        for (int ai = 0; ai < 2; ++ai)
#pragma unroll
            for (int m = 0; m < 4; ++m) { bf16* rowp = O + (size_t)(row0 + ai * HALF + m * 16) * D + col0;
#pragma unroll
                for (int bj = 0; bj < 2; ++bj) { const f32x4 v0 = acc[ai][bj][m][0] * mul, v1 = acc[ai][bj][m][1] * mul;
                    u32x4 w; w.x = pk2(v0[0], v0[1]); w.y = pk2(v0[2], v0[3]); w.z = pk2(v1[0], v1[1]); w.w = pk2(v1[2], v1[3]);
                    *(u32x4*)(rowp + bj * HALF) = w; } }
    }
};
}

#define XB_TMO      128
#define XB_XCNT(j)  (256  + 64 * (j))
#define XB_XSUB(j)  (1280 + 64 * (j))
#define XB_XGEN(j)  (2304 + 64 * (j))
#define XB_TOP      3328
#define XB_TOPGEN   3392
#define XCD_BAR_WORDS 3456
#define XB_SPIN_CAP (1u << 18)

__device__ __forceinline__ unsigned xb_ld(unsigned* p)              { return __hip_atomic_load(p, __ATOMIC_RELAXED, __HIP_MEMORY_SCOPE_AGENT); }
__device__ __forceinline__ unsigned xb_add(unsigned* p, unsigned v) { return __hip_atomic_fetch_add(p, v, __ATOMIC_RELAXED, __HIP_MEMORY_SCOPE_AGENT); }
__device__ __forceinline__ unsigned xb_xcc_id() { return (unsigned)__builtin_amdgcn_s_getreg((3 << 11) | 20) & 0xFu; }
#define XB_SPIN(cond, bar) do { unsigned _sp = 0; while (cond) { __builtin_amdgcn_s_sleep(1); \
    if ((++_sp & 255u) == 0u) { if (xb_ld(&(bar)[XB_TMO])) break; if (_sp > XB_SPIN_CAP) { atomicAdd(&(bar)[XB_TMO], 1u); break; } } } } while (0)

struct XcdBarrier { unsigned* bar; unsigned x; volatile LAS unsigned* st; };

__device__ __forceinline__ XcdBarrier xcd_barrier_post(unsigned* bar, volatile LAS unsigned* st) {
    XcdBarrier b; b.bar = bar; b.x = xb_xcc_id(); b.st = st;
    if (threadIdx.x == 0) (void)xb_add(&bar[XB_XCNT(b.x)], 1u);
    return b;
}
__device__ __forceinline__ void xcd_barrier_complete(unsigned* bar, unsigned x, unsigned& nloc, unsigned& nx) {
    const unsigned G = gridDim.x * gridDim.y * gridDim.z;
    unsigned sum, cnt, mine, sp = 0u;
    for (;;) {
        sum = 0u; cnt = 0u; mine = 0u;
#pragma unroll
        for (unsigned j = 0; j < 16; ++j) { const unsigned c = xb_ld(&bar[XB_XCNT(j)]); sum += c; cnt += (c > 0u) ? 1u : 0u; mine = (j == x) ? c : mine; }
        if (sum == G) break;
        __builtin_amdgcn_s_sleep(1);
        if ((++sp & 255u) == 0u) { if (xb_ld(&bar[XB_TMO])) break; if (sp > XB_SPIN_CAP) { atomicAdd(&bar[XB_TMO], 1u); break; } }
    }
    nloc = mine > 0u ? mine : 1u; nx = cnt > 0u ? cnt : 1u;
}
__device__ __forceinline__ void xcd_barrier(const XcdBarrier& b) {
    asm volatile("s_waitcnt vmcnt(0)" ::: "memory");
    __syncthreads();
    if (threadIdx.x == 0) {
        unsigned* bar = b.bar;
        __builtin_amdgcn_s_waitcnt(0);
        unsigned nloc = b.st[0], nx = b.st[1];
        if (nloc == 0u) { xcd_barrier_complete(bar, b.x, nloc, nx); b.st[0] = nloc; b.st[1] = nx; }
        const unsigned old = xb_add(&bar[XB_XSUB(b.x)], 1u);
        const unsigned gen = old / nloc;
        if (old + 1u == (gen + 1u) * nloc) {
            __builtin_amdgcn_fence(__ATOMIC_RELEASE, "agent");
            asm volatile("s_waitcnt vmcnt(0)" ::: "memory");
            const unsigned og = xb_add(&bar[XB_TOP], 1u);
            const unsigned tg = og / nx;
            if (og + 1u == (tg + 1u) * nx) xb_add(&bar[XB_TOPGEN], 1u);
            else XB_SPIN(xb_ld(&bar[XB_TOPGEN]) == tg, bar);
            __builtin_amdgcn_fence(__ATOMIC_ACQUIRE, "agent");
            xb_add(&bar[XB_XGEN(b.x)], 1u);
            asm volatile("s_waitcnt vmcnt(0)" ::: "memory");
        } else {
            XB_SPIN(xb_ld(&bar[XB_XGEN(b.x)]) == gen, bar);
            __builtin_amdgcn_fence(__ATOMIC_ACQUIRE, "agent");
            asm volatile("s_waitcnt vmcnt(0)" ::: "memory");
        }
    }
    __syncthreads();
}

struct Args { const float* in[34]; float* out; unsigned char* ws; int ph_lo, ph_hi; };
struct Frame {
    LAS unsigned char* lds;
    int vcu, G, cid, wid;
    float* out; unsigned char* ws; unsigned char* st;
};
__device__ __forceinline__ const float* inptr(LAS unsigned char* lds, int i) {
    int off = LDSCTL_OFF + 8 * i; asm volatile("" : "+v"(off));
    const LAS unsigned* p = (const LAS unsigned*)(lds + off);
    const unsigned lo = __builtin_amdgcn_readfirstlane(p[0]), hi = __builtin_amdgcn_readfirstlane(p[1]);
    return (const float*)(((unsigned long long)hi << 32) | lo);
}
#define INP(i) inptr(F.lds, (i))

__device__ __forceinline__ void conv_item(const float* W, int ld, int k0, int c0, int nvalid, const float* scale, bf16* dst, int K, int drow0, LAS float* scr, int lane) {
    const int n4 = (lane & 15) * 4;
#pragma unroll 4
    for (int i = 0; i < 16; ++i) { const int kk = 4 * i + (lane >> 4);
        f32x4 v = {0.f, 0.f, 0.f, 0.f}; if (n4 < nvalid) { v = *(const f32x4*)(W + (size_t)(k0 + kk) * ld + c0 + n4); if (scale) v *= scale[k0 + kk]; }
        LAS float* d = scr + kk * 65 + n4; d[0] = v[0]; d[1] = v[1]; d[2] = v[2]; d[3] = v[3]; }
    LDS_WAIT(); asm volatile("" ::: "memory");
    const int c = lane & 7;
#pragma unroll
    for (int j = 0; j < 8; ++j) { const int nn = (lane >> 3) + 8 * j; const LAS float* sp = scr + (8 * c) * 65 + nn;
        u32x4 o; o.x = pk2(sp[0 * 65], sp[1 * 65]); o.y = pk2(sp[2 * 65], sp[3 * 65]); o.z = pk2(sp[4 * 65], sp[5 * 65]); o.w = pk2(sp[6 * 65], sp[7 * 65]);
        *(u32x4*)(dst + (size_t)(drow0 + nn) * K + k0 + 8 * c) = o; }
    LDS_WAIT(); asm volatile("" ::: "memory");
}
__device__ __forceinline__ void conv_item8(const float* W, int ld, int k0, int c0, const float* scale, float mul, unsigned char* dst, int K, int drow0, LAS float* scr, int lane) {
    const int n4 = (lane & 15) * 4;
#pragma unroll 4
    for (int i = 0; i < 16; ++i) { const int kk = 4 * i + (lane >> 4);
        f32x4 v = *(const f32x4*)(W + (size_t)(k0 + kk) * ld + c0 + n4); v *= scale ? scale[k0 + kk] * mul : mul;
        LAS float* d = scr + kk * 65 + n4; d[0] = v[0]; d[1] = v[1]; d[2] = v[2]; d[3] = v[3]; }
    LDS_WAIT(); asm volatile("" ::: "memory");
    const int c = lane & 3;
#pragma unroll
    for (int j = 0; j < 4; ++j) { const int nn = (lane >> 2) + 16 * j; const LAS float* sp = scr + (16 * c) * 65 + nn;
        u32x4 o; o.x = pk4f8(sp[0 * 65], sp[1 * 65], sp[2 * 65], sp[3 * 65]); o.y = pk4f8(sp[4 * 65], sp[5 * 65], sp[6 * 65], sp[7 * 65]);
        o.z = pk4f8(sp[8 * 65], sp[9 * 65], sp[10 * 65], sp[11 * 65]); o.w = pk4f8(sp[12 * 65], sp[13 * 65], sp[14 * 65], sp[15 * 65]);
        *(u32x4*)(dst + (size_t)(drow0 + nn) * K + k0 + 16 * c) = o; }
    LDS_WAIT(); asm volatile("" ::: "memory");
}
__device__ __forceinline__ void conv_seg8(Frame& F, const float* W, int ld, int K, int ncols, const float* scale, float mul, unsigned char* dst, int r0, int blk, int blks) {
    const int ptid = otid(), plane = ptid & 63, pwave = __builtin_amdgcn_readfirstlane(ptid >> 6);
    LAS float* scr = (LAS float*)(F.lds + pwave * 16640);
    const int gw = F.vcu * 8 + pwave, NGW = F.G * 8;
    const int nblk = ncols / 64, nitems = (K / 64) * nblk;
    for (int it = gw; it < nitems; it += NGW) {
        const int kb = it / nblk, nb = it % nblk, n0 = nb * 64;
        conv_item8(W, ld, kb * 64, n0, scale, mul, dst, K, r0 + (n0 / blk) * blks + (n0 % blk), scr, plane);
    }
}
__device__ __forceinline__ void conv_seg(Frame& F, const float* W, int ld, int K, int c0, int nvalid, int ntotal, const float* scale, bf16* dst, int r0, int blk, int blks) {
    const int ptid = otid(), plane = ptid & 63, pwave = __builtin_amdgcn_readfirstlane(ptid >> 6);
    LAS float* scr = (LAS float*)(F.lds + pwave * 16640);
    const int gw = F.vcu * 8 + pwave, NGW = F.G * 8;
    const int nblk = ntotal / 64, nitems = (K / 64) * nblk;
    for (int it = gw; it < nitems; it += NGW) {
        const int kb = it / nblk, nb = it % nblk, n0 = nb * 64;
        int nv = nvalid - n0; nv = nv < 0 ? 0 : (nv > 64 ? 64 : nv);
        conv_item(W, ld, kb * 64, c0 + n0, nv, scale, dst, K, r0 + (n0 / blk) * blks + (n0 % blk), scr, plane);
    }
}
__device__ __forceinline__ void conv_layer_weights(Frame& F, int l, int part) {
    unsigned char* wl = F.ws + WS_W + (size_t)l * WL_STRIDE;
    const float* win = INP(2) + (size_t)l * D * INC; const float* n1 = INP(1) + l * D;
    const int BIGB = 1 << 30;
    if (part == 0) {
        conv_seg(F, win, INC, D, 0, 3328, 3328, n1, (bf16*)(wl + WL_IN), 0, BIGB, 0);
        conv_seg(F, win, INC, D, 3336, 2048, 2048, n1, (bf16*)(wl + WL_IN), 3328, BIGB, 0);
        conv_seg(F, win, INC, D, 3328, 8, 256, n1, (bf16*)(wl + WL_IN), 5376, BIGB, 0);
    } else {
        conv_seg(F, win, INC, D, 5384, 3072, 3072, n1, (bf16*)(wl + WL_GATE), 0, BIGB, 0);
        for (int i = 0; i < 3; ++i)
            conv_seg(F, INP(23) + ((size_t)l * 3 + i) * 512 * D, D, 512, 0, D, D, nullptr, (bf16*)(wl + WL_BR) + (size_t)i * D * 512, 0, BIGB, 0);
        conv_seg(F, INP(24) + (size_t)l * D * D, D, D, 0, D, D, nullptr, (bf16*)(wl + WL_OUT), 0, BIGB, 0);
    }
}
__device__ __forceinline__ void conv_ffn_weights(Frame& F) {
    const float* n2 = INP(25);
    conv_seg(F, INP(26), FF, D, 0, FF, FF, n2, (bf16*)(F.ws + WS_FFUP), 0, 128, 256);
    conv_seg(F, INP(27), FF, D, 0, FF, FF, n2, (bf16*)(F.ws + WS_FFUP), 128, 128, 256);
    conv_seg(F, INP(28), D, FF, 0, D, D, nullptr, (bf16*)(F.ws + WS_FFDN), 0, 1 << 30, 0);
}
__device__ __forceinline__ void conv_moe_weights(Frame& F) {
    const float* n2 = INP(25) + D;
    for (int e = 0; e < NE; ++e) {
        unsigned char* up = F.ws + WS_MOEW + (size_t)e * MOEW_STRIDE; unsigned char* dn = up + MOEW_DN;
        conv_seg8(F, INP(30) + (size_t)e * D * FFE, FFE, D, FFE, n2, 64.f, up, 0, 128, 256);
        conv_seg8(F, INP(31) + (size_t)e * D * FFE, FFE, D, FFE, n2, 64.f, up, 128, 128, 256);
        conv_seg8(F, INP(32) + (size_t)e * FFE * D, D, FFE, D, nullptr, 128.f, dn, 0, 1 << 30, 0);
    }
}
__device__ __forceinline__ void xprep_phase(Frame& F, const float* x) {
    const int ptid = otid(), plane = ptid & 63, pwave = __builtin_amdgcn_readfirstlane(ptid >> 6);
    const int gw = F.vcu * 8 + pwave, NGW = F.G * 8;
    bf16* xb = (bf16*)(F.ws + WS_XB); float* rstd = (float*)(F.ws + WS_RSTD);
    for (int m0 = 2 * gw; m0 < M; m0 += 2 * NGW) {
        f32x4 v[2][4];
#pragma unroll
        for (int q = 0; q < 2; ++q) { const f32x4* xr = (const f32x4*)(x + (size_t)(m0 + q) * D) + plane;
#pragma unroll
            for (int j = 0; j < 4; ++j) v[q][j] = xr[64 * j]; }
#pragma unroll
        for (int q = 0; q < 2; ++q) { const int m = m0 + q; float sq = 0.f;
#pragma unroll
            for (int j = 0; j < 4; ++j) sq += (v[q][j].x * v[q][j].x + v[q][j].y * v[q][j].y) + (v[q][j].z * v[q][j].z + v[q][j].w * v[q][j].w);
            sq = wave_sum(sq);
            if (plane == 0) rstd[m] = __builtin_amdgcn_rsqf(sq * (1.f / D) + 1e-6f);
            u32x2* o8 = (u32x2*)(xb + (size_t)m * D) + plane;
#pragma unroll
            for (int j = 0; j < 4; ++j) { u32x2 w; w.x = pk2(v[q][j].x, v[q][j].y); w.y = pk2(v[q][j].z, v[q][j].w); o8[64 * j] = w; } }
    }
}
__device__ __forceinline__ void final_norm_phase(Frame& F) {
    const int ptid = otid(), plane = ptid & 63, pwave = __builtin_amdgcn_readfirstlane(ptid >> 6);
    const int gw = F.vcu * 8 + pwave, NGW = F.G * 8;
    const float* fw = INP(33); const unsigned* pinfo = (const unsigned*)(F.ws + WS_PINFO); const int* cnt = (const int*)(F.ws + WS_CNT);
    int tb[8]; { int t = 0;
#pragma unroll
        for (int e = 0; e < 8; ++e) { int n = __builtin_amdgcn_readfirstlane(cnt[e]); n = n < 0 ? 0 : (n > 32768 ? 32768 : n); tb[e] = t; t += (n + 255) >> 8; } }
    const bf16* Y0 = (const bf16*)(F.ws + WS_YP0); const bf16* Y1 = (const bf16*)(F.ws + WS_YP1); const bf16* Y2 = (const bf16*)(F.ws + WS_YP2);
    f32x4 fwv[4];
#pragma unroll
    for (int j = 0; j < 4; ++j) fwv[j] = *((const f32x4*)fw + plane + 64 * j);
    for (int m0 = 2 * gw; m0 < M; m0 += 2 * NGW) {
        f32x4 v[2][4]; u32x2 ya[2][2][4]; float wg[2][2]; int sgm[2][2]; const bf16* yp[2][2];
#pragma unroll
        for (int q = 0; q < 2; ++q) { const int m = m0 + q;
            const f32x4* xr = (const f32x4*)(F.out + (size_t)m * D) + plane;
#pragma unroll
            for (int j = 0; j < 4; ++j) v[q][j] = xr[64 * j];
#pragma unroll
            for (int p = 0; p < 2; ++p) {
                const unsigned pk = __builtin_amdgcn_readfirstlane(pinfo[((size_t)m * 2 + p) * 2]); wg[q][p] = __builtin_bit_cast(float, __builtin_amdgcn_readfirstlane(pinfo[((size_t)m * 2 + p) * 2 + 1]));
                const int e = (int)(pk >> 20), slot = (int)(pk & 0xFFFFFu);
                int tbe = tb[0];
#pragma unroll
                for (int k = 1; k < 8; ++k) tbe = (e == k) ? tb[k] : tbe;
                const int gr = tbe * 256 + slot, seg = gr >> 15, lr = gr & 32767; sgm[q][p] = seg;
                yp[q][p] = (seg == 0 ? Y0 : (seg == 1 ? Y1 : Y2)) + (size_t)lr * D + 4 * plane; } }
#pragma unroll
        for (int q = 0; q < 2; ++q)
#pragma unroll
            for (int p = 0; p < 2; ++p)
#pragma unroll
                for (int j = 0; j < 4; ++j) ya[q][p][j] = *(const u32x2*)(yp[q][p] + 256 * j);
#pragma unroll
        for (int q = 0; q < 2; ++q) { const int m = m0 + q;
#pragma unroll
            for (int p = 0; p < 2; ++p) { const float wgt = wg[q][p];
#pragma unroll
                for (int j = 0; j < 4; ++j) { const u32x2 yy = ya[q][p][j]; v[q][j].x += wgt * bflo(yy.x); v[q][j].y += wgt * bfhi(yy.x); v[q][j].z += wgt * bflo(yy.y); v[q][j].w += wgt * bfhi(yy.y); }
                if (sgm[q][p] == 2) {
#pragma unroll
                    for (int ks = 1; ks < MOE_KSP; ++ks)
#pragma unroll
                        for (int j = 0; j < 4; ++j) { const u32x2 yy = *(const u32x2*)(yp[q][p] + (size_t)ks * (YP2_STRIDE / 2) + 256 * j); v[q][j].x += wgt * bflo(yy.x); v[q][j].y += wgt * bfhi(yy.x); v[q][j].z += wgt * bflo(yy.y); v[q][j].w += wgt * bfhi(yy.y); } } }
            float ssq = 0.f;
#pragma unroll
            for (int j = 0; j < 4; ++j) ssq += (v[q][j].x * v[q][j].x + v[q][j].y * v[q][j].y) + (v[q][j].z * v[q][j].z + v[q][j].w * v[q][j].w);
            ssq = wave_sum(ssq);
            const float r = __builtin_amdgcn_rsqf(ssq * (1.f / D) + 1e-6f);
            f32x4* xo = (f32x4*)(F.out + (size_t)m * D) + plane;
#pragma unroll
            for (int j = 0; j < 4; ++j) xo[64 * j] = v[q][j] * r * fwv[j]; }
    }
}
__device__ __forceinline__ void router_phase(Frame& F) {
    const int ptid = otid(), plane = ptid & 63, pwave = __builtin_amdgcn_readfirstlane(ptid >> 6);
    const float* nw = INP(25) + D; const float* rt = INP(29); float* rstd_w = (float*)(F.ws + WS_RSTD); bf16* xb = (bf16*)(F.ws + WS_XB);
    int* cnt = (int*)(F.ws + WS_CNT); int* list2 = (int*)(F.ws + WS_LIST);
    LAS int* lsel = (LAS int*)F.lds;
    LAS float* lwt = (LAS float*)(F.lds + 1024);
    LAS int* lrank = (LAS int*)(F.lds + 2048);
    LAS int* lcnt = (LAS int*)(F.lds + 3072);
    for (int blk = F.vcu; blk < M / 128; blk += F.G) {
        if (ptid < 16) lcnt[ptid] = 0;
        __syncthreads();
        for (int k = 0; k < 16; ++k) {
            const int lt = pwave * 16 + k, m = blk * 128 + lt;
            float acc[8];
#pragma unroll
            for (int e = 0; e < 8; ++e) acc[e] = 0.f;
            const u32x2* xr2 = (const u32x2*)(xb + (size_t)m * D) + plane;
            f32x4 xv4[4]; float ssq = 0.f;
#pragma unroll
            for (int j = 0; j < 4; ++j) { const u32x2 xx = xr2[64 * j]; xv4[j] = (f32x4){bflo(xx.x), bfhi(xx.x), bflo(xx.y), bfhi(xx.y)}; ssq += (xv4[j].x * xv4[j].x + xv4[j].y * xv4[j].y) + (xv4[j].z * xv4[j].z + xv4[j].w * xv4[j].w); }
            ssq = wave_sum(ssq);
            { unsigned* x8 = (unsigned*)(F.ws + WS_X8 + (size_t)m * D) + plane;
#pragma unroll
              for (int j = 0; j < 4; ++j) x8[64 * j] = pk4f8(xv4[j].x * 4.f, xv4[j].y * 4.f, xv4[j].z * 4.f, xv4[j].w * 4.f); }
#pragma unroll
            for (int j = 0; j < 4; ++j) { const int kk = 4 * plane + 256 * j; const f32x4 nwv = *(const f32x4*)(nw + kk);
#pragma unroll
                for (int q = 0; q < 4; ++q) { const float xv = xv4[j][q] * nwv[q];
                    const f32x4 r0v = *(const f32x4*)(rt + (size_t)(kk + q) * 8), r1v = *(const f32x4*)(rt + (size_t)(kk + q) * 8 + 4);
                    acc[0] += xv * r0v.x; acc[1] += xv * r0v.y; acc[2] += xv * r0v.z; acc[3] += xv * r0v.w; acc[4] += xv * r1v.x; acc[5] += xv * r1v.y; acc[6] += xv * r1v.z; acc[7] += xv * r1v.w; } }
            const float sc = __builtin_amdgcn_rsqf(ssq * (1.f / D) + 1e-6f);
            if (plane == 0) rstd_w[m] = sc;
#pragma unroll
            for (int e = 0; e < 8; ++e) acc[e] = wave_sum(acc[e]) * sc;
            int i0 = 0; float v0 = acc[0];
#pragma unroll
            for (int e = 1; e < 8; ++e) if (acc[e] > v0) { v0 = acc[e]; i0 = e; }
            int i1 = -1; float v1 = -3.0e38f;
#pragma unroll
            for (int e = 0; e < 8; ++e) if (e != i0 && acc[e] > v1) { v1 = acc[e]; i1 = e; }
            const float e1 = expf(v1 - v0), w0 = 1.f / (1.f + e1), w1 = e1 / (1.f + e1);
            if (plane == 0) { lsel[2 * lt] = i0; lsel[2 * lt + 1] = i1; lwt[2 * lt] = w0; lwt[2 * lt + 1] = w1;
                lrank[2 * lt] = atomicAdd((int*)(lcnt + i0), 1); lrank[2 * lt + 1] = atomicAdd((int*)(lcnt + i1), 1); }
        }
        __syncthreads();
        if (ptid < 8) lcnt[8 + ptid] = atomicAdd(cnt + ptid, lcnt[ptid]);
        __syncthreads();
        if (ptid < 256) { const int e = lsel[ptid], slot = lcnt[8 + e] + lrank[ptid];
            u32x2 v; v.x = (unsigned)(blk * 128 + (ptid >> 1)); v.y = __builtin_bit_cast(unsigned, lwt[ptid]);
            *(u32x2*)(list2 + ((size_t)e * 32768 + slot) * 2) = v;
            u32x2 pi; pi.x = ((unsigned)e << 20) | (unsigned)slot; pi.y = v.y; *(u32x2*)((unsigned*)(F.ws + WS_PINFO) + ((size_t)(blk * 128) * 2 + ptid) * 2) = pi; }
        __syncthreads();
    }
}

__device__ __forceinline__ void vprep_phase(Frame& F, int layer) {
    const int ptid = otid(), plane = ptid & 63, pwave = __builtin_amdgcn_readfirstlane(ptid >> 6);
    constexpr int VP = 520, V_VB = 0, V_GB = 64 * VP * 2, V_VD = 2 * 64 * VP * 2;
    LAS bf16* VB = (LAS bf16*)(F.lds + V_VB); LAS bf16* GB = (LAS bf16*)(F.lds + V_GB); LAS bf16* VD = (LAS bf16*)(F.lds + V_VD);
    const bf16* P = (const bf16*)(F.ws + WS_BIG); bf16* VF = (bf16*)(F.ws + WS_VF); bf16* VM = (bf16*)(F.ws + WS_VMIX);
    const bf16* vdT = (const bf16*)(F.ws + WS_VLORA); const bf16* vuT = vdT + 32 * 512;
    const float* mu = INP(3) + layer * 1792 + 1024; const float* v0 = INP(16);
    const int tok = ptid >> 3, part = ptid & 7, r16 = plane & 15, q4 = plane >> 4;
    for (int it = F.vcu; it < M / 64; it += F.G) {
        const int m = it * 64 + tok; const int t = m & (T - 1);
        const bf16* cur = P + (size_t)m * PLD + 1024 + part * 64;
#pragma unroll
        for (int q = 0; q < 8; ++q) { float c[8], p[8]; unpack8(*(const u32x4*)(cur + q * 8), c);
            if (t > 0) unpack8(*(const u32x4*)(cur - PLD + q * 8), p); else {
#pragma unroll
                for (int e = 0; e < 8; ++e) p[e] = 0.f; }
            const f32x4 m0 = *(const f32x4*)(mu + part * 64 + q * 8), m1 = *(const f32x4*)(mu + part * 64 + q * 8 + 4);
#pragma unroll
            for (int e = 0; e < 4; ++e) { c[e] = c[e] + (p[e] - c[e]) * m0[e]; c[4 + e] = c[4 + e] + (p[4 + e] - c[4 + e]) * m1[e]; }
            const u32x4 o = pack8(c);
            if (layer == 0) *(u32x4*)(VF + (size_t)m * 512 + part * 64 + q * 8) = o; else *(LAS u32x4*)(VB + tok * VP + part * 64 + q * 8) = o; }
        if (layer == 0) continue;
        __syncthreads();
        { const int rb = pwave & 3, jt = pwave >> 2; f32x4 acc = {0.f, 0.f, 0.f, 0.f};
#pragma unroll 4
          for (int k0 = 0; k0 < 512; k0 += 32) acc = __builtin_amdgcn_mfma_f32_16x16x32_bf16(*(const LAS bf16x8*)(VB + (16 * rb + r16) * VP + k0 + 8 * q4), *(const bf16x8*)(vdT + (size_t)(16 * jt + r16) * 512 + k0 + 8 * q4), acc, 0, 0, 0);
#pragma unroll
          for (int jj = 0; jj < 4; ++jj) VD[(16 * rb + 4 * q4 + jj) * 40 + 16 * jt + r16] = (bf16)f2bf(acc[jj]); }
        __syncthreads();
        { const int rb = pwave & 3; const bf16x8 af = *(const LAS bf16x8*)(VD + (16 * rb + r16) * 40 + 8 * q4);
#pragma unroll 4
          for (int i = 0; i < 16; ++i) { const int ct = (pwave >> 2) * 16 + i;
              const f32x4 acc = __builtin_amdgcn_mfma_f32_16x16x32_bf16(af, *(const bf16x8*)(vuT + (size_t)(16 * ct + r16) * 32 + 8 * q4), (f32x4){0.f, 0.f, 0.f, 0.f}, 0, 0, 0);
              const float vc = v0[16 * ct + r16];
#pragma unroll
              for (int jj = 0; jj < 4; ++jj) GB[(16 * rb + 4 * q4 + jj) * VP + 16 * ct + r16] = (bf16)f2bf(sigm(vc + acc[jj])); } }
        __syncthreads();
#pragma unroll
        for (int q = 0; q < 8; ++q) { float v[8], g[8], vf[8]; unpack8(*(const LAS u32x4*)(VB + tok * VP + part * 64 + q * 8), v); unpack8(*(const LAS u32x4*)(GB + tok * VP + part * 64 + q * 8), g);
            unpack8(*(const u32x4*)(VF + (size_t)m * 512 + part * 64 + q * 8), vf);
#pragma unroll
            for (int e = 0; e < 8; ++e) v[e] = v[e] + (vf[e] - v[e]) * g[e];
            *(u32x4*)(VM + (size_t)m * 512 + part * 64 + q * 8) = pack8(v); }
        __syncthreads();
    }
}
__device__ __forceinline__ void prepass_a(Frame& F) {
    const int tid = otid();
    bf16* P = (bf16*)(F.ws + WS_BIG); bf16* BND2 = (bf16*)(F.ws + WS_BND2);
    { const int ch = tid & 127; const int kind = ch >> 6, part = ch & 7;
      double invf[4];
#pragma unroll
      for (int p = 0; p < 4; ++p) invf[p] = exp(-(double)(part * 4 + p) * (9.210340371976184 / 32.0));
      for (int m = F.vcu * 4 + (tid >> 7); m < M; m += F.G * 4) {
          const int t = m & (T - 1); bf16* ptr = P + (size_t)m * PLD + C_RET + ch * 8;
          float x[8]; unpack8(*(const u32x4*)ptr, x);
#pragma unroll
          for (int p = 0; p < 4; ++p) { double rev = (double)t * invf[p] * 0.15915494309189535; rev -= floor(rev);
              const float sn = __builtin_amdgcn_sinf((float)rev), cs = __builtin_amdgcn_cosf((float)rev);
              const float x0 = x[2 * p], x1 = x[2 * p + 1]; float o0 = x0 * cs - x1 * sn, o1 = x0 * sn + x1 * cs;
              if (kind) { o0 *= 0.125f; o1 *= 0.125f; }
              x[2 * p] = o0; x[2 * p + 1] = o1; }
          *(u32x4*)ptr = pack8(x); } }
    for (int i = F.vcu * 512 + tid; i < 1024 * 3 * 128; i += F.G * 512) { const int ch = i & 127, k = (i >> 7) % 3, r = i / 384;
        if ((r & 511) != 0) *(u32x4*)(BND2 + ((size_t)r * 3 + k) * 1024 + ch * 8) = *(const u32x4*)(P + ((size_t)r * 32 - 3 + k) * PLD + C_XBC + ch * 8); }
}
__device__ __forceinline__ void prepass_conv(Frame& F, int layer) {
    const int tid = otid();
    bf16* P = (bf16*)(F.ws + WS_BIG); const bf16* BND2 = (const bf16*)(F.ws + WS_BND2);
    const float* cw = INP(17) + layer * 1024 * 4; const float* cbias = INP(18) + layer * 1024;
    const int ch = tid & 127;
    f32x4 wv[8]; float bv[8];
#pragma unroll
    for (int e = 0; e < 8; ++e) { wv[e] = *(const f32x4*)(cw + (ch * 8 + e) * 4); bv[e] = cbias[ch * 8 + e]; }
    for (int r = F.vcu * 4 + (tid >> 7); r < M / 32; r += F.G * 4) {
        float w0[8], w1[8], w2[8];
        if ((r & 511) != 0) { unpack8(*(const u32x4*)(BND2 + ((size_t)r * 3 + 0) * 1024 + ch * 8), w0); unpack8(*(const u32x4*)(BND2 + ((size_t)r * 3 + 1) * 1024 + ch * 8), w1); unpack8(*(const u32x4*)(BND2 + ((size_t)r * 3 + 2) * 1024 + ch * 8), w2); }
        else {
#pragma unroll
            for (int e = 0; e < 8; ++e) { w0[e] = 0.f; w1[e] = 0.f; w2[e] = 0.f; } }
        bf16* ptr = P + (size_t)r * 32 * PLD + C_XBC + ch * 8;
#pragma unroll 4
        for (int i = 0; i < 32; ++i) {
            float x[8], o[8]; unpack8(*(const u32x4*)(ptr + (size_t)i * PLD), x);
#pragma unroll
            for (int e = 0; e < 8; ++e) { o[e] = silu(bv[e] + wv[e][0] * w0[e] + wv[e][1] * w1[e] + wv[e][2] * w2[e] + wv[e][3] * x[e]); w0[e] = w1[e]; w1[e] = w2[e]; w2[e] = x[e]; }
            *(u32x4*)(ptr + (size_t)i * PLD) = pack8(o);
        }
    }
}
template <int CTRL> __device__ __forceinline__ float dpp_f(float v) { return __builtin_bit_cast(float, __builtin_amdgcn_update_dpp(0, __builtin_bit_cast(int, v), CTRL, 0xF, 0xF, true)); }
__device__ __forceinline__ float red8(float v) { v += dpp_f<0xB1>(v); v += dpp_f<0x4E>(v); v += dpp_f<0x141>(v); return v; }
__device__ __forceinline__ float red16(float v) { v = red8(v); v += dpp_f<0x140>(v); return v; }

__device__ __forceinline__ void rwkv_seq(Frame& F, int layer, int bh) {
    const int ptid = otid(), plane = ptid & 63, pwave = __builtin_amdgcn_readfirstlane(ptid >> 6); (void)plane; (void)pwave;
    const int b = bh >> 3, h = bh & 7;
    LAS float* L = (LAS float*)F.lds;
    LAS float *rr = L, *ww = L + 2048, *kf = L + 4096, *vv = L + 6144, *aa = L + 8192, *bb = L + 10240, *gg = L + 12288, *yy = L + 14336, *tw = L + 16384, *xa = L + 18432, *sg = L + 20480, *bon = L + 24576;
    const float* mu = INP(3) + layer * 1792; const float* w_up = INP(4) + layer * 64 * 512; const float* w0 = INP(5) + layer * 512;
    const float* a_up = INP(6) + layer * 64 * 512; const float* a0 = INP(7) + layer * 512; const float* g_up = INP(8) + layer * 128 * 512;
    const float* k_k = INP(9) + layer * 512; const float* k_a = INP(10) + layer * 512; const float* r_k = INP(11) + layer * 512;
    const float* gn_w = INP(12) + layer * 512; const float* gn_b = INP(13) + layer * 512;
    const bf16* P = (const bf16*)(F.ws + WS_BIG); const bf16* vsrc = (const bf16*)(F.ws + (layer == 0 ? WS_VF : WS_VMIX)); bf16* yout = (bf16*)(F.ws + WS_YRW);
    const int tid = ptid, tok = tid >> 4, part = tid & 15, c4 = part * 4, cb = h * 64 + c4;
    const int srow = tid >> 3, sc0 = (tid & 7) * 8;
    float S[8];
#pragma unroll
    for (int j = 0; j < 8; ++j) S[j] = 0.f;
    for (int t0 = 0; t0 < T; t0 += 32) {
        {
            const int t = t0 + tok; const size_t m = (size_t)b * T + t;
            const bf16* cur = P + m * PLD;
#pragma unroll
            for (int q = 0; q < 3; ++q) {
                const int ch = part + 16 * q; int col, kind; LAS float* dst;
                if (ch < 8) { col = h * 64 + ch * 8; dst = rr + tok * 64 + ch * 8; kind = 0; }
                else if (ch < 16) { col = 512 + h * 64 + (ch - 8) * 8; dst = kf + tok * 64 + (ch - 8) * 8; kind = 0; }
                else if (ch < 24) { col = 1536 + (ch - 16) * 8; dst = tw + tok * 64 + (ch - 16) * 8; kind = 1; }
                else if (ch < 32) { col = 1600 + (ch - 24) * 8; dst = xa + tok * 64 + (ch - 24) * 8; kind = 0; }
                else { col = 1664 + (ch - 32) * 8; dst = sg + tok * 128 + (ch - 32) * 8; kind = 2; }
                float c[8], p[8]; unpack8(*(const u32x4*)(cur + col), c);
                if (t > 0) unpack8(*(const u32x4*)(cur - PLD + col), p); else {
#pragma unroll
                    for (int e = 0; e < 8; ++e) p[e] = 0.f; }
#pragma unroll
                for (int e = 0; e < 8; ++e) { float x = c[e] + (p[e] - c[e]) * mu[col + e]; if (kind == 1) x = tanhf(x); else if (kind == 2) x = sigm(x); dst[e] = x; }
            }
            if (part < 8) { float v[8]; unpack8(*(const u32x4*)(vsrc + m * 512 + h * 64 + part * 8), v);
#pragma unroll
                for (int e = 0; e < 8; ++e) vv[tok * 64 + part * 8 + e] = v[e]; }
        }
        __syncthreads();
        {
            f32x4 dw = *(const f32x4*)(w0 + cb), da = *(const f32x4*)(a0 + cb), dg = (f32x4){0.f, 0.f, 0.f, 0.f};
            for (int j = 0; j < 64; ++j) { const float tj = tw[tok * 64 + j], xj = xa[tok * 64 + j];
                dw += *(const f32x4*)(w_up + j * 512 + cb) * tj; da += *(const f32x4*)(a_up + j * 512 + cb) * xj; }
            for (int j = 0; j < 128; ++j) dg += *(const f32x4*)(g_up + j * 512 + cb) * sg[tok * 128 + j];
            float kr[4], kk[4], av[4], ss = 0.f;
#pragma unroll
            for (int e = 0; e < 4; ++e) { kr[e] = kf[tok * 64 + c4 + e]; kk[e] = kr[e] * k_k[cb + e]; ss += kk[e] * kk[e]; av[e] = sigm(da[e]); }
            ss = red16(ss);
            const float inv = __builtin_amdgcn_rsqf(fmaxf(ss, 1e-24f));
            float bs = 0.f;
#pragma unroll
            for (int e = 0; e < 4; ++e) { const float kn = kk[e] * inv; const int o = tok * 64 + c4 + e;
                const float ld = -expf(-softplus_acc(-dw[e]) - 0.5f);
                ww[o] = expf(ld); aa[o] = -kn; bb[o] = kn * av[e];
                const float knew = kr[e] * (1.f + (av[e] - 1.f) * k_a[cb + e]); kf[o] = knew; gg[o] = dg[e];
                bs += rr[o] * knew * r_k[cb + e]; }
            bs = red16(bs);
            if (part == 0) bon[tok] = bs;
        }
        __syncthreads();
        for (int s = 0; s < 32; ++s) {
            const f32x4 a0v = *(const LAS f32x4*)(aa + s * 64 + sc0), a1v = *(const LAS f32x4*)(aa + s * 64 + sc0 + 4);
            const f32x4 w0v = *(const LAS f32x4*)(ww + s * 64 + sc0), w1v = *(const LAS f32x4*)(ww + s * 64 + sc0 + 4);
            const f32x4 b0v = *(const LAS f32x4*)(bb + s * 64 + sc0), b1v = *(const LAS f32x4*)(bb + s * 64 + sc0 + 4);
            const f32x4 k0v = *(const LAS f32x4*)(kf + s * 64 + sc0), k1v = *(const LAS f32x4*)(kf + s * 64 + sc0 + 4);
            const f32x4 r0v = *(const LAS f32x4*)(rr + s * 64 + sc0), r1v = *(const LAS f32x4*)(rr + s * 64 + sc0 + 4);
            const float vi = vv[s * 64 + srow];
            float sa = 0.f;
#pragma unroll
            for (int j = 0; j < 4; ++j) sa += S[j] * a0v[j] + S[4 + j] * a1v[j];
            sa = red8(sa);
            float y = 0.f;
#pragma unroll
            for (int j = 0; j < 4; ++j) { S[j] = S[j] * w0v[j] + sa * b0v[j] + vi * k0v[j]; S[4 + j] = S[4 + j] * w1v[j] + sa * b1v[j] + vi * k1v[j]; y += S[j] * r0v[j] + S[4 + j] * r1v[j]; }
            y = red8(y);
            if ((tid & 7) == 0) yy[s * 64 + srow] = y;
        }
        __syncthreads();
        {
            const size_t m = (size_t)b * T + t0 + tok;
            float y[4], sm = 0.f;
#pragma unroll
            for (int e = 0; e < 4; ++e) { y[e] = yy[tok * 64 + c4 + e]; sm += y[e]; }
            const float mean = red16(sm) * (1.f / 64.f);
            float vs = 0.f;
#pragma unroll
            for (int e = 0; e < 4; ++e) { y[e] -= mean; vs += y[e] * y[e]; }
            const float rs = __builtin_amdgcn_rsqf(red16(vs) * (1.f / 64.f) + 64e-5f);
            const float bo = bon[tok];
            float o[4];
#pragma unroll
            for (int e = 0; e < 4; ++e) { const int idx = tok * 64 + c4 + e; o[e] = (y[e] * rs * gn_w[cb + e] + gn_b[cb + e] + bo * vv[idx]) * gg[idx]; }
            u32x2 w; w.x = pk2(o[0], o[1]); w.y = pk2(o[2], o[3]);
            *(u32x2*)(yout + m * 512 + cb) = w;
        }
        __syncthreads();
    }
}

__device__ __forceinline__ void ret_seq(Frame& F, int bh) {
    const int ptid = otid(), plane = ptid & 63, pwave = __builtin_amdgcn_readfirstlane(ptid >> 6); (void)plane; (void)pwave;
    const int b = bh >> 3, h = bh & 7;
    LAS float* L = (LAS float*)F.lds;
    LAS float *qq = L, *kk = L + 2048, *vv = L + 4096, *gg = L + 6144, *yy = L + 8192;
    bf16* P = (bf16*)(F.ws + WS_BIG);
    const int tid = ptid, tok = tid >> 4, part = tid & 15, c4 = part * 4;
    const int se = tid >> 3, sd0 = (tid & 7) * 8;
    const float gamma = 1.f - exp2f(-5.f - (float)h);
    float S[8];
#pragma unroll
    for (int j = 0; j < 8; ++j) S[j] = 0.f;
    for (int t0 = 0; t0 < T; t0 += 32) {
        {
            const int t = t0 + tok; const size_t m = (size_t)b * T + t;
#pragma unroll
            for (int q = 0; q < 2; ++q) {
                const int ch = part + 16 * q, kind = ch >> 3, cc = ch & 7;
                float x[8]; unpack8(*(const u32x4*)(P + m * PLD + C_RET + kind * 512 + h * 64 + cc * 8), x);
                LAS float* dst = (kind == 0 ? qq : kind == 1 ? kk : kind == 2 ? vv : gg) + tok * 64 + cc * 8;
                if (kind < 2) {
#pragma unroll
                    for (int p = 0; p < 4; ++p) { const int i = cc * 4 + p;
                        const double invf = exp(-(double)i * (9.210340371976184 / 32.0));
                        double sn, cs; sincos((double)t * invf, &sn, &cs);
                        const float x0 = x[2 * p], x1 = x[2 * p + 1], c = (float)cs, s = (float)sn;
                        float o0 = x0 * c - x1 * s, o1 = x0 * s + x1 * c;
                        if (kind == 1) { o0 *= 0.125f; o1 *= 0.125f; }
                        dst[2 * p] = o0; dst[2 * p + 1] = o1; }
                } else {
#pragma unroll
                    for (int e = 0; e < 8; ++e) dst[e] = x[e];
                }
            }
        }
        __syncthreads();
        for (int s = 0; s < 32; ++s) {
            const f32x4 k0v = *(const LAS f32x4*)(kk + s * 64 + sd0), k1v = *(const LAS f32x4*)(kk + s * 64 + sd0 + 4);
            const f32x4 q0v = *(const LAS f32x4*)(qq + s * 64 + sd0), q1v = *(const LAS f32x4*)(qq + s * 64 + sd0 + 4);
            const float ve = vv[s * 64 + se];
            float y = 0.f;
#pragma unroll
            for (int j = 0; j < 4; ++j) { S[j] = gamma * S[j] + k0v[j] * ve; S[4 + j] = gamma * S[4 + j] + k1v[j] * ve; y += q0v[j] * S[j] + q1v[j] * S[4 + j]; }
            y = red8(y);
            if ((tid & 7) == 0) yy[s * 64 + se] = y;
        }
        __syncthreads();
        {
            const size_t m = (size_t)b * T + t0 + tok;
            float y[4], ss = 0.f;
#pragma unroll
            for (int e = 0; e < 4; ++e) { y[e] = yy[tok * 64 + c4 + e]; ss += y[e] * y[e]; }
            const float rs = __builtin_amdgcn_rsqf(red16(ss) * (1.f / 64.f) + 1e-6f);
            float o[4];
#pragma unroll
            for (int e = 0; e < 4; ++e) o[e] = y[e] * rs * silu(gg[tok * 64 + c4 + e]);
            u32x2 w; w.x = pk2(o[0], o[1]); w.y = pk2(o[2], o[3]);
            *(u32x2*)(P + m * PLD + C_RETG + h * 64 + c4) = w;
        }
        __syncthreads();
    }
}

__device__ __forceinline__ void ssd_seq(Frame& F, int layer, int bh) {
    const int ptid = otid(), plane = ptid & 63, pwave = __builtin_amdgcn_readfirstlane(ptid >> 6); (void)plane; (void)pwave;
    const int b = bh >> 3, h = bh & 7, g = h >> 2;
    LAS float* L = (LAS float*)F.lds;
    LAS float *raw = L  , *xs = L + 11200, *Bc = L + 13248, *Cc = L + 17344, *yy = L + 21440, *dts = L + 23488, *das = L + 23520;
    bf16* P = (bf16*)(F.ws + WS_BIG); const float* dtb = (const float*)(F.ws + WS_DT);
    const float* cw = INP(17) + layer * 1024 * 4; const float* cbias = INP(18) + layer * 1024;
    const float dt_bias = INP(19)[layer * 8 + h], A = -expf(INP(20)[layer * 8 + h]), Dh = INP(21)[layer * 8 + h];
    const int tid = ptid;
    const int sp = tid >> 3, sn0 = (tid & 7) * 16;
    float S[16];
#pragma unroll
    for (int j = 0; j < 16; ++j) S[j] = 0.f;
    for (int i = tid; i < 3 * 320; i += 512) raw[i] = 0.f;
    __syncthreads();
    for (int t0 = 0; t0 < T; t0 += 32) {
        for (int idx = tid; idx < 32 * 40; idx += 512) {
            const int row = idx / 40, ch = idx % 40; const size_t m = (size_t)b * T + t0 + row;
            const int col = ch < 8 ? (C_XBC + h * 64 + ch * 8) : (ch < 24 ? (C_XBC + 512 + g * 128 + (ch - 8) * 8) : (C_XBC + 768 + g * 128 + (ch - 24) * 8));
            float x[8]; unpack8(*(const u32x4*)(P + m * PLD + col), x);
#pragma unroll
            for (int e = 0; e < 8; ++e) raw[(3 + row) * 320 + ch * 8 + e] = x[e];
        }
        if (tid < 32) { const size_t m = (size_t)b * T + t0 + tid; const float dt = softplus_acc(dtb[m * 8 + h] + dt_bias); dts[tid] = dt; das[tid] = expf(A * dt); }
        __syncthreads();
        for (int idx = tid; idx < 32 * 320; idx += 512) {
            const int row = idx / 320, c = idx % 320;
            const int chn = c < 64 ? (h * 64 + c) : (c < 192 ? (512 + g * 128 + (c - 64)) : (768 + g * 128 + (c - 192)));
            float a = cbias[chn];
#pragma unroll
            for (int k = 0; k < 4; ++k) a += cw[chn * 4 + k] * raw[(row + k) * 320 + c];
            a = silu(a);
            if (c < 64) xs[row * 64 + c] = a; else if (c < 192) Bc[row * 128 + (c - 64)] = a; else Cc[row * 128 + (c - 192)] = a;
        }
        __syncthreads();
        for (int s = 0; s < 32; ++s) {
            const float da = das[s], xv = xs[s * 64 + sp], dtx = dts[s] * xv;
            float y = 0.f;
#pragma unroll
            for (int q = 0; q < 4; ++q) { const f32x4 bv = *(const LAS f32x4*)(Bc + s * 128 + sn0 + q * 4), cv = *(const LAS f32x4*)(Cc + s * 128 + sn0 + q * 4);
#pragma unroll
                for (int j = 0; j < 4; ++j) { S[q * 4 + j] = da * S[q * 4 + j] + dtx * bv[j]; y += S[q * 4 + j] * cv[j]; } }
            y = red8(y);
            if ((tid & 7) == 0) yy[s * 64 + sp] = y + Dh * xv;
        }
        __syncthreads();
        {
            const int tok = tid >> 4, c4 = (tid & 15) * 4; const size_t m = (size_t)b * T + t0 + tok;
            u32x2 w; w.x = pk2(yy[tok * 64 + c4], yy[tok * 64 + c4 + 1]); w.y = pk2(yy[tok * 64 + c4 + 2], yy[tok * 64 + c4 + 3]);
            *(u32x2*)(P + m * PLD + C_XBC + h * 64 + c4) = w;
            for (int i = tid; i < 3 * 320; i += 512) raw[i] = raw[32 * 320 + i];
        }
        __syncthreads();
    }
}
__device__ __forceinline__ void ssm_norm_phase(Frame& F, int layer) {
    const int ptid = otid(), plane = ptid & 63, pwave = __builtin_amdgcn_readfirstlane(ptid >> 6);
    const int gw = F.vcu * 8 + pwave, NGW = F.G * 8;
    bf16* P = (bf16*)(F.ws + WS_BIG); const float* nw = INP(22) + layer * 512;
    float nwv[8];
#pragma unroll
    for (int e = 0; e < 8; ++e) nwv[e] = nw[plane * 8 + e];
    for (int m0 = 2 * gw; m0 < M; m0 += 2 * NGW) {
        u32x4 yv[2], zv[2];
#pragma unroll
        for (int q = 0; q < 2; ++q) { yv[q] = *(const u32x4*)(P + (size_t)(m0 + q) * PLD + C_XBC + plane * 8); zv[q] = *(const u32x4*)(P + (size_t)(m0 + q) * PLD + C_Z + plane * 8); }
#pragma unroll
        for (int q = 0; q < 2; ++q) { float y[8], z[8]; unpack8(yv[q], y); unpack8(zv[q], z);
            float ss = 0.f;
#pragma unroll
            for (int e = 0; e < 8; ++e) { y[e] *= silu(z[e]); ss += y[e] * y[e]; }
            ss = red16(ss); ss += __shfl_xor(ss, 16);
            const float rs = __builtin_amdgcn_rsqf(ss * (1.f / 256.f) + 1e-6f);
#pragma unroll
            for (int e = 0; e < 8; ++e) y[e] *= rs * nwv[e];
            *(u32x4*)(P + (size_t)(m0 + q) * PLD + C_Z + plane * 8) = pack8(y); }
    }
}
constexpr int PT = 72, PT2 = 136, PF = 68;
__device__ __forceinline__ f32x4 mfma16(bf16x8 a, bf16x8 b, f32x4 c) { return __builtin_amdgcn_mfma_f32_16x16x32_bf16(a, b, c, 0, 0, 0); }
template <int K, bool SA = false, bool SB = false> __device__ __forceinline__ f32x4 mm_ll(const LAS bf16* A, int pa, int m0, const LAS bf16* B, int pb, int n0, f32x4 acc, int lane) {
    const int r = lane & 15, q = lane >> 4;
    const int xa = SA ? (((m0 + r) >> 3) & 7) : 0, xb = SB ? (((n0 + r) >> 3) & 7) : 0;
    const LAS bf16* ap = A + (m0 + r) * pa; const LAS bf16* bp = B + (n0 + r) * pb;
#pragma unroll
    for (int k0 = 0; k0 < K; k0 += 32) acc = mfma16(*(const LAS bf16x8*)(ap + 8 * (((k0 >> 3) + q) ^ xa)), *(const LAS bf16x8*)(bp + 8 * (((k0 >> 3) + q) ^ xb)), acc);
    return acc;
}
template <int K> __device__ __forceinline__ f32x4 mm_lg(const LAS bf16* A, int pa, int m0, const bf16* B, int pb, int n0, f32x4 acc, int lane) {
    const int r = lane & 15, q = lane >> 4;
    const LAS bf16* ap = A + (m0 + r) * pa + 8 * q; const bf16* bp = B + (size_t)(n0 + r) * pb + 8 * q;
#pragma unroll
    for (int k0 = 0; k0 < K; k0 += 32) acc = mfma16(*(const LAS bf16x8*)(ap + k0), *(const bf16x8*)(bp + k0), acc);
    return acc;
}
__device__ __forceinline__ float redl16(float v) { return red16(v); }
__device__ __forceinline__ void st4bf(LAS bf16* p, f32x4 v) { u32x2 w; w.x = pk2(v[0], v[1]); w.y = pk2(v[2], v[3]); *(LAS u32x2*)p = w; }
__device__ __forceinline__ float ldbf(const LAS bf16* p) { return __builtin_bit_cast(float, (unsigned)(*p) << 16); }
constexpr f32x4 FZ4 = {0.f, 0.f, 0.f, 0.f};
__device__ __forceinline__ void tr_write8(LAS bf16* Tm, int pitch, int c0, int t, const float (&v)[8], int) {
    LAS bf16* base = Tm + c0 * pitch + (t ^ (((c0 >> 3) & 7) << 3));
#pragma unroll
    for (int e = 0; e < 8; ++e) base[e * pitch] = (bf16)f2bf(v[e]);
}
__device__ __forceinline__ float tr_at(const LAS bf16* Tm, int pitch, int row, int col) { return __builtin_bit_cast(float, (unsigned)Tm[row * pitch + (col ^ (((row >> 3) & 7) << 3))] << 16); }
__device__ __forceinline__ void ld8f(const LAS float* p, float (&v)[8]) { const f32x4 a = *(const LAS f32x4*)p, b = *(const LAS f32x4*)(p + 4); v[0] = a[0]; v[1] = a[1]; v[2] = a[2]; v[3] = a[3]; v[4] = b[0]; v[5] = b[1]; v[6] = b[2]; v[7] = b[3]; }
__device__ __forceinline__ void st8f(LAS float* p, const float (&v)[8]) { *(LAS f32x4*)p = (f32x4){v[0], v[1], v[2], v[3]}; *(LAS f32x4*)(p + 4) = (f32x4){v[4], v[5], v[6], v[7]}; }

template <bool FINAL>
__device__ __forceinline__ void rwkv_chunk_unit(Frame& F, int layer, int u) {
    const int tid = otid(), w = __builtin_amdgcn_readfirstlane(tid >> 6);
    bf16x8 lfr[16];
#define IDS() const int ft = fresh_tid(tid); const int lane = ft & 63, r16 = lane & 15, q4 = lane >> 4, tok = ft >> 3, part = ft & 7; (void)lane; (void)r16; (void)q4; (void)tok; (void)part
    const int b = u >> 9, sc = (u >> 3) & 63, h = u & 7;
    constexpr int NV = FINAL ? 64 : 128, NVT = NV / 16, NZ = NVT / 2;
    constexpr int X_TW = 0, X_XA = 9216, X_SG = 18432, X_KF = 35840, X_RF = 52224;
    constexpr int O_AT = 0, O_RT = 9216, O_BT = 18432, O_KT = 27648, O_BH = 36864, O_KH = 46080, O_VT = 55296, O_TF = O_BT;
    constexpr int Y0 = 68608;
    constexpr int Y_A = Y0, Y_B = Y0 + 8192, Y_K = Y0 + 16384, Y_R = Y0 + 24576, Y_L = Y0 + 32768, Y_VF = Y0 + 49152;
    constexpr int Y_AAB = Y0, Y_AAK = Y0 + 17408, Y_ARB = Y_AAK + 9216, Y_ARK = Y_ARB + 9216, Y_TB = FINAL ? Y_ARK + 9216 : Y_AAK + 9216, Y_ZU = Y_TB + 9216, Y_YF = Y_AAB;
    static_assert(Y_ZU + NV * PT * 2 <= Y0 + 65536, "region Y");
    constexpr int Z0 = Y0 + 65536, Z_G = Z0, Z_S = FINAL ? Z0 + 8192 : Z0, Z_MISC = 152576, Z_BON = Z_MISC, Z_PC = Z_MISC + 256, Z_PAR = Z_MISC + 512, Z_XS = Y_ZU;
    static_assert(Z_S + NV * PT * 2 <= Z_MISC && Z_PAR + 832 * 4 <= LDSCTL_OFF, "region Z");
    LAS unsigned char* L = F.lds;
#define LB(off) ((LAS bf16*)(L + (off)))
#define LF(off) ((LAS float*)(L + (off)))
    {
        const int pidx = (w == 0) ? 5 : (w == 1) ? 7 : (w == 2) ? 9 : (w == 3) ? 10 : (w == 4) ? 11 : (w == 5) ? 12 : 13;
        if (w < 7) LF(Z_PAR)[w * 64 + (tid & 63)] = (INP(pidx) + layer * 512 + h * 64)[tid & 63];
        const float* mu = INP(3) + layer * 1792;
        for (int i = tid; i < 384; i += 512) LF(Z_PAR)[448 + i] = mu[(i < 64) ? (h * 64 + i) : (i < 128) ? (512 + h * 64 + (i - 64)) : (1536 + (i - 128))];
    }
    __syncthreads();
    const bf16* WupT = (const bf16*)(F.ws + WS_LORA + (size_t)layer * LORA_STRIDE) + h * 64 * 64;
    const bf16* AupT = (const bf16*)(F.ws + WS_LORA + (size_t)layer * LORA_STRIDE + 65536) + h * 64 * 64;
    const bf16* GupT = (const bf16*)(F.ws + WS_LORA + (size_t)layer * LORA_STRIDE + 131072) + h * 64 * 128;
    const bf16* P = (const bf16*)(F.ws + WS_BIG); const bf16* vsrc = (const bf16*)(F.ws + (layer == 0 ? WS_VF : WS_VMIX));
    float* Nbuf = (float*)(F.st + 0) + (size_t)u * 4096; bf16* MT = (bf16*)(F.ws + WS_MT) + (size_t)u * 4096;
    { IDS();
        if (w < 4) {
#pragma unroll
            for (int nt = 0; nt < 4; ++nt)
#pragma unroll
                for (int k2 = 0; k2 < 2; ++k2) { lfr[nt * 4 + k2] = *(const bf16x8*)(WupT + (size_t)(16 * nt + r16) * 64 + 32 * k2 + 8 * q4); lfr[nt * 4 + 2 + k2] = *(const bf16x8*)(AupT + (size_t)(16 * nt + r16) * 64 + 32 * k2 + 8 * q4); }
        } else if (FINAL) {
#pragma unroll
            for (int nt = 0; nt < 4; ++nt)
#pragma unroll
                for (int k4 = 0; k4 < 4; ++k4) lfr[nt * 4 + k4] = *(const bf16x8*)(GupT + (size_t)(16 * nt + r16) * 128 + 32 * k4 + 8 * q4);
        } }
    constexpr int NST = FINAL ? 2 : 4;
    f32x4 Sacc[NST];
    const int s_vb = FINAL ? (w & 3) : w;
#define S_CT(ti) (FINAL ? (2 * (w >> 2) + (ti)) : (ti))
    { IDS();
#pragma unroll
    for (int ti = 0; ti < NST; ++ti) {
        const int ct = S_CT(ti);
#pragma unroll
        for (int jj = 0; jj < 4; ++jj) { const int v = 16 * s_vb + 4 * q4 + jj, c = 16 * ct + r16;
            float x; if (FINAL) x = Nbuf[v * 64 + c]; else x = (v >= 64 && v - 64 == c) ? 1.f : 0.f;
            Sacc[ti][jj] = x; LB(Z_S)[v * PT + c] = (bf16)f2bf(x); }
    } }
    u32x4 pfc[6], pfp[6], pfv;
#define RW_PREFETCH(jn) do { IDS(); const int t_ = sc * 256 + (jn) * 64 + tok; const size_t m_ = (size_t)b * T + t_; const bf16* cur_ = P + m_ * PLD; \
        _Pragma("unroll") for (int i_ = 0; i_ < 6; ++i_) { const int col_ = (i_ == 0) ? (h * 64 + 8 * part) : (i_ == 1) ? (512 + h * 64 + 8 * part) : (i_ == 2) ? (1536 + 8 * part) : (i_ == 3) ? (1600 + 8 * part) : (1664 + 8 * part + (i_ - 4) * 64); \
            pfc[i_] = *(const u32x4*)(cur_ + col_); pfp[i_] = (t_ > 0) ? *(const u32x4*)(cur_ - PLD + col_) : (u32x4){0u, 0u, 0u, 0u}; } \
        pfv = *(const u32x4*)(vsrc + m_ * 512 + h * 64 + 8 * part); } while (0)
    RW_PREFETCH(0);
    for (int j = 0; j < 4; ++j) {
        const int tl0 = sc * 256 + j * 64;
        {
            IDS();
            const int t = tl0 + tok; const size_t m = (size_t)b * T + t; const bf16* cur = P + m * PLD;
#pragma unroll
            for (int i = 0; i < 6; ++i) {
                const int col = (i == 0) ? (h * 64 + 8 * part) : (i == 1) ? (512 + h * 64 + 8 * part) : (i == 2) ? (1536 + 8 * part) : (i == 3) ? (1600 + 8 * part) : (1664 + 8 * part + (i - 4) * 64);
                float c[8], p[8]; unpack8(pfc[i], c); unpack8(pfp[i], p); (void)col;
#pragma unroll
                for (int e = 0; e < 8; ++e) c[e] = c[e] + (p[e] - c[e]) * LF(Z_PAR)[448 + ((i < 4) ? 64 * i : 256 + 64 * (i - 4)) + 8 * part + e];
                if (i == 0) { st8f(LF(X_RF) + tok * 64 + 8 * part, c);
                } else if (i == 1) { st8f(LF(X_KF) + tok * 64 + 8 * part, c);
                } else if (i == 2) {
#pragma unroll
                    for (int e = 0; e < 8; ++e) c[e] = fast_tanh(c[e]);
                    *(LAS u32x4*)(LB(X_TW) + tok * PT + 8 * part) = pack8(c);
                } else if (i == 3) {
                    *(LAS u32x4*)(LB(X_XA) + tok * PT + 8 * part) = pack8(c);
                } else if (FINAL) {
#pragma unroll
                    for (int e = 0; e < 8; ++e) c[e] = sigm(c[e]);
                    *(LAS u32x4*)(LB(X_SG) + tok * PT2 + 8 * part + (i - 4) * 64) = pack8(c);
                }
            }
            float v[8]; unpack8(pfv, v); (void)m; (void)cur;
            st8f(LF(Y_VF) + tok * 64 + 8 * part, v);
        }
        if (j < 3) RW_PREFETCH(j + 1);
        __syncthreads();
        { IDS();
        if (w < 4) {
            const int rb = w;
            float inv[4], bs[4] = {0.f, 0.f, 0.f, 0.f};
            { float ss[4] = {0.f, 0.f, 0.f, 0.f};
#pragma unroll
                for (int nt = 0; nt < 4; ++nt) { const int c = 16 * nt + r16; const float kkc = LF(Z_PAR)[128 + c];
#pragma unroll
                    for (int jj = 0; jj < 4; ++jj) { const float kk = LF(X_KF)[(16 * rb + 4 * q4 + jj) * 64 + c] * kkc; ss[jj] += kk * kk; } }
#pragma unroll
                for (int jj = 0; jj < 4; ++jj) inv[jj] = __builtin_amdgcn_rsqf(fmaxf(redl16(ss[jj]), 1e-24f)); }
#pragma unroll
            for (int nt = 0; nt < 4; ++nt) {
                f32x4 aw = FZ4, aa = FZ4;
#pragma unroll
                for (int k2 = 0; k2 < 2; ++k2) { aw = mfma16(*(const LAS bf16x8*)(LB(X_TW) + (16 * rb + r16) * PT + 32 * k2 + 8 * q4), lfr[nt * 4 + k2], aw); aa = mfma16(*(const LAS bf16x8*)(LB(X_XA) + (16 * rb + r16) * PT + 32 * k2 + 8 * q4), lfr[nt * 4 + 2 + k2], aa); }
                const int c = 16 * nt + r16; const float w0c = LF(Z_PAR)[c], a0c = LF(Z_PAR)[64 + c], kkc = LF(Z_PAR)[128 + c], kac = LF(Z_PAR)[192 + c], rkc = LF(Z_PAR)[256 + c];
#pragma unroll
                for (int jj = 0; jj < 4; ++jj) { const int t = 16 * rb + 4 * q4 + jj, o = t * 64 + c;
                    LF(Y_L)[o] = -0.8750455979f * sigm(w0c + aw[jj]);
                    const float al = sigm(a0c + aa[jj]), kraw = LF(X_KF)[o], rr = LF(X_RF)[o], kn = kraw * kkc * inv[jj];
                    const float knew = kraw * (1.f + (al - 1.f) * kac);
                    LB(Y_A)[o] = (bf16)f2bf(-kn); LB(Y_B)[o] = (bf16)f2bf(kn * al); LB(Y_K)[o] = (bf16)f2bf(knew); LB(Y_R)[o] = (bf16)f2bf(rr);
                    bs[jj] += rr * knew * rkc; } }
#pragma unroll
            for (int jj = 0; jj < 4; ++jj) { const float sm = redl16(bs[jj]); if (r16 == 0) LF(Z_BON)[16 * rb + 4 * q4 + jj] = sm; }
        } else if (FINAL) {
            const int rb = w - 4;
#pragma unroll
            for (int nt = 0; nt < 4; ++nt) { f32x4 ag = FZ4;
#pragma unroll
                for (int k4 = 0; k4 < 4; ++k4) ag = mfma16(*(const LAS bf16x8*)(LB(X_SG) + (16 * rb + r16) * PT2 + 32 * k4 + 8 * q4), lfr[nt * 4 + k4], ag);
#pragma unroll
                for (int jj = 0; jj < 4; ++jj) LB(Z_G)[(16 * rb + 4 * q4 + jj) * 64 + 16 * nt + r16] = (bf16)f2bf(ag[jj]); }
        } }
        __syncthreads();
        if (w == 0) { IDS(); float run = 0.f;
#pragma unroll 8
            for (int t = 0; t < 64; ++t) { run += LF(Y_L)[t * 64 + lane]; LF(Y_L)[t * 64 + lane] = run; }
            LF(Z_PC)[lane] = ex2(run); }
        __syncthreads();
        {
            IDS(); const int t = tok, c0 = 8 * part;
            float Lt[8], Lp[8], Le[8], av[8], bv[8], kv[8], rv[8], vv[8], at[8], rt[8], bt[8], kt[8], bh[8], kh[8];
            ld8f(LF(Y_L) + t * 64 + c0, Lt); ld8f(LF(Y_L) + 63 * 64 + c0, Le); ld8f(LF(Y_VF) + t * 64 + c0, vv);
            if (t > 0) ld8f(LF(Y_L) + (t - 1) * 64 + c0, Lp); else {
#pragma unroll
                for (int e = 0; e < 8; ++e) Lp[e] = 0.f; }
            unpack8(*(const LAS u32x4*)(LB(Y_A) + t * 64 + c0), av); unpack8(*(const LAS u32x4*)(LB(Y_B) + t * 64 + c0), bv);
            unpack8(*(const LAS u32x4*)(LB(Y_K) + t * 64 + c0), kv); unpack8(*(const LAS u32x4*)(LB(Y_R) + t * 64 + c0), rv);
#pragma unroll
            for (int e = 0; e < 8; ++e) { const float eL = ex2(Lt[e]), eLm = ex2(Lp[e]), eN = ex2(-Lt[e]), eE = ex2(Le[e] - Lt[e]);
                at[e] = av[e] * eLm; rt[e] = rv[e] * eL; bt[e] = bv[e] * eN; kt[e] = kv[e] * eN; bh[e] = bv[e] * eE; kh[e] = kv[e] * eE; }
            tr_write8(LB(O_BH), PT, c0, t, bh, part); tr_write8(LB(O_KH), PT, c0, t, kh, part); tr_write8(LB(O_VT), PT, c0, t, vv, part);
            *(LAS u32x4*)(LB(O_AT) + t * PT + c0) = pack8(at); *(LAS u32x4*)(LB(O_RT) + t * PT + c0) = pack8(rt);
            *(LAS u32x4*)(LB(O_BT) + t * PT + c0) = pack8(bt); *(LAS u32x4*)(LB(O_KT) + t * PT + c0) = pack8(kt);
        }
        __syncthreads();
        {
            IDS(); const int rb = w & 3;
#pragma unroll
            for (int ci = 0; ci < 2; ++ci) { const int ct = 2 * (w >> 2) + ci;
                f32x4 ab = FZ4, ak = FZ4, arb = FZ4, ark = FZ4;
                if (ct <= rb) { ab = mm_ll<64>(LB(O_AT), PT, 16 * rb, LB(O_BT), PT, 16 * ct, FZ4, lane); ak = mm_ll<64>(LB(O_AT), PT, 16 * rb, LB(O_KT), PT, 16 * ct, FZ4, lane);
                    if (FINAL) { arb = mm_ll<64>(LB(O_RT), PT, 16 * rb, LB(O_BT), PT, 16 * ct, FZ4, lane); ark = mm_ll<64>(LB(O_RT), PT, 16 * rb, LB(O_KT), PT, 16 * ct, FZ4, lane); } }
#pragma unroll
                for (int jj = 0; jj < 4; ++jj) { const int t = 16 * rb + 4 * q4 + jj, i = 16 * ct + r16;
                    LF(Y_AAB)[t * PF + i] = (i < t) ? ab[jj] : 0.f; LB(Y_TB)[t * PT + i] = (bf16)f2bf(((i >> 4) < (t >> 4)) ? ab[jj] : 0.f); LB(Y_AAK)[t * PT + i] = (bf16)f2bf((i < t) ? ak[jj] : 0.f);
                    if (FINAL) { LB(Y_ARB)[t * PT + i] = (bf16)f2bf((i <= t) ? arb[jj] : 0.f); LB(Y_ARK)[t * PT + i] = (bf16)f2bf((i <= t) ? ark[jj] : 0.f); } } }
        }
        __syncthreads();
        {
            IDS(); const int rb = w & 3;
            constexpr int O_DB = O_BT, O_VB = O_BT + 5120;
            if (w == 0) { const int blk = lane >> 4, col = lane & 15; float x[16];
#pragma unroll
                for (int i = 0; i < 16; ++i) x[i] = (i == col) ? 1.f : 0.f;
#pragma unroll
                for (int g3 = 0; g3 < 3; ++g3) {
                    f32x4 ar[5][4];
#pragma unroll
                    for (int ii = 0; ii < 5; ++ii) { const int i = 1 + 5 * g3 + ii;
#pragma unroll
                        for (int g4 = 0; g4 < 4; ++g4) if (4 * g4 < i) ar[ii][g4] = *(const LAS f32x4*)(LF(Y_AAB) + (16 * blk + i) * PF + 16 * blk + 4 * g4); }
                    asm volatile("" ::: "memory");
#pragma unroll
                    for (int ii = 0; ii < 5; ++ii) { const int i = 1 + 5 * g3 + ii; float sacc = 0.f;
#pragma unroll
                        for (int m2 = 0; m2 < i; ++m2) sacc += ar[ii][m2 >> 2][m2 & 3] * x[m2];
                        x[i] += sacc; }
                }
#pragma unroll
                for (int i = 0; i < 16; ++i) LB(O_DB)[(16 * blk + i) * 40 + col] = (bf16)f2bf(x[i]);
                *(LAS u32x4*)(LB(O_DB) + lane * 40 + 16) = (u32x4){0u, 0u, 0u, 0u}; *(LAS u32x4*)(LB(O_DB) + lane * 40 + 24) = (u32x4){0u, 0u, 0u, 0u}; }
            if (lane < 16) { *(LAS u32x4*)(LB(O_VB) + w * 640 + lane * 40 + 16) = (u32x4){0u, 0u, 0u, 0u}; *(LAS u32x4*)(LB(O_VB) + w * 640 + lane * 40 + 24) = (u32x4){0u, 0u, 0u, 0u}; }
#pragma unroll
            for (int ci = 0; ci < NZ; ++ci) { const int vt = (w >> 2) * NZ + ci;
                f32x4 z = mm_ll<64>(LB(O_AT), PT, 16 * rb, LB(Z_S), PT, 16 * vt, FZ4, lane);
                if (vt < 4) z = mm_ll<64, false, true>(LB(Y_AAK), PT, 16 * rb, LB(O_VT), PT, 16 * vt, z, lane);
                st4bf(LB(Y_ZU) + (16 * vt + r16) * PT + 16 * rb + 4 * q4, z); }
            __syncthreads();
            if (w < NVT) { const int vt = w; LAS bf16* vb = LB(O_VB) + w * 640; LAS bf16* zrow = LB(Y_ZU) + (16 * vt + r16) * PT;
#pragma unroll
                for (int bb = 0; bb < 4; ++bb) {
                    f32x4 acc; { const u32x2 zz = *(const LAS u32x2*)(zrow + 16 * bb + 4 * q4); acc[0] = bflo(zz.x); acc[1] = bfhi(zz.x); acc[2] = bflo(zz.y); acc[3] = bfhi(zz.y); }
                    if (bb >= 1) acc = mfma16(*(const LAS bf16x8*)(LB(Y_TB) + (16 * bb + r16) * PT + 8 * q4), *(const LAS bf16x8*)(zrow + 8 * q4), acc);
                    if (bb >= 3) acc = mfma16(*(const LAS bf16x8*)(LB(Y_TB) + (16 * bb + r16) * PT + 32 + 8 * q4), *(const LAS bf16x8*)(zrow + 32 + 8 * q4), acc);
                    st4bf(vb + r16 * 40 + 4 * q4, acc);
                    const f32x4 ub = mfma16(*(const LAS bf16x8*)(LB(O_DB) + (16 * bb + r16) * 40 + 8 * q4), *(const LAS bf16x8*)(vb + r16 * 40 + 8 * q4), FZ4);
                    st4bf(zrow + 16 * bb + 4 * q4, ub); }
            }
        }
        __syncthreads();
        {
            IDS(); f32x4 yy[2];
            if (FINAL) { const int rb = w & 3;
#pragma unroll
                for (int ci = 0; ci < 2; ++ci) { const int ct = 2 * (w >> 2) + ci;
                    f32x4 y = mm_ll<64>(LB(O_RT), PT, 16 * rb, LB(Z_S), PT, 16 * ct, FZ4, lane);
                    y = mm_ll<64>(LB(Y_ARB), PT, 16 * rb, LB(Y_ZU), PT, 16 * ct, y, lane);
                    yy[ci] = mm_ll<64, false, true>(LB(Y_ARK), PT, 16 * rb, LB(O_VT), PT, 16 * ct, y, lane); } }
#pragma unroll
            for (int ti = 0; ti < NST; ++ti) { const int ct = S_CT(ti); const float pc = LF(Z_PC)[16 * ct + r16];
                f32x4 s = Sacc[ti] * pc;
                s = mm_ll<64, false, true>(LB(Y_ZU), PT, 16 * s_vb, LB(O_BH), PT, 16 * ct, s, lane);
                if (s_vb < 4) s = mm_ll<64, true, true>(LB(O_VT), PT, 16 * s_vb, LB(O_KH), PT, 16 * ct, s, lane);
                Sacc[ti] = s; }
            __syncthreads();
#pragma unroll
            for (int ti = 0; ti < NST; ++ti) { const int ct = S_CT(ti);
#pragma unroll
                for (int jj = 0; jj < 4; ++jj) LB(Z_S)[(16 * s_vb + 4 * q4 + jj) * PT + 16 * ct + r16] = (bf16)f2bf(Sacc[ti][jj]); }
            if (FINAL) { const int rb = w & 3;
#pragma unroll
                for (int ci = 0; ci < 2; ++ci) { const int ct = 2 * (w >> 2) + ci;
#pragma unroll
                    for (int jj = 0; jj < 4; ++jj) LF(Y_YF)[(16 * rb + 4 * q4 + jj) * PF + 16 * ct + r16] = yy[ci][jj]; } }
        }
        __syncthreads();
        if (FINAL) {
            IDS();
            const int t = tok, c0 = 8 * part; const size_t m = (size_t)b * T + tl0 + t;
            float y[8], gg[8], sm = 0.f; ld8f(LF(Y_YF) + t * PF + c0, y); unpack8(*(const LAS u32x4*)(LB(Z_G) + t * 64 + c0), gg);
#pragma unroll
            for (int e = 0; e < 8; ++e) sm += y[e];
            const float mean = red8(sm) * (1.f / 64.f); float vs = 0.f;
#pragma unroll
            for (int e = 0; e < 8; ++e) { y[e] -= mean; vs += y[e] * y[e]; }
            const float rs = __builtin_amdgcn_rsqf(red8(vs) * (1.f / 64.f) + 64e-5f), bo = LF(Z_BON)[t];
#pragma unroll
            for (int e = 0; e < 8; ++e) { const int c = c0 + e; y[e] = (y[e] * rs * LF(Z_PAR)[320 + c] + LF(Z_PAR)[384 + c] + bo * tr_at(LB(O_VT), PT, c, t)) * gg[e]; }
            *(u32x4*)((bf16*)(F.ws + WS_BIG) + m * PLD + 1024 + h * 64 + c0) = pack8(y);
        }
        __syncthreads();
    }
    if (!FINAL) { IDS();
#pragma unroll
        for (int ti = 0; ti < NST; ++ti) { const int ct = S_CT(ti);
            if (s_vb < 4) {
#pragma unroll
                for (int jj = 0; jj < 4; ++jj) Nbuf[(16 * s_vb + 4 * q4 + jj) * 64 + 16 * ct + r16] = Sacc[ti][jj];
            } else { u32x2 wv; wv.x = pk2(Sacc[ti][0], Sacc[ti][1]); wv.y = pk2(Sacc[ti][2], Sacc[ti][3]);
                *(u32x2*)(MT + (16 * ct + r16) * 64 + 16 * (s_vb - 4) + 4 * q4) = wv; }
        }
    }
#undef RW_PREFETCH
#undef IDS
#undef S_CT
#undef LB
#undef LF
}

template <bool FINAL>
__device__ __forceinline__ void ret_chunk_unit(Frame& F, int u) {
    const int tid = otid(), lane = tid & 63, w = __builtin_amdgcn_readfirstlane(tid >> 6), r16 = lane & 15, q4 = lane >> 4;
    const int b = u >> 9, sc = (u >> 3) & 63, h = u & 7;
    constexpr int R_QB = 0, R_KB = 9216, R_KHT = 18432, R_VT = 27648, R_GB = 36864, R_AB = 45056, R_SB = 54272, R_YF = 63488;
    LAS unsigned char* L = F.lds;
#define LB(off) ((LAS bf16*)(L + (off)))
#define LF(off) ((LAS float*)(L + (off)))
    bf16* P = (bf16*)(F.ws + WS_BIG);
    float* Sbuf = (float*)(F.st + 16 * MiB) + (size_t)u * 4096;
    const float lg = log2f(1.f - exp2f(-5.f - (float)h));
    const float g64 = ex2(64.f * lg);
    const int db = w & 3;
    f32x4 Sacc[2];
#pragma unroll
    for (int ci = 0; ci < 2; ++ci) { const int et = 2 * (w >> 2) + ci;
#pragma unroll
        for (int jj = 0; jj < 4; ++jj) Sacc[ci][jj] = FINAL ? Sbuf[(16 * db + 4 * q4 + jj) * 64 + 16 * et + r16] : 0.f;
        if (FINAL) st4bf(LB(R_SB) + (16 * et + r16) * PT + 16 * db + 4 * q4, Sacc[ci]); }
    const int tok = tid >> 3, part = tid & 7;
    u32x4 pq = {0u, 0u, 0u, 0u}, pk, pv, pg = {0u, 0u, 0u, 0u};
#define RET_PREFETCH(jn) do { const bf16* row_ = P + ((size_t)b * T + sc * 256 + (jn) * 64 + tok) * PLD + C_RET + h * 64 + 8 * part; \
        pk = *(const u32x4*)(row_ + 512); pv = *(const u32x4*)(row_ + 1024); if (FINAL) { pq = *(const u32x4*)row_; pg = *(const u32x4*)(row_ + 1536); } } while (0)
    RET_PREFETCH(0);
    for (int j = 0; j < 4; ++j) {
        const int tl0 = sc * 256 + j * 64;
        {
            float qv[8], kv[8], vv[8]; unpack8(pk, kv); unpack8(pv, vv);
            if (FINAL) { unpack8(pq, qv); *(LAS u32x4*)(LB(R_GB) + tok * 64 + 8 * part) = pg; }
            if (j < 3) RET_PREFETCH(j + 1);
            const float zeta = ex2((float)(63 - tok) * lg);
            if (FINAL) { *(LAS u32x4*)(LB(R_QB) + tok * PT + 8 * part) = pack8(qv); *(LAS u32x4*)(LB(R_KB) + tok * PT + 8 * part) = pack8(kv); }
            float kz[8];
#pragma unroll
            for (int e = 0; e < 8; ++e) kz[e] = kv[e] * zeta;
            tr_write8(LB(R_KHT), PT, 8 * part, tok, kz, part); tr_write8(LB(R_VT), PT, 8 * part, tok, vv, part);
        }
        __syncthreads();
        if (FINAL) { const int rb = w & 3;
#pragma unroll
            for (int ci = 0; ci < 2; ++ci) { const int ct = 2 * (w >> 2) + ci; f32x4 a = FZ4;
                if (ct <= rb) a = mm_ll<64>(LB(R_QB), PT, 16 * rb, LB(R_KB), PT, 16 * ct, FZ4, lane);
#pragma unroll
                for (int jj = 0; jj < 4; ++jj) { const int l = 16 * rb + 4 * q4 + jj, s = 16 * ct + r16; LB(R_AB)[l * PT + s] = (bf16)f2bf((s <= l) ? a[jj] * ex2((float)(l - s) * lg) : 0.f); } }
            __syncthreads();
        }
        {
            f32x4 yy[2];
            if (FINAL) { const int rb = w & 3;
#pragma unroll
                for (int ci = 0; ci < 2; ++ci) { const int et = 2 * (w >> 2) + ci;
                    const f32x4 a1 = mm_ll<64, false, true>(LB(R_AB), PT, 16 * rb, LB(R_VT), PT, 16 * et, FZ4, lane), a2 = mm_ll<64>(LB(R_QB), PT, 16 * rb, LB(R_SB), PT, 16 * et, FZ4, lane);
#pragma unroll
                    for (int jj = 0; jj < 4; ++jj) yy[ci][jj] = a1[jj] + ex2((float)(16 * rb + 4 * q4 + jj + 1) * lg) * a2[jj]; } }
#pragma unroll
            for (int ci = 0; ci < 2; ++ci) { const int et = 2 * (w >> 2) + ci; Sacc[ci] = mm_ll<64, true, true>(LB(R_KHT), PT, 16 * db, LB(R_VT), PT, 16 * et, Sacc[ci] * g64, lane); }
            __syncthreads();
            if (FINAL) { const int rb = w & 3;
#pragma unroll
                for (int ci = 0; ci < 2; ++ci) { const int et = 2 * (w >> 2) + ci; st4bf(LB(R_SB) + (16 * et + r16) * PT + 16 * db + 4 * q4, Sacc[ci]);
#pragma unroll
                    for (int jj = 0; jj < 4; ++jj) LF(R_YF)[(16 * rb + 4 * q4 + jj) * PF + 16 * et + r16] = yy[ci][jj]; } }
        }
        __syncthreads();
        if (FINAL) { const size_t m = (size_t)b * T + tl0 + tok; float y[8], g[8], ss = 0.f;
            ld8f(LF(R_YF) + tok * PF + 8 * part, y);
#pragma unroll
            for (int e = 0; e < 8; ++e) ss += y[e] * y[e];
            const float rs = __builtin_amdgcn_rsqf(red8(ss) * (1.f / 64.f) + 1e-6f);
            unpack8(*(const LAS u32x4*)(LB(R_GB) + tok * 64 + 8 * part), g);
#pragma unroll
            for (int e = 0; e < 8; ++e) y[e] = y[e] * rs * silu(g[e]);
            *(u32x4*)(P + m * PLD + C_RETG + h * 64 + 8 * part) = pack8(y);
            __syncthreads(); }
    }
    if (!FINAL) {
#pragma unroll
        for (int ci = 0; ci < 2; ++ci) { const int et = 2 * (w >> 2) + ci;
#pragma unroll
            for (int jj = 0; jj < 4; ++jj) Sbuf[(16 * db + 4 * q4 + jj) * 64 + 16 * et + r16] = Sacc[ci][jj]; }
    }
#undef RET_PREFETCH
#undef LB
#undef LF
}

template <bool FINAL>
__device__ __forceinline__ void ssd_chunk_unit(Frame& F, int layer, int u) {
    const int tid = otid(), w = __builtin_amdgcn_readfirstlane(tid >> 6);
#define IDS() const int ft = fresh_tid(tid); const int lane = ft & 63, r16 = lane & 15, q4 = lane >> 4; (void)lane; (void)r16; (void)q4
    const int b = u >> 9, sc = (u >> 3) & 63, h = u & 7, g = h >> 2;
    constexpr int D_CB = 0, D_BB = 17408, D_BT = 34816, D_YF = 53248, D_XT = 70656, D_XDT = 79872, D_GM = 89088, D_SB = 98304, D_MISC = 115712;
    constexpr int D_DTS = D_MISC, D_ACS = D_MISC + 256, D_CAR = D_MISC + 512;
    LAS unsigned char* L = F.lds;
#define LB(off) ((LAS bf16*)(L + (off)))
#define LF(off) ((LAS float*)(L + (off)))
    bf16* P = (bf16*)(F.ws + WS_BIG); const float* dtb = (const float*)(F.ws + WS_DT);
    const bf16* BND = (const bf16*)(F.ws + WS_BND);
    float* Sbuf = (float*)(F.st + 32 * MiB) + (size_t)u * 8192;
    const float* cw = INP(17) + layer * 1024 * 4; const float* cbias = INP(18) + layer * 1024;
    const float dt_bias = INP(19)[layer * 8 + h], A = -expf(INP(20)[layer * 8 + h]), Dh = INP(21)[layer * 8 + h];
    const int bc_chunk = tid & 31, bc_chn = (bc_chunk < 16) ? (512 + g * 128 + bc_chunk * 8) : (768 + g * 128 + (bc_chunk - 16) * 8);
    const int x_chunk = tid & 7, x_chn = h * 64 + x_chunk * 8;
    const int pb = w & 3;
    f32x4 Sacc[4];
    { IDS();
#pragma unroll
    for (int ci = 0; ci < 4; ++ci) { const int nt = 4 * (w >> 2) + ci;
#pragma unroll
        for (int jj = 0; jj < 4; ++jj) { const float x = FINAL ? Sbuf[(16 * pb + 4 * q4 + jj) * 128 + 16 * nt + r16] : 0.f; Sacc[ci][jj] = x;
            if (FINAL) LB(D_SB)[(16 * pb + 4 * q4 + jj) * PT2 + 16 * nt + r16] = (bf16)f2bf(x); } } }
    float dstot = 0.f;
    u32x4 pbc[4], px; float pdt = 0.f;
#define SSD_PREFETCH(jn) do { const size_t m_ = (size_t)b * T + sc * 256 + (jn) * 64; \
        _Pragma("unroll") for (int it_ = 0; it_ < 4; ++it_) pbc[it_] = *(const u32x4*)(P + (m_ + it_ * 16 + (tid >> 5)) * PLD + C_XBC + bc_chn); \
        px = *(const u32x4*)(P + (m_ + (tid >> 3)) * PLD + C_XBC + x_chn); if (w == 0) pdt = dtb[(m_ + (tid & 63)) * 8 + h]; } while (0)
    SSD_PREFETCH(0);
    for (int j = 0; j < 4; ++j) {
        const int tl0 = sc * 256 + j * 64; const size_t m0 = (size_t)b * T + tl0;
        if (w == 0) {
            IDS(); const float dt = softplus_acc(pdt + dt_bias); float a = A * dt;
#pragma unroll
            for (int o = 1; o < 64; o <<= 1) { const float n = __shfl_up(a, o); if (lane >= o) a += n; }
            LF(D_DTS)[lane] = dt; LF(D_ACS)[lane] = a;
        }
        {
            IDS();
#pragma unroll
            for (int it = 0; it < 4; ++it) { const int t = it * 16 + (ft >> 5); const int ta = tl0 + t;
                float acc[8]; unpack8(pbc[it], acc); (void)ta;
                if (bc_chunk < 16) { *(LAS u32x4*)(LB(D_BB) + t * PT2 + bc_chunk * 8) = pack8(acc); tr_write8(LB(D_BT), PT, bc_chunk * 8, t, acc, bc_chunk & 7); }
                else *(LAS u32x4*)(LB(D_CB) + t * PT2 + (bc_chunk - 16) * 8) = pack8(acc);
            }
        }
        __syncthreads();
        {
            IDS(); const int t = ft >> 3; float acc[8]; unpack8(px, acc);
            if (j < 3) SSD_PREFETCH(j + 1);
            const float sc_d = LF(D_DTS)[t] * __expf(LF(D_ACS)[63] - LF(D_ACS)[t]);
            float xs8[8], xd8[8];
#pragma unroll
            for (int e = 0; e < 8; ++e) { xs8[e] = acc[e]; xd8[e] = acc[e] * sc_d; }
            tr_write8(LB(D_XT), PT, x_chunk * 8, t, xs8, x_chunk); tr_write8(LB(D_XDT), PT, x_chunk * 8, t, xd8, x_chunk);
        }
        if (FINAL) { IDS(); const int rb = w & 3;
#pragma unroll
            for (int ci = 0; ci < 2; ++ci) { const int ct = 2 * (w >> 2) + ci; f32x4 a = FZ4;
                if (ct <= rb) a = mm_ll<128>(LB(D_CB), PT2, 16 * rb, LB(D_BB), PT2, 16 * ct, FZ4, lane);
#pragma unroll
                for (int jj = 0; jj < 4; ++jj) { const int l = 16 * rb + 4 * q4 + jj, s = 16 * ct + r16;
                    LB(D_GM)[l * PT + s] = (bf16)f2bf((s <= l) ? a[jj] * __expf(LF(D_ACS)[l] - LF(D_ACS)[s]) * LF(D_DTS)[s] : 0.f); } } }
        __syncthreads();
        {
            IDS(); f32x4 yy[2];
            if (FINAL) { const int rb = w & 3;
#pragma unroll
                for (int ci = 0; ci < 2; ++ci) { const int pt = 2 * (w >> 2) + ci;
                    const f32x4 a1 = mm_ll<64, false, true>(LB(D_GM), PT, 16 * rb, LB(D_XT), PT, 16 * pt, FZ4, lane), a2 = mm_ll<128>(LB(D_CB), PT2, 16 * rb, LB(D_SB), PT2, 16 * pt, FZ4, lane);
#pragma unroll
                    for (int jj = 0; jj < 4; ++jj) { const int l = 16 * rb + 4 * q4 + jj, p = 16 * pt + r16; yy[ci][jj] = a1[jj] + __expf(LF(D_ACS)[l]) * a2[jj] + Dh * tr_at(LB(D_XT), PT, p, l); } } }
            const float dec = expf(LF(D_ACS)[63]);
#pragma unroll
            for (int ci = 0; ci < 4; ++ci) { const int nt = 4 * (w >> 2) + ci; Sacc[ci] = mm_ll<64, true, true>(LB(D_XDT), PT, 16 * pb, LB(D_BT), PT, 16 * nt, Sacc[ci] * dec, lane); }
            dstot += LF(D_ACS)[63];
            __syncthreads();
            if (FINAL) { const int rb = w & 3;
#pragma unroll
                for (int ci = 0; ci < 4; ++ci) { const int nt = 4 * (w >> 2) + ci;
#pragma unroll
                    for (int jj = 0; jj < 4; ++jj) LB(D_SB)[(16 * pb + 4 * q4 + jj) * PT2 + 16 * nt + r16] = (bf16)f2bf(Sacc[ci][jj]); }
#pragma unroll
                for (int ci = 0; ci < 2; ++ci) { const int pt = 2 * (w >> 2) + ci;
#pragma unroll
                    for (int jj = 0; jj < 4; ++jj) LF(D_YF)[(16 * rb + 4 * q4 + jj) * PF + 16 * pt + r16] = yy[ci][jj]; } }
        }
        __syncthreads();
        if (FINAL) { IDS(); const int tok = ft >> 3, part = ft & 7; float y[8];
            ld8f(LF(D_YF) + tok * PF + 8 * part, y);
            *(u32x4*)(P + (m0 + tok) * PLD + C_XBC + h * 64 + 8 * part) = pack8(y);
            __syncthreads(); }
    }
    if (!FINAL) { IDS();
#pragma unroll
        for (int ci = 0; ci < 4; ++ci) { const int nt = 4 * (w >> 2) + ci;
#pragma unroll
            for (int jj = 0; jj < 4; ++jj) Sbuf[(16 * pb + 4 * q4 + jj) * 128 + 16 * nt + r16] = Sacc[ci][jj]; }
        if (tid == 0) ((float*)(F.ws + WS_DSTOT))[u] = dstot;
    }
#undef SSD_PREFETCH
#undef IDS
#undef LB
#undef LF
}

__device__ __forceinline__ void rwkv_scan_chain(Frame& F, int chain) {
    const int tid = otid(), lane = tid & 63, w = __builtin_amdgcn_readfirstlane(tid >> 6), r16 = lane & 15, q4 = lane >> 4;
    const int b = chain >> 3, h = chain & 7, vb = w & 3, ct0 = 2 * (w >> 2);
    LAS bf16* SB = (LAS bf16*)F.lds;
    f32x4 Sacc[2] = {FZ4, FZ4};
    for (int i = tid; i < 64 * PT / 2; i += 512) ((LAS unsigned*)SB)[i] = 0u;
    f32x4 nv[2]; bf16x8 mf[2][2];
    auto fetch = [&](int sc) {
        const int u = (b * 64 + sc) * 8 + h;
        const float* Nb = (const float*)(F.st + 0) + (size_t)u * 4096; const bf16* MT = (const bf16*)(F.ws + WS_MT) + (size_t)u * 4096;
#pragma unroll
        for (int ci = 0; ci < 2; ++ci) {
#pragma unroll
            for (int jj = 0; jj < 4; ++jj) nv[ci][jj] = Nb[(16 * vb + 4 * q4 + jj) * 64 + 16 * (ct0 + ci) + r16];
#pragma unroll
            for (int k2 = 0; k2 < 2; ++k2) mf[ci][k2] = *(const bf16x8*)(MT + (size_t)(16 * (ct0 + ci) + r16) * 64 + 32 * k2 + 8 * q4); } };
    fetch(0);
    __syncthreads();
    for (int sc = 0; sc < 64; ++sc) {
        const int u = (b * 64 + sc) * 8 + h;
        float* Nb = (float*)(F.st + 0) + (size_t)u * 4096;
        f32x4 nw[2];
#pragma unroll
        for (int ci = 0; ci < 2; ++ci) {
            f32x4 a = nv[ci];
#pragma unroll
            for (int k2 = 0; k2 < 2; ++k2) a = mfma16(*(const LAS bf16x8*)(SB + (16 * vb + r16) * PT + 32 * k2 + 8 * q4), mf[ci][k2], a);
            nw[ci] = a;
#pragma unroll
            for (int jj = 0; jj < 4; ++jj) Nb[(16 * vb + 4 * q4 + jj) * 64 + 16 * (ct0 + ci) + r16] = Sacc[ci][jj]; }
        if (sc + 1 < 64) fetch(sc + 1);
        __syncthreads();
#pragma unroll
        for (int ci = 0; ci < 2; ++ci) { Sacc[ci] = nw[ci];
#pragma unroll
            for (int jj = 0; jj < 4; ++jj) SB[(16 * vb + 4 * q4 + jj) * PT + 16 * (ct0 + ci) + r16] = (bf16)f2bf(nw[ci][jj]); }
        __syncthreads();
    }
}
__device__ __forceinline__ void elem_scans(Frame& F, int blk, int nblk) {
    const int tid = otid();
    const int NRET = 16 * 4096, NSSD = 16 * 8192;
    const float* dst = (const float*)(F.ws + WS_DSTOT);
    for (int it = blk * 512 + tid; it < NRET + NSSD; it += nblk * 512) {
        if (it < NRET) { const int chain = it >> 12, e = it & 4095, b = chain >> 3, h = chain & 7;
            const float g256 = exp2f(256.f * log2f(1.f - exp2f(-5.f - (float)h)));
            float* p = (float*)(F.st + 16 * MiB) + ((size_t)(b * 64) * 8 + h) * 4096 + e; float carry = 0.f;
#pragma unroll 8
            for (int sc = 0; sc < 64; ++sc) { const float t = p[(size_t)sc * 8 * 4096]; p[(size_t)sc * 8 * 4096] = carry; carry = g256 * carry + t; }
        } else { const int i2 = it - NRET, chain = i2 >> 13, e = i2 & 8191, b = chain >> 3, h = chain & 7;
            float* p = (float*)(F.st + 32 * MiB) + ((size_t)(b * 64) * 8 + h) * 8192 + e; const float* d = dst + (b * 64) * 8 + h; float carry = 0.f;
#pragma unroll 8
            for (int sc = 0; sc < 64; ++sc) { const float t = p[(size_t)sc * 8 * 8192]; p[(size_t)sc * 8 * 8192] = carry; carry = expf(d[sc * 8]) * carry + t; }
        }
    }
}
__device__ __forceinline__ void conv_lora(Frame& F) {
    const int tid = otid();
    for (int l = 0; l < 2; ++l) {
        bf16* base = (bf16*)(F.ws + WS_LORA + (size_t)l * LORA_STRIDE);
        const float* wu = INP(4) + l * 64 * 512; const float* au = INP(6) + l * 64 * 512; const float* gu = INP(8) + l * 128 * 512;
        for (int i = F.vcu * 512 + tid; i < 512 * 64; i += F.G * 512) { const int c = i >> 6, jx = i & 63; base[i] = (bf16)f2bf(wu[jx * 512 + c]); base[32768 + i] = (bf16)f2bf(au[jx * 512 + c]); }
        for (int i = F.vcu * 512 + tid; i < 512 * 128; i += F.G * 512) { const int c = i >> 7, jx = i & 127; base[65536 + i] = (bf16)f2bf(gu[jx * 512 + c]); }
    }
}
__device__ __forceinline__ void conv_vlora(Frame& F) {
    const int tid = otid();
    bf16* vdT = (bf16*)(F.ws + WS_VLORA); bf16* vuT = vdT + 32 * 512;
    const float* vdn = INP(14); const float* vup = INP(15);
    for (int i = F.vcu * 512 + tid; i < 32 * 512; i += F.G * 512) { const int j = i >> 9, c = i & 511; vdT[i] = (bf16)f2bf(vdn[c * 32 + j]); }
    for (int i = F.vcu * 512 + tid; i < 512 * 32; i += F.G * 512) { const int c = i >> 5, j = i & 31; vuT[i] = (bf16)f2bf(vup[j * 512 + c]); }
}
__device__ __forceinline__ void save_bnd(Frame& F) {
    const int tid = otid();
    const bf16* P = (const bf16*)(F.ws + WS_BIG); bf16* BND = (bf16*)(F.ws + WS_BND);
    for (int i = F.vcu * 512 + tid; i < 2 * 64 * 3 * 64; i += F.G * 512) { const int ch = i & 63, k = (i >> 6) % 3, bs = i / 192, b = bs >> 6, sc = bs & 63;
        if (sc > 0) *(u32x4*)(BND + (size_t)(bs * 3 + k) * 512 + ch * 8) = *(const u32x4*)(P + ((size_t)b * T + sc * 256 - 3 + k) * PLD + C_XBC + ch * 8); }
}

__device__ __forceinline__ void stagger(int cid) { const int dly = __builtin_amdgcn_readfirstlane((cid >> 3) & 7); for (int i = 0; i < dly; ++i) __builtin_amdgcn_s_sleep(16); }
constexpr int LAYER_BASE0 = 1, LAYER_STRIDE = 18, MOE_BASE = LAYER_BASE0 + LAYER_STRIDE + 15;
__device__ __forceinline__ Frame lf(const Frame& F0) {
    Frame F = F0; unsigned l = (unsigned)(unsigned long long)F.lds;
    asm volatile("" : "+s"(l), "+s"(F.vcu), "+s"(F.G), "+s"(F.cid), "+s"(F.wid), "+s"(F.out), "+s"(F.ws), "+s"(F.st));
    F.lds = (LAS unsigned char*)(unsigned long long)l; return F;
}
__global__ void __launch_bounds__(512, 2) fwd(Args args) {
    extern __shared__ __attribute__((aligned(16))) unsigned char lds_raw[];
    Frame F0;
    F0.lds = (LAS unsigned char*)lds_raw;
    F0.G = gridDim.x; { const int bx = blockIdx.x; F0.vcu = (F0.G % 8 == 0) ? (bx % 8) * (F0.G / 8) + bx / 8 : bx; }
    F0.cid = blockIdx.x; F0.out = args.out; F0.ws = args.ws; F0.wid = __builtin_amdgcn_readfirstlane(threadIdx.x >> 6); F0.st = args.ws + WS_XB;
    volatile LAS unsigned* MISC = (volatile LAS unsigned*)(F0.lds + MISC_OFF);
    for (int u = threadIdx.x; u < (LDS_BYTES - LDSCTL_OFF) / 4; u += 512) ((LAS unsigned*)(F0.lds + LDSCTL_OFF))[u] = 0u;
    __syncthreads();
    if (threadIdx.x < 34) *(LAS unsigned long long*)(F0.lds + LDSCTL_OFF + 8 * threadIdx.x) = (unsigned long long)args.in[threadIdx.x];
    __syncthreads();
    const int lo = args.ph_lo, hi = args.ph_hi;
    XcdBarrier bar; bar.bar = (unsigned*)(F0.ws + WS_CTL); bar.x = 0; bar.st = nullptr;
    if (hi - lo > 1) bar = xcd_barrier_post((unsigned*)(F0.ws + WS_CTL), MISC + 8);
#define IN(k) (lo <= (k) && (k) < hi)
#define SEAM(k) do { if (IN(k) && IN((k) + 1)) xcd_barrier(bar); } while (0)
#define WSP(T_, off) ((T_*)(F.ws + (off)))

    if (IN(0)) { Frame F = lf(F0); conv_layer_weights(F, 0, 0); conv_lora(F); conv_vlora(F); xprep_phase(F, INP(0)); }
    SEAM(0);
    for (int l = 0; l < 2; ++l) {
        const int pb = LAYER_BASE0 + l * LAYER_STRIDE;
        F0.st = (unsigned char*)F0.out;
        if (IN(pb + 0)) {
            Frame F = lf(F0); unsigned char* wl = F.ws + WS_W + (size_t)l * WL_STRIDE;
            pg8::Gemm g{WSP(bf16, WS_XB), (const bf16*)(wl + WL_IN), D, D, D}; pg8::StaticOrder S; S.init(M, NP, F.G, F.cid, D, D);
            pg8::EpiInProj E{WSP(bf16, WS_BIG), (l == 0) ? WSP(float, WS_RSTD) : WSP(float, WS_SS1), WSP(float, WS_DT), l};
            stagger(F.cid); pg8::gemm_phase(F.lds, F.wid, g, S, E);
        }
        SEAM(pb + 0);
        if (IN(pb + 1)) { Frame F = lf(F0); vprep_phase(F, l); prepass_a(F); }
        SEAM(pb + 1);
        if (IN(pb + 2)) { Frame F = lf(F0); prepass_conv(F, l); }
        if (IN(pb + 2) && IN(pb + 3)) xcd_barrier(bar);
        if (IN(pb + 3)) for (int rep = 0; rep <= REP_R1; ++rep) {
#if RW_CH
            for (int r2 = 0; r2 <= REP_RW; ++r2) { Frame F = lf(F0); for (int u = F.cid; u < 1024; u += F.G) rwkv_chunk_unit<false>(F, l, u); }
#else
            { Frame F = lf(F0); if (F.cid < 16) rwkv_seq(F, l, F.cid); }
#endif
#if RET_CH
            for (int r2 = 0; r2 <= REP_RET; ++r2) { Frame F = lf(F0); for (int u = F.cid; u < 1024; u += F.G) ret_chunk_unit<false>(F, u); }
#else
            { Frame F = lf(F0); if (F.cid >= 32 && F.cid < 48) ret_seq(F, F.cid - 32); }
#endif
#if SSD_CH
            for (int r2 = 0; r2 <= REP_SSD; ++r2) { Frame F = lf(F0); for (int u = F.cid; u < 1024; u += F.G) ssd_chunk_unit<false>(F, l, u); }
#else
            { Frame F = lf(F0); if (F.cid >= 16 && F.cid < 32) ssd_seq(F, l, F.cid - 16); }
#endif
        }
        SEAM(pb + 3);
        if (IN(pb + 4)) {
            Frame F = lf(F0);
            if (F.cid < 16) { if (RW_CH) rwkv_scan_chain(F, F.cid); }
            else elem_scans(F, F.cid - 16, F.G - 16);
            if (l == 0 && F.cid >= 16) { Frame Fc = lf(F0); Fc.vcu = Fc.cid - 16; Fc.G = Fc.G - 16;
                conv_layer_weights(Fc, 0, 1); conv_layer_weights(Fc, 1, 0); conv_layer_weights(Fc, 1, 1); conv_ffn_weights(Fc); }
        }
        SEAM(pb + 4);
        if (IN(pb + 5)) {
#if RW_CH
            { Frame F = lf(F0); for (int u = F.cid; u < 1024; u += F.G) rwkv_chunk_unit<true>(F, l, u); }
#endif
#if RET_CH
            { Frame F = lf(F0); for (int u = F.cid; u < 1024; u += F.G) ret_chunk_unit<true>(F, u); }
#endif
#if SSD_CH
            { Frame F = lf(F0); for (int u = F.cid; u < 1024; u += F.G) ssd_chunk_unit<true>(F, l, u); }
#endif
        }
        SEAM(pb + 5);
        if (IN(pb + 6)) { Frame F = lf(F0); ssm_norm_phase(F, l); }
        SEAM(pb + 6);
        if (IN(pb + 7)) {
            Frame F = lf(F0); unsigned char* wl = F.ws + WS_W + (size_t)l * WL_STRIDE; bf16* P = WSP(bf16, WS_BIG);
            pg8::Gemm g{P, (const bf16*)(wl + WL_BR), PLD, 512, 512}; pg8::BranchOrder S; S.init(F.G, F.cid);
            pg8::EpiPlain E{P, WSP(bf16, WS_VMIX)};
            stagger(F.cid); pg8::gemm_phase(F.lds, F.wid, g, S, E);
        }
        SEAM(pb + 7);
        if (IN(pb + 8)) {
            Frame F = lf(F0); unsigned char* wl = F.ws + WS_W + (size_t)l * WL_STRIDE; bf16* P = WSP(bf16, WS_BIG);
            pg8::Gemm g{WSP(bf16, WS_XB), (const bf16*)(wl + WL_GATE), D, D, D}; pg8::GateOrder S; S.init(F.G, F.cid);
            pg8::EpiGateMerge E{P, WSP(const bf16, WS_VMIX), P + C_RET, PLD, (l == 0) ? WSP(float, WS_RSTD) : WSP(float, WS_SS1), l};
            stagger(F.cid); pg8::gemm_phase(F.lds, F.wid, g, S, E);
        }
        if (IN(pb + 8) && IN(pb + 13)) xcd_barrier(bar);
        if (IN(pb + 13)) {
            Frame F = lf(F0); unsigned char* wl = F.ws + WS_W + (size_t)l * WL_STRIDE; bf16* P = WSP(bf16, WS_BIG);
            pg8::Gemm g{P + C_RET, (const bf16*)(wl + WL_OUT), PLD, D, D}; pg8::StaticOrder S; S.init(M, D, F.G, F.cid, PLD, D);
            pg8::EpiResidB E{WSP(bf16, WS_XB), (l == 0) ? WSP(float, WS_SS2) : nullptr, (l == 0) ? nullptr : F.out};
            stagger(F.cid); pg8::gemm_phase(F.lds, F.wid, g, S, E);
        }
        SEAM(pb + 13);
        if (IN(pb + 14)) { Frame F = lf(F0); if (l == 1) { router_phase(F); conv_moe_weights(F); } }
        if (l == 1) SEAM(pb + 14);
        if (l == 0) {
            if (IN(pb + 15)) {
                Frame F = lf(F0);
                pg8::Gemm g{WSP(bf16, WS_XB), WSP(const bf16, WS_FFUP), D, D, D}; pg8::StaticOrder S; S.init(M, 2 * FF, F.G, F.cid, D, D);
                pg8::EpiSwiglu E{WSP(bf16, WS_ACT), FF, WSP(float, WS_SS2), 1};
                stagger(F.cid); pg8::gemm_phase(F.lds, F.wid, g, S, E);
            }
            SEAM(pb + 15);
            if (IN(pb + 16)) {
                Frame F = lf(F0);
                pg8::Gemm g{WSP(const bf16, WS_ACT), WSP(const bf16, WS_FFDN), FF, FF, FF}; pg8::StaticOrder S; S.init(M, D, F.G, F.cid, FF, FF);
                pg8::EpiResidB E{WSP(bf16, WS_XB), WSP(float, WS_SS1), nullptr};
                stagger(F.cid); pg8::gemm_phase(F.lds, F.wid, g, S, E);
            }
            if (IN(pb + 16) && IN(pb + 18)) xcd_barrier(bar);
        }
    }
    {
        const int pb = MOE_BASE;
        for (int st = 0; st < 6; ++st) {
            const int isup = (st == 0 || st == 2 || st == 3), sg = (st < 2) ? 0 : ((st == 2 || st == 4) ? 1 : 2);
            if (IN(pb + st)) {
                if (isup) {
                    Frame F = lf(F0);
                    pg8::Gemm g{WSP(bf16, WS_X8), WSP(const bf16, WS_MOEW), D / 2, D / 2, D / 2}; pg8::MoeOrder<true> S; S.init(WSP(const int, WS_CNT), WSP(const int, WS_LIST), sg, 2 * FFE, F.G, F.cid, D / 2, D / 2, MOEW_STRIDE);
                    pg8::EpiSwiglu8 E{(sg == 2) ? WSP(unsigned char, WS_ACT2) : WSP(unsigned char, WS_ACT), FFE, WSP(float, WS_RSTD)};
                    stagger(F.cid); pg8::gemm_phase<pg8::EpiSwiglu8, pg8::MoeOrder<true>, true>(F.lds, F.wid, g, S, E);
                } else {
                    Frame F = lf(F0);
                    const int ksp = (sg == 2) ? MOE_KSP : 1;
                    pg8::Gemm g{(sg == 2) ? WSP(const bf16, WS_ACT2) : WSP(const bf16, WS_ACT), WSP(const bf16, WS_MOEW + MOEW_DN), FFE / 2, FFE / 2, FFE / 2 / ksp}; pg8::MoeOrder<false> S; S.init(WSP(const int, WS_CNT), WSP(const int, WS_LIST), sg, D, F.G, F.cid, FFE / 2, FFE / 2, MOEW_STRIDE, ksp, FFE / 2 / ksp);
                    pg8::EpiMoeOut E{(sg == 0) ? WSP(bf16, WS_YP0) : (sg == 1 ? WSP(bf16, WS_YP1) : WSP(bf16, WS_YP2)), YP2_STRIDE / 2, 1.f / 1024.f};
                    stagger(F.cid); pg8::gemm_phase<pg8::EpiMoeOut, pg8::MoeOrder<false>, true>(F.lds, F.wid, g, S, E);
                }
            }
            SEAM(pb + st);
        }
        if (IN(pb + 6)) { Frame F = lf(F0); final_norm_phase(F); }
    }
#undef IN
#undef SEAM
#undef WSP
}
constexpr int LAST_PHASE = MOE_BASE + 6;
constexpr int N_PH = LAST_PHASE + 1;

extern "C" void kernel_launch(void* const* d_in, const int* in_sizes, int n_in, void* d_out, int out_size, void* d_ws, size_t ws_size, hipStream_t stream) {
    static int grid = 0;
    if (grid == 0) {
        if (n_in != 34 || out_size != M * D || ws_size < WS_END) { fprintf(stderr, "kernel_launch: unexpected problem (n_in %d out %d ws %zu need %zu)\n", n_in, out_size, ws_size, (size_t)WS_END); grid = -1; return; }
        int dev = 0, cus = 0;
        if (hipGetDevice(&dev) != hipSuccess || hipDeviceGetAttribute(&cus, hipDeviceAttributeMultiprocessorCount, dev) != hipSuccess) { grid = -1; return; }
        if (hipFuncSetAttribute((const void*)fwd, hipFuncAttributeMaxDynamicSharedMemorySize, LDS_BYTES) != hipSuccess) { fprintf(stderr, "kernel_launch: hipFuncSetAttribute failed\n"); grid = -1; return; }
        int per_cu = 0;
        if (hipOccupancyMaxActiveBlocksPerMultiprocessor(&per_cu, (const void*)fwd, 512, LDS_BYTES) != hipSuccess || per_cu < 1) fprintf(stderr, "kernel_launch: occupancy query says %d\n", per_cu);
        (void)hipGetLastError();
        grid = cus;
    }
    if (grid < 0) return;
    (void)hipMemsetAsync((char*)d_ws + WS_CTL, 0, CTL_ZERO_BYTES, stream);
    Args a{};
    for (int i = 0; i < 34; ++i) a.in[i] = (const float*)d_in[i];
    a.out = (float*)d_out; a.ws = (unsigned char*)d_ws;
#if MK_ONE_LAUNCH
    a.ph_lo = 0; a.ph_hi = N_PH;
    hipLaunchKernelGGL(fwd, dim3(grid), dim3(512), LDS_BYTES, stream, a);
#else
    for (int p = 0; p < N_PH; ++p) { a.ph_lo = p; a.ph_hi = p + 1; hipLaunchKernelGGL(fwd, dim3(grid), dim3(512), LDS_BYTES, stream, a); }
#endif
}
```

```cpp
#include <hip/hip_runtime.h>
#include <cstdio>
#include <cstdint>

#ifndef MK_ONE_LAUNCH
#define MK_ONE_LAUNCH 1
#endif

#define LAS __attribute__((address_space(3)))
#define GAS __attribute__((address_space(1)))
typedef unsigned short bf16;
typedef short bf16x8 __attribute__((ext_vector_type(8)));
typedef float f32x4 __attribute__((ext_vector_type(4)));
typedef float f32x2 __attribute__((ext_vector_type(2)));
typedef unsigned u32x4 __attribute__((ext_vector_type(4)));
typedef unsigned u32x2 __attribute__((ext_vector_type(2)));

constexpr int BATCH = 2, T = 16384, D = 1024, M = BATCH * T;
constexpr int INC = 8456;
constexpr int PLD = 5376;
constexpr int NP = 5632;
constexpr int C_RW = 0, C_Z = 1792, C_XBC = 2304, C_RET = 3328, C_RETG = 4864;
constexpr int FF = 2816, FFE = 3584, NE = 8;

constexpr size_t MiB = 1u << 20;
constexpr size_t WS_CTL = 0, CTL_ZERO_BYTES = 64 * 1024;
constexpr size_t WS_RSTD = 1 * MiB, WS_GATES = 2 * MiB, WS_DT = 3 * MiB;
constexpr size_t WS_W = 4 * MiB;
constexpr size_t WL_IN = 0, WL_GATE = 11 * MiB, WL_BR = 17 * MiB, WL_OUT = 20 * MiB, WL_STRIDE = 22 * MiB;
constexpr size_t WS_FFUP = WS_W + 44 * MiB, WS_FFDN = WS_W + 55 * MiB;
constexpr size_t WS_XB = 68 * MiB;
constexpr size_t WS_VF = 132 * MiB;
constexpr size_t WS_BIG = 164 * MiB;
constexpr size_t WS_VMIX = WS_BIG + 336 * MiB, WS_YRW = WS_BIG + 368 * MiB, WS_END = 577 * MiB;
constexpr size_t WS_MOEW_UNUSED = WS_BIG;
constexpr size_t MOEW_STRIDE = 21 * MiB / 2, MOEW_DN = 7 * MiB;
constexpr size_t MOEW_OUT = 64 * MiB;
constexpr size_t WS_X8 = WS_BIG + 88 * MiB;
constexpr int MOE_KSP = 2;
constexpr size_t WS_ACT = WS_BIG + 168 * MiB;

constexpr size_t WS_YP0 = WS_BIG, WS_YP1 = WS_BIG + 280 * MiB, WS_YP2 = 556 * MiB, YP2_STRIDE = 4 * MiB, WS_PINFO = 572 * MiB, WS_ACT2 = 132 * MiB;
constexpr size_t WS_CNT = 32768, WS_LIST = 2 * MiB;
constexpr size_t WS_BND2 = 566 * MiB;
constexpr size_t WS_VLORA = 192 * 1024;
constexpr size_t WS_SS1 = 573 * MiB, WS_SS2 = 575 * MiB;
constexpr size_t WS_DSTOT = 128 * 1024, WS_BND = 256 * 1024;
constexpr size_t WS_LORA = 1 * MiB + 512 * 1024, LORA_STRIDE = 262144;
constexpr size_t WS_ST_RW = WS_XB, WS_ST_RET = WS_XB + 16 * MiB, WS_ST_SSD = WS_XB + 32 * MiB, WS_MT = WS_YRW;
constexpr int RING_BYTES = 131072, LDSCTL_OFF = 159744, MISC_OFF = LDSCTL_OFF + 320, LDS_BYTES = 163840;
#ifndef REP_CONV
#define REP_CONV 0
#endif
#ifndef REP_R1
#define REP_R1 0
#endif
#ifndef REP_RW
#define REP_RW 0
#endif
#ifndef REP_RET
#define REP_RET 0
#endif
#ifndef REP_SSD
#define REP_SSD 0
#endif
#ifndef REP_MISC
#define REP_MISC 0
#endif
#ifndef RW_CH
#define RW_CH 1
#endif
#ifndef RET_CH
#define RET_CH 1
#endif
#ifndef SSD_CH
#define SSD_CH 1
#endif

typedef __bf16 hbf16x2 __attribute__((ext_vector_type(2)));
__device__ __forceinline__ unsigned pk2(float lo, float hi) { const f32x2 v = {lo, hi}; return __builtin_bit_cast(unsigned, __builtin_convertvector(v, hbf16x2)); }
__device__ __forceinline__ unsigned f2bf(float f) { return (unsigned)__builtin_bit_cast(unsigned short, (__bf16)f); }
__device__ __forceinline__ float bflo(unsigned u) { return __builtin_bit_cast(float, u << 16); }
__device__ __forceinline__ float bfhi(unsigned u) { return __builtin_bit_cast(float, u & 0xffff0000u); }
__device__ __forceinline__ void unpack8(const u32x4 u, float (&f)[8]) { f[0] = bflo(u.x); f[1] = bfhi(u.x); f[2] = bflo(u.y); f[3] = bfhi(u.y); f[4] = bflo(u.z); f[5] = bfhi(u.z); f[6] = bflo(u.w); f[7] = bfhi(u.w); }
__device__ __forceinline__ unsigned pk4f8(float a, float b, float c, float d) {
    a = __builtin_amdgcn_fmed3f(a, -448.f, 448.f); b = __builtin_amdgcn_fmed3f(b, -448.f, 448.f); c = __builtin_amdgcn_fmed3f(c, -448.f, 448.f); d = __builtin_amdgcn_fmed3f(d, -448.f, 448.f);
    int w = __builtin_amdgcn_cvt_pk_fp8_f32(a, b, 0, false); w = __builtin_amdgcn_cvt_pk_fp8_f32(c, d, w, true); return (unsigned)w; }
__device__ __forceinline__ u32x4 pack8(const float (&f)[8]) { u32x4 w; w.x = pk2(f[0], f[1]); w.y = pk2(f[2], f[3]); w.z = pk2(f[4], f[5]); w.w = pk2(f[6], f[7]); return w; }
__device__ __forceinline__ float sigm(float x) { return __builtin_amdgcn_rcpf(1.f + __expf(-x)); }
__device__ __forceinline__ float silu(float x) { return x * __builtin_amdgcn_rcpf(1.f + __expf(-x)); }
__device__ __forceinline__ float ex2(float x) { return __builtin_amdgcn_exp2f(x); }
__device__ __forceinline__ float fast_tanh(float x) { return 1.f - 2.f * __builtin_amdgcn_rcpf(1.f + __expf(2.f * x)); }
__device__ __forceinline__ float softplus_acc(float x) { return fmaxf(x, 0.f) + log1pf(expf(-fabsf(x))); }
__device__ __forceinline__ float wave_sum(float v) {
#pragma unroll
    for (int o = 1; o < 64; o <<= 1) v += __shfl_xor(v, o);
    return v;
}
__device__ __forceinline__ int otid_w(int wid) { unsigned z = 0u; asm volatile("" : "+v"(z)); int t = wid * 64 + (int)__builtin_amdgcn_mbcnt_hi(~0u, __builtin_amdgcn_mbcnt_lo(~0u, z)); asm volatile("" : "+v"(t)); return t; }
#define otid() otid_w(F.wid)
__device__ __forceinline__ int fresh_tid(int t) { asm volatile("" : "+v"(t)); return t; }
#define LDS_WAIT() asm volatile("s_waitcnt lgkmcnt(0)" ::: "memory")

namespace pg8 {
constexpr int BM = 256, BK = 64, HALF = 128, HTB = HALF * BK * 2, STAGE_BYTES = 8 * HTB, NXCD = 8, WGM = 8;
__host__ __device__ __forceinline__ int lds_byte(int r, int c) { const int st = (r >> 4) * 2 + (c >> 5), rr = r & 15, cc = c & 31, ob = rr * 64 + cc * 2; return st * 1024 + (ob ^ (((ob >> 9) & 1) << 5)); }
__host__ __device__ __forceinline__ void stage_rc(int b, int& R, int& C) { const int st = b / 1024, sb = b % 1024, swz = sb ^ (((sb >> 9) & 1) << 5); R = (st >> 1) * 16 + swz / 64; C = (st & 1) * 32 + (swz % 64) / 2; }
__host__ __device__ __forceinline__ int perm32(int rho) { const int n = rho >> 4, i = rho & 15; return 8 * (i >> 2) + 4 * n + (i & 3); }

typedef int i32x4v __attribute__((ext_vector_type(4)));
struct Unit { int pm, pn; size_t aofs, bofs; const int* rows; int nvalid, e, ks; };
struct Gemm { const bf16* A; const bf16* Bt; int lda, ldb, K; };

struct StaticOrder {
    static constexpr bool GATHER = false;
    int nM, nN, nwg, G, c; size_t tsA, tsB;
    __device__ __forceinline__ void init(int Mrows, int N, int G_, int c_, int lda, int ldb) { nM = Mrows / BM; nN = N / BM; nwg = nM * nN; G = G_; c = c_; tsA = (size_t)BM * lda * 2; tsB = (size_t)BM * ldb * 2; }
    __device__ __forceinline__ void tile(int L, int& pm, int& pn) const {
        int wgid = L; { const int q = nwg / NXCD, r = nwg % NXCD, xcd = wgid % NXCD, off = wgid / NXCD; wgid = (xcd < r ? xcd * (q + 1) : r * (q + 1) + (xcd - r) * q) + off; }
        const int nig = WGM * nN, gid = wgid / nig, fm = gid * WGM, gsz = (nM - fm) < WGM ? (nM - fm) : WGM;
        pm = fm + ((wgid % nig) % gsz); pn = (wgid % nig) / gsz;
    }
    __device__ __forceinline__ bool next(int i, Unit& u) const {
        const long L = (long)i * G + c; if (L >= nwg) return false;
        tile((int)L, u.pm, u.pn); u.aofs = (size_t)u.pm * tsA; u.bofs = (size_t)u.pn * tsB; u.rows = nullptr; u.nvalid = BM; u.e = 0; u.ks = 0; return true;
    }
};
struct BranchOrder {
    static constexpr bool GATHER = false;
    StaticOrder so;
    __device__ __forceinline__ void init(int G_, int c_) { so.init(M, D, G_, c_, PLD, 512); }
    __device__ __forceinline__ bool next(int j, Unit& u) const {
        const long L = (long)j * so.G + so.c; if (L >= 3 * so.nwg) return false;
        const int i = (int)(L / so.nwg); so.tile((int)(L % so.nwg), u.pm, u.pn);
        const int acol = (i == 0) ? 1024 : (i == 1 ? C_Z : C_RETG);
        u.aofs = (size_t)u.pm * so.tsA + (size_t)acol * 2; u.bofs = ((size_t)i * D + (size_t)u.pn * BM) * 512 * 2; u.rows = nullptr; u.nvalid = BM; u.e = i; u.ks = 0; return true;
    }
};
struct GateOrder {
    static constexpr bool GATHER = false;
    StaticOrder so;
    __device__ __forceinline__ void init(int G_, int c_) { so.init(M, D, G_, c_, D, D); }
    __device__ __forceinline__ bool next(int j, Unit& u) const {
        const long tt = (long)(j / 3) * so.G + so.c; if (tt >= so.nwg) return false;
        const int i = j % 3; so.tile((int)tt, u.pm, u.pn);
        u.aofs = (size_t)u.pm * so.tsA; u.bofs = ((size_t)i * D + (size_t)u.pn * BM) * D * 2; u.rows = nullptr; u.nvalid = BM; u.e = i; u.ks = 0; return true;
    }
};
template <bool GATH> struct MoeOrder {
    static constexpr bool GATHER = GATH;
    unsigned q0, q1, q2, q3;
    int seg, nN, G, c, ksplit; const int* list; size_t bstride, b6, b7, tsB, tsA, kbytes;
    __device__ __forceinline__ void init(const int* counts, const int* list_, int seg_, int N, int G_, int c_, int lda, int ldb, size_t bstride_, size_t b6_, size_t b7_, int ksplit_ = 1, int kpart = 0) {
        unsigned n[8];
#pragma unroll
        for (int e = 0; e < 8; ++e) { int v = __builtin_amdgcn_readfirstlane(counts[e]); v = v < 0 ? 0 : (v > 32768 ? 32768 : v); n[e] = (unsigned)v; }
        q0 = n[0] | (n[1] << 16); q1 = n[2] | (n[3] << 16); q2 = n[4] | (n[5] << 16); q3 = n[6] | (n[7] << 16);
        seg = seg_; nN = N / BM; G = G_; c = c_; list = list_; bstride = bstride_; b6 = b6_; b7 = b7_; tsB = (size_t)BM * ldb * 2; tsA = (size_t)BM * lda * 2; ksplit = ksplit_; kbytes = (size_t)kpart * 2;
    }
    __device__ __forceinline__ bool next(int i, Unit& u) const {
        const unsigned L0 = (unsigned)i * (unsigned)G + (unsigned)c; const unsigned L = L0 / (unsigned)ksplit; const int ks = (int)(L0 - L * (unsigned)ksplit); const int tl = (int)(L / (unsigned)nN), pn = (int)(L - (unsigned)tl * (unsigned)nN), gt = seg * 128 + tl;
        int t = 0, e = 0, tbe = 0, cne = 0;
#pragma unroll
        for (int k = 0; k < 8; ++k) { const unsigned q = (k < 2) ? q0 : (k < 4) ? q1 : (k < 6) ? q2 : q3; const int n = (int)((k & 1) ? (q >> 16) : (q & 0xffffu));
            if (gt >= t) { e = k; tbe = t; cne = n; } t += (n + 255) >> 8; }
        int nt = t - seg * 128; nt = nt < 0 ? 0 : (nt > 128 ? 128 : nt);
        if (L >= (unsigned)(nt * nN)) return false;
        const int rt = gt - tbe;
        u.pm = tl; u.pn = pn; u.e = e; u.ks = ks; u.bofs = (e < 6 ? (size_t)e * bstride : (e == 6 ? b6 : b7)) + (size_t)pn * tsB + ks * kbytes; u.aofs = (GATH ? 0 : (size_t)tl * tsA) + ks * kbytes;
        u.rows = list + ((size_t)e * 32768 + rt * 256) * 2; int nv = cne - rt * 256; u.nvalid = nv > 256 ? 256 : nv; return true;
    }
};

template <class Epi, class Sched, bool F8 = false>
__device__ __forceinline__ void gemm_phase(LAS unsigned char* lds, int wid0, const Gemm g, const Sched& S, const Epi& E) {
    constexpr bool GATHER = Sched::GATHER;
    const int tid = otid_w(wid0), wid = __builtin_amdgcn_readfirstlane(tid >> 6), lane = tid & 63, wr = wid >> 2, wc = wid & 3, fr = lane & 15, fq = lane >> 4;
    const int nt = g.K / BK;
    unsigned voffA[2], voffB[2];
#pragma unroll
    for (int i = 0; i < 2; ++i) { int R, C; stage_rc(tid * 16 + i * 8192, R, C); const int Rb = Epi::PERM ? ((R & ~31) + perm32(R & 31)) : R;
        voffA[i] = (unsigned)(R * g.lda + C) * 2u; voffB[i] = (unsigned)(Rb * g.ldb + C) * 2u; }
    const size_t kstep = (size_t)(BK * 2);
    const size_t hstepA = GATHER ? 0 : (size_t)HALF * g.lda * 2, hstepB = (size_t)HALF * g.ldb * 2;
    const unsigned ldsw = (unsigned)wid * 1024u;
    const int aoff = lds_byte(wr * 64 + fr, fq * 8), boff = lds_byte(wc * 32 + fr, fq * 8);
#define PG8_SA(b, h) (((b) * 2 + (h)) * HTB)
#define PG8_SB(b, h) ((4 + (b) * 2 + (h)) * HTB)
#define PG8_STAGE2(bufoff, gbase, o0, o1) do { \
        __builtin_amdgcn_global_load_lds((const unsigned*)((const char*)(gbase) + (o0)), (LAS unsigned*)(lds + (bufoff) + ldsw), 16, 0, 0); \
        __builtin_amdgcn_global_load_lds((const unsigned*)((const char*)(gbase) + (o1)), (LAS unsigned*)(lds + (bufoff) + ldsw + 8192), 16, 0, 0); } while (0)
#define PG8_STAGE(bufoff, gbase, voff) PG8_STAGE2(bufoff, gbase, (voff)[0], (voff)[1])
#define PG8_LDA(dst, b, h) do { _Pragma("unroll") for (int m = 0; m < 4; ++m) _Pragma("unroll") for (int k = 0; k < 2; ++k) dst[m][k] = *(const LAS bf16x8*)(lds + PG8_SA(b, h) + aoff + m * 2048 + k * 1024); } while (0)
#define PG8_LDB(dst, b, h) do { _Pragma("unroll") for (int n = 0; n < 2; ++n) _Pragma("unroll") for (int k = 0; k < 2; ++k) dst[n][k] = *(const LAS bf16x8*)(lds + PG8_SB(b, h) + boff + n * 2048 + k * 1024); } while (0)
#define PG8_CAT(x) __builtin_shufflevector(__builtin_bit_cast(i32x4v, (x)[0]), __builtin_bit_cast(i32x4v, (x)[1]), 0, 1, 2, 3, 4, 5, 6, 7)
#define PG8_MMA(ai, bj, At, Bt) do { __builtin_amdgcn_s_setprio(1); if constexpr (F8) { _Pragma("unroll") for (int m = 0; m < 4; ++m) _Pragma("unroll") for (int n = 0; n < 2; ++n) \
        asm volatile("v_mfma_f32_16x16x128_f8f6f4 %0, %1, %2, %0" : "+v"(acc[ai][bj][m][n]) : "v"(PG8_CAT(Bt[n])), "v"(PG8_CAT(At[m]))); } else { \
        _Pragma("unroll") for (int m = 0; m < 4; ++m) _Pragma("unroll") for (int n = 0; n < 2; ++n) _Pragma("unroll") for (int k = 0; k < 2; ++k) \
        acc[ai][bj][m][n] = Epi::TRANS ? __builtin_amdgcn_mfma_f32_16x16x32_bf16(Bt[n][k], At[m][k], acc[ai][bj][m][n], 0, 0, 0) : __builtin_amdgcn_mfma_f32_16x16x32_bf16(At[m][k], Bt[n][k], acc[ai][bj][m][n], 0, 0, 0); } __builtin_amdgcn_s_setprio(0); } while (0)
#define PG8_WAIT_V(n) asm volatile("s_waitcnt vmcnt(" #n ")" ::: "memory")
#define PG8_WAIT_L(n) asm volatile("s_waitcnt lgkmcnt(" #n ")" ::: "memory")
#define PG8_BAR __builtin_amdgcn_s_barrier()
#define PG8_SCHED __builtin_amdgcn_sched_barrier(0)
#define GSLOT(which) ((LAS u32x4*)(lds + 131072 + (which) * 8192 + tid * 16))
#define PG8_ROWS(u, which) do { const int _ft = fresh_tid(tid); unsigned _vg[2][2]; _Pragma("unroll") for (int _i = 0; _i < 2; ++_i) { int _R, _C; stage_rc(_ft * 16 + _i * 8192, _R, _C); \
        _Pragma("unroll") for (int _h = 0; _h < 2; ++_h) { const int _r = _h * HALF + _R; \
        const int _t = (_r < (u).nvalid) ? (u).rows[2 * _r] : 0; _vg[_h][_i] = ((unsigned)_t * (unsigned)g.lda + (unsigned)_C) * 2u; } } \
        u32x4 _o; _o.x = _vg[0][0]; _o.y = _vg[0][1]; _o.z = _vg[1][0]; _o.w = _vg[1][1]; *GSLOT(which) = _o; } while (0)
    Unit cur, nxt; int ui = 0;
    if (!S.next(0, cur)) return;
    f32x4 acc[2][2][4][2];
#pragma unroll
    for (int a = 0; a < 2; ++a)
#pragma unroll
        for (int b = 0; b < 2; ++b)
#pragma unroll
            for (int m = 0; m < 4; ++m)
#pragma unroll
                for (int n = 0; n < 2; ++n) acc[a][b][m][n] = (f32x4){0.f, 0.f, 0.f, 0.f};
    bf16x8 At[4][2], B0[2][2], B1[2][2];
    u32x4 gc = {voffA[0], voffA[1], voffA[0], voffA[1]};
    if constexpr (GATHER) { PG8_ROWS(cur, 0); PG8_ROWS(cur, 1); gc = *GSLOT(0); }
#define VGC(h, i) (gc[2 * (h) + (i)])
    const char* cA = (const char*)g.A + cur.aofs; const char* cB = (const char*)g.Bt + cur.bofs;
    PG8_STAGE(PG8_SB(0, 0), cB, voffB); PG8_STAGE(PG8_SB(0, 1), cB + hstepB, voffB); PG8_STAGE2(PG8_SA(0, 0), cA, VGC(0, 0), VGC(0, 1)); PG8_STAGE2(PG8_SA(0, 1), cA + hstepA, VGC(1, 0), VGC(1, 1));
    if (wr == 1) PG8_BAR;
    PG8_WAIT_V(2); PG8_BAR;
    PG8_STAGE(PG8_SB(1, 0), cB + kstep, voffB); PG8_STAGE2(PG8_SA(1, 0), cA + kstep, VGC(0, 0), VGC(0, 1)); PG8_STAGE(PG8_SB(1, 1), cB + hstepB + kstep, voffB);
    PG8_WAIT_V(6); PG8_BAR;
    for (;;) {
        const bool has_next = S.next(ui + 1, nxt);
        const char* nA = has_next ? (const char*)g.A + nxt.aofs : cA; const char* nB = has_next ? (const char*)g.Bt + nxt.bofs : cB;
        if constexpr (GATHER) { if (has_next) PG8_ROWS(nxt, 1); else *GSLOT(1) = *GSLOT(0); }
        for (int t = 0; t < nt; t += 2) {
            const bool last = (t == nt - 2);
            const char* a1 = cA + (size_t)(t + 1) * kstep;
            const char* a2 = last ? nA : cA + (size_t)(t + 2) * kstep; const char* b2 = last ? nB : cB + (size_t)(t + 2) * kstep;
            const char* a3 = a2 + kstep; const char* b3 = b2 + kstep;
            u32x4 gn = gc; if constexpr (GATHER) { gc = *GSLOT(0); gn = last ? *GSLOT(1) : gc; }
            const unsigned s00 = gn.x, s01 = gn.y, s10 = gn.z, s11 = gn.w;
            PG8_LDB(B0, 0, 0); PG8_LDB(B1, 0, 1); PG8_SCHED; PG8_LDA(At, 0, 0); PG8_STAGE2(PG8_SA(1, 1), a1 + hstepA, VGC(1, 0), VGC(1, 1));
            PG8_WAIT_V(8); PG8_WAIT_L(0); PG8_BAR; PG8_MMA(0, 0, At, B0); PG8_MMA(0, 1, At, B1); PG8_BAR; PG8_SCHED;
            PG8_LDA(At, 0, 1); PG8_STAGE(PG8_SB(0, 0), b2, voffB); PG8_STAGE(PG8_SB(0, 1), b2 + hstepB, voffB); PG8_STAGE2(PG8_SA(0, 0), a2, s00, s01);
            PG8_WAIT_V(8); PG8_WAIT_L(0); PG8_BAR; PG8_MMA(1, 0, At, B0); PG8_MMA(1, 1, At, B1); PG8_BAR; PG8_SCHED;
            PG8_LDB(B0, 1, 0); PG8_LDB(B1, 1, 1); PG8_SCHED; PG8_LDA(At, 1, 0); PG8_STAGE2(PG8_SA(0, 1), a2 + hstepA, s10, s11);
            PG8_WAIT_V(8); PG8_WAIT_L(0); PG8_BAR; PG8_MMA(0, 0, At, B0); PG8_MMA(0, 1, At, B1); PG8_BAR; PG8_SCHED;
            PG8_LDA(At, 1, 1); PG8_STAGE(PG8_SB(1, 0), b3, voffB); PG8_STAGE(PG8_SB(1, 1), b3 + hstepB, voffB); PG8_STAGE2(PG8_SA(1, 0), a3, s00, s01);
            PG8_WAIT_V(8); PG8_WAIT_L(0); PG8_BAR; PG8_MMA(1, 0, At, B0); PG8_MMA(1, 1, At, B1); PG8_BAR; PG8_SCHED;
        }
        if (wr == 0) PG8_BAR;
        if constexpr (F8) asm volatile("s_nop 15\n\ts_nop 15" ::: "memory");
        E(acc, cur, wr, wc, fr, fq);
        if (!has_next) break;
#pragma unroll
        for (int a = 0; a < 2; ++a)
#pragma unroll
            for (int b = 0; b < 2; ++b)
#pragma unroll
                for (int m = 0; m < 4; ++m)
#pragma unroll
                    for (int n = 0; n < 2; ++n) acc[a][b][m][n] = (f32x4){0.f, 0.f, 0.f, 0.f};
        cur = nxt; cA = nA; cB = nB; ++ui;
        if constexpr (GATHER) { *GSLOT(0) = *GSLOT(1); }
        if (wr == 1) PG8_BAR;
    }
    PG8_WAIT_V(0);
    PG8_BAR;
#undef PG8_SA
#undef PG8_SB
#undef PG8_STAGE
#undef PG8_STAGE2
#undef PG8_ROWS
#undef GSLOT
#undef VGC
#undef PG8_LDA
#undef PG8_LDB
#undef PG8_MMA
#undef PG8_CAT
#undef PG8_WAIT_V
#undef PG8_WAIT_L
#undef PG8_BAR
#undef PG8_SCHED
}

typedef const f32x4 (&AccRef)[2][2][4][2];
__device__ __forceinline__ float ss16(const float* p) { const f32x4 a = *(const f32x4*)p, b = *(const f32x4*)(p + 4), c = *(const f32x4*)(p + 8), d = *(const f32x4*)(p + 12);
    return (((a[0] + a[1]) + (a[2] + a[3])) + ((b[0] + b[1]) + (b[2] + b[3]))) + (((c[0] + c[1]) + (c[2] + c[3])) + ((d[0] + d[1]) + (d[2] + d[3]))); }
__device__ __forceinline__ float rs_of(const float* rstd, int ssmode, int row) { return ssmode ? __builtin_amdgcn_rsqf(ss16(rstd + (size_t)row * 16) * (1.f / D) + 1e-6f) : rstd[row]; }

struct EpiInProj {
    static constexpr bool PERM = true, TRANS = true;
    bf16* P; const float* rstd; float* dt; int ssmode;
    __device__ __forceinline__ void operator()(AccRef acc, const Unit& u, int wr, int wc, int fr, int fq) const {
        const int row0 = u.pm * BM + wr * 64 + fr;
        float scl[2][4];
#pragma unroll
        for (int ai = 0; ai < 2; ++ai)
#pragma unroll
            for (int m = 0; m < 4; ++m) scl[ai][m] = rs_of(rstd, ssmode, row0 + ai * HALF + m * 16);
        if (u.pn < 21) {
            const int col0 = u.pn * BM + wc * 32 + 8 * fq;
#pragma unroll
            for (int ai = 0; ai < 2; ++ai)
#pragma unroll
                for (int m = 0; m < 4; ++m) { const int row = row0 + ai * HALF + m * 16; const float s = scl[ai][m]; bf16* rowp = P + (size_t)row * PLD + col0;
#pragma unroll
                    for (int bj = 0; bj < 2; ++bj) { const f32x4 v0 = acc[ai][bj][m][0] * s, v1 = acc[ai][bj][m][1] * s;
                        u32x4 w; w.x = pk2(v0[0], v0[1]); w.y = pk2(v0[2], v0[3]); w.z = pk2(v1[0], v1[1]); w.w = pk2(v1[2], v1[3]);
                        *(u32x4*)(rowp + bj * HALF) = w; } }
        } else if (wc == 0 && fq == 0) {
#pragma unroll
            for (int ai = 0; ai < 2; ++ai)
#pragma unroll
                for (int m = 0; m < 4; ++m) { const int row = row0 + ai * HALF + m * 16; const float s = scl[ai][m];
                    *(f32x4*)(dt + (size_t)row * 8) = acc[ai][0][m][0] * s; *(f32x4*)(dt + (size_t)row * 8 + 4) = acc[ai][0][m][1] * s; }
        }
    }
};
struct EpiPlain {
    static constexpr bool PERM = true, TRANS = true;
    bf16* P; bf16* Y2;
    __device__ __forceinline__ void operator()(AccRef acc, const Unit& u, int wr, int wc, int fr, int fq) const {
        bf16* O = (u.e == 0) ? P : (u.e == 1 ? P + C_XBC : Y2); const int ldc = (u.e == 2) ? D : PLD;
        const int row0 = u.pm * BM + wr * 64 + fr, col0 = u.pn * BM + wc * 32 + 8 * fq;
#pragma unroll
        for (int ai = 0; ai < 2; ++ai)
#pragma unroll
            for (int m = 0; m < 4; ++m) { bf16* rowp = O + (size_t)(row0 + ai * HALF + m * 16) * ldc + col0;
#pragma unroll
                for (int bj = 0; bj < 2; ++bj) { const f32x4 v0 = acc[ai][bj][m][0], v1 = acc[ai][bj][m][1];
                    u32x4 w; w.x = pk2(v0[0], v0[1]); w.y = pk2(v0[2], v0[3]); w.z = pk2(v1[0], v1[1]); w.w = pk2(v1[2], v1[3]);
                    *(u32x4*)(rowp + bj * HALF) = w; } }
    }
};
struct EpiGateMerge {
    static constexpr bool PERM = true, TRANS = true;
    const bf16* P; const bf16* Y2; bf16* Mg; int ldm; const float* rstd; int ssmode;
    __device__ __forceinline__ void operator()(AccRef acc, const Unit& u, int wr, int wc, int fr, int fq) const {
        asm volatile("" : "+v"(fr), "+v"(fq));
        const bf16* Y = (u.e == 0) ? P : (u.e == 1 ? P + C_XBC : Y2); const int ldy = (u.e == 2) ? D : PLD; const int first = (u.e == 0);
        const int row0 = u.pm * BM + wr * 64 + fr, col0 = u.pn * BM + wc * 32 + 8 * fq;
#pragma unroll
        for (int ai = 0; ai < 2; ++ai) {
            u32x4 yv[4][2], mv[4][2]; float sc[4];
#pragma unroll
            for (int m = 0; m < 4; ++m) { const int row = row0 + ai * HALF + m * 16; sc[m] = rs_of(rstd, ssmode, row);
#pragma unroll
                for (int bj = 0; bj < 2; ++bj) { yv[m][bj] = *(const u32x4*)(Y + (size_t)row * ldy + col0 + bj * HALF);
                    mv[m][bj] = first ? (u32x4){0u, 0u, 0u, 0u} : *(const u32x4*)(Mg + (size_t)row * ldm + col0 + bj * HALF); } }
#pragma unroll
            for (int m = 0; m < 4; ++m) { const int row = row0 + ai * HALF + m * 16;
#pragma unroll
                for (int bj = 0; bj < 2; ++bj) { float y[8], p[8], o[8]; unpack8(yv[m][bj], y); unpack8(mv[m][bj], p);
                    const f32x4 v0 = acc[ai][bj][m][0] * sc[m], v1 = acc[ai][bj][m][1] * sc[m];
#pragma unroll
                    for (int j = 0; j < 4; ++j) { o[j] = sigm(v0[j]) * y[j] + p[j]; o[4 + j] = sigm(v1[j]) * y[4 + j] + p[4 + j]; }
                    *(u32x4*)(Mg + (size_t)row * ldm + col0 + bj * HALF) = pack8(o); } }
        }
    }
};
struct EpiResid {
    static constexpr bool PERM = false, TRANS = true;
    const float* xin; float* xout; const float* gates; int e;
    __device__ __forceinline__ void operator()(AccRef acc, const Unit& u, int wr, int wc, int fr, int fq) const {
        const int row0 = u.pm * BM + wr * 64 + fr, col0 = u.pn * BM + wc * 32 + 4 * fq;
#pragma unroll
        for (int ai = 0; ai < 2; ++ai)
#pragma unroll
            for (int m = 0; m < 4; ++m) { const int row = row0 + ai * HALF + m * 16; const float s = gates ? gates[(size_t)row * 8 + e] : 1.f;
                const float* ip = xin + (size_t)row * D + col0; float* op = xout + (size_t)row * D + col0;
#pragma unroll
                for (int bj = 0; bj < 2; ++bj)
#pragma unroll
                    for (int n = 0; n < 2; ++n) *(f32x4*)(op + bj * HALF + n * 16) = *(const f32x4*)(ip + bj * HALF + n * 16) + acc[ai][bj][m][n] * s; }
    }
};
struct EpiResidB {
    static constexpr bool PERM = true, TRANS = true;
    bf16* xb; float* SS; float* xf;
    __device__ __forceinline__ void operator()(AccRef acc, const Unit& u, int wr, int wc, int fr, int fq) const {
        asm volatile("" : "+v"(fr), "+v"(fq));
        const int row0 = u.pm * BM + wr * 64 + fr, col0 = u.pn * BM + wc * 32 + 8 * fq;
#pragma unroll
        for (int ai = 0; ai < 2; ++ai) {
            u32x4 xv[4][2];
#pragma unroll
            for (int m = 0; m < 4; ++m)
#pragma unroll
                for (int bj = 0; bj < 2; ++bj) xv[m][bj] = *(const u32x4*)(xb + (size_t)(row0 + ai * HALF + m * 16) * D + col0 + bj * HALF);
#pragma unroll
            for (int m = 0; m < 4; ++m) { const int row = row0 + ai * HALF + m * 16; bf16* rowp = xb + (size_t)row * D + col0; float ss = 0.f;
#pragma unroll
                for (int bj = 0; bj < 2; ++bj) { float v[8]; unpack8(xv[m][bj], v);
#pragma unroll
                    for (int j = 0; j < 4; ++j) { v[j] += acc[ai][bj][m][0][j]; v[4 + j] += acc[ai][bj][m][1][j]; }
                    *(u32x4*)(rowp + bj * HALF) = pack8(v);
                    if (xf) { float* fp = xf + (size_t)row * D + col0 + bj * HALF; *(f32x4*)fp = (f32x4){v[0], v[1], v[2], v[3]}; *(f32x4*)(fp + 4) = (f32x4){v[4], v[5], v[6], v[7]}; }
#pragma unroll
                    for (int j = 0; j < 8; ++j) ss += v[j] * v[j]; }
                if (SS) { ss += __shfl_xor(ss, 16); ss += __shfl_xor(ss, 32); if (fq == 0) SS[(size_t)row * 16 + u.pn * 4 + wc] = ss; } }
        }
    }
};
struct EpiSwiglu {
    static constexpr bool PERM = true, TRANS = true;
    bf16* act; int ldc; const float* rstd; int ssmode;
    __device__ __forceinline__ void operator()(AccRef acc, const Unit& u, int wr, int wc, int fr, int fq) const {
        asm volatile("" : "+v"(fr), "+v"(fq));
        const int row0 = u.pm * BM + wr * 64 + fr, col0 = u.pn * HALF + wc * 32 + 8 * fq;
        float scl[2][4];
        if (u.rows) { int tk[2][4];
#pragma unroll
            for (int ai = 0; ai < 2; ++ai)
#pragma unroll
                for (int m = 0; m < 4; ++m) { const int lr = wr * 64 + fr + ai * HALF + m * 16; tk[ai][m] = (lr < u.nvalid) ? u.rows[2 * lr] : 0; }
#pragma unroll
            for (int ai = 0; ai < 2; ++ai)
#pragma unroll
                for (int m = 0; m < 4; ++m) scl[ai][m] = rstd[tk[ai][m]];
        } else {
#pragma unroll
            for (int ai = 0; ai < 2; ++ai)
#pragma unroll
                for (int m = 0; m < 4; ++m) scl[ai][m] = rs_of(rstd, ssmode, row0 + ai * HALF + m * 16); }
#pragma unroll
        for (int ai = 0; ai < 2; ++ai)
#pragma unroll
            for (int m = 0; m < 4; ++m) { const int row = row0 + ai * HALF + m * 16;
                const float s = scl[ai][m];
                float o[8];
#pragma unroll
                for (int n = 0; n < 2; ++n)
#pragma unroll
                    for (int j = 0; j < 4; ++j) o[4 * n + j] = silu(acc[ai][0][m][n][j] * s) * (acc[ai][1][m][n][j] * s);
                *(u32x4*)(act + (size_t)row * ldc + col0) = pack8(o); }
    }
};
struct EpiSwiglu8 {
    static constexpr bool PERM = true, TRANS = true;
    unsigned char* act; int ldc;
    __device__ __forceinline__ void operator()(AccRef acc, const Unit& u, int wr, int wc, int fr, int fq) const {
        asm volatile("" : "+v"(fr), "+v"(fq));
        const int row0 = u.pm * BM + wr * 64 + fr, col0 = u.pn * HALF + wc * 32 + 8 * fq;
        const float s = 1.f / 256.f, s8 = 8.f / 256.f;
#pragma unroll
        for (int ai = 0; ai < 2; ++ai)
#pragma unroll
            for (int m = 0; m < 4; ++m) { const int row = row0 + ai * HALF + m * 16;
                float o[8];
#pragma unroll
                for (int n = 0; n < 2; ++n)
#pragma unroll
                    for (int j = 0; j < 4; ++j) o[4 * n + j] = silu(acc[ai][0][m][n][j] * s) * (acc[ai][1][m][n][j] * s8);
                u32x2 w; w.x = pk4f8(o[0], o[1], o[2], o[3]); w.y = pk4f8(o[4], o[5], o[6], o[7]);
                *(u32x2*)(act + (size_t)row * ldc + col0) = w; }
    }
};
struct EpiMoeOut {
    static constexpr bool PERM = true, TRANS = true;
    bf16* Y; size_t kstride; float mul;
    __device__ __forceinline__ void operator()(AccRef acc, const Unit& u, int wr, int wc, int fr, int fq) const {
        const int row0 = u.pm * BM + wr * 64 + fr, col0 = u.pn * BM + wc * 32 + 8 * fq; bf16* O = Y + (size_t)u.ks * kstride;
#pragma unroll
        for (int ai = 0; ai < 2; ++ai)
#pragma unroll
            for (int m = 0; m < 4; ++m) { bf16* rowp = O + (size_t)(row0 + ai * HALF + m * 16) * D + col0;
#pragma unroll
                for (int bj = 0; bj < 2; ++bj) { const f32x4 v0 = acc[ai][bj][m][0] * mul, v1 = acc[ai][bj][m][1] * mul;
                    u32x4 w; w.x = pk2(v0[0], v0[1]); w.y = pk2(v0[2], v0[3]); w.z = pk2(v1[0], v1[1]); w.w = pk2(v1[2], v1[3]);
                    *(u32x4*)(rowp + bj * HALF) = w; } }
    }
};
}

#define XB_TMO      128
#define XB_XCNT(j)  (256  + 64 * (j))
#define XB_XSUB(j)  (1280 + 64 * (j))
#define XB_XGEN(j)  (2304 + 64 * (j))
#define XB_TOP      3328
#define XB_TOPGEN   3392
#define XCD_BAR_WORDS 3456
#define XB_SPIN_CAP (1u << 18)

__device__ __forceinline__ unsigned xb_ld(unsigned* p)              { return __hip_atomic_load(p, __ATOMIC_RELAXED, __HIP_MEMORY_SCOPE_AGENT); }
__device__ __forceinline__ unsigned xb_add(unsigned* p, unsigned v) { return __hip_atomic_fetch_add(p, v, __ATOMIC_RELAXED, __HIP_MEMORY_SCOPE_AGENT); }
__device__ __forceinline__ unsigned xb_xcc_id() { return (unsigned)__builtin_amdgcn_s_getreg((3 << 11) | 20) & 0xFu; }
#define XB_SPIN(cond, bar) do { unsigned _sp = 0; while (cond) { __builtin_amdgcn_s_sleep(1); \
    if ((++_sp & 255u) == 0u) { if (xb_ld(&(bar)[XB_TMO])) break; if (_sp > XB_SPIN_CAP) { atomicAdd(&(bar)[XB_TMO], 1u); break; } } } } while (0)

struct XcdBarrier { unsigned* bar; unsigned x; volatile LAS unsigned* st; };

__device__ __forceinline__ XcdBarrier xcd_barrier_post(unsigned* bar, volatile LAS unsigned* st) {
    XcdBarrier b; b.bar = bar; b.x = xb_xcc_id(); b.st = st;
    if (threadIdx.x == 0) (void)xb_add(&bar[XB_XCNT(b.x)], 1u);
    return b;
}
__device__ __forceinline__ void xcd_barrier_complete(unsigned* bar, unsigned x, unsigned& nloc, unsigned& nx) {
    const unsigned G = gridDim.x * gridDim.y * gridDim.z;
    unsigned sum, cnt, mine, sp = 0u;
    for (;;) {
        sum = 0u; cnt = 0u; mine = 0u;
#pragma unroll
        for (unsigned j = 0; j < 16; ++j) { const unsigned c = xb_ld(&bar[XB_XCNT(j)]); sum += c; cnt += (c > 0u) ? 1u : 0u; mine = (j == x) ? c : mine; }
        if (sum == G) break;
        __builtin_amdgcn_s_sleep(1);
        if ((++sp & 255u) == 0u) { if (xb_ld(&bar[XB_TMO])) break; if (sp > XB_SPIN_CAP) { atomicAdd(&bar[XB_TMO], 1u); break; } }
    }
    nloc = mine > 0u ? mine : 1u; nx = cnt > 0u ? cnt : 1u;
}
__device__ __forceinline__ void xcd_barrier(const XcdBarrier& b) {
    asm volatile("s_waitcnt vmcnt(0)" ::: "memory");
    __syncthreads();
    if (threadIdx.x == 0) {
        unsigned* bar = b.bar;
        __builtin_amdgcn_s_waitcnt(0);
        unsigned nloc = b.st[0], nx = b.st[1];
        if (nloc == 0u) { xcd_barrier_complete(bar, b.x, nloc, nx); b.st[0] = nloc; b.st[1] = nx; }
        const unsigned old = xb_add(&bar[XB_XSUB(b.x)], 1u);
        const unsigned gen = old / nloc;
        if (old + 1u == (gen + 1u) * nloc) {
            __builtin_amdgcn_fence(__ATOMIC_RELEASE, "agent");
            asm volatile("s_waitcnt vmcnt(0)" ::: "memory");
            const unsigned og = xb_add(&bar[XB_TOP], 1u);
            const unsigned tg = og / nx;
            if (og + 1u == (tg + 1u) * nx) xb_add(&bar[XB_TOPGEN], 1u);
            else XB_SPIN(xb_ld(&bar[XB_TOPGEN]) == tg, bar);
            __builtin_amdgcn_fence(__ATOMIC_ACQUIRE, "agent");
            xb_add(&bar[XB_XGEN(b.x)], 1u);
            asm volatile("s_waitcnt vmcnt(0)" ::: "memory");
        } else {
            XB_SPIN(xb_ld(&bar[XB_XGEN(b.x)]) == gen, bar);
            __builtin_amdgcn_fence(__ATOMIC_ACQUIRE, "agent");
            asm volatile("s_waitcnt vmcnt(0)" ::: "memory");
        }
    }
    __syncthreads();
}

struct Args { const float* in[34]; float* out; unsigned char* ws; int ph_lo, ph_hi; };
struct Frame {
    LAS unsigned char* lds;
    int vcu, G, cid, wid;
    float* out; unsigned char* ws; unsigned char* st;
};
__device__ __forceinline__ const float* inptr(LAS unsigned char* lds, int i) {
    int off = LDSCTL_OFF + 8 * i; asm volatile("" : "+v"(off));
    const LAS unsigned* p = (const LAS unsigned*)(lds + off);
    const unsigned lo = __builtin_amdgcn_readfirstlane(p[0]), hi = __builtin_amdgcn_readfirstlane(p[1]);
    return (const float*)(((unsigned long long)hi << 32) | lo);
}
#define INP(i) inptr(F.lds, (i))

__device__ __forceinline__ void conv_item(const float* W, int ld, int k0, int c0, int nvalid, const float* scale, bf16* dst, int K, int drow0, LAS float* scr, int lane) {
    const int n4 = (lane & 15) * 4;
#pragma unroll 4
    for (int i = 0; i < 16; ++i) { const int kk = 4 * i + (lane >> 4);
        f32x4 v = {0.f, 0.f, 0.f, 0.f}; if (n4 < nvalid) { v = *(const f32x4*)(W + (size_t)(k0 + kk) * ld + c0 + n4); if (scale) v *= scale[k0 + kk]; }
        LAS float* d = scr + kk * 65 + n4; d[0] = v[0]; d[1] = v[1]; d[2] = v[2]; d[3] = v[3]; }
    LDS_WAIT(); asm volatile("" ::: "memory");
    const int c = lane & 7;
#pragma unroll
    for (int j = 0; j < 8; ++j) { const int nn = (lane >> 3) + 8 * j; const LAS float* sp = scr + (8 * c) * 65 + nn;
        u32x4 o; o.x = pk2(sp[0 * 65], sp[1 * 65]); o.y = pk2(sp[2 * 65], sp[3 * 65]); o.z = pk2(sp[4 * 65], sp[5 * 65]); o.w = pk2(sp[6 * 65], sp[7 * 65]);
        *(u32x4*)(dst + (size_t)(drow0 + nn) * K + k0 + 8 * c) = o; }
    LDS_WAIT(); asm volatile("" ::: "memory");
}
__device__ __forceinline__ void conv_item8(const float* W, int ld, int k0, int c0, const float* scale, float mul, unsigned char* dst, int K, int drow0, LAS float* scr, int lane) {
    const int n4 = (lane & 15) * 4;
#pragma unroll 4
    for (int i = 0; i < 16; ++i) { const int kk = 4 * i + (lane >> 4);
        f32x4 v = *(const f32x4*)(W + (size_t)(k0 + kk) * ld + c0 + n4); v *= scale ? scale[k0 + kk] * mul : mul;
        LAS float* d = scr + kk * 65 + n4; d[0] = v[0]; d[1] = v[1]; d[2] = v[2]; d[3] = v[3]; }
    LDS_WAIT(); asm volatile("" ::: "memory");
    const int c = lane & 3;
#pragma unroll
    for (int j = 0; j < 4; ++j) { const int nn = (lane >> 2) + 16 * j; const LAS float* sp = scr + (16 * c) * 65 + nn;
        u32x4 o; o.x = pk4f8(sp[0 * 65], sp[1 * 65], sp[2 * 65], sp[3 * 65]); o.y = pk4f8(sp[4 * 65], sp[5 * 65], sp[6 * 65], sp[7 * 65]);
        o.z = pk4f8(sp[8 * 65], sp[9 * 65], sp[10 * 65], sp[11 * 65]); o.w = pk4f8(sp[12 * 65], sp[13 * 65], sp[14 * 65], sp[15 * 65]);
        *(u32x4*)(dst + (size_t)(drow0 + nn) * K + k0 + 16 * c) = o; }
    LDS_WAIT(); asm volatile("" ::: "memory");
}
__device__ __forceinline__ void conv_seg8(Frame& F, const float* W, int ld, int K, int ncols, const float* scale, float mul, unsigned char* dst, int r0, int blk, int blks) {
    const int ptid = otid(), plane = ptid & 63, pwave = __builtin_amdgcn_readfirstlane(ptid >> 6);
    LAS float* scr = (LAS float*)(F.lds + pwave * 16640);
    const int gw = F.vcu * 8 + pwave, NGW = F.G * 8;
    const int nblk = ncols / 64, nitems = (K / 64) * nblk;
    for (int it = gw; it < nitems; it += NGW) {
        const int kb = it / nblk, nb = it % nblk, n0 = nb * 64;
        conv_item8(W, ld, kb * 64, n0, scale, mul, dst, K, r0 + (n0 / blk) * blks + (n0 % blk), scr, plane);
    }
}
__device__ __forceinline__ void conv_seg(Frame& F, const float* W, int ld, int K, int c0, int nvalid, int ntotal, const float* scale, bf16* dst, int r0, int blk, int blks) {
    const int ptid = otid(), plane = ptid & 63, pwave = __builtin_amdgcn_readfirstlane(ptid >> 6);
    LAS float* scr = (LAS float*)(F.lds + pwave * 16640);
    const int gw = F.vcu * 8 + pwave, NGW = F.G * 8;
    const int nblk = ntotal / 64, nitems = (K / 64) * nblk;
    for (int it = gw; it < nitems; it += NGW) {
        const int kb = it / nblk, nb = it % nblk, n0 = nb * 64;
        int nv = nvalid - n0; nv = nv < 0 ? 0 : (nv > 64 ? 64 : nv);
        conv_item(W, ld, kb * 64, c0 + n0, nv, scale, dst, K, r0 + (n0 / blk) * blks + (n0 % blk), scr, plane);
    }
}
__device__ __forceinline__ void conv_layer_weights(Frame& F, int l, int part) {
    unsigned char* wl = F.ws + WS_W + (size_t)l * WL_STRIDE;
    const float* win = INP(2) + (size_t)l * D * INC; const float* n1 = INP(1) + l * D;
    const int BIGB = 1 << 30;
    if (part == 0) {
        conv_seg(F, win, INC, D, 0, 3328, 3328, n1, (bf16*)(wl + WL_IN), 0, BIGB, 0);
        conv_seg(F, win, INC, D, 3336, 2048, 2048, n1, (bf16*)(wl + WL_IN), 3328, BIGB, 0);
        conv_seg(F, win, INC, D, 3328, 8, 256, n1, (bf16*)(wl + WL_IN), 5376, BIGB, 0);
    } else {
        conv_seg(F, win, INC, D, 5384, 3072, 3072, n1, (bf16*)(wl + WL_GATE), 0, BIGB, 0);
        for (int i = 0; i < 3; ++i)
            conv_seg(F, INP(23) + ((size_t)l * 3 + i) * 512 * D, D, 512, 0, D, D, nullptr, (bf16*)(wl + WL_BR) + (size_t)i * D * 512, 0, BIGB, 0);
        conv_seg(F, INP(24) + (size_t)l * D * D, D, D, 0, D, D, nullptr, (bf16*)(wl + WL_OUT), 0, BIGB, 0);
    }
}
__device__ __forceinline__ void conv_ffn_weights(Frame& F) {
    const float* n2 = INP(25);
    conv_seg(F, INP(26), FF, D, 0, FF, FF, n2, (bf16*)(F.ws + WS_FFUP), 0, 128, 256);
    conv_seg(F, INP(27), FF, D, 0, FF, FF, n2, (bf16*)(F.ws + WS_FFUP), 128, 128, 256);
    conv_seg(F, INP(28), D, FF, 0, D, D, nullptr, (bf16*)(F.ws + WS_FFDN), 0, 1 << 30, 0);
}
__device__ __forceinline__ unsigned char* moew_ptr(const Frame& F, int e) { return e < 6 ? (unsigned char*)F.out + MOEW_OUT + (size_t)e * MOEW_STRIDE : (e == 6 ? F.ws + WS_FFUP : F.ws + WS_VF + 16 * MiB); }
__device__ __forceinline__ void conv_moe_weights(Frame& F) {
    const float* n2 = INP(25) + D;
    for (int e = 0; e < NE; ++e) {
        unsigned char* up = moew_ptr(F, e); unsigned char* dn = up + MOEW_DN;
        conv_seg8(F, INP(30) + (size_t)e * D * FFE, FFE, D, FFE, n2, 64.f, up, 0, 128, 256);
        conv_seg8(F, INP(31) + (size_t)e * D * FFE, FFE, D, FFE, n2, 64.f, up, 128, 128, 256);
        conv_seg8(F, INP(32) + (size_t)e * FFE * D, D, FFE, D, nullptr, 128.f, dn, 0, 1 << 30, 0);
    }
}
__device__ __forceinline__ void xprep_phase(Frame& F, const float* x) {
    const int ptid = otid(), plane = ptid & 63, pwave = __builtin_amdgcn_readfirstlane(ptid >> 6);
    const int gw = F.vcu * 8 + pwave, NGW = F.G * 8;
    bf16* xb = (bf16*)(F.ws + WS_XB); float* rstd = (float*)(F.ws + WS_RSTD);
    for (int m0 = 2 * gw; m0 < M; m0 += 2 * NGW) {
        f32x4 v[2][4];
#pragma unroll
        for (int q = 0; q < 2; ++q) { const f32x4* xr = (const f32x4*)(x + (size_t)(m0 + q) * D) + plane;
#pragma unroll
            for (int j = 0; j < 4; ++j) v[q][j] = xr[64 * j]; }
#pragma unroll
        for (int q = 0; q < 2; ++q) { const int m = m0 + q; float sq = 0.f;
#pragma unroll
            for (int j = 0; j < 4; ++j) sq += (v[q][j].x * v[q][j].x + v[q][j].y * v[q][j].y) + (v[q][j].z * v[q][j].z + v[q][j].w * v[q][j].w);
            sq = wave_sum(sq);
            if (plane == 0) rstd[m] = __builtin_amdgcn_rsqf(sq * (1.f / D) + 1e-6f);
            u32x2* o8 = (u32x2*)(xb + (size_t)m * D) + plane;
#pragma unroll
            for (int j = 0; j < 4; ++j) { u32x2 w; w.x = pk2(v[q][j].x, v[q][j].y); w.y = pk2(v[q][j].z, v[q][j].w); o8[64 * j] = w; } }
    }
}
__device__ __forceinline__ void final_norm_phase(Frame& F) {
    const int ptid = otid(), plane = ptid & 63, pwave = __builtin_amdgcn_readfirstlane(ptid >> 6);
    const int gw = F.vcu * 8 + pwave, NGW = F.G * 8;
    const float* fw = INP(33); const unsigned* pinfo = (const unsigned*)(F.ws + WS_PINFO); const int* cnt = (const int*)(F.ws + WS_CNT);
    int tb[8]; { int t = 0;
#pragma unroll
        for (int e = 0; e < 8; ++e) { int n = __builtin_amdgcn_readfirstlane(cnt[e]); n = n < 0 ? 0 : (n > 32768 ? 32768 : n); tb[e] = t; t += (n + 255) >> 8; } }
    const bf16* Y0 = (const bf16*)(F.ws + WS_YP0); const bf16* Y1 = (const bf16*)(F.ws + WS_YP1); const bf16* Y2 = (const bf16*)(F.ws + WS_YP2);
    f32x4 fwv[4];
#pragma unroll
    for (int j = 0; j < 4; ++j) fwv[j] = *((const f32x4*)fw + plane + 64 * j);
    for (int m0 = 2 * gw; m0 < M; m0 += 2 * NGW) {
        f32x4 v[2][4]; u32x2 ya[2][2][4]; float wg[2][2]; int sgm[2][2]; const bf16* yp[2][2];
#pragma unroll
        for (int q = 0; q < 2; ++q) { const int m = m0 + q;
            const u32x2* xr = (const u32x2*)((const bf16*)(F.ws + WS_XB) + (size_t)m * D) + plane;
#pragma unroll
            for (int j = 0; j < 4; ++j) { const u32x2 xx = xr[64 * j]; v[q][j] = (f32x4){bflo(xx.x), bfhi(xx.x), bflo(xx.y), bfhi(xx.y)}; }
#pragma unroll
            for (int p = 0; p < 2; ++p) {
                const unsigned pk = __builtin_amdgcn_readfirstlane(pinfo[((size_t)m * 2 + p) * 2]); wg[q][p] = __builtin_bit_cast(float, __builtin_amdgcn_readfirstlane(pinfo[((size_t)m * 2 + p) * 2 + 1]));
                const int e = (int)(pk >> 20), slot = (int)(pk & 0xFFFFFu);
                int tbe = tb[0];
#pragma unroll
                for (int k = 1; k < 8; ++k) tbe = (e == k) ? tb[k] : tbe;
                const int gr = tbe * 256 + slot, seg = gr >> 15, lr = gr & 32767; sgm[q][p] = seg;
                yp[q][p] = (seg == 0 ? Y0 : (seg == 1 ? Y1 : Y2)) + (size_t)lr * D + 4 * plane; } }
#pragma unroll
        for (int q = 0; q < 2; ++q)
#pragma unroll
            for (int p = 0; p < 2; ++p)
#pragma unroll
                for (int j = 0; j < 4; ++j) ya[q][p][j] = *(const u32x2*)(yp[q][p] + 256 * j);
#pragma unroll
        for (int q = 0; q < 2; ++q) { const int m = m0 + q;
#pragma unroll
            for (int p = 0; p < 2; ++p) { const float wgt = wg[q][p];
#pragma unroll
                for (int j = 0; j < 4; ++j) { const u32x2 yy = ya[q][p][j]; v[q][j].x += wgt * bflo(yy.x); v[q][j].y += wgt * bfhi(yy.x); v[q][j].z += wgt * bflo(yy.y); v[q][j].w += wgt * bfhi(yy.y); }
                if (sgm[q][p] == 2) {
#pragma unroll
                    for (int ks = 1; ks < MOE_KSP; ++ks)
#pragma unroll
                        for (int j = 0; j < 4; ++j) { const u32x2 yy = *(const u32x2*)(yp[q][p] + (size_t)ks * (YP2_STRIDE / 2) + 256 * j); v[q][j].x += wgt * bflo(yy.x); v[q][j].y += wgt * bfhi(yy.x); v[q][j].z += wgt * bflo(yy.y); v[q][j].w += wgt * bfhi(yy.y); } } }
            float ssq = 0.f;
#pragma unroll
            for (int j = 0; j < 4; ++j) ssq += (v[q][j].x * v[q][j].x + v[q][j].y * v[q][j].y) + (v[q][j].z * v[q][j].z + v[q][j].w * v[q][j].w);
            ssq = wave_sum(ssq);
            const float r = __builtin_amdgcn_rsqf(ssq * (1.f / D) + 1e-6f);
            f32x4* xo = (f32x4*)(F.out + (size_t)m * D) + plane;
#pragma unroll
            for (int j = 0; j < 4; ++j) xo[64 * j] = v[q][j] * r * fwv[j]; }
    }
}
__device__ __forceinline__ void router_phase(Frame& F) {
    const int ptid = otid(), plane = ptid & 63, pwave = __builtin_amdgcn_readfirstlane(ptid >> 6);
    const float* nw = INP(25) + D; const float* rt = INP(29); bf16* xb = (bf16*)(F.ws + WS_XB);
    int* cnt = (int*)(F.ws + WS_CNT); int* list2 = (int*)(F.ws + WS_LIST);
    LAS int* lsel = (LAS int*)F.lds;
    LAS float* lwt = (LAS float*)(F.lds + 1024);
    LAS int* lrank = (LAS int*)(F.lds + 2048);
    LAS int* lcnt = (LAS int*)(F.lds + 3072);
    for (int blk = F.vcu; blk < M / 128; blk += F.G) {
        if (ptid < 16) lcnt[ptid] = 0;
        __syncthreads();
        for (int k = 0; k < 16; ++k) {
            const int lt = pwave * 16 + k, m = blk * 128 + lt;
            float acc[8];
#pragma unroll
            for (int e = 0; e < 8; ++e) acc[e] = 0.f;
            const u32x2* xr2 = (const u32x2*)(xb + (size_t)m * D) + plane;
            f32x4 xv4[4]; float ssq = 0.f;
#pragma unroll
            for (int j = 0; j < 4; ++j) { const u32x2 xx = xr2[64 * j]; xv4[j] = (f32x4){bflo(xx.x), bfhi(xx.x), bflo(xx.y), bfhi(xx.y)}; ssq += (xv4[j].x * xv4[j].x + xv4[j].y * xv4[j].y) + (xv4[j].z * xv4[j].z + xv4[j].w * xv4[j].w); }
            ssq = wave_sum(ssq);
            const float sc = __builtin_amdgcn_rsqf(ssq * (1.f / D) + 1e-6f);
            { unsigned* x8 = (unsigned*)(F.ws + WS_X8 + (size_t)m * D) + plane; const float s4 = 4.f * sc;
#pragma unroll
              for (int j = 0; j < 4; ++j) x8[64 * j] = pk4f8(xv4[j].x * s4, xv4[j].y * s4, xv4[j].z * s4, xv4[j].w * s4); }
#pragma unroll
            for (int j = 0; j < 4; ++j) { const int kk = 4 * plane + 256 * j; const f32x4 nwv = *(const f32x4*)(nw + kk);
#pragma unroll
                for (int q = 0; q < 4; ++q) { const float xv = xv4[j][q] * nwv[q];
                    const f32x4 r0v = *(const f32x4*)(rt + (size_t)(kk + q) * 8), r1v = *(const f32x4*)(rt + (size_t)(kk + q) * 8 + 4);
                    acc[0] += xv * r0v.x; acc[1] += xv * r0v.y; acc[2] += xv * r0v.z; acc[3] += xv * r0v.w; acc[4] += xv * r1v.x; acc[5] += xv * r1v.y; acc[6] += xv * r1v.z; acc[7] += xv * r1v.w; } }
#pragma unroll
            for (int e = 0; e < 8; ++e) acc[e] = wave_sum(acc[e]) * sc;
            int i0 = 0; float v0 = acc[0];
#pragma unroll
            for (int e = 1; e < 8; ++e) if (acc[e] > v0) { v0 = acc[e]; i0 = e; }
            int i1 = -1; float v1 = -3.0e38f;
#pragma unroll
            for (int e = 0; e < 8; ++e) if (e != i0 && acc[e] > v1) { v1 = acc[e]; i1 = e; }
            const float e1 = expf(v1 - v0), w0 = 1.f / (1.f + e1), w1 = e1 / (1.f + e1);
            if (plane == 0) { lsel[2 * lt] = i0; lsel[2 * lt + 1] = i1; lwt[2 * lt] = w0; lwt[2 * lt + 1] = w1;
                lrank[2 * lt] = atomicAdd((int*)(lcnt + i0), 1); lrank[2 * lt + 1] = atomicAdd((int*)(lcnt + i1), 1); }
        }
        __syncthreads();
        if (ptid < 8) lcnt[8 + ptid] = atomicAdd(cnt + ptid, lcnt[ptid]);
        __syncthreads();
        if (ptid < 256) { const int e = lsel[ptid], slot = lcnt[8 + e] + lrank[ptid];
            u32x2 v; v.x = (unsigned)(blk * 128 + (ptid >> 1)); v.y = __builtin_bit_cast(unsigned, lwt[ptid]);
            *(u32x2*)(list2 + ((size_t)e * 32768 + slot) * 2) = v;
            u32x2 pi; pi.x = ((unsigned)e << 20) | (unsigned)slot; pi.y = v.y; *(u32x2*)((unsigned*)(F.ws + WS_PINFO) + ((size_t)(blk * 128) * 2 + ptid) * 2) = pi; }
        __syncthreads();
    }
}

__device__ __forceinline__ void vprep_phase(Frame& F, int layer) {
    const int ptid = otid(), plane = ptid & 63, pwave = __builtin_amdgcn_readfirstlane(ptid >> 6);
    constexpr int VP = 520, V_VB = 0, V_GB = 64 * VP * 2, V_VD = 2 * 64 * VP * 2;
    LAS bf16* VB = (LAS bf16*)(F.lds + V_VB); LAS bf16* GB = (LAS bf16*)(F.lds + V_GB); LAS bf16* VD = (LAS bf16*)(F.lds + V_VD);
    const bf16* P = (const bf16*)(F.ws + WS_BIG); bf16* VF = (bf16*)(F.ws + WS_VF); bf16* VM = (bf16*)(F.ws + WS_VMIX);
    const bf16* vdT = (const bf16*)(F.ws + WS_VLORA); const bf16* vuT = vdT + 32 * 512;
    const float* mu = INP(3) + layer * 1792 + 1024; const float* v0 = INP(16);
    const int tok = ptid >> 3, part = ptid & 7, r16 = plane & 15, q4 = plane >> 4;
    for (int it = F.vcu; it < M / 64; it += F.G) {
        const int m = it * 64 + tok; const int t = m & (T - 1);
        const bf16* cur = P + (size_t)m * PLD + 1024 + part * 64;
#pragma unroll
        for (int q = 0; q < 8; ++q) { float c[8], p[8]; unpack8(*(const u32x4*)(cur + q * 8), c);
            if (t > 0) unpack8(*(const u32x4*)(cur - PLD + q * 8), p); else {
#pragma unroll
                for (int e = 0; e < 8; ++e) p[e] = 0.f; }
            const f32x4 m0 = *(const f32x4*)(mu + part * 64 + q * 8), m1 = *(const f32x4*)(mu + part * 64 + q * 8 + 4);
#pragma unroll
            for (int e = 0; e < 4; ++e) { c[e] = c[e] + (p[e] - c[e]) * m0[e]; c[4 + e] = c[4 + e] + (p[4 + e] - c[4 + e]) * m1[e]; }
            const u32x4 o = pack8(c);
            if (layer == 0) *(u32x4*)(VF + (size_t)m * 512 + part * 64 + q * 8) = o; else *(LAS u32x4*)(VB + tok * VP + part * 64 + q * 8) = o; }
        if (layer == 0) continue;
        __syncthreads();
        { const int rb = pwave & 3, jt = pwave >> 2; f32x4 acc = {0.f, 0.f, 0.f, 0.f};
#pragma unroll 4
          for (int k0 = 0; k0 < 512; k0 += 32) acc = __builtin_amdgcn_mfma_f32_16x16x32_bf16(*(const LAS bf16x8*)(VB + (16 * rb + r16) * VP + k0 + 8 * q4), *(const bf16x8*)(vdT + (size_t)(16 * jt + r16) * 512 + k0 + 8 * q4), acc, 0, 0, 0);
#pragma unroll
          for (int jj = 0; jj < 4; ++jj) VD[(16 * rb + 4 * q4 + jj) * 40 + 16 * jt + r16] = (bf16)f2bf(acc[jj]); }
        __syncthreads();
        { const int rb = pwave & 3; const bf16x8 af = *(const LAS bf16x8*)(VD + (16 * rb + r16) * 40 + 8 * q4);
#pragma unroll 4
          for (int i = 0; i < 16; ++i) { const int ct = (pwave >> 2) * 16 + i;
              const f32x4 acc = __builtin_amdgcn_mfma_f32_16x16x32_bf16(af, *(const bf16x8*)(vuT + (size_t)(16 * ct + r16) * 32 + 8 * q4), (f32x4){0.f, 0.f, 0.f, 0.f}, 0, 0, 0);
              const float vc = v0[16 * ct + r16];
#pragma unroll
              for (int jj = 0; jj < 4; ++jj) GB[(16 * rb + 4 * q4 + jj) * VP + 16 * ct + r16] = (bf16)f2bf(sigm(vc + acc[jj])); } }
        __syncthreads();
#pragma unroll
        for (int q = 0; q < 8; ++q) { float v[8], g[8], vf[8]; unpack8(*(const LAS u32x4*)(VB + tok * VP + part * 64 + q * 8), v); unpack8(*(const LAS u32x4*)(GB + tok * VP + part * 64 + q * 8), g);
            unpack8(*(const u32x4*)(VF + (size_t)m * 512 + part * 64 + q * 8), vf);
#pragma unroll
            for (int e = 0; e < 8; ++e) v[e] = v[e] + (vf[e] - v[e]) * g[e];
            *(u32x4*)(VM + (size_t)m * 512 + part * 64 + q * 8) = pack8(v); }
        __syncthreads();
    }
}
__device__ __forceinline__ void prepass_a(Frame& F) {
    const int tid = otid();
    bf16* P = (bf16*)(F.ws + WS_BIG); bf16* BND2 = (bf16*)(F.ws + WS_BND2);
    { const int ch = tid & 127; const int kind = ch >> 6, part = ch & 7;
      double invf[4];
#pragma unroll
      for (int p = 0; p < 4; ++p) invf[p] = exp(-(double)(part * 4 + p) * (9.210340371976184 / 32.0));
      for (int m = F.vcu * 4 + (tid >> 7); m < M; m += F.G * 4) {
          const int t = m & (T - 1); bf16* ptr = P + (size_t)m * PLD + C_RET + ch * 8;
          float x[8]; unpack8(*(const u32x4*)ptr, x);
#pragma unroll
          for (int p = 0; p < 4; ++p) { double rev = (double)t * invf[p] * 0.15915494309189535; rev -= floor(rev);
              const float sn = __builtin_amdgcn_sinf((float)rev), cs = __builtin_amdgcn_cosf((float)rev);
              const float x0 = x[2 * p], x1 = x[2 * p + 1]; float o0 = x0 * cs - x1 * sn, o1 = x0 * sn + x1 * cs;
              if (kind) { o0 *= 0.125f; o1 *= 0.125f; }
              x[2 * p] = o0; x[2 * p + 1] = o1; }
          *(u32x4*)ptr = pack8(x); } }
    for (int i = F.vcu * 512 + tid; i < 1024 * 3 * 128; i += F.G * 512) { const int ch = i & 127, k = (i >> 7) % 3, r = i / 384;
        if ((r & 511) != 0) *(u32x4*)(BND2 + ((size_t)r * 3 + k) * 1024 + ch * 8) = *(const u32x4*)(P + ((size_t)r * 32 - 3 + k) * PLD + C_XBC + ch * 8); }
}
__device__ __forceinline__ void prepass_conv(Frame& F, int layer) {
    const int tid = otid();
    bf16* P = (bf16*)(F.ws + WS_BIG); const bf16* BND2 = (const bf16*)(F.ws + WS_BND2);
    const float* cw = INP(17) + layer * 1024 * 4; const float* cbias = INP(18) + layer * 1024;
    const int ch = tid & 127;
    f32x4 wv[8]; float bv[8];
#pragma unroll
    for (int e = 0; e < 8; ++e) { wv[e] = *(const f32x4*)(cw + (ch * 8 + e) * 4); bv[e] = cbias[ch * 8 + e]; }
    for (int r = F.vcu * 4 + (tid >> 7); r < M / 32; r += F.G * 4) {
        float w0[8], w1[8], w2[8];
        if ((r & 511) != 0) { unpack8(*(const u32x4*)(BND2 + ((size_t)r * 3 + 0) * 1024 + ch * 8), w0); unpack8(*(const u32x4*)(BND2 + ((size_t)r * 3 + 1) * 1024 + ch * 8), w1); unpack8(*(const u32x4*)(BND2 + ((size_t)r * 3 + 2) * 1024 + ch * 8), w2); }
        else {
#pragma unroll
            for (int e = 0; e < 8; ++e) { w0[e] = 0.f; w1[e] = 0.f; w2[e] = 0.f; } }
        bf16* ptr = P + (size_t)r * 32 * PLD + C_XBC + ch * 8;
#pragma unroll 4
        for (int i = 0; i < 32; ++i) {
            float x[8], o[8]; unpack8(*(const u32x4*)(ptr + (size_t)i * PLD), x);
#pragma unroll
            for (int e = 0; e < 8; ++e) { o[e] = silu(bv[e] + wv[e][0] * w0[e] + wv[e][1] * w1[e] + wv[e][2] * w2[e] + wv[e][3] * x[e]); w0[e] = w1[e]; w1[e] = w2[e]; w2[e] = x[e]; }
            *(u32x4*)(ptr + (size_t)i * PLD) = pack8(o);
        }
    }
}
template <int CTRL> __device__ __forceinline__ float dpp_f(float v) { return __builtin_bit_cast(float, __builtin_amdgcn_update_dpp(0, __builtin_bit_cast(int, v), CTRL, 0xF, 0xF, true)); }
__device__ __forceinline__ float red8(float v) { v += dpp_f<0xB1>(v); v += dpp_f<0x4E>(v); v += dpp_f<0x141>(v); return v; }
__device__ __forceinline__ float red16(float v) { v = red8(v); v += dpp_f<0x140>(v); return v; }

__device__ __forceinline__ void rwkv_seq(Frame& F, int layer, int bh) {
    const int ptid = otid(), plane = ptid & 63, pwave = __builtin_amdgcn_readfirstlane(ptid >> 6); (void)plane; (void)pwave;
    const int b = bh >> 3, h = bh & 7;
    LAS float* L = (LAS float*)F.lds;
    LAS float *rr = L, *ww = L + 2048, *kf = L + 4096, *vv = L + 6144, *aa = L + 8192, *bb = L + 10240, *gg = L + 12288, *yy = L + 14336, *tw = L + 16384, *xa = L + 18432, *sg = L + 20480, *bon = L + 24576;
    const float* mu = INP(3) + layer * 1792; const float* w_up = INP(4) + layer * 64 * 512; const float* w0 = INP(5) + layer * 512;
    const float* a_up = INP(6) + layer * 64 * 512; const float* a0 = INP(7) + layer * 512; const float* g_up = INP(8) + layer * 128 * 512;
    const float* k_k = INP(9) + layer * 512; const float* k_a = INP(10) + layer * 512; const float* r_k = INP(11) + layer * 512;
    const float* gn_w = INP(12) + layer * 512; const float* gn_b = INP(13) + layer * 512;
    const bf16* P = (const bf16*)(F.ws + WS_BIG); const bf16* vsrc = (const bf16*)(F.ws + (layer == 0 ? WS_VF : WS_VMIX)); bf16* yout = (bf16*)(F.ws + WS_YRW);
    const int tid = ptid, tok = tid >> 4, part = tid & 15, c4 = part * 4, cb = h * 64 + c4;
    const int srow = tid >> 3, sc0 = (tid & 7) * 8;
    float S[8];
#pragma unroll
    for (int j = 0; j < 8; ++j) S[j] = 0.f;
    for (int t0 = 0; t0 < T; t0 += 32) {
        {
            const int t = t0 + tok; const size_t m = (size_t)b * T + t;
            const bf16* cur = P + m * PLD;
#pragma unroll
            for (int q = 0; q < 3; ++q) {
                const int ch = part + 16 * q; int col, kind; LAS float* dst;
                if (ch < 8) { col = h * 64 + ch * 8; dst = rr + tok * 64 + ch * 8; kind = 0; }
                else if (ch < 16) { col = 512 + h * 64 + (ch - 8) * 8; dst = kf + tok * 64 + (ch - 8) * 8; kind = 0; }
                else if (ch < 24) { col = 1536 + (ch - 16) * 8; dst = tw + tok * 64 + (ch - 16) * 8; kind = 1; }
                else if (ch < 32) { col = 1600 + (ch - 24) * 8; dst = xa + tok * 64 + (ch - 24) * 8; kind = 0; }
                else { col = 1664 + (ch - 32) * 8; dst = sg + tok * 128 + (ch - 32) * 8; kind = 2; }
                float c[8], p[8]; unpack8(*(const u32x4*)(cur + col), c);
                if (t > 0) unpack8(*(const u32x4*)(cur - PLD + col), p); else {
#pragma unroll
                    for (int e = 0; e < 8; ++e) p[e] = 0.f; }
#pragma unroll
                for (int e = 0; e < 8; ++e) { float x = c[e] + (p[e] - c[e]) * mu[col + e]; if (kind == 1) x = tanhf(x); else if (kind == 2) x = sigm(x); dst[e] = x; }
            }
            if (part < 8) { float v[8]; unpack8(*(const u32x4*)(vsrc + m * 512 + h * 64 + part * 8), v);
#pragma unroll
                for (int e = 0; e < 8; ++e) vv[tok * 64 + part * 8 + e] = v[e]; }
        }
        __syncthreads();
        {
            f32x4 dw = *(const f32x4*)(w0 + cb), da = *(const f32x4*)(a0 + cb), dg = (f32x4){0.f, 0.f, 0.f, 0.f};
            for (int j = 0; j < 64; ++j) { const float tj = tw[tok * 64 + j], xj = xa[tok * 64 + j];
                dw += *(const f32x4*)(w_up + j * 512 + cb) * tj; da += *(const f32x4*)(a_up + j * 512 + cb) * xj; }
            for (int j = 0; j < 128; ++j) dg += *(const f32x4*)(g_up + j * 512 + cb) * sg[tok * 128 + j];
            float kr[4], kk[4], av[4], ss = 0.f;
#pragma unroll
            for (int e = 0; e < 4; ++e) { kr[e] = kf[tok * 64 + c4 + e]; kk[e] = kr[e] * k_k[cb + e]; ss += kk[e] * kk[e]; av[e] = sigm(da[e]); }
            ss = red16(ss);
            const float inv = __builtin_amdgcn_rsqf(fmaxf(ss, 1e-24f));
            float bs = 0.f;
#pragma unroll
            for (int e = 0; e < 4; ++e) { const float kn = kk[e] * inv; const int o = tok * 64 + c4 + e;
                const float ld = -expf(-softplus_acc(-dw[e]) - 0.5f);
                ww[o] = expf(ld); aa[o] = -kn; bb[o] = kn * av[e];
                const float knew = kr[e] * (1.f + (av[e] - 1.f) * k_a[cb + e]); kf[o] = knew; gg[o] = dg[e];
                bs += rr[o] * knew * r_k[cb + e]; }
            bs = red16(bs);
            if (part == 0) bon[tok] = bs;
        }
        __syncthreads();
        for (int s = 0; s < 32; ++s) {
            const f32x4 a0v = *(const LAS f32x4*)(aa + s * 64 + sc0), a1v = *(const LAS f32x4*)(aa + s * 64 + sc0 + 4);
            const f32x4 w0v = *(const LAS f32x4*)(ww + s * 64 + sc0), w1v = *(const LAS f32x4*)(ww + s * 64 + sc0 + 4);
            const f32x4 b0v = *(const LAS f32x4*)(bb + s * 64 + sc0), b1v = *(const LAS f32x4*)(bb + s * 64 + sc0 + 4);
            const f32x4 k0v = *(const LAS f32x4*)(kf + s * 64 + sc0), k1v = *(const LAS f32x4*)(kf + s * 64 + sc0 + 4);
            const f32x4 r0v = *(const LAS f32x4*)(rr + s * 64 + sc0), r1v = *(const LAS f32x4*)(rr + s * 64 + sc0 + 4);
            const float vi = vv[s * 64 + srow];
            float sa = 0.f;
#pragma unroll
            for (int j = 0; j < 4; ++j) sa += S[j] * a0v[j] + S[4 + j] * a1v[j];
            sa = red8(sa);
            float y = 0.f;
#pragma unroll
            for (int j = 0; j < 4; ++j) { S[j] = S[j] * w0v[j] + sa * b0v[j] + vi * k0v[j]; S[4 + j] = S[4 + j] * w1v[j] + sa * b1v[j] + vi * k1v[j]; y += S[j] * r0v[j] + S[4 + j] * r1v[j]; }
            y = red8(y);
            if ((tid & 7) == 0) yy[s * 64 + srow] = y;
        }
        __syncthreads();
        {
            const size_t m = (size_t)b * T + t0 + tok;
            float y[4], sm = 0.f;
#pragma unroll
            for (int e = 0; e < 4; ++e) { y[e] = yy[tok * 64 + c4 + e]; sm += y[e]; }
            const float mean = red16(sm) * (1.f / 64.f);
            float vs = 0.f;
#pragma unroll
            for (int e = 0; e < 4; ++e) { y[e] -= mean; vs += y[e] * y[e]; }
            const float rs = __builtin_amdgcn_rsqf(red16(vs) * (1.f / 64.f) + 64e-5f);
            const float bo = bon[tok];
            float o[4];
#pragma unroll
            for (int e = 0; e < 4; ++e) { const int idx = tok * 64 + c4 + e; o[e] = (y[e] * rs * gn_w[cb + e] + gn_b[cb + e] + bo * vv[idx]) * gg[idx]; }
            u32x2 w; w.x = pk2(o[0], o[1]); w.y = pk2(o[2], o[3]);
            *(u32x2*)(yout + m * 512 + cb) = w;
        }
        __syncthreads();
    }
}

__device__ __forceinline__ void ret_seq(Frame& F, int bh) {
    const int ptid = otid(), plane = ptid & 63, pwave = __builtin_amdgcn_readfirstlane(ptid >> 6); (void)plane; (void)pwave;
    const int b = bh >> 3, h = bh & 7;
    LAS float* L = (LAS float*)F.lds;
    LAS float *qq = L, *kk = L + 2048, *vv = L + 4096, *gg = L + 6144, *yy = L + 8192;
    bf16* P = (bf16*)(F.ws + WS_BIG);
    const int tid = ptid, tok = tid >> 4, part = tid & 15, c4 = part * 4;
    const int se = tid >> 3, sd0 = (tid & 7) * 8;
    const float gamma = 1.f - exp2f(-5.f - (float)h);
    float S[8];
#pragma unroll
    for (int j = 0; j < 8; ++j) S[j] = 0.f;
    for (int t0 = 0; t0 < T; t0 += 32) {
        {
            const int t = t0 + tok; const size_t m = (size_t)b * T + t;
#pragma unroll
            for (int q = 0; q < 2; ++q) {
                const int ch = part + 16 * q, kind = ch >> 3, cc = ch & 7;
                float x[8]; unpack8(*(const u32x4*)(P + m * PLD + C_RET + kind * 512 + h * 64 + cc * 8), x);
                LAS float* dst = (kind == 0 ? qq : kind == 1 ? kk : kind == 2 ? vv : gg) + tok * 64 + cc * 8;
                if (kind < 2) {
#pragma unroll
                    for (int p = 0; p < 4; ++p) { const int i = cc * 4 + p;
                        const double invf = exp(-(double)i * (9.210340371976184 / 32.0));
                        double sn, cs; sincos((double)t * invf, &sn, &cs);
                        const float x0 = x[2 * p], x1 = x[2 * p + 1], c = (float)cs, s = (float)sn;
                        float o0 = x0 * c - x1 * s, o1 = x0 * s + x1 * c;
                        if (kind == 1) { o0 *= 0.125f; o1 *= 0.125f; }
                        dst[2 * p] = o0; dst[2 * p + 1] = o1; }
                } else {
#pragma unroll
                    for (int e = 0; e < 8; ++e) dst[e] = x[e];
                }
            }
        }
        __syncthreads();
        for (int s = 0; s < 32; ++s) {
            const f32x4 k0v = *(const LAS f32x4*)(kk + s * 64 + sd0), k1v = *(const LAS f32x4*)(kk + s * 64 + sd0 + 4);
            const f32x4 q0v = *(const LAS f32x4*)(qq + s * 64 + sd0), q1v = *(const LAS f32x4*)(qq + s * 64 + sd0 + 4);
            const float ve = vv[s * 64 + se];
            float y = 0.f;
#pragma unroll
            for (int j = 0; j < 4; ++j) { S[j] = gamma * S[j] + k0v[j] * ve; S[4 + j] = gamma * S[4 + j] + k1v[j] * ve; y += q0v[j] * S[j] + q1v[j] * S[4 + j]; }
            y = red8(y);
            if ((tid & 7) == 0) yy[s * 64 + se] = y;
        }
        __syncthreads();
        {
            const size_t m = (size_t)b * T + t0 + tok;
            float y[4], ss = 0.f;
#pragma unroll
            for (int e = 0; e < 4; ++e) { y[e] = yy[tok * 64 + c4 + e]; ss += y[e] * y[e]; }
            const float rs = __builtin_amdgcn_rsqf(red16(ss) * (1.f / 64.f) + 1e-6f);
            float o[4];
#pragma unroll
            for (int e = 0; e < 4; ++e) o[e] = y[e] * rs * silu(gg[tok * 64 + c4 + e]);
            u32x2 w; w.x = pk2(o[0], o[1]); w.y = pk2(o[2], o[3]);
            *(u32x2*)(P + m * PLD + C_RETG + h * 64 + c4) = w;
        }
        __syncthreads();
    }
}

__device__ __forceinline__ void ssd_seq(Frame& F, int layer, int bh) {
    const int ptid = otid(), plane = ptid & 63, pwave = __builtin_amdgcn_readfirstlane(ptid >> 6); (void)plane; (void)pwave;
    const int b = bh >> 3, h = bh & 7, g = h >> 2;
    LAS float* L = (LAS float*)F.lds;
    LAS float *raw = L  , *xs = L + 11200, *Bc = L + 13248, *Cc = L + 17344, *yy = L + 21440, *dts = L + 23488, *das = L + 23520;
    bf16* P = (bf16*)(F.ws + WS_BIG); const float* dtb = (const float*)(F.ws + WS_DT);
    const float* cw = INP(17) + layer * 1024 * 4; const float* cbias = INP(18) + layer * 1024;
    const float dt_bias = INP(19)[layer * 8 + h], A = -expf(INP(20)[layer * 8 + h]), Dh = INP(21)[layer * 8 + h];
    const int tid = ptid;
    const int sp = tid >> 3, sn0 = (tid & 7) * 16;
    float S[16];
#pragma unroll
    for (int j = 0; j < 16; ++j) S[j] = 0.f;
    for (int i = tid; i < 3 * 320; i += 512) raw[i] = 0.f;
    __syncthreads();
    for (int t0 = 0; t0 < T; t0 += 32) {
        for (int idx = tid; idx < 32 * 40; idx += 512) {
            const int row = idx / 40, ch = idx % 40; const size_t m = (size_t)b * T + t0 + row;
            const int col = ch < 8 ? (C_XBC + h * 64 + ch * 8) : (ch < 24 ? (C_XBC + 512 + g * 128 + (ch - 8) * 8) : (C_XBC + 768 + g * 128 + (ch - 24) * 8));
            float x[8]; unpack8(*(const u32x4*)(P + m * PLD + col), x);
#pragma unroll
            for (int e = 0; e < 8; ++e) raw[(3 + row) * 320 + ch * 8 + e] = x[e];
        }
        if (tid < 32) { const size_t m = (size_t)b * T + t0 + tid; const float dt = softplus_acc(dtb[m * 8 + h] + dt_bias); dts[tid] = dt; das[tid] = expf(A * dt); }
        __syncthreads();
        for (int idx = tid; idx < 32 * 320; idx += 512) {
            const int row = idx / 320, c = idx % 320;
            const int chn = c < 64 ? (h * 64 + c) : (c < 192 ? (512 + g * 128 + (c - 64)) : (768 + g * 128 + (c - 192)));
            float a = cbias[chn];
#pragma unroll
            for (int k = 0; k < 4; ++k) a += cw[chn * 4 + k] * raw[(row + k) * 320 + c];
            a = silu(a);
            if (c < 64) xs[row * 64 + c] = a; else if (c < 192) Bc[row * 128 + (c - 64)] = a; else Cc[row * 128 + (c - 192)] = a;
        }
        __syncthreads();
        for (int s = 0; s < 32; ++s) {
            const float da = das[s], xv = xs[s * 64 + sp], dtx = dts[s] * xv;
            float y = 0.f;
#pragma unroll
            for (int q = 0; q < 4; ++q) { const f32x4 bv = *(const LAS f32x4*)(Bc + s * 128 + sn0 + q * 4), cv = *(const LAS f32x4*)(Cc + s * 128 + sn0 + q * 4);
#pragma unroll
                for (int j = 0; j < 4; ++j) { S[q * 4 + j] = da * S[q * 4 + j] + dtx * bv[j]; y += S[q * 4 + j] * cv[j]; } }
            y = red8(y);
            if ((tid & 7) == 0) yy[s * 64 + sp] = y + Dh * xv;
        }
        __syncthreads();
        {
            const int tok = tid >> 4, c4 = (tid & 15) * 4; const size_t m = (size_t)b * T + t0 + tok;
            u32x2 w; w.x = pk2(yy[tok * 64 + c4], yy[tok * 64 + c4 + 1]); w.y = pk2(yy[tok * 64 + c4 + 2], yy[tok * 64 + c4 + 3]);
            *(u32x2*)(P + m * PLD + C_XBC + h * 64 + c4) = w;
            for (int i = tid; i < 3 * 320; i += 512) raw[i] = raw[32 * 320 + i];
        }
        __syncthreads();
    }
}
__device__ __forceinline__ void ssm_norm_phase(Frame& F, int layer) {
    const int ptid = otid(), plane = ptid & 63, pwave = __builtin_amdgcn_readfirstlane(ptid >> 6);
    const int gw = F.vcu * 8 + pwave, NGW = F.G * 8;
    bf16* P = (bf16*)(F.ws + WS_BIG); const float* nw = INP(22) + layer * 512;
    float nwv[8];
#pragma unroll
    for (int e = 0; e < 8; ++e) nwv[e] = nw[plane * 8 + e];
    for (int m0 = 2 * gw; m0 < M; m0 += 2 * NGW) {
        u32x4 yv[2], zv[2];
#pragma unroll
        for (int q = 0; q < 2; ++q) { yv[q] = *(const u32x4*)(P + (size_t)(m0 + q) * PLD + C_XBC + plane * 8); zv[q] = *(const u32x4*)(P + (size_t)(m0 + q) * PLD + C_Z + plane * 8); }
#pragma unroll
        for (int q = 0; q < 2; ++q) { float y[8], z[8]; unpack8(yv[q], y); unpack8(zv[q], z);
            float ss = 0.f;
#pragma unroll
            for (int e = 0; e < 8; ++e) { y[e] *= silu(z[e]); ss += y[e] * y[e]; }
            ss = red16(ss); ss += __shfl_xor(ss, 16);
            const float rs = __builtin_amdgcn_rsqf(ss * (1.f / 256.f) + 1e-6f);
#pragma unroll
            for (int e = 0; e < 8; ++e) y[e] *= rs * nwv[e];
            *(u32x4*)(P + (size_t)(m0 + q) * PLD + C_Z + plane * 8) = pack8(y); }
    }
}
constexpr int PT = 72, PT2 = 136, PF = 68;
__device__ __forceinline__ f32x4 mfma16(bf16x8 a, bf16x8 b, f32x4 c) { return __builtin_amdgcn_mfma_f32_16x16x32_bf16(a, b, c, 0, 0, 0); }
template <int K, bool SA = false, bool SB = false> __device__ __forceinline__ f32x4 mm_ll(const LAS bf16* A, int pa, int m0, const LAS bf16* B, int pb, int n0, f32x4 acc, int lane) {
    const int r = lane & 15, q = lane >> 4;
    const int xa = SA ? (((m0 + r) >> 3) & 7) : 0, xb = SB ? (((n0 + r) >> 3) & 7) : 0;
    const LAS bf16* ap = A + (m0 + r) * pa; const LAS bf16* bp = B + (n0 + r) * pb;
#pragma unroll
    for (int k0 = 0; k0 < K; k0 += 32) acc = mfma16(*(const LAS bf16x8*)(ap + 8 * (((k0 >> 3) + q) ^ xa)), *(const LAS bf16x8*)(bp + 8 * (((k0 >> 3) + q) ^ xb)), acc);
    return acc;
}
template <int K> __device__ __forceinline__ f32x4 mm_lg(const LAS bf16* A, int pa, int m0, const bf16* B, int pb, int n0, f32x4 acc, int lane) {
    const int r = lane & 15, q = lane >> 4;
    const LAS bf16* ap = A + (m0 + r) * pa + 8 * q; const bf16* bp = B + (size_t)(n0 + r) * pb + 8 * q;
#pragma unroll
    for (int k0 = 0; k0 < K; k0 += 32) acc = mfma16(*(const LAS bf16x8*)(ap + k0), *(const bf16x8*)(bp + k0), acc);
    return acc;
}
__device__ __forceinline__ float redl16(float v) { return red16(v); }
__device__ __forceinline__ void st4bf(LAS bf16* p, f32x4 v) { u32x2 w; w.x = pk2(v[0], v[1]); w.y = pk2(v[2], v[3]); *(LAS u32x2*)p = w; }
__device__ __forceinline__ float ldbf(const LAS bf16* p) { return __builtin_bit_cast(float, (unsigned)(*p) << 16); }
constexpr f32x4 FZ4 = {0.f, 0.f, 0.f, 0.f};
__device__ __forceinline__ void tr_write8(LAS bf16* Tm, int pitch, int c0, int t, const float (&v)[8], int) {
    LAS bf16* base = Tm + c0 * pitch + (t ^ (((c0 >> 3) & 7) << 3));
#pragma unroll
    for (int e = 0; e < 8; ++e) base[e * pitch] = (bf16)f2bf(v[e]);
}
__device__ __forceinline__ float tr_at(const LAS bf16* Tm, int pitch, int row, int col) { return __builtin_bit_cast(float, (unsigned)Tm[row * pitch + (col ^ (((row >> 3) & 7) << 3))] << 16); }
__device__ __forceinline__ void ld8f(const LAS float* p, float (&v)[8]) { const f32x4 a = *(const LAS f32x4*)p, b = *(const LAS f32x4*)(p + 4); v[0] = a[0]; v[1] = a[1]; v[2] = a[2]; v[3] = a[3]; v[4] = b[0]; v[5] = b[1]; v[6] = b[2]; v[7] = b[3]; }
__device__ __forceinline__ void st8f(LAS float* p, const float (&v)[8]) { *(LAS f32x4*)p = (f32x4){v[0], v[1], v[2], v[3]}; *(LAS f32x4*)(p + 4) = (f32x4){v[4], v[5], v[6], v[7]}; }

template <bool FINAL>
__device__ __forceinline__ void rwkv_chunk_unit(Frame& F, int layer, int u) {
    const int tid = otid(), w = __builtin_amdgcn_readfirstlane(tid >> 6);
    bf16x8 lfr[16];
#define IDS() const int ft = fresh_tid(tid); const int lane = ft & 63, r16 = lane & 15, q4 = lane >> 4, tok = ft >> 3, part = ft & 7; (void)lane; (void)r16; (void)q4; (void)tok; (void)part
    const int b = u >> 9, sc = (u >> 3) & 63, h = u & 7;
    constexpr int NV = FINAL ? 64 : 128, NVT = NV / 16, NZ = NVT / 2;
    constexpr int X_TW = 0, X_XA = 9216, X_SG = 18432, X_KF = 35840, X_RF = 52224;
    constexpr int O_AT = 0, O_RT = 9216, O_BT = 18432, O_KT = 27648, O_BH = 36864, O_KH = 46080, O_VT = 55296, O_TF = O_BT;
    constexpr int Y0 = 68608;
    constexpr int Y_A = Y0, Y_B = Y0 + 8192, Y_K = Y0 + 16384, Y_R = Y0 + 24576, Y_L = Y0 + 32768, Y_VF = Y0 + 49152;
    constexpr int Y_AAB = Y0, Y_AAK = Y0 + 17408, Y_ARB = Y_AAK + 9216, Y_ARK = Y_ARB + 9216, Y_TB = FINAL ? Y_ARK + 9216 : Y_AAK + 9216, Y_ZU = Y_TB + 9216, Y_YF = Y_AAB;
    static_assert(Y_ZU + NV * PT * 2 <= Y0 + 65536, "region Y");
    constexpr int Z0 = Y0 + 65536, Z_G = Z0, Z_S = FINAL ? Z0 + 8192 : Z0, Z_MISC = 152576, Z_BON = Z_MISC, Z_PC = Z_MISC + 256, Z_PAR = Z_MISC + 512, Z_XS = Y_ZU;
    static_assert(Z_S + NV * PT * 2 <= Z_MISC && Z_PAR + 832 * 4 <= LDSCTL_OFF, "region Z");
    LAS unsigned char* L = F.lds;
#define LB(off) ((LAS bf16*)(L + (off)))
#define LF(off) ((LAS float*)(L + (off)))
    {
        const int pidx = (w == 0) ? 5 : (w == 1) ? 7 : (w == 2) ? 9 : (w == 3) ? 10 : (w == 4) ? 11 : (w == 5) ? 12 : 13;
        if (w < 7) LF(Z_PAR)[w * 64 + (tid & 63)] = (INP(pidx) + layer * 512 + h * 64)[tid & 63];
        const float* mu = INP(3) + layer * 1792;
        for (int i = tid; i < 384; i += 512) LF(Z_PAR)[448 + i] = mu[(i < 64) ? (h * 64 + i) : (i < 128) ? (512 + h * 64 + (i - 64)) : (1536 + (i - 128))];
    }
    __syncthreads();
    const bf16* WupT = (const bf16*)(F.ws + WS_LORA + (size_t)layer * LORA_STRIDE) + h * 64 * 64;
    const bf16* AupT = (const bf16*)(F.ws + WS_LORA + (size_t)layer * LORA_STRIDE + 65536) + h * 64 * 64;
    const bf16* GupT = (const bf16*)(F.ws + WS_LORA + (size_t)layer * LORA_STRIDE + 131072) + h * 64 * 128;
    const bf16* P = (const bf16*)(F.ws + WS_BIG); const bf16* vsrc = (const bf16*)(F.ws + (layer == 0 ? WS_VF : WS_VMIX));
    float* Nbuf = (float*)(F.st + 0) + (size_t)u * 4096; bf16* MT = (bf16*)(F.ws + WS_MT) + (size_t)u * 4096;
    { IDS();
        if (w < 4) {
#pragma unroll
            for (int nt = 0; nt < 4; ++nt)
#pragma unroll
                for (int k2 = 0; k2 < 2; ++k2) { lfr[nt * 4 + k2] = *(const bf16x8*)(WupT + (size_t)(16 * nt + r16) * 64 + 32 * k2 + 8 * q4); lfr[nt * 4 + 2 + k2] = *(const bf16x8*)(AupT + (size_t)(16 * nt + r16) * 64 + 32 * k2 + 8 * q4); }
        } else if (FINAL) {
#pragma unroll
            for (int nt = 0; nt < 4; ++nt)
#pragma unroll
                for (int k4 = 0; k4 < 4; ++k4) lfr[nt * 4 + k4] = *(const bf16x8*)(GupT + (size_t)(16 * nt + r16) * 128 + 32 * k4 + 8 * q4);
        } }
    constexpr int NST = FINAL ? 2 : 4;
    f32x4 Sacc[NST];
    const int s_vb = FINAL ? (w & 3) : w;
#define S_CT(ti) (FINAL ? (2 * (w >> 2) + (ti)) : (ti))
    { IDS();
#pragma unroll
    for (int ti = 0; ti < NST; ++ti) {
        const int ct = S_CT(ti);
#pragma unroll
        for (int jj = 0; jj < 4; ++jj) { const int v = 16 * s_vb + 4 * q4 + jj, c = 16 * ct + r16;
            float x; if (FINAL) x = Nbuf[v * 64 + c]; else x = (v >= 64 && v - 64 == c) ? 1.f : 0.f;
            Sacc[ti][jj] = x; LB(Z_S)[v * PT + c] = (bf16)f2bf(x); }
    } }
    u32x4 pfc[6], pfp[6], pfv;
#define RW_PREFETCH(jn) do { IDS(); const int t_ = sc * 256 + (jn) * 64 + tok; const size_t m_ = (size_t)b * T + t_; const bf16* cur_ = P + m_ * PLD; \
        _Pragma("unroll") for (int i_ = 0; i_ < 6; ++i_) { const int col_ = (i_ == 0) ? (h * 64 + 8 * part) : (i_ == 1) ? (512 + h * 64 + 8 * part) : (i_ == 2) ? (1536 + 8 * part) : (i_ == 3) ? (1600 + 8 * part) : (1664 + 8 * part + (i_ - 4) * 64); \
            pfc[i_] = *(const u32x4*)(cur_ + col_); pfp[i_] = (t_ > 0) ? *(const u32x4*)(cur_ - PLD + col_) : (u32x4){0u, 0u, 0u, 0u}; } \
        pfv = *(const u32x4*)(vsrc + m_ * 512 + h * 64 + 8 * part); } while (0)
    RW_PREFETCH(0);
    for (int j = 0; j < 4; ++j) {
        const int tl0 = sc * 256 + j * 64;
        {
            IDS();
            const int t = tl0 + tok; const size_t m = (size_t)b * T + t; const bf16* cur = P + m * PLD;
#pragma unroll
            for (int i = 0; i < 6; ++i) {
                const int col = (i == 0) ? (h * 64 + 8 * part) : (i == 1) ? (512 + h * 64 + 8 * part) : (i == 2) ? (1536 + 8 * part) : (i == 3) ? (1600 + 8 * part) : (1664 + 8 * part + (i - 4) * 64);
                float c[8], p[8]; unpack8(pfc[i], c); unpack8(pfp[i], p); (void)col;
#pragma unroll
                for (int e = 0; e < 8; ++e) c[e] = c[e] + (p[e] - c[e]) * LF(Z_PAR)[448 + ((i < 4) ? 64 * i : 256 + 64 * (i - 4)) + 8 * part + e];
                if (i == 0) { st8f(LF(X_RF) + tok * 64 + 8 * part, c);
                } else if (i == 1) { st8f(LF(X_KF) + tok * 64 + 8 * part, c);
                } else if (i == 2) {
#pragma unroll
                    for (int e = 0; e < 8; ++e) c[e] = fast_tanh(c[e]);
                    *(LAS u32x4*)(LB(X_TW) + tok * PT + 8 * part) = pack8(c);
                } else if (i == 3) {
                    *(LAS u32x4*)(LB(X_XA) + tok * PT + 8 * part) = pack8(c);
                } else if (FINAL) {
#pragma unroll
                    for (int e = 0; e < 8; ++e) c[e] = sigm(c[e]);
                    *(LAS u32x4*)(LB(X_SG) + tok * PT2 + 8 * part + (i - 4) * 64) = pack8(c);
                }
            }
            float v[8]; unpack8(pfv, v); (void)m; (void)cur;
            st8f(LF(Y_VF) + tok * 64 + 8 * part, v);
        }
        if (j < 3) RW_PREFETCH(j + 1);
        __syncthreads();
        { IDS();
        if (w < 4) {
            const int rb = w;
            float inv[4], bs[4] = {0.f, 0.f, 0.f, 0.f};
            { float ss[4] = {0.f, 0.f, 0.f, 0.f};
#pragma unroll
                for (int nt = 0; nt < 4; ++nt) { const int c = 16 * nt + r16; const float kkc = LF(Z_PAR)[128 + c];
#pragma unroll
                    for (int jj = 0; jj < 4; ++jj) { const float kk = LF(X_KF)[(16 * rb + 4 * q4 + jj) * 64 + c] * kkc; ss[jj] += kk * kk; } }
#pragma unroll
                for (int jj = 0; jj < 4; ++jj) inv[jj] = __builtin_amdgcn_rsqf(fmaxf(redl16(ss[jj]), 1e-24f)); }
#pragma unroll
            for (int nt = 0; nt < 4; ++nt) {
                f32x4 aw = FZ4, aa = FZ4;
#pragma unroll
                for (int k2 = 0; k2 < 2; ++k2) { aw = mfma16(*(const LAS bf16x8*)(LB(X_TW) + (16 * rb + r16) * PT + 32 * k2 + 8 * q4), lfr[nt * 4 + k2], aw); aa = mfma16(*(const LAS bf16x8*)(LB(X_XA) + (16 * rb + r16) * PT + 32 * k2 + 8 * q4), lfr[nt * 4 + 2 + k2], aa); }
                const int c = 16 * nt + r16; const float w0c = LF(Z_PAR)[c], a0c = LF(Z_PAR)[64 + c], kkc = LF(Z_PAR)[128 + c], kac = LF(Z_PAR)[192 + c], rkc = LF(Z_PAR)[256 + c];
#pragma unroll
                for (int jj = 0; jj < 4; ++jj) { const int t = 16 * rb + 4 * q4 + jj, o = t * 64 + c;
                    LF(Y_L)[o] = -0.8750455979f * sigm(w0c + aw[jj]);
                    const float al = sigm(a0c + aa[jj]), kraw = LF(X_KF)[o], rr = LF(X_RF)[o], kn = kraw * kkc * inv[jj];
                    const float knew = kraw * (1.f + (al - 1.f) * kac);
                    LB(Y_A)[o] = (bf16)f2bf(-kn); LB(Y_B)[o] = (bf16)f2bf(kn * al); LB(Y_K)[o] = (bf16)f2bf(knew); LB(Y_R)[o] = (bf16)f2bf(rr);
                    bs[jj] += rr * knew * rkc; } }
#pragma unroll
            for (int jj = 0; jj < 4; ++jj) { const float sm = redl16(bs[jj]); if (r16 == 0) LF(Z_BON)[16 * rb + 4 * q4 + jj] = sm; }
        } else if (FINAL) {
            const int rb = w - 4;
#pragma unroll
            for (int nt = 0; nt < 4; ++nt) { f32x4 ag = FZ4;
#pragma unroll
                for (int k4 = 0; k4 < 4; ++k4) ag = mfma16(*(const LAS bf16x8*)(LB(X_SG) + (16 * rb + r16) * PT2 + 32 * k4 + 8 * q4), lfr[nt * 4 + k4], ag);
#pragma unroll
                for (int jj = 0; jj < 4; ++jj) LB(Z_G)[(16 * rb + 4 * q4 + jj) * 64 + 16 * nt + r16] = (bf16)f2bf(ag[jj]); }
        } }
        __syncthreads();
        if (w == 0) { IDS(); float run = 0.f;
#pragma unroll 8
            for (int t = 0; t < 64; ++t) { run += LF(Y_L)[t * 64 + lane]; LF(Y_L)[t * 64 + lane] = run; }
            LF(Z_PC)[lane] = ex2(run); }
        __syncthreads();
        {
            IDS(); const int t = tok, c0 = 8 * part;
            float Lt[8], Lp[8], Le[8], av[8], bv[8], kv[8], rv[8], vv[8], at[8], rt[8], bt[8], kt[8], bh[8], kh[8];
            ld8f(LF(Y_L) + t * 64 + c0, Lt); ld8f(LF(Y_L) + 63 * 64 + c0, Le); ld8f(LF(Y_VF) + t * 64 + c0, vv);
            if (t > 0) ld8f(LF(Y_L) + (t - 1) * 64 + c0, Lp); else {
#pragma unroll
                for (int e = 0; e < 8; ++e) Lp[e] = 0.f; }
            unpack8(*(const LAS u32x4*)(LB(Y_A) + t * 64 + c0), av); unpack8(*(const LAS u32x4*)(LB(Y_B) + t * 64 + c0), bv);
            unpack8(*(const LAS u32x4*)(LB(Y_K) + t * 64 + c0), kv); unpack8(*(const LAS u32x4*)(LB(Y_R) + t * 64 + c0), rv);
#pragma unroll
            for (int e = 0; e < 8; ++e) { const float eL = ex2(Lt[e]), eLm = ex2(Lp[e]), eN = ex2(-Lt[e]), eE = ex2(Le[e] - Lt[e]);
                at[e] = av[e] * eLm; rt[e] = rv[e] * eL; bt[e] = bv[e] * eN; kt[e] = kv[e] * eN; bh[e] = bv[e] * eE; kh[e] = kv[e] * eE; }
            tr_write8(LB(O_BH), PT, c0, t, bh, part); tr_write8(LB(O_KH), PT, c0, t, kh, part); tr_write8(LB(O_VT), PT, c0, t, vv, part);
            *(LAS u32x4*)(LB(O_AT) + t * PT + c0) = pack8(at); *(LAS u32x4*)(LB(O_RT) + t * PT + c0) = pack8(rt);
            *(LAS u32x4*)(LB(O_BT) + t * PT + c0) = pack8(bt); *(LAS u32x4*)(LB(O_KT) + t * PT + c0) = pack8(kt);
        }
        __syncthreads();
        {
            IDS(); const int rb = w & 3;
#pragma unroll
            for (int ci = 0; ci < 2; ++ci) { const int ct = 2 * (w >> 2) + ci;
                f32x4 ab = FZ4, ak = FZ4, arb = FZ4, ark = FZ4;
                if (ct <= rb) { ab = mm_ll<64>(LB(O_AT), PT, 16 * rb, LB(O_BT), PT, 16 * ct, FZ4, lane); ak = mm_ll<64>(LB(O_AT), PT, 16 * rb, LB(O_KT), PT, 16 * ct, FZ4, lane);
                    if (FINAL) { arb = mm_ll<64>(LB(O_RT), PT, 16 * rb, LB(O_BT), PT, 16 * ct, FZ4, lane); ark = mm_ll<64>(LB(O_RT), PT, 16 * rb, LB(O_KT), PT, 16 * ct, FZ4, lane); } }
#pragma unroll
                for (int jj = 0; jj < 4; ++jj) { const int t = 16 * rb + 4 * q4 + jj, i = 16 * ct + r16;
                    LF(Y_AAB)[t * PF + i] = (i < t) ? ab[jj] : 0.f; LB(Y_TB)[t * PT + i] = (bf16)f2bf(((i >> 4) < (t >> 4)) ? ab[jj] : 0.f); LB(Y_AAK)[t * PT + i] = (bf16)f2bf((i < t) ? ak[jj] : 0.f);
                    if (FINAL) { LB(Y_ARB)[t * PT + i] = (bf16)f2bf((i <= t) ? arb[jj] : 0.f); LB(Y_ARK)[t * PT + i] = (bf16)f2bf((i <= t) ? ark[jj] : 0.f); } } }
        }
        __syncthreads();
        {
            IDS(); const int rb = w & 3;
            constexpr int O_DB = O_BT, O_VB = O_BT + 5120;
            if (w == 0) { const int blk = lane >> 4, col = lane & 15; float x[16];
#pragma unroll
                for (int i = 0; i < 16; ++i) x[i] = (i == col) ? 1.f : 0.f;
#pragma unroll
                for (int g3 = 0; g3 < 3; ++g3) {
                    f32x4 ar[5][4];
#pragma unroll
                    for (int ii = 0; ii < 5; ++ii) { const int i = 1 + 5 * g3 + ii;
#pragma unroll
                        for (int g4 = 0; g4 < 4; ++g4) if (4 * g4 < i) ar[ii][g4] = *(const LAS f32x4*)(LF(Y_AAB) + (16 * blk + i) * PF + 16 * blk + 4 * g4); }
                    asm volatile("" ::: "memory");
#pragma unroll
                    for (int ii = 0; ii < 5; ++ii) { const int i = 1 + 5 * g3 + ii; float sacc = 0.f;
#pragma unroll
                        for (int m2 = 0; m2 < i; ++m2) sacc += ar[ii][m2 >> 2][m2 & 3] * x[m2];
                        x[i] += sacc; }
                }
#pragma unroll
                for (int i = 0; i < 16; ++i) LB(O_DB)[(16 * blk + i) * 40 + col] = (bf16)f2bf(x[i]);
                *(LAS u32x4*)(LB(O_DB) + lane * 40 + 16) = (u32x4){0u, 0u, 0u, 0u}; *(LAS u32x4*)(LB(O_DB) + lane * 40 + 24) = (u32x4){0u, 0u, 0u, 0u}; }
            if (lane < 16) { *(LAS u32x4*)(LB(O_VB) + w * 640 + lane * 40 + 16) = (u32x4){0u, 0u, 0u, 0u}; *(LAS u32x4*)(LB(O_VB) + w * 640 + lane * 40 + 24) = (u32x4){0u, 0u, 0u, 0u}; }
#pragma unroll
            for (int ci = 0; ci < NZ; ++ci) { const int vt = (w >> 2) * NZ + ci;
                f32x4 z = mm_ll<64>(LB(O_AT), PT, 16 * rb, LB(Z_S), PT, 16 * vt, FZ4, lane);
                if (vt < 4) z = mm_ll<64, false, true>(LB(Y_AAK), PT, 16 * rb, LB(O_VT), PT, 16 * vt, z, lane);
                st4bf(LB(Y_ZU) + (16 * vt + r16) * PT + 16 * rb + 4 * q4, z); }
            __syncthreads();
            if (w < NVT) { const int vt = w; LAS bf16* vb = LB(O_VB) + w * 640; LAS bf16* zrow = LB(Y_ZU) + (16 * vt + r16) * PT;
#pragma unroll
                for (int bb = 0; bb < 4; ++bb) {
                    f32x4 acc; { const u32x2 zz = *(const LAS u32x2*)(zrow + 16 * bb + 4 * q4); acc[0] = bflo(zz.x); acc[1] = bfhi(zz.x); acc[2] = bflo(zz.y); acc[3] = bfhi(zz.y); }
                    if (bb >= 1) acc = mfma16(*(const LAS bf16x8*)(LB(Y_TB) + (16 * bb + r16) * PT + 8 * q4), *(const LAS bf16x8*)(zrow + 8 * q4), acc);
                    if (bb >= 3) acc = mfma16(*(const LAS bf16x8*)(LB(Y_TB) + (16 * bb + r16) * PT + 32 + 8 * q4), *(const LAS bf16x8*)(zrow + 32 + 8 * q4), acc);
                    st4bf(vb + r16 * 40 + 4 * q4, acc);
                    const f32x4 ub = mfma16(*(const LAS bf16x8*)(LB(O_DB) + (16 * bb + r16) * 40 + 8 * q4), *(const LAS bf16x8*)(vb + r16 * 40 + 8 * q4), FZ4);
                    st4bf(zrow + 16 * bb + 4 * q4, ub); }
            }
        }
        __syncthreads();
        {
            IDS(); f32x4 yy[2];
            if (FINAL) { const int rb = w & 3;
#pragma unroll
                for (int ci = 0; ci < 2; ++ci) { const int ct = 2 * (w >> 2) + ci;
                    f32x4 y = mm_ll<64>(LB(O_RT), PT, 16 * rb, LB(Z_S), PT, 16 * ct, FZ4, lane);
                    y = mm_ll<64>(LB(Y_ARB), PT, 16 * rb, LB(Y_ZU), PT, 16 * ct, y, lane);
                    yy[ci] = mm_ll<64, false, true>(LB(Y_ARK), PT, 16 * rb, LB(O_VT), PT, 16 * ct, y, lane); } }
#pragma unroll
            for (int ti = 0; ti < NST; ++ti) { const int ct = S_CT(ti); const float pc = LF(Z_PC)[16 * ct + r16];
                f32x4 s = Sacc[ti] * pc;
                s = mm_ll<64, false, true>(LB(Y_ZU), PT, 16 * s_vb, LB(O_BH), PT, 16 * ct, s, lane);
                if (s_vb < 4) s = mm_ll<64, true, true>(LB(O_VT), PT, 16 * s_vb, LB(O_KH), PT, 16 * ct, s, lane);
                Sacc[ti] = s; }
            __syncthreads();
#pragma unroll
            for (int ti = 0; ti < NST; ++ti) { const int ct = S_CT(ti);
#pragma unroll
                for (int jj = 0; jj < 4; ++jj) LB(Z_S)[(16 * s_vb + 4 * q4 + jj) * PT + 16 * ct + r16] = (bf16)f2bf(Sacc[ti][jj]); }
            if (FINAL) { const int rb = w & 3;
#pragma unroll
                for (int ci = 0; ci < 2; ++ci) { const int ct = 2 * (w >> 2) + ci;
#pragma unroll
                    for (int jj = 0; jj < 4; ++jj) LF(Y_YF)[(16 * rb + 4 * q4 + jj) * PF + 16 * ct + r16] = yy[ci][jj]; } }
        }
        __syncthreads();
        if (FINAL) {
            IDS();
            const int t = tok, c0 = 8 * part; const size_t m = (size_t)b * T + tl0 + t;
            float y[8], gg[8], sm = 0.f; ld8f(LF(Y_YF) + t * PF + c0, y); unpack8(*(const LAS u32x4*)(LB(Z_G) + t * 64 + c0), gg);
#pragma unroll
            for (int e = 0; e < 8; ++e) sm += y[e];
            const float mean = red8(sm) * (1.f / 64.f); float vs = 0.f;
#pragma unroll
            for (int e = 0; e < 8; ++e) { y[e] -= mean; vs += y[e] * y[e]; }
            const float rs = __builtin_amdgcn_rsqf(red8(vs) * (1.f / 64.f) + 64e-5f), bo = LF(Z_BON)[t];
#pragma unroll
            for (int e = 0; e < 8; ++e) { const int c = c0 + e; y[e] = (y[e] * rs * LF(Z_PAR)[320 + c] + LF(Z_PAR)[384 + c] + bo * tr_at(LB(O_VT), PT, c, t)) * gg[e]; }
            *(u32x4*)((bf16*)(F.ws + WS_BIG) + m * PLD + 1024 + h * 64 + c0) = pack8(y);
        }
        __syncthreads();
    }
    if (!FINAL) { IDS();
#pragma unroll
        for (int ti = 0; ti < NST; ++ti) { const int ct = S_CT(ti);
            if (s_vb < 4) {
#pragma unroll
                for (int jj = 0; jj < 4; ++jj) Nbuf[(16 * s_vb + 4 * q4 + jj) * 64 + 16 * ct + r16] = Sacc[ti][jj];
            } else { u32x2 wv; wv.x = pk2(Sacc[ti][0], Sacc[ti][1]); wv.y = pk2(Sacc[ti][2], Sacc[ti][3]);
                *(u32x2*)(MT + (16 * ct + r16) * 64 + 16 * (s_vb - 4) + 4 * q4) = wv; }
        }
    }
#undef RW_PREFETCH
#undef IDS
#undef S_CT
#undef LB
#undef LF
}

template <bool FINAL>
__device__ __forceinline__ void ret_chunk_unit(Frame& F, int u) {
    const int tid = otid(), lane = tid & 63, w = __builtin_amdgcn_readfirstlane(tid >> 6), r16 = lane & 15, q4 = lane >> 4;
    const int b = u >> 9, sc = (u >> 3) & 63, h = u & 7;
    constexpr int R_QB = 0, R_KB = 9216, R_KHT = 18432, R_VT = 27648, R_GB = 36864, R_AB = 45056, R_SB = 54272, R_YF = 63488;
    LAS unsigned char* L = F.lds;
#define LB(off) ((LAS bf16*)(L + (off)))
#define LF(off) ((LAS float*)(L + (off)))
    bf16* P = (bf16*)(F.ws + WS_BIG);
    float* Sbuf = (float*)(F.st + 16 * MiB) + (size_t)u * 4096;
    const float lg = log2f(1.f - exp2f(-5.f - (float)h));
    const float g64 = ex2(64.f * lg);
    const int db = w & 3;
    f32x4 Sacc[2];
#pragma unroll
    for (int ci = 0; ci < 2; ++ci) { const int et = 2 * (w >> 2) + ci;
#pragma unroll
        for (int jj = 0; jj < 4; ++jj) Sacc[ci][jj] = FINAL ? Sbuf[(16 * db + 4 * q4 + jj) * 64 + 16 * et + r16] : 0.f;
        if (FINAL) st4bf(LB(R_SB) + (16 * et + r16) * PT + 16 * db + 4 * q4, Sacc[ci]); }
    const int tok = tid >> 3, part = tid & 7;
    u32x4 pq = {0u, 0u, 0u, 0u}, pk, pv, pg = {0u, 0u, 0u, 0u};
#define RET_PREFETCH(jn) do { const bf16* row_ = P + ((size_t)b * T + sc * 256 + (jn) * 64 + tok) * PLD + C_RET + h * 64 + 8 * part; \
        pk = *(const u32x4*)(row_ + 512); pv = *(const u32x4*)(row_ + 1024); if (FINAL) { pq = *(const u32x4*)row_; pg = *(const u32x4*)(row_ + 1536); } } while (0)
    RET_PREFETCH(0);
    for (int j = 0; j < 4; ++j) {
        const int tl0 = sc * 256 + j * 64;
        {
            float qv[8], kv[8], vv[8]; unpack8(pk, kv); unpack8(pv, vv);
            if (FINAL) { unpack8(pq, qv); *(LAS u32x4*)(LB(R_GB) + tok * 64 + 8 * part) = pg; }
            if (j < 3) RET_PREFETCH(j + 1);
            const float zeta = ex2((float)(63 - tok) * lg);
            if (FINAL) { *(LAS u32x4*)(LB(R_QB) + tok * PT + 8 * part) = pack8(qv); *(LAS u32x4*)(LB(R_KB) + tok * PT + 8 * part) = pack8(kv); }
            float kz[8];
#pragma unroll
            for (int e = 0; e < 8; ++e) kz[e] = kv[e] * zeta;
            tr_write8(LB(R_KHT), PT, 8 * part, tok, kz, part); tr_write8(LB(R_VT), PT, 8 * part, tok, vv, part);
        }
        __syncthreads();
        if (FINAL) { const int rb = w & 3;
#pragma unroll
            for (int ci = 0; ci < 2; ++ci) { const int ct = 2 * (w >> 2) + ci; f32x4 a = FZ4;
                if (ct <= rb) a = mm_ll<64>(LB(R_QB), PT, 16 * rb, LB(R_KB), PT, 16 * ct, FZ4, lane);
#pragma unroll
                for (int jj = 0; jj < 4; ++jj) { const int l = 16 * rb + 4 * q4 + jj, s = 16 * ct + r16; LB(R_AB)[l * PT + s] = (bf16)f2bf((s <= l) ? a[jj] * ex2((float)(l - s) * lg) : 0.f); } }
            __syncthreads();
        }
        {
            f32x4 yy[2];
            if (FINAL) { const int rb = w & 3;
#pragma unroll
                for (int ci = 0; ci < 2; ++ci) { const int et = 2 * (w >> 2) + ci;
                    const f32x4 a1 = mm_ll<64, false, true>(LB(R_AB), PT, 16 * rb, LB(R_VT), PT, 16 * et, FZ4, lane), a2 = mm_ll<64>(LB(R_QB), PT, 16 * rb, LB(R_SB), PT, 16 * et, FZ4, lane);
#pragma unroll
                    for (int jj = 0; jj < 4; ++jj) yy[ci][jj] = a1[jj] + ex2((float)(16 * rb + 4 * q4 + jj + 1) * lg) * a2[jj]; } }
#pragma unroll
            for (int ci = 0; ci < 2; ++ci) { const int et = 2 * (w >> 2) + ci; Sacc[ci] = mm_ll<64, true, true>(LB(R_KHT), PT, 16 * db, LB(R_VT), PT, 16 * et, Sacc[ci] * g64, lane); }
            __syncthreads();
            if (FINAL) { const int rb = w & 3;
#pragma unroll
                for (int ci = 0; ci < 2; ++ci) { const int et = 2 * (w >> 2) + ci; st4bf(LB(R_SB) + (16 * et + r16) * PT + 16 * db + 4 * q4, Sacc[ci]);
#pragma unroll
                    for (int jj = 0; jj < 4; ++jj) LF(R_YF)[(16 * rb + 4 * q4 + jj) * PF + 16 * et + r16] = yy[ci][jj]; } }
        }
        __syncthreads();
        if (FINAL) { const size_t m = (size_t)b * T + tl0 + tok; float y[8], g[8], ss = 0.f;
            ld8f(LF(R_YF) + tok * PF + 8 * part, y);
#pragma unroll
            for (int e = 0; e < 8; ++e) ss += y[e] * y[e];
            const float rs = __builtin_amdgcn_rsqf(red8(ss) * (1.f / 64.f) + 1e-6f);
            unpack8(*(const LAS u32x4*)(LB(R_GB) + tok * 64 + 8 * part), g);
#pragma unroll
            for (int e = 0; e < 8; ++e) y[e] = y[e] * rs * silu(g[e]);
            *(u32x4*)(P + m * PLD + C_RETG + h * 64 + 8 * part) = pack8(y);
            __syncthreads(); }
    }
    if (!FINAL) {
#pragma unroll
        for (int ci = 0; ci < 2; ++ci) { const int et = 2 * (w >> 2) + ci;
#pragma unroll
            for (int jj = 0; jj < 4; ++jj) Sbuf[(16 * db + 4 * q4 + jj) * 64 + 16 * et + r16] = Sacc[ci][jj]; }
    }
#undef RET_PREFETCH
#undef LB
#undef LF
}

template <bool FINAL>
__device__ __forceinline__ void ssd_chunk_unit(Frame& F, int layer, int u) {
    const int tid = otid(), w = __builtin_amdgcn_readfirstlane(tid >> 6);
#define IDS() const int ft = fresh_tid(tid); const int lane = ft & 63, r16 = lane & 15, q4 = lane >> 4; (void)lane; (void)r16; (void)q4
    const int b = u >> 9, sc = (u >> 3) & 63, h = u & 7, g = h >> 2;
    constexpr int D_CB = 0, D_BB = 17408, D_BT = 34816, D_YF = 53248, D_XT = 70656, D_XDT = 79872, D_GM = 89088, D_SB = 98304, D_MISC = 115712;
    constexpr int D_DTS = D_MISC, D_ACS = D_MISC + 256, D_CAR = D_MISC + 512;
    LAS unsigned char* L = F.lds;
#define LB(off) ((LAS bf16*)(L + (off)))
#define LF(off) ((LAS float*)(L + (off)))
    bf16* P = (bf16*)(F.ws + WS_BIG); const float* dtb = (const float*)(F.ws + WS_DT);
    const bf16* BND = (const bf16*)(F.ws + WS_BND);
    float* Sbuf = (float*)(F.st + 32 * MiB) + (size_t)u * 8192;
    const float* cw = INP(17) + layer * 1024 * 4; const float* cbias = INP(18) + layer * 1024;
    const float dt_bias = INP(19)[layer * 8 + h], A = -expf(INP(20)[layer * 8 + h]), Dh = INP(21)[layer * 8 + h];
    const int bc_chunk = tid & 31, bc_chn = (bc_chunk < 16) ? (512 + g * 128 + bc_chunk * 8) : (768 + g * 128 + (bc_chunk - 16) * 8);
    const int x_chunk = tid & 7, x_chn = h * 64 + x_chunk * 8;
    const int pb = w & 3;
    f32x4 Sacc[4];
    { IDS();
#pragma unroll
    for (int ci = 0; ci < 4; ++ci) { const int nt = 4 * (w >> 2) + ci;
#pragma unroll
        for (int jj = 0; jj < 4; ++jj) { const float x = FINAL ? Sbuf[(16 * pb + 4 * q4 + jj) * 128 + 16 * nt + r16] : 0.f; Sacc[ci][jj] = x;
            if (FINAL) LB(D_SB)[(16 * pb + 4 * q4 + jj) * PT2 + 16 * nt + r16] = (bf16)f2bf(x); } } }
    float dstot = 0.f;
    u32x4 pbc[4], px; float pdt = 0.f;
#define SSD_PREFETCH(jn) do { const size_t m_ = (size_t)b * T + sc * 256 + (jn) * 64; \
        _Pragma("unroll") for (int it_ = 0; it_ < 4; ++it_) pbc[it_] = *(const u32x4*)(P + (m_ + it_ * 16 + (tid >> 5)) * PLD + C_XBC + bc_chn); \
        px = *(const u32x4*)(P + (m_ + (tid >> 3)) * PLD + C_XBC + x_chn); if (w == 0) pdt = dtb[(m_ + (tid & 63)) * 8 + h]; } while (0)
    SSD_PREFETCH(0);
    for (int j = 0; j < 4; ++j) {
        const int tl0 = sc * 256 + j * 64; const size_t m0 = (size_t)b * T + tl0;
        if (w == 0) {
            IDS(); const float dt = softplus_acc(pdt + dt_bias); float a = A * dt;
#pragma unroll
            for (int o = 1; o < 64; o <<= 1) { const float n = __shfl_up(a, o); if (lane >= o) a += n; }
            LF(D_DTS)[lane] = dt; LF(D_ACS)[lane] = a;
        }
        {
            IDS();
#pragma unroll
            for (int it = 0; it < 4; ++it) { const int t = it * 16 + (ft >> 5); const int ta = tl0 + t;
                float acc[8]; unpack8(pbc[it], acc); (void)ta;
                if (bc_chunk < 16) { *(LAS u32x4*)(LB(D_BB) + t * PT2 + bc_chunk * 8) = pack8(acc); tr_write8(LB(D_BT), PT, bc_chunk * 8, t, acc, bc_chunk & 7); }
                else *(LAS u32x4*)(LB(D_CB) + t * PT2 + (bc_chunk - 16) * 8) = pack8(acc);
            }
        }
        __syncthreads();
        {
            IDS(); const int t = ft >> 3; float acc[8]; unpack8(px, acc);
            if (j < 3) SSD_PREFETCH(j + 1);
            const float sc_d = LF(D_DTS)[t] * __expf(LF(D_ACS)[63] - LF(D_ACS)[t]);
            float xs8[8], xd8[8];
#pragma unroll
            for (int e = 0; e < 8; ++e) { xs8[e] = acc[e]; xd8[e] = acc[e] * sc_d; }
            tr_write8(LB(D_XT), PT, x_chunk * 8, t, xs8, x_chunk); tr_write8(LB(D_XDT), PT, x_chunk * 8, t, xd8, x_chunk);
        }
        if (FINAL) { IDS(); const int rb = w & 3;
#pragma unroll
            for (int ci = 0; ci < 2; ++ci) { const int ct = 2 * (w >> 2) + ci; f32x4 a = FZ4;
                if (ct <= rb) a = mm_ll<128>(LB(D_CB), PT2, 16 * rb, LB(D_BB), PT2, 16 * ct, FZ4, lane);
#pragma unroll
                for (int jj = 0; jj < 4; ++jj) { const int l = 16 * rb + 4 * q4 + jj, s = 16 * ct + r16;
                    LB(D_GM)[l * PT + s] = (bf16)f2bf((s <= l) ? a[jj] * __expf(LF(D_ACS)[l] - LF(D_ACS)[s]) * LF(D_DTS)[s] : 0.f); } } }
        __syncthreads();
        {
            IDS(); f32x4 yy[2];
            if (FINAL) { const int rb = w & 3;
#pragma unroll
                for (int ci = 0; ci < 2; ++ci) { const int pt = 2 * (w >> 2) + ci;
                    const f32x4 a1 = mm_ll<64, false, true>(LB(D_GM), PT, 16 * rb, LB(D_XT), PT, 16 * pt, FZ4, lane), a2 = mm_ll<128>(LB(D_CB), PT2, 16 * rb, LB(D_SB), PT2, 16 * pt, FZ4, lane);
#pragma unroll
                    for (int jj = 0; jj < 4; ++jj) { const int l = 16 * rb + 4 * q4 + jj, p = 16 * pt + r16; yy[ci][jj] = a1[jj] + __expf(LF(D_ACS)[l]) * a2[jj] + Dh * tr_at(LB(D_XT), PT, p, l); } } }
            const float dec = expf(LF(D_ACS)[63]);
#pragma unroll
            for (int ci = 0; ci < 4; ++ci) { const int nt = 4 * (w >> 2) + ci; Sacc[ci] = mm_ll<64, true, true>(LB(D_XDT), PT, 16 * pb, LB(D_BT), PT, 16 * nt, Sacc[ci] * dec, lane); }
            dstot += LF(D_ACS)[63];
            __syncthreads();
            if (FINAL) { const int rb = w & 3;
#pragma unroll
                for (int ci = 0; ci < 4; ++ci) { const int nt = 4 * (w >> 2) + ci;
#pragma unroll
                    for (int jj = 0; jj < 4; ++jj) LB(D_SB)[(16 * pb + 4 * q4 + jj) * PT2 + 16 * nt + r16] = (bf16)f2bf(Sacc[ci][jj]); }
#pragma unroll
                for (int ci = 0; ci < 2; ++ci) { const int pt = 2 * (w >> 2) + ci;
#pragma unroll
                    for (int jj = 0; jj < 4; ++jj) LF(D_YF)[(16 * rb + 4 * q4 + jj) * PF + 16 * pt + r16] = yy[ci][jj]; } }
        }
        __syncthreads();
        if (FINAL) { IDS(); const int tok = ft >> 3, part = ft & 7; float y[8];
            ld8f(LF(D_YF) + tok * PF + 8 * part, y);
            *(u32x4*)(P + (m0 + tok) * PLD + C_XBC + h * 64 + 8 * part) = pack8(y);
            __syncthreads(); }
    }
    if (!FINAL) { IDS();
#pragma unroll
        for (int ci = 0; ci < 4; ++ci) { const int nt = 4 * (w >> 2) + ci;
#pragma unroll
            for (int jj = 0; jj < 4; ++jj) Sbuf[(16 * pb + 4 * q4 + jj) * 128 + 16 * nt + r16] = Sacc[ci][jj]; }
        if (tid == 0) ((float*)(F.ws + WS_DSTOT))[u] = dstot;
    }
#undef SSD_PREFETCH
#undef IDS
#undef LB
#undef LF
}

__device__ __forceinline__ void rwkv_scan_chain(Frame& F, int chain) {
    const int tid = otid(), lane = tid & 63, w = __builtin_amdgcn_readfirstlane(tid >> 6), r16 = lane & 15, q4 = lane >> 4;
    const int b = chain >> 3, h = chain & 7, vb = w & 3, ct0 = 2 * (w >> 2);
    LAS bf16* SB = (LAS bf16*)F.lds;
    f32x4 Sacc[2] = {FZ4, FZ4};
    for (int i = tid; i < 64 * PT / 2; i += 512) ((LAS unsigned*)SB)[i] = 0u;
    f32x4 nv[2]; bf16x8 mf[2][2];
    auto fetch = [&](int sc) {
        const int u = (b * 64 + sc) * 8 + h;
        const float* Nb = (const float*)(F.st + 0) + (size_t)u * 4096; const bf16* MT = (const bf16*)(F.ws + WS_MT) + (size_t)u * 4096;
#pragma unroll
        for (int ci = 0; ci < 2; ++ci) {
#pragma unroll
            for (int jj = 0; jj < 4; ++jj) nv[ci][jj] = Nb[(16 * vb + 4 * q4 + jj) * 64 + 16 * (ct0 + ci) + r16];
#pragma unroll
            for (int k2 = 0; k2 < 2; ++k2) mf[ci][k2] = *(const bf16x8*)(MT + (size_t)(16 * (ct0 + ci) + r16) * 64 + 32 * k2 + 8 * q4); } };
    fetch(0);
    __syncthreads();
    for (int sc = 0; sc < 64; ++sc) {
        const int u = (b * 64 + sc) * 8 + h;
        float* Nb = (float*)(F.st + 0) + (size_t)u * 4096;
        f32x4 nw[2];
#pragma unroll
        for (int ci = 0; ci < 2; ++ci) {
            f32x4 a = nv[ci];
#pragma unroll
            for (int k2 = 0; k2 < 2; ++k2) a = mfma16(*(const LAS bf16x8*)(SB + (16 * vb + r16) * PT + 32 * k2 + 8 * q4), mf[ci][k2], a);
            nw[ci] = a;
#pragma unroll
            for (int jj = 0; jj < 4; ++jj) Nb[(16 * vb + 4 * q4 + jj) * 64 + 16 * (ct0 + ci) + r16] = Sacc[ci][jj]; }
        if (sc + 1 < 64) fetch(sc + 1);
        __syncthreads();
#pragma unroll
        for (int ci = 0; ci < 2; ++ci) { Sacc[ci] = nw[ci];
#pragma unroll
            for (int jj = 0; jj < 4; ++jj) SB[(16 * vb + 4 * q4 + jj) * PT + 16 * (ct0 + ci) + r16] = (bf16)f2bf(nw[ci][jj]); }
        __syncthreads();
    }
}
__device__ __forceinline__ void elem_scans(Frame& F, int blk, int nblk) {
    const int tid = otid();
    const int NRET = 16 * 4096, NSSD = 16 * 8192;
    const float* dst = (const float*)(F.ws + WS_DSTOT);
    for (int it = blk * 512 + tid; it < NRET + NSSD; it += nblk * 512) {
        if (it < NRET) { const int chain = it >> 12, e = it & 4095, b = chain >> 3, h = chain & 7;
            const float g256 = exp2f(256.f * log2f(1.f - exp2f(-5.f - (float)h)));
            float* p = (float*)(F.st + 16 * MiB) + ((size_t)(b * 64) * 8 + h) * 4096 + e; float carry = 0.f;
#pragma unroll 8
            for (int sc = 0; sc < 64; ++sc) { const float t = p[(size_t)sc * 8 * 4096]; p[(size_t)sc * 8 * 4096] = carry; carry = g256 * carry + t; }
        } else { const int i2 = it - NRET, chain = i2 >> 13, e = i2 & 8191, b = chain >> 3, h = chain & 7;
            float* p = (float*)(F.st + 32 * MiB) + ((size_t)(b * 64) * 8 + h) * 8192 + e; const float* d = dst + (b * 64) * 8 + h; float carry = 0.f;
#pragma unroll 8
            for (int sc = 0; sc < 64; ++sc) { const float t = p[(size_t)sc * 8 * 8192]; p[(size_t)sc * 8 * 8192] = carry; carry = expf(d[sc * 8]) * carry + t; }
        }
    }
}
__device__ __forceinline__ void conv_lora(Frame& F) {
    const int tid = otid();
    for (int l = 0; l < 2; ++l) {
        bf16* base = (bf16*)(F.ws + WS_LORA + (size_t)l * LORA_STRIDE);
        const float* wu = INP(4) + l * 64 * 512; const float* au = INP(6) + l * 64 * 512; const float* gu = INP(8) + l * 128 * 512;
        for (int i = F.vcu * 512 + tid; i < 512 * 64; i += F.G * 512) { const int c = i >> 6, jx = i & 63; base[i] = (bf16)f2bf(wu[jx * 512 + c]); base[32768 + i] = (bf16)f2bf(au[jx * 512 + c]); }
        for (int i = F.vcu * 512 + tid; i < 512 * 128; i += F.G * 512) { const int c = i >> 7, jx = i & 127; base[65536 + i] = (bf16)f2bf(gu[jx * 512 + c]); }
    }
}
__device__ __forceinline__ void conv_vlora(Frame& F) {
    const int tid = otid();
    bf16* vdT = (bf16*)(F.ws + WS_VLORA); bf16* vuT = vdT + 32 * 512;
    const float* vdn = INP(14); const float* vup = INP(15);
    for (int i = F.vcu * 512 + tid; i < 32 * 512; i += F.G * 512) { const int j = i >> 9, c = i & 511; vdT[i] = (bf16)f2bf(vdn[c * 32 + j]); }
    for (int i = F.vcu * 512 + tid; i < 512 * 32; i += F.G * 512) { const int c = i >> 5, j = i & 31; vuT[i] = (bf16)f2bf(vup[j * 512 + c]); }
}
__device__ __forceinline__ void save_bnd(Frame& F) {
    const int tid = otid();
    const bf16* P = (const bf16*)(F.ws + WS_BIG); bf16* BND = (bf16*)(F.ws + WS_BND);
    for (int i = F.vcu * 512 + tid; i < 2 * 64 * 3 * 64; i += F.G * 512) { const int ch = i & 63, k = (i >> 6) % 3, bs = i / 192, b = bs >> 6, sc = bs & 63;
        if (sc > 0) *(u32x4*)(BND + (size_t)(bs * 3 + k) * 512 + ch * 8) = *(const u32x4*)(P + ((size_t)b * T + sc * 256 - 3 + k) * PLD + C_XBC + ch * 8); }
}

__device__ __forceinline__ void stagger(int cid) { const int dly = __builtin_amdgcn_readfirstlane((cid >> 3) & 7); for (int i = 0; i < dly; ++i) __builtin_amdgcn_s_sleep(16); }
constexpr int LAYER_BASE0 = 1, LAYER_STRIDE = 18, MOE_BASE = LAYER_BASE0 + LAYER_STRIDE + 15;
__device__ __forceinline__ Frame lf(const Frame& F0) {
    Frame F = F0; unsigned l = (unsigned)(unsigned long long)F.lds;
    asm volatile("" : "+s"(l), "+s"(F.vcu), "+s"(F.G), "+s"(F.cid), "+s"(F.wid), "+s"(F.out), "+s"(F.ws), "+s"(F.st));
    F.lds = (LAS unsigned char*)(unsigned long long)l; return F;
}
__global__ void __launch_bounds__(512, 2) fwd(Args args) {
    extern __shared__ __attribute__((aligned(16))) unsigned char lds_raw[];
    Frame F0;
    F0.lds = (LAS unsigned char*)lds_raw;
    F0.G = gridDim.x; { const int bx = blockIdx.x; F0.vcu = (F0.G % 8 == 0) ? (bx % 8) * (F0.G / 8) + bx / 8 : bx; }
    F0.cid = blockIdx.x; F0.out = args.out; F0.ws = args.ws; F0.wid = __builtin_amdgcn_readfirstlane(threadIdx.x >> 6); F0.st = args.ws + WS_XB;
    volatile LAS unsigned* MISC = (volatile LAS unsigned*)(F0.lds + MISC_OFF);
    for (int u = threadIdx.x; u < (LDS_BYTES - LDSCTL_OFF) / 4; u += 512) ((LAS unsigned*)(F0.lds + LDSCTL_OFF))[u] = 0u;
    __syncthreads();
    if (threadIdx.x < 34) *(LAS unsigned long long*)(F0.lds + LDSCTL_OFF + 8 * threadIdx.x) = (unsigned long long)args.in[threadIdx.x];
    __syncthreads();
    const int lo = args.ph_lo, hi = args.ph_hi;
    XcdBarrier bar; bar.bar = (unsigned*)(F0.ws + WS_CTL); bar.x = 0; bar.st = nullptr;
    if (hi - lo > 1) bar = xcd_barrier_post((unsigned*)(F0.ws + WS_CTL), MISC + 8);
#define IN(k) (lo <= (k) && (k) < hi)
#define SEAM(k) do { if (IN(k) && IN((k) + 1)) xcd_barrier(bar); } while (0)
#define WSP(T_, off) ((T_*)(F.ws + (off)))

    if (IN(0)) { Frame F = lf(F0); conv_layer_weights(F, 0, 0); conv_lora(F); conv_vlora(F); xprep_phase(F, INP(0)); }
    SEAM(0);
    for (int l = 0; l < 2; ++l) {
        const int pb = LAYER_BASE0 + l * LAYER_STRIDE;
        F0.st = (unsigned char*)F0.out;
        if (IN(pb + 0)) {
            Frame F = lf(F0); unsigned char* wl = F.ws + WS_W + (size_t)l * WL_STRIDE;
            pg8::Gemm g{WSP(bf16, WS_XB), (const bf16*)(wl + WL_IN), D, D, D}; pg8::StaticOrder S; S.init(M, NP, F.G, F.cid, D, D);
            pg8::EpiInProj E{WSP(bf16, WS_BIG), (l == 0) ? WSP(float, WS_RSTD) : WSP(float, WS_SS1), WSP(float, WS_DT), l};
            stagger(F.cid); pg8::gemm_phase(F.lds, F.wid, g, S, E);
        }
        SEAM(pb + 0);
        if (IN(pb + 1)) { Frame F = lf(F0); vprep_phase(F, l); prepass_a(F); }
        SEAM(pb + 1);
        if (IN(pb + 2)) { Frame F = lf(F0); prepass_conv(F, l); }
        if (IN(pb + 2) && IN(pb + 3)) xcd_barrier(bar);
        if (IN(pb + 3)) for (int rep = 0; rep <= REP_R1; ++rep) {
#if RW_CH
            for (int r2 = 0; r2 <= REP_RW; ++r2) { Frame F = lf(F0); for (int u = F.cid; u < 1024; u += F.G) rwkv_chunk_unit<false>(F, l, u); }
#else
            { Frame F = lf(F0); if (F.cid < 16) rwkv_seq(F, l, F.cid); }
#endif
#if RET_CH
            for (int r2 = 0; r2 <= REP_RET; ++r2) { Frame F = lf(F0); for (int u = F.cid; u < 1024; u += F.G) ret_chunk_unit<false>(F, u); }
#else
            { Frame F = lf(F0); if (F.cid >= 32 && F.cid < 48) ret_seq(F, F.cid - 32); }
#endif
#if SSD_CH
            for (int r2 = 0; r2 <= REP_SSD; ++r2) { Frame F = lf(F0); for (int u = F.cid; u < 1024; u += F.G) ssd_chunk_unit<false>(F, l, u); }
#else
            { Frame F = lf(F0); if (F.cid >= 16 && F.cid < 32) ssd_seq(F, l, F.cid - 16); }
#endif
        }
        SEAM(pb + 3);
        if (IN(pb + 4)) {
            Frame F = lf(F0);
            if (F.cid < 16) { if (RW_CH) rwkv_scan_chain(F, F.cid); }
            else elem_scans(F, F.cid - 16, F.G - 16);
            if (l == 0 && F.cid >= 16) { Frame Fc = lf(F0); Fc.vcu = Fc.cid - 16; Fc.G = Fc.G - 16;
                conv_layer_weights(Fc, 0, 1); conv_layer_weights(Fc, 1, 0); conv_layer_weights(Fc, 1, 1); conv_ffn_weights(Fc); }
            if (l == 1 && F.cid >= 16) { Frame Fc = lf(F0); Fc.vcu = Fc.cid - 16; Fc.G = Fc.G - 16; conv_moe_weights(Fc); }
        }
        SEAM(pb + 4);
        if (IN(pb + 5)) {
#if RW_CH
            { Frame F = lf(F0); for (int u = F.cid; u < 1024; u += F.G) rwkv_chunk_unit<true>(F, l, u); }
#endif
#if RET_CH
            { Frame F = lf(F0); for (int u = F.cid; u < 1024; u += F.G) ret_chunk_unit<true>(F, u); }
#endif
#if SSD_CH
            { Frame F = lf(F0); for (int u = F.cid; u < 1024; u += F.G) ssd_chunk_unit<true>(F, l, u); }
#endif
        }
        SEAM(pb + 5);
        if (IN(pb + 6)) { Frame F = lf(F0); ssm_norm_phase(F, l); }
        SEAM(pb + 6);
        if (IN(pb + 7)) {
            Frame F = lf(F0); unsigned char* wl = F.ws + WS_W + (size_t)l * WL_STRIDE; bf16* P = WSP(bf16, WS_BIG);
            pg8::Gemm g{P, (const bf16*)(wl + WL_BR), PLD, 512, 512}; pg8::BranchOrder S; S.init(F.G, F.cid);
            pg8::EpiPlain E{P, WSP(bf16, WS_VMIX)};
            stagger(F.cid); pg8::gemm_phase(F.lds, F.wid, g, S, E);
        }
        SEAM(pb + 7);
        if (IN(pb + 8)) {
            Frame F = lf(F0); unsigned char* wl = F.ws + WS_W + (size_t)l * WL_STRIDE; bf16* P = WSP(bf16, WS_BIG);
            pg8::Gemm g{WSP(bf16, WS_XB), (const bf16*)(wl + WL_GATE), D, D, D}; pg8::GateOrder S; S.init(F.G, F.cid);
            pg8::EpiGateMerge E{P, WSP(const bf16, WS_VMIX), P + C_RET, PLD, (l == 0) ? WSP(float, WS_RSTD) : WSP(float, WS_SS1), l};
            stagger(F.cid); pg8::gemm_phase(F.lds, F.wid, g, S, E);
        }
        if (IN(pb + 8) && IN(pb + 13)) xcd_barrier(bar);
        if (IN(pb + 13)) {
            Frame F = lf(F0); unsigned char* wl = F.ws + WS_W + (size_t)l * WL_STRIDE; bf16* P = WSP(bf16, WS_BIG);
            pg8::Gemm g{P + C_RET, (const bf16*)(wl + WL_OUT), PLD, D, D}; pg8::StaticOrder S; S.init(M, D, F.G, F.cid, PLD, D);
            pg8::EpiResidB E{WSP(bf16, WS_XB), (l == 0) ? WSP(float, WS_SS2) : nullptr, nullptr};
            stagger(F.cid); pg8::gemm_phase(F.lds, F.wid, g, S, E);
        }
        SEAM(pb + 13);
        if (IN(pb + 14)) { Frame F = lf(F0); if (l == 1) router_phase(F); }
        if (l == 1) SEAM(pb + 14);
        if (l == 0) {
            if (IN(pb + 15)) {
                Frame F = lf(F0);
                pg8::Gemm g{WSP(bf16, WS_XB), WSP(const bf16, WS_FFUP), D, D, D}; pg8::StaticOrder S; S.init(M, 2 * FF, F.G, F.cid, D, D);
                pg8::EpiSwiglu E{WSP(bf16, WS_ACT), FF, WSP(float, WS_SS2), 1};
                stagger(F.cid); pg8::gemm_phase(F.lds, F.wid, g, S, E);
            }
            SEAM(pb + 15);
            if (IN(pb + 16)) {
                Frame F = lf(F0);
                pg8::Gemm g{WSP(const bf16, WS_ACT), WSP(const bf16, WS_FFDN), FF, FF, FF}; pg8::StaticOrder S; S.init(M, D, F.G, F.cid, FF, FF);
                pg8::EpiResidB E{WSP(bf16, WS_XB), WSP(float, WS_SS1), nullptr};
                stagger(F.cid); pg8::gemm_phase(F.lds, F.wid, g, S, E);
            }
            if (IN(pb + 16) && IN(pb + 18)) xcd_barrier(bar);
        }
    }
    {
        const int pb = MOE_BASE;
        for (int st = 0; st < 6; ++st) {
            const int isup = (st == 0 || st == 2 || st == 3), sg = (st < 2) ? 0 : ((st == 2 || st == 4) ? 1 : 2);
            if (IN(pb + st)) {
                if (isup) {
                    Frame F = lf(F0);
                    unsigned char* wb = (unsigned char*)F.out + MOEW_OUT; const size_t b6 = (size_t)((F.ws + WS_FFUP) - wb), b7 = (size_t)((F.ws + WS_VF + 16 * MiB) - wb);
                    pg8::Gemm g{WSP(bf16, WS_X8), (const bf16*)wb, D / 2, D / 2, D / 2}; pg8::MoeOrder<true> S; S.init(WSP(const int, WS_CNT), WSP(const int, WS_LIST), sg, 2 * FFE, F.G, F.cid, D / 2, D / 2, MOEW_STRIDE, b6, b7);
                    pg8::EpiSwiglu8 E{(sg == 2) ? WSP(unsigned char, WS_ACT2) : WSP(unsigned char, WS_ACT), FFE};
                    stagger(F.cid); pg8::gemm_phase<pg8::EpiSwiglu8, pg8::MoeOrder<true>, true>(F.lds, F.wid, g, S, E);
                } else {
                    Frame F = lf(F0);
                    const int ksp = (sg == 2) ? MOE_KSP : 1;
                    unsigned char* wb = (unsigned char*)F.out + MOEW_OUT; const size_t b6 = (size_t)((F.ws + WS_FFUP) - wb), b7 = (size_t)((F.ws + WS_VF + 16 * MiB) - wb);
                    pg8::Gemm g{(sg == 2) ? WSP(const bf16, WS_ACT2) : WSP(const bf16, WS_ACT), (const bf16*)(wb + MOEW_DN), FFE / 2, FFE / 2, FFE / 2 / ksp}; pg8::MoeOrder<false> S; S.init(WSP(const int, WS_CNT), WSP(const int, WS_LIST), sg, D, F.G, F.cid, FFE / 2, FFE / 2, MOEW_STRIDE, b6, b7, ksp, FFE / 2 / ksp);
                    pg8::EpiMoeOut E{(sg == 0) ? WSP(bf16, WS_YP0) : (sg == 1 ? WSP(bf16, WS_YP1) : WSP(bf16, WS_YP2)), YP2_STRIDE / 2, 1.f / 1024.f};
                    stagger(F.cid); pg8::gemm_phase<pg8::EpiMoeOut, pg8::MoeOrder<false>, true>(F.lds, F.wid, g, S, E);
                }
            }
            SEAM(pb + st);
        }
        if (IN(pb + 6)) { Frame F = lf(F0); final_norm_phase(F); }
    }
#undef IN
#undef SEAM
#undef WSP
}
constexpr int LAST_PHASE = MOE_BASE + 6;
constexpr int N_PH = LAST_PHASE + 1;

extern "C" void kernel_launch(void* const* d_in, const int* in_sizes, int n_in, void* d_out, int out_size, void* d_ws, size_t ws_size, hipStream_t stream) {
    static int grid = 0;
    if (grid == 0) {
        if (n_in != 34 || out_size != M * D || ws_size < WS_END) { fprintf(stderr, "kernel_launch: unexpected problem (n_in %d out %d ws %zu need %zu)\n", n_in, out_size, ws_size, (size_t)WS_END); grid = -1; return; }
        int dev = 0, cus = 0;
        if (hipGetDevice(&dev) != hipSuccess || hipDeviceGetAttribute(&cus, hipDeviceAttributeMultiprocessorCount, dev) != hipSuccess) { grid = -1; return; }
        if (hipFuncSetAttribute((const void*)fwd, hipFuncAttributeMaxDynamicSharedMemorySize, LDS_BYTES) != hipSuccess) { fprintf(stderr, "kernel_launch: hipFuncSetAttribute failed\n"); grid = -1; return; }
        int per_cu = 0;
        if (hipOccupancyMaxActiveBlocksPerMultiprocessor(&per_cu, (const void*)fwd, 512, LDS_BYTES) != hipSuccess || per_cu < 1) fprintf(stderr, "kernel_launch: occupancy query says %d\n", per_cu);
        (void)hipGetLastError();
        grid = cus;
    }
    if (grid < 0) return;
    (void)hipMemsetAsync((char*)d_ws + WS_CTL, 0, CTL_ZERO_BYTES, stream);
    Args a{};
    for (int i = 0; i < 34; ++i) a.in[i] = (const float*)d_in[i];
    a.out = (float*)d_out; a.ws = (unsigned char*)d_ws;
#if MK_ONE_LAUNCH
    a.ph_lo = 0; a.ph_hi = N_PH;
    hipLaunchKernelGGL(fwd, dim3(grid), dim3(512), LDS_BYTES, stream, a);
#else
    for (int p = 0; p < N_PH; ++p) { a.ph_lo = p; a.ph_hi = p + 1; hipLaunchKernelGGL(fwd, dim3(grid), dim3(512), LDS_BYTES, stream, a); }
#endif
}
```

```cpp
#include <hip/hip_runtime.h>
#include <cstdio>
#include <cstdint>

#ifndef MK_ONE_LAUNCH
#define MK_ONE_LAUNCH 1
#endif

#define LAS __attribute__((address_space(3)))
#define GAS __attribute__((address_space(1)))
typedef unsigned short bf16;
typedef short bf16x8 __attribute__((ext_vector_type(8)));
typedef float f32x4 __attribute__((ext_vector_type(4)));
typedef float f32x2 __attribute__((ext_vector_type(2)));
typedef unsigned u32x4 __attribute__((ext_vector_type(4)));
typedef unsigned u32x2 __attribute__((ext_vector_type(2)));

constexpr int BATCH = 2, T = 16384, D = 1024, M = BATCH * T;
constexpr int INC = 8456;
constexpr int PLD = 5376;
constexpr int NP = 5632;
constexpr int C_RW = 0, C_Z = 1792, C_XBC = 2304, C_RET = 3328, C_RETG = 4864;
constexpr int FF = 2816, FFE = 3584, NE = 8;

constexpr size_t MiB = 1u << 20;
constexpr size_t WS_CTL = 0, CTL_ZERO_BYTES = 64 * 1024;
constexpr size_t WS_RSTD = 1 * MiB, WS_GATES = 2 * MiB, WS_DT = 3 * MiB;
constexpr size_t WS_W = 4 * MiB;
constexpr size_t WL_IN = 0, WL_GATE = 11 * MiB, WL_BR = 17 * MiB, WL_OUT = 20 * MiB, WL_STRIDE = 22 * MiB;
constexpr size_t WS_FFUP = WS_W + 44 * MiB, WS_FFDN = WS_W + 55 * MiB;
constexpr size_t WS_XB = 68 * MiB;
constexpr size_t WS_VF = 132 * MiB;
constexpr size_t WS_BIG = 164 * MiB;
constexpr size_t WS_VMIX = WS_BIG + 336 * MiB, WS_YRW = WS_BIG + 368 * MiB, WS_END = 577 * MiB;
constexpr size_t WS_MOEW_UNUSED = WS_BIG;
constexpr size_t MOEW_STRIDE = 21 * MiB / 2, MOEW_DN = 7 * MiB;
constexpr size_t MOEW_OUT = 64 * MiB;
constexpr size_t WS_X8 = WS_BIG + 88 * MiB;
constexpr int MOE_KSP = 2;
constexpr size_t WS_ACT = WS_BIG + 168 * MiB;

constexpr size_t WS_YP0 = WS_BIG, WS_YP1 = WS_BIG + 280 * MiB, WS_YP2 = 556 * MiB, YP2_STRIDE = 4 * MiB, WS_PINFO = 572 * MiB, WS_ACT2 = 132 * MiB;
constexpr size_t WS_CNT = 32768, WS_LIST = 2 * MiB;
constexpr size_t WS_BND2 = 566 * MiB;
constexpr size_t WS_VLORA = 192 * 1024;
constexpr size_t WS_SS1 = 573 * MiB, WS_SS2 = 575 * MiB;
constexpr size_t WS_DSTOT = 128 * 1024, WS_BND = 256 * 1024;
constexpr size_t WS_LORA = 1 * MiB + 512 * 1024, LORA_STRIDE = 262144;
constexpr size_t WS_ST_RW = WS_XB, WS_ST_RET = WS_XB + 16 * MiB, WS_ST_SSD = WS_XB + 32 * MiB, WS_MT = WS_YRW;
constexpr int RING_BYTES = 131072, LDSCTL_OFF = 159744, MISC_OFF = LDSCTL_OFF + 320, LDS_BYTES = 163840;
#ifndef REP_CONV
#define REP_CONV 0
#endif
#ifndef REP_R1
#define REP_R1 0
#endif
#ifndef REP_RW
#define REP_RW 0
#endif
#ifndef REP_RET
#define REP_RET 0
#endif
#ifndef REP_SSD
#define REP_SSD 0
#endif
#ifndef REP_MISC
#define REP_MISC 0
#endif
#ifndef RW_CH
#define RW_CH 1
#endif
#ifndef RET_CH
#define RET_CH 1
#endif
#ifndef SSD_CH
#define SSD_CH 1
#endif

typedef __bf16 hbf16x2 __attribute__((ext_vector_type(2)));
__device__ __forceinline__ unsigned pk2(float lo, float hi) { const f32x2 v = {lo, hi}; return __builtin_bit_cast(unsigned, __builtin_convertvector(v, hbf16x2)); }
__device__ __forceinline__ unsigned f2bf(float f) { return (unsigned)__builtin_bit_cast(unsigned short, (__bf16)f); }
__device__ __forceinline__ float bflo(unsigned u) { return __builtin_bit_cast(float, u << 16); }
__device__ __forceinline__ float bfhi(unsigned u) { return __builtin_bit_cast(float, u & 0xffff0000u); }
__device__ __forceinline__ void unpack8(const u32x4 u, float (&f)[8]) { f[0] = bflo(u.x); f[1] = bfhi(u.x); f[2] = bflo(u.y); f[3] = bfhi(u.y); f[4] = bflo(u.z); f[5] = bfhi(u.z); f[6] = bflo(u.w); f[7] = bfhi(u.w); }
__device__ __forceinline__ unsigned pk4f8(float a, float b, float c, float d) {
    a = __builtin_amdgcn_fmed3f(a, -448.f, 448.f); b = __builtin_amdgcn_fmed3f(b, -448.f, 448.f); c = __builtin_amdgcn_fmed3f(c, -448.f, 448.f); d = __builtin_amdgcn_fmed3f(d, -448.f, 448.f);
    int w = __builtin_amdgcn_cvt_pk_fp8_f32(a, b, 0, false); w = __builtin_amdgcn_cvt_pk_fp8_f32(c, d, w, true); return (unsigned)w; }
__device__ __forceinline__ u32x4 pack8(const float (&f)[8]) { u32x4 w; w.x = pk2(f[0], f[1]); w.y = pk2(f[2], f[3]); w.z = pk2(f[4], f[5]); w.w = pk2(f[6], f[7]); return w; }
__device__ __forceinline__ float sigm(float x) { return __builtin_amdgcn_rcpf(1.f + __expf(-x)); }
__device__ __forceinline__ float silu(float x) { return x * __builtin_amdgcn_rcpf(1.f + __expf(-x)); }
__device__ __forceinline__ float ex2(float x) { return __builtin_amdgcn_exp2f(x); }
__device__ __forceinline__ float fast_tanh(float x) { return 1.f - 2.f * __builtin_amdgcn_rcpf(1.f + __expf(2.f * x)); }
__device__ __forceinline__ float softplus_acc(float x) { return fmaxf(x, 0.f) + log1pf(expf(-fabsf(x))); }
__device__ __forceinline__ float wave_sum(float v) {
#pragma unroll
    for (int o = 1; o < 64; o <<= 1) v += __shfl_xor(v, o);
    return v;
}
__device__ __forceinline__ int otid_w(int wid) { unsigned z = 0u; asm volatile("" : "+v"(z)); int t = wid * 64 + (int)__builtin_amdgcn_mbcnt_hi(~0u, __builtin_amdgcn_mbcnt_lo(~0u, z)); asm volatile("" : "+v"(t)); return t; }
#define otid() otid_w(F.wid)
__device__ __forceinline__ int fresh_tid(int t) { asm volatile("" : "+v"(t)); return t; }
#define LDS_WAIT() asm volatile("s_waitcnt lgkmcnt(0)" ::: "memory")

namespace pg8 {
constexpr int BM = 256, BK = 64, HALF = 128, HTB = HALF * BK * 2, STAGE_BYTES = 8 * HTB, NXCD = 8, WGM = 8;
__host__ __device__ __forceinline__ int lds_byte(int r, int c) { const int st = (r >> 4) * 2 + (c >> 5), rr = r & 15, cc = c & 31, ob = rr * 64 + cc * 2; return st * 1024 + (ob ^ (((ob >> 9) & 1) << 5)); }
__host__ __device__ __forceinline__ void stage_rc(int b, int& R, int& C) { const int st = b / 1024, sb = b % 1024, swz = sb ^ (((sb >> 9) & 1) << 5); R = (st >> 1) * 16 + swz / 64; C = (st & 1) * 32 + (swz % 64) / 2; }
__host__ __device__ __forceinline__ int perm32(int rho) { const int n = rho >> 4, i = rho & 15; return 8 * (i >> 2) + 4 * n + (i & 3); }

typedef int i32x4v __attribute__((ext_vector_type(4)));
struct Unit { int pm, pn; size_t aofs, bofs; const int* rows; int nvalid, e, ks; };
struct Gemm { const bf16* A; const bf16* Bt; int lda, ldb, K; };

struct StaticOrder {
    static constexpr bool GATHER = false;
    int nM, nN, nwg, G, c; size_t tsA, tsB;
    __device__ __forceinline__ void init(int Mrows, int N, int G_, int c_, int lda, int ldb) { nM = Mrows / BM; nN = N / BM; nwg = nM * nN; G = G_; c = c_; tsA = (size_t)BM * lda * 2; tsB = (size_t)BM * ldb * 2; }
    __device__ __forceinline__ void tile(int L, int& pm, int& pn) const {
        int wgid = L; { const int q = nwg / NXCD, r = nwg % NXCD, xcd = wgid % NXCD, off = wgid / NXCD; wgid = (xcd < r ? xcd * (q + 1) : r * (q + 1) + (xcd - r) * q) + off; }
        const int nig = WGM * nN, gid = wgid / nig, fm = gid * WGM, gsz = (nM - fm) < WGM ? (nM - fm) : WGM;
        pm = fm + ((wgid % nig) % gsz); pn = (wgid % nig) / gsz;
    }
    __device__ __forceinline__ bool next(int i, Unit& u) const {
        const long L = (long)i * G + c; if (L >= nwg) return false;
        tile((int)L, u.pm, u.pn); u.aofs = (size_t)u.pm * tsA; u.bofs = (size_t)u.pn * tsB; u.rows = nullptr; u.nvalid = BM; u.e = 0; u.ks = 0; return true;
    }
};
struct BranchOrder {
    static constexpr bool GATHER = false;
    StaticOrder so;
    __device__ __forceinline__ void init(int G_, int c_) { so.init(M, D, G_, c_, PLD, 512); }
    __device__ __forceinline__ bool next(int j, Unit& u) const {
        const long L = (long)j * so.G + so.c; if (L >= 3 * so.nwg) return false;
        const int i = (int)(L / so.nwg); so.tile((int)(L % so.nwg), u.pm, u.pn);
        const int acol = (i == 0) ? 1024 : (i == 1 ? C_Z : C_RETG);
        u.aofs = (size_t)u.pm * so.tsA + (size_t)acol * 2; u.bofs = ((size_t)i * D + (size_t)u.pn * BM) * 512 * 2; u.rows = nullptr; u.nvalid = BM; u.e = i; u.ks = 0; return true;
    }
};
struct GateOrder {
    static constexpr bool GATHER = false;
    StaticOrder so;
    __device__ __forceinline__ void init(int G_, int c_) { so.init(M, D, G_, c_, D, D); }
    __device__ __forceinline__ bool next(int j, Unit& u) const {
        const long tt = (long)(j / 3) * so.G + so.c; if (tt >= so.nwg) return false;
        const int i = j % 3; so.tile((int)tt, u.pm, u.pn);
        u.aofs = (size_t)u.pm * so.tsA; u.bofs = ((size_t)i * D + (size_t)u.pn * BM) * D * 2; u.rows = nullptr; u.nvalid = BM; u.e = i; u.ks = 0; return true;
    }
};
template <bool GATH> struct MoeOrder {
    static constexpr bool GATHER = GATH;
    unsigned q0, q1, q2, q3;
    int seg, nN, G, c, ksplit; const int* list; size_t bstride, b6, b7, tsB, tsA, kbytes;
    __device__ __forceinline__ void init(const int* counts, const int* list_, int seg_, int N, int G_, int c_, int lda, int ldb, size_t bstride_, size_t b6_, size_t b7_, int ksplit_ = 1, int kpart = 0) {
        unsigned n[8];
#pragma unroll
        for (int e = 0; e < 8; ++e) { int v = __builtin_amdgcn_readfirstlane(counts[e]); v = v < 0 ? 0 : (v > 32768 ? 32768 : v); n[e] = (unsigned)v; }
        q0 = n[0] | (n[1] << 16); q1 = n[2] | (n[3] << 16); q2 = n[4] | (n[5] << 16); q3 = n[6] | (n[7] << 16);
        seg = seg_; nN = N / BM; G = G_; c = c_; list = list_; bstride = bstride_; b6 = b6_; b7 = b7_; tsB = (size_t)BM * ldb * 2; tsA = (size_t)BM * lda * 2; ksplit = ksplit_; kbytes = (size_t)kpart * 2;
    }
    __device__ __forceinline__ bool next(int i, Unit& u) const {
        const unsigned L0 = (unsigned)i * (unsigned)G + (unsigned)c; const unsigned L = L0 / (unsigned)ksplit; const int ks = (int)(L0 - L * (unsigned)ksplit); const int tl = (int)(L / (unsigned)nN), pn = (int)(L - (unsigned)tl * (unsigned)nN), gt = seg * 128 + tl;
        int t = 0, e = 0, tbe = 0, cne = 0;
#pragma unroll
        for (int k = 0; k < 8; ++k) { const unsigned q = (k < 2) ? q0 : (k < 4) ? q1 : (k < 6) ? q2 : q3; const int n = (int)((k & 1) ? (q >> 16) : (q & 0xffffu));
            if (gt >= t) { e = k; tbe = t; cne = n; } t += (n + 255) >> 8; }
        int nt = t - seg * 128; nt = nt < 0 ? 0 : (nt > 128 ? 128 : nt);
        if (L >= (unsigned)(nt * nN)) return false;
        const int rt = gt - tbe;
        u.pm = tl; u.pn = pn; u.e = e; u.ks = ks; u.bofs = (e < 6 ? (size_t)e * bstride : (e == 6 ? b6 : b7)) + (size_t)pn * tsB + ks * kbytes; u.aofs = (GATH ? 0 : (size_t)tl * tsA) + ks * kbytes;
        u.rows = list + ((size_t)e * 32768 + rt * 256) * 2; int nv = cne - rt * 256; u.nvalid = nv > 256 ? 256 : nv; return true;
    }
};

template <class Epi, class Sched, bool F8 = false>
__device__ __forceinline__ void gemm_phase(LAS unsigned char* lds, int wid0, const Gemm g, const Sched& S, const Epi& E) {
    constexpr bool GATHER = Sched::GATHER;
    const int tid = otid_w(wid0), wid = __builtin_amdgcn_readfirstlane(tid >> 6), lane = tid & 63, wr = wid >> 2, wc = wid & 3, fr = lane & 15, fq = lane >> 4;
    const int nt = g.K / BK;
    unsigned voffA[2], voffB[2];
#pragma unroll
    for (int i = 0; i < 2; ++i) { int R, C; stage_rc(tid * 16 + i * 8192, R, C); const int Rb = Epi::PERM ? ((R & ~31) + perm32(R & 31)) : R;
        voffA[i] = (unsigned)(R * g.lda + C) * 2u; voffB[i] = (unsigned)(Rb * g.ldb + C) * 2u; }
    const size_t kstep = (size_t)(BK * 2);
    const size_t hstepA = GATHER ? 0 : (size_t)HALF * g.lda * 2, hstepB = (size_t)HALF * g.ldb * 2;
    const unsigned ldsw = (unsigned)wid * 1024u;
    const int aoff = lds_byte(wr * 64 + fr, fq * 8), boff = lds_byte(wc * 32 + fr, fq * 8);
#define PG8_SA(b, h) (((b) * 2 + (h)) * HTB)
#define PG8_SB(b, h) ((4 + (b) * 2 + (h)) * HTB)
#define PG8_STAGE2(bufoff, gbase, o0, o1) do { \
        __builtin_amdgcn_global_load_lds((const unsigned*)((const char*)(gbase) + (o0)), (LAS unsigned*)(lds + (bufoff) + ldsw), 16, 0, 0); \
        __builtin_amdgcn_global_load_lds((const unsigned*)((const char*)(gbase) + (o1)), (LAS unsigned*)(lds + (bufoff) + ldsw + 8192), 16, 0, 0); } while (0)
#define PG8_STAGE(bufoff, gbase, voff) PG8_STAGE2(bufoff, gbase, (voff)[0], (voff)[1])
#define PG8_LDA(dst, b, h) do { _Pragma("unroll") for (int m = 0; m < 4; ++m) _Pragma("unroll") for (int k = 0; k < 2; ++k) dst[m][k] = *(const LAS bf16x8*)(lds + PG8_SA(b, h) + aoff + m * 2048 + k * 1024); } while (0)
#define PG8_LDB(dst, b, h) do { _Pragma("unroll") for (int n = 0; n < 2; ++n) _Pragma("unroll") for (int k = 0; k < 2; ++k) dst[n][k] = *(const LAS bf16x8*)(lds + PG8_SB(b, h) + boff + n * 2048 + k * 1024); } while (0)
#define PG8_CAT(x) __builtin_shufflevector(__builtin_bit_cast(i32x4v, (x)[0]), __builtin_bit_cast(i32x4v, (x)[1]), 0, 1, 2, 3, 4, 5, 6, 7)
#define PG8_MMA(ai, bj, At, Bt) do { __builtin_amdgcn_s_setprio(1); if constexpr (F8) { _Pragma("unroll") for (int m = 0; m < 4; ++m) _Pragma("unroll") for (int n = 0; n < 2; ++n) \
        asm volatile("v_mfma_f32_16x16x128_f8f6f4 %0, %1, %2, %0" : "+v"(acc[ai][bj][m][n]) : "v"(PG8_CAT(Bt[n])), "v"(PG8_CAT(At[m]))); } else { \
        _Pragma("unroll") for (int m = 0; m < 4; ++m) _Pragma("unroll") for (int n = 0; n < 2; ++n) _Pragma("unroll") for (int k = 0; k < 2; ++k) \
        acc[ai][bj][m][n] = Epi::TRANS ? __builtin_amdgcn_mfma_f32_16x16x32_bf16(Bt[n][k], At[m][k], acc[ai][bj][m][n], 0, 0, 0) : __builtin_amdgcn_mfma_f32_16x16x32_bf16(At[m][k], Bt[n][k], acc[ai][bj][m][n], 0, 0, 0); } __builtin_amdgcn_s_setprio(0); } while (0)
#define PG8_WAIT_V(n) asm volatile("s_waitcnt vmcnt(" #n ")" ::: "memory")
#define PG8_WAIT_L(n) asm volatile("s_waitcnt lgkmcnt(" #n ")" ::: "memory")
#define PG8_BAR __builtin_amdgcn_s_barrier()
#define PG8_SCHED __builtin_amdgcn_sched_barrier(0)
#define GSLOT(which) ((LAS u32x4*)(lds + 131072 + (which) * 8192 + tid * 16))
#define PG8_ROWS(u, which) do { const int _ft = fresh_tid(tid); unsigned _vg[2][2]; _Pragma("unroll") for (int _i = 0; _i < 2; ++_i) { int _R, _C; stage_rc(_ft * 16 + _i * 8192, _R, _C); \
        _Pragma("unroll") for (int _h = 0; _h < 2; ++_h) { const int _r = _h * HALF + _R; \
        const int _t = (_r < (u).nvalid) ? (u).rows[2 * _r] : 0; _vg[_h][_i] = ((unsigned)_t * (unsigned)g.lda + (unsigned)_C) * 2u; } } \
        u32x4 _o; _o.x = _vg[0][0]; _o.y = _vg[0][1]; _o.z = _vg[1][0]; _o.w = _vg[1][1]; *GSLOT(which) = _o; } while (0)
    Unit cur, nxt; int ui = 0;
    if (!S.next(0, cur)) return;
    f32x4 acc[2][2][4][2];
#pragma unroll
    for (int a = 0; a < 2; ++a)
#pragma unroll
        for (int b = 0; b < 2; ++b)
#pragma unroll
            for (int m = 0; m < 4; ++m)
#pragma unroll
                for (int n = 0; n < 2; ++n) acc[a][b][m][n] = (f32x4){0.f, 0.f, 0.f, 0.f};
    bf16x8 At[4][2], B0[2][2], B1[2][2];
    u32x4 gc = {voffA[0], voffA[1], voffA[0], voffA[1]};
    if constexpr (GATHER) { PG8_ROWS(cur, 0); PG8_ROWS(cur, 1); gc = *GSLOT(0); }
#define VGC(h, i) (gc[2 * (h) + (i)])
    const char* cA = (const char*)g.A + cur.aofs; const char* cB = (const char*)g.Bt + cur.bofs;
    PG8_STAGE(PG8_SB(0, 0), cB, voffB); PG8_STAGE(PG8_SB(0, 1), cB + hstepB, voffB); PG8_STAGE2(PG8_SA(0, 0), cA, VGC(0, 0), VGC(0, 1)); PG8_STAGE2(PG8_SA(0, 1), cA + hstepA, VGC(1, 0), VGC(1, 1));
    if (wr == 1) PG8_BAR;
    PG8_WAIT_V(2); PG8_BAR;
    PG8_STAGE(PG8_SB(1, 0), cB + kstep, voffB); PG8_STAGE2(PG8_SA(1, 0), cA + kstep, VGC(0, 0), VGC(0, 1)); PG8_STAGE(PG8_SB(1, 1), cB + hstepB + kstep, voffB);
    PG8_WAIT_V(6); PG8_BAR;
    for (;;) {
        const bool has_next = S.next(ui + 1, nxt);
        const char* nA = has_next ? (const char*)g.A + nxt.aofs : cA; const char* nB = has_next ? (const char*)g.Bt + nxt.bofs : cB;
        if constexpr (GATHER) { if (has_next) PG8_ROWS(nxt, 1); else *GSLOT(1) = *GSLOT(0); }
        for (int t = 0; t < nt; t += 2) {
            const bool last = (t == nt - 2);
            const char* a1 = cA + (size_t)(t + 1) * kstep;
            const char* a2 = last ? nA : cA + (size_t)(t + 2) * kstep; const char* b2 = last ? nB : cB + (size_t)(t + 2) * kstep;
            const char* a3 = a2 + kstep; const char* b3 = b2 + kstep;
            u32x4 gn = gc; if constexpr (GATHER) { gc = *GSLOT(0); gn = last ? *GSLOT(1) : gc; }
            const unsigned s00 = gn.x, s01 = gn.y, s10 = gn.z, s11 = gn.w;
            PG8_LDB(B0, 0, 0); PG8_LDB(B1, 0, 1); PG8_SCHED; PG8_LDA(At, 0, 0); PG8_STAGE2(PG8_SA(1, 1), a1 + hstepA, VGC(1, 0), VGC(1, 1));
            PG8_WAIT_V(8); PG8_WAIT_L(0); PG8_BAR; PG8_MMA(0, 0, At, B0); PG8_MMA(0, 1, At, B1); PG8_BAR; PG8_SCHED;
            PG8_LDA(At, 0, 1); PG8_STAGE(PG8_SB(0, 0), b2, voffB); PG8_STAGE(PG8_SB(0, 1), b2 + hstepB, voffB); PG8_STAGE2(PG8_SA(0, 0), a2, s00, s01);
            PG8_WAIT_V(8); PG8_WAIT_L(0); PG8_BAR; PG8_MMA(1, 0, At, B0); PG8_MMA(1, 1, At, B1); PG8_BAR; PG8_SCHED;
            PG8_LDB(B0, 1, 0); PG8_LDB(B1, 1, 1); PG8_SCHED; PG8_LDA(At, 1, 0); PG8_STAGE2(PG8_SA(0, 1), a2 + hstepA, s10, s11);
            PG8_WAIT_V(8); PG8_WAIT_L(0); PG8_BAR; PG8_MMA(0, 0, At, B0); PG8_MMA(0, 1, At, B1); PG8_BAR; PG8_SCHED;
            PG8_LDA(At, 1, 1); PG8_STAGE(PG8_SB(1, 0), b3, voffB); PG8_STAGE(PG8_SB(1, 1), b3 + hstepB, voffB); PG8_STAGE2(PG8_SA(1, 0), a3, s00, s01);
            PG8_WAIT_V(8); PG8_WAIT_L(0); PG8_BAR; PG8_MMA(1, 0, At, B0); PG8_MMA(1, 1, At, B1); PG8_BAR; PG8_SCHED;
        }
        if (wr == 0) PG8_BAR;
        if constexpr (F8) asm volatile("s_nop 15\n\ts_nop 15" ::: "memory");
        E(acc, cur, wr, wc, fr, fq);
        if (!has_next) break;
#pragma unroll
        for (int a = 0; a < 2; ++a)
#pragma unroll
            for (int b = 0; b < 2; ++b)
#pragma unroll
                for (int m = 0; m < 4; ++m)
#pragma unroll
                    for (int n = 0; n < 2; ++n) acc[a][b][m][n] = (f32x4){0.f, 0.f, 0.f, 0.f};
        cur = nxt; cA = nA; cB = nB; ++ui;
        if constexpr (GATHER) { *GSLOT(0) = *GSLOT(1); }
        if (wr == 1) PG8_BAR;
    }
    PG8_WAIT_V(0);
    PG8_BAR;
#undef PG8_SA
#undef PG8_SB
#undef PG8_STAGE
#undef PG8_STAGE2
#undef PG8_ROWS
#undef GSLOT
#undef VGC
#undef PG8_LDA
#undef PG8_LDB
#undef PG8_MMA
#undef PG8_CAT
#undef PG8_WAIT_V
#undef PG8_WAIT_L
#undef PG8_BAR
#undef PG8_SCHED
}

typedef const f32x4 (&AccRef)[2][2][4][2];
__device__ __forceinline__ float ss16(const float* p) { const f32x4 a = *(const f32x4*)p, b = *(const f32x4*)(p + 4), c = *(const f32x4*)(p + 8), d = *(const f32x4*)(p + 12);
    return (((a[0] + a[1]) + (a[2] + a[3])) + ((b[0] + b[1]) + (b[2] + b[3]))) + (((c[0] + c[1]) + (c[2] + c[3])) + ((d[0] + d[1]) + (d[2] + d[3]))); }
__device__ __forceinline__ float rs_of(const float* rstd, int ssmode, int row) { return ssmode ? __builtin_amdgcn_rsqf(ss16(rstd + (size_t)row * 16) * (1.f / D) + 1e-6f) : rstd[row]; }

struct EpiInProj {
    static constexpr bool PERM = true, TRANS = true;
    bf16* P; const float* rstd; float* dt; int ssmode;
    __device__ __forceinline__ void operator()(AccRef acc, const Unit& u, int wr, int wc, int fr, int fq) const {
        const int row0 = u.pm * BM + wr * 64 + fr;
        float scl[2][4];
#pragma unroll
        for (int ai = 0; ai < 2; ++ai)
#pragma unroll
            for (int m = 0; m < 4; ++m) scl[ai][m] = rs_of(rstd, ssmode, row0 + ai * HALF + m * 16);
        if (u.pn < 21) {
            const int col0 = u.pn * BM + wc * 32 + 8 * fq;
#pragma unroll
            for (int ai = 0; ai < 2; ++ai)
#pragma unroll
                for (int m = 0; m < 4; ++m) { const int row = row0 + ai * HALF + m * 16; const float s = scl[ai][m]; bf16* rowp = P + (size_t)row * PLD + col0;
#pragma unroll
                    for (int bj = 0; bj < 2; ++bj) { const f32x4 v0 = acc[ai][bj][m][0] * s, v1 = acc[ai][bj][m][1] * s;
                        u32x4 w; w.x = pk2(v0[0], v0[1]); w.y = pk2(v0[2], v0[3]); w.z = pk2(v1[0], v1[1]); w.w = pk2(v1[2], v1[3]);
                        *(u32x4*)(rowp + bj * HALF) = w; } }
        } else if (wc == 0 && fq == 0) {
#pragma unroll
            for (int ai = 0; ai < 2; ++ai)
#pragma unroll
                for (int m = 0; m < 4; ++m) { const int row = row0 + ai * HALF + m * 16; const float s = scl[ai][m];
                    *(f32x4*)(dt + (size_t)row * 8) = acc[ai][0][m][0] * s; *(f32x4*)(dt + (size_t)row * 8 + 4) = acc[ai][0][m][1] * s; }
        }
    }
};
struct EpiPlain {
    static constexpr bool PERM = true, TRANS = true;
    bf16* P; bf16* Y2;
    __device__ __forceinline__ void operator()(AccRef acc, const Unit& u, int wr, int wc, int fr, int fq) const {
        bf16* O = (u.e == 0) ? P : (u.e == 1 ? P + C_XBC : Y2); const int ldc = (u.e == 2) ? D : PLD;
        const int row0 = u.pm * BM + wr * 64 + fr, col0 = u.pn * BM + wc * 32 + 8 * fq;
#pragma unroll
        for (int ai = 0; ai < 2; ++ai)
#pragma unroll
            for (int m = 0; m < 4; ++m) { bf16* rowp = O + (size_t)(row0 + ai * HALF + m * 16) * ldc + col0;
#pragma unroll
                for (int bj = 0; bj < 2; ++bj) { const f32x4 v0 = acc[ai][bj][m][0], v1 = acc[ai][bj][m][1];
                    u32x4 w; w.x = pk2(v0[0], v0[1]); w.y = pk2(v0[2], v0[3]); w.z = pk2(v1[0], v1[1]); w.w = pk2(v1[2], v1[3]);
                    *(u32x4*)(rowp + bj * HALF) = w; } }
    }
};
struct EpiGateMerge {
    static constexpr bool PERM = true, TRANS = true;
    const bf16* P; const bf16* Y2; bf16* Mg; int ldm; const float* rstd; int ssmode;
    __device__ __forceinline__ void operator()(AccRef acc, const Unit& u, int wr, int wc, int fr, int fq) const {
        asm volatile("" : "+v"(fr), "+v"(fq));
        const bf16* Y = (u.e == 0) ? P : (u.e == 1 ? P + C_XBC : Y2); const int ldy = (u.e == 2) ? D : PLD; const int first = (u.e == 0);
        const int row0 = u.pm * BM + wr * 64 + fr, col0 = u.pn * BM + wc * 32 + 8 * fq;
#pragma unroll
        for (int ai = 0; ai < 2; ++ai) {
            u32x4 yv[4][2], mv[4][2]; float sc[4];
#pragma unroll
            for (int m = 0; m < 4; ++m) { const int row = row0 + ai * HALF + m * 16; sc[m] = rs_of(rstd, ssmode, row);
#pragma unroll
                for (int bj = 0; bj < 2; ++bj) { yv[m][bj] = *(const u32x4*)(Y + (size_t)row * ldy + col0 + bj * HALF);
                    mv[m][bj] = first ? (u32x4){0u, 0u, 0u, 0u} : *(const u32x4*)(Mg + (size_t)row * ldm + col0 + bj * HALF); } }
#pragma unroll
            for (int m = 0; m < 4; ++m) { const int row = row0 + ai * HALF + m * 16;
#pragma unroll
                for (int bj = 0; bj < 2; ++bj) { float y[8], p[8], o[8]; unpack8(yv[m][bj], y); unpack8(mv[m][bj], p);
                    const f32x4 v0 = acc[ai][bj][m][0] * sc[m], v1 = acc[ai][bj][m][1] * sc[m];
#pragma unroll
                    for (int j = 0; j < 4; ++j) { o[j] = sigm(v0[j]) * y[j] + p[j]; o[4 + j] = sigm(v1[j]) * y[4 + j] + p[4 + j]; }
                    *(u32x4*)(Mg + (size_t)row * ldm + col0 + bj * HALF) = pack8(o); } }
        }
    }
};
struct EpiResid {
    static constexpr bool PERM = false, TRANS = true;
    const float* xin; float* xout; const float* gates; int e;
    __device__ __forceinline__ void operator()(AccRef acc, const Unit& u, int wr, int wc, int fr, int fq) const {
        const int row0 = u.pm * BM + wr * 64 + fr, col0 = u.pn * BM + wc * 32 + 4 * fq;
#pragma unroll
        for (int ai = 0; ai < 2; ++ai)
#pragma unroll
            for (int m = 0; m < 4; ++m) { const int row = row0 + ai * HALF + m * 16; const float s = gates ? gates[(size_t)row * 8 + e] : 1.f;
                const float* ip = xin + (size_t)row * D + col0; float* op = xout + (size_t)row * D + col0;
#pragma unroll
                for (int bj = 0; bj < 2; ++bj)
#pragma unroll
                    for (int n = 0; n < 2; ++n) *(f32x4*)(op + bj * HALF + n * 16) = *(const f32x4*)(ip + bj * HALF + n * 16) + acc[ai][bj][m][n] * s; }
    }
};
struct EpiResidB {
    static constexpr bool PERM = true, TRANS = true;
    bf16* xb; float* SS; float* xf;
    __device__ __forceinline__ void operator()(AccRef acc, const Unit& u, int wr, int wc, int fr, int fq) const {
        asm volatile("" : "+v"(fr), "+v"(fq));
        const int row0 = u.pm * BM + wr * 64 + fr, col0 = u.pn * BM + wc * 32 + 8 * fq;
#pragma unroll
        for (int ai = 0; ai < 2; ++ai) {
            u32x4 xv[4][2];
#pragma unroll
            for (int m = 0; m < 4; ++m)
#pragma unroll
                for (int bj = 0; bj < 2; ++bj) xv[m][bj] = *(const u32x4*)(xb + (size_t)(row0 + ai * HALF + m * 16) * D + col0 + bj * HALF);
#pragma unroll
            for (int m = 0; m < 4; ++m) { const int row = row0 + ai * HALF + m * 16; bf16* rowp = xb + (size_t)row * D + col0; float ss = 0.f;
#pragma unroll
                for (int bj = 0; bj < 2; ++bj) { float v[8]; unpack8(xv[m][bj], v);
#pragma unroll
                    for (int j = 0; j < 4; ++j) { v[j] += acc[ai][bj][m][0][j]; v[4 + j] += acc[ai][bj][m][1][j]; }
                    *(u32x4*)(rowp + bj * HALF) = pack8(v);
                    if (xf) { float* fp = xf + (size_t)row * D + col0 + bj * HALF; *(f32x4*)fp = (f32x4){v[0], v[1], v[2], v[3]}; *(f32x4*)(fp + 4) = (f32x4){v[4], v[5], v[6], v[7]}; }
#pragma unroll
                    for (int j = 0; j < 8; ++j) ss += v[j] * v[j]; }
                if (SS) { ss += __shfl_xor(ss, 16); ss += __shfl_xor(ss, 32); if (fq == 0) SS[(size_t)row * 16 + u.pn * 4 + wc] = ss; } }
        }
    }
};
struct EpiSwiglu {
    static constexpr bool PERM = true, TRANS = true;
    bf16* act; int ldc; const float* rstd; int ssmode;
    __device__ __forceinline__ void operator()(AccRef acc, const Unit& u, int wr, int wc, int fr, int fq) const {
        asm volatile("" : "+v"(fr), "+v"(fq));
        const int row0 = u.pm * BM + wr * 64 + fr, col0 = u.pn * HALF + wc * 32 + 8 * fq;
        float scl[2][4];
        if (u.rows) { int tk[2][4];
#pragma unroll
            for (int ai = 0; ai < 2; ++ai)
#pragma unroll
                for (int m = 0; m < 4; ++m) { const int lr = wr * 64 + fr + ai * HALF + m * 16; tk[ai][m] = (lr < u.nvalid) ? u.rows[2 * lr] : 0; }
#pragma unroll
            for (int ai = 0; ai < 2; ++ai)
#pragma unroll
                for (int m = 0; m < 4; ++m) scl[ai][m] = rstd[tk[ai][m]];
        } else {
#pragma unroll
            for (int ai = 0; ai < 2; ++ai)
#pragma unroll
                for (int m = 0; m < 4; ++m) scl[ai][m] = rs_of(rstd, ssmode, row0 + ai * HALF + m * 16); }
#pragma unroll
        for (int ai = 0; ai < 2; ++ai)
#pragma unroll
            for (int m = 0; m < 4; ++m) { const int row = row0 + ai * HALF + m * 16;
                const float s = scl[ai][m];
                float o[8];
#pragma unroll
                for (int n = 0; n < 2; ++n)
#pragma unroll
                    for (int j = 0; j < 4; ++j) o[4 * n + j] = silu(acc[ai][0][m][n][j] * s) * (acc[ai][1][m][n][j] * s);
                *(u32x4*)(act + (size_t)row * ldc + col0) = pack8(o); }
    }
};
struct EpiSwiglu8 {
    static constexpr bool PERM = true, TRANS = true;
    unsigned char* act; int ldc;
    __device__ __forceinline__ void operator()(AccRef acc, const Unit& u, int wr, int wc, int fr, int fq) const {
        asm volatile("" : "+v"(fr), "+v"(fq));
        const int row0 = u.pm * BM + wr * 64 + fr, col0 = u.pn * HALF + wc * 32 + 8 * fq;
        const float s = 1.f / 256.f, s8 = 8.f / 256.f;
#pragma unroll
        for (int ai = 0; ai < 2; ++ai)
#pragma unroll
            for (int m = 0; m < 4; ++m) { const int row = row0 + ai * HALF + m * 16;
                float o[8];
#pragma unroll
                for (int n = 0; n < 2; ++n)
#pragma unroll
                    for (int j = 0; j < 4; ++j) o[4 * n + j] = silu(acc[ai][0][m][n][j] * s) * (acc[ai][1][m][n][j] * s8);
                u32x2 w; w.x = pk4f8(o[0], o[1], o[2], o[3]); w.y = pk4f8(o[4], o[5], o[6], o[7]);
                *(u32x2*)(act + (size_t)row * ldc + col0) = w; }
    }
};
struct EpiMoeOut {
    static constexpr bool PERM = true, TRANS = true;
    bf16* Y; size_t kstride; float mul;
    __device__ __forceinline__ void operator()(AccRef acc, const Unit& u, int wr, int wc, int fr, int fq) const {
        const int row0 = u.pm * BM + wr * 64 + fr, col0 = u.pn * BM + wc * 32 + 8 * fq; bf16* O = Y + (size_t)u.ks * kstride;
#pragma unroll
        for (int ai = 0; ai < 2; ++ai)
#pragma unroll
            for (int m = 0; m < 4; ++m) { bf16* rowp = O + (size_t)(row0 + ai * HALF + m * 16) * D + col0;
#pragma unroll
                for (int bj = 0; bj < 2; ++bj) { const f32x4 v0 = acc[ai][bj][m][0] * mul, v1 = acc[ai][bj][m][1] * mul;
                    u32x4 w; w.x = pk2(v0[0], v0[1]); w.y = pk2(v0[2], v0[3]); w.z = pk2(v1[0], v1[1]); w.w = pk2(v1[2], v1[3]);
                    *(u32x4*)(rowp + bj * HALF) = w; } }
    }
};
}

#define XB_TMO      128
#define XB_XCNT(j)  (256  + 64 * (j))
#define XB_XSUB(j)  (1280 + 64 * (j))
#define XB_XGEN(j)  (2304 + 64 * (j))
#define XB_TOP      3328
#define XB_TOPGEN   3392
#define XCD_BAR_WORDS 3456
#define XB_SPIN_CAP (1u << 18)

__device__ __forceinline__ unsigned xb_ld(unsigned* p)              { return __hip_atomic_load(p, __ATOMIC_RELAXED, __HIP_MEMORY_SCOPE_AGENT); }
__device__ __forceinline__ unsigned xb_add(unsigned* p, unsigned v) { return __hip_atomic_fetch_add(p, v, __ATOMIC_RELAXED, __HIP_MEMORY_SCOPE_AGENT); }
__device__ __forceinline__ unsigned xb_xcc_id() { return (unsigned)__builtin_amdgcn_s_getreg((3 << 11) | 20) & 0xFu; }
#define XB_SPIN(cond, bar) do { unsigned _sp = 0; while (cond) { __builtin_amdgcn_s_sleep(1); \
    if ((++_sp & 255u) == 0u) { if (xb_ld(&(bar)[XB_TMO])) break; if (_sp > XB_SPIN_CAP) { atomicAdd(&(bar)[XB_TMO], 1u); break; } } } } while (0)

struct XcdBarrier { unsigned* bar; unsigned x; volatile LAS unsigned* st; };

__device__ __forceinline__ XcdBarrier xcd_barrier_post(unsigned* bar, volatile LAS unsigned* st) {
    XcdBarrier b; b.bar = bar; b.x = xb_xcc_id(); b.st = st;
    if (threadIdx.x == 0) (void)xb_add(&bar[XB_XCNT(b.x)], 1u);
    return b;
}
__device__ __forceinline__ void xcd_barrier_complete(unsigned* bar, unsigned x, unsigned& nloc, unsigned& nx) {
    const unsigned G = gridDim.x * gridDim.y * gridDim.z;
    unsigned sum, cnt, mine, sp = 0u;
    for (;;) {
        sum = 0u; cnt = 0u; mine = 0u;
#pragma unroll
        for (unsigned j = 0; j < 16; ++j) { const unsigned c = xb_ld(&bar[XB_XCNT(j)]); sum += c; cnt += (c > 0u) ? 1u : 0u; mine = (j == x) ? c : mine; }
        if (sum == G) break;
        __builtin_amdgcn_s_sleep(1);
        if ((++sp & 255u) == 0u) { if (xb_ld(&bar[XB_TMO])) break; if (sp > XB_SPIN_CAP) { atomicAdd(&bar[XB_TMO], 1u); break; } }
    }
    nloc = mine > 0u ? mine : 1u; nx = cnt > 0u ? cnt : 1u;
}
__device__ __forceinline__ void xcd_barrier(const XcdBarrier& b) {
    asm volatile("s_waitcnt vmcnt(0)" ::: "memory");
    __syncthreads();
    if (threadIdx.x == 0) {
        unsigned* bar = b.bar;
        __builtin_amdgcn_s_waitcnt(0);
        unsigned nloc = b.st[0], nx = b.st[1];
        if (nloc == 0u) { xcd_barrier_complete(bar, b.x, nloc, nx); b.st[0] = nloc; b.st[1] = nx; }
        const unsigned old = xb_add(&bar[XB_XSUB(b.x)], 1u);
        const unsigned gen = old / nloc;
        if (old + 1u == (gen + 1u) * nloc) {
            __builtin_amdgcn_fence(__ATOMIC_RELEASE, "agent");
            asm volatile("s_waitcnt vmcnt(0)" ::: "memory");
            const unsigned og = xb_add(&bar[XB_TOP], 1u);
            const unsigned tg = og / nx;
            if (og + 1u == (tg + 1u) * nx) xb_add(&bar[XB_TOPGEN], 1u);
            else XB_SPIN(xb_ld(&bar[XB_TOPGEN]) == tg, bar);
            __builtin_amdgcn_fence(__ATOMIC_ACQUIRE, "agent");
            xb_add(&bar[XB_XGEN(b.x)], 1u);
            asm volatile("s_waitcnt vmcnt(0)" ::: "memory");
        } else {
            XB_SPIN(xb_ld(&bar[XB_XGEN(b.x)]) == gen, bar);
            __builtin_amdgcn_fence(__ATOMIC_ACQUIRE, "agent");
            asm volatile("s_waitcnt vmcnt(0)" ::: "memory");
        }
    }
    __syncthreads();
}

#define GAS __attribute__((address_space(1)))
struct Args { const float* in[34]; float* out; unsigned char* ws; int ph_lo, ph_hi; };
struct Frame {
    LAS unsigned char* lds;
    int vcu, G, cid, wid, rr;
    GAS float* out; GAS unsigned char* ws; GAS unsigned char* st;
};
__device__ __forceinline__ const float* inptr(LAS unsigned char* lds, int i) {
    int off = LDSCTL_OFF + 8 * i; asm volatile("" : "+v"(off));
    const LAS unsigned* p = (const LAS unsigned*)(lds + off);
    const unsigned lo = __builtin_amdgcn_readfirstlane(p[0]), hi = __builtin_amdgcn_readfirstlane(p[1]);
    return (const float*)(GAS const float*)(((unsigned long long)hi << 32) | lo);
}
#define INP(i) inptr(F.lds, (i))

__device__ __forceinline__ void conv_item(const float* W, int ld, int k0, int c0, int nvalid, const float* scale, bf16* dst, int K, int drow0, LAS float* scr, int lane) {
    const int n4 = (lane & 15) * 4;
    f32x4 v[16]; float sc[16];
#pragma unroll
    for (int i = 0; i < 16; ++i) { const int kk = 4 * i + (lane >> 4);
        v[i] = (f32x4){0.f, 0.f, 0.f, 0.f}; sc[i] = 1.f; if (n4 < nvalid) { v[i] = *(const f32x4*)(W + (size_t)(k0 + kk) * ld + c0 + n4); if (scale) sc[i] = scale[k0 + kk]; } }
#pragma unroll
    for (int i = 0; i < 16; ++i) { const int kk = 4 * i + (lane >> 4); const f32x4 x = v[i] * sc[i];
        LAS float* d = scr + kk * 65 + n4; d[0] = x[0]; d[1] = x[1]; d[2] = x[2]; d[3] = x[3]; }
    LDS_WAIT(); asm volatile("" ::: "memory");
    const int c = lane & 7;
#pragma unroll
    for (int j = 0; j < 8; ++j) { const int nn = (lane >> 3) + 8 * j; const LAS float* sp = scr + (8 * c) * 65 + nn;
        u32x4 o; o.x = pk2(sp[0 * 65], sp[1 * 65]); o.y = pk2(sp[2 * 65], sp[3 * 65]); o.z = pk2(sp[4 * 65], sp[5 * 65]); o.w = pk2(sp[6 * 65], sp[7 * 65]);
        *(u32x4*)(dst + (size_t)(drow0 + nn) * K + k0 + 8 * c) = o; }
    LDS_WAIT(); asm volatile("" ::: "memory");
}
__device__ __forceinline__ void conv_item8(const float* W, int ld, int k0, int c0, const float* scale, float mul, unsigned char* dst, int K, int drow0, LAS float* scr, int lane) {
    const int n4 = (lane & 15) * 4;
    f32x4 v[16]; float sc[16];
#pragma unroll
    for (int i = 0; i < 16; ++i) { const int kk = 4 * i + (lane >> 4); v[i] = *(const f32x4*)(W + (size_t)(k0 + kk) * ld + c0 + n4); sc[i] = scale ? scale[k0 + kk] * mul : mul; }
#pragma unroll
    for (int i = 0; i < 16; ++i) { const int kk = 4 * i + (lane >> 4); const f32x4 x = v[i] * sc[i];
        LAS float* d = scr + kk * 65 + n4; d[0] = x[0]; d[1] = x[1]; d[2] = x[2]; d[3] = x[3]; }
    LDS_WAIT(); asm volatile("" ::: "memory");
    const int c = lane & 3;
#pragma unroll
    for (int j = 0; j < 4; ++j) { const int nn = (lane >> 2) + 16 * j; const LAS float* sp = scr + (16 * c) * 65 + nn;
        u32x4 o; o.x = pk4f8(sp[0 * 65], sp[1 * 65], sp[2 * 65], sp[3 * 65]); o.y = pk4f8(sp[4 * 65], sp[5 * 65], sp[6 * 65], sp[7 * 65]);
        o.z = pk4f8(sp[8 * 65], sp[9 * 65], sp[10 * 65], sp[11 * 65]); o.w = pk4f8(sp[12 * 65], sp[13 * 65], sp[14 * 65], sp[15 * 65]);
        *(u32x4*)(dst + (size_t)(drow0 + nn) * K + k0 + 16 * c) = o; }
    LDS_WAIT(); asm volatile("" ::: "memory");
}
__device__ __forceinline__ void conv_seg8(Frame& F, const float* W, int ld, int K, int ncols, const float* scale, float mul, unsigned char* dst, int r0, int blk, int blks) {
    const int ptid = otid(), plane = ptid & 63, pwave = __builtin_amdgcn_readfirstlane(ptid >> 6);
    LAS float* scr = (LAS float*)(F.lds + pwave * 16640);
    const int gw = F.vcu * 8 + pwave, NGW = F.G * 8;
    const int nblk = ncols / 64, nitems = (K / 64) * nblk;
    const int first = (gw - F.rr % NGW + NGW) % NGW; F.rr = (F.rr + nitems) % NGW;
    for (int it = first; it < nitems; it += NGW) {
        const int kb = it / nblk, nb = it % nblk, n0 = nb * 64;
        conv_item8(W, ld, kb * 64, n0, scale, mul, dst, K, r0 + (n0 / blk) * blks + (n0 % blk), scr, plane);
    }
}
__device__ __forceinline__ void conv_seg(Frame& F, const float* W, int ld, int K, int c0, int nvalid, int ntotal, const float* scale, bf16* dst, int r0, int blk, int blks) {
    const int ptid = otid(), plane = ptid & 63, pwave = __builtin_amdgcn_readfirstlane(ptid >> 6);
    LAS float* scr = (LAS float*)(F.lds + pwave * 16640);
    const int gw = F.vcu * 8 + pwave, NGW = F.G * 8;
    const int nblk = ntotal / 64, nitems = (K / 64) * nblk;
    const int first = (gw - F.rr % NGW + NGW) % NGW; F.rr = (F.rr + nitems) % NGW;
    for (int it = first; it < nitems; it += NGW) {
        const int kb = it / nblk, nb = it % nblk, n0 = nb * 64;
        int nv = nvalid - n0; nv = nv < 0 ? 0 : (nv > 64 ? 64 : nv);
        conv_item(W, ld, kb * 64, c0 + n0, nv, scale, dst, K, r0 + (n0 / blk) * blks + (n0 % blk), scr, plane);
    }
}
__device__ __forceinline__ void conv_layer_weights(Frame& F, int l, int part) {
    unsigned char* wl = (unsigned char*)(F.ws + WS_W + (size_t)l * WL_STRIDE);
    const float* win = INP(2) + (size_t)l * D * INC; const float* n1 = INP(1) + l * D;
    const int BIGB = 1 << 30;
    if (part == 0) {
        conv_seg(F, win, INC, D, 0, 3328, 3328, n1, (bf16*)(wl + WL_IN), 0, BIGB, 0);
        conv_seg(F, win, INC, D, 3336, 2048, 2048, n1, (bf16*)(wl + WL_IN), 3328, BIGB, 0);
        conv_seg(F, win, INC, D, 3328, 8, 256, n1, (bf16*)(wl + WL_IN), 5376, BIGB, 0);
    } else {
        conv_seg(F, win, INC, D, 5384, 3072, 3072, n1, (bf16*)(wl + WL_GATE), 0, BIGB, 0);
        for (int i = 0; i < 3; ++i)
            conv_seg(F, INP(23) + ((size_t)l * 3 + i) * 512 * D, D, 512, 0, D, D, nullptr, (bf16*)(wl + WL_BR) + (size_t)i * D * 512, 0, BIGB, 0);
        conv_seg(F, INP(24) + (size_t)l * D * D, D, D, 0, D, D, nullptr, (bf16*)(wl + WL_OUT), 0, BIGB, 0);
    }
}
__device__ __forceinline__ void conv_ffn_weights(Frame& F) {
    const float* n2 = INP(25);
    conv_seg(F, INP(26), FF, D, 0, FF, FF, n2, (bf16*)(F.ws + WS_FFUP), 0, 128, 256);
    conv_seg(F, INP(27), FF, D, 0, FF, FF, n2, (bf16*)(F.ws + WS_FFUP), 128, 128, 256);
    conv_seg(F, INP(28), D, FF, 0, D, D, nullptr, (bf16*)(F.ws + WS_FFDN), 0, 1 << 30, 0);
}
__device__ __forceinline__ unsigned char* moew_ptr(const Frame& F, int e) { return e < 6 ? (unsigned char*)F.out + MOEW_OUT + (size_t)e * MOEW_STRIDE : (e == 6 ? (unsigned char*)(F.ws + WS_FFUP) : (unsigned char*)(F.ws + WS_VF + 16 * MiB)); }
__device__ __forceinline__ void conv_moe_weights(Frame& F, int e_lo, int e_hi) {
    const float* n2 = INP(25) + D;
    for (int e = e_lo; e < e_hi; ++e) {
        unsigned char* up = moew_ptr(F, e); unsigned char* dn = up + MOEW_DN;
        conv_seg8(F, INP(30) + (size_t)e * D * FFE, FFE, D, FFE, n2, 64.f, up, 0, 128, 256);
        conv_seg8(F, INP(31) + (size_t)e * D * FFE, FFE, D, FFE, n2, 64.f, up, 128, 128, 256);
        conv_seg8(F, INP(32) + (size_t)e * FFE * D, D, FFE, D, nullptr, 128.f, dn, 0, 1 << 30, 0);
    }
}
__device__ __forceinline__ void xprep_phase(Frame& F, const float* x) {
    const int ptid = otid(), plane = ptid & 63, pwave = __builtin_amdgcn_readfirstlane(ptid >> 6);
    const int gw = F.vcu * 8 + pwave, NGW = F.G * 8;
    bf16* xb = (bf16*)(F.ws + WS_XB); float* rstd = (float*)(F.ws + WS_RSTD);
    for (int m0 = 2 * gw; m0 < M; m0 += 2 * NGW) {
        f32x4 v[2][4];
#pragma unroll
        for (int q = 0; q < 2; ++q) { const f32x4* xr = (const f32x4*)(x + (size_t)(m0 + q) * D) + plane;
#pragma unroll
            for (int j = 0; j < 4; ++j) v[q][j] = xr[64 * j]; }
#pragma unroll
        for (int q = 0; q < 2; ++q) { const int m = m0 + q; float sq = 0.f;
#pragma unroll
            for (int j = 0; j < 4; ++j) sq += (v[q][j].x * v[q][j].x + v[q][j].y * v[q][j].y) + (v[q][j].z * v[q][j].z + v[q][j].w * v[q][j].w);
            sq = wave_sum(sq);
            if (plane == 0) rstd[m] = __builtin_amdgcn_rsqf(sq * (1.f / D) + 1e-6f);
            u32x2* o8 = (u32x2*)(xb + (size_t)m * D) + plane;
#pragma unroll
            for (int j = 0; j < 4; ++j) { u32x2 w; w.x = pk2(v[q][j].x, v[q][j].y); w.y = pk2(v[q][j].z, v[q][j].w); o8[64 * j] = w; } }
    }
}
__device__ __forceinline__ void final_norm_phase(Frame& F) {
    const int ptid = otid(), plane = ptid & 63, pwave = __builtin_amdgcn_readfirstlane(ptid >> 6);
    const int gw = F.vcu * 8 + pwave, NGW = F.G * 8;
    const float* fw = INP(33); const unsigned* pinfo = (const unsigned*)(F.ws + WS_PINFO); const int* cnt = (const int*)(F.ws + WS_CNT);
    int tb[8]; { int t = 0;
#pragma unroll
        for (int e = 0; e < 8; ++e) { int n = __builtin_amdgcn_readfirstlane(cnt[e]); n = n < 0 ? 0 : (n > 32768 ? 32768 : n); tb[e] = t; t += (n + 255) >> 8; } }
    const bf16* Y0 = (const bf16*)(F.ws + WS_YP0); const bf16* Y1 = (const bf16*)(F.ws + WS_YP1); const bf16* Y2 = (const bf16*)(F.ws + WS_YP2);
    f32x4 fwv[4];
#pragma unroll
    for (int j = 0; j < 4; ++j) fwv[j] = *((const f32x4*)fw + plane + 64 * j);
    for (int m0 = 2 * gw; m0 < M; m0 += 2 * NGW) {
        f32x4 v[2][4]; u32x2 ya[2][2][4]; float wg[2][2]; int sgm[2][2]; const bf16* yp[2][2];
#pragma unroll
        for (int q = 0; q < 2; ++q) { const int m = m0 + q;
            const u32x2* xr = (const u32x2*)((const bf16*)(F.ws + WS_XB) + (size_t)m * D) + plane;
#pragma unroll
            for (int j = 0; j < 4; ++j) { const u32x2 xx = xr[64 * j]; v[q][j] = (f32x4){bflo(xx.x), bfhi(xx.x), bflo(xx.y), bfhi(xx.y)}; }
#pragma unroll
            for (int p = 0; p < 2; ++p) {
                const unsigned pk = __builtin_amdgcn_readfirstlane(pinfo[((size_t)m * 2 + p) * 2]); wg[q][p] = __builtin_bit_cast(float, __builtin_amdgcn_readfirstlane(pinfo[((size_t)m * 2 + p) * 2 + 1]));
                const int e = (int)(pk >> 20), slot = (int)(pk & 0xFFFFFu);
                int tbe = tb[0];
#pragma unroll
                for (int k = 1; k < 8; ++k) tbe = (e == k) ? tb[k] : tbe;
                const int gr = tbe * 256 + slot, seg = gr >> 15, lr = gr & 32767; sgm[q][p] = seg;
                yp[q][p] = (seg == 0 ? Y0 : (seg == 1 ? Y1 : Y2)) + (size_t)lr * D + 4 * plane; } }
#pragma unroll
        for (int q = 0; q < 2; ++q)
#pragma unroll
            for (int p = 0; p < 2; ++p)
#pragma unroll
                for (int j = 0; j < 4; ++j) ya[q][p][j] = *(const u32x2*)(yp[q][p] + 256 * j);
#pragma unroll
        for (int q = 0; q < 2; ++q) { const int m = m0 + q;
#pragma unroll
            for (int p = 0; p < 2; ++p) { const float wgt = wg[q][p];
#pragma unroll
                for (int j = 0; j < 4; ++j) { const u32x2 yy = ya[q][p][j]; v[q][j].x += wgt * bflo(yy.x); v[q][j].y += wgt * bfhi(yy.x); v[q][j].z += wgt * bflo(yy.y); v[q][j].w += wgt * bfhi(yy.y); }
                if (sgm[q][p] == 2) {
#pragma unroll
                    for (int ks = 1; ks < MOE_KSP; ++ks)
#pragma unroll
                        for (int j = 0; j < 4; ++j) { const u32x2 yy = *(const u32x2*)(yp[q][p] + (size_t)ks * (YP2_STRIDE / 2) + 256 * j); v[q][j].x += wgt * bflo(yy.x); v[q][j].y += wgt * bfhi(yy.x); v[q][j].z += wgt * bflo(yy.y); v[q][j].w += wgt * bfhi(yy.y); } } }
            float ssq = 0.f;
#pragma unroll
            for (int j = 0; j < 4; ++j) ssq += (v[q][j].x * v[q][j].x + v[q][j].y * v[q][j].y) + (v[q][j].z * v[q][j].z + v[q][j].w * v[q][j].w);
            ssq = wave_sum(ssq);
            const float r = __builtin_amdgcn_rsqf(ssq * (1.f / D) + 1e-6f);
            f32x4* xo = (f32x4*)(F.out + (size_t)m * D) + plane;
#pragma unroll
            for (int j = 0; j < 4; ++j) xo[64 * j] = v[q][j] * r * fwv[j]; }
    }
}
__device__ __forceinline__ void router_phase(Frame& F) {
    const int ptid = otid(), plane = ptid & 63, pwave = __builtin_amdgcn_readfirstlane(ptid >> 6);
    const float* nw = INP(25) + D; const float* rt = INP(29); bf16* xb = (bf16*)(F.ws + WS_XB);
    int* cnt = (int*)(F.ws + WS_CNT); int* list2 = (int*)(F.ws + WS_LIST);
    LAS int* lsel = (LAS int*)F.lds;
    LAS float* lwt = (LAS float*)(F.lds + 1024);
    LAS int* lrank = (LAS int*)(F.lds + 2048);
    LAS int* lcnt = (LAS int*)(F.lds + 3072);
    for (int blk = F.vcu; blk < M / 128; blk += F.G) {
        if (ptid < 16) lcnt[ptid] = 0;
        __syncthreads();
        for (int k = 0; k < 16; ++k) {
            const int lt = pwave * 16 + k, m = blk * 128 + lt;
            float acc[8];
#pragma unroll
            for (int e = 0; e < 8; ++e) acc[e] = 0.f;
            const u32x2* xr2 = (const u32x2*)(xb + (size_t)m * D) + plane;
            f32x4 xv4[4]; float ssq = 0.f;
#pragma unroll
            for (int j = 0; j < 4; ++j) { const u32x2 xx = xr2[64 * j]; xv4[j] = (f32x4){bflo(xx.x), bfhi(xx.x), bflo(xx.y), bfhi(xx.y)}; ssq += (xv4[j].x * xv4[j].x + xv4[j].y * xv4[j].y) + (xv4[j].z * xv4[j].z + xv4[j].w * xv4[j].w); }
            ssq = wave_sum(ssq);
            const float sc = __builtin_amdgcn_rsqf(ssq * (1.f / D) + 1e-6f);
            { unsigned* x8 = (unsigned*)(F.ws + WS_X8 + (size_t)m * D) + plane; const float s4 = 4.f * sc;
#pragma unroll
              for (int j = 0; j < 4; ++j) x8[64 * j] = pk4f8(xv4[j].x * s4, xv4[j].y * s4, xv4[j].z * s4, xv4[j].w * s4); }
#pragma unroll
            for (int j = 0; j < 4; ++j) { const int kk = 4 * plane + 256 * j; const f32x4 nwv = *(const f32x4*)(nw + kk);
#pragma unroll
                for (int q = 0; q < 4; ++q) { const float xv = xv4[j][q] * nwv[q];
                    const f32x4 r0v = *(const f32x4*)(rt + (size_t)(kk + q) * 8), r1v = *(const f32x4*)(rt + (size_t)(kk + q) * 8 + 4);
                    acc[0] += xv * r0v.x; acc[1] += xv * r0v.y; acc[2] += xv * r0v.z; acc[3] += xv * r0v.w; acc[4] += xv * r1v.x; acc[5] += xv * r1v.y; acc[6] += xv * r1v.z; acc[7] += xv * r1v.w; } }
#pragma unroll
            for (int e = 0; e < 8; ++e) acc[e] = wave_sum(acc[e]) * sc;
            int i0 = 0; float v0 = acc[0];
#pragma unroll
            for (int e = 1; e < 8; ++e) if (acc[e] > v0) { v0 = acc[e]; i0 = e; }
            int i1 = -1; float v1 = -3.0e38f;
#pragma unroll
            for (int e = 0; e < 8; ++e) if (e != i0 && acc[e] > v1) { v1 = acc[e]; i1 = e; }
            const float e1 = expf(v1 - v0), w0 = 1.f / (1.f + e1), w1 = e1 / (1.f + e1);
            if (plane == 0) { lsel[2 * lt] = i0; lsel[2 * lt + 1] = i1; lwt[2 * lt] = w0; lwt[2 * lt + 1] = w1;
                lrank[2 * lt] = atomicAdd((int*)(lcnt + i0), 1); lrank[2 * lt + 1] = atomicAdd((int*)(lcnt + i1), 1); }
        }
        __syncthreads();
        if (ptid < 8) lcnt[8 + ptid] = atomicAdd(cnt + ptid, lcnt[ptid]);
        __syncthreads();
        if (ptid < 256) { const int e = lsel[ptid], slot = lcnt[8 + e] + lrank[ptid];
            u32x2 v; v.x = (unsigned)(blk * 128 + (ptid >> 1)); v.y = __builtin_bit_cast(unsigned, lwt[ptid]);
            *(u32x2*)(list2 + ((size_t)e * 32768 + slot) * 2) = v;
            u32x2 pi; pi.x = ((unsigned)e << 20) | (unsigned)slot; pi.y = v.y; *(u32x2*)((unsigned*)(F.ws + WS_PINFO) + ((size_t)(blk * 128) * 2 + ptid) * 2) = pi; }
        __syncthreads();
    }
}

__device__ __forceinline__ void vprep_phase(Frame& F, int layer) {
    const int ptid = otid(), plane = ptid & 63, pwave = __builtin_amdgcn_readfirstlane(ptid >> 6);
    constexpr int VP = 520, V_VB = 0, V_GB = 64 * VP * 2, V_VD = 2 * 64 * VP * 2;
    LAS bf16* VB = (LAS bf16*)(F.lds + V_VB); LAS bf16* GB = (LAS bf16*)(F.lds + V_GB); LAS bf16* VD = (LAS bf16*)(F.lds + V_VD);
    const bf16* P = (const bf16*)(F.ws + WS_BIG); bf16* VF = (bf16*)(F.ws + WS_VF); bf16* VM = (bf16*)(F.ws + WS_VMIX);
    const bf16* vdT = (const bf16*)(F.ws + WS_VLORA); const bf16* vuT = vdT + 32 * 512;
    const float* mu = INP(3) + layer * 1792 + 1024; const float* v0 = INP(16);
    const int tok = ptid >> 3, part = ptid & 7, r16 = plane & 15, q4 = plane >> 4;
    for (int it = F.vcu; it < M / 64; it += F.G) {
        const int m = it * 64 + tok; const int t = m & (T - 1);
        const bf16* cur = P + (size_t)m * PLD + 1024 + part * 64;
#pragma unroll
        for (int q = 0; q < 8; ++q) { float c[8], p[8]; unpack8(*(const u32x4*)(cur + q * 8), c);
            if (t > 0) unpack8(*(const u32x4*)(cur - PLD + q * 8), p); else {
#pragma unroll
                for (int e = 0; e < 8; ++e) p[e] = 0.f; }
            const f32x4 m0 = *(const f32x4*)(mu + part * 64 + q * 8), m1 = *(const f32x4*)(mu + part * 64 + q * 8 + 4);
#pragma unroll
            for (int e = 0; e < 4; ++e) { c[e] = c[e] + (p[e] - c[e]) * m0[e]; c[4 + e] = c[4 + e] + (p[4 + e] - c[4 + e]) * m1[e]; }
            const u32x4 o = pack8(c);
            if (layer == 0) *(u32x4*)(VF + (size_t)m * 512 + part * 64 + q * 8) = o; else *(LAS u32x4*)(VB + tok * VP + part * 64 + q * 8) = o; }
        if (layer == 0) continue;
        __syncthreads();
        { const int rb = pwave & 3, jt = pwave >> 2; f32x4 acc = {0.f, 0.f, 0.f, 0.f};
#pragma unroll 4
          for (int k0 = 0; k0 < 512; k0 += 32) acc = __builtin_amdgcn_mfma_f32_16x16x32_bf16(*(const LAS bf16x8*)(VB + (16 * rb + r16) * VP + k0 + 8 * q4), *(const bf16x8*)(vdT + (size_t)(16 * jt + r16) * 512 + k0 + 8 * q4), acc, 0, 0, 0);
#pragma unroll
          for (int jj = 0; jj < 4; ++jj) VD[(16 * rb + 4 * q4 + jj) * 40 + 16 * jt + r16] = (bf16)f2bf(acc[jj]); }
        __syncthreads();
        { const int rb = pwave & 3; const bf16x8 af = *(const LAS bf16x8*)(VD + (16 * rb + r16) * 40 + 8 * q4);
#pragma unroll 4
          for (int i = 0; i < 16; ++i) { const int ct = (pwave >> 2) * 16 + i;
              const f32x4 acc = __builtin_amdgcn_mfma_f32_16x16x32_bf16(af, *(const bf16x8*)(vuT + (size_t)(16 * ct + r16) * 32 + 8 * q4), (f32x4){0.f, 0.f, 0.f, 0.f}, 0, 0, 0);
              const float vc = v0[16 * ct + r16];
#pragma unroll
              for (int jj = 0; jj < 4; ++jj) GB[(16 * rb + 4 * q4 + jj) * VP + 16 * ct + r16] = (bf16)f2bf(sigm(vc + acc[jj])); } }
        __syncthreads();
#pragma unroll
        for (int q = 0; q < 8; ++q) { float v[8], g[8], vf[8]; unpack8(*(const LAS u32x4*)(VB + tok * VP + part * 64 + q * 8), v); unpack8(*(const LAS u32x4*)(GB + tok * VP + part * 64 + q * 8), g);
            unpack8(*(const u32x4*)(VF + (size_t)m * 512 + part * 64 + q * 8), vf);
#pragma unroll
            for (int e = 0; e < 8; ++e) v[e] = v[e] + (vf[e] - v[e]) * g[e];
            *(u32x4*)(VM + (size_t)m * 512 + part * 64 + q * 8) = pack8(v); }
        __syncthreads();
    }
}
__device__ __forceinline__ void prepass_a(Frame& F) {
    const int tid = otid();
    bf16* P = (bf16*)(F.ws + WS_BIG); bf16* BND2 = (bf16*)(F.ws + WS_BND2);
    { const int ch = tid & 127; const int kind = ch >> 6, part = ch & 7;
      double invf[4];
#pragma unroll
      for (int p = 0; p < 4; ++p) invf[p] = exp(-(double)(part * 4 + p) * (9.210340371976184 / 32.0));
      for (int m = F.vcu * 4 + (tid >> 7); m < M; m += F.G * 4) {
          const int t = m & (T - 1); bf16* ptr = P + (size_t)m * PLD + C_RET + ch * 8;
          float x[8]; unpack8(*(const u32x4*)ptr, x);
#pragma unroll
          for (int p = 0; p < 4; ++p) { double rev = (double)t * invf[p] * 0.15915494309189535; rev -= floor(rev);
              const float sn = __builtin_amdgcn_sinf((float)rev), cs = __builtin_amdgcn_cosf((float)rev);
              const float x0 = x[2 * p], x1 = x[2 * p + 1]; float o0 = x0 * cs - x1 * sn, o1 = x0 * sn + x1 * cs;
              if (kind) { o0 *= 0.125f; o1 *= 0.125f; }
              x[2 * p] = o0; x[2 * p + 1] = o1; }
          *(u32x4*)ptr = pack8(x); } }
    for (int i = F.vcu * 512 + tid; i < 1024 * 3 * 128; i += F.G * 512) { const int ch = i & 127, k = (i >> 7) % 3, r = i / 384;
        if ((r & 511) != 0) *(u32x4*)(BND2 + ((size_t)r * 3 + k) * 1024 + ch * 8) = *(const u32x4*)(P + ((size_t)r * 32 - 3 + k) * PLD + C_XBC + ch * 8); }
}
__device__ __forceinline__ void prepass_conv(Frame& F, int layer) {
    const int tid = otid();
    bf16* P = (bf16*)(F.ws + WS_BIG); const bf16* BND2 = (const bf16*)(F.ws + WS_BND2);
    const float* cw = INP(17) + layer * 1024 * 4; const float* cbias = INP(18) + layer * 1024;
    const int ch = tid & 127;
    f32x4 wv[8]; float bv[8];
#pragma unroll
    for (int e = 0; e < 8; ++e) { wv[e] = *(const f32x4*)(cw + (ch * 8 + e) * 4); bv[e] = cbias[ch * 8 + e]; }
    for (int r = F.vcu * 4 + (tid >> 7); r < M / 32; r += F.G * 4) {
        float w0[8], w1[8], w2[8];
        if ((r & 511) != 0) { unpack8(*(const u32x4*)(BND2 + ((size_t)r * 3 + 0) * 1024 + ch * 8), w0); unpack8(*(const u32x4*)(BND2 + ((size_t)r * 3 + 1) * 1024 + ch * 8), w1); unpack8(*(const u32x4*)(BND2 + ((size_t)r * 3 + 2) * 1024 + ch * 8), w2); }
        else {
#pragma unroll
            for (int e = 0; e < 8; ++e) { w0[e] = 0.f; w1[e] = 0.f; w2[e] = 0.f; } }
        bf16* ptr = P + (size_t)r * 32 * PLD + C_XBC + ch * 8;
#pragma unroll 4
        for (int i = 0; i < 32; ++i) {
            float x[8], o[8]; unpack8(*(const u32x4*)(ptr + (size_t)i * PLD), x);
#pragma unroll
            for (int e = 0; e < 8; ++e) { o[e] = silu(bv[e] + wv[e][0] * w0[e] + wv[e][1] * w1[e] + wv[e][2] * w2[e] + wv[e][3] * x[e]); w0[e] = w1[e]; w1[e] = w2[e]; w2[e] = x[e]; }
            *(u32x4*)(ptr + (size_t)i * PLD) = pack8(o);
        }
    }
}
template <int CTRL> __device__ __forceinline__ float dpp_f(float v) { return __builtin_bit_cast(float, __builtin_amdgcn_update_dpp(0, __builtin_bit_cast(int, v), CTRL, 0xF, 0xF, true)); }
__device__ __forceinline__ float red8(float v) { v += dpp_f<0xB1>(v); v += dpp_f<0x4E>(v); v += dpp_f<0x141>(v); return v; }
__device__ __forceinline__ float red16(float v) { v = red8(v); v += dpp_f<0x140>(v); return v; }

__device__ __forceinline__ void rwkv_seq(Frame& F, int layer, int bh) {
    const int ptid = otid(), plane = ptid & 63, pwave = __builtin_amdgcn_readfirstlane(ptid >> 6); (void)plane; (void)pwave;
    const int b = bh >> 3, h = bh & 7;
    LAS float* L = (LAS float*)F.lds;
    LAS float *rr = L, *ww = L + 2048, *kf = L + 4096, *vv = L + 6144, *aa = L + 8192, *bb = L + 10240, *gg = L + 12288, *yy = L + 14336, *tw = L + 16384, *xa = L + 18432, *sg = L + 20480, *bon = L + 24576;
    const float* mu = INP(3) + layer * 1792; const float* w_up = INP(4) + layer * 64 * 512; const float* w0 = INP(5) + layer * 512;
    const float* a_up = INP(6) + layer * 64 * 512; const float* a0 = INP(7) + layer * 512; const float* g_up = INP(8) + layer * 128 * 512;
    const float* k_k = INP(9) + layer * 512; const float* k_a = INP(10) + layer * 512; const float* r_k = INP(11) + layer * 512;
    const float* gn_w = INP(12) + layer * 512; const float* gn_b = INP(13) + layer * 512;
    const bf16* P = (const bf16*)(F.ws + WS_BIG); const bf16* vsrc = (const bf16*)(F.ws + (layer == 0 ? WS_VF : WS_VMIX)); bf16* yout = (bf16*)(F.ws + WS_YRW);
    const int tid = ptid, tok = tid >> 4, part = tid & 15, c4 = part * 4, cb = h * 64 + c4;
    const int srow = tid >> 3, sc0 = (tid & 7) * 8;
    float S[8];
#pragma unroll
    for (int j = 0; j < 8; ++j) S[j] = 0.f;
    for (int t0 = 0; t0 < T; t0 += 32) {
        {
            const int t = t0 + tok; const size_t m = (size_t)b * T + t;
            const bf16* cur = P + m * PLD;
#pragma unroll
            for (int q = 0; q < 3; ++q) {
                const int ch = part + 16 * q; int col, kind; LAS float* dst;
                if (ch < 8) { col = h * 64 + ch * 8; dst = rr + tok * 64 + ch * 8; kind = 0; }
                else if (ch < 16) { col = 512 + h * 64 + (ch - 8) * 8; dst = kf + tok * 64 + (ch - 8) * 8; kind = 0; }
                else if (ch < 24) { col = 1536 + (ch - 16) * 8; dst = tw + tok * 64 + (ch - 16) * 8; kind = 1; }
                else if (ch < 32) { col = 1600 + (ch - 24) * 8; dst = xa + tok * 64 + (ch - 24) * 8; kind = 0; }
                else { col = 1664 + (ch - 32) * 8; dst = sg + tok * 128 + (ch - 32) * 8; kind = 2; }
                float c[8], p[8]; unpack8(*(const u32x4*)(cur + col), c);
                if (t > 0) unpack8(*(const u32x4*)(cur - PLD + col), p); else {
#pragma unroll
                    for (int e = 0; e < 8; ++e) p[e] = 0.f; }
#pragma unroll
                for (int e = 0; e < 8; ++e) { float x = c[e] + (p[e] - c[e]) * mu[col + e]; if (kind == 1) x = tanhf(x); else if (kind == 2) x = sigm(x); dst[e] = x; }
            }
            if (part < 8) { float v[8]; unpack8(*(const u32x4*)(vsrc + m * 512 + h * 64 + part * 8), v);
#pragma unroll
                for (int e = 0; e < 8; ++e) vv[tok * 64 + part * 8 + e] = v[e]; }
        }
        __syncthreads();
        {
            f32x4 dw = *(const f32x4*)(w0 + cb), da = *(const f32x4*)(a0 + cb), dg = (f32x4){0.f, 0.f, 0.f, 0.f};
            for (int j = 0; j < 64; ++j) { const float tj = tw[tok * 64 + j], xj = xa[tok * 64 + j];
                dw += *(const f32x4*)(w_up + j * 512 + cb) * tj; da += *(const f32x4*)(a_up + j * 512 + cb) * xj; }
            for (int j = 0; j < 128; ++j) dg += *(const f32x4*)(g_up + j * 512 + cb) * sg[tok * 128 + j];
            float kr[4], kk[4], av[4], ss = 0.f;
#pragma unroll
            for (int e = 0; e < 4; ++e) { kr[e] = kf[tok * 64 + c4 + e]; kk[e] = kr[e] * k_k[cb + e]; ss += kk[e] * kk[e]; av[e] = sigm(da[e]); }
            ss = red16(ss);
            const float inv = __builtin_amdgcn_rsqf(fmaxf(ss, 1e-24f));
            float bs = 0.f;
#pragma unroll
            for (int e = 0; e < 4; ++e) { const float kn = kk[e] * inv; const int o = tok * 64 + c4 + e;
                const float ld = -expf(-softplus_acc(-dw[e]) - 0.5f);
                ww[o] = expf(ld); aa[o] = -kn; bb[o] = kn * av[e];
                const float knew = kr[e] * (1.f + (av[e] - 1.f) * k_a[cb + e]); kf[o] = knew; gg[o] = dg[e];
                bs += rr[o] * knew * r_k[cb + e]; }
            bs = red16(bs);
            if (part == 0) bon[tok] = bs;
        }
        __syncthreads();
        for (int s = 0; s < 32; ++s) {
            const f32x4 a0v = *(const LAS f32x4*)(aa + s * 64 + sc0), a1v = *(const LAS f32x4*)(aa + s * 64 + sc0 + 4);
            const f32x4 w0v = *(const LAS f32x4*)(ww + s * 64 + sc0), w1v = *(const LAS f32x4*)(ww + s * 64 + sc0 + 4);
            const f32x4 b0v = *(const LAS f32x4*)(bb + s * 64 + sc0), b1v = *(const LAS f32x4*)(bb + s * 64 + sc0 + 4);
            const f32x4 k0v = *(const LAS f32x4*)(kf + s * 64 + sc0), k1v = *(const LAS f32x4*)(kf + s * 64 + sc0 + 4);
            const f32x4 r0v = *(const LAS f32x4*)(rr + s * 64 + sc0), r1v = *(const LAS f32x4*)(rr + s * 64 + sc0 + 4);
            const float vi = vv[s * 64 + srow];
            float sa = 0.f;
#pragma unroll
            for (int j = 0; j < 4; ++j) sa += S[j] * a0v[j] + S[4 + j] * a1v[j];
            sa = red8(sa);
            float y = 0.f;
#pragma unroll
            for (int j = 0; j < 4; ++j) { S[j] = S[j] * w0v[j] + sa * b0v[j] + vi * k0v[j]; S[4 + j] = S[4 + j] * w1v[j] + sa * b1v[j] + vi * k1v[j]; y += S[j] * r0v[j] + S[4 + j] * r1v[j]; }
            y = red8(y);
            if ((tid & 7) == 0) yy[s * 64 + srow] = y;
        }
        __syncthreads();
        {
            const size_t m = (size_t)b * T + t0 + tok;
            float y[4], sm = 0.f;
#pragma unroll
            for (int e = 0; e < 4; ++e) { y[e] = yy[tok * 64 + c4 + e]; sm += y[e]; }
            const float mean = red16(sm) * (1.f / 64.f);
            float vs = 0.f;
#pragma unroll
            for (int e = 0; e < 4; ++e) { y[e] -= mean; vs += y[e] * y[e]; }
            const float rs = __builtin_amdgcn_rsqf(red16(vs) * (1.f / 64.f) + 64e-5f);
            const float bo = bon[tok];
            float o[4];
#pragma unroll
            for (int e = 0; e < 4; ++e) { const int idx = tok * 64 + c4 + e; o[e] = (y[e] * rs * gn_w[cb + e] + gn_b[cb + e] + bo * vv[idx]) * gg[idx]; }
            u32x2 w; w.x = pk2(o[0], o[1]); w.y = pk2(o[2], o[3]);
            *(u32x2*)(yout + m * 512 + cb) = w;
        }
        __syncthreads();
    }
}

__device__ __forceinline__ void ret_seq(Frame& F, int bh) {
    const int ptid = otid(), plane = ptid & 63, pwave = __builtin_amdgcn_readfirstlane(ptid >> 6); (void)plane; (void)pwave;
    const int b = bh >> 3, h = bh & 7;
    LAS float* L = (LAS float*)F.lds;
    LAS float *qq = L, *kk = L + 2048, *vv = L + 4096, *gg = L + 6144, *yy = L + 8192;
    bf16* P = (bf16*)(F.ws + WS_BIG);
    const int tid = ptid, tok = tid >> 4, part = tid & 15, c4 = part * 4;
    const int se = tid >> 3, sd0 = (tid & 7) * 8;
    const float gamma = 1.f - exp2f(-5.f - (float)h);
    float S[8];
#pragma unroll
    for (int j = 0; j < 8; ++j) S[j] = 0.f;
    for (int t0 = 0; t0 < T; t0 += 32) {
        {
            const int t = t0 + tok; const size_t m = (size_t)b * T + t;
#pragma unroll
            for (int q = 0; q < 2; ++q) {
                const int ch = part + 16 * q, kind = ch >> 3, cc = ch & 7;
                float x[8]; unpack8(*(const u32x4*)(P + m * PLD + C_RET + kind * 512 + h * 64 + cc * 8), x);
                LAS float* dst = (kind == 0 ? qq : kind == 1 ? kk : kind == 2 ? vv : gg) + tok * 64 + cc * 8;
                if (kind < 2) {
#pragma unroll
                    for (int p = 0; p < 4; ++p) { const int i = cc * 4 + p;
                        const double invf = exp(-(double)i * (9.210340371976184 / 32.0));
                        double sn, cs; sincos((double)t * invf, &sn, &cs);
                        const float x0 = x[2 * p], x1 = x[2 * p + 1], c = (float)cs, s = (float)sn;
                        float o0 = x0 * c - x1 * s, o1 = x0 * s + x1 * c;
                        if (kind == 1) { o0 *= 0.125f; o1 *= 0.125f; }
                        dst[2 * p] = o0; dst[2 * p + 1] = o1; }
                } else {
#pragma unroll
                    for (int e = 0; e < 8; ++e) dst[e] = x[e];
                }
            }
        }
        __syncthreads();
        for (int s = 0; s < 32; ++s) {
            const f32x4 k0v = *(const LAS f32x4*)(kk + s * 64 + sd0), k1v = *(const LAS f32x4*)(kk + s * 64 + sd0 + 4);
            const f32x4 q0v = *(const LAS f32x4*)(qq + s * 64 + sd0), q1v = *(const LAS f32x4*)(qq + s * 64 + sd0 + 4);
            const float ve = vv[s * 64 + se];
            float y = 0.f;
#pragma unroll
            for (int j = 0; j < 4; ++j) { S[j] = gamma * S[j] + k0v[j] * ve; S[4 + j] = gamma * S[4 + j] + k1v[j] * ve; y += q0v[j] * S[j] + q1v[j] * S[4 + j]; }
            y = red8(y);
            if ((tid & 7) == 0) yy[s * 64 + se] = y;
        }
        __syncthreads();
        {
            const size_t m = (size_t)b * T + t0 + tok;
            float y[4], ss = 0.f;
#pragma unroll
            for (int e = 0; e < 4; ++e) { y[e] = yy[tok * 64 + c4 + e]; ss += y[e] * y[e]; }
            const float rs = __builtin_amdgcn_rsqf(red16(ss) * (1.f / 64.f) + 1e-6f);
            float o[4];
#pragma unroll
            for (int e = 0; e < 4; ++e) o[e] = y[e] * rs * silu(gg[tok * 64 + c4 + e]);
            u32x2 w; w.x = pk2(o[0], o[1]); w.y = pk2(o[2], o[3]);
            *(u32x2*)(P + m * PLD + C_RETG + h * 64 + c4) = w;
        }
        __syncthreads();
    }
}

__device__ __forceinline__ void ssd_seq(Frame& F, int layer, int bh) {
    const int ptid = otid(), plane = ptid & 63, pwave = __builtin_amdgcn_readfirstlane(ptid >> 6); (void)plane; (void)pwave;
    const int b = bh >> 3, h = bh & 7, g = h >> 2;
    LAS float* L = (LAS float*)F.lds;
    LAS float *raw = L  , *xs = L + 11200, *Bc = L + 13248, *Cc = L + 17344, *yy = L + 21440, *dts = L + 23488, *das = L + 23520;
    bf16* P = (bf16*)(F.ws + WS_BIG); const float* dtb = (const float*)(F.ws + WS_DT);
    const float* cw = INP(17) + layer * 1024 * 4; const float* cbias = INP(18) + layer * 1024;
    const float dt_bias = INP(19)[layer * 8 + h], A = -expf(INP(20)[layer * 8 + h]), Dh = INP(21)[layer * 8 + h];
    const int tid = ptid;
    const int sp = tid >> 3, sn0 = (tid & 7) * 16;
    float S[16];
#pragma unroll
    for (int j = 0; j < 16; ++j) S[j] = 0.f;
    for (int i = tid; i < 3 * 320; i += 512) raw[i] = 0.f;
    __syncthreads();
    for (int t0 = 0; t0 < T; t0 += 32) {
        for (int idx = tid; idx < 32 * 40; idx += 512) {
            const int row = idx / 40, ch = idx % 40; const size_t m = (size_t)b * T + t0 + row;
            const int col = ch < 8 ? (C_XBC + h * 64 + ch * 8) : (ch < 24 ? (C_XBC + 512 + g * 128 + (ch - 8) * 8) : (C_XBC + 768 + g * 128 + (ch - 24) * 8));
            float x[8]; unpack8(*(const u32x4*)(P + m * PLD + col), x);
#pragma unroll
            for (int e = 0; e < 8; ++e) raw[(3 + row) * 320 + ch * 8 + e] = x[e];
        }
        if (tid < 32) { const size_t m = (size_t)b * T + t0 + tid; const float dt = softplus_acc(dtb[m * 8 + h] + dt_bias); dts[tid] = dt; das[tid] = expf(A * dt); }
        __syncthreads();
        for (int idx = tid; idx < 32 * 320; idx += 512) {
            const int row = idx / 320, c = idx % 320;
            const int chn = c < 64 ? (h * 64 + c) : (c < 192 ? (512 + g * 128 + (c - 64)) : (768 + g * 128 + (c - 192)));
            float a = cbias[chn];
#pragma unroll
            for (int k = 0; k < 4; ++k) a += cw[chn * 4 + k] * raw[(row + k) * 320 + c];
            a = silu(a);
            if (c < 64) xs[row * 64 + c] = a; else if (c < 192) Bc[row * 128 + (c - 64)] = a; else Cc[row * 128 + (c - 192)] = a;
        }
        __syncthreads();
        for (int s = 0; s < 32; ++s) {
            const float da = das[s], xv = xs[s * 64 + sp], dtx = dts[s] * xv;
            float y = 0.f;
#pragma unroll
            for (int q = 0; q < 4; ++q) { const f32x4 bv = *(const LAS f32x4*)(Bc + s * 128 + sn0 + q * 4), cv = *(const LAS f32x4*)(Cc + s * 128 + sn0 + q * 4);
#pragma unroll
                for (int j = 0; j < 4; ++j) { S[q * 4 + j] = da * S[q * 4 + j] + dtx * bv[j]; y += S[q * 4 + j] * cv[j]; } }
            y = red8(y);
            if ((tid & 7) == 0) yy[s * 64 + sp] = y + Dh * xv;
        }
        __syncthreads();
        {
            const int tok = tid >> 4, c4 = (tid & 15) * 4; const size_t m = (size_t)b * T + t0 + tok;
            u32x2 w; w.x = pk2(yy[tok * 64 + c4], yy[tok * 64 + c4 + 1]); w.y = pk2(yy[tok * 64 + c4 + 2], yy[tok * 64 + c4 + 3]);
            *(u32x2*)(P + m * PLD + C_XBC + h * 64 + c4) = w;
            for (int i = tid; i < 3 * 320; i += 512) raw[i] = raw[32 * 320 + i];
        }
        __syncthreads();
    }
}
__device__ __forceinline__ void ssm_norm_phase(Frame& F, int layer) {
    const int ptid = otid(), plane = ptid & 63, pwave = __builtin_amdgcn_readfirstlane(ptid >> 6);
    const int gw = F.vcu * 8 + pwave, NGW = F.G * 8;
    bf16* P = (bf16*)(F.ws + WS_BIG); const float* nw = INP(22) + layer * 512;
    float nwv[8];
#pragma unroll
    for (int e = 0; e < 8; ++e) nwv[e] = nw[plane * 8 + e];
    for (int m0 = 2 * gw; m0 < M; m0 += 2 * NGW) {
        u32x4 yv[2], zv[2];
#pragma unroll
        for (int q = 0; q < 2; ++q) { yv[q] = *(const u32x4*)(P + (size_t)(m0 + q) * PLD + C_XBC + plane * 8); zv[q] = *(const u32x4*)(P + (size_t)(m0 + q) * PLD + C_Z + plane * 8); }
#pragma unroll
        for (int q = 0; q < 2; ++q) { float y[8], z[8]; unpack8(yv[q], y); unpack8(zv[q], z);
            float ss = 0.f;
#pragma unroll
            for (int e = 0; e < 8; ++e) { y[e] *= silu(z[e]); ss += y[e] * y[e]; }
            ss = red16(ss); ss += __shfl_xor(ss, 16);
            const float rs = __builtin_amdgcn_rsqf(ss * (1.f / 256.f) + 1e-6f);
#pragma unroll
            for (int e = 0; e < 8; ++e) y[e] *= rs * nwv[e];
            *(u32x4*)(P + (size_t)(m0 + q) * PLD + C_Z + plane * 8) = pack8(y); }
    }
}
constexpr int PT = 72, PT2 = 136, PF = 68;
__device__ __forceinline__ f32x4 mfma16(bf16x8 a, bf16x8 b, f32x4 c) { return __builtin_amdgcn_mfma_f32_16x16x32_bf16(a, b, c, 0, 0, 0); }
template <int K, bool SA = false, bool SB = false> __device__ __forceinline__ f32x4 mm_ll(const LAS bf16* A, int pa, int m0, const LAS bf16* B, int pb, int n0, f32x4 acc, int lane) {
    const int r = lane & 15, q = lane >> 4;
    const int xa = SA ? (((m0 + r) >> 3) & 7) : 0, xb = SB ? (((n0 + r) >> 3) & 7) : 0;
    const LAS bf16* ap = A + (m0 + r) * pa; const LAS bf16* bp = B + (n0 + r) * pb;
#pragma unroll
    for (int k0 = 0; k0 < K; k0 += 32) acc = mfma16(*(const LAS bf16x8*)(ap + 8 * (((k0 >> 3) + q) ^ xa)), *(const LAS bf16x8*)(bp + 8 * (((k0 >> 3) + q) ^ xb)), acc);
    return acc;
}
template <int K> __device__ __forceinline__ f32x4 mm_lg(const LAS bf16* A, int pa, int m0, const bf16* B, int pb, int n0, f32x4 acc, int lane) {
    const int r = lane & 15, q = lane >> 4;
    const LAS bf16* ap = A + (m0 + r) * pa + 8 * q; const bf16* bp = B + (size_t)(n0 + r) * pb + 8 * q;
#pragma unroll
    for (int k0 = 0; k0 < K; k0 += 32) acc = mfma16(*(const LAS bf16x8*)(ap + k0), *(const bf16x8*)(bp + k0), acc);
    return acc;
}
__device__ __forceinline__ float redl16(float v) { return red16(v); }
__device__ __forceinline__ void st4bf(LAS bf16* p, f32x4 v) { u32x2 w; w.x = pk2(v[0], v[1]); w.y = pk2(v[2], v[3]); *(LAS u32x2*)p = w; }
__device__ __forceinline__ float ldbf(const LAS bf16* p) { return __builtin_bit_cast(float, (unsigned)(*p) << 16); }
constexpr f32x4 FZ4 = {0.f, 0.f, 0.f, 0.f};
__device__ __forceinline__ void tr_write8(LAS bf16* Tm, int pitch, int c0, int t, const float (&v)[8], int) {
    LAS bf16* base = Tm + c0 * pitch + (t ^ (((c0 >> 3) & 7) << 3));
#pragma unroll
    for (int e = 0; e < 8; ++e) base[e * pitch] = (bf16)f2bf(v[e]);
}
__device__ __forceinline__ float tr_at(const LAS bf16* Tm, int pitch, int row, int col) { return __builtin_bit_cast(float, (unsigned)Tm[row * pitch + (col ^ (((row >> 3) & 7) << 3))] << 16); }
__device__ __forceinline__ void ld8f(const LAS float* p, float (&v)[8]) { const f32x4 a = *(const LAS f32x4*)p, b = *(const LAS f32x4*)(p + 4); v[0] = a[0]; v[1] = a[1]; v[2] = a[2]; v[3] = a[3]; v[4] = b[0]; v[5] = b[1]; v[6] = b[2]; v[7] = b[3]; }
__device__ __forceinline__ void st8f(LAS float* p, const float (&v)[8]) { *(LAS f32x4*)p = (f32x4){v[0], v[1], v[2], v[3]}; *(LAS f32x4*)(p + 4) = (f32x4){v[4], v[5], v[6], v[7]}; }

template <bool FINAL>
__device__ __forceinline__ void rwkv_chunk_unit(Frame& F, int layer, int u) {
    const int tid = otid(), w = __builtin_amdgcn_readfirstlane(tid >> 6);
    bf16x8 lfr[16];
#define IDS() const int ft = fresh_tid(tid); const int lane = ft & 63, r16 = lane & 15, q4 = lane >> 4, tok = ft >> 3, part = ft & 7; (void)lane; (void)r16; (void)q4; (void)tok; (void)part
    const int b = u >> 9, sc = (u >> 3) & 63, h = u & 7;
    constexpr int NV = FINAL ? 64 : 128, NVT = NV / 16, NZ = NVT / 2;
    constexpr int X_TW = 0, X_XA = 9216, X_SG = 18432, X_KF = 35840, X_RF = 52224;
    constexpr int O_AT = 0, O_RT = 9216, O_BT = 18432, O_KT = 27648, O_BH = 36864, O_KH = 46080, O_VT = 55296, O_TF = O_BT;
    constexpr int Y0 = 68608;
    constexpr int Y_A = Y0, Y_B = Y0 + 8192, Y_K = Y0 + 16384, Y_R = Y0 + 24576, Y_L = Y0 + 32768, Y_VF = Y0 + 49152;
    constexpr int Y_AAB = Y0, Y_AAK = Y0 + 17408, Y_ARB = Y_AAK + 9216, Y_ARK = Y_ARB + 9216, Y_TB = FINAL ? Y_ARK + 9216 : Y_AAK + 9216, Y_ZU = Y_TB + 9216, Y_YF = Y_AAB;
    static_assert(Y_ZU + NV * PT * 2 <= Y0 + 65536, "region Y");
    constexpr int Z0 = Y0 + 65536, Z_G = Z0, Z_S = FINAL ? Z0 + 8192 : Z0, Z_MISC = 152576, Z_BON = Z_MISC, Z_PC = Z_MISC + 256, Z_PAR = Z_MISC + 512, Z_XS = Y_ZU;
    static_assert(Z_S + NV * PT * 2 <= Z_MISC && Z_PAR + 832 * 4 <= LDSCTL_OFF, "region Z");
    LAS unsigned char* L = F.lds;
#define LB(off) ((LAS bf16*)(L + (off)))
#define LF(off) ((LAS float*)(L + (off)))
    {
        const int pidx = (w == 0) ? 5 : (w == 1) ? 7 : (w == 2) ? 9 : (w == 3) ? 10 : (w == 4) ? 11 : (w == 5) ? 12 : 13;
        if (w < 7) LF(Z_PAR)[w * 64 + (tid & 63)] = (INP(pidx) + layer * 512 + h * 64)[tid & 63];
        const float* mu = INP(3) + layer * 1792;
        for (int i = tid; i < 384; i += 512) LF(Z_PAR)[448 + i] = mu[(i < 64) ? (h * 64 + i) : (i < 128) ? (512 + h * 64 + (i - 64)) : (1536 + (i - 128))];
    }
    __syncthreads();
    const bf16* WupT = (const bf16*)(F.ws + WS_LORA + (size_t)layer * LORA_STRIDE) + h * 64 * 64;
    const bf16* AupT = (const bf16*)(F.ws + WS_LORA + (size_t)layer * LORA_STRIDE + 65536) + h * 64 * 64;
    const bf16* GupT = (const bf16*)(F.ws + WS_LORA + (size_t)layer * LORA_STRIDE + 131072) + h * 64 * 128;
    const bf16* P = (const bf16*)(F.ws + WS_BIG); const bf16* vsrc = (const bf16*)(F.ws + (layer == 0 ? WS_VF : WS_VMIX));
    float* Nbuf = (float*)(F.st + 0) + (size_t)u * 4096; bf16* MT = (bf16*)(F.ws + WS_MT) + (size_t)u * 4096;
    { IDS();
        if (w < 4) {
#pragma unroll
            for (int nt = 0; nt < 4; ++nt)
#pragma unroll
                for (int k2 = 0; k2 < 2; ++k2) { lfr[nt * 4 + k2] = *(const bf16x8*)(WupT + (size_t)(16 * nt + r16) * 64 + 32 * k2 + 8 * q4); lfr[nt * 4 + 2 + k2] = *(const bf16x8*)(AupT + (size_t)(16 * nt + r16) * 64 + 32 * k2 + 8 * q4); }
        } else if (FINAL) {
#pragma unroll
            for (int nt = 0; nt < 4; ++nt)
#pragma unroll
                for (int k4 = 0; k4 < 4; ++k4) lfr[nt * 4 + k4] = *(const bf16x8*)(GupT + (size_t)(16 * nt + r16) * 128 + 32 * k4 + 8 * q4);
        } }
    constexpr int NST = FINAL ? 2 : 4;
    f32x4 Sacc[NST];
    const int s_vb = FINAL ? (w & 3) : w;
#define S_CT(ti) (FINAL ? (2 * (w >> 2) + (ti)) : (ti))
    { IDS();
#pragma unroll
    for (int ti = 0; ti < NST; ++ti) {
        const int ct = S_CT(ti);
        f32x4 nin = FZ4; if (FINAL) nin = *(const f32x4*)(Nbuf + ((s_vb * 4 + ct) * 64 + 16 * q4 + r16) * 4);
#pragma unroll
        for (int jj = 0; jj < 4; ++jj) { const int v = 16 * s_vb + 4 * q4 + jj, c = 16 * ct + r16;
            float x; if (FINAL) x = nin[jj]; else x = (v >= 64 && v - 64 == c) ? 1.f : 0.f;
            Sacc[ti][jj] = x; LB(Z_S)[v * PT + c] = (bf16)f2bf(x); }
    } }
    u32x4 pfc[6], pfp[6], pfv;
#define RW_PREFETCH(jn) do { IDS(); const int t_ = sc * 256 + (jn) * 64 + tok; const size_t m_ = (size_t)b * T + t_; const bf16* cur_ = P + m_ * PLD; \
        _Pragma("unroll") for (int i_ = 0; i_ < 6; ++i_) { const int col_ = (i_ == 0) ? (h * 64 + 8 * part) : (i_ == 1) ? (512 + h * 64 + 8 * part) : (i_ == 2) ? (1536 + 8 * part) : (i_ == 3) ? (1600 + 8 * part) : (1664 + 8 * part + (i_ - 4) * 64); \
            pfc[i_] = *(const u32x4*)(cur_ + col_); pfp[i_] = (t_ > 0) ? *(const u32x4*)(cur_ - PLD + col_) : (u32x4){0u, 0u, 0u, 0u}; } \
        pfv = *(const u32x4*)(vsrc + m_ * 512 + h * 64 + 8 * part); } while (0)
    RW_PREFETCH(0);
    for (int j = 0; j < 4; ++j) {
        const int tl0 = sc * 256 + j * 64;
        {
            IDS();
            const int t = tl0 + tok; const size_t m = (size_t)b * T + t; const bf16* cur = P + m * PLD;
#pragma unroll
            for (int i = 0; i < 6; ++i) {
                const int col = (i == 0) ? (h * 64 + 8 * part) : (i == 1) ? (512 + h * 64 + 8 * part) : (i == 2) ? (1536 + 8 * part) : (i == 3) ? (1600 + 8 * part) : (1664 + 8 * part + (i - 4) * 64);
                float c[8], p[8]; unpack8(pfc[i], c); unpack8(pfp[i], p); (void)col;
#pragma unroll
                for (int e = 0; e < 8; ++e) c[e] = c[e] + (p[e] - c[e]) * LF(Z_PAR)[448 + ((i < 4) ? 64 * i : 256 + 64 * (i - 4)) + 8 * part + e];
                if (i == 0) { st8f(LF(X_RF) + tok * 64 + 8 * part, c);
                } else if (i == 1) { st8f(LF(X_KF) + tok * 64 + 8 * part, c);
                } else if (i == 2) {
#pragma unroll
                    for (int e = 0; e < 8; ++e) c[e] = fast_tanh(c[e]);
                    *(LAS u32x4*)(LB(X_TW) + tok * PT + 8 * part) = pack8(c);
                } else if (i == 3) {
                    *(LAS u32x4*)(LB(X_XA) + tok * PT + 8 * part) = pack8(c);
                } else if (FINAL) {
#pragma unroll
                    for (int e = 0; e < 8; ++e) c[e] = sigm(c[e]);
                    *(LAS u32x4*)(LB(X_SG) + tok * PT2 + 8 * part + (i - 4) * 64) = pack8(c);
                }
            }
            float v[8]; unpack8(pfv, v); (void)m; (void)cur;
            st8f(LF(Y_VF) + tok * 64 + 8 * part, v);
        }
        if (j < 3) RW_PREFETCH(j + 1);
        __syncthreads();
        { IDS();
        if (w < 4) {
            const int rb = w;
            float inv[4], bs[4] = {0.f, 0.f, 0.f, 0.f};
            { float ss[4] = {0.f, 0.f, 0.f, 0.f};
#pragma unroll
                for (int nt = 0; nt < 4; ++nt) { const int c = 16 * nt + r16; const float kkc = LF(Z_PAR)[128 + c];
#pragma unroll
                    for (int jj = 0; jj < 4; ++jj) { const float kk = LF(X_KF)[(16 * rb + 4 * q4 + jj) * 64 + c] * kkc; ss[jj] += kk * kk; } }
#pragma unroll
                for (int jj = 0; jj < 4; ++jj) inv[jj] = __builtin_amdgcn_rsqf(fmaxf(redl16(ss[jj]), 1e-24f)); }
#pragma unroll
            for (int nt = 0; nt < 4; ++nt) {
                f32x4 aw = FZ4, aa = FZ4;
#pragma unroll
                for (int k2 = 0; k2 < 2; ++k2) { aw = mfma16(*(const LAS bf16x8*)(LB(X_TW) + (16 * rb + r16) * PT + 32 * k2 + 8 * q4), lfr[nt * 4 + k2], aw); aa = mfma16(*(const LAS bf16x8*)(LB(X_XA) + (16 * rb + r16) * PT + 32 * k2 + 8 * q4), lfr[nt * 4 + 2 + k2], aa); }
                const int c = 16 * nt + r16; const float w0c = LF(Z_PAR)[c], a0c = LF(Z_PAR)[64 + c], kkc = LF(Z_PAR)[128 + c], kac = LF(Z_PAR)[192 + c], rkc = LF(Z_PAR)[256 + c];
#pragma unroll
                for (int jj = 0; jj < 4; ++jj) { const int t = 16 * rb + 4 * q4 + jj, o = t * 64 + c;
                    LF(Y_L)[o] = -0.8750455979f * sigm(w0c + aw[jj]);
                    const float al = sigm(a0c + aa[jj]), kraw = LF(X_KF)[o], rr = LF(X_RF)[o], kn = kraw * kkc * inv[jj];
                    const float knew = kraw * (1.f + (al - 1.f) * kac);
                    LB(Y_A)[o] = (bf16)f2bf(-kn); LB(Y_B)[o] = (bf16)f2bf(kn * al); LB(Y_K)[o] = (bf16)f2bf(knew); LB(Y_R)[o] = (bf16)f2bf(rr);
                    bs[jj] += rr * knew * rkc; } }
#pragma unroll
            for (int jj = 0; jj < 4; ++jj) { const float sm = redl16(bs[jj]); if (r16 == 0) LF(Z_BON)[16 * rb + 4 * q4 + jj] = sm; }
        } else if (FINAL) {
            const int rb = w - 4;
#pragma unroll
            for (int nt = 0; nt < 4; ++nt) { f32x4 ag = FZ4;
#pragma unroll
                for (int k4 = 0; k4 < 4; ++k4) ag = mfma16(*(const LAS bf16x8*)(LB(X_SG) + (16 * rb + r16) * PT2 + 32 * k4 + 8 * q4), lfr[nt * 4 + k4], ag);
#pragma unroll
                for (int jj = 0; jj < 4; ++jj) LB(Z_G)[(16 * rb + 4 * q4 + jj) * 64 + 16 * nt + r16] = (bf16)f2bf(ag[jj]); }
        } }
        __syncthreads();
        if (w == 0) { IDS(); float run = 0.f;
#pragma unroll 8
            for (int t = 0; t < 64; ++t) { run += LF(Y_L)[t * 64 + lane]; LF(Y_L)[t * 64 + lane] = run; }
            LF(Z_PC)[lane] = ex2(run); }
        __syncthreads();
        {
            IDS(); const int t = tok, c0 = 8 * part;
            float Lt[8], Lp[8], Le[8], av[8], bv[8], kv[8], rv[8], vv[8], at[8], rt[8], bt[8], kt[8], bh[8], kh[8];
            ld8f(LF(Y_L) + t * 64 + c0, Lt); ld8f(LF(Y_L) + 63 * 64 + c0, Le); ld8f(LF(Y_VF) + t * 64 + c0, vv);
            if (t > 0) ld8f(LF(Y_L) + (t - 1) * 64 + c0, Lp); else {
#pragma unroll
                for (int e = 0; e < 8; ++e) Lp[e] = 0.f; }
            unpack8(*(const LAS u32x4*)(LB(Y_A) + t * 64 + c0), av); unpack8(*(const LAS u32x4*)(LB(Y_B) + t * 64 + c0), bv);
            unpack8(*(const LAS u32x4*)(LB(Y_K) + t * 64 + c0), kv); unpack8(*(const LAS u32x4*)(LB(Y_R) + t * 64 + c0), rv);
#pragma unroll
            for (int e = 0; e < 8; ++e) { const float eL = ex2(Lt[e]), eLm = ex2(Lp[e]), eN = ex2(-Lt[e]), eE = ex2(Le[e] - Lt[e]);
                at[e] = av[e] * eLm; rt[e] = rv[e] * eL; bt[e] = bv[e] * eN; kt[e] = kv[e] * eN; bh[e] = bv[e] * eE; kh[e] = kv[e] * eE; }
            tr_write8(LB(O_BH), PT, c0, t, bh, part); tr_write8(LB(O_KH), PT, c0, t, kh, part); tr_write8(LB(O_VT), PT, c0, t, vv, part);
            *(LAS u32x4*)(LB(O_AT) + t * PT + c0) = pack8(at); *(LAS u32x4*)(LB(O_RT) + t * PT + c0) = pack8(rt);
            *(LAS u32x4*)(LB(O_BT) + t * PT + c0) = pack8(bt); *(LAS u32x4*)(LB(O_KT) + t * PT + c0) = pack8(kt);
        }
        __syncthreads();
        {
            IDS(); const int rb = w & 3;
#pragma unroll
            for (int ci = 0; ci < 2; ++ci) { const int ct = 2 * (w >> 2) + ci;
                f32x4 ab = FZ4, ak = FZ4, arb = FZ4, ark = FZ4;
                if (ct <= rb) { ab = mm_ll<64>(LB(O_AT), PT, 16 * rb, LB(O_BT), PT, 16 * ct, FZ4, lane); ak = mm_ll<64>(LB(O_AT), PT, 16 * rb, LB(O_KT), PT, 16 * ct, FZ4, lane);
                    if (FINAL) { arb = mm_ll<64>(LB(O_RT), PT, 16 * rb, LB(O_BT), PT, 16 * ct, FZ4, lane); ark = mm_ll<64>(LB(O_RT), PT, 16 * rb, LB(O_KT), PT, 16 * ct, FZ4, lane); } }
#pragma unroll
                for (int jj = 0; jj < 4; ++jj) { const int t = 16 * rb + 4 * q4 + jj, i = 16 * ct + r16;
                    LF(Y_AAB)[t * PF + i] = (i < t) ? ab[jj] : 0.f; LB(Y_TB)[t * PT + i] = (bf16)f2bf(((i >> 4) < (t >> 4)) ? ab[jj] : 0.f); LB(Y_AAK)[t * PT + i] = (bf16)f2bf((i < t) ? ak[jj] : 0.f);
                    if (FINAL) { LB(Y_ARB)[t * PT + i] = (bf16)f2bf((i <= t) ? arb[jj] : 0.f); LB(Y_ARK)[t * PT + i] = (bf16)f2bf((i <= t) ? ark[jj] : 0.f); } } }
        }
        __syncthreads();
        {
            IDS(); const int rb = w & 3;
            constexpr int O_DB = O_BT, O_VB = O_BT + 5120;
            if (w == 0) { const int blk = lane >> 4, col = lane & 15; float x[16];
#pragma unroll
                for (int i = 0; i < 16; ++i) x[i] = (i == col) ? 1.f : 0.f;
#pragma unroll
                for (int g3 = 0; g3 < 3; ++g3) {
                    f32x4 ar[5][4];
#pragma unroll
                    for (int ii = 0; ii < 5; ++ii) { const int i = 1 + 5 * g3 + ii;
#pragma unroll
                        for (int g4 = 0; g4 < 4; ++g4) if (4 * g4 < i) ar[ii][g4] = *(const LAS f32x4*)(LF(Y_AAB) + (16 * blk + i) * PF + 16 * blk + 4 * g4); }
                    asm volatile("" ::: "memory");
#pragma unroll
                    for (int ii = 0; ii < 5; ++ii) { const int i = 1 + 5 * g3 + ii; float sacc = 0.f;
#pragma unroll
                        for (int m2 = 0; m2 < i; ++m2) sacc += ar[ii][m2 >> 2][m2 & 3] * x[m2];
                        x[i] += sacc; }
                }
#pragma unroll
                for (int i = 0; i < 16; ++i) LB(O_DB)[(16 * blk + i) * 40 + col] = (bf16)f2bf(x[i]);
                *(LAS u32x4*)(LB(O_DB) + lane * 40 + 16) = (u32x4){0u, 0u, 0u, 0u}; *(LAS u32x4*)(LB(O_DB) + lane * 40 + 24) = (u32x4){0u, 0u, 0u, 0u}; }
            if (lane < 16) { *(LAS u32x4*)(LB(O_VB) + w * 640 + lane * 40 + 16) = (u32x4){0u, 0u, 0u, 0u}; *(LAS u32x4*)(LB(O_VB) + w * 640 + lane * 40 + 24) = (u32x4){0u, 0u, 0u, 0u}; }
#pragma unroll
            for (int ci = 0; ci < NZ; ++ci) { const int vt = (w >> 2) * NZ + ci;
                f32x4 z = mm_ll<64>(LB(O_AT), PT, 16 * rb, LB(Z_S), PT, 16 * vt, FZ4, lane);
                if (vt < 4) z = mm_ll<64, false, true>(LB(Y_AAK), PT, 16 * rb, LB(O_VT), PT, 16 * vt, z, lane);
                st4bf(LB(Y_ZU) + (16 * vt + r16) * PT + 16 * rb + 4 * q4, z); }
            __syncthreads();
            if (w < NVT) { const int vt = w; LAS bf16* vb = LB(O_VB) + w * 640; LAS bf16* zrow = LB(Y_ZU) + (16 * vt + r16) * PT;
#pragma unroll
                for (int bb = 0; bb < 4; ++bb) {
                    f32x4 acc; { const u32x2 zz = *(const LAS u32x2*)(zrow + 16 * bb + 4 * q4); acc[0] = bflo(zz.x); acc[1] = bfhi(zz.x); acc[2] = bflo(zz.y); acc[3] = bfhi(zz.y); }
                    if (bb >= 1) acc = mfma16(*(const LAS bf16x8*)(LB(Y_TB) + (16 * bb + r16) * PT + 8 * q4), *(const LAS bf16x8*)(zrow + 8 * q4), acc);
                    if (bb >= 3) acc = mfma16(*(const LAS bf16x8*)(LB(Y_TB) + (16 * bb + r16) * PT + 32 + 8 * q4), *(const LAS bf16x8*)(zrow + 32 + 8 * q4), acc);
                    st4bf(vb + r16 * 40 + 4 * q4, acc);
                    const f32x4 ub = mfma16(*(const LAS bf16x8*)(LB(O_DB) + (16 * bb + r16) * 40 + 8 * q4), *(const LAS bf16x8*)(vb + r16 * 40 + 8 * q4), FZ4);
                    st4bf(zrow + 16 * bb + 4 * q4, ub); }
            }
        }
        __syncthreads();
        {
            IDS(); f32x4 yy[2];
            if (FINAL) { const int rb = w & 3;
#pragma unroll
                for (int ci = 0; ci < 2; ++ci) { const int ct = 2 * (w >> 2) + ci;
                    f32x4 y = mm_ll<64>(LB(O_RT), PT, 16 * rb, LB(Z_S), PT, 16 * ct, FZ4, lane);
                    y = mm_ll<64>(LB(Y_ARB), PT, 16 * rb, LB(Y_ZU), PT, 16 * ct, y, lane);
                    yy[ci] = mm_ll<64, false, true>(LB(Y_ARK), PT, 16 * rb, LB(O_VT), PT, 16 * ct, y, lane); } }
#pragma unroll
            for (int ti = 0; ti < NST; ++ti) { const int ct = S_CT(ti); const float pc = LF(Z_PC)[16 * ct + r16];
                f32x4 s = Sacc[ti] * pc;
                s = mm_ll<64, false, true>(LB(Y_ZU), PT, 16 * s_vb, LB(O_BH), PT, 16 * ct, s, lane);
                if (s_vb < 4) s = mm_ll<64, true, true>(LB(O_VT), PT, 16 * s_vb, LB(O_KH), PT, 16 * ct, s, lane);
                Sacc[ti] = s; }
            __syncthreads();
#pragma unroll
            for (int ti = 0; ti < NST; ++ti) { const int ct = S_CT(ti);
#pragma unroll
                for (int jj = 0; jj < 4; ++jj) LB(Z_S)[(16 * s_vb + 4 * q4 + jj) * PT + 16 * ct + r16] = (bf16)f2bf(Sacc[ti][jj]); }
            if (FINAL) { const int rb = w & 3;
#pragma unroll
                for (int ci = 0; ci < 2; ++ci) { const int ct = 2 * (w >> 2) + ci;
#pragma unroll
                    for (int jj = 0; jj < 4; ++jj) LF(Y_YF)[(16 * rb + 4 * q4 + jj) * PF + 16 * ct + r16] = yy[ci][jj]; } }
        }
        __syncthreads();
        if (FINAL) {
            IDS();
            const int t = tok, c0 = 8 * part; const size_t m = (size_t)b * T + tl0 + t;
            float y[8], gg[8], sm = 0.f; ld8f(LF(Y_YF) + t * PF + c0, y); unpack8(*(const LAS u32x4*)(LB(Z_G) + t * 64 + c0), gg);
#pragma unroll
            for (int e = 0; e < 8; ++e) sm += y[e];
            const float mean = red8(sm) * (1.f / 64.f); float vs = 0.f;
#pragma unroll
            for (int e = 0; e < 8; ++e) { y[e] -= mean; vs += y[e] * y[e]; }
            const float rs = __builtin_amdgcn_rsqf(red8(vs) * (1.f / 64.f) + 64e-5f), bo = LF(Z_BON)[t];
#pragma unroll
            for (int e = 0; e < 8; ++e) { const int c = c0 + e; y[e] = (y[e] * rs * LF(Z_PAR)[320 + c] + LF(Z_PAR)[384 + c] + bo * tr_at(LB(O_VT), PT, c, t)) * gg[e]; }
            *(u32x4*)((bf16*)(F.ws + WS_BIG) + m * PLD + 1024 + h * 64 + c0) = pack8(y);
        }
        __syncthreads();
    }
    if (!FINAL) { IDS();
#pragma unroll
        for (int ti = 0; ti < NST; ++ti) { const int ct = S_CT(ti);
            if (s_vb < 4) { *(f32x4*)(Nbuf + ((s_vb * 4 + ct) * 64 + 16 * q4 + r16) * 4) = Sacc[ti];
            } else { u32x2 wv; wv.x = pk2(Sacc[ti][0], Sacc[ti][1]); wv.y = pk2(Sacc[ti][2], Sacc[ti][3]);
                *(u32x2*)(MT + (16 * ct + r16) * 64 + 16 * (s_vb - 4) + 4 * q4) = wv; }
        }
    }
#undef RW_PREFETCH
#undef IDS
#undef S_CT
#undef LB
#undef LF
}

template <bool FINAL>
__device__ __forceinline__ void ret_chunk_unit(Frame& F, int u) {
    const int tid = otid(), lane = tid & 63, w = __builtin_amdgcn_readfirstlane(tid >> 6), r16 = lane & 15, q4 = lane >> 4;
    const int b = u >> 9, sc = (u >> 3) & 63, h = u & 7;
    constexpr int R_QB = 0, R_KB = 9216, R_KHT = 18432, R_VT = 27648, R_GB = 36864, R_AB = 45056, R_SB = 54272, R_YF = 63488;
    LAS unsigned char* L = F.lds;
#define LB(off) ((LAS bf16*)(L + (off)))
#define LF(off) ((LAS float*)(L + (off)))
    bf16* P = (bf16*)(F.ws + WS_BIG);
    float* Sbuf = (float*)(F.st + 16 * MiB) + (size_t)u * 4096;
    const float lg = log2f(1.f - exp2f(-5.f - (float)h));
    const float g64 = ex2(64.f * lg);
    const int db = w & 3;
    f32x4 Sacc[2];
#pragma unroll
    for (int ci = 0; ci < 2; ++ci) { const int et = 2 * (w >> 2) + ci;
#pragma unroll
        for (int jj = 0; jj < 4; ++jj) Sacc[ci][jj] = FINAL ? Sbuf[(16 * db + 4 * q4 + jj) * 64 + 16 * et + r16] : 0.f;
        if (FINAL) st4bf(LB(R_SB) + (16 * et + r16) * PT + 16 * db + 4 * q4, Sacc[ci]); }
    const int tok = tid >> 3, part = tid & 7;
    u32x4 pq = {0u, 0u, 0u, 0u}, pk, pv, pg = {0u, 0u, 0u, 0u};
#define RET_PREFETCH(jn) do { const bf16* row_ = P + ((size_t)b * T + sc * 256 + (jn) * 64 + tok) * PLD + C_RET + h * 64 + 8 * part; \
        pk = *(const u32x4*)(row_ + 512); pv = *(const u32x4*)(row_ + 1024); if (FINAL) { pq = *(const u32x4*)row_; pg = *(const u32x4*)(row_ + 1536); } } while (0)
    RET_PREFETCH(0);
    for (int j = 0; j < 4; ++j) {
        const int tl0 = sc * 256 + j * 64;
        {
            float qv[8], kv[8], vv[8]; unpack8(pk, kv); unpack8(pv, vv);
            if (FINAL) { unpack8(pq, qv); *(LAS u32x4*)(LB(R_GB) + tok * 64 + 8 * part) = pg; }
            if (j < 3) RET_PREFETCH(j + 1);
            const float zeta = ex2((float)(63 - tok) * lg);
            if (FINAL) { *(LAS u32x4*)(LB(R_QB) + tok * PT + 8 * part) = pack8(qv); *(LAS u32x4*)(LB(R_KB) + tok * PT + 8 * part) = pack8(kv); }
            float kz[8];
#pragma unroll
            for (int e = 0; e < 8; ++e) kz[e] = kv[e] * zeta;
            tr_write8(LB(R_KHT), PT, 8 * part, tok, kz, part); tr_write8(LB(R_VT), PT, 8 * part, tok, vv, part);
        }
        __syncthreads();
        if (FINAL) { const int rb = w & 3;
#pragma unroll
            for (int ci = 0; ci < 2; ++ci) { const int ct = 2 * (w >> 2) + ci; f32x4 a = FZ4;
                if (ct <= rb) a = mm_ll<64>(LB(R_QB), PT, 16 * rb, LB(R_KB), PT, 16 * ct, FZ4, lane);
#pragma unroll
                for (int jj = 0; jj < 4; ++jj) { const int l = 16 * rb + 4 * q4 + jj, s = 16 * ct + r16; LB(R_AB)[l * PT + s] = (bf16)f2bf((s <= l) ? a[jj] * ex2((float)(l - s) * lg) : 0.f); } }
            __syncthreads();
        }
        {
            f32x4 yy[2];
            if (FINAL) { const int rb = w & 3;
#pragma unroll
                for (int ci = 0; ci < 2; ++ci) { const int et = 2 * (w >> 2) + ci;
                    const f32x4 a1 = mm_ll<64, false, true>(LB(R_AB), PT, 16 * rb, LB(R_VT), PT, 16 * et, FZ4, lane), a2 = mm_ll<64>(LB(R_QB), PT, 16 * rb, LB(R_SB), PT, 16 * et, FZ4, lane);
#pragma unroll
                    for (int jj = 0; jj < 4; ++jj) yy[ci][jj] = a1[jj] + ex2((float)(16 * rb + 4 * q4 + jj + 1) * lg) * a2[jj]; } }
#pragma unroll
            for (int ci = 0; ci < 2; ++ci) { const int et = 2 * (w >> 2) + ci; Sacc[ci] = mm_ll<64, true, true>(LB(R_KHT), PT, 16 * db, LB(R_VT), PT, 16 * et, Sacc[ci] * g64, lane); }
            __syncthreads();
            if (FINAL) { const int rb = w & 3;
#pragma unroll
                for (int ci = 0; ci < 2; ++ci) { const int et = 2 * (w >> 2) + ci; st4bf(LB(R_SB) + (16 * et + r16) * PT + 16 * db + 4 * q4, Sacc[ci]);
#pragma unroll
                    for (int jj = 0; jj < 4; ++jj) LF(R_YF)[(16 * rb + 4 * q4 + jj) * PF + 16 * et + r16] = yy[ci][jj]; } }
        }
        __syncthreads();
        if (FINAL) { const size_t m = (size_t)b * T + tl0 + tok; float y[8], g[8], ss = 0.f;
            ld8f(LF(R_YF) + tok * PF + 8 * part, y);
#pragma unroll
            for (int e = 0; e < 8; ++e) ss += y[e] * y[e];
            const float rs = __builtin_amdgcn_rsqf(red8(ss) * (1.f / 64.f) + 1e-6f);
            unpack8(*(const LAS u32x4*)(LB(R_GB) + tok * 64 + 8 * part), g);
#pragma unroll
            for (int e = 0; e < 8; ++e) y[e] = y[e] * rs * silu(g[e]);
            *(u32x4*)(P + m * PLD + C_RETG + h * 64 + 8 * part) = pack8(y);
            __syncthreads(); }
    }
    if (!FINAL) {
#pragma unroll
        for (int ci = 0; ci < 2; ++ci) { const int et = 2 * (w >> 2) + ci;
#pragma unroll
            for (int jj = 0; jj < 4; ++jj) Sbuf[(16 * db + 4 * q4 + jj) * 64 + 16 * et + r16] = Sacc[ci][jj]; }
    }
#undef RET_PREFETCH
#undef LB
#undef LF
}

template <bool FINAL>
__device__ __forceinline__ void ssd_chunk_unit(Frame& F, int layer, int u) {
    const int tid = otid(), w = __builtin_amdgcn_readfirstlane(tid >> 6);
#define IDS() const int ft = fresh_tid(tid); const int lane = ft & 63, r16 = lane & 15, q4 = lane >> 4; (void)lane; (void)r16; (void)q4
    const int b = u >> 9, sc = (u >> 3) & 63, h = u & 7, g = h >> 2;
    constexpr int D_CB = 0, D_BB = 17408, D_BT = 34816, D_YF = 53248, D_XT = 70656, D_XDT = 79872, D_GM = 89088, D_SB = 98304, D_MISC = 115712;
    constexpr int D_DTS = D_MISC, D_ACS = D_MISC + 256, D_CAR = D_MISC + 512;
    LAS unsigned char* L = F.lds;
#define LB(off) ((LAS bf16*)(L + (off)))
#define LF(off) ((LAS float*)(L + (off)))
    bf16* P = (bf16*)(F.ws + WS_BIG); const float* dtb = (const float*)(F.ws + WS_DT);
    const bf16* BND = (const bf16*)(F.ws + WS_BND);
    float* Sbuf = (float*)(F.st + 32 * MiB) + (size_t)u * 8192;
    const float* cw = INP(17) + layer * 1024 * 4; const float* cbias = INP(18) + layer * 1024;
    const float dt_bias = INP(19)[layer * 8 + h], A = -expf(INP(20)[layer * 8 + h]), Dh = INP(21)[layer * 8 + h];
    const int bc_chunk = tid & 31, bc_chn = (bc_chunk < 16) ? (512 + g * 128 + bc_chunk * 8) : (768 + g * 128 + (bc_chunk - 16) * 8);
    const int x_chunk = tid & 7, x_chn = h * 64 + x_chunk * 8;
    const int pb = w & 3;
    f32x4 Sacc[4];
    { IDS();
#pragma unroll
    for (int ci = 0; ci < 4; ++ci) { const int nt = 4 * (w >> 2) + ci;
#pragma unroll
        for (int jj = 0; jj < 4; ++jj) { const float x = FINAL ? Sbuf[(16 * pb + 4 * q4 + jj) * 128 + 16 * nt + r16] : 0.f; Sacc[ci][jj] = x;
            if (FINAL) LB(D_SB)[(16 * pb + 4 * q4 + jj) * PT2 + 16 * nt + r16] = (bf16)f2bf(x); } } }
    float dstot = 0.f;
    u32x4 pbc[4], px; float pdt = 0.f;
#define SSD_PREFETCH(jn) do { const size_t m_ = (size_t)b * T + sc * 256 + (jn) * 64; \
        _Pragma("unroll") for (int it_ = 0; it_ < 4; ++it_) pbc[it_] = *(const u32x4*)(P + (m_ + it_ * 16 + (tid >> 5)) * PLD + C_XBC + bc_chn); \
        px = *(const u32x4*)(P + (m_ + (tid >> 3)) * PLD + C_XBC + x_chn); if (w == 0) pdt = dtb[(m_ + (tid & 63)) * 8 + h]; } while (0)
    SSD_PREFETCH(0);
    for (int j = 0; j < 4; ++j) {
        const int tl0 = sc * 256 + j * 64; const size_t m0 = (size_t)b * T + tl0;
        if (w == 0) {
            IDS(); const float dt = softplus_acc(pdt + dt_bias); float a = A * dt;
#pragma unroll
            for (int o = 1; o < 64; o <<= 1) { const float n = __shfl_up(a, o); if (lane >= o) a += n; }
            LF(D_DTS)[lane] = dt; LF(D_ACS)[lane] = a;
        }
        {
            IDS();
#pragma unroll
            for (int it = 0; it < 4; ++it) { const int t = it * 16 + (ft >> 5); const int ta = tl0 + t;
                float acc[8]; unpack8(pbc[it], acc); (void)ta;
                if (bc_chunk < 16) { *(LAS u32x4*)(LB(D_BB) + t * PT2 + bc_chunk * 8) = pack8(acc); tr_write8(LB(D_BT), PT, bc_chunk * 8, t, acc, bc_chunk & 7); }
                else *(LAS u32x4*)(LB(D_CB) + t * PT2 + (bc_chunk - 16) * 8) = pack8(acc);
            }
        }
        __syncthreads();
        {
            IDS(); const int t = ft >> 3; float acc[8]; unpack8(px, acc);
            if (j < 3) SSD_PREFETCH(j + 1);
            const float sc_d = LF(D_DTS)[t] * __expf(LF(D_ACS)[63] - LF(D_ACS)[t]);
            float xs8[8], xd8[8];
#pragma unroll
            for (int e = 0; e < 8; ++e) { xs8[e] = acc[e]; xd8[e] = acc[e] * sc_d; }
            tr_write8(LB(D_XT), PT, x_chunk * 8, t, xs8, x_chunk); tr_write8(LB(D_XDT), PT, x_chunk * 8, t, xd8, x_chunk);
        }
        if (FINAL) { IDS(); const int rb = w & 3;
#pragma unroll
            for (int ci = 0; ci < 2; ++ci) { const int ct = 2 * (w >> 2) + ci; f32x4 a = FZ4;
                if (ct <= rb) a = mm_ll<128>(LB(D_CB), PT2, 16 * rb, LB(D_BB), PT2, 16 * ct, FZ4, lane);
#pragma unroll
                for (int jj = 0; jj < 4; ++jj) { const int l = 16 * rb + 4 * q4 + jj, s = 16 * ct + r16;
                    LB(D_GM)[l * PT + s] = (bf16)f2bf((s <= l) ? a[jj] * __expf(LF(D_ACS)[l] - LF(D_ACS)[s]) * LF(D_DTS)[s] : 0.f); } } }
        __syncthreads();
        {
            IDS(); f32x4 yy[2];
            if (FINAL) { const int rb = w & 3;
#pragma unroll
                for (int ci = 0; ci < 2; ++ci) { const int pt = 2 * (w >> 2) + ci;
                    const f32x4 a1 = mm_ll<64, false, true>(LB(D_GM), PT, 16 * rb, LB(D_XT), PT, 16 * pt, FZ4, lane), a2 = mm_ll<128>(LB(D_CB), PT2, 16 * rb, LB(D_SB), PT2, 16 * pt, FZ4, lane);
#pragma unroll
                    for (int jj = 0; jj < 4; ++jj) { const int l = 16 * rb + 4 * q4 + jj, p = 16 * pt + r16; yy[ci][jj] = a1[jj] + __expf(LF(D_ACS)[l]) * a2[jj] + Dh * tr_at(LB(D_XT), PT, p, l); } } }
            const float dec = expf(LF(D_ACS)[63]);
#pragma unroll
            for (int ci = 0; ci < 4; ++ci) { const int nt = 4 * (w >> 2) + ci; Sacc[ci] = mm_ll<64, true, true>(LB(D_XDT), PT, 16 * pb, LB(D_BT), PT, 16 * nt, Sacc[ci] * dec, lane); }
            dstot += LF(D_ACS)[63];
            __syncthreads();
            if (FINAL) { const int rb = w & 3;
#pragma unroll
                for (int ci = 0; ci < 4; ++ci) { const int nt = 4 * (w >> 2) + ci;
#pragma unroll
                    for (int jj = 0; jj < 4; ++jj) LB(D_SB)[(16 * pb + 4 * q4 + jj) * PT2 + 16 * nt + r16] = (bf16)f2bf(Sacc[ci][jj]); }
#pragma unroll
                for (int ci = 0; ci < 2; ++ci) { const int pt = 2 * (w >> 2) + ci;
#pragma unroll
                    for (int jj = 0; jj < 4; ++jj) LF(D_YF)[(16 * rb + 4 * q4 + jj) * PF + 16 * pt + r16] = yy[ci][jj]; } }
        }
        __syncthreads();
        if (FINAL) { IDS(); const int tok = ft >> 3, part = ft & 7; float y[8];
            ld8f(LF(D_YF) + tok * PF + 8 * part, y);
            *(u32x4*)(P + (m0 + tok) * PLD + C_XBC + h * 64 + 8 * part) = pack8(y);
            __syncthreads(); }
    }
    if (!FINAL) { IDS();
#pragma unroll
        for (int ci = 0; ci < 4; ++ci) { const int nt = 4 * (w >> 2) + ci;
#pragma unroll
            for (int jj = 0; jj < 4; ++jj) Sbuf[(16 * pb + 4 * q4 + jj) * 128 + 16 * nt + r16] = Sacc[ci][jj]; }
        if (tid == 0) ((float*)(F.ws + WS_DSTOT))[u] = dstot;
    }
#undef SSD_PREFETCH
#undef IDS
#undef LB
#undef LF
}

#define LBAR() do { asm volatile("s_waitcnt lgkmcnt(0)" ::: "memory"); __builtin_amdgcn_s_barrier(); asm volatile("" ::: "memory"); } while (0)
__device__ __forceinline__ void rwkv_scan_chain(Frame& F, int chain) {
    const int tid = otid(), lane = tid & 63, w = __builtin_amdgcn_readfirstlane(tid >> 6), r16 = lane & 15, q4 = lane >> 4;
    const int b = chain >> 3, h = chain & 7, vb = w & 3, ct0 = 2 * (w >> 2);
    LAS bf16* SB = (LAS bf16*)F.lds;
    f32x4 Sacc[2] = {FZ4, FZ4};
    for (int i = tid; i < 64 * PT / 2; i += 512) ((LAS unsigned*)SB)[i] = 0u;
    f32x4 nv[4][2]; bf16x8 mf[4][2][2];
#define CH_FETCH(s_, sc_) do { const int u_ = (b * 64 + (sc_)) * 8 + h; \
        const float* Nb_ = (const float*)(F.st + 0) + (size_t)u_ * 4096; const bf16* MT_ = (const bf16*)(F.ws + WS_MT) + (size_t)u_ * 4096; \
        _Pragma("unroll") for (int ci = 0; ci < 2; ++ci) { \
            nv[s_][ci] = *(const f32x4*)(Nb_ + ((vb * 4 + ct0 + ci) * 64 + lane) * 4); \
            _Pragma("unroll") for (int k2 = 0; k2 < 2; ++k2) mf[s_][ci][k2] = *(const bf16x8*)(MT_ + (size_t)(16 * (ct0 + ci) + r16) * 64 + 32 * k2 + 8 * q4); } } while (0)
    CH_FETCH(0, 0); CH_FETCH(1, 1); CH_FETCH(2, 2); CH_FETCH(3, 3);
    LBAR();
    for (int sc0 = 0; sc0 < 64; sc0 += 4) {
#pragma unroll
        for (int s = 0; s < 4; ++s) {
            const int sc = sc0 + s, u = (b * 64 + sc) * 8 + h;
            float* Nb = (float*)(F.st + 0) + (size_t)u * 4096;
            f32x4 nw[2];
#pragma unroll
            for (int ci = 0; ci < 2; ++ci) {
                f32x4 a = nv[s][ci];
#pragma unroll
                for (int k2 = 0; k2 < 2; ++k2) a = mfma16(*(const LAS bf16x8*)(SB + (16 * vb + r16) * PT + 32 * k2 + 8 * q4), mf[s][ci][k2], a);
                nw[ci] = a;
                *(f32x4*)(Nb + ((vb * 4 + ct0 + ci) * 64 + lane) * 4) = Sacc[ci]; }
            CH_FETCH(s, (sc + 4 < 64) ? sc + 4 : 63);
            LBAR();
#pragma unroll
            for (int ci = 0; ci < 2; ++ci) { Sacc[ci] = nw[ci];
#pragma unroll
                for (int jj = 0; jj < 4; ++jj) SB[(16 * vb + 4 * q4 + jj) * PT + 16 * (ct0 + ci) + r16] = (bf16)f2bf(nw[ci][jj]); }
            LBAR();
        }
    }
#undef CH_FETCH
    __syncthreads();
}
template <int ESZ, bool SSD> __device__ __forceinline__ void elem_scan_item(float* p, const float* d, float g256) {
    float carry = 0.f;
    for (int s0 = 0; s0 < 64; s0 += 32) {
        float t[32], dec[32];
#pragma unroll
        for (int sc = 0; sc < 32; ++sc) t[sc] = p[(size_t)(s0 + sc) * 8 * ESZ];
        if (SSD) {
#pragma unroll
            for (int sc = 0; sc < 32; ++sc) dec[sc] = d[(s0 + sc) * 8];
        }
#pragma unroll
        for (int sc = 0; sc < 32; ++sc) { p[(size_t)(s0 + sc) * 8 * ESZ] = carry; carry = (SSD ? __expf(dec[sc]) : g256) * carry + t[sc]; }
    }
}
__device__ __forceinline__ void elem_scans(Frame& F, int blk, int nblk) {
    const int tid = otid();
    const int NRET = 16 * 4096, NSSD = 16 * 8192;
    const float* dst = (const float*)(F.ws + WS_DSTOT);
    for (int it = blk * 512 + tid; it < NRET + NSSD; it += nblk * 512) {
        if (it < NRET) { const int chain = it >> 12, e = it & 4095, b = chain >> 3, h = chain & 7;
            const float g256 = exp2f(256.f * log2f(1.f - exp2f(-5.f - (float)h)));
            elem_scan_item<4096, false>((float*)(F.st + 16 * MiB) + ((size_t)(b * 64) * 8 + h) * 4096 + e, nullptr, g256);
        } else { const int i2 = it - NRET, chain = i2 >> 13, e = i2 & 8191, b = chain >> 3, h = chain & 7;
            elem_scan_item<8192, true>((float*)(F.st + 32 * MiB) + ((size_t)(b * 64) * 8 + h) * 8192 + e, dst + (b * 64) * 8 + h, 0.f);
        }
    }
}
__device__ __forceinline__ void conv_lora(Frame& F) {
    const int tid = otid();
    for (int l = 0; l < 2; ++l) {
        bf16* base = (bf16*)(F.ws + WS_LORA + (size_t)l * LORA_STRIDE);
        const float* wu = INP(4) + l * 64 * 512; const float* au = INP(6) + l * 64 * 512; const float* gu = INP(8) + l * 128 * 512;
        for (int i = F.vcu * 512 + tid; i < 512 * 64; i += F.G * 512) { const int c = i >> 6, jx = i & 63; base[i] = (bf16)f2bf(wu[jx * 512 + c]); base[32768 + i] = (bf16)f2bf(au[jx * 512 + c]); }
        for (int i = F.vcu * 512 + tid; i < 512 * 128; i += F.G * 512) { const int c = i >> 7, jx = i & 127; base[65536 + i] = (bf16)f2bf(gu[jx * 512 + c]); }
    }
}
__device__ __forceinline__ void conv_vlora(Frame& F) {
    const int tid = otid();
    bf16* vdT = (bf16*)(F.ws + WS_VLORA); bf16* vuT = vdT + 32 * 512;
    const float* vdn = INP(14); const float* vup = INP(15);
    for (int i = F.vcu * 512 + tid; i < 32 * 512; i += F.G * 512) { const int j = i >> 9, c = i & 511; vdT[i] = (bf16)f2bf(vdn[c * 32 + j]); }
    for (int i = F.vcu * 512 + tid; i < 512 * 32; i += F.G * 512) { const int c = i >> 5, j = i & 31; vuT[i] = (bf16)f2bf(vup[j * 512 + c]); }
}
__device__ __forceinline__ void save_bnd(Frame& F) {
    const int tid = otid();
    const bf16* P = (const bf16*)(F.ws + WS_BIG); bf16* BND = (bf16*)(F.ws + WS_BND);
    for (int i = F.vcu * 512 + tid; i < 2 * 64 * 3 * 64; i += F.G * 512) { const int ch = i & 63, k = (i >> 6) % 3, bs = i / 192, b = bs >> 6, sc = bs & 63;
        if (sc > 0) *(u32x4*)(BND + (size_t)(bs * 3 + k) * 512 + ch * 8) = *(const u32x4*)(P + ((size_t)b * T + sc * 256 - 3 + k) * PLD + C_XBC + ch * 8); }
}

__device__ __forceinline__ void stagger(int cid) { const int dly = __builtin_amdgcn_readfirstlane((cid >> 3) & 7); for (int i = 0; i < dly; ++i) __builtin_amdgcn_s_sleep(16); }
constexpr int LAYER_BASE0 = 1, LAYER_STRIDE = 18, MOE_BASE = LAYER_BASE0 + LAYER_STRIDE + 15;
__device__ __forceinline__ Frame lf(const Frame& F0) {
    Frame F = F0; unsigned l = (unsigned)(unsigned long long)F.lds;
    asm volatile("" : "+s"(l), "+s"(F.vcu), "+s"(F.G), "+s"(F.cid), "+s"(F.wid), "+s"(F.out), "+s"(F.ws), "+s"(F.st));
    F.lds = (LAS unsigned char*)(unsigned long long)l; return F;
}
__global__ void __launch_bounds__(512, 2) fwd(Args args) {
    extern __shared__ __attribute__((aligned(16))) unsigned char lds_raw[];
    Frame F0;
    F0.lds = (LAS unsigned char*)lds_raw;
    F0.G = gridDim.x; { const int bx = blockIdx.x; F0.vcu = (F0.G % 8 == 0) ? (bx % 8) * (F0.G / 8) + bx / 8 : bx; }
    F0.rr = 0; F0.cid = blockIdx.x; F0.out = (GAS float*)args.out; F0.ws = (GAS unsigned char*)args.ws; F0.wid = __builtin_amdgcn_readfirstlane(threadIdx.x >> 6); F0.st = (GAS unsigned char*)args.ws + WS_XB;
    volatile LAS unsigned* MISC = (volatile LAS unsigned*)(F0.lds + MISC_OFF);
    for (int u = threadIdx.x; u < (LDS_BYTES - LDSCTL_OFF) / 4; u += 512) ((LAS unsigned*)(F0.lds + LDSCTL_OFF))[u] = 0u;
    __syncthreads();
    if (threadIdx.x < 34) *(LAS unsigned long long*)(F0.lds + LDSCTL_OFF + 8 * threadIdx.x) = (unsigned long long)args.in[threadIdx.x];
    __syncthreads();
    const int lo = args.ph_lo, hi = args.ph_hi;
    XcdBarrier bar; bar.bar = (unsigned*)(F0.ws + WS_CTL); bar.x = 0; bar.st = nullptr;
    if (hi - lo > 1) bar = xcd_barrier_post((unsigned*)(F0.ws + WS_CTL), MISC + 8);
#define IN(k) (lo <= (k) && (k) < hi)
#define SEAM(k) do { if (IN(k) && IN((k) + 1)) xcd_barrier(bar); } while (0)
#define WSP(T_, off) ((T_*)(F.ws + (off)))

    if (IN(0)) { Frame F = lf(F0); conv_layer_weights(F, 0, 0); conv_lora(F); conv_vlora(F); xprep_phase(F, INP(0)); }
    SEAM(0);
    for (int l = 0; l < 2; ++l) {
        const int pb = LAYER_BASE0 + l * LAYER_STRIDE;
        F0.st = (GAS unsigned char*)F0.out;
        if (IN(pb + 0)) {
            Frame F = lf(F0); unsigned char* wl = (unsigned char*)(F.ws + WS_W + (size_t)l * WL_STRIDE);
            pg8::Gemm g{WSP(bf16, WS_XB), (const bf16*)(wl + WL_IN), D, D, D}; pg8::StaticOrder S; S.init(M, NP, F.G, F.cid, D, D);
            pg8::EpiInProj E{WSP(bf16, WS_BIG), (l == 0) ? WSP(float, WS_RSTD) : WSP(float, WS_SS1), WSP(float, WS_DT), l};
            stagger(F.cid); pg8::gemm_phase(F.lds, F.wid, g, S, E);
        }
        SEAM(pb + 0);
        if (IN(pb + 1)) { Frame F = lf(F0); vprep_phase(F, l); prepass_a(F); }
        SEAM(pb + 1);
        if (IN(pb + 2)) { Frame F = lf(F0); prepass_conv(F, l); }
        if (IN(pb + 2) && IN(pb + 3)) xcd_barrier(bar);
        if (IN(pb + 3)) for (int rep = 0; rep <= REP_R1; ++rep) {
#if RW_CH
            for (int r2 = 0; r2 <= REP_RW; ++r2) { Frame F = lf(F0); for (int u = F.cid; u < 1024; u += F.G) rwkv_chunk_unit<false>(F, l, u); }
#else
            { Frame F = lf(F0); if (F.cid < 16) rwkv_seq(F, l, F.cid); }
#endif
#if RET_CH
            for (int r2 = 0; r2 <= REP_RET; ++r2) { Frame F = lf(F0); for (int u = F.cid; u < 1024; u += F.G) ret_chunk_unit<false>(F, u); }
#else
            { Frame F = lf(F0); if (F.cid >= 32 && F.cid < 48) ret_seq(F, F.cid - 32); }
#endif
#if SSD_CH
            for (int r2 = 0; r2 <= REP_SSD; ++r2) { Frame F = lf(F0); for (int u = F.cid; u < 1024; u += F.G) ssd_chunk_unit<false>(F, l, u); }
#else
            { Frame F = lf(F0); if (F.cid >= 16 && F.cid < 32) ssd_seq(F, l, F.cid - 16); }
#endif
        }
        SEAM(pb + 3);
        if (IN(pb + 4)) { Frame F = lf(F0); elem_scans(F, F.cid, F.G); }
        SEAM(pb + 4);
        if (IN(pb + 5)) {
            Frame F = lf(F0);
            if (F.cid < 16) { if (RW_CH) rwkv_scan_chain(F, F.cid);
                for (int u = 960 + F.cid; u < 1024; u += 16) ret_chunk_unit<true>(F, u);
                for (int u = 960 + F.cid; u < 1024; u += 16) ssd_chunk_unit<true>(F, l, u); }
            else {
                Frame Fc = lf(F0); Fc.vcu = Fc.cid - 16; Fc.cid = Fc.cid - 16; Fc.G = Fc.G - 16;
                if (l == 0) { conv_layer_weights(Fc, 0, 1); conv_layer_weights(Fc, 1, 0); conv_layer_weights(Fc, 1, 1); conv_ffn_weights(Fc); conv_moe_weights(Fc, 0, 3); }
                else conv_moe_weights(Fc, 3, NE);
                __syncthreads();
                for (int u = Fc.cid; u < 960; u += Fc.G) ret_chunk_unit<true>(Fc, u);
                for (int u = Fc.cid; u < 960; u += Fc.G) ssd_chunk_unit<true>(Fc, l, u);
            }
        }
        if (IN(pb + 5)) xcd_barrier(bar);
        if (IN(pb + 5)) { Frame F = lf(F0); for (int u = F.cid; u < 1024; u += F.G) rwkv_chunk_unit<true>(F, l, u); }
        SEAM(pb + 5);
        if (IN(pb + 6)) { Frame F = lf(F0); ssm_norm_phase(F, l); }
        SEAM(pb + 6);
        if (IN(pb + 7)) {
            Frame F = lf(F0); unsigned char* wl = (unsigned char*)(F.ws + WS_W + (size_t)l * WL_STRIDE); bf16* P = WSP(bf16, WS_BIG);
            pg8::Gemm g{P, (const bf16*)(wl + WL_BR), PLD, 512, 512}; pg8::BranchOrder S; S.init(F.G, F.cid);
            pg8::EpiPlain E{P, WSP(bf16, WS_VMIX)};
            stagger(F.cid); pg8::gemm_phase(F.lds, F.wid, g, S, E);
        }
        SEAM(pb + 7);
        if (IN(pb + 8)) {
            Frame F = lf(F0); unsigned char* wl = (unsigned char*)(F.ws + WS_W + (size_t)l * WL_STRIDE); bf16* P = WSP(bf16, WS_BIG);
            pg8::Gemm g{WSP(bf16, WS_XB), (const bf16*)(wl + WL_GATE), D, D, D}; pg8::GateOrder S; S.init(F.G, F.cid);
            pg8::EpiGateMerge E{P, WSP(const bf16, WS_VMIX), P + C_RET, PLD, (l == 0) ? WSP(float, WS_RSTD) : WSP(float, WS_SS1), l};
            stagger(F.cid); pg8::gemm_phase(F.lds, F.wid, g, S, E);
        }
        if (IN(pb + 8) && IN(pb + 13)) xcd_barrier(bar);
        if (IN(pb + 13)) {
            Frame F = lf(F0); unsigned char* wl = (unsigned char*)(F.ws + WS_W + (size_t)l * WL_STRIDE); bf16* P = WSP(bf16, WS_BIG);
            pg8::Gemm g{P + C_RET, (const bf16*)(wl + WL_OUT), PLD, D, D}; pg8::StaticOrder S; S.init(M, D, F.G, F.cid, PLD, D);
            pg8::EpiResidB E{WSP(bf16, WS_XB), (l == 0) ? WSP(float, WS_SS2) : nullptr, nullptr};
            stagger(F.cid); pg8::gemm_phase(F.lds, F.wid, g, S, E);
        }
        SEAM(pb + 13);
        if (IN(pb + 14)) { Frame F = lf(F0); if (l == 1) router_phase(F); }
        if (l == 1) SEAM(pb + 14);
        if (l == 0) {
            if (IN(pb + 15)) {
                Frame F = lf(F0);
                pg8::Gemm g{WSP(bf16, WS_XB), WSP(const bf16, WS_FFUP), D, D, D}; pg8::StaticOrder S; S.init(M, 2 * FF, F.G, F.cid, D, D);
                pg8::EpiSwiglu E{WSP(bf16, WS_ACT), FF, WSP(float, WS_SS2), 1};
                stagger(F.cid); pg8::gemm_phase(F.lds, F.wid, g, S, E);
            }
            SEAM(pb + 15);
            if (IN(pb + 16)) {
                Frame F = lf(F0);
                pg8::Gemm g{WSP(const bf16, WS_ACT), WSP(const bf16, WS_FFDN), FF, FF, FF}; pg8::StaticOrder S; S.init(M, D, F.G, F.cid, FF, FF);
                pg8::EpiResidB E{WSP(bf16, WS_XB), WSP(float, WS_SS1), nullptr};
                stagger(F.cid); pg8::gemm_phase(F.lds, F.wid, g, S, E);
            }
            if (IN(pb + 16) && IN(pb + 18)) xcd_barrier(bar);
        }
    }
    {
        const int pb = MOE_BASE;
        for (int st = 0; st < 6; ++st) {
            const int isup = (st == 0 || st == 2 || st == 3), sg = (st < 2) ? 0 : ((st == 2 || st == 4) ? 1 : 2);
            if (IN(pb + st)) {
                if (isup) {
                    Frame F = lf(F0);
                    unsigned char* wb = (unsigned char*)F.out + MOEW_OUT; const size_t b6 = (size_t)((unsigned char*)(F.ws + WS_FFUP) - wb), b7 = (size_t)((unsigned char*)(F.ws + WS_VF + 16 * MiB) - wb);
                    pg8::Gemm g{WSP(bf16, WS_X8), (const bf16*)wb, D / 2, D / 2, D / 2}; pg8::MoeOrder<true> S; S.init(WSP(const int, WS_CNT), WSP(const int, WS_LIST), sg, 2 * FFE, F.G, F.cid, D / 2, D / 2, MOEW_STRIDE, b6, b7);
                    pg8::EpiSwiglu8 E{(sg == 2) ? WSP(unsigned char, WS_ACT2) : WSP(unsigned char, WS_ACT), FFE};
                    stagger(F.cid); pg8::gemm_phase<pg8::EpiSwiglu8, pg8::MoeOrder<true>, true>(F.lds, F.wid, g, S, E);
                } else {
                    Frame F = lf(F0);
                    const int ksp = (sg == 2) ? MOE_KSP : 1;
                    unsigned char* wb = (unsigned char*)F.out + MOEW_OUT; const size_t b6 = (size_t)((unsigned char*)(F.ws + WS_FFUP) - wb), b7 = (size_t)((unsigned char*)(F.ws + WS_VF + 16 * MiB) - wb);
                    pg8::Gemm g{(sg == 2) ? WSP(const bf16, WS_ACT2) : WSP(const bf16, WS_ACT), (const bf16*)(wb + MOEW_DN), FFE / 2, FFE / 2, FFE / 2 / ksp}; pg8::MoeOrder<false> S; S.init(WSP(const int, WS_CNT), WSP(const int, WS_LIST), sg, D, F.G, F.cid, FFE / 2, FFE / 2, MOEW_STRIDE, b6, b7, ksp, FFE / 2 / ksp);
                    pg8::EpiMoeOut E{(sg == 0) ? WSP(bf16, WS_YP0) : (sg == 1 ? WSP(bf16, WS_YP1) : WSP(bf16, WS_YP2)), YP2_STRIDE / 2, 1.f / 1024.f};
                    stagger(F.cid); pg8::gemm_phase<pg8::EpiMoeOut, pg8::MoeOrder<false>, true>(F.lds, F.wid, g, S, E);
                }
            }
            SEAM(pb + st);
        }
        if (IN(pb + 6)) { Frame F = lf(F0); final_norm_phase(F); }
    }
#undef IN
#undef SEAM
#undef WSP
}
constexpr int LAST_PHASE = MOE_BASE + 6;
constexpr int N_PH = LAST_PHASE + 1;

extern "C" void kernel_launch(void* const* d_in, const int* in_sizes, int n_in, void* d_out, int out_size, void* d_ws, size_t ws_size, hipStream_t stream) {
    static int grid = 0;
    if (grid == 0) {
        if (n_in != 34 || out_size != M * D || ws_size < WS_END) { fprintf(stderr, "kernel_launch: unexpected problem (n_in %d out %d ws %zu need %zu)\n", n_in, out_size, ws_size, (size_t)WS_END); grid = -1; return; }
        int dev = 0, cus = 0;
        if (hipGetDevice(&dev) != hipSuccess || hipDeviceGetAttribute(&cus, hipDeviceAttributeMultiprocessorCount, dev) != hipSuccess) { grid = -1; return; }
        if (hipFuncSetAttribute((const void*)fwd, hipFuncAttributeMaxDynamicSharedMemorySize, LDS_BYTES) != hipSuccess) { fprintf(stderr, "kernel_launch: hipFuncSetAttribute failed\n"); grid = -1; return; }
        int per_cu = 0;
        if (hipOccupancyMaxActiveBlocksPerMultiprocessor(&per_cu, (const void*)fwd, 512, LDS_BYTES) != hipSuccess || per_cu < 1) fprintf(stderr, "kernel_launch: occupancy query says %d\n", per_cu);
        (void)hipGetLastError();
        grid = cus;
    }
    if (grid < 0) return;
    (void)hipMemsetAsync((char*)d_ws + WS_CTL, 0, CTL_ZERO_BYTES, stream);
    Args a{};
    for (int i = 0; i < 34; ++i) a.in[i] = (const float*)d_in[i];
    a.out = (float*)d_out; a.ws = (unsigned char*)d_ws;
#if MK_ONE_LAUNCH
    a.ph_lo = 0; a.ph_hi = N_PH;
    hipLaunchKernelGGL(fwd, dim3(grid), dim3(512), LDS_BYTES, stream, a);
#else
    for (int p = 0; p < N_PH; ++p) { a.ph_lo = p; a.ph_hi = p + 1; hipLaunchKernelGGL(fwd, dim3(grid), dim3(512), LDS_BYTES, stream, a); }
#endif
}
```

```cpp
#include <hip/hip_runtime.h>
#include <cstdio>
#include <cstdint>

#ifndef MK_ONE_LAUNCH
#define MK_ONE_LAUNCH 1
#endif

#define LAS __attribute__((address_space(3)))
#define GAS __attribute__((address_space(1)))
typedef unsigned short bf16;
typedef short bf16x8 __attribute__((ext_vector_type(8)));
typedef float f32x4 __attribute__((ext_vector_type(4)));
typedef float f32x2 __attribute__((ext_vector_type(2)));
typedef unsigned u32x4 __attribute__((ext_vector_type(4)));
typedef unsigned u32x2 __attribute__((ext_vector_type(2)));

constexpr int BATCH = 2, T = 16384, D = 1024, M = BATCH * T;
constexpr int INC = 8456;
constexpr int PLD = 5376;
constexpr int NP = 5632;
constexpr int C_RW = 0, C_Z = 1792, C_XBC = 2304, C_RET = 3328, C_RETG = 4864;
constexpr int FF = 2816, FFE = 3584, NE = 8;

constexpr size_t MiB = 1u << 20;
constexpr size_t WS_CTL = 0, CTL_ZERO_BYTES = 64 * 1024;
constexpr size_t WS_RSTD = 1 * MiB, WS_GATES = 2 * MiB, WS_DT = 3 * MiB;
constexpr size_t WS_W = 4 * MiB;
constexpr size_t WL_IN = 0, WL_GATE = 11 * MiB, WL_BR = 17 * MiB, WL_OUT = 20 * MiB, WL_STRIDE = 22 * MiB;
constexpr size_t WS_FFUP = WS_W + 44 * MiB, WS_FFDN = WS_W + 55 * MiB;
constexpr size_t WS_XB = 68 * MiB;
constexpr size_t WS_VF = 132 * MiB;
constexpr size_t WS_BIG = 164 * MiB;
constexpr size_t WS_VMIX = WS_BIG + 336 * MiB, WS_YRW = WS_BIG + 368 * MiB, WS_END = 577 * MiB;
constexpr size_t WS_MOEW_UNUSED = WS_BIG;
constexpr size_t MOEW_STRIDE = 21 * MiB / 2, MOEW_DN = 7 * MiB;
constexpr size_t MOEW_OUT = 64 * MiB;
constexpr size_t WS_X8 = WS_BIG + 88 * MiB;
constexpr int MOE_KSP = 2;
constexpr size_t WS_ACT = WS_BIG + 168 * MiB;

constexpr size_t WS_YP0 = WS_BIG, WS_YP1 = WS_BIG + 280 * MiB, WS_YP2 = 556 * MiB, YP2_STRIDE = 4 * MiB, WS_PINFO = 572 * MiB, WS_ACT2 = 132 * MiB;
constexpr size_t WS_CNT = 32768, WS_LIST = 2 * MiB;
constexpr size_t WS_BND2 = 566 * MiB;
constexpr size_t WS_VLORA = 192 * 1024;
constexpr size_t WS_SS1 = 573 * MiB, WS_SS2 = 575 * MiB;
constexpr size_t WS_DSTOT = 128 * 1024, WS_BND = 256 * 1024;
constexpr size_t WS_LORA = 1 * MiB + 512 * 1024, LORA_STRIDE = 262144;
constexpr size_t WS_ST_RW = WS_XB, WS_ST_RET = WS_XB + 16 * MiB, WS_ST_SSD = WS_XB + 32 * MiB, WS_MT = WS_YRW;
constexpr int RING_BYTES = 131072, LDSCTL_OFF = 159744, MISC_OFF = LDSCTL_OFF + 320, LDS_BYTES = 163840;
#ifndef REP_CONV
#define REP_CONV 0
#endif
#ifndef REP_R1
#define REP_R1 0
#endif
#ifndef REP_RW
#define REP_RW 0
#endif
#ifndef REP_RET
#define REP_RET 0
#endif
#ifndef REP_SSD
#define REP_SSD 0
#endif
#ifndef REP_MISC
#define REP_MISC 0
#endif
#ifndef RW_CH
#define RW_CH 1
#endif
#ifndef RET_CH
#define RET_CH 1
#endif
#ifndef SSD_CH
#define SSD_CH 1
#endif

typedef __bf16 hbf16x2 __attribute__((ext_vector_type(2)));
__device__ __forceinline__ unsigned pk2(float lo, float hi) { const f32x2 v = {lo, hi}; return __builtin_bit_cast(unsigned, __builtin_convertvector(v, hbf16x2)); }
__device__ __forceinline__ unsigned f2bf(float f) { return (unsigned)__builtin_bit_cast(unsigned short, (__bf16)f); }
__device__ __forceinline__ float bflo(unsigned u) { return __builtin_bit_cast(float, u << 16); }
__device__ __forceinline__ float bfhi(unsigned u) { return __builtin_bit_cast(float, u & 0xffff0000u); }
__device__ __forceinline__ void unpack8(const u32x4 u, float (&f)[8]) { f[0] = bflo(u.x); f[1] = bfhi(u.x); f[2] = bflo(u.y); f[3] = bfhi(u.y); f[4] = bflo(u.z); f[5] = bfhi(u.z); f[6] = bflo(u.w); f[7] = bfhi(u.w); }
__device__ __forceinline__ unsigned pk4f8(float a, float b, float c, float d) {
    a = __builtin_amdgcn_fmed3f(a, -448.f, 448.f); b = __builtin_amdgcn_fmed3f(b, -448.f, 448.f); c = __builtin_amdgcn_fmed3f(c, -448.f, 448.f); d = __builtin_amdgcn_fmed3f(d, -448.f, 448.f);
    int w = __builtin_amdgcn_cvt_pk_fp8_f32(a, b, 0, false); w = __builtin_amdgcn_cvt_pk_fp8_f32(c, d, w, true); return (unsigned)w; }
__device__ __forceinline__ u32x4 pack8(const float (&f)[8]) { u32x4 w; w.x = pk2(f[0], f[1]); w.y = pk2(f[2], f[3]); w.z = pk2(f[4], f[5]); w.w = pk2(f[6], f[7]); return w; }
__device__ __forceinline__ float sigm(float x) { return __builtin_amdgcn_rcpf(1.f + __expf(-x)); }
__device__ __forceinline__ float silu(float x) { return x * __builtin_amdgcn_rcpf(1.f + __expf(-x)); }
__device__ __forceinline__ float ex2(float x) { return __builtin_amdgcn_exp2f(x); }
__device__ __forceinline__ float fast_tanh(float x) { return 1.f - 2.f * __builtin_amdgcn_rcpf(1.f + __expf(2.f * x)); }
__device__ __forceinline__ float softplus_acc(float x) { return fmaxf(x, 0.f) + log1pf(expf(-fabsf(x))); }
__device__ __forceinline__ float wave_sum(float v) {
#pragma unroll
    for (int o = 1; o < 64; o <<= 1) v += __shfl_xor(v, o);
    return v;
}
__device__ __forceinline__ int otid_w(int wid) { unsigned z = 0u; asm volatile("" : "+v"(z)); int t = wid * 64 + (int)__builtin_amdgcn_mbcnt_hi(~0u, __builtin_amdgcn_mbcnt_lo(~0u, z)); asm volatile("" : "+v"(t)); return t; }
#define otid() otid_w(F.wid)
__device__ __forceinline__ int fresh_tid(int t) { asm volatile("" : "+v"(t)); return t; }
#define LDS_WAIT() asm volatile("s_waitcnt lgkmcnt(0)" ::: "memory")

namespace pg8 {
constexpr int BM = 256, BK = 64, HALF = 128, HTB = HALF * BK * 2, STAGE_BYTES = 8 * HTB, NXCD = 8, WGM = 8;
__host__ __device__ __forceinline__ int lds_byte(int r, int c) { const int st = (r >> 4) * 2 + (c >> 5), rr = r & 15, cc = c & 31, ob = rr * 64 + cc * 2; return st * 1024 + (ob ^ (((ob >> 9) & 1) << 5)); }
__host__ __device__ __forceinline__ void stage_rc(int b, int& R, int& C) { const int st = b / 1024, sb = b % 1024, swz = sb ^ (((sb >> 9) & 1) << 5); R = (st >> 1) * 16 + swz / 64; C = (st & 1) * 32 + (swz % 64) / 2; }
__host__ __device__ __forceinline__ int perm32(int rho) { const int n = rho >> 4, i = rho & 15; return 8 * (i >> 2) + 4 * n + (i & 3); }

typedef int i32x4v __attribute__((ext_vector_type(4)));
struct Unit { int pm, pn; size_t aofs, bofs; const int* rows; int nvalid, e, ks; };
struct Gemm { const bf16* A; const bf16* Bt; int lda, ldb, K; };

struct StaticOrder {
    static constexpr bool GATHER = false;
    int nM, nN, nwg, G, c; size_t tsA, tsB;
    __device__ __forceinline__ void init(int Mrows, int N, int G_, int c_, int lda, int ldb) { nM = Mrows / BM; nN = N / BM; nwg = nM * nN; G = G_; c = c_; tsA = (size_t)BM * lda * 2; tsB = (size_t)BM * ldb * 2; }
    __device__ __forceinline__ void tile(int L, int& pm, int& pn) const {
        int wgid = L; { const int q = nwg / NXCD, r = nwg % NXCD, xcd = wgid % NXCD, off = wgid / NXCD; wgid = (xcd < r ? xcd * (q + 1) : r * (q + 1) + (xcd - r) * q) + off; }
        const int nig = WGM * nN, gid = wgid / nig, fm = gid * WGM, gsz = (nM - fm) < WGM ? (nM - fm) : WGM;
        pm = fm + ((wgid % nig) % gsz); pn = (wgid % nig) / gsz;
    }
    __device__ __forceinline__ bool next(int i, Unit& u) const {
        const long L = (long)i * G + c; if (L >= nwg) return false;
        tile((int)L, u.pm, u.pn); u.aofs = (size_t)u.pm * tsA; u.bofs = (size_t)u.pn * tsB; u.rows = nullptr; u.nvalid = BM; u.e = 0; u.ks = 0; return true;
    }
};
struct BranchOrder {
    static constexpr bool GATHER = false;
    StaticOrder so;
    __device__ __forceinline__ void init(int G_, int c_) { so.init(M, D, G_, c_, PLD, 512); }
    __device__ __forceinline__ bool next(int j, Unit& u) const {
        const long L = (long)j * so.G + so.c; if (L >= 3 * so.nwg) return false;
        const int i = (int)(L / so.nwg); so.tile((int)(L % so.nwg), u.pm, u.pn);
        const int acol = (i == 0) ? 1024 : (i == 1 ? C_Z : C_RETG);
        u.aofs = (size_t)u.pm * so.tsA + (size_t)acol * 2; u.bofs = ((size_t)i * D + (size_t)u.pn * BM) * 512 * 2; u.rows = nullptr; u.nvalid = BM; u.e = i; u.ks = 0; return true;
    }
};
struct GateOrder {
    static constexpr bool GATHER = false;
    StaticOrder so;
    __device__ __forceinline__ void init(int G_, int c_) { so.init(M, D, G_, c_, D, D); }
    __device__ __forceinline__ bool next(int j, Unit& u) const {
        const long tt = (long)(j / 3) * so.G + so.c; if (tt >= so.nwg) return false;
        const int i = j % 3; so.tile((int)tt, u.pm, u.pn);
        u.aofs = (size_t)u.pm * so.tsA; u.bofs = ((size_t)i * D + (size_t)u.pn * BM) * D * 2; u.rows = nullptr; u.nvalid = BM; u.e = i; u.ks = 0; return true;
    }
};
template <bool GATH> struct MoeOrder {
    static constexpr bool GATHER = GATH;
    unsigned q0, q1, q2, q3;
    int seg, nN, G, c, ksplit; const int* list; size_t bstride, b6, b7, tsB, tsA, kbytes;
    __device__ __forceinline__ void init(const int* counts, const int* list_, int seg_, int N, int G_, int c_, int lda, int ldb, size_t bstride_, size_t b6_, size_t b7_, int ksplit_ = 1, int kpart = 0) {
        unsigned n[8];
#pragma unroll
        for (int e = 0; e < 8; ++e) { int v = __builtin_amdgcn_readfirstlane(counts[e]); v = v < 0 ? 0 : (v > 32768 ? 32768 : v); n[e] = (unsigned)v; }
        q0 = n[0] | (n[1] << 16); q1 = n[2] | (n[3] << 16); q2 = n[4] | (n[5] << 16); q3 = n[6] | (n[7] << 16);
        seg = seg_; nN = N / BM; G = G_; c = c_; list = list_; bstride = bstride_; b6 = b6_; b7 = b7_; tsB = (size_t)BM * ldb * 2; tsA = (size_t)BM * lda * 2; ksplit = ksplit_; kbytes = (size_t)kpart * 2;
    }
    __device__ __forceinline__ bool next(int i, Unit& u) const {
        const unsigned L0 = (unsigned)i * (unsigned)G + (unsigned)c; const unsigned L = L0 / (unsigned)ksplit; const int ks = (int)(L0 - L * (unsigned)ksplit); const int tl = (int)(L / (unsigned)nN), pn = (int)(L - (unsigned)tl * (unsigned)nN), gt = seg * 128 + tl;
        int t = 0, e = 0, tbe = 0, cne = 0;
#pragma unroll
        for (int k = 0; k < 8; ++k) { const unsigned q = (k < 2) ? q0 : (k < 4) ? q1 : (k < 6) ? q2 : q3; const int n = (int)((k & 1) ? (q >> 16) : (q & 0xffffu));
            if (gt >= t) { e = k; tbe = t; cne = n; } t += (n + 255) >> 8; }
        int nt = t - seg * 128; nt = nt < 0 ? 0 : (nt > 128 ? 128 : nt);
        if (L >= (unsigned)(nt * nN)) return false;
        const int rt = gt - tbe;
        u.pm = tl; u.pn = pn; u.e = e; u.ks = ks; u.bofs = (e < 6 ? (size_t)e * bstride : (e == 6 ? b6 : b7)) + (size_t)pn * tsB + ks * kbytes; u.aofs = (GATH ? 0 : (size_t)tl * tsA) + ks * kbytes;
        u.rows = list + ((size_t)e * 32768 + rt * 256) * 2; int nv = cne - rt * 256; u.nvalid = nv > 256 ? 256 : nv; return true;
    }
};

template <class Epi, class Sched, bool F8 = false>
__device__ __forceinline__ void gemm_phase(LAS unsigned char* lds, int wid0, const Gemm g, const Sched& S, const Epi& E) {
    constexpr bool GATHER = Sched::GATHER;
    const int tid = otid_w(wid0), wid = __builtin_amdgcn_readfirstlane(tid >> 6), lane = tid & 63, wr = wid >> 2, wc = wid & 3, fr = lane & 15, fq = lane >> 4;
    const int nt = g.K / BK;
    unsigned voffA[2], voffB[2];
#pragma unroll
    for (int i = 0; i < 2; ++i) { int R, C; stage_rc(tid * 16 + i * 8192, R, C); const int Rb = Epi::PERM ? ((R & ~31) + perm32(R & 31)) : R;
        voffA[i] = (unsigned)(R * g.lda + C) * 2u; voffB[i] = (unsigned)(Rb * g.ldb + C) * 2u; }
    const size_t kstep = (size_t)(BK * 2);
    const size_t hstepA = GATHER ? 0 : (size_t)HALF * g.lda * 2, hstepB = (size_t)HALF * g.ldb * 2;
    const unsigned ldsw = (unsigned)wid * 1024u;
    const int aoff = lds_byte(wr * 64 + fr, fq * 8), boff = lds_byte(wc * 32 + fr, fq * 8);
#define PG8_SA(b, h) (((b) * 2 + (h)) * HTB)
#define PG8_SB(b, h) ((4 + (b) * 2 + (h)) * HTB)
#define PG8_STAGE2(bufoff, gbase, o0, o1) do { \
        __builtin_amdgcn_global_load_lds((const unsigned*)((const char*)(gbase) + (o0)), (LAS unsigned*)(lds + (bufoff) + ldsw), 16, 0, 0); \
        __builtin_amdgcn_global_load_lds((const unsigned*)((const char*)(gbase) + (o1)), (LAS unsigned*)(lds + (bufoff) + ldsw + 8192), 16, 0, 0); } while (0)
#define PG8_STAGE(bufoff, gbase, voff) PG8_STAGE2(bufoff, gbase, (voff)[0], (voff)[1])
#define PG8_LDA(dst, b, h) do { _Pragma("unroll") for (int m = 0; m < 4; ++m) _Pragma("unroll") for (int k = 0; k < 2; ++k) dst[m][k] = *(const LAS bf16x8*)(lds + PG8_SA(b, h) + aoff + m * 2048 + k * 1024); } while (0)
#define PG8_LDB(dst, b, h) do { _Pragma("unroll") for (int n = 0; n < 2; ++n) _Pragma("unroll") for (int k = 0; k < 2; ++k) dst[n][k] = *(const LAS bf16x8*)(lds + PG8_SB(b, h) + boff + n * 2048 + k * 1024); } while (0)
#define PG8_CAT(x) __builtin_shufflevector(__builtin_bit_cast(i32x4v, (x)[0]), __builtin_bit_cast(i32x4v, (x)[1]), 0, 1, 2, 3, 4, 5, 6, 7)
#define PG8_MMA(ai, bj, At, Bt) do { __builtin_amdgcn_s_setprio(1); if constexpr (F8) { _Pragma("unroll") for (int m = 0; m < 4; ++m) _Pragma("unroll") for (int n = 0; n < 2; ++n) \
        asm volatile("v_mfma_f32_16x16x128_f8f6f4 %0, %1, %2, %0" : "+v"(acc[ai][bj][m][n]) : "v"(PG8_CAT(Bt[n])), "v"(PG8_CAT(At[m]))); } else { \
        _Pragma("unroll") for (int m = 0; m < 4; ++m) _Pragma("unroll") for (int n = 0; n < 2; ++n) _Pragma("unroll") for (int k = 0; k < 2; ++k) \
        acc[ai][bj][m][n] = Epi::TRANS ? __builtin_amdgcn_mfma_f32_16x16x32_bf16(Bt[n][k], At[m][k], acc[ai][bj][m][n], 0, 0, 0) : __builtin_amdgcn_mfma_f32_16x16x32_bf16(At[m][k], Bt[n][k], acc[ai][bj][m][n], 0, 0, 0); } __builtin_amdgcn_s_setprio(0); } while (0)
#define PG8_WAIT_V(n) asm volatile("s_waitcnt vmcnt(" #n ")" ::: "memory")
#define PG8_WAIT_L(n) asm volatile("s_waitcnt lgkmcnt(" #n ")" ::: "memory")
#define PG8_BAR __builtin_amdgcn_s_barrier()
#define PG8_SCHED __builtin_amdgcn_sched_barrier(0)
#define GSLOT(which) ((LAS u32x4*)(lds + 131072 + (which) * 8192 + tid * 16))
#define PG8_ROWS(u, which) do { const int _ft = fresh_tid(tid); unsigned _vg[2][2]; _Pragma("unroll") for (int _i = 0; _i < 2; ++_i) { int _R, _C; stage_rc(_ft * 16 + _i * 8192, _R, _C); \
        _Pragma("unroll") for (int _h = 0; _h < 2; ++_h) { const int _r = _h * HALF + _R; \
        const int _t = (_r < (u).nvalid) ? (u).rows[2 * _r] : 0; _vg[_h][_i] = ((unsigned)_t * (unsigned)g.lda + (unsigned)_C) * 2u; } } \
        u32x4 _o; _o.x = _vg[0][0]; _o.y = _vg[0][1]; _o.z = _vg[1][0]; _o.w = _vg[1][1]; *GSLOT(which) = _o; } while (0)
    Unit cur, nxt; int ui = 0;
    if (!S.next(0, cur)) return;
    f32x4 acc[2][2][4][2];
#pragma unroll
    for (int a = 0; a < 2; ++a)
#pragma unroll
        for (int b = 0; b < 2; ++b)
#pragma unroll
            for (int m = 0; m < 4; ++m)
#pragma unroll
                for (int n = 0; n < 2; ++n) acc[a][b][m][n] = (f32x4){0.f, 0.f, 0.f, 0.f};
    bf16x8 At[4][2], B0[2][2], B1[2][2];
    u32x4 gc = {voffA[0], voffA[1], voffA[0], voffA[1]};
    if constexpr (GATHER) { PG8_ROWS(cur, 0); PG8_ROWS(cur, 1); gc = *GSLOT(0); }
#define VGC(h, i) (gc[2 * (h) + (i)])
    const char* cA = (const char*)g.A + cur.aofs; const char* cB = (const char*)g.Bt + cur.bofs;
    PG8_STAGE(PG8_SB(0, 0), cB, voffB); PG8_STAGE(PG8_SB(0, 1), cB + hstepB, voffB); PG8_STAGE2(PG8_SA(0, 0), cA, VGC(0, 0), VGC(0, 1)); PG8_STAGE2(PG8_SA(0, 1), cA + hstepA, VGC(1, 0), VGC(1, 1));
    if (wr == 1) PG8_BAR;
    PG8_WAIT_V(2); PG8_BAR;
    PG8_STAGE(PG8_SB(1, 0), cB + kstep, voffB); PG8_STAGE2(PG8_SA(1, 0), cA + kstep, VGC(0, 0), VGC(0, 1)); PG8_STAGE(PG8_SB(1, 1), cB + hstepB + kstep, voffB);
    PG8_WAIT_V(6); PG8_BAR;
    for (;;) {
        const bool has_next = S.next(ui + 1, nxt);
        const char* nA = has_next ? (const char*)g.A + nxt.aofs : cA; const char* nB = has_next ? (const char*)g.Bt + nxt.bofs : cB;
        if constexpr (GATHER) { if (has_next) PG8_ROWS(nxt, 1); else *GSLOT(1) = *GSLOT(0); }
        for (int t = 0; t < nt; t += 2) {
            const bool last = (t == nt - 2);
            const char* a1 = cA + (size_t)(t + 1) * kstep;
            const char* a2 = last ? nA : cA + (size_t)(t + 2) * kstep; const char* b2 = last ? nB : cB + (size_t)(t + 2) * kstep;
            const char* a3 = a2 + kstep; const char* b3 = b2 + kstep;
            u32x4 gn = gc; if constexpr (GATHER) { gc = *GSLOT(0); gn = last ? *GSLOT(1) : gc; }
            const unsigned s00 = gn.x, s01 = gn.y, s10 = gn.z, s11 = gn.w;
            PG8_LDB(B0, 0, 0); PG8_LDB(B1, 0, 1); PG8_SCHED; PG8_LDA(At, 0, 0); PG8_STAGE2(PG8_SA(1, 1), a1 + hstepA, VGC(1, 0), VGC(1, 1));
            PG8_WAIT_V(8); PG8_WAIT_L(0); PG8_BAR; PG8_MMA(0, 0, At, B0); PG8_MMA(0, 1, At, B1); PG8_BAR; PG8_SCHED;
            PG8_LDA(At, 0, 1); PG8_STAGE(PG8_SB(0, 0), b2, voffB); PG8_STAGE(PG8_SB(0, 1), b2 + hstepB, voffB); PG8_STAGE2(PG8_SA(0, 0), a2, s00, s01);
            PG8_WAIT_V(8); PG8_WAIT_L(0); PG8_BAR; PG8_MMA(1, 0, At, B0); PG8_MMA(1, 1, At, B1); PG8_BAR; PG8_SCHED;
            PG8_LDB(B0, 1, 0); PG8_LDB(B1, 1, 1); PG8_SCHED; PG8_LDA(At, 1, 0); PG8_STAGE2(PG8_SA(0, 1), a2 + hstepA, s10, s11);
            PG8_WAIT_V(8); PG8_WAIT_L(0); PG8_BAR; PG8_MMA(0, 0, At, B0); PG8_MMA(0, 1, At, B1); PG8_BAR; PG8_SCHED;
            PG8_LDA(At, 1, 1); PG8_STAGE(PG8_SB(1, 0), b3, voffB); PG8_STAGE(PG8_SB(1, 1), b3 + hstepB, voffB); PG8_STAGE2(PG8_SA(1, 0), a3, s00, s01);
            PG8_WAIT_V(8); PG8_WAIT_L(0); PG8_BAR; PG8_MMA(1, 0, At, B0); PG8_MMA(1, 1, At, B1); PG8_BAR; PG8_SCHED;
        }
        if (wr == 0) PG8_BAR;
        if constexpr (F8) asm volatile("s_nop 15\n\ts_nop 15" ::: "memory");
        E(acc, cur, wr, wc, fr, fq);
        if (!has_next) break;
#pragma unroll
        for (int a = 0; a < 2; ++a)
#pragma unroll
            for (int b = 0; b < 2; ++b)
#pragma unroll
                for (int m = 0; m < 4; ++m)
#pragma unroll
                    for (int n = 0; n < 2; ++n) acc[a][b][m][n] = (f32x4){0.f, 0.f, 0.f, 0.f};
        cur = nxt; cA = nA; cB = nB; ++ui;
        if constexpr (GATHER) { *GSLOT(0) = *GSLOT(1); }
        if (wr == 1) PG8_BAR;
    }
    PG8_WAIT_V(0);
    PG8_BAR;
#undef PG8_SA
#undef PG8_SB
#undef PG8_STAGE
#undef PG8_STAGE2
#undef PG8_ROWS
#undef GSLOT
#undef VGC
#undef PG8_LDA
#undef PG8_LDB
#undef PG8_MMA
#undef PG8_CAT
#undef PG8_WAIT_V
#undef PG8_WAIT_L
#undef PG8_BAR
#undef PG8_SCHED
}

typedef const f32x4 (&AccRef)[2][2][4][2];
__device__ __forceinline__ float ss16(const float* p) { const f32x4 a = *(const f32x4*)p, b = *(const f32x4*)(p + 4), c = *(const f32x4*)(p + 8), d = *(const f32x4*)(p + 12);
    return (((a[0] + a[1]) + (a[2] + a[3])) + ((b[0] + b[1]) + (b[2] + b[3]))) + (((c[0] + c[1]) + (c[2] + c[3])) + ((d[0] + d[1]) + (d[2] + d[3]))); }
__device__ __forceinline__ float rs_of(const float* rstd, int ssmode, int row) { return ssmode ? __builtin_amdgcn_rsqf(ss16(rstd + (size_t)row * 16) * (1.f / D) + 1e-6f) : rstd[row]; }

struct EpiInProj {
    static constexpr bool PERM = true, TRANS = true;
    bf16* P; const float* rstd; float* dt; int ssmode;
    __device__ __forceinline__ void operator()(AccRef acc, const Unit& u, int wr, int wc, int fr, int fq) const {
        const int row0 = u.pm * BM + wr * 64 + fr;
        float scl[2][4];
#pragma unroll
        for (int ai = 0; ai < 2; ++ai)
#pragma unroll
            for (int m = 0; m < 4; ++m) scl[ai][m] = rs_of(rstd, ssmode, row0 + ai * HALF + m * 16);
        if (u.pn < 21) {
            const int col0 = u.pn * BM + wc * 32 + 8 * fq;
#pragma unroll
            for (int ai = 0; ai < 2; ++ai)
#pragma unroll
                for (int m = 0; m < 4; ++m) { const int row = row0 + ai * HALF + m * 16; const float s = scl[ai][m]; bf16* rowp = P + (size_t)row * PLD + col0;
#pragma unroll
                    for (int bj = 0; bj < 2; ++bj) { const f32x4 v0 = acc[ai][bj][m][0] * s, v1 = acc[ai][bj][m][1] * s;
                        u32x4 w; w.x = pk2(v0[0], v0[1]); w.y = pk2(v0[2], v0[3]); w.z = pk2(v1[0], v1[1]); w.w = pk2(v1[2], v1[3]);
                        *(u32x4*)(rowp + bj * HALF) = w; } }
        } else if (wc == 0 && fq == 0) {
#pragma unroll
            for (int ai = 0; ai < 2; ++ai)
#pragma unroll
                for (int m = 0; m < 4; ++m) { const int row = row0 + ai * HALF + m * 16; const float s = scl[ai][m];
                    *(f32x4*)(dt + (size_t)row * 8) = acc[ai][0][m][0] * s; *(f32x4*)(dt + (size_t)row * 8 + 4) = acc[ai][0][m][1] * s; }
        }
    }
};
struct EpiPlain {
    static constexpr bool PERM = true, TRANS = true;
    bf16* P; bf16* Y2;
    __device__ __forceinline__ void operator()(AccRef acc, const Unit& u, int wr, int wc, int fr, int fq) const {
        bf16* O = (u.e == 0) ? P : (u.e == 1 ? P + C_XBC : Y2); const int ldc = (u.e == 2) ? D : PLD;
        const int row0 = u.pm * BM + wr * 64 + fr, col0 = u.pn * BM + wc * 32 + 8 * fq;
#pragma unroll
        for (int ai = 0; ai < 2; ++ai)
#pragma unroll
            for (int m = 0; m < 4; ++m) { bf16* rowp = O + (size_t)(row0 + ai * HALF + m * 16) * ldc + col0;
#pragma unroll
                for (int bj = 0; bj < 2; ++bj) { const f32x4 v0 = acc[ai][bj][m][0], v1 = acc[ai][bj][m][1];
                    u32x4 w; w.x = pk2(v0[0], v0[1]); w.y = pk2(v0[2], v0[3]); w.z = pk2(v1[0], v1[1]); w.w = pk2(v1[2], v1[3]);
                    *(u32x4*)(rowp + bj * HALF) = w; } }
    }
};
struct EpiGateMerge {
    static constexpr bool PERM = true, TRANS = true;
    const bf16* P; const bf16* Y2; bf16* Mg; int ldm; const float* rstd; int ssmode;
    __device__ __forceinline__ void operator()(AccRef acc, const Unit& u, int wr, int wc, int fr, int fq) const {
        asm volatile("" : "+v"(fr), "+v"(fq));
        const bf16* Y = (u.e == 0) ? P : (u.e == 1 ? P + C_XBC : Y2); const int ldy = (u.e == 2) ? D : PLD; const int first = (u.e == 0);
        const int row0 = u.pm * BM + wr * 64 + fr, col0 = u.pn * BM + wc * 32 + 8 * fq;
#pragma unroll
        for (int ai = 0; ai < 2; ++ai) {
            u32x4 yv[4][2], mv[4][2]; float sc[4];
#pragma unroll
            for (int m = 0; m < 4; ++m) { const int row = row0 + ai * HALF + m * 16; sc[m] = rs_of(rstd, ssmode, row);
#pragma unroll
                for (int bj = 0; bj < 2; ++bj) { yv[m][bj] = *(const u32x4*)(Y + (size_t)row * ldy + col0 + bj * HALF);
                    mv[m][bj] = first ? (u32x4){0u, 0u, 0u, 0u} : *(const u32x4*)(Mg + (size_t)row * ldm + col0 + bj * HALF); } }
#pragma unroll
            for (int m = 0; m < 4; ++m) { const int row = row0 + ai * HALF + m * 16;
#pragma unroll
                for (int bj = 0; bj < 2; ++bj) { float y[8], p[8], o[8]; unpack8(yv[m][bj], y); unpack8(mv[m][bj], p);
                    const f32x4 v0 = acc[ai][bj][m][0] * sc[m], v1 = acc[ai][bj][m][1] * sc[m];
#pragma unroll
                    for (int j = 0; j < 4; ++j) { o[j] = sigm(v0[j]) * y[j] + p[j]; o[4 + j] = sigm(v1[j]) * y[4 + j] + p[4 + j]; }
                    *(u32x4*)(Mg + (size_t)row * ldm + col0 + bj * HALF) = pack8(o); } }
        }
    }
};
struct EpiResid {
    static constexpr bool PERM = false, TRANS = true;
    const float* xin; float* xout; const float* gates; int e;
    __device__ __forceinline__ void operator()(AccRef acc, const Unit& u, int wr, int wc, int fr, int fq) const {
        const int row0 = u.pm * BM + wr * 64 + fr, col0 = u.pn * BM + wc * 32 + 4 * fq;
#pragma unroll
        for (int ai = 0; ai < 2; ++ai)
#pragma unroll
            for (int m = 0; m < 4; ++m) { const int row = row0 + ai * HALF + m * 16; const float s = gates ? gates[(size_t)row * 8 + e] : 1.f;
                const float* ip = xin + (size_t)row * D + col0; float* op = xout + (size_t)row * D + col0;
#pragma unroll
                for (int bj = 0; bj < 2; ++bj)
#pragma unroll
                    for (int n = 0; n < 2; ++n) *(f32x4*)(op + bj * HALF + n * 16) = *(const f32x4*)(ip + bj * HALF + n * 16) + acc[ai][bj][m][n] * s; }
    }
};
struct EpiResidB {
    static constexpr bool PERM = true, TRANS = true;
    bf16* xb; float* SS; float* xf;
    __device__ __forceinline__ void operator()(AccRef acc, const Unit& u, int wr, int wc, int fr, int fq) const {
        asm volatile("" : "+v"(fr), "+v"(fq));
        const int row0 = u.pm * BM + wr * 64 + fr, col0 = u.pn * BM + wc * 32 + 8 * fq;
#pragma unroll
        for (int ai = 0; ai < 2; ++ai) {
            u32x4 xv[4][2];
#pragma unroll
            for (int m = 0; m < 4; ++m)
#pragma unroll
                for (int bj = 0; bj < 2; ++bj) xv[m][bj] = *(const u32x4*)(xb + (size_t)(row0 + ai * HALF + m * 16) * D + col0 + bj * HALF);
#pragma unroll
            for (int m = 0; m < 4; ++m) { const int row = row0 + ai * HALF + m * 16; bf16* rowp = xb + (size_t)row * D + col0; float ss = 0.f;
#pragma unroll
                for (int bj = 0; bj < 2; ++bj) { float v[8]; unpack8(xv[m][bj], v);
#pragma unroll
                    for (int j = 0; j < 4; ++j) { v[j] += acc[ai][bj][m][0][j]; v[4 + j] += acc[ai][bj][m][1][j]; }
                    *(u32x4*)(rowp + bj * HALF) = pack8(v);
                    if (xf) { float* fp = xf + (size_t)row * D + col0 + bj * HALF; *(f32x4*)fp = (f32x4){v[0], v[1], v[2], v[3]}; *(f32x4*)(fp + 4) = (f32x4){v[4], v[5], v[6], v[7]}; }
#pragma unroll
                    for (int j = 0; j < 8; ++j) ss += v[j] * v[j]; }
                if (SS) { ss += __shfl_xor(ss, 16); ss += __shfl_xor(ss, 32); if (fq == 0) SS[(size_t)row * 16 + u.pn * 4 + wc] = ss; } }
        }
    }
};
struct EpiSwiglu {
    static constexpr bool PERM = true, TRANS = true;
    bf16* act; int ldc; const float* rstd; int ssmode;
    __device__ __forceinline__ void operator()(AccRef acc, const Unit& u, int wr, int wc, int fr, int fq) const {
        asm volatile("" : "+v"(fr), "+v"(fq));
        const int row0 = u.pm * BM + wr * 64 + fr, col0 = u.pn * HALF + wc * 32 + 8 * fq;
        float scl[2][4];
        if (u.rows) { int tk[2][4];
#pragma unroll
            for (int ai = 0; ai < 2; ++ai)
#pragma unroll
                for (int m = 0; m < 4; ++m) { const int lr = wr * 64 + fr + ai * HALF + m * 16; tk[ai][m] = (lr < u.nvalid) ? u.rows[2 * lr] : 0; }
#pragma unroll
            for (int ai = 0; ai < 2; ++ai)
#pragma unroll
                for (int m = 0; m < 4; ++m) scl[ai][m] = rstd[tk[ai][m]];
        } else {
#pragma unroll
            for (int ai = 0; ai < 2; ++ai)
#pragma unroll
                for (int m = 0; m < 4; ++m) scl[ai][m] = rs_of(rstd, ssmode, row0 + ai * HALF + m * 16); }
#pragma unroll
        for (int ai = 0; ai < 2; ++ai)
#pragma unroll
            for (int m = 0; m < 4; ++m) { const int row = row0 + ai * HALF + m * 16;
                const float s = scl[ai][m];
                float o[8];
#pragma unroll
                for (int n = 0; n < 2; ++n)
#pragma unroll
                    for (int j = 0; j < 4; ++j) o[4 * n + j] = silu(acc[ai][0][m][n][j] * s) * (acc[ai][1][m][n][j] * s);
                *(u32x4*)(act + (size_t)row * ldc + col0) = pack8(o); }
    }
};
struct EpiSwiglu8 {
    static constexpr bool PERM = true, TRANS = true;
    unsigned char* act; int ldc;
    __device__ __forceinline__ void operator()(AccRef acc, const Unit& u, int wr, int wc, int fr, int fq) const {
        asm volatile("" : "+v"(fr), "+v"(fq));
        const int row0 = u.pm * BM + wr * 64 + fr, col0 = u.pn * HALF + wc * 32 + 8 * fq;
        const float s = 1.f / 256.f, s8 = 8.f / 256.f;
#pragma unroll
        for (int ai = 0; ai < 2; ++ai)
#pragma unroll
            for (int m = 0; m < 4; ++m) { const int row = row0 + ai * HALF + m * 16;
                float o[8];
#pragma unroll
                for (int n = 0; n < 2; ++n)
#pragma unroll
                    for (int j = 0; j < 4; ++j) o[4 * n + j] = silu(acc[ai][0][m][n][j] * s) * (acc[ai][1][m][n][j] * s8);
                u32x2 w; w.x = pk4f8(o[0], o[1], o[2], o[3]); w.y = pk4f8(o[4], o[5], o[6], o[7]);
                *(u32x2*)(act + (size_t)row * ldc + col0) = w; }
    }
};
struct EpiMoeOut {
    static constexpr bool PERM = true, TRANS = true;
    bf16* Y; size_t kstride; float mul;
    __device__ __forceinline__ void operator()(AccRef acc, const Unit& u, int wr, int wc, int fr, int fq) const {
        const int row0 = u.pm * BM + wr * 64 + fr, col0 = u.pn * BM + wc * 32 + 8 * fq; bf16* O = Y + (size_t)u.ks * kstride;
#pragma unroll
        for (int ai = 0; ai < 2; ++ai)
#pragma unroll
            for (int m = 0; m < 4; ++m) { bf16* rowp = O + (size_t)(row0 + ai * HALF + m * 16) * D + col0;
#pragma unroll
                for (int bj = 0; bj < 2; ++bj) { const f32x4 v0 = acc[ai][bj][m][0] * mul, v1 = acc[ai][bj][m][1] * mul;
                    u32x4 w; w.x = pk2(v0[0], v0[1]); w.y = pk2(v0[2], v0[3]); w.z = pk2(v1[0], v1[1]); w.w = pk2(v1[2], v1[3]);
                    *(u32x4*)(rowp + bj * HALF) = w; } }
    }
};
}

#define XB_TMO      128
#define XB_XCNT(j)  (256  + 64 * (j))
#define XB_XSUB(j)  (1280 + 64 * (j))
#define XB_XGEN(j)  (2304 + 64 * (j))
#define XB_TOP      3328
#define XB_TOPGEN   3392
#define XCD_BAR_WORDS 3456
#define XB_SPIN_CAP (1u << 18)

__device__ __forceinline__ unsigned xb_ld(unsigned* p)              { return __hip_atomic_load(p, __ATOMIC_RELAXED, __HIP_MEMORY_SCOPE_AGENT); }
__device__ __forceinline__ unsigned xb_add(unsigned* p, unsigned v) { return __hip_atomic_fetch_add(p, v, __ATOMIC_RELAXED, __HIP_MEMORY_SCOPE_AGENT); }
__device__ __forceinline__ unsigned xb_xcc_id() { return (unsigned)__builtin_amdgcn_s_getreg((3 << 11) | 20) & 0xFu; }
#define XB_SPIN(cond, bar) do { unsigned _sp = 0; while (cond) { __builtin_amdgcn_s_sleep(1); \
    if ((++_sp & 255u) == 0u) { if (xb_ld(&(bar)[XB_TMO])) break; if (_sp > XB_SPIN_CAP) { atomicAdd(&(bar)[XB_TMO], 1u); break; } } } } while (0)

struct XcdBarrier { unsigned* bar; unsigned x; volatile LAS unsigned* st; };

__device__ __forceinline__ XcdBarrier xcd_barrier_post(unsigned* bar, volatile LAS unsigned* st) {
    XcdBarrier b; b.bar = bar; b.x = xb_xcc_id(); b.st = st;
    if (threadIdx.x == 0) (void)xb_add(&bar[XB_XCNT(b.x)], 1u);
    return b;
}
__device__ __forceinline__ void xcd_barrier_complete(unsigned* bar, unsigned x, unsigned& nloc, unsigned& nx) {
    const unsigned G = gridDim.x * gridDim.y * gridDim.z;
    unsigned sum, cnt, mine, sp = 0u;
    for (;;) {
        sum = 0u; cnt = 0u; mine = 0u;
#pragma unroll
        for (unsigned j = 0; j < 16; ++j) { const unsigned c = xb_ld(&bar[XB_XCNT(j)]); sum += c; cnt += (c > 0u) ? 1u : 0u; mine = (j == x) ? c : mine; }
        if (sum == G) break;
        __builtin_amdgcn_s_sleep(1);
        if ((++sp & 255u) == 0u) { if (xb_ld(&bar[XB_TMO])) break; if (sp > XB_SPIN_CAP) { atomicAdd(&bar[XB_TMO], 1u); break; } }
    }
    nloc = mine > 0u ? mine : 1u; nx = cnt > 0u ? cnt : 1u;
}
__device__ __forceinline__ void xcd_barrier(const XcdBarrier& b) {
    asm volatile("s_waitcnt vmcnt(0)" ::: "memory");
    __syncthreads();
    if (threadIdx.x == 0) {
        unsigned* bar = b.bar;
        __builtin_amdgcn_s_waitcnt(0);
        unsigned nloc = b.st[0], nx = b.st[1];
        if (nloc == 0u) { xcd_barrier_complete(bar, b.x, nloc, nx); b.st[0] = nloc; b.st[1] = nx; }
        const unsigned old = xb_add(&bar[XB_XSUB(b.x)], 1u);
        const unsigned gen = old / nloc;
        if (old + 1u == (gen + 1u) * nloc) {
            __builtin_amdgcn_fence(__ATOMIC_RELEASE, "agent");
            asm volatile("s_waitcnt vmcnt(0)" ::: "memory");
            const unsigned og = xb_add(&bar[XB_TOP], 1u);
            const unsigned tg = og / nx;
            if (og + 1u == (tg + 1u) * nx) xb_add(&bar[XB_TOPGEN], 1u);
            else XB_SPIN(xb_ld(&bar[XB_TOPGEN]) == tg, bar);
            __builtin_amdgcn_fence(__ATOMIC_ACQUIRE, "agent");
            xb_add(&bar[XB_XGEN(b.x)], 1u);
            asm volatile("s_waitcnt vmcnt(0)" ::: "memory");
        } else {
            XB_SPIN(xb_ld(&bar[XB_XGEN(b.x)]) == gen, bar);
            __builtin_amdgcn_fence(__ATOMIC_ACQUIRE, "agent");
            asm volatile("s_waitcnt vmcnt(0)" ::: "memory");
        }
    }
    __syncthreads();
}

#define GAS __attribute__((address_space(1)))
struct Args { const float* in[34]; float* out; unsigned char* ws; int ph_lo, ph_hi; };
struct Frame {
    LAS unsigned char* lds;
    int vcu, G, cid, wid, rr;
    GAS float* out; GAS unsigned char* ws; GAS unsigned char* st;
};
__device__ __forceinline__ const float* inptr(LAS unsigned char* lds, int i) {
    int off = LDSCTL_OFF + 8 * i; asm volatile("" : "+v"(off));
    const LAS unsigned* p = (const LAS unsigned*)(lds + off);
    const unsigned lo = __builtin_amdgcn_readfirstlane(p[0]), hi = __builtin_amdgcn_readfirstlane(p[1]);
    return (const float*)(GAS const float*)(((unsigned long long)hi << 32) | lo);
}
#define INP(i) inptr(F.lds, (i))

__device__ __forceinline__ void conv_item(const float* W, int ld, int k0, int c0, int nvalid, const float* scale, bf16* dst, int K, int drow0, LAS float* scr, int lane) {
    const int n4 = (lane & 15) * 4;
    f32x4 v[16]; float sc[16];
#pragma unroll
    for (int i = 0; i < 16; ++i) { const int kk = 4 * i + (lane >> 4);
        v[i] = (f32x4){0.f, 0.f, 0.f, 0.f}; sc[i] = 1.f; if (n4 < nvalid) { v[i] = *(const f32x4*)(W + (size_t)(k0 + kk) * ld + c0 + n4); if (scale) sc[i] = scale[k0 + kk]; } }
#pragma unroll
    for (int i = 0; i < 16; ++i) { const int kk = 4 * i + (lane >> 4); const f32x4 x = v[i] * sc[i];
        LAS float* d = scr + kk * 65 + n4; d[0] = x[0]; d[1] = x[1]; d[2] = x[2]; d[3] = x[3]; }
    LDS_WAIT(); asm volatile("" ::: "memory");
    const int c = lane & 7;
#pragma unroll
    for (int j = 0; j < 8; ++j) { const int nn = (lane >> 3) + 8 * j; const LAS float* sp = scr + (8 * c) * 65 + nn;
        u32x4 o; o.x = pk2(sp[0 * 65], sp[1 * 65]); o.y = pk2(sp[2 * 65], sp[3 * 65]); o.z = pk2(sp[4 * 65], sp[5 * 65]); o.w = pk2(sp[6 * 65], sp[7 * 65]);
        *(u32x4*)(dst + (size_t)(drow0 + nn) * K + k0 + 8 * c) = o; }
    LDS_WAIT(); asm volatile("" ::: "memory");
}
__device__ __forceinline__ void conv_item8(const float* W, int ld, int k0, int c0, const float* scale, float mul, unsigned char* dst, int K, int drow0, LAS float* scr, int lane) {
    const int n4 = (lane & 15) * 4;
    f32x4 v[16]; float sc[16];
#pragma unroll
    for (int i = 0; i < 16; ++i) { const int kk = 4 * i + (lane >> 4); v[i] = *(const f32x4*)(W + (size_t)(k0 + kk) * ld + c0 + n4); sc[i] = scale ? scale[k0 + kk] * mul : mul; }
#pragma unroll
    for (int i = 0; i < 16; ++i) { const int kk = 4 * i + (lane >> 4); const f32x4 x = v[i] * sc[i];
        LAS float* d = scr + kk * 65 + n4; d[0] = x[0]; d[1] = x[1]; d[2] = x[2]; d[3] = x[3]; }
    LDS_WAIT(); asm volatile("" ::: "memory");
    const int c = lane & 3;
#pragma unroll
    for (int j = 0; j < 4; ++j) { const int nn = (lane >> 2) + 16 * j; const LAS float* sp = scr + (16 * c) * 65 + nn;
        u32x4 o; o.x = pk4f8(sp[0 * 65], sp[1 * 65], sp[2 * 65], sp[3 * 65]); o.y = pk4f8(sp[4 * 65], sp[5 * 65], sp[6 * 65], sp[7 * 65]);
        o.z = pk4f8(sp[8 * 65], sp[9 * 65], sp[10 * 65], sp[11 * 65]); o.w = pk4f8(sp[12 * 65], sp[13 * 65], sp[14 * 65], sp[15 * 65]);
        *(u32x4*)(dst + (size_t)(drow0 + nn) * K + k0 + 16 * c) = o; }
    LDS_WAIT(); asm volatile("" ::: "memory");
}
__device__ __forceinline__ void conv_seg8(Frame& F, const float* W, int ld, int K, int ncols, const float* scale, float mul, unsigned char* dst, int r0, int blk, int blks) {
    const int ptid = otid(), plane = ptid & 63, pwave = __builtin_amdgcn_readfirstlane(ptid >> 6);
    LAS float* scr = (LAS float*)(F.lds + pwave * 16640);
    const int gw = F.vcu * 8 + pwave, NGW = F.G * 8;
    const int nblk = ncols / 64, nitems = (K / 64) * nblk;
    const int first = (gw - F.rr % NGW + NGW) % NGW; F.rr = (F.rr + nitems) % NGW;
    for (int it = first; it < nitems; it += NGW) {
        const int kb = it / nblk, nb = it % nblk, n0 = nb * 64;
        conv_item8(W, ld, kb * 64, n0, scale, mul, dst, K, r0 + (n0 / blk) * blks + (n0 % blk), scr, plane);
    }
}
__device__ __forceinline__ void conv_seg(Frame& F, const float* W, int ld, int K, int c0, int nvalid, int ntotal, const float* scale, bf16* dst, int r0, int blk, int blks) {
    const int ptid = otid(), plane = ptid & 63, pwave = __builtin_amdgcn_readfirstlane(ptid >> 6);
    LAS float* scr = (LAS float*)(F.lds + pwave * 16640);
    const int gw = F.vcu * 8 + pwave, NGW = F.G * 8;
    const int nblk = ntotal / 64, nitems = (K / 64) * nblk;
    const int first = (gw - F.rr % NGW + NGW) % NGW; F.rr = (F.rr + nitems) % NGW;
    for (int it = first; it < nitems; it += NGW) {
        const int kb = it / nblk, nb = it % nblk, n0 = nb * 64;
        int nv = nvalid - n0; nv = nv < 0 ? 0 : (nv > 64 ? 64 : nv);
        conv_item(W, ld, kb * 64, c0 + n0, nv, scale, dst, K, r0 + (n0 / blk) * blks + (n0 % blk), scr, plane);
    }
}
__device__ __forceinline__ void conv_layer_weights(Frame& F, int l, int part) {
    unsigned char* wl = (unsigned char*)(F.ws + WS_W + (size_t)l * WL_STRIDE);
    const float* win = INP(2) + (size_t)l * D * INC; const float* n1 = INP(1) + l * D;
    const int BIGB = 1 << 30;
    if (part == 0) {
        conv_seg(F, win, INC, D, 0, 3328, 3328, n1, (bf16*)(wl + WL_IN), 0, BIGB, 0);
        conv_seg(F, win, INC, D, 3336, 2048, 2048, n1, (bf16*)(wl + WL_IN), 3328, BIGB, 0);
        conv_seg(F, win, INC, D, 3328, 8, 256, n1, (bf16*)(wl + WL_IN), 5376, BIGB, 0);
    } else {
        conv_seg(F, win, INC, D, 5384, 3072, 3072, n1, (bf16*)(wl + WL_GATE), 0, BIGB, 0);
        for (int i = 0; i < 3; ++i)
            conv_seg(F, INP(23) + ((size_t)l * 3 + i) * 512 * D, D, 512, 0, D, D, nullptr, (bf16*)(wl + WL_BR) + (size_t)i * D * 512, 0, BIGB, 0);
        conv_seg(F, INP(24) + (size_t)l * D * D, D, D, 0, D, D, nullptr, (bf16*)(wl + WL_OUT), 0, BIGB, 0);
    }
}
__device__ __forceinline__ void conv_ffn_weights(Frame& F) {
    const float* n2 = INP(25);
    conv_seg(F, INP(26), FF, D, 0, FF, FF, n2, (bf16*)(F.ws + WS_FFUP), 0, 128, 256);
    conv_seg(F, INP(27), FF, D, 0, FF, FF, n2, (bf16*)(F.ws + WS_FFUP), 128, 128, 256);
    conv_seg(F, INP(28), D, FF, 0, D, D, nullptr, (bf16*)(F.ws + WS_FFDN), 0, 1 << 30, 0);
}
__device__ __forceinline__ unsigned char* moew_ptr(const Frame& F, int e) { return e < 6 ? (unsigned char*)F.out + MOEW_OUT + (size_t)e * MOEW_STRIDE : (e == 6 ? (unsigned char*)(F.ws + WS_FFUP) : (unsigned char*)(F.ws + WS_VF + 16 * MiB)); }
__device__ __forceinline__ void conv_moe_weights(Frame& F, int e_lo, int e_hi) {
    const float* n2 = INP(25) + D;
    for (int e = e_lo; e < e_hi; ++e) {
        unsigned char* up = moew_ptr(F, e); unsigned char* dn = up + MOEW_DN;
        conv_seg8(F, INP(30) + (size_t)e * D * FFE, FFE, D, FFE, n2, 64.f, up, 0, 128, 256);
        conv_seg8(F, INP(31) + (size_t)e * D * FFE, FFE, D, FFE, n2, 64.f, up, 128, 128, 256);
        conv_seg8(F, INP(32) + (size_t)e * FFE * D, D, FFE, D, nullptr, 128.f, dn, 0, 1 << 30, 0);
    }
}
__device__ __forceinline__ void xprep_phase(Frame& F, const float* x) {
    const int ptid = otid(), plane = ptid & 63, pwave = __builtin_amdgcn_readfirstlane(ptid >> 6);
    const int gw = F.vcu * 8 + pwave, NGW = F.G * 8;
    bf16* xb = (bf16*)(F.ws + WS_XB); float* rstd = (float*)(F.ws + WS_RSTD);
    for (int m0 = 4 * gw; m0 < M; m0 += 4 * NGW) {
        f32x4 v[4][4];
#pragma unroll
        for (int q = 0; q < 4; ++q) { const f32x4* xr = (const f32x4*)(x + (size_t)(m0 + q) * D) + plane;
#pragma unroll
            for (int j = 0; j < 4; ++j) v[q][j] = xr[64 * j]; }
#pragma unroll
        for (int q = 0; q < 4; ++q) { const int m = m0 + q; float sq = 0.f;
#pragma unroll
            for (int j = 0; j < 4; ++j) sq += (v[q][j].x * v[q][j].x + v[q][j].y * v[q][j].y) + (v[q][j].z * v[q][j].z + v[q][j].w * v[q][j].w);
            sq = wave_sum(sq);
            if (plane == 0) rstd[m] = __builtin_amdgcn_rsqf(sq * (1.f / D) + 1e-6f);
            u32x2* o8 = (u32x2*)(xb + (size_t)m * D) + plane;
#pragma unroll
            for (int j = 0; j < 4; ++j) { u32x2 w; w.x = pk2(v[q][j].x, v[q][j].y); w.y = pk2(v[q][j].z, v[q][j].w); o8[64 * j] = w; } }
    }
}
__device__ __forceinline__ void final_norm_phase(Frame& F) {
    const int ptid = otid(), plane = ptid & 63, pwave = __builtin_amdgcn_readfirstlane(ptid >> 6);
    const int gw = F.vcu * 8 + pwave, NGW = F.G * 8;
    const float* fw = INP(33); const unsigned* pinfo = (const unsigned*)(F.ws + WS_PINFO); const int* cnt = (const int*)(F.ws + WS_CNT);
    int tb[8]; { int t = 0;
#pragma unroll
        for (int e = 0; e < 8; ++e) { int n = __builtin_amdgcn_readfirstlane(cnt[e]); n = n < 0 ? 0 : (n > 32768 ? 32768 : n); tb[e] = t; t += (n + 255) >> 8; } }
    const bf16* Y0 = (const bf16*)(F.ws + WS_YP0); const bf16* Y1 = (const bf16*)(F.ws + WS_YP1); const bf16* Y2 = (const bf16*)(F.ws + WS_YP2);
    f32x4 fwv[4];
#pragma unroll
    for (int j = 0; j < 4; ++j) fwv[j] = *((const f32x4*)fw + plane + 64 * j);
    for (int m0 = 2 * gw; m0 < M; m0 += 2 * NGW) {
        f32x4 v[2][4]; u32x2 ya[2][2][4]; float wg[2][2]; int sgm[2][2]; const bf16* yp[2][2];
#pragma unroll
        for (int q = 0; q < 2; ++q) { const int m = m0 + q;
            const u32x2* xr = (const u32x2*)((const bf16*)(F.ws + WS_XB) + (size_t)m * D) + plane;
#pragma unroll
            for (int j = 0; j < 4; ++j) { const u32x2 xx = xr[64 * j]; v[q][j] = (f32x4){bflo(xx.x), bfhi(xx.x), bflo(xx.y), bfhi(xx.y)}; }
#pragma unroll
            for (int p = 0; p < 2; ++p) {
                const unsigned pk = __builtin_amdgcn_readfirstlane(pinfo[((size_t)m * 2 + p) * 2]); wg[q][p] = __builtin_bit_cast(float, __builtin_amdgcn_readfirstlane(pinfo[((size_t)m * 2 + p) * 2 + 1]));
                const int e = (int)(pk >> 20), slot = (int)(pk & 0xFFFFFu);
                int tbe = tb[0];
#pragma unroll
                for (int k = 1; k < 8; ++k) tbe = (e == k) ? tb[k] : tbe;
                const int gr = tbe * 256 + slot, seg = gr >> 15, lr = gr & 32767; sgm[q][p] = seg;
                yp[q][p] = (seg == 0 ? Y0 : (seg == 1 ? Y1 : Y2)) + (size_t)lr * D + 4 * plane; } }
#pragma unroll
        for (int q = 0; q < 2; ++q)
#pragma unroll
            for (int p = 0; p < 2; ++p)
#pragma unroll
                for (int j = 0; j < 4; ++j) ya[q][p][j] = *(const u32x2*)(yp[q][p] + 256 * j);
#pragma unroll
        for (int q = 0; q < 2; ++q) { const int m = m0 + q;
#pragma unroll
            for (int p = 0; p < 2; ++p) { const float wgt = wg[q][p];
#pragma unroll
                for (int j = 0; j < 4; ++j) { const u32x2 yy = ya[q][p][j]; v[q][j].x += wgt * bflo(yy.x); v[q][j].y += wgt * bfhi(yy.x); v[q][j].z += wgt * bflo(yy.y); v[q][j].w += wgt * bfhi(yy.y); }
                if (sgm[q][p] == 2) {
#pragma unroll
                    for (int ks = 1; ks < MOE_KSP; ++ks)
#pragma unroll
                        for (int j = 0; j < 4; ++j) { const u32x2 yy = *(const u32x2*)(yp[q][p] + (size_t)ks * (YP2_STRIDE / 2) + 256 * j); v[q][j].x += wgt * bflo(yy.x); v[q][j].y += wgt * bfhi(yy.x); v[q][j].z += wgt * bflo(yy.y); v[q][j].w += wgt * bfhi(yy.y); } } }
            float ssq = 0.f;
#pragma unroll
            for (int j = 0; j < 4; ++j) ssq += (v[q][j].x * v[q][j].x + v[q][j].y * v[q][j].y) + (v[q][j].z * v[q][j].z + v[q][j].w * v[q][j].w);
            ssq = wave_sum(ssq);
            const float r = __builtin_amdgcn_rsqf(ssq * (1.f / D) + 1e-6f);
            f32x4* xo = (f32x4*)(F.out + (size_t)m * D) + plane;
#pragma unroll
            for (int j = 0; j < 4; ++j) xo[64 * j] = v[q][j] * r * fwv[j]; }
    }
}
__device__ __forceinline__ void router_phase(Frame& F) {
    const int ptid = otid(), plane = ptid & 63, pwave = __builtin_amdgcn_readfirstlane(ptid >> 6);
    const float* nw = INP(25) + D; const float* rt = INP(29); bf16* xb = (bf16*)(F.ws + WS_XB);
    int* cnt = (int*)(F.ws + WS_CNT); int* list2 = (int*)(F.ws + WS_LIST);
    LAS int* lsel = (LAS int*)F.lds;
    LAS float* lwt = (LAS float*)(F.lds + 1024);
    LAS int* lrank = (LAS int*)(F.lds + 2048);
    LAS int* lcnt = (LAS int*)(F.lds + 3072);
    f32x4 nwq[4]; f32x4 rq[16][2];
#pragma unroll
    for (int j = 0; j < 4; ++j) { const int kk = 4 * plane + 256 * j; nwq[j] = *(const f32x4*)(nw + kk);
#pragma unroll
        for (int q = 0; q < 4; ++q) { rq[4 * j + q][0] = *(const f32x4*)(rt + (size_t)(kk + q) * 8); rq[4 * j + q][1] = *(const f32x4*)(rt + (size_t)(kk + q) * 8 + 4); } }
    for (int blk = F.vcu; blk < M / 128; blk += F.G) {
        if (ptid < 16) lcnt[ptid] = 0;
        __syncthreads();
        u32x2 xn[4];
        { const u32x2* xr2 = (const u32x2*)(xb + (size_t)(blk * 128 + pwave * 16) * D) + plane;
#pragma unroll
          for (int j = 0; j < 4; ++j) xn[j] = xr2[64 * j]; }
        for (int k = 0; k < 16; ++k) {
            const int lt = pwave * 16 + k, m = blk * 128 + lt;
            float acc[8];
#pragma unroll
            for (int e = 0; e < 8; ++e) acc[e] = 0.f;
            u32x2 xc[4];
#pragma unroll
            for (int j = 0; j < 4; ++j) xc[j] = xn[j];
            if (k + 1 < 16) { const u32x2* xr2 = (const u32x2*)(xb + (size_t)(m + 1) * D) + plane;
#pragma unroll
                for (int j = 0; j < 4; ++j) xn[j] = xr2[64 * j]; }
            f32x4 xv4[4]; float ssq = 0.f;
#pragma unroll
            for (int j = 0; j < 4; ++j) { const u32x2 xx = xc[j]; xv4[j] = (f32x4){bflo(xx.x), bfhi(xx.x), bflo(xx.y), bfhi(xx.y)}; ssq += (xv4[j].x * xv4[j].x + xv4[j].y * xv4[j].y) + (xv4[j].z * xv4[j].z + xv4[j].w * xv4[j].w); }
            ssq = wave_sum(ssq);
            const float sc = __builtin_amdgcn_rsqf(ssq * (1.f / D) + 1e-6f);
            { unsigned* x8 = (unsigned*)(F.ws + WS_X8 + (size_t)m * D) + plane; const float s4 = 4.f * sc;
#pragma unroll
              for (int j = 0; j < 4; ++j) x8[64 * j] = pk4f8(xv4[j].x * s4, xv4[j].y * s4, xv4[j].z * s4, xv4[j].w * s4); }
#pragma unroll
            for (int j = 0; j < 4; ++j) { const f32x4 nwv = nwq[j];
#pragma unroll
                for (int q = 0; q < 4; ++q) { const float xv = xv4[j][q] * nwv[q];
                    const f32x4 r0v = rq[4 * j + q][0], r1v = rq[4 * j + q][1];
                    acc[0] += xv * r0v.x; acc[1] += xv * r0v.y; acc[2] += xv * r0v.z; acc[3] += xv * r0v.w; acc[4] += xv * r1v.x; acc[5] += xv * r1v.y; acc[6] += xv * r1v.z; acc[7] += xv * r1v.w; } }
#pragma unroll
            for (int e = 0; e < 8; ++e) acc[e] = wave_sum(acc[e]) * sc;
            int i0 = 0; float v0 = acc[0];
#pragma unroll
            for (int e = 1; e < 8; ++e) if (acc[e] > v0) { v0 = acc[e]; i0 = e; }
            int i1 = -1; float v1 = -3.0e38f;
#pragma unroll
            for (int e = 0; e < 8; ++e) if (e != i0 && acc[e] > v1) { v1 = acc[e]; i1 = e; }
            const float e1 = expf(v1 - v0), w0 = 1.f / (1.f + e1), w1 = e1 / (1.f + e1);
            if (plane == 0) { lsel[2 * lt] = i0; lsel[2 * lt + 1] = i1; lwt[2 * lt] = w0; lwt[2 * lt + 1] = w1;
                lrank[2 * lt] = atomicAdd((int*)(lcnt + i0), 1); lrank[2 * lt + 1] = atomicAdd((int*)(lcnt + i1), 1); }
        }
        __syncthreads();
        if (ptid < 8) lcnt[8 + ptid] = atomicAdd(cnt + ptid, lcnt[ptid]);
        __syncthreads();
        if (ptid < 256) { const int e = lsel[ptid], slot = lcnt[8 + e] + lrank[ptid];
            u32x2 v; v.x = (unsigned)(blk * 128 + (ptid >> 1)); v.y = __builtin_bit_cast(unsigned, lwt[ptid]);
            *(u32x2*)(list2 + ((size_t)e * 32768 + slot) * 2) = v;
            u32x2 pi; pi.x = ((unsigned)e << 20) | (unsigned)slot; pi.y = v.y; *(u32x2*)((unsigned*)(F.ws + WS_PINFO) + ((size_t)(blk * 128) * 2 + ptid) * 2) = pi; }
        __syncthreads();
    }
}

__device__ __forceinline__ void vprep_phase(Frame& F, int layer) {
    const int ptid = otid(), plane = ptid & 63, pwave = __builtin_amdgcn_readfirstlane(ptid >> 6);
    constexpr int VP = 520, V_VB = 0, V_GB = 64 * VP * 2, V_VD = 2 * 64 * VP * 2;
    LAS bf16* VB = (LAS bf16*)(F.lds + V_VB); LAS bf16* GB = (LAS bf16*)(F.lds + V_GB); LAS bf16* VD = (LAS bf16*)(F.lds + V_VD);
    const bf16* P = (const bf16*)(F.ws + WS_BIG); bf16* VF = (bf16*)(F.ws + WS_VF); bf16* VM = (bf16*)(F.ws + WS_VMIX);
    const bf16* vdT = (const bf16*)(F.ws + WS_VLORA); const bf16* vuT = vdT + 32 * 512;
    const float* mu = INP(3) + layer * 1792 + 1024; const float* v0 = INP(16);
    const int tok = ptid >> 3, part = ptid & 7, r16 = plane & 15, q4 = plane >> 4;
    for (int it = F.vcu; it < M / 64; it += F.G) {
        const int m = it * 64 + tok; const int t = m & (T - 1);
        const bf16* cur = P + (size_t)m * PLD + 1024 + part * 64;
#pragma unroll
        for (int q = 0; q < 8; ++q) { float c[8], p[8]; unpack8(*(const u32x4*)(cur + q * 8), c);
            if (t > 0) unpack8(*(const u32x4*)(cur - PLD + q * 8), p); else {
#pragma unroll
                for (int e = 0; e < 8; ++e) p[e] = 0.f; }
            const f32x4 m0 = *(const f32x4*)(mu + part * 64 + q * 8), m1 = *(const f32x4*)(mu + part * 64 + q * 8 + 4);
#pragma unroll
            for (int e = 0; e < 4; ++e) { c[e] = c[e] + (p[e] - c[e]) * m0[e]; c[4 + e] = c[4 + e] + (p[4 + e] - c[4 + e]) * m1[e]; }
            const u32x4 o = pack8(c);
            if (layer == 0) *(u32x4*)(VF + (size_t)m * 512 + part * 64 + q * 8) = o; else *(LAS u32x4*)(VB + tok * VP + part * 64 + q * 8) = o; }
        if (layer == 0) continue;
        __syncthreads();
        { const int rb = pwave & 3, jt = pwave >> 2; f32x4 acc = {0.f, 0.f, 0.f, 0.f};
#pragma unroll 4
          for (int k0 = 0; k0 < 512; k0 += 32) acc = __builtin_amdgcn_mfma_f32_16x16x32_bf16(*(const LAS bf16x8*)(VB + (16 * rb + r16) * VP + k0 + 8 * q4), *(const bf16x8*)(vdT + (size_t)(16 * jt + r16) * 512 + k0 + 8 * q4), acc, 0, 0, 0);
#pragma unroll
          for (int jj = 0; jj < 4; ++jj) VD[(16 * rb + 4 * q4 + jj) * 40 + 16 * jt + r16] = (bf16)f2bf(acc[jj]); }
        __syncthreads();
        { const int rb = pwave & 3; const bf16x8 af = *(const LAS bf16x8*)(VD + (16 * rb + r16) * 40 + 8 * q4);
#pragma unroll 4
          for (int i = 0; i < 16; ++i) { const int ct = (pwave >> 2) * 16 + i;
              const f32x4 acc = __builtin_amdgcn_mfma_f32_16x16x32_bf16(af, *(const bf16x8*)(vuT + (size_t)(16 * ct + r16) * 32 + 8 * q4), (f32x4){0.f, 0.f, 0.f, 0.f}, 0, 0, 0);
              const float vc = v0[16 * ct + r16];
#pragma unroll
              for (int jj = 0; jj < 4; ++jj) GB[(16 * rb + 4 * q4 + jj) * VP + 16 * ct + r16] = (bf16)f2bf(sigm(vc + acc[jj])); } }
        __syncthreads();
#pragma unroll
        for (int q = 0; q < 8; ++q) { float v[8], g[8], vf[8]; unpack8(*(const LAS u32x4*)(VB + tok * VP + part * 64 + q * 8), v); unpack8(*(const LAS u32x4*)(GB + tok * VP + part * 64 + q * 8), g);
            unpack8(*(const u32x4*)(VF + (size_t)m * 512 + part * 64 + q * 8), vf);
#pragma unroll
            for (int e = 0; e < 8; ++e) v[e] = v[e] + (vf[e] - v[e]) * g[e];
            *(u32x4*)(VM + (size_t)m * 512 + part * 64 + q * 8) = pack8(v); }
        __syncthreads();
    }
}
__device__ __forceinline__ void prepass_a(Frame& F) {
    const int tid = otid();
    bf16* P = (bf16*)(F.ws + WS_BIG); bf16* BND2 = (bf16*)(F.ws + WS_BND2);
    { const int ch = tid & 127; const int kind = ch >> 6, part = ch & 7;
      unsigned fph[4];
#pragma unroll
      for (int p = 0; p < 4; ++p) fph[p] = (unsigned)(long long)(exp(-(double)(part * 4 + p) * (9.210340371976184 / 32.0)) * 0.15915494309189535 * 4294967296.0 + 0.5);
      const int mstep = F.G * 4;
      for (int m0 = F.vcu * 4 + (tid >> 7); m0 < M; m0 += 4 * mstep) {
          u32x4 raw[4];
#pragma unroll
          for (int i = 0; i < 4; ++i) { const int m = m0 + i * mstep; raw[i] = (m < M) ? *(const u32x4*)(P + (size_t)m * PLD + C_RET + ch * 8) : (u32x4){0u, 0u, 0u, 0u}; }
#pragma unroll
          for (int i = 0; i < 4; ++i) { const int m = m0 + i * mstep; if (m >= M) break;
              const int t = m & (T - 1); bf16* ptr = P + (size_t)m * PLD + C_RET + ch * 8;
              float x[8]; unpack8(raw[i], x);
#pragma unroll
              for (int p = 0; p < 4; ++p) { const float rev = (float)((unsigned)t * fph[p]) * 2.3283064365386963e-10f;
                  const float sn = __builtin_amdgcn_sinf(rev), cs = __builtin_amdgcn_cosf(rev);
                  const float x0 = x[2 * p], x1 = x[2 * p + 1]; float o0 = x0 * cs - x1 * sn, o1 = x0 * sn + x1 * cs;
                  if (kind) { o0 *= 0.125f; o1 *= 0.125f; }
                  x[2 * p] = o0; x[2 * p + 1] = o1; }
              *(u32x4*)ptr = pack8(x); } } }
    for (int i = F.vcu * 512 + tid; i < 1024 * 3 * 128; i += F.G * 512) { const int ch = i & 127, k = (i >> 7) % 3, r = i / 384;
        if ((r & 511) != 0) *(u32x4*)(BND2 + ((size_t)r * 3 + k) * 1024 + ch * 8) = *(const u32x4*)(P + ((size_t)r * 32 - 3 + k) * PLD + C_XBC + ch * 8); }
}
__device__ __forceinline__ void prepass_conv(Frame& F, int layer) {
    const int tid = otid();
    bf16* P = (bf16*)(F.ws + WS_BIG); const bf16* BND2 = (const bf16*)(F.ws + WS_BND2);
    const float* cw = INP(17) + layer * 1024 * 4; const float* cbias = INP(18) + layer * 1024;
    const int ch = tid & 127;
    f32x4 wv[8]; float bv[8];
#pragma unroll
    for (int e = 0; e < 8; ++e) { wv[e] = *(const f32x4*)(cw + (ch * 8 + e) * 4); bv[e] = cbias[ch * 8 + e]; }
    for (int r = F.vcu * 4 + (tid >> 7); r < M / 32; r += F.G * 4) {
        float w0[8], w1[8], w2[8];
        if ((r & 511) != 0) { unpack8(*(const u32x4*)(BND2 + ((size_t)r * 3 + 0) * 1024 + ch * 8), w0); unpack8(*(const u32x4*)(BND2 + ((size_t)r * 3 + 1) * 1024 + ch * 8), w1); unpack8(*(const u32x4*)(BND2 + ((size_t)r * 3 + 2) * 1024 + ch * 8), w2); }
        else {
#pragma unroll
            for (int e = 0; e < 8; ++e) { w0[e] = 0.f; w1[e] = 0.f; w2[e] = 0.f; } }
        bf16* ptr = P + (size_t)r * 32 * PLD + C_XBC + ch * 8;
#pragma unroll 4
        for (int i = 0; i < 32; ++i) {
            float x[8], o[8]; unpack8(*(const u32x4*)(ptr + (size_t)i * PLD), x);
#pragma unroll
            for (int e = 0; e < 8; ++e) { o[e] = silu(bv[e] + wv[e][0] * w0[e] + wv[e][1] * w1[e] + wv[e][2] * w2[e] + wv[e][3] * x[e]); w0[e] = w1[e]; w1[e] = w2[e]; w2[e] = x[e]; }
            *(u32x4*)(ptr + (size_t)i * PLD) = pack8(o);
        }
    }
}
template <int CTRL> __device__ __forceinline__ float dpp_f(float v) { return __builtin_bit_cast(float, __builtin_amdgcn_update_dpp(0, __builtin_bit_cast(int, v), CTRL, 0xF, 0xF, true)); }
__device__ __forceinline__ float red8(float v) { v += dpp_f<0xB1>(v); v += dpp_f<0x4E>(v); v += dpp_f<0x141>(v); return v; }
__device__ __forceinline__ float red16(float v) { v = red8(v); v += dpp_f<0x140>(v); return v; }

__device__ __forceinline__ void rwkv_seq(Frame& F, int layer, int bh) {
    const int ptid = otid(), plane = ptid & 63, pwave = __builtin_amdgcn_readfirstlane(ptid >> 6); (void)plane; (void)pwave;
    const int b = bh >> 3, h = bh & 7;
    LAS float* L = (LAS float*)F.lds;
    LAS float *rr = L, *ww = L + 2048, *kf = L + 4096, *vv = L + 6144, *aa = L + 8192, *bb = L + 10240, *gg = L + 12288, *yy = L + 14336, *tw = L + 16384, *xa = L + 18432, *sg = L + 20480, *bon = L + 24576;
    const float* mu = INP(3) + layer * 1792; const float* w_up = INP(4) + layer * 64 * 512; const float* w0 = INP(5) + layer * 512;
    const float* a_up = INP(6) + layer * 64 * 512; const float* a0 = INP(7) + layer * 512; const float* g_up = INP(8) + layer * 128 * 512;
    const float* k_k = INP(9) + layer * 512; const float* k_a = INP(10) + layer * 512; const float* r_k = INP(11) + layer * 512;
    const float* gn_w = INP(12) + layer * 512; const float* gn_b = INP(13) + layer * 512;
    const bf16* P = (const bf16*)(F.ws + WS_BIG); const bf16* vsrc = (const bf16*)(F.ws + (layer == 0 ? WS_VF : WS_VMIX)); bf16* yout = (bf16*)(F.ws + WS_YRW);
    const int tid = ptid, tok = tid >> 4, part = tid & 15, c4 = part * 4, cb = h * 64 + c4;
    const int srow = tid >> 3, sc0 = (tid & 7) * 8;
    float S[8];
#pragma unroll
    for (int j = 0; j < 8; ++j) S[j] = 0.f;
    for (int t0 = 0; t0 < T; t0 += 32) {
        {
            const int t = t0 + tok; const size_t m = (size_t)b * T + t;
            const bf16* cur = P + m * PLD;
#pragma unroll
            for (int q = 0; q < 3; ++q) {
                const int ch = part + 16 * q; int col, kind; LAS float* dst;
                if (ch < 8) { col = h * 64 + ch * 8; dst = rr + tok * 64 + ch * 8; kind = 0; }
                else if (ch < 16) { col = 512 + h * 64 + (ch - 8) * 8; dst = kf + tok * 64 + (ch - 8) * 8; kind = 0; }
                else if (ch < 24) { col = 1536 + (ch - 16) * 8; dst = tw + tok * 64 + (ch - 16) * 8; kind = 1; }
                else if (ch < 32) { col = 1600 + (ch - 24) * 8; dst = xa + tok * 64 + (ch - 24) * 8; kind = 0; }
                else { col = 1664 + (ch - 32) * 8; dst = sg + tok * 128 + (ch - 32) * 8; kind = 2; }
                float c[8], p[8]; unpack8(*(const u32x4*)(cur + col), c);
                if (t > 0) unpack8(*(const u32x4*)(cur - PLD + col), p); else {
#pragma unroll
                    for (int e = 0; e < 8; ++e) p[e] = 0.f; }
#pragma unroll
                for (int e = 0; e < 8; ++e) { float x = c[e] + (p[e] - c[e]) * mu[col + e]; if (kind == 1) x = tanhf(x); else if (kind == 2) x = sigm(x); dst[e] = x; }
            }
            if (part < 8) { float v[8]; unpack8(*(const u32x4*)(vsrc + m * 512 + h * 64 + part * 8), v);
#pragma unroll
                for (int e = 0; e < 8; ++e) vv[tok * 64 + part * 8 + e] = v[e]; }
        }
        __syncthreads();
        {
            f32x4 dw = *(const f32x4*)(w0 + cb), da = *(const f32x4*)(a0 + cb), dg = (f32x4){0.f, 0.f, 0.f, 0.f};
            for (int j = 0; j < 64; ++j) { const float tj = tw[tok * 64 + j], xj = xa[tok * 64 + j];
                dw += *(const f32x4*)(w_up + j * 512 + cb) * tj; da += *(const f32x4*)(a_up + j * 512 + cb) * xj; }
            for (int j = 0; j < 128; ++j) dg += *(const f32x4*)(g_up + j * 512 + cb) * sg[tok * 128 + j];
            float kr[4], kk[4], av[4], ss = 0.f;
#pragma unroll
            for (int e = 0; e < 4; ++e) { kr[e] = kf[tok * 64 + c4 + e]; kk[e] = kr[e] * k_k[cb + e]; ss += kk[e] * kk[e]; av[e] = sigm(da[e]); }
            ss = red16(ss);
            const float inv = __builtin_amdgcn_rsqf(fmaxf(ss, 1e-24f));
            float bs = 0.f;
#pragma unroll
            for (int e = 0; e < 4; ++e) { const float kn = kk[e] * inv; const int o = tok * 64 + c4 + e;
                const float ld = -expf(-softplus_acc(-dw[e]) - 0.5f);
                ww[o] = expf(ld); aa[o] = -kn; bb[o] = kn * av[e];
                const float knew = kr[e] * (1.f + (av[e] - 1.f) * k_a[cb + e]); kf[o] = knew; gg[o] = dg[e];
                bs += rr[o] * knew * r_k[cb + e]; }
            bs = red16(bs);
            if (part == 0) bon[tok] = bs;
        }
        __syncthreads();
        for (int s = 0; s < 32; ++s) {
            const f32x4 a0v = *(const LAS f32x4*)(aa + s * 64 + sc0), a1v = *(const LAS f32x4*)(aa + s * 64 + sc0 + 4);
            const f32x4 w0v = *(const LAS f32x4*)(ww + s * 64 + sc0), w1v = *(const LAS f32x4*)(ww + s * 64 + sc0 + 4);
            const f32x4 b0v = *(const LAS f32x4*)(bb + s * 64 + sc0), b1v = *(const LAS f32x4*)(bb + s * 64 + sc0 + 4);
            const f32x4 k0v = *(const LAS f32x4*)(kf + s * 64 + sc0), k1v = *(const LAS f32x4*)(kf + s * 64 + sc0 + 4);
            const f32x4 r0v = *(const LAS f32x4*)(rr + s * 64 + sc0), r1v = *(const LAS f32x4*)(rr + s * 64 + sc0 + 4);
            const float vi = vv[s * 64 + srow];
            float sa = 0.f;
#pragma unroll
            for (int j = 0; j < 4; ++j) sa += S[j] * a0v[j] + S[4 + j] * a1v[j];
            sa = red8(sa);
            float y = 0.f;
#pragma unroll
            for (int j = 0; j < 4; ++j) { S[j] = S[j] * w0v[j] + sa * b0v[j] + vi * k0v[j]; S[4 + j] = S[4 + j] * w1v[j] + sa * b1v[j] + vi * k1v[j]; y += S[j] * r0v[j] + S[4 + j] * r1v[j]; }
            y = red8(y);
            if ((tid & 7) == 0) yy[s * 64 + srow] = y;
        }
        __syncthreads();
        {
            const size_t m = (size_t)b * T + t0 + tok;
            float y[4], sm = 0.f;
#pragma unroll
            for (int e = 0; e < 4; ++e) { y[e] = yy[tok * 64 + c4 + e]; sm += y[e]; }
            const float mean = red16(sm) * (1.f / 64.f);
            float vs = 0.f;
#pragma unroll
            for (int e = 0; e < 4; ++e) { y[e] -= mean; vs += y[e] * y[e]; }
            const float rs = __builtin_amdgcn_rsqf(red16(vs) * (1.f / 64.f) + 64e-5f);
            const float bo = bon[tok];
            float o[4];
#pragma unroll
            for (int e = 0; e < 4; ++e) { const int idx = tok * 64 + c4 + e; o[e] = (y[e] * rs * gn_w[cb + e] + gn_b[cb + e] + bo * vv[idx]) * gg[idx]; }
            u32x2 w; w.x = pk2(o[0], o[1]); w.y = pk2(o[2], o[3]);
            *(u32x2*)(yout + m * 512 + cb) = w;
        }
        __syncthreads();
    }
}

__device__ __forceinline__ void ret_seq(Frame& F, int bh) {
    const int ptid = otid(), plane = ptid & 63, pwave = __builtin_amdgcn_readfirstlane(ptid >> 6); (void)plane; (void)pwave;
    const int b = bh >> 3, h = bh & 7;
    LAS float* L = (LAS float*)F.lds;
    LAS float *qq = L, *kk = L + 2048, *vv = L + 4096, *gg = L + 6144, *yy = L + 8192;
    bf16* P = (bf16*)(F.ws + WS_BIG);
    const int tid = ptid, tok = tid >> 4, part = tid & 15, c4 = part * 4;
    const int se = tid >> 3, sd0 = (tid & 7) * 8;
    const float gamma = 1.f - exp2f(-5.f - (float)h);
    float S[8];
#pragma unroll
    for (int j = 0; j < 8; ++j) S[j] = 0.f;
    for (int t0 = 0; t0 < T; t0 += 32) {
        {
            const int t = t0 + tok; const size_t m = (size_t)b * T + t;
#pragma unroll
            for (int q = 0; q < 2; ++q) {
                const int ch = part + 16 * q, kind = ch >> 3, cc = ch & 7;
                float x[8]; unpack8(*(const u32x4*)(P + m * PLD + C_RET + kind * 512 + h * 64 + cc * 8), x);
                LAS float* dst = (kind == 0 ? qq : kind == 1 ? kk : kind == 2 ? vv : gg) + tok * 64 + cc * 8;
                if (kind < 2) {
#pragma unroll
                    for (int p = 0; p < 4; ++p) { const int i = cc * 4 + p;
                        const double invf = exp(-(double)i * (9.210340371976184 / 32.0));
                        double sn, cs; sincos((double)t * invf, &sn, &cs);
                        const float x0 = x[2 * p], x1 = x[2 * p + 1], c = (float)cs, s = (float)sn;
                        float o0 = x0 * c - x1 * s, o1 = x0 * s + x1 * c;
                        if (kind == 1) { o0 *= 0.125f; o1 *= 0.125f; }
                        dst[2 * p] = o0; dst[2 * p + 1] = o1; }
                } else {
#pragma unroll
                    for (int e = 0; e < 8; ++e) dst[e] = x[e];
                }
            }
        }
        __syncthreads();
        for (int s = 0; s < 32; ++s) {
            const f32x4 k0v = *(const LAS f32x4*)(kk + s * 64 + sd0), k1v = *(const LAS f32x4*)(kk + s * 64 + sd0 + 4);
            const f32x4 q0v = *(const LAS f32x4*)(qq + s * 64 + sd0), q1v = *(const LAS f32x4*)(qq + s * 64 + sd0 + 4);
            const float ve = vv[s * 64 + se];
            float y = 0.f;
#pragma unroll
            for (int j = 0; j < 4; ++j) { S[j] = gamma * S[j] + k0v[j] * ve; S[4 + j] = gamma * S[4 + j] + k1v[j] * ve; y += q0v[j] * S[j] + q1v[j] * S[4 + j]; }
            y = red8(y);
            if ((tid & 7) == 0) yy[s * 64 + se] = y;
        }
        __syncthreads();
        {
            const size_t m = (size_t)b * T + t0 + tok;
            float y[4], ss = 0.f;
#pragma unroll
            for (int e = 0; e < 4; ++e) { y[e] = yy[tok * 64 + c4 + e]; ss += y[e] * y[e]; }
            const float rs = __builtin_amdgcn_rsqf(red16(ss) * (1.f / 64.f) + 1e-6f);
            float o[4];
#pragma unroll
            for (int e = 0; e < 4; ++e) o[e] = y[e] * rs * silu(gg[tok * 64 + c4 + e]);
            u32x2 w; w.x = pk2(o[0], o[1]); w.y = pk2(o[2], o[3]);
            *(u32x2*)(P + m * PLD + C_RETG + h * 64 + c4) = w;
        }
        __syncthreads();
    }
}

__device__ __forceinline__ void ssd_seq(Frame& F, int layer, int bh) {
    const int ptid = otid(), plane = ptid & 63, pwave = __builtin_amdgcn_readfirstlane(ptid >> 6); (void)plane; (void)pwave;
    const int b = bh >> 3, h = bh & 7, g = h >> 2;
    LAS float* L = (LAS float*)F.lds;
    LAS float *raw = L  , *xs = L + 11200, *Bc = L + 13248, *Cc = L + 17344, *yy = L + 21440, *dts = L + 23488, *das = L + 23520;
    bf16* P = (bf16*)(F.ws + WS_BIG); const float* dtb = (const float*)(F.ws + WS_DT);
    const float* cw = INP(17) + layer * 1024 * 4; const float* cbias = INP(18) + layer * 1024;
    const float dt_bias = INP(19)[layer * 8 + h], A = -expf(INP(20)[layer * 8 + h]), Dh = INP(21)[layer * 8 + h];
    const int tid = ptid;
    const int sp = tid >> 3, sn0 = (tid & 7) * 16;
    float S[16];
#pragma unroll
    for (int j = 0; j < 16; ++j) S[j] = 0.f;
    for (int i = tid; i < 3 * 320; i += 512) raw[i] = 0.f;
    __syncthreads();
    for (int t0 = 0; t0 < T; t0 += 32) {
        for (int idx = tid; idx < 32 * 40; idx += 512) {
            const int row = idx / 40, ch = idx % 40; const size_t m = (size_t)b * T + t0 + row;
            const int col = ch < 8 ? (C_XBC + h * 64 + ch * 8) : (ch < 24 ? (C_XBC + 512 + g * 128 + (ch - 8) * 8) : (C_XBC + 768 + g * 128 + (ch - 24) * 8));
            float x[8]; unpack8(*(const u32x4*)(P + m * PLD + col), x);
#pragma unroll
            for (int e = 0; e < 8; ++e) raw[(3 + row) * 320 + ch * 8 + e] = x[e];
        }
        if (tid < 32) { const size_t m = (size_t)b * T + t0 + tid; const float dt = softplus_acc(dtb[m * 8 + h] + dt_bias); dts[tid] = dt; das[tid] = expf(A * dt); }
        __syncthreads();
        for (int idx = tid; idx < 32 * 320; idx += 512) {
            const int row = idx / 320, c = idx % 320;
            const int chn = c < 64 ? (h * 64 + c) : (c < 192 ? (512 + g * 128 + (c - 64)) : (768 + g * 128 + (c - 192)));
            float a = cbias[chn];
#pragma unroll
            for (int k = 0; k < 4; ++k) a += cw[chn * 4 + k] * raw[(row + k) * 320 + c];
            a = silu(a);
            if (c < 64) xs[row * 64 + c] = a; else if (c < 192) Bc[row * 128 + (c - 64)] = a; else Cc[row * 128 + (c - 192)] = a;
        }
        __syncthreads();
        for (int s = 0; s < 32; ++s) {
            const float da = das[s], xv = xs[s * 64 + sp], dtx = dts[s] * xv;
            float y = 0.f;
#pragma unroll
            for (int q = 0; q < 4; ++q) { const f32x4 bv = *(const LAS f32x4*)(Bc + s * 128 + sn0 + q * 4), cv = *(const LAS f32x4*)(Cc + s * 128 + sn0 + q * 4);
#pragma unroll
                for (int j = 0; j < 4; ++j) { S[q * 4 + j] = da * S[q * 4 + j] + dtx * bv[j]; y += S[q * 4 + j] * cv[j]; } }
            y = red8(y);
            if ((tid & 7) == 0) yy[s * 64 + sp] = y + Dh * xv;
        }
        __syncthreads();
        {
            const int tok = tid >> 4, c4 = (tid & 15) * 4; const size_t m = (size_t)b * T + t0 + tok;
            u32x2 w; w.x = pk2(yy[tok * 64 + c4], yy[tok * 64 + c4 + 1]); w.y = pk2(yy[tok * 64 + c4 + 2], yy[tok * 64 + c4 + 3]);
            *(u32x2*)(P + m * PLD + C_XBC + h * 64 + c4) = w;
            for (int i = tid; i < 3 * 320; i += 512) raw[i] = raw[32 * 320 + i];
        }
        __syncthreads();
    }
}
__device__ __forceinline__ void ssm_norm_phase(Frame& F, int layer) {
    const int ptid = otid(), plane = ptid & 63, pwave = __builtin_amdgcn_readfirstlane(ptid >> 6);
    const int gw = F.vcu * 8 + pwave, NGW = F.G * 8;
    bf16* P = (bf16*)(F.ws + WS_BIG); const float* nw = INP(22) + layer * 512;
    float nwv[8];
#pragma unroll
    for (int e = 0; e < 8; ++e) nwv[e] = nw[plane * 8 + e];
    for (int m0 = 4 * gw; m0 < M; m0 += 4 * NGW) {
        u32x4 yv[4], zv[4];
#pragma unroll
        for (int q = 0; q < 4; ++q) { yv[q] = *(const u32x4*)(P + (size_t)(m0 + q) * PLD + C_XBC + plane * 8); zv[q] = *(const u32x4*)(P + (size_t)(m0 + q) * PLD + C_Z + plane * 8); }
#pragma unroll
        for (int q = 0; q < 4; ++q) { float y[8], z[8]; unpack8(yv[q], y); unpack8(zv[q], z);
            float ss = 0.f;
#pragma unroll
            for (int e = 0; e < 8; ++e) { y[e] *= silu(z[e]); ss += y[e] * y[e]; }
            ss = red16(ss); ss += __shfl_xor(ss, 16);
            const float rs = __builtin_amdgcn_rsqf(ss * (1.f / 256.f) + 1e-6f);
#pragma unroll
            for (int e = 0; e < 8; ++e) y[e] *= rs * nwv[e];
            *(u32x4*)(P + (size_t)(m0 + q) * PLD + C_Z + plane * 8) = pack8(y); }
    }
}
constexpr int PT = 72, PT2 = 136, PF = 68;
__device__ __forceinline__ f32x4 mfma16(bf16x8 a, bf16x8 b, f32x4 c) { return __builtin_amdgcn_mfma_f32_16x16x32_bf16(a, b, c, 0, 0, 0); }
template <int K, bool SA = false, bool SB = false> __device__ __forceinline__ f32x4 mm_ll(const LAS bf16* A, int pa, int m0, const LAS bf16* B, int pb, int n0, f32x4 acc, int lane) {
    const int r = lane & 15, q = lane >> 4;
    const int xa = SA ? (((m0 + r) >> 3) & 7) : 0, xb = SB ? (((n0 + r) >> 3) & 7) : 0;
    const LAS bf16* ap = A + (m0 + r) * pa; const LAS bf16* bp = B + (n0 + r) * pb;
#pragma unroll
    for (int k0 = 0; k0 < K; k0 += 32) acc = mfma16(*(const LAS bf16x8*)(ap + 8 * (((k0 >> 3) + q) ^ xa)), *(const LAS bf16x8*)(bp + 8 * (((k0 >> 3) + q) ^ xb)), acc);
    return acc;
}
template <int K> __device__ __forceinline__ f32x4 mm_lg(const LAS bf16* A, int pa, int m0, const bf16* B, int pb, int n0, f32x4 acc, int lane) {
    const int r = lane & 15, q = lane >> 4;
    const LAS bf16* ap = A + (m0 + r) * pa + 8 * q; const bf16* bp = B + (size_t)(n0 + r) * pb + 8 * q;
#pragma unroll
    for (int k0 = 0; k0 < K; k0 += 32) acc = mfma16(*(const LAS bf16x8*)(ap + k0), *(const bf16x8*)(bp + k0), acc);
    return acc;
}
__device__ __forceinline__ float redl16(float v) { return red16(v); }
__device__ __forceinline__ void st4bf(LAS bf16* p, f32x4 v) { u32x2 w; w.x = pk2(v[0], v[1]); w.y = pk2(v[2], v[3]); *(LAS u32x2*)p = w; }
__device__ __forceinline__ float ldbf(const LAS bf16* p) { return __builtin_bit_cast(float, (unsigned)(*p) << 16); }
constexpr f32x4 FZ4 = {0.f, 0.f, 0.f, 0.f};
__device__ __forceinline__ void tr_write8(LAS bf16* Tm, int pitch, int c0, int t, const float (&v)[8], int) {
    LAS bf16* base = Tm + c0 * pitch + (t ^ (((c0 >> 3) & 7) << 3));
#pragma unroll
    for (int e = 0; e < 8; ++e) base[e * pitch] = (bf16)f2bf(v[e]);
}
__device__ __forceinline__ float tr_at(const LAS bf16* Tm, int pitch, int row, int col) { return __builtin_bit_cast(float, (unsigned)Tm[row * pitch + (col ^ (((row >> 3) & 7) << 3))] << 16); }
__device__ __forceinline__ void ld8f(const LAS float* p, float (&v)[8]) { const f32x4 a = *(const LAS f32x4*)p, b = *(const LAS f32x4*)(p + 4); v[0] = a[0]; v[1] = a[1]; v[2] = a[2]; v[3] = a[3]; v[4] = b[0]; v[5] = b[1]; v[6] = b[2]; v[7] = b[3]; }
__device__ __forceinline__ void st8f(LAS float* p, const float (&v)[8]) { *(LAS f32x4*)p = (f32x4){v[0], v[1], v[2], v[3]}; *(LAS f32x4*)(p + 4) = (f32x4){v[4], v[5], v[6], v[7]}; }

template <bool FINAL>
__device__ __forceinline__ void rwkv_chunk_units(Frame& F, int layer) {
    const int tid = otid(), w = __builtin_amdgcn_readfirstlane(tid >> 6);
    bf16x8 lfr[16];
#define IDS() const int ft = fresh_tid(tid); const int lane = ft & 63, r16 = lane & 15, q4 = lane >> 4, tok = ft >> 3, part = ft & 7; (void)lane; (void)r16; (void)q4; (void)tok; (void)part
    constexpr int NV = FINAL ? 64 : 128, NVT = NV / 16, NZ = NVT / 2;
    constexpr int X_TW = 0, X_XA = 9216, X_SG = 18432, X_KF = 35840, X_RF = 52224;
    constexpr int O_AT = 0, O_RT = 9216, O_BT = 18432, O_KT = 27648, O_BH = 36864, O_KH = 46080, O_VT = 55296, O_TF = O_BT;
    constexpr int Y0 = 68608;
    constexpr int Y_A = Y0, Y_B = Y0 + 8192, Y_K = Y0 + 16384, Y_R = Y0 + 24576, Y_L = Y0 + 32768, Y_VF = Y0 + 49152;
    constexpr int Y_AAB = Y0, Y_AAK = Y0 + 17408, Y_ARB = Y_AAK + 9216, Y_ARK = Y_ARB + 9216, Y_TB = FINAL ? Y_ARK + 9216 : Y_AAK + 9216, Y_ZU = Y_TB + 9216, Y_YF = Y_AAB;
    static_assert(Y_ZU + NV * PT * 2 <= Y0 + 65536, "region Y");
    constexpr int Z0 = Y0 + 65536, Z_G = Z0, Z_S = FINAL ? Z0 + 8192 : Z0, Z_MISC = 152576, Z_BON = Z_MISC, Z_PC = Z_MISC + 256, Z_PAR = Z_MISC + 512, Z_TOT = Z_PAR + 832 * 4, Z_XS = Y_ZU;
    static_assert(Z_S + NV * PT * 2 <= Z_MISC && Z_TOT + 4 * 64 * 4 <= LDSCTL_OFF, "region Z");
    LAS unsigned char* L = F.lds;
#define LB(off) ((LAS bf16*)(L + (off)))
#define LF(off) ((LAS float*)(L + (off)))
    const bf16* P = (const bf16*)(F.ws + WS_BIG); const bf16* vsrc = (const bf16*)(F.ws + (layer == 0 ? WS_VF : WS_VMIX));
    u32x4 pfc[6], pfp[6], pfv;
#define RW_PREFETCH(un, jn) do { IDS(); const int b_ = (un) >> 9, sc_ = ((un) >> 3) & 63, h_ = (un) & 7; const int t_ = sc_ * 256 + (jn) * 64 + tok; const size_t m_ = (size_t)b_ * T + t_; const bf16* cur_ = P + m_ * PLD; \
        _Pragma("unroll") for (int i_ = 0; i_ < 6; ++i_) { const int col_ = (i_ == 0) ? (h_ * 64 + 8 * part) : (i_ == 1) ? (512 + h_ * 64 + 8 * part) : (i_ == 2) ? (1536 + 8 * part) : (i_ == 3) ? (1600 + 8 * part) : (1664 + 8 * part + (i_ - 4) * 64); \
            pfc[i_] = *(const u32x4*)(cur_ + col_); pfp[i_] = (t_ > 0) ? *(const u32x4*)(cur_ - PLD + col_) : (u32x4){0u, 0u, 0u, 0u}; } \
        pfv = *(const u32x4*)(vsrc + m_ * 512 + h_ * 64 + 8 * part); } while (0)
    if (F.cid < 1024) RW_PREFETCH(F.cid, 0);
    int h_staged = -1;
    for (int u = F.cid; u < 1024; u += F.G) {
    const int b = u >> 9, sc = (u >> 3) & 63, h = u & 7;
    if (h != h_staged) { h_staged = h; __syncthreads();
    {
        const int pidx = (w == 0) ? 5 : (w == 1) ? 7 : (w == 2) ? 9 : (w == 3) ? 10 : (w == 4) ? 11 : (w == 5) ? 12 : 13;
        if (w < 7) LF(Z_PAR)[w * 64 + (tid & 63)] = (INP(pidx) + layer * 512 + h * 64)[tid & 63];
        const float* mu = INP(3) + layer * 1792;
        for (int i = tid; i < 384; i += 512) LF(Z_PAR)[448 + i] = mu[(i < 64) ? (h * 64 + i) : (i < 128) ? (512 + h * 64 + (i - 64)) : (1536 + (i - 128))];
    }
    __syncthreads();
    const bf16* WupT = (const bf16*)(F.ws + WS_LORA + (size_t)layer * LORA_STRIDE) + h * 64 * 64;
    const bf16* AupT = (const bf16*)(F.ws + WS_LORA + (size_t)layer * LORA_STRIDE + 65536) + h * 64 * 64;
    const bf16* GupT = (const bf16*)(F.ws + WS_LORA + (size_t)layer * LORA_STRIDE + 131072) + h * 64 * 128;
    { IDS();
        if (w < 4) {
#pragma unroll
            for (int nt = 0; nt < 4; ++nt)
#pragma unroll
                for (int k2 = 0; k2 < 2; ++k2) { lfr[nt * 4 + k2] = *(const bf16x8*)(WupT + (size_t)(16 * nt + r16) * 64 + 32 * k2 + 8 * q4); lfr[nt * 4 + 2 + k2] = *(const bf16x8*)(AupT + (size_t)(16 * nt + r16) * 64 + 32 * k2 + 8 * q4); }
        } else if (FINAL) {
#pragma unroll
            for (int nt = 0; nt < 4; ++nt)
#pragma unroll
                for (int k4 = 0; k4 < 4; ++k4) lfr[nt * 4 + k4] = *(const bf16x8*)(GupT + (size_t)(16 * nt + r16) * 128 + 32 * k4 + 8 * q4);
        } }
    }
    float* Nbuf = (float*)(F.st + 0) + (size_t)u * 4096; bf16* MT = (bf16*)(F.ws + WS_MT) + (size_t)u * 4096;
    constexpr int NST = FINAL ? 2 : 4;
    f32x4 Sacc[NST];
    const int s_vb = FINAL ? (w & 3) : w;
#define S_CT(ti) (FINAL ? (2 * (w >> 2) + (ti)) : (ti))
    { IDS();
#pragma unroll
    for (int ti = 0; ti < NST; ++ti) {
        const int ct = S_CT(ti);
        f32x4 nin = FZ4; if (FINAL) nin = *(const f32x4*)(Nbuf + ((s_vb * 4 + ct) * 64 + 16 * q4 + r16) * 4);
#pragma unroll
        for (int jj = 0; jj < 4; ++jj) { const int v = 16 * s_vb + 4 * q4 + jj, c = 16 * ct + r16;
            float x; if (FINAL) x = nin[jj]; else x = (v >= 64 && v - 64 == c) ? 1.f : 0.f;
            Sacc[ti][jj] = x; LB(Z_S)[v * PT + c] = (bf16)f2bf(x); }
    } }
    for (int j = 0; j < 4; ++j) {
        const int tl0 = sc * 256 + j * 64;
        {
            IDS();
            const int t = tl0 + tok; const size_t m = (size_t)b * T + t; const bf16* cur = P + m * PLD;
#pragma unroll
            for (int i = 0; i < 6; ++i) {
                const int col = (i == 0) ? (h * 64 + 8 * part) : (i == 1) ? (512 + h * 64 + 8 * part) : (i == 2) ? (1536 + 8 * part) : (i == 3) ? (1600 + 8 * part) : (1664 + 8 * part + (i - 4) * 64);
                float c[8], p[8]; unpack8(pfc[i], c); unpack8(pfp[i], p); (void)col;
#pragma unroll
                for (int e = 0; e < 8; ++e) c[e] = c[e] + (p[e] - c[e]) * LF(Z_PAR)[448 + ((i < 4) ? 64 * i : 256 + 64 * (i - 4)) + 8 * part + e];
                if (i == 0) { st8f(LF(X_RF) + tok * 64 + 8 * part, c);
                } else if (i == 1) { st8f(LF(X_KF) + tok * 64 + 8 * part, c);
                } else if (i == 2) {
#pragma unroll
                    for (int e = 0; e < 8; ++e) c[e] = fast_tanh(c[e]);
                    *(LAS u32x4*)(LB(X_TW) + tok * PT + 8 * part) = pack8(c);
                } else if (i == 3) {
                    *(LAS u32x4*)(LB(X_XA) + tok * PT + 8 * part) = pack8(c);
                } else if (FINAL) {
#pragma unroll
                    for (int e = 0; e < 8; ++e) c[e] = sigm(c[e]);
                    *(LAS u32x4*)(LB(X_SG) + tok * PT2 + 8 * part + (i - 4) * 64) = pack8(c);
                }
            }
            float v[8]; unpack8(pfv, v); (void)m; (void)cur;
            st8f(LF(Y_VF) + tok * 64 + 8 * part, v);
        }
        if (j < 3) RW_PREFETCH(u, j + 1); else if (u + F.G < 1024) RW_PREFETCH(u + F.G, 0);
        __syncthreads();
        { IDS();
        if (w < 4) {
            const int rb = w;
            float inv[4], bs[4] = {0.f, 0.f, 0.f, 0.f};
            { float ss[4] = {0.f, 0.f, 0.f, 0.f};
#pragma unroll
                for (int nt = 0; nt < 4; ++nt) { const int c = 16 * nt + r16; const float kkc = LF(Z_PAR)[128 + c];
#pragma unroll
                    for (int jj = 0; jj < 4; ++jj) { const float kk = LF(X_KF)[(16 * rb + 4 * q4 + jj) * 64 + c] * kkc; ss[jj] += kk * kk; } }
#pragma unroll
                for (int jj = 0; jj < 4; ++jj) inv[jj] = __builtin_amdgcn_rsqf(fmaxf(redl16(ss[jj]), 1e-24f)); }
#pragma unroll
            for (int nt = 0; nt < 4; ++nt) {
                f32x4 aw = FZ4, aa = FZ4;
#pragma unroll
                for (int k2 = 0; k2 < 2; ++k2) { aw = mfma16(*(const LAS bf16x8*)(LB(X_TW) + (16 * rb + r16) * PT + 32 * k2 + 8 * q4), lfr[nt * 4 + k2], aw); aa = mfma16(*(const LAS bf16x8*)(LB(X_XA) + (16 * rb + r16) * PT + 32 * k2 + 8 * q4), lfr[nt * 4 + 2 + k2], aa); }
                const int c = 16 * nt + r16; const float w0c = LF(Z_PAR)[c], a0c = LF(Z_PAR)[64 + c], kkc = LF(Z_PAR)[128 + c], kac = LF(Z_PAR)[192 + c], rkc = LF(Z_PAR)[256 + c];
                {
                    float lv[4];
#pragma unroll
                    for (int jj = 0; jj < 4; ++jj) lv[jj] = -0.8750455979f * sigm(w0c + aw[jj]);
                    lv[1] += lv[0]; lv[2] += lv[1]; lv[3] += lv[2];
                    const float s0 = lv[3]; const float u1 = __shfl(s0, (lane + 48) & 63); const float s1 = s0 + ((q4 >= 1) ? u1 : 0.f);
                    const float u2 = __shfl(s1, (lane + 32) & 63); const float s2 = s1 + ((q4 >= 2) ? u2 : 0.f); const float ex = s2 - s0;
#pragma unroll
                    for (int jj = 0; jj < 4; ++jj) LF(Y_L)[(16 * rb + 4 * q4 + jj) * 64 + c] = lv[jj] + ex;
                    if (q4 == 3) LF(Z_TOT)[rb * 64 + c] = lv[3] + ex; }
#pragma unroll
                for (int jj = 0; jj < 4; ++jj) { const int t = 16 * rb + 4 * q4 + jj, o = t * 64 + c;
                    const float al = sigm(a0c + aa[jj]), kraw = LF(X_KF)[o], rr = LF(X_RF)[o], kn = kraw * kkc * inv[jj];
                    const float knew = kraw * (1.f + (al - 1.f) * kac);
                    LB(Y_A)[o] = (bf16)f2bf(-kn); LB(Y_B)[o] = (bf16)f2bf(kn * al); LB(Y_K)[o] = (bf16)f2bf(knew); LB(Y_R)[o] = (bf16)f2bf(rr);
                    bs[jj] += rr * knew * rkc; } }
#pragma unroll
            for (int jj = 0; jj < 4; ++jj) { const float sm = redl16(bs[jj]); if (r16 == 0) LF(Z_BON)[16 * rb + 4 * q4 + jj] = sm; }
        } else if (FINAL) {
            const int rb = w - 4;
#pragma unroll
            for (int nt = 0; nt < 4; ++nt) { f32x4 ag = FZ4;
#pragma unroll
                for (int k4 = 0; k4 < 4; ++k4) ag = mfma16(*(const LAS bf16x8*)(LB(X_SG) + (16 * rb + r16) * PT2 + 32 * k4 + 8 * q4), lfr[nt * 4 + k4], ag);
#pragma unroll
                for (int jj = 0; jj < 4; ++jj) LB(Z_G)[(16 * rb + 4 * q4 + jj) * 64 + 16 * nt + r16] = (bf16)f2bf(ag[jj]); }
        } }
        __syncthreads();
        {
            IDS(); const int t = tok, c0 = 8 * part;
            float Lt[8], Lp[8], Le[8], av[8], bv[8], kv[8], rv[8], vv[8], at[8], rt[8], bt[8], kt[8], bh[8], kh[8];
            { float t0[8], t1[8], t2[8], t3[8], off[8]; ld8f(LF(Z_TOT) + c0, t0); ld8f(LF(Z_TOT) + 64 + c0, t1); ld8f(LF(Z_TOT) + 128 + c0, t2); ld8f(LF(Z_TOT) + 192 + c0, t3);
              ld8f(LF(Y_L) + t * 64 + c0, Lt); ld8f(LF(Y_VF) + t * 64 + c0, vv);
              if ((t & 15) != 0) ld8f(LF(Y_L) + (t - 1) * 64 + c0, Lp); else {
#pragma unroll
                  for (int e = 0; e < 8; ++e) Lp[e] = 0.f; }
              const int rbk = t >> 4;
#pragma unroll
              for (int e = 0; e < 8; ++e) { off[e] = ((rbk > 0) ? t0[e] : 0.f) + ((rbk > 1) ? t1[e] : 0.f) + ((rbk > 2) ? t2[e] : 0.f); Le[e] = (t0[e] + t1[e]) + (t2[e] + t3[e]); Lt[e] += off[e]; Lp[e] += off[e]; }
              if (t == 0) {
#pragma unroll
                  for (int e = 0; e < 8; ++e) LF(Z_PC)[c0 + e] = ex2(Le[e]); } }
            unpack8(*(const LAS u32x4*)(LB(Y_A) + t * 64 + c0), av); unpack8(*(const LAS u32x4*)(LB(Y_B) + t * 64 + c0), bv);
            unpack8(*(const LAS u32x4*)(LB(Y_K) + t * 64 + c0), kv); unpack8(*(const LAS u32x4*)(LB(Y_R) + t * 64 + c0), rv);
#pragma unroll
            for (int e = 0; e < 8; ++e) { const float eL = ex2(Lt[e]), eLm = ex2(Lp[e]), eN = ex2(-Lt[e]), eE = ex2(Le[e] - Lt[e]);
                at[e] = av[e] * eLm; rt[e] = rv[e] * eL; bt[e] = bv[e] * eN; kt[e] = kv[e] * eN; bh[e] = bv[e] * eE; kh[e] = kv[e] * eE; }
            tr_write8(LB(O_BH), PT, c0, t, bh, part); tr_write8(LB(O_KH), PT, c0, t, kh, part); tr_write8(LB(O_VT), PT, c0, t, vv, part);
            *(LAS u32x4*)(LB(O_AT) + t * PT + c0) = pack8(at); *(LAS u32x4*)(LB(O_RT) + t * PT + c0) = pack8(rt);
            *(LAS u32x4*)(LB(O_BT) + t * PT + c0) = pack8(bt); *(LAS u32x4*)(LB(O_KT) + t * PT + c0) = pack8(kt);
        }
        __syncthreads();
        {
            IDS(); const int rb = w & 3;
#pragma unroll
            for (int ci = 0; ci < 2; ++ci) { const int ct = 2 * (w >> 2) + ci;
                f32x4 ab = FZ4, ak = FZ4, arb = FZ4, ark = FZ4;
                if (ct <= rb) { ab = mm_ll<64>(LB(O_AT), PT, 16 * rb, LB(O_BT), PT, 16 * ct, FZ4, lane); ak = mm_ll<64>(LB(O_AT), PT, 16 * rb, LB(O_KT), PT, 16 * ct, FZ4, lane);
                    if (FINAL) { arb = mm_ll<64>(LB(O_RT), PT, 16 * rb, LB(O_BT), PT, 16 * ct, FZ4, lane); ark = mm_ll<64>(LB(O_RT), PT, 16 * rb, LB(O_KT), PT, 16 * ct, FZ4, lane); } }
#pragma unroll
                for (int jj = 0; jj < 4; ++jj) { const int t = 16 * rb + 4 * q4 + jj, i = 16 * ct + r16;
                    LF(Y_AAB)[t * PF + i] = (i < t) ? ab[jj] : 0.f; LB(Y_TB)[t * PT + i] = (bf16)f2bf(((i >> 4) < (t >> 4)) ? ab[jj] : 0.f); LB(Y_AAK)[t * PT + i] = (bf16)f2bf((i < t) ? ak[jj] : 0.f);
                    if (FINAL) { LB(Y_ARB)[t * PT + i] = (bf16)f2bf((i <= t) ? arb[jj] : 0.f); LB(Y_ARK)[t * PT + i] = (bf16)f2bf((i <= t) ? ark[jj] : 0.f); } } }
        }
        __syncthreads();
        {
            IDS(); const int rb = w & 3;
            constexpr int O_DB = O_BT, O_VB = O_BT + 5120;
            if (w == 0) { const int blk = lane >> 4, col = lane & 15; float x[16];
#pragma unroll
                for (int i = 0; i < 16; ++i) x[i] = (i == col) ? 1.f : 0.f;
#pragma unroll
                for (int g3 = 0; g3 < 3; ++g3) {
                    f32x4 ar[5][4];
#pragma unroll
                    for (int ii = 0; ii < 5; ++ii) { const int i = 1 + 5 * g3 + ii;
#pragma unroll
                        for (int g4 = 0; g4 < 4; ++g4) if (4 * g4 < i) ar[ii][g4] = *(const LAS f32x4*)(LF(Y_AAB) + (16 * blk + i) * PF + 16 * blk + 4 * g4); }
                    asm volatile("" ::: "memory");
#pragma unroll
                    for (int ii = 0; ii < 5; ++ii) { const int i = 1 + 5 * g3 + ii; float sacc = 0.f;
#pragma unroll
                        for (int m2 = 0; m2 < i; ++m2) sacc += ar[ii][m2 >> 2][m2 & 3] * x[m2];
                        x[i] += sacc; }
                }
#pragma unroll
                for (int i = 0; i < 16; ++i) LB(O_DB)[(16 * blk + i) * 40 + col] = (bf16)f2bf(x[i]);
                *(LAS u32x4*)(LB(O_DB) + lane * 40 + 16) = (u32x4){0u, 0u, 0u, 0u}; *(LAS u32x4*)(LB(O_DB) + lane * 40 + 24) = (u32x4){0u, 0u, 0u, 0u}; }
            if (lane < 16) { *(LAS u32x4*)(LB(O_VB) + w * 640 + lane * 40 + 16) = (u32x4){0u, 0u, 0u, 0u}; *(LAS u32x4*)(LB(O_VB) + w * 640 + lane * 40 + 24) = (u32x4){0u, 0u, 0u, 0u}; }
#pragma unroll
            for (int ci = 0; ci < NZ; ++ci) { const int vt = (w >> 2) * NZ + ci;
                f32x4 z = mm_ll<64>(LB(O_AT), PT, 16 * rb, LB(Z_S), PT, 16 * vt, FZ4, lane);
                if (vt < 4) z = mm_ll<64, false, true>(LB(Y_AAK), PT, 16 * rb, LB(O_VT), PT, 16 * vt, z, lane);
                st4bf(LB(Y_ZU) + (16 * vt + r16) * PT + 16 * rb + 4 * q4, z); }
            __syncthreads();
            if (w < NVT) { const int vt = w; LAS bf16* vb = LB(O_VB) + w * 640; LAS bf16* zrow = LB(Y_ZU) + (16 * vt + r16) * PT;
#pragma unroll
                for (int bb = 0; bb < 4; ++bb) {
                    f32x4 acc; { const u32x2 zz = *(const LAS u32x2*)(zrow + 16 * bb + 4 * q4); acc[0] = bflo(zz.x); acc[1] = bfhi(zz.x); acc[2] = bflo(zz.y); acc[3] = bfhi(zz.y); }
                    if (bb >= 1) acc = mfma16(*(const LAS bf16x8*)(LB(Y_TB) + (16 * bb + r16) * PT + 8 * q4), *(const LAS bf16x8*)(zrow + 8 * q4), acc);
                    if (bb >= 3) acc = mfma16(*(const LAS bf16x8*)(LB(Y_TB) + (16 * bb + r16) * PT + 32 + 8 * q4), *(const LAS bf16x8*)(zrow + 32 + 8 * q4), acc);
                    st4bf(vb + r16 * 40 + 4 * q4, acc);
                    const f32x4 ub = mfma16(*(const LAS bf16x8*)(LB(O_DB) + (16 * bb + r16) * 40 + 8 * q4), *(const LAS bf16x8*)(vb + r16 * 40 + 8 * q4), FZ4);
                    st4bf(zrow + 16 * bb + 4 * q4, ub); }
            }
        }
        __syncthreads();
        {
            IDS(); f32x4 yy[2];
            if (FINAL) { const int rb = w & 3;
#pragma unroll
                for (int ci = 0; ci < 2; ++ci) { const int ct = 2 * (w >> 2) + ci;
                    f32x4 y = mm_ll<64>(LB(O_RT), PT, 16 * rb, LB(Z_S), PT, 16 * ct, FZ4, lane);
                    y = mm_ll<64>(LB(Y_ARB), PT, 16 * rb, LB(Y_ZU), PT, 16 * ct, y, lane);
                    yy[ci] = mm_ll<64, false, true>(LB(Y_ARK), PT, 16 * rb, LB(O_VT), PT, 16 * ct, y, lane); } }
#pragma unroll
            for (int ti = 0; ti < NST; ++ti) { const int ct = S_CT(ti); const float pc = LF(Z_PC)[16 * ct + r16];
                f32x4 s = Sacc[ti] * pc;
                s = mm_ll<64, false, true>(LB(Y_ZU), PT, 16 * s_vb, LB(O_BH), PT, 16 * ct, s, lane);
                if (s_vb < 4) s = mm_ll<64, true, true>(LB(O_VT), PT, 16 * s_vb, LB(O_KH), PT, 16 * ct, s, lane);
                Sacc[ti] = s; }
            __syncthreads();
#pragma unroll
            for (int ti = 0; ti < NST; ++ti) { const int ct = S_CT(ti);
#pragma unroll
                for (int jj = 0; jj < 4; ++jj) LB(Z_S)[(16 * s_vb + 4 * q4 + jj) * PT + 16 * ct + r16] = (bf16)f2bf(Sacc[ti][jj]); }
            if (FINAL) { const int rb = w & 3;
#pragma unroll
                for (int ci = 0; ci < 2; ++ci) { const int ct = 2 * (w >> 2) + ci;
#pragma unroll
                    for (int jj = 0; jj < 4; ++jj) LF(Y_YF)[(16 * rb + 4 * q4 + jj) * PF + 16 * ct + r16] = yy[ci][jj]; } }
        }
        __syncthreads();
        if (FINAL) {
            IDS();
            const int t = tok, c0 = 8 * part; const size_t m = (size_t)b * T + tl0 + t;
            float y[8], gg[8], sm = 0.f; ld8f(LF(Y_YF) + t * PF + c0, y); unpack8(*(const LAS u32x4*)(LB(Z_G) + t * 64 + c0), gg);
#pragma unroll
            for (int e = 0; e < 8; ++e) sm += y[e];
            const float mean = red8(sm) * (1.f / 64.f); float vs = 0.f;
#pragma unroll
            for (int e = 0; e < 8; ++e) { y[e] -= mean; vs += y[e] * y[e]; }
            const float rs = __builtin_amdgcn_rsqf(red8(vs) * (1.f / 64.f) + 64e-5f), bo = LF(Z_BON)[t];
#pragma unroll
            for (int e = 0; e < 8; ++e) { const int c = c0 + e; y[e] = (y[e] * rs * LF(Z_PAR)[320 + c] + LF(Z_PAR)[384 + c] + bo * tr_at(LB(O_VT), PT, c, t)) * gg[e]; }
            *(u32x4*)((bf16*)(F.ws + WS_BIG) + m * PLD + 1024 + h * 64 + c0) = pack8(y);
        }
        __syncthreads();
    }
    if (!FINAL) { IDS();
#pragma unroll
        for (int ti = 0; ti < NST; ++ti) { const int ct = S_CT(ti);
            if (s_vb < 4) { *(f32x4*)(Nbuf + ((s_vb * 4 + ct) * 64 + 16 * q4 + r16) * 4) = Sacc[ti];
            } else { u32x2 wv; wv.x = pk2(Sacc[ti][0], Sacc[ti][1]); wv.y = pk2(Sacc[ti][2], Sacc[ti][3]);
                *(u32x2*)(MT + (16 * ct + r16) * 64 + 16 * (s_vb - 4) + 4 * q4) = wv; }
        }
    }
    }
#undef RW_PREFETCH
#undef IDS
#undef S_CT
#undef LB
#undef LF
}

template <bool FINAL>
__device__ __forceinline__ void ret_chunk_unit(Frame& F, int u) {
    const int tid = otid(), lane = tid & 63, w = __builtin_amdgcn_readfirstlane(tid >> 6), r16 = lane & 15, q4 = lane >> 4;
    const int b = u >> 9, sc = (u >> 3) & 63, h = u & 7;
    constexpr int R_QB = 0, R_KB = 9216, R_KHT = 18432, R_VT = 27648, R_GB = 36864, R_AB = 45056, R_SB = 54272, R_YF = 63488;
    LAS unsigned char* L = F.lds;
#define LB(off) ((LAS bf16*)(L + (off)))
#define LF(off) ((LAS float*)(L + (off)))
    bf16* P = (bf16*)(F.ws + WS_BIG);
    float* Sbuf = (float*)(F.st + 16 * MiB) + (size_t)u * 4096;
    const float lg = log2f(1.f - exp2f(-5.f - (float)h));
    const float g64 = ex2(64.f * lg);
    const int db = w & 3;
    f32x4 Sacc[2];
#pragma unroll
    for (int ci = 0; ci < 2; ++ci) { const int et = 2 * (w >> 2) + ci;
#pragma unroll
        for (int jj = 0; jj < 4; ++jj) Sacc[ci][jj] = FINAL ? Sbuf[(16 * db + 4 * q4 + jj) * 64 + 16 * et + r16] : 0.f;
        if (FINAL) st4bf(LB(R_SB) + (16 * et + r16) * PT + 16 * db + 4 * q4, Sacc[ci]); }
    const int tok = tid >> 3, part = tid & 7;
    u32x4 pq = {0u, 0u, 0u, 0u}, pk, pv, pg = {0u, 0u, 0u, 0u};
#define RET_PREFETCH(jn) do { const bf16* row_ = P + ((size_t)b * T + sc * 256 + (jn) * 64 + tok) * PLD + C_RET + h * 64 + 8 * part; \
        pk = *(const u32x4*)(row_ + 512); pv = *(const u32x4*)(row_ + 1024); if (FINAL) { pq = *(const u32x4*)row_; pg = *(const u32x4*)(row_ + 1536); } } while (0)
    RET_PREFETCH(0);
    for (int j = 0; j < 4; ++j) {
        const int tl0 = sc * 256 + j * 64;
        {
            float qv[8], kv[8], vv[8]; unpack8(pk, kv); unpack8(pv, vv);
            if (FINAL) { unpack8(pq, qv); *(LAS u32x4*)(LB(R_GB) + tok * 64 + 8 * part) = pg; }
            if (j < 3) RET_PREFETCH(j + 1);
            const float zeta = ex2((float)(63 - tok) * lg);
            if (FINAL) { *(LAS u32x4*)(LB(R_QB) + tok * PT + 8 * part) = pack8(qv); *(LAS u32x4*)(LB(R_KB) + tok * PT + 8 * part) = pack8(kv); }
            float kz[8];
#pragma unroll
            for (int e = 0; e < 8; ++e) kz[e] = kv[e] * zeta;
            tr_write8(LB(R_KHT), PT, 8 * part, tok, kz, part); tr_write8(LB(R_VT), PT, 8 * part, tok, vv, part);
        }
        __syncthreads();
        if (FINAL) { const int rb = w & 3;
#pragma unroll
            for (int ci = 0; ci < 2; ++ci) { const int ct = 2 * (w >> 2) + ci; f32x4 a = FZ4;
                if (ct <= rb) a = mm_ll<64>(LB(R_QB), PT, 16 * rb, LB(R_KB), PT, 16 * ct, FZ4, lane);
#pragma unroll
                for (int jj = 0; jj < 4; ++jj) { const int l = 16 * rb + 4 * q4 + jj, s = 16 * ct + r16; LB(R_AB)[l * PT + s] = (bf16)f2bf((s <= l) ? a[jj] * ex2((float)(l - s) * lg) : 0.f); } }
            __syncthreads();
        }
        {
            f32x4 yy[2];
            if (FINAL) { const int rb = w & 3;
#pragma unroll
                for (int ci = 0; ci < 2; ++ci) { const int et = 2 * (w >> 2) + ci;
                    const f32x4 a1 = mm_ll<64, false, true>(LB(R_AB), PT, 16 * rb, LB(R_VT), PT, 16 * et, FZ4, lane), a2 = mm_ll<64>(LB(R_QB), PT, 16 * rb, LB(R_SB), PT, 16 * et, FZ4, lane);
#pragma unroll
                    for (int jj = 0; jj < 4; ++jj) yy[ci][jj] = a1[jj] + ex2((float)(16 * rb + 4 * q4 + jj + 1) * lg) * a2[jj]; } }
#pragma unroll
            for (int ci = 0; ci < 2; ++ci) { const int et = 2 * (w >> 2) + ci; Sacc[ci] = mm_ll<64, true, true>(LB(R_KHT), PT, 16 * db, LB(R_VT), PT, 16 * et, Sacc[ci] * g64, lane); }
            __syncthreads();
            if (FINAL) { const int rb = w & 3;
#pragma unroll
                for (int ci = 0; ci < 2; ++ci) { const int et = 2 * (w >> 2) + ci; st4bf(LB(R_SB) + (16 * et + r16) * PT + 16 * db + 4 * q4, Sacc[ci]);
#pragma unroll
                    for (int jj = 0; jj < 4; ++jj) LF(R_YF)[(16 * rb + 4 * q4 + jj) * PF + 16 * et + r16] = yy[ci][jj]; } }
        }
        __syncthreads();
        if (FINAL) { const size_t m = (size_t)b * T + tl0 + tok; float y[8], g[8], ss = 0.f;
            ld8f(LF(R_YF) + tok * PF + 8 * part, y);
#pragma unroll
            for (int e = 0; e < 8; ++e) ss += y[e] * y[e];
            const float rs = __builtin_amdgcn_rsqf(red8(ss) * (1.f / 64.f) + 1e-6f);
            unpack8(*(const LAS u32x4*)(LB(R_GB) + tok * 64 + 8 * part), g);
#pragma unroll
            for (int e = 0; e < 8; ++e) y[e] = y[e] * rs * silu(g[e]);
            *(u32x4*)(P + m * PLD + C_RETG + h * 64 + 8 * part) = pack8(y);
            __syncthreads(); }
    }
    if (!FINAL) {
#pragma unroll
        for (int ci = 0; ci < 2; ++ci) { const int et = 2 * (w >> 2) + ci;
#pragma unroll
            for (int jj = 0; jj < 4; ++jj) Sbuf[(16 * db + 4 * q4 + jj) * 64 + 16 * et + r16] = Sacc[ci][jj]; }
    }
#undef RET_PREFETCH
#undef LB
#undef LF
}

template <bool FINAL>
__device__ __forceinline__ void ssd_chunk_unit(Frame& F, int layer, int u) {
    const int tid = otid(), w = __builtin_amdgcn_readfirstlane(tid >> 6);
#define IDS() const int ft = fresh_tid(tid); const int lane = ft & 63, r16 = lane & 15, q4 = lane >> 4; (void)lane; (void)r16; (void)q4
    const int b = u >> 9, sc = (u >> 3) & 63, h = u & 7, g = h >> 2;
    constexpr int D_CB = 0, D_BB = 17408, D_BT = 34816, D_YF = 53248, D_XT = 70656, D_XDT = 79872, D_GM = 89088, D_SB = 98304, D_MISC = 115712;
    constexpr int D_DTS = D_MISC, D_ACS = D_MISC + 256, D_CAR = D_MISC + 512;
    LAS unsigned char* L = F.lds;
#define LB(off) ((LAS bf16*)(L + (off)))
#define LF(off) ((LAS float*)(L + (off)))
    bf16* P = (bf16*)(F.ws + WS_BIG); const float* dtb = (const float*)(F.ws + WS_DT);
    const bf16* BND = (const bf16*)(F.ws + WS_BND);
    float* Sbuf = (float*)(F.st + 32 * MiB) + (size_t)u * 8192;
    const float* cw = INP(17) + layer * 1024 * 4; const float* cbias = INP(18) + layer * 1024;
    const float dt_bias = INP(19)[layer * 8 + h], A = -expf(INP(20)[layer * 8 + h]), Dh = INP(21)[layer * 8 + h];
    const int bc_chunk = tid & 31, bc_chn = (bc_chunk < 16) ? (512 + g * 128 + bc_chunk * 8) : (768 + g * 128 + (bc_chunk - 16) * 8);
    const int x_chunk = tid & 7, x_chn = h * 64 + x_chunk * 8;
    const int pb = w & 3;
    f32x4 Sacc[4];
    { IDS();
#pragma unroll
    for (int ci = 0; ci < 4; ++ci) { const int nt = 4 * (w >> 2) + ci;
#pragma unroll
        for (int jj = 0; jj < 4; ++jj) { const float x = FINAL ? Sbuf[(16 * pb + 4 * q4 + jj) * 128 + 16 * nt + r16] : 0.f; Sacc[ci][jj] = x;
            if (FINAL) LB(D_SB)[(16 * pb + 4 * q4 + jj) * PT2 + 16 * nt + r16] = (bf16)f2bf(x); } } }
    float dstot = 0.f;
    u32x4 pbc[4], px; float pdt = 0.f;
#define SSD_PREFETCH(jn) do { const size_t m_ = (size_t)b * T + sc * 256 + (jn) * 64; \
        _Pragma("unroll") for (int it_ = 0; it_ < 4; ++it_) pbc[it_] = *(const u32x4*)(P + (m_ + it_ * 16 + (tid >> 5)) * PLD + C_XBC + bc_chn); \
        px = *(const u32x4*)(P + (m_ + (tid >> 3)) * PLD + C_XBC + x_chn); if (w == 0) pdt = dtb[(m_ + (tid & 63)) * 8 + h]; } while (0)
    SSD_PREFETCH(0);
    for (int j = 0; j < 4; ++j) {
        const int tl0 = sc * 256 + j * 64; const size_t m0 = (size_t)b * T + tl0;
        if (w == 0) {
            IDS(); const float dt = softplus_acc(pdt + dt_bias); float a = A * dt;
#pragma unroll
            for (int o = 1; o < 64; o <<= 1) { const float n = __shfl_up(a, o); if (lane >= o) a += n; }
            LF(D_DTS)[lane] = dt; LF(D_ACS)[lane] = a;
        }
        {
            IDS();
#pragma unroll
            for (int it = 0; it < 4; ++it) { const int t = it * 16 + (ft >> 5); const int ta = tl0 + t;
                float acc[8]; unpack8(pbc[it], acc); (void)ta;
                if (bc_chunk < 16) { *(LAS u32x4*)(LB(D_BB) + t * PT2 + bc_chunk * 8) = pack8(acc); tr_write8(LB(D_BT), PT, bc_chunk * 8, t, acc, bc_chunk & 7); }
                else *(LAS u32x4*)(LB(D_CB) + t * PT2 + (bc_chunk - 16) * 8) = pack8(acc);
            }
        }
        __syncthreads();
        {
            IDS(); const int t = ft >> 3; float acc[8]; unpack8(px, acc);
            if (j < 3) SSD_PREFETCH(j + 1);
            const float sc_d = LF(D_DTS)[t] * __expf(LF(D_ACS)[63] - LF(D_ACS)[t]);
            float xs8[8], xd8[8];
#pragma unroll
            for (int e = 0; e < 8; ++e) { xs8[e] = acc[e]; xd8[e] = acc[e] * sc_d; }
            tr_write8(LB(D_XT), PT, x_chunk * 8, t, xs8, x_chunk); tr_write8(LB(D_XDT), PT, x_chunk * 8, t, xd8, x_chunk);
        }
        if (FINAL) { IDS(); const int rb = w & 3;
#pragma unroll
            for (int ci = 0; ci < 2; ++ci) { const int ct = 2 * (w >> 2) + ci; f32x4 a = FZ4;
                if (ct <= rb) a = mm_ll<128>(LB(D_CB), PT2, 16 * rb, LB(D_BB), PT2, 16 * ct, FZ4, lane);
#pragma unroll
                for (int jj = 0; jj < 4; ++jj) { const int l = 16 * rb + 4 * q4 + jj, s = 16 * ct + r16;
                    LB(D_GM)[l * PT + s] = (bf16)f2bf((s <= l) ? a[jj] * __expf(LF(D_ACS)[l] - LF(D_ACS)[s]) * LF(D_DTS)[s] : 0.f); } } }
        __syncthreads();
        {
            IDS(); f32x4 yy[2];
            if (FINAL) { const int rb = w & 3;
#pragma unroll
                for (int ci = 0; ci < 2; ++ci) { const int pt = 2 * (w >> 2) + ci;
                    const f32x4 a1 = mm_ll<64, false, true>(LB(D_GM), PT, 16 * rb, LB(D_XT), PT, 16 * pt, FZ4, lane), a2 = mm_ll<128>(LB(D_CB), PT2, 16 * rb, LB(D_SB), PT2, 16 * pt, FZ4, lane);
#pragma unroll
                    for (int jj = 0; jj < 4; ++jj) { const int l = 16 * rb + 4 * q4 + jj, p = 16 * pt + r16; yy[ci][jj] = a1[jj] + __expf(LF(D_ACS)[l]) * a2[jj] + Dh * tr_at(LB(D_XT), PT, p, l); } } }
            const float dec = expf(LF(D_ACS)[63]);
#pragma unroll
            for (int ci = 0; ci < 4; ++ci) { const int nt = 4 * (w >> 2) + ci; Sacc[ci] = mm_ll<64, true, true>(LB(D_XDT), PT, 16 * pb, LB(D_BT), PT, 16 * nt, Sacc[ci] * dec, lane); }
            dstot += LF(D_ACS)[63];
            __syncthreads();
            if (FINAL) { const int rb = w & 3;
#pragma unroll
                for (int ci = 0; ci < 4; ++ci) { const int nt = 4 * (w >> 2) + ci;
#pragma unroll
                    for (int jj = 0; jj < 4; ++jj) LB(D_SB)[(16 * pb + 4 * q4 + jj) * PT2 + 16 * nt + r16] = (bf16)f2bf(Sacc[ci][jj]); }
#pragma unroll
                for (int ci = 0; ci < 2; ++ci) { const int pt = 2 * (w >> 2) + ci;
#pragma unroll
                    for (int jj = 0; jj < 4; ++jj) LF(D_YF)[(16 * rb + 4 * q4 + jj) * PF + 16 * pt + r16] = yy[ci][jj]; } }
        }
        __syncthreads();
        if (FINAL) { IDS(); const int tok = ft >> 3, part = ft & 7; float y[8];
            ld8f(LF(D_YF) + tok * PF + 8 * part, y);
            *(u32x4*)(P + (m0 + tok) * PLD + C_XBC + h * 64 + 8 * part) = pack8(y);
            __syncthreads(); }
    }
    if (!FINAL) { IDS();
#pragma unroll
        for (int ci = 0; ci < 4; ++ci) { const int nt = 4 * (w >> 2) + ci;
#pragma unroll
            for (int jj = 0; jj < 4; ++jj) Sbuf[(16 * pb + 4 * q4 + jj) * 128 + 16 * nt + r16] = Sacc[ci][jj]; }
        if (tid == 0) ((float*)(F.ws + WS_DSTOT))[u] = dstot;
    }
#undef SSD_PREFETCH
#undef IDS
#undef LB
#undef LF
}

#define LBAR() do { asm volatile("s_waitcnt lgkmcnt(0)" ::: "memory"); __builtin_amdgcn_s_barrier(); asm volatile("" ::: "memory"); } while (0)
__device__ __forceinline__ void rwkv_scan_chain(Frame& F, int chain) {
    const int tid = otid(), lane = tid & 63, w = __builtin_amdgcn_readfirstlane(tid >> 6), r16 = lane & 15, q4 = lane >> 4;
    const int b = chain >> 3, h = chain & 7, vb = w & 3, ct0 = 2 * (w >> 2);
    LAS bf16* SB = (LAS bf16*)F.lds;
    f32x4 Sacc[2] = {FZ4, FZ4};
    for (int i = tid; i < 64 * PT / 2; i += 512) ((LAS unsigned*)SB)[i] = 0u;
    f32x4 nv[4][2]; bf16x8 mf[4][2][2];
#define CH_FETCH(s_, sc_) do { const int u_ = (b * 64 + (sc_)) * 8 + h; \
        const float* Nb_ = (const float*)(F.st + 0) + (size_t)u_ * 4096; const bf16* MT_ = (const bf16*)(F.ws + WS_MT) + (size_t)u_ * 4096; \
        _Pragma("unroll") for (int ci = 0; ci < 2; ++ci) { \
            nv[s_][ci] = *(const f32x4*)(Nb_ + ((vb * 4 + ct0 + ci) * 64 + lane) * 4); \
            _Pragma("unroll") for (int k2 = 0; k2 < 2; ++k2) mf[s_][ci][k2] = *(const bf16x8*)(MT_ + (size_t)(16 * (ct0 + ci) + r16) * 64 + 32 * k2 + 8 * q4); } } while (0)
    CH_FETCH(0, 0); CH_FETCH(1, 1); CH_FETCH(2, 2); CH_FETCH(3, 3);
    LBAR();
    for (int sc0 = 0; sc0 < 64; sc0 += 4) {
#pragma unroll
        for (int s = 0; s < 4; ++s) {
            const int sc = sc0 + s, u = (b * 64 + sc) * 8 + h;
            float* Nb = (float*)(F.st + 0) + (size_t)u * 4096;
            f32x4 nw[2];
#pragma unroll
            for (int ci = 0; ci < 2; ++ci) {
                f32x4 a = nv[s][ci];
#pragma unroll
                for (int k2 = 0; k2 < 2; ++k2) a = mfma16(*(const LAS bf16x8*)(SB + (16 * vb + r16) * PT + 32 * k2 + 8 * q4), mf[s][ci][k2], a);
                nw[ci] = a;
                *(f32x4*)(Nb + ((vb * 4 + ct0 + ci) * 64 + lane) * 4) = Sacc[ci]; }
            CH_FETCH(s, (sc + 4 < 64) ? sc + 4 : 63);
            LBAR();
#pragma unroll
            for (int ci = 0; ci < 2; ++ci) { Sacc[ci] = nw[ci];
#pragma unroll
                for (int jj = 0; jj < 4; ++jj) SB[(16 * vb + 4 * q4 + jj) * PT + 16 * (ct0 + ci) + r16] = (bf16)f2bf(nw[ci][jj]); }
            LBAR();
        }
    }
#undef CH_FETCH
    __syncthreads();
}
template <int ESZ, bool SSD> __device__ __forceinline__ void elem_scan_item(float* p, const float* d, float g256) {
    float carry = 0.f;
    for (int s0 = 0; s0 < 64; s0 += 32) {
        float t[32], dec[32];
#pragma unroll
        for (int sc = 0; sc < 32; ++sc) t[sc] = p[(size_t)(s0 + sc) * 8 * ESZ];
        if (SSD) {
#pragma unroll
            for (int sc = 0; sc < 32; ++sc) dec[sc] = d[(s0 + sc) * 8];
        }
#pragma unroll
        for (int sc = 0; sc < 32; ++sc) { p[(size_t)(s0 + sc) * 8 * ESZ] = carry; carry = (SSD ? __expf(dec[sc]) : g256) * carry + t[sc]; }
    }
}
__device__ __forceinline__ void elem_scans(Frame& F, int blk, int nblk) {
    const int tid = otid();
    const int NRET = 16 * 4096, NSSD = 16 * 8192;
    const float* dst = (const float*)(F.ws + WS_DSTOT);
    for (int it = blk * 512 + tid; it < NRET + NSSD; it += nblk * 512) {
        if (it < NRET) { const int chain = it >> 12, e = it & 4095, b = chain >> 3, h = chain & 7;
            const float g256 = exp2f(256.f * log2f(1.f - exp2f(-5.f - (float)h)));
            elem_scan_item<4096, false>((float*)(F.st + 16 * MiB) + ((size_t)(b * 64) * 8 + h) * 4096 + e, nullptr, g256);
        } else { const int i2 = it - NRET, chain = i2 >> 13, e = i2 & 8191, b = chain >> 3, h = chain & 7;
            elem_scan_item<8192, true>((float*)(F.st + 32 * MiB) + ((size_t)(b * 64) * 8 + h) * 8192 + e, dst + (b * 64) * 8 + h, 0.f);
        }
    }
}
__device__ __forceinline__ void conv_lora(Frame& F) {
    const int tid = otid();
    for (int l = 0; l < 2; ++l) {
        bf16* base = (bf16*)(F.ws + WS_LORA + (size_t)l * LORA_STRIDE);
        const float* wu = INP(4) + l * 64 * 512; const float* au = INP(6) + l * 64 * 512; const float* gu = INP(8) + l * 128 * 512;
        for (int i = F.vcu * 512 + tid; i < 512 * 64; i += F.G * 512) { const int c = i >> 6, jx = i & 63; base[i] = (bf16)f2bf(wu[jx * 512 + c]); base[32768 + i] = (bf16)f2bf(au[jx * 512 + c]); }
        for (int i = F.vcu * 512 + tid; i < 512 * 128; i += F.G * 512) { const int c = i >> 7, jx = i & 127; base[65536 + i] = (bf16)f2bf(gu[jx * 512 + c]); }
    }
}
__device__ __forceinline__ void conv_vlora(Frame& F) {
    const int tid = otid();
    bf16* vdT = (bf16*)(F.ws + WS_VLORA); bf16* vuT = vdT + 32 * 512;
    const float* vdn = INP(14); const float* vup = INP(15);
    for (int i = F.vcu * 512 + tid; i < 32 * 512; i += F.G * 512) { const int j = i >> 9, c = i & 511; vdT[i] = (bf16)f2bf(vdn[c * 32 + j]); }
    for (int i = F.vcu * 512 + tid; i < 512 * 32; i += F.G * 512) { const int c = i >> 5, j = i & 31; vuT[i] = (bf16)f2bf(vup[j * 512 + c]); }
}
__device__ __forceinline__ void save_bnd(Frame& F) {
    const int tid = otid();
    const bf16* P = (const bf16*)(F.ws + WS_BIG); bf16* BND = (bf16*)(F.ws + WS_BND);
    for (int i = F.vcu * 512 + tid; i < 2 * 64 * 3 * 64; i += F.G * 512) { const int ch = i & 63, k = (i >> 6) % 3, bs = i / 192, b = bs >> 6, sc = bs & 63;
        if (sc > 0) *(u32x4*)(BND + (size_t)(bs * 3 + k) * 512 + ch * 8) = *(const u32x4*)(P + ((size_t)b * T + sc * 256 - 3 + k) * PLD + C_XBC + ch * 8); }
}

__device__ __forceinline__ void stagger(int cid) { const int dly = __builtin_amdgcn_readfirstlane((cid >> 3) & 7); for (int i = 0; i < dly; ++i) __builtin_amdgcn_s_sleep(16); }
constexpr int LAYER_BASE0 = 1, LAYER_STRIDE = 18, MOE_BASE = LAYER_BASE0 + LAYER_STRIDE + 15;
__device__ __forceinline__ Frame lf(const Frame& F0) {
    Frame F = F0; unsigned l = (unsigned)(unsigned long long)F.lds;
    asm volatile("" : "+s"(l), "+s"(F.vcu), "+s"(F.G), "+s"(F.cid), "+s"(F.wid), "+s"(F.out), "+s"(F.ws), "+s"(F.st));
    F.lds = (LAS unsigned char*)(unsigned long long)l; return F;
}
__global__ void __launch_bounds__(512, 2) fwd(Args args) {
    extern __shared__ __attribute__((aligned(16))) unsigned char lds_raw[];
    Frame F0;
    F0.lds = (LAS unsigned char*)lds_raw;
    F0.G = gridDim.x; { const int bx = blockIdx.x; F0.vcu = (F0.G % 8 == 0) ? (bx % 8) * (F0.G / 8) + bx / 8 : bx; }
    F0.rr = 0; F0.cid = blockIdx.x; F0.out = (GAS float*)args.out; F0.ws = (GAS unsigned char*)args.ws; F0.wid = __builtin_amdgcn_readfirstlane(threadIdx.x >> 6); F0.st = (GAS unsigned char*)args.ws + WS_XB;
    volatile LAS unsigned* MISC = (volatile LAS unsigned*)(F0.lds + MISC_OFF);
    for (int u = threadIdx.x; u < (LDS_BYTES - LDSCTL_OFF) / 4; u += 512) ((LAS unsigned*)(F0.lds + LDSCTL_OFF))[u] = 0u;
    __syncthreads();
    if (threadIdx.x < 34) *(LAS unsigned long long*)(F0.lds + LDSCTL_OFF + 8 * threadIdx.x) = (unsigned long long)args.in[threadIdx.x];
    __syncthreads();
    const int lo = args.ph_lo, hi = args.ph_hi;
    XcdBarrier bar; bar.bar = (unsigned*)(F0.ws + WS_CTL); bar.x = 0; bar.st = nullptr;
    if (hi - lo > 1) bar = xcd_barrier_post((unsigned*)(F0.ws + WS_CTL), MISC + 8);
#define IN(k) (lo <= (k) && (k) < hi)
#define SEAM(k) do { if (IN(k) && IN((k) + 1)) xcd_barrier(bar); } while (0)
#define WSP(T_, off) ((T_*)(F.ws + (off)))

    if (IN(0)) { Frame F = lf(F0); conv_layer_weights(F, 0, 0); conv_lora(F); conv_vlora(F); xprep_phase(F, INP(0)); }
    SEAM(0);
    for (int l = 0; l < 2; ++l) {
        const int pb = LAYER_BASE0 + l * LAYER_STRIDE;
        F0.st = (GAS unsigned char*)F0.out;
        if (IN(pb + 0)) {
            Frame F = lf(F0); unsigned char* wl = (unsigned char*)(F.ws + WS_W + (size_t)l * WL_STRIDE);
            pg8::Gemm g{WSP(bf16, WS_XB), (const bf16*)(wl + WL_IN), D, D, D}; pg8::StaticOrder S; S.init(M, NP, F.G, F.cid, D, D);
            pg8::EpiInProj E{WSP(bf16, WS_BIG), (l == 0) ? WSP(float, WS_RSTD) : WSP(float, WS_SS1), WSP(float, WS_DT), l};
            stagger(F.cid); pg8::gemm_phase(F.lds, F.wid, g, S, E);
        }
        SEAM(pb + 0);
        if (IN(pb + 1)) { Frame F = lf(F0); vprep_phase(F, l); prepass_a(F); }
        SEAM(pb + 1);
        if (IN(pb + 2)) { Frame F = lf(F0); prepass_conv(F, l); }
        if (IN(pb + 2) && IN(pb + 3)) xcd_barrier(bar);
        if (IN(pb + 3)) for (int rep = 0; rep <= REP_R1; ++rep) {
#if RW_CH
            for (int r2 = 0; r2 <= REP_RW; ++r2) { Frame F = lf(F0); rwkv_chunk_units<false>(F, l); }
#else
            { Frame F = lf(F0); if (F.cid < 16) rwkv_seq(F, l, F.cid); }
#endif
#if RET_CH
            for (int r2 = 0; r2 <= REP_RET; ++r2) { Frame F = lf(F0); for (int u = F.cid; u < 1024; u += F.G) ret_chunk_unit<false>(F, u); }
#else
            { Frame F = lf(F0); if (F.cid >= 32 && F.cid < 48) ret_seq(F, F.cid - 32); }
#endif
#if SSD_CH
            for (int r2 = 0; r2 <= REP_SSD; ++r2) { Frame F = lf(F0); for (int u = F.cid; u < 1024; u += F.G) ssd_chunk_unit<false>(F, l, u); }
#else
            { Frame F = lf(F0); if (F.cid >= 16 && F.cid < 32) ssd_seq(F, l, F.cid - 16); }
#endif
        }
        SEAM(pb + 3);
        if (IN(pb + 4)) { Frame F = lf(F0); elem_scans(F, F.cid, F.G); }
        SEAM(pb + 4);
        if (IN(pb + 5)) {
            Frame F = lf(F0);
            if (F.cid < 16) { if (RW_CH) rwkv_scan_chain(F, F.cid);
                for (int u = 960 + F.cid; u < 1024; u += 16) ret_chunk_unit<true>(F, u);
                for (int u = 960 + F.cid; u < 1024; u += 16) ssd_chunk_unit<true>(F, l, u); }
            else {
                Frame Fc = lf(F0); Fc.vcu = Fc.cid - 16; Fc.cid = Fc.cid - 16; Fc.G = Fc.G - 16;
                if (l == 0) { conv_layer_weights(Fc, 0, 1); conv_layer_weights(Fc, 1, 0); conv_layer_weights(Fc, 1, 1); conv_ffn_weights(Fc); conv_moe_weights(Fc, 0, 3); }
                else conv_moe_weights(Fc, 3, NE);
                __syncthreads();
                for (int u = Fc.cid; u < 960; u += Fc.G) ret_chunk_unit<true>(Fc, u);
                for (int u = Fc.cid; u < 960; u += Fc.G) ssd_chunk_unit<true>(Fc, l, u);
            }
        }
        if (IN(pb + 5)) xcd_barrier(bar);
        if (IN(pb + 5)) { Frame F = lf(F0); rwkv_chunk_units<true>(F, l); }
        SEAM(pb + 5);
        if (IN(pb + 6)) { Frame F = lf(F0); ssm_norm_phase(F, l); }
        SEAM(pb + 6);
        if (IN(pb + 7)) {
            Frame F = lf(F0); unsigned char* wl = (unsigned char*)(F.ws + WS_W + (size_t)l * WL_STRIDE); bf16* P = WSP(bf16, WS_BIG);
            pg8::Gemm g{P, (const bf16*)(wl + WL_BR), PLD, 512, 512}; pg8::BranchOrder S; S.init(F.G, F.cid);
            pg8::EpiPlain E{P, WSP(bf16, WS_VMIX)};
            stagger(F.cid); pg8::gemm_phase(F.lds, F.wid, g, S, E);
        }
        SEAM(pb + 7);
        if (IN(pb + 8)) {
            Frame F = lf(F0); unsigned char* wl = (unsigned char*)(F.ws + WS_W + (size_t)l * WL_STRIDE); bf16* P = WSP(bf16, WS_BIG);
            pg8::Gemm g{WSP(bf16, WS_XB), (const bf16*)(wl + WL_GATE), D, D, D}; pg8::GateOrder S; S.init(F.G, F.cid);
            pg8::EpiGateMerge E{P, WSP(const bf16, WS_VMIX), P + C_RET, PLD, (l == 0) ? WSP(float, WS_RSTD) : WSP(float, WS_SS1), l};
            stagger(F.cid); pg8::gemm_phase(F.lds, F.wid, g, S, E);
        }
        if (IN(pb + 8) && IN(pb + 13)) xcd_barrier(bar);
        if (IN(pb + 13)) {
            Frame F = lf(F0); unsigned char* wl = (unsigned char*)(F.ws + WS_W + (size_t)l * WL_STRIDE); bf16* P = WSP(bf16, WS_BIG);
            pg8::Gemm g{P + C_RET, (const bf16*)(wl + WL_OUT), PLD, D, D}; pg8::StaticOrder S; S.init(M, D, F.G, F.cid, PLD, D);
            pg8::EpiResidB E{WSP(bf16, WS_XB), (l == 0) ? WSP(float, WS_SS2) : nullptr, nullptr};
            stagger(F.cid); pg8::gemm_phase(F.lds, F.wid, g, S, E);
        }
        SEAM(pb + 13);
        if (IN(pb + 14)) { Frame F = lf(F0); if (l == 1) router_phase(F); }
        if (l == 1) SEAM(pb + 14);
        if (l == 0) {
            if (IN(pb + 15)) {
                Frame F = lf(F0);
                pg8::Gemm g{WSP(bf16, WS_XB), WSP(const bf16, WS_FFUP), D, D, D}; pg8::StaticOrder S; S.init(M, 2 * FF, F.G, F.cid, D, D);
                pg8::EpiSwiglu E{WSP(bf16, WS_ACT), FF, WSP(float, WS_SS2), 1};
                stagger(F.cid); pg8::gemm_phase(F.lds, F.wid, g, S, E);
            }
            SEAM(pb + 15);
            if (IN(pb + 16)) {
                Frame F = lf(F0);
                pg8::Gemm g{WSP(const bf16, WS_ACT), WSP(const bf16, WS_FFDN), FF, FF, FF}; pg8::StaticOrder S; S.init(M, D, F.G, F.cid, FF, FF);
                pg8::EpiResidB E{WSP(bf16, WS_XB), WSP(float, WS_SS1), nullptr};
                stagger(F.cid); pg8::gemm_phase(F.lds, F.wid, g, S, E);
            }
            if (IN(pb + 16) && IN(pb + 18)) xcd_barrier(bar);
        }
    }
    {
        const int pb = MOE_BASE;
        for (int st = 0; st < 6; ++st) {
            const int isup = (st == 0 || st == 2 || st == 3), sg = (st < 2) ? 0 : ((st == 2 || st == 4) ? 1 : 2);
            if (IN(pb + st)) {
                if (isup) {
                    Frame F = lf(F0);
                    unsigned char* wb = (unsigned char*)F.out + MOEW_OUT; const size_t b6 = (size_t)((unsigned char*)(F.ws + WS_FFUP) - wb), b7 = (size_t)((unsigned char*)(F.ws + WS_VF + 16 * MiB) - wb);
                    pg8::Gemm g{WSP(bf16, WS_X8), (const bf16*)wb, D / 2, D / 2, D / 2}; pg8::MoeOrder<true> S; S.init(WSP(const int, WS_CNT), WSP(const int, WS_LIST), sg, 2 * FFE, F.G, F.cid, D / 2, D / 2, MOEW_STRIDE, b6, b7);
                    pg8::EpiSwiglu8 E{(sg == 2) ? WSP(unsigned char, WS_ACT2) : WSP(unsigned char, WS_ACT), FFE};
                    stagger(F.cid); pg8::gemm_phase<pg8::EpiSwiglu8, pg8::MoeOrder<true>, true>(F.lds, F.wid, g, S, E);
                } else {
                    Frame F = lf(F0);
                    const int ksp = (sg == 2) ? MOE_KSP : 1;
                    unsigned char* wb = (unsigned char*)F.out + MOEW_OUT; const size_t b6 = (size_t)((unsigned char*)(F.ws + WS_FFUP) - wb), b7 = (size_t)((unsigned char*)(F.ws + WS_VF + 16 * MiB) - wb);
                    pg8::Gemm g{(sg == 2) ? WSP(const bf16, WS_ACT2) : WSP(const bf16, WS_ACT), (const bf16*)(wb + MOEW_DN), FFE / 2, FFE / 2, FFE / 2 / ksp}; pg8::MoeOrder<false> S; S.init(WSP(const int, WS_CNT), WSP(const int, WS_LIST), sg, D, F.G, F.cid, FFE / 2, FFE / 2, MOEW_STRIDE, b6, b7, ksp, FFE / 2 / ksp);
                    pg8::EpiMoeOut E{(sg == 0) ? WSP(bf16, WS_YP0) : (sg == 1 ? WSP(bf16, WS_YP1) : WSP(bf16, WS_YP2)), YP2_STRIDE / 2, 1.f / 1024.f};
                    stagger(F.cid); pg8::gemm_phase<pg8::EpiMoeOut, pg8::MoeOrder<false>, true>(F.lds, F.wid, g, S, E);
                }
            }
            SEAM(pb + st);
        }
        if (IN(pb + 6)) { Frame F = lf(F0); final_norm_phase(F); }
    }
#undef IN
#undef SEAM
#undef WSP
}
constexpr int LAST_PHASE = MOE_BASE + 6;
constexpr int N_PH = LAST_PHASE + 1;

extern "C" void kernel_launch(void* const* d_in, const int* in_sizes, int n_in, void* d_out, int out_size, void* d_ws, size_t ws_size, hipStream_t stream) {
    static int grid = 0;
    if (grid == 0) {
        if (n_in != 34 || out_size != M * D || ws_size < WS_END) { fprintf(stderr, "kernel_launch: unexpected problem (n_in %d out %d ws %zu need %zu)\n", n_in, out_size, ws_size, (size_t)WS_END); grid = -1; return; }
        int dev = 0, cus = 0;
        if (hipGetDevice(&dev) != hipSuccess || hipDeviceGetAttribute(&cus, hipDeviceAttributeMultiprocessorCount, dev) != hipSuccess) { grid = -1; return; }
        if (hipFuncSetAttribute((const void*)fwd, hipFuncAttributeMaxDynamicSharedMemorySize, LDS_BYTES) != hipSuccess) { fprintf(stderr, "kernel_launch: hipFuncSetAttribute failed\n"); grid = -1; return; }
        int per_cu = 0;
        if (hipOccupancyMaxActiveBlocksPerMultiprocessor(&per_cu, (const void*)fwd, 512, LDS_BYTES) != hipSuccess || per_cu < 1) fprintf(stderr, "kernel_launch: occupancy query says %d\n", per_cu);
        (void)hipGetLastError();
        grid = cus;
    }
    if (grid < 0) return;
    (void)hipMemsetAsync((char*)d_ws + WS_CTL, 0, CTL_ZERO_BYTES, stream);
    Args a{};
    for (int i = 0; i < 34; ++i) a.in[i] = (const float*)d_in[i];
    a.out = (float*)d_out; a.ws = (unsigned char*)d_ws;
#if MK_ONE_LAUNCH
    a.ph_lo = 0; a.ph_hi = N_PH;
    hipLaunchKernelGGL(fwd, dim3(grid), dim3(512), LDS_BYTES, stream, a);
#else
    for (int p = 0; p < N_PH; ++p) { a.ph_lo = p; a.ph_hi = p + 1; hipLaunchKernelGGL(fwd, dim3(grid), dim3(512), LDS_BYTES, stream, a); }
#endif
}
```

```cpp
#include <hip/hip_runtime.h>
#include <cstdio>
#include <cstdint>

#ifndef MK_ONE_LAUNCH
#define MK_ONE_LAUNCH 1
#endif

#define LAS __attribute__((address_space(3)))
#define GAS __attribute__((address_space(1)))
typedef unsigned short bf16;
typedef short bf16x8 __attribute__((ext_vector_type(8)));
typedef float f32x4 __attribute__((ext_vector_type(4)));
typedef float f32x2 __attribute__((ext_vector_type(2)));
typedef unsigned u32x4 __attribute__((ext_vector_type(4)));
typedef unsigned u32x2 __attribute__((ext_vector_type(2)));

constexpr int BATCH = 2, T = 16384, D = 1024, M = BATCH * T;
constexpr int INC = 8456;
constexpr int PLD = 5376;
constexpr int NP = 5632;
constexpr int C_RW = 0, C_Z = 1792, C_XBC = 2304, C_RET = 3328, C_RETG = 4864;
constexpr int FF = 2816, FFE = 3584, NE = 8;

constexpr size_t MiB = 1u << 20;
constexpr size_t WS_CTL = 0, CTL_ZERO_BYTES = 64 * 1024;
constexpr size_t WS_RSTD = 1 * MiB, WS_GATES = 2 * MiB, WS_DT = 3 * MiB;
constexpr size_t WS_W = 4 * MiB;
constexpr size_t WL_IN = 0, WL_GATE = 11 * MiB, WL_BR = 17 * MiB, WL_OUT = 20 * MiB, WL_STRIDE = 22 * MiB;
constexpr size_t WS_FFUP = WS_W + 44 * MiB, WS_FFDN = WS_W + 55 * MiB;
constexpr size_t WS_XB = 68 * MiB;
constexpr size_t WS_VF = 132 * MiB;
constexpr size_t WS_BIG = 164 * MiB;
constexpr size_t WS_VMIX = WS_BIG + 336 * MiB, WS_YRW = WS_BIG + 368 * MiB, WS_END = 577 * MiB;
constexpr size_t WS_MOEW_UNUSED = WS_BIG;
constexpr size_t MOEW_STRIDE = 21 * MiB / 2, MOEW_DN = 7 * MiB;
constexpr size_t MOEW_OUT = 64 * MiB;
constexpr size_t WS_X8 = WS_BIG + 88 * MiB;
constexpr int MOE_KSP = 2;
constexpr size_t WS_ACT = WS_BIG + 168 * MiB;

constexpr size_t WS_YP0 = WS_BIG, WS_YP1 = WS_BIG + 280 * MiB, WS_YP2 = 556 * MiB, YP2_STRIDE = 4 * MiB, WS_PINFO = 572 * MiB, WS_ACT2 = 132 * MiB;
constexpr size_t WS_CNT = 32768, WS_LIST = 2 * MiB;
constexpr size_t WS_BND2 = 566 * MiB;
constexpr size_t WS_VLORA = 192 * 1024;
constexpr size_t WS_SS1 = 573 * MiB, WS_SS2 = 575 * MiB;
constexpr size_t WS_DSTOT = 128 * 1024, WS_BND = 256 * 1024;
constexpr size_t WS_LORA = 1 * MiB + 512 * 1024, LORA_STRIDE = 262144;
constexpr size_t WS_ST_RW = WS_XB, WS_ST_RET = WS_XB + 16 * MiB, WS_ST_SSD = WS_XB + 32 * MiB, WS_MT = WS_YRW;
constexpr int RING_BYTES = 131072, LDSCTL_OFF = 159744, MISC_OFF = LDSCTL_OFF + 320, LDS_BYTES = 163840;
#ifndef REP_CONV
#define REP_CONV 0
#endif
#ifndef REP_R1
#define REP_R1 0
#endif
#ifndef REP_RW
#define REP_RW 0
#endif
#ifndef REP_RET
#define REP_RET 0
#endif
#ifndef REP_SSD
#define REP_SSD 0
#endif
#ifndef REP_MISC
#define REP_MISC 0
#endif
#ifndef RW_CH
#define RW_CH 1
#endif
#ifndef RET_CH
#define RET_CH 1
#endif
#ifndef SSD_CH
#define SSD_CH 1
#endif

typedef __bf16 hbf16x2 __attribute__((ext_vector_type(2)));
__device__ __forceinline__ unsigned pk2(float lo, float hi) { const f32x2 v = {lo, hi}; return __builtin_bit_cast(unsigned, __builtin_convertvector(v, hbf16x2)); }
__device__ __forceinline__ unsigned f2bf(float f) { return (unsigned)__builtin_bit_cast(unsigned short, (__bf16)f); }
__device__ __forceinline__ float bflo(unsigned u) { return __builtin_bit_cast(float, u << 16); }
__device__ __forceinline__ float bfhi(unsigned u) { return __builtin_bit_cast(float, u & 0xffff0000u); }
__device__ __forceinline__ void unpack8(const u32x4 u, float (&f)[8]) { f[0] = bflo(u.x); f[1] = bfhi(u.x); f[2] = bflo(u.y); f[3] = bfhi(u.y); f[4] = bflo(u.z); f[5] = bfhi(u.z); f[6] = bflo(u.w); f[7] = bfhi(u.w); }
__device__ __forceinline__ unsigned pk4f8(float a, float b, float c, float d) {
    a = __builtin_amdgcn_fmed3f(a, -448.f, 448.f); b = __builtin_amdgcn_fmed3f(b, -448.f, 448.f); c = __builtin_amdgcn_fmed3f(c, -448.f, 448.f); d = __builtin_amdgcn_fmed3f(d, -448.f, 448.f);
    int w = __builtin_amdgcn_cvt_pk_fp8_f32(a, b, 0, false); w = __builtin_amdgcn_cvt_pk_fp8_f32(c, d, w, true); return (unsigned)w; }
__device__ __forceinline__ u32x4 pack8(const float (&f)[8]) { u32x4 w; w.x = pk2(f[0], f[1]); w.y = pk2(f[2], f[3]); w.z = pk2(f[4], f[5]); w.w = pk2(f[6], f[7]); return w; }
__device__ __forceinline__ float sigm(float x) { return __builtin_amdgcn_rcpf(1.f + __expf(-x)); }
__device__ __forceinline__ float silu(float x) { return x * __builtin_amdgcn_rcpf(1.f + __expf(-x)); }
__device__ __forceinline__ float ex2(float x) { return __builtin_amdgcn_exp2f(x); }
__device__ __forceinline__ float fast_tanh(float x) { return 1.f - 2.f * __builtin_amdgcn_rcpf(1.f + __expf(2.f * x)); }
__device__ __forceinline__ float softplus_acc(float x) { return fmaxf(x, 0.f) + log1pf(expf(-fabsf(x))); }
__device__ __forceinline__ float wave_sum(float v) {
#pragma unroll
    for (int o = 1; o < 64; o <<= 1) v += __shfl_xor(v, o);
    return v;
}
__device__ __forceinline__ int otid_w(int wid) { unsigned z = 0u; asm volatile("" : "+v"(z)); int t = wid * 64 + (int)__builtin_amdgcn_mbcnt_hi(~0u, __builtin_amdgcn_mbcnt_lo(~0u, z)); asm volatile("" : "+v"(t)); return t; }
#define otid() otid_w(F.wid)
__device__ __forceinline__ int fresh_tid(int t) { asm volatile("" : "+v"(t)); return t; }
#define LDS_WAIT() asm volatile("s_waitcnt lgkmcnt(0)" ::: "memory")

namespace pg8 {
constexpr int BM = 256, BK = 64, HALF = 128, HTB = HALF * BK * 2, STAGE_BYTES = 8 * HTB, NXCD = 8, WGM = 8;
__host__ __device__ __forceinline__ int lds_byte(int r, int c) { const int st = (r >> 4) * 2 + (c >> 5), rr = r & 15, cc = c & 31, ob = rr * 64 + cc * 2; return st * 1024 + (ob ^ (((ob >> 9) & 1) << 5)); }
__host__ __device__ __forceinline__ void stage_rc(int b, int& R, int& C) { const int st = b / 1024, sb = b % 1024, swz = sb ^ (((sb >> 9) & 1) << 5); R = (st >> 1) * 16 + swz / 64; C = (st & 1) * 32 + (swz % 64) / 2; }
__host__ __device__ __forceinline__ int perm32(int rho) { const int n = rho >> 4, i = rho & 15; return 8 * (i >> 2) + 4 * n + (i & 3); }

typedef int i32x4v __attribute__((ext_vector_type(4)));
struct Unit { int pm, pn; size_t aofs, bofs; const int* rows; int nvalid, e, ks; };
struct Gemm { const bf16* A; const bf16* Bt; int lda, ldb, K; };

struct StaticOrder {
    static constexpr bool GATHER = false;
    int nM, nN, nwg, G, c; size_t tsA, tsB;
    __device__ __forceinline__ void init(int Mrows, int N, int G_, int c_, int lda, int ldb) { nM = Mrows / BM; nN = N / BM; nwg = nM * nN; G = G_; c = c_; tsA = (size_t)BM * lda * 2; tsB = (size_t)BM * ldb * 2; }
    __device__ __forceinline__ void tile(int L, int& pm, int& pn) const {
        int wgid = L; { const int q = nwg / NXCD, r = nwg % NXCD, xcd = wgid % NXCD, off = wgid / NXCD; wgid = (xcd < r ? xcd * (q + 1) : r * (q + 1) + (xcd - r) * q) + off; }
        const int nig = WGM * nN, gid = wgid / nig, fm = gid * WGM, gsz = (nM - fm) < WGM ? (nM - fm) : WGM;
        pm = fm + ((wgid % nig) % gsz); pn = (wgid % nig) / gsz;
    }
    __device__ __forceinline__ bool next(int i, Unit& u) const {
        const long L = (long)i * G + c; if (L >= nwg) return false;
        tile((int)L, u.pm, u.pn); u.aofs = (size_t)u.pm * tsA; u.bofs = (size_t)u.pn * tsB; u.rows = nullptr; u.nvalid = BM; u.e = 0; u.ks = 0; return true;
    }
};
struct BranchOrder {
    static constexpr bool GATHER = false;
    StaticOrder so;
    __device__ __forceinline__ void init(int G_, int c_) { so.init(M, D, G_, c_, PLD, 512); }
    __device__ __forceinline__ bool next(int j, Unit& u) const {
        const long L = (long)j * so.G + so.c; if (L >= 3 * so.nwg) return false;
        const int i = (int)(L / so.nwg); so.tile((int)(L % so.nwg), u.pm, u.pn);
        const int acol = (i == 0) ? 1024 : (i == 1 ? C_Z : C_RETG);
        u.aofs = (size_t)u.pm * so.tsA + (size_t)acol * 2; u.bofs = ((size_t)i * D + (size_t)u.pn * BM) * 512 * 2; u.rows = nullptr; u.nvalid = BM; u.e = i; u.ks = 0; return true;
    }
};
struct GateOrder {
    static constexpr bool GATHER = false;
    StaticOrder so;
    __device__ __forceinline__ void init(int G_, int c_) { so.init(M, D, G_, c_, D, D); }
    __device__ __forceinline__ bool next(int j, Unit& u) const {
        const long tt = (long)(j / 3) * so.G + so.c; if (tt >= so.nwg) return false;
        const int i = j % 3; so.tile((int)tt, u.pm, u.pn);
        u.aofs = (size_t)u.pm * so.tsA; u.bofs = ((size_t)i * D + (size_t)u.pn * BM) * D * 2; u.rows = nullptr; u.nvalid = BM; u.e = i; u.ks = 0; return true;
    }
};
template <bool GATH> struct MoeOrder {
    static constexpr bool GATHER = GATH;
    unsigned q0, q1, q2, q3;
    int seg, nN, G, c, ksplit; const int* list; size_t bstride, b6, b7, tsB, tsA, kbytes;
    __device__ __forceinline__ void init(const int* counts, const int* list_, int seg_, int N, int G_, int c_, int lda, int ldb, size_t bstride_, size_t b6_, size_t b7_, int ksplit_ = 1, int kpart = 0) {
        unsigned n[8];
#pragma unroll
        for (int e = 0; e < 8; ++e) { int v = __builtin_amdgcn_readfirstlane(counts[e]); v = v < 0 ? 0 : (v > 32768 ? 32768 : v); n[e] = (unsigned)v; }
        q0 = n[0] | (n[1] << 16); q1 = n[2] | (n[3] << 16); q2 = n[4] | (n[5] << 16); q3 = n[6] | (n[7] << 16);
        seg = seg_; nN = N / BM; G = G_; c = c_; list = list_; bstride = bstride_; b6 = b6_; b7 = b7_; tsB = (size_t)BM * ldb * 2; tsA = (size_t)BM * lda * 2; ksplit = ksplit_; kbytes = (size_t)kpart * 2;
    }
    __device__ __forceinline__ bool next(int i, Unit& u) const {
        const unsigned L0 = (unsigned)i * (unsigned)G + (unsigned)c; const unsigned L = L0 / (unsigned)ksplit; const int ks = (int)(L0 - L * (unsigned)ksplit); const int tl = (int)(L / (unsigned)nN), pn = (int)(L - (unsigned)tl * (unsigned)nN), gt = seg * 128 + tl;
        int t = 0, e = 0, tbe = 0, cne = 0;
#pragma unroll
        for (int k = 0; k < 8; ++k) { const unsigned q = (k < 2) ? q0 : (k < 4) ? q1 : (k < 6) ? q2 : q3; const int n = (int)((k & 1) ? (q >> 16) : (q & 0xffffu));
            if (gt >= t) { e = k; tbe = t; cne = n; } t += (n + 255) >> 8; }
        int nt = t - seg * 128; nt = nt < 0 ? 0 : (nt > 128 ? 128 : nt);
        if (L >= (unsigned)(nt * nN)) return false;
        const int rt = gt - tbe;
        u.pm = tl; u.pn = pn; u.e = e; u.ks = ks; u.bofs = (e < 6 ? (size_t)e * bstride : (e == 6 ? b6 : b7)) + (size_t)pn * tsB + ks * kbytes; u.aofs = (GATH ? 0 : (size_t)tl * tsA) + ks * kbytes;
        u.rows = list + ((size_t)e * 32768 + rt * 256) * 2; int nv = cne - rt * 256; u.nvalid = nv > 256 ? 256 : nv; return true;
    }
};

template <class Epi, class Sched, bool F8 = false>
__device__ __forceinline__ void gemm_phase(LAS unsigned char* lds, int wid0, const Gemm g, const Sched& S, const Epi& E) {
    constexpr bool GATHER = Sched::GATHER;
    const int tid = otid_w(wid0), wid = __builtin_amdgcn_readfirstlane(tid >> 6), lane = tid & 63, wr = wid >> 2, wc = wid & 3, fr = lane & 15, fq = lane >> 4;
    const int nt = g.K / BK;
    unsigned voffA[2], voffB[2];
#pragma unroll
    for (int i = 0; i < 2; ++i) { int R, C; stage_rc(tid * 16 + i * 8192, R, C); const int Rb = Epi::PERM ? ((R & ~31) + perm32(R & 31)) : R;
        voffA[i] = (unsigned)(R * g.lda + C) * 2u; voffB[i] = (unsigned)(Rb * g.ldb + C) * 2u; }
    const size_t kstep = (size_t)(BK * 2);
    const size_t hstepA = GATHER ? 0 : (size_t)HALF * g.lda * 2, hstepB = (size_t)HALF * g.ldb * 2;
    const unsigned ldsw = (unsigned)wid * 1024u;
    const int aoff = lds_byte(wr * 64 + fr, fq * 8), boff = lds_byte(wc * 32 + fr, fq * 8);
#define PG8_SA(b, h) (((b) * 2 + (h)) * HTB)
#define PG8_SB(b, h) ((4 + (b) * 2 + (h)) * HTB)
#define PG8_STAGE2(bufoff, gbase, o0, o1) do { \
        __builtin_amdgcn_global_load_lds((const unsigned*)((const char*)(gbase) + (o0)), (LAS unsigned*)(lds + (bufoff) + ldsw), 16, 0, 0); \
        __builtin_amdgcn_global_load_lds((const unsigned*)((const char*)(gbase) + (o1)), (LAS unsigned*)(lds + (bufoff) + ldsw + 8192), 16, 0, 0); } while (0)
#define PG8_STAGE(bufoff, gbase, voff) PG8_STAGE2(bufoff, gbase, (voff)[0], (voff)[1])
#define PG8_LDA(dst, b, h) do { _Pragma("unroll") for (int m = 0; m < 4; ++m) _Pragma("unroll") for (int k = 0; k < 2; ++k) dst[m][k] = *(const LAS bf16x8*)(lds + PG8_SA(b, h) + aoff + m * 2048 + k * 1024); } while (0)
#define PG8_LDB(dst, b, h) do { _Pragma("unroll") for (int n = 0; n < 2; ++n) _Pragma("unroll") for (int k = 0; k < 2; ++k) dst[n][k] = *(const LAS bf16x8*)(lds + PG8_SB(b, h) + boff + n * 2048 + k * 1024); } while (0)
#define PG8_CAT(x) __builtin_shufflevector(__builtin_bit_cast(i32x4v, (x)[0]), __builtin_bit_cast(i32x4v, (x)[1]), 0, 1, 2, 3, 4, 5, 6, 7)
#define PG8_MMA(ai, bj, At, Bt) do { __builtin_amdgcn_s_setprio(1); if constexpr (F8) { _Pragma("unroll") for (int m = 0; m < 4; ++m) _Pragma("unroll") for (int n = 0; n < 2; ++n) \
        asm volatile("v_mfma_f32_16x16x128_f8f6f4 %0, %1, %2, %0" : "+v"(acc[ai][bj][m][n]) : "v"(PG8_CAT(Bt[n])), "v"(PG8_CAT(At[m]))); } else { \
        _Pragma("unroll") for (int m = 0; m < 4; ++m) _Pragma("unroll") for (int n = 0; n < 2; ++n) _Pragma("unroll") for (int k = 0; k < 2; ++k) \
        acc[ai][bj][m][n] = Epi::TRANS ? __builtin_amdgcn_mfma_f32_16x16x32_bf16(Bt[n][k], At[m][k], acc[ai][bj][m][n], 0, 0, 0) : __builtin_amdgcn_mfma_f32_16x16x32_bf16(At[m][k], Bt[n][k], acc[ai][bj][m][n], 0, 0, 0); } __builtin_amdgcn_s_setprio(0); } while (0)
#define PG8_WAIT_V(n) asm volatile("s_waitcnt vmcnt(" #n ")" ::: "memory")
#define PG8_WAIT_L(n) asm volatile("s_waitcnt lgkmcnt(" #n ")" ::: "memory")
#define PG8_BAR __builtin_amdgcn_s_barrier()
#define PG8_SCHED __builtin_amdgcn_sched_barrier(0)
#define GSLOT(which) ((LAS u32x4*)(lds + 131072 + (which) * 8192 + tid * 16))
#define PG8_ROWS(u, which) do { const int _ft = fresh_tid(tid); unsigned _vg[2][2]; _Pragma("unroll") for (int _i = 0; _i < 2; ++_i) { int _R, _C; stage_rc(_ft * 16 + _i * 8192, _R, _C); \
        _Pragma("unroll") for (int _h = 0; _h < 2; ++_h) { const int _r = _h * HALF + _R; \
        const int _t = (_r < (u).nvalid) ? (u).rows[2 * _r] : 0; _vg[_h][_i] = ((unsigned)_t * (unsigned)g.lda + (unsigned)_C) * 2u; } } \
        u32x4 _o; _o.x = _vg[0][0]; _o.y = _vg[0][1]; _o.z = _vg[1][0]; _o.w = _vg[1][1]; *GSLOT(which) = _o; } while (0)
    Unit cur, nxt; int ui = 0;
    if (!S.next(0, cur)) return;
    f32x4 acc[2][2][4][2];
#pragma unroll
    for (int a = 0; a < 2; ++a)
#pragma unroll
        for (int b = 0; b < 2; ++b)
#pragma unroll
            for (int m = 0; m < 4; ++m)
#pragma unroll
                for (int n = 0; n < 2; ++n) acc[a][b][m][n] = (f32x4){0.f, 0.f, 0.f, 0.f};
    bf16x8 At[4][2], B0[2][2], B1[2][2];
    u32x4 gc = {voffA[0], voffA[1], voffA[0], voffA[1]};
    if constexpr (GATHER) { PG8_ROWS(cur, 0); PG8_ROWS(cur, 1); gc = *GSLOT(0); }
#define VGC(h, i) (gc[2 * (h) + (i)])
    const char* cA = (const char*)g.A + cur.aofs; const char* cB = (const char*)g.Bt + cur.bofs;
    PG8_STAGE(PG8_SB(0, 0), cB, voffB); PG8_STAGE(PG8_SB(0, 1), cB + hstepB, voffB); PG8_STAGE2(PG8_SA(0, 0), cA, VGC(0, 0), VGC(0, 1)); PG8_STAGE2(PG8_SA(0, 1), cA + hstepA, VGC(1, 0), VGC(1, 1));
    if (wr == 1) PG8_BAR;
    PG8_WAIT_V(2); PG8_BAR;
    PG8_STAGE(PG8_SB(1, 0), cB + kstep, voffB); PG8_STAGE2(PG8_SA(1, 0), cA + kstep, VGC(0, 0), VGC(0, 1)); PG8_STAGE(PG8_SB(1, 1), cB + hstepB + kstep, voffB);
    PG8_WAIT_V(6); PG8_BAR;
    for (;;) {
        const bool has_next = S.next(ui + 1, nxt);
        const char* nA = has_next ? (const char*)g.A + nxt.aofs : cA; const char* nB = has_next ? (const char*)g.Bt + nxt.bofs : cB;
        if constexpr (GATHER) { if (has_next) PG8_ROWS(nxt, 1); else *GSLOT(1) = *GSLOT(0); }
        for (int t = 0; t < nt; t += 2) {
            const bool last = (t == nt - 2);
            const char* a1 = cA + (size_t)(t + 1) * kstep;
            const char* a2 = last ? nA : cA + (size_t)(t + 2) * kstep; const char* b2 = last ? nB : cB + (size_t)(t + 2) * kstep;
            const char* a3 = a2 + kstep; const char* b3 = b2 + kstep;
            u32x4 gn = gc; if constexpr (GATHER) { gc = *GSLOT(0); gn = last ? *GSLOT(1) : gc; }
            const unsigned s00 = gn.x, s01 = gn.y, s10 = gn.z, s11 = gn.w;
            PG8_LDB(B0, 0, 0); PG8_LDB(B1, 0, 1); PG8_SCHED; PG8_LDA(At, 0, 0); PG8_STAGE2(PG8_SA(1, 1), a1 + hstepA, VGC(1, 0), VGC(1, 1));
            PG8_WAIT_V(8); PG8_WAIT_L(0); PG8_BAR; PG8_MMA(0, 0, At, B0); PG8_MMA(0, 1, At, B1); PG8_BAR; PG8_SCHED;
            PG8_LDA(At, 0, 1); PG8_STAGE(PG8_SB(0, 0), b2, voffB); PG8_STAGE(PG8_SB(0, 1), b2 + hstepB, voffB); PG8_STAGE2(PG8_SA(0, 0), a2, s00, s01);
            PG8_WAIT_V(8); PG8_WAIT_L(0); PG8_BAR; PG8_MMA(1, 0, At, B0); PG8_MMA(1, 1, At, B1); PG8_BAR; PG8_SCHED;
            PG8_LDB(B0, 1, 0); PG8_LDB(B1, 1, 1); PG8_SCHED; PG8_LDA(At, 1, 0); PG8_STAGE2(PG8_SA(0, 1), a2 + hstepA, s10, s11);
            PG8_WAIT_V(8); PG8_WAIT_L(0); PG8_BAR; PG8_MMA(0, 0, At, B0); PG8_MMA(0, 1, At, B1); PG8_BAR; PG8_SCHED;
            PG8_LDA(At, 1, 1); PG8_STAGE(PG8_SB(1, 0), b3, voffB); PG8_STAGE(PG8_SB(1, 1), b3 + hstepB, voffB); PG8_STAGE2(PG8_SA(1, 0), a3, s00, s01);
            PG8_WAIT_V(8); PG8_WAIT_L(0); PG8_BAR; PG8_MMA(1, 0, At, B0); PG8_MMA(1, 1, At, B1); PG8_BAR; PG8_SCHED;
        }
        if (wr == 0) PG8_BAR;
        if constexpr (F8) asm volatile("s_nop 15\n\ts_nop 15" ::: "memory");
        E(acc, cur, wr, wc, fr, fq);
        if (!has_next) break;
#pragma unroll
        for (int a = 0; a < 2; ++a)
#pragma unroll
            for (int b = 0; b < 2; ++b)
#pragma unroll
                for (int m = 0; m < 4; ++m)
#pragma unroll
                    for (int n = 0; n < 2; ++n) acc[a][b][m][n] = (f32x4){0.f, 0.f, 0.f, 0.f};
        cur = nxt; cA = nA; cB = nB; ++ui;
        if constexpr (GATHER) { *GSLOT(0) = *GSLOT(1); }
        if (wr == 1) PG8_BAR;
    }
    PG8_WAIT_V(0);
    PG8_BAR;
#undef PG8_SA
#undef PG8_SB
#undef PG8_STAGE
#undef PG8_STAGE2
#undef PG8_ROWS
#undef GSLOT
#undef VGC
#undef PG8_LDA
#undef PG8_LDB
#undef PG8_MMA
#undef PG8_CAT
#undef PG8_WAIT_V
#undef PG8_WAIT_L
#undef PG8_BAR
#undef PG8_SCHED
}

typedef const f32x4 (&AccRef)[2][2][4][2];
__device__ __forceinline__ float ss16(const float* p) { const f32x4 a = *(const f32x4*)p, b = *(const f32x4*)(p + 4), c = *(const f32x4*)(p + 8), d = *(const f32x4*)(p + 12);
    return (((a[0] + a[1]) + (a[2] + a[3])) + ((b[0] + b[1]) + (b[2] + b[3]))) + (((c[0] + c[1]) + (c[2] + c[3])) + ((d[0] + d[1]) + (d[2] + d[3]))); }
__device__ __forceinline__ float rs_of(const float* rstd, int ssmode, int row) { return ssmode ? __builtin_amdgcn_rsqf(ss16(rstd + (size_t)row * 16) * (1.f / D) + 1e-6f) : rstd[row]; }

struct EpiInProj {
    static constexpr bool PERM = true, TRANS = true;
    bf16* P; const float* rstd; float* dt; int ssmode;
    __device__ __forceinline__ void operator()(AccRef acc, const Unit& u, int wr, int wc, int fr, int fq) const {
        const int row0 = u.pm * BM + wr * 64 + fr;
        float scl[2][4];
#pragma unroll
        for (int ai = 0; ai < 2; ++ai)
#pragma unroll
            for (int m = 0; m < 4; ++m) scl[ai][m] = rs_of(rstd, ssmode, row0 + ai * HALF + m * 16);
        if (u.pn < 21) {
            const int col0 = u.pn * BM + wc * 32 + 8 * fq;
#pragma unroll
            for (int ai = 0; ai < 2; ++ai)
#pragma unroll
                for (int m = 0; m < 4; ++m) { const int row = row0 + ai * HALF + m * 16; const float s = scl[ai][m]; bf16* rowp = P + (size_t)row * PLD + col0;
#pragma unroll
                    for (int bj = 0; bj < 2; ++bj) { const f32x4 v0 = acc[ai][bj][m][0] * s, v1 = acc[ai][bj][m][1] * s;
                        u32x4 w; w.x = pk2(v0[0], v0[1]); w.y = pk2(v0[2], v0[3]); w.z = pk2(v1[0], v1[1]); w.w = pk2(v1[2], v1[3]);
                        *(u32x4*)(rowp + bj * HALF) = w; } }
        } else if (wc == 0 && fq == 0) {
#pragma unroll
            for (int ai = 0; ai < 2; ++ai)
#pragma unroll
                for (int m = 0; m < 4; ++m) { const int row = row0 + ai * HALF + m * 16; const float s = scl[ai][m];
                    *(f32x4*)(dt + (size_t)row * 8) = acc[ai][0][m][0] * s; *(f32x4*)(dt + (size_t)row * 8 + 4) = acc[ai][0][m][1] * s; }
        }
    }
};
struct EpiPlain {
    static constexpr bool PERM = true, TRANS = true;
    bf16* P; bf16* Y2;
    __device__ __forceinline__ void operator()(AccRef acc, const Unit& u, int wr, int wc, int fr, int fq) const {
        bf16* O = (u.e == 0) ? P : (u.e == 1 ? P + C_XBC : Y2); const int ldc = (u.e == 2) ? D : PLD;
        const int row0 = u.pm * BM + wr * 64 + fr, col0 = u.pn * BM + wc * 32 + 8 * fq;
#pragma unroll
        for (int ai = 0; ai < 2; ++ai)
#pragma unroll
            for (int m = 0; m < 4; ++m) { bf16* rowp = O + (size_t)(row0 + ai * HALF + m * 16) * ldc + col0;
#pragma unroll
                for (int bj = 0; bj < 2; ++bj) { const f32x4 v0 = acc[ai][bj][m][0], v1 = acc[ai][bj][m][1];
                    u32x4 w; w.x = pk2(v0[0], v0[1]); w.y = pk2(v0[2], v0[3]); w.z = pk2(v1[0], v1[1]); w.w = pk2(v1[2], v1[3]);
                    *(u32x4*)(rowp + bj * HALF) = w; } }
    }
};
struct EpiGateMerge {
    static constexpr bool PERM = true, TRANS = true;
    const bf16* P; const bf16* Y2; bf16* Mg; int ldm; const float* rstd; int ssmode;
    __device__ __forceinline__ void operator()(AccRef acc, const Unit& u, int wr, int wc, int fr, int fq) const {
        asm volatile("" : "+v"(fr), "+v"(fq));
        const bf16* Y = (u.e == 0) ? P : (u.e == 1 ? P + C_XBC : Y2); const int ldy = (u.e == 2) ? D : PLD; const int first = (u.e == 0);
        const int row0 = u.pm * BM + wr * 64 + fr, col0 = u.pn * BM + wc * 32 + 8 * fq;
#pragma unroll
        for (int ai = 0; ai < 2; ++ai) {
            u32x4 yv[4][2], mv[4][2]; float sc[4];
#pragma unroll
            for (int m = 0; m < 4; ++m) { const int row = row0 + ai * HALF + m * 16; sc[m] = rs_of(rstd, ssmode, row);
#pragma unroll
                for (int bj = 0; bj < 2; ++bj) { yv[m][bj] = *(const u32x4*)(Y + (size_t)row * ldy + col0 + bj * HALF);
                    mv[m][bj] = first ? (u32x4){0u, 0u, 0u, 0u} : *(const u32x4*)(Mg + (size_t)row * ldm + col0 + bj * HALF); } }
#pragma unroll
            for (int m = 0; m < 4; ++m) { const int row = row0 + ai * HALF + m * 16;
#pragma unroll
                for (int bj = 0; bj < 2; ++bj) { float y[8], p[8], o[8]; unpack8(yv[m][bj], y); unpack8(mv[m][bj], p);
                    const f32x4 v0 = acc[ai][bj][m][0] * sc[m], v1 = acc[ai][bj][m][1] * sc[m];
#pragma unroll
                    for (int j = 0; j < 4; ++j) { o[j] = sigm(v0[j]) * y[j] + p[j]; o[4 + j] = sigm(v1[j]) * y[4 + j] + p[4 + j]; }
                    *(u32x4*)(Mg + (size_t)row * ldm + col0 + bj * HALF) = pack8(o); } }
        }
    }
};
struct EpiResid {
    static constexpr bool PERM = false, TRANS = true;
    const float* xin; float* xout; const float* gates; int e;
    __device__ __forceinline__ void operator()(AccRef acc, const Unit& u, int wr, int wc, int fr, int fq) const {
        const int row0 = u.pm * BM + wr * 64 + fr, col0 = u.pn * BM + wc * 32 + 4 * fq;
#pragma unroll
        for (int ai = 0; ai < 2; ++ai)
#pragma unroll
            for (int m = 0; m < 4; ++m) { const int row = row0 + ai * HALF + m * 16; const float s = gates ? gates[(size_t)row * 8 + e] : 1.f;
                const float* ip = xin + (size_t)row * D + col0; float* op = xout + (size_t)row * D + col0;
#pragma unroll
                for (int bj = 0; bj < 2; ++bj)
#pragma unroll
                    for (int n = 0; n < 2; ++n) *(f32x4*)(op + bj * HALF + n * 16) = *(const f32x4*)(ip + bj * HALF + n * 16) + acc[ai][bj][m][n] * s; }
    }
};
struct EpiResidB {
    static constexpr bool PERM = true, TRANS = true;
    bf16* xb; float* SS; float* xf;
    __device__ __forceinline__ void operator()(AccRef acc, const Unit& u, int wr, int wc, int fr, int fq) const {
        asm volatile("" : "+v"(fr), "+v"(fq));
        const int row0 = u.pm * BM + wr * 64 + fr, col0 = u.pn * BM + wc * 32 + 8 * fq;
#pragma unroll
        for (int ai = 0; ai < 2; ++ai) {
            u32x4 xv[4][2];
#pragma unroll
            for (int m = 0; m < 4; ++m)
#pragma unroll
                for (int bj = 0; bj < 2; ++bj) xv[m][bj] = *(const u32x4*)(xb + (size_t)(row0 + ai * HALF + m * 16) * D + col0 + bj * HALF);
#pragma unroll
            for (int m = 0; m < 4; ++m) { const int row = row0 + ai * HALF + m * 16; bf16* rowp = xb + (size_t)row * D + col0; float ss = 0.f;
#pragma unroll
                for (int bj = 0; bj < 2; ++bj) { float v[8]; unpack8(xv[m][bj], v);
#pragma unroll
                    for (int j = 0; j < 4; ++j) { v[j] += acc[ai][bj][m][0][j]; v[4 + j] += acc[ai][bj][m][1][j]; }
                    *(u32x4*)(rowp + bj * HALF) = pack8(v);
                    if (xf) { float* fp = xf + (size_t)row * D + col0 + bj * HALF; *(f32x4*)fp = (f32x4){v[0], v[1], v[2], v[3]}; *(f32x4*)(fp + 4) = (f32x4){v[4], v[5], v[6], v[7]}; }
#pragma unroll
                    for (int j = 0; j < 8; ++j) ss += v[j] * v[j]; }
                if (SS) { ss += __shfl_xor(ss, 16); ss += __shfl_xor(ss, 32); if (fq == 0) SS[(size_t)row * 16 + u.pn * 4 + wc] = ss; } }
        }
    }
};
struct EpiSwiglu {
    static constexpr bool PERM = true, TRANS = true;
    bf16* act; int ldc; const float* rstd; int ssmode;
    __device__ __forceinline__ void operator()(AccRef acc, const Unit& u, int wr, int wc, int fr, int fq) const {
        asm volatile("" : "+v"(fr), "+v"(fq));
        const int row0 = u.pm * BM + wr * 64 + fr, col0 = u.pn * HALF + wc * 32 + 8 * fq;
        float scl[2][4];
        if (u.rows) { int tk[2][4];
#pragma unroll
            for (int ai = 0; ai < 2; ++ai)
#pragma unroll
                for (int m = 0; m < 4; ++m) { const int lr = wr * 64 + fr + ai * HALF + m * 16; tk[ai][m] = (lr < u.nvalid) ? u.rows[2 * lr] : 0; }
#pragma unroll
            for (int ai = 0; ai < 2; ++ai)
#pragma unroll
                for (int m = 0; m < 4; ++m) scl[ai][m] = rstd[tk[ai][m]];
        } else {
#pragma unroll
            for (int ai = 0; ai < 2; ++ai)
#pragma unroll
                for (int m = 0; m < 4; ++m) scl[ai][m] = rs_of(rstd, ssmode, row0 + ai * HALF + m * 16); }
#pragma unroll
        for (int ai = 0; ai < 2; ++ai)
#pragma unroll
            for (int m = 0; m < 4; ++m) { const int row = row0 + ai * HALF + m * 16;
                const float s = scl[ai][m];
                float o[8];
#pragma unroll
                for (int n = 0; n < 2; ++n)
#pragma unroll
                    for (int j = 0; j < 4; ++j) o[4 * n + j] = silu(acc[ai][0][m][n][j] * s) * (acc[ai][1][m][n][j] * s);
                *(u32x4*)(act + (size_t)row * ldc + col0) = pack8(o); }
    }
};
struct EpiSwiglu8 {
    static constexpr bool PERM = true, TRANS = true;
    unsigned char* act; int ldc;
    __device__ __forceinline__ void operator()(AccRef acc, const Unit& u, int wr, int wc, int fr, int fq) const {
        asm volatile("" : "+v"(fr), "+v"(fq));
        const int row0 = u.pm * BM + wr * 64 + fr, col0 = u.pn * HALF + wc * 32 + 8 * fq;
        const float s = 1.f / 256.f, s8 = 8.f / 256.f;
#pragma unroll
        for (int ai = 0; ai < 2; ++ai)
#pragma unroll
            for (int m = 0; m < 4; ++m) { const int row = row0 + ai * HALF + m * 16;
                float o[8];
#pragma unroll
                for (int n = 0; n < 2; ++n)
#pragma unroll
                    for (int j = 0; j < 4; ++j) o[4 * n + j] = silu(acc[ai][0][m][n][j] * s) * (acc[ai][1][m][n][j] * s8);
                u32x2 w; w.x = pk4f8(o[0], o[1], o[2], o[3]); w.y = pk4f8(o[4], o[5], o[6], o[7]);
                *(u32x2*)(act + (size_t)row * ldc + col0) = w; }
    }
};
struct EpiMoeOut {
    static constexpr bool PERM = true, TRANS = true;
    bf16* Y; size_t kstride; float mul;
    __device__ __forceinline__ void operator()(AccRef acc, const Unit& u, int wr, int wc, int fr, int fq) const {
        const int row0 = u.pm * BM + wr * 64 + fr, col0 = u.pn * BM + wc * 32 + 8 * fq; bf16* O = Y + (size_t)u.ks * kstride;
#pragma unroll
        for (int ai = 0; ai < 2; ++ai)
#pragma unroll
            for (int m = 0; m < 4; ++m) { bf16* rowp = O + (size_t)(row0 + ai * HALF + m * 16) * D + col0;
#pragma unroll
                for (int bj = 0; bj < 2; ++bj) { const f32x4 v0 = acc[ai][bj][m][0] * mul, v1 = acc[ai][bj][m][1] * mul;
                    u32x4 w; w.x = pk2(v0[0], v0[1]); w.y = pk2(v0[2], v0[3]); w.z = pk2(v1[0], v1[1]); w.w = pk2(v1[2], v1[3]);
                    *(u32x4*)(rowp + bj * HALF) = w; } }
    }
};
}

#define XB_TMO      128
#define XB_XCNT(j)  (256  + 64 * (j))
#define XB_XSUB(j)  (1280 + 64 * (j))
#define XB_XGEN(j)  (2304 + 64 * (j))
#define XB_TOP      3328
#define XB_TOPGEN   3392
#define XCD_BAR_WORDS 3456
#define XB_SPIN_CAP (1u << 18)

__device__ __forceinline__ unsigned xb_ld(unsigned* p)              { return __hip_atomic_load(p, __ATOMIC_RELAXED, __HIP_MEMORY_SCOPE_AGENT); }
__device__ __forceinline__ unsigned xb_add(unsigned* p, unsigned v) { return __hip_atomic_fetch_add(p, v, __ATOMIC_RELAXED, __HIP_MEMORY_SCOPE_AGENT); }
__device__ __forceinline__ unsigned xb_xcc_id() { return (unsigned)__builtin_amdgcn_s_getreg((3 << 11) | 20) & 0xFu; }
#define XB_SPIN(cond, bar) do { unsigned _sp = 0; while (cond) { __builtin_amdgcn_s_sleep(1); \
    if ((++_sp & 255u) == 0u) { if (xb_ld(&(bar)[XB_TMO])) break; if (_sp > XB_SPIN_CAP) { atomicAdd(&(bar)[XB_TMO], 1u); break; } } } } while (0)

struct XcdBarrier { unsigned* bar; unsigned x; volatile LAS unsigned* st; };

__device__ __forceinline__ XcdBarrier xcd_barrier_post(unsigned* bar, volatile LAS unsigned* st) {
    XcdBarrier b; b.bar = bar; b.x = xb_xcc_id(); b.st = st;
    if (threadIdx.x == 0) (void)xb_add(&bar[XB_XCNT(b.x)], 1u);
    return b;
}
__device__ __forceinline__ void xcd_barrier_complete(unsigned* bar, unsigned x, unsigned& nloc, unsigned& nx) {
    const unsigned G = gridDim.x * gridDim.y * gridDim.z;
    unsigned sum, cnt, mine, sp = 0u;
    for (;;) {
        sum = 0u; cnt = 0u; mine = 0u;
#pragma unroll
        for (unsigned j = 0; j < 16; ++j) { const unsigned c = xb_ld(&bar[XB_XCNT(j)]); sum += c; cnt += (c > 0u) ? 1u : 0u; mine = (j == x) ? c : mine; }
        if (sum == G) break;
        __builtin_amdgcn_s_sleep(1);
        if ((++sp & 255u) == 0u) { if (xb_ld(&bar[XB_TMO])) break; if (sp > XB_SPIN_CAP) { atomicAdd(&bar[XB_TMO], 1u); break; } }
    }
    nloc = mine > 0u ? mine : 1u; nx = cnt > 0u ? cnt : 1u;
}
__device__ __forceinline__ void xcd_barrier(const XcdBarrier& b) {
    asm volatile("s_waitcnt vmcnt(0)" ::: "memory");
    __syncthreads();
    if (threadIdx.x == 0) {
        unsigned* bar = b.bar;
        __builtin_amdgcn_s_waitcnt(0);
        unsigned nloc = b.st[0], nx = b.st[1];
        if (nloc == 0u) { xcd_barrier_complete(bar, b.x, nloc, nx); b.st[0] = nloc; b.st[1] = nx; }
        const unsigned old = xb_add(&bar[XB_XSUB(b.x)], 1u);
        const unsigned gen = old / nloc;
        if (old + 1u == (gen + 1u) * nloc) {
            __builtin_amdgcn_fence(__ATOMIC_RELEASE, "agent");
            asm volatile("s_waitcnt vmcnt(0)" ::: "memory");
            const unsigned og = xb_add(&bar[XB_TOP], 1u);
            const unsigned tg = og / nx;
            if (og + 1u == (tg + 1u) * nx) xb_add(&bar[XB_TOPGEN], 1u);
            else XB_SPIN(xb_ld(&bar[XB_TOPGEN]) == tg, bar);
            __builtin_amdgcn_fence(__ATOMIC_ACQUIRE, "agent");
            xb_add(&bar[XB_XGEN(b.x)], 1u);
            asm volatile("s_waitcnt vmcnt(0)" ::: "memory");
        } else {
            XB_SPIN(xb_ld(&bar[XB_XGEN(b.x)]) == gen, bar);
            __builtin_amdgcn_fence(__ATOMIC_ACQUIRE, "agent");
            asm volatile("s_waitcnt vmcnt(0)" ::: "memory");
        }
    }
    __syncthreads();
}

#define GAS __attribute__((address_space(1)))
struct Args { const float* in[34]; float* out; unsigned char* ws; int ph_lo, ph_hi; };
struct Frame {
    LAS unsigned char* lds;
    int vcu, G, cid, wid, rr;
    GAS float* out; GAS unsigned char* ws; GAS unsigned char* st;
};
__device__ __forceinline__ const float* inptr(LAS unsigned char* lds, int i) {
    int off = LDSCTL_OFF + 8 * i; asm volatile("" : "+v"(off));
    const LAS unsigned* p = (const LAS unsigned*)(lds + off);
    const unsigned lo = __builtin_amdgcn_readfirstlane(p[0]), hi = __builtin_amdgcn_readfirstlane(p[1]);
    return (const float*)(GAS const float*)(((unsigned long long)hi << 32) | lo);
}
#define INP(i) inptr(F.lds, (i))

__device__ __forceinline__ void conv_item(const float* W, int ld, int k0, int c0, int nvalid, const float* scale, bf16* dst, int K, int drow0, LAS float* scr, int lane) {
    const int n4 = (lane & 15) * 4;
    f32x4 v[16]; float sc[16];
#pragma unroll
    for (int i = 0; i < 16; ++i) { const int kk = 4 * i + (lane >> 4);
        v[i] = (f32x4){0.f, 0.f, 0.f, 0.f}; sc[i] = 1.f; if (n4 < nvalid) { v[i] = *(const f32x4*)(W + (size_t)(k0 + kk) * ld + c0 + n4); if (scale) sc[i] = scale[k0 + kk]; } }
#pragma unroll
    for (int i = 0; i < 16; ++i) { const int kk = 4 * i + (lane >> 4); const f32x4 x = v[i] * sc[i];
        LAS float* d = scr + kk * 65 + n4; d[0] = x[0]; d[1] = x[1]; d[2] = x[2]; d[3] = x[3]; }
    LDS_WAIT(); asm volatile("" ::: "memory");
    const int c = lane & 7;
#pragma unroll
    for (int j = 0; j < 8; ++j) { const int nn = (lane >> 3) + 8 * j; const LAS float* sp = scr + (8 * c) * 65 + nn;
        u32x4 o; o.x = pk2(sp[0 * 65], sp[1 * 65]); o.y = pk2(sp[2 * 65], sp[3 * 65]); o.z = pk2(sp[4 * 65], sp[5 * 65]); o.w = pk2(sp[6 * 65], sp[7 * 65]);
        *(u32x4*)(dst + (size_t)(drow0 + nn) * K + k0 + 8 * c) = o; }
    LDS_WAIT(); asm volatile("" ::: "memory");
}
__device__ __forceinline__ void conv_item8(const float* W, int ld, int k0, int c0, const float* scale, float mul, unsigned char* dst, int K, int drow0, LAS float* scr, int lane) {
    const int n4 = (lane & 15) * 4;
    f32x4 v[16]; float sc[16];
#pragma unroll
    for (int i = 0; i < 16; ++i) { const int kk = 4 * i + (lane >> 4); v[i] = *(const f32x4*)(W + (size_t)(k0 + kk) * ld + c0 + n4); sc[i] = scale ? scale[k0 + kk] * mul : mul; }
#pragma unroll
    for (int i = 0; i < 16; ++i) { const int kk = 4 * i + (lane >> 4); const f32x4 x = v[i] * sc[i];
        LAS float* d = scr + kk * 65 + n4; d[0] = x[0]; d[1] = x[1]; d[2] = x[2]; d[3] = x[3]; }
    LDS_WAIT(); asm volatile("" ::: "memory");
    const int c = lane & 3;
#pragma unroll
    for (int j = 0; j < 4; ++j) { const int nn = (lane >> 2) + 16 * j; const LAS float* sp = scr + (16 * c) * 65 + nn;
        u32x4 o; o.x = pk4f8(sp[0 * 65], sp[1 * 65], sp[2 * 65], sp[3 * 65]); o.y = pk4f8(sp[4 * 65], sp[5 * 65], sp[6 * 65], sp[7 * 65]);
        o.z = pk4f8(sp[8 * 65], sp[9 * 65], sp[10 * 65], sp[11 * 65]); o.w = pk4f8(sp[12 * 65], sp[13 * 65], sp[14 * 65], sp[15 * 65]);
        *(u32x4*)(dst + (size_t)(drow0 + nn) * K + k0 + 16 * c) = o; }
    LDS_WAIT(); asm volatile("" ::: "memory");
}
__device__ __forceinline__ void conv_seg8(Frame& F, const float* W, int ld, int K, int ncols, const float* scale, float mul, unsigned char* dst, int r0, int blk, int blks) {
    const int ptid = otid(), plane = ptid & 63, pwave = __builtin_amdgcn_readfirstlane(ptid >> 6);
    LAS float* scr = (LAS float*)(F.lds + pwave * 16640);
    const int gw = F.vcu * 8 + pwave, NGW = F.G * 8;
    const int nblk = ncols / 64, nitems = (K / 64) * nblk;
    const int first = (gw - F.rr % NGW + NGW) % NGW; F.rr = (F.rr + nitems) % NGW;
    for (int it = first; it < nitems; it += NGW) {
        const int kb = it / nblk, nb = it % nblk, n0 = nb * 64;
        conv_item8(W, ld, kb * 64, n0, scale, mul, dst, K, r0 + (n0 / blk) * blks + (n0 % blk), scr, plane);
    }
}
__device__ __forceinline__ void conv_seg(Frame& F, const float* W, int ld, int K, int c0, int nvalid, int ntotal, const float* scale, bf16* dst, int r0, int blk, int blks) {
    const int ptid = otid(), plane = ptid & 63, pwave = __builtin_amdgcn_readfirstlane(ptid >> 6);
    LAS float* scr = (LAS float*)(F.lds + pwave * 16640);
    const int gw = F.vcu * 8 + pwave, NGW = F.G * 8;
    const int nblk = ntotal / 64, nitems = (K / 64) * nblk;
    const int first = (gw - F.rr % NGW + NGW) % NGW; F.rr = (F.rr + nitems) % NGW;
    for (int it = first; it < nitems; it += NGW) {
        const int kb = it / nblk, nb = it % nblk, n0 = nb * 64;
        int nv = nvalid - n0; nv = nv < 0 ? 0 : (nv > 64 ? 64 : nv);
        conv_item(W, ld, kb * 64, c0 + n0, nv, scale, dst, K, r0 + (n0 / blk) * blks + (n0 % blk), scr, plane);
    }
}
__device__ __forceinline__ void conv_layer_weights(Frame& F, int l, int part) {
    unsigned char* wl = (unsigned char*)(F.ws + WS_W + (size_t)l * WL_STRIDE);
    const float* win = INP(2) + (size_t)l * D * INC; const float* n1 = INP(1) + l * D;
    const int BIGB = 1 << 30;
    if (part == 0) {
        conv_seg(F, win, INC, D, 0, 3328, 3328, n1, (bf16*)(wl + WL_IN), 0, BIGB, 0);
        conv_seg(F, win, INC, D, 3336, 2048, 2048, n1, (bf16*)(wl + WL_IN), 3328, BIGB, 0);
        conv_seg(F, win, INC, D, 3328, 8, 256, n1, (bf16*)(wl + WL_IN), 5376, BIGB, 0);
    } else {
        conv_seg(F, win, INC, D, 5384, 3072, 3072, n1, (bf16*)(wl + WL_GATE), 0, BIGB, 0);
        for (int i = 0; i < 3; ++i)
            conv_seg(F, INP(23) + ((size_t)l * 3 + i) * 512 * D, D, 512, 0, D, D, nullptr, (bf16*)(wl + WL_BR) + (size_t)i * D * 512, 0, BIGB, 0);
        conv_seg(F, INP(24) + (size_t)l * D * D, D, D, 0, D, D, nullptr, (bf16*)(wl + WL_OUT), 0, BIGB, 0);
    }
}
__device__ __forceinline__ void conv_ffn_weights(Frame& F) {
    const float* n2 = INP(25);
    conv_seg(F, INP(26), FF, D, 0, FF, FF, n2, (bf16*)(F.ws + WS_FFUP), 0, 128, 256);
    conv_seg(F, INP(27), FF, D, 0, FF, FF, n2, (bf16*)(F.ws + WS_FFUP), 128, 128, 256);
    conv_seg(F, INP(28), D, FF, 0, D, D, nullptr, (bf16*)(F.ws + WS_FFDN), 0, 1 << 30, 0);
}
__device__ __forceinline__ unsigned char* moew_ptr(const Frame& F, int e) { return e < 6 ? (unsigned char*)F.out + MOEW_OUT + (size_t)e * MOEW_STRIDE : (e == 6 ? (unsigned char*)(F.ws + WS_FFUP) : (unsigned char*)(F.ws + WS_VF + 16 * MiB)); }
__device__ __forceinline__ void conv_moe_weights(Frame& F, int e_lo, int e_hi) {
    const float* n2 = INP(25) + D;
    for (int e = e_lo; e < e_hi; ++e) {
        unsigned char* up = moew_ptr(F, e); unsigned char* dn = up + MOEW_DN;
        conv_seg8(F, INP(30) + (size_t)e * D * FFE, FFE, D, FFE, n2, 64.f, up, 0, 128, 256);
        conv_seg8(F, INP(31) + (size_t)e * D * FFE, FFE, D, FFE, n2, 64.f, up, 128, 128, 256);
        conv_seg8(F, INP(32) + (size_t)e * FFE * D, D, FFE, D, nullptr, 128.f, dn, 0, 1 << 30, 0);
    }
}
__device__ __forceinline__ void xprep_phase(Frame& F, const float* x) {
    const int ptid = otid(), plane = ptid & 63, pwave = __builtin_amdgcn_readfirstlane(ptid >> 6);
    const int gw = F.vcu * 8 + pwave, NGW = F.G * 8;
    bf16* xb = (bf16*)(F.ws + WS_XB); float* rstd = (float*)(F.ws + WS_RSTD);
    for (int m0 = 4 * gw; m0 < M; m0 += 4 * NGW) {
        f32x4 v[4][4];
#pragma unroll
        for (int q = 0; q < 4; ++q) { const f32x4* xr = (const f32x4*)(x + (size_t)(m0 + q) * D) + plane;
#pragma unroll
            for (int j = 0; j < 4; ++j) v[q][j] = xr[64 * j]; }
#pragma unroll
        for (int q = 0; q < 4; ++q) { const int m = m0 + q; float sq = 0.f;
#pragma unroll
            for (int j = 0; j < 4; ++j) sq += (v[q][j].x * v[q][j].x + v[q][j].y * v[q][j].y) + (v[q][j].z * v[q][j].z + v[q][j].w * v[q][j].w);
            sq = wave_sum(sq);
            if (plane == 0) rstd[m] = __builtin_amdgcn_rsqf(sq * (1.f / D) + 1e-6f);
            u32x2* o8 = (u32x2*)(xb + (size_t)m * D) + plane;
#pragma unroll
            for (int j = 0; j < 4; ++j) { u32x2 w; w.x = pk2(v[q][j].x, v[q][j].y); w.y = pk2(v[q][j].z, v[q][j].w); o8[64 * j] = w; } }
    }
}
__device__ __forceinline__ void final_norm_phase(Frame& F) {
    const int ptid = otid(), plane = ptid & 63, pwave = __builtin_amdgcn_readfirstlane(ptid >> 6);
    const int gw = F.vcu * 8 + pwave, NGW = F.G * 8;
    const float* fw = INP(33); const unsigned* pinfo = (const unsigned*)(F.ws + WS_PINFO); const int* cnt = (const int*)(F.ws + WS_CNT);
    int tb[8]; { int t = 0;
#pragma unroll
        for (int e = 0; e < 8; ++e) { int n = __builtin_amdgcn_readfirstlane(cnt[e]); n = n < 0 ? 0 : (n > 32768 ? 32768 : n); tb[e] = t; t += (n + 255) >> 8; } }
    const bf16* Y0 = (const bf16*)(F.ws + WS_YP0); const bf16* Y1 = (const bf16*)(F.ws + WS_YP1); const bf16* Y2 = (const bf16*)(F.ws + WS_YP2);
    f32x4 fwv[4];
#pragma unroll
    for (int j = 0; j < 4; ++j) fwv[j] = *((const f32x4*)fw + plane + 64 * j);
    for (int m0 = 2 * gw; m0 < M; m0 += 2 * NGW) {
        f32x4 v[2][4]; u32x2 ya[2][2][4]; float wg[2][2]; int sgm[2][2]; const bf16* yp[2][2];
#pragma unroll
        for (int q = 0; q < 2; ++q) { const int m = m0 + q;
            const u32x2* xr = (const u32x2*)((const bf16*)(F.ws + WS_XB) + (size_t)m * D) + plane;
#pragma unroll
            for (int j = 0; j < 4; ++j) { const u32x2 xx = xr[64 * j]; v[q][j] = (f32x4){bflo(xx.x), bfhi(xx.x), bflo(xx.y), bfhi(xx.y)}; }
#pragma unroll
            for (int p = 0; p < 2; ++p) {
                const unsigned pk = __builtin_amdgcn_readfirstlane(pinfo[((size_t)m * 2 + p) * 2]); wg[q][p] = __builtin_bit_cast(float, __builtin_amdgcn_readfirstlane(pinfo[((size_t)m * 2 + p) * 2 + 1]));
                const int e = (int)(pk >> 20), slot = (int)(pk & 0xFFFFFu);
                int tbe = tb[0];
#pragma unroll
                for (int k = 1; k < 8; ++k) tbe = (e == k) ? tb[k] : tbe;
                const int gr = tbe * 256 + slot, seg = gr >> 15, lr = gr & 32767; sgm[q][p] = seg;
                yp[q][p] = (seg == 0 ? Y0 : (seg == 1 ? Y1 : Y2)) + (size_t)lr * D + 4 * plane; } }
#pragma unroll
        for (int q = 0; q < 2; ++q)
#pragma unroll
            for (int p = 0; p < 2; ++p)
#pragma unroll
                for (int j = 0; j < 4; ++j) ya[q][p][j] = *(const u32x2*)(yp[q][p] + 256 * j);
#pragma unroll
        for (int q = 0; q < 2; ++q) { const int m = m0 + q;
#pragma unroll
            for (int p = 0; p < 2; ++p) { const float wgt = wg[q][p];
#pragma unroll
                for (int j = 0; j < 4; ++j) { const u32x2 yy = ya[q][p][j]; v[q][j].x += wgt * bflo(yy.x); v[q][j].y += wgt * bfhi(yy.x); v[q][j].z += wgt * bflo(yy.y); v[q][j].w += wgt * bfhi(yy.y); }
                if (sgm[q][p] == 2) {
#pragma unroll
                    for (int ks = 1; ks < MOE_KSP; ++ks)
#pragma unroll
                        for (int j = 0; j < 4; ++j) { const u32x2 yy = *(const u32x2*)(yp[q][p] + (size_t)ks * (YP2_STRIDE / 2) + 256 * j); v[q][j].x += wgt * bflo(yy.x); v[q][j].y += wgt * bfhi(yy.x); v[q][j].z += wgt * bflo(yy.y); v[q][j].w += wgt * bfhi(yy.y); } } }
            float ssq = 0.f;
#pragma unroll
            for (int j = 0; j < 4; ++j) ssq += (v[q][j].x * v[q][j].x + v[q][j].y * v[q][j].y) + (v[q][j].z * v[q][j].z + v[q][j].w * v[q][j].w);
            ssq = wave_sum(ssq);
            const float r = __builtin_amdgcn_rsqf(ssq * (1.f / D) + 1e-6f);
            f32x4* xo = (f32x4*)(F.out + (size_t)m * D) + plane;
#pragma unroll
            for (int j = 0; j < 4; ++j) xo[64 * j] = v[q][j] * r * fwv[j]; }
    }
}
__device__ __forceinline__ void router_phase(Frame& F) {
    const int ptid = otid(), plane = ptid & 63, pwave = __builtin_amdgcn_readfirstlane(ptid >> 6);
    const float* nw = INP(25) + D; const float* rt = INP(29); bf16* xb = (bf16*)(F.ws + WS_XB);
    int* cnt = (int*)(F.ws + WS_CNT); int* list2 = (int*)(F.ws + WS_LIST);
    LAS int* lsel = (LAS int*)F.lds;
    LAS float* lwt = (LAS float*)(F.lds + 1024);
    LAS int* lrank = (LAS int*)(F.lds + 2048);
    LAS int* lcnt = (LAS int*)(F.lds + 3072);
    f32x4 nwq[4]; f32x4 rq[16][2];
#pragma unroll
    for (int j = 0; j < 4; ++j) { const int kk = 4 * plane + 256 * j; nwq[j] = *(const f32x4*)(nw + kk);
#pragma unroll
        for (int q = 0; q < 4; ++q) { rq[4 * j + q][0] = *(const f32x4*)(rt + (size_t)(kk + q) * 8); rq[4 * j + q][1] = *(const f32x4*)(rt + (size_t)(kk + q) * 8 + 4); } }
    for (int blk = F.vcu; blk < M / 128; blk += F.G) {
        if (ptid < 16) lcnt[ptid] = 0;
        __syncthreads();
        u32x2 xn[4];
        { const u32x2* xr2 = (const u32x2*)(xb + (size_t)(blk * 128 + pwave * 16) * D) + plane;
#pragma unroll
          for (int j = 0; j < 4; ++j) xn[j] = xr2[64 * j]; }
        for (int k = 0; k < 16; ++k) {
            const int lt = pwave * 16 + k, m = blk * 128 + lt;
            float acc[8];
#pragma unroll
            for (int e = 0; e < 8; ++e) acc[e] = 0.f;
            u32x2 xc[4];
#pragma unroll
            for (int j = 0; j < 4; ++j) xc[j] = xn[j];
            if (k + 1 < 16) { const u32x2* xr2 = (const u32x2*)(xb + (size_t)(m + 1) * D) + plane;
#pragma unroll
                for (int j = 0; j < 4; ++j) xn[j] = xr2[64 * j]; }
            f32x4 xv4[4]; float ssq = 0.f;
#pragma unroll
            for (int j = 0; j < 4; ++j) { const u32x2 xx = xc[j]; xv4[j] = (f32x4){bflo(xx.x), bfhi(xx.x), bflo(xx.y), bfhi(xx.y)}; ssq += (xv4[j].x * xv4[j].x + xv4[j].y * xv4[j].y) + (xv4[j].z * xv4[j].z + xv4[j].w * xv4[j].w); }
            ssq = wave_sum(ssq);
            const float sc = __builtin_amdgcn_rsqf(ssq * (1.f / D) + 1e-6f);
            { unsigned* x8 = (unsigned*)(F.ws + WS_X8 + (size_t)m * D) + plane; const float s4 = 4.f * sc;
#pragma unroll
              for (int j = 0; j < 4; ++j) x8[64 * j] = pk4f8(xv4[j].x * s4, xv4[j].y * s4, xv4[j].z * s4, xv4[j].w * s4); }
#pragma unroll
            for (int j = 0; j < 4; ++j) { const f32x4 nwv = nwq[j];
#pragma unroll
                for (int q = 0; q < 4; ++q) { const float xv = xv4[j][q] * nwv[q];
                    const f32x4 r0v = rq[4 * j + q][0], r1v = rq[4 * j + q][1];
                    acc[0] += xv * r0v.x; acc[1] += xv * r0v.y; acc[2] += xv * r0v.z; acc[3] += xv * r0v.w; acc[4] += xv * r1v.x; acc[5] += xv * r1v.y; acc[6] += xv * r1v.z; acc[7] += xv * r1v.w; } }
#pragma unroll
            for (int e = 0; e < 8; ++e) acc[e] = wave_sum(acc[e]) * sc;
            int i0 = 0; float v0 = acc[0];
#pragma unroll
            for (int e = 1; e < 8; ++e) if (acc[e] > v0) { v0 = acc[e]; i0 = e; }
            int i1 = -1; float v1 = -3.0e38f;
#pragma unroll
            for (int e = 0; e < 8; ++e) if (e != i0 && acc[e] > v1) { v1 = acc[e]; i1 = e; }
            const float e1 = expf(v1 - v0), w0 = 1.f / (1.f + e1), w1 = e1 / (1.f + e1);
            if (plane == 0) { lsel[2 * lt] = i0; lsel[2 * lt + 1] = i1; lwt[2 * lt] = w0; lwt[2 * lt + 1] = w1;
                lrank[2 * lt] = atomicAdd((int*)(lcnt + i0), 1); lrank[2 * lt + 1] = atomicAdd((int*)(lcnt + i1), 1); }
        }
        __syncthreads();
        if (ptid < 8) lcnt[8 + ptid] = atomicAdd(cnt + ptid, lcnt[ptid]);
        __syncthreads();
        if (ptid < 256) { const int e = lsel[ptid], slot = lcnt[8 + e] + lrank[ptid];
            u32x2 v; v.x = (unsigned)(blk * 128 + (ptid >> 1)); v.y = __builtin_bit_cast(unsigned, lwt[ptid]);
            *(u32x2*)(list2 + ((size_t)e * 32768 + slot) * 2) = v;
            u32x2 pi; pi.x = ((unsigned)e << 20) | (unsigned)slot; pi.y = v.y; *(u32x2*)((unsigned*)(F.ws + WS_PINFO) + ((size_t)(blk * 128) * 2 + ptid) * 2) = pi; }
        __syncthreads();
    }
}

__device__ __forceinline__ void vprep_phase(Frame& F, int layer) {
    const int ptid = otid(), plane = ptid & 63, pwave = __builtin_amdgcn_readfirstlane(ptid >> 6);
    constexpr int VP = 520, V_VB = 0, V_GB = 64 * VP * 2, V_VD = 2 * 64 * VP * 2;
    LAS bf16* VB = (LAS bf16*)(F.lds + V_VB); LAS bf16* GB = (LAS bf16*)(F.lds + V_GB); LAS bf16* VD = (LAS bf16*)(F.lds + V_VD);
    const bf16* P = (const bf16*)(F.ws + WS_BIG); bf16* VF = (bf16*)(F.ws + WS_VF); bf16* VM = (bf16*)(F.ws + WS_VMIX);
    const bf16* vdT = (const bf16*)(F.ws + WS_VLORA); const bf16* vuT = vdT + 32 * 512;
    const float* mu = INP(3) + layer * 1792 + 1024; const float* v0 = INP(16);
    const int tok = ptid >> 3, part = ptid & 7, r16 = plane & 15, q4 = plane >> 4;
    for (int it = F.vcu; it < M / 64; it += F.G) {
        const int m = it * 64 + tok; const int t = m & (T - 1);
        const bf16* cur = P + (size_t)m * PLD + 1024 + part * 64;
#pragma unroll
        for (int q = 0; q < 8; ++q) { float c[8], p[8]; unpack8(*(const u32x4*)(cur + q * 8), c);
            if (t > 0) unpack8(*(const u32x4*)(cur - PLD + q * 8), p); else {
#pragma unroll
                for (int e = 0; e < 8; ++e) p[e] = 0.f; }
            const f32x4 m0 = *(const f32x4*)(mu + part * 64 + q * 8), m1 = *(const f32x4*)(mu + part * 64 + q * 8 + 4);
#pragma unroll
            for (int e = 0; e < 4; ++e) { c[e] = c[e] + (p[e] - c[e]) * m0[e]; c[4 + e] = c[4 + e] + (p[4 + e] - c[4 + e]) * m1[e]; }
            const u32x4 o = pack8(c);
            if (layer == 0) *(u32x4*)(VF + (size_t)m * 512 + part * 64 + q * 8) = o; else *(LAS u32x4*)(VB + tok * VP + part * 64 + q * 8) = o; }
        if (layer == 0) continue;
        __syncthreads();
        { const int rb = pwave & 3, jt = pwave >> 2; f32x4 acc = {0.f, 0.f, 0.f, 0.f};
#pragma unroll 4
          for (int k0 = 0; k0 < 512; k0 += 32) acc = __builtin_amdgcn_mfma_f32_16x16x32_bf16(*(const LAS bf16x8*)(VB + (16 * rb + r16) * VP + k0 + 8 * q4), *(const bf16x8*)(vdT + (size_t)(16 * jt + r16) * 512 + k0 + 8 * q4), acc, 0, 0, 0);
#pragma unroll
          for (int jj = 0; jj < 4; ++jj) VD[(16 * rb + 4 * q4 + jj) * 40 + 16 * jt + r16] = (bf16)f2bf(acc[jj]); }
        __syncthreads();
        { const int rb = pwave & 3; const bf16x8 af = *(const LAS bf16x8*)(VD + (16 * rb + r16) * 40 + 8 * q4);
#pragma unroll 4
          for (int i = 0; i < 16; ++i) { const int ct = (pwave >> 2) * 16 + i;
              const f32x4 acc = __builtin_amdgcn_mfma_f32_16x16x32_bf16(af, *(const bf16x8*)(vuT + (size_t)(16 * ct + r16) * 32 + 8 * q4), (f32x4){0.f, 0.f, 0.f, 0.f}, 0, 0, 0);
              const float vc = v0[16 * ct + r16];
#pragma unroll
              for (int jj = 0; jj < 4; ++jj) GB[(16 * rb + 4 * q4 + jj) * VP + 16 * ct + r16] = (bf16)f2bf(sigm(vc + acc[jj])); } }
        __syncthreads();
#pragma unroll
        for (int q = 0; q < 8; ++q) { float v[8], g[8], vf[8]; unpack8(*(const LAS u32x4*)(VB + tok * VP + part * 64 + q * 8), v); unpack8(*(const LAS u32x4*)(GB + tok * VP + part * 64 + q * 8), g);
            unpack8(*(const u32x4*)(VF + (size_t)m * 512 + part * 64 + q * 8), vf);
#pragma unroll
            for (int e = 0; e < 8; ++e) v[e] = v[e] + (vf[e] - v[e]) * g[e];
            *(u32x4*)(VM + (size_t)m * 512 + part * 64 + q * 8) = pack8(v); }
        __syncthreads();
    }
}
__device__ __forceinline__ void prepass_a(Frame& F) {
    const int tid = otid();
    bf16* P = (bf16*)(F.ws + WS_BIG); bf16* BND2 = (bf16*)(F.ws + WS_BND2);
    { const int ch = tid & 127; const int kind = ch >> 6, part = ch & 7;
      unsigned fph[4];
#pragma unroll
      for (int p = 0; p < 4; ++p) fph[p] = (unsigned)(long long)(exp(-(double)(part * 4 + p) * (9.210340371976184 / 32.0)) * 0.15915494309189535 * 4294967296.0 + 0.5);
      const int mstep = F.G * 4;
      for (int m0 = F.vcu * 4 + (tid >> 7); m0 < M; m0 += 4 * mstep) {
          u32x4 raw[4];
#pragma unroll
          for (int i = 0; i < 4; ++i) { const int m = m0 + i * mstep; raw[i] = (m < M) ? *(const u32x4*)(P + (size_t)m * PLD + C_RET + ch * 8) : (u32x4){0u, 0u, 0u, 0u}; }
#pragma unroll
          for (int i = 0; i < 4; ++i) { const int m = m0 + i * mstep; if (m >= M) break;
              const int t = m & (T - 1); bf16* ptr = P + (size_t)m * PLD + C_RET + ch * 8;
              float x[8]; unpack8(raw[i], x);
#pragma unroll
              for (int p = 0; p < 4; ++p) { const float rev = (float)((unsigned)t * fph[p]) * 2.3283064365386963e-10f;
                  const float sn = __builtin_amdgcn_sinf(rev), cs = __builtin_amdgcn_cosf(rev);
                  const float x0 = x[2 * p], x1 = x[2 * p + 1]; float o0 = x0 * cs - x1 * sn, o1 = x0 * sn + x1 * cs;
                  if (kind) { o0 *= 0.125f; o1 *= 0.125f; }
                  x[2 * p] = o0; x[2 * p + 1] = o1; }
              *(u32x4*)ptr = pack8(x); } } }
    for (int i = F.vcu * 512 + tid; i < 1024 * 3 * 128; i += F.G * 512) { const int ch = i & 127, k = (i >> 7) % 3, r = i / 384;
        if ((r & 511) != 0) *(u32x4*)(BND2 + ((size_t)r * 3 + k) * 1024 + ch * 8) = *(const u32x4*)(P + ((size_t)r * 32 - 3 + k) * PLD + C_XBC + ch * 8); }
}
__device__ __forceinline__ void prepass_conv(Frame& F, int layer) {
    const int tid = otid();
    bf16* P = (bf16*)(F.ws + WS_BIG); const bf16* BND2 = (const bf16*)(F.ws + WS_BND2);
    const float* cw = INP(17) + layer * 1024 * 4; const float* cbias = INP(18) + layer * 1024;
    const int ch = tid & 127;
    f32x4 wv[8]; float bv[8];
#pragma unroll
    for (int e = 0; e < 8; ++e) { wv[e] = *(const f32x4*)(cw + (ch * 8 + e) * 4); bv[e] = cbias[ch * 8 + e]; }
    for (int r = F.vcu * 4 + (tid >> 7); r < M / 32; r += F.G * 4) {
        float w0[8], w1[8], w2[8];
        if ((r & 511) != 0) { unpack8(*(const u32x4*)(BND2 + ((size_t)r * 3 + 0) * 1024 + ch * 8), w0); unpack8(*(const u32x4*)(BND2 + ((size_t)r * 3 + 1) * 1024 + ch * 8), w1); unpack8(*(const u32x4*)(BND2 + ((size_t)r * 3 + 2) * 1024 + ch * 8), w2); }
        else {
#pragma unroll
            for (int e = 0; e < 8; ++e) { w0[e] = 0.f; w1[e] = 0.f; w2[e] = 0.f; } }
        bf16* ptr = P + (size_t)r * 32 * PLD + C_XBC + ch * 8;
#pragma unroll 4
        for (int i = 0; i < 32; ++i) {
            float x[8], o[8]; unpack8(*(const u32x4*)(ptr + (size_t)i * PLD), x);
#pragma unroll
            for (int e = 0; e < 8; ++e) { o[e] = silu(bv[e] + wv[e][0] * w0[e] + wv[e][1] * w1[e] + wv[e][2] * w2[e] + wv[e][3] * x[e]); w0[e] = w1[e]; w1[e] = w2[e]; w2[e] = x[e]; }
            *(u32x4*)(ptr + (size_t)i * PLD) = pack8(o);
        }
    }
}
template <int CTRL> __device__ __forceinline__ float dpp_f(float v) { return __builtin_bit_cast(float, __builtin_amdgcn_update_dpp(0, __builtin_bit_cast(int, v), CTRL, 0xF, 0xF, true)); }
__device__ __forceinline__ float red8(float v) { v += dpp_f<0xB1>(v); v += dpp_f<0x4E>(v); v += dpp_f<0x141>(v); return v; }
__device__ __forceinline__ float red16(float v) { v = red8(v); v += dpp_f<0x140>(v); return v; }

__device__ __forceinline__ void rwkv_seq(Frame& F, int layer, int bh) {
    const int ptid = otid(), plane = ptid & 63, pwave = __builtin_amdgcn_readfirstlane(ptid >> 6); (void)plane; (void)pwave;
    const int b = bh >> 3, h = bh & 7;
    LAS float* L = (LAS float*)F.lds;
    LAS float *rr = L, *ww = L + 2048, *kf = L + 4096, *vv = L + 6144, *aa = L + 8192, *bb = L + 10240, *gg = L + 12288, *yy = L + 14336, *tw = L + 16384, *xa = L + 18432, *sg = L + 20480, *bon = L + 24576;
    const float* mu = INP(3) + layer * 1792; const float* w_up = INP(4) + layer * 64 * 512; const float* w0 = INP(5) + layer * 512;
    const float* a_up = INP(6) + layer * 64 * 512; const float* a0 = INP(7) + layer * 512; const float* g_up = INP(8) + layer * 128 * 512;
    const float* k_k = INP(9) + layer * 512; const float* k_a = INP(10) + layer * 512; const float* r_k = INP(11) + layer * 512;
    const float* gn_w = INP(12) + layer * 512; const float* gn_b = INP(13) + layer * 512;
    const bf16* P = (const bf16*)(F.ws + WS_BIG); const bf16* vsrc = (const bf16*)(F.ws + (layer == 0 ? WS_VF : WS_VMIX)); bf16* yout = (bf16*)(F.ws + WS_YRW);
    const int tid = ptid, tok = tid >> 4, part = tid & 15, c4 = part * 4, cb = h * 64 + c4;
    const int srow = tid >> 3, sc0 = (tid & 7) * 8;
    float S[8];
#pragma unroll
    for (int j = 0; j < 8; ++j) S[j] = 0.f;
    for (int t0 = 0; t0 < T; t0 += 32) {
        {
            const int t = t0 + tok; const size_t m = (size_t)b * T + t;
            const bf16* cur = P + m * PLD;
#pragma unroll
            for (int q = 0; q < 3; ++q) {
                const int ch = part + 16 * q; int col, kind; LAS float* dst;
                if (ch < 8) { col = h * 64 + ch * 8; dst = rr + tok * 64 + ch * 8; kind = 0; }
                else if (ch < 16) { col = 512 + h * 64 + (ch - 8) * 8; dst = kf + tok * 64 + (ch - 8) * 8; kind = 0; }
                else if (ch < 24) { col = 1536 + (ch - 16) * 8; dst = tw + tok * 64 + (ch - 16) * 8; kind = 1; }
                else if (ch < 32) { col = 1600 + (ch - 24) * 8; dst = xa + tok * 64 + (ch - 24) * 8; kind = 0; }
                else { col = 1664 + (ch - 32) * 8; dst = sg + tok * 128 + (ch - 32) * 8; kind = 2; }
                float c[8], p[8]; unpack8(*(const u32x4*)(cur + col), c);
                if (t > 0) unpack8(*(const u32x4*)(cur - PLD + col), p); else {
#pragma unroll
                    for (int e = 0; e < 8; ++e) p[e] = 0.f; }
#pragma unroll
                for (int e = 0; e < 8; ++e) { float x = c[e] + (p[e] - c[e]) * mu[col + e]; if (kind == 1) x = tanhf(x); else if (kind == 2) x = sigm(x); dst[e] = x; }
            }
            if (part < 8) { float v[8]; unpack8(*(const u32x4*)(vsrc + m * 512 + h * 64 + part * 8), v);
#pragma unroll
                for (int e = 0; e < 8; ++e) vv[tok * 64 + part * 8 + e] = v[e]; }
        }
        __syncthreads();
        {
            f32x4 dw = *(const f32x4*)(w0 + cb), da = *(const f32x4*)(a0 + cb), dg = (f32x4){0.f, 0.f, 0.f, 0.f};
            for (int j = 0; j < 64; ++j) { const float tj = tw[tok * 64 + j], xj = xa[tok * 64 + j];
                dw += *(const f32x4*)(w_up + j * 512 + cb) * tj; da += *(const f32x4*)(a_up + j * 512 + cb) * xj; }
            for (int j = 0; j < 128; ++j) dg += *(const f32x4*)(g_up + j * 512 + cb) * sg[tok * 128 + j];
            float kr[4], kk[4], av[4], ss = 0.f;
#pragma unroll
            for (int e = 0; e < 4; ++e) { kr[e] = kf[tok * 64 + c4 + e]; kk[e] = kr[e] * k_k[cb + e]; ss += kk[e] * kk[e]; av[e] = sigm(da[e]); }
            ss = red16(ss);
            const float inv = __builtin_amdgcn_rsqf(fmaxf(ss, 1e-24f));
            float bs = 0.f;
#pragma unroll
            for (int e = 0; e < 4; ++e) { const float kn = kk[e] * inv; const int o = tok * 64 + c4 + e;
                const float ld = -expf(-softplus_acc(-dw[e]) - 0.5f);
                ww[o] = expf(ld); aa[o] = -kn; bb[o] = kn * av[e];
                const float knew = kr[e] * (1.f + (av[e] - 1.f) * k_a[cb + e]); kf[o] = knew; gg[o] = dg[e];
                bs += rr[o] * knew * r_k[cb + e]; }
            bs = red16(bs);
            if (part == 0) bon[tok] = bs;
        }
        __syncthreads();
        for (int s = 0; s < 32; ++s) {
            const f32x4 a0v = *(const LAS f32x4*)(aa + s * 64 + sc0), a1v = *(const LAS f32x4*)(aa + s * 64 + sc0 + 4);
            const f32x4 w0v = *(const LAS f32x4*)(ww + s * 64 + sc0), w1v = *(const LAS f32x4*)(ww + s * 64 + sc0 + 4);
            const f32x4 b0v = *(const LAS f32x4*)(bb + s * 64 + sc0), b1v = *(const LAS f32x4*)(bb + s * 64 + sc0 + 4);
            const f32x4 k0v = *(const LAS f32x4*)(kf + s * 64 + sc0), k1v = *(const LAS f32x4*)(kf + s * 64 + sc0 + 4);
            const f32x4 r0v = *(const LAS f32x4*)(rr + s * 64 + sc0), r1v = *(const LAS f32x4*)(rr + s * 64 + sc0 + 4);
            const float vi = vv[s * 64 + srow];
            float sa = 0.f;
#pragma unroll
            for (int j = 0; j < 4; ++j) sa += S[j] * a0v[j] + S[4 + j] * a1v[j];
            sa = red8(sa);
            float y = 0.f;
#pragma unroll
            for (int j = 0; j < 4; ++j) { S[j] = S[j] * w0v[j] + sa * b0v[j] + vi * k0v[j]; S[4 + j] = S[4 + j] * w1v[j] + sa * b1v[j] + vi * k1v[j]; y += S[j] * r0v[j] + S[4 + j] * r1v[j]; }
            y = red8(y);
            if ((tid & 7) == 0) yy[s * 64 + srow] = y;
        }
        __syncthreads();
        {
            const size_t m = (size_t)b * T + t0 + tok;
            float y[4], sm = 0.f;
#pragma unroll
            for (int e = 0; e < 4; ++e) { y[e] = yy[tok * 64 + c4 + e]; sm += y[e]; }
            const float mean = red16(sm) * (1.f / 64.f);
            float vs = 0.f;
#pragma unroll
            for (int e = 0; e < 4; ++e) { y[e] -= mean; vs += y[e] * y[e]; }
            const float rs = __builtin_amdgcn_rsqf(red16(vs) * (1.f / 64.f) + 64e-5f);
            const float bo = bon[tok];
            float o[4];
#pragma unroll
            for (int e = 0; e < 4; ++e) { const int idx = tok * 64 + c4 + e; o[e] = (y[e] * rs * gn_w[cb + e] + gn_b[cb + e] + bo * vv[idx]) * gg[idx]; }
            u32x2 w; w.x = pk2(o[0], o[1]); w.y = pk2(o[2], o[3]);
            *(u32x2*)(yout + m * 512 + cb) = w;
        }
        __syncthreads();
    }
}

__device__ __forceinline__ void ret_seq(Frame& F, int bh) {
    const int ptid = otid(), plane = ptid & 63, pwave = __builtin_amdgcn_readfirstlane(ptid >> 6); (void)plane; (void)pwave;
    const int b = bh >> 3, h = bh & 7;
    LAS float* L = (LAS float*)F.lds;
    LAS float *qq = L, *kk = L + 2048, *vv = L + 4096, *gg = L + 6144, *yy = L + 8192;
    bf16* P = (bf16*)(F.ws + WS_BIG);
    const int tid = ptid, tok = tid >> 4, part = tid & 15, c4 = part * 4;
    const int se = tid >> 3, sd0 = (tid & 7) * 8;
    const float gamma = 1.f - exp2f(-5.f - (float)h);
    float S[8];
#pragma unroll
    for (int j = 0; j < 8; ++j) S[j] = 0.f;
    for (int t0 = 0; t0 < T; t0 += 32) {
        {
            const int t = t0 + tok; const size_t m = (size_t)b * T + t;
#pragma unroll
            for (int q = 0; q < 2; ++q) {
                const int ch = part + 16 * q, kind = ch >> 3, cc = ch & 7;
                float x[8]; unpack8(*(const u32x4*)(P + m * PLD + C_RET + kind * 512 + h * 64 + cc * 8), x);
                LAS float* dst = (kind == 0 ? qq : kind == 1 ? kk : kind == 2 ? vv : gg) + tok * 64 + cc * 8;
                if (kind < 2) {
#pragma unroll
                    for (int p = 0; p < 4; ++p) { const int i = cc * 4 + p;
                        const double invf = exp(-(double)i * (9.210340371976184 / 32.0));
                        double sn, cs; sincos((double)t * invf, &sn, &cs);
                        const float x0 = x[2 * p], x1 = x[2 * p + 1], c = (float)cs, s = (float)sn;
                        float o0 = x0 * c - x1 * s, o1 = x0 * s + x1 * c;
                        if (kind == 1) { o0 *= 0.125f; o1 *= 0.125f; }
                        dst[2 * p] = o0; dst[2 * p + 1] = o1; }
                } else {
#pragma unroll
                    for (int e = 0; e < 8; ++e) dst[e] = x[e];
                }
            }
        }
        __syncthreads();
        for (int s = 0; s < 32; ++s) {
            const f32x4 k0v = *(const LAS f32x4*)(kk + s * 64 + sd0), k1v = *(const LAS f32x4*)(kk + s * 64 + sd0 + 4);
            const f32x4 q0v = *(const LAS f32x4*)(qq + s * 64 + sd0), q1v = *(const LAS f32x4*)(qq + s * 64 + sd0 + 4);
            const float ve = vv[s * 64 + se];
            float y = 0.f;
#pragma unroll
            for (int j = 0; j < 4; ++j) { S[j] = gamma * S[j] + k0v[j] * ve; S[4 + j] = gamma * S[4 + j] + k1v[j] * ve; y += q0v[j] * S[j] + q1v[j] * S[4 + j]; }
            y = red8(y);
            if ((tid & 7) == 0) yy[s * 64 + se] = y;
        }
        __syncthreads();
        {
            const size_t m = (size_t)b * T + t0 + tok;
            float y[4], ss = 0.f;
#pragma unroll
            for (int e = 0; e < 4; ++e) { y[e] = yy[tok * 64 + c4 + e]; ss += y[e] * y[e]; }
            const float rs = __builtin_amdgcn_rsqf(red16(ss) * (1.f / 64.f) + 1e-6f);
            float o[4];
#pragma unroll
            for (int e = 0; e < 4; ++e) o[e] = y[e] * rs * silu(gg[tok * 64 + c4 + e]);
            u32x2 w; w.x = pk2(o[0], o[1]); w.y = pk2(o[2], o[3]);
            *(u32x2*)(P + m * PLD + C_RETG + h * 64 + c4) = w;
        }
        __syncthreads();
    }
}

__device__ __forceinline__ void ssd_seq(Frame& F, int layer, int bh) {
    const int ptid = otid(), plane = ptid & 63, pwave = __builtin_amdgcn_readfirstlane(ptid >> 6); (void)plane; (void)pwave;
    const int b = bh >> 3, h = bh & 7, g = h >> 2;
    LAS float* L = (LAS float*)F.lds;
    LAS float *raw = L  , *xs = L + 11200, *Bc = L + 13248, *Cc = L + 17344, *yy = L + 21440, *dts = L + 23488, *das = L + 23520;
    bf16* P = (bf16*)(F.ws + WS_BIG); const float* dtb = (const float*)(F.ws + WS_DT);
    const float* cw = INP(17) + layer * 1024 * 4; const float* cbias = INP(18) + layer * 1024;
    const float dt_bias = INP(19)[layer * 8 + h], A = -expf(INP(20)[layer * 8 + h]), Dh = INP(21)[layer * 8 + h];
    const int tid = ptid;
    const int sp = tid >> 3, sn0 = (tid & 7) * 16;
    float S[16];
#pragma unroll
    for (int j = 0; j < 16; ++j) S[j] = 0.f;
    for (int i = tid; i < 3 * 320; i += 512) raw[i] = 0.f;
    __syncthreads();
    for (int t0 = 0; t0 < T; t0 += 32) {
        for (int idx = tid; idx < 32 * 40; idx += 512) {
            const int row = idx / 40, ch = idx % 40; const size_t m = (size_t)b * T + t0 + row;
            const int col = ch < 8 ? (C_XBC + h * 64 + ch * 8) : (ch < 24 ? (C_XBC + 512 + g * 128 + (ch - 8) * 8) : (C_XBC + 768 + g * 128 + (ch - 24) * 8));
            float x[8]; unpack8(*(const u32x4*)(P + m * PLD + col), x);
#pragma unroll
            for (int e = 0; e < 8; ++e) raw[(3 + row) * 320 + ch * 8 + e] = x[e];
        }
        if (tid < 32) { const size_t m = (size_t)b * T + t0 + tid; const float dt = softplus_acc(dtb[m * 8 + h] + dt_bias); dts[tid] = dt; das[tid] = expf(A * dt); }
        __syncthreads();
        for (int idx = tid; idx < 32 * 320; idx += 512) {
            const int row = idx / 320, c = idx % 320;
            const int chn = c < 64 ? (h * 64 + c) : (c < 192 ? (512 + g * 128 + (c - 64)) : (768 + g * 128 + (c - 192)));
            float a = cbias[chn];
#pragma unroll
            for (int k = 0; k < 4; ++k) a += cw[chn * 4 + k] * raw[(row + k) * 320 + c];
            a = silu(a);
            if (c < 64) xs[row * 64 + c] = a; else if (c < 192) Bc[row * 128 + (c - 64)] = a; else Cc[row * 128 + (c - 192)] = a;
        }
        __syncthreads();
        for (int s = 0; s < 32; ++s) {
            const float da = das[s], xv = xs[s * 64 + sp], dtx = dts[s] * xv;
            float y = 0.f;
#pragma unroll
            for (int q = 0; q < 4; ++q) { const f32x4 bv = *(const LAS f32x4*)(Bc + s * 128 + sn0 + q * 4), cv = *(const LAS f32x4*)(Cc + s * 128 + sn0 + q * 4);
#pragma unroll
                for (int j = 0; j < 4; ++j) { S[q * 4 + j] = da * S[q * 4 + j] + dtx * bv[j]; y += S[q * 4 + j] * cv[j]; } }
            y = red8(y);
            if ((tid & 7) == 0) yy[s * 64 + sp] = y + Dh * xv;
        }
        __syncthreads();
        {
            const int tok = tid >> 4, c4 = (tid & 15) * 4; const size_t m = (size_t)b * T + t0 + tok;
            u32x2 w; w.x = pk2(yy[tok * 64 + c4], yy[tok * 64 + c4 + 1]); w.y = pk2(yy[tok * 64 + c4 + 2], yy[tok * 64 + c4 + 3]);
            *(u32x2*)(P + m * PLD + C_XBC + h * 64 + c4) = w;
            for (int i = tid; i < 3 * 320; i += 512) raw[i] = raw[32 * 320 + i];
        }
        __syncthreads();
    }
}
__device__ __forceinline__ void ssm_norm_phase(Frame& F, int layer) {
    const int ptid = otid(), plane = ptid & 63, pwave = __builtin_amdgcn_readfirstlane(ptid >> 6);
    const int gw = F.vcu * 8 + pwave, NGW = F.G * 8;
    bf16* P = (bf16*)(F.ws + WS_BIG); const float* nw = INP(22) + layer * 512;
    float nwv[8];
#pragma unroll
    for (int e = 0; e < 8; ++e) nwv[e] = nw[plane * 8 + e];
    for (int m0 = 4 * gw; m0 < M; m0 += 4 * NGW) {
        u32x4 yv[4], zv[4];
#pragma unroll
        for (int q = 0; q < 4; ++q) { yv[q] = *(const u32x4*)(P + (size_t)(m0 + q) * PLD + C_XBC + plane * 8); zv[q] = *(const u32x4*)(P + (size_t)(m0 + q) * PLD + C_Z + plane * 8); }
#pragma unroll
        for (int q = 0; q < 4; ++q) { float y[8], z[8]; unpack8(yv[q], y); unpack8(zv[q], z);
            float ss = 0.f;
#pragma unroll
            for (int e = 0; e < 8; ++e) { y[e] *= silu(z[e]); ss += y[e] * y[e]; }
            ss = red16(ss); ss += __shfl_xor(ss, 16);
            const float rs = __builtin_amdgcn_rsqf(ss * (1.f / 256.f) + 1e-6f);
#pragma unroll
            for (int e = 0; e < 8; ++e) y[e] *= rs * nwv[e];
            *(u32x4*)(P + (size_t)(m0 + q) * PLD + C_Z + plane * 8) = pack8(y); }
    }
}
constexpr int PT = 72, PT2 = 136, PF = 68;
__device__ __forceinline__ f32x4 mfma16(bf16x8 a, bf16x8 b, f32x4 c) { return __builtin_amdgcn_mfma_f32_16x16x32_bf16(a, b, c, 0, 0, 0); }
template <int K, bool SA = false, bool SB = false> __device__ __forceinline__ f32x4 mm_ll(const LAS bf16* A, int pa, int m0, const LAS bf16* B, int pb, int n0, f32x4 acc, int lane) {
    const int r = lane & 15, q = lane >> 4;
    const int xa = SA ? (((m0 + r) >> 3) & 7) : 0, xb = SB ? (((n0 + r) >> 3) & 7) : 0;
    const LAS bf16* ap = A + (m0 + r) * pa; const LAS bf16* bp = B + (n0 + r) * pb;
#pragma unroll
    for (int k0 = 0; k0 < K; k0 += 32) acc = mfma16(*(const LAS bf16x8*)(ap + 8 * (((k0 >> 3) + q) ^ xa)), *(const LAS bf16x8*)(bp + 8 * (((k0 >> 3) + q) ^ xb)), acc);
    return acc;
}
template <int K> __device__ __forceinline__ f32x4 mm_lg(const LAS bf16* A, int pa, int m0, const bf16* B, int pb, int n0, f32x4 acc, int lane) {
    const int r = lane & 15, q = lane >> 4;
    const LAS bf16* ap = A + (m0 + r) * pa + 8 * q; const bf16* bp = B + (size_t)(n0 + r) * pb + 8 * q;
#pragma unroll
    for (int k0 = 0; k0 < K; k0 += 32) acc = mfma16(*(const LAS bf16x8*)(ap + k0), *(const bf16x8*)(bp + k0), acc);
    return acc;
}
__device__ __forceinline__ float redl16(float v) { return red16(v); }
__device__ __forceinline__ void st4bf(LAS bf16* p, f32x4 v) { u32x2 w; w.x = pk2(v[0], v[1]); w.y = pk2(v[2], v[3]); *(LAS u32x2*)p = w; }
__device__ __forceinline__ float ldbf(const LAS bf16* p) { return __builtin_bit_cast(float, (unsigned)(*p) << 16); }
constexpr f32x4 FZ4 = {0.f, 0.f, 0.f, 0.f};
__device__ __forceinline__ void tr_write8(LAS bf16* Tm, int pitch, int c0, int t, const float (&v)[8], int) {
    LAS bf16* base = Tm + c0 * pitch + (t ^ (((c0 >> 3) & 7) << 3));
#pragma unroll
    for (int e = 0; e < 8; ++e) base[e * pitch] = (bf16)f2bf(v[e]);
}
__device__ __forceinline__ float tr_at(const LAS bf16* Tm, int pitch, int row, int col) { return __builtin_bit_cast(float, (unsigned)Tm[row * pitch + (col ^ (((row >> 3) & 7) << 3))] << 16); }
__device__ __forceinline__ void ld8f(const LAS float* p, float (&v)[8]) { const f32x4 a = *(const LAS f32x4*)p, b = *(const LAS f32x4*)(p + 4); v[0] = a[0]; v[1] = a[1]; v[2] = a[2]; v[3] = a[3]; v[4] = b[0]; v[5] = b[1]; v[6] = b[2]; v[7] = b[3]; }
__device__ __forceinline__ void st8f(LAS float* p, const float (&v)[8]) { *(LAS f32x4*)p = (f32x4){v[0], v[1], v[2], v[3]}; *(LAS f32x4*)(p + 4) = (f32x4){v[4], v[5], v[6], v[7]}; }

template <bool FINAL>
__device__ __forceinline__ void rwkv_chunk_units(Frame& F, int layer) {
    const int tid = otid(), w = __builtin_amdgcn_readfirstlane(tid >> 6);
    bf16x8 lfr[16];
#define IDS() const int ft = fresh_tid(tid); const int lane = ft & 63, r16 = lane & 15, q4 = lane >> 4, tok = ft >> 3, part = ft & 7; (void)lane; (void)r16; (void)q4; (void)tok; (void)part
    constexpr int NV = FINAL ? 64 : 128, NVT = NV / 16, NZ = NVT / 2;
    constexpr int X_TW = 0, X_XA = 9216, X_SG = 18432, X_KF = 35840, X_RF = 52224;
    constexpr int O_AT = 0, O_RT = 9216, O_BT = 18432, O_KT = 27648, O_BH = 36864, O_KH = 46080, O_VT = 55296, O_TF = O_BT;
    constexpr int Y0 = 68608;
    constexpr int Y_A = Y0, Y_B = Y0 + 8192, Y_K = Y0 + 16384, Y_R = Y0 + 24576, Y_L = Y0 + 32768, Y_VF = Y0 + 49152;
    constexpr int Y_AAB = Y0, Y_AAK = Y0 + 17408, Y_ARB = Y_AAK + 9216, Y_ARK = Y_ARB + 9216, Y_TB = FINAL ? Y_ARK + 9216 : Y_AAK + 9216, Y_ZU = Y_TB + 9216, Y_YF = Y_AAB;
    static_assert(Y_ZU + NV * PT * 2 <= Y0 + 65536, "region Y");
    constexpr int Z0 = Y0 + 65536, Z_G = Z0, Z_S = FINAL ? Z0 + 8192 : Z0, Z_MISC = 152576, Z_BON = Z_MISC, Z_PC = Z_MISC + 256, Z_PAR = Z_MISC + 512, Z_TOT = Z_PAR + 832 * 4, Z_XS = Y_ZU;
    static_assert(Z_S + NV * PT * 2 <= Z_MISC && Z_TOT + 4 * 64 * 4 <= LDSCTL_OFF, "region Z");
    LAS unsigned char* L = F.lds;
#define LB(off) ((LAS bf16*)(L + (off)))
#define LF(off) ((LAS float*)(L + (off)))
    const bf16* P = (const bf16*)(F.ws + WS_BIG); const bf16* vsrc = (const bf16*)(F.ws + (layer == 0 ? WS_VF : WS_VMIX));
    u32x4 pfc[6], pfp[6], pfv;
#define RW_PREFETCH(un, jn) do { IDS(); const int b_ = (un) >> 9, sc_ = ((un) >> 3) & 63, h_ = (un) & 7; const int t_ = sc_ * 256 + (jn) * 64 + tok; const size_t m_ = (size_t)b_ * T + t_; const bf16* cur_ = P + m_ * PLD; \
        _Pragma("unroll") for (int i_ = 0; i_ < 6; ++i_) { const int col_ = (i_ == 0) ? (h_ * 64 + 8 * part) : (i_ == 1) ? (512 + h_ * 64 + 8 * part) : (i_ == 2) ? (1536 + 8 * part) : (i_ == 3) ? (1600 + 8 * part) : (1664 + 8 * part + (i_ - 4) * 64); \
            pfc[i_] = *(const u32x4*)(cur_ + col_); pfp[i_] = (t_ > 0) ? *(const u32x4*)(cur_ - PLD + col_) : (u32x4){0u, 0u, 0u, 0u}; } \
        pfv = *(const u32x4*)(vsrc + m_ * 512 + h_ * 64 + 8 * part); } while (0)
    if (F.cid < 1024) RW_PREFETCH(F.cid, 0);
    int h_staged = -1;
    for (int u = F.cid; u < 1024; u += F.G) {
    const int b = u >> 9, sc = (u >> 3) & 63, h = u & 7;
    if (h != h_staged) { h_staged = h; __syncthreads();
    {
        const int pidx = (w == 0) ? 5 : (w == 1) ? 7 : (w == 2) ? 9 : (w == 3) ? 10 : (w == 4) ? 11 : (w == 5) ? 12 : 13;
        if (w < 7) LF(Z_PAR)[w * 64 + (tid & 63)] = (INP(pidx) + layer * 512 + h * 64)[tid & 63];
        const float* mu = INP(3) + layer * 1792;
        for (int i = tid; i < 384; i += 512) LF(Z_PAR)[448 + i] = mu[(i < 64) ? (h * 64 + i) : (i < 128) ? (512 + h * 64 + (i - 64)) : (1536 + (i - 128))];
    }
    __syncthreads();
    const bf16* WupT = (const bf16*)(F.ws + WS_LORA + (size_t)layer * LORA_STRIDE) + h * 64 * 64;
    const bf16* AupT = (const bf16*)(F.ws + WS_LORA + (size_t)layer * LORA_STRIDE + 65536) + h * 64 * 64;
    const bf16* GupT = (const bf16*)(F.ws + WS_LORA + (size_t)layer * LORA_STRIDE + 131072) + h * 64 * 128;
    { IDS();
        if (w < 4) {
#pragma unroll
            for (int nt = 0; nt < 4; ++nt)
#pragma unroll
                for (int k2 = 0; k2 < 2; ++k2) { lfr[nt * 4 + k2] = *(const bf16x8*)(WupT + (size_t)(16 * nt + r16) * 64 + 32 * k2 + 8 * q4); lfr[nt * 4 + 2 + k2] = *(const bf16x8*)(AupT + (size_t)(16 * nt + r16) * 64 + 32 * k2 + 8 * q4); }
        } else if (FINAL) {
#pragma unroll
            for (int nt = 0; nt < 4; ++nt)
#pragma unroll
                for (int k4 = 0; k4 < 4; ++k4) lfr[nt * 4 + k4] = *(const bf16x8*)(GupT + (size_t)(16 * nt + r16) * 128 + 32 * k4 + 8 * q4);
        } }
    }
    float* Nbuf = (float*)(F.st + 0) + (size_t)u * 4096; bf16* MT = (bf16*)(F.ws + WS_MT) + (size_t)u * 4096;
    constexpr int NST = FINAL ? 2 : 4;
    f32x4 Sacc[NST];
    const int s_vb = FINAL ? (w & 3) : w;
#define S_CT(ti) (FINAL ? (2 * (w >> 2) + (ti)) : (ti))
    { IDS();
#pragma unroll
    for (int ti = 0; ti < NST; ++ti) {
        const int ct = S_CT(ti);
        f32x4 nin = FZ4; if (FINAL) nin = *(const f32x4*)(Nbuf + ((s_vb * 4 + ct) * 64 + 16 * q4 + r16) * 4);
#pragma unroll
        for (int jj = 0; jj < 4; ++jj) { const int v = 16 * s_vb + 4 * q4 + jj, c = 16 * ct + r16;
            float x; if (FINAL) x = nin[jj]; else x = (v >= 64 && v - 64 == c) ? 1.f : 0.f;
            Sacc[ti][jj] = x; LB(Z_S)[v * PT + c] = (bf16)f2bf(x); }
    } }
    for (int j = 0; j < 4; ++j) {
        const int tl0 = sc * 256 + j * 64;
        {
            IDS();
            const int t = tl0 + tok; const size_t m = (size_t)b * T + t; const bf16* cur = P + m * PLD;
#pragma unroll
            for (int i = 0; i < 6; ++i) {
                const int col = (i == 0) ? (h * 64 + 8 * part) : (i == 1) ? (512 + h * 64 + 8 * part) : (i == 2) ? (1536 + 8 * part) : (i == 3) ? (1600 + 8 * part) : (1664 + 8 * part + (i - 4) * 64);
                float c[8], p[8]; unpack8(pfc[i], c); unpack8(pfp[i], p); (void)col;
#pragma unroll
                for (int e = 0; e < 8; ++e) c[e] = c[e] + (p[e] - c[e]) * LF(Z_PAR)[448 + ((i < 4) ? 64 * i : 256 + 64 * (i - 4)) + 8 * part + e];
                if (i == 0) { st8f(LF(X_RF) + tok * 64 + 8 * part, c);
                } else if (i == 1) { st8f(LF(X_KF) + tok * 64 + 8 * part, c);
                } else if (i == 2) {
#pragma unroll
                    for (int e = 0; e < 8; ++e) c[e] = fast_tanh(c[e]);
                    *(LAS u32x4*)(LB(X_TW) + tok * PT + 8 * part) = pack8(c);
                } else if (i == 3) {
                    *(LAS u32x4*)(LB(X_XA) + tok * PT + 8 * part) = pack8(c);
                } else if (FINAL) {
#pragma unroll
                    for (int e = 0; e < 8; ++e) c[e] = sigm(c[e]);
                    *(LAS u32x4*)(LB(X_SG) + tok * PT2 + 8 * part + (i - 4) * 64) = pack8(c);
                }
            }
            float v[8]; unpack8(pfv, v); (void)m; (void)cur;
            st8f(LF(Y_VF) + tok * 64 + 8 * part, v);
        }
        if (j < 3) RW_PREFETCH(u, j + 1); else if (u + F.G < 1024) RW_PREFETCH(u + F.G, 0);
        __syncthreads();
        { IDS();
        if (w < 4) {
            const int rb = w;
            float inv[4], bs[4] = {0.f, 0.f, 0.f, 0.f};
            { float ss[4] = {0.f, 0.f, 0.f, 0.f};
#pragma unroll
                for (int nt = 0; nt < 4; ++nt) { const int c = 16 * nt + r16; const float kkc = LF(Z_PAR)[128 + c];
#pragma unroll
                    for (int jj = 0; jj < 4; ++jj) { const float kk = LF(X_KF)[(16 * rb + 4 * q4 + jj) * 64 + c] * kkc; ss[jj] += kk * kk; } }
#pragma unroll
                for (int jj = 0; jj < 4; ++jj) inv[jj] = __builtin_amdgcn_rsqf(fmaxf(redl16(ss[jj]), 1e-24f)); }
#pragma unroll
            for (int nt = 0; nt < 4; ++nt) {
                f32x4 aw = FZ4, aa = FZ4;
#pragma unroll
                for (int k2 = 0; k2 < 2; ++k2) { aw = mfma16(*(const LAS bf16x8*)(LB(X_TW) + (16 * rb + r16) * PT + 32 * k2 + 8 * q4), lfr[nt * 4 + k2], aw); aa = mfma16(*(const LAS bf16x8*)(LB(X_XA) + (16 * rb + r16) * PT + 32 * k2 + 8 * q4), lfr[nt * 4 + 2 + k2], aa); }
                const int c = 16 * nt + r16; const float w0c = LF(Z_PAR)[c], a0c = LF(Z_PAR)[64 + c], kkc = LF(Z_PAR)[128 + c], kac = LF(Z_PAR)[192 + c], rkc = LF(Z_PAR)[256 + c];
                {
                    float lv[4];
#pragma unroll
                    for (int jj = 0; jj < 4; ++jj) lv[jj] = -0.8750455979f * sigm(w0c + aw[jj]);
                    lv[1] += lv[0]; lv[2] += lv[1]; lv[3] += lv[2];
                    const float s0 = lv[3]; const float u1 = __shfl(s0, (lane + 48) & 63); const float s1 = s0 + ((q4 >= 1) ? u1 : 0.f);
                    const float u2 = __shfl(s1, (lane + 32) & 63); const float s2 = s1 + ((q4 >= 2) ? u2 : 0.f); const float ex = s2 - s0;
#pragma unroll
                    for (int jj = 0; jj < 4; ++jj) LF(Y_L)[(16 * rb + 4 * q4 + jj) * 64 + c] = lv[jj] + ex;
                    if (q4 == 3) LF(Z_TOT)[rb * 64 + c] = lv[3] + ex; }
#pragma unroll
                for (int jj = 0; jj < 4; ++jj) { const int t = 16 * rb + 4 * q4 + jj, o = t * 64 + c;
                    const float al = sigm(a0c + aa[jj]), kraw = LF(X_KF)[o], rr = LF(X_RF)[o], kn = kraw * kkc * inv[jj];
                    const float knew = kraw * (1.f + (al - 1.f) * kac);
                    LB(Y_A)[o] = (bf16)f2bf(-kn); LB(Y_B)[o] = (bf16)f2bf(kn * al); LB(Y_K)[o] = (bf16)f2bf(knew); LB(Y_R)[o] = (bf16)f2bf(rr);
                    bs[jj] += rr * knew * rkc; } }
#pragma unroll
            for (int jj = 0; jj < 4; ++jj) { const float sm = redl16(bs[jj]); if (r16 == 0) LF(Z_BON)[16 * rb + 4 * q4 + jj] = sm; }
        } else if (FINAL) {
            const int rb = w - 4;
#pragma unroll
            for (int nt = 0; nt < 4; ++nt) { f32x4 ag = FZ4;
#pragma unroll
                for (int k4 = 0; k4 < 4; ++k4) ag = mfma16(*(const LAS bf16x8*)(LB(X_SG) + (16 * rb + r16) * PT2 + 32 * k4 + 8 * q4), lfr[nt * 4 + k4], ag);
#pragma unroll
                for (int jj = 0; jj < 4; ++jj) LB(Z_G)[(16 * rb + 4 * q4 + jj) * 64 + 16 * nt + r16] = (bf16)f2bf(ag[jj]); }
        } }
        __syncthreads();
        {
            IDS(); const int t = tok, c0 = 8 * part;
            float Lt[8], Lp[8], Le[8], av[8], bv[8], kv[8], rv[8], vv[8], at[8], rt[8], bt[8], kt[8], bh[8], kh[8];
            { float t0[8], t1[8], t2[8], t3[8], off[8]; ld8f(LF(Z_TOT) + c0, t0); ld8f(LF(Z_TOT) + 64 + c0, t1); ld8f(LF(Z_TOT) + 128 + c0, t2); ld8f(LF(Z_TOT) + 192 + c0, t3);
              ld8f(LF(Y_L) + t * 64 + c0, Lt); ld8f(LF(Y_VF) + t * 64 + c0, vv);
              if ((t & 15) != 0) ld8f(LF(Y_L) + (t - 1) * 64 + c0, Lp); else {
#pragma unroll
                  for (int e = 0; e < 8; ++e) Lp[e] = 0.f; }
              const int rbk = t >> 4;
#pragma unroll
              for (int e = 0; e < 8; ++e) { off[e] = ((rbk > 0) ? t0[e] : 0.f) + ((rbk > 1) ? t1[e] : 0.f) + ((rbk > 2) ? t2[e] : 0.f); Le[e] = (t0[e] + t1[e]) + (t2[e] + t3[e]); Lt[e] += off[e]; Lp[e] += off[e]; }
              if (t == 0) {
#pragma unroll
                  for (int e = 0; e < 8; ++e) LF(Z_PC)[c0 + e] = ex2(Le[e]); } }
            unpack8(*(const LAS u32x4*)(LB(Y_A) + t * 64 + c0), av); unpack8(*(const LAS u32x4*)(LB(Y_B) + t * 64 + c0), bv);
            unpack8(*(const LAS u32x4*)(LB(Y_K) + t * 64 + c0), kv); unpack8(*(const LAS u32x4*)(LB(Y_R) + t * 64 + c0), rv);
#pragma unroll
            for (int e = 0; e < 8; ++e) { const float eL = ex2(Lt[e]), eLm = ex2(Lp[e]), eN = ex2(-Lt[e]), eE = ex2(Le[e] - Lt[e]);
                at[e] = av[e] * eLm; rt[e] = rv[e] * eL; bt[e] = bv[e] * eN; kt[e] = kv[e] * eN; bh[e] = bv[e] * eE; kh[e] = kv[e] * eE; }
            tr_write8(LB(O_BH), PT, c0, t, bh, part); tr_write8(LB(O_KH), PT, c0, t, kh, part); tr_write8(LB(O_VT), PT, c0, t, vv, part);
            *(LAS u32x4*)(LB(O_AT) + t * PT + c0) = pack8(at); *(LAS u32x4*)(LB(O_RT) + t * PT + c0) = pack8(rt);
            *(LAS u32x4*)(LB(O_BT) + t * PT + c0) = pack8(bt); *(LAS u32x4*)(LB(O_KT) + t * PT + c0) = pack8(kt);
        }
        __syncthreads();
        {
            IDS(); const int rb = w & 3;
#pragma unroll
            for (int ci = 0; ci < 2; ++ci) { const int ct = 2 * (w >> 2) + ci;
                f32x4 ab = FZ4, ak = FZ4, arb = FZ4, ark = FZ4;
                if (ct <= rb) { ab = mm_ll<64>(LB(O_AT), PT, 16 * rb, LB(O_BT), PT, 16 * ct, FZ4, lane); ak = mm_ll<64>(LB(O_AT), PT, 16 * rb, LB(O_KT), PT, 16 * ct, FZ4, lane);
                    if (FINAL) { arb = mm_ll<64>(LB(O_RT), PT, 16 * rb, LB(O_BT), PT, 16 * ct, FZ4, lane); ark = mm_ll<64>(LB(O_RT), PT, 16 * rb, LB(O_KT), PT, 16 * ct, FZ4, lane); } }
#pragma unroll
                for (int jj = 0; jj < 4; ++jj) { const int t = 16 * rb + 4 * q4 + jj, i = 16 * ct + r16;
                    LF(Y_AAB)[t * PF + i] = (i < t) ? ab[jj] : 0.f; LB(Y_TB)[t * PT + i] = (bf16)f2bf(((i >> 4) < (t >> 4)) ? ab[jj] : 0.f); LB(Y_AAK)[t * PT + i] = (bf16)f2bf((i < t) ? ak[jj] : 0.f);
                    if (FINAL) { LB(Y_ARB)[t * PT + i] = (bf16)f2bf((i <= t) ? arb[jj] : 0.f); LB(Y_ARK)[t * PT + i] = (bf16)f2bf((i <= t) ? ark[jj] : 0.f); } } }
        }
        __syncthreads();
        {
            IDS(); const int rb = w & 3;
            constexpr int O_DB = O_BT, O_VB = O_BT + 5120;
            if (w == 0) { const int blk = lane >> 4, col = lane & 15; float x[16];
#pragma unroll
                for (int i = 0; i < 16; ++i) x[i] = (i == col) ? 1.f : 0.f;
#pragma unroll
                for (int g3 = 0; g3 < 3; ++g3) {
                    f32x4 ar[5][4];
#pragma unroll
                    for (int ii = 0; ii < 5; ++ii) { const int i = 1 + 5 * g3 + ii;
#pragma unroll
                        for (int g4 = 0; g4 < 4; ++g4) if (4 * g4 < i) ar[ii][g4] = *(const LAS f32x4*)(LF(Y_AAB) + (16 * blk + i) * PF + 16 * blk + 4 * g4); }
                    asm volatile("" ::: "memory");
#pragma unroll
                    for (int ii = 0; ii < 5; ++ii) { const int i = 1 + 5 * g3 + ii; float sacc = 0.f;
#pragma unroll
                        for (int m2 = 0; m2 < i; ++m2) sacc += ar[ii][m2 >> 2][m2 & 3] * x[m2];
                        x[i] += sacc; }
                }
#pragma unroll
                for (int i = 0; i < 16; ++i) LB(O_DB)[(16 * blk + i) * 40 + col] = (bf16)f2bf(x[i]);
                *(LAS u32x4*)(LB(O_DB) + lane * 40 + 16) = (u32x4){0u, 0u, 0u, 0u}; *(LAS u32x4*)(LB(O_DB) + lane * 40 + 24) = (u32x4){0u, 0u, 0u, 0u}; }
            if (lane < 16) { *(LAS u32x4*)(LB(O_VB) + w * 640 + lane * 40 + 16) = (u32x4){0u, 0u, 0u, 0u}; *(LAS u32x4*)(LB(O_VB) + w * 640 + lane * 40 + 24) = (u32x4){0u, 0u, 0u, 0u}; }
#pragma unroll
            for (int ci = 0; ci < NZ; ++ci) { const int vt = (w >> 2) * NZ + ci;
                f32x4 z = mm_ll<64>(LB(O_AT), PT, 16 * rb, LB(Z_S), PT, 16 * vt, FZ4, lane);
                if (vt < 4) z = mm_ll<64, false, true>(LB(Y_AAK), PT, 16 * rb, LB(O_VT), PT, 16 * vt, z, lane);
                st4bf(LB(Y_ZU) + (16 * vt + r16) * PT + 16 * rb + 4 * q4, z); }
            __syncthreads();
            if (w < NVT) { const int vt = w; LAS bf16* vb = LB(O_VB) + w * 640; LAS bf16* zrow = LB(Y_ZU) + (16 * vt + r16) * PT;
#pragma unroll
                for (int bb = 0; bb < 4; ++bb) {
                    f32x4 acc; { const u32x2 zz = *(const LAS u32x2*)(zrow + 16 * bb + 4 * q4); acc[0] = bflo(zz.x); acc[1] = bfhi(zz.x); acc[2] = bflo(zz.y); acc[3] = bfhi(zz.y); }
                    if (bb >= 1) acc = mfma16(*(const LAS bf16x8*)(LB(Y_TB) + (16 * bb + r16) * PT + 8 * q4), *(const LAS bf16x8*)(zrow + 8 * q4), acc);
                    if (bb >= 3) acc = mfma16(*(const LAS bf16x8*)(LB(Y_TB) + (16 * bb + r16) * PT + 32 + 8 * q4), *(const LAS bf16x8*)(zrow + 32 + 8 * q4), acc);
                    st4bf(vb + r16 * 40 + 4 * q4, acc);
                    const f32x4 ub = mfma16(*(const LAS bf16x8*)(LB(O_DB) + (16 * bb + r16) * 40 + 8 * q4), *(const LAS bf16x8*)(vb + r16 * 40 + 8 * q4), FZ4);
                    st4bf(zrow + 16 * bb + 4 * q4, ub); }
            }
        }
        __syncthreads();
        {
            IDS(); f32x4 yy[2];
            if (FINAL) { const int rb = w & 3;
#pragma unroll
                for (int ci = 0; ci < 2; ++ci) { const int ct = 2 * (w >> 2) + ci;
                    f32x4 y = mm_ll<64>(LB(O_RT), PT, 16 * rb, LB(Z_S), PT, 16 * ct, FZ4, lane);
                    y = mm_ll<64>(LB(Y_ARB), PT, 16 * rb, LB(Y_ZU), PT, 16 * ct, y, lane);
                    yy[ci] = mm_ll<64, false, true>(LB(Y_ARK), PT, 16 * rb, LB(O_VT), PT, 16 * ct, y, lane); } }
#pragma unroll
            for (int ti = 0; ti < NST; ++ti) { const int ct = S_CT(ti); const float pc = LF(Z_PC)[16 * ct + r16];
                f32x4 s = Sacc[ti] * pc;
                s = mm_ll<64, false, true>(LB(Y_ZU), PT, 16 * s_vb, LB(O_BH), PT, 16 * ct, s, lane);
                if (s_vb < 4) s = mm_ll<64, true, true>(LB(O_VT), PT, 16 * s_vb, LB(O_KH), PT, 16 * ct, s, lane);
                Sacc[ti] = s; }
            __syncthreads();
#pragma unroll
            for (int ti = 0; ti < NST; ++ti) { const int ct = S_CT(ti);
#pragma unroll
                for (int jj = 0; jj < 4; ++jj) LB(Z_S)[(16 * s_vb + 4 * q4 + jj) * PT + 16 * ct + r16] = (bf16)f2bf(Sacc[ti][jj]); }
            if (FINAL) { const int rb = w & 3;
#pragma unroll
                for (int ci = 0; ci < 2; ++ci) { const int ct = 2 * (w >> 2) + ci;
#pragma unroll
                    for (int jj = 0; jj < 4; ++jj) LF(Y_YF)[(16 * rb + 4 * q4 + jj) * PF + 16 * ct + r16] = yy[ci][jj]; } }
        }
        __syncthreads();
        if (FINAL) {
            IDS();
            const int t = tok, c0 = 8 * part; const size_t m = (size_t)b * T + tl0 + t;
            float y[8], gg[8], sm = 0.f; ld8f(LF(Y_YF) + t * PF + c0, y); unpack8(*(const LAS u32x4*)(LB(Z_G) + t * 64 + c0), gg);
#pragma unroll
            for (int e = 0; e < 8; ++e) sm += y[e];
            const float mean = red8(sm) * (1.f / 64.f); float vs = 0.f;
#pragma unroll
            for (int e = 0; e < 8; ++e) { y[e] -= mean; vs += y[e] * y[e]; }
            const float rs = __builtin_amdgcn_rsqf(red8(vs) * (1.f / 64.f) + 64e-5f), bo = LF(Z_BON)[t];
#pragma unroll
            for (int e = 0; e < 8; ++e) { const int c = c0 + e; y[e] = (y[e] * rs * LF(Z_PAR)[320 + c] + LF(Z_PAR)[384 + c] + bo * tr_at(LB(O_VT), PT, c, t)) * gg[e]; }
            *(u32x4*)((bf16*)(F.ws + WS_BIG) + m * PLD + 1024 + h * 64 + c0) = pack8(y);
        }
        __syncthreads();
    }
    if (!FINAL) { IDS();
#pragma unroll
        for (int ti = 0; ti < NST; ++ti) { const int ct = S_CT(ti);
            if (s_vb < 4) { *(f32x4*)(Nbuf + ((s_vb * 4 + ct) * 64 + 16 * q4 + r16) * 4) = Sacc[ti];
            } else { u32x2 wv; wv.x = pk2(Sacc[ti][0], Sacc[ti][1]); wv.y = pk2(Sacc[ti][2], Sacc[ti][3]);
                *(u32x2*)(MT + (16 * ct + r16) * 64 + 16 * (s_vb - 4) + 4 * q4) = wv; }
        }
    }
    }
#undef RW_PREFETCH
#undef IDS
#undef S_CT
#undef LB
#undef LF
}

template <bool FINAL>
__device__ __forceinline__ void ret_chunk_unit(Frame& F, int u) {
    const int tid = otid(), lane = tid & 63, w = __builtin_amdgcn_readfirstlane(tid >> 6), r16 = lane & 15, q4 = lane >> 4;
    const int b = u >> 9, sc = (u >> 3) & 63, h = u & 7;
    constexpr int R_QB = 0, R_KB = 9216, R_KHT = 18432, R_VT = 27648, R_GB = 36864, R_AB = 45056, R_SB = 54272, R_YF = 63488;
    LAS unsigned char* L = F.lds;
#define LB(off) ((LAS bf16*)(L + (off)))
#define LF(off) ((LAS float*)(L + (off)))
    bf16* P = (bf16*)(F.ws + WS_BIG);
    float* Sbuf = (float*)(F.st + 16 * MiB) + (size_t)u * 4096;
    const float lg = log2f(1.f - exp2f(-5.f - (float)h));
    const float g64 = ex2(64.f * lg);
    const int db = w & 3;
    f32x4 Sacc[2];
#pragma unroll
    for (int ci = 0; ci < 2; ++ci) { const int et = 2 * (w >> 2) + ci;
#pragma unroll
        for (int jj = 0; jj < 4; ++jj) Sacc[ci][jj] = FINAL ? Sbuf[(16 * db + 4 * q4 + jj) * 64 + 16 * et + r16] : 0.f;
        if (FINAL) st4bf(LB(R_SB) + (16 * et + r16) * PT + 16 * db + 4 * q4, Sacc[ci]); }
    const int tok = tid >> 3, part = tid & 7;
    u32x4 pq = {0u, 0u, 0u, 0u}, pk, pv, pg = {0u, 0u, 0u, 0u};
#define RET_PREFETCH(jn) do { const bf16* row_ = P + ((size_t)b * T + sc * 256 + (jn) * 64 + tok) * PLD + C_RET + h * 64 + 8 * part; \
        pk = *(const u32x4*)(row_ + 512); pv = *(const u32x4*)(row_ + 1024); if (FINAL) { pq = *(const u32x4*)row_; pg = *(const u32x4*)(row_ + 1536); } } while (0)
    RET_PREFETCH(0);
    for (int j = 0; j < 4; ++j) {
        const int tl0 = sc * 256 + j * 64;
        {
            float qv[8], kv[8], vv[8]; unpack8(pk, kv); unpack8(pv, vv);
            if (FINAL) { unpack8(pq, qv); *(LAS u32x4*)(LB(R_GB) + tok * 64 + 8 * part) = pg; }
            if (j < 3) RET_PREFETCH(j + 1);
            const float zeta = ex2((float)(63 - tok) * lg);
            if (FINAL) { *(LAS u32x4*)(LB(R_QB) + tok * PT + 8 * part) = pack8(qv); *(LAS u32x4*)(LB(R_KB) + tok * PT + 8 * part) = pack8(kv); }
            float kz[8];
#pragma unroll
            for (int e = 0; e < 8; ++e) kz[e] = kv[e] * zeta;
            tr_write8(LB(R_KHT), PT, 8 * part, tok, kz, part); tr_write8(LB(R_VT), PT, 8 * part, tok, vv, part);
        }
        __syncthreads();
        if (FINAL) { const int rb = w & 3;
#pragma unroll
            for (int ci = 0; ci < 2; ++ci) { const int ct = 2 * (w >> 2) + ci; f32x4 a = FZ4;
                if (ct <= rb) a = mm_ll<64>(LB(R_QB), PT, 16 * rb, LB(R_KB), PT, 16 * ct, FZ4, lane);
#pragma unroll
                for (int jj = 0; jj < 4; ++jj) { const int l = 16 * rb + 4 * q4 + jj, s = 16 * ct + r16; LB(R_AB)[l * PT + s] = (bf16)f2bf((s <= l) ? a[jj] * ex2((float)(l - s) * lg) : 0.f); } }
            __syncthreads();
        }
        {
            f32x4 yy[2];
            if (FINAL) { const int rb = w & 3;
#pragma unroll
                for (int ci = 0; ci < 2; ++ci) { const int et = 2 * (w >> 2) + ci;
                    const f32x4 a1 = mm_ll<64, false, true>(LB(R_AB), PT, 16 * rb, LB(R_VT), PT, 16 * et, FZ4, lane), a2 = mm_ll<64>(LB(R_QB), PT, 16 * rb, LB(R_SB), PT, 16 * et, FZ4, lane);
#pragma unroll
                    for (int jj = 0; jj < 4; ++jj) yy[ci][jj] = a1[jj] + ex2((float)(16 * rb + 4 * q4 + jj + 1) * lg) * a2[jj]; } }
#pragma unroll
            for (int ci = 0; ci < 2; ++ci) { const int et = 2 * (w >> 2) + ci; Sacc[ci] = mm_ll<64, true, true>(LB(R_KHT), PT, 16 * db, LB(R_VT), PT, 16 * et, Sacc[ci] * g64, lane); }
            __syncthreads();
            if (FINAL) { const int rb = w & 3;
#pragma unroll
                for (int ci = 0; ci < 2; ++ci) { const int et = 2 * (w >> 2) + ci; st4bf(LB(R_SB) + (16 * et + r16) * PT + 16 * db + 4 * q4, Sacc[ci]);
#pragma unroll
                    for (int jj = 0; jj < 4; ++jj) LF(R_YF)[(16 * rb + 4 * q4 + jj) * PF + 16 * et + r16] = yy[ci][jj]; } }
        }
        __syncthreads();
        if (FINAL) { const size_t m = (size_t)b * T + tl0 + tok; float y[8], g[8], ss = 0.f;
            ld8f(LF(R_YF) + tok * PF + 8 * part, y);
#pragma unroll
            for (int e = 0; e < 8; ++e) ss += y[e] * y[e];
            const float rs = __builtin_amdgcn_rsqf(red8(ss) * (1.f / 64.f) + 1e-6f);
            unpack8(*(const LAS u32x4*)(LB(R_GB) + tok * 64 + 8 * part), g);
#pragma unroll
            for (int e = 0; e < 8; ++e) y[e] = y[e] * rs * silu(g[e]);
            *(u32x4*)(P + m * PLD + C_RETG + h * 64 + 8 * part) = pack8(y);
            __syncthreads(); }
    }
    if (!FINAL) {
#pragma unroll
        for (int ci = 0; ci < 2; ++ci) { const int et = 2 * (w >> 2) + ci;
#pragma unroll
            for (int jj = 0; jj < 4; ++jj) Sbuf[(16 * db + 4 * q4 + jj) * 64 + 16 * et + r16] = Sacc[ci][jj]; }
    }
#undef RET_PREFETCH
#undef LB
#undef LF
}

template <bool FINAL>
__device__ __forceinline__ void ssd_chunk_unit(Frame& F, int layer, int u) {
    const int tid = otid(), w = __builtin_amdgcn_readfirstlane(tid >> 6);
#define IDS() const int ft = fresh_tid(tid); const int lane = ft & 63, r16 = lane & 15, q4 = lane >> 4; (void)lane; (void)r16; (void)q4
    const int b = u >> 9, sc = (u >> 3) & 63, h = u & 7, g = h >> 2;
    constexpr int D_CB = 0, D_BB = 17408, D_BT = 34816, D_YF = 53248, D_XT = 70656, D_XDT = 79872, D_GM = 89088, D_SB = 98304, D_MISC = 115712;
    constexpr int D_DTS = D_MISC, D_ACS = D_MISC + 256, D_CAR = D_MISC + 512;
    LAS unsigned char* L = F.lds;
#define LB(off) ((LAS bf16*)(L + (off)))
#define LF(off) ((LAS float*)(L + (off)))
    bf16* P = (bf16*)(F.ws + WS_BIG); const float* dtb = (const float*)(F.ws + WS_DT);
    const bf16* BND = (const bf16*)(F.ws + WS_BND);
    float* Sbuf = (float*)(F.st + 32 * MiB) + (size_t)u * 8192;
    const float* cw = INP(17) + layer * 1024 * 4; const float* cbias = INP(18) + layer * 1024;
    const float dt_bias = INP(19)[layer * 8 + h], A = -expf(INP(20)[layer * 8 + h]), Dh = INP(21)[layer * 8 + h];
    const int bc_chunk = tid & 31, bc_chn = (bc_chunk < 16) ? (512 + g * 128 + bc_chunk * 8) : (768 + g * 128 + (bc_chunk - 16) * 8);
    const int x_chunk = tid & 7, x_chn = h * 64 + x_chunk * 8;
    const int pb = w & 3;
    f32x4 Sacc[4];
    { IDS();
#pragma unroll
    for (int ci = 0; ci < 4; ++ci) { const int nt = 4 * (w >> 2) + ci;
#pragma unroll
        for (int jj = 0; jj < 4; ++jj) { const float x = FINAL ? Sbuf[(16 * pb + 4 * q4 + jj) * 128 + 16 * nt + r16] : 0.f; Sacc[ci][jj] = x;
            if (FINAL) LB(D_SB)[(16 * pb + 4 * q4 + jj) * PT2 + 16 * nt + r16] = (bf16)f2bf(x); } } }
    float dstot = 0.f;
    u32x4 pbc[4], px; float pdt = 0.f;
#define SSD_PREFETCH(jn) do { const size_t m_ = (size_t)b * T + sc * 256 + (jn) * 64; \
        _Pragma("unroll") for (int it_ = 0; it_ < 4; ++it_) pbc[it_] = *(const u32x4*)(P + (m_ + it_ * 16 + (tid >> 5)) * PLD + C_XBC + bc_chn); \
        px = *(const u32x4*)(P + (m_ + (tid >> 3)) * PLD + C_XBC + x_chn); if (w == 0) pdt = dtb[(m_ + (tid & 63)) * 8 + h]; } while (0)
    SSD_PREFETCH(0);
    for (int j = 0; j < 4; ++j) {
        const int tl0 = sc * 256 + j * 64; const size_t m0 = (size_t)b * T + tl0;
        if (w == 0) {
            IDS(); const float dt = softplus_acc(pdt + dt_bias); float a = A * dt;
#pragma unroll
            for (int o = 1; o < 64; o <<= 1) { const float n = __shfl_up(a, o); if (lane >= o) a += n; }
            LF(D_DTS)[lane] = dt; LF(D_ACS)[lane] = a;
        }
        {
            IDS();
#pragma unroll
            for (int it = 0; it < 4; ++it) { const int t = it * 16 + (ft >> 5); const int ta = tl0 + t;
                float acc[8]; unpack8(pbc[it], acc); (void)ta;
                if (bc_chunk < 16) { *(LAS u32x4*)(LB(D_BB) + t * PT2 + bc_chunk * 8) = pack8(acc); tr_write8(LB(D_BT), PT, bc_chunk * 8, t, acc, bc_chunk & 7); }
                else *(LAS u32x4*)(LB(D_CB) + t * PT2 + (bc_chunk - 16) * 8) = pack8(acc);
            }
        }
        __syncthreads();
        {
            IDS(); const int t = ft >> 3; float acc[8]; unpack8(px, acc);
            if (j < 3) SSD_PREFETCH(j + 1);
            const float sc_d = LF(D_DTS)[t] * __expf(LF(D_ACS)[63] - LF(D_ACS)[t]);
            float xs8[8], xd8[8];
#pragma unroll
            for (int e = 0; e < 8; ++e) { xs8[e] = acc[e]; xd8[e] = acc[e] * sc_d; }
            tr_write8(LB(D_XT), PT, x_chunk * 8, t, xs8, x_chunk); tr_write8(LB(D_XDT), PT, x_chunk * 8, t, xd8, x_chunk);
        }
        if (FINAL) { IDS(); const int rb = w & 3;
#pragma unroll
            for (int ci = 0; ci < 2; ++ci) { const int ct = 2 * (w >> 2) + ci; f32x4 a = FZ4;
                if (ct <= rb) a = mm_ll<128>(LB(D_CB), PT2, 16 * rb, LB(D_BB), PT2, 16 * ct, FZ4, lane);
#pragma unroll
                for (int jj = 0; jj < 4; ++jj) { const int l = 16 * rb + 4 * q4 + jj, s = 16 * ct + r16;
                    LB(D_GM)[l * PT + s] = (bf16)f2bf((s <= l) ? a[jj] * __expf(LF(D_ACS)[l] - LF(D_ACS)[s]) * LF(D_DTS)[s] : 0.f); } } }
        __syncthreads();
        {
            IDS(); f32x4 yy[2];
            if (FINAL) { const int rb = w & 3;
#pragma unroll
                for (int ci = 0; ci < 2; ++ci) { const int pt = 2 * (w >> 2) + ci;
                    const f32x4 a1 = mm_ll<64, false, true>(LB(D_GM), PT, 16 * rb, LB(D_XT), PT, 16 * pt, FZ4, lane), a2 = mm_ll<128>(LB(D_CB), PT2, 16 * rb, LB(D_SB), PT2, 16 * pt, FZ4, lane);
#pragma unroll
                    for (int jj = 0; jj < 4; ++jj) { const int l = 16 * rb + 4 * q4 + jj, p = 16 * pt + r16; yy[ci][jj] = a1[jj] + __expf(LF(D_ACS)[l]) * a2[jj] + Dh * tr_at(LB(D_XT), PT, p, l); } } }
            const float dec = expf(LF(D_ACS)[63]);
#pragma unroll
            for (int ci = 0; ci < 4; ++ci) { const int nt = 4 * (w >> 2) + ci; Sacc[ci] = mm_ll<64, true, true>(LB(D_XDT), PT, 16 * pb, LB(D_BT), PT, 16 * nt, Sacc[ci] * dec, lane); }
            dstot += LF(D_ACS)[63];
            __syncthreads();
            if (FINAL) { const int rb = w & 3;
#pragma unroll
                for (int ci = 0; ci < 4; ++ci) { const int nt = 4 * (w >> 2) + ci;
#pragma unroll
                    for (int jj = 0; jj < 4; ++jj) LB(D_SB)[(16 * pb + 4 * q4 + jj) * PT2 + 16 * nt + r16] = (bf16)f2bf(Sacc[ci][jj]); }
#pragma unroll
                for (int ci = 0; ci < 2; ++ci) { const int pt = 2 * (w >> 2) + ci;
#pragma unroll
                    for (int jj = 0; jj < 4; ++jj) LF(D_YF)[(16 * rb + 4 * q4 + jj) * PF + 16 * pt + r16] = yy[ci][jj]; } }
        }
        __syncthreads();
        if (FINAL) { IDS(); const int tok = ft >> 3, part = ft & 7; float y[8];
            ld8f(LF(D_YF) + tok * PF + 8 * part, y);
            *(u32x4*)(P + (m0 + tok) * PLD + C_XBC + h * 64 + 8 * part) = pack8(y);
            __syncthreads(); }
    }
    if (!FINAL) { IDS();
#pragma unroll
        for (int ci = 0; ci < 4; ++ci) { const int nt = 4 * (w >> 2) + ci;
#pragma unroll
            for (int jj = 0; jj < 4; ++jj) Sbuf[(16 * pb + 4 * q4 + jj) * 128 + 16 * nt + r16] = Sacc[ci][jj]; }
        if (tid == 0) ((float*)(F.ws + WS_DSTOT))[u] = dstot;
    }
#undef SSD_PREFETCH
#undef IDS
#undef LB
#undef LF
}

#define LBAR() do { asm volatile("s_waitcnt lgkmcnt(0)" ::: "memory"); __builtin_amdgcn_s_barrier(); asm volatile("" ::: "memory"); } while (0)
__device__ __forceinline__ void rwkv_scan_chain(Frame& F, int chain) {
    const int tid = otid(), lane = tid & 63, w = __builtin_amdgcn_readfirstlane(tid >> 6), r16 = lane & 15, q4 = lane >> 4;
    const int b = chain >> 3, h = chain & 7, vb = w & 3, ct0 = 2 * (w >> 2);
    LAS bf16* SB = (LAS bf16*)F.lds;
    f32x4 Sacc[2] = {FZ4, FZ4};
    for (int i = tid; i < 64 * PT / 2; i += 512) ((LAS unsigned*)SB)[i] = 0u;
    f32x4 nv[4][2]; bf16x8 mf[4][2][2];
#define CH_FETCH(s_, sc_) do { const int u_ = (b * 64 + (sc_)) * 8 + h; \
        const float* Nb_ = (const float*)(F.st + 0) + (size_t)u_ * 4096; const bf16* MT_ = (const bf16*)(F.ws + WS_MT) + (size_t)u_ * 4096; \
        _Pragma("unroll") for (int ci = 0; ci < 2; ++ci) { \
            nv[s_][ci] = *(const f32x4*)(Nb_ + ((vb * 4 + ct0 + ci) * 64 + lane) * 4); \
            _Pragma("unroll") for (int k2 = 0; k2 < 2; ++k2) mf[s_][ci][k2] = *(const bf16x8*)(MT_ + (size_t)(16 * (ct0 + ci) + r16) * 64 + 32 * k2 + 8 * q4); } } while (0)
    CH_FETCH(0, 0); CH_FETCH(1, 1); CH_FETCH(2, 2); CH_FETCH(3, 3);
    LBAR();
    for (int sc0 = 0; sc0 < 64; sc0 += 4) {
#pragma unroll
        for (int s = 0; s < 4; ++s) {
            const int sc = sc0 + s, u = (b * 64 + sc) * 8 + h;
            float* Nb = (float*)(F.st + 0) + (size_t)u * 4096;
            f32x4 nw[2];
#pragma unroll
            for (int ci = 0; ci < 2; ++ci) {
                f32x4 a = nv[s][ci];
#pragma unroll
                for (int k2 = 0; k2 < 2; ++k2) a = mfma16(*(const LAS bf16x8*)(SB + (16 * vb + r16) * PT + 32 * k2 + 8 * q4), mf[s][ci][k2], a);
                nw[ci] = a;
                *(f32x4*)(Nb + ((vb * 4 + ct0 + ci) * 64 + lane) * 4) = Sacc[ci]; }
            CH_FETCH(s, (sc + 4 < 64) ? sc + 4 : 63);
            LBAR();
#pragma unroll
            for (int ci = 0; ci < 2; ++ci) { Sacc[ci] = nw[ci];
#pragma unroll
                for (int jj = 0; jj < 4; ++jj) SB[(16 * vb + 4 * q4 + jj) * PT + 16 * (ct0 + ci) + r16] = (bf16)f2bf(nw[ci][jj]); }
            LBAR();
        }
    }
#undef CH_FETCH
    __syncthreads();
}
template <int ESZ, bool SSD> __device__ __forceinline__ void elem_scan_item(float* p, const float* d, float g256) {
    float carry = 0.f;
    for (int s0 = 0; s0 < 64; s0 += 32) {
        float t[32], dec[32];
#pragma unroll
        for (int sc = 0; sc < 32; ++sc) t[sc] = p[(size_t)(s0 + sc) * 8 * ESZ];
        if (SSD) {
#pragma unroll
            for (int sc = 0; sc < 32; ++sc) dec[sc] = d[(s0 + sc) * 8];
        }
#pragma unroll
        for (int sc = 0; sc < 32; ++sc) { p[(size_t)(s0 + sc) * 8 * ESZ] = carry; carry = (SSD ? __expf(dec[sc]) : g256) * carry + t[sc]; }
    }
}
__device__ __forceinline__ void elem_scans(Frame& F, int blk, int nblk) {
    const int tid = otid();
    const int NRET = 16 * 4096, NSSD = 16 * 8192;
    const float* dst = (const float*)(F.ws + WS_DSTOT);
    for (int it = blk * 512 + tid; it < NRET + NSSD; it += nblk * 512) {
        if (it < NRET) { const int chain = it >> 12, e = it & 4095, b = chain >> 3, h = chain & 7;
            const float g256 = exp2f(256.f * log2f(1.f - exp2f(-5.f - (float)h)));
            elem_scan_item<4096, false>((float*)(F.st + 16 * MiB) + ((size_t)(b * 64) * 8 + h) * 4096 + e, nullptr, g256);
        } else { const int i2 = it - NRET, chain = i2 >> 13, e = i2 & 8191, b = chain >> 3, h = chain & 7;
            elem_scan_item<8192, true>((float*)(F.st + 32 * MiB) + ((size_t)(b * 64) * 8 + h) * 8192 + e, dst + (b * 64) * 8 + h, 0.f);
        }
    }
}
__device__ __forceinline__ void conv_lora(Frame& F) {
    const int tid = otid();
    for (int l = 0; l < 2; ++l) {
        bf16* base = (bf16*)(F.ws + WS_LORA + (size_t)l * LORA_STRIDE);
        const float* wu = INP(4) + l * 64 * 512; const float* au = INP(6) + l * 64 * 512; const float* gu = INP(8) + l * 128 * 512;
        for (int i = F.vcu * 512 + tid; i < 512 * 64; i += F.G * 512) { const int c = i >> 6, jx = i & 63; base[i] = (bf16)f2bf(wu[jx * 512 + c]); base[32768 + i] = (bf16)f2bf(au[jx * 512 + c]); }
        for (int i = F.vcu * 512 + tid; i < 512 * 128; i += F.G * 512) { const int c = i >> 7, jx = i & 127; base[65536 + i] = (bf16)f2bf(gu[jx * 512 + c]); }
    }
}
__device__ __forceinline__ void conv_vlora(Frame& F) {
    const int tid = otid();
    bf16* vdT = (bf16*)(F.ws + WS_VLORA); bf16* vuT = vdT + 32 * 512;
    const float* vdn = INP(14); const float* vup = INP(15);
    for (int i = F.vcu * 512 + tid; i < 32 * 512; i += F.G * 512) { const int j = i >> 9, c = i & 511; vdT[i] = (bf16)f2bf(vdn[c * 32 + j]); }
    for (int i = F.vcu * 512 + tid; i < 512 * 32; i += F.G * 512) { const int c = i >> 5, j = i & 31; vuT[i] = (bf16)f2bf(vup[j * 512 + c]); }
}
__device__ __forceinline__ void save_bnd(Frame& F) {
    const int tid = otid();
    const bf16* P = (const bf16*)(F.ws + WS_BIG); bf16* BND = (bf16*)(F.ws + WS_BND);
    for (int i = F.vcu * 512 + tid; i < 2 * 64 * 3 * 64; i += F.G * 512) { const int ch = i & 63, k = (i >> 6) % 3, bs = i / 192, b = bs >> 6, sc = bs & 63;
        if (sc > 0) *(u32x4*)(BND + (size_t)(bs * 3 + k) * 512 + ch * 8) = *(const u32x4*)(P + ((size_t)b * T + sc * 256 - 3 + k) * PLD + C_XBC + ch * 8); }
}

__device__ __forceinline__ void stagger(int cid) { (void)cid; }
constexpr int LAYER_BASE0 = 1, LAYER_STRIDE = 18, MOE_BASE = LAYER_BASE0 + LAYER_STRIDE + 15;
__device__ __forceinline__ Frame lf(const Frame& F0) {
    Frame F = F0; unsigned l = (unsigned)(unsigned long long)F.lds;
    asm volatile("" : "+s"(l), "+s"(F.vcu), "+s"(F.G), "+s"(F.cid), "+s"(F.wid), "+s"(F.out), "+s"(F.ws), "+s"(F.st));
    F.lds = (LAS unsigned char*)(unsigned long long)l; return F;
}
__global__ void __launch_bounds__(512, 2) fwd(Args args) {
    extern __shared__ __attribute__((aligned(16))) unsigned char lds_raw[];
    Frame F0;
    F0.lds = (LAS unsigned char*)lds_raw;
    F0.G = gridDim.x; { const int bx = blockIdx.x; F0.vcu = (F0.G % 8 == 0) ? (bx % 8) * (F0.G / 8) + bx / 8 : bx; }
    F0.rr = 0; F0.cid = blockIdx.x; F0.out = (GAS float*)args.out; F0.ws = (GAS unsigned char*)args.ws; F0.wid = __builtin_amdgcn_readfirstlane(threadIdx.x >> 6); F0.st = (GAS unsigned char*)args.ws + WS_XB;
    volatile LAS unsigned* MISC = (volatile LAS unsigned*)(F0.lds + MISC_OFF);
    for (int u = threadIdx.x; u < (LDS_BYTES - LDSCTL_OFF) / 4; u += 512) ((LAS unsigned*)(F0.lds + LDSCTL_OFF))[u] = 0u;
    __syncthreads();
    if (threadIdx.x < 34) *(LAS unsigned long long*)(F0.lds + LDSCTL_OFF + 8 * threadIdx.x) = (unsigned long long)args.in[threadIdx.x];
    __syncthreads();
    const int lo = args.ph_lo, hi = args.ph_hi;
    XcdBarrier bar; bar.bar = (unsigned*)(F0.ws + WS_CTL); bar.x = 0; bar.st = nullptr;
    if (hi - lo > 1) bar = xcd_barrier_post((unsigned*)(F0.ws + WS_CTL), MISC + 8);
#define IN(k) (lo <= (k) && (k) < hi)
#define SEAM(k) do { if (IN(k) && IN((k) + 1)) xcd_barrier(bar); } while (0)
#define WSP(T_, off) ((T_*)(F.ws + (off)))

    if (IN(0)) { Frame F = lf(F0); conv_layer_weights(F, 0, 0); conv_lora(F); conv_vlora(F); xprep_phase(F, INP(0)); }
    SEAM(0);
    for (int l = 0; l < 2; ++l) {
        const int pb = LAYER_BASE0 + l * LAYER_STRIDE;
        F0.st = (GAS unsigned char*)F0.out;
        if (IN(pb + 0)) {
            Frame F = lf(F0); unsigned char* wl = (unsigned char*)(F.ws + WS_W + (size_t)l * WL_STRIDE);
            pg8::Gemm g{WSP(bf16, WS_XB), (const bf16*)(wl + WL_IN), D, D, D}; pg8::StaticOrder S; S.init(M, NP, F.G, F.cid, D, D);
            pg8::EpiInProj E{WSP(bf16, WS_BIG), (l == 0) ? WSP(float, WS_RSTD) : WSP(float, WS_SS1), WSP(float, WS_DT), l};
            stagger(F.cid); pg8::gemm_phase(F.lds, F.wid, g, S, E);
        }
        SEAM(pb + 0);
        if (IN(pb + 1)) { Frame F = lf(F0); vprep_phase(F, l); prepass_a(F); }
        SEAM(pb + 1);
        if (IN(pb + 2)) { Frame F = lf(F0); prepass_conv(F, l); }
        if (IN(pb + 2) && IN(pb + 3)) xcd_barrier(bar);
        if (IN(pb + 3)) for (int rep = 0; rep <= REP_R1; ++rep) {
#if RW_CH
            for (int r2 = 0; r2 <= REP_RW; ++r2) { Frame F = lf(F0); rwkv_chunk_units<false>(F, l); }
#else
            { Frame F = lf(F0); if (F.cid < 16) rwkv_seq(F, l, F.cid); }
#endif
#if RET_CH
            for (int r2 = 0; r2 <= REP_RET; ++r2) { Frame F = lf(F0); for (int u = F.cid; u < 1024; u += F.G) ret_chunk_unit<false>(F, u); }
#else
            { Frame F = lf(F0); if (F.cid >= 32 && F.cid < 48) ret_seq(F, F.cid - 32); }
#endif
#if SSD_CH
            for (int r2 = 0; r2 <= REP_SSD; ++r2) { Frame F = lf(F0); for (int u = F.cid; u < 1024; u += F.G) ssd_chunk_unit<false>(F, l, u); }
#else
            { Frame F = lf(F0); if (F.cid >= 16 && F.cid < 32) ssd_seq(F, l, F.cid - 16); }
#endif
        }
        SEAM(pb + 3);
        if (IN(pb + 4)) { Frame F = lf(F0); elem_scans(F, F.cid, F.G); }
        SEAM(pb + 4);
        if (IN(pb + 5)) {
            Frame F = lf(F0);
            if (F.cid < 16) { if (RW_CH) rwkv_scan_chain(F, F.cid);
                for (int u = 960 + F.cid; u < 1024; u += 16) ret_chunk_unit<true>(F, u);
                for (int u = 960 + F.cid; u < 1024; u += 16) ssd_chunk_unit<true>(F, l, u); }
            else {
                Frame Fc = lf(F0); Fc.vcu = Fc.cid - 16; Fc.cid = Fc.cid - 16; Fc.G = Fc.G - 16;
                if (l == 0) { conv_layer_weights(Fc, 0, 1); conv_layer_weights(Fc, 1, 0); conv_layer_weights(Fc, 1, 1); conv_ffn_weights(Fc); conv_moe_weights(Fc, 0, 3); }
                else conv_moe_weights(Fc, 3, NE);
                __syncthreads();
                for (int u = Fc.cid; u < 960; u += Fc.G) ret_chunk_unit<true>(Fc, u);
                for (int u = Fc.cid; u < 960; u += Fc.G) ssd_chunk_unit<true>(Fc, l, u);
            }
        }
        if (IN(pb + 5)) xcd_barrier(bar);
        if (IN(pb + 5)) { Frame F = lf(F0); rwkv_chunk_units<true>(F, l); }
        SEAM(pb + 5);
        if (IN(pb + 6)) { Frame F = lf(F0); ssm_norm_phase(F, l); }
        SEAM(pb + 6);
        if (IN(pb + 7)) {
            Frame F = lf(F0); unsigned char* wl = (unsigned char*)(F.ws + WS_W + (size_t)l * WL_STRIDE); bf16* P = WSP(bf16, WS_BIG);
            pg8::Gemm g{P, (const bf16*)(wl + WL_BR), PLD, 512, 512}; pg8::BranchOrder S; S.init(F.G, F.cid);
            pg8::EpiPlain E{P, WSP(bf16, WS_VMIX)};
            stagger(F.cid); pg8::gemm_phase(F.lds, F.wid, g, S, E);
        }
        SEAM(pb + 7);
        if (IN(pb + 8)) {
            Frame F = lf(F0); unsigned char* wl = (unsigned char*)(F.ws + WS_W + (size_t)l * WL_STRIDE); bf16* P = WSP(bf16, WS_BIG);
            pg8::Gemm g{WSP(bf16, WS_XB), (const bf16*)(wl + WL_GATE), D, D, D}; pg8::GateOrder S; S.init(F.G, F.cid);
            pg8::EpiGateMerge E{P, WSP(const bf16, WS_VMIX), P + C_RET, PLD, (l == 0) ? WSP(float, WS_RSTD) : WSP(float, WS_SS1), l};
            stagger(F.cid); pg8::gemm_phase(F.lds, F.wid, g, S, E);
        }
        if (IN(pb + 8) && IN(pb + 13)) xcd_barrier(bar);
        if (IN(pb + 13)) {
            Frame F = lf(F0); unsigned char* wl = (unsigned char*)(F.ws + WS_W + (size_t)l * WL_STRIDE); bf16* P = WSP(bf16, WS_BIG);
            pg8::Gemm g{P + C_RET, (const bf16*)(wl + WL_OUT), PLD, D, D}; pg8::StaticOrder S; S.init(M, D, F.G, F.cid, PLD, D);
            pg8::EpiResidB E{WSP(bf16, WS_XB), (l == 0) ? WSP(float, WS_SS2) : nullptr, nullptr};
            stagger(F.cid); pg8::gemm_phase(F.lds, F.wid, g, S, E);
        }
        SEAM(pb + 13);
        if (IN(pb + 14)) { Frame F = lf(F0); if (l == 1) router_phase(F); }
        if (l == 1) SEAM(pb + 14);
        if (l == 0) {
            if (IN(pb + 15)) {
                Frame F = lf(F0);
                pg8::Gemm g{WSP(bf16, WS_XB), WSP(const bf16, WS_FFUP), D, D, D}; pg8::StaticOrder S; S.init(M, 2 * FF, F.G, F.cid, D, D);
                pg8::EpiSwiglu E{WSP(bf16, WS_ACT), FF, WSP(float, WS_SS2), 1};
                stagger(F.cid); pg8::gemm_phase(F.lds, F.wid, g, S, E);
            }
            SEAM(pb + 15);
            if (IN(pb + 16)) {
                Frame F = lf(F0);
                pg8::Gemm g{WSP(const bf16, WS_ACT), WSP(const bf16, WS_FFDN), FF, FF, FF}; pg8::StaticOrder S; S.init(M, D, F.G, F.cid, FF, FF);
                pg8::EpiResidB E{WSP(bf16, WS_XB), WSP(float, WS_SS1), nullptr};
                stagger(F.cid); pg8::gemm_phase(F.lds, F.wid, g, S, E);
            }
            if (IN(pb + 16) && IN(pb + 18)) xcd_barrier(bar);
        }
    }
    {
        const int pb = MOE_BASE;
        for (int st = 0; st < 6; ++st) {
            const int isup = (st == 0 || st == 2 || st == 3), sg = (st < 2) ? 0 : ((st == 2 || st == 4) ? 1 : 2);
            if (IN(pb + st)) {
                if (isup) {
                    Frame F = lf(F0);
                    unsigned char* wb = (unsigned char*)F.out + MOEW_OUT; const size_t b6 = (size_t)((unsigned char*)(F.ws + WS_FFUP) - wb), b7 = (size_t)((unsigned char*)(F.ws + WS_VF + 16 * MiB) - wb);
                    pg8::Gemm g{WSP(bf16, WS_X8), (const bf16*)wb, D / 2, D / 2, D / 2}; pg8::MoeOrder<true> S; S.init(WSP(const int, WS_CNT), WSP(const int, WS_LIST), sg, 2 * FFE, F.G, F.cid, D / 2, D / 2, MOEW_STRIDE, b6, b7);
                    pg8::EpiSwiglu8 E{(sg == 2) ? WSP(unsigned char, WS_ACT2) : WSP(unsigned char, WS_ACT), FFE};
                    stagger(F.cid); pg8::gemm_phase<pg8::EpiSwiglu8, pg8::MoeOrder<true>, true>(F.lds, F.wid, g, S, E);
                } else {
                    Frame F = lf(F0);
                    const int ksp = (sg == 2) ? MOE_KSP : 1;
                    unsigned char* wb = (unsigned char*)F.out + MOEW_OUT; const size_t b6 = (size_t)((unsigned char*)(F.ws + WS_FFUP) - wb), b7 = (size_t)((unsigned char*)(F.ws + WS_VF + 16 * MiB) - wb);
                    pg8::Gemm g{(sg == 2) ? WSP(const bf16, WS_ACT2) : WSP(const bf16, WS_ACT), (const bf16*)(wb + MOEW_DN), FFE / 2, FFE / 2, FFE / 2 / ksp}; pg8::MoeOrder<false> S; S.init(WSP(const int, WS_CNT), WSP(const int, WS_LIST), sg, D, F.G, F.cid, FFE / 2, FFE / 2, MOEW_STRIDE, b6, b7, ksp, FFE / 2 / ksp);
                    pg8::EpiMoeOut E{(sg == 0) ? WSP(bf16, WS_YP0) : (sg == 1 ? WSP(bf16, WS_YP1) : WSP(bf16, WS_YP2)), YP2_STRIDE / 2, 1.f / 1024.f};
                    stagger(F.cid); pg8::gemm_phase<pg8::EpiMoeOut, pg8::MoeOrder<false>, true>(F.lds, F.wid, g, S, E);
                }
            }
            SEAM(pb + st);
        }
        if (IN(pb + 6)) { Frame F = lf(F0); final_norm_phase(F); }
    }
#undef IN
#undef SEAM
#undef WSP
}
constexpr int LAST_PHASE = MOE_BASE + 6;
constexpr int N_PH = LAST_PHASE + 1;

extern "C" void kernel_launch(void* const* d_in, const int* in_sizes, int n_in, void* d_out, int out_size, void* d_ws, size_t ws_size, hipStream_t stream) {
    static int grid = 0;
    if (grid == 0) {
        if (n_in != 34 || out_size != M * D || ws_size < WS_END) { fprintf(stderr, "kernel_launch: unexpected problem (n_in %d out %d ws %zu need %zu)\n", n_in, out_size, ws_size, (size_t)WS_END); grid = -1; return; }
        int dev = 0, cus = 0;
        if (hipGetDevice(&dev) != hipSuccess || hipDeviceGetAttribute(&cus, hipDeviceAttributeMultiprocessorCount, dev) != hipSuccess) { grid = -1; return; }
        if (hipFuncSetAttribute((const void*)fwd, hipFuncAttributeMaxDynamicSharedMemorySize, LDS_BYTES) != hipSuccess) { fprintf(stderr, "kernel_launch: hipFuncSetAttribute failed\n"); grid = -1; return; }
        int per_cu = 0;
        if (hipOccupancyMaxActiveBlocksPerMultiprocessor(&per_cu, (const void*)fwd, 512, LDS_BYTES) != hipSuccess || per_cu < 1) fprintf(stderr, "kernel_launch: occupancy query says %d\n", per_cu);
        (void)hipGetLastError();
        grid = cus;
    }
    if (grid < 0) return;
    (void)hipMemsetAsync((char*)d_ws + WS_CTL, 0, CTL_ZERO_BYTES, stream);
    Args a{};
    for (int i = 0; i < 34; ++i) a.in[i] = (const float*)d_in[i];
    a.out = (float*)d_out; a.ws = (unsigned char*)d_ws;
#if MK_ONE_LAUNCH
    a.ph_lo = 0; a.ph_hi = N_PH;
    hipLaunchKernelGGL(fwd, dim3(grid), dim3(512), LDS_BYTES, stream, a);
#else
    for (int p = 0; p < N_PH; ++p) { a.ph_lo = p; a.ph_hi = p + 1; hipLaunchKernelGGL(fwd, dim3(grid), dim3(512), LDS_BYTES, stream, a); }
#endif
}
```

```cpp
#include <hip/hip_runtime.h>
#include <cstdio>
#include <cstdint>

#ifndef MK_ONE_LAUNCH
#define MK_ONE_LAUNCH 1
#endif

#define LAS __attribute__((address_space(3)))
#define GAS __attribute__((address_space(1)))
typedef unsigned short bf16;
typedef short bf16x8 __attribute__((ext_vector_type(8)));
typedef float f32x4 __attribute__((ext_vector_type(4)));
typedef float f32x2 __attribute__((ext_vector_type(2)));
typedef unsigned u32x4 __attribute__((ext_vector_type(4)));
typedef unsigned u32x2 __attribute__((ext_vector_type(2)));

constexpr int BATCH = 2, T = 16384, D = 1024, M = BATCH * T;
constexpr int INC = 8456;
constexpr int PLD = 5376;
constexpr int NP = 5632;
constexpr int C_RW = 0, C_Z = 1792, C_XBC = 2304, C_RET = 3328, C_RETG = 4864;
constexpr int FF = 2816, FFE = 3584, NE = 8;

constexpr size_t MiB = 1u << 20;
constexpr size_t WS_CTL = 0, CTL_ZERO_BYTES = 64 * 1024;
constexpr size_t WS_RSTD = 1 * MiB, WS_GATES = 2 * MiB, WS_DT = 3 * MiB;
constexpr size_t WS_W = 4 * MiB;
constexpr size_t WL_IN = 0, WL_GATE = 11 * MiB, WL_BR = 17 * MiB, WL_OUT = 20 * MiB, WL_STRIDE = 22 * MiB;
constexpr size_t WS_FFUP = WS_W + 44 * MiB, WS_FFDN = WS_W + 55 * MiB;
constexpr size_t WS_XB = 68 * MiB;
constexpr size_t WS_VF = 132 * MiB;
constexpr size_t WS_BIG = 164 * MiB;
constexpr size_t WS_VMIX = WS_BIG + 336 * MiB, WS_YRW = WS_BIG + 368 * MiB, WS_END = 577 * MiB;
constexpr size_t WS_MOEW_UNUSED = WS_BIG;
constexpr size_t MOEW_STRIDE = 21 * MiB / 2, MOEW_DN = 7 * MiB;
constexpr size_t MOEW_OUT = 64 * MiB;
constexpr size_t X8_OUT = 96 * MiB;
constexpr size_t WS_X8 = WS_BIG + 88 * MiB;
constexpr int MOE_KSP = 2;
constexpr size_t WS_ACT = WS_BIG + 168 * MiB;

constexpr size_t WS_YP0 = WS_BIG, WS_YP1 = WS_BIG + 280 * MiB, WS_YP2 = 556 * MiB, YP2_STRIDE = 4 * MiB, WS_PINFO = 572 * MiB, WS_ACT2 = WS_BIG + 120 * MiB;
constexpr size_t WS_CNT = 32768, WS_LIST = 2 * MiB;
constexpr size_t WS_BND2 = 566 * MiB;
constexpr size_t WS_VLORA = 192 * 1024;
constexpr size_t WS_SS1 = 573 * MiB, WS_SS2 = 575 * MiB;
constexpr size_t WS_DSTOT = 128 * 1024, WS_BND = 256 * 1024;
constexpr size_t WS_LORA = 1 * MiB + 512 * 1024, LORA_STRIDE = 262144;
constexpr size_t WS_ST_RW = WS_XB, WS_ST_RET = WS_XB + 16 * MiB, WS_ST_SSD = WS_XB + 32 * MiB, WS_MT = WS_YRW;
constexpr int RING_BYTES = 131072, LDSCTL_OFF = 159744, MISC_OFF = LDSCTL_OFF + 320, LDS_BYTES = 163840;
#ifndef FFN_UP8
#define FFN_UP8 1
#endif
#ifndef FFN_DN8
#define FFN_DN8 0
#endif
#ifndef REP_CONV
#define REP_CONV 0
#endif
#ifndef REP_R1
#define REP_R1 0
#endif
#ifndef REP_RW
#define REP_RW 0
#endif
#ifndef REP_RET
#define REP_RET 0
#endif
#ifndef REP_SSD
#define REP_SSD 0
#endif
#ifndef REP_MISC
#define REP_MISC 0
#endif
#ifndef RW_CH
#define RW_CH 1
#endif
#ifndef RET_CH
#define RET_CH 1
#endif
#ifndef SSD_CH
#define SSD_CH 1
#endif

typedef __bf16 hbf16x2 __attribute__((ext_vector_type(2)));
__device__ __forceinline__ unsigned pk2(float lo, float hi) { const f32x2 v = {lo, hi}; return __builtin_bit_cast(unsigned, __builtin_convertvector(v, hbf16x2)); }
__device__ __forceinline__ unsigned f2bf(float f) { return (unsigned)__builtin_bit_cast(unsigned short, (__bf16)f); }
__device__ __forceinline__ float bflo(unsigned u) { return __builtin_bit_cast(float, u << 16); }
__device__ __forceinline__ float bfhi(unsigned u) { return __builtin_bit_cast(float, u & 0xffff0000u); }
__device__ __forceinline__ void unpack8(const u32x4 u, float (&f)[8]) { f[0] = bflo(u.x); f[1] = bfhi(u.x); f[2] = bflo(u.y); f[3] = bfhi(u.y); f[4] = bflo(u.z); f[5] = bfhi(u.z); f[6] = bflo(u.w); f[7] = bfhi(u.w); }
__device__ __forceinline__ unsigned pk4f8(float a, float b, float c, float d) {
    a = __builtin_amdgcn_fmed3f(a, -448.f, 448.f); b = __builtin_amdgcn_fmed3f(b, -448.f, 448.f); c = __builtin_amdgcn_fmed3f(c, -448.f, 448.f); d = __builtin_amdgcn_fmed3f(d, -448.f, 448.f);
    int w = __builtin_amdgcn_cvt_pk_fp8_f32(a, b, 0, false); w = __builtin_amdgcn_cvt_pk_fp8_f32(c, d, w, true); return (unsigned)w; }
__device__ __forceinline__ u32x4 pack8(const float (&f)[8]) { u32x4 w; w.x = pk2(f[0], f[1]); w.y = pk2(f[2], f[3]); w.z = pk2(f[4], f[5]); w.w = pk2(f[6], f[7]); return w; }
__device__ __forceinline__ float sigm(float x) { return __builtin_amdgcn_rcpf(1.f + __expf(-x)); }
__device__ __forceinline__ float silu(float x) { return x * __builtin_amdgcn_rcpf(1.f + __expf(-x)); }
__device__ __forceinline__ float ex2(float x) { return __builtin_amdgcn_exp2f(x); }
__device__ __forceinline__ float fast_tanh(float x) { return 1.f - 2.f * __builtin_amdgcn_rcpf(1.f + __expf(2.f * x)); }
__device__ __forceinline__ float softplus_acc(float x) { return fmaxf(x, 0.f) + log1pf(expf(-fabsf(x))); }
__device__ __forceinline__ float wave_sum(float v) {
#pragma unroll
    for (int o = 1; o < 64; o <<= 1) v += __shfl_xor(v, o);
    return v;
}
__device__ __forceinline__ int otid_w(int wid) { unsigned z = 0u; asm volatile("" : "+v"(z)); int t = wid * 64 + (int)__builtin_amdgcn_mbcnt_hi(~0u, __builtin_amdgcn_mbcnt_lo(~0u, z)); asm volatile("" : "+v"(t)); return t; }
#define otid() otid_w(F.wid)
__device__ __forceinline__ int fresh_tid(int t) { asm volatile("" : "+v"(t)); return t; }
#define LDS_WAIT() asm volatile("s_waitcnt lgkmcnt(0)" ::: "memory")

__device__ __forceinline__ size_t moew_wsoff(int e) { return e == 3 ? WS_VF : e == 4 ? WS_W : e == 5 ? WS_W + MOEW_STRIDE : e == 6 ? WS_FFUP : WS_VF + 16 * MiB; }
namespace pg8 {
constexpr int BM = 256, BK = 64, HALF = 128, HTB = HALF * BK * 2, STAGE_BYTES = 8 * HTB, NXCD = 8, WGM = 8;
__host__ __device__ __forceinline__ int lds_byte(int r, int c) { const int st = (r >> 4) * 2 + (c >> 5), rr = r & 15, cc = c & 31, ob = rr * 64 + cc * 2; return st * 1024 + (ob ^ (((ob >> 9) & 1) << 5)); }
__host__ __device__ __forceinline__ void stage_rc(int b, int& R, int& C) { const int st = b / 1024, sb = b % 1024, swz = sb ^ (((sb >> 9) & 1) << 5); R = (st >> 1) * 16 + swz / 64; C = (st & 1) * 32 + (swz % 64) / 2; }
__host__ __device__ __forceinline__ int perm32(int rho) { const int n = rho >> 4, i = rho & 15; return 8 * (i >> 2) + 4 * n + (i & 3); }

typedef int i32x4v __attribute__((ext_vector_type(4)));
struct Unit { int pm, pn; size_t aofs, bofs; const int* rows; int nvalid, e, ks; };
struct Gemm { const bf16* A; const bf16* Bt; int lda, ldb, K; };

struct StaticOrder {
    static constexpr bool GATHER = false;
    int nM, nN, nwg, G, c; size_t tsA, tsB;
    __device__ __forceinline__ void init(int Mrows, int N, int G_, int c_, int lda, int ldb) { nM = Mrows / BM; nN = N / BM; nwg = nM * nN; G = G_; c = c_; tsA = (size_t)BM * lda * 2; tsB = (size_t)BM * ldb * 2; }
    __device__ __forceinline__ void tile(int L, int& pm, int& pn) const {
        int wgid = L; { const int q = nwg / NXCD, r = nwg % NXCD, xcd = wgid % NXCD, off = wgid / NXCD; wgid = (xcd < r ? xcd * (q + 1) : r * (q + 1) + (xcd - r) * q) + off; }
        const int nig = WGM * nN, gid = wgid / nig, fm = gid * WGM, gsz = (nM - fm) < WGM ? (nM - fm) : WGM;
        pm = fm + ((wgid % nig) % gsz); pn = (wgid % nig) / gsz;
    }
    __device__ __forceinline__ bool next(int i, Unit& u) const {
        const long L = (long)i * G + c; if (L >= nwg) return false;
        tile((int)L, u.pm, u.pn); u.aofs = (size_t)u.pm * tsA; u.bofs = (size_t)u.pn * tsB; u.rows = nullptr; u.nvalid = BM; u.e = 0; u.ks = 0; return true;
    }
};
struct BranchOrder {
    static constexpr bool GATHER = false;
    StaticOrder so;
    __device__ __forceinline__ void init(int G_, int c_) { so.init(M, D, G_, c_, PLD, 512); }
    __device__ __forceinline__ bool next(int j, Unit& u) const {
        const long L = (long)j * so.G + so.c; if (L >= 3 * so.nwg) return false;
        const int i = (int)(L / so.nwg); so.tile((int)(L % so.nwg), u.pm, u.pn);
        const int acol = (i == 0) ? 1024 : (i == 1 ? C_Z : C_RETG);
        u.aofs = (size_t)u.pm * so.tsA + (size_t)acol * 2; u.bofs = ((size_t)i * D + (size_t)u.pn * BM) * 512 * 2; u.rows = nullptr; u.nvalid = BM; u.e = i; u.ks = 0; return true;
    }
};
struct GateOrder {
    static constexpr bool GATHER = false;
    StaticOrder so;
    int ld;
    __device__ __forceinline__ void init(int G_, int c_, int ld_ = D) { ld = ld_; so.init(M, D, G_, c_, ld_, ld_); }
    __device__ __forceinline__ bool next(int j, Unit& u) const {
        const long tt = (long)(j / 3) * so.G + so.c; if (tt >= so.nwg) return false;
        const int i = j % 3; so.tile((int)tt, u.pm, u.pn);
        u.aofs = (size_t)u.pm * so.tsA; u.bofs = ((size_t)i * D + (size_t)u.pn * BM) * ld * 2; u.rows = nullptr; u.nvalid = BM; u.e = i; u.ks = 0; return true;
    }
};
template <bool GATH> struct MoeOrder {
    static constexpr bool GATHER = GATH;
    unsigned q0, q1, q2, q3;
    int seg, nN, G, c, ksplit; const int* list; size_t bstride, dws, tsB, tsA, kbytes;
    __device__ __forceinline__ void init(const int* counts, const int* list_, int seg_, int N, int G_, int c_, int lda, int ldb, size_t bstride_, const unsigned char* wsb, const unsigned char* wb, int ksplit_ = 1, int kpart = 0) {
        unsigned n[8];
#pragma unroll
        for (int e = 0; e < 8; ++e) { int v = __builtin_amdgcn_readfirstlane(counts[e]); v = v < 0 ? 0 : (v > 32768 ? 32768 : v); n[e] = (unsigned)v; }
        q0 = n[0] | (n[1] << 16); q1 = n[2] | (n[3] << 16); q2 = n[4] | (n[5] << 16); q3 = n[6] | (n[7] << 16);
        seg = seg_; nN = N / BM; G = G_; c = c_; list = list_; bstride = bstride_; dws = (size_t)(wsb - wb); tsB = (size_t)BM * ldb * 2; tsA = (size_t)BM * lda * 2; ksplit = ksplit_; kbytes = (size_t)kpart * 2;
    }
    __device__ __forceinline__ bool next(int i, Unit& u) const {
        const unsigned L0 = (unsigned)i * (unsigned)G + (unsigned)c; const unsigned L = L0 / (unsigned)ksplit; const int ks = (int)(L0 - L * (unsigned)ksplit); const int tl = (int)(L / (unsigned)nN), pn = (int)(L - (unsigned)tl * (unsigned)nN), gt = seg * 128 + tl;
        int t = 0, e = 0, tbe = 0, cne = 0;
#pragma unroll
        for (int k = 0; k < 8; ++k) { const unsigned q = (k < 2) ? q0 : (k < 4) ? q1 : (k < 6) ? q2 : q3; const int n = (int)((k & 1) ? (q >> 16) : (q & 0xffffu));
            if (gt >= t) { e = k; tbe = t; cne = n; } t += (n + 255) >> 8; }
        int nt = t - seg * 128; nt = nt < 0 ? 0 : (nt > 128 ? 128 : nt);
        if (L >= (unsigned)(nt * nN)) return false;
        const int rt = gt - tbe;
        u.pm = tl; u.pn = pn; u.e = e; u.ks = ks; u.bofs = (e < 3 ? (size_t)e * bstride : dws + moew_wsoff(e)) + (size_t)pn * tsB + ks * kbytes; u.aofs = (GATH ? 0 : (size_t)tl * tsA) + ks * kbytes;
        u.rows = list + ((size_t)e * 32768 + rt * 256) * 2; int nv = cne - rt * 256; u.nvalid = nv > 256 ? 256 : nv; return true;
    }
};

template <class Epi, class Sched, bool F8 = false>
__device__ __forceinline__ void gemm_phase(LAS unsigned char* lds, int wid0, const Gemm g, const Sched& S, const Epi& E) {
    constexpr bool GATHER = Sched::GATHER;
    const int tid = otid_w(wid0), wid = __builtin_amdgcn_readfirstlane(tid >> 6), lane = tid & 63, wr = wid >> 2, wc = wid & 3, fr = lane & 15, fq = lane >> 4;
    const int nt = g.K / BK;
    unsigned voffA[2], voffB[2];
#pragma unroll
    for (int i = 0; i < 2; ++i) { int R, C; stage_rc(tid * 16 + i * 8192, R, C); const int Rb = Epi::PERM ? ((R & ~31) + perm32(R & 31)) : R;
        voffA[i] = (unsigned)(R * g.lda + C) * 2u; voffB[i] = (unsigned)(Rb * g.ldb + C) * 2u; }
    const size_t kstep = (size_t)(BK * 2);
    const size_t hstepA = GATHER ? 0 : (size_t)HALF * g.lda * 2, hstepB = (size_t)HALF * g.ldb * 2;
    const unsigned ldsw = (unsigned)wid * 1024u;
    const int aoff = lds_byte(wr * 64 + fr, fq * 8), boff = lds_byte(wc * 32 + fr, fq * 8);
#define PG8_SA(b, h) (((b) * 2 + (h)) * HTB)
#define PG8_SB(b, h) ((4 + (b) * 2 + (h)) * HTB)
#define PG8_STAGE2(bufoff, gbase, o0, o1) do { \
        __builtin_amdgcn_global_load_lds((const unsigned*)((const char*)(gbase) + (o0)), (LAS unsigned*)(lds + (bufoff) + ldsw), 16, 0, 0); \
        __builtin_amdgcn_global_load_lds((const unsigned*)((const char*)(gbase) + (o1)), (LAS unsigned*)(lds + (bufoff) + ldsw + 8192), 16, 0, 0); } while (0)
#define PG8_STAGE(bufoff, gbase, voff) PG8_STAGE2(bufoff, gbase, (voff)[0], (voff)[1])
#define PG8_LDA(dst, b, h) do { _Pragma("unroll") for (int m = 0; m < 4; ++m) _Pragma("unroll") for (int k = 0; k < 2; ++k) dst[m][k] = *(const LAS bf16x8*)(lds + PG8_SA(b, h) + aoff + m * 2048 + k * 1024); } while (0)
#define PG8_LDB(dst, b, h) do { _Pragma("unroll") for (int n = 0; n < 2; ++n) _Pragma("unroll") for (int k = 0; k < 2; ++k) dst[n][k] = *(const LAS bf16x8*)(lds + PG8_SB(b, h) + boff + n * 2048 + k * 1024); } while (0)
#define PG8_CAT(x) __builtin_shufflevector(__builtin_bit_cast(i32x4v, (x)[0]), __builtin_bit_cast(i32x4v, (x)[1]), 0, 1, 2, 3, 4, 5, 6, 7)
#define PG8_MMA(ai, bj, At, Bt) do { __builtin_amdgcn_s_setprio(1); if constexpr (F8) { _Pragma("unroll") for (int m = 0; m < 4; ++m) _Pragma("unroll") for (int n = 0; n < 2; ++n) \
        asm volatile("v_mfma_f32_16x16x128_f8f6f4 %0, %1, %2, %0" : "+v"(acc[ai][bj][m][n]) : "v"(PG8_CAT(Bt[n])), "v"(PG8_CAT(At[m]))); } else { \
        _Pragma("unroll") for (int m = 0; m < 4; ++m) _Pragma("unroll") for (int n = 0; n < 2; ++n) _Pragma("unroll") for (int k = 0; k < 2; ++k) \
        acc[ai][bj][m][n] = Epi::TRANS ? __builtin_amdgcn_mfma_f32_16x16x32_bf16(Bt[n][k], At[m][k], acc[ai][bj][m][n], 0, 0, 0) : __builtin_amdgcn_mfma_f32_16x16x32_bf16(At[m][k], Bt[n][k], acc[ai][bj][m][n], 0, 0, 0); } __builtin_amdgcn_s_setprio(0); } while (0)
#define PG8_WAIT_V(n) asm volatile("s_waitcnt vmcnt(" #n ")" ::: "memory")
#define PG8_WAIT_L(n) asm volatile("s_waitcnt lgkmcnt(" #n ")" ::: "memory")
#define PG8_BAR __builtin_amdgcn_s_barrier()
#define PG8_SCHED __builtin_amdgcn_sched_barrier(0)
#define GSLOT(which) ((LAS u32x4*)(lds + 131072 + (which) * 8192 + tid * 16))
#define PG8_ROWS(u, which) do { const int _ft = fresh_tid(tid); int _R0, _C0, _R1, _C1; stage_rc(_ft * 16, _R0, _C0); stage_rc(_ft * 16 + 8192, _R1, _C1); const int _nv = (u).nvalid; \
        int _t0 = (u).rows[2 * ((_R0 < _nv) ? _R0 : 0)], _t1 = (u).rows[2 * ((_R1 < _nv) ? _R1 : 0)], _t2 = (u).rows[2 * ((HALF + _R0 < _nv) ? HALF + _R0 : 0)], _t3 = (u).rows[2 * ((HALF + _R1 < _nv) ? HALF + _R1 : 0)]; \
        asm("" : "+v"(_t0), "+v"(_t1), "+v"(_t2), "+v"(_t3));     \
        u32x4 _o; _o.x = ((unsigned)_t0 * (unsigned)g.lda + (unsigned)_C0) * 2u; _o.y = ((unsigned)_t1 * (unsigned)g.lda + (unsigned)_C1) * 2u; \
        _o.z = ((unsigned)_t2 * (unsigned)g.lda + (unsigned)_C0) * 2u; _o.w = ((unsigned)_t3 * (unsigned)g.lda + (unsigned)_C1) * 2u; *GSLOT(which) = _o; } while (0)
#define IDL_OFF 147456
#define PG8_IDS_DMA(u) do { if (wid < 2) __builtin_amdgcn_global_load_lds((const unsigned*)((const char*)(u).rows + (size_t)tid * 16), (LAS unsigned*)(lds + IDL_OFF + (unsigned)wid * 1024u), 16, 0, 0); } while (0)
#define PG8_ROWS_FROM_IDL(u, which) do { const int _ft = fresh_tid(tid); int _R0, _C0, _R1, _C1; stage_rc(_ft * 16, _R0, _C0); stage_rc(_ft * 16 + 8192, _R1, _C1); const int _nv = (u).nvalid; \
        const LAS int* _idl = (const LAS int*)(lds + IDL_OFF); u32x4 _o; \
        _o.x = ((unsigned)_idl[2 * ((_R0 < _nv) ? _R0 : 0)] * (unsigned)g.lda + (unsigned)_C0) * 2u; _o.y = ((unsigned)_idl[2 * ((_R1 < _nv) ? _R1 : 0)] * (unsigned)g.lda + (unsigned)_C1) * 2u; \
        _o.z = ((unsigned)_idl[2 * ((HALF + _R0 < _nv) ? HALF + _R0 : 0)] * (unsigned)g.lda + (unsigned)_C0) * 2u; _o.w = ((unsigned)_idl[2 * ((HALF + _R1 < _nv) ? HALF + _R1 : 0)] * (unsigned)g.lda + (unsigned)_C1) * 2u; \
        *GSLOT(which) = _o; } while (0)
    Unit cur, nxt; int ui = 0;
    if (!S.next(0, cur)) return;
    f32x4 acc[2][2][4][2];
#pragma unroll
    for (int a = 0; a < 2; ++a)
#pragma unroll
        for (int b = 0; b < 2; ++b)
#pragma unroll
            for (int m = 0; m < 4; ++m)
#pragma unroll
                for (int n = 0; n < 2; ++n) acc[a][b][m][n] = (f32x4){0.f, 0.f, 0.f, 0.f};
    bf16x8 At[4][2], B0[2][2], B1[2][2];
    u32x4 gc = {voffA[0], voffA[1], voffA[0], voffA[1]};
    if constexpr (GATHER) { PG8_ROWS(cur, 0); gc = *GSLOT(0); *GSLOT(1) = gc; }
#define VGC(h, i) (gc[2 * (h) + (i)])
    const char* cA = (const char*)g.A + cur.aofs; const char* cB = (const char*)g.Bt + cur.bofs;
    PG8_STAGE(PG8_SB(0, 0), cB, voffB); PG8_STAGE(PG8_SB(0, 1), cB + hstepB, voffB); PG8_STAGE2(PG8_SA(0, 0), cA, VGC(0, 0), VGC(0, 1)); PG8_STAGE2(PG8_SA(0, 1), cA + hstepA, VGC(1, 0), VGC(1, 1));
    if (wr == 1) PG8_BAR;
    PG8_WAIT_V(2); PG8_BAR;
    PG8_STAGE(PG8_SB(1, 0), cB + kstep, voffB); PG8_STAGE2(PG8_SA(1, 0), cA + kstep, VGC(0, 0), VGC(0, 1)); PG8_STAGE(PG8_SB(1, 1), cB + hstepB + kstep, voffB);
    PG8_WAIT_V(6); PG8_BAR;
    for (;;) {
        const bool has_next = S.next(ui + 1, nxt);
        const char* nA = has_next ? (const char*)g.A + nxt.aofs : cA; const char* nB = has_next ? (const char*)g.Bt + nxt.bofs : cB;
        if constexpr (GATHER) { if (has_next) PG8_IDS_DMA(nxt); }
        for (int t = 0; t < nt; t += 2) {
            const bool last = (t == nt - 2);
            const char* a1 = cA + (size_t)(t + 1) * kstep;
            const char* a2 = last ? nA : cA + (size_t)(t + 2) * kstep; const char* b2 = last ? nB : cB + (size_t)(t + 2) * kstep;
            const char* a3 = a2 + kstep; const char* b3 = b2 + kstep;
            if constexpr (GATHER) { if (t == ((nt >= 4) ? nt - 4 : 0)) { if (has_next) PG8_ROWS_FROM_IDL(nxt, 1); else *GSLOT(1) = *GSLOT(0); } }
            u32x4 gn = gc; if constexpr (GATHER) { gc = *GSLOT(0); gn = last ? *GSLOT(1) : gc; }
            const unsigned s00 = gn.x, s01 = gn.y, s10 = gn.z, s11 = gn.w;
            PG8_LDB(B0, 0, 0); PG8_LDB(B1, 0, 1); PG8_SCHED; PG8_LDA(At, 0, 0); PG8_STAGE2(PG8_SA(1, 1), a1 + hstepA, VGC(1, 0), VGC(1, 1));
            PG8_WAIT_V(8); PG8_WAIT_L(0); PG8_BAR; PG8_MMA(0, 0, At, B0); PG8_MMA(0, 1, At, B1); PG8_BAR; PG8_SCHED;
            PG8_LDA(At, 0, 1); PG8_STAGE(PG8_SB(0, 0), b2, voffB); PG8_STAGE(PG8_SB(0, 1), b2 + hstepB, voffB); PG8_STAGE2(PG8_SA(0, 0), a2, s00, s01);
            PG8_WAIT_V(8); PG8_WAIT_L(0); PG8_BAR; PG8_MMA(1, 0, At, B0); PG8_MMA(1, 1, At, B1); PG8_BAR; PG8_SCHED;
            PG8_LDB(B0, 1, 0); PG8_LDB(B1, 1, 1); PG8_SCHED; PG8_LDA(At, 1, 0); PG8_STAGE2(PG8_SA(0, 1), a2 + hstepA, s10, s11);
            PG8_WAIT_V(8); PG8_WAIT_L(0); PG8_BAR; PG8_MMA(0, 0, At, B0); PG8_MMA(0, 1, At, B1); PG8_BAR; PG8_SCHED;
            PG8_LDA(At, 1, 1); PG8_STAGE(PG8_SB(1, 0), b3, voffB); PG8_STAGE(PG8_SB(1, 1), b3 + hstepB, voffB); PG8_STAGE2(PG8_SA(1, 0), a3, s00, s01);
            PG8_WAIT_V(8); PG8_WAIT_L(0); PG8_BAR; PG8_MMA(1, 0, At, B0); PG8_MMA(1, 1, At, B1); PG8_BAR; PG8_SCHED;
        }
        if (wr == 0) PG8_BAR;
        if constexpr (F8) asm volatile("s_nop 15\n\ts_nop 15" ::: "memory");
        { const int l2 = otid_w(wid0) & 63; E(acc, cur, wr, wc, l2 & 15, l2 >> 4); }
        if (!has_next) break;
#pragma unroll
        for (int a = 0; a < 2; ++a)
#pragma unroll
            for (int b = 0; b < 2; ++b)
#pragma unroll
                for (int m = 0; m < 4; ++m)
#pragma unroll
                    for (int n = 0; n < 2; ++n) acc[a][b][m][n] = (f32x4){0.f, 0.f, 0.f, 0.f};
        cur = nxt; cA = nA; cB = nB; ++ui;
        if constexpr (GATHER) { *GSLOT(0) = *GSLOT(1); }
        if (wr == 1) PG8_BAR;
    }
    PG8_WAIT_V(0);
    PG8_BAR;
#undef PG8_SA
#undef PG8_SB
#undef PG8_STAGE
#undef PG8_STAGE2
#undef PG8_ROWS
#undef PG8_IDS_DMA
#undef PG8_ROWS_FROM_IDL
#undef IDL_OFF
#undef GSLOT
#undef VGC
#undef PG8_LDA
#undef PG8_LDB
#undef PG8_MMA
#undef PG8_CAT
#undef PG8_WAIT_V
#undef PG8_WAIT_L
#undef PG8_BAR
#undef PG8_SCHED
}

typedef const f32x4 (&AccRef)[2][2][4][2];
__device__ __forceinline__ float ss16(const float* p) { const f32x4 a = *(const f32x4*)p, b = *(const f32x4*)(p + 4), c = *(const f32x4*)(p + 8), d = *(const f32x4*)(p + 12);
    return (((a[0] + a[1]) + (a[2] + a[3])) + ((b[0] + b[1]) + (b[2] + b[3]))) + (((c[0] + c[1]) + (c[2] + c[3])) + ((d[0] + d[1]) + (d[2] + d[3]))); }
__device__ __forceinline__ float rs_of(const float* rstd, int ssmode, int row) { return ssmode ? __builtin_amdgcn_rsqf(ss16(rstd + (size_t)row * 16) * (1.f / D) + 1e-6f) : rstd[row]; }

__device__ __forceinline__ void row_scales(const float* rstd, int ssmode, int row0, float (&scl)[2][4]) {
    if (ssmode) {
#pragma unroll
        for (int ai = 0; ai < 2; ++ai) { f32x4 q[4][4];
#pragma unroll
            for (int m = 0; m < 4; ++m)
#pragma unroll
                for (int k = 0; k < 4; ++k) q[m][k] = *(const f32x4*)(rstd + (size_t)(row0 + ai * HALF + m * 16) * 16 + 4 * k);
#pragma unroll
            for (int m = 0; m < 4; ++m) { const f32x4 a = q[m][0], b = q[m][1], c = q[m][2], d = q[m][3];
                scl[ai][m] = __builtin_amdgcn_rsqf(((((a[0] + a[1]) + (a[2] + a[3])) + ((b[0] + b[1]) + (b[2] + b[3]))) + (((c[0] + c[1]) + (c[2] + c[3])) + ((d[0] + d[1]) + (d[2] + d[3])))) * (1.f / D) + 1e-6f); } }
    } else {
#pragma unroll
        for (int ai = 0; ai < 2; ++ai)
#pragma unroll
            for (int m = 0; m < 4; ++m) scl[ai][m] = rstd[row0 + ai * HALF + m * 16];
    }
}
struct EpiInProj {
    static constexpr bool PERM = true, TRANS = true;
    bf16* P; const float* rstd; float* dt; int ssmode;
    __device__ __forceinline__ void operator()(AccRef acc, const Unit& u, int wr, int wc, int fr, int fq) const {
        const int row0 = u.pm * BM + wr * 64 + fr;
        float scl[2][4];
        row_scales(rstd, ssmode, row0, scl);
        if (u.pn < 21) {
            const int col0 = u.pn * BM + wc * 32 + 8 * fq;
#pragma unroll
            for (int ai = 0; ai < 2; ++ai)
#pragma unroll
                for (int m = 0; m < 4; ++m) { const int row = row0 + ai * HALF + m * 16; const float s = scl[ai][m]; bf16* rowp = P + (size_t)row * PLD + col0;
#pragma unroll
                    for (int bj = 0; bj < 2; ++bj) { const f32x4 v0 = acc[ai][bj][m][0] * s, v1 = acc[ai][bj][m][1] * s;
                        u32x4 w; w.x = pk2(v0[0], v0[1]); w.y = pk2(v0[2], v0[3]); w.z = pk2(v1[0], v1[1]); w.w = pk2(v1[2], v1[3]);
                        *(u32x4*)(rowp + bj * HALF) = w; } }
        } else if (wc == 0 && fq == 0) {
#pragma unroll
            for (int ai = 0; ai < 2; ++ai)
#pragma unroll
                for (int m = 0; m < 4; ++m) { const int row = row0 + ai * HALF + m * 16; const float s = scl[ai][m];
                    *(f32x4*)(dt + (size_t)row * 8) = acc[ai][0][m][0] * s; *(f32x4*)(dt + (size_t)row * 8 + 4) = acc[ai][0][m][1] * s; }
        }
    }
};
struct EpiPlain {
    static constexpr bool PERM = true, TRANS = true;
    bf16* P; bf16* Y2;
    __device__ __forceinline__ void operator()(AccRef acc, const Unit& u, int wr, int wc, int fr, int fq) const {
        bf16* O = (u.e == 0) ? P : (u.e == 1 ? P + C_XBC : Y2); const int ldc = (u.e == 2) ? D : PLD;
        const int row0 = u.pm * BM + wr * 64 + fr, col0 = u.pn * BM + wc * 32 + 8 * fq;
#pragma unroll
        for (int ai = 0; ai < 2; ++ai)
#pragma unroll
            for (int m = 0; m < 4; ++m) { bf16* rowp = O + (size_t)(row0 + ai * HALF + m * 16) * ldc + col0;
#pragma unroll
                for (int bj = 0; bj < 2; ++bj) { const f32x4 v0 = acc[ai][bj][m][0], v1 = acc[ai][bj][m][1];
                    u32x4 w; w.x = pk2(v0[0], v0[1]); w.y = pk2(v0[2], v0[3]); w.z = pk2(v1[0], v1[1]); w.w = pk2(v1[2], v1[3]);
                    *(u32x4*)(rowp + bj * HALF) = w; } }
    }
};
struct EpiGateMerge {
    static constexpr bool PERM = true, TRANS = true;
    const bf16* P; const bf16* Y2; bf16* Mg; int ldm; const float* rstd; float mul;
    __device__ __forceinline__ void operator()(AccRef acc, const Unit& u, int wr, int wc, int fr, int fq) const {
        asm volatile("" : "+v"(fr), "+v"(fq));
        const bf16* Y = (u.e == 0) ? P : (u.e == 1 ? P + C_XBC : Y2); const int ldy = (u.e == 2) ? D : PLD; const int first = (u.e == 0);
        const int row0 = u.pm * BM + wr * 64 + fr, col0 = u.pn * BM + wc * 32 + 8 * fq;
        u32x4 yv[2][2][2], mv[2][2][2]; float sc[2][2];
#define GM_LOAD(slot, q) do { _Pragma("unroll") for (int m2 = 0; m2 < 2; ++m2) { const int row = row0 + ((q) >> 1) * HALF + (((q) & 1) * 2 + m2) * 16; sc[slot][m2] = rstd[row] * mul; \
            _Pragma("unroll") for (int bj = 0; bj < 2; ++bj) { yv[slot][m2][bj] = *(const u32x4*)(Y + (size_t)row * ldy + col0 + bj * HALF); \
                mv[slot][m2][bj] = first ? (u32x4){0u, 0u, 0u, 0u} : *(const u32x4*)(Mg + (size_t)row * ldm + col0 + bj * HALF); } } } while (0)
        GM_LOAD(0, 0); GM_LOAD(1, 1);
#pragma unroll
        for (int q = 0; q < 4; ++q) { const int slot = q & 1, ai = q >> 1, mb = (q & 1) * 2;
#pragma unroll
            for (int m2 = 0; m2 < 2; ++m2) { const int row = row0 + ai * HALF + (mb + m2) * 16;
#pragma unroll
                for (int bj = 0; bj < 2; ++bj) { float y[8], p[8], o[8]; unpack8(yv[slot][m2][bj], y); unpack8(mv[slot][m2][bj], p);
                    const f32x4 v0 = acc[ai][bj][mb + m2][0] * sc[slot][m2], v1 = acc[ai][bj][mb + m2][1] * sc[slot][m2];
#pragma unroll
                    for (int j = 0; j < 4; ++j) { o[j] = sigm(v0[j]) * y[j] + p[j]; o[4 + j] = sigm(v1[j]) * y[4 + j] + p[4 + j]; }
                    *(u32x4*)(Mg + (size_t)row * ldm + col0 + bj * HALF) = pack8(o); } }
            if (q == 0) GM_LOAD(0, 2); else if (q == 1) GM_LOAD(1, 3);
        }
#undef GM_LOAD
    }
};
struct EpiResid {
    static constexpr bool PERM = false, TRANS = true;
    const float* xin; float* xout; const float* gates; int e;
    __device__ __forceinline__ void operator()(AccRef acc, const Unit& u, int wr, int wc, int fr, int fq) const {
        const int row0 = u.pm * BM + wr * 64 + fr, col0 = u.pn * BM + wc * 32 + 4 * fq;
#pragma unroll
        for (int ai = 0; ai < 2; ++ai)
#pragma unroll
            for (int m = 0; m < 4; ++m) { const int row = row0 + ai * HALF + m * 16; const float s = gates ? gates[(size_t)row * 8 + e] : 1.f;
                const float* ip = xin + (size_t)row * D + col0; float* op = xout + (size_t)row * D + col0;
#pragma unroll
                for (int bj = 0; bj < 2; ++bj)
#pragma unroll
                    for (int n = 0; n < 2; ++n) *(f32x4*)(op + bj * HALF + n * 16) = *(const f32x4*)(ip + bj * HALF + n * 16) + acc[ai][bj][m][n] * s; }
    }
};
struct EpiResidB {
    static constexpr bool PERM = true, TRANS = true;
    bf16* xb; float* SS; float* xf; unsigned char* x8; float mul = 1.f;
    __device__ __forceinline__ void operator()(AccRef acc, const Unit& u, int wr, int wc, int fr, int fq) const {
        asm volatile("" : "+v"(fr), "+v"(fq));
        const int row0 = u.pm * BM + wr * 64 + fr, col0 = u.pn * BM + wc * 32 + 8 * fq;
#pragma unroll
        for (int ai = 0; ai < 2; ++ai) {
            u32x4 xv[4][2];
#pragma unroll
            for (int m = 0; m < 4; ++m)
#pragma unroll
                for (int bj = 0; bj < 2; ++bj) xv[m][bj] = *(const u32x4*)(xb + (size_t)(row0 + ai * HALF + m * 16) * D + col0 + bj * HALF);
#pragma unroll
            for (int m = 0; m < 4; ++m) { const int row = row0 + ai * HALF + m * 16; bf16* rowp = xb + (size_t)row * D + col0; float ss = 0.f;
#pragma unroll
                for (int bj = 0; bj < 2; ++bj) { float v[8]; unpack8(xv[m][bj], v);
#pragma unroll
                    for (int j = 0; j < 4; ++j) { v[j] += acc[ai][bj][m][0][j] * mul; v[4 + j] += acc[ai][bj][m][1][j] * mul; }
                    *(u32x4*)(rowp + bj * HALF) = pack8(v);
                    if (x8) { u32x2 w8; w8.x = pk4f8(v[0] * 4.f, v[1] * 4.f, v[2] * 4.f, v[3] * 4.f); w8.y = pk4f8(v[4] * 4.f, v[5] * 4.f, v[6] * 4.f, v[7] * 4.f); *(u32x2*)(x8 + (size_t)row * D + col0 + bj * HALF) = w8; }
                    if (xf) { float* fp = xf + (size_t)row * D + col0 + bj * HALF; *(f32x4*)fp = (f32x4){v[0], v[1], v[2], v[3]}; *(f32x4*)(fp + 4) = (f32x4){v[4], v[5], v[6], v[7]}; }
#pragma unroll
                    for (int j = 0; j < 8; ++j) ss += v[j] * v[j]; }
                if (SS) { ss += __shfl_xor(ss, 16); ss += __shfl_xor(ss, 32); if (fq == 0) SS[(size_t)row * 16 + u.pn * 4 + wc] = ss; } }
        }
    }
};
struct EpiSwiglu {
    static constexpr bool PERM = true, TRANS = true;
    bf16* act; int ldc; const float* rstd; int ssmode; float mul = 1.f;
    __device__ __forceinline__ void operator()(AccRef acc, const Unit& u, int wr, int wc, int fr, int fq) const {
        asm volatile("" : "+v"(fr), "+v"(fq));
        const int row0 = u.pm * BM + wr * 64 + fr, col0 = u.pn * HALF + wc * 32 + 8 * fq;
        float scl[2][4];
        if (u.rows) { int tk[2][4];
#pragma unroll
            for (int ai = 0; ai < 2; ++ai)
#pragma unroll
                for (int m = 0; m < 4; ++m) { const int lr = wr * 64 + fr + ai * HALF + m * 16; tk[ai][m] = (lr < u.nvalid) ? u.rows[2 * lr] : 0; }
#pragma unroll
            for (int ai = 0; ai < 2; ++ai)
#pragma unroll
                for (int m = 0; m < 4; ++m) scl[ai][m] = rstd[tk[ai][m]];
        } else {
            row_scales(rstd, ssmode, row0, scl); }
#pragma unroll
        for (int ai = 0; ai < 2; ++ai)
#pragma unroll
            for (int m = 0; m < 4; ++m) { const int row = row0 + ai * HALF + m * 16;
                const float s = scl[ai][m] * mul;
                float o[8];
#pragma unroll
                for (int n = 0; n < 2; ++n)
#pragma unroll
                    for (int j = 0; j < 4; ++j) o[4 * n + j] = silu(acc[ai][0][m][n][j] * s) * (acc[ai][1][m][n][j] * s);
                *(u32x4*)(act + (size_t)row * ldc + col0) = pack8(o); }
    }
};
struct EpiSwiglu8 {
    static constexpr bool PERM = true, TRANS = true;
    unsigned char* act; int ldc;
    __device__ __forceinline__ void operator()(AccRef acc, const Unit& u, int wr, int wc, int fr, int fq) const {
        asm volatile("" : "+v"(fr), "+v"(fq));
        const int row0 = u.pm * BM + wr * 64 + fr, col0 = u.pn * HALF + wc * 32 + 8 * fq;
        const float s = 1.f / 256.f, s8 = 8.f / 256.f;
#pragma unroll
        for (int ai = 0; ai < 2; ++ai)
#pragma unroll
            for (int m = 0; m < 4; ++m) { const int row = row0 + ai * HALF + m * 16;
                float o[8];
#pragma unroll
                for (int n = 0; n < 2; ++n)
#pragma unroll
                    for (int j = 0; j < 4; ++j) o[4 * n + j] = silu(acc[ai][0][m][n][j] * s) * (acc[ai][1][m][n][j] * s8);
                u32x2 w; w.x = pk4f8(o[0], o[1], o[2], o[3]); w.y = pk4f8(o[4], o[5], o[6], o[7]);
                *(u32x2*)(act + (size_t)row * ldc + col0) = w; }
    }
};
struct EpiSwiglu8R {
    static constexpr bool PERM = true, TRANS = true;
    unsigned char* act; int ldc; const float* rstd; int ssmode; float mul;
    __device__ __forceinline__ void operator()(AccRef acc, const Unit& u, int wr, int wc, int fr, int fq) const {
        asm volatile("" : "+v"(fr), "+v"(fq));
        const int row0 = u.pm * BM + wr * 64 + fr, col0 = u.pn * HALF + wc * 32 + 8 * fq;
        float scl[2][4]; row_scales(rstd, ssmode, row0, scl);
#pragma unroll
        for (int ai = 0; ai < 2; ++ai)
#pragma unroll
            for (int m = 0; m < 4; ++m) { const int row = row0 + ai * HALF + m * 16;
                const float s = scl[ai][m] * mul, s8 = s * 8.f;
                float o[8];
#pragma unroll
                for (int n = 0; n < 2; ++n)
#pragma unroll
                    for (int j = 0; j < 4; ++j) o[4 * n + j] = silu(acc[ai][0][m][n][j] * s) * (acc[ai][1][m][n][j] * s8);
                u32x2 w; w.x = pk4f8(o[0], o[1], o[2], o[3]); w.y = pk4f8(o[4], o[5], o[6], o[7]);
                *(u32x2*)(act + (size_t)row * ldc + col0) = w; }
    }
};
struct EpiMoeOut {
    static constexpr bool PERM = true, TRANS = true;
    bf16* Y; size_t kstride; float mul;
    __device__ __forceinline__ void operator()(AccRef acc, const Unit& u, int wr, int wc, int fr, int fq) const {
        const int row0 = u.pm * BM + wr * 64 + fr, col0 = u.pn * BM + wc * 32 + 8 * fq; bf16* O = Y + (size_t)u.ks * kstride;
#pragma unroll
        for (int ai = 0; ai < 2; ++ai)
#pragma unroll
            for (int m = 0; m < 4; ++m) { bf16* rowp = O + (size_t)(row0 + ai * HALF + m * 16) * D + col0;
#pragma unroll
                for (int bj = 0; bj < 2; ++bj) { const f32x4 v0 = acc[ai][bj][m][0] * mul, v1 = acc[ai][bj][m][1] * mul;
                    u32x4 w; w.x = pk2(v0[0], v0[1]); w.y = pk2(v0[2], v0[3]); w.z = pk2(v1[0], v1[1]); w.w = pk2(v1[2], v1[3]);
                    *(u32x4*)(rowp + bj * HALF) = w; } }
    }
};
}

#define XB_TMO      128
#define XB_XCNT(j)  (256  + 64 * (j))
#define XB_XSUB(j)  (1280 + 64 * (j))
#define XB_XGEN(j)  (2304 + 64 * (j))
#define XB_TOP      3328
#define XB_TOPGEN   3392
#define XCD_BAR_WORDS 3456
#define XB_SPIN_CAP (1u << 18)

__device__ __forceinline__ unsigned xb_ld(unsigned* p)              { return __hip_atomic_load(p, __ATOMIC_RELAXED, __HIP_MEMORY_SCOPE_AGENT); }
__device__ __forceinline__ unsigned xb_add(unsigned* p, unsigned v) { return __hip_atomic_fetch_add(p, v, __ATOMIC_RELAXED, __HIP_MEMORY_SCOPE_AGENT); }
__device__ __forceinline__ unsigned xb_xcc_id() { return (unsigned)__builtin_amdgcn_s_getreg((3 << 11) | 20) & 0xFu; }
#define XB_SPIN(cond, bar) do { unsigned _sp = 0; while (cond) { __builtin_amdgcn_s_sleep(1); \
    if ((++_sp & 255u) == 0u) { if (xb_ld(&(bar)[XB_TMO])) break; if (_sp > XB_SPIN_CAP) { atomicAdd(&(bar)[XB_TMO], 1u); break; } } } } while (0)

struct XcdBarrier { unsigned* bar; unsigned x; volatile LAS unsigned* st; };

__device__ __forceinline__ XcdBarrier xcd_barrier_post(unsigned* bar, volatile LAS unsigned* st) {
    XcdBarrier b; b.bar = bar; b.x = xb_xcc_id(); b.st = st;
    if (threadIdx.x == 0) (void)xb_add(&bar[XB_XCNT(b.x)], 1u);
    return b;
}
__device__ __forceinline__ void xcd_barrier_complete(unsigned* bar, unsigned x, unsigned& nloc, unsigned& nx) {
    const unsigned G = gridDim.x * gridDim.y * gridDim.z;
    unsigned sum, cnt, mine, sp = 0u;
    for (;;) {
        sum = 0u; cnt = 0u; mine = 0u;
#pragma unroll
        for (unsigned j = 0; j < 16; ++j) { const unsigned c = xb_ld(&bar[XB_XCNT(j)]); sum += c; cnt += (c > 0u) ? 1u : 0u; mine = (j == x) ? c : mine; }
        if (sum == G) break;
        __builtin_amdgcn_s_sleep(1);
        if ((++sp & 255u) == 0u) { if (xb_ld(&bar[XB_TMO])) break; if (sp > XB_SPIN_CAP) { atomicAdd(&bar[XB_TMO], 1u); break; } }
    }
    nloc = mine > 0u ? mine : 1u; nx = cnt > 0u ? cnt : 1u;
}
__device__ __forceinline__ void xcd_barrier(const XcdBarrier& b) {
    asm volatile("s_waitcnt vmcnt(0)" ::: "memory");
    __syncthreads();
    if (threadIdx.x == 0) {
        unsigned* bar = b.bar;
        __builtin_amdgcn_s_waitcnt(0);
        unsigned nloc = b.st[0], nx = b.st[1];
        if (nloc == 0u) { xcd_barrier_complete(bar, b.x, nloc, nx); b.st[0] = nloc; b.st[1] = nx; }
        const unsigned old = xb_add(&bar[XB_XSUB(b.x)], 1u);
        const unsigned gen = old / nloc;
        if (old + 1u == (gen + 1u) * nloc) {
            __builtin_amdgcn_fence(__ATOMIC_RELEASE, "agent");
            asm volatile("s_waitcnt vmcnt(0)" ::: "memory");
            const unsigned og = xb_add(&bar[XB_TOP], 1u);
            const unsigned tg = og / nx;
            if (og + 1u == (tg + 1u) * nx) xb_add(&bar[XB_TOPGEN], 1u);
            else XB_SPIN(xb_ld(&bar[XB_TOPGEN]) == tg, bar);
            __builtin_amdgcn_fence(__ATOMIC_ACQUIRE, "agent");
            xb_add(&bar[XB_XGEN(b.x)], 1u);
            asm volatile("s_waitcnt vmcnt(0)" ::: "memory");
        } else {
            XB_SPIN(xb_ld(&bar[XB_XGEN(b.x)]) == gen, bar);
            __builtin_amdgcn_fence(__ATOMIC_ACQUIRE, "agent");
            asm volatile("s_waitcnt vmcnt(0)" ::: "memory");
        }
    }
    __syncthreads();
}

#define GAS __attribute__((address_space(1)))
struct Args { const float* in[34]; float* out; unsigned char* ws; int ph_lo, ph_hi; };
struct Frame {
    LAS unsigned char* lds;
    int vcu, G, cid, wid, rr;
    GAS float* out; GAS unsigned char* ws; GAS unsigned char* st;
};
__device__ __forceinline__ const float* inptr(LAS unsigned char* lds, int i) {
    int off = LDSCTL_OFF + 8 * i; asm volatile("" : "+v"(off));
    const LAS unsigned* p = (const LAS unsigned*)(lds + off);
    const unsigned lo = __builtin_amdgcn_readfirstlane(p[0]), hi = __builtin_amdgcn_readfirstlane(p[1]);
    return (const float*)(GAS const float*)(((unsigned long long)hi << 32) | lo);
}
#define INP(i) inptr(F.lds, (i))

__device__ __forceinline__ void conv_item(const float* W, int ld, int k0, int c0, int nvalid, const float* scale, bf16* dst, int K, int drow0, LAS float* scr, int lane) {
    const int n4 = (lane & 15) * 4;
    f32x4 v[16]; float sc[16];
#pragma unroll
    for (int i = 0; i < 16; ++i) sc[i] = 1.f;
    if (scale) {
#pragma unroll
        for (int i = 0; i < 16; ++i) sc[i] = scale[k0 + 4 * i + (lane >> 4)];
        asm volatile("" : "+v"(sc[0]), "+v"(sc[1]), "+v"(sc[2]), "+v"(sc[3]), "+v"(sc[4]), "+v"(sc[5]), "+v"(sc[6]), "+v"(sc[7]), "+v"(sc[8]), "+v"(sc[9]), "+v"(sc[10]), "+v"(sc[11]), "+v"(sc[12]), "+v"(sc[13]), "+v"(sc[14]), "+v"(sc[15]));     }
    { const bool valid_ = n4 < nvalid; const int n4c = valid_ ? n4 : 0;
#pragma unroll
      for (int i = 0; i < 16; ++i) { const int kk = 4 * i + (lane >> 4); v[i] = *(const f32x4*)(W + (size_t)(k0 + kk) * ld + c0 + n4c); if (!valid_) v[i] = (f32x4){0.f, 0.f, 0.f, 0.f}; } }
#pragma unroll
    for (int i = 0; i < 16; ++i) { const int kk = 4 * i + (lane >> 4); const f32x4 x = v[i] * sc[i];
        LAS float* d = scr + kk * 65 + n4; d[0] = x[0]; d[1] = x[1]; d[2] = x[2]; d[3] = x[3]; }
    LDS_WAIT(); asm volatile("" ::: "memory");
    const int c = lane & 7;
#pragma unroll
    for (int j = 0; j < 8; ++j) { const int nn = (lane >> 3) + 8 * j; const LAS float* sp = scr + (8 * c) * 65 + nn;
        u32x4 o; o.x = pk2(sp[0 * 65], sp[1 * 65]); o.y = pk2(sp[2 * 65], sp[3 * 65]); o.z = pk2(sp[4 * 65], sp[5 * 65]); o.w = pk2(sp[6 * 65], sp[7 * 65]);
        *(u32x4*)(dst + (size_t)(drow0 + nn) * K + k0 + 8 * c) = o; }
    LDS_WAIT(); asm volatile("" ::: "memory");
}
__device__ __forceinline__ void conv_item8(const float* W, int ld, int k0, int c0, const float* scale, float mul, unsigned char* dst, int K, int drow0, LAS float* scr, int lane) {
    const int n4 = (lane & 15) * 4;
    f32x4 v[16]; float sc[16];
#pragma unroll
    for (int i = 0; i < 16; ++i) sc[i] = mul;
    if (scale) {
#pragma unroll
        for (int i = 0; i < 16; ++i) sc[i] = scale[k0 + 4 * i + (lane >> 4)];
        asm volatile("" : "+v"(sc[0]), "+v"(sc[1]), "+v"(sc[2]), "+v"(sc[3]), "+v"(sc[4]), "+v"(sc[5]), "+v"(sc[6]), "+v"(sc[7]), "+v"(sc[8]), "+v"(sc[9]), "+v"(sc[10]), "+v"(sc[11]), "+v"(sc[12]), "+v"(sc[13]), "+v"(sc[14]), "+v"(sc[15]));
#pragma unroll
        for (int i = 0; i < 16; ++i) sc[i] *= mul; }
#pragma unroll
    for (int i = 0; i < 16; ++i) { const int kk = 4 * i + (lane >> 4); v[i] = *(const f32x4*)(W + (size_t)(k0 + kk) * ld + c0 + n4); }
#pragma unroll
    for (int i = 0; i < 16; ++i) { const int kk = 4 * i + (lane >> 4); const f32x4 x = v[i] * sc[i];
        LAS float* d = scr + kk * 65 + n4; d[0] = x[0]; d[1] = x[1]; d[2] = x[2]; d[3] = x[3]; }
    LDS_WAIT(); asm volatile("" ::: "memory");
    const int c = lane & 3;
#pragma unroll
    for (int j = 0; j < 4; ++j) { const int nn = (lane >> 2) + 16 * j; const LAS float* sp = scr + (16 * c) * 65 + nn;
        u32x4 o; o.x = pk4f8(sp[0 * 65], sp[1 * 65], sp[2 * 65], sp[3 * 65]); o.y = pk4f8(sp[4 * 65], sp[5 * 65], sp[6 * 65], sp[7 * 65]);
        o.z = pk4f8(sp[8 * 65], sp[9 * 65], sp[10 * 65], sp[11 * 65]); o.w = pk4f8(sp[12 * 65], sp[13 * 65], sp[14 * 65], sp[15 * 65]);
        *(u32x4*)(dst + (size_t)(drow0 + nn) * K + k0 + 16 * c) = o; }
    LDS_WAIT(); asm volatile("" ::: "memory");
}
__device__ __forceinline__ void conv_seg8(Frame& F, const float* W, int ld, int K, int ncols, const float* scale, float mul, unsigned char* dst, int r0, int blk, int blks) {
    const int ptid = otid(), plane = ptid & 63, pwave = __builtin_amdgcn_readfirstlane(ptid >> 6);
    LAS float* scr = (LAS float*)(F.lds + pwave * 16640);
    const int gw = F.vcu * 8 + pwave, NGW = F.G * 8;
    const int nblk = ncols / 64, nitems = (K / 64) * nblk;
    const int first = (gw - F.rr % NGW + NGW) % NGW; F.rr = (F.rr + nitems) % NGW;
    for (int it = first; it < nitems; it += NGW) {
        const int kb = it / nblk, nb = it % nblk, n0 = nb * 64;
        conv_item8(W, ld, kb * 64, n0, scale, mul, dst, K, r0 + (n0 / blk) * blks + (n0 % blk), scr, plane);
    }
}
__device__ __forceinline__ void conv_seg(Frame& F, const float* W, int ld, int K, int c0, int nvalid, int ntotal, const float* scale, bf16* dst, int r0, int blk, int blks) {
    const int ptid = otid(), plane = ptid & 63, pwave = __builtin_amdgcn_readfirstlane(ptid >> 6);
    LAS float* scr = (LAS float*)(F.lds + pwave * 16640);
    const int gw = F.vcu * 8 + pwave, NGW = F.G * 8;
    const int nblk = ntotal / 64, nitems = (K / 64) * nblk;
    const int first = (gw - F.rr % NGW + NGW) % NGW; F.rr = (F.rr + nitems) % NGW;
    for (int it = first; it < nitems; it += NGW) {
        const int kb = it / nblk, nb = it % nblk, n0 = nb * 64;
        int nv = nvalid - n0; nv = nv < 0 ? 0 : (nv > 64 ? 64 : nv);
        conv_item(W, ld, kb * 64, c0 + n0, nv, scale, dst, K, r0 + (n0 / blk) * blks + (n0 % blk), scr, plane);
    }
}
__device__ __forceinline__ void conv_layer_weights(Frame& F, int l, int part) {
    unsigned char* wl = (unsigned char*)(F.ws + WS_W + (size_t)l * WL_STRIDE);
    const float* win = INP(2) + (size_t)l * D * INC; const float* n1 = INP(1) + l * D;
    const int BIGB = 1 << 30;
    if (part == 0) {
        conv_seg(F, win, INC, D, 0, 3328, 3328, n1, (bf16*)(wl + WL_IN), 0, BIGB, 0);
        conv_seg(F, win, INC, D, 3336, 2048, 2048, n1, (bf16*)(wl + WL_IN), 3328, BIGB, 0);
        conv_seg(F, win, INC, D, 3328, 8, 256, n1, (bf16*)(wl + WL_IN), 5376, BIGB, 0);
    } else {
        conv_seg8(F, win + 5384, INC, D, 3072, n1, 64.f, wl + WL_GATE, 0, BIGB, 0);
        for (int i = 0; i < 3; ++i)
            conv_seg(F, INP(23) + ((size_t)l * 3 + i) * 512 * D, D, 512, 0, D, D, nullptr, (bf16*)(wl + WL_BR) + (size_t)i * D * 512, 0, BIGB, 0);
        conv_seg(F, INP(24) + (size_t)l * D * D, D, D, 0, D, D, nullptr, (bf16*)(wl + WL_OUT), 0, BIGB, 0);
    }
}
__device__ __forceinline__ void conv_ffn_weights(Frame& F) {
    const float* n2 = INP(25);
#if FFN_UP8
    conv_seg8(F, INP(26), FF, D, FF, n2, 64.f, (unsigned char*)(F.ws + WS_FFUP), 0, 128, 256);
    conv_seg8(F, INP(27), FF, D, FF, n2, 64.f, (unsigned char*)(F.ws + WS_FFUP), 128, 128, 256);
#else
    conv_seg(F, INP(26), FF, D, 0, FF, FF, n2, (bf16*)(F.ws + WS_FFUP), 0, 128, 256);
    conv_seg(F, INP(27), FF, D, 0, FF, FF, n2, (bf16*)(F.ws + WS_FFUP), 128, 128, 256);
#endif
#if FFN_DN8
    conv_seg8(F, INP(28), D, FF, D, nullptr, 128.f, (unsigned char*)(F.ws + WS_FFDN), 0, 1 << 30, 0);
#else
    conv_seg(F, INP(28), D, FF, 0, D, D, nullptr, (bf16*)(F.ws + WS_FFDN), 0, 1 << 30, 0);
#endif
}
__device__ __forceinline__ unsigned char* moew_ptr(const Frame& F, int e) { return e < 3 ? (unsigned char*)F.out + MOEW_OUT + (size_t)e * MOEW_STRIDE : (unsigned char*)(F.ws + moew_wsoff(e)); }
__device__ __forceinline__ void conv_moe_weights(Frame& F, int e_lo, int e_hi) {
    const float* n2 = INP(25) + D;
    for (int e = e_lo; e < e_hi; ++e) {
        unsigned char* up = moew_ptr(F, e); unsigned char* dn = up + MOEW_DN;
        conv_seg8(F, INP(30) + (size_t)e * D * FFE, FFE, D, FFE, n2, 64.f, up, 0, 128, 256);
        conv_seg8(F, INP(31) + (size_t)e * D * FFE, FFE, D, FFE, n2, 64.f, up, 128, 128, 256);
        conv_seg8(F, INP(32) + (size_t)e * FFE * D, D, FFE, D, nullptr, 128.f, dn, 0, 1 << 30, 0);
    }
}
__device__ __forceinline__ void xprep_phase(Frame& F, const float* x) {
    const int ptid = otid(), plane = ptid & 63, pwave = __builtin_amdgcn_readfirstlane(ptid >> 6);
    const int gw = F.vcu * 8 + pwave, NGW = F.G * 8;
    bf16* xb = (bf16*)(F.ws + WS_XB); float* rstd = (float*)(F.ws + WS_RSTD);
    for (int m0 = 4 * gw; m0 < M; m0 += 4 * NGW) {
        f32x4 v[4][4];
#pragma unroll
        for (int q = 0; q < 4; ++q) { const f32x4* xr = (const f32x4*)(x + (size_t)(m0 + q) * D) + plane;
#pragma unroll
            for (int j = 0; j < 4; ++j) v[q][j] = xr[64 * j]; }
#pragma unroll
        for (int q = 0; q < 4; ++q) { const int m = m0 + q; float sq = 0.f;
#pragma unroll
            for (int j = 0; j < 4; ++j) sq += (v[q][j].x * v[q][j].x + v[q][j].y * v[q][j].y) + (v[q][j].z * v[q][j].z + v[q][j].w * v[q][j].w);
            sq = wave_sum(sq);
            if (plane == 0) rstd[m] = __builtin_amdgcn_rsqf(sq * (1.f / D) + 1e-6f);
            u32x2* o8 = (u32x2*)(xb + (size_t)m * D) + plane;
#pragma unroll
            for (int j = 0; j < 4; ++j) { u32x2 w; w.x = pk2(v[q][j].x, v[q][j].y); w.y = pk2(v[q][j].z, v[q][j].w); o8[64 * j] = w; }
            unsigned* x8 = (unsigned*)((unsigned char*)F.out + X8_OUT + (size_t)m * D) + plane;
#pragma unroll
            for (int j = 0; j < 4; ++j) x8[64 * j] = pk4f8(v[q][j].x * 4.f, v[q][j].y * 4.f, v[q][j].z * 4.f, v[q][j].w * 4.f); }
    }
}
__device__ __forceinline__ void final_norm_phase(Frame& F) {
    const int ptid = otid(), plane = ptid & 63, pwave = __builtin_amdgcn_readfirstlane(ptid >> 6);
    const int gw = F.vcu * 8 + pwave, NGW = F.G * 8;
    const float* fw = INP(33); const unsigned* pinfo = (const unsigned*)(F.ws + WS_PINFO); const int* cnt = (const int*)(F.ws + WS_CNT);
    int tb[8]; { int t = 0;
#pragma unroll
        for (int e = 0; e < 8; ++e) { int n = __builtin_amdgcn_readfirstlane(cnt[e]); n = n < 0 ? 0 : (n > 32768 ? 32768 : n); tb[e] = t; t += (n + 255) >> 8; } }
    const bf16* Y0 = (const bf16*)(F.ws + WS_YP0); const bf16* Y1 = (const bf16*)(F.ws + WS_YP1); const bf16* Y2 = (const bf16*)(F.ws + WS_YP2);
    f32x4 fwv[4];
#pragma unroll
    for (int j = 0; j < 4; ++j) fwv[j] = *((const f32x4*)fw + plane + 64 * j);
    unsigned pkv[2][2], pwv[2][2];
#define FN_PINFO(mm) do { _Pragma("unroll") for (int q_ = 0; q_ < 2; ++q_) _Pragma("unroll") for (int p_ = 0; p_ < 2; ++p_) { pkv[q_][p_] = pinfo[((size_t)((mm) + q_) * 2 + p_) * 2]; pwv[q_][p_] = pinfo[((size_t)((mm) + q_) * 2 + p_) * 2 + 1]; } } while (0)
    FN_PINFO((2 * gw < M) ? 2 * gw : 0);
    for (int m0 = 2 * gw; m0 < M; m0 += 2 * NGW) {
        f32x4 v[2][4]; u32x2 ya[2][2][4]; float wg[2][2]; int sgm[2][2]; const bf16* yp[2][2];
#pragma unroll
        for (int q = 0; q < 2; ++q) { const int m = m0 + q;
            const u32x2* xr = (const u32x2*)((const bf16*)(F.ws + WS_XB) + (size_t)m * D) + plane;
#pragma unroll
            for (int j = 0; j < 4; ++j) { const u32x2 xx = xr[64 * j]; v[q][j] = (f32x4){bflo(xx.x), bfhi(xx.x), bflo(xx.y), bfhi(xx.y)}; }
#pragma unroll
            for (int p = 0; p < 2; ++p) {
                const unsigned pk = __builtin_amdgcn_readfirstlane(pkv[q][p]); wg[q][p] = __builtin_bit_cast(float, __builtin_amdgcn_readfirstlane(pwv[q][p]));
                const int e = (int)(pk >> 20), slot = (int)(pk & 0xFFFFFu);
                int tbe = tb[0];
#pragma unroll
                for (int k = 1; k < 8; ++k) tbe = (e == k) ? tb[k] : tbe;
                const int gr = tbe * 256 + slot, seg = gr >> 15, lr = gr & 32767; sgm[q][p] = seg;
                yp[q][p] = (seg == 0 ? Y0 : (seg == 1 ? Y1 : Y2)) + (size_t)lr * D + 4 * plane; } }
        FN_PINFO((m0 + 2 * NGW < M) ? m0 + 2 * NGW : m0);
#pragma unroll
        for (int q = 0; q < 2; ++q)
#pragma unroll
            for (int p = 0; p < 2; ++p)
#pragma unroll
                for (int j = 0; j < 4; ++j) ya[q][p][j] = *(const u32x2*)(yp[q][p] + 256 * j);
#pragma unroll
        for (int q = 0; q < 2; ++q) { const int m = m0 + q;
#pragma unroll
            for (int p = 0; p < 2; ++p) { const float wgt = wg[q][p];
#pragma unroll
                for (int j = 0; j < 4; ++j) { const u32x2 yy = ya[q][p][j]; v[q][j].x += wgt * bflo(yy.x); v[q][j].y += wgt * bfhi(yy.x); v[q][j].z += wgt * bflo(yy.y); v[q][j].w += wgt * bfhi(yy.y); }
                if (sgm[q][p] == 2) {
#pragma unroll
                    for (int ks = 1; ks < MOE_KSP; ++ks)
#pragma unroll
                        for (int j = 0; j < 4; ++j) { const u32x2 yy = *(const u32x2*)(yp[q][p] + (size_t)ks * (YP2_STRIDE / 2) + 256 * j); v[q][j].x += wgt * bflo(yy.x); v[q][j].y += wgt * bfhi(yy.x); v[q][j].z += wgt * bflo(yy.y); v[q][j].w += wgt * bfhi(yy.y); } } }
            float ssq = 0.f;
#pragma unroll
            for (int j = 0; j < 4; ++j) ssq += (v[q][j].x * v[q][j].x + v[q][j].y * v[q][j].y) + (v[q][j].z * v[q][j].z + v[q][j].w * v[q][j].w);
            ssq = wave_sum(ssq);
            const float r = __builtin_amdgcn_rsqf(ssq * (1.f / D) + 1e-6f);
            f32x4* xo = (f32x4*)(F.out + (size_t)m * D) + plane;
#pragma unroll
            for (int j = 0; j < 4; ++j) xo[64 * j] = v[q][j] * r * fwv[j]; }
    }
#undef FN_PINFO
}
__device__ __forceinline__ void router_phase(Frame& F) {
    const int ptid = otid(), plane = ptid & 63, pwave = __builtin_amdgcn_readfirstlane(ptid >> 6);
    const float* nw = INP(25) + D; const float* rt = INP(29); bf16* xb = (bf16*)(F.ws + WS_XB);
    int* cnt = (int*)(F.ws + WS_CNT); int* list2 = (int*)(F.ws + WS_LIST);
    LAS int* lsel = (LAS int*)F.lds;
    LAS float* lwt = (LAS float*)(F.lds + 1024);
    LAS int* lrank = (LAS int*)(F.lds + 2048);
    LAS int* lcnt = (LAS int*)(F.lds + 3072);
    f32x4 nwq[4]; f32x4 rq[16][2];
#pragma unroll
    for (int j = 0; j < 4; ++j) { const int kk = 4 * plane + 256 * j; nwq[j] = *(const f32x4*)(nw + kk);
#pragma unroll
        for (int q = 0; q < 4; ++q) { rq[4 * j + q][0] = *(const f32x4*)(rt + (size_t)(kk + q) * 8); rq[4 * j + q][1] = *(const f32x4*)(rt + (size_t)(kk + q) * 8 + 4); } }
    for (int blk = F.vcu; blk < M / 128; blk += F.G) {
        if (ptid < 16) lcnt[ptid] = 0;
        __syncthreads();
        u32x2 xn[4];
        { const u32x2* xr2 = (const u32x2*)(xb + (size_t)(blk * 128 + pwave * 16) * D) + plane;
#pragma unroll
          for (int j = 0; j < 4; ++j) xn[j] = xr2[64 * j]; }
        for (int k = 0; k < 16; ++k) {
            const int lt = pwave * 16 + k, m = blk * 128 + lt;
            float acc[8];
#pragma unroll
            for (int e = 0; e < 8; ++e) acc[e] = 0.f;
            u32x2 xc[4];
#pragma unroll
            for (int j = 0; j < 4; ++j) xc[j] = xn[j];
            { const u32x2* xr2 = (const u32x2*)(xb + (size_t)((k + 1 < 16) ? m + 1 : m) * D) + plane;
#pragma unroll
                for (int j = 0; j < 4; ++j) xn[j] = xr2[64 * j]; }
            f32x4 xv4[4]; float ssq = 0.f;
#pragma unroll
            for (int j = 0; j < 4; ++j) { const u32x2 xx = xc[j]; xv4[j] = (f32x4){bflo(xx.x), bfhi(xx.x), bflo(xx.y), bfhi(xx.y)}; ssq += (xv4[j].x * xv4[j].x + xv4[j].y * xv4[j].y) + (xv4[j].z * xv4[j].z + xv4[j].w * xv4[j].w); }
            ssq = wave_sum(ssq);
            const float sc = __builtin_amdgcn_rsqf(ssq * (1.f / D) + 1e-6f);
            { unsigned* x8 = (unsigned*)(F.ws + WS_X8 + (size_t)m * D) + plane; const float s4 = 4.f * sc;
#pragma unroll
              for (int j = 0; j < 4; ++j) x8[64 * j] = pk4f8(xv4[j].x * s4, xv4[j].y * s4, xv4[j].z * s4, xv4[j].w * s4); }
#pragma unroll
            for (int j = 0; j < 4; ++j) { const f32x4 nwv = nwq[j];
#pragma unroll
                for (int q = 0; q < 4; ++q) { const float xv = xv4[j][q] * nwv[q];
                    const f32x4 r0v = rq[4 * j + q][0], r1v = rq[4 * j + q][1];
                    acc[0] += xv * r0v.x; acc[1] += xv * r0v.y; acc[2] += xv * r0v.z; acc[3] += xv * r0v.w; acc[4] += xv * r1v.x; acc[5] += xv * r1v.y; acc[6] += xv * r1v.z; acc[7] += xv * r1v.w; } }
#pragma unroll
            for (int e = 0; e < 8; ++e) acc[e] = wave_sum(acc[e]) * sc;
            int i0 = 0; float v0 = acc[0];
#pragma unroll
            for (int e = 1; e < 8; ++e) if (acc[e] > v0) { v0 = acc[e]; i0 = e; }
            int i1 = -1; float v1 = -3.0e38f;
#pragma unroll
            for (int e = 0; e < 8; ++e) if (e != i0 && acc[e] > v1) { v1 = acc[e]; i1 = e; }
            const float e1 = expf(v1 - v0), w0 = 1.f / (1.f + e1), w1 = e1 / (1.f + e1);
            if (plane == 0) { lsel[2 * lt] = i0; lsel[2 * lt + 1] = i1; lwt[2 * lt] = w0; lwt[2 * lt + 1] = w1;
                lrank[2 * lt] = atomicAdd((int*)(lcnt + i0), 1); lrank[2 * lt + 1] = atomicAdd((int*)(lcnt + i1), 1); }
        }
        __syncthreads();
        if (ptid < 8) lcnt[8 + ptid] = atomicAdd(cnt + ptid, lcnt[ptid]);
        __syncthreads();
        if (ptid < 256) { const int e = lsel[ptid], slot = lcnt[8 + e] + lrank[ptid];
            u32x2 v; v.x = (unsigned)(blk * 128 + (ptid >> 1)); v.y = __builtin_bit_cast(unsigned, lwt[ptid]);
            *(u32x2*)(list2 + ((size_t)e * 32768 + slot) * 2) = v;
            u32x2 pi; pi.x = ((unsigned)e << 20) | (unsigned)slot; pi.y = v.y; *(u32x2*)((unsigned*)(F.ws + WS_PINFO) + ((size_t)(blk * 128) * 2 + ptid) * 2) = pi; }
        __syncthreads();
    }
}

__device__ __forceinline__ void rstd_from_slots(Frame& F) {
    const int tid = otid(); const float* SS = (const float*)(F.ws + WS_SS1); float* rstd = (float*)(F.ws + WS_RSTD);
    for (int m = F.vcu * 512 + tid; m < M; m += F.G * 512) rstd[m] = pg8::rs_of(SS, 1, m);
}
__device__ __forceinline__ void vprep_phase(Frame& F, int layer) {
    const int ptid = otid(), plane = ptid & 63, pwave = __builtin_amdgcn_readfirstlane(ptid >> 6);
    constexpr int VP = 520, V_VB = 0, V_GB = 64 * VP * 2, V_VD = 2 * 64 * VP * 2;
    LAS bf16* VB = (LAS bf16*)(F.lds + V_VB); LAS bf16* GB = (LAS bf16*)(F.lds + V_GB); LAS bf16* VD = (LAS bf16*)(F.lds + V_VD);
    const bf16* P = (const bf16*)(F.ws + WS_BIG); bf16* VF = (bf16*)(F.ws + WS_VF); bf16* VM = (bf16*)(F.ws + WS_VMIX);
    const bf16* vdT = (const bf16*)(F.ws + WS_VLORA); const bf16* vuT = vdT + 32 * 512;
    const float* mu = INP(3) + layer * 1792 + 1024; const float* v0 = INP(16);
    const int tok = ptid >> 3, part = ptid & 7, r16 = plane & 15, q4 = plane >> 4;
    bf16x8 fdn[16], fup[16];
    if (layer != 0) {
#pragma unroll
        for (int k = 0; k < 16; ++k) { fdn[k] = *(const bf16x8*)(vdT + (size_t)(16 * (pwave >> 2) + r16) * 512 + 32 * k + 8 * q4); fup[k] = *(const bf16x8*)(vuT + (size_t)(16 * ((pwave >> 2) * 16 + k) + r16) * 32 + 8 * q4); }
    }
    for (int it = F.vcu; it < M / 64; it += F.G) {
        const int m = it * 64 + tok; const int t = m & (T - 1);
        const bf16* cur = P + (size_t)m * PLD + 1024 + part * 64;
        u32x4 cv8[8], pv8[8];
        { const bf16* prv = (t > 0) ? cur - PLD : cur;
#pragma unroll
          for (int q = 0; q < 8; ++q) { cv8[q] = *(const u32x4*)(cur + q * 8); pv8[q] = *(const u32x4*)(prv + q * 8); } }
#pragma unroll
        for (int q = 0; q < 8; ++q) { float c[8], p[8]; unpack8(cv8[q], c); unpack8(pv8[q], p);
            if (t == 0) {
#pragma unroll
                for (int e = 0; e < 8; ++e) p[e] = 0.f; }
            const f32x4 m0 = *(const f32x4*)(mu + part * 64 + q * 8), m1 = *(const f32x4*)(mu + part * 64 + q * 8 + 4);
#pragma unroll
            for (int e = 0; e < 4; ++e) { c[e] = c[e] + (p[e] - c[e]) * m0[e]; c[4 + e] = c[4 + e] + (p[4 + e] - c[4 + e]) * m1[e]; }
            const u32x4 o = pack8(c);
            if (layer == 0) *(u32x4*)(VF + (size_t)m * 512 + part * 64 + q * 8) = o; else *(LAS u32x4*)(VB + tok * VP + part * 64 + q * 8) = o; }
        if (layer == 0) continue;
        u32x4 vf8[8];
#pragma unroll
        for (int q = 0; q < 8; ++q) vf8[q] = *(const u32x4*)(VF + (size_t)m * 512 + part * 64 + q * 8);
        __syncthreads();
        { const int rb = pwave & 3, jt = pwave >> 2; f32x4 acc = {0.f, 0.f, 0.f, 0.f};
#pragma unroll
          for (int k = 0; k < 16; ++k) acc = __builtin_amdgcn_mfma_f32_16x16x32_bf16(*(const LAS bf16x8*)(VB + (16 * rb + r16) * VP + 32 * k + 8 * q4), fdn[k], acc, 0, 0, 0); (void)jt;
#pragma unroll
          for (int jj = 0; jj < 4; ++jj) VD[(16 * rb + 4 * q4 + jj) * 40 + 16 * jt + r16] = (bf16)f2bf(acc[jj]); }
        __syncthreads();
        { const int rb = pwave & 3; const bf16x8 af = *(const LAS bf16x8*)(VD + (16 * rb + r16) * 40 + 8 * q4);
#pragma unroll
          for (int i = 0; i < 16; ++i) { const int ct = (pwave >> 2) * 16 + i;
              const f32x4 acc = __builtin_amdgcn_mfma_f32_16x16x32_bf16(af, fup[i], (f32x4){0.f, 0.f, 0.f, 0.f}, 0, 0, 0);
              const float vc = v0[16 * ct + r16];
#pragma unroll
              for (int jj = 0; jj < 4; ++jj) GB[(16 * rb + 4 * q4 + jj) * VP + 16 * ct + r16] = (bf16)f2bf(sigm(vc + acc[jj])); } }
        __syncthreads();
#pragma unroll
        for (int q = 0; q < 8; ++q) { float v[8], g[8], vf[8]; unpack8(*(const LAS u32x4*)(VB + tok * VP + part * 64 + q * 8), v); unpack8(*(const LAS u32x4*)(GB + tok * VP + part * 64 + q * 8), g);
            unpack8(vf8[q], vf);
#pragma unroll
            for (int e = 0; e < 8; ++e) v[e] = v[e] + (vf[e] - v[e]) * g[e];
            *(u32x4*)(VM + (size_t)m * 512 + part * 64 + q * 8) = pack8(v); }
        __syncthreads();
    }
}
__device__ __forceinline__ void prepass_a(Frame& F) {
    const int tid = otid();
    bf16* P = (bf16*)(F.ws + WS_BIG); bf16* BND2 = (bf16*)(F.ws + WS_BND2);
    { const int ch = tid & 127; const int kind = ch >> 6, part = ch & 7;
      unsigned fph[4];
#pragma unroll
      for (int p = 0; p < 4; ++p) fph[p] = (unsigned)(long long)(exp(-(double)(part * 4 + p) * (9.210340371976184 / 32.0)) * 0.15915494309189535 * 4294967296.0 + 0.5);
      const int mstep = F.G * 4;
      for (int m0 = F.vcu * 4 + (tid >> 7); m0 < M; m0 += 4 * mstep) {
          u32x4 raw[4];
#pragma unroll
          for (int i = 0; i < 4; ++i) { const int m = m0 + i * mstep; raw[i] = (m < M) ? *(const u32x4*)(P + (size_t)m * PLD + C_RET + ch * 8) : (u32x4){0u, 0u, 0u, 0u}; }
#pragma unroll
          for (int i = 0; i < 4; ++i) { const int m = m0 + i * mstep; if (m >= M) break;
              const int t = m & (T - 1); bf16* ptr = P + (size_t)m * PLD + C_RET + ch * 8;
              float x[8]; unpack8(raw[i], x);
#pragma unroll
              for (int p = 0; p < 4; ++p) { const float rev = (float)((unsigned)t * fph[p]) * 2.3283064365386963e-10f;
                  const float sn = __builtin_amdgcn_sinf(rev), cs = __builtin_amdgcn_cosf(rev);
                  const float x0 = x[2 * p], x1 = x[2 * p + 1]; float o0 = x0 * cs - x1 * sn, o1 = x0 * sn + x1 * cs;
                  if (kind) { o0 *= 0.125f; o1 *= 0.125f; }
                  x[2 * p] = o0; x[2 * p + 1] = o1; }
              *(u32x4*)ptr = pack8(x); } } }
    for (int i = F.vcu * 512 + tid; i < 1024 * 3 * 128; i += F.G * 512) { const int ch = i & 127, k = (i >> 7) % 3, r = i / 384;
        if ((r & 511) != 0) *(u32x4*)(BND2 + ((size_t)r * 3 + k) * 1024 + ch * 8) = *(const u32x4*)(P + ((size_t)r * 32 - 3 + k) * PLD + C_XBC + ch * 8); }
}
__device__ __forceinline__ void prepass_conv(Frame& F, int layer) {
    const int tid = otid();
    bf16* P = (bf16*)(F.ws + WS_BIG); const bf16* BND2 = (const bf16*)(F.ws + WS_BND2);
    const float* cw = INP(17) + layer * 1024 * 4; const float* cbias = INP(18) + layer * 1024;
    const int ch = tid & 127;
    f32x4 wv[8]; float bv[8];
#pragma unroll
    for (int e = 0; e < 8; ++e) { wv[e] = *(const f32x4*)(cw + (ch * 8 + e) * 4); bv[e] = cbias[ch * 8 + e]; }
    for (int r = F.vcu * 4 + (tid >> 7); r < M / 32; r += F.G * 4) {
        float w0[8], w1[8], w2[8];
        if ((r & 511) != 0) { unpack8(*(const u32x4*)(BND2 + ((size_t)r * 3 + 0) * 1024 + ch * 8), w0); unpack8(*(const u32x4*)(BND2 + ((size_t)r * 3 + 1) * 1024 + ch * 8), w1); unpack8(*(const u32x4*)(BND2 + ((size_t)r * 3 + 2) * 1024 + ch * 8), w2); }
        else {
#pragma unroll
            for (int e = 0; e < 8; ++e) { w0[e] = 0.f; w1[e] = 0.f; w2[e] = 0.f; } }
        bf16* ptr = P + (size_t)r * 32 * PLD + C_XBC + ch * 8;
#pragma unroll
        for (int hb = 0; hb < 2; ++hb) {
            u32x4 raw[16];
#pragma unroll
            for (int i = 0; i < 16; ++i) raw[i] = *(const u32x4*)(ptr + (size_t)(16 * hb + i) * PLD);
#pragma unroll
            for (int i = 0; i < 16; ++i) {
                float x[8], o[8]; unpack8(raw[i], x);
#pragma unroll
                for (int e = 0; e < 8; ++e) { o[e] = silu(bv[e] + wv[e][0] * w0[e] + wv[e][1] * w1[e] + wv[e][2] * w2[e] + wv[e][3] * x[e]); w0[e] = w1[e]; w1[e] = w2[e]; w2[e] = x[e]; }
                *(u32x4*)(ptr + (size_t)(16 * hb + i) * PLD) = pack8(o);
            }
        }
    }
}
template <int CTRL> __device__ __forceinline__ float dpp_f(float v) { return __builtin_bit_cast(float, __builtin_amdgcn_update_dpp(0, __builtin_bit_cast(int, v), CTRL, 0xF, 0xF, true)); }
__device__ __forceinline__ float red8(float v) { v += dpp_f<0xB1>(v); v += dpp_f<0x4E>(v); v += dpp_f<0x141>(v); return v; }
__device__ __forceinline__ float red16(float v) { v = red8(v); v += dpp_f<0x140>(v); return v; }

__device__ __forceinline__ void rwkv_seq(Frame& F, int layer, int bh) {
    const int ptid = otid(), plane = ptid & 63, pwave = __builtin_amdgcn_readfirstlane(ptid >> 6); (void)plane; (void)pwave;
    const int b = bh >> 3, h = bh & 7;
    LAS float* L = (LAS float*)F.lds;
    LAS float *rr = L, *ww = L + 2048, *kf = L + 4096, *vv = L + 6144, *aa = L + 8192, *bb = L + 10240, *gg = L + 12288, *yy = L + 14336, *tw = L + 16384, *xa = L + 18432, *sg = L + 20480, *bon = L + 24576;
    const float* mu = INP(3) + layer * 1792; const float* w_up = INP(4) + layer * 64 * 512; const float* w0 = INP(5) + layer * 512;
    const float* a_up = INP(6) + layer * 64 * 512; const float* a0 = INP(7) + layer * 512; const float* g_up = INP(8) + layer * 128 * 512;
    const float* k_k = INP(9) + layer * 512; const float* k_a = INP(10) + layer * 512; const float* r_k = INP(11) + layer * 512;
    const float* gn_w = INP(12) + layer * 512; const float* gn_b = INP(13) + layer * 512;
    const bf16* P = (const bf16*)(F.ws + WS_BIG); const bf16* vsrc = (const bf16*)(F.ws + (layer == 0 ? WS_VF : WS_VMIX)); bf16* yout = (bf16*)(F.ws + WS_YRW);
    const int tid = ptid, tok = tid >> 4, part = tid & 15, c4 = part * 4, cb = h * 64 + c4;
    const int srow = tid >> 3, sc0 = (tid & 7) * 8;
    float S[8];
#pragma unroll
    for (int j = 0; j < 8; ++j) S[j] = 0.f;
    for (int t0 = 0; t0 < T; t0 += 32) {
        {
            const int t = t0 + tok; const size_t m = (size_t)b * T + t;
            const bf16* cur = P + m * PLD;
#pragma unroll
            for (int q = 0; q < 3; ++q) {
                const int ch = part + 16 * q; int col, kind; LAS float* dst;
                if (ch < 8) { col = h * 64 + ch * 8; dst = rr + tok * 64 + ch * 8; kind = 0; }
                else if (ch < 16) { col = 512 + h * 64 + (ch - 8) * 8; dst = kf + tok * 64 + (ch - 8) * 8; kind = 0; }
                else if (ch < 24) { col = 1536 + (ch - 16) * 8; dst = tw + tok * 64 + (ch - 16) * 8; kind = 1; }
                else if (ch < 32) { col = 1600 + (ch - 24) * 8; dst = xa + tok * 64 + (ch - 24) * 8; kind = 0; }
                else { col = 1664 + (ch - 32) * 8; dst = sg + tok * 128 + (ch - 32) * 8; kind = 2; }
                float c[8], p[8]; unpack8(*(const u32x4*)(cur + col), c);
                if (t > 0) unpack8(*(const u32x4*)(cur - PLD + col), p); else {
#pragma unroll
                    for (int e = 0; e < 8; ++e) p[e] = 0.f; }
#pragma unroll
                for (int e = 0; e < 8; ++e) { float x = c[e] + (p[e] - c[e]) * mu[col + e]; if (kind == 1) x = tanhf(x); else if (kind == 2) x = sigm(x); dst[e] = x; }
            }
            if (part < 8) { float v[8]; unpack8(*(const u32x4*)(vsrc + m * 512 + h * 64 + part * 8), v);
#pragma unroll
                for (int e = 0; e < 8; ++e) vv[tok * 64 + part * 8 + e] = v[e]; }
        }
        __syncthreads();
        {
            f32x4 dw = *(const f32x4*)(w0 + cb), da = *(const f32x4*)(a0 + cb), dg = (f32x4){0.f, 0.f, 0.f, 0.f};
            for (int j = 0; j < 64; ++j) { const float tj = tw[tok * 64 + j], xj = xa[tok * 64 + j];
                dw += *(const f32x4*)(w_up + j * 512 + cb) * tj; da += *(const f32x4*)(a_up + j * 512 + cb) * xj; }
            for (int j = 0; j < 128; ++j) dg += *(const f32x4*)(g_up + j * 512 + cb) * sg[tok * 128 + j];
            float kr[4], kk[4], av[4], ss = 0.f;
#pragma unroll
            for (int e = 0; e < 4; ++e) { kr[e] = kf[tok * 64 + c4 + e]; kk[e] = kr[e] * k_k[cb + e]; ss += kk[e] * kk[e]; av[e] = sigm(da[e]); }
            ss = red16(ss);
            const float inv = __builtin_amdgcn_rsqf(fmaxf(ss, 1e-24f));
            float bs = 0.f;
#pragma unroll
            for (int e = 0; e < 4; ++e) { const float kn = kk[e] * inv; const int o = tok * 64 + c4 + e;
                const float ld = -expf(-softplus_acc(-dw[e]) - 0.5f);
                ww[o] = expf(ld); aa[o] = -kn; bb[o] = kn * av[e];
                const float knew = kr[e] * (1.f + (av[e] - 1.f) * k_a[cb + e]); kf[o] = knew; gg[o] = dg[e];
                bs += rr[o] * knew * r_k[cb + e]; }
            bs = red16(bs);
            if (part == 0) bon[tok] = bs;
        }
        __syncthreads();
        for (int s = 0; s < 32; ++s) {
            const f32x4 a0v = *(const LAS f32x4*)(aa + s * 64 + sc0), a1v = *(const LAS f32x4*)(aa + s * 64 + sc0 + 4);
            const f32x4 w0v = *(const LAS f32x4*)(ww + s * 64 + sc0), w1v = *(const LAS f32x4*)(ww + s * 64 + sc0 + 4);
            const f32x4 b0v = *(const LAS f32x4*)(bb + s * 64 + sc0), b1v = *(const LAS f32x4*)(bb + s * 64 + sc0 + 4);
            const f32x4 k0v = *(const LAS f32x4*)(kf + s * 64 + sc0), k1v = *(const LAS f32x4*)(kf + s * 64 + sc0 + 4);
            const f32x4 r0v = *(const LAS f32x4*)(rr + s * 64 + sc0), r1v = *(const LAS f32x4*)(rr + s * 64 + sc0 + 4);
            const float vi = vv[s * 64 + srow];
            float sa = 0.f;
#pragma unroll
            for (int j = 0; j < 4; ++j) sa += S[j] * a0v[j] + S[4 + j] * a1v[j];
            sa = red8(sa);
            float y = 0.f;
#pragma unroll
            for (int j = 0; j < 4; ++j) { S[j] = S[j] * w0v[j] + sa * b0v[j] + vi * k0v[j]; S[4 + j] = S[4 + j] * w1v[j] + sa * b1v[j] + vi * k1v[j]; y += S[j] * r0v[j] + S[4 + j] * r1v[j]; }
            y = red8(y);
            if ((tid & 7) == 0) yy[s * 64 + srow] = y;
        }
        __syncthreads();
        {
            const size_t m = (size_t)b * T + t0 + tok;
            float y[4], sm = 0.f;
#pragma unroll
            for (int e = 0; e < 4; ++e) { y[e] = yy[tok * 64 + c4 + e]; sm += y[e]; }
            const float mean = red16(sm) * (1.f / 64.f);
            float vs = 0.f;
#pragma unroll
            for (int e = 0; e < 4; ++e) { y[e] -= mean; vs += y[e] * y[e]; }
            const float rs = __builtin_amdgcn_rsqf(red16(vs) * (1.f / 64.f) + 64e-5f);
            const float bo = bon[tok];
            float o[4];
#pragma unroll
            for (int e = 0; e < 4; ++e) { const int idx = tok * 64 + c4 + e; o[e] = (y[e] * rs * gn_w[cb + e] + gn_b[cb + e] + bo * vv[idx]) * gg[idx]; }
            u32x2 w; w.x = pk2(o[0], o[1]); w.y = pk2(o[2], o[3]);
            *(u32x2*)(yout + m * 512 + cb) = w;
        }
        __syncthreads();
    }
}

__device__ __forceinline__ void ret_seq(Frame& F, int bh) {
    const int ptid = otid(), plane = ptid & 63, pwave = __builtin_amdgcn_readfirstlane(ptid >> 6); (void)plane; (void)pwave;
    const int b = bh >> 3, h = bh & 7;
    LAS float* L = (LAS float*)F.lds;
    LAS float *qq = L, *kk = L + 2048, *vv = L + 4096, *gg = L + 6144, *yy = L + 8192;
    bf16* P = (bf16*)(F.ws + WS_BIG);
    const int tid = ptid, tok = tid >> 4, part = tid & 15, c4 = part * 4;
    const int se = tid >> 3, sd0 = (tid & 7) * 8;
    const float gamma = 1.f - exp2f(-5.f - (float)h);
    float S[8];
#pragma unroll
    for (int j = 0; j < 8; ++j) S[j] = 0.f;
    for (int t0 = 0; t0 < T; t0 += 32) {
        {
            const int t = t0 + tok; const size_t m = (size_t)b * T + t;
#pragma unroll
            for (int q = 0; q < 2; ++q) {
                const int ch = part + 16 * q, kind = ch >> 3, cc = ch & 7;
                float x[8]; unpack8(*(const u32x4*)(P + m * PLD + C_RET + kind * 512 + h * 64 + cc * 8), x);
                LAS float* dst = (kind == 0 ? qq : kind == 1 ? kk : kind == 2 ? vv : gg) + tok * 64 + cc * 8;
                if (kind < 2) {
#pragma unroll
                    for (int p = 0; p < 4; ++p) { const int i = cc * 4 + p;
                        const double invf = exp(-(double)i * (9.210340371976184 / 32.0));
                        double sn, cs; sincos((double)t * invf, &sn, &cs);
                        const float x0 = x[2 * p], x1 = x[2 * p + 1], c = (float)cs, s = (float)sn;
                        float o0 = x0 * c - x1 * s, o1 = x0 * s + x1 * c;
                        if (kind == 1) { o0 *= 0.125f; o1 *= 0.125f; }
                        dst[2 * p] = o0; dst[2 * p + 1] = o1; }
                } else {
#pragma unroll
                    for (int e = 0; e < 8; ++e) dst[e] = x[e];
                }
            }
        }
        __syncthreads();
        for (int s = 0; s < 32; ++s) {
            const f32x4 k0v = *(const LAS f32x4*)(kk + s * 64 + sd0), k1v = *(const LAS f32x4*)(kk + s * 64 + sd0 + 4);
            const f32x4 q0v = *(const LAS f32x4*)(qq + s * 64 + sd0), q1v = *(const LAS f32x4*)(qq + s * 64 + sd0 + 4);
            const float ve = vv[s * 64 + se];
            float y = 0.f;
#pragma unroll
            for (int j = 0; j < 4; ++j) { S[j] = gamma * S[j] + k0v[j] * ve; S[4 + j] = gamma * S[4 + j] + k1v[j] * ve; y += q0v[j] * S[j] + q1v[j] * S[4 + j]; }
            y = red8(y);
            if ((tid & 7) == 0) yy[s * 64 + se] = y;
        }
        __syncthreads();
        {
            const size_t m = (size_t)b * T + t0 + tok;
            float y[4], ss = 0.f;
#pragma unroll
            for (int e = 0; e < 4; ++e) { y[e] = yy[tok * 64 + c4 + e]; ss += y[e] * y[e]; }
            const float rs = __builtin_amdgcn_rsqf(red16(ss) * (1.f / 64.f) + 1e-6f);
            float o[4];
#pragma unroll
            for (int e = 0; e < 4; ++e) o[e] = y[e] * rs * silu(gg[tok * 64 + c4 + e]);
            u32x2 w; w.x = pk2(o[0], o[1]); w.y = pk2(o[2], o[3]);
            *(u32x2*)(P + m * PLD + C_RETG + h * 64 + c4) = w;
        }
        __syncthreads();
    }
}

__device__ __forceinline__ void ssd_seq(Frame& F, int layer, int bh) {
    const int ptid = otid(), plane = ptid & 63, pwave = __builtin_amdgcn_readfirstlane(ptid >> 6); (void)plane; (void)pwave;
    const int b = bh >> 3, h = bh & 7, g = h >> 2;
    LAS float* L = (LAS float*)F.lds;
    LAS float *raw = L  , *xs = L + 11200, *Bc = L + 13248, *Cc = L + 17344, *yy = L + 21440, *dts = L + 23488, *das = L + 23520;
    bf16* P = (bf16*)(F.ws + WS_BIG); const float* dtb = (const float*)(F.ws + WS_DT);
    const float* cw = INP(17) + layer * 1024 * 4; const float* cbias = INP(18) + layer * 1024;
    const float dt_bias = INP(19)[layer * 8 + h], A = -expf(INP(20)[layer * 8 + h]), Dh = INP(21)[layer * 8 + h];
    const int tid = ptid;
    const int sp = tid >> 3, sn0 = (tid & 7) * 16;
    float S[16];
#pragma unroll
    for (int j = 0; j < 16; ++j) S[j] = 0.f;
    for (int i = tid; i < 3 * 320; i += 512) raw[i] = 0.f;
    __syncthreads();
    for (int t0 = 0; t0 < T; t0 += 32) {
        for (int idx = tid; idx < 32 * 40; idx += 512) {
            const int row = idx / 40, ch = idx % 40; const size_t m = (size_t)b * T + t0 + row;
            const int col = ch < 8 ? (C_XBC + h * 64 + ch * 8) : (ch < 24 ? (C_XBC + 512 + g * 128 + (ch - 8) * 8) : (C_XBC + 768 + g * 128 + (ch - 24) * 8));
            float x[8]; unpack8(*(const u32x4*)(P + m * PLD + col), x);
#pragma unroll
            for (int e = 0; e < 8; ++e) raw[(3 + row) * 320 + ch * 8 + e] = x[e];
        }
        if (tid < 32) { const size_t m = (size_t)b * T + t0 + tid; const float dt = softplus_acc(dtb[m * 8 + h] + dt_bias); dts[tid] = dt; das[tid] = expf(A * dt); }
        __syncthreads();
        for (int idx = tid; idx < 32 * 320; idx += 512) {
            const int row = idx / 320, c = idx % 320;
            const int chn = c < 64 ? (h * 64 + c) : (c < 192 ? (512 + g * 128 + (c - 64)) : (768 + g * 128 + (c - 192)));
            float a = cbias[chn];
#pragma unroll
            for (int k = 0; k < 4; ++k) a += cw[chn * 4 + k] * raw[(row + k) * 320 + c];
            a = silu(a);
            if (c < 64) xs[row * 64 + c] = a; else if (c < 192) Bc[row * 128 + (c - 64)] = a; else Cc[row * 128 + (c - 192)] = a;
        }
        __syncthreads();
        for (int s = 0; s < 32; ++s) {
            const float da = das[s], xv = xs[s * 64 + sp], dtx = dts[s] * xv;
            float y = 0.f;
#pragma unroll
            for (int q = 0; q < 4; ++q) { const f32x4 bv = *(const LAS f32x4*)(Bc + s * 128 + sn0 + q * 4), cv = *(const LAS f32x4*)(Cc + s * 128 + sn0 + q * 4);
#pragma unroll
                for (int j = 0; j < 4; ++j) { S[q * 4 + j] = da * S[q * 4 + j] + dtx * bv[j]; y += S[q * 4 + j] * cv[j]; } }
            y = red8(y);
            if ((tid & 7) == 0) yy[s * 64 + sp] = y + Dh * xv;
        }
        __syncthreads();
        {
            const int tok = tid >> 4, c4 = (tid & 15) * 4; const size_t m = (size_t)b * T + t0 + tok;
            u32x2 w; w.x = pk2(yy[tok * 64 + c4], yy[tok * 64 + c4 + 1]); w.y = pk2(yy[tok * 64 + c4 + 2], yy[tok * 64 + c4 + 3]);
            *(u32x2*)(P + m * PLD + C_XBC + h * 64 + c4) = w;
            for (int i = tid; i < 3 * 320; i += 512) raw[i] = raw[32 * 320 + i];
        }
        __syncthreads();
    }
}
__device__ __forceinline__ void ssm_norm_phase(Frame& F, int layer) {
    const int ptid = otid(), plane = ptid & 63, pwave = __builtin_amdgcn_readfirstlane(ptid >> 6);
    const int gw = F.vcu * 8 + pwave, NGW = F.G * 8;
    bf16* P = (bf16*)(F.ws + WS_BIG); const float* nw = INP(22) + layer * 512;
    float nwv[8];
#pragma unroll
    for (int e = 0; e < 8; ++e) nwv[e] = nw[plane * 8 + e];
    for (int m0 = 4 * gw; m0 < M; m0 += 4 * NGW) {
        u32x4 yv[4], zv[4];
#pragma unroll
        for (int q = 0; q < 4; ++q) { yv[q] = *(const u32x4*)(P + (size_t)(m0 + q) * PLD + C_XBC + plane * 8); zv[q] = *(const u32x4*)(P + (size_t)(m0 + q) * PLD + C_Z + plane * 8); }
#pragma unroll
        for (int q = 0; q < 4; ++q) { float y[8], z[8]; unpack8(yv[q], y); unpack8(zv[q], z);
            float ss = 0.f;
#pragma unroll
            for (int e = 0; e < 8; ++e) { y[e] *= silu(z[e]); ss += y[e] * y[e]; }
            ss = red16(ss); ss += __shfl_xor(ss, 16);
            const float rs = __builtin_amdgcn_rsqf(ss * (1.f / 256.f) + 1e-6f);
#pragma unroll
            for (int e = 0; e < 8; ++e) y[e] *= rs * nwv[e];
            *(u32x4*)(P + (size_t)(m0 + q) * PLD + C_Z + plane * 8) = pack8(y); }
    }
}
constexpr int PT = 72, PT2 = 136, PF = 68;
__device__ __forceinline__ f32x4 mfma16(bf16x8 a, bf16x8 b, f32x4 c) { return __builtin_amdgcn_mfma_f32_16x16x32_bf16(a, b, c, 0, 0, 0); }
template <int K, bool SA = false, bool SB = false> __device__ __forceinline__ f32x4 mm_ll(const LAS bf16* A, int pa, int m0, const LAS bf16* B, int pb, int n0, f32x4 acc, int lane) {
    const int r = lane & 15, q = lane >> 4;
    const int xa = SA ? (((m0 + r) >> 3) & 7) : 0, xb = SB ? (((n0 + r) >> 3) & 7) : 0;
    const LAS bf16* ap = A + (m0 + r) * pa; const LAS bf16* bp = B + (n0 + r) * pb;
    bf16x8 fa[K / 32], fb[K / 32];
#pragma unroll
    for (int k = 0; k < K / 32; ++k) { fa[k] = *(const LAS bf16x8*)(ap + 8 * ((4 * k + q) ^ xa)); fb[k] = *(const LAS bf16x8*)(bp + 8 * ((4 * k + q) ^ xb)); }
    if constexpr (K == 64) asm("" : "+v"(fa[0]), "+v"(fa[1]), "+v"(fb[0]), "+v"(fb[1]));
    else if constexpr (K == 128) asm("" : "+v"(fa[0]), "+v"(fa[1]), "+v"(fa[2]), "+v"(fa[3]), "+v"(fb[0]), "+v"(fb[1]), "+v"(fb[2]), "+v"(fb[3]));
#pragma unroll
    for (int k = 0; k < K / 32; ++k) acc = mfma16(fa[k], fb[k], acc);
    return acc;
}
template <int K> __device__ __forceinline__ f32x4 mm_lg(const LAS bf16* A, int pa, int m0, const bf16* B, int pb, int n0, f32x4 acc, int lane) {
    const int r = lane & 15, q = lane >> 4;
    const LAS bf16* ap = A + (m0 + r) * pa + 8 * q; const bf16* bp = B + (size_t)(n0 + r) * pb + 8 * q;
#pragma unroll
    for (int k0 = 0; k0 < K; k0 += 32) acc = mfma16(*(const LAS bf16x8*)(ap + k0), *(const bf16x8*)(bp + k0), acc);
    return acc;
}
__device__ __forceinline__ float redl16(float v) { return red16(v); }
__device__ __forceinline__ void st4bf(LAS bf16* p, f32x4 v) { u32x2 w; w.x = pk2(v[0], v[1]); w.y = pk2(v[2], v[3]); *(LAS u32x2*)p = w; }
__device__ __forceinline__ float ldbf(const LAS bf16* p) { return __builtin_bit_cast(float, (unsigned)(*p) << 16); }
constexpr f32x4 FZ4 = {0.f, 0.f, 0.f, 0.f};
__device__ __forceinline__ void tr_write8(LAS bf16* Tm, int pitch, int c0, int t, const float (&v)[8], int) {
    LAS bf16* base = Tm + c0 * pitch + (t ^ (((c0 >> 3) & 7) << 3));
#pragma unroll
    for (int e = 0; e < 8; ++e) base[e * pitch] = (bf16)f2bf(v[e]);
}
__device__ __forceinline__ float tr_at(const LAS bf16* Tm, int pitch, int row, int col) { return __builtin_bit_cast(float, (unsigned)Tm[row * pitch + (col ^ (((row >> 3) & 7) << 3))] << 16); }
__device__ __forceinline__ void ld8f(const LAS float* p, float (&v)[8]) { const f32x4 a = *(const LAS f32x4*)p, b = *(const LAS f32x4*)(p + 4); v[0] = a[0]; v[1] = a[1]; v[2] = a[2]; v[3] = a[3]; v[4] = b[0]; v[5] = b[1]; v[6] = b[2]; v[7] = b[3]; }
__device__ __forceinline__ void st8f(LAS float* p, const float (&v)[8]) { *(LAS f32x4*)p = (f32x4){v[0], v[1], v[2], v[3]}; *(LAS f32x4*)(p + 4) = (f32x4){v[4], v[5], v[6], v[7]}; }

template <bool FINAL>
__device__ __forceinline__ void rwkv_chunk_units(Frame& F, int layer) {
    const int tid = otid(), w = __builtin_amdgcn_readfirstlane(tid >> 6);
    bf16x8 lfr[16];
#define IDS() const int ft = fresh_tid(tid); const int lane = ft & 63, r16 = lane & 15, q4 = lane >> 4, tok = ft >> 3, part = ft & 7; (void)lane; (void)r16; (void)q4; (void)tok; (void)part
    constexpr int NV = FINAL ? 64 : 128, NVT = NV / 16, NZ = NVT / 2;
    constexpr int X_TW = 0, X_XA = 9216, X_SG = 18432, X_KF = 35840, X_RF = 52224;
    constexpr int O_AT = 0, O_RT = 9216, O_BT = 18432, O_KT = 27648, O_BH = 36864, O_KH = 46080, O_VT = 55296, O_TF = O_BT;
    constexpr int Y0 = 68608;
    constexpr int Y_A = Y0, Y_B = Y0 + 8192, Y_K = Y0 + 16384, Y_R = Y0 + 24576, Y_L = Y0 + 32768, Y_VF = Y0 + 49152;
    constexpr int Y_AAB = Y0, Y_AAK = Y0 + 17408, Y_ARB = Y_AAK + 9216, Y_ARK = Y_ARB + 9216, Y_TB = FINAL ? Y_ARK + 9216 : Y_AAK + 9216, Y_ZU = Y_TB + 9216, Y_YF = Y_AAB;
    static_assert(Y_ZU + NV * PT * 2 <= Y0 + 65536, "region Y");
    constexpr int Z0 = Y0 + 65536, Z_G = Z0, Z_S = FINAL ? Z0 + 8192 : Z0, Z_MISC = 152576, Z_BON = Z_MISC, Z_PC = Z_MISC + 256, Z_PAR = Z_MISC + 512, Z_TOT = Z_PAR + 832 * 4, Z_XS = Y_ZU;
    static_assert(Z_S + NV * PT * 2 <= Z_MISC && Z_TOT + 4 * 64 * 4 <= LDSCTL_OFF, "region Z");
    LAS unsigned char* L = F.lds;
#define LB(off) ((LAS bf16*)(L + (off)))
#define LF(off) ((LAS float*)(L + (off)))
    const bf16* P = (const bf16*)(F.ws + WS_BIG); const bf16* vsrc = (const bf16*)(F.ws + (layer == 0 ? WS_VF : WS_VMIX));
    u32x4 pfc[6], pfp[6], pfv;
#define RW_PREFETCH(un, jn) do { IDS(); const int b_ = (un) >> 9, sc_ = ((un) >> 3) & 63, h_ = (un) & 7; const int t_ = sc_ * 256 + (jn) * 64 + tok; const size_t m_ = (size_t)b_ * T + t_; const bf16* cur_ = P + m_ * PLD; const bf16* prv_ = (t_ > 0) ? cur_ - PLD : cur_; \
        _Pragma("unroll") for (int i_ = 0; i_ < 6; ++i_) { const int col_ = (i_ == 0) ? (h_ * 64 + 8 * part) : (i_ == 1) ? (512 + h_ * 64 + 8 * part) : (i_ == 2) ? (1536 + 8 * part) : (i_ == 3) ? (1600 + 8 * part) : (1664 + 8 * part + (i_ - 4) * 64); \
            pfc[i_] = *(const u32x4*)(cur_ + col_); pfp[i_] = *(const u32x4*)(prv_ + col_); } \
        pfv = *(const u32x4*)(vsrc + m_ * 512 + h_ * 64 + 8 * part); } while (0)
    RW_PREFETCH((F.cid < 1024) ? F.cid : 0, 0);
    int h_staged = -1;
    for (int u = F.cid; u < 1024; u += F.G) {
    const int b = u >> 9, sc = (u >> 3) & 63, h = u & 7;
    if (h != h_staged) { h_staged = h; __syncthreads();
    {
        const int pidx = (w == 0) ? 5 : (w == 1) ? 7 : (w == 2) ? 9 : (w == 3) ? 10 : (w == 4) ? 11 : (w == 5) ? 12 : 13;
        if (w < 7) LF(Z_PAR)[w * 64 + (tid & 63)] = (INP(pidx) + layer * 512 + h * 64)[tid & 63];
        const float* mu = INP(3) + layer * 1792;
        for (int i = tid; i < 384; i += 512) LF(Z_PAR)[448 + i] = mu[(i < 64) ? (h * 64 + i) : (i < 128) ? (512 + h * 64 + (i - 64)) : (1536 + (i - 128))];
    }
    __syncthreads();
    const bf16* WupT = (const bf16*)(F.ws + WS_LORA + (size_t)layer * LORA_STRIDE) + h * 64 * 64;
    const bf16* AupT = (const bf16*)(F.ws + WS_LORA + (size_t)layer * LORA_STRIDE + 65536) + h * 64 * 64;
    const bf16* GupT = (const bf16*)(F.ws + WS_LORA + (size_t)layer * LORA_STRIDE + 131072) + h * 64 * 128;
    { IDS();
        if (w < 4 || !FINAL) {
#pragma unroll
            for (int nt = 0; nt < 4; ++nt)
#pragma unroll
                for (int k2 = 0; k2 < 2; ++k2) { lfr[nt * 4 + k2] = *(const bf16x8*)(WupT + (size_t)(16 * nt + r16) * 64 + 32 * k2 + 8 * q4); lfr[nt * 4 + 2 + k2] = *(const bf16x8*)(AupT + (size_t)(16 * nt + r16) * 64 + 32 * k2 + 8 * q4); }
        } else if (FINAL) {
#pragma unroll
            for (int nt = 0; nt < 4; ++nt)
#pragma unroll
                for (int k4 = 0; k4 < 4; ++k4) lfr[nt * 4 + k4] = *(const bf16x8*)(GupT + (size_t)(16 * nt + r16) * 128 + 32 * k4 + 8 * q4);
        } }
    }
    float* Nbuf = (float*)(F.st + 0) + (size_t)u * 4096; bf16* MT = (bf16*)(F.ws + WS_MT) + (size_t)u * 4096;
    constexpr int NST = FINAL ? 2 : 4;
    f32x4 Sacc[NST];
    const int s_vb = FINAL ? (w & 3) : w;
#define S_CT(ti) (FINAL ? (2 * (w >> 2) + (ti)) : (ti))
    { IDS();
#pragma unroll
    for (int ti = 0; ti < NST; ++ti) {
        const int ct = S_CT(ti);
        f32x4 nin = FZ4; if (FINAL) nin = *(const f32x4*)(Nbuf + ((s_vb * 4 + ct) * 64 + 16 * q4 + r16) * 4);
#pragma unroll
        for (int jj = 0; jj < 4; ++jj) { const int v = 16 * s_vb + 4 * q4 + jj, c = 16 * ct + r16;
            float x; if (FINAL) x = nin[jj]; else x = (v >= 64 && v - 64 == c) ? 1.f : 0.f;
            Sacc[ti][jj] = x; LB(Z_S)[v * PT + c] = (bf16)f2bf(x); }
    } }
    for (int j = 0; j < 4; ++j) {
        const int tl0 = sc * 256 + j * 64;
        {
            IDS();
            const int t = tl0 + tok; const size_t m = (size_t)b * T + t; const bf16* cur = P + m * PLD;
#pragma unroll
            for (int i = 0; i < 6; ++i) {
                const int col = (i == 0) ? (h * 64 + 8 * part) : (i == 1) ? (512 + h * 64 + 8 * part) : (i == 2) ? (1536 + 8 * part) : (i == 3) ? (1600 + 8 * part) : (1664 + 8 * part + (i - 4) * 64);
                float c[8], p[8]; unpack8(pfc[i], c); unpack8(pfp[i], p); (void)col;
                if (t == 0) {
#pragma unroll
                    for (int e = 0; e < 8; ++e) p[e] = 0.f; }
#pragma unroll
                for (int e = 0; e < 8; ++e) c[e] = c[e] + (p[e] - c[e]) * LF(Z_PAR)[448 + ((i < 4) ? 64 * i : 256 + 64 * (i - 4)) + 8 * part + e];
                if (i == 0) { st8f(LF(X_RF) + tok * 64 + 8 * part, c);
                } else if (i == 1) { st8f(LF(X_KF) + tok * 64 + 8 * part, c);
                } else if (i == 2) {
#pragma unroll
                    for (int e = 0; e < 8; ++e) c[e] = fast_tanh(c[e]);
                    *(LAS u32x4*)(LB(X_TW) + tok * PT + 8 * part) = pack8(c);
                } else if (i == 3) {
                    *(LAS u32x4*)(LB(X_XA) + tok * PT + 8 * part) = pack8(c);
                } else if (FINAL) {
#pragma unroll
                    for (int e = 0; e < 8; ++e) c[e] = sigm(c[e]);
                    *(LAS u32x4*)(LB(X_SG) + tok * PT2 + 8 * part + (i - 4) * 64) = pack8(c);
                }
            }
            float v[8]; unpack8(pfv, v); (void)m; (void)cur;
            st8f(LF(Y_VF) + tok * 64 + 8 * part, v);
        }
        { const int un_ = (j < 3) ? u : ((u + F.G < 1024) ? u + F.G : u), jn_ = (j < 3) ? j + 1 : 0; RW_PREFETCH(un_, jn_); }
        __syncthreads();
        { IDS();
        if (w < 4 || !FINAL) {
            const int rb = w & 3;
            float inv[4], bs[4] = {0.f, 0.f, 0.f, 0.f};
            { float ss[4] = {0.f, 0.f, 0.f, 0.f};
#pragma unroll
                for (int nt = 0; nt < 4; ++nt) { const int c = 16 * nt + r16; const float kkc = LF(Z_PAR)[128 + c];
#pragma unroll
                    for (int jj = 0; jj < 4; ++jj) { const float kk = LF(X_KF)[(16 * rb + 4 * q4 + jj) * 64 + c] * kkc; ss[jj] += kk * kk; } }
#pragma unroll
                for (int jj = 0; jj < 4; ++jj) inv[jj] = __builtin_amdgcn_rsqf(fmaxf(redl16(ss[jj]), 1e-24f)); }
#pragma unroll
            for (int nt = 0; nt < 4; ++nt) {
                if (!FINAL && (nt >> 1) != (w >> 2)) continue;
                f32x4 aw = FZ4, aa = FZ4;
#pragma unroll
                for (int k2 = 0; k2 < 2; ++k2) { aw = mfma16(*(const LAS bf16x8*)(LB(X_TW) + (16 * rb + r16) * PT + 32 * k2 + 8 * q4), lfr[nt * 4 + k2], aw); aa = mfma16(*(const LAS bf16x8*)(LB(X_XA) + (16 * rb + r16) * PT + 32 * k2 + 8 * q4), lfr[nt * 4 + 2 + k2], aa); }
                const int c = 16 * nt + r16; const float w0c = LF(Z_PAR)[c], a0c = LF(Z_PAR)[64 + c], kkc = LF(Z_PAR)[128 + c], kac = LF(Z_PAR)[192 + c], rkc = LF(Z_PAR)[256 + c];
                {
                    float lv[4];
#pragma unroll
                    for (int jj = 0; jj < 4; ++jj) lv[jj] = -0.8750455979f * sigm(w0c + aw[jj]);
                    lv[1] += lv[0]; lv[2] += lv[1]; lv[3] += lv[2];
                    const float s0 = lv[3]; const float u1 = __shfl(s0, (lane + 48) & 63); const float s1 = s0 + ((q4 >= 1) ? u1 : 0.f);
                    const float u2 = __shfl(s1, (lane + 32) & 63); const float s2 = s1 + ((q4 >= 2) ? u2 : 0.f); const float ex = s2 - s0;
#pragma unroll
                    for (int jj = 0; jj < 4; ++jj) LF(Y_L)[(16 * rb + 4 * q4 + jj) * 64 + c] = lv[jj] + ex;
                    if (q4 == 3) LF(Z_TOT)[rb * 64 + c] = lv[3] + ex; }
#pragma unroll
                for (int jj = 0; jj < 4; ++jj) { const int t = 16 * rb + 4 * q4 + jj, o = t * 64 + c;
                    const float al = sigm(a0c + aa[jj]), kraw = LF(X_KF)[o], rr = LF(X_RF)[o], kn = kraw * kkc * inv[jj];
                    const float knew = kraw * (1.f + (al - 1.f) * kac);
                    LB(Y_A)[o] = (bf16)f2bf(-kn); LB(Y_B)[o] = (bf16)f2bf(kn * al); LB(Y_K)[o] = (bf16)f2bf(knew); LB(Y_R)[o] = (bf16)f2bf(rr);
                    bs[jj] += rr * knew * rkc; } }
#pragma unroll
            for (int jj = 0; jj < 4; ++jj) { const float sm = redl16(bs[jj]); if (FINAL && r16 == 0) LF(Z_BON)[16 * rb + 4 * q4 + jj] = sm; }
        } else if (FINAL) {
            const int rb = w - 4;
#pragma unroll
            for (int nt = 0; nt < 4; ++nt) { f32x4 ag = FZ4;
#pragma unroll
                for (int k4 = 0; k4 < 4; ++k4) ag = mfma16(*(const LAS bf16x8*)(LB(X_SG) + (16 * rb + r16) * PT2 + 32 * k4 + 8 * q4), lfr[nt * 4 + k4], ag);
#pragma unroll
                for (int jj = 0; jj < 4; ++jj) LB(Z_G)[(16 * rb + 4 * q4 + jj) * 64 + 16 * nt + r16] = (bf16)f2bf(ag[jj]); }
        } }
        __syncthreads();
        {
            IDS(); const int t = tok, c0 = 8 * part;
            float Lt[8], Lp[8], Le[8], av[8], bv[8], kv[8], rv[8], vv[8], at[8], rt[8], bt[8], kt[8], bh[8], kh[8];
            { float t0[8], t1[8], t2[8], t3[8], off[8]; ld8f(LF(Z_TOT) + c0, t0); ld8f(LF(Z_TOT) + 64 + c0, t1); ld8f(LF(Z_TOT) + 128 + c0, t2); ld8f(LF(Z_TOT) + 192 + c0, t3);
              ld8f(LF(Y_L) + t * 64 + c0, Lt); ld8f(LF(Y_VF) + t * 64 + c0, vv);
              if ((t & 15) != 0) ld8f(LF(Y_L) + (t - 1) * 64 + c0, Lp); else {
#pragma unroll
                  for (int e = 0; e < 8; ++e) Lp[e] = 0.f; }
              const int rbk = t >> 4;
#pragma unroll
              for (int e = 0; e < 8; ++e) { off[e] = ((rbk > 0) ? t0[e] : 0.f) + ((rbk > 1) ? t1[e] : 0.f) + ((rbk > 2) ? t2[e] : 0.f); Le[e] = (t0[e] + t1[e]) + (t2[e] + t3[e]); Lt[e] += off[e]; Lp[e] += off[e]; }
              if (t == 0) {
#pragma unroll
                  for (int e = 0; e < 8; ++e) LF(Z_PC)[c0 + e] = ex2(Le[e]); } }
            unpack8(*(const LAS u32x4*)(LB(Y_A) + t * 64 + c0), av); unpack8(*(const LAS u32x4*)(LB(Y_B) + t * 64 + c0), bv);
            unpack8(*(const LAS u32x4*)(LB(Y_K) + t * 64 + c0), kv); unpack8(*(const LAS u32x4*)(LB(Y_R) + t * 64 + c0), rv);
#pragma unroll
            for (int e = 0; e < 8; ++e) { const float eL = ex2(Lt[e]), eLm = ex2(Lp[e]), eN = ex2(-Lt[e]), eE = ex2(Le[e] - Lt[e]);
                at[e] = av[e] * eLm; rt[e] = rv[e] * eL; bt[e] = bv[e] * eN; kt[e] = kv[e] * eN; bh[e] = bv[e] * eE; kh[e] = kv[e] * eE; }
            tr_write8(LB(O_BH), PT, c0, t, bh, part); tr_write8(LB(O_KH), PT, c0, t, kh, part); tr_write8(LB(O_VT), PT, c0, t, vv, part);
            *(LAS u32x4*)(LB(O_AT) + t * PT + c0) = pack8(at); *(LAS u32x4*)(LB(O_RT) + t * PT + c0) = pack8(rt);
            *(LAS u32x4*)(LB(O_BT) + t * PT + c0) = pack8(bt); *(LAS u32x4*)(LB(O_KT) + t * PT + c0) = pack8(kt);
        }
        __syncthreads();
        {
            IDS(); const int rb = w & 3;
#pragma unroll
            for (int ci = 0; ci < 2; ++ci) { const int ct = 2 * (w >> 2) + ci;
                f32x4 ab = FZ4, ak = FZ4, arb = FZ4, ark = FZ4;
                if (ct <= rb) { ab = mm_ll<64>(LB(O_AT), PT, 16 * rb, LB(O_BT), PT, 16 * ct, FZ4, lane); ak = mm_ll<64>(LB(O_AT), PT, 16 * rb, LB(O_KT), PT, 16 * ct, FZ4, lane);
                    if (FINAL) { arb = mm_ll<64>(LB(O_RT), PT, 16 * rb, LB(O_BT), PT, 16 * ct, FZ4, lane); ark = mm_ll<64>(LB(O_RT), PT, 16 * rb, LB(O_KT), PT, 16 * ct, FZ4, lane); } }
#pragma unroll
                for (int jj = 0; jj < 4; ++jj) { const int t = 16 * rb + 4 * q4 + jj, i = 16 * ct + r16;
                    LF(Y_AAB)[t * PF + i] = (i < t) ? ab[jj] : 0.f; LB(Y_TB)[t * PT + i] = (bf16)f2bf(((i >> 4) < (t >> 4)) ? ab[jj] : 0.f); LB(Y_AAK)[t * PT + i] = (bf16)f2bf((i < t) ? ak[jj] : 0.f);
                    if (FINAL) { LB(Y_ARB)[t * PT + i] = (bf16)f2bf((i <= t) ? arb[jj] : 0.f); LB(Y_ARK)[t * PT + i] = (bf16)f2bf((i <= t) ? ark[jj] : 0.f); } } }
        }
        __syncthreads();
        {
            IDS(); const int rb = w & 3;
            constexpr int O_DB = O_BT, O_VB = O_BT + 5120;
            if (w == 0) { const int blk = lane >> 4, col = lane & 15; float x[16];
#pragma unroll
                for (int i = 0; i < 16; ++i) x[i] = (i == col) ? 1.f : 0.f;
#pragma unroll
                for (int g3 = 0; g3 < 3; ++g3) {
                    f32x4 ar[5][4];
#pragma unroll
                    for (int ii = 0; ii < 5; ++ii) { const int i = 1 + 5 * g3 + ii;
#pragma unroll
                        for (int g4 = 0; g4 < 4; ++g4) if (4 * g4 < i) ar[ii][g4] = *(const LAS f32x4*)(LF(Y_AAB) + (16 * blk + i) * PF + 16 * blk + 4 * g4); }
                    asm volatile("" ::: "memory");
#pragma unroll
                    for (int ii = 0; ii < 5; ++ii) { const int i = 1 + 5 * g3 + ii; float sacc = 0.f;
#pragma unroll
                        for (int m2 = 0; m2 < i; ++m2) sacc += ar[ii][m2 >> 2][m2 & 3] * x[m2];
                        x[i] += sacc; }
                }
#pragma unroll
                for (int i = 0; i < 16; ++i) LB(O_DB)[(16 * blk + i) * 40 + col] = (bf16)f2bf(x[i]);
                *(LAS u32x4*)(LB(O_DB) + lane * 40 + 16) = (u32x4){0u, 0u, 0u, 0u}; *(LAS u32x4*)(LB(O_DB) + lane * 40 + 24) = (u32x4){0u, 0u, 0u, 0u}; }
            if (lane < 16) { *(LAS u32x4*)(LB(O_VB) + w * 640 + lane * 40 + 16) = (u32x4){0u, 0u, 0u, 0u}; *(LAS u32x4*)(LB(O_VB) + w * 640 + lane * 40 + 24) = (u32x4){0u, 0u, 0u, 0u}; }
#pragma unroll
            for (int ci = 0; ci < NZ; ++ci) { const int vt = (w >> 2) * NZ + ci;
                f32x4 z = mm_ll<64>(LB(O_AT), PT, 16 * rb, LB(Z_S), PT, 16 * vt, FZ4, lane);
                if (vt < 4) z = mm_ll<64, false, true>(LB(Y_AAK), PT, 16 * rb, LB(O_VT), PT, 16 * vt, z, lane);
                st4bf(LB(Y_ZU) + (16 * vt + r16) * PT + 16 * rb + 4 * q4, z); }
            __syncthreads();
            if (w < NVT) { const int vt = w; LAS bf16* vb = LB(O_VB) + w * 640; LAS bf16* zrow = LB(Y_ZU) + (16 * vt + r16) * PT;
#pragma unroll
                for (int bb = 0; bb < 4; ++bb) {
                    f32x4 acc; { const u32x2 zz = *(const LAS u32x2*)(zrow + 16 * bb + 4 * q4); acc[0] = bflo(zz.x); acc[1] = bfhi(zz.x); acc[2] = bflo(zz.y); acc[3] = bfhi(zz.y); }
                    if (bb >= 1) acc = mfma16(*(const LAS bf16x8*)(LB(Y_TB) + (16 * bb + r16) * PT + 8 * q4), *(const LAS bf16x8*)(zrow + 8 * q4), acc);
                    if (bb >= 3) acc = mfma16(*(const LAS bf16x8*)(LB(Y_TB) + (16 * bb + r16) * PT + 32 + 8 * q4), *(const LAS bf16x8*)(zrow + 32 + 8 * q4), acc);
                    st4bf(vb + r16 * 40 + 4 * q4, acc);
                    const f32x4 ub = mfma16(*(const LAS bf16x8*)(LB(O_DB) + (16 * bb + r16) * 40 + 8 * q4), *(const LAS bf16x8*)(vb + r16 * 40 + 8 * q4), FZ4);
                    st4bf(zrow + 16 * bb + 4 * q4, ub); }
            }
        }
        __syncthreads();
        {
            IDS(); f32x4 yy[2];
            if (FINAL) { const int rb = w & 3;
#pragma unroll
                for (int ci = 0; ci < 2; ++ci) { const int ct = 2 * (w >> 2) + ci;
                    f32x4 y = mm_ll<64>(LB(O_RT), PT, 16 * rb, LB(Z_S), PT, 16 * ct, FZ4, lane);
                    y = mm_ll<64>(LB(Y_ARB), PT, 16 * rb, LB(Y_ZU), PT, 16 * ct, y, lane);
                    yy[ci] = mm_ll<64, false, true>(LB(Y_ARK), PT, 16 * rb, LB(O_VT), PT, 16 * ct, y, lane); } }
#pragma unroll
            for (int ti = 0; ti < NST; ++ti) { const int ct = S_CT(ti); const float pc = LF(Z_PC)[16 * ct + r16];
                f32x4 s = Sacc[ti] * pc;
                s = mm_ll<64, false, true>(LB(Y_ZU), PT, 16 * s_vb, LB(O_BH), PT, 16 * ct, s, lane);
                if (s_vb < 4) s = mm_ll<64, true, true>(LB(O_VT), PT, 16 * s_vb, LB(O_KH), PT, 16 * ct, s, lane);
                Sacc[ti] = s; }
            __syncthreads();
#pragma unroll
            for (int ti = 0; ti < NST; ++ti) { const int ct = S_CT(ti);
#pragma unroll
                for (int jj = 0; jj < 4; ++jj) LB(Z_S)[(16 * s_vb + 4 * q4 + jj) * PT + 16 * ct + r16] = (bf16)f2bf(Sacc[ti][jj]); }
            if (FINAL) { const int rb = w & 3;
#pragma unroll
                for (int ci = 0; ci < 2; ++ci) { const int ct = 2 * (w >> 2) + ci;
#pragma unroll
                    for (int jj = 0; jj < 4; ++jj) LF(Y_YF)[(16 * rb + 4 * q4 + jj) * PF + 16 * ct + r16] = yy[ci][jj]; } }
        }
        __syncthreads();
        if (FINAL) {
            IDS();
            const int t = tok, c0 = 8 * part; const size_t m = (size_t)b * T + tl0 + t;
            float y[8], gg[8], sm = 0.f; ld8f(LF(Y_YF) + t * PF + c0, y); unpack8(*(const LAS u32x4*)(LB(Z_G) + t * 64 + c0), gg);
#pragma unroll
            for (int e = 0; e < 8; ++e) sm += y[e];
            const float mean = red8(sm) * (1.f / 64.f); float vs = 0.f;
#pragma unroll
            for (int e = 0; e < 8; ++e) { y[e] -= mean; vs += y[e] * y[e]; }
            const float rs = __builtin_amdgcn_rsqf(red8(vs) * (1.f / 64.f) + 64e-5f), bo = LF(Z_BON)[t];
#pragma unroll
            for (int e = 0; e < 8; ++e) { const int c = c0 + e; y[e] = (y[e] * rs * LF(Z_PAR)[320 + c] + LF(Z_PAR)[384 + c] + bo * tr_at(LB(O_VT), PT, c, t)) * gg[e]; }
            *(u32x4*)((bf16*)(F.ws + WS_BIG) + m * PLD + 1024 + h * 64 + c0) = pack8(y);
        }
        __syncthreads();
    }
    if (!FINAL) { IDS();
#pragma unroll
        for (int ti = 0; ti < NST; ++ti) { const int ct = S_CT(ti);
            if (s_vb < 4) { *(f32x4*)(Nbuf + ((s_vb * 4 + ct) * 64 + 16 * q4 + r16) * 4) = Sacc[ti];
            } else { u32x2 wv; wv.x = pk2(Sacc[ti][0], Sacc[ti][1]); wv.y = pk2(Sacc[ti][2], Sacc[ti][3]);
                *(u32x2*)(MT + (16 * ct + r16) * 64 + 16 * (s_vb - 4) + 4 * q4) = wv; }
        }
    }
    }
#undef RW_PREFETCH
#undef IDS
#undef S_CT
#undef LB
#undef LF
}

template <bool FINAL>
__device__ __forceinline__ void ret_chunk_units(Frame& F, int u0, int u1, int du) {
    const int tid = otid(), lane = tid & 63, w = __builtin_amdgcn_readfirstlane(tid >> 6), r16 = lane & 15, q4 = lane >> 4;
    constexpr int R_QB = 0, R_KB = 9216, R_KHT = 18432, R_VT = 27648, R_GB = 36864, R_AB = 45056, R_SB = 54272, R_YF = 63488;
    LAS unsigned char* L = F.lds;
#define LB(off) ((LAS bf16*)(L + (off)))
#define LF(off) ((LAS float*)(L + (off)))
    bf16* P = (bf16*)(F.ws + WS_BIG);
    const int tok = tid >> 3, part = tid & 7;
    const int db = w & 3;
    u32x4 pq = {0u, 0u, 0u, 0u}, pk, pv, pg = {0u, 0u, 0u, 0u};
#define RET_PREFETCH(un, jn) do { const int b_ = (un) >> 9, sc_ = ((un) >> 3) & 63, h_ = (un) & 7; const bf16* row_ = P + ((size_t)b_ * T + sc_ * 256 + (jn) * 64 + tok) * PLD + C_RET + h_ * 64 + 8 * part; \
        pk = *(const u32x4*)(row_ + 512); pv = *(const u32x4*)(row_ + 1024); if (FINAL) { pq = *(const u32x4*)row_; pg = *(const u32x4*)(row_ + 1536); } } while (0)
    RET_PREFETCH((u0 < u1) ? u0 : 0, 0);
    for (int u = u0; u < u1; u += du) {
    const int b = u >> 9, sc = (u >> 3) & 63, h = u & 7;
    float* Sbuf = (float*)(F.st + 16 * MiB) + (size_t)u * 4096;
    const float lg = log2f(1.f - exp2f(-5.f - (float)h));
    const float g64 = ex2(64.f * lg);
    f32x4 Sacc[2];
#pragma unroll
    for (int ci = 0; ci < 2; ++ci) { const int et = 2 * (w >> 2) + ci;
#pragma unroll
        for (int jj = 0; jj < 4; ++jj) Sacc[ci][jj] = FINAL ? Sbuf[(16 * db + 4 * q4 + jj) * 64 + 16 * et + r16] : 0.f;
        if (FINAL) st4bf(LB(R_SB) + (16 * et + r16) * PT + 16 * db + 4 * q4, Sacc[ci]); }
    for (int j = 0; j < 4; ++j) {
        const int tl0 = sc * 256 + j * 64;
        {
            float qv[8], kv[8], vv[8]; unpack8(pk, kv); unpack8(pv, vv);
            if (FINAL) { unpack8(pq, qv); *(LAS u32x4*)(LB(R_GB) + tok * 64 + 8 * part) = pg; }
            { const bool nu_ = (u + du < u1); const int un_ = (j < 3) ? u : (nu_ ? u + du : u), jn_ = (j < 3) ? j + 1 : (nu_ ? 0 : j); RET_PREFETCH(un_, jn_); }
            const float zeta = ex2((float)(63 - tok) * lg);
            if (FINAL) { *(LAS u32x4*)(LB(R_QB) + tok * PT + 8 * part) = pack8(qv); *(LAS u32x4*)(LB(R_KB) + tok * PT + 8 * part) = pack8(kv); }
            float kz[8];
#pragma unroll
            for (int e = 0; e < 8; ++e) kz[e] = kv[e] * zeta;
            tr_write8(LB(R_KHT), PT, 8 * part, tok, kz, part); tr_write8(LB(R_VT), PT, 8 * part, tok, vv, part);
        }
        __syncthreads();
        if (FINAL) { const int rb = w & 3;
#pragma unroll
            for (int ci = 0; ci < 2; ++ci) { const int ct = 2 * (w >> 2) + ci; f32x4 a = FZ4;
                if (ct <= rb) a = mm_ll<64>(LB(R_QB), PT, 16 * rb, LB(R_KB), PT, 16 * ct, FZ4, lane);
#pragma unroll
                for (int jj = 0; jj < 4; ++jj) { const int l = 16 * rb + 4 * q4 + jj, s = 16 * ct + r16; LB(R_AB)[l * PT + s] = (bf16)f2bf((s <= l) ? a[jj] * ex2((float)(l - s) * lg) : 0.f); } }
            __syncthreads();
        }
        {
            f32x4 yy[2];
            if (FINAL) { const int rb = w & 3;
#pragma unroll
                for (int ci = 0; ci < 2; ++ci) { const int et = 2 * (w >> 2) + ci;
                    const f32x4 a1 = mm_ll<64, false, true>(LB(R_AB), PT, 16 * rb, LB(R_VT), PT, 16 * et, FZ4, lane), a2 = mm_ll<64>(LB(R_QB), PT, 16 * rb, LB(R_SB), PT, 16 * et, FZ4, lane);
#pragma unroll
                    for (int jj = 0; jj < 4; ++jj) yy[ci][jj] = a1[jj] + ex2((float)(16 * rb + 4 * q4 + jj + 1) * lg) * a2[jj]; } }
#pragma unroll
            for (int ci = 0; ci < 2; ++ci) { const int et = 2 * (w >> 2) + ci; Sacc[ci] = mm_ll<64, true, true>(LB(R_KHT), PT, 16 * db, LB(R_VT), PT, 16 * et, Sacc[ci] * g64, lane); }
            __syncthreads();
            if (FINAL) { const int rb = w & 3;
#pragma unroll
                for (int ci = 0; ci < 2; ++ci) { const int et = 2 * (w >> 2) + ci; st4bf(LB(R_SB) + (16 * et + r16) * PT + 16 * db + 4 * q4, Sacc[ci]);
#pragma unroll
                    for (int jj = 0; jj < 4; ++jj) LF(R_YF)[(16 * rb + 4 * q4 + jj) * PF + 16 * et + r16] = yy[ci][jj]; } }
        }
        __syncthreads();
        if (FINAL) { const size_t m = (size_t)b * T + tl0 + tok; float y[8], g[8], ss = 0.f;
            ld8f(LF(R_YF) + tok * PF + 8 * part, y);
#pragma unroll
            for (int e = 0; e < 8; ++e) ss += y[e] * y[e];
            const float rs = __builtin_amdgcn_rsqf(red8(ss) * (1.f / 64.f) + 1e-6f);
            unpack8(*(const LAS u32x4*)(LB(R_GB) + tok * 64 + 8 * part), g);
#pragma unroll
            for (int e = 0; e < 8; ++e) y[e] = y[e] * rs * silu(g[e]);
            *(u32x4*)(P + m * PLD + C_RETG + h * 64 + 8 * part) = pack8(y);
            __syncthreads(); }
    }
    if (!FINAL) {
#pragma unroll
        for (int ci = 0; ci < 2; ++ci) { const int et = 2 * (w >> 2) + ci;
#pragma unroll
            for (int jj = 0; jj < 4; ++jj) Sbuf[(16 * db + 4 * q4 + jj) * 64 + 16 * et + r16] = Sacc[ci][jj]; }
    }
    }
#undef RET_PREFETCH
#undef LB
#undef LF
}

template <bool FINAL>
__device__ __forceinline__ void ssd_chunk_units(Frame& F, int layer, int u0, int u1, int du) {
    const int tid = otid(), w = __builtin_amdgcn_readfirstlane(tid >> 6);
#define IDS() const int ft = fresh_tid(tid); const int lane = ft & 63, r16 = lane & 15, q4 = lane >> 4; (void)lane; (void)r16; (void)q4
    constexpr int D_CB = 0, D_BB = 17408, D_BT = 34816, D_YF = 53248, D_XT = 70656, D_XDT = 79872, D_GM = 89088, D_SB = 98304, D_MISC = 115712;
    constexpr int D_DTS = D_MISC, D_ACS = D_MISC + 256, D_CAR = D_MISC + 512;
    LAS unsigned char* L = F.lds;
#define LB(off) ((LAS bf16*)(L + (off)))
#define LF(off) ((LAS float*)(L + (off)))
    bf16* P = (bf16*)(F.ws + WS_BIG); const float* dtb = (const float*)(F.ws + WS_DT);
    const bf16* BND = (const bf16*)(F.ws + WS_BND);
    const float* cw = INP(17) + layer * 1024 * 4; const float* cbias = INP(18) + layer * 1024; (void)cw; (void)cbias;
    const int bc_chunk = tid & 31, x_chunk = tid & 7;
    u32x4 pbc[4], px; float pdt = 0.f;
#define SSD_PREFETCH(un, jn) do { const int b_ = (un) >> 9, sc_ = ((un) >> 3) & 63, h_ = (un) & 7, g_ = h_ >> 2; const size_t m_ = (size_t)b_ * T + sc_ * 256 + (jn) * 64; \
        const int bcn_ = (bc_chunk < 16) ? (512 + g_ * 128 + bc_chunk * 8) : (768 + g_ * 128 + (bc_chunk - 16) * 8); \
        _Pragma("unroll") for (int it_ = 0; it_ < 4; ++it_) pbc[it_] = *(const u32x4*)(P + (m_ + it_ * 16 + (tid >> 5)) * PLD + C_XBC + bcn_); \
        px = *(const u32x4*)(P + (m_ + (tid >> 3)) * PLD + C_XBC + h_ * 64 + x_chunk * 8); if (w == 0) pdt = dtb[(m_ + (tid & 63)) * 8 + h_]; } while (0)
    SSD_PREFETCH((u0 < u1) ? u0 : 0, 0);
    for (int u = u0; u < u1; u += du) {
    const int b = u >> 9, sc = (u >> 3) & 63, h = u & 7, g = h >> 2; (void)g;
    float* Sbuf = (float*)(F.st + 32 * MiB) + (size_t)u * 8192;
    const float dt_bias = INP(19)[layer * 8 + h], A = -expf(INP(20)[layer * 8 + h]), Dh = INP(21)[layer * 8 + h];
    const int x_chn = h * 64 + x_chunk * 8; (void)x_chn;
    const int pb = w & 3;
    f32x4 Sacc[4];
    { IDS();
#pragma unroll
    for (int ci = 0; ci < 4; ++ci) { const int nt = 4 * (w >> 2) + ci;
#pragma unroll
        for (int jj = 0; jj < 4; ++jj) { const float x = FINAL ? Sbuf[(16 * pb + 4 * q4 + jj) * 128 + 16 * nt + r16] : 0.f; Sacc[ci][jj] = x;
            if (FINAL) LB(D_SB)[(16 * pb + 4 * q4 + jj) * PT2 + 16 * nt + r16] = (bf16)f2bf(x); } } }
    float dstot = 0.f;
    for (int j = 0; j < 4; ++j) {
        const int tl0 = sc * 256 + j * 64; const size_t m0 = (size_t)b * T + tl0;
        if (w == 0) {
            IDS(); const float dt = softplus_acc(pdt + dt_bias); float a = A * dt;
#pragma unroll
            for (int o = 1; o < 64; o <<= 1) { const float n = __shfl_up(a, o); if (lane >= o) a += n; }
            LF(D_DTS)[lane] = dt; LF(D_ACS)[lane] = a;
        }
        {
            IDS();
#pragma unroll
            for (int it = 0; it < 4; ++it) { const int t = it * 16 + (ft >> 5); const int ta = tl0 + t;
                float acc[8]; unpack8(pbc[it], acc); (void)ta;
                if (bc_chunk < 16) { *(LAS u32x4*)(LB(D_BB) + t * PT2 + bc_chunk * 8) = pack8(acc); tr_write8(LB(D_BT), PT, bc_chunk * 8, t, acc, bc_chunk & 7); }
                else *(LAS u32x4*)(LB(D_CB) + t * PT2 + (bc_chunk - 16) * 8) = pack8(acc);
            }
        }
        __syncthreads();
        {
            IDS(); const int t = ft >> 3; float acc[8]; unpack8(px, acc);
            { const bool nu_ = (u + du < u1); const int un_ = (j < 3) ? u : (nu_ ? u + du : u), jn_ = (j < 3) ? j + 1 : (nu_ ? 0 : j); SSD_PREFETCH(un_, jn_); }
            const float sc_d = LF(D_DTS)[t] * __expf(LF(D_ACS)[63] - LF(D_ACS)[t]);
            float xs8[8], xd8[8];
#pragma unroll
            for (int e = 0; e < 8; ++e) { xs8[e] = acc[e]; xd8[e] = acc[e] * sc_d; }
            tr_write8(LB(D_XT), PT, x_chunk * 8, t, xs8, x_chunk); tr_write8(LB(D_XDT), PT, x_chunk * 8, t, xd8, x_chunk);
        }
        if (FINAL) { IDS(); const int rb = w & 3;
#pragma unroll
            for (int ci = 0; ci < 2; ++ci) { const int ct = 2 * (w >> 2) + ci; f32x4 a = FZ4;
                if (ct <= rb) a = mm_ll<128>(LB(D_CB), PT2, 16 * rb, LB(D_BB), PT2, 16 * ct, FZ4, lane);
#pragma unroll
                for (int jj = 0; jj < 4; ++jj) { const int l = 16 * rb + 4 * q4 + jj, s = 16 * ct + r16;
                    LB(D_GM)[l * PT + s] = (bf16)f2bf((s <= l) ? a[jj] * __expf(LF(D_ACS)[l] - LF(D_ACS)[s]) * LF(D_DTS)[s] : 0.f); } } }
        __syncthreads();
        {
            IDS(); f32x4 yy[2];
            if (FINAL) { const int rb = w & 3;
#pragma unroll
                for (int ci = 0; ci < 2; ++ci) { const int pt = 2 * (w >> 2) + ci;
                    const f32x4 a1 = mm_ll<64, false, true>(LB(D_GM), PT, 16 * rb, LB(D_XT), PT, 16 * pt, FZ4, lane), a2 = mm_ll<128>(LB(D_CB), PT2, 16 * rb, LB(D_SB), PT2, 16 * pt, FZ4, lane);
#pragma unroll
                    for (int jj = 0; jj < 4; ++jj) { const int l = 16 * rb + 4 * q4 + jj, p = 16 * pt + r16; yy[ci][jj] = a1[jj] + __expf(LF(D_ACS)[l]) * a2[jj] + Dh * tr_at(LB(D_XT), PT, p, l); } } }
            const float dec = expf(LF(D_ACS)[63]);
#pragma unroll
            for (int ci = 0; ci < 4; ++ci) { const int nt = 4 * (w >> 2) + ci; Sacc[ci] = mm_ll<64, true, true>(LB(D_XDT), PT, 16 * pb, LB(D_BT), PT, 16 * nt, Sacc[ci] * dec, lane); }
            dstot += LF(D_ACS)[63];
            __syncthreads();
            if (FINAL) { const int rb = w & 3;
#pragma unroll
                for (int ci = 0; ci < 4; ++ci) { const int nt = 4 * (w >> 2) + ci;
#pragma unroll
                    for (int jj = 0; jj < 4; ++jj) LB(D_SB)[(16 * pb + 4 * q4 + jj) * PT2 + 16 * nt + r16] = (bf16)f2bf(Sacc[ci][jj]); }
#pragma unroll
                for (int ci = 0; ci < 2; ++ci) { const int pt = 2 * (w >> 2) + ci;
#pragma unroll
                    for (int jj = 0; jj < 4; ++jj) LF(D_YF)[(16 * rb + 4 * q4 + jj) * PF + 16 * pt + r16] = yy[ci][jj]; } }
        }
        __syncthreads();
        if (FINAL) { IDS(); const int tok = ft >> 3, part = ft & 7; float y[8];
            ld8f(LF(D_YF) + tok * PF + 8 * part, y);
            *(u32x4*)(P + (m0 + tok) * PLD + C_XBC + h * 64 + 8 * part) = pack8(y);
            __syncthreads(); }
    }
    if (!FINAL) { IDS();
#pragma unroll
        for (int ci = 0; ci < 4; ++ci) { const int nt = 4 * (w >> 2) + ci;
#pragma unroll
            for (int jj = 0; jj < 4; ++jj) Sbuf[(16 * pb + 4 * q4 + jj) * 128 + 16 * nt + r16] = Sacc[ci][jj]; }
        if (tid == 0) ((float*)(F.ws + WS_DSTOT))[u] = dstot;
    }
    }
#undef SSD_PREFETCH
#undef IDS
#undef LB
#undef LF
}

#define LBAR() do { asm volatile("s_waitcnt lgkmcnt(0)" ::: "memory"); __builtin_amdgcn_s_barrier(); asm volatile("" ::: "memory"); } while (0)
__device__ __forceinline__ void rwkv_scan_chain(Frame& F, int chain) {
    const int tid = otid(), lane = tid & 63, w = __builtin_amdgcn_readfirstlane(tid >> 6), r16 = lane & 15, q4 = lane >> 4;
    const int b = chain >> 3, h = chain & 7, vb = w & 3, ct0 = 2 * (w >> 2);
    LAS bf16* SB = (LAS bf16*)F.lds;
    f32x4 Sacc[2] = {FZ4, FZ4};
    for (int i = tid; i < 64 * PT / 2; i += 512) ((LAS unsigned*)SB)[i] = 0u;
    f32x4 nv[4][2]; bf16x8 mf[4][2][2];
#define CH_FETCH(s_, sc_) do { const int u_ = (b * 64 + (sc_)) * 8 + h; \
        const float* Nb_ = (const float*)(F.st + 0) + (size_t)u_ * 4096; const bf16* MT_ = (const bf16*)(F.ws + WS_MT) + (size_t)u_ * 4096; \
        _Pragma("unroll") for (int ci = 0; ci < 2; ++ci) { \
            nv[s_][ci] = *(const f32x4*)(Nb_ + ((vb * 4 + ct0 + ci) * 64 + lane) * 4); \
            _Pragma("unroll") for (int k2 = 0; k2 < 2; ++k2) mf[s_][ci][k2] = *(const bf16x8*)(MT_ + (size_t)(16 * (ct0 + ci) + r16) * 64 + 32 * k2 + 8 * q4); } } while (0)
    CH_FETCH(0, 0); CH_FETCH(1, 1); CH_FETCH(2, 2); CH_FETCH(3, 3);
    LBAR();
    for (int sc0 = 0; sc0 < 64; sc0 += 4) {
#pragma unroll
        for (int s = 0; s < 4; ++s) {
            const int sc = sc0 + s, u = (b * 64 + sc) * 8 + h;
            float* Nb = (float*)(F.st + 0) + (size_t)u * 4096;
            f32x4 nw[2];
#pragma unroll
            for (int ci = 0; ci < 2; ++ci) {
                f32x4 a = nv[s][ci];
#pragma unroll
                for (int k2 = 0; k2 < 2; ++k2) a = mfma16(*(const LAS bf16x8*)(SB + (16 * vb + r16) * PT + 32 * k2 + 8 * q4), mf[s][ci][k2], a);
                nw[ci] = a;
                *(f32x4*)(Nb + ((vb * 4 + ct0 + ci) * 64 + lane) * 4) = Sacc[ci]; }
            CH_FETCH(s, (sc + 4 < 64) ? sc + 4 : 63);
            LBAR();
#pragma unroll
            for (int ci = 0; ci < 2; ++ci) { Sacc[ci] = nw[ci];
#pragma unroll
                for (int jj = 0; jj < 4; ++jj) SB[(16 * vb + 4 * q4 + jj) * PT + 16 * (ct0 + ci) + r16] = (bf16)f2bf(nw[ci][jj]); }
            LBAR();
        }
    }
#undef CH_FETCH
    __syncthreads();
}
template <int ESZ, bool SSD> __device__ __forceinline__ void elem_scan_item(float* p, const float* d, float g256) {
    float carry = 0.f;
    for (int s0 = 0; s0 < 64; s0 += 32) {
        float t[32], dec[32];
#pragma unroll
        for (int sc = 0; sc < 32; ++sc) t[sc] = p[(size_t)(s0 + sc) * 8 * ESZ];
        if (SSD) {
#pragma unroll
            for (int sc = 0; sc < 32; ++sc) dec[sc] = d[(s0 + sc) * 8];
        }
#pragma unroll
        for (int sc = 0; sc < 32; ++sc) { p[(size_t)(s0 + sc) * 8 * ESZ] = carry; carry = (SSD ? __expf(dec[sc]) : g256) * carry + t[sc]; }
    }
}
__device__ __forceinline__ void elem_scans(Frame& F, int blk, int nblk) {
    const int tid = otid();
    const int NRET = 16 * 4096, NSSD = 16 * 8192;
    const float* dst = (const float*)(F.ws + WS_DSTOT);
    for (int it = blk * 512 + tid; it < NRET + NSSD; it += nblk * 512) {
        if (it < NRET) { const int chain = it >> 12, e = it & 4095, b = chain >> 3, h = chain & 7;
            const float g256 = exp2f(256.f * log2f(1.f - exp2f(-5.f - (float)h)));
            elem_scan_item<4096, false>((float*)(F.st + 16 * MiB) + ((size_t)(b * 64) * 8 + h) * 4096 + e, nullptr, g256);
        } else { const int i2 = it - NRET, chain = i2 >> 13, e = i2 & 8191, b = chain >> 3, h = chain & 7;
            elem_scan_item<8192, true>((float*)(F.st + 32 * MiB) + ((size_t)(b * 64) * 8 + h) * 8192 + e, dst + (b * 64) * 8 + h, 0.f);
        }
    }
}
__device__ __forceinline__ void conv_lora(Frame& F) {
    const int tid = otid();
    for (int l = 0; l < 2; ++l) {
        bf16* base = (bf16*)(F.ws + WS_LORA + (size_t)l * LORA_STRIDE);
        const float* wu = INP(4) + l * 64 * 512; const float* au = INP(6) + l * 64 * 512; const float* gu = INP(8) + l * 128 * 512;
        for (int i = F.vcu * 512 + tid; i < 512 * 64; i += F.G * 512) { const int c = i >> 6, jx = i & 63; base[i] = (bf16)f2bf(wu[jx * 512 + c]); base[32768 + i] = (bf16)f2bf(au[jx * 512 + c]); }
        for (int i = F.vcu * 512 + tid; i < 512 * 128; i += F.G * 512) { const int c = i >> 7, jx = i & 127; base[65536 + i] = (bf16)f2bf(gu[jx * 512 + c]); }
    }
}
__device__ __forceinline__ void conv_vlora(Frame& F) {
    const int tid = otid();
    bf16* vdT = (bf16*)(F.ws + WS_VLORA); bf16* vuT = vdT + 32 * 512;
    const float* vdn = INP(14); const float* vup = INP(15);
    for (int i = F.vcu * 512 + tid; i < 32 * 512; i += F.G * 512) { const int j = i >> 9, c = i & 511; vdT[i] = (bf16)f2bf(vdn[c * 32 + j]); }
    for (int i = F.vcu * 512 + tid; i < 512 * 32; i += F.G * 512) { const int c = i >> 5, j = i & 31; vuT[i] = (bf16)f2bf(vup[j * 512 + c]); }
}
__device__ __forceinline__ void save_bnd(Frame& F) {
    const int tid = otid();
    const bf16* P = (const bf16*)(F.ws + WS_BIG); bf16* BND = (bf16*)(F.ws + WS_BND);
    for (int i = F.vcu * 512 + tid; i < 2 * 64 * 3 * 64; i += F.G * 512) { const int ch = i & 63, k = (i >> 6) % 3, bs = i / 192, b = bs >> 6, sc = bs & 63;
        if (sc > 0) *(u32x4*)(BND + (size_t)(bs * 3 + k) * 512 + ch * 8) = *(const u32x4*)(P + ((size_t)b * T + sc * 256 - 3 + k) * PLD + C_XBC + ch * 8); }
}

__device__ __forceinline__ void stagger(int cid) { (void)cid; }
constexpr int LAYER_BASE0 = 1, LAYER_STRIDE = 18, MOE_BASE = LAYER_BASE0 + LAYER_STRIDE + 15;
__device__ __forceinline__ Frame lf(const Frame& F0) {
    Frame F = F0; unsigned l = (unsigned)(unsigned long long)F.lds;
    asm volatile("" : "+s"(l), "+s"(F.vcu), "+s"(F.G), "+s"(F.cid), "+s"(F.wid), "+s"(F.out), "+s"(F.ws), "+s"(F.st));
    F.lds = (LAS unsigned char*)(unsigned long long)l; return F;
}
__global__ void __launch_bounds__(512, 2) fwd(Args args) {
    extern __shared__ __attribute__((aligned(16))) unsigned char lds_raw[];
    Frame F0;
    F0.lds = (LAS unsigned char*)lds_raw;
    F0.G = gridDim.x; { const int bx = blockIdx.x; F0.vcu = (F0.G % 8 == 0) ? (bx % 8) * (F0.G / 8) + bx / 8 : bx; }
    F0.rr = 0; F0.cid = blockIdx.x; F0.out = (GAS float*)args.out; F0.ws = (GAS unsigned char*)args.ws; F0.wid = __builtin_amdgcn_readfirstlane(threadIdx.x >> 6); F0.st = (GAS unsigned char*)args.ws + WS_XB;
    volatile LAS unsigned* MISC = (volatile LAS unsigned*)(F0.lds + MISC_OFF);
    for (int u = threadIdx.x; u < (LDS_BYTES - LDSCTL_OFF) / 4; u += 512) ((LAS unsigned*)(F0.lds + LDSCTL_OFF))[u] = 0u;
    __syncthreads();
    if (threadIdx.x < 34) *(LAS unsigned long long*)(F0.lds + LDSCTL_OFF + 8 * threadIdx.x) = (unsigned long long)args.in[threadIdx.x];
    __syncthreads();
    const int lo = args.ph_lo, hi = args.ph_hi;
    XcdBarrier bar; bar.bar = (unsigned*)(F0.ws + WS_CTL); bar.x = 0; bar.st = nullptr;
    if (hi - lo > 1) bar = xcd_barrier_post((unsigned*)(F0.ws + WS_CTL), MISC + 8);
#define IN(k) (lo <= (k) && (k) < hi)
#define SEAM(k) do { if (IN(k) && IN((k) + 1)) xcd_barrier(bar); } while (0)
#define WSP(T_, off) ((T_*)(F.ws + (off)))

    if (IN(0)) { Frame F = lf(F0); conv_layer_weights(F, 0, 0); conv_lora(F); conv_vlora(F); xprep_phase(F, INP(0)); }
    SEAM(0);
    for (int l = 0; l < 2; ++l) {
        const int pb = LAYER_BASE0 + l * LAYER_STRIDE;
        F0.st = (GAS unsigned char*)F0.out;
        if (IN(pb + 0)) {
            Frame F = lf(F0); unsigned char* wl = (unsigned char*)(F.ws + WS_W + (size_t)l * WL_STRIDE);
            pg8::Gemm g{WSP(bf16, WS_XB), (const bf16*)(wl + WL_IN), D, D, D}; pg8::StaticOrder S; S.init(M, NP, F.G, F.cid, D, D);
            pg8::EpiInProj E{WSP(bf16, WS_BIG), (l == 0) ? WSP(float, WS_RSTD) : WSP(float, WS_SS1), WSP(float, WS_DT), l};
            stagger(F.cid); pg8::gemm_phase(F.lds, F.wid, g, S, E);
        }
        SEAM(pb + 0);
        if (IN(pb + 1)) { Frame F = lf(F0); if (l == 1) rstd_from_slots(F); vprep_phase(F, l); prepass_a(F); }
        SEAM(pb + 1);
        if (IN(pb + 2)) { Frame F = lf(F0); prepass_conv(F, l); }
        if (IN(pb + 2) && IN(pb + 3)) xcd_barrier(bar);
        if (IN(pb + 3)) for (int rep = 0; rep <= REP_R1; ++rep) {
#if RW_CH
            for (int r2 = 0; r2 <= REP_RW; ++r2) { Frame F = lf(F0); rwkv_chunk_units<false>(F, l); }
#else
            { Frame F = lf(F0); if (F.cid < 16) rwkv_seq(F, l, F.cid); }
#endif
#if RET_CH
            for (int r2 = 0; r2 <= REP_RET; ++r2) { Frame F = lf(F0); ret_chunk_units<false>(F, F.cid, 1024, F.G); }
#else
            { Frame F = lf(F0); if (F.cid >= 32 && F.cid < 48) ret_seq(F, F.cid - 32); }
#endif
#if SSD_CH
            for (int r2 = 0; r2 <= REP_SSD; ++r2) { Frame F = lf(F0); ssd_chunk_units<false>(F, l, F.cid, 1024, F.G); }
#else
            { Frame F = lf(F0); if (F.cid >= 16 && F.cid < 32) ssd_seq(F, l, F.cid - 16); }
#endif
        }
        SEAM(pb + 3);
        if (IN(pb + 4)) { Frame F = lf(F0); elem_scans(F, F.cid, F.G); }
        SEAM(pb + 4);
        if (IN(pb + 5)) {
            Frame F = lf(F0);
            if (F.cid < 16) { if (RW_CH) rwkv_scan_chain(F, F.cid);
                ssd_chunk_units<true>(F, l, 960 + F.cid, 1024, 16); }
            else {
                Frame Fc = lf(F0); Fc.vcu = Fc.cid - 16; Fc.cid = Fc.cid - 16; Fc.G = Fc.G - 16;
                if (l == 0) { conv_layer_weights(Fc, 0, 1); conv_layer_weights(Fc, 1, 0); conv_layer_weights(Fc, 1, 1); conv_ffn_weights(Fc); conv_moe_weights(Fc, 0, 3); }
                else conv_moe_weights(Fc, 3, NE);
                __syncthreads();
                ret_chunk_units<true>(Fc, Fc.cid, 1024, Fc.G);
                ssd_chunk_units<true>(Fc, l, Fc.cid, 960, Fc.G);
            }
        }
        if (IN(pb + 5)) xcd_barrier(bar);
        if (IN(pb + 5)) { { Frame F = lf(F0); ssm_norm_phase(F, l); }
                          { Frame F = lf(F0); rwkv_chunk_units<true>(F, l); } }
        SEAM(pb + 5);
        if (IN(pb + 7)) {
            Frame F = lf(F0); unsigned char* wl = (unsigned char*)(F.ws + WS_W + (size_t)l * WL_STRIDE); bf16* P = WSP(bf16, WS_BIG);
            pg8::Gemm g{P, (const bf16*)(wl + WL_BR), PLD, 512, 512}; pg8::BranchOrder S; S.init(F.G, F.cid);
            pg8::EpiPlain E{P, WSP(bf16, WS_VMIX)};
            stagger(F.cid); pg8::gemm_phase(F.lds, F.wid, g, S, E);
        }
        SEAM(pb + 7);
        if (IN(pb + 8)) {
            Frame F = lf(F0); unsigned char* wl = (unsigned char*)(F.ws + WS_W + (size_t)l * WL_STRIDE); bf16* P = WSP(bf16, WS_BIG);
            pg8::Gemm g{(const bf16*)((unsigned char*)F.out + X8_OUT), (const bf16*)(wl + WL_GATE), D / 2, D / 2, D / 2}; pg8::GateOrder S; S.init(F.G, F.cid, D / 2);
            pg8::EpiGateMerge E{P, WSP(const bf16, WS_VMIX), P + C_RET, PLD, WSP(float, WS_RSTD), 1.f / 256.f};
            stagger(F.cid); pg8::gemm_phase<pg8::EpiGateMerge, pg8::GateOrder, true>(F.lds, F.wid, g, S, E);
        }
        if (IN(pb + 8) && IN(pb + 13)) xcd_barrier(bar);
        if (IN(pb + 13)) {
            Frame F = lf(F0); unsigned char* wl = (unsigned char*)(F.ws + WS_W + (size_t)l * WL_STRIDE); bf16* P = WSP(bf16, WS_BIG);
            pg8::Gemm g{P + C_RET, (const bf16*)(wl + WL_OUT), PLD, D, D}; pg8::StaticOrder S; S.init(M, D, F.G, F.cid, PLD, D);
            pg8::EpiResidB E{WSP(bf16, WS_XB), (l == 0) ? WSP(float, WS_SS2) : nullptr, nullptr, (l == 0 && FFN_UP8) ? (unsigned char*)F.out + X8_OUT : nullptr};
            stagger(F.cid); pg8::gemm_phase(F.lds, F.wid, g, S, E);
        }
        SEAM(pb + 13);
        if (IN(pb + 14)) { Frame F = lf(F0); if (l == 1) router_phase(F); }
        if (l == 1) SEAM(pb + 14);
        if (l == 0) {
            if (IN(pb + 15)) {
                Frame F = lf(F0);
#if FFN_UP8
                pg8::Gemm g{(const bf16*)((unsigned char*)F.out + X8_OUT), WSP(const bf16, WS_FFUP), D / 2, D / 2, D / 2}; pg8::StaticOrder S; S.init(M, 2 * FF, F.G, F.cid, D / 2, D / 2);
                const float amul = 1.f / 256.f;
#else
                pg8::Gemm g{WSP(bf16, WS_XB), WSP(const bf16, WS_FFUP), D, D, D}; pg8::StaticOrder S; S.init(M, 2 * FF, F.G, F.cid, D, D);
                const float amul = 1.f;
#endif
#if FFN_DN8
                pg8::EpiSwiglu8R E{WSP(unsigned char, WS_ACT), FF, WSP(float, WS_SS2), 1, amul};
                stagger(F.cid); pg8::gemm_phase<pg8::EpiSwiglu8R, pg8::StaticOrder, FFN_UP8 != 0>(F.lds, F.wid, g, S, E);
#else
                pg8::EpiSwiglu E{WSP(bf16, WS_ACT), FF, WSP(float, WS_SS2), 1, amul};
                stagger(F.cid); pg8::gemm_phase<pg8::EpiSwiglu, pg8::StaticOrder, FFN_UP8 != 0>(F.lds, F.wid, g, S, E);
#endif
            }
            SEAM(pb + 15);
            if (IN(pb + 16)) {
                Frame F = lf(F0);
#if FFN_DN8
                pg8::Gemm g{WSP(const bf16, WS_ACT), WSP(const bf16, WS_FFDN), FF / 2, FF / 2, FF / 2}; pg8::StaticOrder S; S.init(M, D, F.G, F.cid, FF / 2, FF / 2);
                pg8::EpiResidB E{WSP(bf16, WS_XB), WSP(float, WS_SS1), nullptr, (unsigned char*)F.out + X8_OUT, 1.f / 1024.f};
#else
                pg8::Gemm g{WSP(const bf16, WS_ACT), WSP(const bf16, WS_FFDN), FF, FF, FF}; pg8::StaticOrder S; S.init(M, D, F.G, F.cid, FF, FF);
                pg8::EpiResidB E{WSP(bf16, WS_XB), WSP(float, WS_SS1), nullptr, (unsigned char*)F.out + X8_OUT};
#endif
                stagger(F.cid); pg8::gemm_phase<pg8::EpiResidB, pg8::StaticOrder, FFN_DN8 != 0>(F.lds, F.wid, g, S, E);
            }
            if (IN(pb + 16) && IN(pb + 18)) xcd_barrier(bar);
        }
    }
    {
        const int pb = MOE_BASE;
        for (int st = 0; st < 6; ++st) {
            const int isup = (st == 0 || st == 2 || st == 3), sg = (st < 2) ? 0 : ((st == 2 || st == 4) ? 1 : 2);
            if (IN(pb + st)) {
                if (isup) {
                    Frame F = lf(F0);
                    unsigned char* wb = (unsigned char*)F.out + MOEW_OUT;
                    pg8::Gemm g{WSP(bf16, WS_X8), (const bf16*)wb, D / 2, D / 2, D / 2}; pg8::MoeOrder<true> S; S.init(WSP(const int, WS_CNT), WSP(const int, WS_LIST), sg, 2 * FFE, F.G, F.cid, D / 2, D / 2, MOEW_STRIDE, (const unsigned char*)F.ws, wb);
                    pg8::EpiSwiglu8 E{(sg == 2) ? WSP(unsigned char, WS_ACT2) : WSP(unsigned char, WS_ACT), FFE};
                    stagger(F.cid); pg8::gemm_phase<pg8::EpiSwiglu8, pg8::MoeOrder<true>, true>(F.lds, F.wid, g, S, E);
                } else {
                    Frame F = lf(F0);
                    const int ksp = (sg == 2) ? MOE_KSP : 1;
                    unsigned char* wb = (unsigned char*)F.out + MOEW_OUT;
                    pg8::Gemm g{(sg == 2) ? WSP(const bf16, WS_ACT2) : WSP(const bf16, WS_ACT), (const bf16*)(wb + MOEW_DN), FFE / 2, FFE / 2, FFE / 2 / ksp}; pg8::MoeOrder<false> S; S.init(WSP(const int, WS_CNT), WSP(const int, WS_LIST), sg, D, F.G, F.cid, FFE / 2, FFE / 2, MOEW_STRIDE, (const unsigned char*)F.ws, wb, ksp, FFE / 2 / ksp);
                    pg8::EpiMoeOut E{(sg == 0) ? WSP(bf16, WS_YP0) : (sg == 1 ? WSP(bf16, WS_YP1) : WSP(bf16, WS_YP2)), YP2_STRIDE / 2, 1.f / 1024.f};
                    stagger(F.cid); pg8::gemm_phase<pg8::EpiMoeOut, pg8::MoeOrder<false>, true>(F.lds, F.wid, g, S, E);
                }
            }
            SEAM(pb + st);
        }
        if (IN(pb + 6)) { Frame F = lf(F0); final_norm_phase(F); }
    }
#undef IN
#undef SEAM
#undef WSP
}
constexpr int LAST_PHASE = MOE_BASE + 6;
constexpr int N_PH = LAST_PHASE + 1;

extern "C" void kernel_launch(void* const* d_in, const int* in_sizes, int n_in, void* d_out, int out_size, void* d_ws, size_t ws_size, hipStream_t stream) {
    static int grid = 0;
    if (grid == 0) {
        if (n_in != 34 || out_size != M * D || ws_size < WS_END) { fprintf(stderr, "kernel_launch: unexpected problem (n_in %d out %d ws %zu need %zu)\n", n_in, out_size, ws_size, (size_t)WS_END); grid = -1; return; }
        int dev = 0, cus = 0;
        if (hipGetDevice(&dev) != hipSuccess || hipDeviceGetAttribute(&cus, hipDeviceAttributeMultiprocessorCount, dev) != hipSuccess) { grid = -1; return; }
        if (hipFuncSetAttribute((const void*)fwd, hipFuncAttributeMaxDynamicSharedMemorySize, LDS_BYTES) != hipSuccess) { fprintf(stderr, "kernel_launch: hipFuncSetAttribute failed\n"); grid = -1; return; }
        int per_cu = 0;
        if (hipOccupancyMaxActiveBlocksPerMultiprocessor(&per_cu, (const void*)fwd, 512, LDS_BYTES) != hipSuccess || per_cu < 1) fprintf(stderr, "kernel_launch: occupancy query says %d\n", per_cu);
        (void)hipGetLastError();
        grid = cus;
    }
    if (grid < 0) return;
    (void)hipMemsetAsync((char*)d_ws + WS_CTL, 0, CTL_ZERO_BYTES, stream);
    Args a{};
    for (int i = 0; i < 34; ++i) a.in[i] = (const float*)d_in[i];
    a.out = (float*)d_out; a.ws = (unsigned char*)d_ws;
#if MK_ONE_LAUNCH
    a.ph_lo = 0; a.ph_hi = N_PH;
    hipLaunchKernelGGL(fwd, dim3(grid), dim3(512), LDS_BYTES, stream, a);
#else
    for (int p = 0; p < N_PH; ++p) { a.ph_lo = p; a.ph_hi = p + 1; hipLaunchKernelGGL(fwd, dim3(grid), dim3(512), LDS_BYTES, stream, a); }
#endif
}
```
